# Optimizing an MI355X kernel written in HIP

```python
import math
import jax
import jax.numpy as jnp
from jax import lax
import numpy as np


D_MODEL = 1024
BATCH = 1
SEQ = 16384
DEPTH = 4

N_MIXERS = 3
N_LAYERS_A = (DEPTH + 2) // 3
N_LAYERS_B = (DEPTH + 1) // 3
N_LAYERS_C = DEPTH // 3
DEEPNORM_ALPHA = (2.0 * DEPTH) ** 0.25
DEEPNORM_BETA = (8.0 * DEPTH) ** -0.25
LN_EPS = 1e-5

RW_HEAD = 64
RW_HEADS = D_MODEL // RW_HEAD
RW_DECAY_LORA = 64
RW_AAA_LORA = 64
RW_GATE_LORA = 160
RW_GN_EPS = 64e-5

MB_DI = 2 * D_MODEL
MB_HEADDIM = 64
MB_HEADS = MB_DI // MB_HEADDIM
MB_GROUPS = 4
MB_HPG = MB_HEADS // MB_GROUPS
MB_STATE = 128
MB_CONV = 4
MB_CHUNK = 128
MB_CONV_DIM = MB_DI + 2 * MB_GROUPS * MB_STATE
MB_PROJ = MB_DI + MB_CONV_DIM + MB_HEADS
MB_NORM_EPS = 1e-5

GL_HEADS = 4
GL_KD = D_MODEL // 2
GL_VD = D_MODEL
GL_DK = GL_KD // GL_HEADS
GL_DV = GL_VD // GL_HEADS
GL_GATE_LORA = 16
GL_GATE_NORM = 16.0
GL_CHUNK = 64
GL_PROJ = 2 * GL_KD + 2 * GL_VD + GL_GATE_LORA
GL_NORM_EPS = 1e-5

MOE_GROUPS = 4
MOE_PER_GROUP = 8
MOE_EXPERTS = MOE_GROUPS * MOE_PER_GROUP
MOE_TOPK = 2
MOE_FF = 512
MOE_BLOCK = 128

kernel_name = 'hybrid_rwkv7_mamba2_gla_hmoe_deepnorm'


def layer_norm(x, g, b):
    xf = x.astype(jnp.float32)
    mu = jnp.mean(xf, -1, keepdims=True)
    var = jnp.mean(jnp.square(xf - mu), -1, keepdims=True)
    return ((xf - mu) * lax.rsqrt(var + LN_EPS) * g + b).astype(x.dtype)


def token_shift(x):
    return jnp.pad(x, ((0, 0), (1, 0), (0, 0)))[:, :-1]


def causal_depthwise_conv(x, w, b):
    width, ch = w.shape
    y = lax.conv_general_dilated(x, w[:, None, :].astype(x.dtype), window_strides=(1,),
                                 padding=[(width - 1, 0)],
                                 dimension_numbers=('NWC', 'WIO', 'NWC'),
                                 feature_group_count=ch)
    return y + b


def rwkv7_mix(x, mu, w_rkv, w0, w1, w2, a0, a1, a2, g1, g2, k_k, k_a, r_k, lnx_g, lnx_b, w_o):
    f32 = jnp.float32
    bsz, seq, dm = x.shape
    H, N = RW_HEADS, RW_HEAD
    xx = token_shift(x) - x
    xs = x[None] + xx[None] * mu[:, None, None, :]
    r, k, v = jnp.einsum('pbsd,pde->pbse', xs[:3], w_rkv)
    xw, xa, xg = xs[3], xs[4], xs[5]
    w_log = -jax.nn.softplus(-(w0 + jnp.tanh(xw @ w1) @ w2)) - 0.5
    decay = jnp.exp(-jnp.exp(w_log.astype(f32)))
    a = jax.nn.sigmoid((a0 + (xa @ a1) @ a2).astype(f32))
    g = jax.nn.sigmoid(xg @ g1) @ g2

    def heads(t):
        return t.astype(f32).reshape(bsz, seq, H, N)

    kk = heads(k * k_k)
    kk = kk / jnp.maximum(jnp.sqrt(jnp.sum(kk * kk, -1, keepdims=True)), 1e-12)
    k_h = heads(k.astype(f32) * (1.0 + (a - 1.0) * k_a.astype(f32)))
    r_h, v_h, a_h, w_h = heads(r), heads(v), heads(a), heads(decay)

    def step(state, inp):
        r_t, w_t, k_t, v_t, kk_t, a_t = inp
        sa = jnp.einsum('bhvk,bhk->bhv', state, -kk_t)
        state = (state * w_t[:, :, None, :] + sa[..., None] * (kk_t * a_t)[:, :, None, :]
                 + v_t[..., None] * k_t[:, :, None, :])
        return state, jnp.einsum('bhvk,bhk->bhv', state, r_t)

    seq_in = tuple(jnp.moveaxis(t, 1, 0) for t in (r_h, w_h, k_h, v_h, kk, a_h))
    _, y = lax.scan(step, jnp.zeros((bsz, H, N, N), f32), seq_in)
    y = jnp.moveaxis(y, 0, 1)
    mu_y = jnp.mean(y, -1, keepdims=True)
    var_y = jnp.mean(jnp.square(y - mu_y), -1, keepdims=True)
    y = ((y - mu_y) * lax.rsqrt(var_y + RW_GN_EPS)).reshape(bsz, seq, dm) * lnx_g + lnx_b
    bonus = jnp.sum(r_h * k_h * r_k.astype(f32), -1, keepdims=True) * v_h
    y = (y + bonus.reshape(bsz, seq, dm)) * g
    return (y.astype(x.dtype) @ w_o).astype(x.dtype)


def mamba2_mix(x, w_in, conv_w, conv_b, dt_bias, a_log, d_skip, norm_g, w_out):
    f32 = jnp.float32
    bsz, seq, _ = x.shape
    G, E, P, N, L = MB_GROUPS, MB_HPG, MB_HEADDIM, MB_STATE, MB_CHUNK
    nc = seq // L
    zxbcdt = x @ w_in
    z, xbc, dt = jnp.split(zxbcdt, [MB_DI, MB_DI + MB_CONV_DIM], axis=-1)
    xbc = jax.nn.silu(causal_depthwise_conv(xbc, conv_w, conv_b))
    xs, bm, cm = jnp.split(xbc, [MB_DI, MB_DI + G * N], axis=-1)
    dt = jax.nn.softplus((dt + dt_bias).astype(f32))
    a = -jnp.exp(a_log.astype(f32)).reshape(G, E)

    xs_c = xs.astype(f32).reshape(bsz, nc, L, G, E, P)
    b_c = bm.astype(f32).reshape(bsz, nc, L, G, N)
    c_c = cm.astype(f32).reshape(bsz, nc, L, G, N)
    dt_c = dt.reshape(bsz, nc, L, G, E)
    da_cs = jnp.cumsum(dt_c * a, axis=2)
    xdt = xs_c * dt_c[..., None]

    causal = jnp.tril(jnp.ones((L, L), bool))[:, :, None, None]
    seg = da_cs[:, :, :, None] - da_cs[:, :, None, :]
    decay_ls = jnp.exp(jnp.where(causal, seg, -jnp.inf))
    scores = jnp.einsum('bclgn,bcsgn->bclsg', c_c, b_c)
    y_diag = jnp.einsum('bclsg,bclsge,bcsgep->bclgep', scores, decay_ls, xdt)

    decay_to_end = jnp.exp(da_cs[:, :, -1:] - da_cs)
    chunk_states = jnp.einsum('bclgn,bclge,bclgep->bcgepn', b_c, decay_to_end, xdt)
    chunk_decay = jnp.exp(da_cs[:, :, -1])

    def carry(h, inp):
        s_c, dec_c = inp
        return h * dec_c[..., None, None] + s_c, h

    _, prev = lax.scan(carry, jnp.zeros((bsz, G, E, P, N), f32),
                       (jnp.moveaxis(chunk_states, 1, 0), jnp.moveaxis(chunk_decay, 1, 0)))
    prev = jnp.moveaxis(prev, 0, 1)
    y_off = jnp.einsum('bclgn,bcgepn,bclge->bclgep', c_c, prev, jnp.exp(da_cs))
    y = y_diag + y_off + xs_c * d_skip.astype(f32).reshape(G, E)[:, :, None]
    y = y.reshape(bsz, seq, MB_DI) * jax.nn.silu(z.astype(f32))
    yg = y.reshape(bsz, seq, G, MB_DI // G)
    yg = yg * lax.rsqrt(jnp.mean(yg * yg, -1, keepdims=True) + MB_NORM_EPS)
    y = yg.reshape(bsz, seq, MB_DI) * norm_g
    return (y.astype(x.dtype) @ w_out).astype(x.dtype)


def gla_mix(x, w_in, gk_w2, gk_b, norm_g, w_out):
    f32 = jnp.float32
    bsz, seq, _ = x.shape
    H, DK, DV, C = GL_HEADS, GL_DK, GL_DV, GL_CHUNK
    n = seq // C
    proj = x @ w_in
    q, k, v, g, gk_lr = jnp.split(proj, [GL_KD, 2 * GL_KD, 2 * GL_KD + GL_VD, 2 * GL_KD + 2 * GL_VD], axis=-1)
    log_alpha = jax.nn.log_sigmoid((gk_lr @ gk_w2 + gk_b).astype(f32)) / GL_GATE_NORM
    q = q.astype(f32).reshape(bsz, n, C, H, DK) * (DK ** -0.5)
    k = k.astype(f32).reshape(bsz, n, C, H, DK)
    v = v.astype(f32).reshape(bsz, n, C, H, DV)
    b_cs = jnp.cumsum(log_alpha.reshape(bsz, n, C, H, DK), axis=2)
    q_in = q * jnp.exp(b_cs)
    k_in = k * jnp.exp(-b_cs)
    k_end = k * jnp.exp(b_cs[:, :, -1:] - b_cs)
    mask = jnp.tril(jnp.ones((C, C), bool))
    attn = jnp.where(mask, jnp.einsum('bnihk,bnjhk->bnhij', q_in, k_in), 0.0)
    o_intra = jnp.einsum('bnhij,bnjhv->bnihv', attn, v)
    chunk_kv = jnp.einsum('bnjhk,bnjhv->bnhkv', k_end, v)
    chunk_decay = jnp.exp(b_cs[:, :, -1])

    def carry(s, inp):
        kv_c, dec_c = inp
        return s * dec_c[..., None] + kv_c, s

    _, prev = lax.scan(carry, jnp.zeros((bsz, H, DK, DV), f32),
                       (jnp.moveaxis(chunk_kv, 1, 0), jnp.moveaxis(chunk_decay, 1, 0)))
    prev = jnp.moveaxis(prev, 0, 1)
    o = o_intra + jnp.einsum('bnihk,bnhkv->bnihv', q_in, prev)
    o = o.reshape(bsz, seq, H, DV)
    o = o * lax.rsqrt(jnp.mean(o * o, -1, keepdims=True) + GL_NORM_EPS) * norm_g
    o = o.reshape(bsz, seq, GL_VD) * jax.nn.silu(g.astype(f32))
    return (o.astype(x.dtype) @ w_out).astype(x.dtype)


def hier_moe(x, w_group, b_group, w_route, b_route, w_in, w_down):
    f32 = jnp.float32
    bsz, seq, dm = x.shape
    T = bsz * seq
    E, EPG, K, BLK = MOE_EXPERTS, MOE_PER_GROUP, MOE_TOPK, MOE_BLOCK
    xt = x.reshape(T, dm)
    group_probs = jax.nn.softmax((xt @ w_group + b_group).astype(f32), -1)
    p_group, g_idx = lax.top_k(group_probs, 1)
    exp_logits = (xt @ w_route + b_route).astype(f32).reshape(T, MOE_GROUPS, EPG)
    sel_logits = jnp.take_along_axis(exp_logits, g_idx[:, :, None], axis=1)[:, 0]
    p_exp, e_local = lax.top_k(jax.nn.softmax(sel_logits, -1), K)
    gates = p_group * p_exp / jnp.sum(p_exp, -1, keepdims=True)
    expert_id = g_idx * EPG + e_local

    A = T * K
    flat_e = expert_id.reshape(A)
    flat_tok = jnp.repeat(jnp.arange(T, dtype=jnp.int32), K)
    flat_gate = gates.reshape(A)
    order = jnp.argsort(flat_e)
    se = flat_e[order]
    tok_sorted = flat_tok[order]
    counts = jnp.bincount(flat_e, length=E)
    starts = jnp.cumsum(counts) - counts
    padded = (counts + BLK - 1) // BLK * BLK
    pad_end = jnp.cumsum(padded)
    pad_start = pad_end - padded
    dest = pad_start[se] + (jnp.arange(A) - starts[se])
    n_blocks = (A + E * (BLK - 1) + BLK - 1) // BLK
    buf = jnp.zeros((n_blocks * BLK, dm), x.dtype).at[dest].set(xt[tok_sorted])
    block_expert = jnp.minimum(jnp.searchsorted(pad_end, jnp.arange(n_blocks) * BLK, side='right'), E - 1)

    def expert_block(blk):
        xb, e = blk
        hg, hu = jnp.split(xb @ w_in[e], 2, axis=-1)
        return (jax.nn.silu(hg) * hu) @ w_down[e]

    y_buf = lax.map(expert_block, (buf.reshape(n_blocks, BLK, dm), block_expert)).reshape(n_blocks * BLK, dm)
    y_assign = (y_buf[dest] * flat_gate[order][:, None]).astype(x.dtype)
    y = jnp.zeros((T, dm), x.dtype).at[tok_sorted].add(y_assign)
    return y.reshape(bsz, seq, dm)


def setup_inputs(seed: int = 0) -> dict:
    key = jax.random.key(seed)
    ks = iter(jax.random.split(key, 48))
    f32 = jnp.float32
    D = D_MODEL
    NA, NB, NC = N_LAYERS_A, N_LAYERS_B, N_LAYERS_C

    def nrm(shape, scale):
        return jax.random.normal(next(ks), shape, f32) * scale

    def unif(shape, lo, hi):
        return jax.random.uniform(next(ks), shape, f32, lo, hi)

    inp = {}
    inp['x'] = nrm((BATCH, SEQ, D), 1.0)
    inp['ln_g'] = 1.0 + nrm((DEPTH, 2, D), 0.01)
    inp['ln_b'] = nrm((DEPTH, 2, D), 0.01)
    inp['rw_mu'] = unif((NA, 6, D), 0.0, 1.0)
    inp['rw_w_rkv'] = nrm((NA, 3, D, D), D ** -0.5)
    inp['rw_w0'] = unif((NA, D), -6.0, -1.0)
    inp['rw_w1'] = nrm((NA, D, RW_DECAY_LORA), D ** -0.5)
    inp['rw_w2'] = nrm((NA, RW_DECAY_LORA, D), 0.1 * RW_DECAY_LORA ** -0.5)
    inp['rw_a0'] = nrm((NA, D), 0.1)
    inp['rw_a1'] = nrm((NA, D, RW_AAA_LORA), D ** -0.5)
    inp['rw_a2'] = nrm((NA, RW_AAA_LORA, D), 0.1 * RW_AAA_LORA ** -0.5)
    inp['rw_g1'] = nrm((NA, D, RW_GATE_LORA), D ** -0.5)
    inp['rw_g2'] = nrm((NA, RW_GATE_LORA, D), RW_GATE_LORA ** -0.5)
    inp['rw_k_k'] = 0.85 + nrm((NA, D), 0.01)
    inp['rw_k_a'] = 1.0 + nrm((NA, D), 0.01)
    inp['rw_r_k'] = nrm((NA, RW_HEADS, RW_HEAD), 0.1)
    inp['rw_lnx_g'] = 1.0 + nrm((NA, D), 0.01)
    inp['rw_lnx_b'] = nrm((NA, D), 0.01)
    inp['rw_w_o'] = nrm((NA, D, D), D ** -0.5 * DEEPNORM_BETA)
    inp['mb_w_in'] = nrm((NB, D, MB_PROJ), D ** -0.5)
    inp['mb_conv_w'] = nrm((NB, MB_CONV, MB_CONV_DIM), MB_CONV ** -0.5)
    inp['mb_conv_b'] = nrm((NB, MB_CONV_DIM), 0.01)
    dt0 = jnp.exp(unif((NB, MB_HEADS), math.log(1e-3), math.log(1e-1)))
    inp['mb_dt_bias'] = dt0 + jnp.log(-jnp.expm1(-dt0))
    inp['mb_a_log'] = jnp.log(unif((NB, MB_HEADS), 1.0, 16.0))
    inp['mb_d'] = 1.0 + nrm((NB, MB_HEADS), 0.01)
    inp['mb_norm_g'] = 1.0 + nrm((NB, MB_DI), 0.01)
    inp['mb_w_out'] = nrm((NB, MB_DI, D), MB_DI ** -0.5 * DEEPNORM_BETA)
    inp['gl_w_in'] = nrm((NC, D, GL_PROJ), D ** -0.5)
    inp['gl_gk_w2'] = nrm((NC, GL_GATE_LORA, GL_KD), GL_GATE_LORA ** -0.5)
    inp['gl_gk_b'] = nrm((NC, GL_KD), 0.1)
    inp['gl_norm_g'] = 1.0 + nrm((NC, GL_DV), 0.01)
    inp['gl_w_out'] = nrm((NC, GL_VD, D), GL_VD ** -0.5 * DEEPNORM_BETA)
    inp['moe_w_group'] = nrm((DEPTH, D, MOE_GROUPS), D ** -0.5)
    inp['moe_b_group'] = nrm((DEPTH, MOE_GROUPS), 0.01)
    inp['moe_w_route'] = nrm((DEPTH, D, MOE_EXPERTS), D ** -0.5)
    inp['moe_b_route'] = nrm((DEPTH, MOE_EXPERTS), 0.01)
    inp['moe_w_in'] = nrm((DEPTH, MOE_EXPERTS, D, 2 * MOE_FF), D ** -0.5)
    inp['moe_w_down'] = nrm((DEPTH, MOE_EXPERTS, MOE_FF, D), MOE_FF ** -0.5 * DEEPNORM_BETA)
    return inp


def reference(x, ln_g, ln_b, rw_mu, rw_w_rkv, rw_w0, rw_w1, rw_w2, rw_a0, rw_a1, rw_a2,
              rw_g1, rw_g2, rw_k_k, rw_k_a, rw_r_k, rw_lnx_g, rw_lnx_b, rw_w_o,
              mb_w_in, mb_conv_w, mb_conv_b, mb_dt_bias, mb_a_log, mb_d, mb_norm_g, mb_w_out,
              gl_w_in, gl_gk_w2, gl_gk_b, gl_norm_g, gl_w_out,
              moe_w_group, moe_b_group, moe_w_route, moe_b_route, moe_w_in, moe_w_down):
    h = x
    for i in range(DEPTH):
        kind, j = i % N_MIXERS, i // N_MIXERS
        if kind == 0:
            m = rwkv7_mix(h, rw_mu[j], rw_w_rkv[j], rw_w0[j], rw_w1[j], rw_w2[j], rw_a0[j], rw_a1[j],
                          rw_a2[j], rw_g1[j], rw_g2[j], rw_k_k[j], rw_k_a[j], rw_r_k[j],
                          rw_lnx_g[j], rw_lnx_b[j], rw_w_o[j])
        elif kind == 1:
            m = mamba2_mix(h, mb_w_in[j], mb_conv_w[j], mb_conv_b[j], mb_dt_bias[j], mb_a_log[j],
                           mb_d[j], mb_norm_g[j], mb_w_out[j])
        else:
            m = gla_mix(h, gl_w_in[j], gl_gk_w2[j], gl_gk_b[j], gl_norm_g[j], gl_w_out[j])
        h = layer_norm(DEEPNORM_ALPHA * h + m, ln_g[i, 0], ln_b[i, 0])
        f = hier_moe(h, moe_w_group[i], moe_b_group[i], moe_w_route[i], moe_b_route[i],
                     moe_w_in[i], moe_w_down[i])
        h = layer_norm(DEEPNORM_ALPHA * h + f, ln_g[i, 1], ln_b[i, 1])
    return h
```

```cpp
#include <hip/hip_runtime.h>
#include <hip/hip_cooperative_groups.h>
#include <cstdint>
#include <cstdio>
#include <cstring>
namespace cg = cooperative_groups;

typedef unsigned short bf16_t;
typedef short bf16x8 __attribute__((ext_vector_type(8)));
typedef short s16x4 __attribute__((ext_vector_type(4)));
typedef float f32x4 __attribute__((ext_vector_type(4)));
typedef float f32x2 __attribute__((ext_vector_type(2)));
typedef unsigned u32x4 __attribute__((ext_vector_type(4)));
typedef unsigned u32x2 __attribute__((ext_vector_type(2)));
#define LAS __attribute__((address_space(3)))
#define DEV __device__ __forceinline__

constexpr int T = 16384, D = 1024, DEPTH = 4;
constexpr int NTHR = 512, NBLK = 256;
constexpr int LDS_BYTES = 155648;
constexpr float ALPHA = 1.681792830507429f;
constexpr float LN_EPS = 1e-5f;
constexpr int MOE_ROWS = 40960;

DEV int tid_() { int t = threadIdx.x; asm volatile("" : "+v"(t)); return t; }
DEV int bid_() { int b = blockIdx.x; asm volatile("" : "+s"(b)); return b; }
#define NB_ 256
DEV unsigned f2bf(float f) { unsigned u = __float_as_uint(f); u += 0x7FFFu + ((u >> 16) & 1u); return u >> 16; }
DEV float bf2f(unsigned short b) { return __uint_as_float(((unsigned)b) << 16); }
DEV unsigned pk2(float lo, float hi) { unsigned r; asm("v_cvt_pk_bf16_f32 %0, %1, %2" : "=v"(r) : "v"(lo), "v"(hi)); return r; }
DEV float bflo(unsigned u) { return __uint_as_float(u << 16); }
DEV float bfhi(unsigned u) { return __uint_as_float(u & 0xFFFF0000u); }
DEV float sigmoidf_(float x) { return 1.0f / (1.0f + __expf(-x)); }
DEV float siluf_(float x) { return x / (1.0f + __expf(-x)); }
DEV float softplusf_(float x) { return fmaxf(x, 0.f) + __logf(1.0f + __expf(-fabsf(x))); }
DEV float tanhf_(float x) { const float e = __expf(-2.0f * fabsf(x)); const float r = (1.0f - e) / (1.0f + e); return x < 0.f ? -r : r; }
DEV float wave_sum(float v) {
#pragma unroll
    for (int o = 32; o > 0; o >>= 1) v += __shfl_xor(v, o);
    return v;
}
DEV float sum16(float v) {
#pragma unroll
    for (int o = 8; o > 0; o >>= 1) v += __shfl_xor(v, o);
    return v;
}
template <int N> DEV float reduce_scatter(float (&v)[N], int lane) {
    int s = 1;
#pragma unroll
    for (int h = N / 2; h >= 1; h >>= 1) {
#pragma unroll
        for (int i = 0; i < h; ++i) {
            const bool up = (lane & s) != 0;
            const float send = up ? v[i] : v[i + h];
            const float keep = up ? v[i + h] : v[i];
            v[i] = keep + __shfl_xor(send, s);
        }
        s <<= 1;
    }
    float r = v[0];
    for (; s < 64; s <<= 1) r += __shfl_xor(r, s);
    return r;
}
template <int N> DEV int rs_index(int lane) {
    int o = 0, s = 1;
#pragma unroll
    for (int h = N / 2; h >= 1; h >>= 1) { if (lane & s) o += h; s <<= 1; }
    return o;
}

DEV bf16x8 frag_rm(const LAS bf16_t* base, int ld, int row0, int k0, int lane) {
    return *(const LAS bf16x8*)(base + (row0 + (lane & 15)) * ld + k0 + 8 * (lane >> 4));
}
DEV bf16x8 frag_tr(const LAS bf16_t* base, int ld, int k0, int c0, int lane) {
    const int g = lane >> 4, i = lane & 15, q = i >> 2, p = i & 3;
    const LAS bf16_t* a = base + (k0 + 8 * g + q) * ld + c0 + 4 * p;
    s16x4 lo = __builtin_amdgcn_ds_read_tr16_b64_v4i16((LAS s16x4*)a);
    s16x4 hi = __builtin_amdgcn_ds_read_tr16_b64_v4i16((LAS s16x4*)(a + 4 * ld));
    bf16x8 r; r[0] = lo[0]; r[1] = lo[1]; r[2] = lo[2]; r[3] = lo[3]; r[4] = hi[0]; r[5] = hi[1]; r[6] = hi[2]; r[7] = hi[3];
    return r;
}
#define MFMA16(a, b, c) __builtin_amdgcn_mfma_f32_16x16x32_bf16((a), (b), (c), 0, 0, 0)
DEV size_t fragmajor_off(int n, int k, int K) { return ((size_t)((n >> 4) * (K >> 5) + (k >> 5)) * 64 + (n & 15) + 16 * ((k & 31) >> 3)) * 8 + (k & 7); }

template <int N> DEV void skinny_group(const f32x4 (&z)[4], const LAS float* wt, int lane, LAS float* outw) {
    float pe[N];
#pragma unroll
    for (int o = 0; o < N; ++o) {
        float a = 0.f;
#pragma unroll
        for (int q = 0; q < 4; ++q) { const f32x4 w = *(const LAS f32x4*)(wt + o * 1028 + 256 * q + 4 * lane); a += z[q][0] * w[0] + z[q][1] * w[1] + z[q][2] * w[2] + z[q][3] * w[3]; }
        pe[o] = a;
    }
    const float r = reduce_scatter<N>(pe, lane);
    if (lane < N) outw[rs_index<N>(lane)] = r;
}
#ifndef SINGLE_LAUNCH
#define SINGLE_LAUNCH 0
#endif
struct ConvJob {
    const float* src; bf16_t* dst;
    int K, N, src_ld, Kpad, Npad, perm, batch;
    long long src_bs, dst_bs;
    DEV int ntiles() const { return (Kpad / 64) * (Npad / 64) * batch; }
};
constexpr int NJOBS = 14;

#define PARAM_LIST(X) \
    X(const float*, x) X(const float*, ln_g) X(const float*, ln_b) \
    X(const float*, rw_mu) X(const float*, rw_w_rkv) X(const float*, rw_w0) X(const float*, rw_w1) X(const float*, rw_w2) X(const float*, rw_a0) X(const float*, rw_a1) X(const float*, rw_a2) \
    X(const float*, rw_g1) X(const float*, rw_g2) X(const float*, rw_k_k) X(const float*, rw_k_a) X(const float*, rw_r_k) X(const float*, rw_lnx_g) X(const float*, rw_lnx_b) X(const float*, rw_w_o) \
    X(const float*, mb_w_in) X(const float*, mb_conv_w) X(const float*, mb_conv_b) X(const float*, mb_dt_bias) X(const float*, mb_a_log) X(const float*, mb_d) X(const float*, mb_norm_g) X(const float*, mb_w_out) \
    X(const float*, gl_w_in) X(const float*, gl_gk_w2) X(const float*, gl_gk_b) X(const float*, gl_norm_g) X(const float*, gl_w_out) \
    X(const float*, moe_w_group) X(const float*, moe_b_group) X(const float*, moe_w_route) X(const float*, moe_b_route) X(const float*, moe_w_in) X(const float*, moe_w_down) \
    X(float*, out) \
    X(bf16_t*, rw_rkv_t) X(bf16_t*, rw_w1_t) X(bf16_t*, rw_a1_t) X(bf16_t*, rw_g1_t) X(bf16_t*, rw_w2_t) X(bf16_t*, rw_a2_t) X(bf16_t*, rw_g2_t) X(bf16_t*, rw_wo_t) \
    X(bf16_t*, mb_win_t) X(bf16_t*, mb_wout_t) X(bf16_t*, gl_win_t) X(bf16_t*, gl_wout_t) X(bf16_t*, moe_w1_t) X(bf16_t*, moe_w2_t) \
    X(float*, H) X(float*, H1) X(float*, MIX) X(bf16_t*, X6) X(float*, Rr) X(float*, Kk) X(float*, Vv) X(bf16_t*, LW) X(float*, Wd) X(float*, Aa) X(float*, Gg) \
    X(float*, P2) X(float*, P3) X(float*, P4) X(float*, P5) X(float*, C1) X(float*, C2) X(float*, BC) X(float*, Y) X(bf16_t*, YB) \
    X(bf16_t*, Z) X(bf16_t*, XBC) X(bf16_t*, XC) X(float*, DT) X(float*, STATES) X(float*, CD) X(bf16_t*, PREV) X(bf16_t*, QKVG) X(float*, LA) X(float*, CDG) \
    X(bf16_t*, BUF) X(bf16_t*, ACT) X(bf16_t*, YBUF) X(int*, CNT) X(int*, EIDX) X(float*, GATE) X(int*, DEST) X(int*, TAB) X(unsigned*, bar)
struct Params {
#define X(t, n) t n;
    PARAM_LIST(X)
#undef X
};

enum Op : unsigned char { OP_CONVERT = 0, OP_RW_MIX, OP_RW_GEMM1, OP_RW_GEMM2, OP_RW_PREP, OP_RW_SCAN, OP_RW_POST, OP_RW_OUT,
    OP_LN1, OP_MOE_SCATTER, OP_MOE_GEMM1, OP_MOE_GEMM2, OP_LN2,
    OP_MB_CAST, OP_MB_GEMM_IN, OP_MB_CONV, OP_MB_STATES, OP_MB_SCAN, OP_MB_OUT, OP_MB_GEMM_OUT,
    OP_GL_CAST, OP_GL_GEMM_IN, OP_GL_KV, OP_GL_SCAN, OP_GL_OUT, OP_GL_GEMM_OUT };


DEV ConvJob make_job(const Params& p, int q) {
    const long long DD = (long long)D * D;
    switch (q) {
    case 0: return ConvJob{p.rw_w_rkv, p.rw_rkv_t, 1024, 1024, 1024, 1024, 1024, 0, 6, DD, DD};
    case 1: return ConvJob{p.rw_w1, p.rw_w1_t, 1024, 64, 64, 1024, 256, 0, 2, (long long)D * 64, (long long)256 * D};
    case 2: return ConvJob{p.rw_a1, p.rw_a1_t, 1024, 64, 64, 1024, 256, 0, 2, (long long)D * 64, (long long)256 * D};
    case 3: return ConvJob{p.rw_g1, p.rw_g1_t, 1024, 160, 160, 1024, 256, 0, 2, (long long)D * 160, (long long)256 * D};
    case 4: return ConvJob{p.rw_w2, p.rw_w2_t, 64, 1024, 1024, 256, 1024, 0, 2, (long long)64 * D, (long long)D * 256};
    case 5: return ConvJob{p.rw_a2, p.rw_a2_t, 64, 1024, 1024, 256, 1024, 0, 2, (long long)64 * D, (long long)D * 256};
    case 6: return ConvJob{p.rw_g2, p.rw_g2_t, 160, 1024, 1024, 256, 1024, 0, 2, (long long)160 * D, (long long)D * 256};
    case 7: return ConvJob{p.rw_w_o, p.rw_wo_t, 1024, 1024, 1024, 1024, 1024, 0, 2, DD, DD};
    case 8: return ConvJob{p.mb_w_in, p.mb_win_t, 1024, 5120, 5152, 1024, 5120, 0, 1, 0, 0};
    case 9: return ConvJob{p.mb_w_out, p.mb_wout_t, 2048, 1024, 1024, 2048, 1024, 0, 1, 0, 0};
    case 10: return ConvJob{p.gl_w_in, p.gl_win_t, 1024, 3072, 3088, 1024, 3072, 0, 1, 0, 0};
    case 11: return ConvJob{p.gl_w_out, p.gl_wout_t, 1024, 1024, 1024, 1024, 1024, 0, 1, 0, 0};
    case 12: return ConvJob{p.moe_w_in, p.moe_w1_t, 1024, 1024, 1024, 1024, 1024, 1, 128, DD, DD};
    default: return ConvJob{p.moe_w_down, p.moe_w2_t, 512, 1024, 1024, 512, 1024, 0, 128, (long long)512 * 1024, (long long)1024 * 512};
    }
}

DEV void phase_convert(const Params& p, LAS unsigned char* lds) {
    const int tid = tid_(), bid = bid_(); (void)tid; (void)bid;
    LAS bf16_t* tile = (LAS bf16_t*)lds;
    int tbeg = 0;
#pragma unroll
    for (int j = 0; j < NJOBS; ++j) {
      const ConvJob J = make_job(p, j);
      const int jend = tbeg + J.ntiles();
      const int ti0 = tbeg + (((int)bid - tbeg) % NB_ + NB_) % NB_;
      const int jbeg = tbeg; tbeg = jend;
#pragma unroll 1
      for (int ti = ti0; ti < jend; ti += NB_) {
        int local = ti - jbeg;
        const int tk = J.Kpad / 64, tn = J.Npad / 64;
        const int b = local / (tk * tn); local -= b * tk * tn;
        const int nt = local / tk, kt = local - nt * tk;
        const float* src = J.src + (size_t)b * J.src_bs;
        bf16_t* dst = J.dst + (size_t)b * J.dst_bs;
        const int k0 = kt * 64, n0 = nt * 64;
#pragma unroll
        for (int pass = 0; pass < 2; ++pass) {
            const int kk = (tid >> 4) + pass * 32, nn = (tid & 15) * 4;
            f32x4 v = {0.f, 0.f, 0.f, 0.f};
            if (k0 + kk < J.K && n0 + nn < J.N) v = *(const f32x4*)(src + (size_t)(k0 + kk) * J.src_ld + n0 + nn);
#pragma unroll
            for (int e = 0; e < 4; ++e) tile[(nn + e) * 72 + kk] = (bf16_t)f2bf(v[e]);
        }
        __syncthreads();
        {
            const int nn = tid >> 3, kc = (tid & 7) * 8;
            int nsrc = n0 + nn, ndst = nsrc;
            if (J.perm == 1) { const int up = nsrc >= 512, jj = nsrc - (up ? 512 : 0); ndst = (jj >> 7) * 256 + (up ? 128 : 0) + (jj & 127); }
            const u32x4 v = *(const LAS u32x4*)(tile + nn * 72 + kc);
            *(u32x4*)(dst + (size_t)ndst * J.Kpad + k0 + kc) = v;
        }
        __syncthreads();
      }
    }
}
namespace pg8 {
constexpr int BM = 256, BK = 64, HALF = 128, HTB = HALF * BK * 2, STAGE_BYTES = 8 * HTB;
DEV int lds_byte(int r, int c) { const int st = (r >> 4) * 2 + (c >> 5), rr = r & 15, cc = c & 31, ob = rr * 64 + cc * 2; return st * 1024 + (ob ^ (((ob >> 9) & 1) << 5)); }
DEV void stage_rc(int b, int& R, int& C) { const int st = b / 1024, sb = b % 1024, swz = sb ^ (((sb >> 9) & 1) << 5); R = (st >> 1) * 16 + swz / 64; C = (st & 1) * 32 + (swz % 64) / 2; }

struct Unit { const char* A; const char* B; int row0, col0, id, aux; };

DEV bool tile_order(int i, int G, int c, int nM, int nN, int& pm, int& pn) {
    const int nwg = nM * nN; const long L = (long)i * G + c; if (L >= nwg) return false;
    int wgid = (int)L; { const int q = nwg / 8, r = nwg % 8, xcd = wgid % 8, off = wgid / 8; wgid = (xcd < r ? xcd * (q + 1) : r * (q + 1) + (xcd - r) * q) + off; }
    const int nig = 8 * nN, gid = wgid / nig, fm = gid * 8, gsz = (nM - fm) < 8 ? (nM - fm) : 8;
    pm = fm + ((wgid % nig) % gsz); pn = (wgid % nig) / gsz; return true;
}

template <class Epi, class Sched>
DEV void gemm_phase(LAS unsigned char* lds, const int K, const Sched& S, const Epi& E) {
    const int tid = tid_(), wid = __builtin_amdgcn_readfirstlane(tid >> 6), lane = tid & 63, wr = wid >> 2, wc = wid & 3, fr = lane & 15, fq = lane >> 4;
    const int nt = K / BK;
    unsigned voff[2];
#pragma unroll
    for (int i = 0; i < 2; ++i) { int R, C; stage_rc(tid * 16 + i * 8192, R, C); voff[i] = (unsigned)(R * K + C) * 2u; }
    const size_t kstep = (size_t)(BK * 2);
    const size_t hstep = (size_t)HALF * K * 2;
    const unsigned ldsw = (unsigned)wid * 1024u;
    const int aoff = lds_byte(wr * 64 + fr, fq * 8), boff = lds_byte(wc * 32 + fr, fq * 8);
#define PG8_SA(b, h) (((b) * 2 + (h)) * HTB)
#define PG8_SB(b, h) ((4 + (b) * 2 + (h)) * HTB)
#define PG8_STAGE(bufoff, gbase) do { _Pragma("unroll") for (int _i = 0; _i < 2; ++_i) \
        __builtin_amdgcn_global_load_lds((const unsigned*)((const char*)(gbase) + voff[_i]), (LAS unsigned*)(lds + (bufoff) + ldsw + _i * 8192), 16, 0, 0); } while (0)
#define PG8_LDA(dst, b, h) do { _Pragma("unroll") for (int m = 0; m < 4; ++m) _Pragma("unroll") for (int k = 0; k < 2; ++k) dst[m][k] = *(const LAS bf16x8*)(lds + PG8_SA(b, h) + aoff + m * 2048 + k * 1024); } while (0)
#define PG8_LDB(dst, b, h) do { _Pragma("unroll") for (int n = 0; n < 2; ++n) _Pragma("unroll") for (int k = 0; k < 2; ++k) dst[n][k] = *(const LAS bf16x8*)(lds + PG8_SB(b, h) + boff + n * 2048 + k * 1024); } while (0)
#define PG8_MMA(ai, bj, At, Bt) do { __builtin_amdgcn_s_setprio(1); _Pragma("unroll") for (int m = 0; m < 4; ++m) _Pragma("unroll") for (int n = 0; n < 2; ++n) _Pragma("unroll") for (int k = 0; k < 2; ++k) \
        acc[ai][bj][m][n] = __builtin_amdgcn_mfma_f32_16x16x32_bf16(Bt[n][k], At[m][k], acc[ai][bj][m][n], 0, 0, 0); __builtin_amdgcn_s_setprio(0); } while (0)
#define PG8_WAIT_V(n) asm volatile("s_waitcnt vmcnt(" #n ")" ::: "memory")
#define PG8_WAIT_L(n) asm volatile("s_waitcnt lgkmcnt(" #n ")" ::: "memory")
#define PG8_BAR __builtin_amdgcn_s_barrier()
#define PG8_SCHED __builtin_amdgcn_sched_barrier(0)
    Unit cur, nxt; int ui = 0;
    if (!S.next(0, cur)) return;
    f32x4 acc[2][2][4][2];
#pragma unroll
    for (int a = 0; a < 2; ++a)
#pragma unroll
        for (int b = 0; b < 2; ++b)
#pragma unroll
            for (int m = 0; m < 4; ++m)
#pragma unroll
                for (int n = 0; n < 2; ++n) acc[a][b][m][n] = (f32x4){0.f, 0.f, 0.f, 0.f};
    bf16x8 At[4][2], B0[2][2], B1[2][2];
    const char* cA = cur.A; const char* cB = cur.B;
    PG8_STAGE(PG8_SB(0, 0), cB); PG8_STAGE(PG8_SA(0, 0), cA); PG8_STAGE(PG8_SB(0, 1), cB + hstep); PG8_STAGE(PG8_SA(0, 1), cA + hstep);
    if (wr == 1) PG8_BAR;
    PG8_WAIT_V(4); PG8_BAR;
    PG8_STAGE(PG8_SB(1, 0), cB + kstep); PG8_STAGE(PG8_SA(1, 0), cA + kstep); PG8_STAGE(PG8_SB(1, 1), cB + hstep + kstep);
    PG8_WAIT_V(6); PG8_BAR;
    for (;;) {
        const bool has_next = S.next(ui + 1, nxt);
        const char* nA = has_next ? nxt.A : cA; const char* nB = has_next ? nxt.B : cB;
#pragma unroll 1
        for (int t = 0; t < nt; t += 2) {
            const bool last = (t == nt - 2);
            const char* a1 = cA + (size_t)(t + 1) * kstep;
            const char* a2 = last ? nA : cA + (size_t)(t + 2) * kstep; const char* b2 = last ? nB : cB + (size_t)(t + 2) * kstep;
            const char* a3 = a2 + kstep; const char* b3 = b2 + kstep;
            PG8_LDB(B0, 0, 0); PG8_SCHED; PG8_LDA(At, 0, 0); PG8_STAGE(PG8_SA(1, 1), a1 + hstep);
            PG8_WAIT_L(8); PG8_BAR; PG8_WAIT_L(0); PG8_MMA(0, 0, At, B0); PG8_BAR; PG8_SCHED;
            PG8_LDB(B1, 0, 1); PG8_STAGE(PG8_SB(0, 0), b2);
            PG8_BAR; PG8_WAIT_L(0); PG8_MMA(0, 1, At, B1); PG8_BAR;
            PG8_LDA(At, 0, 1); PG8_STAGE(PG8_SA(0, 0), a2);
            PG8_BAR; PG8_WAIT_L(0); PG8_MMA(1, 0, At, B0); PG8_BAR; PG8_SCHED;
            PG8_STAGE(PG8_SB(0, 1), b2 + hstep);
            PG8_WAIT_V(6); PG8_BAR; PG8_MMA(1, 1, At, B1); PG8_BAR;
            PG8_LDB(B0, 1, 0); PG8_SCHED; PG8_LDA(At, 1, 0); PG8_STAGE(PG8_SA(0, 1), a2 + hstep);
            PG8_WAIT_L(8); PG8_BAR; PG8_WAIT_L(0); PG8_MMA(0, 0, At, B0); PG8_BAR; PG8_SCHED;
            PG8_LDB(B1, 1, 1); PG8_STAGE(PG8_SB(1, 0), b3);
            PG8_BAR; PG8_WAIT_L(0); PG8_MMA(0, 1, At, B1); PG8_BAR;
            PG8_LDA(At, 1, 1); PG8_STAGE(PG8_SA(1, 0), a3);
            PG8_BAR; PG8_WAIT_L(0); PG8_MMA(1, 0, At, B0); PG8_BAR; PG8_SCHED;
            PG8_STAGE(PG8_SB(1, 1), b3 + hstep);
            PG8_WAIT_V(6); PG8_BAR; PG8_MMA(1, 1, At, B1); PG8_BAR;
        }
        E(acc, cur, wr, wc, fr, fq);
        if (!has_next) break;
#pragma unroll
        for (int a = 0; a < 2; ++a)
#pragma unroll
            for (int b = 0; b < 2; ++b)
#pragma unroll
                for (int m = 0; m < 4; ++m)
#pragma unroll
                    for (int n = 0; n < 2; ++n) acc[a][b][m][n] = (f32x4){0.f, 0.f, 0.f, 0.f};
        cur = nxt; cA = nA; cB = nB; ++ui;
    }
    PG8_WAIT_V(0);
    if (wr == 0) PG8_BAR;
    PG8_BAR;
#undef PG8_SA
#undef PG8_SB
#undef PG8_STAGE
#undef PG8_LDA
#undef PG8_LDB
#undef PG8_MMA
#undef PG8_WAIT_V
#undef PG8_WAIT_L
#undef PG8_BAR
#undef PG8_SCHED
}
}
using pg8::Unit;
typedef f32x4 AccT[2][2][4][2];
#define FOR_ACC(ai, bj, m, n) _Pragma("unroll") for (int ai = 0; ai < 2; ++ai) _Pragma("unroll") for (int m = 0; m < 4; ++m) _Pragma("unroll") for (int bj = 0; bj < 2; ++bj) _Pragma("unroll") for (int n = 0; n < 2; ++n)
#define ACC_FENCE __builtin_amdgcn_sched_barrier(0)
#define ACC_ROW(u, ai, m) ((u).row0 + 128 * (ai) + 64 * wr + 16 * (m) + fr)
#define ACC_COL(u, bj, n) ((u).col0 + 128 * (bj) + 32 * wc + 16 * (n) + 4 * fq)
DEV void st_bf4(bf16_t* p, f32x4 v) { u32x2 w; w.x = pk2(v[0], v[1]); w.y = pk2(v[2], v[3]); *(u32x2*)p = w; }
DEV void load_row(const float* p, int lane, f32x4 (&v)[4]) {
#pragma unroll
    for (int q = 0; q < 4; ++q) v[q] = *(const f32x4*)(p + 256 * q + 4 * lane);
}

DEV void phase_rw_mix(const Params& p, int j, const float* hin) {
    const int tid = tid_(), bid = bid_(); (void)tid; (void)bid;
    const int lane = tid & 63, wid = tid >> 6;
    const float* mu = p.rw_mu + (size_t)j * 6 * D;
    for (int r = 0; r < 8; ++r) {
        const int t = bid * 64 + wid * 8 + r;
        f32x4 x[4], xp[4];
        load_row(hin + (size_t)t * D, lane, x);
        if (t > 0) load_row(hin + (size_t)(t - 1) * D, lane, xp);
        else { for (int q = 0; q < 4; ++q) xp[q] = (f32x4){0.f, 0.f, 0.f, 0.f}; }
#pragma unroll
        for (int s = 0; s < 6; ++s) {
#pragma unroll
            for (int q = 0; q < 4; ++q) {
                const f32x4 m = *(const f32x4*)(mu + s * D + 256 * q + 4 * lane);
                const f32x4 o = x[q] + (xp[q] - x[q]) * m;
                st_bf4(p.X6 + (size_t)s * T * D + (size_t)t * D + 256 * q + 4 * lane, o);
            }
        }
    }
}

struct SchedRW1 {
    const Params* p; int j;
    DEV bool next(int i, Unit& u) const {
        int pm, pn; if (!pg8::tile_order(i, NB_, bid_(), 64, 15, pm, pn)) return false;
        int id, lpn; if (pn < 12) { id = pn >> 2; lpn = pn & 3; } else { id = 3 + (pn - 12); lpn = 0; }
        u.A = (const char*)(p->X6 + (size_t)id * T * D + (size_t)pm * 256 * D);
        const bf16_t* B;
        if (id < 3) B = p->rw_rkv_t + ((size_t)j * 3 + id) * D * D + (size_t)lpn * 256 * D;
        else B = p->rw_w1_t + (size_t)(id - 3) * (2 * 256 * D) + (size_t)j * 256 * D;
        u.B = (const char*)B; u.row0 = pm * 256; u.col0 = lpn * 256; u.id = id; u.aux = 0; return true;
    }
};
struct EpiRW1 {
    const Params* p;
    DEV void operator()(const AccT& acc, const Unit& u, int wr, int wc, int fr, int fq) const {
        if (u.id < 3) {
            float* O = p->Rr + (size_t)u.id * T * D;
            FOR_ACC(ai, bj, m, n) *(f32x4*)(O + (size_t)ACC_ROW(u, ai, m) * D + ACC_COL(u, bj, n)) = acc[ai][bj][m][n];
        } else {
            bf16_t* O = p->LW + (size_t)(u.id - 3) * T * 256;
            FOR_ACC(ai, bj, m, n) {
                f32x4 v = acc[ai][bj][m][n];
                if (u.id == 3) { for (int e = 0; e < 4; ++e) v[e] = tanhf_(v[e]); }
                else if (u.id == 5) { for (int e = 0; e < 4; ++e) v[e] = sigmoidf_(v[e]); }
                st_bf4(O + (size_t)ACC_ROW(u, ai, m) * 256 + ACC_COL(u, bj, n), v); ACC_FENCE;
            }
        }
    }
};
struct SchedRW2 {
    const Params* p; int j;
    DEV bool next(int i, Unit& u) const {
        int pm, pn; if (!pg8::tile_order(i, NB_, bid_(), 64, 12, pm, pn)) return false;
        const int id = pn >> 2, lpn = pn & 3;
        u.A = (const char*)(p->LW + (size_t)id * T * 256 + (size_t)pm * 256 * 256);
        const bf16_t* B = p->rw_w2_t + (size_t)id * (2 * D * 256) + (size_t)j * D * 256 + (size_t)lpn * 256 * 256;
        u.B = (const char*)B; u.row0 = pm * 256; u.col0 = lpn * 256; u.id = id; u.aux = 0; return true;
    }
};
struct EpiRW2 {
    const Params* p; int j;
    DEV void operator()(const AccT& acc, const Unit& u, int wr, int wc, int fr, int fq) const {
        if (u.id == 0) { const float* bias = p->rw_w0 + (size_t)j * D;
            FOR_ACC(ai, bj, m, n) { f32x4 v = acc[ai][bj][m][n]; const int c = ACC_COL(u, bj, n); const f32x4 b = *(const f32x4*)(bias + c);
                for (int e = 0; e < 4; ++e) { const float x = -(b[e] + v[e]); const float wl = -(fmaxf(x, 0.f) + __logf(1.0f + __expf(-fabsf(x)))) - 0.5f; v[e] = __expf(-__expf(wl)); }
                *(f32x4*)(p->Wd + (size_t)ACC_ROW(u, ai, m) * D + c) = v; ACC_FENCE; } }
        else if (u.id == 1) { const float* bias = p->rw_a0 + (size_t)j * D;
            FOR_ACC(ai, bj, m, n) { f32x4 v = acc[ai][bj][m][n]; const int c = ACC_COL(u, bj, n); const f32x4 b = *(const f32x4*)(bias + c);
                for (int e = 0; e < 4; ++e) v[e] = sigmoidf_(b[e] + v[e]);
                *(f32x4*)(p->Aa + (size_t)ACC_ROW(u, ai, m) * D + c) = v; ACC_FENCE; } }
        else { FOR_ACC(ai, bj, m, n) *(f32x4*)(p->Gg + (size_t)ACC_ROW(u, ai, m) * D + ACC_COL(u, bj, n)) = acc[ai][bj][m][n]; }
    }
};

DEV void phase_rw_prep(const Params& p, int j) {
    const int tid = tid_(), bid = bid_(); (void)tid; (void)bid;
    const int lane = tid & 63, wid = tid >> 6;
    const float* k_k = p.rw_k_k + (size_t)j * D; const float* k_a = p.rw_k_a + (size_t)j * D; const float* r_k = p.rw_r_k + (size_t)j * D;
    for (int rr = 0; rr < 8; ++rr) {
        const int t = bid * 64 + wid * 8 + rr; const size_t ro = (size_t)t * D;
#pragma unroll
        for (int q = 0; q < 4; ++q) {
            const int c = 256 * q + 4 * lane; const int head = 4 * q + (lane >> 4);
            const f32x4 r = *(const f32x4*)(p.Rr + ro + c), k = *(const f32x4*)(p.Kk + ro + c), w = *(const f32x4*)(p.Wd + ro + c), a = *(const f32x4*)(p.Aa + ro + c);
            const f32x4 kkw = *(const f32x4*)(k_k + c), kaw = *(const f32x4*)(k_a + c), rkw = *(const f32x4*)(r_k + c);
            f32x4 kk = k * kkw;
            float ss = kk[0] * kk[0] + kk[1] * kk[1] + kk[2] * kk[2] + kk[3] * kk[3];
            ss = sum16(ss);
            const float inv = 1.0f / fmaxf(sqrtf(ss), 1e-12f);
            kk = kk * inv;
            const f32x4 b = kk * a;
            f32x4 kh; for (int e = 0; e < 4; ++e) kh[e] = k[e] * (1.0f + (a[e] - 1.0f) * kaw[e]);
            const f32x4 wrr = w * r;
            float c1 = b[0] * r[0] + b[1] * r[1] + b[2] * r[2] + b[3] * r[3];
            float c2 = kh[0] * r[0] + kh[1] * r[1] + kh[2] * r[2] + kh[3] * r[3];
            float bc = r[0] * kh[0] * rkw[0] + r[1] * kh[1] * rkw[1] + r[2] * kh[2] * rkw[2] + r[3] * kh[3] * rkw[3];
            c1 = sum16(c1); c2 = sum16(c2); bc = sum16(bc);
            *(f32x4*)(p.P2 + ro + c) = -kk; *(f32x4*)(p.P3 + ro + c) = b; *(f32x4*)(p.P4 + ro + c) = kh; *(f32x4*)(p.P5 + ro + c) = wrr;
            if ((lane & 15) == 0) { p.C1[(size_t)t * 16 + head] = c1; p.C2[(size_t)t * 16 + head] = c2; p.BC[(size_t)t * 16 + head] = bc; }
        }
    }
}

template <int CTRL> DEV float dppf(float v) { return __builtin_bit_cast(float, __builtin_amdgcn_update_dpp(0, __builtin_bit_cast(int, v), CTRL, 0xF, 0xF, false)); }
DEV float allsum16_dpp(float v) {
    v += dppf<0xB1>(v);
    v += dppf<0x4E>(v);
    v += dppf<0x141>(v);
    v += dppf<0x140>(v);
    return v;
}
constexpr int SC_TC = 32;
constexpr int SC_STEP_F = 5 * 64 + 16 + 2 + 2;
DEV void phase_rw_scan(const Params& p, LAS unsigned char* lds) {
    const int tid = tid_(), bid = bid_(); (void)tid; (void)bid;
    if (bid >= 64) return;
    const int lane = tid & 63, wid = tid >> 6;
    const int head = bid >> 2, rbase = (bid & 3) * 16;
    LAS float* buf = (LAS float*)lds;
    LAS float* ybuf = buf + 2 * SC_TC * SC_STEP_F;
    f32x4 stg[6];
#define SC_ISSUE(chunk) do { _Pragma("unroll") for (int i = 0; i < 6; ++i) { \
        const int it = tid + i * 512; stg[i] = (f32x4){0.f, 0.f, 0.f, 0.f}; \
        if (it < SC_TC * 85) { const int st = it / 85, w = it - st * 85; const int t = (chunk) * SC_TC + st; \
            if (w < 80) { const int a = w >> 4, q = w & 15; const float* sp_ = (a == 0 || a == 4) ? p.Wd + (size_t)(a >> 2) * T * D : p.P2 + (size_t)(a - 1) * T * D; stg[i] = *(const f32x4*)(sp_ + (size_t)t * D + head * 64 + q * 4); } \
            else if (w < 84) { stg[i] = *(const f32x4*)(p.Vv + (size_t)t * D + head * 64 + rbase + (w - 80) * 4); } \
            else { stg[i].x = p.C1[(size_t)t * 16 + head]; stg[i].y = p.C2[(size_t)t * 16 + head]; } } } } while (0)
#define SC_COMMIT(b) do { _Pragma("unroll") for (int i = 0; i < 6; ++i) { const int it = tid + i * 512; \
        if (it < SC_TC * 85) { const int st = it / 85, w = it - st * 85; *(LAS f32x4*)(buf + ((b) * SC_TC + st) * SC_STEP_F + w * 4) = stg[i]; } } } while (0)
    SC_ISSUE(0); SC_COMMIT(0); __syncthreads();
    const int row = lane >> 4, kq = lane & 15;
    f32x4 s = {0.f, 0.f, 0.f, 0.f};
    const int nchunk = T / SC_TC;
    for (int c = 0; c < nchunk; ++c) {
        const int b = c & 1;
        if (c + 1 < nchunk) SC_ISSUE(c + 1);
        if (wid < 4) {
#pragma unroll 2
            for (int st = 0; st < SC_TC; ++st) {
                const LAS float* sp = buf + (b * SC_TC + st) * SC_STEP_F;
                const f32x4 w = *(const LAS f32x4*)(sp + kq * 4), p2 = *(const LAS f32x4*)(sp + 64 + kq * 4), p3 = *(const LAS f32x4*)(sp + 128 + kq * 4),
                            p4 = *(const LAS f32x4*)(sp + 192 + kq * 4), p5 = *(const LAS f32x4*)(sp + 256 + kq * 4);
                const float vv = sp[320 + wid * 4 + row], c1 = sp[336], c2 = sp[337];
                float sa = s[0] * p2[0] + s[1] * p2[1] + s[2] * p2[2] + s[3] * p2[3];
                float yy = s[0] * p5[0] + s[1] * p5[1] + s[2] * p5[2] + s[3] * p5[3];
                sa = allsum16_dpp(sa); yy = allsum16_dpp(yy);
                yy += sa * c1 + vv * c2;
#pragma unroll
                for (int e = 0; e < 4; ++e) s[e] = s[e] * w[e] + sa * p3[e] + vv * p4[e];
                if (kq == 0) ybuf[(b * SC_TC + st) * 16 + wid * 4 + row] = yy;
            }
        }
        if (c + 1 < nchunk) SC_COMMIT(b ^ 1);
        __syncthreads();
        { const int st = tid >> 4, r = tid & 15; p.Y[(size_t)(c * SC_TC + st) * D + head * 64 + rbase + r] = ybuf[(b * SC_TC + st) * 16 + r]; }
    }
}

DEV void phase_rw_post(const Params& p, int j) {
    const int tid = tid_(), bid = bid_(); (void)tid; (void)bid;
    const int lane = tid & 63, wid = tid >> 6;
    const float* lg = p.rw_lnx_g + (size_t)j * D; const float* lb = p.rw_lnx_b + (size_t)j * D;
    for (int rr = 0; rr < 8; ++rr) {
        const int t = bid * 64 + wid * 8 + rr; const size_t ro = (size_t)t * D;
#pragma unroll
        for (int q = 0; q < 4; ++q) {
            const int c = 256 * q + 4 * lane; const int head = 4 * q + (lane >> 4);
            const f32x4 y = *(const f32x4*)(p.Y + ro + c), v = *(const f32x4*)(p.Vv + ro + c), g = *(const f32x4*)(p.Gg + ro + c);
            const float mean = sum16(y[0] + y[1] + y[2] + y[3]) * (1.0f / 64.0f);
            const f32x4 d = y - mean;
            const float var = sum16(d[0] * d[0] + d[1] * d[1] + d[2] * d[2] + d[3] * d[3]) * (1.0f / 64.0f);
            const float rs = rsqrtf(var + 64e-5f);
            const float bc = p.BC[(size_t)t * 16 + head];
            const f32x4 gw = *(const f32x4*)(lg + c), bw = *(const f32x4*)(lb + c);
            f32x4 o; for (int e = 0; e < 4; ++e) o[e] = (d[e] * rs * gw[e] + bw[e] + bc * v[e]) * g[e];
            st_bf4(p.YB + ro + c, o);
        }
    }
}
struct SchedOut {
    const bf16_t* A; const bf16_t* Bt; int K;
    DEV bool next(int i, Unit& u) const {
        int pm, pn; if (!pg8::tile_order(i, NB_, bid_(), 64, 4, pm, pn)) return false;
        u.A = (const char*)(A + (size_t)pm * 256 * K); u.B = (const char*)(Bt + (size_t)pn * 256 * K); u.row0 = pm * 256; u.col0 = pn * 256; u.id = 0; u.aux = 0; return true;
    }
};
struct EpiOut {
    float* O;
    DEV void operator()(const AccT& acc, const Unit& u, int wr, int wc, int fr, int fq) const {
        FOR_ACC(ai, bj, m, n) *(f32x4*)(O + (size_t)ACC_ROW(u, ai, m) * D + ACC_COL(u, bj, n)) = acc[ai][bj][m][n];
    }
};
DEV void phase_ln1(const Params& p, int layer, const float* hin, LAS unsigned char* lds) {
    const int tid = tid_(), bid = bid_(); (void)tid; (void)bid;
    const int lane = tid & 63, wid = tid >> 6;
    LAS float* wt = (LAS float*)lds;
    LAS float* lg = wt + 36 * 1028;
    LAS int* cnt = (LAS int*)(lg + 8 * 64);
    const float* wr_ = p.moe_w_route + (size_t)layer * D * 32; const float* wg_ = p.moe_w_group + (size_t)layer * D * 4;
    for (int i = tid; i < D * 32; i += NTHR) { const int k = i >> 5, o = i & 31; wt[o * 1028 + k] = wr_[i]; }
    for (int i = tid; i < D * 4; i += NTHR) { const int k = i >> 2, o = i & 3; wt[(32 + o) * 1028 + k] = wg_[i]; }
    if (tid < 32) cnt[tid] = 0;
    __syncthreads();
    const float* g = p.ln_g + ((size_t)layer * 2 + 0) * D; const float* be = p.ln_b + ((size_t)layer * 2 + 0) * D;
    const float* br = p.moe_b_route + layer * 32; const float* bg = p.moe_b_group + layer * 4;
    for (int rr = 0; rr < 8; ++rr) {
        const int t = bid * 64 + wid * 8 + rr; const size_t ro = (size_t)t * D;
        f32x4 z[4], m[4];
        load_row(hin + ro, lane, z); load_row(p.MIX + ro, lane, m);
        float s = 0.f;
#pragma unroll
        for (int q = 0; q < 4; ++q) { z[q] = z[q] * ALPHA + m[q]; s += z[q][0] + z[q][1] + z[q][2] + z[q][3]; }
        const float mean = wave_sum(s) * (1.0f / D);
        float vs = 0.f;
#pragma unroll
        for (int q = 0; q < 4; ++q) { z[q] = z[q] - mean; vs += z[q][0] * z[q][0] + z[q][1] * z[q][1] + z[q][2] * z[q][2] + z[q][3] * z[q][3]; }
        const float rs = rsqrtf(wave_sum(vs) * (1.0f / D) + LN_EPS);
#pragma unroll
        for (int q = 0; q < 4; ++q) {
            const f32x4 gw = *(const f32x4*)(g + 256 * q + 4 * lane), bw = *(const f32x4*)(be + 256 * q + 4 * lane);
            z[q] = z[q] * rs * gw + bw;
            *(f32x4*)(p.H1 + ro + 256 * q + 4 * lane) = z[q];
        }
        LAS float* L = lg + wid * 64;
#pragma unroll 1
        for (int gI = 0; gI < 4; ++gI) skinny_group<8>(z, wt + gI * 8 * 1028, lane, L + gI * 8);
        skinny_group<4>(z, wt + 32 * 1028, lane, L + 32);
        if (lane == 0) {
            const float q0 = L[32] + bg[0], q1 = L[33] + bg[1], q2 = L[34] + bg[2], q3 = L[35] + bg[3];
            int gi = 0; float gm = q0;
            if (q1 > gm) { gm = q1; gi = 1; } if (q2 > gm) { gm = q2; gi = 2; } if (q3 > gm) { gm = q3; gi = 3; }
            const float den = __expf(q0 - gm) + __expf(q1 - gm) + __expf(q2 - gm) + __expf(q3 - gm);
            const float pgrp = 1.0f / den;
            float l1 = -INFINITY, l2 = -INFINITY; int i1 = 0, i2 = 0;
#pragma unroll 1
            for (int o = 0; o < 8; ++o) { const float v = L[gi * 8 + o] + br[gi * 8 + o];
                if (v > l1) { l2 = l1; i2 = i1; l1 = v; i1 = o; } else if (v > l2) { l2 = v; i2 = o; } }
            const float e2 = __expf(l2 - l1), inv = 1.0f / (1.0f + e2);
            const int e0 = gi * 8 + i1, e1 = gi * 8 + i2;
            p.EIDX[2 * t] = e0; p.EIDX[2 * t + 1] = e1; p.GATE[2 * t] = pgrp * inv; p.GATE[2 * t + 1] = pgrp * e2 * inv;
            atomicAdd((int*)&cnt[e0], 1); atomicAdd((int*)&cnt[e1], 1);
        }
    }
    __syncthreads();
    if (tid < 32) p.CNT[bid * 32 + tid] = cnt[tid];
}

DEV void phase_moe_scatter(const Params& p, LAS unsigned char* lds) {
    const int tid = tid_(), bid = bid_(); (void)tid; (void)bid;
    const int lane = tid & 63, wid = tid >> 6;
    LAS int* part = (LAS int*)lds;
    LAS int* pre = part + 512;
    LAS int* base = pre + 512;
    LAS int* pst = base + 32;
    LAS int* dst = pst + 40;
    LAS int* eid = dst + 128;
    { const int e = tid & 31, part_i = tid >> 5; int tot = 0, prf = 0;
      for (int b = part_i * 16; b < part_i * 16 + 16; ++b) { const int c = p.CNT[b * 32 + e]; tot += c; if (b < (int)bid) prf += c; }
      part[part_i * 32 + e] = tot; pre[part_i * 32 + e] = prf; }
    if (tid < 128) eid[tid] = p.EIDX[bid * 128 + tid];
    __syncthreads();
    if (tid < 32) { int tot = 0, prf = 0; for (int i = 0; i < 16; ++i) { tot += part[i * 32 + tid]; prf += pre[i * 32 + tid]; } part[tid] = tot; pre[tid] = prf; }
    __syncthreads();
    if (tid == 0) { int acc = 0; for (int e = 0; e < 32; ++e) { pst[e] = acc; acc += ((part[e] + 255) >> 8) << 8; } pst[32] = acc;
        if (bid == 0) { for (int e = 0; e <= 32; ++e) p.TAB[e] = pst[e]; p.TAB[33] = acc >> 8;
            for (int e = 0; e < 32; ++e) for (int mt = pst[e] >> 8; mt < (pst[e + 1] >> 8); ++mt) p.TAB[64 + mt] = e; } }
    __syncthreads();
    if (tid < 32) { int run = pst[tid] + pre[tid]; for (int a = 0; a < 128; ++a) if (eid[a] == tid) dst[a] = run++; }
    __syncthreads();
    if (tid < 128) p.DEST[bid * 128 + tid] = dst[tid];
    for (int a = wid * 16; a < wid * 16 + 16; ++a) {
        const int t = bid * 64 + (a >> 1); const int d = dst[a];
        f32x4 z[4]; load_row(p.H1 + (size_t)t * D, lane, z);
#pragma unroll
        for (int q = 0; q < 4; ++q) st_bf4(p.BUF + (size_t)d * D + 256 * q + 4 * lane, z[q]);
    }
}

template <int which> struct SchedMoe {
    const Params* p; int layer;
    DEV bool next(int i, Unit& u) const {
        const int nmt = p->TAB[33]; int pm, pn; if (!pg8::tile_order(i, NB_, bid_(), nmt, 4, pm, pn)) return false;
        const int row0 = pm * 256; const int e = p->TAB[64 + pm];
        if constexpr (which == 0) { u.A = (const char*)(p->BUF + (size_t)row0 * D); u.B = (const char*)(p->moe_w1_t + ((size_t)layer * 32 + e) * 1024 * 1024 + (size_t)pn * 256 * 1024); }
        else { u.A = (const char*)(p->ACT + (size_t)row0 * 512); u.B = (const char*)(p->moe_w2_t + ((size_t)layer * 32 + e) * 1024 * 512 + (size_t)pn * 256 * 512); }
        u.row0 = row0; u.col0 = pn * 256; u.id = e; u.aux = 0; return true;
    }
};
struct EpiMoe1 {
    bf16_t* O;
    DEV void operator()(const AccT& acc, const Unit& u, int wr, int wc, int fr, int fq) const {
#pragma unroll
        for (int ai = 0; ai < 2; ++ai)
#pragma unroll
            for (int m = 0; m < 4; ++m)
#pragma unroll
                for (int n = 0; n < 2; ++n) {
                    const f32x4 gt = acc[ai][0][m][n], up = acc[ai][1][m][n]; f32x4 v;
                    for (int e = 0; e < 4; ++e) v[e] = siluf_(gt[e]) * up[e];
                    const int col = (u.col0 >> 1) + 32 * wc + 16 * n + 4 * fq;
                    st_bf4(O + (size_t)ACC_ROW(u, ai, m) * 512 + col, v); ACC_FENCE;
                }
    }
};
struct EpiMoe2 {
    bf16_t* O;
    DEV void operator()(const AccT& acc, const Unit& u, int wr, int wc, int fr, int fq) const {
        FOR_ACC(ai, bj, m, n) { st_bf4(O + (size_t)ACC_ROW(u, ai, m) * D + ACC_COL(u, bj, n), acc[ai][bj][m][n]); ACC_FENCE; }
    }
};

DEV void phase_ln2(const Params& p, int layer, float* hout) {
    const int tid = tid_(), bid = bid_(); (void)tid; (void)bid;
    const int lane = tid & 63, wid = tid >> 6;
    const float* g = p.ln_g + ((size_t)layer * 2 + 1) * D; const float* be = p.ln_b + ((size_t)layer * 2 + 1) * D;
    for (int rr = 0; rr < 8; ++rr) {
        const int t = bid * 64 + wid * 8 + rr; const size_t ro = (size_t)t * D;
        const int d0 = p.DEST[2 * t], d1 = p.DEST[2 * t + 1]; const float g0 = p.GATE[2 * t], g1 = p.GATE[2 * t + 1];
        f32x4 z[4]; load_row(p.H1 + ro, lane, z);
        float s = 0.f;
#pragma unroll
        for (int q = 0; q < 4; ++q) {
            const u32x2 a = *(const u32x2*)(p.YBUF + (size_t)d0 * D + 256 * q + 4 * lane), b = *(const u32x2*)(p.YBUF + (size_t)d1 * D + 256 * q + 4 * lane);
            z[q][0] = z[q][0] * ALPHA + g0 * bflo(a.x) + g1 * bflo(b.x); z[q][1] = z[q][1] * ALPHA + g0 * bfhi(a.x) + g1 * bfhi(b.x);
            z[q][2] = z[q][2] * ALPHA + g0 * bflo(a.y) + g1 * bflo(b.y); z[q][3] = z[q][3] * ALPHA + g0 * bfhi(a.y) + g1 * bfhi(b.y);
            s += z[q][0] + z[q][1] + z[q][2] + z[q][3];
        }
        const float mean = wave_sum(s) * (1.0f / D);
        float vs = 0.f;
#pragma unroll
        for (int q = 0; q < 4; ++q) { z[q] = z[q] - mean; vs += z[q][0] * z[q][0] + z[q][1] * z[q][1] + z[q][2] * z[q][2] + z[q][3] * z[q][3]; }
        const float rs = rsqrtf(wave_sum(vs) * (1.0f / D) + LN_EPS);
#pragma unroll
        for (int q = 0; q < 4; ++q) {
            const f32x4 gw = *(const f32x4*)(g + 256 * q + 4 * lane), bw = *(const f32x4*)(be + 256 * q + 4 * lane);
            *(f32x4*)(hout + ro + 256 * q + 4 * lane) = z[q] * rs * gw + bw;
        }
    }
}
constexpr int MB_PROJ = 5152;
DEV void phase_mb_cast(const Params& p, int j, const float* hin, LAS unsigned char* lds) {
    const int tid = tid_(), bid = bid_(); (void)tid; (void)bid;
    const int lane = tid & 63, wid = tid >> 6;
    LAS float* wt = (LAS float*)lds;
    const float* w = p.mb_w_in + (size_t)j * D * MB_PROJ;
    for (int i = tid; i < D * 32; i += NTHR) { const int k = i >> 5, o = i & 31; wt[o * 1028 + k] = w[(size_t)k * MB_PROJ + 5120 + o]; }
    __syncthreads();
    for (int rr = 0; rr < 8; ++rr) {
        const int t = bid * 64 + wid * 8 + rr; const size_t ro = (size_t)t * D;
        f32x4 z[4]; load_row(hin + ro, lane, z);
#pragma unroll
        for (int q = 0; q < 4; ++q) st_bf4(p.X6 + ro + 256 * q + 4 * lane, z[q]);
        LAS float* L = wt + 32 * 1028 + wid * 32;
#pragma unroll 1
        for (int gI = 0; gI < 4; ++gI) skinny_group<8>(z, wt + gI * 8 * 1028, lane, L + gI * 8);
        if (lane < 32) p.DT[(size_t)t * 32 + lane] = softplusf_(L[lane] + p.mb_dt_bias[j * 32 + lane]);
    }
}
struct SchedMbIn {
    const Params* p;
    DEV bool next(int i, Unit& u) const {
        int pm, pn; if (!pg8::tile_order(i, NB_, bid_(), 64, 20, pm, pn)) return false;
        u.A = (const char*)(p->X6 + (size_t)pm * 256 * D); u.B = (const char*)(p->mb_win_t + (size_t)pn * 256 * D); u.row0 = pm * 256; u.col0 = pn * 256; u.id = 0; u.aux = 0; return true;
    }
};
struct EpiMbIn {
    const Params* p;
    DEV void operator()(const AccT& acc, const Unit& u, int wr, int wc, int fr, int fq) const {
        const bool isz = u.col0 < 2048; bf16_t* O = p->Z + (isz ? (size_t)0 : (size_t)T * 2048 - 2048); const int ld = isz ? 2048 : 3072;
        FOR_ACC(ai, bj, m, n) { st_bf4(O + (size_t)ACC_ROW(u, ai, m) * ld + ACC_COL(u, bj, n), acc[ai][bj][m][n]); ACC_FENCE; }
    }
};
DEV void phase_mb_conv(const Params& p, int j) {
    const int tid = tid_(), bid = bid_(); (void)tid; (void)bid;
    if (tid >= 384) return;
    const int c0 = tid * 8; const int t0 = bid * 64;
    const float* cw = p.mb_conv_w + (size_t)j * 4 * 3072; const float* cb = p.mb_conv_b + (size_t)j * 3072;
    float w[4][8], b[8];
#pragma unroll
    for (int i = 0; i < 4; ++i) { const f32x4 a = *(const f32x4*)(cw + i * 3072 + c0), bb = *(const f32x4*)(cw + i * 3072 + c0 + 4); for (int e = 0; e < 4; ++e) { w[i][e] = a[e]; w[i][4 + e] = bb[e]; } }
    { const f32x4 a = *(const f32x4*)(cb + c0), bb = *(const f32x4*)(cb + c0 + 4); for (int e = 0; e < 4; ++e) { b[e] = a[e]; b[4 + e] = bb[e]; } }
    float x0[8], x1[8], x2[8], x3[8];
    auto ld = [&](int t, float (&x)[8]) {
        if (t < 0) { for (int e = 0; e < 8; ++e) x[e] = 0.f; return; }
        const u32x4 v = *(const u32x4*)(p.XBC + (size_t)t * 3072 + c0);
        x[0] = bflo(v.x); x[1] = bfhi(v.x); x[2] = bflo(v.y); x[3] = bfhi(v.y); x[4] = bflo(v.z); x[5] = bfhi(v.z); x[6] = bflo(v.w); x[7] = bfhi(v.w);
    };
    ld(t0 - 3, x0); ld(t0 - 2, x1); ld(t0 - 1, x2);
    for (int tt = 0; tt < 64; ++tt) {
        ld(t0 + tt, x3);
        float o[8];
#pragma unroll
        for (int e = 0; e < 8; ++e) o[e] = siluf_(b[e] + w[0][e] * x0[e] + w[1][e] * x1[e] + w[2][e] * x2[e] + w[3][e] * x3[e]);
        u32x4 r; r.x = pk2(o[0], o[1]); r.y = pk2(o[2], o[3]); r.z = pk2(o[4], o[5]); r.w = pk2(o[6], o[7]);
        *(u32x4*)(p.XC + (size_t)(t0 + tt) * 3072 + c0) = r;
#pragma unroll
        for (int e = 0; e < 8; ++e) { x0[e] = x1[e]; x1[e] = x2[e]; x2[e] = x3[e]; }
    }
}

DEV void mb_dacs(const Params& p, int j, int c, int g, LAS float* dts, LAS float* dacs) {
    const int tid = tid_(); const int lane = tid & 63, h = tid >> 6;
    const int hh = 8 * g + h; const float a = -__expf(p.mb_a_log[j * 32 + hh]);
    const float d0 = p.DT[(size_t)(c * 128 + 2 * lane) * 32 + hh], d1 = p.DT[(size_t)(c * 128 + 2 * lane + 1) * 32 + hh];
    const float a0 = d0 * a, a1 = d1 * a;
    float s = a0 + a1;
#pragma unroll
    for (int o = 1; o < 64; o <<= 1) { const float v = __shfl_up(s, o); if (lane >= o) s += v; }
    dts[h * 128 + 2 * lane] = d0; dts[h * 128 + 2 * lane + 1] = d1;
    dacs[h * 128 + 2 * lane] = s - a1; dacs[h * 128 + 2 * lane + 1] = s;
}
constexpr int LDB = 136;
constexpr int LDX = 72;
DEV void ld_tile128(const bf16_t* src, int gld, LAS bf16_t* dst) {
    const int tid = tid_();
    for (int i = tid; i < 128 * 16; i += NTHR) { const int r = i >> 4, c8 = (i & 15) * 8; *(LAS u32x4*)(dst + r * LDB + c8) = *(const u32x4*)(src + (size_t)r * gld + c8); }
}

DEV void phase_mb_states(const Params& p, int j, LAS unsigned char* lds) {
    const int tid = tid_(), bid = bid_(); (void)tid; (void)bid;
    const int lane = tid & 63, w = tid >> 6;
    LAS bf16_t* Bm = (LAS bf16_t*)lds;
    LAS bf16_t* Xh = Bm + 128 * LDB;
    LAS float* dts = (LAS float*)(Xh + 128 * LDX);
    LAS float* dacs = dts + 1024;
    for (int u = bid; u < 512; u += NB_) {
        const int c = u >> 2, g = u & 3; const int t0 = c * 128;
        __syncthreads();
        mb_dacs(p, j, c, g, dts, dacs);
        ld_tile128(p.XC + (size_t)t0 * 3072 + 2048 + 128 * g, 3072, Bm);
        __syncthreads();
        if (tid < 8) p.CD[(c * 32) + 8 * g + tid] = __expf(dacs[tid * 128 + 127]);
        bf16x8 bfr[4];
#pragma unroll
        for (int ks = 0; ks < 4; ++ks) bfr[ks] = frag_tr(Bm, LDB, 32 * ks, 16 * w, lane);
        for (int h = 0; h < 8; ++h) {
            { const int l = tid >> 2, p0 = (tid & 3) * 16; const float sc = dts[h * 128 + l] * __expf(dacs[h * 128 + 127] - dacs[h * 128 + l]);
              const bf16_t* src = p.XC + (size_t)(t0 + l) * 3072 + 64 * (8 * g + h) + p0;
#pragma unroll
              for (int hf = 0; hf < 2; ++hf) { const u32x4 v = *(const u32x4*)(src + 8 * hf); u32x4 r;
                  r.x = pk2(bflo(v.x) * sc, bfhi(v.x) * sc); r.y = pk2(bflo(v.y) * sc, bfhi(v.y) * sc); r.z = pk2(bflo(v.z) * sc, bfhi(v.z) * sc); r.w = pk2(bflo(v.w) * sc, bfhi(v.w) * sc);
                  *(LAS u32x4*)(Xh + l * LDX + p0 + 8 * hf) = r; } }
            __syncthreads();
            f32x4 acc[4];
#pragma unroll
            for (int pb = 0; pb < 4; ++pb) { acc[pb] = (f32x4){0.f, 0.f, 0.f, 0.f};
#pragma unroll
                for (int ks = 0; ks < 4; ++ks) { const bf16x8 af = frag_tr(Xh, LDX, 32 * ks, 16 * pb, lane); acc[pb] = MFMA16(af, bfr[ks], acc[pb]); } }
            float* S = p.STATES + (((size_t)c * 32 + 8 * g + h) * 64) * 128;
#pragma unroll
            for (int pb = 0; pb < 4; ++pb)
#pragma unroll
                for (int r = 0; r < 4; ++r) S[(size_t)(16 * pb + 4 * (lane >> 4) + r) * 128 + 16 * w + (lane & 15)] = acc[pb][r];
            __syncthreads();
        }
    }
}
DEV void phase_mb_scan(const Params& p) {
    const int tid = tid_(), bid = bid_(); (void)tid; (void)bid;
    const int gid = bid * NTHR + tid;
    if (gid >= 32 * 64 * 64) return;
    const int np = gid & 63, pp = (gid >> 6) & 63, h = gid >> 12; const int n = 2 * np;
    float r0 = 0.f, r1 = 0.f;
    const size_t eo = ((size_t)h * 64 + pp) * 128 + n;
    const size_t fo = (size_t)h * 64 * 128 + fragmajor_off(pp, n, 128);
#pragma unroll 4
    for (int c = 0; c < 128; ++c) {
        const f32x2 s = *(const f32x2*)(p.STATES + (size_t)c * 32 * 64 * 128 + eo);
        const float cd = p.CD[c * 32 + h];
        *(unsigned*)(p.PREV + (size_t)c * 32 * 64 * 128 + fo) = pk2(r0, r1);
        r0 = r0 * cd + s[0]; r1 = r1 * cd + s[1];
    }
}
DEV void phase_mb_out(const Params& p, int j, LAS unsigned char* lds) {
    const int tid = tid_(), bid = bid_(); (void)tid; (void)bid;
    const int lane = tid & 63, w = tid >> 6; const int fr = lane & 15, fq = lane >> 4;
    LAS bf16_t* Cm = (LAS bf16_t*)lds;
    LAS bf16_t* Bm = Cm + 128 * LDB;
    LAS bf16_t* Xh = Bm + 128 * LDB;
    LAS bf16_t* Mw = Xh + 128 * LDX;
    LAS float* dts = (LAS float*)(Mw + 8 * 16 * LDB);
    LAS float* dacs = dts + 1024;
    LAS bf16_t* Mme = Mw + w * 16 * LDB;
    for (int u = bid; u < 512; u += NB_) {
        const int c = u >> 2, g = u & 3; const int t0 = c * 128;
        __syncthreads();
        mb_dacs(p, j, c, g, dts, dacs);
        ld_tile128(p.XC + (size_t)t0 * 3072 + 2048 + 512 + 128 * g, 3072, Cm);
        ld_tile128(p.XC + (size_t)t0 * 3072 + 2048 + 128 * g, 3072, Bm);
        __syncthreads();
        f32x4 sc[8]; bf16x8 cf[4];
#pragma unroll
        for (int ks = 0; ks < 4; ++ks) cf[ks] = frag_rm(Cm, LDB, 16 * w, 32 * ks, lane);
#pragma unroll
        for (int sb = 0; sb < 8; ++sb) { sc[sb] = (f32x4){0.f, 0.f, 0.f, 0.f};
#pragma unroll
            for (int ks = 0; ks < 4; ++ks) sc[sb] = MFMA16(cf[ks], frag_rm(Bm, LDB, 16 * sb, 32 * ks, lane), sc[sb]); }
        float ssq[4] = {0.f, 0.f, 0.f, 0.f};
#pragma unroll 1
        for (int h = 0; h < 8; ++h) {
            const int hh = 8 * g + h;
            { const int l = tid >> 2, p0 = (tid & 3) * 16; const float scl = dts[h * 128 + l];
              const bf16_t* src = p.XC + (size_t)(t0 + l) * 3072 + 64 * hh + p0;
#pragma unroll
              for (int hf = 0; hf < 2; ++hf) { const u32x4 v = *(const u32x4*)(src + 8 * hf); u32x4 r;
                  r.x = pk2(bflo(v.x) * scl, bfhi(v.x) * scl); r.y = pk2(bflo(v.y) * scl, bfhi(v.y) * scl); r.z = pk2(bflo(v.z) * scl, bfhi(v.z) * scl); r.w = pk2(bflo(v.w) * scl, bfhi(v.w) * scl);
                  *(LAS u32x4*)(Xh + l * LDX + p0 + 8 * hf) = r; } }
            float dl[4];
#pragma unroll
            for (int r = 0; r < 4; ++r) dl[r] = dacs[h * 128 + 16 * w + 4 * fq + r];
#pragma unroll
            for (int sb = 0; sb < 8; ++sb) { const int s = 16 * sb + fr; const float ds = dacs[h * 128 + s];
#pragma unroll
                for (int r = 0; r < 4; ++r) { const int l = 16 * w + 4 * fq + r; const float m = (s <= l) ? sc[sb][r] * __expf(dl[r] - ds) : 0.f; Mme[(4 * fq + r) * LDB + s] = (bf16_t)f2bf(m); } }
            __syncthreads();
            bf16x8 mf[4];
#pragma unroll
            for (int ks = 0; ks < 4; ++ks) mf[ks] = frag_rm(Mme, LDB, 0, 32 * ks, lane);
            const bf16_t* pv = p.PREV + ((size_t)c * 32 + hh) * 64 * 128;
#pragma unroll
            for (int pb = 0; pb < 4; ++pb) {
                f32x4 a = {0.f, 0.f, 0.f, 0.f}, o = {0.f, 0.f, 0.f, 0.f};
#pragma unroll
                for (int ks = 0; ks < 4; ++ks) {
                    a = MFMA16(mf[ks], frag_tr(Xh, LDX, 32 * ks, 16 * pb, lane), a);
                    const bf16x8 pf = *(const bf16x8*)(pv + ((size_t)(pb * 4 + ks) * 64 + lane) * 8);
                    o = MFMA16(cf[ks], pf, o);
                }
                const float dsk = p.mb_d[j * 32 + hh];
#pragma unroll
                for (int r = 0; r < 4; ++r) {
                    const int t = t0 + 16 * w + 4 * fq + r; const int ch = 64 * hh + 16 * pb + fr;
                    const float xs = bf2f(p.XC[(size_t)t * 3072 + ch]); const float z = bf2f(p.Z[(size_t)t * 2048 + ch]);
                    float v = a[r] + o[r] * __expf(dl[r]) + xs * dsk;
                    v *= siluf_(z);
                    ssq[r] += v * v;
                    p.YB[(size_t)t * 2048 + ch] = (bf16_t)f2bf(v * p.mb_norm_g[(size_t)j * 2048 + ch]);
                }
            }
            __syncthreads();
        }
#pragma unroll
        for (int r = 0; r < 4; ++r) ssq[r] = rsqrtf(sum16(ssq[r]) * (1.0f / 512.0f) + 1e-5f);
#pragma unroll 1
        for (int h = 0; h < 8; ++h)
#pragma unroll
            for (int pb = 0; pb < 4; ++pb) { const int ch = 512 * g + 64 * h + 16 * pb + fr;
#pragma unroll
                for (int r = 0; r < 4; ++r) { bf16_t* q = p.YB + (size_t)(t0 + 16 * w + 4 * fq + r) * 2048 + ch; *q = (bf16_t)f2bf(bf2f(*q) * ssq[r]); } }
    }
}
constexpr int GL_PROJ = 3088;
constexpr int LDV = 264;
DEV void phase_gl_cast(const Params& p, int j, const float* hin, LAS unsigned char* lds) {
    const int tid = tid_(), bid = bid_(); (void)tid; (void)bid;
    const int lane = tid & 63, wid = tid >> 6;
    LAS float* wt = (LAS float*)lds;
    LAS float* w2 = wt + 16 * 1028;
    LAS float* lr = w2 + 16 * 512;
    const float* w = p.gl_w_in + (size_t)j * D * GL_PROJ;
    for (int i = tid; i < D * 16; i += NTHR) { const int k = i >> 4, o = i & 15; wt[o * 1028 + k] = w[(size_t)k * GL_PROJ + 3072 + o]; }
    for (int i = tid; i < 16 * 512; i += NTHR) w2[i] = p.gl_gk_w2[(size_t)j * 16 * 512 + i];
    __syncthreads();
    for (int rr = 0; rr < 8; ++rr) {
        const int t = bid * 64 + wid * 8 + rr; const size_t ro = (size_t)t * D;
        f32x4 z[4]; load_row(hin + ro, lane, z);
#pragma unroll
        for (int q = 0; q < 4; ++q) st_bf4(p.X6 + ro + 256 * q + 4 * lane, z[q]);
#pragma unroll 1
        for (int gI = 0; gI < 2; ++gI) skinny_group<8>(z, wt + gI * 8 * 1028, lane, lr + wid * 16 + gI * 8);
        float l16[16];
#pragma unroll
        for (int o = 0; o < 16; ++o) l16[o] = lr[wid * 16 + o];
#pragma unroll
        for (int cc = 0; cc < 8; ++cc) {
            const int c = cc * 64 + lane; float a = p.gl_gk_b[j * 512 + c];
#pragma unroll
            for (int o = 0; o < 16; ++o) a += l16[o] * w2[o * 512 + c];
            const float ls = fminf(a, 0.f) - log1pf(__expf(-fabsf(a)));
            p.LA[(size_t)t * 512 + c] = ls * (1.0f / 16.0f);
        }
    }
}
struct SchedGlIn {
    const Params* p;
    DEV bool next(int i, Unit& u) const {
        int pm, pn; if (!pg8::tile_order(i, NB_, bid_(), 64, 12, pm, pn)) return false;
        u.A = (const char*)(p->X6 + (size_t)pm * 256 * D); u.B = (const char*)(p->gl_win_t + (size_t)pn * 256 * D); u.row0 = pm * 256; u.col0 = pn * 256; u.id = 0; u.aux = 0; return true;
    }
};
struct EpiGlIn {
    const Params* p;
    DEV void operator()(const AccT& acc, const Unit& u, int wr, int wc, int fr, int fq) const {
        FOR_ACC(ai, bj, m, n) { st_bf4(p->QKVG + (size_t)ACC_ROW(u, ai, m) * 3072 + ACC_COL(u, bj, n), acc[ai][bj][m][n]); ACC_FENCE; }
    }
};
DEV void gl_bcs(const Params& p, int n, int h, LAS float* bcs) {
    const int tid = tid_();
    for (int i = tid; i < 64 * 32; i += NTHR) { const int r = i >> 5, c4 = (i & 31) * 4; *(LAS f32x4*)(bcs + r * 128 + c4) = *(const f32x4*)(p.LA + (size_t)(n * 64 + r) * 512 + 128 * h + c4); }
    __syncthreads();
    if (tid < 128) { float s = 0.f; for (int r = 0; r < 64; ++r) { s += bcs[r * 128 + tid]; bcs[r * 128 + tid] = s; } }
    __syncthreads();
}
DEV void phase_gl_kv(const Params& p, LAS unsigned char* lds) {
    const int tid = tid_(), bid = bid_(); (void)tid; (void)bid;
    const int lane = tid & 63, w = tid >> 6;
    LAS float* bcs = (LAS float*)lds;
    LAS bf16_t* Ke = (LAS bf16_t*)(bcs + 64 * 128);
    LAS bf16_t* Vs = Ke + 64 * LDB;
    for (int u = bid; u < 1024; u += NB_) {
        const int n = u >> 2, h = u & 3; const int t0 = n * 64;
        __syncthreads();
        gl_bcs(p, n, h, bcs);
        for (int i = tid; i < 64 * 16; i += NTHR) { const int r = i >> 4, c8 = (i & 15) * 8;
            const u32x4 v = *(const u32x4*)(p.QKVG + (size_t)(t0 + r) * 3072 + 512 + 128 * h + c8); float f[8];
            f[0] = bflo(v.x); f[1] = bfhi(v.x); f[2] = bflo(v.y); f[3] = bfhi(v.y); f[4] = bflo(v.z); f[5] = bfhi(v.z); f[6] = bflo(v.w); f[7] = bfhi(v.w);
#pragma unroll
            for (int e = 0; e < 8; ++e) f[e] *= __expf(bcs[63 * 128 + c8 + e] - bcs[r * 128 + c8 + e]);
            u32x4 o; o.x = pk2(f[0], f[1]); o.y = pk2(f[2], f[3]); o.z = pk2(f[4], f[5]); o.w = pk2(f[6], f[7]);
            *(LAS u32x4*)(Ke + r * LDB + c8) = o; }
        for (int i = tid; i < 64 * 32; i += NTHR) { const int r = i >> 5, c8 = (i & 31) * 8; *(LAS u32x4*)(Vs + r * LDV + c8) = *(const u32x4*)(p.QKVG + (size_t)(t0 + r) * 3072 + 1024 + 256 * h + c8); }
        if (tid < 128) p.CDG[((size_t)n * 4 + h) * 128 + tid] = __expf(bcs[63 * 128 + tid]);
        __syncthreads();
        bf16x8 af[2];
#pragma unroll
        for (int ks = 0; ks < 2; ++ks) af[ks] = frag_tr(Ke, LDB, 32 * ks, 16 * w, lane);
        float* O = p.STATES + (((size_t)n * 4 + h) * 128) * 256;
#pragma unroll
        for (int vb = 0; vb < 16; ++vb) {
            f32x4 acc = {0.f, 0.f, 0.f, 0.f};
#pragma unroll
            for (int ks = 0; ks < 2; ++ks) acc = MFMA16(af[ks], frag_tr(Vs, LDV, 32 * ks, 16 * vb, lane), acc);
#pragma unroll
            for (int r = 0; r < 4; ++r) O[(size_t)(16 * w + 4 * (lane >> 4) + r) * 256 + 16 * vb + (lane & 15)] = acc[r];
        }
    }
}
DEV void phase_gl_scan(const Params& p) {
    const int tid = tid_(), bid = bid_(); (void)tid; (void)bid;
    const int gid = bid * NTHR + tid;
    if (gid >= 4 * 64 * 256) return;
    const int v = gid & 255, kp = (gid >> 8) & 63, h = gid >> 14; const int k = 2 * kp;
    float r0 = 0.f, r1 = 0.f;
    const size_t fo = (size_t)h * 128 * 256 + fragmajor_off(v, k, 128);
#pragma unroll 4
    for (int n = 0; n < 256; ++n) {
        const float* S = p.STATES + (((size_t)n * 4 + h) * 128) * 256;
        const float s0 = S[(size_t)k * 256 + v], s1 = S[(size_t)(k + 1) * 256 + v];
        const f32x2 cd = *(const f32x2*)(p.CDG + ((size_t)n * 4 + h) * 128 + k);
        *(unsigned*)(p.PREV + (size_t)n * 4 * 128 * 256 + fo) = pk2(r0, r1);
        r0 = r0 * cd[0] + s0; r1 = r1 * cd[1] + s1;
    }
}
DEV void phase_gl_out(const Params& p, int j, LAS unsigned char* lds) {
    const int tid = tid_(), bid = bid_(); (void)tid; (void)bid;
    const int lane = tid & 63, w = tid >> 6; const int fr = lane & 15, fq = lane >> 4;
    LAS float* bcs = (LAS float*)lds;
    LAS bf16_t* Qs = (LAS bf16_t*)(bcs + 64 * 128);
    LAS bf16_t* Ks = Qs + 64 * LDB;
    LAS bf16_t* Vs = Ks + 64 * LDB;
    LAS bf16_t* At = Vs + 64 * LDV;
    LAS float* red = (LAS float*)(At + 64 * LDX);
    for (int u = bid; u < 1024; u += NB_) {
        const int n = u >> 2, h = u & 3; const int t0 = n * 64;
        __syncthreads();
        gl_bcs(p, n, h, bcs);
        for (int i = tid; i < 64 * 16; i += NTHR) { const int r = i >> 4, c8 = (i & 15) * 8;
            const u32x4 vq = *(const u32x4*)(p.QKVG + (size_t)(t0 + r) * 3072 + 128 * h + c8), vk = *(const u32x4*)(p.QKVG + (size_t)(t0 + r) * 3072 + 512 + 128 * h + c8);
            float fq_[8], fk_[8];
            fq_[0] = bflo(vq.x); fq_[1] = bfhi(vq.x); fq_[2] = bflo(vq.y); fq_[3] = bfhi(vq.y); fq_[4] = bflo(vq.z); fq_[5] = bfhi(vq.z); fq_[6] = bflo(vq.w); fq_[7] = bfhi(vq.w);
            fk_[0] = bflo(vk.x); fk_[1] = bfhi(vk.x); fk_[2] = bflo(vk.y); fk_[3] = bfhi(vk.y); fk_[4] = bflo(vk.z); fk_[5] = bfhi(vk.z); fk_[6] = bflo(vk.w); fk_[7] = bfhi(vk.w);
#pragma unroll
            for (int e = 0; e < 8; ++e) { const float b = bcs[r * 128 + c8 + e]; fq_[e] *= __expf(b) * 0.08838834764831845f; fk_[e] *= __expf(-b); }
            u32x4 o; o.x = pk2(fq_[0], fq_[1]); o.y = pk2(fq_[2], fq_[3]); o.z = pk2(fq_[4], fq_[5]); o.w = pk2(fq_[6], fq_[7]);
            *(LAS u32x4*)(Qs + r * LDB + c8) = o;
            o.x = pk2(fk_[0], fk_[1]); o.y = pk2(fk_[2], fk_[3]); o.z = pk2(fk_[4], fk_[5]); o.w = pk2(fk_[6], fk_[7]);
            *(LAS u32x4*)(Ks + r * LDB + c8) = o; }
        for (int i = tid; i < 64 * 32; i += NTHR) { const int r = i >> 5, c8 = (i & 31) * 8; *(LAS u32x4*)(Vs + r * LDV + c8) = *(const u32x4*)(p.QKVG + (size_t)(t0 + r) * 3072 + 1024 + 256 * h + c8); }
        __syncthreads();
        { const int ib = w >> 1;
#pragma unroll
          for (int jj = 0; jj < 2; ++jj) { const int jb = 2 * (w & 1) + jj; f32x4 a = {0.f, 0.f, 0.f, 0.f};
#pragma unroll
              for (int ks = 0; ks < 4; ++ks) a = MFMA16(frag_rm(Qs, LDB, 16 * ib, 32 * ks, lane), frag_rm(Ks, LDB, 16 * jb, 32 * ks, lane), a);
#pragma unroll
              for (int r = 0; r < 4; ++r) { const int i = 16 * ib + 4 * fq + r, jx = 16 * jb + fr; At[i * LDX + jx] = (bf16_t)f2bf(jx <= i ? a[r] : 0.f); } } }
        __syncthreads();
        f32x4 o[4][2];
        const bf16_t* pv = p.PREV + ((size_t)n * 4 + h) * 128 * 256;
#pragma unroll
        for (int vv = 0; vv < 2; ++vv) { const int vb = 2 * w + vv;
            bf16x8 bi[2], bp[4];
#pragma unroll
            for (int ks = 0; ks < 2; ++ks) bi[ks] = frag_tr(Vs, LDV, 32 * ks, 16 * vb, lane);
#pragma unroll
            for (int ks = 0; ks < 4; ++ks) bp[ks] = *(const bf16x8*)(pv + ((size_t)(vb * 4 + ks) * 64 + lane) * 8);
#pragma unroll
            for (int ib = 0; ib < 4; ++ib) { f32x4 a = {0.f, 0.f, 0.f, 0.f};
#pragma unroll
                for (int ks = 0; ks < 2; ++ks) a = MFMA16(frag_rm(At, LDX, 16 * ib, 32 * ks, lane), bi[ks], a);
#pragma unroll
                for (int ks = 0; ks < 4; ++ks) a = MFMA16(frag_rm(Qs, LDB, 16 * ib, 32 * ks, lane), bp[ks], a);
                o[ib][vv] = a; } }
#pragma unroll
        for (int ib = 0; ib < 4; ++ib)
#pragma unroll
            for (int r = 0; r < 4; ++r) { float s = o[ib][0][r] * o[ib][0][r] + o[ib][1][r] * o[ib][1][r]; s = sum16(s); if (fr == 0) red[w * 64 + 16 * ib + 4 * fq + r] = s; }
        __syncthreads();
#pragma unroll
        for (int ib = 0; ib < 4; ++ib)
#pragma unroll
            for (int r = 0; r < 4; ++r) { const int i = 16 * ib + 4 * fq + r; float s = 0.f;
#pragma unroll
                for (int ww = 0; ww < 8; ++ww) s += red[ww * 64 + i];
                const float rs = rsqrtf(s * (1.0f / 256.0f) + 1e-5f);
#pragma unroll
                for (int vv = 0; vv < 2; ++vv) { const int v = 32 * w + 16 * vv + fr; const int t = t0 + i;
                    const float gt = bf2f(p.QKVG[(size_t)t * 3072 + 2048 + 256 * h + v]);
                    p.YB[(size_t)t * D + 256 * h + v] = (bf16_t)f2bf(o[ib][vv][r] * rs * p.gl_norm_g[j * 256 + v] * siluf_(gt)); } }
    }
}
#define XB_TMO      128
#define XB_XCNT(j)  (256  + 64 * (j))
#define XB_XSUB(j)  (1280 + 64 * (j))
#define XB_XGEN(j)  (2304 + 64 * (j))
#define XB_TOP      3328
#define XB_TOPGEN   3392
#define XCD_BAR_WORDS 3456
#define XB_SPIN_CAP (1u << 22)
DEV unsigned xb_ld(unsigned* p)              { return __hip_atomic_load(p, __ATOMIC_RELAXED, __HIP_MEMORY_SCOPE_AGENT); }
DEV unsigned xb_add(unsigned* p, unsigned v) { return __hip_atomic_fetch_add(p, v, __ATOMIC_RELAXED, __HIP_MEMORY_SCOPE_AGENT); }
DEV unsigned xb_xcc_id() { return (unsigned)__builtin_amdgcn_s_getreg((3 << 11) | 20) & 0xFu; }
#define XB_SPIN(cond, bar) do { unsigned _sp = 0; while (cond) { __builtin_amdgcn_s_sleep(1); \
    if ((++_sp & 255u) == 0u) { if (xb_ld(&(bar)[XB_TMO])) break; if (_sp > XB_SPIN_CAP) { atomicAdd(&(bar)[XB_TMO], 1u); break; } } } } while (0)
struct XcdBarrier { unsigned* bar; unsigned x; volatile LAS unsigned* st; };
DEV XcdBarrier xcd_barrier_post(unsigned* bar, volatile LAS unsigned* st) {
    XcdBarrier b; b.bar = bar; b.x = xb_xcc_id(); b.st = st;
    if (threadIdx.x == 0) (void)xb_add(&bar[XB_XCNT(b.x)], 1u);
    return b;
}
DEV void xcd_barrier_complete(unsigned* bar, unsigned x, unsigned& nloc, unsigned& nx) {
    const unsigned G = gridDim.x * gridDim.y * gridDim.z;
    unsigned sum, cnt, mine, sp = 0u;
    for (;;) {
        sum = 0u; cnt = 0u; mine = 0u;
#pragma unroll
        for (unsigned j = 0; j < 16; ++j) { const unsigned c = xb_ld(&bar[XB_XCNT(j)]); sum += c; cnt += (c > 0u) ? 1u : 0u; mine = (j == x) ? c : mine; }
        if (sum == G) break;
        __builtin_amdgcn_s_sleep(1);
        if ((++sp & 255u) == 0u) { if (xb_ld(&bar[XB_TMO])) break; if (sp > XB_SPIN_CAP) { atomicAdd(&bar[XB_TMO], 1u); break; } }
    }
    nloc = mine > 0u ? mine : 1u; nx = cnt > 0u ? cnt : 1u;
}
DEV void xcd_barrier(const XcdBarrier& b) {
    asm volatile("s_waitcnt vmcnt(0)" ::: "memory");
    __syncthreads();
    if (threadIdx.x == 0) {
        unsigned* bar = b.bar;
        __builtin_amdgcn_s_waitcnt(0);
        unsigned nloc = b.st[0], nx = b.st[1];
        if (nloc == 0u) { xcd_barrier_complete(bar, b.x, nloc, nx); b.st[0] = nloc; b.st[1] = nx; }
        const unsigned old = xb_add(&bar[XB_XSUB(b.x)], 1u);
        const unsigned gen = old / nloc;
        if (old + 1u == (gen + 1u) * nloc) {
            __builtin_amdgcn_fence(__ATOMIC_RELEASE, "agent");
            asm volatile("s_waitcnt vmcnt(0)" ::: "memory");
            const unsigned og = xb_add(&bar[XB_TOP], 1u);
            const unsigned tg = og / nx;
            if (og + 1u == (tg + 1u) * nx) xb_add(&bar[XB_TOPGEN], 1u);
            else XB_SPIN(xb_ld(&bar[XB_TOPGEN]) == tg, bar);
            __builtin_amdgcn_fence(__ATOMIC_ACQUIRE, "agent");
            xb_add(&bar[XB_XGEN(b.x)], 1u);
            asm volatile("s_waitcnt vmcnt(0)" ::: "memory");
        } else {
            XB_SPIN(xb_ld(&bar[XB_XGEN(b.x)]) == gen, bar);
            __builtin_amdgcn_fence(__ATOMIC_ACQUIRE, "agent");
            asm volatile("s_waitcnt vmcnt(0)" ::: "memory");
        }
    }
    __syncthreads();
}

DEV void run_phase(const Params& p, int op, int arg, LAS unsigned char* lds) {
    const int layer = arg; const int jj = layer / 3;
    const float* hin = layer == 0 ? p.x : p.H;
    float* hout = layer == DEPTH - 1 ? p.out : p.H;
#ifdef ONLY_OP
    if (op != ONLY_OP) return;
#endif
    switch (op) {
    case OP_CONVERT: phase_convert(p, lds); break;
    case OP_RW_MIX: phase_rw_mix(p, jj, hin); break;
    case OP_RW_GEMM1: { SchedRW1 S{&p, jj}; EpiRW1 E{&p}; pg8::gemm_phase(lds, 1024, S, E); } break;
    case OP_RW_GEMM2: { SchedRW2 S{&p, jj}; EpiRW2 E{&p, jj}; pg8::gemm_phase(lds, 256, S, E); } break;
    case OP_RW_PREP: phase_rw_prep(p, jj); break;
    case OP_RW_SCAN: phase_rw_scan(p, lds); break;
    case OP_RW_POST: phase_rw_post(p, jj); break;
    case OP_RW_OUT: { SchedOut S{p.YB, p.rw_wo_t + (size_t)jj * D * D, 1024}; EpiOut E{p.MIX}; pg8::gemm_phase(lds, 1024, S, E); } break;
    case OP_LN1: phase_ln1(p, layer, hin, lds); break;
    case OP_MOE_SCATTER: phase_moe_scatter(p, lds); break;
    case OP_MOE_GEMM1: { SchedMoe<0> S{&p, layer}; EpiMoe1 E{p.ACT}; pg8::gemm_phase(lds, 1024, S, E); } break;
    case OP_MOE_GEMM2: { SchedMoe<1> S{&p, layer}; EpiMoe2 E{p.YBUF}; pg8::gemm_phase(lds, 512, S, E); } break;
    case OP_LN2: phase_ln2(p, layer, hout); break;
    case OP_MB_CAST: phase_mb_cast(p, jj, hin, lds); break;
    case OP_MB_GEMM_IN: { SchedMbIn S{&p}; EpiMbIn E{&p}; pg8::gemm_phase(lds, 1024, S, E); } break;
    case OP_MB_CONV: phase_mb_conv(p, jj); break;
    case OP_MB_STATES: phase_mb_states(p, jj, lds); break;
    case OP_MB_SCAN: phase_mb_scan(p); break;
    case OP_MB_OUT: phase_mb_out(p, jj, lds); break;
    case OP_MB_GEMM_OUT: { SchedOut S{p.YB, p.mb_wout_t + (size_t)jj * D * 2048, 2048}; EpiOut E{p.MIX}; pg8::gemm_phase(lds, 2048, S, E); } break;
    case OP_GL_CAST: phase_gl_cast(p, jj, hin, lds); break;
    case OP_GL_GEMM_IN: { SchedGlIn S{&p}; EpiGlIn E{&p}; pg8::gemm_phase(lds, 1024, S, E); } break;
    case OP_GL_KV: phase_gl_kv(p, lds); break;
    case OP_GL_SCAN: phase_gl_scan(p); break;
    case OP_GL_OUT: phase_gl_out(p, jj, lds); break;
    case OP_GL_GEMM_OUT: { SchedOut S{p.YB, p.gl_wout_t + (size_t)jj * D * D, 1024}; EpiOut E{p.MIX}; pg8::gemm_phase(lds, 1024, S, E); } break;
    default: break;
    }
}

constexpr int NPHASES = 1 + 12 + 12 + 11 + 12;
DEV void decode_phase(int ph, int& op, int& layer) {
    if (ph == 0) { op = OP_CONVERT; layer = 0; return; }
    int q = ph - 1; layer = 0;
    if (q >= 12) { q -= 12; layer = 1; if (q >= 12) { q -= 12; layer = 2; if (q >= 11) { q -= 11; layer = 3; } } }
    const int kind = layer % 3; const int nmix = kind == 2 ? 6 : 7;
    if (q < nmix) op = (kind == 0 ? OP_RW_MIX : kind == 1 ? OP_MB_CAST : OP_GL_CAST) + q;
    else op = OP_LN1 + (q - nmix);
}

#define X(t, n) t n##_,
template <bool COOP>
__global__ void __launch_bounds__(NTHR, 2) mega(PARAM_LIST(X) const int ph0, const int ph1) {
#undef X
    Params p;
#define X(t, n) p.n = n##_;
    PARAM_LIST(X)
#undef X
    extern __shared__ __attribute__((aligned(16))) unsigned char smem_raw[];
    LAS unsigned char* lds = (LAS unsigned char*)smem_raw;
    if constexpr (COOP) {
        volatile LAS unsigned* st = (volatile LAS unsigned*)(lds + LDS_BYTES - 16);
        if (threadIdx.x == 0) { st[0] = 0u; st[1] = 0u; }
        __syncthreads();
        XcdBarrier xb = xcd_barrier_post(p.bar, st);
        if (ph0 < 0) cg::this_grid().sync();
        for (int ph = ph0; ph < ph1; ++ph) {
            int op, arg; decode_phase(ph, op, arg);
            run_phase(p, op, arg, lds);
            if (ph + 1 < ph1) xcd_barrier(xb);
        }
    } else {
        for (int ph = ph0; ph < ph1; ++ph) { int op, arg; decode_phase(ph, op, arg); run_phase(p, op, arg, lds); }
    }
}

struct Bump { size_t off = 0; template <class Tp> Tp* take(char* base, size_t n) { Tp* r = (Tp*)(base + off); off += (n * sizeof(Tp) + 255) & ~(size_t)255; return r; } };

extern "C" void kernel_launch(void* const* d_in, const int* in_sizes, int n_in, void* d_out, int out_size, void* d_ws, size_t ws_size, hipStream_t stream) {
    (void)in_sizes; (void)n_in; (void)out_size;
    Params p; std::memset((void*)&p, 0, sizeof(p));
    auto F = [&](int i) { return (const float*)d_in[i]; };
    p.x = F(0); p.ln_g = F(1); p.ln_b = F(2);
    p.rw_mu = F(3); p.rw_w_rkv = F(4); p.rw_w0 = F(5); p.rw_w1 = F(6); p.rw_w2 = F(7); p.rw_a0 = F(8);
    p.rw_a1 = F(9); p.rw_a2 = F(10); p.rw_g1 = F(11); p.rw_g2 = F(12);
    p.rw_k_k = F(13); p.rw_k_a = F(14); p.rw_r_k = F(15); p.rw_lnx_g = F(16); p.rw_lnx_b = F(17); p.rw_w_o = F(18);
    p.mb_w_in = F(19); p.mb_conv_w = F(20); p.mb_conv_b = F(21); p.mb_dt_bias = F(22); p.mb_a_log = F(23); p.mb_d = F(24); p.mb_norm_g = F(25); p.mb_w_out = F(26);
    p.gl_w_in = F(27); p.gl_gk_w2 = F(28); p.gl_gk_b = F(29); p.gl_norm_g = F(30); p.gl_w_out = F(31);
    p.moe_w_group = F(32); p.moe_b_group = F(33); p.moe_w_route = F(34); p.moe_b_route = F(35); p.moe_w_in = F(36); p.moe_w_down = F(37);
    p.out = (float*)d_out;
    char* ws = (char*)d_ws; Bump B;
    p.bar = B.take<unsigned>(ws, XCD_BAR_WORDS);
    const size_t TD = (size_t)T * D;
    p.rw_rkv_t = B.take<bf16_t>(ws, 2 * 3 * (size_t)D * D); p.rw_w1_t = B.take<bf16_t>(ws, 2 * 256 * (size_t)D); p.rw_a1_t = B.take<bf16_t>(ws, 2 * 256 * (size_t)D); p.rw_g1_t = B.take<bf16_t>(ws, 2 * 256 * (size_t)D);
    p.rw_w2_t = B.take<bf16_t>(ws, 2 * (size_t)D * 256); p.rw_a2_t = B.take<bf16_t>(ws, 2 * (size_t)D * 256); p.rw_g2_t = B.take<bf16_t>(ws, 2 * (size_t)D * 256); p.rw_wo_t = B.take<bf16_t>(ws, 2 * (size_t)D * D);
    p.mb_win_t = B.take<bf16_t>(ws, 5120 * (size_t)D); p.mb_wout_t = B.take<bf16_t>(ws, (size_t)D * 2048); p.gl_win_t = B.take<bf16_t>(ws, 3072 * (size_t)D); p.gl_wout_t = B.take<bf16_t>(ws, (size_t)D * D);
    p.moe_w1_t = B.take<bf16_t>(ws, 128 * (size_t)1024 * 1024); p.moe_w2_t = B.take<bf16_t>(ws, 128 * (size_t)1024 * 512);
    p.H = B.take<float>(ws, TD); p.H1 = B.take<float>(ws, TD); p.MIX = B.take<float>(ws, TD);
    p.BUF = B.take<bf16_t>(ws, (size_t)MOE_ROWS * D); p.ACT = B.take<bf16_t>(ws, (size_t)MOE_ROWS * 512); p.YBUF = B.take<bf16_t>(ws, (size_t)MOE_ROWS * D);
    p.CNT = B.take<int>(ws, 256 * 32); p.EIDX = B.take<int>(ws, 2 * T); p.GATE = B.take<float>(ws, 2 * T); p.DEST = B.take<int>(ws, 2 * T); p.TAB = B.take<int>(ws, 256);
    p.YB = B.take<bf16_t>(ws, (size_t)T * 2048);
    const size_t arena0 = B.off;
    p.X6 = B.take<bf16_t>(ws, 6 * TD);
    p.P2 = (float*)p.X6; p.P3 = p.P2 + TD; p.P4 = p.P3 + TD;
    p.Rr = B.take<float>(ws, TD); p.Kk = B.take<float>(ws, TD); p.Vv = B.take<float>(ws, TD);
    p.Y = p.Rr;
    p.LW = B.take<bf16_t>(ws, 3 * (size_t)T * 256);
    p.Wd = B.take<float>(ws, TD); p.P5 = B.take<float>(ws, TD); p.Aa = B.take<float>(ws, TD); p.Gg = B.take<float>(ws, TD);
    p.C1 = B.take<float>(ws, (size_t)T * 16); p.C2 = B.take<float>(ws, (size_t)T * 16); p.BC = B.take<float>(ws, (size_t)T * 16);
    { Bump A2; A2.off = arena0 + ((TD * 2 + 255) & ~(size_t)255);
      p.Z = A2.take<bf16_t>(ws, (size_t)T * 2048); p.XBC = A2.take<bf16_t>(ws, (size_t)T * 3072); p.XC = A2.take<bf16_t>(ws, (size_t)T * 3072);
      p.DT = A2.take<float>(ws, (size_t)T * 32); p.STATES = A2.take<float>(ws, (size_t)128 * 32 * 64 * 128); p.CD = A2.take<float>(ws, 128 * 32);
      p.PREV = A2.take<bf16_t>(ws, (size_t)128 * 32 * 64 * 128);
      p.LA = A2.take<float>(ws, (size_t)T * 512); p.CDG = A2.take<float>(ws, 256 * 4 * 128);
      p.QKVG = p.XBC;
      if (A2.off > B.off) B.off = A2.off; }
    if (B.off > ws_size) { fprintf(stderr, "workspace too small: need %zu have %zu\n", B.off, ws_size); return; }
    const int np = NPHASES;
#define X(t, n) (void*)&p.n,
#if SINGLE_LAUNCH
    (void)hipFuncSetAttribute((const void*)mega<true>, hipFuncAttributeMaxDynamicSharedMemorySize, LDS_BYTES);
    (void)hipMemsetAsync(p.bar, 0, XCD_BAR_WORDS * sizeof(unsigned), stream);
    int ph0 = 0, ph1 = np; void* args[] = {PARAM_LIST(X) (void*)&ph0, (void*)&ph1};
    hipError_t e = hipLaunchCooperativeKernel((const void*)mega<true>, dim3(NBLK), dim3(NTHR), args, LDS_BYTES, stream);
    if (e != hipSuccess) fprintf(stderr, "cooperative launch failed: %s\n", hipGetErrorString(e));
#else
    (void)hipFuncSetAttribute((const void*)mega<false>, hipFuncAttributeMaxDynamicSharedMemorySize, LDS_BYTES);
    for (int ph = 0; ph < np; ++ph) { int ph0 = ph, ph1 = ph + 1; void* args[] = {PARAM_LIST(X) (void*)&ph0, (void*)&ph1};
        hipError_t e = hipLaunchKernel((const void*)mega<false>, dim3(NBLK), dim3(NTHR), args, LDS_BYTES, stream);
        if (e != hipSuccess) fprintf(stderr, "launch failed: %s\n", hipGetErrorString(e)); }
#endif
#undef X
}
```

```cpp
#include <hip/hip_runtime.h>
#include <hip/hip_cooperative_groups.h>
#include <cstdint>
#include <cstdio>
#include <cstring>
namespace cg = cooperative_groups;

typedef unsigned short bf16_t;
typedef short bf16x8 __attribute__((ext_vector_type(8)));
typedef short s16x4 __attribute__((ext_vector_type(4)));
typedef float f32x4 __attribute__((ext_vector_type(4)));
typedef float f32x2 __attribute__((ext_vector_type(2)));
typedef unsigned u32x4 __attribute__((ext_vector_type(4)));
typedef unsigned u32x2 __attribute__((ext_vector_type(2)));
#define LAS __attribute__((address_space(3)))
#define DEV __device__ __forceinline__

constexpr int T = 16384, D = 1024, DEPTH = 4;
constexpr int NTHR = 512, NBLK = 256;
constexpr int LDS_BYTES = 155648;
constexpr float ALPHA = 1.681792830507429f;
constexpr float LN_EPS = 1e-5f;
constexpr int MOE_ROWS = 40960;

DEV int tid_() { int t = threadIdx.x; asm volatile("" : "+v"(t)); return t; }
DEV int bid_() { int b = blockIdx.x; asm volatile("" : "+s"(b)); return b; }
#define NB_ 256
DEV unsigned f2bf(float f) { unsigned u = __float_as_uint(f); u += 0x7FFFu + ((u >> 16) & 1u); return u >> 16; }
DEV float bf2f(unsigned short b) { return __uint_as_float(((unsigned)b) << 16); }
DEV unsigned pk2(float lo, float hi) { unsigned r; asm("v_cvt_pk_bf16_f32 %0, %1, %2" : "=v"(r) : "v"(lo), "v"(hi)); return r; }
DEV float bflo(unsigned u) { return __uint_as_float(u << 16); }
DEV float bfhi(unsigned u) { return __uint_as_float(u & 0xFFFF0000u); }
DEV float sigmoidf_(float x) { return 1.0f / (1.0f + __expf(-x)); }
DEV float siluf_(float x) { return x / (1.0f + __expf(-x)); }
DEV float softplusf_(float x) { return fmaxf(x, 0.f) + __logf(1.0f + __expf(-fabsf(x))); }
DEV float tanhf_(float x) { const float e = __expf(-2.0f * fabsf(x)); const float r = (1.0f - e) / (1.0f + e); return x < 0.f ? -r : r; }
DEV float wave_sum(float v) {
#pragma unroll
    for (int o = 32; o > 0; o >>= 1) v += __shfl_xor(v, o);
    return v;
}
DEV float sum16(float v) {
#pragma unroll
    for (int o = 8; o > 0; o >>= 1) v += __shfl_xor(v, o);
    return v;
}
template <int N> DEV float reduce_scatter(float (&v)[N], int lane) {
    int s = 1;
#pragma unroll
    for (int h = N / 2; h >= 1; h >>= 1) {
#pragma unroll
        for (int i = 0; i < h; ++i) {
            const bool up = (lane & s) != 0;
            const float send = up ? v[i] : v[i + h];
            const float keep = up ? v[i + h] : v[i];
            v[i] = keep + __shfl_xor(send, s);
        }
        s <<= 1;
    }
    float r = v[0];
    for (; s < 64; s <<= 1) r += __shfl_xor(r, s);
    return r;
}
template <int N> DEV int rs_index(int lane) {
    int o = 0, s = 1;
#pragma unroll
    for (int h = N / 2; h >= 1; h >>= 1) { if (lane & s) o += h; s <<= 1; }
    return o;
}

DEV bf16x8 frag_rm(const LAS bf16_t* base, int ld, int row0, int k0, int lane) {
    return *(const LAS bf16x8*)(base + (row0 + (lane & 15)) * ld + k0 + 8 * (lane >> 4));
}
DEV bf16x8 frag_tr(const LAS bf16_t* base, int ld, int k0, int c0, int lane) {
    const int g = lane >> 4, i = lane & 15, q = i >> 2, p = i & 3;
    const LAS bf16_t* a = base + (k0 + 8 * g + q) * ld + c0 + 4 * p;
    s16x4 lo = __builtin_amdgcn_ds_read_tr16_b64_v4i16((LAS s16x4*)a);
    s16x4 hi = __builtin_amdgcn_ds_read_tr16_b64_v4i16((LAS s16x4*)(a + 4 * ld));
    bf16x8 r; r[0] = lo[0]; r[1] = lo[1]; r[2] = lo[2]; r[3] = lo[3]; r[4] = hi[0]; r[5] = hi[1]; r[6] = hi[2]; r[7] = hi[3];
    return r;
}
#define MFMA16(a, b, c) __builtin_amdgcn_mfma_f32_16x16x32_bf16((a), (b), (c), 0, 0, 0)
DEV size_t fragmajor_off(int n, int k, int K) { return ((size_t)((n >> 4) * (K >> 5) + (k >> 5)) * 64 + (n & 15) + 16 * ((k & 31) >> 3)) * 8 + (k & 7); }

template <int N> DEV void skinny_group(const f32x4 (&z)[4], const LAS float* wt, int lane, LAS float* outw) {
    float pe[N];
#pragma unroll
    for (int o = 0; o < N; ++o) {
        float a = 0.f;
#pragma unroll
        for (int q = 0; q < 4; ++q) { const f32x4 w = *(const LAS f32x4*)(wt + o * 1028 + 256 * q + 4 * lane); a += z[q][0] * w[0] + z[q][1] * w[1] + z[q][2] * w[2] + z[q][3] * w[3]; }
        pe[o] = a;
    }
    const float r = reduce_scatter<N>(pe, lane);
    if (lane < N) outw[rs_index<N>(lane)] = r;
}
#ifndef SINGLE_LAUNCH
#define SINGLE_LAUNCH 1
#endif
struct ConvJob {
    const float* src; bf16_t* dst;
    int K, N, src_ld, Kpad, Npad, perm, batch;
    long long src_bs, dst_bs;
    DEV int ntiles() const { return (Kpad / 64) * (Npad / 64) * batch; }
};
constexpr int NJOBS = 14;

#define PARAM_LIST(X) \
    X(const float*, x) X(const float*, ln_g) X(const float*, ln_b) \
    X(const float*, rw_mu) X(const float*, rw_w_rkv) X(const float*, rw_w0) X(const float*, rw_w1) X(const float*, rw_w2) X(const float*, rw_a0) X(const float*, rw_a1) X(const float*, rw_a2) \
    X(const float*, rw_g1) X(const float*, rw_g2) X(const float*, rw_k_k) X(const float*, rw_k_a) X(const float*, rw_r_k) X(const float*, rw_lnx_g) X(const float*, rw_lnx_b) X(const float*, rw_w_o) \
    X(const float*, mb_w_in) X(const float*, mb_conv_w) X(const float*, mb_conv_b) X(const float*, mb_dt_bias) X(const float*, mb_a_log) X(const float*, mb_d) X(const float*, mb_norm_g) X(const float*, mb_w_out) \
    X(const float*, gl_w_in) X(const float*, gl_gk_w2) X(const float*, gl_gk_b) X(const float*, gl_norm_g) X(const float*, gl_w_out) \
    X(const float*, moe_w_group) X(const float*, moe_b_group) X(const float*, moe_w_route) X(const float*, moe_b_route) X(const float*, moe_w_in) X(const float*, moe_w_down) \
    X(float*, out) \
    X(bf16_t*, rw_rkv_t) X(bf16_t*, rw_w1_t) X(bf16_t*, rw_a1_t) X(bf16_t*, rw_g1_t) X(bf16_t*, rw_w2_t) X(bf16_t*, rw_a2_t) X(bf16_t*, rw_g2_t) X(bf16_t*, rw_wo_t) \
    X(bf16_t*, mb_win_t) X(bf16_t*, mb_wout_t) X(bf16_t*, gl_win_t) X(bf16_t*, gl_wout_t) X(bf16_t*, moe_w1_t) X(bf16_t*, moe_w2_t) \
    X(float*, H) X(float*, H1) X(float*, MIX) X(bf16_t*, X6) X(float*, Rr) X(float*, Kk) X(float*, Vv) X(bf16_t*, LW) X(float*, Wd) X(float*, Aa) X(float*, Gg) \
    X(float*, P2) X(float*, P3) X(float*, P4) X(float*, P5) X(float*, C1) X(float*, C2) X(float*, BC) X(float*, Y) X(bf16_t*, YB) \
    X(bf16_t*, Z) X(bf16_t*, XBC) X(bf16_t*, XC) X(float*, DT) X(float*, STATES) X(float*, CD) X(bf16_t*, PREV) X(bf16_t*, QKVG) X(float*, LA) X(float*, CDG) \
    X(bf16_t*, BUF) X(bf16_t*, ACT) X(bf16_t*, YBUF) X(int*, CNT) X(int*, EIDX) X(float*, GATE) X(int*, DEST) X(int*, TAB) X(unsigned*, bar)
struct Params {
#define X(t, n) t n;
    PARAM_LIST(X)
#undef X
};

enum Op : unsigned char { OP_CONVERT = 0, OP_RW_MIX, OP_RW_GEMM1, OP_RW_GEMM2, OP_RW_PREP, OP_RW_SCAN, OP_RW_POST, OP_RW_OUT,
    OP_LN1, OP_MOE_SCATTER, OP_MOE_GEMM1, OP_MOE_GEMM2, OP_LN2,
    OP_MB_CAST, OP_MB_GEMM_IN, OP_MB_CONV, OP_MB_STATES, OP_MB_SCAN, OP_MB_OUT, OP_MB_GEMM_OUT,
    OP_GL_CAST, OP_GL_GEMM_IN, OP_GL_KV, OP_GL_SCAN, OP_GL_OUT, OP_GL_GEMM_OUT };


DEV ConvJob make_job(const Params& p, int q) {
    const long long DD = (long long)D * D;
    switch (q) {
    case 0: return ConvJob{p.rw_w_rkv, p.rw_rkv_t, 1024, 1024, 1024, 1024, 1024, 0, 6, DD, DD};
    case 1: return ConvJob{p.rw_w1, p.rw_w1_t, 1024, 64, 64, 1024, 256, 0, 2, (long long)D * 64, (long long)256 * D};
    case 2: return ConvJob{p.rw_a1, p.rw_a1_t, 1024, 64, 64, 1024, 256, 0, 2, (long long)D * 64, (long long)256 * D};
    case 3: return ConvJob{p.rw_g1, p.rw_g1_t, 1024, 160, 160, 1024, 256, 0, 2, (long long)D * 160, (long long)256 * D};
    case 4: return ConvJob{p.rw_w2, p.rw_w2_t, 64, 1024, 1024, 256, 1024, 0, 2, (long long)64 * D, (long long)D * 256};
    case 5: return ConvJob{p.rw_a2, p.rw_a2_t, 64, 1024, 1024, 256, 1024, 0, 2, (long long)64 * D, (long long)D * 256};
    case 6: return ConvJob{p.rw_g2, p.rw_g2_t, 160, 1024, 1024, 256, 1024, 0, 2, (long long)160 * D, (long long)D * 256};
    case 7: return ConvJob{p.rw_w_o, p.rw_wo_t, 1024, 1024, 1024, 1024, 1024, 0, 2, DD, DD};
    case 8: return ConvJob{p.mb_w_in, p.mb_win_t, 1024, 5120, 5152, 1024, 5120, 0, 1, 0, 0};
    case 9: return ConvJob{p.mb_w_out, p.mb_wout_t, 2048, 1024, 1024, 2048, 1024, 0, 1, 0, 0};
    case 10: return ConvJob{p.gl_w_in, p.gl_win_t, 1024, 3072, 3088, 1024, 3072, 0, 1, 0, 0};
    case 11: return ConvJob{p.gl_w_out, p.gl_wout_t, 1024, 1024, 1024, 1024, 1024, 0, 1, 0, 0};
    case 12: return ConvJob{p.moe_w_in, p.moe_w1_t, 1024, 1024, 1024, 1024, 1024, 1, 128, DD, DD};
    default: return ConvJob{p.moe_w_down, p.moe_w2_t, 512, 1024, 1024, 512, 1024, 0, 128, (long long)512 * 1024, (long long)1024 * 512};
    }
}

DEV void phase_convert(const Params& p, LAS unsigned char* lds) {
    const int tid = tid_(), bid = bid_(); (void)tid; (void)bid;
    LAS bf16_t* tile = (LAS bf16_t*)lds;
    int tbeg = 0;
#pragma unroll
    for (int j = 0; j < NJOBS; ++j) {
      const ConvJob J = make_job(p, j);
      const int jend = tbeg + J.ntiles();
      const int ti0 = tbeg + (((int)bid - tbeg) % NB_ + NB_) % NB_;
      const int jbeg = tbeg; tbeg = jend;
#pragma unroll 1
      for (int ti = ti0; ti < jend; ti += NB_) {
        int local = ti - jbeg;
        const int tk = J.Kpad / 64, tn = J.Npad / 64;
        const int b = local / (tk * tn); local -= b * tk * tn;
        const int nt = local / tk, kt = local - nt * tk;
        const float* src = J.src + (size_t)b * J.src_bs;
        bf16_t* dst = J.dst + (size_t)b * J.dst_bs;
        const int k0 = kt * 64, n0 = nt * 64;
#pragma unroll
        for (int pass = 0; pass < 2; ++pass) {
            const int kk = (tid >> 4) + pass * 32, nn = (tid & 15) * 4;
            f32x4 v = {0.f, 0.f, 0.f, 0.f};
            if (k0 + kk < J.K && n0 + nn < J.N) v = *(const f32x4*)(src + (size_t)(k0 + kk) * J.src_ld + n0 + nn);
#pragma unroll
            for (int e = 0; e < 4; ++e) tile[(nn + e) * 72 + kk] = (bf16_t)f2bf(v[e]);
        }
        __syncthreads();
        {
            const int nn = tid >> 3, kc = (tid & 7) * 8;
            int nsrc = n0 + nn, ndst = nsrc;
            if (J.perm == 1) { const int up = nsrc >= 512, jj = nsrc - (up ? 512 : 0); ndst = (jj >> 7) * 256 + (up ? 128 : 0) + (jj & 127); }
            const u32x4 v = *(const LAS u32x4*)(tile + nn * 72 + kc);
            *(u32x4*)(dst + (size_t)ndst * J.Kpad + k0 + kc) = v;
        }
        __syncthreads();
      }
    }
}
namespace pg8 {
constexpr int BM = 256, BK = 64, HALF = 128, HTB = HALF * BK * 2, STAGE_BYTES = 8 * HTB;
DEV int lds_byte(int r, int c) { const int st = (r >> 4) * 2 + (c >> 5), rr = r & 15, cc = c & 31, ob = rr * 64 + cc * 2; return st * 1024 + (ob ^ (((ob >> 9) & 1) << 5)); }
DEV void stage_rc(int b, int& R, int& C) { const int st = b / 1024, sb = b % 1024, swz = sb ^ (((sb >> 9) & 1) << 5); R = (st >> 1) * 16 + swz / 64; C = (st & 1) * 32 + (swz % 64) / 2; }

struct Unit { const char* A; const char* B; int row0, col0, id, aux; };

DEV bool tile_order(int i, int G, int c, int nM, int nN, int& pm, int& pn) {
    const int nwg = nM * nN; const long L = (long)i * G + c; if (L >= nwg) return false;
    int wgid = (int)L; { const int q = nwg / 8, r = nwg % 8, xcd = wgid % 8, off = wgid / 8; wgid = (xcd < r ? xcd * (q + 1) : r * (q + 1) + (xcd - r) * q) + off; }
    const int nig = 8 * nN, gid = wgid / nig, fm = gid * 8, gsz = (nM - fm) < 8 ? (nM - fm) : 8;
    pm = fm + ((wgid % nig) % gsz); pn = (wgid % nig) / gsz; return true;
}

template <class Epi, class Sched>
DEV void gemm_phase(LAS unsigned char* lds, const int K, const Sched& S, const Epi& E) {
    const int tid = tid_(), wid = __builtin_amdgcn_readfirstlane(tid >> 6), lane = tid & 63, wr = wid >> 2, wc = wid & 3, fr = lane & 15, fq = lane >> 4;
    const int nt = K / BK;
    unsigned voff[2];
#pragma unroll
    for (int i = 0; i < 2; ++i) { int R, C; stage_rc(tid * 16 + i * 8192, R, C); voff[i] = (unsigned)(R * K + C) * 2u; }
    const size_t kstep = (size_t)(BK * 2);
    const size_t hstep = (size_t)HALF * K * 2;
    const unsigned ldsw = (unsigned)wid * 1024u;
    const int aoff = lds_byte(wr * 64 + fr, fq * 8), boff = lds_byte(wc * 32 + fr, fq * 8);
#define PG8_SA(b, h) (((b) * 2 + (h)) * HTB)
#define PG8_SB(b, h) ((4 + (b) * 2 + (h)) * HTB)
#define PG8_STAGE(bufoff, gbase) do { _Pragma("unroll") for (int _i = 0; _i < 2; ++_i) \
        __builtin_amdgcn_global_load_lds((const unsigned*)((const char*)(gbase) + voff[_i]), (LAS unsigned*)(lds + (bufoff) + ldsw + _i * 8192), 16, 0, 0); } while (0)
#define PG8_LDA(dst, b, h) do { _Pragma("unroll") for (int m = 0; m < 4; ++m) _Pragma("unroll") for (int k = 0; k < 2; ++k) dst[m][k] = *(const LAS bf16x8*)(lds + PG8_SA(b, h) + aoff + m * 2048 + k * 1024); } while (0)
#define PG8_LDB(dst, b, h) do { _Pragma("unroll") for (int n = 0; n < 2; ++n) _Pragma("unroll") for (int k = 0; k < 2; ++k) dst[n][k] = *(const LAS bf16x8*)(lds + PG8_SB(b, h) + boff + n * 2048 + k * 1024); } while (0)
#define PG8_MMA(ai, bj, At, Bt) do { __builtin_amdgcn_s_setprio(1); _Pragma("unroll") for (int m = 0; m < 4; ++m) _Pragma("unroll") for (int n = 0; n < 2; ++n) _Pragma("unroll") for (int k = 0; k < 2; ++k) \
        acc[ai][bj][m][n] = __builtin_amdgcn_mfma_f32_16x16x32_bf16(Bt[n][k], At[m][k], acc[ai][bj][m][n], 0, 0, 0); __builtin_amdgcn_s_setprio(0); } while (0)
#define PG8_WAIT_V(n) asm volatile("s_waitcnt vmcnt(" #n ")" ::: "memory")
#define PG8_WAIT_L(n) asm volatile("s_waitcnt lgkmcnt(" #n ")" ::: "memory")
#define PG8_BAR __builtin_amdgcn_s_barrier()
#define PG8_SCHED __builtin_amdgcn_sched_barrier(0)
    Unit cur, nxt; int ui = 0;
    if (!S.next(0, cur)) return;
    f32x4 acc[2][2][4][2];
#pragma unroll
    for (int a = 0; a < 2; ++a)
#pragma unroll
        for (int b = 0; b < 2; ++b)
#pragma unroll
            for (int m = 0; m < 4; ++m)
#pragma unroll
                for (int n = 0; n < 2; ++n) acc[a][b][m][n] = (f32x4){0.f, 0.f, 0.f, 0.f};
    bf16x8 At[4][2], B0[2][2], B1[2][2];
    const char* cA = cur.A; const char* cB = cur.B;
    PG8_STAGE(PG8_SB(0, 0), cB); PG8_STAGE(PG8_SA(0, 0), cA); PG8_STAGE(PG8_SB(0, 1), cB + hstep); PG8_STAGE(PG8_SA(0, 1), cA + hstep);
    if (wr == 1) PG8_BAR;
    PG8_WAIT_V(4); PG8_BAR;
    PG8_STAGE(PG8_SB(1, 0), cB + kstep); PG8_STAGE(PG8_SA(1, 0), cA + kstep); PG8_STAGE(PG8_SB(1, 1), cB + hstep + kstep);
    PG8_WAIT_V(6); PG8_BAR;
    for (;;) {
        const bool has_next = S.next(ui + 1, nxt);
        const char* nA = has_next ? nxt.A : cA; const char* nB = has_next ? nxt.B : cB;
#pragma unroll 1
        for (int t = 0; t < nt; t += 2) {
            const bool last = (t == nt - 2);
            const char* a1 = cA + (size_t)(t + 1) * kstep;
            const char* a2 = last ? nA : cA + (size_t)(t + 2) * kstep; const char* b2 = last ? nB : cB + (size_t)(t + 2) * kstep;
            const char* a3 = a2 + kstep; const char* b3 = b2 + kstep;
            PG8_LDB(B0, 0, 0); PG8_SCHED; PG8_LDA(At, 0, 0); PG8_STAGE(PG8_SA(1, 1), a1 + hstep);
            PG8_WAIT_L(8); PG8_BAR; PG8_WAIT_L(0); PG8_MMA(0, 0, At, B0); PG8_BAR; PG8_SCHED;
            PG8_LDB(B1, 0, 1); PG8_STAGE(PG8_SB(0, 0), b2);
            PG8_BAR; PG8_WAIT_L(0); PG8_MMA(0, 1, At, B1); PG8_BAR;
            PG8_LDA(At, 0, 1); PG8_STAGE(PG8_SA(0, 0), a2);
            PG8_BAR; PG8_WAIT_L(0); PG8_MMA(1, 0, At, B0); PG8_BAR; PG8_SCHED;
            PG8_STAGE(PG8_SB(0, 1), b2 + hstep);
            PG8_WAIT_V(6); PG8_BAR; PG8_MMA(1, 1, At, B1); PG8_BAR;
            PG8_LDB(B0, 1, 0); PG8_SCHED; PG8_LDA(At, 1, 0); PG8_STAGE(PG8_SA(0, 1), a2 + hstep);
            PG8_WAIT_L(8); PG8_BAR; PG8_WAIT_L(0); PG8_MMA(0, 0, At, B0); PG8_BAR; PG8_SCHED;
            PG8_LDB(B1, 1, 1); PG8_STAGE(PG8_SB(1, 0), b3);
            PG8_BAR; PG8_WAIT_L(0); PG8_MMA(0, 1, At, B1); PG8_BAR;
            PG8_LDA(At, 1, 1); PG8_STAGE(PG8_SA(1, 0), a3);
            PG8_BAR; PG8_WAIT_L(0); PG8_MMA(1, 0, At, B0); PG8_BAR; PG8_SCHED;
            PG8_STAGE(PG8_SB(1, 1), b3 + hstep);
            PG8_WAIT_V(6); PG8_BAR; PG8_MMA(1, 1, At, B1); PG8_BAR;
        }
        E(acc, cur, wr, wc, fr, fq);
        if (!has_next) break;
#pragma unroll
        for (int a = 0; a < 2; ++a)
#pragma unroll
            for (int b = 0; b < 2; ++b)
#pragma unroll
                for (int m = 0; m < 4; ++m)
#pragma unroll
                    for (int n = 0; n < 2; ++n) acc[a][b][m][n] = (f32x4){0.f, 0.f, 0.f, 0.f};
        cur = nxt; cA = nA; cB = nB; ++ui;
    }
    PG8_WAIT_V(0);
    if (wr == 0) PG8_BAR;
    PG8_BAR;
#undef PG8_SA
#undef PG8_SB
#undef PG8_STAGE
#undef PG8_LDA
#undef PG8_LDB
#undef PG8_MMA
#undef PG8_WAIT_V
#undef PG8_WAIT_L
#undef PG8_BAR
#undef PG8_SCHED
}
}
using pg8::Unit;
typedef f32x4 AccT[2][2][4][2];
#define FOR_ACC(ai, bj, m, n) _Pragma("unroll") for (int ai = 0; ai < 2; ++ai) _Pragma("unroll") for (int m = 0; m < 4; ++m) _Pragma("unroll") for (int bj = 0; bj < 2; ++bj) _Pragma("unroll") for (int n = 0; n < 2; ++n)
#define ACC_FENCE __builtin_amdgcn_sched_barrier(0)
#define ACC_ROW(u, ai, m) ((u).row0 + 128 * (ai) + 64 * wr + 16 * (m) + fr)
#define ACC_COL(u, bj, n) ((u).col0 + 128 * (bj) + 32 * wc + 16 * (n) + 4 * fq)
DEV void st_bf4(bf16_t* p, f32x4 v) { u32x2 w; w.x = pk2(v[0], v[1]); w.y = pk2(v[2], v[3]); *(u32x2*)p = w; }
DEV void load_row(const float* p, int lane, f32x4 (&v)[4]) {
#pragma unroll
    for (int q = 0; q < 4; ++q) v[q] = *(const f32x4*)(p + 256 * q + 4 * lane);
}

DEV void phase_rw_mix(const Params& p, int j, const float* hin) {
    const int tid = tid_(), bid = bid_(); (void)tid; (void)bid;
    const int lane = tid & 63, wid = tid >> 6;
    const float* mu = p.rw_mu + (size_t)j * 6 * D;
    for (int r = 0; r < 8; ++r) {
        const int t = bid * 64 + wid * 8 + r;
        f32x4 x[4], xp[4];
        load_row(hin + (size_t)t * D, lane, x);
        if (t > 0) load_row(hin + (size_t)(t - 1) * D, lane, xp);
        else { for (int q = 0; q < 4; ++q) xp[q] = (f32x4){0.f, 0.f, 0.f, 0.f}; }
#pragma unroll
        for (int s = 0; s < 6; ++s) {
#pragma unroll
            for (int q = 0; q < 4; ++q) {
                const f32x4 m = *(const f32x4*)(mu + s * D + 256 * q + 4 * lane);
                const f32x4 o = x[q] + (xp[q] - x[q]) * m;
                st_bf4(p.X6 + (size_t)s * T * D + (size_t)t * D + 256 * q + 4 * lane, o);
            }
        }
    }
}

struct SchedRW1 {
    const Params* p; int j;
    DEV bool next(int i, Unit& u) const {
        int pm, pn; if (!pg8::tile_order(i, NB_, bid_(), 64, 15, pm, pn)) return false;
        int id, lpn; if (pn < 12) { id = pn >> 2; lpn = pn & 3; } else { id = 3 + (pn - 12); lpn = 0; }
        u.A = (const char*)(p->X6 + (size_t)id * T * D + (size_t)pm * 256 * D);
        const bf16_t* B;
        if (id < 3) B = p->rw_rkv_t + ((size_t)j * 3 + id) * D * D + (size_t)lpn * 256 * D;
        else B = p->rw_w1_t + (size_t)(id - 3) * (2 * 256 * D) + (size_t)j * 256 * D;
        u.B = (const char*)B; u.row0 = pm * 256; u.col0 = lpn * 256; u.id = id; u.aux = 0; return true;
    }
};
struct EpiRW1 {
    const Params* p;
    DEV void operator()(const AccT& acc, const Unit& u, int wr, int wc, int fr, int fq) const {
        if (u.id < 3) {
            float* O = p->Rr + (size_t)u.id * T * D;
            FOR_ACC(ai, bj, m, n) *(f32x4*)(O + (size_t)ACC_ROW(u, ai, m) * D + ACC_COL(u, bj, n)) = acc[ai][bj][m][n];
        } else {
            bf16_t* O = p->LW + (size_t)(u.id - 3) * T * 256;
            FOR_ACC(ai, bj, m, n) {
                f32x4 v = acc[ai][bj][m][n];
                if (u.id == 3) { for (int e = 0; e < 4; ++e) v[e] = tanhf_(v[e]); }
                else if (u.id == 5) { for (int e = 0; e < 4; ++e) v[e] = sigmoidf_(v[e]); }
                st_bf4(O + (size_t)ACC_ROW(u, ai, m) * 256 + ACC_COL(u, bj, n), v); ACC_FENCE;
            }
        }
    }
};
struct SchedRW2 {
    const Params* p; int j;
    DEV bool next(int i, Unit& u) const {
        int pm, pn; if (!pg8::tile_order(i, NB_, bid_(), 64, 12, pm, pn)) return false;
        const int id = pn >> 2, lpn = pn & 3;
        u.A = (const char*)(p->LW + (size_t)id * T * 256 + (size_t)pm * 256 * 256);
        const bf16_t* B = p->rw_w2_t + (size_t)id * (2 * D * 256) + (size_t)j * D * 256 + (size_t)lpn * 256 * 256;
        u.B = (const char*)B; u.row0 = pm * 256; u.col0 = lpn * 256; u.id = id; u.aux = 0; return true;
    }
};
struct EpiRW2 {
    const Params* p; int j;
    DEV void operator()(const AccT& acc, const Unit& u, int wr, int wc, int fr, int fq) const {
        if (u.id == 0) { const float* bias = p->rw_w0 + (size_t)j * D;
            FOR_ACC(ai, bj, m, n) { f32x4 v = acc[ai][bj][m][n]; const int c = ACC_COL(u, bj, n); const f32x4 b = *(const f32x4*)(bias + c);
                for (int e = 0; e < 4; ++e) { const float x = -(b[e] + v[e]); const float wl = -(fmaxf(x, 0.f) + __logf(1.0f + __expf(-fabsf(x)))) - 0.5f; v[e] = __expf(-__expf(wl)); }
                *(f32x4*)(p->Wd + (size_t)ACC_ROW(u, ai, m) * D + c) = v; ACC_FENCE; } }
        else if (u.id == 1) { const float* bias = p->rw_a0 + (size_t)j * D;
            FOR_ACC(ai, bj, m, n) { f32x4 v = acc[ai][bj][m][n]; const int c = ACC_COL(u, bj, n); const f32x4 b = *(const f32x4*)(bias + c);
                for (int e = 0; e < 4; ++e) v[e] = sigmoidf_(b[e] + v[e]);
                *(f32x4*)(p->Aa + (size_t)ACC_ROW(u, ai, m) * D + c) = v; ACC_FENCE; } }
        else { FOR_ACC(ai, bj, m, n) *(f32x4*)(p->Gg + (size_t)ACC_ROW(u, ai, m) * D + ACC_COL(u, bj, n)) = acc[ai][bj][m][n]; }
    }
};

DEV void phase_rw_prep(const Params& p, int j) {
    const int tid = tid_(), bid = bid_(); (void)tid; (void)bid;
    const int lane = tid & 63, wid = tid >> 6;
    const float* k_k = p.rw_k_k + (size_t)j * D; const float* k_a = p.rw_k_a + (size_t)j * D; const float* r_k = p.rw_r_k + (size_t)j * D;
    for (int rr = 0; rr < 8; ++rr) {
        const int t = bid * 64 + wid * 8 + rr; const size_t ro = (size_t)t * D;
#pragma unroll
        for (int q = 0; q < 4; ++q) {
            const int c = 256 * q + 4 * lane; const int head = 4 * q + (lane >> 4);
            const f32x4 r = *(const f32x4*)(p.Rr + ro + c), k = *(const f32x4*)(p.Kk + ro + c), w = *(const f32x4*)(p.Wd + ro + c), a = *(const f32x4*)(p.Aa + ro + c);
            const f32x4 kkw = *(const f32x4*)(k_k + c), kaw = *(const f32x4*)(k_a + c), rkw = *(const f32x4*)(r_k + c);
            f32x4 kk = k * kkw;
            float ss = kk[0] * kk[0] + kk[1] * kk[1] + kk[2] * kk[2] + kk[3] * kk[3];
            ss = sum16(ss);
            const float inv = 1.0f / fmaxf(sqrtf(ss), 1e-12f);
            kk = kk * inv;
            const f32x4 b = kk * a;
            f32x4 kh; for (int e = 0; e < 4; ++e) kh[e] = k[e] * (1.0f + (a[e] - 1.0f) * kaw[e]);
            const f32x4 wrr = w * r;
            float c1 = b[0] * r[0] + b[1] * r[1] + b[2] * r[2] + b[3] * r[3];
            float c2 = kh[0] * r[0] + kh[1] * r[1] + kh[2] * r[2] + kh[3] * r[3];
            float bc = r[0] * kh[0] * rkw[0] + r[1] * kh[1] * rkw[1] + r[2] * kh[2] * rkw[2] + r[3] * kh[3] * rkw[3];
            c1 = sum16(c1); c2 = sum16(c2); bc = sum16(bc);
            *(f32x4*)(p.P2 + ro + c) = -kk; *(f32x4*)(p.P3 + ro + c) = b; *(f32x4*)(p.P4 + ro + c) = kh; *(f32x4*)(p.P5 + ro + c) = wrr;
            if ((lane & 15) == 0) { p.C1[(size_t)t * 16 + head] = c1; p.C2[(size_t)t * 16 + head] = c2; p.BC[(size_t)t * 16 + head] = bc; }
        }
    }
}

template <int CTRL> DEV float dppf(float v) { return __builtin_bit_cast(float, __builtin_amdgcn_update_dpp(0, __builtin_bit_cast(int, v), CTRL, 0xF, 0xF, false)); }
DEV float allsum16_dpp(float v) {
    v += dppf<0xB1>(v);
    v += dppf<0x4E>(v);
    v += dppf<0x141>(v);
    v += dppf<0x140>(v);
    return v;
}
constexpr int SC_TC = 32;
constexpr int SC_STEP_F = 5 * 64 + 16 + 2 + 2;
DEV void phase_rw_scan(const Params& p, LAS unsigned char* lds) {
    const int tid = tid_(), bid = bid_(); (void)tid; (void)bid;
    if (bid >= 64) return;
    const int lane = tid & 63, wid = tid >> 6;
    const int head = bid >> 2, rbase = (bid & 3) * 16;
    LAS float* buf = (LAS float*)lds;
    LAS float* ybuf = buf + 2 * SC_TC * SC_STEP_F;
    f32x4 stg[6];
#define SC_ISSUE(chunk) do { _Pragma("unroll") for (int i = 0; i < 6; ++i) { \
        const int it = tid + i * 512; stg[i] = (f32x4){0.f, 0.f, 0.f, 0.f}; \
        if (it < SC_TC * 85) { const int st = it / 85, w = it - st * 85; const int t = (chunk) * SC_TC + st; \
            if (w < 80) { const int a = w >> 4, q = w & 15; const float* sp_ = (a == 0 || a == 4) ? p.Wd + (size_t)(a >> 2) * T * D : p.P2 + (size_t)(a - 1) * T * D; stg[i] = *(const f32x4*)(sp_ + (size_t)t * D + head * 64 + q * 4); } \
            else if (w < 84) { stg[i] = *(const f32x4*)(p.Vv + (size_t)t * D + head * 64 + rbase + (w - 80) * 4); } \
            else { stg[i].x = p.C1[(size_t)t * 16 + head]; stg[i].y = p.C2[(size_t)t * 16 + head]; } } } } while (0)
#define SC_COMMIT(b) do { _Pragma("unroll") for (int i = 0; i < 6; ++i) { const int it = tid + i * 512; \
        if (it < SC_TC * 85) { const int st = it / 85, w = it - st * 85; *(LAS f32x4*)(buf + ((b) * SC_TC + st) * SC_STEP_F + w * 4) = stg[i]; } } } while (0)
    SC_ISSUE(0); SC_COMMIT(0); __syncthreads();
    const int row = lane >> 4, kq = lane & 15;
    f32x4 s = {0.f, 0.f, 0.f, 0.f};
    const int nchunk = T / SC_TC;
    for (int c = 0; c < nchunk; ++c) {
        const int b = c & 1;
        if (c + 1 < nchunk) SC_ISSUE(c + 1);
        if (wid < 4) {
#pragma unroll 2
            for (int st = 0; st < SC_TC; ++st) {
                const LAS float* sp = buf + (b * SC_TC + st) * SC_STEP_F;
                const f32x4 w = *(const LAS f32x4*)(sp + kq * 4), p2 = *(const LAS f32x4*)(sp + 64 + kq * 4), p3 = *(const LAS f32x4*)(sp + 128 + kq * 4),
                            p4 = *(const LAS f32x4*)(sp + 192 + kq * 4), p5 = *(const LAS f32x4*)(sp + 256 + kq * 4);
                const float vv = sp[320 + wid * 4 + row], c1 = sp[336], c2 = sp[337];
                float sa = s[0] * p2[0] + s[1] * p2[1] + s[2] * p2[2] + s[3] * p2[3];
                float yy = s[0] * p5[0] + s[1] * p5[1] + s[2] * p5[2] + s[3] * p5[3];
                sa = allsum16_dpp(sa); yy = allsum16_dpp(yy);
                yy += sa * c1 + vv * c2;
#pragma unroll
                for (int e = 0; e < 4; ++e) s[e] = s[e] * w[e] + sa * p3[e] + vv * p4[e];
                if (kq == 0) ybuf[(b * SC_TC + st) * 16 + wid * 4 + row] = yy;
            }
        }
        if (c + 1 < nchunk) SC_COMMIT(b ^ 1);
        __syncthreads();
        { const int st = tid >> 4, r = tid & 15; p.Y[(size_t)(c * SC_TC + st) * D + head * 64 + rbase + r] = ybuf[(b * SC_TC + st) * 16 + r]; }
    }
}

DEV void phase_rw_post(const Params& p, int j) {
    const int tid = tid_(), bid = bid_(); (void)tid; (void)bid;
    const int lane = tid & 63, wid = tid >> 6;
    const float* lg = p.rw_lnx_g + (size_t)j * D; const float* lb = p.rw_lnx_b + (size_t)j * D;
    for (int rr = 0; rr < 8; ++rr) {
        const int t = bid * 64 + wid * 8 + rr; const size_t ro = (size_t)t * D;
#pragma unroll
        for (int q = 0; q < 4; ++q) {
            const int c = 256 * q + 4 * lane; const int head = 4 * q + (lane >> 4);
            const f32x4 y = *(const f32x4*)(p.Y + ro + c), v = *(const f32x4*)(p.Vv + ro + c), g = *(const f32x4*)(p.Gg + ro + c);
            const float mean = sum16(y[0] + y[1] + y[2] + y[3]) * (1.0f / 64.0f);
            const f32x4 d = y - mean;
            const float var = sum16(d[0] * d[0] + d[1] * d[1] + d[2] * d[2] + d[3] * d[3]) * (1.0f / 64.0f);
            const float rs = rsqrtf(var + 64e-5f);
            const float bc = p.BC[(size_t)t * 16 + head];
            const f32x4 gw = *(const f32x4*)(lg + c), bw = *(const f32x4*)(lb + c);
            f32x4 o; for (int e = 0; e < 4; ++e) o[e] = (d[e] * rs * gw[e] + bw[e] + bc * v[e]) * g[e];
            st_bf4(p.YB + ro + c, o);
        }
    }
}
struct SchedOut {
    const bf16_t* A; const bf16_t* Bt; int K;
    DEV bool next(int i, Unit& u) const {
        int pm, pn; if (!pg8::tile_order(i, NB_, bid_(), 64, 4, pm, pn)) return false;
        u.A = (const char*)(A + (size_t)pm * 256 * K); u.B = (const char*)(Bt + (size_t)pn * 256 * K); u.row0 = pm * 256; u.col0 = pn * 256; u.id = 0; u.aux = 0; return true;
    }
};
struct EpiOut {
    float* O;
    DEV void operator()(const AccT& acc, const Unit& u, int wr, int wc, int fr, int fq) const {
        FOR_ACC(ai, bj, m, n) *(f32x4*)(O + (size_t)ACC_ROW(u, ai, m) * D + ACC_COL(u, bj, n)) = acc[ai][bj][m][n];
    }
};
DEV void phase_ln1(const Params& p, int layer, const float* hin, LAS unsigned char* lds) {
    const int tid = tid_(), bid = bid_(); (void)tid; (void)bid;
    const int lane = tid & 63, wid = tid >> 6;
    LAS float* wt = (LAS float*)lds;
    LAS float* lg = wt + 36 * 1028;
    LAS int* cnt = (LAS int*)(lg + 8 * 64);
    const float* wr_ = p.moe_w_route + (size_t)layer * D * 32; const float* wg_ = p.moe_w_group + (size_t)layer * D * 4;
    for (int i = tid; i < D * 32; i += NTHR) { const int k = i >> 5, o = i & 31; wt[o * 1028 + k] = wr_[i]; }
    for (int i = tid; i < D * 4; i += NTHR) { const int k = i >> 2, o = i & 3; wt[(32 + o) * 1028 + k] = wg_[i]; }
    if (tid < 32) cnt[tid] = 0;
    __syncthreads();
    const float* g = p.ln_g + ((size_t)layer * 2 + 0) * D; const float* be = p.ln_b + ((size_t)layer * 2 + 0) * D;
    const float* br = p.moe_b_route + layer * 32; const float* bg = p.moe_b_group + layer * 4;
    for (int rr = 0; rr < 8; ++rr) {
        const int t = bid * 64 + wid * 8 + rr; const size_t ro = (size_t)t * D;
        f32x4 z[4], m[4];
        load_row(hin + ro, lane, z); load_row(p.MIX + ro, lane, m);
        float s = 0.f;
#pragma unroll
        for (int q = 0; q < 4; ++q) { z[q] = z[q] * ALPHA + m[q]; s += z[q][0] + z[q][1] + z[q][2] + z[q][3]; }
        const float mean = wave_sum(s) * (1.0f / D);
        float vs = 0.f;
#pragma unroll
        for (int q = 0; q < 4; ++q) { z[q] = z[q] - mean; vs += z[q][0] * z[q][0] + z[q][1] * z[q][1] + z[q][2] * z[q][2] + z[q][3] * z[q][3]; }
        const float rs = rsqrtf(wave_sum(vs) * (1.0f / D) + LN_EPS);
#pragma unroll
        for (int q = 0; q < 4; ++q) {
            const f32x4 gw = *(const f32x4*)(g + 256 * q + 4 * lane), bw = *(const f32x4*)(be + 256 * q + 4 * lane);
            z[q] = z[q] * rs * gw + bw;
            *(f32x4*)(p.H1 + ro + 256 * q + 4 * lane) = z[q];
        }
        LAS float* L = lg + wid * 64;
#pragma unroll 1
        for (int gI = 0; gI < 4; ++gI) skinny_group<8>(z, wt + gI * 8 * 1028, lane, L + gI * 8);
        skinny_group<4>(z, wt + 32 * 1028, lane, L + 32);
        if (lane == 0) {
            const float q0 = L[32] + bg[0], q1 = L[33] + bg[1], q2 = L[34] + bg[2], q3 = L[35] + bg[3];
            int gi = 0; float gm = q0;
            if (q1 > gm) { gm = q1; gi = 1; } if (q2 > gm) { gm = q2; gi = 2; } if (q3 > gm) { gm = q3; gi = 3; }
            const float den = __expf(q0 - gm) + __expf(q1 - gm) + __expf(q2 - gm) + __expf(q3 - gm);
            const float pgrp = 1.0f / den;
            float l1 = -INFINITY, l2 = -INFINITY; int i1 = 0, i2 = 0;
#pragma unroll 1
            for (int o = 0; o < 8; ++o) { const float v = L[gi * 8 + o] + br[gi * 8 + o];
                if (v > l1) { l2 = l1; i2 = i1; l1 = v; i1 = o; } else if (v > l2) { l2 = v; i2 = o; } }
            const float e2 = __expf(l2 - l1), inv = 1.0f / (1.0f + e2);
            const int e0 = gi * 8 + i1, e1 = gi * 8 + i2;
            p.EIDX[2 * t] = e0; p.EIDX[2 * t + 1] = e1; p.GATE[2 * t] = pgrp * inv; p.GATE[2 * t + 1] = pgrp * e2 * inv;
            atomicAdd((int*)&cnt[e0], 1); atomicAdd((int*)&cnt[e1], 1);
        }
    }
    __syncthreads();
    if (tid < 32) p.CNT[bid * 32 + tid] = cnt[tid];
}

DEV void phase_moe_scatter(const Params& p, LAS unsigned char* lds) {
    const int tid = tid_(), bid = bid_(); (void)tid; (void)bid;
    const int lane = tid & 63, wid = tid >> 6;
    LAS int* part = (LAS int*)lds;
    LAS int* pre = part + 512;
    LAS int* base = pre + 512;
    LAS int* pst = base + 32;
    LAS int* dst = pst + 40;
    LAS int* eid = dst + 128;
    { const int e = tid & 31, part_i = tid >> 5; int tot = 0, prf = 0;
      for (int b = part_i * 16; b < part_i * 16 + 16; ++b) { const int c = p.CNT[b * 32 + e]; tot += c; if (b < (int)bid) prf += c; }
      part[part_i * 32 + e] = tot; pre[part_i * 32 + e] = prf; }
    if (tid < 128) eid[tid] = p.EIDX[bid * 128 + tid];
    __syncthreads();
    if (tid < 32) { int tot = 0, prf = 0; for (int i = 0; i < 16; ++i) { tot += part[i * 32 + tid]; prf += pre[i * 32 + tid]; } part[tid] = tot; pre[tid] = prf; }
    __syncthreads();
    if (tid == 0) { int acc = 0; for (int e = 0; e < 32; ++e) { pst[e] = acc; acc += ((part[e] + 255) >> 8) << 8; } pst[32] = acc;
        if (bid == 0) { for (int e = 0; e <= 32; ++e) p.TAB[e] = pst[e]; p.TAB[33] = acc >> 8;
            for (int e = 0; e < 32; ++e) for (int mt = pst[e] >> 8; mt < (pst[e + 1] >> 8); ++mt) p.TAB[64 + mt] = e; } }
    __syncthreads();
    if (tid < 32) { int run = pst[tid] + pre[tid]; for (int a = 0; a < 128; ++a) if (eid[a] == tid) dst[a] = run++; }
    __syncthreads();
    if (tid < 128) p.DEST[bid * 128 + tid] = dst[tid];
    for (int a = wid * 16; a < wid * 16 + 16; ++a) {
        const int t = bid * 64 + (a >> 1); const int d = dst[a];
        f32x4 z[4]; load_row(p.H1 + (size_t)t * D, lane, z);
#pragma unroll
        for (int q = 0; q < 4; ++q) st_bf4(p.BUF + (size_t)d * D + 256 * q + 4 * lane, z[q]);
    }
}

template <int which> struct SchedMoe {
    const Params* p; int layer;
    DEV bool next(int i, Unit& u) const {
        const int nmt = p->TAB[33]; int pm, pn; if (!pg8::tile_order(i, NB_, bid_(), nmt, 4, pm, pn)) return false;
        const int row0 = pm * 256; const int e = p->TAB[64 + pm];
        if constexpr (which == 0) { u.A = (const char*)(p->BUF + (size_t)row0 * D); u.B = (const char*)(p->moe_w1_t + ((size_t)layer * 32 + e) * 1024 * 1024 + (size_t)pn * 256 * 1024); }
        else { u.A = (const char*)(p->ACT + (size_t)row0 * 512); u.B = (const char*)(p->moe_w2_t + ((size_t)layer * 32 + e) * 1024 * 512 + (size_t)pn * 256 * 512); }
        u.row0 = row0; u.col0 = pn * 256; u.id = e; u.aux = 0; return true;
    }
};
struct EpiMoe1 {
    bf16_t* O;
    DEV void operator()(const AccT& acc, const Unit& u, int wr, int wc, int fr, int fq) const {
#pragma unroll
        for (int ai = 0; ai < 2; ++ai)
#pragma unroll
            for (int m = 0; m < 4; ++m)
#pragma unroll
                for (int n = 0; n < 2; ++n) {
                    const f32x4 gt = acc[ai][0][m][n], up = acc[ai][1][m][n]; f32x4 v;
                    for (int e = 0; e < 4; ++e) v[e] = siluf_(gt[e]) * up[e];
                    const int col = (u.col0 >> 1) + 32 * wc + 16 * n + 4 * fq;
                    st_bf4(O + (size_t)ACC_ROW(u, ai, m) * 512 + col, v); ACC_FENCE;
                }
    }
};
struct EpiMoe2 {
    bf16_t* O;
    DEV void operator()(const AccT& acc, const Unit& u, int wr, int wc, int fr, int fq) const {
        FOR_ACC(ai, bj, m, n) { st_bf4(O + (size_t)ACC_ROW(u, ai, m) * D + ACC_COL(u, bj, n), acc[ai][bj][m][n]); ACC_FENCE; }
    }
};

DEV void phase_ln2(const Params& p, int layer, float* hout) {
    const int tid = tid_(), bid = bid_(); (void)tid; (void)bid;
    const int lane = tid & 63, wid = tid >> 6;
    const float* g = p.ln_g + ((size_t)layer * 2 + 1) * D; const float* be = p.ln_b + ((size_t)layer * 2 + 1) * D;
    for (int rr = 0; rr < 8; ++rr) {
        const int t = bid * 64 + wid * 8 + rr; const size_t ro = (size_t)t * D;
        const int d0 = p.DEST[2 * t], d1 = p.DEST[2 * t + 1]; const float g0 = p.GATE[2 * t], g1 = p.GATE[2 * t + 1];
        f32x4 z[4]; load_row(p.H1 + ro, lane, z);
        float s = 0.f;
#pragma unroll
        for (int q = 0; q < 4; ++q) {
            const u32x2 a = *(const u32x2*)(p.YBUF + (size_t)d0 * D + 256 * q + 4 * lane), b = *(const u32x2*)(p.YBUF + (size_t)d1 * D + 256 * q + 4 * lane);
            z[q][0] = z[q][0] * ALPHA + g0 * bflo(a.x) + g1 * bflo(b.x); z[q][1] = z[q][1] * ALPHA + g0 * bfhi(a.x) + g1 * bfhi(b.x);
            z[q][2] = z[q][2] * ALPHA + g0 * bflo(a.y) + g1 * bflo(b.y); z[q][3] = z[q][3] * ALPHA + g0 * bfhi(a.y) + g1 * bfhi(b.y);
            s += z[q][0] + z[q][1] + z[q][2] + z[q][3];
        }
        const float mean = wave_sum(s) * (1.0f / D);
        float vs = 0.f;
#pragma unroll
        for (int q = 0; q < 4; ++q) { z[q] = z[q] - mean; vs += z[q][0] * z[q][0] + z[q][1] * z[q][1] + z[q][2] * z[q][2] + z[q][3] * z[q][3]; }
        const float rs = rsqrtf(wave_sum(vs) * (1.0f / D) + LN_EPS);
#pragma unroll
        for (int q = 0; q < 4; ++q) {
            const f32x4 gw = *(const f32x4*)(g + 256 * q + 4 * lane), bw = *(const f32x4*)(be + 256 * q + 4 * lane);
            *(f32x4*)(hout + ro + 256 * q + 4 * lane) = z[q] * rs * gw + bw;
        }
    }
}
constexpr int MB_PROJ = 5152;
DEV void phase_mb_cast(const Params& p, int j, const float* hin, LAS unsigned char* lds) {
    const int tid = tid_(), bid = bid_(); (void)tid; (void)bid;
    const int lane = tid & 63, wid = tid >> 6;
    LAS float* wt = (LAS float*)lds;
    const float* w = p.mb_w_in + (size_t)j * D * MB_PROJ;
    for (int i = tid; i < D * 32; i += NTHR) { const int k = i >> 5, o = i & 31; wt[o * 1028 + k] = w[(size_t)k * MB_PROJ + 5120 + o]; }
    __syncthreads();
    for (int rr = 0; rr < 8; ++rr) {
        const int t = bid * 64 + wid * 8 + rr; const size_t ro = (size_t)t * D;
        f32x4 z[4]; load_row(hin + ro, lane, z);
#pragma unroll
        for (int q = 0; q < 4; ++q) st_bf4(p.X6 + ro + 256 * q + 4 * lane, z[q]);
        LAS float* L = wt + 32 * 1028 + wid * 32;
#pragma unroll 1
        for (int gI = 0; gI < 4; ++gI) skinny_group<8>(z, wt + gI * 8 * 1028, lane, L + gI * 8);
        if (lane < 32) p.DT[(size_t)t * 32 + lane] = softplusf_(L[lane] + p.mb_dt_bias[j * 32 + lane]);
    }
}
struct SchedMbIn {
    const Params* p;
    DEV bool next(int i, Unit& u) const {
        int pm, pn; if (!pg8::tile_order(i, NB_, bid_(), 64, 20, pm, pn)) return false;
        u.A = (const char*)(p->X6 + (size_t)pm * 256 * D); u.B = (const char*)(p->mb_win_t + (size_t)pn * 256 * D); u.row0 = pm * 256; u.col0 = pn * 256; u.id = 0; u.aux = 0; return true;
    }
};
struct EpiMbIn {
    const Params* p;
    DEV void operator()(const AccT& acc, const Unit& u, int wr, int wc, int fr, int fq) const {
        const bool isz = u.col0 < 2048; bf16_t* O = p->Z + (isz ? (size_t)0 : (size_t)T * 2048 - 2048); const int ld = isz ? 2048 : 3072;
        FOR_ACC(ai, bj, m, n) { st_bf4(O + (size_t)ACC_ROW(u, ai, m) * ld + ACC_COL(u, bj, n), acc[ai][bj][m][n]); ACC_FENCE; }
    }
};
DEV void phase_mb_conv(const Params& p, int j) {
    const int tid = tid_(), bid = bid_(); (void)tid; (void)bid;
    if (tid >= 384) return;
    const int c0 = tid * 8; const int t0 = bid * 64;
    const float* cw = p.mb_conv_w + (size_t)j * 4 * 3072; const float* cb = p.mb_conv_b + (size_t)j * 3072;
    float w[4][8], b[8];
#pragma unroll
    for (int i = 0; i < 4; ++i) { const f32x4 a = *(const f32x4*)(cw + i * 3072 + c0), bb = *(const f32x4*)(cw + i * 3072 + c0 + 4); for (int e = 0; e < 4; ++e) { w[i][e] = a[e]; w[i][4 + e] = bb[e]; } }
    { const f32x4 a = *(const f32x4*)(cb + c0), bb = *(const f32x4*)(cb + c0 + 4); for (int e = 0; e < 4; ++e) { b[e] = a[e]; b[4 + e] = bb[e]; } }
    float x0[8], x1[8], x2[8], x3[8];
    auto ld = [&](int t, float (&x)[8]) {
        if (t < 0) { for (int e = 0; e < 8; ++e) x[e] = 0.f; return; }
        const u32x4 v = *(const u32x4*)(p.XBC + (size_t)t * 3072 + c0);
        x[0] = bflo(v.x); x[1] = bfhi(v.x); x[2] = bflo(v.y); x[3] = bfhi(v.y); x[4] = bflo(v.z); x[5] = bfhi(v.z); x[6] = bflo(v.w); x[7] = bfhi(v.w);
    };
    ld(t0 - 3, x0); ld(t0 - 2, x1); ld(t0 - 1, x2);
    for (int tt = 0; tt < 64; ++tt) {
        ld(t0 + tt, x3);
        float o[8];
#pragma unroll
        for (int e = 0; e < 8; ++e) o[e] = siluf_(b[e] + w[0][e] * x0[e] + w[1][e] * x1[e] + w[2][e] * x2[e] + w[3][e] * x3[e]);
        u32x4 r; r.x = pk2(o[0], o[1]); r.y = pk2(o[2], o[3]); r.z = pk2(o[4], o[5]); r.w = pk2(o[6], o[7]);
        *(u32x4*)(p.XC + (size_t)(t0 + tt) * 3072 + c0) = r;
#pragma unroll
        for (int e = 0; e < 8; ++e) { x0[e] = x1[e]; x1[e] = x2[e]; x2[e] = x3[e]; }
    }
}

DEV void mb_dacs(const Params& p, int j, int c, int g, LAS float* dts, LAS float* dacs) {
    const int tid = tid_(); const int lane = tid & 63, h = tid >> 6;
    const int hh = 8 * g + h; const float a = -__expf(p.mb_a_log[j * 32 + hh]);
    const float d0 = p.DT[(size_t)(c * 128 + 2 * lane) * 32 + hh], d1 = p.DT[(size_t)(c * 128 + 2 * lane + 1) * 32 + hh];
    const float a0 = d0 * a, a1 = d1 * a;
    float s = a0 + a1;
#pragma unroll
    for (int o = 1; o < 64; o <<= 1) { const float v = __shfl_up(s, o); if (lane >= o) s += v; }
    dts[h * 128 + 2 * lane] = d0; dts[h * 128 + 2 * lane + 1] = d1;
    dacs[h * 128 + 2 * lane] = s - a1; dacs[h * 128 + 2 * lane + 1] = s;
}
constexpr int LDB = 136;
constexpr int LDX = 72;
DEV void ld_tile128(const bf16_t* src, int gld, LAS bf16_t* dst) {
    const int tid = tid_();
    for (int i = tid; i < 128 * 16; i += NTHR) { const int r = i >> 4, c8 = (i & 15) * 8; *(LAS u32x4*)(dst + r * LDB + c8) = *(const u32x4*)(src + (size_t)r * gld + c8); }
}

DEV void phase_mb_states(const Params& p, int j, LAS unsigned char* lds) {
    const int tid = tid_(), bid = bid_(); (void)tid; (void)bid;
    const int lane = tid & 63, w = tid >> 6;
    LAS bf16_t* Bm = (LAS bf16_t*)lds;
    LAS bf16_t* Xh = Bm + 128 * LDB;
    LAS float* dts = (LAS float*)(Xh + 128 * LDX);
    LAS float* dacs = dts + 1024;
    for (int u = bid; u < 512; u += NB_) {
        const int c = u >> 2, g = u & 3; const int t0 = c * 128;
        __syncthreads();
        mb_dacs(p, j, c, g, dts, dacs);
        ld_tile128(p.XC + (size_t)t0 * 3072 + 2048 + 128 * g, 3072, Bm);
        __syncthreads();
        if (tid < 8) p.CD[(c * 32) + 8 * g + tid] = __expf(dacs[tid * 128 + 127]);
        bf16x8 bfr[4];
#pragma unroll
        for (int ks = 0; ks < 4; ++ks) bfr[ks] = frag_tr(Bm, LDB, 32 * ks, 16 * w, lane);
        for (int h = 0; h < 8; ++h) {
            { const int l = tid >> 2, p0 = (tid & 3) * 16; const float sc = dts[h * 128 + l] * __expf(dacs[h * 128 + 127] - dacs[h * 128 + l]);
              const bf16_t* src = p.XC + (size_t)(t0 + l) * 3072 + 64 * (8 * g + h) + p0;
#pragma unroll
              for (int hf = 0; hf < 2; ++hf) { const u32x4 v = *(const u32x4*)(src + 8 * hf); u32x4 r;
                  r.x = pk2(bflo(v.x) * sc, bfhi(v.x) * sc); r.y = pk2(bflo(v.y) * sc, bfhi(v.y) * sc); r.z = pk2(bflo(v.z) * sc, bfhi(v.z) * sc); r.w = pk2(bflo(v.w) * sc, bfhi(v.w) * sc);
                  *(LAS u32x4*)(Xh + l * LDX + p0 + 8 * hf) = r; } }
            __syncthreads();
            f32x4 acc[4];
#pragma unroll
            for (int pb = 0; pb < 4; ++pb) { acc[pb] = (f32x4){0.f, 0.f, 0.f, 0.f};
#pragma unroll
                for (int ks = 0; ks < 4; ++ks) { const bf16x8 af = frag_tr(Xh, LDX, 32 * ks, 16 * pb, lane); acc[pb] = MFMA16(af, bfr[ks], acc[pb]); } }
            float* S = p.STATES + (((size_t)c * 32 + 8 * g + h) * 64) * 128;
#pragma unroll
            for (int pb = 0; pb < 4; ++pb)
#pragma unroll
                for (int r = 0; r < 4; ++r) S[(size_t)(16 * pb + 4 * (lane >> 4) + r) * 128 + 16 * w + (lane & 15)] = acc[pb][r];
            __syncthreads();
        }
    }
}
DEV void phase_mb_scan(const Params& p) {
    const int tid = tid_(), bid = bid_(); (void)tid; (void)bid;
    const int gid = bid * NTHR + tid;
    if (gid >= 32 * 64 * 64) return;
    const int np = gid & 63, pp = (gid >> 6) & 63, h = gid >> 12; const int n = 2 * np;
    float r0 = 0.f, r1 = 0.f;
    const size_t eo = ((size_t)h * 64 + pp) * 128 + n;
    const size_t fo = (size_t)h * 64 * 128 + fragmajor_off(pp, n, 128);
#pragma unroll 4
    for (int c = 0; c < 128; ++c) {
        const f32x2 s = *(const f32x2*)(p.STATES + (size_t)c * 32 * 64 * 128 + eo);
        const float cd = p.CD[c * 32 + h];
        *(unsigned*)(p.PREV + (size_t)c * 32 * 64 * 128 + fo) = pk2(r0, r1);
        r0 = r0 * cd + s[0]; r1 = r1 * cd + s[1];
    }
}
DEV void phase_mb_out(const Params& p, int j, LAS unsigned char* lds) {
    const int tid = tid_(), bid = bid_(); (void)tid; (void)bid;
    const int lane = tid & 63, w = tid >> 6; const int fr = lane & 15, fq = lane >> 4;
    LAS bf16_t* Cm = (LAS bf16_t*)lds;
    LAS bf16_t* Bm = Cm + 128 * LDB;
    LAS bf16_t* Xh = Bm + 128 * LDB;
    LAS bf16_t* Mw = Xh + 128 * LDX;
    LAS float* dts = (LAS float*)(Mw + 8 * 16 * LDB);
    LAS float* dacs = dts + 1024;
    LAS bf16_t* Mme = Mw + w * 16 * LDB;
    for (int u = bid; u < 512; u += NB_) {
        const int c = u >> 2, g = u & 3; const int t0 = c * 128;
        __syncthreads();
        mb_dacs(p, j, c, g, dts, dacs);
        ld_tile128(p.XC + (size_t)t0 * 3072 + 2048 + 512 + 128 * g, 3072, Cm);
        ld_tile128(p.XC + (size_t)t0 * 3072 + 2048 + 128 * g, 3072, Bm);
        __syncthreads();
        f32x4 sc[8]; bf16x8 cf[4];
#pragma unroll
        for (int ks = 0; ks < 4; ++ks) cf[ks] = frag_rm(Cm, LDB, 16 * w, 32 * ks, lane);
#pragma unroll
        for (int sb = 0; sb < 8; ++sb) { sc[sb] = (f32x4){0.f, 0.f, 0.f, 0.f};
#pragma unroll
            for (int ks = 0; ks < 4; ++ks) sc[sb] = MFMA16(cf[ks], frag_rm(Bm, LDB, 16 * sb, 32 * ks, lane), sc[sb]); }
        float ssq[4] = {0.f, 0.f, 0.f, 0.f};
#pragma unroll 1
        for (int h = 0; h < 8; ++h) {
            const int hh = 8 * g + h;
            { const int l = tid >> 2, p0 = (tid & 3) * 16; const float scl = dts[h * 128 + l];
              const bf16_t* src = p.XC + (size_t)(t0 + l) * 3072 + 64 * hh + p0;
#pragma unroll
              for (int hf = 0; hf < 2; ++hf) { const u32x4 v = *(const u32x4*)(src + 8 * hf); u32x4 r;
                  r.x = pk2(bflo(v.x) * scl, bfhi(v.x) * scl); r.y = pk2(bflo(v.y) * scl, bfhi(v.y) * scl); r.z = pk2(bflo(v.z) * scl, bfhi(v.z) * scl); r.w = pk2(bflo(v.w) * scl, bfhi(v.w) * scl);
                  *(LAS u32x4*)(Xh + l * LDX + p0 + 8 * hf) = r; } }
            float dl[4];
#pragma unroll
            for (int r = 0; r < 4; ++r) dl[r] = dacs[h * 128 + 16 * w + 4 * fq + r];
#pragma unroll
            for (int sb = 0; sb < 8; ++sb) { const int s = 16 * sb + fr; const float ds = dacs[h * 128 + s];
#pragma unroll
                for (int r = 0; r < 4; ++r) { const int l = 16 * w + 4 * fq + r; const float m = (s <= l) ? sc[sb][r] * __expf(dl[r] - ds) : 0.f; Mme[(4 * fq + r) * LDB + s] = (bf16_t)f2bf(m); } }
            __syncthreads();
            bf16x8 mf[4];
#pragma unroll
            for (int ks = 0; ks < 4; ++ks) mf[ks] = frag_rm(Mme, LDB, 0, 32 * ks, lane);
            const bf16_t* pv = p.PREV + ((size_t)c * 32 + hh) * 64 * 128;
#pragma unroll
            for (int pb = 0; pb < 4; ++pb) {
                f32x4 a = {0.f, 0.f, 0.f, 0.f}, o = {0.f, 0.f, 0.f, 0.f};
#pragma unroll
                for (int ks = 0; ks < 4; ++ks) {
                    a = MFMA16(mf[ks], frag_tr(Xh, LDX, 32 * ks, 16 * pb, lane), a);
                    const bf16x8 pf = *(const bf16x8*)(pv + ((size_t)(pb * 4 + ks) * 64 + lane) * 8);
                    o = MFMA16(cf[ks], pf, o);
                }
                const float dsk = p.mb_d[j * 32 + hh];
#pragma unroll
                for (int r = 0; r < 4; ++r) {
                    const int t = t0 + 16 * w + 4 * fq + r; const int ch = 64 * hh + 16 * pb + fr;
                    const float xs = bf2f(p.XC[(size_t)t * 3072 + ch]); const float z = bf2f(p.Z[(size_t)t * 2048 + ch]);
                    float v = a[r] + o[r] * __expf(dl[r]) + xs * dsk;
                    v *= siluf_(z);
                    ssq[r] += v * v;
                    p.YB[(size_t)t * 2048 + ch] = (bf16_t)f2bf(v * p.mb_norm_g[(size_t)j * 2048 + ch]);
                }
            }
            __syncthreads();
        }
#pragma unroll
        for (int r = 0; r < 4; ++r) ssq[r] = rsqrtf(sum16(ssq[r]) * (1.0f / 512.0f) + 1e-5f);
#pragma unroll 1
        for (int h = 0; h < 8; ++h)
#pragma unroll
            for (int pb = 0; pb < 4; ++pb) { const int ch = 512 * g + 64 * h + 16 * pb + fr;
#pragma unroll
                for (int r = 0; r < 4; ++r) { bf16_t* q = p.YB + (size_t)(t0 + 16 * w + 4 * fq + r) * 2048 + ch; *q = (bf16_t)f2bf(bf2f(*q) * ssq[r]); } }
    }
}
constexpr int GL_PROJ = 3088;
constexpr int LDV = 264;
DEV void phase_gl_cast(const Params& p, int j, const float* hin, LAS unsigned char* lds) {
    const int tid = tid_(), bid = bid_(); (void)tid; (void)bid;
    const int lane = tid & 63, wid = tid >> 6;
    LAS float* wt = (LAS float*)lds;
    LAS float* w2 = wt + 16 * 1028;
    LAS float* lr = w2 + 16 * 512;
    const float* w = p.gl_w_in + (size_t)j * D * GL_PROJ;
    for (int i = tid; i < D * 16; i += NTHR) { const int k = i >> 4, o = i & 15; wt[o * 1028 + k] = w[(size_t)k * GL_PROJ + 3072 + o]; }
    for (int i = tid; i < 16 * 512; i += NTHR) w2[i] = p.gl_gk_w2[(size_t)j * 16 * 512 + i];
    __syncthreads();
    for (int rr = 0; rr < 8; ++rr) {
        const int t = bid * 64 + wid * 8 + rr; const size_t ro = (size_t)t * D;
        f32x4 z[4]; load_row(hin + ro, lane, z);
#pragma unroll
        for (int q = 0; q < 4; ++q) st_bf4(p.X6 + ro + 256 * q + 4 * lane, z[q]);
#pragma unroll 1
        for (int gI = 0; gI < 2; ++gI) skinny_group<8>(z, wt + gI * 8 * 1028, lane, lr + wid * 16 + gI * 8);
        float l16[16];
#pragma unroll
        for (int o = 0; o < 16; ++o) l16[o] = lr[wid * 16 + o];
#pragma unroll
        for (int cc = 0; cc < 8; ++cc) {
            const int c = cc * 64 + lane; float a = p.gl_gk_b[j * 512 + c];
#pragma unroll
            for (int o = 0; o < 16; ++o) a += l16[o] * w2[o * 512 + c];
            const float ls = fminf(a, 0.f) - log1pf(__expf(-fabsf(a)));
            p.LA[(size_t)t * 512 + c] = ls * (1.0f / 16.0f);
        }
    }
}
struct SchedGlIn {
    const Params* p;
    DEV bool next(int i, Unit& u) const {
        int pm, pn; if (!pg8::tile_order(i, NB_, bid_(), 64, 12, pm, pn)) return false;
        u.A = (const char*)(p->X6 + (size_t)pm * 256 * D); u.B = (const char*)(p->gl_win_t + (size_t)pn * 256 * D); u.row0 = pm * 256; u.col0 = pn * 256; u.id = 0; u.aux = 0; return true;
    }
};
struct EpiGlIn {
    const Params* p;
    DEV void operator()(const AccT& acc, const Unit& u, int wr, int wc, int fr, int fq) const {
        FOR_ACC(ai, bj, m, n) { st_bf4(p->QKVG + (size_t)ACC_ROW(u, ai, m) * 3072 + ACC_COL(u, bj, n), acc[ai][bj][m][n]); ACC_FENCE; }
    }
};
DEV void gl_bcs(const Params& p, int n, int h, LAS float* bcs) {
    const int tid = tid_();
    for (int i = tid; i < 64 * 32; i += NTHR) { const int r = i >> 5, c4 = (i & 31) * 4; *(LAS f32x4*)(bcs + r * 128 + c4) = *(const f32x4*)(p.LA + (size_t)(n * 64 + r) * 512 + 128 * h + c4); }
    __syncthreads();
    if (tid < 128) { float s = 0.f; for (int r = 0; r < 64; ++r) { s += bcs[r * 128 + tid]; bcs[r * 128 + tid] = s; } }
    __syncthreads();
}
DEV void phase_gl_kv(const Params& p, LAS unsigned char* lds) {
    const int tid = tid_(), bid = bid_(); (void)tid; (void)bid;
    const int lane = tid & 63, w = tid >> 6;
    LAS float* bcs = (LAS float*)lds;
    LAS bf16_t* Ke = (LAS bf16_t*)(bcs + 64 * 128);
    LAS bf16_t* Vs = Ke + 64 * LDB;
    for (int u = bid; u < 1024; u += NB_) {
        const int n = u >> 2, h = u & 3; const int t0 = n * 64;
        __syncthreads();
        gl_bcs(p, n, h, bcs);
        for (int i = tid; i < 64 * 16; i += NTHR) { const int r = i >> 4, c8 = (i & 15) * 8;
            const u32x4 v = *(const u32x4*)(p.QKVG + (size_t)(t0 + r) * 3072 + 512 + 128 * h + c8); float f[8];
            f[0] = bflo(v.x); f[1] = bfhi(v.x); f[2] = bflo(v.y); f[3] = bfhi(v.y); f[4] = bflo(v.z); f[5] = bfhi(v.z); f[6] = bflo(v.w); f[7] = bfhi(v.w);
#pragma unroll
            for (int e = 0; e < 8; ++e) f[e] *= __expf(bcs[63 * 128 + c8 + e] - bcs[r * 128 + c8 + e]);
            u32x4 o; o.x = pk2(f[0], f[1]); o.y = pk2(f[2], f[3]); o.z = pk2(f[4], f[5]); o.w = pk2(f[6], f[7]);
            *(LAS u32x4*)(Ke + r * LDB + c8) = o; }
        for (int i = tid; i < 64 * 32; i += NTHR) { const int r = i >> 5, c8 = (i & 31) * 8; *(LAS u32x4*)(Vs + r * LDV + c8) = *(const u32x4*)(p.QKVG + (size_t)(t0 + r) * 3072 + 1024 + 256 * h + c8); }
        if (tid < 128) p.CDG[((size_t)n * 4 + h) * 128 + tid] = __expf(bcs[63 * 128 + tid]);
        __syncthreads();
        bf16x8 af[2];
#pragma unroll
        for (int ks = 0; ks < 2; ++ks) af[ks] = frag_tr(Ke, LDB, 32 * ks, 16 * w, lane);
        float* O = p.STATES + (((size_t)n * 4 + h) * 128) * 256;
#pragma unroll
        for (int vb = 0; vb < 16; ++vb) {
            f32x4 acc = {0.f, 0.f, 0.f, 0.f};
#pragma unroll
            for (int ks = 0; ks < 2; ++ks) acc = MFMA16(af[ks], frag_tr(Vs, LDV, 32 * ks, 16 * vb, lane), acc);
#pragma unroll
            for (int r = 0; r < 4; ++r) O[(size_t)(16 * w + 4 * (lane >> 4) + r) * 256 + 16 * vb + (lane & 15)] = acc[r];
        }
    }
}
DEV void phase_gl_scan(const Params& p) {
    const int tid = tid_(), bid = bid_(); (void)tid; (void)bid;
    const int gid = bid * NTHR + tid;
    if (gid >= 4 * 64 * 256) return;
    const int v = gid & 255, kp = (gid >> 8) & 63, h = gid >> 14; const int k = 2 * kp;
    float r0 = 0.f, r1 = 0.f;
    const size_t fo = (size_t)h * 128 * 256 + fragmajor_off(v, k, 128);
#pragma unroll 4
    for (int n = 0; n < 256; ++n) {
        const float* S = p.STATES + (((size_t)n * 4 + h) * 128) * 256;
        const float s0 = S[(size_t)k * 256 + v], s1 = S[(size_t)(k + 1) * 256 + v];
        const f32x2 cd = *(const f32x2*)(p.CDG + ((size_t)n * 4 + h) * 128 + k);
        *(unsigned*)(p.PREV + (size_t)n * 4 * 128 * 256 + fo) = pk2(r0, r1);
        r0 = r0 * cd[0] + s0; r1 = r1 * cd[1] + s1;
    }
}
DEV void phase_gl_out(const Params& p, int j, LAS unsigned char* lds) {
    const int tid = tid_(), bid = bid_(); (void)tid; (void)bid;
    const int lane = tid & 63, w = tid >> 6; const int fr = lane & 15, fq = lane >> 4;
    LAS float* bcs = (LAS float*)lds;
    LAS bf16_t* Qs = (LAS bf16_t*)(bcs + 64 * 128);
    LAS bf16_t* Ks = Qs + 64 * LDB;
    LAS bf16_t* Vs = Ks + 64 * LDB;
    LAS bf16_t* At = Vs + 64 * LDV;
    LAS float* red = (LAS float*)(At + 64 * LDX);
    for (int u = bid; u < 1024; u += NB_) {
        const int n = u >> 2, h = u & 3; const int t0 = n * 64;
        __syncthreads();
        gl_bcs(p, n, h, bcs);
        for (int i = tid; i < 64 * 16; i += NTHR) { const int r = i >> 4, c8 = (i & 15) * 8;
            const u32x4 vq = *(const u32x4*)(p.QKVG + (size_t)(t0 + r) * 3072 + 128 * h + c8), vk = *(const u32x4*)(p.QKVG + (size_t)(t0 + r) * 3072 + 512 + 128 * h + c8);
            float fq_[8], fk_[8];
            fq_[0] = bflo(vq.x); fq_[1] = bfhi(vq.x); fq_[2] = bflo(vq.y); fq_[3] = bfhi(vq.y); fq_[4] = bflo(vq.z); fq_[5] = bfhi(vq.z); fq_[6] = bflo(vq.w); fq_[7] = bfhi(vq.w);
            fk_[0] = bflo(vk.x); fk_[1] = bfhi(vk.x); fk_[2] = bflo(vk.y); fk_[3] = bfhi(vk.y); fk_[4] = bflo(vk.z); fk_[5] = bfhi(vk.z); fk_[6] = bflo(vk.w); fk_[7] = bfhi(vk.w);
#pragma unroll
            for (int e = 0; e < 8; ++e) { const float b = bcs[r * 128 + c8 + e]; fq_[e] *= __expf(b) * 0.08838834764831845f; fk_[e] *= __expf(-b); }
            u32x4 o; o.x = pk2(fq_[0], fq_[1]); o.y = pk2(fq_[2], fq_[3]); o.z = pk2(fq_[4], fq_[5]); o.w = pk2(fq_[6], fq_[7]);
            *(LAS u32x4*)(Qs + r * LDB + c8) = o;
            o.x = pk2(fk_[0], fk_[1]); o.y = pk2(fk_[2], fk_[3]); o.z = pk2(fk_[4], fk_[5]); o.w = pk2(fk_[6], fk_[7]);
            *(LAS u32x4*)(Ks + r * LDB + c8) = o; }
        for (int i = tid; i < 64 * 32; i += NTHR) { const int r = i >> 5, c8 = (i & 31) * 8; *(LAS u32x4*)(Vs + r * LDV + c8) = *(const u32x4*)(p.QKVG + (size_t)(t0 + r) * 3072 + 1024 + 256 * h + c8); }
        __syncthreads();
        { const int ib = w >> 1;
#pragma unroll
          for (int jj = 0; jj < 2; ++jj) { const int jb = 2 * (w & 1) + jj; f32x4 a = {0.f, 0.f, 0.f, 0.f};
#pragma unroll
              for (int ks = 0; ks < 4; ++ks) a = MFMA16(frag_rm(Qs, LDB, 16 * ib, 32 * ks, lane), frag_rm(Ks, LDB, 16 * jb, 32 * ks, lane), a);
#pragma unroll
              for (int r = 0; r < 4; ++r) { const int i = 16 * ib + 4 * fq + r, jx = 16 * jb + fr; At[i * LDX + jx] = (bf16_t)f2bf(jx <= i ? a[r] : 0.f); } } }
        __syncthreads();
        f32x4 o[4][2];
        const bf16_t* pv = p.PREV + ((size_t)n * 4 + h) * 128 * 256;
#pragma unroll
        for (int vv = 0; vv < 2; ++vv) { const int vb = 2 * w + vv;
            bf16x8 bi[2], bp[4];
#pragma unroll
            for (int ks = 0; ks < 2; ++ks) bi[ks] = frag_tr(Vs, LDV, 32 * ks, 16 * vb, lane);
#pragma unroll
            for (int ks = 0; ks < 4; ++ks) bp[ks] = *(const bf16x8*)(pv + ((size_t)(vb * 4 + ks) * 64 + lane) * 8);
#pragma unroll
            for (int ib = 0; ib < 4; ++ib) { f32x4 a = {0.f, 0.f, 0.f, 0.f};
#pragma unroll
                for (int ks = 0; ks < 2; ++ks) a = MFMA16(frag_rm(At, LDX, 16 * ib, 32 * ks, lane), bi[ks], a);
#pragma unroll
                for (int ks = 0; ks < 4; ++ks) a = MFMA16(frag_rm(Qs, LDB, 16 * ib, 32 * ks, lane), bp[ks], a);
                o[ib][vv] = a; } }
#pragma unroll
        for (int ib = 0; ib < 4; ++ib)
#pragma unroll
            for (int r = 0; r < 4; ++r) { float s = o[ib][0][r] * o[ib][0][r] + o[ib][1][r] * o[ib][1][r]; s = sum16(s); if (fr == 0) red[w * 64 + 16 * ib + 4 * fq + r] = s; }
        __syncthreads();
#pragma unroll
        for (int ib = 0; ib < 4; ++ib)
#pragma unroll
            for (int r = 0; r < 4; ++r) { const int i = 16 * ib + 4 * fq + r; float s = 0.f;
#pragma unroll
                for (int ww = 0; ww < 8; ++ww) s += red[ww * 64 + i];
                const float rs = rsqrtf(s * (1.0f / 256.0f) + 1e-5f);
#pragma unroll
                for (int vv = 0; vv < 2; ++vv) { const int v = 32 * w + 16 * vv + fr; const int t = t0 + i;
                    const float gt = bf2f(p.QKVG[(size_t)t * 3072 + 2048 + 256 * h + v]);
                    p.YB[(size_t)t * D + 256 * h + v] = (bf16_t)f2bf(o[ib][vv][r] * rs * p.gl_norm_g[j * 256 + v] * siluf_(gt)); } }
    }
}
#define XB_TMO      128
#define XB_XCNT(j)  (256  + 64 * (j))
#define XB_XSUB(j)  (1280 + 64 * (j))
#define XB_XGEN(j)  (2304 + 64 * (j))
#define XB_TOP      3328
#define XB_TOPGEN   3392
#define XCD_BAR_WORDS 3456
#define XB_SPIN_CAP (1u << 22)
DEV unsigned xb_ld(unsigned* p)              { return __hip_atomic_load(p, __ATOMIC_RELAXED, __HIP_MEMORY_SCOPE_AGENT); }
DEV unsigned xb_add(unsigned* p, unsigned v) { return __hip_atomic_fetch_add(p, v, __ATOMIC_RELAXED, __HIP_MEMORY_SCOPE_AGENT); }
DEV unsigned xb_xcc_id() { return (unsigned)__builtin_amdgcn_s_getreg((3 << 11) | 20) & 0xFu; }
#define XB_SPIN(cond, bar) do { unsigned _sp = 0; while (cond) { __builtin_amdgcn_s_sleep(1); \
    if ((++_sp & 255u) == 0u) { if (xb_ld(&(bar)[XB_TMO])) break; if (_sp > XB_SPIN_CAP) { atomicAdd(&(bar)[XB_TMO], 1u); break; } } } } while (0)
struct XcdBarrier { unsigned* bar; unsigned x; volatile LAS unsigned* st; };
DEV XcdBarrier xcd_barrier_post(unsigned* bar, volatile LAS unsigned* st) {
    XcdBarrier b; b.bar = bar; b.x = xb_xcc_id(); b.st = st;
    if (threadIdx.x == 0) (void)xb_add(&bar[XB_XCNT(b.x)], 1u);
    return b;
}
DEV void xcd_barrier_complete(unsigned* bar, unsigned x, unsigned& nloc, unsigned& nx) {
    const unsigned G = gridDim.x * gridDim.y * gridDim.z;
    unsigned sum, cnt, mine, sp = 0u;
    for (;;) {
        sum = 0u; cnt = 0u; mine = 0u;
#pragma unroll
        for (unsigned j = 0; j < 16; ++j) { const unsigned c = xb_ld(&bar[XB_XCNT(j)]); sum += c; cnt += (c > 0u) ? 1u : 0u; mine = (j == x) ? c : mine; }
        if (sum == G) break;
        __builtin_amdgcn_s_sleep(1);
        if ((++sp & 255u) == 0u) { if (xb_ld(&bar[XB_TMO])) break; if (sp > XB_SPIN_CAP) { atomicAdd(&bar[XB_TMO], 1u); break; } }
    }
    nloc = mine > 0u ? mine : 1u; nx = cnt > 0u ? cnt : 1u;
}
DEV void xcd_barrier(const XcdBarrier& b) {
    asm volatile("s_waitcnt vmcnt(0)" ::: "memory");
    __syncthreads();
    if (threadIdx.x == 0) {
        unsigned* bar = b.bar;
        __builtin_amdgcn_s_waitcnt(0);
        unsigned nloc = b.st[0], nx = b.st[1];
        if (nloc == 0u) { xcd_barrier_complete(bar, b.x, nloc, nx); b.st[0] = nloc; b.st[1] = nx; }
        const unsigned old = xb_add(&bar[XB_XSUB(b.x)], 1u);
        const unsigned gen = old / nloc;
        if (old + 1u == (gen + 1u) * nloc) {
            __builtin_amdgcn_fence(__ATOMIC_RELEASE, "agent");
            asm volatile("s_waitcnt vmcnt(0)" ::: "memory");
            const unsigned og = xb_add(&bar[XB_TOP], 1u);
            const unsigned tg = og / nx;
            if (og + 1u == (tg + 1u) * nx) xb_add(&bar[XB_TOPGEN], 1u);
            else XB_SPIN(xb_ld(&bar[XB_TOPGEN]) == tg, bar);
            __builtin_amdgcn_fence(__ATOMIC_ACQUIRE, "agent");
            xb_add(&bar[XB_XGEN(b.x)], 1u);
            asm volatile("s_waitcnt vmcnt(0)" ::: "memory");
        } else {
            XB_SPIN(xb_ld(&bar[XB_XGEN(b.x)]) == gen, bar);
            __builtin_amdgcn_fence(__ATOMIC_ACQUIRE, "agent");
            asm volatile("s_waitcnt vmcnt(0)" ::: "memory");
        }
    }
    __syncthreads();
}

DEV void run_phase(const Params& p, int op, int arg, LAS unsigned char* lds) {
    const int layer = arg; const int jj = layer / 3;
    const float* hin = layer == 0 ? p.x : p.H;
    float* hout = layer == DEPTH - 1 ? p.out : p.H;
#ifdef ONLY_OP
    if (op != ONLY_OP) return;
#endif
    switch (op) {
    case OP_CONVERT: phase_convert(p, lds); break;
    case OP_RW_MIX: phase_rw_mix(p, jj, hin); break;
    case OP_RW_GEMM1: { SchedRW1 S{&p, jj}; EpiRW1 E{&p}; pg8::gemm_phase(lds, 1024, S, E); } break;
    case OP_RW_GEMM2: { SchedRW2 S{&p, jj}; EpiRW2 E{&p, jj}; pg8::gemm_phase(lds, 256, S, E); } break;
    case OP_RW_PREP: phase_rw_prep(p, jj); break;
    case OP_RW_SCAN: phase_rw_scan(p, lds); break;
    case OP_RW_POST: phase_rw_post(p, jj); break;
    case OP_RW_OUT: { SchedOut S{p.YB, p.rw_wo_t + (size_t)jj * D * D, 1024}; EpiOut E{p.MIX}; pg8::gemm_phase(lds, 1024, S, E); } break;
    case OP_LN1: phase_ln1(p, layer, hin, lds); break;
    case OP_MOE_SCATTER: phase_moe_scatter(p, lds); break;
    case OP_MOE_GEMM1: { SchedMoe<0> S{&p, layer}; EpiMoe1 E{p.ACT}; pg8::gemm_phase(lds, 1024, S, E); } break;
    case OP_MOE_GEMM2: { SchedMoe<1> S{&p, layer}; EpiMoe2 E{p.YBUF}; pg8::gemm_phase(lds, 512, S, E); } break;
    case OP_LN2: phase_ln2(p, layer, hout); break;
    case OP_MB_CAST: phase_mb_cast(p, jj, hin, lds); break;
    case OP_MB_GEMM_IN: { SchedMbIn S{&p}; EpiMbIn E{&p}; pg8::gemm_phase(lds, 1024, S, E); } break;
    case OP_MB_CONV: phase_mb_conv(p, jj); break;
    case OP_MB_STATES: phase_mb_states(p, jj, lds); break;
    case OP_MB_SCAN: phase_mb_scan(p); break;
    case OP_MB_OUT: phase_mb_out(p, jj, lds); break;
    case OP_MB_GEMM_OUT: { SchedOut S{p.YB, p.mb_wout_t + (size_t)jj * D * 2048, 2048}; EpiOut E{p.MIX}; pg8::gemm_phase(lds, 2048, S, E); } break;
    case OP_GL_CAST: phase_gl_cast(p, jj, hin, lds); break;
    case OP_GL_GEMM_IN: { SchedGlIn S{&p}; EpiGlIn E{&p}; pg8::gemm_phase(lds, 1024, S, E); } break;
    case OP_GL_KV: phase_gl_kv(p, lds); break;
    case OP_GL_SCAN: phase_gl_scan(p); break;
    case OP_GL_OUT: phase_gl_out(p, jj, lds); break;
    case OP_GL_GEMM_OUT: { SchedOut S{p.YB, p.gl_wout_t + (size_t)jj * D * D, 1024}; EpiOut E{p.MIX}; pg8::gemm_phase(lds, 1024, S, E); } break;
    default: break;
    }
}

constexpr int NPHASES = 1 + 12 + 12 + 11 + 12;
DEV void decode_phase(int ph, int& op, int& layer) {
    if (ph == 0) { op = OP_CONVERT; layer = 0; return; }
    int q = ph - 1; layer = 0;
    if (q >= 12) { q -= 12; layer = 1; if (q >= 12) { q -= 12; layer = 2; if (q >= 11) { q -= 11; layer = 3; } } }
    const int kind = layer % 3; const int nmix = kind == 2 ? 6 : 7;
    if (q < nmix) op = (kind == 0 ? OP_RW_MIX : kind == 1 ? OP_MB_CAST : OP_GL_CAST) + q;
    else op = OP_LN1 + (q - nmix);
}

#define X(t, n) t n##_,
template <bool COOP>
__global__ void __launch_bounds__(NTHR, 2) mega(PARAM_LIST(X) const int ph0, const int ph1) {
#undef X
    Params p;
#define X(t, n) p.n = n##_;
    PARAM_LIST(X)
#undef X
    extern __shared__ __attribute__((aligned(16))) unsigned char smem_raw[];
    LAS unsigned char* lds = (LAS unsigned char*)smem_raw;
    if constexpr (COOP) {
        volatile LAS unsigned* st = (volatile LAS unsigned*)(lds + LDS_BYTES - 16);
        if (threadIdx.x == 0) { st[0] = 0u; st[1] = 0u; }
        __syncthreads();
        XcdBarrier xb = xcd_barrier_post(p.bar, st);
        if (ph0 < 0) cg::this_grid().sync();
        for (int ph = ph0; ph < ph1; ++ph) {
            int op, arg; decode_phase(ph, op, arg);
            run_phase(p, op, arg, lds);
            if (ph + 1 < ph1) xcd_barrier(xb);
        }
    } else {
        for (int ph = ph0; ph < ph1; ++ph) { int op, arg; decode_phase(ph, op, arg); run_phase(p, op, arg, lds); }
    }
}

struct Bump { size_t off = 0; template <class Tp> Tp* take(char* base, size_t n) { Tp* r = (Tp*)(base + off); off += (n * sizeof(Tp) + 255) & ~(size_t)255; return r; } };

extern "C" void kernel_launch(void* const* d_in, const int* in_sizes, int n_in, void* d_out, int out_size, void* d_ws, size_t ws_size, hipStream_t stream) {
    (void)in_sizes; (void)n_in; (void)out_size;
    Params p; std::memset((void*)&p, 0, sizeof(p));
    auto F = [&](int i) { return (const float*)d_in[i]; };
    p.x = F(0); p.ln_g = F(1); p.ln_b = F(2);
    p.rw_mu = F(3); p.rw_w_rkv = F(4); p.rw_w0 = F(5); p.rw_w1 = F(6); p.rw_w2 = F(7); p.rw_a0 = F(8);
    p.rw_a1 = F(9); p.rw_a2 = F(10); p.rw_g1 = F(11); p.rw_g2 = F(12);
    p.rw_k_k = F(13); p.rw_k_a = F(14); p.rw_r_k = F(15); p.rw_lnx_g = F(16); p.rw_lnx_b = F(17); p.rw_w_o = F(18);
    p.mb_w_in = F(19); p.mb_conv_w = F(20); p.mb_conv_b = F(21); p.mb_dt_bias = F(22); p.mb_a_log = F(23); p.mb_d = F(24); p.mb_norm_g = F(25); p.mb_w_out = F(26);
    p.gl_w_in = F(27); p.gl_gk_w2 = F(28); p.gl_gk_b = F(29); p.gl_norm_g = F(30); p.gl_w_out = F(31);
    p.moe_w_group = F(32); p.moe_b_group = F(33); p.moe_w_route = F(34); p.moe_b_route = F(35); p.moe_w_in = F(36); p.moe_w_down = F(37);
    p.out = (float*)d_out;
    char* ws = (char*)d_ws; Bump B;
    p.bar = B.take<unsigned>(ws, XCD_BAR_WORDS);
    const size_t TD = (size_t)T * D;
    p.rw_rkv_t = B.take<bf16_t>(ws, 2 * 3 * (size_t)D * D); p.rw_w1_t = B.take<bf16_t>(ws, 2 * 256 * (size_t)D); p.rw_a1_t = B.take<bf16_t>(ws, 2 * 256 * (size_t)D); p.rw_g1_t = B.take<bf16_t>(ws, 2 * 256 * (size_t)D);
    p.rw_w2_t = B.take<bf16_t>(ws, 2 * (size_t)D * 256); p.rw_a2_t = B.take<bf16_t>(ws, 2 * (size_t)D * 256); p.rw_g2_t = B.take<bf16_t>(ws, 2 * (size_t)D * 256); p.rw_wo_t = B.take<bf16_t>(ws, 2 * (size_t)D * D);
    p.mb_win_t = B.take<bf16_t>(ws, 5120 * (size_t)D); p.mb_wout_t = B.take<bf16_t>(ws, (size_t)D * 2048); p.gl_win_t = B.take<bf16_t>(ws, 3072 * (size_t)D); p.gl_wout_t = B.take<bf16_t>(ws, (size_t)D * D);
    p.moe_w1_t = B.take<bf16_t>(ws, 128 * (size_t)1024 * 1024); p.moe_w2_t = B.take<bf16_t>(ws, 128 * (size_t)1024 * 512);
    p.H = B.take<float>(ws, TD); p.H1 = B.take<float>(ws, TD); p.MIX = B.take<float>(ws, TD);
    p.BUF = B.take<bf16_t>(ws, (size_t)MOE_ROWS * D); p.ACT = B.take<bf16_t>(ws, (size_t)MOE_ROWS * 512); p.YBUF = B.take<bf16_t>(ws, (size_t)MOE_ROWS * D);
    p.CNT = B.take<int>(ws, 256 * 32); p.EIDX = B.take<int>(ws, 2 * T); p.GATE = B.take<float>(ws, 2 * T); p.DEST = B.take<int>(ws, 2 * T); p.TAB = B.take<int>(ws, 256);
    p.YB = B.take<bf16_t>(ws, (size_t)T * 2048);
    const size_t arena0 = B.off;
    p.X6 = B.take<bf16_t>(ws, 6 * TD);
    p.P2 = (float*)p.X6; p.P3 = p.P2 + TD; p.P4 = p.P3 + TD;
    p.Rr = B.take<float>(ws, TD); p.Kk = B.take<float>(ws, TD); p.Vv = B.take<float>(ws, TD);
    p.Y = p.Rr;
    p.LW = B.take<bf16_t>(ws, 3 * (size_t)T * 256);
    p.Wd = B.take<float>(ws, TD); p.P5 = B.take<float>(ws, TD); p.Aa = B.take<float>(ws, TD); p.Gg = B.take<float>(ws, TD);
    p.C1 = B.take<float>(ws, (size_t)T * 16); p.C2 = B.take<float>(ws, (size_t)T * 16); p.BC = B.take<float>(ws, (size_t)T * 16);
    { Bump A2; A2.off = arena0 + ((TD * 2 + 255) & ~(size_t)255);
      p.Z = A2.take<bf16_t>(ws, (size_t)T * 2048); p.XBC = A2.take<bf16_t>(ws, (size_t)T * 3072); p.XC = A2.take<bf16_t>(ws, (size_t)T * 3072);
      p.DT = A2.take<float>(ws, (size_t)T * 32); p.STATES = A2.take<float>(ws, (size_t)128 * 32 * 64 * 128); p.CD = A2.take<float>(ws, 128 * 32);
      p.PREV = A2.take<bf16_t>(ws, (size_t)128 * 32 * 64 * 128);
      p.LA = A2.take<float>(ws, (size_t)T * 512); p.CDG = A2.take<float>(ws, 256 * 4 * 128);
      p.QKVG = p.XBC;
      if (A2.off > B.off) B.off = A2.off; }
    if (B.off > ws_size) { fprintf(stderr, "workspace too small: need %zu have %zu\n", B.off, ws_size); return; }
    const int np = NPHASES;
#define X(t, n) (void*)&p.n,
#if SINGLE_LAUNCH
    (void)hipFuncSetAttribute((const void*)mega<true>, hipFuncAttributeMaxDynamicSharedMemorySize, LDS_BYTES);
    (void)hipMemsetAsync(p.bar, 0, XCD_BAR_WORDS * sizeof(unsigned), stream);
    int ph0 = 0, ph1 = np; void* args[] = {PARAM_LIST(X) (void*)&ph0, (void*)&ph1};
    hipError_t e = hipLaunchCooperativeKernel((const void*)mega<true>, dim3(NBLK), dim3(NTHR), args, LDS_BYTES, stream);
    if (e != hipSuccess) fprintf(stderr, "cooperative launch failed: %s\n", hipGetErrorString(e));
#else
    (void)hipFuncSetAttribute((const void*)mega<false>, hipFuncAttributeMaxDynamicSharedMemorySize, LDS_BYTES);
    for (int ph = 0; ph < np; ++ph) { int ph0 = ph, ph1 = ph + 1; void* args[] = {PARAM_LIST(X) (void*)&ph0, (void*)&ph1};
        hipError_t e = hipLaunchKernel((const void*)mega<false>, dim3(NBLK), dim3(NTHR), args, LDS_BYTES, stream);
        if (e != hipSuccess) fprintf(stderr, "launch failed: %s\n", hipGetErrorString(e)); }
#endif
#undef X
}
```

```cpp
#include <hip/hip_runtime.h>
#include <hip/hip_cooperative_groups.h>
#include <cstdint>
#include <cstdio>
#include <cstring>
namespace cg = cooperative_groups;

typedef unsigned short bf16_t;
typedef short bf16x8 __attribute__((ext_vector_type(8)));
typedef short s16x4 __attribute__((ext_vector_type(4)));
typedef float f32x4 __attribute__((ext_vector_type(4)));
typedef float f32x2 __attribute__((ext_vector_type(2)));
typedef unsigned u32x4 __attribute__((ext_vector_type(4)));
typedef unsigned u32x2 __attribute__((ext_vector_type(2)));
#define LAS __attribute__((address_space(3)))
#define DEV __device__ __forceinline__

constexpr int T = 16384, D = 1024, DEPTH = 4;
constexpr int NTHR = 512, NBLK = 256;
constexpr int LDS_BYTES = 155648;
constexpr float ALPHA = 1.681792830507429f;
constexpr float LN_EPS = 1e-5f;
constexpr int MOE_ROWS = 40960;

DEV int tid_() { int t = threadIdx.x; asm volatile("" : "+v"(t)); return t; }
DEV int bid_() { int b = blockIdx.x; asm volatile("" : "+s"(b)); return b; }
#define NB_ 256
DEV unsigned f2bf(float f) { unsigned u = __float_as_uint(f); u += 0x7FFFu + ((u >> 16) & 1u); return u >> 16; }
DEV float bf2f(unsigned short b) { return __uint_as_float(((unsigned)b) << 16); }
typedef __bf16 bf16n2 __attribute__((ext_vector_type(2)));
DEV unsigned pk2(float lo, float hi) { f32x2 v = {lo, hi}; bf16n2 b = __builtin_convertvector(v, bf16n2); return __builtin_bit_cast(unsigned, b); }
DEV float bflo(unsigned u) { return __uint_as_float(u << 16); }
DEV float bfhi(unsigned u) { return __uint_as_float(u & 0xFFFF0000u); }
DEV float sigmoidf_(float x) { return 1.0f / (1.0f + __expf(-x)); }
DEV float siluf_(float x) { return x / (1.0f + __expf(-x)); }
DEV float softplusf_(float x) { return fmaxf(x, 0.f) + __logf(1.0f + __expf(-fabsf(x))); }
DEV float tanhf_(float x) { const float e = __expf(-2.0f * fabsf(x)); const float r = (1.0f - e) / (1.0f + e); return x < 0.f ? -r : r; }
DEV float wave_sum(float v) {
#pragma unroll
    for (int o = 32; o > 0; o >>= 1) v += __shfl_xor(v, o);
    return v;
}
DEV float sum16(float v) {
#pragma unroll
    for (int o = 8; o > 0; o >>= 1) v += __shfl_xor(v, o);
    return v;
}
template <int N> DEV float reduce_scatter(float (&v)[N], int lane) {
    int s = 1;
#pragma unroll
    for (int h = N / 2; h >= 1; h >>= 1) {
#pragma unroll
        for (int i = 0; i < h; ++i) {
            const bool up = (lane & s) != 0;
            const float send = up ? v[i] : v[i + h];
            const float keep = up ? v[i + h] : v[i];
            v[i] = keep + __shfl_xor(send, s);
        }
        s <<= 1;
    }
    float r = v[0];
    for (; s < 64; s <<= 1) r += __shfl_xor(r, s);
    return r;
}
template <int N> DEV int rs_index(int lane) {
    int o = 0, s = 1;
#pragma unroll
    for (int h = N / 2; h >= 1; h >>= 1) { if (lane & s) o += h; s <<= 1; }
    return o;
}

DEV bf16x8 frag_rm(const LAS bf16_t* base, int ld, int row0, int k0, int lane) {
    return *(const LAS bf16x8*)(base + (row0 + (lane & 15)) * ld + k0 + 8 * (lane >> 4));
}
DEV bf16x8 frag_tr(const LAS bf16_t* base, int ld, int k0, int c0, int lane) {
    const int g = lane >> 4, i = lane & 15, q = i >> 2, p = i & 3;
    const LAS bf16_t* a = base + (k0 + 8 * g + q) * ld + c0 + 4 * p;
    s16x4 lo = __builtin_amdgcn_ds_read_tr16_b64_v4i16((LAS s16x4*)a);
    s16x4 hi = __builtin_amdgcn_ds_read_tr16_b64_v4i16((LAS s16x4*)(a + 4 * ld));
    bf16x8 r; r[0] = lo[0]; r[1] = lo[1]; r[2] = lo[2]; r[3] = lo[3]; r[4] = hi[0]; r[5] = hi[1]; r[6] = hi[2]; r[7] = hi[3];
    return r;
}
#define MFMA16(a, b, c) __builtin_amdgcn_mfma_f32_16x16x32_bf16((a), (b), (c), 0, 0, 0)
DEV size_t fragmajor_off(int n, int k, int K) { return ((size_t)((n >> 4) * (K >> 5) + (k >> 5)) * 64 + (n & 15) + 16 * ((k & 31) >> 3)) * 8 + (k & 7); }

template <int N> DEV void skinny_group(const f32x4 (&z)[4], const LAS float* wt, int lane, LAS float* outw) {
    float pe[N];
#pragma unroll
    for (int o = 0; o < N; ++o) {
        float a = 0.f;
#pragma unroll
        for (int q = 0; q < 4; ++q) { const f32x4 w = *(const LAS f32x4*)(wt + o * 1028 + 256 * q + 4 * lane); a += z[q][0] * w[0] + z[q][1] * w[1] + z[q][2] * w[2] + z[q][3] * w[3]; }
        pe[o] = a;
    }
    const float r = reduce_scatter<N>(pe, lane);
    if (lane < N) outw[rs_index<N>(lane)] = r;
}
#ifndef SINGLE_LAUNCH
#define SINGLE_LAUNCH 1
#endif
struct ConvJob {
    const float* src; bf16_t* dst;
    int K, N, src_ld, Kpad, Npad, perm, batch;
    long long src_bs, dst_bs;
    DEV int ntiles() const { return (Kpad / 64) * (Npad / 64) * batch; }
};
constexpr int NJOBS = 14;

#define PARAM_LIST(X) \
    X(const float*, x) X(const float*, ln_g) X(const float*, ln_b) \
    X(const float*, rw_mu) X(const float*, rw_w_rkv) X(const float*, rw_w0) X(const float*, rw_w1) X(const float*, rw_w2) X(const float*, rw_a0) X(const float*, rw_a1) X(const float*, rw_a2) \
    X(const float*, rw_g1) X(const float*, rw_g2) X(const float*, rw_k_k) X(const float*, rw_k_a) X(const float*, rw_r_k) X(const float*, rw_lnx_g) X(const float*, rw_lnx_b) X(const float*, rw_w_o) \
    X(const float*, mb_w_in) X(const float*, mb_conv_w) X(const float*, mb_conv_b) X(const float*, mb_dt_bias) X(const float*, mb_a_log) X(const float*, mb_d) X(const float*, mb_norm_g) X(const float*, mb_w_out) \
    X(const float*, gl_w_in) X(const float*, gl_gk_w2) X(const float*, gl_gk_b) X(const float*, gl_norm_g) X(const float*, gl_w_out) \
    X(const float*, moe_w_group) X(const float*, moe_b_group) X(const float*, moe_w_route) X(const float*, moe_b_route) X(const float*, moe_w_in) X(const float*, moe_w_down) \
    X(float*, out) \
    X(bf16_t*, rw_rkv_t) X(bf16_t*, rw_w1_t) X(bf16_t*, rw_a1_t) X(bf16_t*, rw_g1_t) X(bf16_t*, rw_w2_t) X(bf16_t*, rw_a2_t) X(bf16_t*, rw_g2_t) X(bf16_t*, rw_wo_t) \
    X(bf16_t*, mb_win_t) X(bf16_t*, mb_wout_t) X(bf16_t*, gl_win_t) X(bf16_t*, gl_wout_t) X(bf16_t*, moe_w1_t) X(bf16_t*, moe_w2_t) \
    X(float*, H) X(float*, H1) X(float*, MIX) X(bf16_t*, X6) X(float*, Rr) X(float*, Kk) X(float*, Vv) X(bf16_t*, LW) X(float*, Wd) X(float*, Aa) X(float*, Gg) \
    X(float*, P2) X(float*, P3) X(float*, P4) X(float*, P5) X(float*, C1) X(float*, C2) X(float*, BC) X(float*, Y) X(bf16_t*, YB) \
    X(bf16_t*, Z) X(bf16_t*, XBC) X(bf16_t*, XC) X(float*, DT) X(float*, STATES) X(float*, CD) X(bf16_t*, PREV) X(bf16_t*, QKVG) X(float*, LA) X(float*, CDG) \
    X(bf16_t*, BUF) X(bf16_t*, ACT) X(bf16_t*, YBUF) X(int*, CNT) X(int*, EIDX) X(float*, GATE) X(int*, DEST) X(int*, TAB) X(unsigned*, bar) \
    X(bf16_t*, RWf) X(bf16_t*, RBf) X(bf16_t*, RUt) X(bf16_t*, RNa) X(float*, RGc) X(bf16_t*, RUa) X(bf16_t*, RS0)
struct Params {
#define X(t, n) t n;
    PARAM_LIST(X)
#undef X
};

enum Op : unsigned char { OP_CONVERT = 0, OP_RW_MIX, OP_RW_GEMM1, OP_RW_GEMM2, OP_RW_PREP, OP_RW_CHA, OP_RW_CHB, OP_RW_CHC, OP_RW_OUT,
    OP_LN1, OP_MOE_SCATTER, OP_MOE_GEMM1, OP_MOE_GEMM2, OP_LN2,
    OP_MB_CAST, OP_MB_GEMM_IN, OP_MB_CONV, OP_MB_STATES, OP_MB_SCAN, OP_MB_OUT, OP_MB_GEMM_OUT,
    OP_GL_CAST, OP_GL_GEMM_IN, OP_GL_KV, OP_GL_SCAN, OP_GL_OUT, OP_GL_GEMM_OUT };


DEV ConvJob make_job(const Params& p, int q) {
    const long long DD = (long long)D * D;
    switch (q) {
    case 0: return ConvJob{p.rw_w_rkv, p.rw_rkv_t, 1024, 1024, 1024, 1024, 1024, 0, 6, DD, DD};
    case 1: return ConvJob{p.rw_w1, p.rw_w1_t, 1024, 64, 64, 1024, 256, 0, 2, (long long)D * 64, (long long)256 * D};
    case 2: return ConvJob{p.rw_a1, p.rw_a1_t, 1024, 64, 64, 1024, 256, 0, 2, (long long)D * 64, (long long)256 * D};
    case 3: return ConvJob{p.rw_g1, p.rw_g1_t, 1024, 160, 160, 1024, 256, 0, 2, (long long)D * 160, (long long)256 * D};
    case 4: return ConvJob{p.rw_w2, p.rw_w2_t, 64, 1024, 1024, 256, 1024, 0, 2, (long long)64 * D, (long long)D * 256};
    case 5: return ConvJob{p.rw_a2, p.rw_a2_t, 64, 1024, 1024, 256, 1024, 0, 2, (long long)64 * D, (long long)D * 256};
    case 6: return ConvJob{p.rw_g2, p.rw_g2_t, 160, 1024, 1024, 256, 1024, 0, 2, (long long)160 * D, (long long)D * 256};
    case 7: return ConvJob{p.rw_w_o, p.rw_wo_t, 1024, 1024, 1024, 1024, 1024, 0, 2, DD, DD};
    case 8: return ConvJob{p.mb_w_in, p.mb_win_t, 1024, 5120, 5152, 1024, 5120, 0, 1, 0, 0};
    case 9: return ConvJob{p.mb_w_out, p.mb_wout_t, 2048, 1024, 1024, 2048, 1024, 0, 1, 0, 0};
    case 10: return ConvJob{p.gl_w_in, p.gl_win_t, 1024, 3072, 3088, 1024, 3072, 0, 1, 0, 0};
    case 11: return ConvJob{p.gl_w_out, p.gl_wout_t, 1024, 1024, 1024, 1024, 1024, 0, 1, 0, 0};
    case 12: return ConvJob{p.moe_w_in, p.moe_w1_t, 1024, 1024, 1024, 1024, 1024, 1, 128, DD, DD};
    default: return ConvJob{p.moe_w_down, p.moe_w2_t, 512, 1024, 1024, 512, 1024, 0, 128, (long long)512 * 1024, (long long)1024 * 512};
    }
}

DEV void phase_convert(const Params& p, LAS unsigned char* lds) {
    const int tid = tid_(), bid = bid_(); (void)tid; (void)bid;
    LAS bf16_t* tile = (LAS bf16_t*)lds;
    int tbeg = 0;
#pragma unroll
    for (int j = 0; j < NJOBS; ++j) {
      const ConvJob J = make_job(p, j);
      const int jend = tbeg + J.ntiles();
      const int ti0 = tbeg + (((int)bid - tbeg) % NB_ + NB_) % NB_;
      const int jbeg = tbeg; tbeg = jend;
#pragma unroll 1
      for (int ti = ti0; ti < jend; ti += NB_) {
        int local = ti - jbeg;
        const int tk = J.Kpad / 64, tn = J.Npad / 64;
        const int b = local / (tk * tn); local -= b * tk * tn;
        const int nt = local / tk, kt = local - nt * tk;
        const float* src = J.src + (size_t)b * J.src_bs;
        bf16_t* dst = J.dst + (size_t)b * J.dst_bs;
        const int k0 = kt * 64, n0 = nt * 64;
#pragma unroll
        for (int pass = 0; pass < 2; ++pass) {
            const int kk = (tid >> 4) + pass * 32, nn = (tid & 15) * 4;
            f32x4 v = {0.f, 0.f, 0.f, 0.f};
            if (k0 + kk < J.K && n0 + nn < J.N) v = *(const f32x4*)(src + (size_t)(k0 + kk) * J.src_ld + n0 + nn);
#pragma unroll
            for (int e = 0; e < 4; ++e) tile[(nn + e) * 72 + kk] = (bf16_t)f2bf(v[e]);
        }
        __syncthreads();
        {
            const int nn = tid >> 3, kc = (tid & 7) * 8;
            int nsrc = n0 + nn, ndst = nsrc;
            if (J.perm == 1) { const int up = nsrc >= 512, jj = nsrc - (up ? 512 : 0); ndst = (jj >> 7) * 256 + (up ? 128 : 0) + (jj & 127); }
            const u32x4 v = *(const LAS u32x4*)(tile + nn * 72 + kc);
            *(u32x4*)(dst + (size_t)ndst * J.Kpad + k0 + kc) = v;
        }
        __syncthreads();
      }
    }
}
namespace pg8 {
constexpr int BM = 256, BK = 64, HALF = 128, HTB = HALF * BK * 2, STAGE_BYTES = 8 * HTB;
DEV int lds_byte(int r, int c) { const int st = (r >> 4) * 2 + (c >> 5), rr = r & 15, cc = c & 31, ob = rr * 64 + cc * 2; return st * 1024 + (ob ^ (((ob >> 9) & 1) << 5)); }
DEV void stage_rc(int b, int& R, int& C) { const int st = b / 1024, sb = b % 1024, swz = sb ^ (((sb >> 9) & 1) << 5); R = (st >> 1) * 16 + swz / 64; C = (st & 1) * 32 + (swz % 64) / 2; }

struct Unit { const char* A; const char* B; int row0, col0, id, aux; };

DEV bool tile_order(int i, int G, int c, int nM, int nN, int& pm, int& pn) {
    const int nwg = nM * nN; const long L = (long)i * G + c; if (L >= nwg) return false;
    int wgid = (int)L; { const int q = nwg / 8, r = nwg % 8, xcd = wgid % 8, off = wgid / 8; wgid = (xcd < r ? xcd * (q + 1) : r * (q + 1) + (xcd - r) * q) + off; }
    const int nig = 8 * nN, gid = wgid / nig, fm = gid * 8, gsz = (nM - fm) < 8 ? (nM - fm) : 8;
    pm = fm + ((wgid % nig) % gsz); pn = (wgid % nig) / gsz; return true;
}

template <class Epi, class Sched>
DEV void gemm_phase(LAS unsigned char* lds, const int K, const Sched& S, const Epi& E) {
    const int tid = tid_(), wid = __builtin_amdgcn_readfirstlane(tid >> 6), lane = tid & 63, wr = wid >> 2, wc = wid & 3, fr = lane & 15, fq = lane >> 4;
    const int nt = K / BK;
    unsigned voff[2];
#pragma unroll
    for (int i = 0; i < 2; ++i) { int R, C; stage_rc(tid * 16 + i * 8192, R, C); voff[i] = (unsigned)(R * K + C) * 2u; }
    const size_t kstep = (size_t)(BK * 2);
    const size_t hstep = (size_t)HALF * K * 2;
    const unsigned ldsw = (unsigned)wid * 1024u;
    const int aoff = lds_byte(wr * 64 + fr, fq * 8), boff = lds_byte(wc * 32 + fr, fq * 8);
#define PG8_SA(b, h) (((b) * 2 + (h)) * HTB)
#define PG8_SB(b, h) ((4 + (b) * 2 + (h)) * HTB)
#define PG8_STAGE(bufoff, gbase) do { _Pragma("unroll") for (int _i = 0; _i < 2; ++_i) \
        __builtin_amdgcn_global_load_lds((const unsigned*)((const char*)(gbase) + voff[_i]), (LAS unsigned*)(lds + (bufoff) + ldsw + _i * 8192), 16, 0, 0); } while (0)
#define PG8_LDA(dst, b, h) do { _Pragma("unroll") for (int m = 0; m < 4; ++m) _Pragma("unroll") for (int k = 0; k < 2; ++k) dst[m][k] = *(const LAS bf16x8*)(lds + PG8_SA(b, h) + aoff + m * 2048 + k * 1024); } while (0)
#define PG8_LDB(dst, b, h) do { _Pragma("unroll") for (int n = 0; n < 2; ++n) _Pragma("unroll") for (int k = 0; k < 2; ++k) dst[n][k] = *(const LAS bf16x8*)(lds + PG8_SB(b, h) + boff + n * 2048 + k * 1024); } while (0)
#define PG8_MMA(ai, bj, At, Bt) do { __builtin_amdgcn_s_setprio(1); _Pragma("unroll") for (int m = 0; m < 4; ++m) _Pragma("unroll") for (int n = 0; n < 2; ++n) _Pragma("unroll") for (int k = 0; k < 2; ++k) \
        acc[ai][bj][m][n] = __builtin_amdgcn_mfma_f32_16x16x32_bf16(Bt[n][k], At[m][k], acc[ai][bj][m][n], 0, 0, 0); __builtin_amdgcn_s_setprio(0); } while (0)
#define PG8_WAIT_V(n) asm volatile("s_waitcnt vmcnt(" #n ")" ::: "memory")
#define PG8_WAIT_L(n) asm volatile("s_waitcnt lgkmcnt(" #n ")" ::: "memory")
#define PG8_BAR __builtin_amdgcn_s_barrier()
#define PG8_SCHED __builtin_amdgcn_sched_barrier(0)
    Unit cur, nxt; int ui = 0;
    if (!S.next(0, cur)) return;
    f32x4 acc[2][2][4][2];
#pragma unroll
    for (int a = 0; a < 2; ++a)
#pragma unroll
        for (int b = 0; b < 2; ++b)
#pragma unroll
            for (int m = 0; m < 4; ++m)
#pragma unroll
                for (int n = 0; n < 2; ++n) acc[a][b][m][n] = (f32x4){0.f, 0.f, 0.f, 0.f};
    bf16x8 At[4][2], B0[2][2], B1[2][2];
    const char* cA = cur.A; const char* cB = cur.B;
    PG8_STAGE(PG8_SB(0, 0), cB); PG8_STAGE(PG8_SA(0, 0), cA); PG8_STAGE(PG8_SB(0, 1), cB + hstep); PG8_STAGE(PG8_SA(0, 1), cA + hstep);
    if (wr == 1) PG8_BAR;
    PG8_WAIT_V(4); PG8_BAR;
    PG8_STAGE(PG8_SB(1, 0), cB + kstep); PG8_STAGE(PG8_SA(1, 0), cA + kstep); PG8_STAGE(PG8_SB(1, 1), cB + hstep + kstep);
    PG8_WAIT_V(6); PG8_BAR;
    for (;;) {
        const bool has_next = S.next(ui + 1, nxt);
        const char* nA = has_next ? nxt.A : cA; const char* nB = has_next ? nxt.B : cB;
#pragma unroll 1
        for (int t = 0; t < nt; t += 2) {
            const bool last = (t == nt - 2);
            const char* a1 = cA + (size_t)(t + 1) * kstep;
            const char* a2 = last ? nA : cA + (size_t)(t + 2) * kstep; const char* b2 = last ? nB : cB + (size_t)(t + 2) * kstep;
            const char* a3 = a2 + kstep; const char* b3 = b2 + kstep;
            PG8_LDB(B0, 0, 0); PG8_SCHED; PG8_LDA(At, 0, 0); PG8_STAGE(PG8_SA(1, 1), a1 + hstep);
            PG8_WAIT_L(8); PG8_BAR; PG8_WAIT_L(0); PG8_MMA(0, 0, At, B0); PG8_BAR; PG8_SCHED;
            PG8_LDB(B1, 0, 1); PG8_STAGE(PG8_SB(0, 0), b2);
            PG8_BAR; PG8_WAIT_L(0); PG8_MMA(0, 1, At, B1); PG8_BAR;
            PG8_LDA(At, 0, 1); PG8_STAGE(PG8_SA(0, 0), a2);
            PG8_BAR; PG8_WAIT_L(0); PG8_MMA(1, 0, At, B0); PG8_BAR; PG8_SCHED;
            PG8_STAGE(PG8_SB(0, 1), b2 + hstep);
            PG8_WAIT_V(6); PG8_BAR; PG8_MMA(1, 1, At, B1); PG8_BAR;
            PG8_LDB(B0, 1, 0); PG8_SCHED; PG8_LDA(At, 1, 0); PG8_STAGE(PG8_SA(0, 1), a2 + hstep);
            PG8_WAIT_L(8); PG8_BAR; PG8_WAIT_L(0); PG8_MMA(0, 0, At, B0); PG8_BAR; PG8_SCHED;
            PG8_LDB(B1, 1, 1); PG8_STAGE(PG8_SB(1, 0), b3);
            PG8_BAR; PG8_WAIT_L(0); PG8_MMA(0, 1, At, B1); PG8_BAR;
            PG8_LDA(At, 1, 1); PG8_STAGE(PG8_SA(1, 0), a3);
            PG8_BAR; PG8_WAIT_L(0); PG8_MMA(1, 0, At, B0); PG8_BAR; PG8_SCHED;
            PG8_STAGE(PG8_SB(1, 1), b3 + hstep);
            PG8_WAIT_V(6); PG8_BAR; PG8_MMA(1, 1, At, B1); PG8_BAR;
        }
        E(acc, cur, wr, wc, fr, fq);
        if (!has_next) break;
#pragma unroll
        for (int a = 0; a < 2; ++a)
#pragma unroll
            for (int b = 0; b < 2; ++b)
#pragma unroll
                for (int m = 0; m < 4; ++m)
#pragma unroll
                    for (int n = 0; n < 2; ++n) acc[a][b][m][n] = (f32x4){0.f, 0.f, 0.f, 0.f};
        cur = nxt; cA = nA; cB = nB; ++ui;
    }
    PG8_WAIT_V(0);
    if (wr == 0) PG8_BAR;
    PG8_BAR;
#undef PG8_SA
#undef PG8_SB
#undef PG8_STAGE
#undef PG8_LDA
#undef PG8_LDB
#undef PG8_MMA
#undef PG8_WAIT_V
#undef PG8_WAIT_L
#undef PG8_BAR
#undef PG8_SCHED
}
}
using pg8::Unit;
typedef f32x4 AccT[2][2][4][2];
#define FOR_ACC(ai, bj, m, n) _Pragma("unroll") for (int ai = 0; ai < 2; ++ai) _Pragma("unroll") for (int m = 0; m < 4; ++m) _Pragma("unroll") for (int bj = 0; bj < 2; ++bj) _Pragma("unroll") for (int n = 0; n < 2; ++n)
#define ACC_FENCE __builtin_amdgcn_sched_barrier(0)
#define ACC_ROW(u, ai, m) ((u).row0 + 128 * (ai) + 64 * wr + 16 * (m) + fr)
#define ACC_COL(u, bj, n) ((u).col0 + 128 * (bj) + 32 * wc + 16 * (n) + 4 * fq)
DEV void st_bf4(bf16_t* p, f32x4 v) { u32x2 w; w.x = pk2(v[0], v[1]); w.y = pk2(v[2], v[3]); *(u32x2*)p = w; }
DEV void load_row(const float* p, int lane, f32x4 (&v)[4]) {
#pragma unroll
    for (int q = 0; q < 4; ++q) v[q] = *(const f32x4*)(p + 256 * q + 4 * lane);
}

DEV void phase_rw_mix(const Params& p, int j, const float* hin) {
    const int tid = tid_(), bid = bid_(); (void)tid; (void)bid;
    const int lane = tid & 63, wid = tid >> 6;
    const float* mu = p.rw_mu + (size_t)j * 6 * D;
    for (int r = 0; r < 8; ++r) {
        const int t = bid * 64 + wid * 8 + r;
        f32x4 x[4], xp[4];
        load_row(hin + (size_t)t * D, lane, x);
        if (t > 0) load_row(hin + (size_t)(t - 1) * D, lane, xp);
        else { for (int q = 0; q < 4; ++q) xp[q] = (f32x4){0.f, 0.f, 0.f, 0.f}; }
#pragma unroll
        for (int s = 0; s < 6; ++s) {
#pragma unroll
            for (int q = 0; q < 4; ++q) {
                const f32x4 m = *(const f32x4*)(mu + s * D + 256 * q + 4 * lane);
                const f32x4 o = x[q] + (xp[q] - x[q]) * m;
                st_bf4(p.X6 + (size_t)s * T * D + (size_t)t * D + 256 * q + 4 * lane, o);
            }
        }
    }
}

struct SchedRW1 {
    const Params* p; int j;
    DEV bool next(int i, Unit& u) const {
        int pm, pn; if (!pg8::tile_order(i, NB_, bid_(), 64, 15, pm, pn)) return false;
        int id, lpn; if (pn < 12) { id = pn >> 2; lpn = pn & 3; } else { id = 3 + (pn - 12); lpn = 0; }
        u.A = (const char*)(p->X6 + (size_t)id * T * D + (size_t)pm * 256 * D);
        const bf16_t* B;
        if (id < 3) B = p->rw_rkv_t + ((size_t)j * 3 + id) * D * D + (size_t)lpn * 256 * D;
        else B = p->rw_w1_t + (size_t)(id - 3) * (2 * 256 * D) + (size_t)j * 256 * D;
        u.B = (const char*)B; u.row0 = pm * 256; u.col0 = lpn * 256; u.id = id; u.aux = 0; return true;
    }
};
struct EpiRW1 {
    const Params* p;
    DEV void operator()(const AccT& acc, const Unit& u, int wr, int wc, int fr, int fq) const {
        if (u.id < 3) {
            float* O = p->Rr + (size_t)u.id * T * D;
            FOR_ACC(ai, bj, m, n) *(f32x4*)(O + (size_t)ACC_ROW(u, ai, m) * D + ACC_COL(u, bj, n)) = acc[ai][bj][m][n];
        } else {
            bf16_t* O = p->LW + (size_t)(u.id - 3) * T * 256;
            FOR_ACC(ai, bj, m, n) {
                f32x4 v = acc[ai][bj][m][n];
                if (u.id == 3) { for (int e = 0; e < 4; ++e) v[e] = tanhf_(v[e]); }
                else if (u.id == 5) { for (int e = 0; e < 4; ++e) v[e] = sigmoidf_(v[e]); }
                st_bf4(O + (size_t)ACC_ROW(u, ai, m) * 256 + ACC_COL(u, bj, n), v); ACC_FENCE;
            }
        }
    }
};
struct SchedRW2 {
    const Params* p; int j;
    DEV bool next(int i, Unit& u) const {
        int pm, pn; if (!pg8::tile_order(i, NB_, bid_(), 64, 12, pm, pn)) return false;
        const int id = pn >> 2, lpn = pn & 3;
        u.A = (const char*)(p->LW + (size_t)id * T * 256 + (size_t)pm * 256 * 256);
        const bf16_t* B = p->rw_w2_t + (size_t)id * (2 * D * 256) + (size_t)j * D * 256 + (size_t)lpn * 256 * 256;
        u.B = (const char*)B; u.row0 = pm * 256; u.col0 = lpn * 256; u.id = id; u.aux = 0; return true;
    }
};
struct EpiRW2 {
    const Params* p; int j;
    DEV void operator()(const AccT& acc, const Unit& u, int wr, int wc, int fr, int fq) const {
        if (u.id == 0) { const float* bias = p->rw_w0 + (size_t)j * D;
            FOR_ACC(ai, bj, m, n) { f32x4 v = acc[ai][bj][m][n]; const int c = ACC_COL(u, bj, n); const f32x4 b = *(const f32x4*)(bias + c);
                for (int e = 0; e < 4; ++e) { const float x = -(b[e] + v[e]); const float wl = -(fmaxf(x, 0.f) + __logf(1.0f + __expf(-fabsf(x)))) - 0.5f; v[e] = -__expf(wl); }
                *(f32x4*)(p->Wd + (size_t)ACC_ROW(u, ai, m) * D + c) = v; ACC_FENCE; } }
        else if (u.id == 1) { const float* bias = p->rw_a0 + (size_t)j * D;
            FOR_ACC(ai, bj, m, n) { f32x4 v = acc[ai][bj][m][n]; const int c = ACC_COL(u, bj, n); const f32x4 b = *(const f32x4*)(bias + c);
                for (int e = 0; e < 4; ++e) v[e] = sigmoidf_(b[e] + v[e]);
                *(f32x4*)(p->Aa + (size_t)ACC_ROW(u, ai, m) * D + c) = v; ACC_FENCE; } }
        else { FOR_ACC(ai, bj, m, n) *(f32x4*)(p->Gg + (size_t)ACC_ROW(u, ai, m) * D + ACC_COL(u, bj, n)) = acc[ai][bj][m][n]; }
    }
};

DEV void phase_rw_prep(const Params& p, int j) {
    const int tid = tid_(), bid = bid_(); (void)tid; (void)bid;
    const int lane = tid & 63, wid = tid >> 6;
    const float* k_k = p.rw_k_k + (size_t)j * D; const float* k_a = p.rw_k_a + (size_t)j * D; const float* r_k = p.rw_r_k + (size_t)j * D;
    for (int rr = 0; rr < 8; ++rr) {
        const int t = bid * 64 + wid * 8 + rr; const size_t ro = (size_t)t * D;
#pragma unroll
        for (int q = 0; q < 4; ++q) {
            const int c = 256 * q + 4 * lane; const int head = 4 * q + (lane >> 4);
            const f32x4 r = *(const f32x4*)(p.Rr + ro + c), k = *(const f32x4*)(p.Kk + ro + c), a = *(const f32x4*)(p.Aa + ro + c);
            const f32x4 kkw = *(const f32x4*)(k_k + c), kaw = *(const f32x4*)(k_a + c), rkw = *(const f32x4*)(r_k + c);
            f32x4 kk = k * kkw;
            float ss = kk[0] * kk[0] + kk[1] * kk[1] + kk[2] * kk[2] + kk[3] * kk[3];
            ss = sum16(ss);
            const float inv = 1.0f / fmaxf(sqrtf(ss), 1e-12f);
            kk = kk * inv;
            const f32x4 b = kk * a;
            f32x4 kh; for (int e = 0; e < 4; ++e) kh[e] = k[e] * (1.0f + (a[e] - 1.0f) * kaw[e]);
            float bc = r[0] * kh[0] * rkw[0] + r[1] * kh[1] * rkw[1] + r[2] * kh[2] * rkw[2] + r[3] * kh[3] * rkw[3];
            bc = sum16(bc);
            *(f32x4*)(p.P2 + ro + c) = -kk; *(f32x4*)(p.P3 + ro + c) = b; *(f32x4*)(p.P4 + ro + c) = kh;
            if ((lane & 15) == 0) p.BC[(size_t)t * 16 + head] = bc;
        }
    }
}

struct SchedOut {
    const bf16_t* A; const bf16_t* Bt; int K;
    DEV bool next(int i, Unit& u) const {
        int pm, pn; if (!pg8::tile_order(i, NB_, bid_(), 64, 4, pm, pn)) return false;
        u.A = (const char*)(A + (size_t)pm * 256 * K); u.B = (const char*)(Bt + (size_t)pn * 256 * K); u.row0 = pm * 256; u.col0 = pn * 256; u.id = 0; u.aux = 0; return true;
    }
};
struct EpiOut {
    float* O;
    DEV void operator()(const AccT& acc, const Unit& u, int wr, int wc, int fr, int fq) const {
        FOR_ACC(ai, bj, m, n) *(f32x4*)(O + (size_t)ACC_ROW(u, ai, m) * D + ACC_COL(u, bj, n)) = acc[ai][bj][m][n];
    }
};
constexpr int RC_LD = 72;
#ifdef DBG
#define DBGF(cond, bit) do { if (cond) atomicOr(&p.TAB[200], (bit)); } while (0)
#else
#define DBGF(cond, bit) do {} while (0)
#endif
DEV bool bad_(float x) { return !(fabsf(x) < 1e30f); }
DEV int rc_pi(int g, int j) { return j < 4 ? 4 * g + j : 16 + 4 * g + (j - 4); }

DEV void rc_cum(const Params& p, int t0, int cb, LAS float* cum, LAS float* seg) {
    const int tid = tid_(); const int k = tid & 63, sg = tid >> 6;
    float v[8]; float s = 0.f;
#pragma unroll
    for (int i = 0; i < 8; ++i) { s += p.Wd[(size_t)(t0 + sg * 8 + i) * D + cb + k]; v[i] = s; }
    seg[sg * 64 + k] = s;
    __syncthreads();
    float off = 0.f;
#pragma unroll
    for (int q = 0; q < 8; ++q) off += (q < sg) ? seg[q * 64 + k] : 0.f;
#pragma unroll
    for (int i = 0; i < 8; ++i) cum[(sg * 8 + i) * 64 + k] = v[i] + off;
    __syncthreads();
}
DEV void ld8(const float* p, float (&f)[8]) { const f32x4 a = *(const f32x4*)p, b = *(const f32x4*)(p + 4); f[0] = a[0]; f[1] = a[1]; f[2] = a[2]; f[3] = a[3]; f[4] = b[0]; f[5] = b[1]; f[6] = b[2]; f[7] = b[3]; }
DEV void lds8(const LAS float* p, float (&f)[8]) { const f32x4 a = *(const LAS f32x4*)p, b = *(const LAS f32x4*)(p + 4); f[0] = a[0]; f[1] = a[1]; f[2] = a[2]; f[3] = a[3]; f[4] = b[0]; f[5] = b[1]; f[6] = b[2]; f[7] = b[3]; }
DEV u32x4 pk8(const float (&f)[8]) { u32x4 o; o.x = pk2(f[0], f[1]); o.y = pk2(f[2], f[3]); o.z = pk2(f[4], f[5]); o.w = pk2(f[6], f[7]); return o; }

DEV void phase_rw_cha(const Params& p, LAS unsigned char* lds) {
    const int tid = tid_(), bid = bid_(); const int lane = tid & 63, w = tid >> 6; const int fr = lane & 15, fq = lane >> 4;
    LAS float* cum = (LAS float*)lds;
    LAS float* seg = cum + 64 * 64;
    LAS float* Aab = seg + 8 * 64;
    LAS bf16_t* As = (LAS bf16_t*)(Aab + 64 * 68);
    LAS bf16_t* Bs = As + 64 * RC_LD; LAS bf16_t* Ks = Bs + 64 * RC_LD; LAS bf16_t* Vs = Ks + 64 * RC_LD; LAS bf16_t* Ke = Vs + 64 * RC_LD;
    LAS bf16_t* Aak = Ke + 64 * RC_LD; LAS bf16_t* Ts = Aak + 64 * RC_LD; LAS bf16_t* X1 = Ts + 64 * RC_LD;
    for (int u = bid; u < 4096; u += NB_) {
        const int c = u >> 4, h = u & 15; const int t0 = c * 64, cb = h * 64; const size_t ub = (size_t)c * 16 + h;
        __syncthreads();
        rc_cum(p, t0, cb, cum, seg);
        {
            const int t = tid >> 3, k8 = (tid & 7) * 8; const size_t go = (size_t)(t0 + t) * D + cb + k8;
            float a[8], b[8], kh[8], v[8], ct[8], cp[8], ce[8];
            ld8(p.P2 + go, a); ld8(p.P3 + go, b); ld8(p.P4 + go, kh); ld8(p.Vv + go, v);
            lds8(cum + t * 64 + k8, ct); lds8(cum + 63 * 64 + k8, ce);
            if (t > 0) lds8(cum + (t - 1) * 64 + k8, cp); else { for (int e = 0; e < 8; ++e) cp[e] = 0.f; }
            float at[8], bt[8], kt[8], be[8], ke[8];
#pragma unroll
            for (int e = 0; e < 8; ++e) { const float ei = __expf(-ct[e]), ee = __expf(ce[e] - ct[e]); at[e] = a[e] * __expf(cp[e]); bt[e] = b[e] * ei; kt[e] = kh[e] * ei; be[e] = b[e] * ee; ke[e] = kh[e] * ee; }
            *(LAS u32x4*)(As + t * RC_LD + k8) = pk8(at); *(LAS u32x4*)(Bs + t * RC_LD + k8) = pk8(bt); *(LAS u32x4*)(Ks + t * RC_LD + k8) = pk8(kt);
            *(LAS u32x4*)(Ke + t * RC_LD + k8) = pk8(ke); *(LAS u32x4*)(Vs + t * RC_LD + k8) = pk8(v);
            const int tq = t & 31, g = (tq & 15) >> 2, j = (tq & 3) + ((tq >> 4) << 2);
            bf16_t* bfp = p.RBf + ub * 4096;
#pragma unroll
            for (int e = 0; e < 8; ++e) { const int k = k8 + e; bfp[(((k >> 4) * 2 + (t >> 5)) * 64 + g * 16 + (k & 15)) * 8 + j] = (bf16_t)f2bf(be[e]); }
            if (t == 63) { float gm[8]; for (int e = 0; e < 8; ++e) gm[e] = __expf(ce[e]); *(f32x4*)(p.RGc + ub * 64 + k8) = (f32x4){gm[0], gm[1], gm[2], gm[3]}; *(f32x4*)(p.RGc + ub * 64 + k8 + 4) = (f32x4){gm[4], gm[5], gm[6], gm[7]}; }
        }
        __syncthreads();
        {
            const int tb = w >> 1;
#pragma unroll
            for (int ii = 0; ii < 2; ++ii) { const int ib = 2 * (w & 1) + ii;
                f32x4 ab = {0.f, 0.f, 0.f, 0.f}, ak = {0.f, 0.f, 0.f, 0.f};
                if (ib <= tb) {
#pragma unroll
                    for (int ks = 0; ks < 2; ++ks) { const bf16x8 af = frag_rm(As, RC_LD, 16 * tb, 32 * ks, lane);
                        ab = MFMA16(af, frag_rm(Bs, RC_LD, 16 * ib, 32 * ks, lane), ab); ak = MFMA16(af, frag_rm(Ks, RC_LD, 16 * ib, 32 * ks, lane), ak); } }
#pragma unroll
                for (int r = 0; r < 4; ++r) { const int t = 16 * tb + 4 * fq + r, i = 16 * ib + fr; const bool keep = i < t;
                    Aab[t * 68 + i] = keep ? ab[r] : 0.f; Aak[t * RC_LD + i] = (bf16_t)f2bf(keep ? ak[r] : 0.f); } }
        }
        __syncthreads();
        if (w == 0) {
            float Tc[64];
            Tc[0] = lane == 0 ? 1.f : 0.f;
#pragma unroll
            for (int t = 1; t < 64; ++t) {
                float acc = lane == t ? 1.f : 0.f;
#pragma unroll
                for (int i4 = 0; i4 < (t + 3) / 4; ++i4) { const f32x4 a4 = *(const LAS f32x4*)(Aab + t * 68 + i4 * 4);
#pragma unroll
                    for (int e = 0; e < 4; ++e) if (i4 * 4 + e < t) acc += a4[e] * Tc[i4 * 4 + e]; }
#ifdef DBG_TI
                Tc[t] = lane == t ? 1.f : 0.f; (void)acc;
#else
                Tc[t] = acc;
#endif
            }
#pragma unroll
            for (int t = 0; t < 64; ++t) Ts[t * RC_LD + lane] = (bf16_t)f2bf(Tc[t]);

        } else {
            for (int tl = w - 1; tl < 32; tl += 7) {
                const int rb = (tl & 15) >> 2, vbk = tl & 3; f32x4 acc = {0.f, 0.f, 0.f, 0.f};
                if (tl < 16) {
#pragma unroll
                    for (int ks = 0; ks < 2; ++ks) acc = MFMA16(frag_rm(Aak, RC_LD, 16 * rb, 32 * ks, lane), frag_tr(Vs, RC_LD, 32 * ks, 16 * vbk, lane), acc);
#pragma unroll
                    for (int r = 0; r < 4; ++r) X1[(16 * rb + 4 * fq + r) * RC_LD + 16 * vbk + fr] = (bf16_t)f2bf(acc[r]);
                } else {
#pragma unroll
                    for (int ks = 0; ks < 2; ++ks) acc = MFMA16(frag_tr(Ke, RC_LD, 32 * ks, 16 * rb, lane), frag_tr(Vs, RC_LD, 32 * ks, 16 * vbk, lane), acc);
                    { u32x2 o; o.x = pk2(acc[0], acc[1]); o.y = pk2(acc[2], acc[3]); *(u32x2*)(p.RNa + (((ub * 4 + vbk) * 4 + rb) * 64 + lane) * 4) = o; }
                }
            }
        }
        __syncthreads();
#pragma unroll
        for (int q = 0; q < 4; ++q) { const int tl = w * 4 + q; const int tt = (tl & 15) >> 2, cbk = tl & 3; f32x4 acc = {0.f, 0.f, 0.f, 0.f};
            if (tl < 16) {
#pragma unroll
                for (int ks = 0; ks < 2; ++ks) acc = MFMA16(frag_rm(Ts, RC_LD, 16 * tt, 32 * ks, lane), frag_tr(As, RC_LD, 32 * ks, 16 * cbk, lane), acc);
                const int k = 16 * cbk + fr, kq = k & 31, g = (kq & 15) >> 2, j = (kq & 3) + ((kq >> 4) << 2);
                bf16_t* wf = p.RWf + ub * 4096;
#pragma unroll
                for (int r = 0; r < 4; ++r) wf[((tt * 2 + (k >> 5)) * 64 + g * 16 + 4 * fq + r) * 8 + j] = (bf16_t)f2bf(acc[r]);
            } else {
#pragma unroll
                for (int ks = 0; ks < 2; ++ks) acc = MFMA16(frag_rm(Ts, RC_LD, 16 * tt, 32 * ks, lane), frag_tr(X1, RC_LD, 32 * ks, 16 * cbk, lane), acc);
                { u32x2 o; o.x = pk2(acc[0], acc[1]); o.y = pk2(acc[2], acc[3]); *(u32x2*)(p.RUt + (((ub * 4 + cbk) * 4 + tt) * 64 + lane) * 4) = o; }
            } }
    }
}

DEV void phase_rw_chb(const Params& p) {
    const int tid = tid_(), bid = bid_();
    if (bid >= 64 || tid >= 64) return;
    const int lane = tid; const int head = bid >> 2, vb = bid & 3; const int fq = lane >> 4;
    f32x4 s[4]; for (int i = 0; i < 4; ++i) s[i] = (f32x4){0.f, 0.f, 0.f, 0.f};
    struct In { bf16x8 wf[8], bf[8]; u32x2 ut[4], na[4]; f32x4 gc[4]; };
    auto load = [&](int c, In& I) {
        const size_t ub = (size_t)c * 16 + head;
#pragma unroll
        for (int f = 0; f < 8; ++f) { I.wf[f] = *(const bf16x8*)(p.RWf + ub * 4096 + (f * 64 + lane) * 8); I.bf[f] = *(const bf16x8*)(p.RBf + ub * 4096 + (f * 64 + lane) * 8); }
#pragma unroll
        for (int q = 0; q < 4; ++q) { I.ut[q] = *(const u32x2*)(p.RUt + (((ub * 4 + vb) * 4 + q) * 64 + lane) * 4); I.na[q] = *(const u32x2*)(p.RNa + (((ub * 4 + vb) * 4 + q) * 64 + lane) * 4);
            I.gc[q] = *(const f32x4*)(p.RGc + ub * 64 + 16 * q + 4 * fq); }
    };
    unsigned dbgm = 0; (void)dbgm;
    In cur, nxt; load(0, cur);
#pragma unroll 1
    for (int c = 0; c < 256; ++c) {
#ifdef DBG
        load(c, cur);
#else
        if (c + 1 < 256) load(c + 1, nxt); else nxt = cur;
#endif
        const size_t ub = (size_t)c * 16 + head;
#pragma unroll
        for (int kt = 0; kt < 4; ++kt) { u32x2 o; o.x = pk2(s[kt][0], s[kt][1]); o.y = pk2(s[kt][2], s[kt][3]); *(u32x2*)(p.RS0 + (((ub * 4 + vb) * 4 + kt) * 64 + lane) * 4) = o; }
        bf16x8 sb[2];
#pragma unroll
        for (int ks = 0; ks < 2; ++ks) { u32x4 o; o.x = pk2(s[2 * ks][0], s[2 * ks][1]); o.y = pk2(s[2 * ks][2], s[2 * ks][3]); o.z = pk2(s[2 * ks + 1][0], s[2 * ks + 1][1]); o.w = pk2(s[2 * ks + 1][2], s[2 * ks + 1][3]); sb[ks] = __builtin_bit_cast(bf16x8, o); }
        f32x4 uu[4];
#pragma unroll
        for (int tt = 0; tt < 4; ++tt) { uu[tt] = (f32x4){bflo(cur.ut[tt].x), bfhi(cur.ut[tt].x), bflo(cur.ut[tt].y), bfhi(cur.ut[tt].y)}; uu[tt] = MFMA16(cur.wf[tt * 2], sb[0], uu[tt]); uu[tt] = MFMA16(cur.wf[tt * 2 + 1], sb[1], uu[tt]); }
#pragma unroll
        for (int tt = 0; tt < 4; ++tt) { u32x2 o; o.x = pk2(uu[tt][0], uu[tt][1]); o.y = pk2(uu[tt][2], uu[tt][3]); *(u32x2*)(p.RUa + (((ub * 4 + vb) * 4 + tt) * 64 + lane) * 4) = o; }
#ifdef DBG
        { unsigned m = 0;
#pragma unroll
          for (int q = 0; q < 4; ++q) { if (((cur.ut[q].x & 0x7F80u) == 0x7F80u) || ((cur.ut[q].x & 0x7F800000u) == 0x7F800000u) || ((cur.ut[q].y & 0x7F80u) == 0x7F80u) || ((cur.ut[q].y & 0x7F800000u) == 0x7F800000u)) m |= 1u;
              if (((cur.na[q].x & 0x7F80u) == 0x7F80u) || ((cur.na[q].x & 0x7F800000u) == 0x7F800000u) || ((cur.na[q].y & 0x7F80u) == 0x7F80u) || ((cur.na[q].y & 0x7F800000u) == 0x7F800000u)) m |= 2u;
              if (bad_(cur.gc[q][0]) || bad_(cur.gc[q][1]) || bad_(cur.gc[q][2]) || bad_(cur.gc[q][3])) m |= 4u; }
          dbgm |= m; }
#endif
        bf16x8 ubf[2];
#pragma unroll
        for (int ks = 0; ks < 2; ++ks) { u32x4 o; o.x = pk2(uu[2 * ks][0], uu[2 * ks][1]); o.y = pk2(uu[2 * ks][2], uu[2 * ks][3]); o.z = pk2(uu[2 * ks + 1][0], uu[2 * ks + 1][1]); o.w = pk2(uu[2 * ks + 1][2], uu[2 * ks + 1][3]); ubf[ks] = __builtin_bit_cast(bf16x8, o); }
#pragma unroll
        for (int kt = 0; kt < 4; ++kt) { s[kt] = s[kt] * cur.gc[kt] + (f32x4){bflo(cur.na[kt].x), bfhi(cur.na[kt].x), bflo(cur.na[kt].y), bfhi(cur.na[kt].y)};
#ifndef DBG_NOB
            s[kt] = MFMA16(cur.bf[kt * 2], ubf[0], s[kt]); s[kt] = MFMA16(cur.bf[kt * 2 + 1], ubf[1], s[kt]);
#endif
        }
#ifndef DBG
        cur = nxt;
#endif
    }
    DBGF(dbgm != 0, (int)dbgm);
}

DEV void phase_rw_chc(const Params& p, int j, LAS unsigned char* lds) {
    const int tid = tid_(), bid = bid_(); const int lane = tid & 63, w = tid >> 6; const int fr = lane & 15, fq = lane >> 4;
    LAS float* cum = (LAS float*)lds;
    LAS float* seg = cum + 64 * 64;
    LAS float* red = seg + 8 * 64;
    LAS bf16_t* Rs = (LAS bf16_t*)(red + 8 * 32);
    LAS bf16_t* Bs = Rs + 64 * RC_LD; LAS bf16_t* Ks = Bs + 64 * RC_LD; LAS bf16_t* Vs = Ks + 64 * RC_LD;
    LAS bf16_t* Us = Vs + 64 * RC_LD; LAS bf16_t* S0 = Us + 64 * RC_LD; LAS bf16_t* Arb = S0 + 64 * RC_LD; LAS bf16_t* Ark = Arb + 64 * RC_LD;
    const float* lg = p.rw_lnx_g + (size_t)j * D; const float* lb = p.rw_lnx_b + (size_t)j * D;
    for (int u = bid; u < 4096; u += NB_) {
        const int c = u >> 4, h = u & 15; const int t0 = c * 64, cb = h * 64; const size_t ub = (size_t)c * 16 + h;
        __syncthreads();
        rc_cum(p, t0, cb, cum, seg);
        {   const int t = tid >> 3, k8 = (tid & 7) * 8; const size_t go = (size_t)(t0 + t) * D + cb + k8;
            float r[8], b[8], kh[8], v[8], ct[8];
            ld8(p.Rr + go, r); ld8(p.P3 + go, b); ld8(p.P4 + go, kh); ld8(p.Vv + go, v); lds8(cum + t * 64 + k8, ct);
#pragma unroll
            for (int e = 0; e < 8; ++e) { const float ei = __expf(-ct[e]); r[e] *= __expf(ct[e]); b[e] *= ei; kh[e] *= ei; }
            *(LAS u32x4*)(Rs + t * RC_LD + k8) = pk8(r); *(LAS u32x4*)(Bs + t * RC_LD + k8) = pk8(b); *(LAS u32x4*)(Ks + t * RC_LD + k8) = pk8(kh); *(LAS u32x4*)(Vs + t * RC_LD + k8) = pk8(v);
            for (int it = tid; it < 2048; it += NTHR) { const int which = it >> 10, tl = (it >> 6) & 15, ln = it & 63; const int vbk = tl >> 2, rb = tl & 3;
                const bf16_t* src = (which ? p.RS0 : p.RUa) + (((ub * 4 + vbk) * 4 + rb) * 64 + ln) * 4; const u32x2 q = *(const u32x2*)src;
                LAS bf16_t* dst = (which ? S0 : Us) + (16 * rb + 4 * (ln >> 4)) * RC_LD + 16 * vbk + (ln & 15);
                dst[0] = (bf16_t)(q.x & 0xFFFF); dst[RC_LD] = (bf16_t)(q.x >> 16); dst[2 * RC_LD] = (bf16_t)(q.y & 0xFFFF); dst[3 * RC_LD] = (bf16_t)(q.y >> 16); }
        }
        __syncthreads();
        {   const int tb = w >> 1;
#pragma unroll
            for (int ii = 0; ii < 2; ++ii) { const int ib = 2 * (w & 1) + ii;
                f32x4 ab = {0.f, 0.f, 0.f, 0.f}, ak = {0.f, 0.f, 0.f, 0.f};
                if (ib <= tb) {
#pragma unroll
                    for (int ks = 0; ks < 2; ++ks) { const bf16x8 af = frag_rm(Rs, RC_LD, 16 * tb, 32 * ks, lane);
                        ab = MFMA16(af, frag_rm(Bs, RC_LD, 16 * ib, 32 * ks, lane), ab); ak = MFMA16(af, frag_rm(Ks, RC_LD, 16 * ib, 32 * ks, lane), ak); } }
#pragma unroll
                for (int r = 0; r < 4; ++r) { const int t = 16 * tb + 4 * fq + r, i = 16 * ib + fr; const bool keep = i <= t;
                    Arb[t * RC_LD + i] = (bf16_t)f2bf(keep ? ab[r] : 0.f); Ark[t * RC_LD + i] = (bf16_t)f2bf(keep ? ak[r] : 0.f); } }
        }
        __syncthreads();
        const int tt = w & 3; f32x4 y[2];
#pragma unroll
        for (int q = 0; q < 2; ++q) { const int vbk = 2 * (w >> 2) + q; f32x4 acc = {0.f, 0.f, 0.f, 0.f};
#pragma unroll
            for (int ks = 0; ks < 2; ++ks) {
                acc = MFMA16(frag_rm(Rs, RC_LD, 16 * tt, 32 * ks, lane), frag_tr(S0, RC_LD, 32 * ks, 16 * vbk, lane), acc);
                acc = MFMA16(frag_rm(Arb, RC_LD, 16 * tt, 32 * ks, lane), frag_tr(Us, RC_LD, 32 * ks, 16 * vbk, lane), acc);
                acc = MFMA16(frag_rm(Ark, RC_LD, 16 * tt, 32 * ks, lane), frag_tr(Vs, RC_LD, 32 * ks, 16 * vbk, lane), acc); }
            y[q] = acc; }
#pragma unroll
        for (int r = 0; r < 4; ++r) { const float s1 = sum16(y[0][r] + y[1][r]); const float s2 = sum16(y[0][r] * y[0][r] + y[1][r] * y[1][r]);
            if (fr == 0) { red[(w * 16 + 4 * fq + r) * 2] = s1; red[(w * 16 + 4 * fq + r) * 2 + 1] = s2; } }
        __syncthreads();
#pragma unroll
        for (int r = 0; r < 4; ++r) { const int row = 4 * fq + r; const int t = t0 + 16 * tt + row;
            const float s1 = red[(w * 16 + row) * 2] + red[((w ^ 4) * 16 + row) * 2], s2 = red[(w * 16 + row) * 2 + 1] + red[((w ^ 4) * 16 + row) * 2 + 1];
            const float mean = s1 * (1.0f / 64.0f), var = s2 * (1.0f / 64.0f) - mean * mean; const float rs = rsqrtf(fmaxf(var, 0.f) + 64e-5f);
            const float bc = p.BC[(size_t)t * 16 + h];
#pragma unroll
            for (int q = 0; q < 2; ++q) { const int ch = cb + 16 * (2 * (w >> 2) + q) + fr; const size_t go = (size_t)t * D + ch;
                const float o = ((y[q][r] - mean) * rs * lg[ch] + lb[ch] + bc * p.Vv[go]) * p.Gg[go];
                p.YB[go] = (bf16_t)f2bf((o == o && fabsf(o) < 1e30f) ? o : 0.f); } }
    }
}
DEV void phase_ln1(const Params& p, int layer, const float* hin, LAS unsigned char* lds) {
    const int tid = tid_(), bid = bid_(); (void)tid; (void)bid;
    const int lane = tid & 63, wid = tid >> 6;
    LAS float* wt = (LAS float*)lds;
    LAS float* lg = wt + 36 * 1028;
    LAS int* cnt = (LAS int*)(lg + 8 * 64);
    const float* wr_ = p.moe_w_route + (size_t)layer * D * 32; const float* wg_ = p.moe_w_group + (size_t)layer * D * 4;
    for (int i = tid; i < D * 32; i += NTHR) { const int k = i >> 5, o = i & 31; wt[o * 1028 + k] = wr_[i]; }
    for (int i = tid; i < D * 4; i += NTHR) { const int k = i >> 2, o = i & 3; wt[(32 + o) * 1028 + k] = wg_[i]; }
    if (tid < 32) cnt[tid] = 0;
    __syncthreads();
    const float* g = p.ln_g + ((size_t)layer * 2 + 0) * D; const float* be = p.ln_b + ((size_t)layer * 2 + 0) * D;
    const float* br = p.moe_b_route + layer * 32; const float* bg = p.moe_b_group + layer * 4;
    for (int rr = 0; rr < 8; ++rr) {
        const int t = bid * 64 + wid * 8 + rr; const size_t ro = (size_t)t * D;
        f32x4 z[4], m[4];
        load_row(hin + ro, lane, z); load_row(p.MIX + ro, lane, m);
        float s = 0.f;
#pragma unroll
        for (int q = 0; q < 4; ++q) { z[q] = z[q] * ALPHA + m[q]; s += z[q][0] + z[q][1] + z[q][2] + z[q][3]; }
        const float mean = wave_sum(s) * (1.0f / D);
        float vs = 0.f;
#pragma unroll
        for (int q = 0; q < 4; ++q) { z[q] = z[q] - mean; vs += z[q][0] * z[q][0] + z[q][1] * z[q][1] + z[q][2] * z[q][2] + z[q][3] * z[q][3]; }
        const float rs = rsqrtf(wave_sum(vs) * (1.0f / D) + LN_EPS);
#pragma unroll
        for (int q = 0; q < 4; ++q) {
            const f32x4 gw = *(const f32x4*)(g + 256 * q + 4 * lane), bw = *(const f32x4*)(be + 256 * q + 4 * lane);
            z[q] = z[q] * rs * gw + bw;
            *(f32x4*)(p.H1 + ro + 256 * q + 4 * lane) = z[q];
        }
        LAS float* L = lg + wid * 64;
#pragma unroll 1
        for (int gI = 0; gI < 4; ++gI) skinny_group<8>(z, wt + gI * 8 * 1028, lane, L + gI * 8);
        skinny_group<4>(z, wt + 32 * 1028, lane, L + 32);
        if (lane == 0) {
            const float q0 = L[32] + bg[0], q1 = L[33] + bg[1], q2 = L[34] + bg[2], q3 = L[35] + bg[3];
            int gi = 0; float gm = q0;
            if (q1 > gm) { gm = q1; gi = 1; } if (q2 > gm) { gm = q2; gi = 2; } if (q3 > gm) { gm = q3; gi = 3; }
            const float den = __expf(q0 - gm) + __expf(q1 - gm) + __expf(q2 - gm) + __expf(q3 - gm);
            const float pgrp = 1.0f / den;
            float l1 = -INFINITY, l2 = -INFINITY; int i1 = 0, i2 = 0;
#pragma unroll 1
            for (int o = 0; o < 8; ++o) { const float v = L[gi * 8 + o] + br[gi * 8 + o];
                if (v > l1) { l2 = l1; i2 = i1; l1 = v; i1 = o; } else if (v > l2) { l2 = v; i2 = o; } }
            const float e2 = __expf(l2 - l1), inv = 1.0f / (1.0f + e2);
            const int e0 = gi * 8 + i1, e1 = gi * 8 + i2;
            p.EIDX[2 * t] = e0; p.EIDX[2 * t + 1] = e1; p.GATE[2 * t] = pgrp * inv; p.GATE[2 * t + 1] = pgrp * e2 * inv;
            atomicAdd((int*)&cnt[e0], 1); atomicAdd((int*)&cnt[e1], 1);
        }
    }
    __syncthreads();
    if (tid < 32) p.CNT[bid * 32 + tid] = cnt[tid];
}

DEV void phase_moe_scatter(const Params& p, LAS unsigned char* lds) {
    const int tid = tid_(), bid = bid_(); (void)tid; (void)bid;
    const int lane = tid & 63, wid = tid >> 6;
    LAS int* part = (LAS int*)lds;
    LAS int* pre = part + 512;
    LAS int* base = pre + 512;
    LAS int* pst = base + 32;
    LAS int* dst = pst + 40;
    LAS int* eid = dst + 128;
    { const int e = tid & 31, part_i = tid >> 5; int tot = 0, prf = 0;
      for (int b = part_i * 16; b < part_i * 16 + 16; ++b) { const int c = p.CNT[b * 32 + e]; tot += c; if (b < (int)bid) prf += c; }
      part[part_i * 32 + e] = tot; pre[part_i * 32 + e] = prf; }
    if (tid < 128) eid[tid] = p.EIDX[bid * 128 + tid];
    __syncthreads();
    if (tid < 32) { int tot = 0, prf = 0; for (int i = 0; i < 16; ++i) { tot += part[i * 32 + tid]; prf += pre[i * 32 + tid]; } part[tid] = tot; pre[tid] = prf; }
    __syncthreads();
    if (tid == 0) { int acc = 0; for (int e = 0; e < 32; ++e) { pst[e] = acc; acc += ((part[e] + 255) >> 8) << 8; } pst[32] = acc;
        if (bid == 0) { for (int e = 0; e <= 32; ++e) p.TAB[e] = pst[e]; p.TAB[33] = acc >> 8;
            for (int e = 0; e < 32; ++e) for (int mt = pst[e] >> 8; mt < (pst[e + 1] >> 8); ++mt) p.TAB[64 + mt] = e; } }
    __syncthreads();
    if (tid < 32) { int run = pst[tid] + pre[tid]; for (int a = 0; a < 128; ++a) if (eid[a] == tid) dst[a] = run++; }
    __syncthreads();
    if (tid < 128) p.DEST[bid * 128 + tid] = dst[tid];
    for (int a = wid * 16; a < wid * 16 + 16; ++a) {
        const int t = bid * 64 + (a >> 1); const int d = dst[a];
        f32x4 z[4]; load_row(p.H1 + (size_t)t * D, lane, z);
#pragma unroll
        for (int q = 0; q < 4; ++q) st_bf4(p.BUF + (size_t)d * D + 256 * q + 4 * lane, z[q]);
    }
}

template <int which> struct SchedMoe {
    const Params* p; int layer;
    DEV bool next(int i, Unit& u) const {
        const int nmt = __hip_atomic_load(p->TAB + 33, __ATOMIC_RELAXED, __HIP_MEMORY_SCOPE_AGENT); int pm, pn; if (!pg8::tile_order(i, NB_, bid_(), nmt, 4, pm, pn)) return false;
        const int row0 = pm * 256; const int e = __hip_atomic_load(p->TAB + 64 + pm, __ATOMIC_RELAXED, __HIP_MEMORY_SCOPE_AGENT);
        if constexpr (which == 0) { u.A = (const char*)(p->BUF + (size_t)row0 * D); u.B = (const char*)(p->moe_w1_t + ((size_t)layer * 32 + e) * 1024 * 1024 + (size_t)pn * 256 * 1024); }
        else { u.A = (const char*)(p->ACT + (size_t)row0 * 512); u.B = (const char*)(p->moe_w2_t + ((size_t)layer * 32 + e) * 1024 * 512 + (size_t)pn * 256 * 512); }
        u.row0 = row0; u.col0 = pn * 256; u.id = e; u.aux = 0; return true;
    }
};
struct EpiMoe1 {
    bf16_t* O;
    DEV void operator()(const AccT& acc, const Unit& u, int wr, int wc, int fr, int fq) const {
#pragma unroll
        for (int ai = 0; ai < 2; ++ai)
#pragma unroll
            for (int m = 0; m < 4; ++m)
#pragma unroll
                for (int n = 0; n < 2; ++n) {
                    const f32x4 gt = acc[ai][0][m][n], up = acc[ai][1][m][n]; f32x4 v;
                    for (int e = 0; e < 4; ++e) v[e] = siluf_(gt[e]) * up[e];
                    const int col = (u.col0 >> 1) + 32 * wc + 16 * n + 4 * fq;
                    st_bf4(O + (size_t)ACC_ROW(u, ai, m) * 512 + col, v); ACC_FENCE;
                }
    }
};
struct EpiMoe2 {
    bf16_t* O;
    DEV void operator()(const AccT& acc, const Unit& u, int wr, int wc, int fr, int fq) const {
        FOR_ACC(ai, bj, m, n) { st_bf4(O + (size_t)ACC_ROW(u, ai, m) * D + ACC_COL(u, bj, n), acc[ai][bj][m][n]); ACC_FENCE; }
    }
};

DEV void phase_ln2(const Params& p, int layer, float* hout) {
    const int tid = tid_(), bid = bid_(); (void)tid; (void)bid;
    const int lane = tid & 63, wid = tid >> 6;
    const float* g = p.ln_g + ((size_t)layer * 2 + 1) * D; const float* be = p.ln_b + ((size_t)layer * 2 + 1) * D;
    for (int rr = 0; rr < 8; ++rr) {
        const int t = bid * 64 + wid * 8 + rr; const size_t ro = (size_t)t * D;
        const int d0 = p.DEST[2 * t], d1 = p.DEST[2 * t + 1]; const float g0 = p.GATE[2 * t], g1 = p.GATE[2 * t + 1];
        f32x4 z[4]; load_row(p.H1 + ro, lane, z);
        float s = 0.f;
#pragma unroll
        for (int q = 0; q < 4; ++q) {
            const u32x2 a = *(const u32x2*)(p.YBUF + (size_t)d0 * D + 256 * q + 4 * lane), b = *(const u32x2*)(p.YBUF + (size_t)d1 * D + 256 * q + 4 * lane);
            z[q][0] = z[q][0] * ALPHA + g0 * bflo(a.x) + g1 * bflo(b.x); z[q][1] = z[q][1] * ALPHA + g0 * bfhi(a.x) + g1 * bfhi(b.x);
            z[q][2] = z[q][2] * ALPHA + g0 * bflo(a.y) + g1 * bflo(b.y); z[q][3] = z[q][3] * ALPHA + g0 * bfhi(a.y) + g1 * bfhi(b.y);
            s += z[q][0] + z[q][1] + z[q][2] + z[q][3];
        }
        const float mean = wave_sum(s) * (1.0f / D);
        float vs = 0.f;
#pragma unroll
        for (int q = 0; q < 4; ++q) { z[q] = z[q] - mean; vs += z[q][0] * z[q][0] + z[q][1] * z[q][1] + z[q][2] * z[q][2] + z[q][3] * z[q][3]; }
        const float rs = rsqrtf(wave_sum(vs) * (1.0f / D) + LN_EPS);
#pragma unroll
        for (int q = 0; q < 4; ++q) {
            const f32x4 gw = *(const f32x4*)(g + 256 * q + 4 * lane), bw = *(const f32x4*)(be + 256 * q + 4 * lane);
            *(f32x4*)(hout + ro + 256 * q + 4 * lane) = z[q] * rs * gw + bw;
        }
    }
}
constexpr int MB_PROJ = 5152;
DEV void phase_mb_cast(const Params& p, int j, const float* hin, LAS unsigned char* lds) {
    const int tid = tid_(), bid = bid_(); (void)tid; (void)bid;
    const int lane = tid & 63, wid = tid >> 6;
    LAS float* wt = (LAS float*)lds;
    const float* w = p.mb_w_in + (size_t)j * D * MB_PROJ;
    for (int i = tid; i < D * 32; i += NTHR) { const int k = i >> 5, o = i & 31; wt[o * 1028 + k] = w[(size_t)k * MB_PROJ + 5120 + o]; }
    __syncthreads();
    for (int rr = 0; rr < 8; ++rr) {
        const int t = bid * 64 + wid * 8 + rr; const size_t ro = (size_t)t * D;
        f32x4 z[4]; load_row(hin + ro, lane, z);
#pragma unroll
        for (int q = 0; q < 4; ++q) st_bf4(p.X6 + ro + 256 * q + 4 * lane, z[q]);
        LAS float* L = wt + 32 * 1028 + wid * 32;
#pragma unroll 1
        for (int gI = 0; gI < 4; ++gI) skinny_group<8>(z, wt + gI * 8 * 1028, lane, L + gI * 8);
        if (lane < 32) p.DT[(size_t)t * 32 + lane] = softplusf_(L[lane] + p.mb_dt_bias[j * 32 + lane]);
    }
}
struct SchedMbIn {
    const Params* p;
    DEV bool next(int i, Unit& u) const {
        int pm, pn; if (!pg8::tile_order(i, NB_, bid_(), 64, 20, pm, pn)) return false;
        u.A = (const char*)(p->X6 + (size_t)pm * 256 * D); u.B = (const char*)(p->mb_win_t + (size_t)pn * 256 * D); u.row0 = pm * 256; u.col0 = pn * 256; u.id = 0; u.aux = 0; return true;
    }
};
struct EpiMbIn {
    const Params* p;
    DEV void operator()(const AccT& acc, const Unit& u, int wr, int wc, int fr, int fq) const {
        const bool isz = u.col0 < 2048; bf16_t* O = p->Z + (isz ? (size_t)0 : (size_t)T * 2048 - 2048); const int ld = isz ? 2048 : 3072;
        FOR_ACC(ai, bj, m, n) { st_bf4(O + (size_t)ACC_ROW(u, ai, m) * ld + ACC_COL(u, bj, n), acc[ai][bj][m][n]); ACC_FENCE; }
    }
};
DEV void phase_mb_conv(const Params& p, int j) {
    const int tid = tid_(), bid = bid_(); (void)tid; (void)bid;
    if (tid >= 384) return;
    const int c0 = tid * 8; const int t0 = bid * 64;
    const float* cw = p.mb_conv_w + (size_t)j * 4 * 3072; const float* cb = p.mb_conv_b + (size_t)j * 3072;
    float w[4][8], b[8];
#pragma unroll
    for (int i = 0; i < 4; ++i) { const f32x4 a = *(const f32x4*)(cw + i * 3072 + c0), bb = *(const f32x4*)(cw + i * 3072 + c0 + 4); for (int e = 0; e < 4; ++e) { w[i][e] = a[e]; w[i][4 + e] = bb[e]; } }
    { const f32x4 a = *(const f32x4*)(cb + c0), bb = *(const f32x4*)(cb + c0 + 4); for (int e = 0; e < 4; ++e) { b[e] = a[e]; b[4 + e] = bb[e]; } }
    float x0[8], x1[8], x2[8], x3[8];
    auto ld = [&](int t, float (&x)[8]) {
        if (t < 0) { for (int e = 0; e < 8; ++e) x[e] = 0.f; return; }
        const u32x4 v = *(const u32x4*)(p.XBC + (size_t)t * 3072 + c0);
        x[0] = bflo(v.x); x[1] = bfhi(v.x); x[2] = bflo(v.y); x[3] = bfhi(v.y); x[4] = bflo(v.z); x[5] = bfhi(v.z); x[6] = bflo(v.w); x[7] = bfhi(v.w);
    };
    ld(t0 - 3, x0); ld(t0 - 2, x1); ld(t0 - 1, x2);
    for (int tt = 0; tt < 64; ++tt) {
        ld(t0 + tt, x3);
        float o[8];
#pragma unroll
        for (int e = 0; e < 8; ++e) o[e] = siluf_(b[e] + w[0][e] * x0[e] + w[1][e] * x1[e] + w[2][e] * x2[e] + w[3][e] * x3[e]);
        u32x4 r; r.x = pk2(o[0], o[1]); r.y = pk2(o[2], o[3]); r.z = pk2(o[4], o[5]); r.w = pk2(o[6], o[7]);
        *(u32x4*)(p.XC + (size_t)(t0 + tt) * 3072 + c0) = r;
#pragma unroll
        for (int e = 0; e < 8; ++e) { x0[e] = x1[e]; x1[e] = x2[e]; x2[e] = x3[e]; }
    }
}

DEV void mb_dacs(const Params& p, int j, int c, int g, LAS float* dts, LAS float* dacs) {
    const int tid = tid_(); const int lane = tid & 63, h = tid >> 6;
    const int hh = 8 * g + h; const float a = -__expf(p.mb_a_log[j * 32 + hh]);
    const float d0 = p.DT[(size_t)(c * 128 + 2 * lane) * 32 + hh], d1 = p.DT[(size_t)(c * 128 + 2 * lane + 1) * 32 + hh];
    const float a0 = d0 * a, a1 = d1 * a;
    float s = a0 + a1;
#pragma unroll
    for (int o = 1; o < 64; o <<= 1) { const float v = __shfl_up(s, o); if (lane >= o) s += v; }
    dts[h * 128 + 2 * lane] = d0; dts[h * 128 + 2 * lane + 1] = d1;
    dacs[h * 128 + 2 * lane] = s - a1; dacs[h * 128 + 2 * lane + 1] = s;
}
constexpr int LDB = 136;
constexpr int LDX = 72;
DEV void ld_tile128(const bf16_t* src, int gld, LAS bf16_t* dst) {
    const int tid = tid_();
    for (int i = tid; i < 128 * 16; i += NTHR) { const int r = i >> 4, c8 = (i & 15) * 8; *(LAS u32x4*)(dst + r * LDB + c8) = *(const u32x4*)(src + (size_t)r * gld + c8); }
}

DEV void phase_mb_states(const Params& p, int j, LAS unsigned char* lds) {
    const int tid = tid_(), bid = bid_(); (void)tid; (void)bid;
    const int lane = tid & 63, w = tid >> 6;
    LAS bf16_t* Bm = (LAS bf16_t*)lds;
    LAS bf16_t* Xh = Bm + 128 * LDB;
    LAS float* dts = (LAS float*)(Xh + 128 * LDX);
    LAS float* dacs = dts + 1024;
    for (int u = bid; u < 512; u += NB_) {
        const int c = u >> 2, g = u & 3; const int t0 = c * 128;
        __syncthreads();
        mb_dacs(p, j, c, g, dts, dacs);
        ld_tile128(p.XC + (size_t)t0 * 3072 + 2048 + 128 * g, 3072, Bm);
        __syncthreads();
        if (tid < 8) p.CD[(c * 32) + 8 * g + tid] = __expf(dacs[tid * 128 + 127]);
        bf16x8 bfr[4];
#pragma unroll
        for (int ks = 0; ks < 4; ++ks) bfr[ks] = frag_tr(Bm, LDB, 32 * ks, 16 * w, lane);
        for (int h = 0; h < 8; ++h) {
            { const int l = tid >> 2, p0 = (tid & 3) * 16; const float sc = dts[h * 128 + l] * __expf(dacs[h * 128 + 127] - dacs[h * 128 + l]);
              const bf16_t* src = p.XC + (size_t)(t0 + l) * 3072 + 64 * (8 * g + h) + p0;
#pragma unroll
              for (int hf = 0; hf < 2; ++hf) { const u32x4 v = *(const u32x4*)(src + 8 * hf); u32x4 r;
                  r.x = pk2(bflo(v.x) * sc, bfhi(v.x) * sc); r.y = pk2(bflo(v.y) * sc, bfhi(v.y) * sc); r.z = pk2(bflo(v.z) * sc, bfhi(v.z) * sc); r.w = pk2(bflo(v.w) * sc, bfhi(v.w) * sc);
                  *(LAS u32x4*)(Xh + l * LDX + p0 + 8 * hf) = r; } }
            __syncthreads();
            f32x4 acc[4];
#pragma unroll
            for (int pb = 0; pb < 4; ++pb) { acc[pb] = (f32x4){0.f, 0.f, 0.f, 0.f};
#pragma unroll
                for (int ks = 0; ks < 4; ++ks) { const bf16x8 af = frag_tr(Xh, LDX, 32 * ks, 16 * pb, lane); acc[pb] = MFMA16(af, bfr[ks], acc[pb]); } }
            float* S = p.STATES + (((size_t)c * 32 + 8 * g + h) * 64) * 128;
#pragma unroll
            for (int pb = 0; pb < 4; ++pb)
#pragma unroll
                for (int r = 0; r < 4; ++r) S[(size_t)(16 * pb + 4 * (lane >> 4) + r) * 128 + 16 * w + (lane & 15)] = acc[pb][r];
            __syncthreads();
        }
    }
}
DEV void phase_mb_scan(const Params& p) {
    const int tid = tid_(), bid = bid_(); (void)tid; (void)bid;
    const int gid = bid * NTHR + tid;
    if (gid >= 32 * 64 * 64) return;
    const int np = gid & 63, pp = (gid >> 6) & 63, h = gid >> 12; const int n = 2 * np;
    float r0 = 0.f, r1 = 0.f;
    const size_t eo = ((size_t)h * 64 + pp) * 128 + n;
    const size_t fo = (size_t)h * 64 * 128 + fragmajor_off(pp, n, 128);
#pragma unroll 4
    for (int c = 0; c < 128; ++c) {
        const f32x2 s = *(const f32x2*)(p.STATES + (size_t)c * 32 * 64 * 128 + eo);
        const float cd = p.CD[c * 32 + h];
        *(unsigned*)(p.PREV + (size_t)c * 32 * 64 * 128 + fo) = pk2(r0, r1);
        r0 = r0 * cd + s[0]; r1 = r1 * cd + s[1];
    }
}
DEV void phase_mb_out(const Params& p, int j, LAS unsigned char* lds) {
    const int tid = tid_(), bid = bid_(); (void)tid; (void)bid;
    const int lane = tid & 63, w = tid >> 6; const int fr = lane & 15, fq = lane >> 4;
    LAS bf16_t* Cm = (LAS bf16_t*)lds;
    LAS bf16_t* Bm = Cm + 128 * LDB;
    LAS bf16_t* Xh = Bm + 128 * LDB;
    LAS bf16_t* Mw = Xh + 128 * LDX;
    LAS float* dts = (LAS float*)(Mw + 8 * 16 * LDB);
    LAS float* dacs = dts + 1024;
    LAS bf16_t* Mme = Mw + w * 16 * LDB;
    for (int u = bid; u < 512; u += NB_) {
        const int c = u >> 2, g = u & 3; const int t0 = c * 128;
        __syncthreads();
        mb_dacs(p, j, c, g, dts, dacs);
        ld_tile128(p.XC + (size_t)t0 * 3072 + 2048 + 512 + 128 * g, 3072, Cm);
        ld_tile128(p.XC + (size_t)t0 * 3072 + 2048 + 128 * g, 3072, Bm);
        __syncthreads();
        f32x4 sc[8]; bf16x8 cf[4];
#pragma unroll
        for (int ks = 0; ks < 4; ++ks) cf[ks] = frag_rm(Cm, LDB, 16 * w, 32 * ks, lane);
#pragma unroll
        for (int sb = 0; sb < 8; ++sb) { sc[sb] = (f32x4){0.f, 0.f, 0.f, 0.f};
#pragma unroll
            for (int ks = 0; ks < 4; ++ks) sc[sb] = MFMA16(cf[ks], frag_rm(Bm, LDB, 16 * sb, 32 * ks, lane), sc[sb]); }
        float ssq[4] = {0.f, 0.f, 0.f, 0.f};
#pragma unroll 1
        for (int h = 0; h < 8; ++h) {
            const int hh = 8 * g + h;
            { const int l = tid >> 2, p0 = (tid & 3) * 16; const float scl = dts[h * 128 + l];
              const bf16_t* src = p.XC + (size_t)(t0 + l) * 3072 + 64 * hh + p0;
#pragma unroll
              for (int hf = 0; hf < 2; ++hf) { const u32x4 v = *(const u32x4*)(src + 8 * hf); u32x4 r;
                  r.x = pk2(bflo(v.x) * scl, bfhi(v.x) * scl); r.y = pk2(bflo(v.y) * scl, bfhi(v.y) * scl); r.z = pk2(bflo(v.z) * scl, bfhi(v.z) * scl); r.w = pk2(bflo(v.w) * scl, bfhi(v.w) * scl);
                  *(LAS u32x4*)(Xh + l * LDX + p0 + 8 * hf) = r; } }
            float dl[4];
#pragma unroll
            for (int r = 0; r < 4; ++r) dl[r] = dacs[h * 128 + 16 * w + 4 * fq + r];
#pragma unroll
            for (int sb = 0; sb < 8; ++sb) { const int s = 16 * sb + fr; const float ds = dacs[h * 128 + s];
#pragma unroll
                for (int r = 0; r < 4; ++r) { const int l = 16 * w + 4 * fq + r; const float m = (s <= l) ? sc[sb][r] * __expf(dl[r] - ds) : 0.f; Mme[(4 * fq + r) * LDB + s] = (bf16_t)f2bf(m); } }
            __syncthreads();
            bf16x8 mf[4];
#pragma unroll
            for (int ks = 0; ks < 4; ++ks) mf[ks] = frag_rm(Mme, LDB, 0, 32 * ks, lane);
            const bf16_t* pv = p.PREV + ((size_t)c * 32 + hh) * 64 * 128;
#pragma unroll
            for (int pb = 0; pb < 4; ++pb) {
                f32x4 a = {0.f, 0.f, 0.f, 0.f}, o = {0.f, 0.f, 0.f, 0.f};
#pragma unroll
                for (int ks = 0; ks < 4; ++ks) {
                    a = MFMA16(mf[ks], frag_tr(Xh, LDX, 32 * ks, 16 * pb, lane), a);
                    const bf16x8 pf = *(const bf16x8*)(pv + ((size_t)(pb * 4 + ks) * 64 + lane) * 8);
                    o = MFMA16(cf[ks], pf, o);
                }
                const float dsk = p.mb_d[j * 32 + hh];
#pragma unroll
                for (int r = 0; r < 4; ++r) {
                    const int t = t0 + 16 * w + 4 * fq + r; const int ch = 64 * hh + 16 * pb + fr;
                    const float xs = bf2f(p.XC[(size_t)t * 3072 + ch]); const float z = bf2f(p.Z[(size_t)t * 2048 + ch]);
                    float v = a[r] + o[r] * __expf(dl[r]) + xs * dsk;
                    v *= siluf_(z);
                    ssq[r] += v * v;
                    p.YB[(size_t)t * 2048 + ch] = (bf16_t)f2bf(v * p.mb_norm_g[(size_t)j * 2048 + ch]);
                }
            }
            __syncthreads();
        }
#pragma unroll
        for (int r = 0; r < 4; ++r) ssq[r] = rsqrtf(sum16(ssq[r]) * (1.0f / 512.0f) + 1e-5f);
#pragma unroll 1
        for (int h = 0; h < 8; ++h)
#pragma unroll
            for (int pb = 0; pb < 4; ++pb) { const int ch = 512 * g + 64 * h + 16 * pb + fr;
#pragma unroll
                for (int r = 0; r < 4; ++r) { bf16_t* q = p.YB + (size_t)(t0 + 16 * w + 4 * fq + r) * 2048 + ch; *q = (bf16_t)f2bf(bf2f(*q) * ssq[r]); } }
    }
}
constexpr int GL_PROJ = 3088;
constexpr int LDV = 264;
DEV void phase_gl_cast(const Params& p, int j, const float* hin, LAS unsigned char* lds) {
    const int tid = tid_(), bid = bid_(); (void)tid; (void)bid;
    const int lane = tid & 63, wid = tid >> 6;
    LAS float* wt = (LAS float*)lds;
    LAS float* w2 = wt + 16 * 1028;
    LAS float* lr = w2 + 16 * 512;
    const float* w = p.gl_w_in + (size_t)j * D * GL_PROJ;
    for (int i = tid; i < D * 16; i += NTHR) { const int k = i >> 4, o = i & 15; wt[o * 1028 + k] = w[(size_t)k * GL_PROJ + 3072 + o]; }
    for (int i = tid; i < 16 * 512; i += NTHR) w2[i] = p.gl_gk_w2[(size_t)j * 16 * 512 + i];
    __syncthreads();
    for (int rr = 0; rr < 8; ++rr) {
        const int t = bid * 64 + wid * 8 + rr; const size_t ro = (size_t)t * D;
        f32x4 z[4]; load_row(hin + ro, lane, z);
#pragma unroll
        for (int q = 0; q < 4; ++q) st_bf4(p.X6 + ro + 256 * q + 4 * lane, z[q]);
#pragma unroll 1
        for (int gI = 0; gI < 2; ++gI) skinny_group<8>(z, wt + gI * 8 * 1028, lane, lr + wid * 16 + gI * 8);
        float l16[16];
#pragma unroll
        for (int o = 0; o < 16; ++o) l16[o] = lr[wid * 16 + o];
#pragma unroll
        for (int cc = 0; cc < 8; ++cc) {
            const int c = cc * 64 + lane; float a = p.gl_gk_b[j * 512 + c];
#pragma unroll
            for (int o = 0; o < 16; ++o) a += l16[o] * w2[o * 512 + c];
            const float ls = fminf(a, 0.f) - log1pf(__expf(-fabsf(a)));
            p.LA[(size_t)t * 512 + c] = ls * (1.0f / 16.0f);
        }
    }
}
struct SchedGlIn {
    const Params* p;
    DEV bool next(int i, Unit& u) const {
        int pm, pn; if (!pg8::tile_order(i, NB_, bid_(), 64, 12, pm, pn)) return false;
        u.A = (const char*)(p->X6 + (size_t)pm * 256 * D); u.B = (const char*)(p->gl_win_t + (size_t)pn * 256 * D); u.row0 = pm * 256; u.col0 = pn * 256; u.id = 0; u.aux = 0; return true;
    }
};
struct EpiGlIn {
    const Params* p;
    DEV void operator()(const AccT& acc, const Unit& u, int wr, int wc, int fr, int fq) const {
        FOR_ACC(ai, bj, m, n) { st_bf4(p->QKVG + (size_t)ACC_ROW(u, ai, m) * 3072 + ACC_COL(u, bj, n), acc[ai][bj][m][n]); ACC_FENCE; }
    }
};
DEV void gl_bcs(const Params& p, int n, int h, LAS float* bcs) {
    const int tid = tid_();
    for (int i = tid; i < 64 * 32; i += NTHR) { const int r = i >> 5, c4 = (i & 31) * 4; *(LAS f32x4*)(bcs + r * 128 + c4) = *(const f32x4*)(p.LA + (size_t)(n * 64 + r) * 512 + 128 * h + c4); }
    __syncthreads();
    if (tid < 128) { float s = 0.f; for (int r = 0; r < 64; ++r) { s += bcs[r * 128 + tid]; bcs[r * 128 + tid] = s; } }
    __syncthreads();
}
DEV void phase_gl_kv(const Params& p, LAS unsigned char* lds) {
    const int tid = tid_(), bid = bid_(); (void)tid; (void)bid;
    const int lane = tid & 63, w = tid >> 6;
    LAS float* bcs = (LAS float*)lds;
    LAS bf16_t* Ke = (LAS bf16_t*)(bcs + 64 * 128);
    LAS bf16_t* Vs = Ke + 64 * LDB;
    for (int u = bid; u < 1024; u += NB_) {
        const int n = u >> 2, h = u & 3; const int t0 = n * 64;
        __syncthreads();
        gl_bcs(p, n, h, bcs);
        for (int i = tid; i < 64 * 16; i += NTHR) { const int r = i >> 4, c8 = (i & 15) * 8;
            const u32x4 v = *(const u32x4*)(p.QKVG + (size_t)(t0 + r) * 3072 + 512 + 128 * h + c8); float f[8];
            f[0] = bflo(v.x); f[1] = bfhi(v.x); f[2] = bflo(v.y); f[3] = bfhi(v.y); f[4] = bflo(v.z); f[5] = bfhi(v.z); f[6] = bflo(v.w); f[7] = bfhi(v.w);
#pragma unroll
            for (int e = 0; e < 8; ++e) f[e] *= __expf(bcs[63 * 128 + c8 + e] - bcs[r * 128 + c8 + e]);
            u32x4 o; o.x = pk2(f[0], f[1]); o.y = pk2(f[2], f[3]); o.z = pk2(f[4], f[5]); o.w = pk2(f[6], f[7]);
            *(LAS u32x4*)(Ke + r * LDB + c8) = o; }
        for (int i = tid; i < 64 * 32; i += NTHR) { const int r = i >> 5, c8 = (i & 31) * 8; *(LAS u32x4*)(Vs + r * LDV + c8) = *(const u32x4*)(p.QKVG + (size_t)(t0 + r) * 3072 + 1024 + 256 * h + c8); }
        if (tid < 128) p.CDG[((size_t)n * 4 + h) * 128 + tid] = __expf(bcs[63 * 128 + tid]);
        __syncthreads();
        bf16x8 af[2];
#pragma unroll
        for (int ks = 0; ks < 2; ++ks) af[ks] = frag_tr(Ke, LDB, 32 * ks, 16 * w, lane);
        float* O = p.STATES + (((size_t)n * 4 + h) * 128) * 256;
#pragma unroll
        for (int vb = 0; vb < 16; ++vb) {
            f32x4 acc = {0.f, 0.f, 0.f, 0.f};
#pragma unroll
            for (int ks = 0; ks < 2; ++ks) acc = MFMA16(af[ks], frag_tr(Vs, LDV, 32 * ks, 16 * vb, lane), acc);
#pragma unroll
            for (int r = 0; r < 4; ++r) O[(size_t)(16 * w + 4 * (lane >> 4) + r) * 256 + 16 * vb + (lane & 15)] = acc[r];
        }
    }
}
DEV void phase_gl_scan(const Params& p) {
    const int tid = tid_(), bid = bid_(); (void)tid; (void)bid;
    const int gid = bid * NTHR + tid;
    if (gid >= 4 * 64 * 256) return;
    const int v = gid & 255, kp = (gid >> 8) & 63, h = gid >> 14; const int k = 2 * kp;
    float r0 = 0.f, r1 = 0.f;
    const size_t fo = (size_t)h * 128 * 256 + fragmajor_off(v, k, 128);
#pragma unroll 4
    for (int n = 0; n < 256; ++n) {
        const float* S = p.STATES + (((size_t)n * 4 + h) * 128) * 256;
        const float s0 = S[(size_t)k * 256 + v], s1 = S[(size_t)(k + 1) * 256 + v];
        const f32x2 cd = *(const f32x2*)(p.CDG + ((size_t)n * 4 + h) * 128 + k);
        *(unsigned*)(p.PREV + (size_t)n * 4 * 128 * 256 + fo) = pk2(r0, r1);
        r0 = r0 * cd[0] + s0; r1 = r1 * cd[1] + s1;
    }
}
DEV void phase_gl_out(const Params& p, int j, LAS unsigned char* lds) {
    const int tid = tid_(), bid = bid_(); (void)tid; (void)bid;
    const int lane = tid & 63, w = tid >> 6; const int fr = lane & 15, fq = lane >> 4;
    LAS float* bcs = (LAS float*)lds;
    LAS bf16_t* Qs = (LAS bf16_t*)(bcs + 64 * 128);
    LAS bf16_t* Ks = Qs + 64 * LDB;
    LAS bf16_t* Vs = Ks + 64 * LDB;
    LAS bf16_t* At = Vs + 64 * LDV;
    LAS float* red = (LAS float*)(At + 64 * LDX);
    for (int u = bid; u < 1024; u += NB_) {
        const int n = u >> 2, h = u & 3; const int t0 = n * 64;
        __syncthreads();
        gl_bcs(p, n, h, bcs);
        for (int i = tid; i < 64 * 16; i += NTHR) { const int r = i >> 4, c8 = (i & 15) * 8;
            const u32x4 vq = *(const u32x4*)(p.QKVG + (size_t)(t0 + r) * 3072 + 128 * h + c8), vk = *(const u32x4*)(p.QKVG + (size_t)(t0 + r) * 3072 + 512 + 128 * h + c8);
            float fq_[8], fk_[8];
            fq_[0] = bflo(vq.x); fq_[1] = bfhi(vq.x); fq_[2] = bflo(vq.y); fq_[3] = bfhi(vq.y); fq_[4] = bflo(vq.z); fq_[5] = bfhi(vq.z); fq_[6] = bflo(vq.w); fq_[7] = bfhi(vq.w);
            fk_[0] = bflo(vk.x); fk_[1] = bfhi(vk.x); fk_[2] = bflo(vk.y); fk_[3] = bfhi(vk.y); fk_[4] = bflo(vk.z); fk_[5] = bfhi(vk.z); fk_[6] = bflo(vk.w); fk_[7] = bfhi(vk.w);
#pragma unroll
            for (int e = 0; e < 8; ++e) { const float b = bcs[r * 128 + c8 + e]; fq_[e] *= __expf(b) * 0.08838834764831845f; fk_[e] *= __expf(-b); }
            u32x4 o; o.x = pk2(fq_[0], fq_[1]); o.y = pk2(fq_[2], fq_[3]); o.z = pk2(fq_[4], fq_[5]); o.w = pk2(fq_[6], fq_[7]);
            *(LAS u32x4*)(Qs + r * LDB + c8) = o;
            o.x = pk2(fk_[0], fk_[1]); o.y = pk2(fk_[2], fk_[3]); o.z = pk2(fk_[4], fk_[5]); o.w = pk2(fk_[6], fk_[7]);
            *(LAS u32x4*)(Ks + r * LDB + c8) = o; }
        for (int i = tid; i < 64 * 32; i += NTHR) { const int r = i >> 5, c8 = (i & 31) * 8; *(LAS u32x4*)(Vs + r * LDV + c8) = *(const u32x4*)(p.QKVG + (size_t)(t0 + r) * 3072 + 1024 + 256 * h + c8); }
        __syncthreads();
        { const int ib = w >> 1;
#pragma unroll
          for (int jj = 0; jj < 2; ++jj) { const int jb = 2 * (w & 1) + jj; f32x4 a = {0.f, 0.f, 0.f, 0.f};
#pragma unroll
              for (int ks = 0; ks < 4; ++ks) a = MFMA16(frag_rm(Qs, LDB, 16 * ib, 32 * ks, lane), frag_rm(Ks, LDB, 16 * jb, 32 * ks, lane), a);
#pragma unroll
              for (int r = 0; r < 4; ++r) { const int i = 16 * ib + 4 * fq + r, jx = 16 * jb + fr; At[i * LDX + jx] = (bf16_t)f2bf(jx <= i ? a[r] : 0.f); } } }
        __syncthreads();
        f32x4 o[4][2];
        const bf16_t* pv = p.PREV + ((size_t)n * 4 + h) * 128 * 256;
#pragma unroll
        for (int vv = 0; vv < 2; ++vv) { const int vb = 2 * w + vv;
            bf16x8 bi[2], bp[4];
#pragma unroll
            for (int ks = 0; ks < 2; ++ks) bi[ks] = frag_tr(Vs, LDV, 32 * ks, 16 * vb, lane);
#pragma unroll
            for (int ks = 0; ks < 4; ++ks) bp[ks] = *(const bf16x8*)(pv + ((size_t)(vb * 4 + ks) * 64 + lane) * 8);
#pragma unroll
            for (int ib = 0; ib < 4; ++ib) { f32x4 a = {0.f, 0.f, 0.f, 0.f};
#pragma unroll
                for (int ks = 0; ks < 2; ++ks) a = MFMA16(frag_rm(At, LDX, 16 * ib, 32 * ks, lane), bi[ks], a);
#pragma unroll
                for (int ks = 0; ks < 4; ++ks) a = MFMA16(frag_rm(Qs, LDB, 16 * ib, 32 * ks, lane), bp[ks], a);
                o[ib][vv] = a; } }
#pragma unroll
        for (int ib = 0; ib < 4; ++ib)
#pragma unroll
            for (int r = 0; r < 4; ++r) { float s = o[ib][0][r] * o[ib][0][r] + o[ib][1][r] * o[ib][1][r]; s = sum16(s); if (fr == 0) red[w * 64 + 16 * ib + 4 * fq + r] = s; }
        __syncthreads();
#pragma unroll
        for (int ib = 0; ib < 4; ++ib)
#pragma unroll
            for (int r = 0; r < 4; ++r) { const int i = 16 * ib + 4 * fq + r; float s = 0.f;
#pragma unroll
                for (int ww = 0; ww < 8; ++ww) s += red[ww * 64 + i];
                const float rs = rsqrtf(s * (1.0f / 256.0f) + 1e-5f);
#pragma unroll
                for (int vv = 0; vv < 2; ++vv) { const int v = 32 * w + 16 * vv + fr; const int t = t0 + i;
                    const float gt = bf2f(p.QKVG[(size_t)t * 3072 + 2048 + 256 * h + v]);
                    p.YB[(size_t)t * D + 256 * h + v] = (bf16_t)f2bf(o[ib][vv][r] * rs * p.gl_norm_g[j * 256 + v] * siluf_(gt)); } }
    }
}
#define XB_TMO      128
#define XB_XCNT(j)  (256  + 64 * (j))
#define XB_XSUB(j)  (1280 + 64 * (j))
#define XB_XGEN(j)  (2304 + 64 * (j))
#define XB_TOP      3328
#define XB_TOPGEN   3392
#define XCD_BAR_WORDS 3456
#define XB_SPIN_CAP (1u << 22)
DEV unsigned xb_ld(unsigned* p)              { return __hip_atomic_load(p, __ATOMIC_RELAXED, __HIP_MEMORY_SCOPE_AGENT); }
DEV unsigned xb_add(unsigned* p, unsigned v) { return __hip_atomic_fetch_add(p, v, __ATOMIC_RELAXED, __HIP_MEMORY_SCOPE_AGENT); }
DEV unsigned xb_xcc_id() { return (unsigned)__builtin_amdgcn_s_getreg((3 << 11) | 20) & 0xFu; }
#define XB_SPIN(cond, bar) do { unsigned _sp = 0; while (cond) { __builtin_amdgcn_s_sleep(1); \
    if ((++_sp & 255u) == 0u) { if (xb_ld(&(bar)[XB_TMO])) break; if (_sp > XB_SPIN_CAP) { atomicAdd(&(bar)[XB_TMO], 1u); break; } } } } while (0)
struct XcdBarrier { unsigned* bar; unsigned x; volatile LAS unsigned* st; };
DEV XcdBarrier xcd_barrier_post(unsigned* bar, volatile LAS unsigned* st) {
    XcdBarrier b; b.bar = bar; b.x = xb_xcc_id(); b.st = st;
    if (threadIdx.x == 0) (void)xb_add(&bar[XB_XCNT(b.x)], 1u);
    return b;
}
DEV void xcd_barrier_complete(unsigned* bar, unsigned x, unsigned& nloc, unsigned& nx) {
    const unsigned G = gridDim.x * gridDim.y * gridDim.z;
    unsigned sum, cnt, mine, sp = 0u;
    for (;;) {
        sum = 0u; cnt = 0u; mine = 0u;
#pragma unroll
        for (unsigned j = 0; j < 16; ++j) { const unsigned c = xb_ld(&bar[XB_XCNT(j)]); sum += c; cnt += (c > 0u) ? 1u : 0u; mine = (j == x) ? c : mine; }
        if (sum == G) break;
        __builtin_amdgcn_s_sleep(1);
        if ((++sp & 255u) == 0u) { if (xb_ld(&bar[XB_TMO])) break; if (sp > XB_SPIN_CAP) { atomicAdd(&bar[XB_TMO], 1u); break; } }
    }
    nloc = mine > 0u ? mine : 1u; nx = cnt > 0u ? cnt : 1u;
}
DEV void xcd_barrier(const XcdBarrier& b) {
    asm volatile("s_waitcnt vmcnt(0)" ::: "memory");
    __syncthreads();
    if (threadIdx.x == 0) {
        unsigned* bar = b.bar;
        __builtin_amdgcn_s_waitcnt(0);
        unsigned nloc = b.st[0], nx = b.st[1];
        if (nloc == 0u) { xcd_barrier_complete(bar, b.x, nloc, nx); b.st[0] = nloc; b.st[1] = nx; }
        const unsigned old = xb_add(&bar[XB_XSUB(b.x)], 1u);
        const unsigned gen = old / nloc;
        if (old + 1u == (gen + 1u) * nloc) {
            __builtin_amdgcn_fence(__ATOMIC_RELEASE, "agent");
            asm volatile("s_waitcnt vmcnt(0)" ::: "memory");
            const unsigned og = xb_add(&bar[XB_TOP], 1u);
            const unsigned tg = og / nx;
            if (og + 1u == (tg + 1u) * nx) xb_add(&bar[XB_TOPGEN], 1u);
            else XB_SPIN(xb_ld(&bar[XB_TOPGEN]) == tg, bar);
            __builtin_amdgcn_fence(__ATOMIC_ACQUIRE, "agent");
            xb_add(&bar[XB_XGEN(b.x)], 1u);
            asm volatile("s_waitcnt vmcnt(0)" ::: "memory");
        } else {
            XB_SPIN(xb_ld(&bar[XB_XGEN(b.x)]) == gen, bar);
            __builtin_amdgcn_fence(__ATOMIC_ACQUIRE, "agent");
            asm volatile("s_waitcnt vmcnt(0)" ::: "memory");
        }
    }
    __syncthreads();
}

DEV void run_phase(const Params& p, int op, int arg, LAS unsigned char* lds) {
    const int layer = arg; const int jj = layer / 3;
    const float* hin = layer == 0 ? p.x : p.H;
    float* hout = layer == DEPTH - 1 ? p.out : p.H;
#ifdef ONLY_OP
    if (op != ONLY_OP) return;
#endif
#ifdef OPMASK
    if (!((OPMASK >> op) & 1ull)) return;
#endif
    switch (op) {
    case OP_CONVERT: phase_convert(p, lds);
#ifdef DBG
        if (blockIdx.x == 0 && threadIdx.x < 8) p.TAB[200 + threadIdx.x] = 0;
#endif
        break;
    case OP_RW_MIX: phase_rw_mix(p, jj, hin); break;
    case OP_RW_GEMM1: { SchedRW1 S{&p, jj}; EpiRW1 E{&p}; pg8::gemm_phase(lds, 1024, S, E); } break;
    case OP_RW_GEMM2: { SchedRW2 S{&p, jj}; EpiRW2 E{&p, jj}; pg8::gemm_phase(lds, 256, S, E); } break;
    case OP_RW_PREP: phase_rw_prep(p, jj); break;
    case OP_RW_CHA: phase_rw_cha(p, lds); break;
    case OP_RW_CHB: phase_rw_chb(p); break;
    case OP_RW_CHC: phase_rw_chc(p, jj, lds); break;
    case OP_RW_OUT: { SchedOut S{p.YB, p.rw_wo_t + (size_t)jj * D * D, 1024}; EpiOut E{p.MIX}; pg8::gemm_phase(lds, 1024, S, E); } break;
    case OP_LN1: phase_ln1(p, layer, hin, lds); break;
    case OP_MOE_SCATTER: phase_moe_scatter(p, lds); break;
    case OP_MOE_GEMM1: { SchedMoe<0> S{&p, layer}; EpiMoe1 E{p.ACT}; pg8::gemm_phase(lds, 1024, S, E); } break;
    case OP_MOE_GEMM2: { SchedMoe<1> S{&p, layer}; EpiMoe2 E{p.YBUF}; pg8::gemm_phase(lds, 512, S, E); } break;
    case OP_LN2: phase_ln2(p, layer, hout); break;
    case OP_MB_CAST: phase_mb_cast(p, jj, hin, lds); break;
    case OP_MB_GEMM_IN: { SchedMbIn S{&p}; EpiMbIn E{&p}; pg8::gemm_phase(lds, 1024, S, E); } break;
    case OP_MB_CONV: phase_mb_conv(p, jj); break;
    case OP_MB_STATES: phase_mb_states(p, jj, lds); break;
    case OP_MB_SCAN: phase_mb_scan(p); break;
    case OP_MB_OUT: phase_mb_out(p, jj, lds); break;
    case OP_MB_GEMM_OUT: { SchedOut S{p.YB, p.mb_wout_t + (size_t)jj * D * 2048, 2048}; EpiOut E{p.MIX}; pg8::gemm_phase(lds, 2048, S, E); } break;
    case OP_GL_CAST: phase_gl_cast(p, jj, hin, lds); break;
    case OP_GL_GEMM_IN: { SchedGlIn S{&p}; EpiGlIn E{&p}; pg8::gemm_phase(lds, 1024, S, E); } break;
    case OP_GL_KV: phase_gl_kv(p, lds); break;
    case OP_GL_SCAN: phase_gl_scan(p); break;
    case OP_GL_OUT: phase_gl_out(p, jj, lds); break;
    case OP_GL_GEMM_OUT: { SchedOut S{p.YB, p.gl_wout_t + (size_t)jj * D * D, 1024}; EpiOut E{p.MIX}; pg8::gemm_phase(lds, 1024, S, E); } break;
    default: break;
    }
}

constexpr int NPHASES = 1 + 13 + 12 + 11 + 13;
DEV void decode_phase(int ph, int& op, int& layer) {
    if (ph == 0) { op = OP_CONVERT; layer = 0; return; }
    int q = ph - 1; layer = 0;
    if (q >= 13) { q -= 13; layer = 1; if (q >= 12) { q -= 12; layer = 2; if (q >= 11) { q -= 11; layer = 3; } } }
    const int kind = layer % 3; const int nmix = kind == 0 ? 8 : kind == 1 ? 7 : 6;
    if (q < nmix) op = (kind == 0 ? OP_RW_MIX : kind == 1 ? OP_MB_CAST : OP_GL_CAST) + q;
    else op = OP_LN1 + (q - nmix);
}

#define X(t, n) t n##_,
template <bool COOP>
__global__ void __launch_bounds__(NTHR, 2) mega(PARAM_LIST(X) const int ph0, const int ph1) {
#undef X
    Params p;
#define X(t, n) p.n = n##_;
    PARAM_LIST(X)
#undef X
    extern __shared__ __attribute__((aligned(16))) unsigned char smem_raw[];
    LAS unsigned char* lds = (LAS unsigned char*)smem_raw;
    if constexpr (COOP) {
        volatile LAS unsigned* st = (volatile LAS unsigned*)(lds + LDS_BYTES - 16);
        if (threadIdx.x == 0) { st[0] = 0u; st[1] = 0u; }
        __syncthreads();
        XcdBarrier xb = xcd_barrier_post(p.bar, st);
        if (ph0 < 0) cg::this_grid().sync();
        for (int ph = ph0; ph < ph1; ++ph) {
            int op, arg; decode_phase(ph, op, arg);
#ifdef REPEAT_MASK
            if ((REPEAT_MASK >> op) & 1ull) { run_phase(p, op, arg, lds); xcd_barrier(xb); }
#endif
            run_phase(p, op, arg, lds);
            if (ph + 1 < ph1) xcd_barrier(xb);
        }
#ifdef DBG
        xcd_barrier(xb);
        { const int code = __hip_atomic_load(p.TAB + 200, __ATOMIC_RELAXED, __HIP_MEMORY_SCOPE_AGENT);
          for (size_t i = (size_t)blockIdx.x * NTHR + threadIdx.x; i < (size_t)T * D; i += (size_t)NB_ * NTHR) p.out[i] = 0.f;
          __syncthreads();
          if (blockIdx.x == 0 && threadIdx.x == 0) p.out[0] = sqrtf((float)DBG_DECODE(code) * 1.68e7f); }
#endif
    } else {
        for (int ph = ph0; ph < ph1; ++ph) { int op, arg; decode_phase(ph, op, arg); run_phase(p, op, arg, lds); }
    }
}

struct Bump { size_t off = 0; template <class Tp> Tp* take(char* base, size_t n) { Tp* r = (Tp*)(base + off); off += (n * sizeof(Tp) + 255) & ~(size_t)255; return r; } };

extern "C" void kernel_launch(void* const* d_in, const int* in_sizes, int n_in, void* d_out, int out_size, void* d_ws, size_t ws_size, hipStream_t stream) {
    (void)in_sizes; (void)n_in; (void)out_size;
    Params p; std::memset((void*)&p, 0, sizeof(p));
    auto F = [&](int i) { return (const float*)d_in[i]; };
    p.x = F(0); p.ln_g = F(1); p.ln_b = F(2);
    p.rw_mu = F(3); p.rw_w_rkv = F(4); p.rw_w0 = F(5); p.rw_w1 = F(6); p.rw_w2 = F(7); p.rw_a0 = F(8);
    p.rw_a1 = F(9); p.rw_a2 = F(10); p.rw_g1 = F(11); p.rw_g2 = F(12);
    p.rw_k_k = F(13); p.rw_k_a = F(14); p.rw_r_k = F(15); p.rw_lnx_g = F(16); p.rw_lnx_b = F(17); p.rw_w_o = F(18);
    p.mb_w_in = F(19); p.mb_conv_w = F(20); p.mb_conv_b = F(21); p.mb_dt_bias = F(22); p.mb_a_log = F(23); p.mb_d = F(24); p.mb_norm_g = F(25); p.mb_w_out = F(26);
    p.gl_w_in = F(27); p.gl_gk_w2 = F(28); p.gl_gk_b = F(29); p.gl_norm_g = F(30); p.gl_w_out = F(31);
    p.moe_w_group = F(32); p.moe_b_group = F(33); p.moe_w_route = F(34); p.moe_b_route = F(35); p.moe_w_in = F(36); p.moe_w_down = F(37);
    p.out = (float*)d_out;
    char* ws = (char*)d_ws; Bump B;
    p.bar = B.take<unsigned>(ws, XCD_BAR_WORDS);
    const size_t TD = (size_t)T * D;
    p.rw_rkv_t = B.take<bf16_t>(ws, 2 * 3 * (size_t)D * D); p.rw_w1_t = B.take<bf16_t>(ws, 2 * 256 * (size_t)D); p.rw_a1_t = B.take<bf16_t>(ws, 2 * 256 * (size_t)D); p.rw_g1_t = B.take<bf16_t>(ws, 2 * 256 * (size_t)D);
    p.rw_w2_t = B.take<bf16_t>(ws, 2 * (size_t)D * 256); p.rw_a2_t = B.take<bf16_t>(ws, 2 * (size_t)D * 256); p.rw_g2_t = B.take<bf16_t>(ws, 2 * (size_t)D * 256); p.rw_wo_t = B.take<bf16_t>(ws, 2 * (size_t)D * D);
    p.mb_win_t = B.take<bf16_t>(ws, 5120 * (size_t)D); p.mb_wout_t = B.take<bf16_t>(ws, (size_t)D * 2048); p.gl_win_t = B.take<bf16_t>(ws, 3072 * (size_t)D); p.gl_wout_t = B.take<bf16_t>(ws, (size_t)D * D);
    p.moe_w1_t = B.take<bf16_t>(ws, 128 * (size_t)1024 * 1024); p.moe_w2_t = B.take<bf16_t>(ws, 128 * (size_t)1024 * 512);
    p.H = B.take<float>(ws, TD); p.H1 = B.take<float>(ws, TD); p.MIX = B.take<float>(ws, TD);
    p.BUF = B.take<bf16_t>(ws, (size_t)MOE_ROWS * D); p.ACT = B.take<bf16_t>(ws, (size_t)MOE_ROWS * 512); p.YBUF = B.take<bf16_t>(ws, (size_t)MOE_ROWS * D);
    p.CNT = B.take<int>(ws, 256 * 32); p.EIDX = B.take<int>(ws, 2 * T); p.GATE = B.take<float>(ws, 2 * T); p.DEST = B.take<int>(ws, 2 * T); p.TAB = B.take<int>(ws, 256);
    p.YB = B.take<bf16_t>(ws, (size_t)T * 2048);
    const size_t arena0 = B.off;
    p.X6 = B.take<bf16_t>(ws, 6 * TD);
    p.P2 = (float*)p.X6; p.P3 = p.P2 + TD; p.P4 = p.P3 + TD;
    p.Rr = B.take<float>(ws, TD); p.Kk = B.take<float>(ws, TD); p.Vv = B.take<float>(ws, TD);
    p.Y = p.Rr;
    p.LW = B.take<bf16_t>(ws, 3 * (size_t)T * 256);
    p.Wd = B.take<float>(ws, TD); p.P5 = B.take<float>(ws, TD); p.Aa = B.take<float>(ws, TD); p.Gg = B.take<float>(ws, TD);
    p.C1 = B.take<float>(ws, (size_t)T * 16); p.C2 = B.take<float>(ws, (size_t)T * 16); p.BC = B.take<float>(ws, (size_t)T * 16);
    p.RWf = B.take<bf16_t>(ws, TD); p.RBf = B.take<bf16_t>(ws, TD); p.RUt = B.take<bf16_t>(ws, TD); p.RNa = B.take<bf16_t>(ws, TD); p.RGc = B.take<float>(ws, (size_t)4096 * 64); p.RUa = B.take<bf16_t>(ws, TD); p.RS0 = B.take<bf16_t>(ws, TD);
    { Bump A2; A2.off = arena0 + ((TD * 2 + 255) & ~(size_t)255);
      p.Z = A2.take<bf16_t>(ws, (size_t)T * 2048); p.XBC = A2.take<bf16_t>(ws, (size_t)T * 3072); p.XC = A2.take<bf16_t>(ws, (size_t)T * 3072);
      p.DT = A2.take<float>(ws, (size_t)T * 32); p.STATES = A2.take<float>(ws, (size_t)128 * 32 * 64 * 128); p.CD = A2.take<float>(ws, 128 * 32);
      p.PREV = A2.take<bf16_t>(ws, (size_t)128 * 32 * 64 * 128);
      p.LA = A2.take<float>(ws, (size_t)T * 512); p.CDG = A2.take<float>(ws, 256 * 4 * 128);
      p.QKVG = p.XBC;
      if (A2.off > B.off) B.off = A2.off; }
    if (B.off > ws_size) { fprintf(stderr, "workspace too small: need %zu have %zu\n", B.off, ws_size); return; }
    const int np = NPHASES;
#define X(t, n) (void*)&p.n,
#if SINGLE_LAUNCH
    (void)hipFuncSetAttribute((const void*)mega<true>, hipFuncAttributeMaxDynamicSharedMemorySize, LDS_BYTES);
    (void)hipMemsetAsync(p.bar, 0, XCD_BAR_WORDS * sizeof(unsigned), stream);
    int ph0 = 0, ph1 = np; void* args[] = {PARAM_LIST(X) (void*)&ph0, (void*)&ph1};
    hipError_t e = hipLaunchCooperativeKernel((const void*)mega<true>, dim3(NBLK), dim3(NTHR), args, LDS_BYTES, stream);
    if (e != hipSuccess) fprintf(stderr, "cooperative launch failed: %s\n", hipGetErrorString(e));
#else
    (void)hipFuncSetAttribute((const void*)mega<false>, hipFuncAttributeMaxDynamicSharedMemorySize, LDS_BYTES);
    for (int ph = 0; ph < np; ++ph) { int ph0 = ph, ph1 = ph + 1; void* args[] = {PARAM_LIST(X) (void*)&ph0, (void*)&ph1};
        hipError_t e = hipLaunchKernel((const void*)mega<false>, dim3(NBLK), dim3(NTHR), args, LDS_BYTES, stream);
        if (e != hipSuccess) fprintf(stderr, "launch failed: %s\n", hipGetErrorString(e)); }
#endif
#undef X
}
```

```cpp
#include <hip/hip_runtime.h>
#include <hip/hip_cooperative_groups.h>
#include <cstdint>
#include <cstdio>
#include <cstring>
namespace cg = cooperative_groups;

typedef unsigned short bf16_t;
typedef short bf16x8 __attribute__((ext_vector_type(8)));
typedef short s16x4 __attribute__((ext_vector_type(4)));
typedef float f32x4 __attribute__((ext_vector_type(4)));
typedef float f32x2 __attribute__((ext_vector_type(2)));
typedef unsigned u32x4 __attribute__((ext_vector_type(4)));
typedef unsigned u32x2 __attribute__((ext_vector_type(2)));
#define LAS __attribute__((address_space(3)))
#define DEV __device__ __forceinline__

constexpr int T = 16384, D = 1024, DEPTH = 4;
constexpr int NTHR = 512, NBLK = 256;
constexpr int LDS_BYTES = 155648;
constexpr float ALPHA = 1.681792830507429f;
constexpr float LN_EPS = 1e-5f;
constexpr int MOE_ROWS = 40960;

DEV int tid_() { int t = threadIdx.x; asm volatile("" : "+v"(t)); return t; }
DEV int bid_() { int b = blockIdx.x; asm volatile("" : "+s"(b)); return b; }
#define NB_ 256
DEV unsigned f2bf(float f) { unsigned u = __float_as_uint(f); u += 0x7FFFu + ((u >> 16) & 1u); return u >> 16; }
DEV float bf2f(unsigned short b) { return __uint_as_float(((unsigned)b) << 16); }
typedef __bf16 bf16n2 __attribute__((ext_vector_type(2)));
DEV unsigned pk2(float lo, float hi) { f32x2 v = {lo, hi}; bf16n2 b = __builtin_convertvector(v, bf16n2); return __builtin_bit_cast(unsigned, b); }
DEV float bflo(unsigned u) { return __uint_as_float(u << 16); }
DEV float bfhi(unsigned u) { return __uint_as_float(u & 0xFFFF0000u); }
DEV float sigmoidf_(float x) { return 1.0f / (1.0f + __expf(-x)); }
DEV float siluf_(float x) { return x / (1.0f + __expf(-x)); }
DEV float softplusf_(float x) { return fmaxf(x, 0.f) + __logf(1.0f + __expf(-fabsf(x))); }
DEV float tanhf_(float x) { const float e = __expf(-2.0f * fabsf(x)); const float r = (1.0f - e) / (1.0f + e); return x < 0.f ? -r : r; }
DEV float wave_sum(float v) {
#pragma unroll
    for (int o = 32; o > 0; o >>= 1) v += __shfl_xor(v, o);
    return v;
}
DEV float sum16(float v) {
#pragma unroll
    for (int o = 8; o > 0; o >>= 1) v += __shfl_xor(v, o);
    return v;
}
template <int N> DEV float reduce_scatter(float (&v)[N], int lane) {
    int s = 1;
#pragma unroll
    for (int h = N / 2; h >= 1; h >>= 1) {
#pragma unroll
        for (int i = 0; i < h; ++i) {
            const bool up = (lane & s) != 0;
            const float send = up ? v[i] : v[i + h];
            const float keep = up ? v[i + h] : v[i];
            v[i] = keep + __shfl_xor(send, s);
        }
        s <<= 1;
    }
    float r = v[0];
    for (; s < 64; s <<= 1) r += __shfl_xor(r, s);
    return r;
}
template <int N> DEV int rs_index(int lane) {
    int o = 0, s = 1;
#pragma unroll
    for (int h = N / 2; h >= 1; h >>= 1) { if (lane & s) o += h; s <<= 1; }
    return o;
}

DEV bf16x8 frag_rm(const LAS bf16_t* base, int ld, int row0, int k0, int lane) {
    return *(const LAS bf16x8*)(base + (row0 + (lane & 15)) * ld + k0 + 8 * (lane >> 4));
}
DEV bf16x8 frag_tr(const LAS bf16_t* base, int ld, int k0, int c0, int lane) {
    const int g = lane >> 4, i = lane & 15, q = i >> 2, p = i & 3;
    const LAS bf16_t* a = base + (k0 + 8 * g + q) * ld + c0 + 4 * p;
    s16x4 lo = __builtin_amdgcn_ds_read_tr16_b64_v4i16((LAS s16x4*)a);
    s16x4 hi = __builtin_amdgcn_ds_read_tr16_b64_v4i16((LAS s16x4*)(a + 4 * ld));
    bf16x8 r; r[0] = lo[0]; r[1] = lo[1]; r[2] = lo[2]; r[3] = lo[3]; r[4] = hi[0]; r[5] = hi[1]; r[6] = hi[2]; r[7] = hi[3];
    return r;
}
#define MFMA16(a, b, c) __builtin_amdgcn_mfma_f32_16x16x32_bf16((a), (b), (c), 0, 0, 0)
DEV size_t fragmajor_off(int n, int k, int K) { return ((size_t)((n >> 4) * (K >> 5) + (k >> 5)) * 64 + (n & 15) + 16 * ((k & 31) >> 3)) * 8 + (k & 7); }

template <int N> DEV void skinny_group(const f32x4 (&z)[4], const LAS float* wt, int lane, LAS float* outw) {
    float pe[N];
#pragma unroll
    for (int o = 0; o < N; ++o) {
        float a = 0.f;
#pragma unroll
        for (int q = 0; q < 4; ++q) { const f32x4 w = *(const LAS f32x4*)(wt + o * 1028 + 256 * q + 4 * lane); a += z[q][0] * w[0] + z[q][1] * w[1] + z[q][2] * w[2] + z[q][3] * w[3]; }
        pe[o] = a;
    }
    const float r = reduce_scatter<N>(pe, lane);
    if (lane < N) outw[rs_index<N>(lane)] = r;
}
#ifndef SINGLE_LAUNCH
#define SINGLE_LAUNCH 1
#endif
constexpr size_t OFF_bar = 0ull;
constexpr size_t OFF_rw_rkv_t = 13824ull;
constexpr size_t OFF_rw_w1_t = 12596736ull;
constexpr size_t OFF_rw_a1_t = 13645312ull;
constexpr size_t OFF_rw_g1_t = 14693888ull;
constexpr size_t OFF_rw_w2_t = 15742464ull;
constexpr size_t OFF_rw_a2_t = 16791040ull;
constexpr size_t OFF_rw_g2_t = 17839616ull;
constexpr size_t OFF_rw_wo_t = 18888192ull;
constexpr size_t OFF_mb_win_t = 23082496ull;
constexpr size_t OFF_mb_wout_t = 33568256ull;
constexpr size_t OFF_gl_win_t = 37762560ull;
constexpr size_t OFF_gl_wout_t = 44054016ull;
constexpr size_t OFF_moe_w1_t = 46151168ull;
constexpr size_t OFF_moe_w2_t = 314586624ull;
constexpr size_t OFF_H = 448804352ull;
constexpr size_t OFF_H1 = 515913216ull;
constexpr size_t OFF_MIX = 583022080ull;
constexpr size_t OFF_BUF = 650130944ull;
constexpr size_t OFF_ACT = 734017024ull;
constexpr size_t OFF_YBUF = 775960064ull;
constexpr size_t OFF_CNT = 859846144ull;
constexpr size_t OFF_EIDX = 859878912ull;
constexpr size_t OFF_GATE = 860009984ull;
constexpr size_t OFF_DEST = 860141056ull;
constexpr size_t OFF_TAB = 860272128ull;
constexpr size_t OFF_YB = 860273152ull;
constexpr size_t OFF_X6 = 927382016ull;
constexpr size_t OFF_Rr = 1128708608ull;
constexpr size_t OFF_Kk = 1195817472ull;
constexpr size_t OFF_Vv = 1262926336ull;
constexpr size_t OFF_LW = 1330035200ull;
constexpr size_t OFF_Wd = 1355201024ull;
constexpr size_t OFF_Aa = 1422309888ull;
constexpr size_t OFF_Gg = 1489418752ull;
constexpr size_t OFF_RWf = 1556527616ull;
constexpr size_t OFF_RBf = 1590082048ull;
constexpr size_t OFF_RUt = 1623636480ull;
constexpr size_t OFF_RNa = 1657190912ull;
constexpr size_t OFF_RGc = 1690745344ull;
constexpr size_t OFF_RUa = 1691793920ull;
constexpr size_t OFF_RS0 = 1725348352ull;
constexpr size_t OFF_Z = 960936448ull;
constexpr size_t OFF_XBC = 1028045312ull;
constexpr size_t OFF_XC = 1128708608ull;
constexpr size_t OFF_DT = 1229371904ull;
constexpr size_t OFF_STATES = 1231469056ull;
constexpr size_t OFF_CD = 1365686784ull;
constexpr size_t OFF_PREV = 1365703168ull;
constexpr size_t OFF_LA = 1432812032ull;
constexpr size_t OFF_CDG = 1466366464ull;
constexpr size_t OFF_QKVG = OFF_XBC;
constexpr size_t WS_TOTAL = 1758902784ull;
typedef unsigned T_bar;
typedef bf16_t T_rw_rkv_t;
typedef bf16_t T_rw_w1_t;
typedef bf16_t T_rw_a1_t;
typedef bf16_t T_rw_g1_t;
typedef bf16_t T_rw_w2_t;
typedef bf16_t T_rw_a2_t;
typedef bf16_t T_rw_g2_t;
typedef bf16_t T_rw_wo_t;
typedef bf16_t T_mb_win_t;
typedef bf16_t T_mb_wout_t;
typedef bf16_t T_gl_win_t;
typedef bf16_t T_gl_wout_t;
typedef bf16_t T_moe_w1_t;
typedef bf16_t T_moe_w2_t;
typedef float T_H;
typedef float T_H1;
typedef float T_MIX;
typedef bf16_t T_BUF;
typedef bf16_t T_ACT;
typedef bf16_t T_YBUF;
typedef int T_CNT;
typedef int T_EIDX;
typedef float T_GATE;
typedef int T_DEST;
typedef int T_TAB;
typedef bf16_t T_YB;
typedef bf16_t T_X6;
typedef float T_Rr;
typedef float T_Kk;
typedef float T_Vv;
typedef bf16_t T_LW;
typedef float T_Wd;
typedef float T_Aa;
typedef float T_Gg;
typedef bf16_t T_RWf;
typedef bf16_t T_RBf;
typedef bf16_t T_RUt;
typedef bf16_t T_RNa;
typedef float T_RGc;
typedef bf16_t T_RUa;
typedef bf16_t T_RS0;
typedef bf16_t T_Z;
typedef bf16_t T_XBC;
typedef bf16_t T_XC;
typedef float T_DT;
typedef float T_STATES;
typedef float T_CD;
typedef bf16_t T_PREV;
typedef float T_LA;
typedef float T_CDG;
typedef bf16_t T_QKVG;
#define WS_(P, N) ((T_##N*)((P).ws + OFF_##N))
struct ConvJob {
    const float* src; bf16_t* dst;
    int K, N, src_ld, Kpad, Npad, perm, batch;
    long long src_bs, dst_bs;
    DEV int ntiles() const { return (Kpad / 64) * (Npad / 64) * batch; }
};
constexpr int NJOBS = 14;

#define PARAM_LIST(X) \
    X(const float*, x) X(const float*, ln_g) X(const float*, ln_b) \
    X(const float*, rw_mu) X(const float*, rw_w_rkv) X(const float*, rw_w0) X(const float*, rw_w1) X(const float*, rw_w2) X(const float*, rw_a0) X(const float*, rw_a1) X(const float*, rw_a2) \
    X(const float*, rw_g1) X(const float*, rw_g2) X(const float*, rw_k_k) X(const float*, rw_k_a) X(const float*, rw_r_k) X(const float*, rw_lnx_g) X(const float*, rw_lnx_b) X(const float*, rw_w_o) \
    X(const float*, mb_w_in) X(const float*, mb_conv_w) X(const float*, mb_conv_b) X(const float*, mb_dt_bias) X(const float*, mb_a_log) X(const float*, mb_d) X(const float*, mb_norm_g) X(const float*, mb_w_out) \
    X(const float*, gl_w_in) X(const float*, gl_gk_w2) X(const float*, gl_gk_b) X(const float*, gl_norm_g) X(const float*, gl_w_out) \
    X(const float*, moe_w_group) X(const float*, moe_b_group) X(const float*, moe_w_route) X(const float*, moe_b_route) X(const float*, moe_w_in) X(const float*, moe_w_down) \
    X(float*, out) X(char*, ws)
struct Params {
#define X(t, n) t n;
    PARAM_LIST(X)
#undef X
};

enum Op : unsigned char { OP_CONVERT = 0, OP_RW_MIX, OP_RW_GEMM1, OP_RW_GEMM2, OP_RW_CHA, OP_RW_CHB, OP_RW_CHC, OP_RW_OUT,
    OP_LN1, OP_MOE_SCATTER, OP_MOE_GEMM1, OP_MOE_GEMM2, OP_LN2,
    OP_MB_CAST, OP_MB_GEMM_IN, OP_MB_CONV, OP_MB_STATES, OP_MB_SCAN, OP_MB_OUT, OP_MB_GEMM_OUT,
    OP_GL_CAST, OP_GL_GEMM_IN, OP_GL_KV, OP_GL_SCAN, OP_GL_OUT, OP_GL_GEMM_OUT };


DEV ConvJob make_job(const Params& p, int q) {
    const long long DD = (long long)D * D;
    switch (q) {
    case 0: return ConvJob{p.rw_w_rkv, WS_(p, rw_rkv_t), 1024, 1024, 1024, 1024, 1024, 0, 6, DD, DD};
    case 1: return ConvJob{p.rw_w1, WS_(p, rw_w1_t), 1024, 64, 64, 1024, 256, 0, 2, (long long)D * 64, (long long)256 * D};
    case 2: return ConvJob{p.rw_a1, WS_(p, rw_a1_t), 1024, 64, 64, 1024, 256, 0, 2, (long long)D * 64, (long long)256 * D};
    case 3: return ConvJob{p.rw_g1, WS_(p, rw_g1_t), 1024, 160, 160, 1024, 256, 0, 2, (long long)D * 160, (long long)256 * D};
    case 4: return ConvJob{p.rw_w2, WS_(p, rw_w2_t), 64, 1024, 1024, 256, 1024, 0, 2, (long long)64 * D, (long long)D * 256};
    case 5: return ConvJob{p.rw_a2, WS_(p, rw_a2_t), 64, 1024, 1024, 256, 1024, 0, 2, (long long)64 * D, (long long)D * 256};
    case 6: return ConvJob{p.rw_g2, WS_(p, rw_g2_t), 160, 1024, 1024, 256, 1024, 0, 2, (long long)160 * D, (long long)D * 256};
    case 7: return ConvJob{p.rw_w_o, WS_(p, rw_wo_t), 1024, 1024, 1024, 1024, 1024, 0, 2, DD, DD};
    case 8: return ConvJob{p.mb_w_in, WS_(p, mb_win_t), 1024, 5120, 5152, 1024, 5120, 0, 1, 0, 0};
    case 9: return ConvJob{p.mb_w_out, WS_(p, mb_wout_t), 2048, 1024, 1024, 2048, 1024, 0, 1, 0, 0};
    case 10: return ConvJob{p.gl_w_in, WS_(p, gl_win_t), 1024, 3072, 3088, 1024, 3072, 0, 1, 0, 0};
    case 11: return ConvJob{p.gl_w_out, WS_(p, gl_wout_t), 1024, 1024, 1024, 1024, 1024, 0, 1, 0, 0};
    case 12: return ConvJob{p.moe_w_in, WS_(p, moe_w1_t), 1024, 1024, 1024, 1024, 1024, 1, 128, DD, DD};
    default: return ConvJob{p.moe_w_down, WS_(p, moe_w2_t), 512, 1024, 1024, 512, 1024, 0, 128, (long long)512 * 1024, (long long)1024 * 512};
    }
}

DEV void phase_convert(const Params& p, LAS unsigned char* lds) {
    const int tid = tid_(), bid = bid_(); (void)tid; (void)bid;
    LAS bf16_t* tile = (LAS bf16_t*)lds;
    int tbeg = 0;
#pragma unroll
    for (int j = 0; j < NJOBS; ++j) {
      const ConvJob J = make_job(p, j);
      const int jend = tbeg + J.ntiles();
      const int ti0 = tbeg + (((int)bid - tbeg) % NB_ + NB_) % NB_;
      const int jbeg = tbeg; tbeg = jend;
#pragma unroll 1
      for (int ti = ti0; ti < jend; ti += NB_) {
        int local = ti - jbeg;
        const int tk = J.Kpad / 64, tn = J.Npad / 64;
        const int b = local / (tk * tn); local -= b * tk * tn;
        const int nt = local / tk, kt = local - nt * tk;
        const float* src = J.src + (size_t)b * J.src_bs;
        bf16_t* dst = J.dst + (size_t)b * J.dst_bs;
        const int k0 = kt * 64, n0 = nt * 64;
#pragma unroll
        for (int pass = 0; pass < 2; ++pass) {
            const int kk = (tid >> 4) + pass * 32, nn = (tid & 15) * 4;
            f32x4 v = {0.f, 0.f, 0.f, 0.f};
            if (k0 + kk < J.K && n0 + nn < J.N) v = *(const f32x4*)(src + (size_t)(k0 + kk) * J.src_ld + n0 + nn);
#pragma unroll
            for (int e = 0; e < 4; ++e) tile[(nn + e) * 72 + kk] = (bf16_t)f2bf(v[e]);
        }
        __syncthreads();
        {
            const int nn = tid >> 3, kc = (tid & 7) * 8;
            int nsrc = n0 + nn, ndst = nsrc;
            if (J.perm == 1) { const int up = nsrc >= 512, jj = nsrc - (up ? 512 : 0); ndst = (jj >> 7) * 256 + (up ? 128 : 0) + (jj & 127); }
            const u32x4 v = *(const LAS u32x4*)(tile + nn * 72 + kc);
            *(u32x4*)(dst + (size_t)ndst * J.Kpad + k0 + kc) = v;
        }
        __syncthreads();
      }
    }
}
namespace pg8 {
constexpr int BM = 256, BK = 64, HALF = 128, HTB = HALF * BK * 2, STAGE_BYTES = 8 * HTB;
DEV int lds_byte(int r, int c) { const int st = (r >> 4) * 2 + (c >> 5), rr = r & 15, cc = c & 31, ob = rr * 64 + cc * 2; return st * 1024 + (ob ^ (((ob >> 9) & 1) << 5)); }
DEV void stage_rc(int b, int& R, int& C) { const int st = b / 1024, sb = b % 1024, swz = sb ^ (((sb >> 9) & 1) << 5); R = (st >> 1) * 16 + swz / 64; C = (st & 1) * 32 + (swz % 64) / 2; }

struct Unit { const char* A; const char* B; int row0, col0, id, aux; };

DEV bool tile_order(int i, int G, int c, int nM, int nN, int& pm, int& pn) {
    const int nwg = nM * nN; const long L = (long)i * G + c; if (L >= nwg) return false;
    int wgid = (int)L; { const int q = nwg / 8, r = nwg % 8, xcd = wgid % 8, off = wgid / 8; wgid = (xcd < r ? xcd * (q + 1) : r * (q + 1) + (xcd - r) * q) + off; }
    const int nig = 8 * nN, gid = wgid / nig, fm = gid * 8, gsz = (nM - fm) < 8 ? (nM - fm) : 8;
    pm = fm + ((wgid % nig) % gsz); pn = (wgid % nig) / gsz; return true;
}

template <class Epi, class Sched>
DEV void gemm_phase(LAS unsigned char* lds, const int K, const Sched& S, const Epi& E) {
    const int tid = tid_(), wid = __builtin_amdgcn_readfirstlane(tid >> 6), lane = tid & 63, wr = wid >> 2, wc = wid & 3, fr = lane & 15, fq = lane >> 4;
    const int nt = K / BK;
    unsigned voff[2];
#pragma unroll
    for (int i = 0; i < 2; ++i) { int R, C; stage_rc(tid * 16 + i * 8192, R, C); voff[i] = (unsigned)(R * K + C) * 2u; }
    const size_t kstep = (size_t)(BK * 2);
    const size_t hstep = (size_t)HALF * K * 2;
    const unsigned ldsw = (unsigned)wid * 1024u;
    const int aoff = lds_byte(wr * 64 + fr, fq * 8), boff = lds_byte(wc * 32 + fr, fq * 8);
#define PG8_SA(b, h) (((b) * 2 + (h)) * HTB)
#define PG8_SB(b, h) ((4 + (b) * 2 + (h)) * HTB)
#define PG8_STAGE(bufoff, gbase) do { _Pragma("unroll") for (int _i = 0; _i < 2; ++_i) \
        __builtin_amdgcn_global_load_lds((const unsigned*)((const char*)(gbase) + voff[_i]), (LAS unsigned*)(lds + (bufoff) + ldsw + _i * 8192), 16, 0, 0); } while (0)
#define PG8_LDA(dst, b, h) do { _Pragma("unroll") for (int m = 0; m < 4; ++m) _Pragma("unroll") for (int k = 0; k < 2; ++k) dst[m][k] = *(const LAS bf16x8*)(lds + PG8_SA(b, h) + aoff + m * 2048 + k * 1024); } while (0)
#define PG8_LDB(dst, b, h) do { _Pragma("unroll") for (int n = 0; n < 2; ++n) _Pragma("unroll") for (int k = 0; k < 2; ++k) dst[n][k] = *(const LAS bf16x8*)(lds + PG8_SB(b, h) + boff + n * 2048 + k * 1024); } while (0)
#define PG8_MMA(ai, bj, At, Bt) do { __builtin_amdgcn_s_setprio(1); _Pragma("unroll") for (int m = 0; m < 4; ++m) _Pragma("unroll") for (int n = 0; n < 2; ++n) _Pragma("unroll") for (int k = 0; k < 2; ++k) \
        acc[ai][bj][m][n] = __builtin_amdgcn_mfma_f32_16x16x32_bf16(Bt[n][k], At[m][k], acc[ai][bj][m][n], 0, 0, 0); __builtin_amdgcn_s_setprio(0); } while (0)
#define PG8_WAIT_V(n) asm volatile("s_waitcnt vmcnt(" #n ")" ::: "memory")
#define PG8_WAIT_L(n) asm volatile("s_waitcnt lgkmcnt(" #n ")" ::: "memory")
#define PG8_BAR __builtin_amdgcn_s_barrier()
#define PG8_SCHED __builtin_amdgcn_sched_barrier(0)
    Unit cur, nxt; int ui = 0;
    if (!S.next(0, cur)) return;
    f32x4 acc[2][2][4][2];
#pragma unroll
    for (int a = 0; a < 2; ++a)
#pragma unroll
        for (int b = 0; b < 2; ++b)
#pragma unroll
            for (int m = 0; m < 4; ++m)
#pragma unroll
                for (int n = 0; n < 2; ++n) acc[a][b][m][n] = (f32x4){0.f, 0.f, 0.f, 0.f};
    bf16x8 At[4][2], B0[2][2], B1[2][2];
    const char* cA = cur.A; const char* cB = cur.B;
    PG8_STAGE(PG8_SB(0, 0), cB); PG8_STAGE(PG8_SA(0, 0), cA); PG8_STAGE(PG8_SB(0, 1), cB + hstep); PG8_STAGE(PG8_SA(0, 1), cA + hstep);
    if (wr == 1) PG8_BAR;
    PG8_WAIT_V(4); PG8_BAR;
    PG8_STAGE(PG8_SB(1, 0), cB + kstep); PG8_STAGE(PG8_SA(1, 0), cA + kstep); PG8_STAGE(PG8_SB(1, 1), cB + hstep + kstep);
    PG8_WAIT_V(6); PG8_BAR;
    for (;;) {
        const bool has_next = S.next(ui + 1, nxt);
        const char* nA = has_next ? nxt.A : cA; const char* nB = has_next ? nxt.B : cB;
#pragma unroll 1
        for (int t = 0; t < nt; t += 2) {
            const bool last = (t == nt - 2);
            const char* a1 = cA + (size_t)(t + 1) * kstep;
            const char* a2 = last ? nA : cA + (size_t)(t + 2) * kstep; const char* b2 = last ? nB : cB + (size_t)(t + 2) * kstep;
            const char* a3 = a2 + kstep; const char* b3 = b2 + kstep;
            PG8_LDB(B0, 0, 0); PG8_SCHED; PG8_LDA(At, 0, 0); PG8_STAGE(PG8_SA(1, 1), a1 + hstep);
            PG8_WAIT_L(8); PG8_BAR; PG8_WAIT_L(0); PG8_MMA(0, 0, At, B0); PG8_BAR; PG8_SCHED;
            PG8_LDB(B1, 0, 1); PG8_STAGE(PG8_SB(0, 0), b2);
            PG8_BAR; PG8_WAIT_L(0); PG8_MMA(0, 1, At, B1); PG8_BAR;
            PG8_LDA(At, 0, 1); PG8_STAGE(PG8_SA(0, 0), a2);
            PG8_BAR; PG8_WAIT_L(0); PG8_MMA(1, 0, At, B0); PG8_BAR; PG8_SCHED;
            PG8_STAGE(PG8_SB(0, 1), b2 + hstep);
            PG8_WAIT_V(6); PG8_BAR; PG8_MMA(1, 1, At, B1); PG8_BAR;
            PG8_LDB(B0, 1, 0); PG8_SCHED; PG8_LDA(At, 1, 0); PG8_STAGE(PG8_SA(0, 1), a2 + hstep);
            PG8_WAIT_L(8); PG8_BAR; PG8_WAIT_L(0); PG8_MMA(0, 0, At, B0); PG8_BAR; PG8_SCHED;
            PG8_LDB(B1, 1, 1); PG8_STAGE(PG8_SB(1, 0), b3);
            PG8_BAR; PG8_WAIT_L(0); PG8_MMA(0, 1, At, B1); PG8_BAR;
            PG8_LDA(At, 1, 1); PG8_STAGE(PG8_SA(1, 0), a3);
            PG8_BAR; PG8_WAIT_L(0); PG8_MMA(1, 0, At, B0); PG8_BAR; PG8_SCHED;
            PG8_STAGE(PG8_SB(1, 1), b3 + hstep);
            PG8_WAIT_V(6); PG8_BAR; PG8_MMA(1, 1, At, B1); PG8_BAR;
        }
        E(acc, cur, wr, wc, fr, fq);
        if (!has_next) break;
#pragma unroll
        for (int a = 0; a < 2; ++a)
#pragma unroll
            for (int b = 0; b < 2; ++b)
#pragma unroll
                for (int m = 0; m < 4; ++m)
#pragma unroll
                    for (int n = 0; n < 2; ++n) acc[a][b][m][n] = (f32x4){0.f, 0.f, 0.f, 0.f};
        cur = nxt; cA = nA; cB = nB; ++ui;
    }
    PG8_WAIT_V(0);
    if (wr == 0) PG8_BAR;
    PG8_BAR;
#undef PG8_SA
#undef PG8_SB
#undef PG8_STAGE
#undef PG8_LDA
#undef PG8_LDB
#undef PG8_MMA
#undef PG8_WAIT_V
#undef PG8_WAIT_L
#undef PG8_BAR
#undef PG8_SCHED
}
}
using pg8::Unit;
typedef f32x4 AccT[2][2][4][2];
#define FOR_ACC(ai, bj, m, n) _Pragma("unroll") for (int ai = 0; ai < 2; ++ai) _Pragma("unroll") for (int m = 0; m < 4; ++m) _Pragma("unroll") for (int bj = 0; bj < 2; ++bj) _Pragma("unroll") for (int n = 0; n < 2; ++n)
#define ACC_FENCE __builtin_amdgcn_sched_barrier(0)
#define ACC_ROW(u, ai, m) ((u).row0 + 128 * (ai) + 64 * wr + 16 * (m) + fr)
#define ACC_COL(u, bj, n) ((u).col0 + 128 * (bj) + 32 * wc + 16 * (n) + 4 * fq)
DEV void st_bf4(bf16_t* p, f32x4 v) { u32x2 w; w.x = pk2(v[0], v[1]); w.y = pk2(v[2], v[3]); *(u32x2*)p = w; }
DEV void load_row(const float* p, int lane, f32x4 (&v)[4]) {
#pragma unroll
    for (int q = 0; q < 4; ++q) v[q] = *(const f32x4*)(p + 256 * q + 4 * lane);
}

DEV void phase_rw_mix(const Params& p, int j, const float* hin) {
    const int tid = tid_(), bid = bid_(); (void)tid; (void)bid;
    const int lane = tid & 63, wid = tid >> 6;
    const float* mu = p.rw_mu + (size_t)j * 6 * D;
    for (int r = 0; r < 8; ++r) {
        const int t = bid * 64 + wid * 8 + r;
        f32x4 x[4], xp[4];
        load_row(hin + (size_t)t * D, lane, x);
        if (t > 0) load_row(hin + (size_t)(t - 1) * D, lane, xp);
        else { for (int q = 0; q < 4; ++q) xp[q] = (f32x4){0.f, 0.f, 0.f, 0.f}; }
#pragma unroll
        for (int s = 0; s < 6; ++s) {
#pragma unroll
            for (int q = 0; q < 4; ++q) {
                const f32x4 m = *(const f32x4*)(mu + s * D + 256 * q + 4 * lane);
                const f32x4 o = x[q] + (xp[q] - x[q]) * m;
                st_bf4(WS_(p, X6) + (size_t)s * T * D + (size_t)t * D + 256 * q + 4 * lane, o);
            }
        }
    }
}

struct SchedRW1 {
    const Params* p; int j;
    DEV bool next(int i, Unit& u) const {
        int pm, pn; if (!pg8::tile_order(i, NB_, bid_(), 64, 15, pm, pn)) return false;
        int id, lpn; if (pn < 12) { id = pn >> 2; lpn = pn & 3; } else { id = 3 + (pn - 12); lpn = 0; }
        u.A = (const char*)(WS_(*p, X6) + (size_t)id * T * D + (size_t)pm * 256 * D);
        const bf16_t* B;
        if (id < 3) B = WS_(*p, rw_rkv_t) + ((size_t)j * 3 + id) * D * D + (size_t)lpn * 256 * D;
        else B = WS_(*p, rw_w1_t) + (size_t)(id - 3) * (2 * 256 * D) + (size_t)j * 256 * D;
        u.B = (const char*)B; u.row0 = pm * 256; u.col0 = lpn * 256; u.id = id; u.aux = 0; return true;
    }
};
struct EpiRW1 {
    const Params* p;
    DEV void operator()(const AccT& acc, const Unit& u, int wr, int wc, int fr, int fq) const {
        if (u.id < 3) {
            float* O = WS_(*p, Rr) + (size_t)u.id * T * D;
            FOR_ACC(ai, bj, m, n) *(f32x4*)(O + (size_t)ACC_ROW(u, ai, m) * D + ACC_COL(u, bj, n)) = acc[ai][bj][m][n];
        } else {
            bf16_t* O = WS_(*p, LW) + (size_t)(u.id - 3) * T * 256;
            FOR_ACC(ai, bj, m, n) {
                f32x4 v = acc[ai][bj][m][n];
                if (u.id == 3) { for (int e = 0; e < 4; ++e) v[e] = tanhf_(v[e]); }
                else if (u.id == 5) { for (int e = 0; e < 4; ++e) v[e] = sigmoidf_(v[e]); }
                st_bf4(O + (size_t)ACC_ROW(u, ai, m) * 256 + ACC_COL(u, bj, n), v); ACC_FENCE;
            }
        }
    }
};
struct SchedRW2 {
    const Params* p; int j;
    DEV bool next(int i, Unit& u) const {
        int pm, pn; if (!pg8::tile_order(i, NB_, bid_(), 64, 12, pm, pn)) return false;
        const int id = pn >> 2, lpn = pn & 3;
        u.A = (const char*)(WS_(*p, LW) + (size_t)id * T * 256 + (size_t)pm * 256 * 256);
        const bf16_t* B = WS_(*p, rw_w2_t) + (size_t)id * (2 * D * 256) + (size_t)j * D * 256 + (size_t)lpn * 256 * 256;
        u.B = (const char*)B; u.row0 = pm * 256; u.col0 = lpn * 256; u.id = id; u.aux = 0; return true;
    }
};
struct EpiRW2 {
    const Params* p; int j;
    DEV void operator()(const AccT& acc, const Unit& u, int wr, int wc, int fr, int fq) const {
        if (u.id == 0) { const float* bias = p->rw_w0 + (size_t)j * D;
            FOR_ACC(ai, bj, m, n) { f32x4 v = acc[ai][bj][m][n]; const int c = ACC_COL(u, bj, n); const f32x4 b = *(const f32x4*)(bias + c);
                for (int e = 0; e < 4; ++e) { const float x = -(b[e] + v[e]); const float wl = -(fmaxf(x, 0.f) + __logf(1.0f + __expf(-fabsf(x)))) - 0.5f; v[e] = -__expf(wl); }
                *(f32x4*)(WS_(*p, Wd) + (size_t)ACC_ROW(u, ai, m) * D + c) = v; ACC_FENCE; } }
        else if (u.id == 1) { const float* bias = p->rw_a0 + (size_t)j * D;
            FOR_ACC(ai, bj, m, n) { f32x4 v = acc[ai][bj][m][n]; const int c = ACC_COL(u, bj, n); const f32x4 b = *(const f32x4*)(bias + c);
                for (int e = 0; e < 4; ++e) v[e] = sigmoidf_(b[e] + v[e]);
                *(f32x4*)(WS_(*p, Aa) + (size_t)ACC_ROW(u, ai, m) * D + c) = v; ACC_FENCE; } }
        else { FOR_ACC(ai, bj, m, n) *(f32x4*)(WS_(*p, Gg) + (size_t)ACC_ROW(u, ai, m) * D + ACC_COL(u, bj, n)) = acc[ai][bj][m][n]; }
    }
};

struct SchedOut {
    const bf16_t* A; const bf16_t* Bt; int K;
    DEV bool next(int i, Unit& u) const {
        int pm, pn; if (!pg8::tile_order(i, NB_, bid_(), 64, 4, pm, pn)) return false;
        u.A = (const char*)(A + (size_t)pm * 256 * K); u.B = (const char*)(Bt + (size_t)pn * 256 * K); u.row0 = pm * 256; u.col0 = pn * 256; u.id = 0; u.aux = 0; return true;
    }
};
struct EpiOut {
    float* O;
    DEV void operator()(const AccT& acc, const Unit& u, int wr, int wc, int fr, int fq) const {
        FOR_ACC(ai, bj, m, n) *(f32x4*)(O + (size_t)ACC_ROW(u, ai, m) * D + ACC_COL(u, bj, n)) = acc[ai][bj][m][n];
    }
};
constexpr int RC_LD = 72;
#ifdef DBG
#define DBGF(cond, bit) do { if (cond) atomicOr(&WS_(p, TAB)[200], (bit)); } while (0)
#else
#define DBGF(cond, bit) do {} while (0)
#endif
DEV bool bad_(float x) { return !(fabsf(x) < 1e30f); }
DEV int rc_pi(int g, int j) { return j < 4 ? 4 * g + j : 16 + 4 * g + (j - 4); }

DEV void rc_cum(const Params& p, int t0, int cb, LAS float* cum, LAS float* seg) {
    const int tid = tid_(); const int k = tid & 63, sg = tid >> 6;
    float v[8]; float s = 0.f;
#pragma unroll
    for (int i = 0; i < 8; ++i) { s += WS_(p, Wd)[(size_t)(t0 + sg * 8 + i) * D + cb + k]; v[i] = s; }
    seg[sg * 64 + k] = s;
    __syncthreads();
    float off = 0.f;
#pragma unroll
    for (int q = 0; q < 8; ++q) off += (q < sg) ? seg[q * 64 + k] : 0.f;
#pragma unroll
    for (int i = 0; i < 8; ++i) cum[(sg * 8 + i) * 64 + k] = v[i] + off;
    __syncthreads();
}
DEV void ld8(const float* p, float (&f)[8]) { const f32x4 a = *(const f32x4*)p, b = *(const f32x4*)(p + 4); f[0] = a[0]; f[1] = a[1]; f[2] = a[2]; f[3] = a[3]; f[4] = b[0]; f[5] = b[1]; f[6] = b[2]; f[7] = b[3]; }
DEV void lds8(const LAS float* p, float (&f)[8]) { const f32x4 a = *(const LAS f32x4*)p, b = *(const LAS f32x4*)(p + 4); f[0] = a[0]; f[1] = a[1]; f[2] = a[2]; f[3] = a[3]; f[4] = b[0]; f[5] = b[1]; f[6] = b[2]; f[7] = b[3]; }
DEV u32x4 pk8(const float (&f)[8]) { u32x4 o; o.x = pk2(f[0], f[1]); o.y = pk2(f[2], f[3]); o.z = pk2(f[4], f[5]); o.w = pk2(f[6], f[7]); return o; }

DEV bf16x8 frag_rm_pi(const LAS bf16_t* base, int ld, int row0, int k0, int lane) {
    const LAS bf16_t* a = base + (row0 + (lane & 15)) * ld + k0 + 4 * (lane >> 4);
    const s16x4 lo = *(const LAS s16x4*)a, hi = *(const LAS s16x4*)(a + 16);
    bf16x8 r; r[0] = lo[0]; r[1] = lo[1]; r[2] = lo[2]; r[3] = lo[3]; r[4] = hi[0]; r[5] = hi[1]; r[6] = hi[2]; r[7] = hi[3]; return r;
}
DEV void rc_prep8(const float (&k)[8], const float (&al)[8], const float* k_k, const float* k_a, float (&a)[8], float (&b)[8], float (&kh)[8]) {
    float kkw[8], kaw[8]; ld8(k_k, kkw); ld8(k_a, kaw);
    float kk[8]; float ss = 0.f;
#pragma unroll
    for (int e = 0; e < 8; ++e) { kk[e] = k[e] * kkw[e]; ss += kk[e] * kk[e]; }
    ss += __shfl_xor(ss, 1); ss += __shfl_xor(ss, 2); ss += __shfl_xor(ss, 4);
    const float inv = 1.0f / fmaxf(sqrtf(ss), 1e-12f);
#pragma unroll
    for (int e = 0; e < 8; ++e) { const float kn = kk[e] * inv; a[e] = -kn; b[e] = kn * al[e]; kh[e] = k[e] * (1.0f + (al[e] - 1.0f) * kaw[e]); }
}
DEV void phase_rw_cha(const Params& p, int jl, LAS unsigned char* lds) {
    const int tid = tid_(), bid = bid_(); const int lane = tid & 63, w = tid >> 6; const int fr = lane & 15, fq = lane >> 4;
    LAS float* cum = (LAS float*)lds;
    LAS float* seg = cum + 64 * 64;
    LAS float* Aab = seg + 8 * 64;
    LAS bf16_t* As = (LAS bf16_t*)(Aab + 64 * 68);
    LAS bf16_t* Bs = As + 64 * RC_LD; LAS bf16_t* Ks = Bs + 64 * RC_LD; LAS bf16_t* Vs = Ks + 64 * RC_LD; LAS bf16_t* Ke = Vs + 64 * RC_LD;
    LAS bf16_t* Aak = Ke + 64 * RC_LD; LAS bf16_t* Ts = Aak + 64 * RC_LD; LAS bf16_t* X1 = Ts + 64 * RC_LD; LAS bf16_t* Aabh = X1 + 64 * RC_LD;
    LAS bf16_t* Fimg = Aabh + 64 * RC_LD;
    LAS bf16_t* Wimg = Fimg + 4096;
    for (int u = bid; u < 4096; u += NB_) {
        const int c = u >> 4, h = u & 15; const int t0 = c * 64, cb = h * 64; const size_t ub = (size_t)c * 16 + h;
        __syncthreads();
        rc_cum(p, t0, cb, cum, seg);
        {
            const int t = tid >> 3, k8 = (tid & 7) * 8; const size_t go = (size_t)(t0 + t) * D + cb + k8;
            float a[8], b[8], kh[8], v[8], ct[8], cp[8], ce[8];
            { float kr[8], al[8]; ld8(WS_(p, Kk) + go, kr); ld8(WS_(p, Aa) + go, al); ld8(WS_(p, Vv) + go, v);
              rc_prep8(kr, al, p.rw_k_k + (size_t)jl * D + cb + k8, p.rw_k_a + (size_t)jl * D + cb + k8, a, b, kh); }
            lds8(cum + t * 64 + k8, ct); lds8(cum + 63 * 64 + k8, ce);
            if (t > 0) lds8(cum + (t - 1) * 64 + k8, cp); else { for (int e = 0; e < 8; ++e) cp[e] = 0.f; }
            float at[8], bt[8], kt[8], be[8], ke[8];
#pragma unroll
            for (int e = 0; e < 8; ++e) { const float ei = __expf(-ct[e]), ee = __expf(ce[e] - ct[e]); at[e] = a[e] * __expf(cp[e]); bt[e] = b[e] * ei; kt[e] = kh[e] * ei; be[e] = b[e] * ee; ke[e] = kh[e] * ee; }
            *(LAS u32x4*)(As + t * RC_LD + k8) = pk8(at); *(LAS u32x4*)(Bs + t * RC_LD + k8) = pk8(bt); *(LAS u32x4*)(Ks + t * RC_LD + k8) = pk8(kt);
            *(LAS u32x4*)(Ke + t * RC_LD + k8) = pk8(ke); *(LAS u32x4*)(Vs + t * RC_LD + k8) = pk8(v);
            const int tq = t & 31, g = (tq & 15) >> 2, j = (tq & 3) + ((tq >> 4) << 2);
#pragma unroll
            for (int e = 0; e < 8; ++e) { const int k = k8 + e; Fimg[(((k >> 4) * 2 + (t >> 5)) * 64 + g * 16 + (k & 15)) * 8 + j] = (bf16_t)f2bf(be[e]); }
            *(LAS u32x4*)(Ts + tid * 8) = (u32x4){0u, 0u, 0u, 0u}; if (tid < 64) *(LAS u32x4*)(Ts + (512 + tid) * 8) = (u32x4){0u, 0u, 0u, 0u};
            if (t == 63) { float gm[8]; for (int e = 0; e < 8; ++e) gm[e] = __expf(ce[e]); *(f32x4*)(WS_(p, RGc) + ub * 64 + k8) = (f32x4){gm[0], gm[1], gm[2], gm[3]}; *(f32x4*)(WS_(p, RGc) + ub * 64 + k8 + 4) = (f32x4){gm[4], gm[5], gm[6], gm[7]}; }
        }
        __syncthreads();
        {
            const int tb = w >> 1;
#pragma unroll
            for (int ii = 0; ii < 2; ++ii) { const int ib = 2 * (w & 1) + ii;
                f32x4 ab = {0.f, 0.f, 0.f, 0.f}, ak = {0.f, 0.f, 0.f, 0.f};
                if (ib <= tb) {
#pragma unroll
                    for (int ks = 0; ks < 2; ++ks) { const bf16x8 af = frag_rm(As, RC_LD, 16 * tb, 32 * ks, lane);
                        ab = MFMA16(af, frag_rm(Bs, RC_LD, 16 * ib, 32 * ks, lane), ab); ak = MFMA16(af, frag_rm(Ks, RC_LD, 16 * ib, 32 * ks, lane), ak); } }
#pragma unroll
                for (int r = 0; r < 4; ++r) { const int t = 16 * tb + 4 * fq + r, i = 16 * ib + fr; const bool keep = i < t;
                    Aab[t * 68 + i] = keep ? ab[r] : 0.f; Aabh[t * RC_LD + i] = (bf16_t)f2bf(keep ? ab[r] : 0.f); Aak[t * RC_LD + i] = (bf16_t)f2bf(keep ? ak[r] : 0.f); } }
            *(u32x4*)(WS_(p, RBf) + ub * 4096 + tid * 8) = *(const LAS u32x4*)(Fimg + tid * 8);
        }
        __syncthreads();
        if (w == 0) {
            const int blk = lane >> 4, jc = lane & 15;
            float Tc[16];
#pragma unroll
            for (int t = 0; t < 16; ++t) {
                float acc = jc == t ? 1.f : 0.f;
#pragma unroll
                for (int i4 = 0; i4 < (t + 3) / 4; ++i4) { const f32x4 a4 = *(const LAS f32x4*)(Aab + (16 * blk + t) * 68 + 16 * blk + i4 * 4);
#pragma unroll
                    for (int e = 0; e < 4; ++e) if (i4 * 4 + e < t) acc += a4[e] * Tc[i4 * 4 + e]; }
                Tc[t] = acc;
            }
#pragma unroll
            for (int t = 0; t < 16; ++t) Ts[(16 * blk + t) * RC_LD + 16 * blk + jc] = (bf16_t)f2bf(Tc[t]);
#pragma unroll
            for (int b = 1; b < 4; ++b) {
                const s16x4 dlo = *(const LAS s16x4*)(Ts + (16 * b + fr) * RC_LD + 16 * b + 4 * fq);
                bf16x8 dfr; dfr[0] = dlo[0]; dfr[1] = dlo[1]; dfr[2] = dlo[2]; dfr[3] = dlo[3]; dfr[4] = 0; dfr[5] = 0; dfr[6] = 0; dfr[7] = 0;
                f32x4 tt_[3];
#pragma unroll
                for (int cbk = 0; cbk < b; ++cbk) {
                    f32x4 x = {0.f, 0.f, 0.f, 0.f};
#pragma unroll
                    for (int ks = 0; ks < 2; ++ks) x = MFMA16(frag_rm(Aabh, RC_LD, 16 * b, 32 * ks, lane), frag_tr(Ts, RC_LD, 32 * ks, 16 * cbk, lane), x);
                    u32x4 xb; xb.x = pk2(x[0], x[1]); xb.y = pk2(x[2], x[3]); xb.z = 0u; xb.w = 0u;
                    tt_[cbk] = MFMA16(dfr, __builtin_bit_cast(bf16x8, xb), ((f32x4){0.f, 0.f, 0.f, 0.f}));
                }
#pragma unroll
                for (int cbk = 0; cbk < b; ++cbk)
#pragma unroll
                    for (int r = 0; r < 4; ++r) Ts[(16 * b + 4 * fq + r) * RC_LD + 16 * cbk + fr] = (bf16_t)f2bf(tt_[cbk][r]);
            }
        } else {
            for (int tl = w - 1; tl < 32; tl += 7) {
                const int rb = (tl & 15) >> 2, vbk = tl & 3; f32x4 acc = {0.f, 0.f, 0.f, 0.f};
                if (tl < 16) {
#pragma unroll
                    for (int ks = 0; ks < 2; ++ks) acc = MFMA16(frag_rm(Aak, RC_LD, 16 * rb, 32 * ks, lane), frag_tr(Vs, RC_LD, 32 * ks, 16 * vbk, lane), acc);
#pragma unroll
                    for (int r = 0; r < 4; ++r) X1[(16 * rb + 4 * fq + r) * RC_LD + 16 * vbk + fr] = (bf16_t)f2bf(acc[r]);
                } else {
#pragma unroll
                    for (int ks = 0; ks < 2; ++ks) acc = MFMA16(frag_tr(Ke, RC_LD, 32 * ks, 16 * rb, lane), frag_tr(Vs, RC_LD, 32 * ks, 16 * vbk, lane), acc);
                    { u32x2 o; o.x = pk2(acc[0], acc[1]); o.y = pk2(acc[2], acc[3]); *(u32x2*)(WS_(p, RNa) + (((ub * 4 + vbk) * 4 + rb) * 64 + lane) * 4) = o; }
                }
            }
        }
        __syncthreads();
#pragma unroll
        for (int q = 0; q < 4; ++q) { const int tl = w * 4 + q; const int tt = (tl & 15) >> 2, cbk = tl & 3; f32x4 acc = {0.f, 0.f, 0.f, 0.f};
            if (tl < 16) {
#pragma unroll
                for (int ks = 0; ks < 2; ++ks) acc = MFMA16(frag_rm(Ts, RC_LD, 16 * tt, 32 * ks, lane), frag_tr(As, RC_LD, 32 * ks, 16 * cbk, lane), acc);
                const int k = 16 * cbk + fr, kq = k & 31, g = (kq & 15) >> 2, j = (kq & 3) + ((kq >> 4) << 2);
#pragma unroll
                for (int r = 0; r < 4; ++r) Wimg[((tt * 2 + (k >> 5)) * 64 + g * 16 + 4 * fq + r) * 8 + j] = (bf16_t)f2bf(acc[r]);
            } else {
#pragma unroll
                for (int ks = 0; ks < 2; ++ks) acc = MFMA16(frag_rm(Ts, RC_LD, 16 * tt, 32 * ks, lane), frag_tr(X1, RC_LD, 32 * ks, 16 * cbk, lane), acc);
                { u32x2 o; o.x = pk2(acc[0], acc[1]); o.y = pk2(acc[2], acc[3]); *(u32x2*)(WS_(p, RUt) + (((ub * 4 + cbk) * 4 + tt) * 64 + lane) * 4) = o; }
            } }
        __syncthreads();
        *(u32x4*)(WS_(p, RWf) + ub * 4096 + tid * 8) = *(const LAS u32x4*)(Wimg + tid * 8);
    }
}

constexpr int RB_SLOT = 20992, RB_R = 6, RB_P = 4;
DEV void phase_rw_chb(const Params& p, LAS unsigned char* lds) {
    const int tid = tid_(), bid = bid_();
    if (bid >= 64) return;
    const int lane = tid & 63, w = __builtin_amdgcn_readfirstlane(tid >> 6); const int head = bid >> 2, vb = bid & 3; const int fq = lane >> 4;
    auto issue = [&](int c) {
        const size_t ub = (size_t)c * 16 + head; LAS unsigned char* slot = lds + (c % RB_R) * RB_SLOT;
#pragma unroll
        for (int i = 0; i < 3; ++i) { const int pi = (w - 1) * 3 + i;
            if (pi < 8) __builtin_amdgcn_global_load_lds((const unsigned*)(WS_(p, RWf) + ub * 4096 + pi * 512 + lane * 8), (LAS unsigned*)(slot + pi * 1024), 16, 0, 0);
            else if (pi < 16) __builtin_amdgcn_global_load_lds((const unsigned*)(WS_(p, RBf) + ub * 4096 + (pi - 8) * 512 + lane * 8), (LAS unsigned*)(slot + 8192 + (pi - 8) * 1024), 16, 0, 0);
            else if (pi < 18) __builtin_amdgcn_global_load_lds((const unsigned*)(WS_(p, RUt) + (ub * 4 + vb) * 1024 + (pi - 16) * 512 + lane * 8), (LAS unsigned*)(slot + 16384 + (pi - 16) * 1024), 16, 0, 0);
            else if (pi < 20) __builtin_amdgcn_global_load_lds((const unsigned*)(WS_(p, RNa) + (ub * 4 + vb) * 1024 + (pi - 18) * 512 + lane * 8), (LAS unsigned*)(slot + 18432 + (pi - 18) * 1024), 16, 0, 0);
            else __builtin_amdgcn_global_load_lds((const unsigned*)(WS_(p, RGc) + ub * 64 + lane), (LAS unsigned*)(slot + 20480), 4, 0, 0);
        }
    };
    if (w > 0) {
#pragma unroll 1
        for (int c = 0; c < RB_P; ++c) issue(c);
        asm volatile("s_waitcnt vmcnt(9)" ::: "memory");
    }
    __builtin_amdgcn_s_barrier();
    f32x4 s[4]; for (int i = 0; i < 4; ++i) s[i] = (f32x4){0.f, 0.f, 0.f, 0.f};
#pragma unroll 1
    for (int c = 0; c < 256; ++c) {
        if (w > 0) {
            if (c + RB_P < 256) { issue(c + RB_P); asm volatile("s_waitcnt vmcnt(9)" ::: "memory"); }
            else asm volatile("s_waitcnt vmcnt(0)" ::: "memory");
        } else {
            const LAS unsigned char* slot = lds + (c % RB_R) * RB_SLOT; const size_t ub = (size_t)c * 16 + head;
            bf16x8 wf[8], bf[8]; u32x2 ut[4], na[4]; f32x4 gc[4];
#pragma unroll
            for (int f = 0; f < 8; ++f) { wf[f] = *(const LAS bf16x8*)(slot + (f * 64 + lane) * 16); bf[f] = *(const LAS bf16x8*)(slot + 8192 + (f * 64 + lane) * 16); }
#pragma unroll
            for (int q = 0; q < 4; ++q) { ut[q] = *(const LAS u32x2*)(slot + 16384 + (q * 64 + lane) * 8); na[q] = *(const LAS u32x2*)(slot + 18432 + (q * 64 + lane) * 8); gc[q] = *(const LAS f32x4*)(slot + 20480 + (16 * q + 4 * fq) * 4); }
#pragma unroll
            for (int kt = 0; kt < 4; ++kt) { u32x2 o; o.x = pk2(s[kt][0], s[kt][1]); o.y = pk2(s[kt][2], s[kt][3]); *(u32x2*)(WS_(p, RS0) + (((ub * 4 + vb) * 4 + kt) * 64 + lane) * 4) = o; }
            bf16x8 sb[2];
#pragma unroll
            for (int ks = 0; ks < 2; ++ks) { u32x4 o; o.x = pk2(s[2 * ks][0], s[2 * ks][1]); o.y = pk2(s[2 * ks][2], s[2 * ks][3]); o.z = pk2(s[2 * ks + 1][0], s[2 * ks + 1][1]); o.w = pk2(s[2 * ks + 1][2], s[2 * ks + 1][3]); sb[ks] = __builtin_bit_cast(bf16x8, o); }
            f32x4 uu[4];
#pragma unroll
            for (int tt = 0; tt < 4; ++tt) { uu[tt] = (f32x4){bflo(ut[tt].x), bfhi(ut[tt].x), bflo(ut[tt].y), bfhi(ut[tt].y)}; uu[tt] = MFMA16(wf[tt * 2], sb[0], uu[tt]); uu[tt] = MFMA16(wf[tt * 2 + 1], sb[1], uu[tt]); }
#pragma unroll
            for (int tt = 0; tt < 4; ++tt) { u32x2 o; o.x = pk2(uu[tt][0], uu[tt][1]); o.y = pk2(uu[tt][2], uu[tt][3]); *(u32x2*)(WS_(p, RUa) + (((ub * 4 + vb) * 4 + tt) * 64 + lane) * 4) = o; }
            bf16x8 ubf[2];
#pragma unroll
            for (int ks = 0; ks < 2; ++ks) { u32x4 o; o.x = pk2(uu[2 * ks][0], uu[2 * ks][1]); o.y = pk2(uu[2 * ks][2], uu[2 * ks][3]); o.z = pk2(uu[2 * ks + 1][0], uu[2 * ks + 1][1]); o.w = pk2(uu[2 * ks + 1][2], uu[2 * ks + 1][3]); ubf[ks] = __builtin_bit_cast(bf16x8, o); }
#pragma unroll
            for (int kt = 0; kt < 4; ++kt) { s[kt] = s[kt] * gc[kt] + (f32x4){bflo(na[kt].x), bfhi(na[kt].x), bflo(na[kt].y), bfhi(na[kt].y)}; s[kt] = MFMA16(bf[kt * 2], ubf[0], s[kt]); s[kt] = MFMA16(bf[kt * 2 + 1], ubf[1], s[kt]); }
            asm volatile("s_waitcnt lgkmcnt(0)" ::: "memory");
        }
        __builtin_amdgcn_s_barrier();
    }
    asm volatile("s_waitcnt vmcnt(0)" ::: "memory");
}

DEV void phase_rw_chc(const Params& p, int j, LAS unsigned char* lds) {
    const int tid = tid_(), bid = bid_(); const int lane = tid & 63, w = tid >> 6; const int fr = lane & 15, fq = lane >> 4;
    LAS float* cum = (LAS float*)lds;
    LAS float* seg = cum + 64 * 64;
    LAS float* Ys = seg + 8 * 64;
    LAS bf16_t* Rs = (LAS bf16_t*)(Ys + 64 * 68);
    LAS bf16_t* Bs = Rs + 64 * RC_LD; LAS bf16_t* Ks = Bs + 64 * RC_LD; LAS bf16_t* Vs = Ks + 64 * RC_LD; LAS bf16_t* Arb = Vs + 64 * RC_LD; LAS bf16_t* Ark = Arb + 64 * RC_LD;
    const float* lg = p.rw_lnx_g + (size_t)j * D; const float* lb = p.rw_lnx_b + (size_t)j * D;
    for (int u = bid; u < 4096; u += NB_) {
        const int c = u >> 4, h = u & 15; const int t0 = c * 64, cb = h * 64; const size_t ub = (size_t)c * 16 + h;
        const int tt = w & 3;
        u32x2 ufr[2][2][2], sfr[2][2][2];
#pragma unroll
        for (int q = 0; q < 2; ++q)
#pragma unroll
            for (int ks = 0; ks < 2; ++ks)
#pragma unroll
                for (int hf = 0; hf < 2; ++hf) { const size_t o = (((ub * 4 + 2 * (w >> 2) + q) * 4 + 2 * ks + hf) * 64 + lane) * 4;
                    ufr[q][ks][hf] = *(const u32x2*)(WS_(p, RUa) + o); sfr[q][ks][hf] = *(const u32x2*)(WS_(p, RS0) + o); }
        __syncthreads();
        rc_cum(p, t0, cb, cum, seg);
        const int t = tid >> 3, k8 = (tid & 7) * 8; const size_t go = (size_t)(t0 + t) * D + cb + k8;
        float v[8]; float bc;
        {   float r[8], kr[8], al[8], a[8], b[8], kh[8], ct[8], rkw[8];
            ld8(WS_(p, Rr) + go, r); ld8(WS_(p, Kk) + go, kr); ld8(WS_(p, Aa) + go, al); ld8(WS_(p, Vv) + go, v); lds8(cum + t * 64 + k8, ct);
            rc_prep8(kr, al, p.rw_k_k + (size_t)j * D + cb + k8, p.rw_k_a + (size_t)j * D + cb + k8, a, b, kh);
            ld8(p.rw_r_k + (size_t)j * D + cb + k8, rkw);
            bc = 0.f;
#pragma unroll
            for (int e = 0; e < 8; ++e) bc += r[e] * kh[e] * rkw[e];
            bc += __shfl_xor(bc, 1); bc += __shfl_xor(bc, 2); bc += __shfl_xor(bc, 4);
#pragma unroll
            for (int e = 0; e < 8; ++e) { const float ei = __expf(-ct[e]); r[e] *= __expf(ct[e]); b[e] *= ei; kh[e] *= ei; }
            *(LAS u32x4*)(Rs + t * RC_LD + k8) = pk8(r); *(LAS u32x4*)(Bs + t * RC_LD + k8) = pk8(b); *(LAS u32x4*)(Ks + t * RC_LD + k8) = pk8(kh); *(LAS u32x4*)(Vs + t * RC_LD + k8) = pk8(v);
        }
        __syncthreads();
        {   const int tb = w >> 1;
#pragma unroll
            for (int ii = 0; ii < 2; ++ii) { const int ib = 2 * (w & 1) + ii;
                f32x4 ab = {0.f, 0.f, 0.f, 0.f}, ak = {0.f, 0.f, 0.f, 0.f};
                if (ib <= tb) {
#pragma unroll
                    for (int ks = 0; ks < 2; ++ks) { const bf16x8 af = frag_rm(Rs, RC_LD, 16 * tb, 32 * ks, lane);
                        ab = MFMA16(af, frag_rm(Bs, RC_LD, 16 * ib, 32 * ks, lane), ab); ak = MFMA16(af, frag_rm(Ks, RC_LD, 16 * ib, 32 * ks, lane), ak); } }
#pragma unroll
                for (int r = 0; r < 4; ++r) { const int tr = 16 * tb + 4 * fq + r, i = 16 * ib + fr; const bool keep = i <= tr;
                    Arb[tr * RC_LD + i] = (bf16_t)f2bf(keep ? ab[r] : 0.f); Ark[tr * RC_LD + i] = (bf16_t)f2bf(keep ? ak[r] : 0.f); } }
        }
        __syncthreads();
#pragma unroll
        for (int q = 0; q < 2; ++q) { const int vbk = 2 * (w >> 2) + q; f32x4 acc = {0.f, 0.f, 0.f, 0.f};
#pragma unroll
            for (int ks = 0; ks < 2; ++ks) {
                u32x4 bu, bs; bu.x = ufr[q][ks][0].x; bu.y = ufr[q][ks][0].y; bu.z = ufr[q][ks][1].x; bu.w = ufr[q][ks][1].y; bs.x = sfr[q][ks][0].x; bs.y = sfr[q][ks][0].y; bs.z = sfr[q][ks][1].x; bs.w = sfr[q][ks][1].y;
                acc = MFMA16(frag_rm_pi(Rs, RC_LD, 16 * tt, 32 * ks, lane), __builtin_bit_cast(bf16x8, bs), acc);
                acc = MFMA16(frag_rm_pi(Arb, RC_LD, 16 * tt, 32 * ks, lane), __builtin_bit_cast(bf16x8, bu), acc);
                acc = MFMA16(frag_rm(Ark, RC_LD, 16 * tt, 32 * ks, lane), frag_tr(Vs, RC_LD, 32 * ks, 16 * vbk, lane), acc); }
#pragma unroll
            for (int r = 0; r < 4; ++r) Ys[(16 * tt + 4 * fq + r) * 68 + 16 * vbk + fr] = acc[r]; }
        __syncthreads();
        {
            float y[8], g[8], lgw[8], lbw[8]; lds8(Ys + t * 68 + k8, y); ld8(WS_(p, Gg) + go, g); ld8(lg + cb + k8, lgw); ld8(lb + cb + k8, lbw);
            float s1 = 0.f, s2 = 0.f;
#pragma unroll
            for (int e = 0; e < 8; ++e) { s1 += y[e]; s2 += y[e] * y[e]; }
            s1 += __shfl_xor(s1, 1); s1 += __shfl_xor(s1, 2); s1 += __shfl_xor(s1, 4); s2 += __shfl_xor(s2, 1); s2 += __shfl_xor(s2, 2); s2 += __shfl_xor(s2, 4);
            const float mean = s1 * (1.0f / 64.0f), var = s2 * (1.0f / 64.0f) - mean * mean; const float rs = rsqrtf(fmaxf(var, 0.f) + 64e-5f);
            float o[8];
#pragma unroll
            for (int e = 0; e < 8; ++e) o[e] = ((y[e] - mean) * rs * lgw[e] + lbw[e] + bc * v[e]) * g[e];
            *(u32x4*)(WS_(p, YB) + go) = pk8(o);
        }
    }
}
DEV void phase_ln1(const Params& p, int layer, const float* hin, LAS unsigned char* lds) {
    const int tid = tid_(), bid = bid_(); (void)tid; (void)bid;
    const int lane = tid & 63, wid = tid >> 6;
    LAS float* wt = (LAS float*)lds;
    LAS float* lg = wt + 36 * 1028;
    LAS int* cnt = (LAS int*)(lg + 8 * 64);
    const float* wr_ = p.moe_w_route + (size_t)layer * D * 32; const float* wg_ = p.moe_w_group + (size_t)layer * D * 4;
    for (int i = tid; i < D * 32; i += NTHR) { const int k = i >> 5, o = i & 31; wt[o * 1028 + k] = wr_[i]; }
    for (int i = tid; i < D * 4; i += NTHR) { const int k = i >> 2, o = i & 3; wt[(32 + o) * 1028 + k] = wg_[i]; }
    if (tid < 32) cnt[tid] = 0;
    __syncthreads();
    const float* g = p.ln_g + ((size_t)layer * 2 + 0) * D; const float* be = p.ln_b + ((size_t)layer * 2 + 0) * D;
    const float* br = p.moe_b_route + layer * 32; const float* bg = p.moe_b_group + layer * 4;
    for (int rr = 0; rr < 8; ++rr) {
        const int t = bid * 64 + wid * 8 + rr; const size_t ro = (size_t)t * D;
        f32x4 z[4], m[4];
        load_row(hin + ro, lane, z); load_row(WS_(p, MIX) + ro, lane, m);
        float s = 0.f;
#pragma unroll
        for (int q = 0; q < 4; ++q) { z[q] = z[q] * ALPHA + m[q]; s += z[q][0] + z[q][1] + z[q][2] + z[q][3]; }
        const float mean = wave_sum(s) * (1.0f / D);
        float vs = 0.f;
#pragma unroll
        for (int q = 0; q < 4; ++q) { z[q] = z[q] - mean; vs += z[q][0] * z[q][0] + z[q][1] * z[q][1] + z[q][2] * z[q][2] + z[q][3] * z[q][3]; }
        const float rs = rsqrtf(wave_sum(vs) * (1.0f / D) + LN_EPS);
#pragma unroll
        for (int q = 0; q < 4; ++q) {
            const f32x4 gw = *(const f32x4*)(g + 256 * q + 4 * lane), bw = *(const f32x4*)(be + 256 * q + 4 * lane);
            z[q] = z[q] * rs * gw + bw;
            *(f32x4*)(WS_(p, H1) + ro + 256 * q + 4 * lane) = z[q];
        }
        LAS float* L = lg + wid * 64;
#pragma unroll 1
        for (int gI = 0; gI < 4; ++gI) skinny_group<8>(z, wt + gI * 8 * 1028, lane, L + gI * 8);
        skinny_group<4>(z, wt + 32 * 1028, lane, L + 32);
        if (lane == 0) {
            const float q0 = L[32] + bg[0], q1 = L[33] + bg[1], q2 = L[34] + bg[2], q3 = L[35] + bg[3];
            int gi = 0; float gm = q0;
            if (q1 > gm) { gm = q1; gi = 1; } if (q2 > gm) { gm = q2; gi = 2; } if (q3 > gm) { gm = q3; gi = 3; }
            const float den = __expf(q0 - gm) + __expf(q1 - gm) + __expf(q2 - gm) + __expf(q3 - gm);
            const float pgrp = 1.0f / den;
            float l1 = -INFINITY, l2 = -INFINITY; int i1 = 0, i2 = 0;
#pragma unroll 1
            for (int o = 0; o < 8; ++o) { const float v = L[gi * 8 + o] + br[gi * 8 + o];
                if (v > l1) { l2 = l1; i2 = i1; l1 = v; i1 = o; } else if (v > l2) { l2 = v; i2 = o; } }
            const float e2 = __expf(l2 - l1), inv = 1.0f / (1.0f + e2);
            const int e0 = gi * 8 + i1, e1 = gi * 8 + i2;
            WS_(p, EIDX)[2 * t] = e0; WS_(p, EIDX)[2 * t + 1] = e1; WS_(p, GATE)[2 * t] = pgrp * inv; WS_(p, GATE)[2 * t + 1] = pgrp * e2 * inv;
            atomicAdd((int*)&cnt[e0], 1); atomicAdd((int*)&cnt[e1], 1);
        }
    }
    __syncthreads();
    if (tid < 32) WS_(p, CNT)[bid * 32 + tid] = cnt[tid];
}

DEV void phase_moe_scatter(const Params& p, LAS unsigned char* lds) {
    const int tid = tid_(), bid = bid_(); (void)tid; (void)bid;
    const int lane = tid & 63, wid = tid >> 6;
    LAS int* part = (LAS int*)lds;
    LAS int* pre = part + 512;
    LAS int* base = pre + 512;
    LAS int* pst = base + 32;
    LAS int* dst = pst + 40;
    LAS int* eid = dst + 128;
    { const int e = tid & 31, part_i = tid >> 5; int tot = 0, prf = 0;
      for (int b = part_i * 16; b < part_i * 16 + 16; ++b) { const int c = WS_(p, CNT)[b * 32 + e]; tot += c; if (b < (int)bid) prf += c; }
      part[part_i * 32 + e] = tot; pre[part_i * 32 + e] = prf; }
    if (tid < 128) eid[tid] = WS_(p, EIDX)[bid * 128 + tid];
    __syncthreads();
    if (tid < 32) { int tot = 0, prf = 0; for (int i = 0; i < 16; ++i) { tot += part[i * 32 + tid]; prf += pre[i * 32 + tid]; } part[tid] = tot; pre[tid] = prf; }
    __syncthreads();
    if (tid == 0) { int acc = 0; for (int e = 0; e < 32; ++e) { pst[e] = acc; acc += ((part[e] + 255) >> 8) << 8; } pst[32] = acc;
        if (bid == 0) { for (int e = 0; e <= 32; ++e) WS_(p, TAB)[e] = pst[e]; WS_(p, TAB)[33] = acc >> 8;
            for (int e = 0; e < 32; ++e) for (int mt = pst[e] >> 8; mt < (pst[e + 1] >> 8); ++mt) WS_(p, TAB)[64 + mt] = e; } }
    __syncthreads();
    if (tid < 32) { int run = pst[tid] + pre[tid]; for (int a = 0; a < 128; ++a) if (eid[a] == tid) dst[a] = run++; }
    __syncthreads();
    if (tid < 128) WS_(p, DEST)[bid * 128 + tid] = dst[tid];
    for (int a = wid * 16; a < wid * 16 + 16; ++a) {
        const int t = bid * 64 + (a >> 1); const int d = dst[a];
        f32x4 z[4]; load_row(WS_(p, H1) + (size_t)t * D, lane, z);
#pragma unroll
        for (int q = 0; q < 4; ++q) st_bf4(WS_(p, BUF) + (size_t)d * D + 256 * q + 4 * lane, z[q]);
    }
}

template <int which> struct SchedMoe {
    const Params* p; int layer;
    DEV bool next(int i, Unit& u) const {
        const int nmt = __hip_atomic_load(WS_(*p, TAB) + 33, __ATOMIC_RELAXED, __HIP_MEMORY_SCOPE_AGENT); int pm, pn; if (!pg8::tile_order(i, NB_, bid_(), nmt, 4, pm, pn)) return false;
        const int row0 = pm * 256; const int e = __hip_atomic_load(WS_(*p, TAB) + 64 + pm, __ATOMIC_RELAXED, __HIP_MEMORY_SCOPE_AGENT);
        if constexpr (which == 0) { u.A = (const char*)(WS_(*p, BUF) + (size_t)row0 * D); u.B = (const char*)(WS_(*p, moe_w1_t) + ((size_t)layer * 32 + e) * 1024 * 1024 + (size_t)pn * 256 * 1024); }
        else { u.A = (const char*)(WS_(*p, ACT) + (size_t)row0 * 512); u.B = (const char*)(WS_(*p, moe_w2_t) + ((size_t)layer * 32 + e) * 1024 * 512 + (size_t)pn * 256 * 512); }
        u.row0 = row0; u.col0 = pn * 256; u.id = e; u.aux = 0; return true;
    }
};
struct EpiMoe1 {
    bf16_t* O;
    DEV void operator()(const AccT& acc, const Unit& u, int wr, int wc, int fr, int fq) const {
#pragma unroll
        for (int ai = 0; ai < 2; ++ai)
#pragma unroll
            for (int m = 0; m < 4; ++m)
#pragma unroll
                for (int n = 0; n < 2; ++n) {
                    const f32x4 gt = acc[ai][0][m][n], up = acc[ai][1][m][n]; f32x4 v;
                    for (int e = 0; e < 4; ++e) v[e] = siluf_(gt[e]) * up[e];
                    const int col = (u.col0 >> 1) + 32 * wc + 16 * n + 4 * fq;
                    st_bf4(O + (size_t)ACC_ROW(u, ai, m) * 512 + col, v); ACC_FENCE;
                }
    }
};
struct EpiMoe2 {
    bf16_t* O;
    DEV void operator()(const AccT& acc, const Unit& u, int wr, int wc, int fr, int fq) const {
        FOR_ACC(ai, bj, m, n) { st_bf4(O + (size_t)ACC_ROW(u, ai, m) * D + ACC_COL(u, bj, n), acc[ai][bj][m][n]); ACC_FENCE; }
    }
};

DEV void phase_ln2(const Params& p, int layer, float* hout) {
    const int tid = tid_(), bid = bid_(); (void)tid; (void)bid;
    const int lane = tid & 63, wid = tid >> 6;
    const float* g = p.ln_g + ((size_t)layer * 2 + 1) * D; const float* be = p.ln_b + ((size_t)layer * 2 + 1) * D;
    for (int rr = 0; rr < 8; ++rr) {
        const int t = bid * 64 + wid * 8 + rr; const size_t ro = (size_t)t * D;
        const int d0 = WS_(p, DEST)[2 * t], d1 = WS_(p, DEST)[2 * t + 1]; const float g0 = WS_(p, GATE)[2 * t], g1 = WS_(p, GATE)[2 * t + 1];
        f32x4 z[4]; load_row(WS_(p, H1) + ro, lane, z);
        float s = 0.f;
#pragma unroll
        for (int q = 0; q < 4; ++q) {
            const u32x2 a = *(const u32x2*)(WS_(p, YBUF) + (size_t)d0 * D + 256 * q + 4 * lane), b = *(const u32x2*)(WS_(p, YBUF) + (size_t)d1 * D + 256 * q + 4 * lane);
            z[q][0] = z[q][0] * ALPHA + g0 * bflo(a.x) + g1 * bflo(b.x); z[q][1] = z[q][1] * ALPHA + g0 * bfhi(a.x) + g1 * bfhi(b.x);
            z[q][2] = z[q][2] * ALPHA + g0 * bflo(a.y) + g1 * bflo(b.y); z[q][3] = z[q][3] * ALPHA + g0 * bfhi(a.y) + g1 * bfhi(b.y);
            s += z[q][0] + z[q][1] + z[q][2] + z[q][3];
        }
        const float mean = wave_sum(s) * (1.0f / D);
        float vs = 0.f;
#pragma unroll
        for (int q = 0; q < 4; ++q) { z[q] = z[q] - mean; vs += z[q][0] * z[q][0] + z[q][1] * z[q][1] + z[q][2] * z[q][2] + z[q][3] * z[q][3]; }
        const float rs = rsqrtf(wave_sum(vs) * (1.0f / D) + LN_EPS);
#pragma unroll
        for (int q = 0; q < 4; ++q) {
            const f32x4 gw = *(const f32x4*)(g + 256 * q + 4 * lane), bw = *(const f32x4*)(be + 256 * q + 4 * lane);
            *(f32x4*)(hout + ro + 256 * q + 4 * lane) = z[q] * rs * gw + bw;
        }
    }
}
constexpr int MB_PROJ = 5152;
DEV void phase_mb_cast(const Params& p, int j, const float* hin, LAS unsigned char* lds) {
    const int tid = tid_(), bid = bid_(); (void)tid; (void)bid;
    const int lane = tid & 63, wid = tid >> 6;
    LAS float* wt = (LAS float*)lds;
    const float* w = p.mb_w_in + (size_t)j * D * MB_PROJ;
    for (int i = tid; i < D * 32; i += NTHR) { const int k = i >> 5, o = i & 31; wt[o * 1028 + k] = w[(size_t)k * MB_PROJ + 5120 + o]; }
    __syncthreads();
    for (int rr = 0; rr < 8; ++rr) {
        const int t = bid * 64 + wid * 8 + rr; const size_t ro = (size_t)t * D;
        f32x4 z[4]; load_row(hin + ro, lane, z);
#pragma unroll
        for (int q = 0; q < 4; ++q) st_bf4(WS_(p, X6) + ro + 256 * q + 4 * lane, z[q]);
        LAS float* L = wt + 32 * 1028 + wid * 32;
#pragma unroll 1
        for (int gI = 0; gI < 4; ++gI) skinny_group<8>(z, wt + gI * 8 * 1028, lane, L + gI * 8);
        if (lane < 32) WS_(p, DT)[(size_t)t * 32 + lane] = softplusf_(L[lane] + p.mb_dt_bias[j * 32 + lane]);
    }
}
struct SchedMbIn {
    const Params* p;
    DEV bool next(int i, Unit& u) const {
        int pm, pn; if (!pg8::tile_order(i, NB_, bid_(), 64, 20, pm, pn)) return false;
        u.A = (const char*)(WS_(*p, X6) + (size_t)pm * 256 * D); u.B = (const char*)(WS_(*p, mb_win_t) + (size_t)pn * 256 * D); u.row0 = pm * 256; u.col0 = pn * 256; u.id = 0; u.aux = 0; return true;
    }
};
struct EpiMbIn {
    const Params* p;
    DEV void operator()(const AccT& acc, const Unit& u, int wr, int wc, int fr, int fq) const {
        const bool isz = u.col0 < 2048; bf16_t* O = WS_(*p, Z) + (isz ? (size_t)0 : (size_t)T * 2048 - 2048); const int ld = isz ? 2048 : 3072;
        FOR_ACC(ai, bj, m, n) { st_bf4(O + (size_t)ACC_ROW(u, ai, m) * ld + ACC_COL(u, bj, n), acc[ai][bj][m][n]); ACC_FENCE; }
    }
};
DEV void phase_mb_conv(const Params& p, int j) {
    const int tid = tid_(), bid = bid_(); (void)tid; (void)bid;
    if (tid >= 384) return;
    const int c0 = tid * 8; const int t0 = bid * 64;
    const float* cw = p.mb_conv_w + (size_t)j * 4 * 3072; const float* cb = p.mb_conv_b + (size_t)j * 3072;
    float w[4][8], b[8];
#pragma unroll
    for (int i = 0; i < 4; ++i) { const f32x4 a = *(const f32x4*)(cw + i * 3072 + c0), bb = *(const f32x4*)(cw + i * 3072 + c0 + 4); for (int e = 0; e < 4; ++e) { w[i][e] = a[e]; w[i][4 + e] = bb[e]; } }
    { const f32x4 a = *(const f32x4*)(cb + c0), bb = *(const f32x4*)(cb + c0 + 4); for (int e = 0; e < 4; ++e) { b[e] = a[e]; b[4 + e] = bb[e]; } }
    float x0[8], x1[8], x2[8], x3[8];
    auto ld = [&](int t, float (&x)[8]) {
        if (t < 0) { for (int e = 0; e < 8; ++e) x[e] = 0.f; return; }
        const u32x4 v = *(const u32x4*)(WS_(p, XBC) + (size_t)t * 3072 + c0);
        x[0] = bflo(v.x); x[1] = bfhi(v.x); x[2] = bflo(v.y); x[3] = bfhi(v.y); x[4] = bflo(v.z); x[5] = bfhi(v.z); x[6] = bflo(v.w); x[7] = bfhi(v.w);
    };
    ld(t0 - 3, x0); ld(t0 - 2, x1); ld(t0 - 1, x2);
    for (int tt = 0; tt < 64; ++tt) {
        ld(t0 + tt, x3);
        float o[8];
#pragma unroll
        for (int e = 0; e < 8; ++e) o[e] = siluf_(b[e] + w[0][e] * x0[e] + w[1][e] * x1[e] + w[2][e] * x2[e] + w[3][e] * x3[e]);
        u32x4 r; r.x = pk2(o[0], o[1]); r.y = pk2(o[2], o[3]); r.z = pk2(o[4], o[5]); r.w = pk2(o[6], o[7]);
        *(u32x4*)(WS_(p, XC) + (size_t)(t0 + tt) * 3072 + c0) = r;
#pragma unroll
        for (int e = 0; e < 8; ++e) { x0[e] = x1[e]; x1[e] = x2[e]; x2[e] = x3[e]; }
    }
}

DEV void mb_dacs(const Params& p, int j, int c, int g, LAS float* dts, LAS float* dacs) {
    const int tid = tid_(); const int lane = tid & 63, h = tid >> 6;
    const int hh = 8 * g + h; const float a = -__expf(p.mb_a_log[j * 32 + hh]);
    const float d0 = WS_(p, DT)[(size_t)(c * 128 + 2 * lane) * 32 + hh], d1 = WS_(p, DT)[(size_t)(c * 128 + 2 * lane + 1) * 32 + hh];
    const float a0 = d0 * a, a1 = d1 * a;
    float s = a0 + a1;
#pragma unroll
    for (int o = 1; o < 64; o <<= 1) { const float v = __shfl_up(s, o); if (lane >= o) s += v; }
    dts[h * 128 + 2 * lane] = d0; dts[h * 128 + 2 * lane + 1] = d1;
    dacs[h * 128 + 2 * lane] = s - a1; dacs[h * 128 + 2 * lane + 1] = s;
}
constexpr int LDB = 136;
constexpr int LDX = 72;
DEV void ld_tile128(const bf16_t* src, int gld, LAS bf16_t* dst) {
    const int tid = tid_();
    for (int i = tid; i < 128 * 16; i += NTHR) { const int r = i >> 4, c8 = (i & 15) * 8; *(LAS u32x4*)(dst + r * LDB + c8) = *(const u32x4*)(src + (size_t)r * gld + c8); }
}

DEV void phase_mb_states(const Params& p, int j, LAS unsigned char* lds) {
    const int tid = tid_(), bid = bid_(); (void)tid; (void)bid;
    const int lane = tid & 63, w = tid >> 6;
    LAS bf16_t* Bm = (LAS bf16_t*)lds;
    LAS bf16_t* Xh = Bm + 128 * LDB;
    LAS float* dts = (LAS float*)(Xh + 128 * LDX);
    LAS float* dacs = dts + 1024;
    for (int u = bid; u < 512; u += NB_) {
        const int c = u >> 2, g = u & 3; const int t0 = c * 128;
        __syncthreads();
        mb_dacs(p, j, c, g, dts, dacs);
        ld_tile128(WS_(p, XC) + (size_t)t0 * 3072 + 2048 + 128 * g, 3072, Bm);
        __syncthreads();
        if (tid < 8) WS_(p, CD)[(c * 32) + 8 * g + tid] = __expf(dacs[tid * 128 + 127]);
        bf16x8 bfr[4];
#pragma unroll
        for (int ks = 0; ks < 4; ++ks) bfr[ks] = frag_tr(Bm, LDB, 32 * ks, 16 * w, lane);
        for (int h = 0; h < 8; ++h) {
            { const int l = tid >> 2, p0 = (tid & 3) * 16; const float sc = dts[h * 128 + l] * __expf(dacs[h * 128 + 127] - dacs[h * 128 + l]);
              const bf16_t* src = WS_(p, XC) + (size_t)(t0 + l) * 3072 + 64 * (8 * g + h) + p0;
#pragma unroll
              for (int hf = 0; hf < 2; ++hf) { const u32x4 v = *(const u32x4*)(src + 8 * hf); u32x4 r;
                  r.x = pk2(bflo(v.x) * sc, bfhi(v.x) * sc); r.y = pk2(bflo(v.y) * sc, bfhi(v.y) * sc); r.z = pk2(bflo(v.z) * sc, bfhi(v.z) * sc); r.w = pk2(bflo(v.w) * sc, bfhi(v.w) * sc);
                  *(LAS u32x4*)(Xh + l * LDX + p0 + 8 * hf) = r; } }
            __syncthreads();
            f32x4 acc[4];
#pragma unroll
            for (int pb = 0; pb < 4; ++pb) { acc[pb] = (f32x4){0.f, 0.f, 0.f, 0.f};
#pragma unroll
                for (int ks = 0; ks < 4; ++ks) { const bf16x8 af = frag_tr(Xh, LDX, 32 * ks, 16 * pb, lane); acc[pb] = MFMA16(af, bfr[ks], acc[pb]); } }
            float* S = WS_(p, STATES) + (((size_t)c * 32 + 8 * g + h) * 64) * 128;
#pragma unroll
            for (int pb = 0; pb < 4; ++pb)
#pragma unroll
                for (int r = 0; r < 4; ++r) S[(size_t)(16 * pb + 4 * (lane >> 4) + r) * 128 + 16 * w + (lane & 15)] = acc[pb][r];
            __syncthreads();
        }
    }
}
DEV void phase_mb_scan(const Params& p) {
    const int tid = tid_(), bid = bid_(); (void)tid; (void)bid;
    const int gid = bid * NTHR + tid;
    if (gid >= 32 * 64 * 64) return;
    const int np = gid & 63, pp = (gid >> 6) & 63, h = gid >> 12; const int n = 2 * np;
    float r0 = 0.f, r1 = 0.f;
    const size_t eo = ((size_t)h * 64 + pp) * 128 + n;
    const size_t fo = (size_t)h * 64 * 128 + fragmajor_off(pp, n, 128);
#pragma unroll 4
    for (int c = 0; c < 128; ++c) {
        const f32x2 s = *(const f32x2*)(WS_(p, STATES) + (size_t)c * 32 * 64 * 128 + eo);
        const float cd = WS_(p, CD)[c * 32 + h];
        *(unsigned*)(WS_(p, PREV) + (size_t)c * 32 * 64 * 128 + fo) = pk2(r0, r1);
        r0 = r0 * cd + s[0]; r1 = r1 * cd + s[1];
    }
}
DEV void phase_mb_out(const Params& p, int j, LAS unsigned char* lds) {
    const int tid = tid_(), bid = bid_(); (void)tid; (void)bid;
    const int lane = tid & 63, w = tid >> 6; const int fr = lane & 15, fq = lane >> 4;
    LAS bf16_t* Cm = (LAS bf16_t*)lds;
    LAS bf16_t* Bm = Cm + 128 * LDB;
    LAS bf16_t* Xh = Bm + 128 * LDB;
    LAS bf16_t* Mw = Xh + 128 * LDX;
    LAS float* dts = (LAS float*)(Mw + 8 * 16 * LDB);
    LAS float* dacs = dts + 1024;
    LAS bf16_t* Mme = Mw + w * 16 * LDB;
    for (int u = bid; u < 512; u += NB_) {
        const int c = u >> 2, g = u & 3; const int t0 = c * 128;
        __syncthreads();
        mb_dacs(p, j, c, g, dts, dacs);
        ld_tile128(WS_(p, XC) + (size_t)t0 * 3072 + 2048 + 512 + 128 * g, 3072, Cm);
        ld_tile128(WS_(p, XC) + (size_t)t0 * 3072 + 2048 + 128 * g, 3072, Bm);
        __syncthreads();
        f32x4 sc[8]; bf16x8 cf[4];
#pragma unroll
        for (int ks = 0; ks < 4; ++ks) cf[ks] = frag_rm(Cm, LDB, 16 * w, 32 * ks, lane);
#pragma unroll
        for (int sb = 0; sb < 8; ++sb) { sc[sb] = (f32x4){0.f, 0.f, 0.f, 0.f};
#pragma unroll
            for (int ks = 0; ks < 4; ++ks) sc[sb] = MFMA16(cf[ks], frag_rm(Bm, LDB, 16 * sb, 32 * ks, lane), sc[sb]); }
        float ssq[4] = {0.f, 0.f, 0.f, 0.f};
#pragma unroll 1
        for (int h = 0; h < 8; ++h) {
            const int hh = 8 * g + h;
            { const int l = tid >> 2, p0 = (tid & 3) * 16; const float scl = dts[h * 128 + l];
              const bf16_t* src = WS_(p, XC) + (size_t)(t0 + l) * 3072 + 64 * hh + p0;
#pragma unroll
              for (int hf = 0; hf < 2; ++hf) { const u32x4 v = *(const u32x4*)(src + 8 * hf); u32x4 r;
                  r.x = pk2(bflo(v.x) * scl, bfhi(v.x) * scl); r.y = pk2(bflo(v.y) * scl, bfhi(v.y) * scl); r.z = pk2(bflo(v.z) * scl, bfhi(v.z) * scl); r.w = pk2(bflo(v.w) * scl, bfhi(v.w) * scl);
                  *(LAS u32x4*)(Xh + l * LDX + p0 + 8 * hf) = r; } }
            float dl[4];
#pragma unroll
            for (int r = 0; r < 4; ++r) dl[r] = dacs[h * 128 + 16 * w + 4 * fq + r];
#pragma unroll
            for (int sb = 0; sb < 8; ++sb) { const int s = 16 * sb + fr; const float ds = dacs[h * 128 + s];
#pragma unroll
                for (int r = 0; r < 4; ++r) { const int l = 16 * w + 4 * fq + r; const float m = (s <= l) ? sc[sb][r] * __expf(dl[r] - ds) : 0.f; Mme[(4 * fq + r) * LDB + s] = (bf16_t)f2bf(m); } }
            __syncthreads();
            bf16x8 mf[4];
#pragma unroll
            for (int ks = 0; ks < 4; ++ks) mf[ks] = frag_rm(Mme, LDB, 0, 32 * ks, lane);
            const bf16_t* pv = WS_(p, PREV) + ((size_t)c * 32 + hh) * 64 * 128;
#pragma unroll
            for (int pb = 0; pb < 4; ++pb) {
                f32x4 a = {0.f, 0.f, 0.f, 0.f}, o = {0.f, 0.f, 0.f, 0.f};
#pragma unroll
                for (int ks = 0; ks < 4; ++ks) {
                    a = MFMA16(mf[ks], frag_tr(Xh, LDX, 32 * ks, 16 * pb, lane), a);
                    const bf16x8 pf = *(const bf16x8*)(pv + ((size_t)(pb * 4 + ks) * 64 + lane) * 8);
                    o = MFMA16(cf[ks], pf, o);
                }
                const float dsk = p.mb_d[j * 32 + hh];
#pragma unroll
                for (int r = 0; r < 4; ++r) {
                    const int t = t0 + 16 * w + 4 * fq + r; const int ch = 64 * hh + 16 * pb + fr;
                    const float xs = bf2f(WS_(p, XC)[(size_t)t * 3072 + ch]); const float z = bf2f(WS_(p, Z)[(size_t)t * 2048 + ch]);
                    float v = a[r] + o[r] * __expf(dl[r]) + xs * dsk;
                    v *= siluf_(z);
                    ssq[r] += v * v;
                    WS_(p, YB)[(size_t)t * 2048 + ch] = (bf16_t)f2bf(v * p.mb_norm_g[(size_t)j * 2048 + ch]);
                }
            }
            __syncthreads();
        }
#pragma unroll
        for (int r = 0; r < 4; ++r) ssq[r] = rsqrtf(sum16(ssq[r]) * (1.0f / 512.0f) + 1e-5f);
#pragma unroll 1
        for (int h = 0; h < 8; ++h)
#pragma unroll
            for (int pb = 0; pb < 4; ++pb) { const int ch = 512 * g + 64 * h + 16 * pb + fr;
#pragma unroll
                for (int r = 0; r < 4; ++r) { bf16_t* q = WS_(p, YB) + (size_t)(t0 + 16 * w + 4 * fq + r) * 2048 + ch; *q = (bf16_t)f2bf(bf2f(*q) * ssq[r]); } }
    }
}
constexpr int GL_PROJ = 3088;
constexpr int LDV = 264;
DEV void phase_gl_cast(const Params& p, int j, const float* hin, LAS unsigned char* lds) {
    const int tid = tid_(), bid = bid_(); (void)tid; (void)bid;
    const int lane = tid & 63, wid = tid >> 6;
    LAS float* wt = (LAS float*)lds;
    LAS float* w2 = wt + 16 * 1028;
    LAS float* lr = w2 + 16 * 512;
    const float* w = p.gl_w_in + (size_t)j * D * GL_PROJ;
    for (int i = tid; i < D * 16; i += NTHR) { const int k = i >> 4, o = i & 15; wt[o * 1028 + k] = w[(size_t)k * GL_PROJ + 3072 + o]; }
    for (int i = tid; i < 16 * 512; i += NTHR) w2[i] = p.gl_gk_w2[(size_t)j * 16 * 512 + i];
    __syncthreads();
    for (int rr = 0; rr < 8; ++rr) {
        const int t = bid * 64 + wid * 8 + rr; const size_t ro = (size_t)t * D;
        f32x4 z[4]; load_row(hin + ro, lane, z);
#pragma unroll
        for (int q = 0; q < 4; ++q) st_bf4(WS_(p, X6) + ro + 256 * q + 4 * lane, z[q]);
#pragma unroll 1
        for (int gI = 0; gI < 2; ++gI) skinny_group<8>(z, wt + gI * 8 * 1028, lane, lr + wid * 16 + gI * 8);
        float l16[16];
#pragma unroll
        for (int o = 0; o < 16; ++o) l16[o] = lr[wid * 16 + o];
#pragma unroll
        for (int cc = 0; cc < 8; ++cc) {
            const int c = cc * 64 + lane; float a = p.gl_gk_b[j * 512 + c];
#pragma unroll
            for (int o = 0; o < 16; ++o) a += l16[o] * w2[o * 512 + c];
            const float ls = fminf(a, 0.f) - log1pf(__expf(-fabsf(a)));
            WS_(p, LA)[(size_t)t * 512 + c] = ls * (1.0f / 16.0f);
        }
    }
}
struct SchedGlIn {
    const Params* p;
    DEV bool next(int i, Unit& u) const {
        int pm, pn; if (!pg8::tile_order(i, NB_, bid_(), 64, 12, pm, pn)) return false;
        u.A = (const char*)(WS_(*p, X6) + (size_t)pm * 256 * D); u.B = (const char*)(WS_(*p, gl_win_t) + (size_t)pn * 256 * D); u.row0 = pm * 256; u.col0 = pn * 256; u.id = 0; u.aux = 0; return true;
    }
};
struct EpiGlIn {
    const Params* p;
    DEV void operator()(const AccT& acc, const Unit& u, int wr, int wc, int fr, int fq) const {
        FOR_ACC(ai, bj, m, n) { st_bf4(WS_(*p, QKVG) + (size_t)ACC_ROW(u, ai, m) * 3072 + ACC_COL(u, bj, n), acc[ai][bj][m][n]); ACC_FENCE; }
    }
};
DEV void gl_bcs(const Params& p, int n, int h, LAS float* bcs) {
    const int tid = tid_();
    for (int i = tid; i < 64 * 32; i += NTHR) { const int r = i >> 5, c4 = (i & 31) * 4; *(LAS f32x4*)(bcs + r * 128 + c4) = *(const f32x4*)(WS_(p, LA) + (size_t)(n * 64 + r) * 512 + 128 * h + c4); }
    __syncthreads();
    if (tid < 128) { float s = 0.f; for (int r = 0; r < 64; ++r) { s += bcs[r * 128 + tid]; bcs[r * 128 + tid] = s; } }
    __syncthreads();
}
DEV void phase_gl_kv(const Params& p, LAS unsigned char* lds) {
    const int tid = tid_(), bid = bid_(); (void)tid; (void)bid;
    const int lane = tid & 63, w = tid >> 6;
    LAS float* bcs = (LAS float*)lds;
    LAS bf16_t* Ke = (LAS bf16_t*)(bcs + 64 * 128);
    LAS bf16_t* Vs = Ke + 64 * LDB;
    for (int u = bid; u < 1024; u += NB_) {
        const int n = u >> 2, h = u & 3; const int t0 = n * 64;
        __syncthreads();
        gl_bcs(p, n, h, bcs);
        for (int i = tid; i < 64 * 16; i += NTHR) { const int r = i >> 4, c8 = (i & 15) * 8;
            const u32x4 v = *(const u32x4*)(WS_(p, QKVG) + (size_t)(t0 + r) * 3072 + 512 + 128 * h + c8); float f[8];
            f[0] = bflo(v.x); f[1] = bfhi(v.x); f[2] = bflo(v.y); f[3] = bfhi(v.y); f[4] = bflo(v.z); f[5] = bfhi(v.z); f[6] = bflo(v.w); f[7] = bfhi(v.w);
#pragma unroll
            for (int e = 0; e < 8; ++e) f[e] *= __expf(bcs[63 * 128 + c8 + e] - bcs[r * 128 + c8 + e]);
            u32x4 o; o.x = pk2(f[0], f[1]); o.y = pk2(f[2], f[3]); o.z = pk2(f[4], f[5]); o.w = pk2(f[6], f[7]);
            *(LAS u32x4*)(Ke + r * LDB + c8) = o; }
        for (int i = tid; i < 64 * 32; i += NTHR) { const int r = i >> 5, c8 = (i & 31) * 8; *(LAS u32x4*)(Vs + r * LDV + c8) = *(const u32x4*)(WS_(p, QKVG) + (size_t)(t0 + r) * 3072 + 1024 + 256 * h + c8); }
        if (tid < 128) WS_(p, CDG)[((size_t)n * 4 + h) * 128 + tid] = __expf(bcs[63 * 128 + tid]);
        __syncthreads();
        bf16x8 af[2];
#pragma unroll
        for (int ks = 0; ks < 2; ++ks) af[ks] = frag_tr(Ke, LDB, 32 * ks, 16 * w, lane);
        float* O = WS_(p, STATES) + (((size_t)n * 4 + h) * 128) * 256;
#pragma unroll
        for (int vb = 0; vb < 16; ++vb) {
            f32x4 acc = {0.f, 0.f, 0.f, 0.f};
#pragma unroll
            for (int ks = 0; ks < 2; ++ks) acc = MFMA16(af[ks], frag_tr(Vs, LDV, 32 * ks, 16 * vb, lane), acc);
#pragma unroll
            for (int r = 0; r < 4; ++r) O[(size_t)(16 * w + 4 * (lane >> 4) + r) * 256 + 16 * vb + (lane & 15)] = acc[r];
        }
    }
}
DEV void phase_gl_scan(const Params& p) {
    const int tid = tid_(), bid = bid_(); (void)tid; (void)bid;
    const int gid = bid * NTHR + tid;
    if (gid >= 4 * 64 * 256) return;
    const int v = gid & 255, kp = (gid >> 8) & 63, h = gid >> 14; const int k = 2 * kp;
    float r0 = 0.f, r1 = 0.f;
    const size_t fo = (size_t)h * 128 * 256 + fragmajor_off(v, k, 128);
#pragma unroll 4
    for (int n = 0; n < 256; ++n) {
        const float* S = WS_(p, STATES) + (((size_t)n * 4 + h) * 128) * 256;
        const float s0 = S[(size_t)k * 256 + v], s1 = S[(size_t)(k + 1) * 256 + v];
        const f32x2 cd = *(const f32x2*)(WS_(p, CDG) + ((size_t)n * 4 + h) * 128 + k);
        *(unsigned*)(WS_(p, PREV) + (size_t)n * 4 * 128 * 256 + fo) = pk2(r0, r1);
        r0 = r0 * cd[0] + s0; r1 = r1 * cd[1] + s1;
    }
}
DEV void phase_gl_out(const Params& p, int j, LAS unsigned char* lds) {
    const int tid = tid_(), bid = bid_(); (void)tid; (void)bid;
    const int lane = tid & 63, w = tid >> 6; const int fr = lane & 15, fq = lane >> 4;
    LAS float* bcs = (LAS float*)lds;
    LAS bf16_t* Qs = (LAS bf16_t*)(bcs + 64 * 128);
    LAS bf16_t* Ks = Qs + 64 * LDB;
    LAS bf16_t* Vs = Ks + 64 * LDB;
    LAS bf16_t* At = Vs + 64 * LDV;
    LAS float* red = (LAS float*)(At + 64 * LDX);
    for (int u = bid; u < 1024; u += NB_) {
        const int n = u >> 2, h = u & 3; const int t0 = n * 64;
        __syncthreads();
        gl_bcs(p, n, h, bcs);
        for (int i = tid; i < 64 * 16; i += NTHR) { const int r = i >> 4, c8 = (i & 15) * 8;
            const u32x4 vq = *(const u32x4*)(WS_(p, QKVG) + (size_t)(t0 + r) * 3072 + 128 * h + c8), vk = *(const u32x4*)(WS_(p, QKVG) + (size_t)(t0 + r) * 3072 + 512 + 128 * h + c8);
            float fq_[8], fk_[8];
            fq_[0] = bflo(vq.x); fq_[1] = bfhi(vq.x); fq_[2] = bflo(vq.y); fq_[3] = bfhi(vq.y); fq_[4] = bflo(vq.z); fq_[5] = bfhi(vq.z); fq_[6] = bflo(vq.w); fq_[7] = bfhi(vq.w);
            fk_[0] = bflo(vk.x); fk_[1] = bfhi(vk.x); fk_[2] = bflo(vk.y); fk_[3] = bfhi(vk.y); fk_[4] = bflo(vk.z); fk_[5] = bfhi(vk.z); fk_[6] = bflo(vk.w); fk_[7] = bfhi(vk.w);
#pragma unroll
            for (int e = 0; e < 8; ++e) { const float b = bcs[r * 128 + c8 + e]; fq_[e] *= __expf(b) * 0.08838834764831845f; fk_[e] *= __expf(-b); }
            u32x4 o; o.x = pk2(fq_[0], fq_[1]); o.y = pk2(fq_[2], fq_[3]); o.z = pk2(fq_[4], fq_[5]); o.w = pk2(fq_[6], fq_[7]);
            *(LAS u32x4*)(Qs + r * LDB + c8) = o;
            o.x = pk2(fk_[0], fk_[1]); o.y = pk2(fk_[2], fk_[3]); o.z = pk2(fk_[4], fk_[5]); o.w = pk2(fk_[6], fk_[7]);
            *(LAS u32x4*)(Ks + r * LDB + c8) = o; }
        for (int i = tid; i < 64 * 32; i += NTHR) { const int r = i >> 5, c8 = (i & 31) * 8; *(LAS u32x4*)(Vs + r * LDV + c8) = *(const u32x4*)(WS_(p, QKVG) + (size_t)(t0 + r) * 3072 + 1024 + 256 * h + c8); }
        __syncthreads();
        { const int ib = w >> 1;
#pragma unroll
          for (int jj = 0; jj < 2; ++jj) { const int jb = 2 * (w & 1) + jj; f32x4 a = {0.f, 0.f, 0.f, 0.f};
#pragma unroll
              for (int ks = 0; ks < 4; ++ks) a = MFMA16(frag_rm(Qs, LDB, 16 * ib, 32 * ks, lane), frag_rm(Ks, LDB, 16 * jb, 32 * ks, lane), a);
#pragma unroll
              for (int r = 0; r < 4; ++r) { const int i = 16 * ib + 4 * fq + r, jx = 16 * jb + fr; At[i * LDX + jx] = (bf16_t)f2bf(jx <= i ? a[r] : 0.f); } } }
        __syncthreads();
        f32x4 o[4][2];
        const bf16_t* pv = WS_(p, PREV) + ((size_t)n * 4 + h) * 128 * 256;
#pragma unroll
        for (int vv = 0; vv < 2; ++vv) { const int vb = 2 * w + vv;
            bf16x8 bi[2], bp[4];
#pragma unroll
            for (int ks = 0; ks < 2; ++ks) bi[ks] = frag_tr(Vs, LDV, 32 * ks, 16 * vb, lane);
#pragma unroll
            for (int ks = 0; ks < 4; ++ks) bp[ks] = *(const bf16x8*)(pv + ((size_t)(vb * 4 + ks) * 64 + lane) * 8);
#pragma unroll
            for (int ib = 0; ib < 4; ++ib) { f32x4 a = {0.f, 0.f, 0.f, 0.f};
#pragma unroll
                for (int ks = 0; ks < 2; ++ks) a = MFMA16(frag_rm(At, LDX, 16 * ib, 32 * ks, lane), bi[ks], a);
#pragma unroll
                for (int ks = 0; ks < 4; ++ks) a = MFMA16(frag_rm(Qs, LDB, 16 * ib, 32 * ks, lane), bp[ks], a);
                o[ib][vv] = a; } }
#pragma unroll
        for (int ib = 0; ib < 4; ++ib)
#pragma unroll
            for (int r = 0; r < 4; ++r) { float s = o[ib][0][r] * o[ib][0][r] + o[ib][1][r] * o[ib][1][r]; s = sum16(s); if (fr == 0) red[w * 64 + 16 * ib + 4 * fq + r] = s; }
        __syncthreads();
#pragma unroll
        for (int ib = 0; ib < 4; ++ib)
#pragma unroll
            for (int r = 0; r < 4; ++r) { const int i = 16 * ib + 4 * fq + r; float s = 0.f;
#pragma unroll
                for (int ww = 0; ww < 8; ++ww) s += red[ww * 64 + i];
                const float rs = rsqrtf(s * (1.0f / 256.0f) + 1e-5f);
#pragma unroll
                for (int vv = 0; vv < 2; ++vv) { const int v = 32 * w + 16 * vv + fr; const int t = t0 + i;
                    const float gt = bf2f(WS_(p, QKVG)[(size_t)t * 3072 + 2048 + 256 * h + v]);
                    WS_(p, YB)[(size_t)t * D + 256 * h + v] = (bf16_t)f2bf(o[ib][vv][r] * rs * p.gl_norm_g[j * 256 + v] * siluf_(gt)); } }
    }
}
#define XB_TMO      128
#define XB_XCNT(j)  (256  + 64 * (j))
#define XB_XSUB(j)  (1280 + 64 * (j))
#define XB_XGEN(j)  (2304 + 64 * (j))
#define XB_TOP      3328
#define XB_TOPGEN   3392
#define XCD_BAR_WORDS 3456
#define XB_SPIN_CAP (1u << 22)
DEV unsigned xb_ld(unsigned* p)              { return __hip_atomic_load(p, __ATOMIC_RELAXED, __HIP_MEMORY_SCOPE_AGENT); }
DEV unsigned xb_add(unsigned* p, unsigned v) { return __hip_atomic_fetch_add(p, v, __ATOMIC_RELAXED, __HIP_MEMORY_SCOPE_AGENT); }
DEV unsigned xb_xcc_id() { return (unsigned)__builtin_amdgcn_s_getreg((3 << 11) | 20) & 0xFu; }
#define XB_SPIN(cond, bar) do { unsigned _sp = 0; while (cond) { __builtin_amdgcn_s_sleep(1); \
    if ((++_sp & 255u) == 0u) { if (xb_ld(&(bar)[XB_TMO])) break; if (_sp > XB_SPIN_CAP) { atomicAdd(&(bar)[XB_TMO], 1u); break; } } } } while (0)
struct XcdBarrier { unsigned* bar; unsigned x; volatile LAS unsigned* st; };
DEV XcdBarrier xcd_barrier_post(unsigned* bar, volatile LAS unsigned* st) {
    XcdBarrier b; b.bar = bar; b.x = xb_xcc_id(); b.st = st;
    if (threadIdx.x == 0) (void)xb_add(&bar[XB_XCNT(b.x)], 1u);
    return b;
}
DEV void xcd_barrier_complete(unsigned* bar, unsigned x, unsigned& nloc, unsigned& nx) {
    const unsigned G = gridDim.x * gridDim.y * gridDim.z;
    unsigned sum, cnt, mine, sp = 0u;
    for (;;) {
        sum = 0u; cnt = 0u; mine = 0u;
#pragma unroll
        for (unsigned j = 0; j < 16; ++j) { const unsigned c = xb_ld(&bar[XB_XCNT(j)]); sum += c; cnt += (c > 0u) ? 1u : 0u; mine = (j == x) ? c : mine; }
        if (sum == G) break;
        __builtin_amdgcn_s_sleep(1);
        if ((++sp & 255u) == 0u) { if (xb_ld(&bar[XB_TMO])) break; if (sp > XB_SPIN_CAP) { atomicAdd(&bar[XB_TMO], 1u); break; } }
    }
    nloc = mine > 0u ? mine : 1u; nx = cnt > 0u ? cnt : 1u;
}
DEV void xcd_barrier(const XcdBarrier& b) {
    asm volatile("s_waitcnt vmcnt(0)" ::: "memory");
    __syncthreads();
    if (threadIdx.x == 0) {
        unsigned* bar = b.bar;
        __builtin_amdgcn_s_waitcnt(0);
        unsigned nloc = b.st[0], nx = b.st[1];
        if (nloc == 0u) { xcd_barrier_complete(bar, b.x, nloc, nx); b.st[0] = nloc; b.st[1] = nx; }
        const unsigned old = xb_add(&bar[XB_XSUB(b.x)], 1u);
        const unsigned gen = old / nloc;
        if (old + 1u == (gen + 1u) * nloc) {
            __builtin_amdgcn_fence(__ATOMIC_RELEASE, "agent");
            asm volatile("s_waitcnt vmcnt(0)" ::: "memory");
            const unsigned og = xb_add(&bar[XB_TOP], 1u);
            const unsigned tg = og / nx;
            if (og + 1u == (tg + 1u) * nx) xb_add(&bar[XB_TOPGEN], 1u);
            else XB_SPIN(xb_ld(&bar[XB_TOPGEN]) == tg, bar);
            __builtin_amdgcn_fence(__ATOMIC_ACQUIRE, "agent");
            xb_add(&bar[XB_XGEN(b.x)], 1u);
            asm volatile("s_waitcnt vmcnt(0)" ::: "memory");
        } else {
            XB_SPIN(xb_ld(&bar[XB_XGEN(b.x)]) == gen, bar);
            __builtin_amdgcn_fence(__ATOMIC_ACQUIRE, "agent");
            asm volatile("s_waitcnt vmcnt(0)" ::: "memory");
        }
    }
    __syncthreads();
}

DEV void run_phase(const Params& pin, int op, int arg, LAS unsigned char* lds) {
    Params p = pin; asm volatile("" : "+s"(p.ws));
    const int layer = arg; const int jj = layer / 3;
    const float* hin = layer == 0 ? p.x : WS_(p, H);
    float* hout = layer == DEPTH - 1 ? p.out : WS_(p, H);
#ifdef ONLY_OP
    if (op != ONLY_OP) return;
#endif
#ifdef OPMASK
    if (!((OPMASK >> op) & 1ull)) return;
#endif
    switch (op) {
    case OP_CONVERT: phase_convert(p, lds);
#ifdef DBG
        if (blockIdx.x == 0 && threadIdx.x < 8) WS_(p, TAB)[200 + threadIdx.x] = 0;
#endif
        break;
    case OP_RW_MIX: phase_rw_mix(p, jj, hin); break;
    case OP_RW_GEMM1: { SchedRW1 S{&p, jj}; EpiRW1 E{&p}; pg8::gemm_phase(lds, 1024, S, E); } break;
    case OP_RW_GEMM2: { SchedRW2 S{&p, jj}; EpiRW2 E{&p, jj}; pg8::gemm_phase(lds, 256, S, E); } break;
    case OP_RW_CHA: phase_rw_cha(p, jj, lds); break;
    case OP_RW_CHB: phase_rw_chb(p, lds); break;
    case OP_RW_CHC: phase_rw_chc(p, jj, lds); break;
    case OP_RW_OUT: { SchedOut S{WS_(p, YB), WS_(p, rw_wo_t) + (size_t)jj * D * D, 1024}; EpiOut E{WS_(p, MIX)}; pg8::gemm_phase(lds, 1024, S, E); } break;
    case OP_LN1: phase_ln1(p, layer, hin, lds); break;
    case OP_MOE_SCATTER: phase_moe_scatter(p, lds); break;
    case OP_MOE_GEMM1: { SchedMoe<0> S{&p, layer}; EpiMoe1 E{WS_(p, ACT)}; pg8::gemm_phase(lds, 1024, S, E); } break;
    case OP_MOE_GEMM2: { SchedMoe<1> S{&p, layer}; EpiMoe2 E{WS_(p, YBUF)}; pg8::gemm_phase(lds, 512, S, E); } break;
    case OP_LN2: phase_ln2(p, layer, hout); break;
    case OP_MB_CAST: phase_mb_cast(p, jj, hin, lds); break;
    case OP_MB_GEMM_IN: { SchedMbIn S{&p}; EpiMbIn E{&p}; pg8::gemm_phase(lds, 1024, S, E); } break;
    case OP_MB_CONV: phase_mb_conv(p, jj); break;
    case OP_MB_STATES: phase_mb_states(p, jj, lds); break;
    case OP_MB_SCAN: phase_mb_scan(p); break;
    case OP_MB_OUT: phase_mb_out(p, jj, lds); break;
    case OP_MB_GEMM_OUT: { SchedOut S{WS_(p, YB), WS_(p, mb_wout_t) + (size_t)jj * D * 2048, 2048}; EpiOut E{WS_(p, MIX)}; pg8::gemm_phase(lds, 2048, S, E); } break;
    case OP_GL_CAST: phase_gl_cast(p, jj, hin, lds); break;
    case OP_GL_GEMM_IN: { SchedGlIn S{&p}; EpiGlIn E{&p}; pg8::gemm_phase(lds, 1024, S, E); } break;
    case OP_GL_KV: phase_gl_kv(p, lds); break;
    case OP_GL_SCAN: phase_gl_scan(p); break;
    case OP_GL_OUT: phase_gl_out(p, jj, lds); break;
    case OP_GL_GEMM_OUT: { SchedOut S{WS_(p, YB), WS_(p, gl_wout_t) + (size_t)jj * D * D, 1024}; EpiOut E{WS_(p, MIX)}; pg8::gemm_phase(lds, 1024, S, E); } break;
    default: break;
    }
}

constexpr int NPHASES = 1 + 12 + 12 + 11 + 12;
DEV void decode_phase(int ph, int& op, int& layer) {
    if (ph == 0) { op = OP_CONVERT; layer = 0; return; }
    int q = ph - 1; layer = 0;
    if (q >= 12) { q -= 12; layer = 1; if (q >= 12) { q -= 12; layer = 2; if (q >= 11) { q -= 11; layer = 3; } } }
    const int kind = layer % 3; const int nmix = kind == 1 ? 7 : kind == 0 ? 7 : 6;
    if (q < nmix) op = (kind == 0 ? OP_RW_MIX : kind == 1 ? OP_MB_CAST : OP_GL_CAST) + q;
    else op = OP_LN1 + (q - nmix);
}

#define X(t, n) t n##_,
template <bool COOP>
__global__ void __launch_bounds__(NTHR, 2) mega(PARAM_LIST(X) const int ph0, const int ph1) {
#undef X
    Params p;
#define X(t, n) p.n = n##_;
    PARAM_LIST(X)
#undef X

    extern __shared__ __attribute__((aligned(16))) unsigned char smem_raw[];
    LAS unsigned char* lds = (LAS unsigned char*)smem_raw;
    if constexpr (COOP) {
        volatile LAS unsigned* st = (volatile LAS unsigned*)(lds + LDS_BYTES - 16);
        if (threadIdx.x == 0) { st[0] = 0u; st[1] = 0u; }
        __syncthreads();
        XcdBarrier xb = xcd_barrier_post(WS_(p, bar), st);
        if (ph0 < 0) cg::this_grid().sync();
        for (int ph = ph0; ph < ph1; ++ph) {
            int op, arg; decode_phase(ph, op, arg);
#ifdef REPEAT_MASK
            const int reps = 1 + (int)((REPEAT_MASK >> op) & 1ull);
#else
            const int reps = 1;
#endif
#pragma unroll 1
            for (int rep = 0; rep < reps; ++rep) {
                run_phase(p, op, arg, lds);
                if (ph + 1 < ph1 || rep + 1 < reps) xcd_barrier(xb);
            }
        }
#ifdef DBG
        xcd_barrier(xb);
        { const int code = __hip_atomic_load(WS_(p, TAB) + 200, __ATOMIC_RELAXED, __HIP_MEMORY_SCOPE_AGENT);
          for (size_t i = (size_t)blockIdx.x * NTHR + threadIdx.x; i < (size_t)T * D; i += (size_t)NB_ * NTHR) p.out[i] = 0.f;
          __syncthreads();
          if (blockIdx.x == 0 && threadIdx.x == 0) p.out[0] = sqrtf((float)DBG_DECODE(code) * 1.68e7f); }
#endif
    } else {
        for (int ph = ph0; ph < ph1; ++ph) { int op, arg; decode_phase(ph, op, arg); run_phase(p, op, arg, lds); }
    }
}


extern "C" void kernel_launch(void* const* d_in, const int* in_sizes, int n_in, void* d_out, int out_size, void* d_ws, size_t ws_size, hipStream_t stream) {
    (void)in_sizes; (void)n_in; (void)out_size;
    Params p; std::memset((void*)&p, 0, sizeof(p));
    auto F = [&](int i) { return (const float*)d_in[i]; };
    p.x = F(0); p.ln_g = F(1); p.ln_b = F(2);
    p.rw_mu = F(3); p.rw_w_rkv = F(4); p.rw_w0 = F(5); p.rw_w1 = F(6); p.rw_w2 = F(7); p.rw_a0 = F(8);
    p.rw_a1 = F(9); p.rw_a2 = F(10); p.rw_g1 = F(11); p.rw_g2 = F(12);
    p.rw_k_k = F(13); p.rw_k_a = F(14); p.rw_r_k = F(15); p.rw_lnx_g = F(16); p.rw_lnx_b = F(17); p.rw_w_o = F(18);
    p.mb_w_in = F(19); p.mb_conv_w = F(20); p.mb_conv_b = F(21); p.mb_dt_bias = F(22); p.mb_a_log = F(23); p.mb_d = F(24); p.mb_norm_g = F(25); p.mb_w_out = F(26);
    p.gl_w_in = F(27); p.gl_gk_w2 = F(28); p.gl_gk_b = F(29); p.gl_norm_g = F(30); p.gl_w_out = F(31);
    p.moe_w_group = F(32); p.moe_b_group = F(33); p.moe_w_route = F(34); p.moe_b_route = F(35); p.moe_w_in = F(36); p.moe_w_down = F(37);
    p.out = (float*)d_out;
    p.ws = (char*)d_ws;
    if (WS_TOTAL > ws_size) { fprintf(stderr, "workspace too small: need %zu have %zu\n", (size_t)WS_TOTAL, ws_size); return; }
    unsigned* bar_ptr = (unsigned*)(p.ws + OFF_bar);
    const int np = NPHASES;
#define X(t, n) (void*)&p.n,
#if SINGLE_LAUNCH
    (void)hipFuncSetAttribute((const void*)mega<true>, hipFuncAttributeMaxDynamicSharedMemorySize, LDS_BYTES);
    (void)hipMemsetAsync(bar_ptr, 0, XCD_BAR_WORDS * sizeof(unsigned), stream);
    int ph0 = 0, ph1 = np; void* args[] = {PARAM_LIST(X) (void*)&ph0, (void*)&ph1};
    hipError_t e = hipLaunchCooperativeKernel((const void*)mega<true>, dim3(NBLK), dim3(NTHR), args, LDS_BYTES, stream);
    if (e != hipSuccess) fprintf(stderr, "cooperative launch failed: %s\n", hipGetErrorString(e));
#else
    (void)hipFuncSetAttribute((const void*)mega<false>, hipFuncAttributeMaxDynamicSharedMemorySize, LDS_BYTES);
    for (int ph = 0; ph < np; ++ph) { int ph0 = ph, ph1 = ph + 1; void* args[] = {PARAM_LIST(X) (void*)&ph0, (void*)&ph1};
        hipError_t e = hipLaunchKernel((const void*)mega<false>, dim3(NBLK), dim3(NTHR), args, LDS_BYTES, stream);
        if (e != hipSuccess) fprintf(stderr, "launch failed: %s\n", hipGetErrorString(e)); }
#endif
#undef X
}
```

```cpp
#include <hip/hip_runtime.h>
#include <hip/hip_cooperative_groups.h>
#include <cstdint>
#include <cstdio>
#include <cstring>
namespace cg = cooperative_groups;

typedef unsigned short bf16_t;
typedef short bf16x8 __attribute__((ext_vector_type(8)));
typedef short s16x4 __attribute__((ext_vector_type(4)));
typedef float f32x4 __attribute__((ext_vector_type(4)));
typedef float f32x2 __attribute__((ext_vector_type(2)));
typedef unsigned u32x4 __attribute__((ext_vector_type(4)));
typedef unsigned u32x2 __attribute__((ext_vector_type(2)));
#define LAS __attribute__((address_space(3)))
#define DEV __device__ __forceinline__

constexpr int T = 16384, D = 1024, DEPTH = 4;
constexpr int NTHR = 512, NBLK = 256;
constexpr int LDS_BYTES = 155648;
constexpr float ALPHA = 1.681792830507429f;
constexpr float LN_EPS = 1e-5f;
constexpr int MOE_ROWS = 40960;

DEV int tid_() { int t = threadIdx.x; asm volatile("" : "+v"(t)); return t; }
DEV int bid_() { int b = blockIdx.x; asm volatile("" : "+s"(b)); return b; }
#define NB_ 256
DEV unsigned f2bf(float f) { unsigned u = __float_as_uint(f); u += 0x7FFFu + ((u >> 16) & 1u); return u >> 16; }
DEV float bf2f(unsigned short b) { return __uint_as_float(((unsigned)b) << 16); }
typedef __bf16 bf16n2 __attribute__((ext_vector_type(2)));
DEV unsigned pk2(float lo, float hi) { f32x2 v = {lo, hi}; bf16n2 b = __builtin_convertvector(v, bf16n2); return __builtin_bit_cast(unsigned, b); }
DEV float bflo(unsigned u) { return __uint_as_float(u << 16); }
DEV float bfhi(unsigned u) { return __uint_as_float(u & 0xFFFF0000u); }
DEV float sigmoidf_(float x) { return 1.0f / (1.0f + __expf(-x)); }
DEV float siluf_(float x) { return x / (1.0f + __expf(-x)); }
DEV float softplusf_(float x) { return fmaxf(x, 0.f) + __logf(1.0f + __expf(-fabsf(x))); }
DEV float tanhf_(float x) { const float e = __expf(-2.0f * fabsf(x)); const float r = (1.0f - e) / (1.0f + e); return x < 0.f ? -r : r; }
DEV float wave_sum(float v) {
#pragma unroll
    for (int o = 32; o > 0; o >>= 1) v += __shfl_xor(v, o);
    return v;
}
DEV float sum16(float v) {
#pragma unroll
    for (int o = 8; o > 0; o >>= 1) v += __shfl_xor(v, o);
    return v;
}
template <int N> DEV float reduce_scatter(float (&v)[N], int lane) {
    int s = 1;
#pragma unroll
    for (int h = N / 2; h >= 1; h >>= 1) {
#pragma unroll
        for (int i = 0; i < h; ++i) {
            const bool up = (lane & s) != 0;
            const float send = up ? v[i] : v[i + h];
            const float keep = up ? v[i + h] : v[i];
            v[i] = keep + __shfl_xor(send, s);
        }
        s <<= 1;
    }
    float r = v[0];
    for (; s < 64; s <<= 1) r += __shfl_xor(r, s);
    return r;
}
template <int N> DEV int rs_index(int lane) {
    int o = 0, s = 1;
#pragma unroll
    for (int h = N / 2; h >= 1; h >>= 1) { if (lane & s) o += h; s <<= 1; }
    return o;
}

DEV bf16x8 frag_rm(const LAS bf16_t* base, int ld, int row0, int k0, int lane) {
    return *(const LAS bf16x8*)(base + (row0 + (lane & 15)) * ld + k0 + 8 * (lane >> 4));
}
DEV bf16x8 frag_tr(const LAS bf16_t* base, int ld, int k0, int c0, int lane) {
    const int g = lane >> 4, i = lane & 15, q = i >> 2, p = i & 3;
    const LAS bf16_t* a = base + (k0 + 8 * g + q) * ld + c0 + 4 * p;
    s16x4 lo = __builtin_amdgcn_ds_read_tr16_b64_v4i16((LAS s16x4*)a);
    s16x4 hi = __builtin_amdgcn_ds_read_tr16_b64_v4i16((LAS s16x4*)(a + 4 * ld));
    bf16x8 r; r[0] = lo[0]; r[1] = lo[1]; r[2] = lo[2]; r[3] = lo[3]; r[4] = hi[0]; r[5] = hi[1]; r[6] = hi[2]; r[7] = hi[3];
    return r;
}
#define MFMA16(a, b, c) __builtin_amdgcn_mfma_f32_16x16x32_bf16((a), (b), (c), 0, 0, 0)
DEV size_t fragmajor_off(int n, int k, int K) { return ((size_t)((n >> 4) * (K >> 5) + (k >> 5)) * 64 + (n & 15) + 16 * ((k & 31) >> 3)) * 8 + (k & 7); }

template <int N> DEV void skinny_group(const f32x4 (&z)[4], const LAS float* wt, int lane, LAS float* outw) {
    float pe[N];
#pragma unroll
    for (int o = 0; o < N; ++o) {
        float a = 0.f;
#pragma unroll
        for (int q = 0; q < 4; ++q) { const f32x4 w = *(const LAS f32x4*)(wt + o * 1028 + 256 * q + 4 * lane); a += z[q][0] * w[0] + z[q][1] * w[1] + z[q][2] * w[2] + z[q][3] * w[3]; }
        pe[o] = a;
    }
    const float r = reduce_scatter<N>(pe, lane);
    if (lane < N) outw[rs_index<N>(lane)] = r;
}
#ifndef SINGLE_LAUNCH
#define SINGLE_LAUNCH 1
#endif
constexpr size_t OFF_bar = 0ull;
constexpr size_t OFF_rw_rkv_t = 13824ull;
constexpr size_t OFF_rw_w1_t = 12596736ull;
constexpr size_t OFF_rw_a1_t = 13645312ull;
constexpr size_t OFF_rw_g1_t = 14693888ull;
constexpr size_t OFF_rw_w2_t = 15742464ull;
constexpr size_t OFF_rw_a2_t = 16791040ull;
constexpr size_t OFF_rw_g2_t = 17839616ull;
constexpr size_t OFF_rw_wo_t = 18888192ull;
constexpr size_t OFF_mb_win_t = 23082496ull;
constexpr size_t OFF_mb_wout_t = 33568256ull;
constexpr size_t OFF_gl_win_t = 37762560ull;
constexpr size_t OFF_gl_wout_t = 44054016ull;
constexpr size_t OFF_moe_w1_t = 46151168ull;
constexpr size_t OFF_moe_w2_t = 314586624ull;
constexpr size_t OFF_H = 448804352ull;
constexpr size_t OFF_H1 = 515913216ull;
constexpr size_t OFF_MIX = 583022080ull;
constexpr size_t OFF_BUF = 650130944ull;
constexpr size_t OFF_ACT = 734017024ull;
constexpr size_t OFF_YBUF = 775960064ull;
constexpr size_t OFF_CNT = 859846144ull;
constexpr size_t OFF_EIDX = 859878912ull;
constexpr size_t OFF_GATE = 860009984ull;
constexpr size_t OFF_DEST = 860141056ull;
constexpr size_t OFF_TAB = 860272128ull;
constexpr size_t OFF_YB = 860273152ull;
constexpr size_t OFF_X6 = 927382016ull;
constexpr size_t OFF_Rr = 1128708608ull;
constexpr size_t OFF_Kk = 1195817472ull;
constexpr size_t OFF_Vv = 1262926336ull;
constexpr size_t OFF_LW = 1330035200ull;
constexpr size_t OFF_Wd = 1355201024ull;
constexpr size_t OFF_Aa = 1422309888ull;
constexpr size_t OFF_Gg = 1489418752ull;
constexpr size_t OFF_RWf = 1556527616ull;
constexpr size_t OFF_RBf = 1590082048ull;
constexpr size_t OFF_RUt = 1623636480ull;
constexpr size_t OFF_RNa = 1657190912ull;
constexpr size_t OFF_RGc = 1690745344ull;
constexpr size_t OFF_RUa = 1691793920ull;
constexpr size_t OFF_RS0 = 1725348352ull;
constexpr size_t OFF_Z = 960936448ull;
constexpr size_t OFF_XBC = 1028045312ull;
constexpr size_t OFF_XC = 1128708608ull;
constexpr size_t OFF_DT = 1229371904ull;
constexpr size_t OFF_STATES = 1231469056ull;
constexpr size_t OFF_CD = 1365686784ull;
constexpr size_t OFF_PREV = 1365703168ull;
constexpr size_t OFF_LA = 1432812032ull;
constexpr size_t OFF_CDG = 1466366464ull;
constexpr size_t OFF_QKVG = OFF_XBC;
constexpr size_t WS_TOTAL = 1758902784ull;
typedef unsigned T_bar;
typedef bf16_t T_rw_rkv_t;
typedef bf16_t T_rw_w1_t;
typedef bf16_t T_rw_a1_t;
typedef bf16_t T_rw_g1_t;
typedef bf16_t T_rw_w2_t;
typedef bf16_t T_rw_a2_t;
typedef bf16_t T_rw_g2_t;
typedef bf16_t T_rw_wo_t;
typedef bf16_t T_mb_win_t;
typedef bf16_t T_mb_wout_t;
typedef bf16_t T_gl_win_t;
typedef bf16_t T_gl_wout_t;
typedef bf16_t T_moe_w1_t;
typedef bf16_t T_moe_w2_t;
typedef float T_H;
typedef float T_H1;
typedef float T_MIX;
typedef bf16_t T_BUF;
typedef bf16_t T_ACT;
typedef bf16_t T_YBUF;
typedef int T_CNT;
typedef int T_EIDX;
typedef float T_GATE;
typedef int T_DEST;
typedef int T_TAB;
typedef bf16_t T_YB;
typedef bf16_t T_X6;
typedef float T_Rr;
typedef float T_Kk;
typedef float T_Vv;
typedef bf16_t T_LW;
typedef float T_Wd;
typedef float T_Aa;
typedef float T_Gg;
typedef bf16_t T_RWf;
typedef bf16_t T_RBf;
typedef bf16_t T_RUt;
typedef bf16_t T_RNa;
typedef float T_RGc;
typedef bf16_t T_RUa;
typedef bf16_t T_RS0;
typedef bf16_t T_Z;
typedef bf16_t T_XBC;
typedef bf16_t T_XC;
typedef float T_DT;
typedef float T_STATES;
typedef float T_CD;
typedef bf16_t T_PREV;
typedef float T_LA;
typedef float T_CDG;
typedef bf16_t T_QKVG;
#define WS_(P, N) ((T_##N*)((P).ws + OFF_##N))
constexpr size_t OFF_Hb = OFF_H, OFF_H1b = OFF_H1, OFF_MIXb = OFF_MIX;
typedef bf16_t T_Hb; typedef bf16_t T_H1b; typedef bf16_t T_MIXb;
constexpr size_t OFF_moe_wr_t = OFF_H + 33554432ull;
typedef bf16_t T_moe_wr_t;
struct ConvJob {
    const float* src; bf16_t* dst;
    int K, N, src_ld, Kpad, Npad, perm, batch;
    long long src_bs, dst_bs;
    DEV int ntiles() const { return (Kpad / 64) * (Npad / 64) * batch; }
};
constexpr int NJOBS = 14;

#define PARAM_LIST(X) \
    X(const float*, x) X(const float*, ln_g) X(const float*, ln_b) \
    X(const float*, rw_mu) X(const float*, rw_w_rkv) X(const float*, rw_w0) X(const float*, rw_w1) X(const float*, rw_w2) X(const float*, rw_a0) X(const float*, rw_a1) X(const float*, rw_a2) \
    X(const float*, rw_g1) X(const float*, rw_g2) X(const float*, rw_k_k) X(const float*, rw_k_a) X(const float*, rw_r_k) X(const float*, rw_lnx_g) X(const float*, rw_lnx_b) X(const float*, rw_w_o) \
    X(const float*, mb_w_in) X(const float*, mb_conv_w) X(const float*, mb_conv_b) X(const float*, mb_dt_bias) X(const float*, mb_a_log) X(const float*, mb_d) X(const float*, mb_norm_g) X(const float*, mb_w_out) \
    X(const float*, gl_w_in) X(const float*, gl_gk_w2) X(const float*, gl_gk_b) X(const float*, gl_norm_g) X(const float*, gl_w_out) \
    X(const float*, moe_w_group) X(const float*, moe_b_group) X(const float*, moe_w_route) X(const float*, moe_b_route) X(const float*, moe_w_in) X(const float*, moe_w_down) \
    X(float*, out) X(char*, ws)
struct Params {
#define X(t, n) t n;
    PARAM_LIST(X)
#undef X
};

enum Op : unsigned char { OP_CONVERT = 0, OP_PRE0, OP_RW_GEMM1, OP_RW_GEMM2, OP_RW_CHA, OP_RW_CHB, OP_RW_CHC, OP_RW_OUT,
    OP_LN1, OP_MOE_SCATTER, OP_MOE_GEMM1, OP_MOE_GEMM2, OP_LN2,
    OP_MB_GEMM_IN, OP_MB_CONV, OP_MB_STATES, OP_MB_SCAN, OP_MB_OUT, OP_MB_GEMM_OUT,
    OP_GL_GEMM_IN, OP_GL_KV, OP_GL_SCAN, OP_GL_OUT, OP_GL_GEMM_OUT };


DEV ConvJob make_job(const Params& p, int q) {
    const long long DD = (long long)D * D;
    switch (q) {
    case 0: return ConvJob{p.rw_w_rkv, WS_(p, rw_rkv_t), 1024, 1024, 1024, 1024, 1024, 0, 6, DD, DD};
    case 1: return ConvJob{p.rw_w1, WS_(p, rw_w1_t), 1024, 64, 64, 1024, 256, 0, 2, (long long)D * 64, (long long)256 * D};
    case 2: return ConvJob{p.rw_a1, WS_(p, rw_a1_t), 1024, 64, 64, 1024, 256, 0, 2, (long long)D * 64, (long long)256 * D};
    case 3: return ConvJob{p.rw_g1, WS_(p, rw_g1_t), 1024, 160, 160, 1024, 256, 0, 2, (long long)D * 160, (long long)256 * D};
    case 4: return ConvJob{p.rw_w2, WS_(p, rw_w2_t), 64, 1024, 1024, 256, 1024, 0, 2, (long long)64 * D, (long long)D * 256};
    case 5: return ConvJob{p.rw_a2, WS_(p, rw_a2_t), 64, 1024, 1024, 256, 1024, 0, 2, (long long)64 * D, (long long)D * 256};
    case 6: return ConvJob{p.rw_g2, WS_(p, rw_g2_t), 160, 1024, 1024, 256, 1024, 0, 2, (long long)160 * D, (long long)D * 256};
    case 7: return ConvJob{p.rw_w_o, WS_(p, rw_wo_t), 1024, 1024, 1024, 1024, 1024, 0, 2, DD, DD};
    case 8: return ConvJob{p.mb_w_in, WS_(p, mb_win_t), 1024, 5120, 5152, 1024, 5120, 0, 1, 0, 0};
    case 9: return ConvJob{p.mb_w_out, WS_(p, mb_wout_t), 2048, 1024, 1024, 2048, 1024, 0, 1, 0, 0};
    case 10: return ConvJob{p.gl_w_in, WS_(p, gl_win_t), 1024, 3072, 3088, 1024, 3072, 0, 1, 0, 0};
    case 11: return ConvJob{p.gl_w_out, WS_(p, gl_wout_t), 1024, 1024, 1024, 1024, 1024, 0, 1, 0, 0};
    case 12: return ConvJob{p.moe_w_in, WS_(p, moe_w1_t), 1024, 1024, 1024, 1024, 1024, 1, 128, DD, DD};
    default: return ConvJob{p.moe_w_down, WS_(p, moe_w2_t), 512, 1024, 1024, 512, 1024, 0, 128, (long long)512 * 1024, (long long)1024 * 512};
    }
}

DEV void phase_convert(const Params& p, LAS unsigned char* lds) {
    const int tid = tid_(), bid = bid_(); (void)tid; (void)bid;
    LAS bf16_t* tile = (LAS bf16_t*)lds;
    int tbeg = 0;
#pragma unroll
    for (int j = 0; j < NJOBS; ++j) {
      const ConvJob J = make_job(p, j);
      const int jend = tbeg + J.ntiles();
      const int ti0 = tbeg + (((int)bid - tbeg) % NB_ + NB_) % NB_;
      const int jbeg = tbeg; tbeg = jend;
#pragma unroll 1
      for (int ti = ti0; ti < jend; ti += NB_) {
        int local = ti - jbeg;
        const int tk = J.Kpad / 64, tn = J.Npad / 64;
        const int b = local / (tk * tn); local -= b * tk * tn;
        const int nt = local / tk, kt = local - nt * tk;
        const float* src = J.src + (size_t)b * J.src_bs;
        bf16_t* dst = J.dst + (size_t)b * J.dst_bs;
        const int k0 = kt * 64, n0 = nt * 64;
#pragma unroll
        for (int pass = 0; pass < 2; ++pass) {
            const int kk = (tid >> 4) + pass * 32, nn = (tid & 15) * 4;
            f32x4 v = {0.f, 0.f, 0.f, 0.f};
            if (k0 + kk < J.K && n0 + nn < J.N) v = *(const f32x4*)(src + (size_t)(k0 + kk) * J.src_ld + n0 + nn);
#pragma unroll
            for (int e = 0; e < 4; ++e) tile[(nn + e) * 72 + kk] = (bf16_t)f2bf(v[e]);
        }
        __syncthreads();
        {
            const int nn = tid >> 3, kc = (tid & 7) * 8;
            int nsrc = n0 + nn, ndst = nsrc;
            if (J.perm == 1) { const int up = nsrc >= 512, jj = nsrc - (up ? 512 : 0); ndst = (jj >> 7) * 256 + (up ? 128 : 0) + (jj & 127); }
            const u32x4 v = *(const LAS u32x4*)(tile + nn * 72 + kc);
            *(u32x4*)(dst + (size_t)ndst * J.Kpad + k0 + kc) = v;
        }
        __syncthreads();
      }
    }
    if (bid < 4 * 48) { const int layer = bid / 48, o = bid % 48;
        for (int k = tid; k < D; k += NTHR) { float v = 0.f;
            if (o < 32) v = p.moe_w_route[((size_t)layer * D + k) * 32 + o]; else if (o < 36) v = p.moe_w_group[((size_t)layer * D + k) * 4 + (o - 32)];
            WS_(p, moe_wr_t)[((size_t)layer * 48 + o) * D + k] = (bf16_t)f2bf(v); } }
}
namespace pg8 {
constexpr int BM = 256, BK = 64, HALF = 128, HTB = HALF * BK * 2, STAGE_BYTES = 8 * HTB;
DEV int lds_byte(int r, int c) { const int st = (r >> 4) * 2 + (c >> 5), rr = r & 15, cc = c & 31, ob = rr * 64 + cc * 2; return st * 1024 + (ob ^ (((ob >> 9) & 1) << 5)); }
DEV void stage_rc(int b, int& R, int& C) { const int st = b / 1024, sb = b % 1024, swz = sb ^ (((sb >> 9) & 1) << 5); R = (st >> 1) * 16 + swz / 64; C = (st & 1) * 32 + (swz % 64) / 2; }

struct Unit { const char* A; const char* B; int row0, col0, id, aux; };

DEV bool tile_order(int i, int G, int c, int nM, int nN, int& pm, int& pn) {
    const int nwg = nM * nN; const long L = (long)i * G + c; if (L >= nwg) return false;
    int wgid = (int)L; { const int q = nwg / 8, r = nwg % 8, xcd = wgid % 8, off = wgid / 8; wgid = (xcd < r ? xcd * (q + 1) : r * (q + 1) + (xcd - r) * q) + off; }
    const int nig = 8 * nN, gid = wgid / nig, fm = gid * 8, gsz = (nM - fm) < 8 ? (nM - fm) : 8;
    pm = fm + ((wgid % nig) % gsz); pn = (wgid % nig) / gsz; return true;
}

template <class Epi, class Sched>
DEV void gemm_phase(LAS unsigned char* lds, const int K, const Sched& S, const Epi& E) {
    const int tid = tid_(), wid = __builtin_amdgcn_readfirstlane(tid >> 6), lane = tid & 63, wr = wid >> 2, wc = wid & 3, fr = lane & 15, fq = lane >> 4;
    const int nt = K / BK;
    unsigned voff[2];
#pragma unroll
    for (int i = 0; i < 2; ++i) { int R, C; stage_rc(tid * 16 + i * 8192, R, C); voff[i] = (unsigned)(R * K + C) * 2u; }
    const size_t kstep = (size_t)(BK * 2);
    const size_t hstep = (size_t)HALF * K * 2;
    const unsigned ldsw = (unsigned)wid * 1024u;
    const int aoff = lds_byte(wr * 64 + fr, fq * 8), boff = lds_byte(wc * 32 + fr, fq * 8);
#define PG8_SA(b, h) (((b) * 2 + (h)) * HTB)
#define PG8_SB(b, h) ((4 + (b) * 2 + (h)) * HTB)
#define PG8_STAGE(bufoff, gbase) do { _Pragma("unroll") for (int _i = 0; _i < 2; ++_i) \
        __builtin_amdgcn_global_load_lds((const unsigned*)((const char*)(gbase) + voff[_i]), (LAS unsigned*)(lds + (bufoff) + ldsw + _i * 8192), 16, 0, 0); } while (0)
#define PG8_LDA(dst, b, h) do { _Pragma("unroll") for (int m = 0; m < 4; ++m) _Pragma("unroll") for (int k = 0; k < 2; ++k) dst[m][k] = *(const LAS bf16x8*)(lds + PG8_SA(b, h) + aoff + m * 2048 + k * 1024); } while (0)
#define PG8_LDB(dst, b, h) do { _Pragma("unroll") for (int n = 0; n < 2; ++n) _Pragma("unroll") for (int k = 0; k < 2; ++k) dst[n][k] = *(const LAS bf16x8*)(lds + PG8_SB(b, h) + boff + n * 2048 + k * 1024); } while (0)
#define PG8_MMA(ai, bj, At, Bt) do { __builtin_amdgcn_s_setprio(1); _Pragma("unroll") for (int m = 0; m < 4; ++m) _Pragma("unroll") for (int n = 0; n < 2; ++n) _Pragma("unroll") for (int k = 0; k < 2; ++k) \
        acc[ai][bj][m][n] = __builtin_amdgcn_mfma_f32_16x16x32_bf16(Bt[n][k], At[m][k], acc[ai][bj][m][n], 0, 0, 0); __builtin_amdgcn_s_setprio(0); } while (0)
#define PG8_WAIT_V(n) asm volatile("s_waitcnt vmcnt(" #n ")" ::: "memory")
#define PG8_WAIT_L(n) asm volatile("s_waitcnt lgkmcnt(" #n ")" ::: "memory")
#define PG8_BAR __builtin_amdgcn_s_barrier()
#define PG8_SCHED __builtin_amdgcn_sched_barrier(0)
    Unit cur, nxt; int ui = 0;
    if (!S.next(0, cur)) return;
    f32x4 acc[2][2][4][2];
#pragma unroll
    for (int a = 0; a < 2; ++a)
#pragma unroll
        for (int b = 0; b < 2; ++b)
#pragma unroll
            for (int m = 0; m < 4; ++m)
#pragma unroll
                for (int n = 0; n < 2; ++n) acc[a][b][m][n] = (f32x4){0.f, 0.f, 0.f, 0.f};
    bf16x8 At[4][2], B0[2][2], B1[2][2];
    const char* cA = cur.A; const char* cB = cur.B;
    PG8_STAGE(PG8_SB(0, 0), cB); PG8_STAGE(PG8_SA(0, 0), cA); PG8_STAGE(PG8_SB(0, 1), cB + hstep); PG8_STAGE(PG8_SA(0, 1), cA + hstep);
    if (wr == 1) PG8_BAR;
    PG8_WAIT_V(4); PG8_BAR;
    PG8_STAGE(PG8_SB(1, 0), cB + kstep); PG8_STAGE(PG8_SA(1, 0), cA + kstep); PG8_STAGE(PG8_SB(1, 1), cB + hstep + kstep);
    PG8_WAIT_V(6); PG8_BAR;
    for (;;) {
        const bool has_next = S.next(ui + 1, nxt);
        const char* nA = has_next ? nxt.A : cA; const char* nB = has_next ? nxt.B : cB;
#pragma unroll 1
        for (int t = 0; t < nt; t += 2) {
            const bool last = (t == nt - 2);
            const char* a1 = cA + (size_t)(t + 1) * kstep;
            const char* a2 = last ? nA : cA + (size_t)(t + 2) * kstep; const char* b2 = last ? nB : cB + (size_t)(t + 2) * kstep;
            const char* a3 = a2 + kstep; const char* b3 = b2 + kstep;
            PG8_LDB(B0, 0, 0); PG8_SCHED; PG8_LDA(At, 0, 0); PG8_STAGE(PG8_SA(1, 1), a1 + hstep);
            PG8_WAIT_L(8); PG8_BAR; PG8_WAIT_L(0); PG8_MMA(0, 0, At, B0); PG8_BAR; PG8_SCHED;
            PG8_LDB(B1, 0, 1); PG8_STAGE(PG8_SB(0, 0), b2);
            PG8_BAR; PG8_WAIT_L(0); PG8_MMA(0, 1, At, B1); PG8_BAR;
            PG8_LDA(At, 0, 1); PG8_STAGE(PG8_SA(0, 0), a2);
            PG8_BAR; PG8_WAIT_L(0); PG8_MMA(1, 0, At, B0); PG8_BAR; PG8_SCHED;
            PG8_STAGE(PG8_SB(0, 1), b2 + hstep);
            PG8_WAIT_V(6); PG8_BAR; PG8_MMA(1, 1, At, B1); PG8_BAR;
            PG8_LDB(B0, 1, 0); PG8_SCHED; PG8_LDA(At, 1, 0); PG8_STAGE(PG8_SA(0, 1), a2 + hstep);
            PG8_WAIT_L(8); PG8_BAR; PG8_WAIT_L(0); PG8_MMA(0, 0, At, B0); PG8_BAR; PG8_SCHED;
            PG8_LDB(B1, 1, 1); PG8_STAGE(PG8_SB(1, 0), b3);
            PG8_BAR; PG8_WAIT_L(0); PG8_MMA(0, 1, At, B1); PG8_BAR;
            PG8_LDA(At, 1, 1); PG8_STAGE(PG8_SA(1, 0), a3);
            PG8_BAR; PG8_WAIT_L(0); PG8_MMA(1, 0, At, B0); PG8_BAR; PG8_SCHED;
            PG8_STAGE(PG8_SB(1, 1), b3 + hstep);
            PG8_WAIT_V(6); PG8_BAR; PG8_MMA(1, 1, At, B1); PG8_BAR;
        }
        E(acc, cur, wr, wc, fr, fq);
        if (!has_next) break;
#pragma unroll
        for (int a = 0; a < 2; ++a)
#pragma unroll
            for (int b = 0; b < 2; ++b)
#pragma unroll
                for (int m = 0; m < 4; ++m)
#pragma unroll
                    for (int n = 0; n < 2; ++n) acc[a][b][m][n] = (f32x4){0.f, 0.f, 0.f, 0.f};
        cur = nxt; cA = nA; cB = nB; ++ui;
    }
    PG8_WAIT_V(0);
    if (wr == 0) PG8_BAR;
    PG8_BAR;
#undef PG8_SA
#undef PG8_SB
#undef PG8_STAGE
#undef PG8_LDA
#undef PG8_LDB
#undef PG8_MMA
#undef PG8_WAIT_V
#undef PG8_WAIT_L
#undef PG8_BAR
#undef PG8_SCHED
}
}
using pg8::Unit;
typedef f32x4 AccT[2][2][4][2];
#define FOR_ACC(ai, bj, m, n) _Pragma("unroll") for (int ai = 0; ai < 2; ++ai) _Pragma("unroll") for (int m = 0; m < 4; ++m) _Pragma("unroll") for (int bj = 0; bj < 2; ++bj) _Pragma("unroll") for (int n = 0; n < 2; ++n)
#define ACC_FENCE __builtin_amdgcn_sched_barrier(0)
#define ACC_ROW(u, ai, m) ((u).row0 + 128 * (ai) + 64 * wr + 16 * (m) + fr)
#define ACC_COL(u, bj, n) ((u).col0 + 128 * (bj) + 32 * wc + 16 * (n) + 4 * fq)
DEV void st_bf4(bf16_t* p, f32x4 v) { u32x2 w; w.x = pk2(v[0], v[1]); w.y = pk2(v[2], v[3]); *(u32x2*)p = w; }
DEV void load_row(const float* p, int lane, f32x4 (&v)[4]) {
#pragma unroll
    for (int q = 0; q < 4; ++q) v[q] = *(const f32x4*)(p + 256 * q + 4 * lane);
}

DEV void load_row_bf(const bf16_t* p, int lane, f32x4 (&v)[4]) {
#pragma unroll
    for (int q = 0; q < 4; ++q) { const u32x2 a = *(const u32x2*)(p + 256 * q + 4 * lane); v[q] = (f32x4){bflo(a.x), bfhi(a.x), bflo(a.y), bfhi(a.y)}; }
}
DEV void store_row_bf(bf16_t* p, int lane, const f32x4 (&v)[4]) {
#pragma unroll
    for (int q = 0; q < 4; ++q) st_bf4(p + 256 * q + 4 * lane, v[q]);
}
DEV void emit_mix6(const Params& p, int j, int t, int lane, const f32x4 (&x)[4], const f32x4 (&xp)[4]) {
    const float* mu = p.rw_mu + (size_t)j * 6 * D;
#pragma unroll
    for (int s = 0; s < 6; ++s) {
#pragma unroll
        for (int q = 0; q < 4; ++q) {
            const f32x4 m = *(const f32x4*)(mu + s * D + 256 * q + 4 * lane);
            st_bf4(WS_(p, X6) + (size_t)s * T * D + (size_t)t * D + 256 * q + 4 * lane, x[q] + (xp[q] - x[q]) * m);
        }
        __builtin_amdgcn_sched_barrier(0);
    }
}
DEV void phase_pre0(const Params& p) {
    const int tid = tid_(), bid = bid_(); const int lane = tid & 63, wid = tid >> 6;
    f32x4 x[4], xp[4];
    const int tfirst = bid * 64 + wid * 8;
    if (tfirst > 0) load_row(p.x + (size_t)(tfirst - 1) * D, lane, xp); else { for (int q = 0; q < 4; ++q) xp[q] = (f32x4){0.f, 0.f, 0.f, 0.f}; }
    for (int r = 0; r < 8; ++r) {
        const int t = tfirst + r;
        load_row(p.x + (size_t)t * D, lane, x);
        store_row_bf(WS_(p, Hb) + (size_t)t * D, lane, x);
        emit_mix6(p, 0, t, lane, x, xp);
#pragma unroll
        for (int q = 0; q < 4; ++q) xp[q] = x[q];
    }
}

struct SchedRW1 {
    const Params* p; int j;
    DEV bool next(int i, Unit& u) const {
        int pm, pn; if (!pg8::tile_order(i, NB_, bid_(), 64, 15, pm, pn)) return false;
        int id, lpn; if (pn < 12) { id = pn >> 2; lpn = pn & 3; } else { id = 3 + (pn - 12); lpn = 0; }
        u.A = (const char*)(WS_(*p, X6) + (size_t)id * T * D + (size_t)pm * 256 * D);
        const bf16_t* B;
        if (id < 3) B = WS_(*p, rw_rkv_t) + ((size_t)j * 3 + id) * D * D + (size_t)lpn * 256 * D;
        else B = WS_(*p, rw_w1_t) + (size_t)(id - 3) * (2 * 256 * D) + (size_t)j * 256 * D;
        u.B = (const char*)B; u.row0 = pm * 256; u.col0 = lpn * 256; u.id = id; u.aux = 0; return true;
    }
};
struct EpiRW1 {
    const Params* p;
    DEV void operator()(const AccT& acc, const Unit& u, int wr, int wc, int fr, int fq) const {
        if (u.id < 3) {
            float* O = WS_(*p, Rr) + (size_t)u.id * T * D;
            FOR_ACC(ai, bj, m, n) *(f32x4*)(O + (size_t)ACC_ROW(u, ai, m) * D + ACC_COL(u, bj, n)) = acc[ai][bj][m][n];
        } else {
            bf16_t* O = WS_(*p, LW) + (size_t)(u.id - 3) * T * 256;
            FOR_ACC(ai, bj, m, n) {
                f32x4 v = acc[ai][bj][m][n];
                if (u.id == 3) { for (int e = 0; e < 4; ++e) v[e] = tanhf_(v[e]); }
                else if (u.id == 5) { for (int e = 0; e < 4; ++e) v[e] = sigmoidf_(v[e]); }
                st_bf4(O + (size_t)ACC_ROW(u, ai, m) * 256 + ACC_COL(u, bj, n), v); ACC_FENCE;
            }
        }
    }
};
struct SchedRW2 {
    const Params* p; int j;
    DEV bool next(int i, Unit& u) const {
        int pm, pn; if (!pg8::tile_order(i, NB_, bid_(), 64, 12, pm, pn)) return false;
        const int id = pn >> 2, lpn = pn & 3;
        u.A = (const char*)(WS_(*p, LW) + (size_t)id * T * 256 + (size_t)pm * 256 * 256);
        const bf16_t* B = WS_(*p, rw_w2_t) + (size_t)id * (2 * D * 256) + (size_t)j * D * 256 + (size_t)lpn * 256 * 256;
        u.B = (const char*)B; u.row0 = pm * 256; u.col0 = lpn * 256; u.id = id; u.aux = 0; return true;
    }
};
struct EpiRW2 {
    const Params* p; int j;
    DEV void operator()(const AccT& acc, const Unit& u, int wr, int wc, int fr, int fq) const {
        if (u.id == 0) { const float* bias = p->rw_w0 + (size_t)j * D;
            FOR_ACC(ai, bj, m, n) { f32x4 v = acc[ai][bj][m][n]; const int c = ACC_COL(u, bj, n); const f32x4 b = *(const f32x4*)(bias + c);
                for (int e = 0; e < 4; ++e) { const float x = -(b[e] + v[e]); const float wl = -(fmaxf(x, 0.f) + __logf(1.0f + __expf(-fabsf(x)))) - 0.5f; v[e] = -__expf(wl); }
                *(f32x4*)(WS_(*p, Wd) + (size_t)ACC_ROW(u, ai, m) * D + c) = v; ACC_FENCE; } }
        else if (u.id == 1) { const float* bias = p->rw_a0 + (size_t)j * D;
            FOR_ACC(ai, bj, m, n) { f32x4 v = acc[ai][bj][m][n]; const int c = ACC_COL(u, bj, n); const f32x4 b = *(const f32x4*)(bias + c);
                for (int e = 0; e < 4; ++e) v[e] = sigmoidf_(b[e] + v[e]);
                *(f32x4*)(WS_(*p, Aa) + (size_t)ACC_ROW(u, ai, m) * D + c) = v; ACC_FENCE; } }
        else { FOR_ACC(ai, bj, m, n) *(f32x4*)(WS_(*p, Gg) + (size_t)ACC_ROW(u, ai, m) * D + ACC_COL(u, bj, n)) = acc[ai][bj][m][n]; }
    }
};

struct SchedOut {
    const bf16_t* A; const bf16_t* Bt; int K;
    DEV bool next(int i, Unit& u) const {
        int pm, pn; if (!pg8::tile_order(i, NB_, bid_(), 64, 4, pm, pn)) return false;
        u.A = (const char*)(A + (size_t)pm * 256 * K); u.B = (const char*)(Bt + (size_t)pn * 256 * K); u.row0 = pm * 256; u.col0 = pn * 256; u.id = 0; u.aux = 0; return true;
    }
};
struct EpiOut {
    bf16_t* O;
    DEV void operator()(const AccT& acc, const Unit& u, int wr, int wc, int fr, int fq) const {
        FOR_ACC(ai, bj, m, n) { st_bf4(O + (size_t)ACC_ROW(u, ai, m) * D + ACC_COL(u, bj, n), acc[ai][bj][m][n]); ACC_FENCE; }
    }
};
constexpr int RC_LD = 72;
#ifdef DBG
#define DBGF(cond, bit) do { if (cond) atomicOr(&WS_(p, TAB)[200], (bit)); } while (0)
#else
#define DBGF(cond, bit) do {} while (0)
#endif
DEV bool bad_(float x) { return !(fabsf(x) < 1e30f); }
DEV int rc_pi(int g, int j) { return j < 4 ? 4 * g + j : 16 + 4 * g + (j - 4); }

DEV void rc_cum(const Params& p, int t0, int cb, LAS float* cum, LAS float* seg) {
    const int tid = tid_(); const int k = tid & 63, sg = tid >> 6;
    float v[8]; float s = 0.f;
#pragma unroll
    for (int i = 0; i < 8; ++i) { s += WS_(p, Wd)[(size_t)(t0 + sg * 8 + i) * D + cb + k]; v[i] = s; }
    seg[sg * 64 + k] = s;
    __syncthreads();
    float off = 0.f;
#pragma unroll
    for (int q = 0; q < 8; ++q) off += (q < sg) ? seg[q * 64 + k] : 0.f;
#pragma unroll
    for (int i = 0; i < 8; ++i) cum[(sg * 8 + i) * 64 + k] = v[i] + off;
    __syncthreads();
}
DEV void ld8(const float* p, float (&f)[8]) { const f32x4 a = *(const f32x4*)p, b = *(const f32x4*)(p + 4); f[0] = a[0]; f[1] = a[1]; f[2] = a[2]; f[3] = a[3]; f[4] = b[0]; f[5] = b[1]; f[6] = b[2]; f[7] = b[3]; }
DEV void lds8(const LAS float* p, float (&f)[8]) { const f32x4 a = *(const LAS f32x4*)p, b = *(const LAS f32x4*)(p + 4); f[0] = a[0]; f[1] = a[1]; f[2] = a[2]; f[3] = a[3]; f[4] = b[0]; f[5] = b[1]; f[6] = b[2]; f[7] = b[3]; }
DEV u32x4 pk8(const float (&f)[8]) { u32x4 o; o.x = pk2(f[0], f[1]); o.y = pk2(f[2], f[3]); o.z = pk2(f[4], f[5]); o.w = pk2(f[6], f[7]); return o; }

DEV bf16x8 frag_rm_pi(const LAS bf16_t* base, int ld, int row0, int k0, int lane) {
    const LAS bf16_t* a = base + (row0 + (lane & 15)) * ld + k0 + 4 * (lane >> 4);
    const s16x4 lo = *(const LAS s16x4*)a, hi = *(const LAS s16x4*)(a + 16);
    bf16x8 r; r[0] = lo[0]; r[1] = lo[1]; r[2] = lo[2]; r[3] = lo[3]; r[4] = hi[0]; r[5] = hi[1]; r[6] = hi[2]; r[7] = hi[3]; return r;
}
DEV void rc_prep8(const float (&k)[8], const float (&al)[8], const float* k_k, const float* k_a, float (&a)[8], float (&b)[8], float (&kh)[8]) {
    float kkw[8], kaw[8]; ld8(k_k, kkw); ld8(k_a, kaw);
    float kk[8]; float ss = 0.f;
#pragma unroll
    for (int e = 0; e < 8; ++e) { kk[e] = k[e] * kkw[e]; ss += kk[e] * kk[e]; }
    ss += __shfl_xor(ss, 1); ss += __shfl_xor(ss, 2); ss += __shfl_xor(ss, 4);
    const float inv = 1.0f / fmaxf(sqrtf(ss), 1e-12f);
#pragma unroll
    for (int e = 0; e < 8; ++e) { const float kn = kk[e] * inv; a[e] = -kn; b[e] = kn * al[e]; kh[e] = k[e] * (1.0f + (al[e] - 1.0f) * kaw[e]); }
}
DEV void phase_rw_cha(const Params& p, int jl, LAS unsigned char* lds) {
    const int tid = tid_(), bid = bid_(); const int lane = tid & 63, w = tid >> 6; const int fr = lane & 15, fq = lane >> 4;
    LAS float* cum = (LAS float*)lds;
    LAS float* seg = cum + 64 * 64;
    LAS float* Aab = seg + 8 * 64;
    LAS bf16_t* As = (LAS bf16_t*)(Aab + 64 * 68);
    LAS bf16_t* Bs = As + 64 * RC_LD; LAS bf16_t* Ks = Bs + 64 * RC_LD; LAS bf16_t* Vs = Ks + 64 * RC_LD; LAS bf16_t* Ke = Vs + 64 * RC_LD;
    LAS bf16_t* Aak = Ke + 64 * RC_LD; LAS bf16_t* Ts = Aak + 64 * RC_LD; LAS bf16_t* X1 = Ts + 64 * RC_LD; LAS bf16_t* Aabh = X1 + 64 * RC_LD;
    LAS bf16_t* Fimg = Aabh + 64 * RC_LD;
    LAS bf16_t* Wimg = Fimg + 4096;
    for (int u = bid; u < 4096; u += NB_) {
        const int c = u >> 4, h = u & 15; const int t0 = c * 64, cb = h * 64; const size_t ub = (size_t)c * 16 + h;
        __syncthreads();
        rc_cum(p, t0, cb, cum, seg);
        {
            const int t = tid >> 3, k8 = (tid & 7) * 8; const size_t go = (size_t)(t0 + t) * D + cb + k8;
            float a[8], b[8], kh[8], v[8], ct[8], cp[8], ce[8];
            { float kr[8], al[8]; ld8(WS_(p, Kk) + go, kr); ld8(WS_(p, Aa) + go, al); ld8(WS_(p, Vv) + go, v);
              rc_prep8(kr, al, p.rw_k_k + (size_t)jl * D + cb + k8, p.rw_k_a + (size_t)jl * D + cb + k8, a, b, kh); }
            lds8(cum + t * 64 + k8, ct); lds8(cum + 63 * 64 + k8, ce);
            if (t > 0) lds8(cum + (t - 1) * 64 + k8, cp); else { for (int e = 0; e < 8; ++e) cp[e] = 0.f; }
            float at[8], bt[8], kt[8], be[8], ke[8];
#pragma unroll
            for (int e = 0; e < 8; ++e) { const float ei = __expf(-ct[e]), ee = __expf(ce[e] - ct[e]); at[e] = a[e] * __expf(cp[e]); bt[e] = b[e] * ei; kt[e] = kh[e] * ei; be[e] = b[e] * ee; ke[e] = kh[e] * ee; }
            *(LAS u32x4*)(As + t * RC_LD + k8) = pk8(at); *(LAS u32x4*)(Bs + t * RC_LD + k8) = pk8(bt); *(LAS u32x4*)(Ks + t * RC_LD + k8) = pk8(kt);
            *(LAS u32x4*)(Ke + t * RC_LD + k8) = pk8(ke); *(LAS u32x4*)(Vs + t * RC_LD + k8) = pk8(v);
            const int tq = t & 31, g = (tq & 15) >> 2, j = (tq & 3) + ((tq >> 4) << 2);
#pragma unroll
            for (int e = 0; e < 8; ++e) { const int k = k8 + e; Fimg[(((k >> 4) * 2 + (t >> 5)) * 64 + g * 16 + (k & 15)) * 8 + j] = (bf16_t)f2bf(be[e]); }
            *(LAS u32x4*)(Ts + tid * 8) = (u32x4){0u, 0u, 0u, 0u}; if (tid < 64) *(LAS u32x4*)(Ts + (512 + tid) * 8) = (u32x4){0u, 0u, 0u, 0u};
            if (t == 63) { float gm[8]; for (int e = 0; e < 8; ++e) gm[e] = __expf(ce[e]); *(f32x4*)(WS_(p, RGc) + ub * 64 + k8) = (f32x4){gm[0], gm[1], gm[2], gm[3]}; *(f32x4*)(WS_(p, RGc) + ub * 64 + k8 + 4) = (f32x4){gm[4], gm[5], gm[6], gm[7]}; }
        }
        __syncthreads();
        {
            const int tb = w >> 1;
#pragma unroll
            for (int ii = 0; ii < 2; ++ii) { const int ib = 2 * (w & 1) + ii;
                f32x4 ab = {0.f, 0.f, 0.f, 0.f}, ak = {0.f, 0.f, 0.f, 0.f};
                if (ib <= tb) {
#pragma unroll
                    for (int ks = 0; ks < 2; ++ks) { const bf16x8 af = frag_rm(As, RC_LD, 16 * tb, 32 * ks, lane);
                        ab = MFMA16(af, frag_rm(Bs, RC_LD, 16 * ib, 32 * ks, lane), ab); ak = MFMA16(af, frag_rm(Ks, RC_LD, 16 * ib, 32 * ks, lane), ak); } }
#pragma unroll
                for (int r = 0; r < 4; ++r) { const int t = 16 * tb + 4 * fq + r, i = 16 * ib + fr; const bool keep = i < t;
                    Aab[t * 68 + i] = keep ? ab[r] : 0.f; Aabh[t * RC_LD + i] = (bf16_t)f2bf(keep ? ab[r] : 0.f); Aak[t * RC_LD + i] = (bf16_t)f2bf(keep ? ak[r] : 0.f); } }
            *(u32x4*)(WS_(p, RBf) + ub * 4096 + tid * 8) = *(const LAS u32x4*)(Fimg + tid * 8);
        }
        __syncthreads();
        if (w == 0) {
            const int blk = lane >> 4, jc = lane & 15;
            float Tc[16];
#pragma unroll
            for (int t = 0; t < 16; ++t) {
                float acc = jc == t ? 1.f : 0.f;
#pragma unroll
                for (int i4 = 0; i4 < (t + 3) / 4; ++i4) { const f32x4 a4 = *(const LAS f32x4*)(Aab + (16 * blk + t) * 68 + 16 * blk + i4 * 4);
#pragma unroll
                    for (int e = 0; e < 4; ++e) if (i4 * 4 + e < t) acc += a4[e] * Tc[i4 * 4 + e]; }
                Tc[t] = acc;
            }
#pragma unroll
            for (int t = 0; t < 16; ++t) Ts[(16 * blk + t) * RC_LD + 16 * blk + jc] = (bf16_t)f2bf(Tc[t]);
#pragma unroll
            for (int b = 1; b < 4; ++b) {
                const s16x4 dlo = *(const LAS s16x4*)(Ts + (16 * b + fr) * RC_LD + 16 * b + 4 * fq);
                bf16x8 dfr; dfr[0] = dlo[0]; dfr[1] = dlo[1]; dfr[2] = dlo[2]; dfr[3] = dlo[3]; dfr[4] = 0; dfr[5] = 0; dfr[6] = 0; dfr[7] = 0;
                f32x4 tt_[3];
#pragma unroll
                for (int cbk = 0; cbk < b; ++cbk) {
                    f32x4 x = {0.f, 0.f, 0.f, 0.f};
#pragma unroll
                    for (int ks = 0; ks < 2; ++ks) x = MFMA16(frag_rm(Aabh, RC_LD, 16 * b, 32 * ks, lane), frag_tr(Ts, RC_LD, 32 * ks, 16 * cbk, lane), x);
                    u32x4 xb; xb.x = pk2(x[0], x[1]); xb.y = pk2(x[2], x[3]); xb.z = 0u; xb.w = 0u;
                    tt_[cbk] = MFMA16(dfr, __builtin_bit_cast(bf16x8, xb), ((f32x4){0.f, 0.f, 0.f, 0.f}));
                }
#pragma unroll
                for (int cbk = 0; cbk < b; ++cbk)
#pragma unroll
                    for (int r = 0; r < 4; ++r) Ts[(16 * b + 4 * fq + r) * RC_LD + 16 * cbk + fr] = (bf16_t)f2bf(tt_[cbk][r]);
            }
        } else {
            for (int tl = w - 1; tl < 32; tl += 7) {
                const int rb = (tl & 15) >> 2, vbk = tl & 3; f32x4 acc = {0.f, 0.f, 0.f, 0.f};
                if (tl < 16) {
#pragma unroll
                    for (int ks = 0; ks < 2; ++ks) acc = MFMA16(frag_rm(Aak, RC_LD, 16 * rb, 32 * ks, lane), frag_tr(Vs, RC_LD, 32 * ks, 16 * vbk, lane), acc);
#pragma unroll
                    for (int r = 0; r < 4; ++r) X1[(16 * rb + 4 * fq + r) * RC_LD + 16 * vbk + fr] = (bf16_t)f2bf(acc[r]);
                } else {
#pragma unroll
                    for (int ks = 0; ks < 2; ++ks) acc = MFMA16(frag_tr(Ke, RC_LD, 32 * ks, 16 * rb, lane), frag_tr(Vs, RC_LD, 32 * ks, 16 * vbk, lane), acc);
                    { u32x2 o; o.x = pk2(acc[0], acc[1]); o.y = pk2(acc[2], acc[3]); *(u32x2*)(WS_(p, RNa) + (((ub * 4 + vbk) * 4 + rb) * 64 + lane) * 4) = o; }
                }
            }
        }
        __syncthreads();
#pragma unroll
        for (int q = 0; q < 4; ++q) { const int tl = w * 4 + q; const int tt = (tl & 15) >> 2, cbk = tl & 3; f32x4 acc = {0.f, 0.f, 0.f, 0.f};
            if (tl < 16) {
#pragma unroll
                for (int ks = 0; ks < 2; ++ks) acc = MFMA16(frag_rm(Ts, RC_LD, 16 * tt, 32 * ks, lane), frag_tr(As, RC_LD, 32 * ks, 16 * cbk, lane), acc);
                const int k = 16 * cbk + fr, kq = k & 31, g = (kq & 15) >> 2, j = (kq & 3) + ((kq >> 4) << 2);
#pragma unroll
                for (int r = 0; r < 4; ++r) Wimg[((tt * 2 + (k >> 5)) * 64 + g * 16 + 4 * fq + r) * 8 + j] = (bf16_t)f2bf(acc[r]);
            } else {
#pragma unroll
                for (int ks = 0; ks < 2; ++ks) acc = MFMA16(frag_rm(Ts, RC_LD, 16 * tt, 32 * ks, lane), frag_tr(X1, RC_LD, 32 * ks, 16 * cbk, lane), acc);
                { u32x2 o; o.x = pk2(acc[0], acc[1]); o.y = pk2(acc[2], acc[3]); *(u32x2*)(WS_(p, RUt) + (((ub * 4 + cbk) * 4 + tt) * 64 + lane) * 4) = o; }
            } }
        __syncthreads();
        *(u32x4*)(WS_(p, RWf) + ub * 4096 + tid * 8) = *(const LAS u32x4*)(Wimg + tid * 8);
    }
}

constexpr int RB_SLOT = 20992, RB_R = 6, RB_P = 4;
DEV void phase_rw_chb(const Params& p, LAS unsigned char* lds) {
    const int tid = tid_(), bid = bid_();
    if (bid >= 64) return;
    const int lane = tid & 63, w = __builtin_amdgcn_readfirstlane(tid >> 6); const int head = bid >> 2, vb = bid & 3; const int fq = lane >> 4;
    auto issue = [&](int c) {
        const size_t ub = (size_t)c * 16 + head; LAS unsigned char* slot = lds + (c % RB_R) * RB_SLOT;
#pragma unroll
        for (int i = 0; i < 3; ++i) { const int pi = (w - 1) * 3 + i;
            if (pi < 8) __builtin_amdgcn_global_load_lds((const unsigned*)(WS_(p, RWf) + ub * 4096 + pi * 512 + lane * 8), (LAS unsigned*)(slot + pi * 1024), 16, 0, 0);
            else if (pi < 16) __builtin_amdgcn_global_load_lds((const unsigned*)(WS_(p, RBf) + ub * 4096 + (pi - 8) * 512 + lane * 8), (LAS unsigned*)(slot + 8192 + (pi - 8) * 1024), 16, 0, 0);
            else if (pi < 18) __builtin_amdgcn_global_load_lds((const unsigned*)(WS_(p, RUt) + (ub * 4 + vb) * 1024 + (pi - 16) * 512 + lane * 8), (LAS unsigned*)(slot + 16384 + (pi - 16) * 1024), 16, 0, 0);
            else if (pi < 20) __builtin_amdgcn_global_load_lds((const unsigned*)(WS_(p, RNa) + (ub * 4 + vb) * 1024 + (pi - 18) * 512 + lane * 8), (LAS unsigned*)(slot + 18432 + (pi - 18) * 1024), 16, 0, 0);
            else __builtin_amdgcn_global_load_lds((const unsigned*)(WS_(p, RGc) + ub * 64 + lane), (LAS unsigned*)(slot + 20480), 4, 0, 0);
        }
    };
    if (w > 0) {
#pragma unroll 1
        for (int c = 0; c < RB_P; ++c) issue(c);
        asm volatile("s_waitcnt vmcnt(9)" ::: "memory");
    }
    __builtin_amdgcn_s_barrier();
    f32x4 s[4]; for (int i = 0; i < 4; ++i) s[i] = (f32x4){0.f, 0.f, 0.f, 0.f};
#pragma unroll 1
    for (int c = 0; c < 256; ++c) {
        if (w > 0) {
            if (c + RB_P < 256) { issue(c + RB_P); asm volatile("s_waitcnt vmcnt(9)" ::: "memory"); }
            else asm volatile("s_waitcnt vmcnt(0)" ::: "memory");
        } else {
            const LAS unsigned char* slot = lds + (c % RB_R) * RB_SLOT; const size_t ub = (size_t)c * 16 + head;
            bf16x8 wf[8], bf[8]; u32x2 ut[4], na[4]; f32x4 gc[4];
#pragma unroll
            for (int f = 0; f < 8; ++f) { wf[f] = *(const LAS bf16x8*)(slot + (f * 64 + lane) * 16); bf[f] = *(const LAS bf16x8*)(slot + 8192 + (f * 64 + lane) * 16); }
#pragma unroll
            for (int q = 0; q < 4; ++q) { ut[q] = *(const LAS u32x2*)(slot + 16384 + (q * 64 + lane) * 8); na[q] = *(const LAS u32x2*)(slot + 18432 + (q * 64 + lane) * 8); gc[q] = *(const LAS f32x4*)(slot + 20480 + (16 * q + 4 * fq) * 4); }
#pragma unroll
            for (int kt = 0; kt < 4; ++kt) { u32x2 o; o.x = pk2(s[kt][0], s[kt][1]); o.y = pk2(s[kt][2], s[kt][3]); *(u32x2*)(WS_(p, RS0) + (((ub * 4 + vb) * 4 + kt) * 64 + lane) * 4) = o; }
            bf16x8 sb[2];
#pragma unroll
            for (int ks = 0; ks < 2; ++ks) { u32x4 o; o.x = pk2(s[2 * ks][0], s[2 * ks][1]); o.y = pk2(s[2 * ks][2], s[2 * ks][3]); o.z = pk2(s[2 * ks + 1][0], s[2 * ks + 1][1]); o.w = pk2(s[2 * ks + 1][2], s[2 * ks + 1][3]); sb[ks] = __builtin_bit_cast(bf16x8, o); }
            f32x4 uu[4];
#pragma unroll
            for (int tt = 0; tt < 4; ++tt) { uu[tt] = (f32x4){bflo(ut[tt].x), bfhi(ut[tt].x), bflo(ut[tt].y), bfhi(ut[tt].y)}; uu[tt] = MFMA16(wf[tt * 2], sb[0], uu[tt]); uu[tt] = MFMA16(wf[tt * 2 + 1], sb[1], uu[tt]); }
#pragma unroll
            for (int tt = 0; tt < 4; ++tt) { u32x2 o; o.x = pk2(uu[tt][0], uu[tt][1]); o.y = pk2(uu[tt][2], uu[tt][3]); *(u32x2*)(WS_(p, RUa) + (((ub * 4 + vb) * 4 + tt) * 64 + lane) * 4) = o; }
            bf16x8 ubf[2];
#pragma unroll
            for (int ks = 0; ks < 2; ++ks) { u32x4 o; o.x = pk2(uu[2 * ks][0], uu[2 * ks][1]); o.y = pk2(uu[2 * ks][2], uu[2 * ks][3]); o.z = pk2(uu[2 * ks + 1][0], uu[2 * ks + 1][1]); o.w = pk2(uu[2 * ks + 1][2], uu[2 * ks + 1][3]); ubf[ks] = __builtin_bit_cast(bf16x8, o); }
#pragma unroll
            for (int kt = 0; kt < 4; ++kt) { s[kt] = s[kt] * gc[kt] + (f32x4){bflo(na[kt].x), bfhi(na[kt].x), bflo(na[kt].y), bfhi(na[kt].y)}; s[kt] = MFMA16(bf[kt * 2], ubf[0], s[kt]); s[kt] = MFMA16(bf[kt * 2 + 1], ubf[1], s[kt]); }
            asm volatile("s_waitcnt lgkmcnt(0)" ::: "memory");
        }
        __builtin_amdgcn_s_barrier();
    }
    asm volatile("s_waitcnt vmcnt(0)" ::: "memory");
}

DEV void phase_rw_chc(const Params& p, int j, LAS unsigned char* lds) {
    const int tid = tid_(), bid = bid_(); const int lane = tid & 63, w = tid >> 6; const int fr = lane & 15, fq = lane >> 4;
    LAS float* cum = (LAS float*)lds;
    LAS float* seg = cum + 64 * 64;
    LAS float* Ys = seg + 8 * 64;
    LAS bf16_t* Rs = (LAS bf16_t*)(Ys + 64 * 68);
    LAS bf16_t* Bs = Rs + 64 * RC_LD; LAS bf16_t* Ks = Bs + 64 * RC_LD; LAS bf16_t* Vs = Ks + 64 * RC_LD; LAS bf16_t* Arb = Vs + 64 * RC_LD; LAS bf16_t* Ark = Arb + 64 * RC_LD;
    const float* lg = p.rw_lnx_g + (size_t)j * D; const float* lb = p.rw_lnx_b + (size_t)j * D;
    for (int u = bid; u < 4096; u += NB_) {
        const int c = u >> 4, h = u & 15; const int t0 = c * 64, cb = h * 64; const size_t ub = (size_t)c * 16 + h;
        const int tt = w & 3;
        u32x2 ufr[2][2][2], sfr[2][2][2];
#pragma unroll
        for (int q = 0; q < 2; ++q)
#pragma unroll
            for (int ks = 0; ks < 2; ++ks)
#pragma unroll
                for (int hf = 0; hf < 2; ++hf) { const size_t o = (((ub * 4 + 2 * (w >> 2) + q) * 4 + 2 * ks + hf) * 64 + lane) * 4;
                    ufr[q][ks][hf] = *(const u32x2*)(WS_(p, RUa) + o); sfr[q][ks][hf] = *(const u32x2*)(WS_(p, RS0) + o); }
        __syncthreads();
        rc_cum(p, t0, cb, cum, seg);
        const int t = tid >> 3, k8 = (tid & 7) * 8; const size_t go = (size_t)(t0 + t) * D + cb + k8;
        float v[8]; float bc;
        {   float r[8], kr[8], al[8], a[8], b[8], kh[8], ct[8], rkw[8];
            ld8(WS_(p, Rr) + go, r); ld8(WS_(p, Kk) + go, kr); ld8(WS_(p, Aa) + go, al); ld8(WS_(p, Vv) + go, v); lds8(cum + t * 64 + k8, ct);
            rc_prep8(kr, al, p.rw_k_k + (size_t)j * D + cb + k8, p.rw_k_a + (size_t)j * D + cb + k8, a, b, kh);
            ld8(p.rw_r_k + (size_t)j * D + cb + k8, rkw);
            bc = 0.f;
#pragma unroll
            for (int e = 0; e < 8; ++e) bc += r[e] * kh[e] * rkw[e];
            bc += __shfl_xor(bc, 1); bc += __shfl_xor(bc, 2); bc += __shfl_xor(bc, 4);
#pragma unroll
            for (int e = 0; e < 8; ++e) { const float ei = __expf(-ct[e]); r[e] *= __expf(ct[e]); b[e] *= ei; kh[e] *= ei; }
            *(LAS u32x4*)(Rs + t * RC_LD + k8) = pk8(r); *(LAS u32x4*)(Bs + t * RC_LD + k8) = pk8(b); *(LAS u32x4*)(Ks + t * RC_LD + k8) = pk8(kh); *(LAS u32x4*)(Vs + t * RC_LD + k8) = pk8(v);
        }
        __syncthreads();
        {   const int tb = w >> 1;
#pragma unroll
            for (int ii = 0; ii < 2; ++ii) { const int ib = 2 * (w & 1) + ii;
                f32x4 ab = {0.f, 0.f, 0.f, 0.f}, ak = {0.f, 0.f, 0.f, 0.f};
                if (ib <= tb) {
#pragma unroll
                    for (int ks = 0; ks < 2; ++ks) { const bf16x8 af = frag_rm(Rs, RC_LD, 16 * tb, 32 * ks, lane);
                        ab = MFMA16(af, frag_rm(Bs, RC_LD, 16 * ib, 32 * ks, lane), ab); ak = MFMA16(af, frag_rm(Ks, RC_LD, 16 * ib, 32 * ks, lane), ak); } }
#pragma unroll
                for (int r = 0; r < 4; ++r) { const int tr = 16 * tb + 4 * fq + r, i = 16 * ib + fr; const bool keep = i <= tr;
                    Arb[tr * RC_LD + i] = (bf16_t)f2bf(keep ? ab[r] : 0.f); Ark[tr * RC_LD + i] = (bf16_t)f2bf(keep ? ak[r] : 0.f); } }
        }
        __syncthreads();
#pragma unroll
        for (int q = 0; q < 2; ++q) { const int vbk = 2 * (w >> 2) + q; f32x4 acc = {0.f, 0.f, 0.f, 0.f};
#pragma unroll
            for (int ks = 0; ks < 2; ++ks) {
                u32x4 bu, bs; bu.x = ufr[q][ks][0].x; bu.y = ufr[q][ks][0].y; bu.z = ufr[q][ks][1].x; bu.w = ufr[q][ks][1].y; bs.x = sfr[q][ks][0].x; bs.y = sfr[q][ks][0].y; bs.z = sfr[q][ks][1].x; bs.w = sfr[q][ks][1].y;
                acc = MFMA16(frag_rm_pi(Rs, RC_LD, 16 * tt, 32 * ks, lane), __builtin_bit_cast(bf16x8, bs), acc);
                acc = MFMA16(frag_rm_pi(Arb, RC_LD, 16 * tt, 32 * ks, lane), __builtin_bit_cast(bf16x8, bu), acc);
                acc = MFMA16(frag_rm(Ark, RC_LD, 16 * tt, 32 * ks, lane), frag_tr(Vs, RC_LD, 32 * ks, 16 * vbk, lane), acc); }
#pragma unroll
            for (int r = 0; r < 4; ++r) Ys[(16 * tt + 4 * fq + r) * 68 + 16 * vbk + fr] = acc[r]; }
        __syncthreads();
        {
            float y[8], g[8], lgw[8], lbw[8]; lds8(Ys + t * 68 + k8, y); ld8(WS_(p, Gg) + go, g); ld8(lg + cb + k8, lgw); ld8(lb + cb + k8, lbw);
            float s1 = 0.f, s2 = 0.f;
#pragma unroll
            for (int e = 0; e < 8; ++e) { s1 += y[e]; s2 += y[e] * y[e]; }
            s1 += __shfl_xor(s1, 1); s1 += __shfl_xor(s1, 2); s1 += __shfl_xor(s1, 4); s2 += __shfl_xor(s2, 1); s2 += __shfl_xor(s2, 2); s2 += __shfl_xor(s2, 4);
            const float mean = s1 * (1.0f / 64.0f), var = s2 * (1.0f / 64.0f) - mean * mean; const float rs = rsqrtf(fmaxf(var, 0.f) + 64e-5f);
            float o[8];
#pragma unroll
            for (int e = 0; e < 8; ++e) o[e] = ((y[e] - mean) * rs * lgw[e] + lbw[e] + bc * v[e]) * g[e];
            *(u32x4*)(WS_(p, YB) + go) = pk8(o);
        }
    }
}
DEV void phase_ln1(const Params& p, int layer, LAS unsigned char* lds) {
    const int tid = tid_(), bid = bid_(); (void)tid; (void)bid;
    const int lane = tid & 63, wid = tid >> 6; const int fr = lane & 15, fq = lane >> 4;
    LAS float* lgt = (LAS float*)lds;
    LAS int* cnt = (LAS int*)(lgt + 2 * 64 * 48);
    if (tid < 32) cnt[tid] = 0;
    const float* g = p.ln_g + ((size_t)layer * 2 + 0) * D; const float* be = p.ln_b + ((size_t)layer * 2 + 0) * D;
    const float* br = p.moe_b_route + layer * 32; const float* bg = p.moe_b_group + layer * 4;
    u32x2 rh[4], rm[4];
#pragma unroll
    for (int q = 0; q < 4; ++q) { rh[q] = *(const u32x2*)(WS_(p, Hb) + (size_t)(bid * 64 + wid * 8) * D + 256 * q + 4 * lane); rm[q] = *(const u32x2*)(WS_(p, MIXb) + (size_t)(bid * 64 + wid * 8) * D + 256 * q + 4 * lane); }
#pragma unroll 1
    for (int rr = 0; rr < 8; ++rr) {
        const int t = bid * 64 + wid * 8 + rr; const size_t ro = (size_t)t * D;
        f32x4 z[4], m[4];
#pragma unroll
        for (int q = 0; q < 4; ++q) { z[q] = (f32x4){bflo(rh[q].x), bfhi(rh[q].x), bflo(rh[q].y), bfhi(rh[q].y)}; m[q] = (f32x4){bflo(rm[q].x), bfhi(rm[q].x), bflo(rm[q].y), bfhi(rm[q].y)}; }
        { const size_t rn = (size_t)(rr < 7 ? t + 1 : t) * D;
#pragma unroll
          for (int q = 0; q < 4; ++q) { rh[q] = *(const u32x2*)(WS_(p, Hb) + rn + 256 * q + 4 * lane); rm[q] = *(const u32x2*)(WS_(p, MIXb) + rn + 256 * q + 4 * lane); } }
        float s = 0.f;
#pragma unroll
        for (int q = 0; q < 4; ++q) { z[q] = z[q] * ALPHA + m[q]; s += z[q][0] + z[q][1] + z[q][2] + z[q][3]; }
        const float mean = wave_sum(s) * (1.0f / D);
        float vs = 0.f;
#pragma unroll
        for (int q = 0; q < 4; ++q) { z[q] = z[q] - mean; vs += z[q][0] * z[q][0] + z[q][1] * z[q][1] + z[q][2] * z[q][2] + z[q][3] * z[q][3]; }
        const float rs = rsqrtf(wave_sum(vs) * (1.0f / D) + LN_EPS);
#pragma unroll
        for (int q = 0; q < 4; ++q) {
            const f32x4 gw = *(const f32x4*)(g + 256 * q + 4 * lane), bw = *(const f32x4*)(be + 256 * q + 4 * lane);
            st_bf4(WS_(p, H1b) + ro + 256 * q + 4 * lane, z[q] * rs * gw + bw);
        }
    }
    asm volatile("s_waitcnt vmcnt(0)" ::: "memory");
    __syncthreads();
    {   const int rt = wid & 3, kh = wid >> 2;
        const bf16_t* Ab = WS_(p, H1b) + (size_t)(bid * 64 + 16 * rt + fr) * D + 512 * kh + 8 * fq;
        const bf16_t* Wb = WS_(p, moe_wr_t) + (size_t)layer * 48 * D + (size_t)fr * D + 512 * kh + 8 * fq;
        f32x4 acc[3]; for (int i = 0; i < 3; ++i) acc[i] = (f32x4){0.f, 0.f, 0.f, 0.f};
#pragma unroll 4
        for (int ks = 0; ks < 16; ++ks) {
            const bf16x8 af = *(const bf16x8*)(Ab + 32 * ks);
#pragma unroll
            for (int ct = 0; ct < 3; ++ct) acc[ct] = MFMA16(af, *(const bf16x8*)(Wb + (size_t)16 * ct * D + 32 * ks), acc[ct]);
        }
#pragma unroll
        for (int ct = 0; ct < 3; ++ct)
#pragma unroll
            for (int r = 0; r < 4; ++r) lgt[(kh * 64 + 16 * rt + 4 * fq + r) * 48 + 16 * ct + fr] = acc[ct][r];
    }
    __syncthreads();
    if (tid < 64) {
        const int t = bid * 64 + tid; const LAS float* L0 = lgt + tid * 48; const LAS float* L1 = lgt + (64 + tid) * 48;
        const float q0 = L0[32] + L1[32] + bg[0], q1 = L0[33] + L1[33] + bg[1], q2 = L0[34] + L1[34] + bg[2], q3 = L0[35] + L1[35] + bg[3];
        int gi = 0; float gm = q0;
        if (q1 > gm) { gm = q1; gi = 1; } if (q2 > gm) { gm = q2; gi = 2; } if (q3 > gm) { gm = q3; gi = 3; }
        const float den = __expf(q0 - gm) + __expf(q1 - gm) + __expf(q2 - gm) + __expf(q3 - gm);
        const float pgrp = 1.0f / den;
        float l1 = -INFINITY, l2 = -INFINITY; int i1 = 0, i2 = 0;
#pragma unroll 1
        for (int o = 0; o < 8; ++o) { const float v = L0[gi * 8 + o] + L1[gi * 8 + o] + br[gi * 8 + o];
            if (v > l1) { l2 = l1; i2 = i1; l1 = v; i1 = o; } else if (v > l2) { l2 = v; i2 = o; } }
        const float e2 = __expf(l2 - l1), inv = 1.0f / (1.0f + e2);
        const int e0 = gi * 8 + i1, e1 = gi * 8 + i2;
        WS_(p, EIDX)[2 * t] = e0; WS_(p, EIDX)[2 * t + 1] = e1; WS_(p, GATE)[2 * t] = pgrp * inv; WS_(p, GATE)[2 * t + 1] = pgrp * e2 * inv;
        atomicAdd((int*)&cnt[e0], 1); atomicAdd((int*)&cnt[e1], 1);
    }
    __syncthreads();
    if (tid < 32) WS_(p, CNT)[bid * 32 + tid] = cnt[tid];
}

DEV void phase_moe_scatter(const Params& p, LAS unsigned char* lds) {
    const int tid = tid_(), bid = bid_(); (void)tid; (void)bid;
    const int lane = tid & 63, wid = tid >> 6;
    LAS int* part = (LAS int*)lds;
    LAS int* pre = part + 512;
    LAS int* base = pre + 512;
    LAS int* pst = base + 32;
    LAS int* dst = pst + 40;
    LAS int* eid = dst + 128;
    { const int e = tid & 31, part_i = tid >> 5; int tot = 0, prf = 0;
      for (int b = part_i * 16; b < part_i * 16 + 16; ++b) { const int c = WS_(p, CNT)[b * 32 + e]; tot += c; if (b < (int)bid) prf += c; }
      part[part_i * 32 + e] = tot; pre[part_i * 32 + e] = prf; }
    if (tid < 128) eid[tid] = WS_(p, EIDX)[bid * 128 + tid];
    __syncthreads();
    if (tid < 32) { int tot = 0, prf = 0; for (int i = 0; i < 16; ++i) { tot += part[i * 32 + tid]; prf += pre[i * 32 + tid]; } part[tid] = tot; pre[tid] = prf; }
    __syncthreads();
    if (tid == 0) { int acc = 0; for (int e = 0; e < 32; ++e) { pst[e] = acc; acc += ((part[e] + 255) >> 8) << 8; } pst[32] = acc;
        if (bid == 0) { for (int e = 0; e <= 32; ++e) WS_(p, TAB)[e] = pst[e]; WS_(p, TAB)[33] = acc >> 8;
            for (int e = 0; e < 32; ++e) for (int mt = pst[e] >> 8; mt < (pst[e + 1] >> 8); ++mt) WS_(p, TAB)[64 + mt] = e; } }
    __syncthreads();
    if (tid < 32) { int run = pst[tid] + pre[tid]; for (int a = 0; a < 128; ++a) if (eid[a] == tid) dst[a] = run++; }
    __syncthreads();
    if (tid < 128) WS_(p, DEST)[bid * 128 + tid] = dst[tid];
    for (int a = wid * 16; a < wid * 16 + 16; ++a) {
        const int t = bid * 64 + (a >> 1); const int d = dst[a];
        const u32x4 v0 = *(const u32x4*)(WS_(p, H1b) + (size_t)t * D + lane * 8), v1 = *(const u32x4*)(WS_(p, H1b) + (size_t)t * D + 512 + lane * 8);
        *(u32x4*)(WS_(p, BUF) + (size_t)d * D + lane * 8) = v0; *(u32x4*)(WS_(p, BUF) + (size_t)d * D + 512 + lane * 8) = v1;
    }
}

template <int which> struct SchedMoe {
    const Params* p; int layer;
    DEV bool next(int i, Unit& u) const {
        const int nmt = __hip_atomic_load(WS_(*p, TAB) + 33, __ATOMIC_RELAXED, __HIP_MEMORY_SCOPE_AGENT); int pm, pn; if (!pg8::tile_order(i, NB_, bid_(), nmt, 4, pm, pn)) return false;
        const int row0 = pm * 256; const int e = __hip_atomic_load(WS_(*p, TAB) + 64 + pm, __ATOMIC_RELAXED, __HIP_MEMORY_SCOPE_AGENT);
        if constexpr (which == 0) { u.A = (const char*)(WS_(*p, BUF) + (size_t)row0 * D); u.B = (const char*)(WS_(*p, moe_w1_t) + ((size_t)layer * 32 + e) * 1024 * 1024 + (size_t)pn * 256 * 1024); }
        else { u.A = (const char*)(WS_(*p, ACT) + (size_t)row0 * 512); u.B = (const char*)(WS_(*p, moe_w2_t) + ((size_t)layer * 32 + e) * 1024 * 512 + (size_t)pn * 256 * 512); }
        u.row0 = row0; u.col0 = pn * 256; u.id = e; u.aux = 0; return true;
    }
};
struct EpiMoe1 {
    bf16_t* O;
    DEV void operator()(const AccT& acc, const Unit& u, int wr, int wc, int fr, int fq) const {
#pragma unroll
        for (int ai = 0; ai < 2; ++ai)
#pragma unroll
            for (int m = 0; m < 4; ++m)
#pragma unroll
                for (int n = 0; n < 2; ++n) {
                    const f32x4 gt = acc[ai][0][m][n], up = acc[ai][1][m][n]; f32x4 v;
                    for (int e = 0; e < 4; ++e) v[e] = siluf_(gt[e]) * up[e];
                    const int col = (u.col0 >> 1) + 32 * wc + 16 * n + 4 * fq;
                    st_bf4(O + (size_t)ACC_ROW(u, ai, m) * 512 + col, v); ACC_FENCE;
                }
    }
};
struct EpiMoe2 {
    bf16_t* O;
    DEV void operator()(const AccT& acc, const Unit& u, int wr, int wc, int fr, int fq) const {
        FOR_ACC(ai, bj, m, n) { st_bf4(O + (size_t)ACC_ROW(u, ai, m) * D + ACC_COL(u, bj, n), acc[ai][bj][m][n]); ACC_FENCE; }
    }
};

struct Ln2Raw { u32x2 h[4], a[4], b[4]; float g0, g1; };
DEV void ln2_issue(const Params& p, int t, int lane, Ln2Raw& R) {
    const int d0 = WS_(p, DEST)[2 * t], d1 = WS_(p, DEST)[2 * t + 1]; R.g0 = WS_(p, GATE)[2 * t]; R.g1 = WS_(p, GATE)[2 * t + 1];
#pragma unroll
    for (int q = 0; q < 4; ++q) { R.h[q] = *(const u32x2*)(WS_(p, H1b) + (size_t)t * D + 256 * q + 4 * lane);
        R.a[q] = *(const u32x2*)(WS_(p, YBUF) + (size_t)d0 * D + 256 * q + 4 * lane); R.b[q] = *(const u32x2*)(WS_(p, YBUF) + (size_t)d1 * D + 256 * q + 4 * lane); }
}
DEV void ln2_finish(const Ln2Raw& R, const float* g, const float* be, int lane, f32x4 (&z)[4]) {
    float s = 0.f; const float g0 = R.g0, g1 = R.g1;
#pragma unroll
    for (int q = 0; q < 4; ++q) {
        z[q][0] = bflo(R.h[q].x) * ALPHA + g0 * bflo(R.a[q].x) + g1 * bflo(R.b[q].x); z[q][1] = bfhi(R.h[q].x) * ALPHA + g0 * bfhi(R.a[q].x) + g1 * bfhi(R.b[q].x);
        z[q][2] = bflo(R.h[q].y) * ALPHA + g0 * bflo(R.a[q].y) + g1 * bflo(R.b[q].y); z[q][3] = bfhi(R.h[q].y) * ALPHA + g0 * bfhi(R.a[q].y) + g1 * bfhi(R.b[q].y);
        s += z[q][0] + z[q][1] + z[q][2] + z[q][3];
    }
    const float mean = wave_sum(s) * (1.0f / D);
    float vs = 0.f;
#pragma unroll
    for (int q = 0; q < 4; ++q) { z[q] = z[q] - mean; vs += z[q][0] * z[q][0] + z[q][1] * z[q][1] + z[q][2] * z[q][2] + z[q][3] * z[q][3]; }
    const float rs = rsqrtf(wave_sum(vs) * (1.0f / D) + LN_EPS);
#pragma unroll
    for (int q = 0; q < 4; ++q) { const f32x4 gw = *(const f32x4*)(g + 256 * q + 4 * lane), bw = *(const f32x4*)(be + 256 * q + 4 * lane); z[q] = z[q] * rs * gw + bw; }
}
DEV void phase_ln2(const Params& p, int layer, LAS unsigned char* lds) {
    const int tid = tid_(), bid = bid_(); const int lane = tid & 63, wid = tid >> 6;
    const float* g = p.ln_g + ((size_t)layer * 2 + 1) * D; const float* be = p.ln_b + ((size_t)layer * 2 + 1) * D;
    const int nk = layer == DEPTH - 1 ? 3 : (layer + 1) % 3;
    const int nj = (layer + 1) / 3;
    LAS float* wt = (LAS float*)lds;
    LAS float* w2 = wt + 16 * 1028;
    LAS float* L = (nk == 2 ? w2 + 16 * 512 : wt + 32 * 1028) + wid * 32;
    if (nk == 1) { const float* w = p.mb_w_in + (size_t)nj * D * 5152;
        for (int i = tid; i < D * 32; i += NTHR) { const int k = i >> 5, o = i & 31; wt[o * 1028 + k] = w[(size_t)k * 5152 + 5120 + o]; } __syncthreads(); }
    else if (nk == 2) { const float* w = p.gl_w_in + (size_t)nj * D * 3088;
        for (int i = tid; i < D * 16; i += NTHR) { const int k = i >> 4, o = i & 15; wt[o * 1028 + k] = w[(size_t)k * 3088 + 3072 + o]; }
        for (int i = tid; i < 16 * 512; i += NTHR) w2[i] = p.gl_gk_w2[(size_t)nj * 16 * 512 + i]; __syncthreads(); }
    const int tfirst = bid * 64 + wid * 8;
    f32x4 z[4], zp[4];
    Ln2Raw R0, R1;
    ln2_issue(p, tfirst, lane, R0);
    if (nk == 0) { if (tfirst > 0) { ln2_issue(p, tfirst - 1, lane, R1); ln2_finish(R1, g, be, lane, zp); } else { for (int q = 0; q < 4; ++q) zp[q] = (f32x4){0.f, 0.f, 0.f, 0.f}; } }
#pragma unroll 1
    for (int rr = 0; rr < 8; ++rr) {
        const int t = tfirst + rr; const size_t ro = (size_t)t * D;
        ln2_issue(p, rr < 7 ? t + 1 : t, lane, R1);
        ln2_finish(R0, g, be, lane, z);
        R0 = R1;
        if (nk == 3) {
#pragma unroll
            for (int q = 0; q < 4; ++q) *(f32x4*)(p.out + ro + 256 * q + 4 * lane) = z[q];
        } else store_row_bf(WS_(p, Hb) + ro, lane, z);
        if (nk == 0) {
            emit_mix6(p, nj, t, lane, z, zp);
#pragma unroll
            for (int q = 0; q < 4; ++q) zp[q] = z[q];
        } else if (nk == 1) {
#pragma unroll 1
            for (int gI = 0; gI < 4; ++gI) skinny_group<8>(z, wt + gI * 8 * 1028, lane, L + gI * 8);
            if (lane < 32) WS_(p, DT)[(size_t)t * 32 + lane] = softplusf_(L[lane] + p.mb_dt_bias[nj * 32 + lane]);
        } else if (nk == 2) {
#pragma unroll 1
            for (int gI = 0; gI < 2; ++gI) skinny_group<8>(z, wt + gI * 8 * 1028, lane, L + gI * 8);
            float l16[16];
#pragma unroll
            for (int o = 0; o < 16; ++o) l16[o] = L[o];
#pragma unroll 1
            for (int cc = 0; cc < 8; ++cc) {
                const int c = cc * 64 + lane; float a = p.gl_gk_b[nj * 512 + c];
#pragma unroll
                for (int o = 0; o < 16; ++o) a += l16[o] * w2[o * 512 + c];
                const float ls = fminf(a, 0.f) - __logf(1.0f + __expf(-fabsf(a)));
                WS_(p, LA)[(size_t)t * 512 + c] = ls * (1.0f / 16.0f);
            }
        }
    }
}
constexpr int MB_PROJ = 5152;
struct SchedMbIn {
    const Params* p;
    DEV bool next(int i, Unit& u) const {
        int pm, pn; if (!pg8::tile_order(i, NB_, bid_(), 64, 20, pm, pn)) return false;
        u.A = (const char*)(WS_(*p, Hb) + (size_t)pm * 256 * D); u.B = (const char*)(WS_(*p, mb_win_t) + (size_t)pn * 256 * D); u.row0 = pm * 256; u.col0 = pn * 256; u.id = 0; u.aux = 0; return true;
    }
};
struct EpiMbIn {
    const Params* p;
    DEV void operator()(const AccT& acc, const Unit& u, int wr, int wc, int fr, int fq) const {
        const bool isz = u.col0 < 2048; bf16_t* O = WS_(*p, Z) + (isz ? (size_t)0 : (size_t)T * 2048 - 2048); const int ld = isz ? 2048 : 3072;
        FOR_ACC(ai, bj, m, n) { st_bf4(O + (size_t)ACC_ROW(u, ai, m) * ld + ACC_COL(u, bj, n), acc[ai][bj][m][n]); ACC_FENCE; }
    }
};
DEV void phase_mb_conv(const Params& p, int j) {
    const int tid = tid_(), bid = bid_(); (void)tid; (void)bid;
    if (tid >= 384) return;
    const int c0 = tid * 8; const int t0 = bid * 64;
    const float* cw = p.mb_conv_w + (size_t)j * 4 * 3072; const float* cb = p.mb_conv_b + (size_t)j * 3072;
    float w[4][8], b[8];
#pragma unroll
    for (int i = 0; i < 4; ++i) { const f32x4 a = *(const f32x4*)(cw + i * 3072 + c0), bb = *(const f32x4*)(cw + i * 3072 + c0 + 4); for (int e = 0; e < 4; ++e) { w[i][e] = a[e]; w[i][4 + e] = bb[e]; } }
    { const f32x4 a = *(const f32x4*)(cb + c0), bb = *(const f32x4*)(cb + c0 + 4); for (int e = 0; e < 4; ++e) { b[e] = a[e]; b[4 + e] = bb[e]; } }
    float x0[8], x1[8], x2[8], x3[8];
    auto ld = [&](int t, float (&x)[8]) {
        if (t < 0) { for (int e = 0; e < 8; ++e) x[e] = 0.f; return; }
        const u32x4 v = *(const u32x4*)(WS_(p, XBC) + (size_t)t * 3072 + c0);
        x[0] = bflo(v.x); x[1] = bfhi(v.x); x[2] = bflo(v.y); x[3] = bfhi(v.y); x[4] = bflo(v.z); x[5] = bfhi(v.z); x[6] = bflo(v.w); x[7] = bfhi(v.w);
    };
    ld(t0 - 3, x0); ld(t0 - 2, x1); ld(t0 - 1, x2);
    for (int tt = 0; tt < 64; ++tt) {
        ld(t0 + tt, x3);
        float o[8];
#pragma unroll
        for (int e = 0; e < 8; ++e) o[e] = siluf_(b[e] + w[0][e] * x0[e] + w[1][e] * x1[e] + w[2][e] * x2[e] + w[3][e] * x3[e]);
        u32x4 r; r.x = pk2(o[0], o[1]); r.y = pk2(o[2], o[3]); r.z = pk2(o[4], o[5]); r.w = pk2(o[6], o[7]);
        *(u32x4*)(WS_(p, XC) + (size_t)(t0 + tt) * 3072 + c0) = r;
#pragma unroll
        for (int e = 0; e < 8; ++e) { x0[e] = x1[e]; x1[e] = x2[e]; x2[e] = x3[e]; }
    }
}

DEV void mb_dacs(const Params& p, int j, int c, int g, LAS float* dts, LAS float* dacs) {
    const int tid = tid_(); const int lane = tid & 63, h = tid >> 6;
    const int hh = 8 * g + h; const float a = -__expf(p.mb_a_log[j * 32 + hh]);
    const float d0 = WS_(p, DT)[(size_t)(c * 128 + 2 * lane) * 32 + hh], d1 = WS_(p, DT)[(size_t)(c * 128 + 2 * lane + 1) * 32 + hh];
    const float a0 = d0 * a, a1 = d1 * a;
    float s = a0 + a1;
#pragma unroll
    for (int o = 1; o < 64; o <<= 1) { const float v = __shfl_up(s, o); if (lane >= o) s += v; }
    dts[h * 128 + 2 * lane] = d0; dts[h * 128 + 2 * lane + 1] = d1;
    dacs[h * 128 + 2 * lane] = s - a1; dacs[h * 128 + 2 * lane + 1] = s;
}
constexpr int LDB = 136;
constexpr int LDX = 72;
DEV void ld_tile128(const bf16_t* src, int gld, LAS bf16_t* dst) {
    const int tid = tid_();
    for (int i = tid; i < 128 * 16; i += NTHR) { const int r = i >> 4, c8 = (i & 15) * 8; *(LAS u32x4*)(dst + r * LDB + c8) = *(const u32x4*)(src + (size_t)r * gld + c8); }
}

DEV void phase_mb_states(const Params& p, int j, LAS unsigned char* lds) {
    const int tid = tid_(), bid = bid_(); (void)tid; (void)bid;
    const int lane = tid & 63, w = tid >> 6;
    LAS bf16_t* Bm = (LAS bf16_t*)lds;
    LAS bf16_t* Xh = Bm + 128 * LDB;
    LAS float* dts = (LAS float*)(Xh + 128 * LDX);
    LAS float* dacs = dts + 1024;
    for (int u = bid; u < 512; u += NB_) {
        const int c = u >> 2, g = u & 3; const int t0 = c * 128;
        __syncthreads();
        mb_dacs(p, j, c, g, dts, dacs);
        ld_tile128(WS_(p, XC) + (size_t)t0 * 3072 + 2048 + 128 * g, 3072, Bm);
        __syncthreads();
        if (tid < 8) WS_(p, CD)[(c * 32) + 8 * g + tid] = __expf(dacs[tid * 128 + 127]);
        bf16x8 bfr[4];
#pragma unroll
        for (int ks = 0; ks < 4; ++ks) bfr[ks] = frag_tr(Bm, LDB, 32 * ks, 16 * w, lane);
        for (int h = 0; h < 8; ++h) {
            { const int l = tid >> 2, p0 = (tid & 3) * 16; const float sc = dts[h * 128 + l] * __expf(dacs[h * 128 + 127] - dacs[h * 128 + l]);
              const bf16_t* src = WS_(p, XC) + (size_t)(t0 + l) * 3072 + 64 * (8 * g + h) + p0;
#pragma unroll
              for (int hf = 0; hf < 2; ++hf) { const u32x4 v = *(const u32x4*)(src + 8 * hf); u32x4 r;
                  r.x = pk2(bflo(v.x) * sc, bfhi(v.x) * sc); r.y = pk2(bflo(v.y) * sc, bfhi(v.y) * sc); r.z = pk2(bflo(v.z) * sc, bfhi(v.z) * sc); r.w = pk2(bflo(v.w) * sc, bfhi(v.w) * sc);
                  *(LAS u32x4*)(Xh + l * LDX + p0 + 8 * hf) = r; } }
            __syncthreads();
            f32x4 acc[4];
#pragma unroll
            for (int pb = 0; pb < 4; ++pb) { acc[pb] = (f32x4){0.f, 0.f, 0.f, 0.f};
#pragma unroll
                for (int ks = 0; ks < 4; ++ks) { const bf16x8 af = frag_tr(Xh, LDX, 32 * ks, 16 * pb, lane); acc[pb] = MFMA16(af, bfr[ks], acc[pb]); } }
            float* S = WS_(p, STATES) + (((size_t)c * 32 + 8 * g + h) * 64) * 128;
#pragma unroll
            for (int pb = 0; pb < 4; ++pb)
#pragma unroll
                for (int r = 0; r < 4; ++r) S[(size_t)(16 * pb + 4 * (lane >> 4) + r) * 128 + 16 * w + (lane & 15)] = acc[pb][r];
            __syncthreads();
        }
    }
}
DEV void phase_mb_scan(const Params& p) {
    const int tid = tid_(), bid = bid_(); (void)tid; (void)bid;
    const int gid = bid * NTHR + tid;
    if (gid >= 32 * 64 * 64) return;
    const int np = gid & 63, pp = (gid >> 6) & 63, h = gid >> 12; const int n = 2 * np;
    float r0 = 0.f, r1 = 0.f;
    const size_t eo = ((size_t)h * 64 + pp) * 128 + n;
    const size_t fo = (size_t)h * 64 * 128 + fragmajor_off(pp, n, 128);
#pragma unroll 16
    for (int c = 0; c < 128; ++c) {
        const f32x2 s = *(const f32x2*)(WS_(p, STATES) + (size_t)c * 32 * 64 * 128 + eo);
        const float cd = WS_(p, CD)[c * 32 + h];
        *(unsigned*)(WS_(p, PREV) + (size_t)c * 32 * 64 * 128 + fo) = pk2(r0, r1);
        r0 = r0 * cd + s[0]; r1 = r1 * cd + s[1];
    }
}
DEV void phase_mb_out(const Params& p, int j, LAS unsigned char* lds) {
    const int tid = tid_(), bid = bid_(); (void)tid; (void)bid;
    const int lane = tid & 63, w = tid >> 6; const int fr = lane & 15, fq = lane >> 4;
    LAS bf16_t* Cm = (LAS bf16_t*)lds;
    LAS bf16_t* Bm = Cm + 128 * LDB;
    LAS bf16_t* Xh = Bm + 128 * LDB;
    LAS bf16_t* Mw = Xh + 128 * LDX;
    LAS float* dts = (LAS float*)(Mw + 8 * 16 * LDB);
    LAS float* dacs = dts + 1024;
    LAS bf16_t* Mme = Mw + w * 16 * LDB;
    for (int u = bid; u < 512; u += NB_) {
        const int c = u >> 2, g = u & 3; const int t0 = c * 128;
        __syncthreads();
        mb_dacs(p, j, c, g, dts, dacs);
        ld_tile128(WS_(p, XC) + (size_t)t0 * 3072 + 2048 + 512 + 128 * g, 3072, Cm);
        ld_tile128(WS_(p, XC) + (size_t)t0 * 3072 + 2048 + 128 * g, 3072, Bm);
        __syncthreads();
        f32x4 sc[8]; bf16x8 cf[4];
#pragma unroll
        for (int ks = 0; ks < 4; ++ks) cf[ks] = frag_rm(Cm, LDB, 16 * w, 32 * ks, lane);
#pragma unroll
        for (int sb = 0; sb < 8; ++sb) { sc[sb] = (f32x4){0.f, 0.f, 0.f, 0.f};
#pragma unroll
            for (int ks = 0; ks < 4; ++ks) sc[sb] = MFMA16(cf[ks], frag_rm(Bm, LDB, 16 * sb, 32 * ks, lane), sc[sb]); }
        float ssq = 0.f;
        const int rl = tid >> 2, p0 = (tid & 3) * 16;
        const LAS float* Yrow = (const LAS float*)(Mw + (rl >> 4) * 16 * LDB) + (rl & 15) * 68 + p0;
        LAS float* Yw = (LAS float*)Mme;
        u32x4 xraw[2], zraw[2], xnx[2], znx[2]; bf16x8 pfc[16];
#define MB_LOADH(HH, XR, ZR) do { const int hh_ = 8 * g + (HH); \
            XR[0] = *(const u32x4*)(WS_(p, XC) + (size_t)(t0 + rl) * 3072 + 64 * hh_ + p0); XR[1] = *(const u32x4*)(WS_(p, XC) + (size_t)(t0 + rl) * 3072 + 64 * hh_ + p0 + 8); \
            ZR[0] = *(const u32x4*)(WS_(p, Z) + (size_t)(t0 + rl) * 2048 + 64 * hh_ + p0); ZR[1] = *(const u32x4*)(WS_(p, Z) + (size_t)(t0 + rl) * 2048 + 64 * hh_ + p0 + 8); } while (0)
        MB_LOADH(0, xraw, zraw);
#pragma unroll 1
        for (int h = 0; h < 8; ++h) {
            const int hh = 8 * g + h;
            MB_LOADH(h < 7 ? h + 1 : h, xnx, znx);
            { const bf16_t* pv_ = WS_(p, PREV) + ((size_t)c * 32 + hh) * 64 * 128;
#pragma unroll
              for (int i_ = 0; i_ < 16; ++i_) pfc[i_] = *(const bf16x8*)(pv_ + ((size_t)i_ * 64 + lane) * 8); }
            { const float scl = dts[h * 128 + rl];
#pragma unroll
              for (int hf = 0; hf < 2; ++hf) { const u32x4 v = xraw[hf]; u32x4 r;
                  r.x = pk2(bflo(v.x) * scl, bfhi(v.x) * scl); r.y = pk2(bflo(v.y) * scl, bfhi(v.y) * scl); r.z = pk2(bflo(v.z) * scl, bfhi(v.z) * scl); r.w = pk2(bflo(v.w) * scl, bfhi(v.w) * scl);
                  *(LAS u32x4*)(Xh + rl * LDX + p0 + 8 * hf) = r; } }
            const u32x4 zraw0 = zraw[0], zraw1 = zraw[1];
            float dl[4];
#pragma unroll
            for (int r = 0; r < 4; ++r) dl[r] = dacs[h * 128 + 16 * w + 4 * fq + r];
#pragma unroll
            for (int sb = 0; sb < 8; ++sb) { const int s_ = 16 * sb + fr; const float ds = dacs[h * 128 + s_];
#pragma unroll
                for (int r = 0; r < 4; ++r) { const int l = 16 * w + 4 * fq + r; const float m = (s_ <= l) ? sc[sb][r] * __expf(dl[r] - ds) : 0.f; Mme[(4 * fq + r) * LDB + s_] = (bf16_t)f2bf(m); } }
            __syncthreads();
            bf16x8 mf[4];
#pragma unroll
            for (int ks = 0; ks < 4; ++ks) mf[ks] = frag_rm(Mme, LDB, 0, 32 * ks, lane);
            f32x4 yv[4];
#pragma unroll
            for (int pb = 0; pb < 4; ++pb) {
                f32x4 a = {0.f, 0.f, 0.f, 0.f}, o = {0.f, 0.f, 0.f, 0.f};
#pragma unroll
                for (int ks = 0; ks < 4; ++ks) {
                    a = MFMA16(mf[ks], frag_tr(Xh, LDX, 32 * ks, 16 * pb, lane), a);
                    o = MFMA16(cf[ks], pfc[pb * 4 + ks], o);
                }
#pragma unroll
                for (int r = 0; r < 4; ++r) a[r] += o[r] * __expf(dl[r]);
                yv[pb] = a;
            }
#pragma unroll
            for (int pb = 0; pb < 4; ++pb)
#pragma unroll
                for (int r = 0; r < 4; ++r) Yw[(4 * fq + r) * 68 + 16 * pb + fr] = yv[pb][r];
            __syncthreads();
            {
                const float dsk = p.mb_d[j * 32 + hh]; const float* ng = p.mb_norm_g + (size_t)j * 2048 + 64 * hh + p0;
                float y[16], xs[16], zz[16];
#pragma unroll
                for (int q = 0; q < 4; ++q) { const f32x4 t4 = *(const LAS f32x4*)(Yrow + 4 * q); y[4 * q] = t4[0]; y[4 * q + 1] = t4[1]; y[4 * q + 2] = t4[2]; y[4 * q + 3] = t4[3]; }
                xs[0] = bflo(xraw[0].x); xs[1] = bfhi(xraw[0].x); xs[2] = bflo(xraw[0].y); xs[3] = bfhi(xraw[0].y); xs[4] = bflo(xraw[0].z); xs[5] = bfhi(xraw[0].z); xs[6] = bflo(xraw[0].w); xs[7] = bfhi(xraw[0].w);
                xs[8] = bflo(xraw[1].x); xs[9] = bfhi(xraw[1].x); xs[10] = bflo(xraw[1].y); xs[11] = bfhi(xraw[1].y); xs[12] = bflo(xraw[1].z); xs[13] = bfhi(xraw[1].z); xs[14] = bflo(xraw[1].w); xs[15] = bfhi(xraw[1].w);
                zz[0] = bflo(zraw0.x); zz[1] = bfhi(zraw0.x); zz[2] = bflo(zraw0.y); zz[3] = bfhi(zraw0.y); zz[4] = bflo(zraw0.z); zz[5] = bfhi(zraw0.z); zz[6] = bflo(zraw0.w); zz[7] = bfhi(zraw0.w);
                zz[8] = bflo(zraw1.x); zz[9] = bfhi(zraw1.x); zz[10] = bflo(zraw1.y); zz[11] = bfhi(zraw1.y); zz[12] = bflo(zraw1.z); zz[13] = bfhi(zraw1.z); zz[14] = bflo(zraw1.w); zz[15] = bfhi(zraw1.w);
                float o[16];
#pragma unroll
                for (int q = 0; q < 4; ++q) { const f32x4 n4 = *(const f32x4*)(ng + 4 * q);
#pragma unroll
                    for (int e = 0; e < 4; ++e) { const int i = 4 * q + e; const float v = (y[i] + xs[i] * dsk) * siluf_(zz[i]); ssq += v * v; o[i] = v * n4[e]; } }
                bf16_t* dst = WS_(p, YB) + (size_t)(t0 + rl) * 2048 + 64 * hh + p0;
                u32x4 w0, w1; w0.x = pk2(o[0], o[1]); w0.y = pk2(o[2], o[3]); w0.z = pk2(o[4], o[5]); w0.w = pk2(o[6], o[7]); w1.x = pk2(o[8], o[9]); w1.y = pk2(o[10], o[11]); w1.z = pk2(o[12], o[13]); w1.w = pk2(o[14], o[15]);
                *(u32x4*)dst = w0; *(u32x4*)(dst + 8) = w1;
            }
            xraw[0] = xnx[0]; xraw[1] = xnx[1]; zraw[0] = znx[0]; zraw[1] = znx[1];
            __syncthreads();
        }
#undef MB_LOADH
        ssq += __shfl_xor(ssq, 1); ssq += __shfl_xor(ssq, 2);
        const float rstd = rsqrtf(ssq * (1.0f / 512.0f) + 1e-5f);
#pragma unroll 1
        for (int h = 0; h < 8; ++h) {
            bf16_t* dst = WS_(p, YB) + (size_t)(t0 + rl) * 2048 + 64 * (8 * g + h) + p0;
#pragma unroll
            for (int hf = 0; hf < 2; ++hf) { const u32x4 v = *(const u32x4*)(dst + 8 * hf); u32x4 r;
                r.x = pk2(bflo(v.x) * rstd, bfhi(v.x) * rstd); r.y = pk2(bflo(v.y) * rstd, bfhi(v.y) * rstd); r.z = pk2(bflo(v.z) * rstd, bfhi(v.z) * rstd); r.w = pk2(bflo(v.w) * rstd, bfhi(v.w) * rstd);
                *(u32x4*)(dst + 8 * hf) = r; }
        }
    }
}
constexpr int GL_PROJ = 3088;
constexpr int LDV = 264;
struct SchedGlIn {
    const Params* p;
    DEV bool next(int i, Unit& u) const {
        int pm, pn; if (!pg8::tile_order(i, NB_, bid_(), 64, 12, pm, pn)) return false;
        u.A = (const char*)(WS_(*p, Hb) + (size_t)pm * 256 * D); u.B = (const char*)(WS_(*p, gl_win_t) + (size_t)pn * 256 * D); u.row0 = pm * 256; u.col0 = pn * 256; u.id = 0; u.aux = 0; return true;
    }
};
struct EpiGlIn {
    const Params* p;
    DEV void operator()(const AccT& acc, const Unit& u, int wr, int wc, int fr, int fq) const {
        FOR_ACC(ai, bj, m, n) { st_bf4(WS_(*p, QKVG) + (size_t)ACC_ROW(u, ai, m) * 3072 + ACC_COL(u, bj, n), acc[ai][bj][m][n]); ACC_FENCE; }
    }
};
DEV void gl_bcs(const Params& p, int n, int h, LAS float* bcs) {
    const int tid = tid_();
    for (int i = tid; i < 64 * 32; i += NTHR) { const int r = i >> 5, c4 = (i & 31) * 4; *(LAS f32x4*)(bcs + r * 128 + c4) = *(const f32x4*)(WS_(p, LA) + (size_t)(n * 64 + r) * 512 + 128 * h + c4); }
    __syncthreads();
    if (tid < 128) { float s = 0.f; for (int r = 0; r < 64; ++r) { s += bcs[r * 128 + tid]; bcs[r * 128 + tid] = s; } }
    __syncthreads();
}
DEV void phase_gl_kv(const Params& p, LAS unsigned char* lds) {
    const int tid = tid_(), bid = bid_(); (void)tid; (void)bid;
    const int lane = tid & 63, w = tid >> 6;
    LAS float* bcs = (LAS float*)lds;
    LAS bf16_t* Ke = (LAS bf16_t*)(bcs + 64 * 128);
    LAS bf16_t* Vs = Ke + 64 * LDB;
    for (int u = bid; u < 1024; u += NB_) {
        const int n = u >> 2, h = u & 3; const int t0 = n * 64;
        __syncthreads();
        gl_bcs(p, n, h, bcs);
        for (int i = tid; i < 64 * 16; i += NTHR) { const int r = i >> 4, c8 = (i & 15) * 8;
            const u32x4 v = *(const u32x4*)(WS_(p, QKVG) + (size_t)(t0 + r) * 3072 + 512 + 128 * h + c8); float f[8];
            f[0] = bflo(v.x); f[1] = bfhi(v.x); f[2] = bflo(v.y); f[3] = bfhi(v.y); f[4] = bflo(v.z); f[5] = bfhi(v.z); f[6] = bflo(v.w); f[7] = bfhi(v.w);
#pragma unroll
            for (int e = 0; e < 8; ++e) f[e] *= __expf(bcs[63 * 128 + c8 + e] - bcs[r * 128 + c8 + e]);
            u32x4 o; o.x = pk2(f[0], f[1]); o.y = pk2(f[2], f[3]); o.z = pk2(f[4], f[5]); o.w = pk2(f[6], f[7]);
            *(LAS u32x4*)(Ke + r * LDB + c8) = o; }
        for (int i = tid; i < 64 * 32; i += NTHR) { const int r = i >> 5, c8 = (i & 31) * 8; *(LAS u32x4*)(Vs + r * LDV + c8) = *(const u32x4*)(WS_(p, QKVG) + (size_t)(t0 + r) * 3072 + 1024 + 256 * h + c8); }
        if (tid < 128) WS_(p, CDG)[((size_t)n * 4 + h) * 128 + tid] = __expf(bcs[63 * 128 + tid]);
        __syncthreads();
        bf16x8 af[2];
#pragma unroll
        for (int ks = 0; ks < 2; ++ks) af[ks] = frag_tr(Ke, LDB, 32 * ks, 16 * w, lane);
        float* O = WS_(p, STATES) + (((size_t)n * 4 + h) * 128) * 256;
#pragma unroll
        for (int vb = 0; vb < 16; ++vb) {
            f32x4 acc = {0.f, 0.f, 0.f, 0.f};
#pragma unroll
            for (int ks = 0; ks < 2; ++ks) acc = MFMA16(af[ks], frag_tr(Vs, LDV, 32 * ks, 16 * vb, lane), acc);
#pragma unroll
            for (int r = 0; r < 4; ++r) O[(size_t)(16 * w + 4 * (lane >> 4) + r) * 256 + 16 * vb + (lane & 15)] = acc[r];
        }
    }
}
DEV void phase_gl_scan(const Params& p) {
    const int tid = tid_(), bid = bid_(); (void)tid; (void)bid;
    const int gid = bid * NTHR + tid;
    if (gid >= 4 * 64 * 256) return;
    const int v = gid & 255, kp = (gid >> 8) & 63, h = gid >> 14; const int k = 2 * kp;
    float r0 = 0.f, r1 = 0.f;
    const size_t fo = (size_t)h * 128 * 256 + fragmajor_off(v, k, 128);
#pragma unroll 16
    for (int n = 0; n < 256; ++n) {
        const float* S = WS_(p, STATES) + (((size_t)n * 4 + h) * 128) * 256;
        const float s0 = S[(size_t)k * 256 + v], s1 = S[(size_t)(k + 1) * 256 + v];
        const f32x2 cd = *(const f32x2*)(WS_(p, CDG) + ((size_t)n * 4 + h) * 128 + k);
        *(unsigned*)(WS_(p, PREV) + (size_t)n * 4 * 128 * 256 + fo) = pk2(r0, r1);
        r0 = r0 * cd[0] + s0; r1 = r1 * cd[1] + s1;
    }
}
DEV void phase_gl_out(const Params& p, int j, LAS unsigned char* lds) {
    const int tid = tid_(), bid = bid_(); (void)tid; (void)bid;
    const int lane = tid & 63, w = tid >> 6; const int fr = lane & 15, fq = lane >> 4;
    LAS float* bcs = (LAS float*)lds;
    LAS bf16_t* Qs = (LAS bf16_t*)(bcs + 64 * 128);
    LAS bf16_t* Ks = Qs + 64 * LDB;
    LAS bf16_t* Vs = Ks + 64 * LDB;
    LAS bf16_t* At = Vs + 64 * LDV;
    LAS float* red = (LAS float*)(At + 64 * LDX);
    for (int u = bid; u < 1024; u += NB_) {
        const int n = u >> 2, h = u & 3; const int t0 = n * 64;
        __syncthreads();
        gl_bcs(p, n, h, bcs);
        for (int i = tid; i < 64 * 16; i += NTHR) { const int r = i >> 4, c8 = (i & 15) * 8;
            const u32x4 vq = *(const u32x4*)(WS_(p, QKVG) + (size_t)(t0 + r) * 3072 + 128 * h + c8), vk = *(const u32x4*)(WS_(p, QKVG) + (size_t)(t0 + r) * 3072 + 512 + 128 * h + c8);
            float fq_[8], fk_[8];
            fq_[0] = bflo(vq.x); fq_[1] = bfhi(vq.x); fq_[2] = bflo(vq.y); fq_[3] = bfhi(vq.y); fq_[4] = bflo(vq.z); fq_[5] = bfhi(vq.z); fq_[6] = bflo(vq.w); fq_[7] = bfhi(vq.w);
            fk_[0] = bflo(vk.x); fk_[1] = bfhi(vk.x); fk_[2] = bflo(vk.y); fk_[3] = bfhi(vk.y); fk_[4] = bflo(vk.z); fk_[5] = bfhi(vk.z); fk_[6] = bflo(vk.w); fk_[7] = bfhi(vk.w);
#pragma unroll
            for (int e = 0; e < 8; ++e) { const float b = bcs[r * 128 + c8 + e]; fq_[e] *= __expf(b) * 0.08838834764831845f; fk_[e] *= __expf(-b); }
            u32x4 o; o.x = pk2(fq_[0], fq_[1]); o.y = pk2(fq_[2], fq_[3]); o.z = pk2(fq_[4], fq_[5]); o.w = pk2(fq_[6], fq_[7]);
            *(LAS u32x4*)(Qs + r * LDB + c8) = o;
            o.x = pk2(fk_[0], fk_[1]); o.y = pk2(fk_[2], fk_[3]); o.z = pk2(fk_[4], fk_[5]); o.w = pk2(fk_[6], fk_[7]);
            *(LAS u32x4*)(Ks + r * LDB + c8) = o; }
        for (int i = tid; i < 64 * 32; i += NTHR) { const int r = i >> 5, c8 = (i & 31) * 8; *(LAS u32x4*)(Vs + r * LDV + c8) = *(const u32x4*)(WS_(p, QKVG) + (size_t)(t0 + r) * 3072 + 1024 + 256 * h + c8); }
        __syncthreads();
        { const int ib = w >> 1;
#pragma unroll
          for (int jj = 0; jj < 2; ++jj) { const int jb = 2 * (w & 1) + jj; f32x4 a = {0.f, 0.f, 0.f, 0.f};
#pragma unroll
              for (int ks = 0; ks < 4; ++ks) a = MFMA16(frag_rm(Qs, LDB, 16 * ib, 32 * ks, lane), frag_rm(Ks, LDB, 16 * jb, 32 * ks, lane), a);
#pragma unroll
              for (int r = 0; r < 4; ++r) { const int i = 16 * ib + 4 * fq + r, jx = 16 * jb + fr; At[i * LDX + jx] = (bf16_t)f2bf(jx <= i ? a[r] : 0.f); } } }
        __syncthreads();
        f32x4 o[4][2];
        const bf16_t* pv = WS_(p, PREV) + ((size_t)n * 4 + h) * 128 * 256;
#pragma unroll
        for (int vv = 0; vv < 2; ++vv) { const int vb = 2 * w + vv;
            bf16x8 bi[2], bp[4];
#pragma unroll
            for (int ks = 0; ks < 2; ++ks) bi[ks] = frag_tr(Vs, LDV, 32 * ks, 16 * vb, lane);
#pragma unroll
            for (int ks = 0; ks < 4; ++ks) bp[ks] = *(const bf16x8*)(pv + ((size_t)(vb * 4 + ks) * 64 + lane) * 8);
#pragma unroll
            for (int ib = 0; ib < 4; ++ib) { f32x4 a = {0.f, 0.f, 0.f, 0.f};
#pragma unroll
                for (int ks = 0; ks < 2; ++ks) a = MFMA16(frag_rm(At, LDX, 16 * ib, 32 * ks, lane), bi[ks], a);
#pragma unroll
                for (int ks = 0; ks < 4; ++ks) a = MFMA16(frag_rm(Qs, LDB, 16 * ib, 32 * ks, lane), bp[ks], a);
                o[ib][vv] = a; } }
#pragma unroll
        for (int ib = 0; ib < 4; ++ib)
#pragma unroll
            for (int r = 0; r < 4; ++r) { float s = o[ib][0][r] * o[ib][0][r] + o[ib][1][r] * o[ib][1][r]; s = sum16(s); if (fr == 0) red[w * 64 + 16 * ib + 4 * fq + r] = s; }
        __syncthreads();
#pragma unroll
        for (int ib = 0; ib < 4; ++ib)
#pragma unroll
            for (int r = 0; r < 4; ++r) { const int i = 16 * ib + 4 * fq + r; float s = 0.f;
#pragma unroll
                for (int ww = 0; ww < 8; ++ww) s += red[ww * 64 + i];
                const float rs = rsqrtf(s * (1.0f / 256.0f) + 1e-5f);
#pragma unroll
                for (int vv = 0; vv < 2; ++vv) { const int v = 32 * w + 16 * vv + fr; const int t = t0 + i;
                    const float gt = bf2f(WS_(p, QKVG)[(size_t)t * 3072 + 2048 + 256 * h + v]);
                    WS_(p, YB)[(size_t)t * D + 256 * h + v] = (bf16_t)f2bf(o[ib][vv][r] * rs * p.gl_norm_g[j * 256 + v] * siluf_(gt)); } }
    }
}
#define XB_TMO      128
#define XB_XCNT(j)  (256  + 64 * (j))
#define XB_XSUB(j)  (1280 + 64 * (j))
#define XB_XGEN(j)  (2304 + 64 * (j))
#define XB_TOP      3328
#define XB_TOPGEN   3392
#define XCD_BAR_WORDS 3456
#define XB_SPIN_CAP (1u << 22)
DEV unsigned xb_ld(unsigned* p)              { return __hip_atomic_load(p, __ATOMIC_RELAXED, __HIP_MEMORY_SCOPE_AGENT); }
DEV unsigned xb_add(unsigned* p, unsigned v) { return __hip_atomic_fetch_add(p, v, __ATOMIC_RELAXED, __HIP_MEMORY_SCOPE_AGENT); }
DEV unsigned xb_xcc_id() { return (unsigned)__builtin_amdgcn_s_getreg((3 << 11) | 20) & 0xFu; }
#define XB_SPIN(cond, bar) do { unsigned _sp = 0; while (cond) { __builtin_amdgcn_s_sleep(1); \
    if ((++_sp & 255u) == 0u) { if (xb_ld(&(bar)[XB_TMO])) break; if (_sp > XB_SPIN_CAP) { atomicAdd(&(bar)[XB_TMO], 1u); break; } } } } while (0)
struct XcdBarrier { unsigned* bar; unsigned x; volatile LAS unsigned* st; };
DEV XcdBarrier xcd_barrier_post(unsigned* bar, volatile LAS unsigned* st) {
    XcdBarrier b; b.bar = bar; b.x = xb_xcc_id(); b.st = st;
    if (threadIdx.x == 0) (void)xb_add(&bar[XB_XCNT(b.x)], 1u);
    return b;
}
DEV void xcd_barrier_complete(unsigned* bar, unsigned x, unsigned& nloc, unsigned& nx) {
    const unsigned G = gridDim.x * gridDim.y * gridDim.z;
    unsigned sum, cnt, mine, sp = 0u;
    for (;;) {
        sum = 0u; cnt = 0u; mine = 0u;
#pragma unroll
        for (unsigned j = 0; j < 16; ++j) { const unsigned c = xb_ld(&bar[XB_XCNT(j)]); sum += c; cnt += (c > 0u) ? 1u : 0u; mine = (j == x) ? c : mine; }
        if (sum == G) break;
        __builtin_amdgcn_s_sleep(1);
        if ((++sp & 255u) == 0u) { if (xb_ld(&bar[XB_TMO])) break; if (sp > XB_SPIN_CAP) { atomicAdd(&bar[XB_TMO], 1u); break; } }
    }
    nloc = mine > 0u ? mine : 1u; nx = cnt > 0u ? cnt : 1u;
}
DEV void xcd_barrier(const XcdBarrier& b) {
    asm volatile("s_waitcnt vmcnt(0)" ::: "memory");
    __syncthreads();
    if (threadIdx.x == 0) {
        unsigned* bar = b.bar;
        __builtin_amdgcn_s_waitcnt(0);
        unsigned nloc = b.st[0], nx = b.st[1];
        if (nloc == 0u) { xcd_barrier_complete(bar, b.x, nloc, nx); b.st[0] = nloc; b.st[1] = nx; }
        const unsigned old = xb_add(&bar[XB_XSUB(b.x)], 1u);
        const unsigned gen = old / nloc;
        if (old + 1u == (gen + 1u) * nloc) {
            __builtin_amdgcn_fence(__ATOMIC_RELEASE, "agent");
            asm volatile("s_waitcnt vmcnt(0)" ::: "memory");
            const unsigned og = xb_add(&bar[XB_TOP], 1u);
            const unsigned tg = og / nx;
            if (og + 1u == (tg + 1u) * nx) xb_add(&bar[XB_TOPGEN], 1u);
            else XB_SPIN(xb_ld(&bar[XB_TOPGEN]) == tg, bar);
            __builtin_amdgcn_fence(__ATOMIC_ACQUIRE, "agent");
            xb_add(&bar[XB_XGEN(b.x)], 1u);
            asm volatile("s_waitcnt vmcnt(0)" ::: "memory");
        } else {
            XB_SPIN(xb_ld(&bar[XB_XGEN(b.x)]) == gen, bar);
            __builtin_amdgcn_fence(__ATOMIC_ACQUIRE, "agent");
            asm volatile("s_waitcnt vmcnt(0)" ::: "memory");
        }
    }
    __syncthreads();
}

DEV void run_phase(const Params& pin, int op, int arg, LAS unsigned char* lds) {
    Params p = pin; asm volatile("" : "+s"(p.ws));
    const int layer = arg; const int jj = layer / 3;
#ifdef ONLY_OP
    if (op != ONLY_OP) return;
#endif
#ifdef OPMASK
    if (!((OPMASK >> op) & 1ull)) return;
#endif
    switch (op) {
    case OP_CONVERT: phase_convert(p, lds);
#ifdef DBG
        if (blockIdx.x == 0 && threadIdx.x < 8) WS_(p, TAB)[200 + threadIdx.x] = 0;
#endif
        break;
    case OP_PRE0: phase_pre0(p); break;
    case OP_RW_GEMM1: { SchedRW1 S{&p, jj}; EpiRW1 E{&p}; pg8::gemm_phase(lds, 1024, S, E); } break;
    case OP_RW_GEMM2: { SchedRW2 S{&p, jj}; EpiRW2 E{&p, jj}; pg8::gemm_phase(lds, 256, S, E); } break;
    case OP_RW_CHA: phase_rw_cha(p, jj, lds); break;
    case OP_RW_CHB: phase_rw_chb(p, lds); break;
    case OP_RW_CHC: phase_rw_chc(p, jj, lds); break;
    case OP_RW_OUT: { SchedOut S{WS_(p, YB), WS_(p, rw_wo_t) + (size_t)jj * D * D, 1024}; EpiOut E{WS_(p, MIXb)}; pg8::gemm_phase(lds, 1024, S, E); } break;
    case OP_LN1: phase_ln1(p, layer, lds); break;
    case OP_MOE_SCATTER: phase_moe_scatter(p, lds); break;
    case OP_MOE_GEMM1: { SchedMoe<0> S{&p, layer}; EpiMoe1 E{WS_(p, ACT)}; pg8::gemm_phase(lds, 1024, S, E); } break;
    case OP_MOE_GEMM2: { SchedMoe<1> S{&p, layer}; EpiMoe2 E{WS_(p, YBUF)}; pg8::gemm_phase(lds, 512, S, E); } break;
    case OP_LN2: phase_ln2(p, layer, lds); break;
    case OP_MB_GEMM_IN: { SchedMbIn S{&p}; EpiMbIn E{&p}; pg8::gemm_phase(lds, 1024, S, E); } break;
    case OP_MB_CONV: phase_mb_conv(p, jj); break;
    case OP_MB_STATES: phase_mb_states(p, jj, lds); break;
    case OP_MB_SCAN: phase_mb_scan(p); break;
    case OP_MB_OUT: phase_mb_out(p, jj, lds); break;
    case OP_MB_GEMM_OUT: { SchedOut S{WS_(p, YB), WS_(p, mb_wout_t) + (size_t)jj * D * 2048, 2048}; EpiOut E{WS_(p, MIXb)}; pg8::gemm_phase(lds, 2048, S, E); } break;
    case OP_GL_GEMM_IN: { SchedGlIn S{&p}; EpiGlIn E{&p}; pg8::gemm_phase(lds, 1024, S, E); } break;
    case OP_GL_KV: phase_gl_kv(p, lds); break;
    case OP_GL_SCAN: phase_gl_scan(p); break;
    case OP_GL_OUT: phase_gl_out(p, jj, lds); break;
    case OP_GL_GEMM_OUT: { SchedOut S{WS_(p, YB), WS_(p, gl_wout_t) + (size_t)jj * D * D, 1024}; EpiOut E{WS_(p, MIXb)}; pg8::gemm_phase(lds, 1024, S, E); } break;
    default: break;
    }
}

constexpr int NPHASES = 2 + 11 + 11 + 10 + 11;
DEV void decode_phase(int ph, int& op, int& layer) {
    if (ph < 2) { op = ph; layer = 0; return; }
    int q = ph - 2; layer = 0;
    if (q >= 11) { q -= 11; layer = 1; if (q >= 11) { q -= 11; layer = 2; if (q >= 10) { q -= 10; layer = 3; } } }
    const int kind = layer % 3; const int nmix = kind == 2 ? 5 : 6;
    if (q < nmix) op = (kind == 0 ? OP_RW_GEMM1 : kind == 1 ? OP_MB_GEMM_IN : OP_GL_GEMM_IN) + q;
    else op = OP_LN1 + (q - nmix);
}

#define X(t, n) t n##_,
template <bool COOP>
__global__ void __launch_bounds__(NTHR, 2) mega(PARAM_LIST(X) const int ph0, const int ph1) {
#undef X
    Params p;
#define X(t, n) p.n = n##_;
    PARAM_LIST(X)
#undef X

    extern __shared__ __attribute__((aligned(16))) unsigned char smem_raw[];
    LAS unsigned char* lds = (LAS unsigned char*)smem_raw;
    if constexpr (COOP) {
        volatile LAS unsigned* st = (volatile LAS unsigned*)(lds + LDS_BYTES - 16);
        if (threadIdx.x == 0) { st[0] = 0u; st[1] = 0u; }
        __syncthreads();
        XcdBarrier xb = xcd_barrier_post(WS_(p, bar), st);
        if (ph0 < 0) cg::this_grid().sync();
        for (int ph = ph0; ph < ph1; ++ph) {
            int op, arg; decode_phase(ph, op, arg);
#ifdef REPEAT_MASK
            const int reps = 1 + (int)((REPEAT_MASK >> op) & 1ull);
#else
            const int reps = 1;
#endif
#pragma unroll 1
            for (int rep = 0; rep < reps; ++rep) {
                run_phase(p, op, arg, lds);
                if (ph + 1 < ph1 || rep + 1 < reps) xcd_barrier(xb);
            }
        }
#ifdef DBG
        xcd_barrier(xb);
        { const int code = __hip_atomic_load(WS_(p, TAB) + 200, __ATOMIC_RELAXED, __HIP_MEMORY_SCOPE_AGENT);
          for (size_t i = (size_t)blockIdx.x * NTHR + threadIdx.x; i < (size_t)T * D; i += (size_t)NB_ * NTHR) p.out[i] = 0.f;
          __syncthreads();
          if (blockIdx.x == 0 && threadIdx.x == 0) p.out[0] = sqrtf((float)DBG_DECODE(code) * 1.68e7f); }
#endif
    } else {
        for (int ph = ph0; ph < ph1; ++ph) { int op, arg; decode_phase(ph, op, arg); run_phase(p, op, arg, lds); }
    }
}


extern "C" void kernel_launch(void* const* d_in, const int* in_sizes, int n_in, void* d_out, int out_size, void* d_ws, size_t ws_size, hipStream_t stream) {
    (void)in_sizes; (void)n_in; (void)out_size;
    Params p; std::memset((void*)&p, 0, sizeof(p));
    auto F = [&](int i) { return (const float*)d_in[i]; };
    p.x = F(0); p.ln_g = F(1); p.ln_b = F(2);
    p.rw_mu = F(3); p.rw_w_rkv = F(4); p.rw_w0 = F(5); p.rw_w1 = F(6); p.rw_w2 = F(7); p.rw_a0 = F(8);
    p.rw_a1 = F(9); p.rw_a2 = F(10); p.rw_g1 = F(11); p.rw_g2 = F(12);
    p.rw_k_k = F(13); p.rw_k_a = F(14); p.rw_r_k = F(15); p.rw_lnx_g = F(16); p.rw_lnx_b = F(17); p.rw_w_o = F(18);
    p.mb_w_in = F(19); p.mb_conv_w = F(20); p.mb_conv_b = F(21); p.mb_dt_bias = F(22); p.mb_a_log = F(23); p.mb_d = F(24); p.mb_norm_g = F(25); p.mb_w_out = F(26);
    p.gl_w_in = F(27); p.gl_gk_w2 = F(28); p.gl_gk_b = F(29); p.gl_norm_g = F(30); p.gl_w_out = F(31);
    p.moe_w_group = F(32); p.moe_b_group = F(33); p.moe_w_route = F(34); p.moe_b_route = F(35); p.moe_w_in = F(36); p.moe_w_down = F(37);
    p.out = (float*)d_out;
    p.ws = (char*)d_ws;
    if (WS_TOTAL > ws_size) { fprintf(stderr, "workspace too small: need %zu have %zu\n", (size_t)WS_TOTAL, ws_size); return; }
    unsigned* bar_ptr = (unsigned*)(p.ws + OFF_bar);
    const int np = NPHASES;
#define X(t, n) (void*)&p.n,
#if SINGLE_LAUNCH
    (void)hipFuncSetAttribute((const void*)mega<true>, hipFuncAttributeMaxDynamicSharedMemorySize, LDS_BYTES);
    (void)hipMemsetAsync(bar_ptr, 0, XCD_BAR_WORDS * sizeof(unsigned), stream);
    int ph0 = 0, ph1 = np; void* args[] = {PARAM_LIST(X) (void*)&ph0, (void*)&ph1};
    hipError_t e = hipLaunchCooperativeKernel((const void*)mega<true>, dim3(NBLK), dim3(NTHR), args, LDS_BYTES, stream);
    if (e != hipSuccess) fprintf(stderr, "cooperative launch failed: %s\n", hipGetErrorString(e));
#else
    (void)hipFuncSetAttribute((const void*)mega<false>, hipFuncAttributeMaxDynamicSharedMemorySize, LDS_BYTES);
    for (int ph = 0; ph < np; ++ph) { int ph0 = ph, ph1 = ph + 1; void* args[] = {PARAM_LIST(X) (void*)&ph0, (void*)&ph1};
        hipError_t e = hipLaunchKernel((const void*)mega<false>, dim3(NBLK), dim3(NTHR), args, LDS_BYTES, stream);
        if (e != hipSuccess) fprintf(stderr, "launch failed: %s\n", hipGetErrorString(e)); }
#endif
#undef X
}
```

```cpp
#include <hip/hip_runtime.h>
#include <hip/hip_cooperative_groups.h>
#include <cstdint>
#include <cstdio>
#include <cstring>
namespace cg = cooperative_groups;

typedef unsigned short bf16_t;
typedef short bf16x8 __attribute__((ext_vector_type(8)));
typedef short s16x4 __attribute__((ext_vector_type(4)));
typedef float f32x4 __attribute__((ext_vector_type(4)));
typedef float f32x2 __attribute__((ext_vector_type(2)));
typedef unsigned u32x4 __attribute__((ext_vector_type(4)));
typedef unsigned u32x2 __attribute__((ext_vector_type(2)));
#define LAS __attribute__((address_space(3)))
#define DEV __device__ __forceinline__

constexpr int T = 16384, D = 1024, DEPTH = 4;
constexpr int NTHR = 512, NBLK = 256;
constexpr int LDS_BYTES = 155648;
constexpr float ALPHA = 1.681792830507429f;
constexpr float LN_EPS = 1e-5f;
constexpr int MOE_ROWS = 40960;

DEV int tid_() { int t = threadIdx.x; asm volatile("" : "+v"(t)); return t; }
DEV int bid_() { int b = blockIdx.x; asm volatile("" : "+s"(b)); return b; }
#define NB_ 256
DEV void lds_barrier() { asm volatile("s_waitcnt lgkmcnt(0)" ::: "memory"); __builtin_amdgcn_s_barrier(); asm volatile("" ::: "memory"); }
DEV unsigned f2bf(float f) { unsigned u = __float_as_uint(f); u += 0x7FFFu + ((u >> 16) & 1u); return u >> 16; }
DEV float bf2f(unsigned short b) { return __uint_as_float(((unsigned)b) << 16); }
typedef __bf16 bf16n2 __attribute__((ext_vector_type(2)));
DEV unsigned pk2(float lo, float hi) { f32x2 v = {lo, hi}; bf16n2 b = __builtin_convertvector(v, bf16n2); return __builtin_bit_cast(unsigned, b); }
DEV float bflo(unsigned u) { return __uint_as_float(u << 16); }
DEV float bfhi(unsigned u) { return __uint_as_float(u & 0xFFFF0000u); }
DEV float sigmoidf_(float x) { return 1.0f / (1.0f + __expf(-x)); }
DEV float siluf_(float x) { return x / (1.0f + __expf(-x)); }
DEV float softplusf_(float x) { return fmaxf(x, 0.f) + __logf(1.0f + __expf(-fabsf(x))); }
DEV float tanhf_(float x) { const float e = __expf(-2.0f * fabsf(x)); const float r = (1.0f - e) / (1.0f + e); return x < 0.f ? -r : r; }
DEV float wave_sum(float v) {
#pragma unroll
    for (int o = 32; o > 0; o >>= 1) v += __shfl_xor(v, o);
    return v;
}
DEV float sum16(float v) {
#pragma unroll
    for (int o = 8; o > 0; o >>= 1) v += __shfl_xor(v, o);
    return v;
}
template <int N> DEV float reduce_scatter(float (&v)[N], int lane) {
    int s = 1;
#pragma unroll
    for (int h = N / 2; h >= 1; h >>= 1) {
#pragma unroll
        for (int i = 0; i < h; ++i) {
            const bool up = (lane & s) != 0;
            const float send = up ? v[i] : v[i + h];
            const float keep = up ? v[i + h] : v[i];
            v[i] = keep + __shfl_xor(send, s);
        }
        s <<= 1;
    }
    float r = v[0];
    for (; s < 64; s <<= 1) r += __shfl_xor(r, s);
    return r;
}
template <int N> DEV int rs_index(int lane) {
    int o = 0, s = 1;
#pragma unroll
    for (int h = N / 2; h >= 1; h >>= 1) { if (lane & s) o += h; s <<= 1; }
    return o;
}

DEV bf16x8 frag_rm(const LAS bf16_t* base, int ld, int row0, int k0, int lane) {
    return *(const LAS bf16x8*)(base + (row0 + (lane & 15)) * ld + k0 + 8 * (lane >> 4));
}
DEV bf16x8 frag_tr(const LAS bf16_t* base, int ld, int k0, int c0, int lane) {
    const int g = lane >> 4, i = lane & 15, q = i >> 2, p = i & 3;
    const LAS bf16_t* a = base + (k0 + 8 * g + q) * ld + c0 + 4 * p;
    s16x4 lo = __builtin_amdgcn_ds_read_tr16_b64_v4i16((LAS s16x4*)a);
    s16x4 hi = __builtin_amdgcn_ds_read_tr16_b64_v4i16((LAS s16x4*)(a + 4 * ld));
    bf16x8 r; r[0] = lo[0]; r[1] = lo[1]; r[2] = lo[2]; r[3] = lo[3]; r[4] = hi[0]; r[5] = hi[1]; r[6] = hi[2]; r[7] = hi[3];
    return r;
}
#define MFMA16(a, b, c) __builtin_amdgcn_mfma_f32_16x16x32_bf16((a), (b), (c), 0, 0, 0)
DEV size_t fragmajor_off(int n, int k, int K) { return ((size_t)((n >> 4) * (K >> 5) + (k >> 5)) * 64 + (n & 15) + 16 * ((k & 31) >> 3)) * 8 + (k & 7); }

template <int N> DEV void skinny_group(const f32x4 (&z)[4], const LAS float* wt, int lane, LAS float* outw) {
    float pe[N];
#pragma unroll
    for (int o = 0; o < N; ++o) {
        float a = 0.f;
#pragma unroll
        for (int q = 0; q < 4; ++q) { const f32x4 w = *(const LAS f32x4*)(wt + o * 1028 + 256 * q + 4 * lane); a += z[q][0] * w[0] + z[q][1] * w[1] + z[q][2] * w[2] + z[q][3] * w[3]; }
        pe[o] = a;
    }
    const float r = reduce_scatter<N>(pe, lane);
    if (lane < N) outw[rs_index<N>(lane)] = r;
}
#ifndef SINGLE_LAUNCH
#define SINGLE_LAUNCH 1
#endif
constexpr size_t OFF_bar = 0ull;
constexpr size_t OFF_rw_rkv_t = 13824ull;
constexpr size_t OFF_rw_w1_t = 12596736ull;
constexpr size_t OFF_rw_a1_t = 13645312ull;
constexpr size_t OFF_rw_g1_t = 14693888ull;
constexpr size_t OFF_rw_w2_t = 15742464ull;
constexpr size_t OFF_rw_a2_t = 16791040ull;
constexpr size_t OFF_rw_g2_t = 17839616ull;
constexpr size_t OFF_rw_wo_t = 18888192ull;
constexpr size_t OFF_mb_win_t = 23082496ull;
constexpr size_t OFF_mb_wout_t = 33568256ull;
constexpr size_t OFF_gl_win_t = 37762560ull;
constexpr size_t OFF_gl_wout_t = 44054016ull;
constexpr size_t OFF_moe_w1_t = 46151168ull;
constexpr size_t OFF_moe_w2_t = 314586624ull;
constexpr size_t OFF_H = 448804352ull;
constexpr size_t OFF_H1 = 515913216ull;
constexpr size_t OFF_MIX = 583022080ull;
constexpr size_t OFF_BUF = 650130944ull;
constexpr size_t OFF_ACT = 734017024ull;
constexpr size_t OFF_YBUF = 775960064ull;
constexpr size_t OFF_CNT = 859846144ull;
constexpr size_t OFF_EIDX = 859878912ull;
constexpr size_t OFF_GATE = 860009984ull;
constexpr size_t OFF_DEST = 860141056ull;
constexpr size_t OFF_TAB = 860272128ull;
constexpr size_t OFF_YB = 860273152ull;
constexpr size_t OFF_X6 = 927382016ull;
constexpr size_t OFF_Rr = 1128708608ull;
constexpr size_t OFF_Kk = 1195817472ull;
constexpr size_t OFF_Vv = 1262926336ull;
constexpr size_t OFF_LW = 1330035200ull;
constexpr size_t OFF_Wd = 1355201024ull;
constexpr size_t OFF_Aa = 1422309888ull;
constexpr size_t OFF_Gg = 1489418752ull;
constexpr size_t OFF_RWf = 1556527616ull;
constexpr size_t OFF_RBf = 1590082048ull;
constexpr size_t OFF_RUt = 1623636480ull;
constexpr size_t OFF_RNa = 1657190912ull;
constexpr size_t OFF_RGc = 1690745344ull;
constexpr size_t OFF_RUa = 1691793920ull;
constexpr size_t OFF_RS0 = 1725348352ull;
constexpr size_t OFF_Z = 960936448ull;
constexpr size_t OFF_XBC = 1028045312ull;
constexpr size_t OFF_XC = 1128708608ull;
constexpr size_t OFF_DT = 1229371904ull;
constexpr size_t OFF_STATES = 1231469056ull;
constexpr size_t OFF_CD = 1365686784ull;
constexpr size_t OFF_PREV = 1365703168ull;
constexpr size_t OFF_LA = 1432812032ull;
constexpr size_t OFF_CDG = 1466366464ull;
constexpr size_t OFF_QKVG = OFF_XBC;
constexpr size_t WS_TOTAL = 1758902784ull;
typedef unsigned T_bar;
typedef bf16_t T_rw_rkv_t;
typedef bf16_t T_rw_w1_t;
typedef bf16_t T_rw_a1_t;
typedef bf16_t T_rw_g1_t;
typedef bf16_t T_rw_w2_t;
typedef bf16_t T_rw_a2_t;
typedef bf16_t T_rw_g2_t;
typedef bf16_t T_rw_wo_t;
typedef bf16_t T_mb_win_t;
typedef bf16_t T_mb_wout_t;
typedef bf16_t T_gl_win_t;
typedef bf16_t T_gl_wout_t;
typedef bf16_t T_moe_w1_t;
typedef bf16_t T_moe_w2_t;
typedef float T_H;
typedef float T_H1;
typedef float T_MIX;
typedef bf16_t T_BUF;
typedef bf16_t T_ACT;
typedef bf16_t T_YBUF;
typedef int T_CNT;
typedef int T_EIDX;
typedef float T_GATE;
typedef int T_DEST;
typedef int T_TAB;
typedef bf16_t T_YB;
typedef bf16_t T_X6;
typedef float T_Rr;
typedef float T_Kk;
typedef float T_Vv;
typedef bf16_t T_LW;
typedef float T_Wd;
typedef float T_Aa;
typedef float T_Gg;
typedef bf16_t T_RWf;
typedef bf16_t T_RBf;
typedef bf16_t T_RUt;
typedef bf16_t T_RNa;
typedef float T_RGc;
typedef bf16_t T_RUa;
typedef bf16_t T_RS0;
typedef bf16_t T_Z;
typedef bf16_t T_XBC;
typedef bf16_t T_XC;
typedef float T_DT;
typedef bf16_t T_STATES;
typedef float T_CD;
typedef bf16_t T_PREV;
typedef float T_LA;
typedef float T_CDG;
typedef bf16_t T_QKVG;
#define WS_(P, N) ((T_##N*)((P).ws + OFF_##N))
constexpr size_t OFF_Hb = OFF_H, OFF_H1b = OFF_H1, OFF_MIXb = OFF_MIX;
typedef bf16_t T_Hb; typedef bf16_t T_H1b; typedef bf16_t T_MIXb;
constexpr size_t OFF_moe_wr_t = OFF_H + 33554432ull;
typedef bf16_t T_moe_wr_t;
constexpr size_t OFF_mb_dt_t = OFF_moe_wr_t + 4ull * 48 * 1024 * 2, OFF_gl_lr_t = OFF_mb_dt_t + 32ull * 1024 * 2;
typedef bf16_t T_mb_dt_t; typedef bf16_t T_gl_lr_t;
constexpr size_t OFF_Rb = OFF_Rr, OFF_Kb = OFF_Kk, OFF_Vb = OFF_Vv, OFF_Ab = OFF_Aa, OFF_Gb = OFF_Gg;
typedef bf16_t T_Rb; typedef bf16_t T_Kb; typedef bf16_t T_Vb; typedef bf16_t T_Ab; typedef bf16_t T_Gb;
struct ConvJob {
    const float* src; bf16_t* dst;
    int K, N, src_ld, Kpad, Npad, perm, batch;
    long long src_bs, dst_bs;
    DEV int ntiles() const { return (Kpad / 64) * (Npad / 64) * batch; }
};
constexpr int NJOBS = 16;
constexpr int MOE_SPLIT = 64;

#define PARAM_LIST(X) \
    X(const float*, x) X(const float*, ln_g) X(const float*, ln_b) \
    X(const float*, rw_mu) X(const float*, rw_w_rkv) X(const float*, rw_w0) X(const float*, rw_w1) X(const float*, rw_w2) X(const float*, rw_a0) X(const float*, rw_a1) X(const float*, rw_a2) \
    X(const float*, rw_g1) X(const float*, rw_g2) X(const float*, rw_k_k) X(const float*, rw_k_a) X(const float*, rw_r_k) X(const float*, rw_lnx_g) X(const float*, rw_lnx_b) X(const float*, rw_w_o) \
    X(const float*, mb_w_in) X(const float*, mb_conv_w) X(const float*, mb_conv_b) X(const float*, mb_dt_bias) X(const float*, mb_a_log) X(const float*, mb_d) X(const float*, mb_norm_g) X(const float*, mb_w_out) \
    X(const float*, gl_w_in) X(const float*, gl_gk_w2) X(const float*, gl_gk_b) X(const float*, gl_norm_g) X(const float*, gl_w_out) \
    X(const float*, moe_w_group) X(const float*, moe_b_group) X(const float*, moe_w_route) X(const float*, moe_b_route) X(const float*, moe_w_in) X(const float*, moe_w_down) \
    X(float*, out) X(char*, ws)
struct Params {
#define X(t, n) t n;
    PARAM_LIST(X)
#undef X
};

enum Op : unsigned char { OP_CONVERT = 0, OP_PRE0, OP_RW_GEMM1, OP_RW_GEMM2, OP_RW_CHA, OP_RW_CHB, OP_RW_CHC, OP_RW_OUT,
    OP_LN1, OP_MOE_SCATTER, OP_MOE_GEMM1, OP_MOE_GEMM2, OP_LN2,
    OP_MB_GEMM_IN, OP_MB_CONV, OP_MB_STATES, OP_MB_SCAN, OP_MB_OUT, OP_MB_GEMM_OUT,
    OP_GL_GEMM_IN, OP_GL_KV, OP_GL_SCAN, OP_GL_OUT, OP_GL_GEMM_OUT };


DEV ConvJob make_job(const Params& p, int q) {
    const long long DD = (long long)D * D;
    switch (q) {
    case 0: return ConvJob{p.rw_w_rkv, WS_(p, rw_rkv_t), 1024, 1024, 1024, 1024, 1024, 0, 6, DD, DD};
    case 1: return ConvJob{p.rw_w1, WS_(p, rw_w1_t), 1024, 64, 64, 1024, 256, 0, 2, (long long)D * 64, (long long)256 * D};
    case 2: return ConvJob{p.rw_a1, WS_(p, rw_a1_t), 1024, 64, 64, 1024, 256, 0, 2, (long long)D * 64, (long long)256 * D};
    case 3: return ConvJob{p.rw_g1, WS_(p, rw_g1_t), 1024, 160, 160, 1024, 256, 0, 2, (long long)D * 160, (long long)256 * D};
    case 4: return ConvJob{p.rw_w2, WS_(p, rw_w2_t), 64, 1024, 1024, 256, 1024, 0, 2, (long long)64 * D, (long long)D * 256};
    case 5: return ConvJob{p.rw_a2, WS_(p, rw_a2_t), 64, 1024, 1024, 256, 1024, 0, 2, (long long)64 * D, (long long)D * 256};
    case 6: return ConvJob{p.rw_g2, WS_(p, rw_g2_t), 160, 1024, 1024, 256, 1024, 0, 2, (long long)160 * D, (long long)D * 256};
    case 7: return ConvJob{p.rw_w_o, WS_(p, rw_wo_t), 1024, 1024, 1024, 1024, 1024, 0, 2, DD, DD};
    case 8: return ConvJob{p.mb_w_in, WS_(p, mb_win_t), 1024, 5120, 5152, 1024, 5120, 0, 1, 0, 0};
    case 9: return ConvJob{p.mb_w_out, WS_(p, mb_wout_t), 2048, 1024, 1024, 2048, 1024, 0, 1, 0, 0};
    case 10: return ConvJob{p.gl_w_in, WS_(p, gl_win_t), 1024, 3072, 3088, 1024, 3072, 0, 1, 0, 0};
    case 11: return ConvJob{p.gl_w_out, WS_(p, gl_wout_t), 1024, 1024, 1024, 1024, 1024, 0, 1, 0, 0};
    case 12: return ConvJob{p.moe_w_in, WS_(p, moe_w1_t), 1024, 1024, 1024, 1024, 1024, 1, MOE_SPLIT, DD, DD};
    case 13: return ConvJob{p.moe_w_down, WS_(p, moe_w2_t), 512, 1024, 1024, 512, 1024, 0, MOE_SPLIT, (long long)512 * 1024, (long long)1024 * 512};
    case 14: return ConvJob{p.moe_w_in + (size_t)MOE_SPLIT * DD, WS_(p, moe_w1_t) + (size_t)MOE_SPLIT * DD, 1024, 1024, 1024, 1024, 1024, 1, 128 - MOE_SPLIT, DD, DD};
    default: return ConvJob{p.moe_w_down + (size_t)MOE_SPLIT * 512 * 1024, WS_(p, moe_w2_t) + (size_t)MOE_SPLIT * 512 * 1024, 512, 1024, 1024, 512, 1024, 0, 128 - MOE_SPLIT, (long long)512 * 1024, (long long)1024 * 512};
    }
}

template <int J0, int J1> DEV void convert_jobs(const Params& p, LAS unsigned char* lds, int B0, int NBW) {
    const int tid = tid_(), bid = bid_();
    const int lane = tid & 63, wv = tid >> 6; const int gw = (bid - B0) * 8 + wv, NW = NBW * 8;
    LAS bf16_t* tile = (LAS bf16_t*)lds + wv * (64 * 72);
    int tbeg = 0;
#pragma unroll
    for (int j = J0; j < J1; ++j) {
      const ConvJob J = make_job(p, j);
      const int jend = tbeg + J.ntiles();
      const int ti0 = tbeg + ((gw - tbeg) % NW + NW) % NW;
      const int jbeg = tbeg; tbeg = jend;
#pragma unroll 1
      for (int ti = ti0; ti < jend; ti += NW) {
        int local = ti - jbeg;
        const int tk = J.Kpad / 64, tn = J.Npad / 64;
        const int b = local / (tk * tn); local -= b * tk * tn;
        const int nt = local / tk, kt = local - nt * tk;
        const float* src = J.src + (size_t)b * J.src_bs;
        bf16_t* dst = J.dst + (size_t)b * J.dst_bs;
        const int k0 = kt * 64, n0 = nt * 64;
        const int nn = (lane & 15) * 4; const bool nok = n0 + nn < J.N;
        f32x4 v[16];
#pragma unroll
        for (int i = 0; i < 16; ++i) { const int kk = (lane >> 4) + 4 * i; v[i] = (nok && k0 + kk < J.K) ? *(const f32x4*)(src + (size_t)(k0 + kk) * J.src_ld + n0 + nn) : (f32x4){0.f, 0.f, 0.f, 0.f}; }
#pragma unroll
        for (int i = 0; i < 16; ++i) { const int kk = (lane >> 4) + 4 * i;
#pragma unroll
            for (int e = 0; e < 4; ++e) tile[(nn + e) * 72 + kk] = (bf16_t)f2bf(v[i][e]); }
#pragma unroll
        for (int i = 0; i < 8; ++i) { const int r = (lane >> 3) + 8 * i, kc = (lane & 7) * 8;
            int nsrc = n0 + r, ndst = nsrc;
            if (J.perm == 1) { const int up = nsrc >= 512, jj = nsrc - (up ? 512 : 0); ndst = (jj >> 7) * 256 + (up ? 128 : 0) + (jj & 127); }
            *(u32x4*)(dst + (size_t)ndst * J.Kpad + k0 + kc) = *(const LAS u32x4*)(tile + r * 72 + kc); }
      }
    }
}
DEV void phase_convert(const Params& p, LAS unsigned char* lds) {
    const int tid = tid_(), bid = bid_();
    convert_jobs<0, 14>(p, lds, 0, NB_);
    if (bid < 4 * 48) { const int layer = bid / 48, o = bid % 48;
        for (int k = tid; k < D; k += NTHR) { float v = 0.f;
            if (o < 32) v = p.moe_w_route[((size_t)layer * D + k) * 32 + o]; else if (o < 36) v = p.moe_w_group[((size_t)layer * D + k) * 4 + (o - 32)];
            WS_(p, moe_wr_t)[((size_t)layer * 48 + o) * D + k] = (bf16_t)f2bf(v); } }
    else if (bid < 4 * 48 + 32) { const int o = bid - 192;
        for (int k = tid; k < D; k += NTHR) WS_(p, mb_dt_t)[(size_t)o * D + k] = (bf16_t)f2bf(p.mb_w_in[(size_t)k * 5152 + 5120 + o]); }
    else if (bid < 4 * 48 + 48) { const int o = bid - 224;
        for (int k = tid; k < D; k += NTHR) WS_(p, gl_lr_t)[(size_t)o * D + k] = (bf16_t)f2bf(p.gl_w_in[(size_t)k * 3088 + 3072 + o]); }
}
namespace pg8 {
constexpr int BM = 256, BK = 64, HALF = 128, HTB = HALF * BK * 2, STAGE_BYTES = 8 * HTB;
DEV int lds_byte(int r, int c) { const int st = (r >> 4) * 2 + (c >> 5), rr = r & 15, cc = c & 31, ob = rr * 64 + cc * 2; return st * 1024 + (ob ^ (((ob >> 9) & 1) << 5)); }
DEV void stage_rc(int b, int& R, int& C) { const int st = b / 1024, sb = b % 1024, swz = sb ^ (((sb >> 9) & 1) << 5); R = (st >> 1) * 16 + swz / 64; C = (st & 1) * 32 + (swz % 64) / 2; }

struct Unit { const char* A; const char* B; int row0, col0, id, aux; };

DEV bool tile_order(int i, int G, int c, int nM, int nN, int& pm, int& pn) {
    const int nwg = nM * nN; const long L = (long)i * G + c; if (L >= nwg) return false;
    int wgid = (int)L; { const int q = nwg / 8, r = nwg % 8, xcd = wgid % 8, off = wgid / 8; wgid = (xcd < r ? xcd * (q + 1) : r * (q + 1) + (xcd - r) * q) + off; }
    const int nig = 8 * nN, gid = wgid / nig, fm = gid * 8, gsz = (nM - fm) < 8 ? (nM - fm) : 8;
    pm = fm + ((wgid % nig) % gsz); pn = (wgid % nig) / gsz; return true;
}

template <class Epi, class Sched>
DEV void gemm_phase(LAS unsigned char* lds, const int K, const Sched& S, const Epi& E) {
    const int tid = tid_(), wid = __builtin_amdgcn_readfirstlane(tid >> 6), lane = tid & 63, wr = wid >> 2, wc = wid & 3, fr = lane & 15, fq = lane >> 4;
    const int nt = K / BK;
    unsigned voff[2];
#pragma unroll
    for (int i = 0; i < 2; ++i) { int R, C; stage_rc(tid * 16 + i * 8192, R, C); voff[i] = (unsigned)(R * K + C) * 2u; }
    const size_t kstep = (size_t)(BK * 2);
    const size_t hstep = (size_t)HALF * K * 2;
    const unsigned ldsw = (unsigned)wid * 1024u;
    const int aoff = lds_byte(wr * 64 + fr, fq * 8), boff = lds_byte(wc * 32 + fr, fq * 8);
#define PG8_SA(b, h) (((b) * 2 + (h)) * HTB)
#define PG8_SB(b, h) ((4 + (b) * 2 + (h)) * HTB)
#define PG8_STAGE(bufoff, gbase) do { _Pragma("unroll") for (int _i = 0; _i < 2; ++_i) \
        __builtin_amdgcn_global_load_lds((const unsigned*)((const char*)(gbase) + voff[_i]), (LAS unsigned*)(lds + (bufoff) + ldsw + _i * 8192), 16, 0, 0); } while (0)
#define PG8_LDA(dst, b, h) do { _Pragma("unroll") for (int m = 0; m < 4; ++m) _Pragma("unroll") for (int k = 0; k < 2; ++k) dst[m][k] = *(const LAS bf16x8*)(lds + PG8_SA(b, h) + aoff + m * 2048 + k * 1024); } while (0)
#define PG8_LDB(dst, b, h) do { _Pragma("unroll") for (int n = 0; n < 2; ++n) _Pragma("unroll") for (int k = 0; k < 2; ++k) dst[n][k] = *(const LAS bf16x8*)(lds + PG8_SB(b, h) + boff + n * 2048 + k * 1024); } while (0)
#define PG8_MMA(ai, bj, At, Bt) do { __builtin_amdgcn_s_setprio(1); _Pragma("unroll") for (int m = 0; m < 4; ++m) _Pragma("unroll") for (int n = 0; n < 2; ++n) _Pragma("unroll") for (int k = 0; k < 2; ++k) \
        acc[ai][bj][m][n] = __builtin_amdgcn_mfma_f32_16x16x32_bf16(Bt[n][k], At[m][k], acc[ai][bj][m][n], 0, 0, 0); __builtin_amdgcn_s_setprio(0); } while (0)
#define PG8_WAIT_V(n) asm volatile("s_waitcnt vmcnt(" #n ")" ::: "memory")
#define PG8_WAIT_L(n) asm volatile("s_waitcnt lgkmcnt(" #n ")" ::: "memory")
#define PG8_BAR __builtin_amdgcn_s_barrier()
#define PG8_SCHED __builtin_amdgcn_sched_barrier(0)
    Unit cur, nxt; int ui = 0;
    if (!S.next(0, cur)) return;
    f32x4 acc[2][2][4][2];
#pragma unroll
    for (int a = 0; a < 2; ++a)
#pragma unroll
        for (int b = 0; b < 2; ++b)
#pragma unroll
            for (int m = 0; m < 4; ++m)
#pragma unroll
                for (int n = 0; n < 2; ++n) acc[a][b][m][n] = (f32x4){0.f, 0.f, 0.f, 0.f};
    bf16x8 At[4][2], B0[2][2], B1[2][2];
    const char* cA = cur.A; const char* cB = cur.B;
    PG8_STAGE(PG8_SB(0, 0), cB); PG8_STAGE(PG8_SA(0, 0), cA); PG8_STAGE(PG8_SB(0, 1), cB + hstep); PG8_STAGE(PG8_SA(0, 1), cA + hstep);
    if (wr == 1) PG8_BAR;
    PG8_WAIT_V(4); PG8_BAR;
    PG8_STAGE(PG8_SB(1, 0), cB + kstep); PG8_STAGE(PG8_SA(1, 0), cA + kstep); PG8_STAGE(PG8_SB(1, 1), cB + hstep + kstep);
    PG8_WAIT_V(6); PG8_BAR;
    for (;;) {
        const bool has_next = S.next(ui + 1, nxt);
        const char* nA = has_next ? nxt.A : cA; const char* nB = has_next ? nxt.B : cB;
#pragma unroll 1
        for (int t = 0; t < nt; t += 2) {
            const bool last = (t == nt - 2);
            const char* a1 = cA + (size_t)(t + 1) * kstep;
            const char* a2 = last ? nA : cA + (size_t)(t + 2) * kstep; const char* b2 = last ? nB : cB + (size_t)(t + 2) * kstep;
            const char* a3 = a2 + kstep; const char* b3 = b2 + kstep;
            PG8_LDB(B0, 0, 0); PG8_SCHED; PG8_LDA(At, 0, 0); PG8_STAGE(PG8_SA(1, 1), a1 + hstep);
            PG8_WAIT_L(8); PG8_BAR; PG8_WAIT_L(0); PG8_MMA(0, 0, At, B0); PG8_BAR; PG8_SCHED;
            PG8_LDB(B1, 0, 1); PG8_STAGE(PG8_SB(0, 0), b2);
            PG8_BAR; PG8_WAIT_L(0); PG8_MMA(0, 1, At, B1); PG8_BAR;
            PG8_LDA(At, 0, 1); PG8_STAGE(PG8_SA(0, 0), a2);
            PG8_BAR; PG8_WAIT_L(0); PG8_MMA(1, 0, At, B0); PG8_BAR; PG8_SCHED;
            PG8_STAGE(PG8_SB(0, 1), b2 + hstep);
            PG8_WAIT_V(6); PG8_BAR; PG8_MMA(1, 1, At, B1); PG8_BAR;
            PG8_LDB(B0, 1, 0); PG8_SCHED; PG8_LDA(At, 1, 0); PG8_STAGE(PG8_SA(0, 1), a2 + hstep);
            PG8_WAIT_L(8); PG8_BAR; PG8_WAIT_L(0); PG8_MMA(0, 0, At, B0); PG8_BAR; PG8_SCHED;
            PG8_LDB(B1, 1, 1); PG8_STAGE(PG8_SB(1, 0), b3);
            PG8_BAR; PG8_WAIT_L(0); PG8_MMA(0, 1, At, B1); PG8_BAR;
            PG8_LDA(At, 1, 1); PG8_STAGE(PG8_SA(1, 0), a3);
            PG8_BAR; PG8_WAIT_L(0); PG8_MMA(1, 0, At, B0); PG8_BAR; PG8_SCHED;
            PG8_STAGE(PG8_SB(1, 1), b3 + hstep);
            PG8_WAIT_V(6); PG8_BAR; PG8_MMA(1, 1, At, B1); PG8_BAR;
        }
        E(acc, cur, wr, wc, fr, fq);
        if (!has_next) break;
#pragma unroll
        for (int a = 0; a < 2; ++a)
#pragma unroll
            for (int b = 0; b < 2; ++b)
#pragma unroll
                for (int m = 0; m < 4; ++m)
#pragma unroll
                    for (int n = 0; n < 2; ++n) acc[a][b][m][n] = (f32x4){0.f, 0.f, 0.f, 0.f};
        cur = nxt; cA = nA; cB = nB; ++ui;
    }
    PG8_WAIT_V(0);
    if (wr == 0) PG8_BAR;
    PG8_BAR;
#undef PG8_SA
#undef PG8_SB
#undef PG8_STAGE
#undef PG8_LDA
#undef PG8_LDB
#undef PG8_MMA
#undef PG8_WAIT_V
#undef PG8_WAIT_L
#undef PG8_BAR
#undef PG8_SCHED
}
}
using pg8::Unit;
typedef f32x4 AccT[2][2][4][2];
#define FOR_ACC(ai, bj, m, n) _Pragma("unroll") for (int ai = 0; ai < 2; ++ai) _Pragma("unroll") for (int m = 0; m < 4; ++m) _Pragma("unroll") for (int bj = 0; bj < 2; ++bj) _Pragma("unroll") for (int n = 0; n < 2; ++n)
#define ACC_FENCE __builtin_amdgcn_sched_barrier(0)
#define ACC_ROW(u, ai, m) ((u).row0 + 128 * (ai) + 64 * wr + 16 * (m) + fr)
#define ACC_COL(u, bj, n) ((u).col0 + 128 * (bj) + 32 * wc + 16 * (n) + 4 * fq)
DEV void st_bf4(bf16_t* p, f32x4 v) { u32x2 w; w.x = pk2(v[0], v[1]); w.y = pk2(v[2], v[3]); *(u32x2*)p = w; }
DEV void load_row(const float* p, int lane, f32x4 (&v)[4]) {
#pragma unroll
    for (int q = 0; q < 4; ++q) v[q] = *(const f32x4*)(p + 256 * q + 4 * lane);
}

DEV void load_row_bf(const bf16_t* p, int lane, f32x4 (&v)[4]) {
#pragma unroll
    for (int q = 0; q < 4; ++q) { const u32x2 a = *(const u32x2*)(p + 256 * q + 4 * lane); v[q] = (f32x4){bflo(a.x), bfhi(a.x), bflo(a.y), bfhi(a.y)}; }
}
DEV void store_row_bf(bf16_t* p, int lane, const f32x4 (&v)[4]) {
#pragma unroll
    for (int q = 0; q < 4; ++q) st_bf4(p + 256 * q + 4 * lane, v[q]);
}
DEV void emit_mix6(const Params& p, int j, int t, int lane, const f32x4 (&x)[4], const f32x4 (&xp)[4]) {
    const float* mu = p.rw_mu + (size_t)j * 6 * D;
#pragma unroll
    for (int s = 0; s < 6; ++s) {
#pragma unroll
        for (int q = 0; q < 4; ++q) {
            const f32x4 m = *(const f32x4*)(mu + s * D + 256 * q + 4 * lane);
            st_bf4(WS_(p, X6) + (size_t)s * T * D + (size_t)t * D + 256 * q + 4 * lane, x[q] + (xp[q] - x[q]) * m);
        }
        __builtin_amdgcn_sched_barrier(0);
    }
}
DEV void phase_pre0(const Params& p) {
    const int tid = tid_(), bid = bid_(); const int lane = tid & 63, wid = tid >> 6;
    f32x4 x[4], xp[4];
    const int tfirst = bid * 64 + wid * 8;
    if (tfirst > 0) load_row(p.x + (size_t)(tfirst - 1) * D, lane, xp); else { for (int q = 0; q < 4; ++q) xp[q] = (f32x4){0.f, 0.f, 0.f, 0.f}; }
    f32x4 xn[4]; load_row(p.x + (size_t)tfirst * D, lane, xn);
#pragma unroll 1
    for (int r = 0; r < 8; ++r) {
        const int t = tfirst + r;
#pragma unroll
        for (int q = 0; q < 4; ++q) x[q] = xn[q];
        load_row(p.x + (size_t)(r < 7 ? t + 1 : t) * D, lane, xn);
        store_row_bf(WS_(p, Hb) + (size_t)t * D, lane, x);
        emit_mix6(p, 0, t, lane, x, xp);
#pragma unroll
        for (int q = 0; q < 4; ++q) xp[q] = x[q];
    }
}

struct SchedRW1 {
    const Params* p; int j;
    DEV bool next(int i, Unit& u) const {
        int pm, pn; if (!pg8::tile_order(i, NB_, bid_(), 64, 15, pm, pn)) return false;
        int id, lpn; if (pn < 12) { id = pn >> 2; lpn = pn & 3; } else { id = 3 + (pn - 12); lpn = 0; }
        u.A = (const char*)(WS_(*p, X6) + (size_t)id * T * D + (size_t)pm * 256 * D);
        const bf16_t* B;
        if (id < 3) B = WS_(*p, rw_rkv_t) + ((size_t)j * 3 + id) * D * D + (size_t)lpn * 256 * D;
        else B = WS_(*p, rw_w1_t) + (size_t)(id - 3) * (2 * 256 * D) + (size_t)j * 256 * D;
        u.B = (const char*)B; u.row0 = pm * 256; u.col0 = lpn * 256; u.id = id; u.aux = 0; return true;
    }
};
struct EpiRW1 {
    const Params* p;
    DEV void operator()(const AccT& acc, const Unit& u, int wr, int wc, int fr, int fq) const {
        if (u.id < 3) {
            bf16_t* O = WS_(*p, Rb) + (size_t)u.id * 2 * T * D;
            FOR_ACC(ai, bj, m, n) { st_bf4(O + (size_t)ACC_ROW(u, ai, m) * D + ACC_COL(u, bj, n), acc[ai][bj][m][n]); ACC_FENCE; }
        } else {
            bf16_t* O = WS_(*p, LW) + (size_t)(u.id - 3) * T * 256;
            FOR_ACC(ai, bj, m, n) {
                f32x4 v = acc[ai][bj][m][n];
                if (u.id == 3) { for (int e = 0; e < 4; ++e) v[e] = tanhf_(v[e]); }
                else if (u.id == 5) { for (int e = 0; e < 4; ++e) v[e] = sigmoidf_(v[e]); }
                st_bf4(O + (size_t)ACC_ROW(u, ai, m) * 256 + ACC_COL(u, bj, n), v); ACC_FENCE;
            }
        }
    }
};
struct SchedRW2 {
    const Params* p; int j;
    DEV bool next(int i, Unit& u) const {
        int pm, pn; if (!pg8::tile_order(i, NB_, bid_(), 64, 12, pm, pn)) return false;
        const int id = pn >> 2, lpn = pn & 3;
        u.A = (const char*)(WS_(*p, LW) + (size_t)id * T * 256 + (size_t)pm * 256 * 256);
        const bf16_t* B = WS_(*p, rw_w2_t) + (size_t)id * (2 * D * 256) + (size_t)j * D * 256 + (size_t)lpn * 256 * 256;
        u.B = (const char*)B; u.row0 = pm * 256; u.col0 = lpn * 256; u.id = id; u.aux = 0; return true;
    }
};
struct EpiRW2 {
    const Params* p; int j;
    DEV void operator()(const AccT& acc, const Unit& u, int wr, int wc, int fr, int fq) const {
        if (u.id == 0) { const float* bias = p->rw_w0 + (size_t)j * D; f32x4 bv[2][2];
#pragma unroll
            for (int bj = 0; bj < 2; ++bj)
#pragma unroll
                for (int n = 0; n < 2; ++n) bv[bj][n] = *(const f32x4*)(bias + ACC_COL(u, bj, n));
            FOR_ACC(ai, bj, m, n) { f32x4 v = acc[ai][bj][m][n]; const int c = ACC_COL(u, bj, n); const f32x4 b = bv[bj][n];
                for (int e = 0; e < 4; ++e) { const float x = -(b[e] + v[e]); const float wl = -(fmaxf(x, 0.f) + __logf(1.0f + __expf(-fabsf(x)))) - 0.5f; v[e] = -__expf(wl); }
                *(f32x4*)(WS_(*p, Wd) + (size_t)ACC_ROW(u, ai, m) * D + c) = v; ACC_FENCE; } }
        else if (u.id == 1) { const float* bias = p->rw_a0 + (size_t)j * D; f32x4 bv[2][2];
#pragma unroll
            for (int bj = 0; bj < 2; ++bj)
#pragma unroll
                for (int n = 0; n < 2; ++n) bv[bj][n] = *(const f32x4*)(bias + ACC_COL(u, bj, n));
            FOR_ACC(ai, bj, m, n) { f32x4 v = acc[ai][bj][m][n]; const int c = ACC_COL(u, bj, n); const f32x4 b = bv[bj][n];
                for (int e = 0; e < 4; ++e) v[e] = sigmoidf_(b[e] + v[e]);
                st_bf4(WS_(*p, Ab) + (size_t)ACC_ROW(u, ai, m) * D + c, v); ACC_FENCE; } }
        else { FOR_ACC(ai, bj, m, n) { st_bf4(WS_(*p, Gb) + (size_t)ACC_ROW(u, ai, m) * D + ACC_COL(u, bj, n), acc[ai][bj][m][n]); ACC_FENCE; } }
    }
};

struct SchedOut {
    const bf16_t* A; const bf16_t* Bt; int K;
    DEV bool next(int i, Unit& u) const {
        int pm, pn; if (!pg8::tile_order(i, NB_, bid_(), 64, 4, pm, pn)) return false;
        u.A = (const char*)(A + (size_t)pm * 256 * K); u.B = (const char*)(Bt + (size_t)pn * 256 * K); u.row0 = pm * 256; u.col0 = pn * 256; u.id = 0; u.aux = 0; return true;
    }
};
struct EpiOut {
    bf16_t* O;
    DEV void operator()(const AccT& acc, const Unit& u, int wr, int wc, int fr, int fq) const {
        FOR_ACC(ai, bj, m, n) { st_bf4(O + (size_t)ACC_ROW(u, ai, m) * D + ACC_COL(u, bj, n), acc[ai][bj][m][n]); ACC_FENCE; }
    }
};
constexpr int RC_LD = 72;
#ifdef DBG
#define DBGF(cond, bit) do { if (cond) atomicOr(&WS_(p, TAB)[200], (bit)); } while (0)
#else
#define DBGF(cond, bit) do {} while (0)
#endif
DEV bool bad_(float x) { return !(fabsf(x) < 1e30f); }
DEV int rc_pi(int g, int j) { return j < 4 ? 4 * g + j : 16 + 4 * g + (j - 4); }

DEV void rc_load_wd(const Params& p, int t0, int cb, float (&wd)[8]) {
    const int tid = tid_(); const int k = tid & 63, sg = tid >> 6;
#pragma unroll
    for (int i = 0; i < 8; ++i) wd[i] = WS_(p, Wd)[(size_t)(t0 + sg * 8 + i) * D + cb + k];
}
DEV void rc_cum_regs(const float (&wd)[8], LAS float* cum, LAS float* seg) {
    const int tid = tid_(); const int k = tid & 63, sg = tid >> 6;
    float v[8]; float s = 0.f;
#pragma unroll
    for (int i = 0; i < 8; ++i) { s += wd[i]; v[i] = s; }
    seg[sg * 64 + k] = s;
    lds_barrier();
    float off = 0.f;
#pragma unroll
    for (int q = 0; q < 8; ++q) off += (q < sg) ? seg[q * 64 + k] : 0.f;
#pragma unroll
    for (int i = 0; i < 8; ++i) cum[(sg * 8 + i) * 64 + k] = v[i] + off;
    lds_barrier();
}
DEV void ld8b(const bf16_t* p, float (&f)[8]) { const u32x4 v = *(const u32x4*)p; f[0] = bflo(v.x); f[1] = bfhi(v.x); f[2] = bflo(v.y); f[3] = bfhi(v.y); f[4] = bflo(v.z); f[5] = bfhi(v.z); f[6] = bflo(v.w); f[7] = bfhi(v.w); }
DEV void ld8(const float* p, float (&f)[8]) { const f32x4 a = *(const f32x4*)p, b = *(const f32x4*)(p + 4); f[0] = a[0]; f[1] = a[1]; f[2] = a[2]; f[3] = a[3]; f[4] = b[0]; f[5] = b[1]; f[6] = b[2]; f[7] = b[3]; }
DEV void lds8(const LAS float* p, float (&f)[8]) { const f32x4 a = *(const LAS f32x4*)p, b = *(const LAS f32x4*)(p + 4); f[0] = a[0]; f[1] = a[1]; f[2] = a[2]; f[3] = a[3]; f[4] = b[0]; f[5] = b[1]; f[6] = b[2]; f[7] = b[3]; }
DEV u32x4 pk8(const float (&f)[8]) { u32x4 o; o.x = pk2(f[0], f[1]); o.y = pk2(f[2], f[3]); o.z = pk2(f[4], f[5]); o.w = pk2(f[6], f[7]); return o; }

DEV bf16x8 frag_rm_pi(const LAS bf16_t* base, int ld, int row0, int k0, int lane) {
    const LAS bf16_t* a = base + (row0 + (lane & 15)) * ld + k0 + 4 * (lane >> 4);
    const s16x4 lo = *(const LAS s16x4*)a, hi = *(const LAS s16x4*)(a + 16);
    bf16x8 r; r[0] = lo[0]; r[1] = lo[1]; r[2] = lo[2]; r[3] = lo[3]; r[4] = hi[0]; r[5] = hi[1]; r[6] = hi[2]; r[7] = hi[3]; return r;
}
DEV void rc_prep8(const float (&k)[8], const float (&al)[8], const float (&kkw)[8], const float (&kaw)[8], float (&a)[8], float (&b)[8], float (&kh)[8]) {
    float kk[8]; float ss = 0.f;
#pragma unroll
    for (int e = 0; e < 8; ++e) { kk[e] = k[e] * kkw[e]; ss += kk[e] * kk[e]; }
    ss += __shfl_xor(ss, 1); ss += __shfl_xor(ss, 2); ss += __shfl_xor(ss, 4);
    const float inv = 1.0f / fmaxf(sqrtf(ss), 1e-12f);
#pragma unroll
    for (int e = 0; e < 8; ++e) { const float kn = kk[e] * inv; a[e] = -kn; b[e] = kn * al[e]; kh[e] = k[e] * (1.0f + (al[e] - 1.0f) * kaw[e]); }
}
DEV void phase_rw_cha(const Params& p, int jl, LAS unsigned char* lds) {
    const int tid = tid_(), bid = bid_(); const int lane = tid & 63, w = tid >> 6; const int fr = lane & 15, fq = lane >> 4;
    LAS float* cum = (LAS float*)lds;
    LAS float* seg = cum + 64 * 64;
    LAS float* Aab = seg + 8 * 64;
    LAS bf16_t* As = (LAS bf16_t*)(Aab + 64 * 68);
    LAS bf16_t* Bs = As + 64 * RC_LD; LAS bf16_t* Ks = Bs + 64 * RC_LD; LAS bf16_t* Vs = Ks + 64 * RC_LD; LAS bf16_t* Ke = Vs + 64 * RC_LD;
    LAS bf16_t* Aak = Ke + 64 * RC_LD; LAS bf16_t* Ts = Aak + 64 * RC_LD; LAS bf16_t* X1 = Ts + 64 * RC_LD; LAS bf16_t* Aabh = X1 + 64 * RC_LD;
    LAS bf16_t* Fimg = Aabh + 64 * RC_LD;
    LAS bf16_t* Wimg = Fimg + 4096;
    float pwd[8], pkr[8], pal[8], pv[8];
    float kkw[8], kaw[8];
    ld8(p.rw_k_k + (size_t)jl * D + (bid & 15) * 64 + (tid & 7) * 8, kkw); ld8(p.rw_k_a + (size_t)jl * D + (bid & 15) * 64 + (tid & 7) * 8, kaw);
    { const int c = bid >> 4, h = bid & 15; rc_load_wd(p, c * 64, h * 64, pwd);
      const size_t go = (size_t)(c * 64 + (tid >> 3)) * D + h * 64 + (tid & 7) * 8; ld8b(WS_(p, Kb) + go, pkr); ld8b(WS_(p, Ab) + go, pal); ld8b(WS_(p, Vb) + go, pv); }
    for (int u = bid; u < 4096; u += NB_) {
        const int c = u >> 4, h = u & 15; const int t0 = c * 64, cb = h * 64; const size_t ub = (size_t)c * 16 + h;
        lds_barrier();
        rc_cum_regs(pwd, cum, seg);
        {
            const int t = tid >> 3, k8 = (tid & 7) * 8;
            float a[8], b[8], kh[8], v[8], ct[8], cp[8], ce[8];
            rc_prep8(pkr, pal, kkw, kaw, a, b, kh);
#pragma unroll
            for (int e = 0; e < 8; ++e) v[e] = pv[e];
            if (u + NB_ < 4096) { const int un = u + NB_; const int cn = un >> 4, hn = un & 15; rc_load_wd(p, cn * 64, hn * 64, pwd);
                const size_t gn = (size_t)(cn * 64 + t) * D + hn * 64 + k8; ld8b(WS_(p, Kb) + gn, pkr); ld8b(WS_(p, Ab) + gn, pal); ld8b(WS_(p, Vb) + gn, pv); }
            lds8(cum + t * 64 + k8, ct); lds8(cum + 63 * 64 + k8, ce);
            if (t > 0) lds8(cum + (t - 1) * 64 + k8, cp); else { for (int e = 0; e < 8; ++e) cp[e] = 0.f; }
            float at[8], bt[8], kt[8], be[8], ke[8];
#pragma unroll
            for (int e = 0; e < 8; ++e) { const float ei = __expf(-ct[e]), ee = __expf(ce[e] - ct[e]); at[e] = a[e] * __expf(cp[e]); bt[e] = b[e] * ei; kt[e] = kh[e] * ei; be[e] = b[e] * ee; ke[e] = kh[e] * ee; }
            *(LAS u32x4*)(As + t * RC_LD + k8) = pk8(at); *(LAS u32x4*)(Bs + t * RC_LD + k8) = pk8(bt); *(LAS u32x4*)(Ks + t * RC_LD + k8) = pk8(kt);
            *(LAS u32x4*)(Ke + t * RC_LD + k8) = pk8(ke); *(LAS u32x4*)(Vs + t * RC_LD + k8) = pk8(v);
            const int tq = t & 31, g = (tq & 15) >> 2, j = (tq & 3) + ((tq >> 4) << 2);
#pragma unroll
            for (int e = 0; e < 8; ++e) { const int k = k8 + e; Fimg[(((k >> 4) * 2 + (t >> 5)) * 64 + g * 16 + (k & 15)) * 8 + j] = (bf16_t)f2bf(be[e]); }
            *(LAS u32x4*)(Ts + tid * 8) = (u32x4){0u, 0u, 0u, 0u}; if (tid < 64) *(LAS u32x4*)(Ts + (512 + tid) * 8) = (u32x4){0u, 0u, 0u, 0u};
            if (t == 63) { float gm[8]; for (int e = 0; e < 8; ++e) gm[e] = __expf(ce[e]); *(f32x4*)(WS_(p, RGc) + ub * 64 + k8) = (f32x4){gm[0], gm[1], gm[2], gm[3]}; *(f32x4*)(WS_(p, RGc) + ub * 64 + k8 + 4) = (f32x4){gm[4], gm[5], gm[6], gm[7]}; }
        }
        lds_barrier();
        {
            const int tb = w >> 1;
#pragma unroll
            for (int ii = 0; ii < 2; ++ii) { const int ib = 2 * (w & 1) + ii;
                f32x4 ab = {0.f, 0.f, 0.f, 0.f}, ak = {0.f, 0.f, 0.f, 0.f};
                if (ib <= tb) {
#pragma unroll
                    for (int ks = 0; ks < 2; ++ks) { const bf16x8 af = frag_rm(As, RC_LD, 16 * tb, 32 * ks, lane);
                        ab = MFMA16(af, frag_rm(Bs, RC_LD, 16 * ib, 32 * ks, lane), ab); ak = MFMA16(af, frag_rm(Ks, RC_LD, 16 * ib, 32 * ks, lane), ak); } }
#pragma unroll
                for (int r = 0; r < 4; ++r) { const int t = 16 * tb + 4 * fq + r, i = 16 * ib + fr; const bool keep = i < t;
                    Aab[t * 68 + i] = keep ? ab[r] : 0.f; Aabh[t * RC_LD + i] = (bf16_t)f2bf(keep ? ab[r] : 0.f); Aak[t * RC_LD + i] = (bf16_t)f2bf(keep ? ak[r] : 0.f); } }
            *(u32x4*)(WS_(p, RBf) + ub * 4096 + tid * 8) = *(const LAS u32x4*)(Fimg + tid * 8);
        }
        lds_barrier();
        if (w == 0) {
            const int blk = lane >> 4, jc = lane & 15;
            float Tc[16];
#pragma unroll
            for (int t = 0; t < 16; ++t) {
                float acc = jc == t ? 1.f : 0.f;
#pragma unroll
                for (int i4 = 0; i4 < (t + 3) / 4; ++i4) { const f32x4 a4 = *(const LAS f32x4*)(Aab + (16 * blk + t) * 68 + 16 * blk + i4 * 4);
#pragma unroll
                    for (int e = 0; e < 4; ++e) if (i4 * 4 + e < t) acc += a4[e] * Tc[i4 * 4 + e]; }
                Tc[t] = acc;
            }
#pragma unroll
            for (int t = 0; t < 16; ++t) Ts[(16 * blk + t) * RC_LD + 16 * blk + jc] = (bf16_t)f2bf(Tc[t]);
#pragma unroll
            for (int b = 1; b < 4; ++b) {
                const s16x4 dlo = *(const LAS s16x4*)(Ts + (16 * b + fr) * RC_LD + 16 * b + 4 * fq);
                bf16x8 dfr; dfr[0] = dlo[0]; dfr[1] = dlo[1]; dfr[2] = dlo[2]; dfr[3] = dlo[3]; dfr[4] = 0; dfr[5] = 0; dfr[6] = 0; dfr[7] = 0;
                f32x4 tt_[3];
#pragma unroll
                for (int cbk = 0; cbk < b; ++cbk) {
                    f32x4 x = {0.f, 0.f, 0.f, 0.f};
#pragma unroll
                    for (int ks = 0; ks < 2; ++ks) x = MFMA16(frag_rm(Aabh, RC_LD, 16 * b, 32 * ks, lane), frag_tr(Ts, RC_LD, 32 * ks, 16 * cbk, lane), x);
                    u32x4 xb; xb.x = pk2(x[0], x[1]); xb.y = pk2(x[2], x[3]); xb.z = 0u; xb.w = 0u;
                    tt_[cbk] = MFMA16(dfr, __builtin_bit_cast(bf16x8, xb), ((f32x4){0.f, 0.f, 0.f, 0.f}));
                }
#pragma unroll
                for (int cbk = 0; cbk < b; ++cbk)
#pragma unroll
                    for (int r = 0; r < 4; ++r) Ts[(16 * b + 4 * fq + r) * RC_LD + 16 * cbk + fr] = (bf16_t)f2bf(tt_[cbk][r]);
            }
        } else {
            for (int tl = w - 1; tl < 32; tl += 7) {
                const int rb = (tl & 15) >> 2, vbk = tl & 3; f32x4 acc = {0.f, 0.f, 0.f, 0.f};
                if (tl < 16) {
#pragma unroll
                    for (int ks = 0; ks < 2; ++ks) acc = MFMA16(frag_rm(Aak, RC_LD, 16 * rb, 32 * ks, lane), frag_tr(Vs, RC_LD, 32 * ks, 16 * vbk, lane), acc);
#pragma unroll
                    for (int r = 0; r < 4; ++r) X1[(16 * rb + 4 * fq + r) * RC_LD + 16 * vbk + fr] = (bf16_t)f2bf(acc[r]);
                } else {
#pragma unroll
                    for (int ks = 0; ks < 2; ++ks) acc = MFMA16(frag_tr(Ke, RC_LD, 32 * ks, 16 * rb, lane), frag_tr(Vs, RC_LD, 32 * ks, 16 * vbk, lane), acc);
                    { u32x2 o; o.x = pk2(acc[0], acc[1]); o.y = pk2(acc[2], acc[3]); *(u32x2*)(WS_(p, RNa) + (((ub * 4 + vbk) * 4 + rb) * 64 + lane) * 4) = o; }
                }
            }
        }
        lds_barrier();
#pragma unroll
        for (int q = 0; q < 4; ++q) { const int tl = w * 4 + q; const int tt = (tl & 15) >> 2, cbk = tl & 3; f32x4 acc = {0.f, 0.f, 0.f, 0.f};
            if (tl < 16) {
#pragma unroll
                for (int ks = 0; ks < 2; ++ks) acc = MFMA16(frag_rm(Ts, RC_LD, 16 * tt, 32 * ks, lane), frag_tr(As, RC_LD, 32 * ks, 16 * cbk, lane), acc);
                const int k = 16 * cbk + fr, kq = k & 31, g = (kq & 15) >> 2, j = (kq & 3) + ((kq >> 4) << 2);
#pragma unroll
                for (int r = 0; r < 4; ++r) Wimg[((tt * 2 + (k >> 5)) * 64 + g * 16 + 4 * fq + r) * 8 + j] = (bf16_t)f2bf(acc[r]);
            } else {
#pragma unroll
                for (int ks = 0; ks < 2; ++ks) acc = MFMA16(frag_rm(Ts, RC_LD, 16 * tt, 32 * ks, lane), frag_tr(X1, RC_LD, 32 * ks, 16 * cbk, lane), acc);
                { u32x2 o; o.x = pk2(acc[0], acc[1]); o.y = pk2(acc[2], acc[3]); *(u32x2*)(WS_(p, RUt) + (((ub * 4 + cbk) * 4 + tt) * 64 + lane) * 4) = o; }
            } }
        lds_barrier();
        *(u32x4*)(WS_(p, RWf) + ub * 4096 + tid * 8) = *(const LAS u32x4*)(Wimg + tid * 8);
    }
}

constexpr int RB_SLOT = 20992, RB_R = 6, RB_P = 5;
struct RbOpsA { bf16x8 wf[8]; u32x2 ut[4]; };
struct RbOpsB { bf16x8 bf[8]; u32x2 na[4]; f32x4 gc[4]; };
DEV void rb_read_a(const LAS unsigned char* slot, int lane, RbOpsA& O) {
#pragma unroll
    for (int f = 0; f < 8; ++f) O.wf[f] = *(const LAS bf16x8*)(slot + (f * 64 + lane) * 16);
#pragma unroll
    for (int q = 0; q < 4; ++q) O.ut[q] = *(const LAS u32x2*)(slot + 16384 + (q * 64 + lane) * 8);
}
DEV void rb_read_b(const LAS unsigned char* slot, int lane, RbOpsB& O) {
    const int fq = lane >> 4;
#pragma unroll
    for (int f = 0; f < 8; ++f) O.bf[f] = *(const LAS bf16x8*)(slot + 8192 + (f * 64 + lane) * 16);
#pragma unroll
    for (int q = 0; q < 4; ++q) { O.na[q] = *(const LAS u32x2*)(slot + 18432 + (q * 64 + lane) * 8); O.gc[q] = *(const LAS f32x4*)(slot + 20480 + (16 * q + 4 * fq) * 4); }
}
DEV void phase_rw_chb(const Params& p, int layer, LAS unsigned char* lds) {
    const int tid = tid_(), bid = bid_();
    if (bid >= 64) { if (layer == 0) convert_jobs<14, 16>(p, lds, 64, NB_ - 64); return; }
    const int lane = tid & 63, w = __builtin_amdgcn_readfirstlane(tid >> 6); const int head = bid >> 2, vb = bid & 3;
    auto issue = [&](int c) {
        const size_t ub = (size_t)c * 16 + head; LAS unsigned char* slot = lds + (c % RB_R) * RB_SLOT;
#pragma unroll
        for (int i = 0; i < 3; ++i) { const int pi = (w - 1) * 3 + i;
            if (pi < 8) __builtin_amdgcn_global_load_lds((const unsigned*)(WS_(p, RWf) + ub * 4096 + pi * 512 + lane * 8), (LAS unsigned*)(slot + pi * 1024), 16, 0, 0);
            else if (pi < 16) __builtin_amdgcn_global_load_lds((const unsigned*)(WS_(p, RBf) + ub * 4096 + (pi - 8) * 512 + lane * 8), (LAS unsigned*)(slot + 8192 + (pi - 8) * 1024), 16, 0, 0);
            else if (pi < 18) __builtin_amdgcn_global_load_lds((const unsigned*)(WS_(p, RUt) + (ub * 4 + vb) * 1024 + (pi - 16) * 512 + lane * 8), (LAS unsigned*)(slot + 16384 + (pi - 16) * 1024), 16, 0, 0);
            else if (pi < 20) __builtin_amdgcn_global_load_lds((const unsigned*)(WS_(p, RNa) + (ub * 4 + vb) * 1024 + (pi - 18) * 512 + lane * 8), (LAS unsigned*)(slot + 18432 + (pi - 18) * 1024), 16, 0, 0);
            else __builtin_amdgcn_global_load_lds((const unsigned*)(WS_(p, RGc) + ub * 64 + lane), (LAS unsigned*)(slot + 20480), 4, 0, 0);
        }
    };
    if (w > 0) {
#pragma unroll 1
        for (int c = 0; c < RB_P; ++c) issue(c);
        asm volatile("s_waitcnt vmcnt(9)" ::: "memory");
    }
    __builtin_amdgcn_s_barrier();
    f32x4 s[4]; for (int i = 0; i < 4; ++i) s[i] = (f32x4){0.f, 0.f, 0.f, 0.f};
    RbOpsA cur, nxt; RbOpsB cb_;
    if (w == 0) { rb_read_a(lds, lane, cur); }
#pragma unroll 1
    for (int c = 0; c < 256; ++c) {
        if (w > 0) {
            if (c + RB_P < 256) { issue(c + RB_P); asm volatile("s_waitcnt vmcnt(9)" ::: "memory"); }
            else asm volatile("s_waitcnt vmcnt(0)" ::: "memory");
        } else {
            const size_t ub = (size_t)c * 16 + head;
            rb_read_b(lds + (c % RB_R) * RB_SLOT, lane, cb_);
            rb_read_a(lds + ((c + 1 < 256 ? c + 1 : c) % RB_R) * RB_SLOT, lane, nxt);
#pragma unroll
            for (int kt = 0; kt < 4; ++kt) { u32x2 o; o.x = pk2(s[kt][0], s[kt][1]); o.y = pk2(s[kt][2], s[kt][3]); *(u32x2*)(WS_(p, RS0) + (((ub * 4 + vb) * 4 + kt) * 64 + lane) * 4) = o; }
            bf16x8 sb[2];
#pragma unroll
            for (int ks = 0; ks < 2; ++ks) { u32x4 o; o.x = pk2(s[2 * ks][0], s[2 * ks][1]); o.y = pk2(s[2 * ks][2], s[2 * ks][3]); o.z = pk2(s[2 * ks + 1][0], s[2 * ks + 1][1]); o.w = pk2(s[2 * ks + 1][2], s[2 * ks + 1][3]); sb[ks] = __builtin_bit_cast(bf16x8, o); }
            f32x4 uu[4];
#pragma unroll
            for (int tt = 0; tt < 4; ++tt) { uu[tt] = (f32x4){bflo(cur.ut[tt].x), bfhi(cur.ut[tt].x), bflo(cur.ut[tt].y), bfhi(cur.ut[tt].y)}; uu[tt] = MFMA16(cur.wf[tt * 2], sb[0], uu[tt]); uu[tt] = MFMA16(cur.wf[tt * 2 + 1], sb[1], uu[tt]); }
#pragma unroll
            for (int tt = 0; tt < 4; ++tt) { u32x2 o; o.x = pk2(uu[tt][0], uu[tt][1]); o.y = pk2(uu[tt][2], uu[tt][3]); *(u32x2*)(WS_(p, RUa) + (((ub * 4 + vb) * 4 + tt) * 64 + lane) * 4) = o; }
            bf16x8 ubf[2];
#pragma unroll
            for (int ks = 0; ks < 2; ++ks) { u32x4 o; o.x = pk2(uu[2 * ks][0], uu[2 * ks][1]); o.y = pk2(uu[2 * ks][2], uu[2 * ks][3]); o.z = pk2(uu[2 * ks + 1][0], uu[2 * ks + 1][1]); o.w = pk2(uu[2 * ks + 1][2], uu[2 * ks + 1][3]); ubf[ks] = __builtin_bit_cast(bf16x8, o); }
#pragma unroll
            for (int kt = 0; kt < 4; ++kt) { s[kt] = s[kt] * cb_.gc[kt] + (f32x4){bflo(cb_.na[kt].x), bfhi(cb_.na[kt].x), bflo(cb_.na[kt].y), bfhi(cb_.na[kt].y)}; s[kt] = MFMA16(cb_.bf[kt * 2], ubf[0], s[kt]); s[kt] = MFMA16(cb_.bf[kt * 2 + 1], ubf[1], s[kt]); }
            cur = nxt;
            asm volatile("s_waitcnt lgkmcnt(0)" ::: "memory");
        }
        __builtin_amdgcn_s_barrier();
    }
    asm volatile("s_waitcnt vmcnt(0)" ::: "memory");
}

DEV void phase_rw_chc(const Params& p, int j, LAS unsigned char* lds) {
    const int tid = tid_(), bid = bid_(); const int lane = tid & 63, w = tid >> 6; const int fr = lane & 15, fq = lane >> 4;
    LAS float* cum = (LAS float*)lds;
    LAS float* seg = cum + 64 * 64;
    LAS float* Ys = seg + 8 * 64;
    LAS bf16_t* Rs = (LAS bf16_t*)(Ys + 64 * 68);
    LAS bf16_t* Bs = Rs + 64 * RC_LD; LAS bf16_t* Ks = Bs + 64 * RC_LD; LAS bf16_t* Vs = Ks + 64 * RC_LD; LAS bf16_t* Arb = Vs + 64 * RC_LD; LAS bf16_t* Ark = Arb + 64 * RC_LD;
    float pwd[8], pr[8], pkr[8], pal[8], pv[8], pg[8];
    float kkw[8], kaw[8], rkw[8], lgw[8], lbw[8];
    { const size_t po = (size_t)j * D + (bid & 15) * 64 + (tid & 7) * 8; ld8(p.rw_k_k + po, kkw); ld8(p.rw_k_a + po, kaw); ld8(p.rw_r_k + po, rkw); ld8(p.rw_lnx_g + po, lgw); ld8(p.rw_lnx_b + po, lbw); }
    { const int c = bid >> 4, h = bid & 15; rc_load_wd(p, c * 64, h * 64, pwd);
      const size_t go = (size_t)(c * 64 + (tid >> 3)) * D + h * 64 + (tid & 7) * 8; ld8b(WS_(p, Rb) + go, pr); ld8b(WS_(p, Kb) + go, pkr); ld8b(WS_(p, Ab) + go, pal); ld8b(WS_(p, Vb) + go, pv); ld8b(WS_(p, Gb) + go, pg); }
    for (int u = bid; u < 4096; u += NB_) {
        const int c = u >> 4, h = u & 15; const int t0 = c * 64, cb = h * 64; const size_t ub = (size_t)c * 16 + h;
        const int tt = w & 3;
        u32x2 ufr[2][2][2], sfr[2][2][2];
#pragma unroll
        for (int q = 0; q < 2; ++q)
#pragma unroll
            for (int ks = 0; ks < 2; ++ks)
#pragma unroll
                for (int hf = 0; hf < 2; ++hf) { const size_t o = (((ub * 4 + 2 * (w >> 2) + q) * 4 + 2 * ks + hf) * 64 + lane) * 4;
                    ufr[q][ks][hf] = *(const u32x2*)(WS_(p, RUa) + o); sfr[q][ks][hf] = *(const u32x2*)(WS_(p, RS0) + o); }
        lds_barrier();
        rc_cum_regs(pwd, cum, seg);
#ifdef DBL_CUM
        rc_cum_regs(pwd, cum, seg);
#endif
        const int t = tid >> 3, k8 = (tid & 7) * 8; const size_t go = (size_t)(t0 + t) * D + cb + k8;
        float v[8], gg[8]; float bc;
        {   float r[8], a[8], b[8], kh[8], ct[8];
#pragma unroll
            for (int e = 0; e < 8; ++e) { r[e] = pr[e]; v[e] = pv[e]; gg[e] = pg[e]; }
            lds8(cum + t * 64 + k8, ct);
            rc_prep8(pkr, pal, kkw, kaw, a, b, kh);
            if (u + NB_ < 4096) { const int un = u + NB_; const int cn = un >> 4, hn = un & 15; rc_load_wd(p, cn * 64, hn * 64, pwd);
                const size_t gn = (size_t)(cn * 64 + t) * D + hn * 64 + k8; ld8b(WS_(p, Rb) + gn, pr); ld8b(WS_(p, Kb) + gn, pkr); ld8b(WS_(p, Ab) + gn, pal); ld8b(WS_(p, Vb) + gn, pv); ld8b(WS_(p, Gb) + gn, pg); }
            bc = 0.f;
#pragma unroll
            for (int e = 0; e < 8; ++e) bc += r[e] * kh[e] * rkw[e];
            bc += __shfl_xor(bc, 1); bc += __shfl_xor(bc, 2); bc += __shfl_xor(bc, 4);
#pragma unroll
            for (int e = 0; e < 8; ++e) { const float ei = __expf(-ct[e]); r[e] *= __expf(ct[e]); b[e] *= ei; kh[e] *= ei; }
            *(LAS u32x4*)(Rs + t * RC_LD + k8) = pk8(r); *(LAS u32x4*)(Bs + t * RC_LD + k8) = pk8(b); *(LAS u32x4*)(Ks + t * RC_LD + k8) = pk8(kh); *(LAS u32x4*)(Vs + t * RC_LD + k8) = pk8(v);
        }
        lds_barrier();
#ifdef DBL_S3
#pragma unroll 1
        for (int rep_ = 0; rep_ < 2; ++rep_)
#endif
        {   const int tb = w >> 1;
#pragma unroll
            for (int ii = 0; ii < 2; ++ii) { const int ib = 2 * (w & 1) + ii;
                f32x4 ab = {0.f, 0.f, 0.f, 0.f}, ak = {0.f, 0.f, 0.f, 0.f};
                if (ib <= tb) {
#pragma unroll
                    for (int ks = 0; ks < 2; ++ks) { const bf16x8 af = frag_rm(Rs, RC_LD, 16 * tb, 32 * ks, lane);
                        ab = MFMA16(af, frag_rm(Bs, RC_LD, 16 * ib, 32 * ks, lane), ab); ak = MFMA16(af, frag_rm(Ks, RC_LD, 16 * ib, 32 * ks, lane), ak); } }
#pragma unroll
                for (int r = 0; r < 4; ++r) { const int tr = 16 * tb + 4 * fq + r, i = 16 * ib + fr; const bool keep = i <= tr;
                    Arb[tr * RC_LD + i] = (bf16_t)f2bf(keep ? ab[r] : 0.f); Ark[tr * RC_LD + i] = (bf16_t)f2bf(keep ? ak[r] : 0.f); } }
        }
        lds_barrier();
#ifdef DBL_Y
#pragma unroll 1
        for (int rep_ = 0; rep_ < 2; ++rep_)
#endif
#pragma unroll
        for (int q = 0; q < 2; ++q) { const int vbk = 2 * (w >> 2) + q; f32x4 acc = {0.f, 0.f, 0.f, 0.f};
#pragma unroll
            for (int ks = 0; ks < 2; ++ks) {
                u32x4 bu, bs; bu.x = ufr[q][ks][0].x; bu.y = ufr[q][ks][0].y; bu.z = ufr[q][ks][1].x; bu.w = ufr[q][ks][1].y; bs.x = sfr[q][ks][0].x; bs.y = sfr[q][ks][0].y; bs.z = sfr[q][ks][1].x; bs.w = sfr[q][ks][1].y;
                acc = MFMA16(frag_rm_pi(Rs, RC_LD, 16 * tt, 32 * ks, lane), __builtin_bit_cast(bf16x8, bs), acc);
                acc = MFMA16(frag_rm_pi(Arb, RC_LD, 16 * tt, 32 * ks, lane), __builtin_bit_cast(bf16x8, bu), acc);
                acc = MFMA16(frag_rm(Ark, RC_LD, 16 * tt, 32 * ks, lane), frag_tr(Vs, RC_LD, 32 * ks, 16 * vbk, lane), acc); }
#pragma unroll
            for (int r = 0; r < 4; ++r) Ys[(16 * tt + 4 * fq + r) * 68 + 16 * vbk + fr] = acc[r]; }
        lds_barrier();
        {
            float y[8]; lds8(Ys + t * 68 + k8, y);
            float s1 = 0.f, s2 = 0.f;
#pragma unroll
            for (int e = 0; e < 8; ++e) { s1 += y[e]; s2 += y[e] * y[e]; }
            s1 += __shfl_xor(s1, 1); s1 += __shfl_xor(s1, 2); s1 += __shfl_xor(s1, 4); s2 += __shfl_xor(s2, 1); s2 += __shfl_xor(s2, 2); s2 += __shfl_xor(s2, 4);
            const float mean = s1 * (1.0f / 64.0f), var = s2 * (1.0f / 64.0f) - mean * mean; const float rs = rsqrtf(fmaxf(var, 0.f) + 64e-5f);
            float o[8];
#pragma unroll
            for (int e = 0; e < 8; ++e) o[e] = ((y[e] - mean) * rs * lgw[e] + lbw[e] + bc * v[e]) * gg[e];
            *(u32x4*)(WS_(p, YB) + go) = pk8(o);
        }
    }
}
DEV void phase_ln1(const Params& p, int layer, LAS unsigned char* lds) {
    const int tid = tid_(), bid = bid_(); (void)tid; (void)bid;
    const int lane = tid & 63, wid = tid >> 6; const int fr = lane & 15, fq = lane >> 4;
    LAS float* lgt = (LAS float*)lds;
    LAS int* cnt = (LAS int*)(lgt + 2 * 64 * 48);
    if (tid < 32) cnt[tid] = 0;
    const float* g = p.ln_g + ((size_t)layer * 2 + 0) * D; const float* be = p.ln_b + ((size_t)layer * 2 + 0) * D;
    const float* br = p.moe_b_route + layer * 32; const float* bg = p.moe_b_group + layer * 4;
    f32x4 gwv[4], bwv[4];
#pragma unroll
    for (int q = 0; q < 4; ++q) { gwv[q] = *(const f32x4*)(g + 256 * q + 4 * lane); bwv[q] = *(const f32x4*)(be + 256 * q + 4 * lane); }
    u32x2 rh[4], rm[4];
#pragma unroll
    for (int q = 0; q < 4; ++q) { rh[q] = *(const u32x2*)(WS_(p, Hb) + (size_t)(bid * 64 + wid * 8) * D + 256 * q + 4 * lane); rm[q] = *(const u32x2*)(WS_(p, MIXb) + (size_t)(bid * 64 + wid * 8) * D + 256 * q + 4 * lane); }
#pragma unroll 1
    for (int rr = 0; rr < 8; ++rr) {
        const int t = bid * 64 + wid * 8 + rr; const size_t ro = (size_t)t * D;
        f32x4 z[4], m[4];
#pragma unroll
        for (int q = 0; q < 4; ++q) { z[q] = (f32x4){bflo(rh[q].x), bfhi(rh[q].x), bflo(rh[q].y), bfhi(rh[q].y)}; m[q] = (f32x4){bflo(rm[q].x), bfhi(rm[q].x), bflo(rm[q].y), bfhi(rm[q].y)}; }
        { const size_t rn = (size_t)(rr < 7 ? t + 1 : t) * D;
#pragma unroll
          for (int q = 0; q < 4; ++q) { rh[q] = *(const u32x2*)(WS_(p, Hb) + rn + 256 * q + 4 * lane); rm[q] = *(const u32x2*)(WS_(p, MIXb) + rn + 256 * q + 4 * lane); } }
        float s = 0.f;
#pragma unroll
        for (int q = 0; q < 4; ++q) { z[q] = z[q] * ALPHA + m[q]; s += z[q][0] + z[q][1] + z[q][2] + z[q][3]; }
        const float mean = wave_sum(s) * (1.0f / D);
        float vs = 0.f;
#pragma unroll
        for (int q = 0; q < 4; ++q) { z[q] = z[q] - mean; vs += z[q][0] * z[q][0] + z[q][1] * z[q][1] + z[q][2] * z[q][2] + z[q][3] * z[q][3]; }
        const float rs = rsqrtf(wave_sum(vs) * (1.0f / D) + LN_EPS);
#pragma unroll
        for (int q = 0; q < 4; ++q) {
            st_bf4(WS_(p, H1b) + ro + 256 * q + 4 * lane, z[q] * rs * gwv[q] + bwv[q]);
        }
    }
    asm volatile("s_waitcnt vmcnt(0)" ::: "memory");
    __syncthreads();
    {   const int rt = wid & 3, kh = wid >> 2;
        const bf16_t* Ab = WS_(p, H1b) + (size_t)(bid * 64 + 16 * rt + fr) * D + 512 * kh + 8 * fq;
        const bf16_t* Wb = WS_(p, moe_wr_t) + (size_t)layer * 48 * D + (size_t)fr * D + 512 * kh + 8 * fq;
        f32x4 acc[3]; for (int i = 0; i < 3; ++i) acc[i] = (f32x4){0.f, 0.f, 0.f, 0.f};
#pragma unroll 8
        for (int ks = 0; ks < 16; ++ks) {
            const bf16x8 af = *(const bf16x8*)(Ab + 32 * ks);
#pragma unroll
            for (int ct = 0; ct < 3; ++ct) acc[ct] = MFMA16(af, *(const bf16x8*)(Wb + (size_t)16 * ct * D + 32 * ks), acc[ct]);
        }
#pragma unroll
        for (int ct = 0; ct < 3; ++ct)
#pragma unroll
            for (int r = 0; r < 4; ++r) lgt[(kh * 64 + 16 * rt + 4 * fq + r) * 48 + 16 * ct + fr] = acc[ct][r];
    }
    __syncthreads();
    if (tid < 64) {
        const int t = bid * 64 + tid; const LAS float* L0 = lgt + tid * 48; const LAS float* L1 = lgt + (64 + tid) * 48;
        const float q0 = L0[32] + L1[32] + bg[0], q1 = L0[33] + L1[33] + bg[1], q2 = L0[34] + L1[34] + bg[2], q3 = L0[35] + L1[35] + bg[3];
        int gi = 0; float gm = q0;
        if (q1 > gm) { gm = q1; gi = 1; } if (q2 > gm) { gm = q2; gi = 2; } if (q3 > gm) { gm = q3; gi = 3; }
        const float den = __expf(q0 - gm) + __expf(q1 - gm) + __expf(q2 - gm) + __expf(q3 - gm);
        const float pgrp = __builtin_amdgcn_rcpf(den);
        float l1 = -INFINITY, l2 = -INFINITY; int i1 = 0, i2 = 0;
#pragma unroll 1
        for (int o = 0; o < 8; ++o) { const float v = L0[gi * 8 + o] + L1[gi * 8 + o] + br[gi * 8 + o];
            if (v > l1) { l2 = l1; i2 = i1; l1 = v; i1 = o; } else if (v > l2) { l2 = v; i2 = o; } }
        const float e2 = __expf(l2 - l1), inv = __builtin_amdgcn_rcpf(1.0f + e2);
        const int e0 = gi * 8 + i1, e1 = gi * 8 + i2;
        WS_(p, EIDX)[2 * t] = e0; WS_(p, EIDX)[2 * t + 1] = e1; WS_(p, GATE)[2 * t] = pgrp * inv; WS_(p, GATE)[2 * t + 1] = pgrp * e2 * inv;
        atomicAdd((int*)&cnt[e0], 1); atomicAdd((int*)&cnt[e1], 1);
    }
    __syncthreads();
    if (tid < 32) WS_(p, CNT)[bid * 32 + tid] = cnt[tid];
}

DEV void phase_moe_scatter(const Params& p, LAS unsigned char* lds) {
    const int tid = tid_(), bid = bid_(); (void)tid; (void)bid;
    const int lane = tid & 63, wid = tid >> 6;
    LAS int* part = (LAS int*)lds;
    LAS int* pre = part + 512;
    LAS int* base = pre + 512;
    LAS int* pst = base + 32;
    LAS int* dst = pst + 40;
    LAS int* eid = dst + 128;
    { const int e = tid & 31, part_i = tid >> 5; int tot = 0, prf = 0;
      for (int b = part_i * 16; b < part_i * 16 + 16; ++b) { const int c = WS_(p, CNT)[b * 32 + e]; tot += c; if (b < (int)bid) prf += c; }
      part[part_i * 32 + e] = tot; pre[part_i * 32 + e] = prf; }
    if (tid < 128) eid[tid] = WS_(p, EIDX)[bid * 128 + tid];
    lds_barrier();
    if (tid < 32) { int tot = 0, prf = 0; for (int i = 0; i < 16; ++i) { tot += part[i * 32 + tid]; prf += pre[i * 32 + tid]; } part[tid] = tot; pre[tid] = prf; }
    lds_barrier();
    if (tid == 0) { int acc = 0; for (int e = 0; e < 32; ++e) { pst[e] = acc; acc += ((part[e] + 255) >> 8) << 8; } pst[32] = acc;
        if (bid == 0) { for (int e = 0; e <= 32; ++e) WS_(p, TAB)[e] = pst[e]; WS_(p, TAB)[33] = acc >> 8;
            for (int e = 0; e < 32; ++e) for (int mt = pst[e] >> 8; mt < (pst[e + 1] >> 8); ++mt) WS_(p, TAB)[64 + mt] = e; } }
    lds_barrier();
    if (tid < 32) { int run = pst[tid] + pre[tid]; for (int a = 0; a < 128; ++a) if (eid[a] == tid) dst[a] = run++; }
    lds_barrier();
    if (tid < 128) WS_(p, DEST)[bid * 128 + tid] = dst[tid];
#pragma unroll 4
    for (int a = wid * 16; a < wid * 16 + 16; ++a) {
        const int t = bid * 64 + (a >> 1); const int d = dst[a];
        const u32x4 v0 = *(const u32x4*)(WS_(p, H1b) + (size_t)t * D + lane * 8), v1 = *(const u32x4*)(WS_(p, H1b) + (size_t)t * D + 512 + lane * 8);
        *(u32x4*)(WS_(p, BUF) + (size_t)d * D + lane * 8) = v0; *(u32x4*)(WS_(p, BUF) + (size_t)d * D + 512 + lane * 8) = v1;
    }
}

template <int which> struct SchedMoe {
    const Params* p; int layer; const LAS int* tab;
    DEV bool next(int i, Unit& u) const {
        const int nmt = tab[33]; int pm, pn; if (!pg8::tile_order(i, NB_, bid_(), nmt, 4, pm, pn)) return false;
        const int row0 = pm * 256; const int e = tab[64 + pm];
        if constexpr (which == 0) { u.A = (const char*)(WS_(*p, BUF) + (size_t)row0 * D); u.B = (const char*)(WS_(*p, moe_w1_t) + ((size_t)layer * 32 + e) * 1024 * 1024 + (size_t)pn * 256 * 1024); }
        else { u.A = (const char*)(WS_(*p, ACT) + (size_t)row0 * 512); u.B = (const char*)(WS_(*p, moe_w2_t) + ((size_t)layer * 32 + e) * 1024 * 512 + (size_t)pn * 256 * 512); }
        u.row0 = row0; u.col0 = pn * 256; u.id = e; u.aux = 0; return true;
    }
};
struct EpiMoe1 {
    bf16_t* O;
    DEV void operator()(const AccT& acc, const Unit& u, int wr, int wc, int fr, int fq) const {
#pragma unroll
        for (int ai = 0; ai < 2; ++ai)
#pragma unroll
            for (int m = 0; m < 4; ++m)
#pragma unroll
                for (int n = 0; n < 2; ++n) {
                    const f32x4 gt = acc[ai][0][m][n], up = acc[ai][1][m][n]; f32x4 v;
                    for (int e = 0; e < 4; ++e) v[e] = siluf_(gt[e]) * up[e];
                    const int col = (u.col0 >> 1) + 32 * wc + 16 * n + 4 * fq;
                    st_bf4(O + (size_t)ACC_ROW(u, ai, m) * 512 + col, v); ACC_FENCE;
                }
    }
};
struct EpiMoe2 {
    bf16_t* O;
    DEV void operator()(const AccT& acc, const Unit& u, int wr, int wc, int fr, int fq) const {
        FOR_ACC(ai, bj, m, n) { st_bf4(O + (size_t)ACC_ROW(u, ai, m) * D + ACC_COL(u, bj, n), acc[ai][bj][m][n]); ACC_FENCE; }
    }
};

struct Ln2Raw { u32x2 h[4], a[4], b[4]; float g0, g1; };
DEV void ln2_issue(const Params& p, int t, int lane, Ln2Raw& R, int dpre, float gpre, int tbase) {
    const int i0 = 2 * (t - tbase); const int d0 = __shfl(dpre, i0), d1 = __shfl(dpre, i0 + 1); R.g0 = __shfl(gpre, i0); R.g1 = __shfl(gpre, i0 + 1);
#pragma unroll
    for (int q = 0; q < 4; ++q) { R.h[q] = *(const u32x2*)(WS_(p, H1b) + (size_t)t * D + 256 * q + 4 * lane);
        R.a[q] = *(const u32x2*)(WS_(p, YBUF) + (size_t)d0 * D + 256 * q + 4 * lane); R.b[q] = *(const u32x2*)(WS_(p, YBUF) + (size_t)d1 * D + 256 * q + 4 * lane); }
}
DEV void ln2_finish(const Ln2Raw& R, const f32x4 (&gwv)[4], const f32x4 (&bwv)[4], f32x4 (&z)[4]) {
    float s = 0.f; const float g0 = R.g0, g1 = R.g1;
#pragma unroll
    for (int q = 0; q < 4; ++q) {
        z[q][0] = bflo(R.h[q].x) * ALPHA + g0 * bflo(R.a[q].x) + g1 * bflo(R.b[q].x); z[q][1] = bfhi(R.h[q].x) * ALPHA + g0 * bfhi(R.a[q].x) + g1 * bfhi(R.b[q].x);
        z[q][2] = bflo(R.h[q].y) * ALPHA + g0 * bflo(R.a[q].y) + g1 * bflo(R.b[q].y); z[q][3] = bfhi(R.h[q].y) * ALPHA + g0 * bfhi(R.a[q].y) + g1 * bfhi(R.b[q].y);
        s += z[q][0] + z[q][1] + z[q][2] + z[q][3];
    }
    const float mean = wave_sum(s) * (1.0f / D);
    float vs = 0.f;
#pragma unroll
    for (int q = 0; q < 4; ++q) { z[q] = z[q] - mean; vs += z[q][0] * z[q][0] + z[q][1] * z[q][1] + z[q][2] * z[q][2] + z[q][3] * z[q][3]; }
    const float rs = rsqrtf(wave_sum(vs) * (1.0f / D) + LN_EPS);
#pragma unroll
    for (int q = 0; q < 4; ++q) z[q] = z[q] * rs * gwv[q] + bwv[q];
}
DEV void phase_ln2(const Params& p, int layer, LAS unsigned char* lds) {
    const int tid = tid_(), bid = bid_(); const int lane = tid & 63, wid = tid >> 6; const int fr = lane & 15, fq = lane >> 4;
    const float* g = p.ln_g + ((size_t)layer * 2 + 1) * D; const float* be = p.ln_b + ((size_t)layer * 2 + 1) * D;
    const int nk = layer == DEPTH - 1 ? 3 : (layer + 1) % 3;
    const int nj = (layer + 1) / 3;
    LAS float* lgt = (LAS float*)lds;
    LAS float* w2 = lgt + 2 * 64 * 32;
    if (nk == 2) { for (int i = tid; i < 16 * 512; i += NTHR) w2[i] = p.gl_gk_w2[(size_t)nj * 16 * 512 + i]; }
    const int tfirst = bid * 64 + wid * 8;
    f32x4 z[4], zp[4], gwv[4], bwv[4];
#pragma unroll
    for (int q = 0; q < 4; ++q) { gwv[q] = *(const f32x4*)(g + 256 * q + 4 * lane); bwv[q] = *(const f32x4*)(be + 256 * q + 4 * lane); }
    Ln2Raw R0, R1;
    const int tbase = tfirst > 0 ? tfirst - 1 : 0;
    const int dpre = lane < 18 ? WS_(p, DEST)[2 * tbase + lane] : 0; const float gpre = lane < 18 ? WS_(p, GATE)[2 * tbase + lane] : 0.f;
    ln2_issue(p, tfirst, lane, R0, dpre, gpre, tbase);
    if (nk == 0) { if (tfirst > 0) { ln2_issue(p, tfirst - 1, lane, R1, dpre, gpre, tbase); ln2_finish(R1, gwv, bwv, zp); } else { for (int q = 0; q < 4; ++q) zp[q] = (f32x4){0.f, 0.f, 0.f, 0.f}; } }
#pragma unroll 1
    for (int rr = 0; rr < 8; ++rr) {
        const int t = tfirst + rr; const size_t ro = (size_t)t * D;
        ln2_issue(p, rr < 7 ? t + 1 : t, lane, R1, dpre, gpre, tbase);
        ln2_finish(R0, gwv, bwv, z);
        R0 = R1;
        if (nk == 3) {
#pragma unroll
            for (int q = 0; q < 4; ++q) *(f32x4*)(p.out + ro + 256 * q + 4 * lane) = z[q];
        } else store_row_bf(WS_(p, Hb) + ro, lane, z);
        if (nk == 0) {
            emit_mix6(p, nj, t, lane, z, zp);
#pragma unroll
            for (int q = 0; q < 4; ++q) zp[q] = z[q];
        }
    }
    if (nk == 1 || nk == 2) {
        asm volatile("s_waitcnt vmcnt(0)" ::: "memory");
        __syncthreads();
        const int nct = nk == 1 ? 2 : 1; const int rt = wid & 3, kh = wid >> 2;
        const bf16_t* Ab = WS_(p, Hb) + (size_t)(bid * 64 + 16 * rt + fr) * D + 512 * kh + 8 * fq;
        const bf16_t* Wb = (nk == 1 ? WS_(p, mb_dt_t) : WS_(p, gl_lr_t)) + (size_t)fr * D + 512 * kh + 8 * fq;
        f32x4 acc[2]; acc[0] = (f32x4){0.f, 0.f, 0.f, 0.f}; acc[1] = acc[0];
#pragma unroll 4
        for (int ks = 0; ks < 16; ++ks) {
            const bf16x8 af = *(const bf16x8*)(Ab + 32 * ks);
            acc[0] = MFMA16(af, *(const bf16x8*)(Wb + 32 * ks), acc[0]);
            if (nct == 2) acc[1] = MFMA16(af, *(const bf16x8*)(Wb + (size_t)16 * D + 32 * ks), acc[1]);
        }
#pragma unroll
        for (int ct = 0; ct < 2; ++ct)
#pragma unroll
            for (int r = 0; r < 4; ++r) lgt[(kh * 64 + 16 * rt + 4 * fq + r) * 32 + 16 * ct + fr] = acc[ct][r];
        __syncthreads();
        if (nk == 1) {
#pragma unroll
            for (int i = 0; i < 4; ++i) { const int idx = tid + i * NTHR; const int row = idx >> 5, o = idx & 31;
                WS_(p, DT)[(size_t)(bid * 64 + row) * 32 + o] = softplusf_(lgt[row * 32 + o] + lgt[(64 + row) * 32 + o] + p.mb_dt_bias[nj * 32 + o]); }
        } else {
            const int row = tid >> 3, c0 = (tid & 7) * 64; float lr[16];
#pragma unroll
            for (int o = 0; o < 16; ++o) lr[o] = lgt[row * 32 + o] + lgt[(64 + row) * 32 + o];
#pragma unroll 1
            for (int c4 = 0; c4 < 16; ++c4) { const int c = c0 + 4 * c4; f32x4 a = *(const f32x4*)(p.gl_gk_b + nj * 512 + c);
#pragma unroll
                for (int o = 0; o < 16; ++o) { const f32x4 wv = *(const LAS f32x4*)(w2 + o * 512 + c); a = a + wv * lr[o]; }
                f32x4 r;
#pragma unroll
                for (int e = 0; e < 4; ++e) r[e] = (fminf(a[e], 0.f) - __logf(1.0f + __expf(-fabsf(a[e])))) * (1.0f / 16.0f);
                *(f32x4*)(WS_(p, LA) + (size_t)(bid * 64 + row) * 512 + c) = r; }
        }
    }
}
constexpr int MB_PROJ = 5152;
struct SchedMbIn {
    const Params* p;
    DEV bool next(int i, Unit& u) const {
        int pm, pn; if (!pg8::tile_order(i, NB_, bid_(), 64, 20, pm, pn)) return false;
        u.A = (const char*)(WS_(*p, Hb) + (size_t)pm * 256 * D); u.B = (const char*)(WS_(*p, mb_win_t) + (size_t)pn * 256 * D); u.row0 = pm * 256; u.col0 = pn * 256; u.id = 0; u.aux = 0; return true;
    }
};
struct EpiMbIn {
    const Params* p;
    DEV void operator()(const AccT& acc, const Unit& u, int wr, int wc, int fr, int fq) const {
        const bool isz = u.col0 < 2048; bf16_t* O = WS_(*p, Z) + (isz ? (size_t)0 : (size_t)T * 2048 - 2048); const int ld = isz ? 2048 : 3072;
        FOR_ACC(ai, bj, m, n) { st_bf4(O + (size_t)ACC_ROW(u, ai, m) * ld + ACC_COL(u, bj, n), acc[ai][bj][m][n]); ACC_FENCE; }
    }
};
DEV void phase_mb_conv(const Params& p, int j) {
    const int tid = tid_(), bid = bid_(); (void)tid; (void)bid;
    if (tid >= 384) return;
    const int c0 = tid * 8; const int t0 = bid * 64;
    const float* cw = p.mb_conv_w + (size_t)j * 4 * 3072; const float* cb = p.mb_conv_b + (size_t)j * 3072;
    float w[4][8], b[8];
#pragma unroll
    for (int i = 0; i < 4; ++i) { const f32x4 a = *(const f32x4*)(cw + i * 3072 + c0), bb = *(const f32x4*)(cw + i * 3072 + c0 + 4); for (int e = 0; e < 4; ++e) { w[i][e] = a[e]; w[i][4 + e] = bb[e]; } }
    { const f32x4 a = *(const f32x4*)(cb + c0), bb = *(const f32x4*)(cb + c0 + 4); for (int e = 0; e < 4; ++e) { b[e] = a[e]; b[4 + e] = bb[e]; } }
    float x0[8], x1[8], x2[8], x3[8];
    auto ld = [&](int t, float (&x)[8]) {
        if (t < 0) { for (int e = 0; e < 8; ++e) x[e] = 0.f; return; }
        const u32x4 v = *(const u32x4*)(WS_(p, XBC) + (size_t)t * 3072 + c0);
        x[0] = bflo(v.x); x[1] = bfhi(v.x); x[2] = bflo(v.y); x[3] = bfhi(v.y); x[4] = bflo(v.z); x[5] = bfhi(v.z); x[6] = bflo(v.w); x[7] = bfhi(v.w);
    };
    ld(t0 - 3, x0); ld(t0 - 2, x1); ld(t0 - 1, x2);
#pragma unroll 4
    for (int tt = 0; tt < 64; ++tt) {
        ld(t0 + tt, x3);
        float o[8];
#pragma unroll
        for (int e = 0; e < 8; ++e) o[e] = siluf_(b[e] + w[0][e] * x0[e] + w[1][e] * x1[e] + w[2][e] * x2[e] + w[3][e] * x3[e]);
        u32x4 r; r.x = pk2(o[0], o[1]); r.y = pk2(o[2], o[3]); r.z = pk2(o[4], o[5]); r.w = pk2(o[6], o[7]);
        *(u32x4*)(WS_(p, XC) + (size_t)(t0 + tt) * 3072 + c0) = r;
#pragma unroll
        for (int e = 0; e < 8; ++e) { x0[e] = x1[e]; x1[e] = x2[e]; x2[e] = x3[e]; }
    }
}

DEV void mb_dacs(const Params& p, int j, int c, int g, LAS float* dts, LAS float* dacs) {
    const int tid = tid_(); const int lane = tid & 63, h = tid >> 6;
    const int hh = 8 * g + h; const float a = -__expf(p.mb_a_log[j * 32 + hh]);
    const float d0 = WS_(p, DT)[(size_t)(c * 128 + 2 * lane) * 32 + hh], d1 = WS_(p, DT)[(size_t)(c * 128 + 2 * lane + 1) * 32 + hh];
    const float a0 = d0 * a, a1 = d1 * a;
    float s = a0 + a1;
#pragma unroll
    for (int o = 1; o < 64; o <<= 1) { const float v = __shfl_up(s, o); if (lane >= o) s += v; }
    dts[h * 128 + 2 * lane] = d0; dts[h * 128 + 2 * lane + 1] = d1;
    dacs[h * 128 + 2 * lane] = s - a1; dacs[h * 128 + 2 * lane + 1] = s;
}
constexpr int LDB = 136;
constexpr int LDX = 72;
DEV void ld_tile128(const bf16_t* src, int gld, LAS bf16_t* dst) {
    const int tid = tid_();
    for (int i = tid; i < 128 * 16; i += NTHR) { const int r = i >> 4, c8 = (i & 15) * 8; *(LAS u32x4*)(dst + r * LDB + c8) = *(const u32x4*)(src + (size_t)r * gld + c8); }
}

DEV void phase_mb_states(const Params& p, int j, LAS unsigned char* lds) {
    const int tid = tid_(), bid = bid_(); (void)tid; (void)bid;
    const int lane = tid & 63, w = tid >> 6;
    LAS bf16_t* Bm = (LAS bf16_t*)lds;
    LAS bf16_t* Xh = Bm + 128 * LDB;
    LAS float* dts = (LAS float*)(Xh + 128 * LDX);
    LAS float* dacs = dts + 1024;
    for (int u = bid; u < 512; u += NB_) {
        const int c = u >> 2, g = u & 3; const int t0 = c * 128;
        lds_barrier();
        mb_dacs(p, j, c, g, dts, dacs);
        ld_tile128(WS_(p, XC) + (size_t)t0 * 3072 + 2048 + 128 * g, 3072, Bm);
        lds_barrier();
        if (tid < 8) WS_(p, CD)[(c * 32) + 8 * g + tid] = __expf(dacs[tid * 128 + 127]);
        bf16x8 bfr[4];
#pragma unroll
        for (int ks = 0; ks < 4; ++ks) bfr[ks] = frag_tr(Bm, LDB, 32 * ks, 16 * w, lane);
        for (int h = 0; h < 8; ++h) {
            { const int l = tid >> 2, p0 = (tid & 3) * 16; const float sc = dts[h * 128 + l] * __expf(dacs[h * 128 + 127] - dacs[h * 128 + l]);
              const bf16_t* src = WS_(p, XC) + (size_t)(t0 + l) * 3072 + 64 * (8 * g + h) + p0;
#pragma unroll
              for (int hf = 0; hf < 2; ++hf) { const u32x4 v = *(const u32x4*)(src + 8 * hf); u32x4 r;
                  r.x = pk2(bflo(v.x) * sc, bfhi(v.x) * sc); r.y = pk2(bflo(v.y) * sc, bfhi(v.y) * sc); r.z = pk2(bflo(v.z) * sc, bfhi(v.z) * sc); r.w = pk2(bflo(v.w) * sc, bfhi(v.w) * sc);
                  *(LAS u32x4*)(Xh + l * LDX + p0 + 8 * hf) = r; } }
            lds_barrier();
            f32x4 acc[4];
#pragma unroll
            for (int pb = 0; pb < 4; ++pb) { acc[pb] = (f32x4){0.f, 0.f, 0.f, 0.f};
#pragma unroll
                for (int ks = 0; ks < 4; ++ks) { const bf16x8 af = frag_tr(Xh, LDX, 32 * ks, 16 * pb, lane); acc[pb] = MFMA16(af, bfr[ks], acc[pb]); } }
            bf16_t* S = WS_(p, STATES) + (((size_t)c * 32 + 8 * g + h) * 64) * 128;
#pragma unroll
            for (int pb = 0; pb < 4; ++pb)
#pragma unroll
                for (int r = 0; r < 4; ++r) S[(size_t)(16 * pb + 4 * (lane >> 4) + r) * 128 + 16 * w + (lane & 15)] = (bf16_t)f2bf(acc[pb][r]);
            lds_barrier();
        }
    }
}
DEV void phase_mb_scan(const Params& p) {
    const int tid = tid_(), bid = bid_(); (void)tid; (void)bid;
    const int gid = bid * NTHR + tid;
    if (gid >= 32 * 64 * 64) return;
    const int np = gid & 63, pp = (gid >> 6) & 63, h = gid >> 12; const int n = 2 * np;
    float r0 = 0.f, r1 = 0.f;
    const size_t eo = ((size_t)h * 64 + pp) * 128 + n;
    const size_t fo = (size_t)h * 64 * 128 + fragmajor_off(pp, n, 128);
#pragma unroll 16
    for (int c = 0; c < 128; ++c) {
        const unsigned sraw = *(const unsigned*)(WS_(p, STATES) + (size_t)c * 32 * 64 * 128 + eo); const f32x2 s = {bflo(sraw), bfhi(sraw)};
        const float cd = WS_(p, CD)[c * 32 + h];
        *(unsigned*)(WS_(p, PREV) + (size_t)c * 32 * 64 * 128 + fo) = pk2(r0, r1);
        r0 = r0 * cd + s[0]; r1 = r1 * cd + s[1];
    }
}
DEV void phase_mb_out(const Params& p, int j, LAS unsigned char* lds) {
    const int tid = tid_(), bid = bid_(); (void)tid; (void)bid;
    const int lane = tid & 63, w = tid >> 6; const int fr = lane & 15, fq = lane >> 4;
    LAS bf16_t* Cm = (LAS bf16_t*)lds;
    LAS bf16_t* Bm = Cm + 128 * LDB;
    LAS bf16_t* Xh = Bm + 128 * LDB;
    LAS bf16_t* Mw = Xh + 128 * LDX;
    LAS float* dts = (LAS float*)(Mw + 8 * 16 * LDB);
    LAS float* dacs = dts + 1024;
    LAS bf16_t* Mme = Mw + w * 16 * LDB;
    for (int u = bid; u < 512; u += NB_) {
        const int c = u >> 2, g = u & 3; const int t0 = c * 128;
        lds_barrier();
        mb_dacs(p, j, c, g, dts, dacs);
        ld_tile128(WS_(p, XC) + (size_t)t0 * 3072 + 2048 + 512 + 128 * g, 3072, Cm);
        ld_tile128(WS_(p, XC) + (size_t)t0 * 3072 + 2048 + 128 * g, 3072, Bm);
        lds_barrier();
        f32x4 sc[8]; bf16x8 cf[4];
#pragma unroll
        for (int ks = 0; ks < 4; ++ks) cf[ks] = frag_rm(Cm, LDB, 16 * w, 32 * ks, lane);
#pragma unroll
        for (int sb = 0; sb < 8; ++sb) { sc[sb] = (f32x4){0.f, 0.f, 0.f, 0.f};
#pragma unroll
            for (int ks = 0; ks < 4; ++ks) sc[sb] = MFMA16(cf[ks], frag_rm(Bm, LDB, 16 * sb, 32 * ks, lane), sc[sb]); }
        float ssq = 0.f;
        const int rl = tid >> 2, p0 = (tid & 3) * 16;
        const LAS float* Yrow = (const LAS float*)(Mw + (rl >> 4) * 16 * LDB) + (rl & 15) * 68 + p0;
        LAS float* Yw = (LAS float*)Mme;
        u32x4 xraw[2], zraw[2], xnx[2], znx[2]; bf16x8 pfc[16];
#define MB_LOADH(HH, XR, ZR) do { const int hh_ = 8 * g + (HH); \
            XR[0] = *(const u32x4*)(WS_(p, XC) + (size_t)(t0 + rl) * 3072 + 64 * hh_ + p0); XR[1] = *(const u32x4*)(WS_(p, XC) + (size_t)(t0 + rl) * 3072 + 64 * hh_ + p0 + 8); \
            ZR[0] = *(const u32x4*)(WS_(p, Z) + (size_t)(t0 + rl) * 2048 + 64 * hh_ + p0); ZR[1] = *(const u32x4*)(WS_(p, Z) + (size_t)(t0 + rl) * 2048 + 64 * hh_ + p0 + 8); } while (0)
        MB_LOADH(0, xraw, zraw);
#pragma unroll 1
        for (int h = 0; h < 8; ++h) {
            const int hh = 8 * g + h;
            MB_LOADH(h < 7 ? h + 1 : h, xnx, znx);
            { const bf16_t* pv_ = WS_(p, PREV) + ((size_t)c * 32 + hh) * 64 * 128;
#pragma unroll
              for (int i_ = 0; i_ < 16; ++i_) pfc[i_] = *(const bf16x8*)(pv_ + ((size_t)i_ * 64 + lane) * 8); }
            { const float scl = dts[h * 128 + rl];
#pragma unroll
              for (int hf = 0; hf < 2; ++hf) { const u32x4 v = xraw[hf]; u32x4 r;
                  r.x = pk2(bflo(v.x) * scl, bfhi(v.x) * scl); r.y = pk2(bflo(v.y) * scl, bfhi(v.y) * scl); r.z = pk2(bflo(v.z) * scl, bfhi(v.z) * scl); r.w = pk2(bflo(v.w) * scl, bfhi(v.w) * scl);
                  *(LAS u32x4*)(Xh + rl * LDX + p0 + 8 * hf) = r; } }
            const u32x4 zraw0 = zraw[0], zraw1 = zraw[1];
            float dl[4];
#pragma unroll
            for (int r = 0; r < 4; ++r) dl[r] = dacs[h * 128 + 16 * w + 4 * fq + r];
#pragma unroll
            for (int sb = 0; sb < 8; ++sb) { const int s_ = 16 * sb + fr; const float ds = dacs[h * 128 + s_];
#pragma unroll
                for (int r = 0; r < 4; ++r) { const int l = 16 * w + 4 * fq + r; const float m = (s_ <= l) ? sc[sb][r] * __expf(dl[r] - ds) : 0.f; Mme[(4 * fq + r) * LDB + s_] = (bf16_t)f2bf(m); } }
            lds_barrier();
            bf16x8 mf[4];
#pragma unroll
            for (int ks = 0; ks < 4; ++ks) mf[ks] = frag_rm(Mme, LDB, 0, 32 * ks, lane);
            f32x4 yv[4];
#pragma unroll
            for (int pb = 0; pb < 4; ++pb) {
                f32x4 a = {0.f, 0.f, 0.f, 0.f}, o = {0.f, 0.f, 0.f, 0.f};
#pragma unroll
                for (int ks = 0; ks < 4; ++ks) {
                    a = MFMA16(mf[ks], frag_tr(Xh, LDX, 32 * ks, 16 * pb, lane), a);
                    o = MFMA16(cf[ks], pfc[pb * 4 + ks], o);
                }
#pragma unroll
                for (int r = 0; r < 4; ++r) a[r] += o[r] * __expf(dl[r]);
                yv[pb] = a;
            }
#pragma unroll
            for (int pb = 0; pb < 4; ++pb)
#pragma unroll
                for (int r = 0; r < 4; ++r) Yw[(4 * fq + r) * 68 + 16 * pb + fr] = yv[pb][r];
            lds_barrier();
            {
                const float dsk = p.mb_d[j * 32 + hh]; const float* ng = p.mb_norm_g + (size_t)j * 2048 + 64 * hh + p0;
                float y[16], xs[16], zz[16];
#pragma unroll
                for (int q = 0; q < 4; ++q) { const f32x4 t4 = *(const LAS f32x4*)(Yrow + 4 * q); y[4 * q] = t4[0]; y[4 * q + 1] = t4[1]; y[4 * q + 2] = t4[2]; y[4 * q + 3] = t4[3]; }
                xs[0] = bflo(xraw[0].x); xs[1] = bfhi(xraw[0].x); xs[2] = bflo(xraw[0].y); xs[3] = bfhi(xraw[0].y); xs[4] = bflo(xraw[0].z); xs[5] = bfhi(xraw[0].z); xs[6] = bflo(xraw[0].w); xs[7] = bfhi(xraw[0].w);
                xs[8] = bflo(xraw[1].x); xs[9] = bfhi(xraw[1].x); xs[10] = bflo(xraw[1].y); xs[11] = bfhi(xraw[1].y); xs[12] = bflo(xraw[1].z); xs[13] = bfhi(xraw[1].z); xs[14] = bflo(xraw[1].w); xs[15] = bfhi(xraw[1].w);
                zz[0] = bflo(zraw0.x); zz[1] = bfhi(zraw0.x); zz[2] = bflo(zraw0.y); zz[3] = bfhi(zraw0.y); zz[4] = bflo(zraw0.z); zz[5] = bfhi(zraw0.z); zz[6] = bflo(zraw0.w); zz[7] = bfhi(zraw0.w);
                zz[8] = bflo(zraw1.x); zz[9] = bfhi(zraw1.x); zz[10] = bflo(zraw1.y); zz[11] = bfhi(zraw1.y); zz[12] = bflo(zraw1.z); zz[13] = bfhi(zraw1.z); zz[14] = bflo(zraw1.w); zz[15] = bfhi(zraw1.w);
                float o[16];
#pragma unroll
                for (int q = 0; q < 4; ++q) { const f32x4 n4 = *(const f32x4*)(ng + 4 * q);
#pragma unroll
                    for (int e = 0; e < 4; ++e) { const int i = 4 * q + e; const float v = (y[i] + xs[i] * dsk) * siluf_(zz[i]); ssq += v * v; o[i] = v * n4[e]; } }
                bf16_t* dst = WS_(p, YB) + (size_t)(t0 + rl) * 2048 + 64 * hh + p0;
                u32x4 w0, w1; w0.x = pk2(o[0], o[1]); w0.y = pk2(o[2], o[3]); w0.z = pk2(o[4], o[5]); w0.w = pk2(o[6], o[7]); w1.x = pk2(o[8], o[9]); w1.y = pk2(o[10], o[11]); w1.z = pk2(o[12], o[13]); w1.w = pk2(o[14], o[15]);
                *(u32x4*)dst = w0; *(u32x4*)(dst + 8) = w1;
            }
            xraw[0] = xnx[0]; xraw[1] = xnx[1]; zraw[0] = znx[0]; zraw[1] = znx[1];
            lds_barrier();
        }
#undef MB_LOADH
        ssq += __shfl_xor(ssq, 1); ssq += __shfl_xor(ssq, 2);
        const float rstd = rsqrtf(ssq * (1.0f / 512.0f) + 1e-5f);
#pragma unroll 1
        for (int h = 0; h < 8; ++h) {
            bf16_t* dst = WS_(p, YB) + (size_t)(t0 + rl) * 2048 + 64 * (8 * g + h) + p0;
#pragma unroll
            for (int hf = 0; hf < 2; ++hf) { const u32x4 v = *(const u32x4*)(dst + 8 * hf); u32x4 r;
                r.x = pk2(bflo(v.x) * rstd, bfhi(v.x) * rstd); r.y = pk2(bflo(v.y) * rstd, bfhi(v.y) * rstd); r.z = pk2(bflo(v.z) * rstd, bfhi(v.z) * rstd); r.w = pk2(bflo(v.w) * rstd, bfhi(v.w) * rstd);
                *(u32x4*)(dst + 8 * hf) = r; }
        }
    }
}
constexpr int GL_PROJ = 3088;
constexpr int LDV = 264;
struct SchedGlIn {
    const Params* p;
    DEV bool next(int i, Unit& u) const {
        int pm, pn; if (!pg8::tile_order(i, NB_, bid_(), 64, 12, pm, pn)) return false;
        u.A = (const char*)(WS_(*p, Hb) + (size_t)pm * 256 * D); u.B = (const char*)(WS_(*p, gl_win_t) + (size_t)pn * 256 * D); u.row0 = pm * 256; u.col0 = pn * 256; u.id = 0; u.aux = 0; return true;
    }
};
struct EpiGlIn {
    const Params* p;
    DEV void operator()(const AccT& acc, const Unit& u, int wr, int wc, int fr, int fq) const {
        FOR_ACC(ai, bj, m, n) { st_bf4(WS_(*p, QKVG) + (size_t)ACC_ROW(u, ai, m) * 3072 + ACC_COL(u, bj, n), acc[ai][bj][m][n]); ACC_FENCE; }
    }
};
DEV void gl_bcs(const Params& p, int n, int h, LAS float* bcs) {
    const int tid = tid_();
    for (int i = tid; i < 64 * 32; i += NTHR) { const int r = i >> 5, c4 = (i & 31) * 4; *(LAS f32x4*)(bcs + r * 128 + c4) = *(const f32x4*)(WS_(p, LA) + (size_t)(n * 64 + r) * 512 + 128 * h + c4); }
    lds_barrier();
    if (tid < 128) { float s = 0.f; for (int r = 0; r < 64; ++r) { s += bcs[r * 128 + tid]; bcs[r * 128 + tid] = s; } }
    lds_barrier();
}
DEV void phase_gl_kv(const Params& p, LAS unsigned char* lds) {
    const int tid = tid_(), bid = bid_(); (void)tid; (void)bid;
    const int lane = tid & 63, w = tid >> 6;
    LAS float* bcs = (LAS float*)lds;
    LAS bf16_t* Ke = (LAS bf16_t*)(bcs + 64 * 128);
    LAS bf16_t* Vs = Ke + 64 * LDB;
    for (int u = bid; u < 1024; u += NB_) {
        const int n = u >> 2, h = u & 3; const int t0 = n * 64;
        lds_barrier();
        gl_bcs(p, n, h, bcs);
        for (int i = tid; i < 64 * 16; i += NTHR) { const int r = i >> 4, c8 = (i & 15) * 8;
            const u32x4 v = *(const u32x4*)(WS_(p, QKVG) + (size_t)(t0 + r) * 3072 + 512 + 128 * h + c8); float f[8];
            f[0] = bflo(v.x); f[1] = bfhi(v.x); f[2] = bflo(v.y); f[3] = bfhi(v.y); f[4] = bflo(v.z); f[5] = bfhi(v.z); f[6] = bflo(v.w); f[7] = bfhi(v.w);
#pragma unroll
            for (int e = 0; e < 8; ++e) f[e] *= __expf(bcs[63 * 128 + c8 + e] - bcs[r * 128 + c8 + e]);
            u32x4 o; o.x = pk2(f[0], f[1]); o.y = pk2(f[2], f[3]); o.z = pk2(f[4], f[5]); o.w = pk2(f[6], f[7]);
            *(LAS u32x4*)(Ke + r * LDB + c8) = o; }
        for (int i = tid; i < 64 * 32; i += NTHR) { const int r = i >> 5, c8 = (i & 31) * 8; *(LAS u32x4*)(Vs + r * LDV + c8) = *(const u32x4*)(WS_(p, QKVG) + (size_t)(t0 + r) * 3072 + 1024 + 256 * h + c8); }
        if (tid < 128) WS_(p, CDG)[((size_t)n * 4 + h) * 128 + tid] = __expf(bcs[63 * 128 + tid]);
        lds_barrier();
        bf16x8 af[2];
#pragma unroll
        for (int ks = 0; ks < 2; ++ks) af[ks] = frag_tr(Ke, LDB, 32 * ks, 16 * w, lane);
        bf16_t* O = WS_(p, STATES) + (((size_t)n * 4 + h) * 128) * 256;
#pragma unroll
        for (int vb = 0; vb < 16; ++vb) {
            f32x4 acc = {0.f, 0.f, 0.f, 0.f};
#pragma unroll
            for (int ks = 0; ks < 2; ++ks) acc = MFMA16(af[ks], frag_tr(Vs, LDV, 32 * ks, 16 * vb, lane), acc);
#pragma unroll
            for (int r = 0; r < 4; ++r) O[(size_t)(16 * w + 4 * (lane >> 4) + r) * 256 + 16 * vb + (lane & 15)] = (bf16_t)f2bf(acc[r]);
        }
    }
}
DEV void phase_gl_scan(const Params& p) {
    const int tid = tid_(), bid = bid_(); (void)tid; (void)bid;
    const int gid = bid * NTHR + tid;
    if (gid >= 4 * 64 * 256) return;
    const int v = gid & 255, kp = (gid >> 8) & 63, h = gid >> 14; const int k = 2 * kp;
    float r0 = 0.f, r1 = 0.f;
    const size_t fo = (size_t)h * 128 * 256 + fragmajor_off(v, k, 128);
#pragma unroll 16
    for (int n = 0; n < 256; ++n) {
        const bf16_t* S = WS_(p, STATES) + (((size_t)n * 4 + h) * 128) * 256;
        const float s0 = bf2f(S[(size_t)k * 256 + v]), s1 = bf2f(S[(size_t)(k + 1) * 256 + v]);
        const f32x2 cd = *(const f32x2*)(WS_(p, CDG) + ((size_t)n * 4 + h) * 128 + k);
        *(unsigned*)(WS_(p, PREV) + (size_t)n * 4 * 128 * 256 + fo) = pk2(r0, r1);
        r0 = r0 * cd[0] + s0; r1 = r1 * cd[1] + s1;
    }
}
DEV void phase_gl_out(const Params& p, int j, LAS unsigned char* lds) {
    const int tid = tid_(), bid = bid_(); (void)tid; (void)bid;
    const int lane = tid & 63, w = tid >> 6; const int fr = lane & 15, fq = lane >> 4;
    LAS float* bcs = (LAS float*)lds;
    LAS bf16_t* Qs = (LAS bf16_t*)(bcs + 64 * 128);
    LAS bf16_t* Ks = Qs + 64 * LDB;
    LAS bf16_t* Vs = Ks + 64 * LDB;
    LAS bf16_t* At = Vs + 64 * LDV;
    LAS float* red = (LAS float*)(At + 64 * LDX);
    for (int u = bid; u < 1024; u += NB_) {
        const int n = u >> 2, h = u & 3; const int t0 = n * 64;
        lds_barrier();
        gl_bcs(p, n, h, bcs);
        for (int i = tid; i < 64 * 16; i += NTHR) { const int r = i >> 4, c8 = (i & 15) * 8;
            const u32x4 vq = *(const u32x4*)(WS_(p, QKVG) + (size_t)(t0 + r) * 3072 + 128 * h + c8), vk = *(const u32x4*)(WS_(p, QKVG) + (size_t)(t0 + r) * 3072 + 512 + 128 * h + c8);
            float fq_[8], fk_[8];
            fq_[0] = bflo(vq.x); fq_[1] = bfhi(vq.x); fq_[2] = bflo(vq.y); fq_[3] = bfhi(vq.y); fq_[4] = bflo(vq.z); fq_[5] = bfhi(vq.z); fq_[6] = bflo(vq.w); fq_[7] = bfhi(vq.w);
            fk_[0] = bflo(vk.x); fk_[1] = bfhi(vk.x); fk_[2] = bflo(vk.y); fk_[3] = bfhi(vk.y); fk_[4] = bflo(vk.z); fk_[5] = bfhi(vk.z); fk_[6] = bflo(vk.w); fk_[7] = bfhi(vk.w);
#pragma unroll
            for (int e = 0; e < 8; ++e) { const float b = bcs[r * 128 + c8 + e]; fq_[e] *= __expf(b) * 0.08838834764831845f; fk_[e] *= __expf(-b); }
            u32x4 o; o.x = pk2(fq_[0], fq_[1]); o.y = pk2(fq_[2], fq_[3]); o.z = pk2(fq_[4], fq_[5]); o.w = pk2(fq_[6], fq_[7]);
            *(LAS u32x4*)(Qs + r * LDB + c8) = o;
            o.x = pk2(fk_[0], fk_[1]); o.y = pk2(fk_[2], fk_[3]); o.z = pk2(fk_[4], fk_[5]); o.w = pk2(fk_[6], fk_[7]);
            *(LAS u32x4*)(Ks + r * LDB + c8) = o; }
        for (int i = tid; i < 64 * 32; i += NTHR) { const int r = i >> 5, c8 = (i & 31) * 8; *(LAS u32x4*)(Vs + r * LDV + c8) = *(const u32x4*)(WS_(p, QKVG) + (size_t)(t0 + r) * 3072 + 1024 + 256 * h + c8); }
        lds_barrier();
        { const int ib = w >> 1;
#pragma unroll
          for (int jj = 0; jj < 2; ++jj) { const int jb = 2 * (w & 1) + jj; f32x4 a = {0.f, 0.f, 0.f, 0.f};
#pragma unroll
              for (int ks = 0; ks < 4; ++ks) a = MFMA16(frag_rm(Qs, LDB, 16 * ib, 32 * ks, lane), frag_rm(Ks, LDB, 16 * jb, 32 * ks, lane), a);
#pragma unroll
              for (int r = 0; r < 4; ++r) { const int i = 16 * ib + 4 * fq + r, jx = 16 * jb + fr; At[i * LDX + jx] = (bf16_t)f2bf(jx <= i ? a[r] : 0.f); } } }
        lds_barrier();
        f32x4 o[4][2];
        const bf16_t* pv = WS_(p, PREV) + ((size_t)n * 4 + h) * 128 * 256;
#pragma unroll
        for (int vv = 0; vv < 2; ++vv) { const int vb = 2 * w + vv;
            bf16x8 bi[2], bp[4];
#pragma unroll
            for (int ks = 0; ks < 2; ++ks) bi[ks] = frag_tr(Vs, LDV, 32 * ks, 16 * vb, lane);
#pragma unroll
            for (int ks = 0; ks < 4; ++ks) bp[ks] = *(const bf16x8*)(pv + ((size_t)(vb * 4 + ks) * 64 + lane) * 8);
#pragma unroll
            for (int ib = 0; ib < 4; ++ib) { f32x4 a = {0.f, 0.f, 0.f, 0.f};
#pragma unroll
                for (int ks = 0; ks < 2; ++ks) a = MFMA16(frag_rm(At, LDX, 16 * ib, 32 * ks, lane), bi[ks], a);
#pragma unroll
                for (int ks = 0; ks < 4; ++ks) a = MFMA16(frag_rm(Qs, LDB, 16 * ib, 32 * ks, lane), bp[ks], a);
                o[ib][vv] = a; } }
#pragma unroll
        for (int ib = 0; ib < 4; ++ib)
#pragma unroll
            for (int r = 0; r < 4; ++r) { float s = o[ib][0][r] * o[ib][0][r] + o[ib][1][r] * o[ib][1][r]; s = sum16(s); if (fr == 0) red[w * 64 + 16 * ib + 4 * fq + r] = s; }
        lds_barrier();
        {   LAS bf16_t* Os = (LAS bf16_t*)bcs;
#pragma unroll
            for (int ib = 0; ib < 4; ++ib)
#pragma unroll
                for (int vv = 0; vv < 2; ++vv)
#pragma unroll
                    for (int r = 0; r < 4; ++r) Os[(16 * ib + 4 * fq + r) * LDV + 32 * w + 16 * vv + fr] = (bf16_t)f2bf(o[ib][vv][r]);
            lds_barrier();
            const int row = tid >> 3, c0 = (tid & 7) * 32; const int t = t0 + row; float s = 0.f;
#pragma unroll
            for (int ww = 0; ww < 8; ++ww) s += red[ww * 64 + row];
            const float rs = rsqrtf(s * (1.0f / 256.0f) + 1e-5f);
#pragma unroll
            for (int q = 0; q < 4; ++q) {
                const u32x4 ov = *(const LAS u32x4*)(Os + row * LDV + c0 + 8 * q), gv = *(const u32x4*)(WS_(p, QKVG) + (size_t)t * 3072 + 2048 + 256 * h + c0 + 8 * q);
                const f32x4 n0 = *(const f32x4*)(p.gl_norm_g + j * 256 + c0 + 8 * q), n1 = *(const f32x4*)(p.gl_norm_g + j * 256 + c0 + 8 * q + 4);
                float r8[8];
                r8[0] = bflo(ov.x) * rs * n0[0] * siluf_(bflo(gv.x)); r8[1] = bfhi(ov.x) * rs * n0[1] * siluf_(bfhi(gv.x)); r8[2] = bflo(ov.y) * rs * n0[2] * siluf_(bflo(gv.y)); r8[3] = bfhi(ov.y) * rs * n0[3] * siluf_(bfhi(gv.y));
                r8[4] = bflo(ov.z) * rs * n1[0] * siluf_(bflo(gv.z)); r8[5] = bfhi(ov.z) * rs * n1[1] * siluf_(bfhi(gv.z)); r8[6] = bflo(ov.w) * rs * n1[2] * siluf_(bflo(gv.w)); r8[7] = bfhi(ov.w) * rs * n1[3] * siluf_(bfhi(gv.w));
                u32x4 wv; wv.x = pk2(r8[0], r8[1]); wv.y = pk2(r8[2], r8[3]); wv.z = pk2(r8[4], r8[5]); wv.w = pk2(r8[6], r8[7]);
                *(u32x4*)(WS_(p, YB) + (size_t)t * D + 256 * h + c0 + 8 * q) = wv;
            }
        }
    }
}
#define XB_TMO      128
#define XB_XCNT(j)  (256  + 64 * (j))
#define XB_XSUB(j)  (1280 + 64 * (j))
#define XB_XGEN(j)  (2304 + 64 * (j))
#define XB_TOP      3328
#define XB_TOPGEN   3392
#define XCD_BAR_WORDS 3456
#define XB_SPIN_CAP (1u << 22)
DEV unsigned xb_ld(unsigned* p)              { return __hip_atomic_load(p, __ATOMIC_RELAXED, __HIP_MEMORY_SCOPE_AGENT); }
DEV unsigned xb_add(unsigned* p, unsigned v) { return __hip_atomic_fetch_add(p, v, __ATOMIC_RELAXED, __HIP_MEMORY_SCOPE_AGENT); }
DEV unsigned xb_xcc_id() { return (unsigned)__builtin_amdgcn_s_getreg((3 << 11) | 20) & 0xFu; }
#define XB_SPIN(cond, bar) do { unsigned _sp = 0; while (cond) { __builtin_amdgcn_s_sleep(1); \
    if ((++_sp & 255u) == 0u) { if (xb_ld(&(bar)[XB_TMO])) break; if (_sp > XB_SPIN_CAP) { atomicAdd(&(bar)[XB_TMO], 1u); break; } } } } while (0)
struct XcdBarrier { unsigned* bar; unsigned x; volatile LAS unsigned* st; };
DEV XcdBarrier xcd_barrier_post(unsigned* bar, volatile LAS unsigned* st) {
    XcdBarrier b; b.bar = bar; b.x = xb_xcc_id(); b.st = st;
    if (threadIdx.x == 0) (void)xb_add(&bar[XB_XCNT(b.x)], 1u);
    return b;
}
DEV void xcd_barrier_complete(unsigned* bar, unsigned x, unsigned& nloc, unsigned& nx) {
    const unsigned G = gridDim.x * gridDim.y * gridDim.z;
    unsigned sum, cnt, mine, sp = 0u;
    for (;;) {
        sum = 0u; cnt = 0u; mine = 0u;
#pragma unroll
        for (unsigned j = 0; j < 16; ++j) { const unsigned c = xb_ld(&bar[XB_XCNT(j)]); sum += c; cnt += (c > 0u) ? 1u : 0u; mine = (j == x) ? c : mine; }
        if (sum == G) break;
        __builtin_amdgcn_s_sleep(1);
        if ((++sp & 255u) == 0u) { if (xb_ld(&bar[XB_TMO])) break; if (sp > XB_SPIN_CAP) { atomicAdd(&bar[XB_TMO], 1u); break; } }
    }
    nloc = mine > 0u ? mine : 1u; nx = cnt > 0u ? cnt : 1u;
}
DEV void xcd_barrier(const XcdBarrier& b) {
    asm volatile("s_waitcnt vmcnt(0)" ::: "memory");
    __syncthreads();
    if (threadIdx.x == 0) {
        unsigned* bar = b.bar;
        __builtin_amdgcn_s_waitcnt(0);
        unsigned nloc = b.st[0], nx = b.st[1];
        if (nloc == 0u) { xcd_barrier_complete(bar, b.x, nloc, nx); b.st[0] = nloc; b.st[1] = nx; }
        const unsigned old = xb_add(&bar[XB_XSUB(b.x)], 1u);
        const unsigned gen = old / nloc;
        if (old + 1u == (gen + 1u) * nloc) {
            __builtin_amdgcn_fence(__ATOMIC_RELEASE, "agent");
            asm volatile("s_waitcnt vmcnt(0)" ::: "memory");
            const unsigned og = xb_add(&bar[XB_TOP], 1u);
            const unsigned tg = og / nx;
            if (og + 1u == (tg + 1u) * nx) xb_add(&bar[XB_TOPGEN], 1u);
            else XB_SPIN(xb_ld(&bar[XB_TOPGEN]) == tg, bar);
            __builtin_amdgcn_fence(__ATOMIC_ACQUIRE, "agent");
            xb_add(&bar[XB_XGEN(b.x)], 1u);
            asm volatile("s_waitcnt vmcnt(0)" ::: "memory");
        } else {
            XB_SPIN(xb_ld(&bar[XB_XGEN(b.x)]) == gen, bar);
            __builtin_amdgcn_fence(__ATOMIC_ACQUIRE, "agent");
            asm volatile("s_waitcnt vmcnt(0)" ::: "memory");
        }
    }
    __syncthreads();
}

DEV LAS int* moe_tab_to_lds(const Params& p, LAS unsigned char* lds) {
    LAS int* tab = (LAS int*)(lds + pg8::STAGE_BYTES);
    const int tid = tid_();
    if (tid < 256) tab[tid] = __hip_atomic_load(WS_(p, TAB) + tid, __ATOMIC_RELAXED, __HIP_MEMORY_SCOPE_AGENT);
    __syncthreads();
    return tab;
}
DEV void run_phase(const Params& pin, int op, int arg, LAS unsigned char* lds) {
    Params p = pin; asm volatile("" : "+s"(p.ws));
    const int layer = arg; const int jj = layer / 3;
#ifdef ONLY_OP
    if (op != ONLY_OP) return;
#endif
#ifdef OPMASK
    if (!((OPMASK >> op) & 1ull)) return;
#endif
    switch (op) {
    case OP_CONVERT: phase_convert(p, lds);
#ifdef DBG
        if (blockIdx.x == 0 && threadIdx.x < 8) WS_(p, TAB)[200 + threadIdx.x] = 0;
#endif
        break;
    case OP_PRE0: phase_pre0(p); break;
    case OP_RW_GEMM1: { SchedRW1 S{&p, jj}; EpiRW1 E{&p}; pg8::gemm_phase(lds, 1024, S, E); } break;
    case OP_RW_GEMM2: { SchedRW2 S{&p, jj}; EpiRW2 E{&p, jj}; pg8::gemm_phase(lds, 256, S, E); } break;
    case OP_RW_CHA: phase_rw_cha(p, jj, lds); break;
    case OP_RW_CHB: phase_rw_chb(p, layer, lds); break;
    case OP_RW_CHC: phase_rw_chc(p, jj, lds); break;
    case OP_RW_OUT: { SchedOut S{WS_(p, YB), WS_(p, rw_wo_t) + (size_t)jj * D * D, 1024}; EpiOut E{WS_(p, MIXb)}; pg8::gemm_phase(lds, 1024, S, E); } break;
    case OP_LN1: phase_ln1(p, layer, lds); break;
    case OP_MOE_SCATTER: phase_moe_scatter(p, lds); break;
    case OP_MOE_GEMM1: { LAS int* tab = moe_tab_to_lds(p, lds); SchedMoe<0> S{&p, layer, tab}; EpiMoe1 E{WS_(p, ACT)}; pg8::gemm_phase(lds, 1024, S, E); } break;
    case OP_MOE_GEMM2: { LAS int* tab = moe_tab_to_lds(p, lds); SchedMoe<1> S{&p, layer, tab}; EpiMoe2 E{WS_(p, YBUF)}; pg8::gemm_phase(lds, 512, S, E); } break;
    case OP_LN2: phase_ln2(p, layer, lds); break;
    case OP_MB_GEMM_IN: { SchedMbIn S{&p}; EpiMbIn E{&p}; pg8::gemm_phase(lds, 1024, S, E); } break;
    case OP_MB_CONV: phase_mb_conv(p, jj); break;
    case OP_MB_STATES: phase_mb_states(p, jj, lds); break;
    case OP_MB_SCAN: phase_mb_scan(p); break;
    case OP_MB_OUT: phase_mb_out(p, jj, lds); break;
    case OP_MB_GEMM_OUT: { SchedOut S{WS_(p, YB), WS_(p, mb_wout_t) + (size_t)jj * D * 2048, 2048}; EpiOut E{WS_(p, MIXb)}; pg8::gemm_phase(lds, 2048, S, E); } break;
    case OP_GL_GEMM_IN: { SchedGlIn S{&p}; EpiGlIn E{&p}; pg8::gemm_phase(lds, 1024, S, E); } break;
    case OP_GL_KV: phase_gl_kv(p, lds); break;
    case OP_GL_SCAN: phase_gl_scan(p); break;
    case OP_GL_OUT: phase_gl_out(p, jj, lds); break;
    case OP_GL_GEMM_OUT: { SchedOut S{WS_(p, YB), WS_(p, gl_wout_t) + (size_t)jj * D * D, 1024}; EpiOut E{WS_(p, MIXb)}; pg8::gemm_phase(lds, 1024, S, E); } break;
    default: break;
    }
}

constexpr int NPHASES = 2 + 11 + 11 + 10 + 11;
DEV void decode_phase(int ph, int& op, int& layer) {
    if (ph < 2) { op = ph; layer = 0; return; }
    int q = ph - 2; layer = 0;
    if (q >= 11) { q -= 11; layer = 1; if (q >= 11) { q -= 11; layer = 2; if (q >= 10) { q -= 10; layer = 3; } } }
    const int kind = layer % 3; const int nmix = kind == 2 ? 5 : 6;
    if (q < nmix) op = (kind == 0 ? OP_RW_GEMM1 : kind == 1 ? OP_MB_GEMM_IN : OP_GL_GEMM_IN) + q;
    else op = OP_LN1 + (q - nmix);
}

#define X(t, n) t n##_,
template <bool COOP>
__global__ void __launch_bounds__(NTHR, 2) mega(PARAM_LIST(X) const int ph0, const int ph1) {
#undef X
    Params p;
#define X(t, n) p.n = n##_;
    PARAM_LIST(X)
#undef X

    extern __shared__ __attribute__((aligned(16))) unsigned char smem_raw[];
    LAS unsigned char* lds = (LAS unsigned char*)smem_raw;
    if constexpr (COOP) {
        volatile LAS unsigned* st = (volatile LAS unsigned*)(lds + LDS_BYTES - 16);
        if (threadIdx.x == 0) { st[0] = 0u; st[1] = 0u; }
        __syncthreads();
        XcdBarrier xb = xcd_barrier_post(WS_(p, bar), st);
        if (ph0 < 0) cg::this_grid().sync();
        for (int ph = ph0; ph < ph1; ++ph) {
            int op, arg; decode_phase(ph, op, arg);
#ifdef REPEAT_MASK
            const int reps = 1 + (int)((REPEAT_MASK >> op) & 1ull);
#else
            const int reps = 1;
#endif
#pragma unroll 1
            for (int rep = 0; rep < reps; ++rep) {
                run_phase(p, op, arg, lds);
                if (ph + 1 < ph1 || rep + 1 < reps) { xcd_barrier(xb);
#ifdef BAR2
                    xcd_barrier(xb);
#endif
                }
            }
        }
#ifdef DBG
        xcd_barrier(xb);
        { const int code = __hip_atomic_load(WS_(p, TAB) + 200, __ATOMIC_RELAXED, __HIP_MEMORY_SCOPE_AGENT);
          for (size_t i = (size_t)blockIdx.x * NTHR + threadIdx.x; i < (size_t)T * D; i += (size_t)NB_ * NTHR) p.out[i] = 0.f;
          __syncthreads();
          if (blockIdx.x == 0 && threadIdx.x == 0) p.out[0] = sqrtf((float)DBG_DECODE(code) * 1.68e7f); }
#endif
    } else {
        for (int ph = ph0; ph < ph1; ++ph) { int op, arg; decode_phase(ph, op, arg); run_phase(p, op, arg, lds); }
    }
}


extern "C" void kernel_launch(void* const* d_in, const int* in_sizes, int n_in, void* d_out, int out_size, void* d_ws, size_t ws_size, hipStream_t stream) {
    (void)in_sizes; (void)n_in; (void)out_size;
    Params p; std::memset((void*)&p, 0, sizeof(p));
    auto F = [&](int i) { return (const float*)d_in[i]; };
    p.x = F(0); p.ln_g = F(1); p.ln_b = F(2);
    p.rw_mu = F(3); p.rw_w_rkv = F(4); p.rw_w0 = F(5); p.rw_w1 = F(6); p.rw_w2 = F(7); p.rw_a0 = F(8);
    p.rw_a1 = F(9); p.rw_a2 = F(10); p.rw_g1 = F(11); p.rw_g2 = F(12);
    p.rw_k_k = F(13); p.rw_k_a = F(14); p.rw_r_k = F(15); p.rw_lnx_g = F(16); p.rw_lnx_b = F(17); p.rw_w_o = F(18);
    p.mb_w_in = F(19); p.mb_conv_w = F(20); p.mb_conv_b = F(21); p.mb_dt_bias = F(22); p.mb_a_log = F(23); p.mb_d = F(24); p.mb_norm_g = F(25); p.mb_w_out = F(26);
    p.gl_w_in = F(27); p.gl_gk_w2 = F(28); p.gl_gk_b = F(29); p.gl_norm_g = F(30); p.gl_w_out = F(31);
    p.moe_w_group = F(32); p.moe_b_group = F(33); p.moe_w_route = F(34); p.moe_b_route = F(35); p.moe_w_in = F(36); p.moe_w_down = F(37);
    p.out = (float*)d_out;
    p.ws = (char*)d_ws;
    if (WS_TOTAL > ws_size) { fprintf(stderr, "workspace too small: need %zu have %zu\n", (size_t)WS_TOTAL, ws_size); return; }
    unsigned* bar_ptr = (unsigned*)(p.ws + OFF_bar);
    const int np = NPHASES;
#define X(t, n) (void*)&p.n,
#if SINGLE_LAUNCH
    (void)hipFuncSetAttribute((const void*)mega<true>, hipFuncAttributeMaxDynamicSharedMemorySize, LDS_BYTES);
    (void)hipMemsetAsync(bar_ptr, 0, XCD_BAR_WORDS * sizeof(unsigned), stream);
    int ph0 = 0, ph1 = np; void* args[] = {PARAM_LIST(X) (void*)&ph0, (void*)&ph1};
    hipError_t e = hipLaunchCooperativeKernel((const void*)mega<true>, dim3(NBLK), dim3(NTHR), args, LDS_BYTES, stream);
    if (e != hipSuccess) fprintf(stderr, "cooperative launch failed: %s\n", hipGetErrorString(e));
#else
    (void)hipFuncSetAttribute((const void*)mega<false>, hipFuncAttributeMaxDynamicSharedMemorySize, LDS_BYTES);
    for (int ph = 0; ph < np; ++ph) { int ph0 = ph, ph1 = ph + 1; void* args[] = {PARAM_LIST(X) (void*)&ph0, (void*)&ph1};
        hipError_t e = hipLaunchKernel((const void*)mega<false>, dim3(NBLK), dim3(NTHR), args, LDS_BYTES, stream);
        if (e != hipSuccess) fprintf(stderr, "launch failed: %s\n", hipGetErrorString(e)); }
#endif
#undef X
}
```

```cpp
#include <hip/hip_runtime.h>
#include <hip/hip_cooperative_groups.h>
#include <cstdint>
#include <cstdio>
#include <cstring>
namespace cg = cooperative_groups;

typedef unsigned short bf16_t;
typedef short bf16x8 __attribute__((ext_vector_type(8)));
typedef short s16x4 __attribute__((ext_vector_type(4)));
typedef float f32x4 __attribute__((ext_vector_type(4)));
typedef float f32x2 __attribute__((ext_vector_type(2)));
typedef unsigned u32x4 __attribute__((ext_vector_type(4)));
typedef unsigned u32x2 __attribute__((ext_vector_type(2)));
#define LAS __attribute__((address_space(3)))
#define DEV __device__ __forceinline__

constexpr int T = 16384, D = 1024, DEPTH = 4;
constexpr int NTHR = 512, NBLK = 256;
constexpr int LDS_BYTES = 155648;
constexpr float ALPHA = 1.681792830507429f;
constexpr float LN_EPS = 1e-5f;
constexpr int MOE_ROWS = 40960;

DEV int tid_() { int t = threadIdx.x; asm volatile("" : "+v"(t)); return t; }
DEV int bid_() { int b = blockIdx.x; asm volatile("" : "+s"(b)); return b; }
#define NB_ 256
DEV void lds_barrier() { asm volatile("s_waitcnt lgkmcnt(0)" ::: "memory"); __builtin_amdgcn_s_barrier(); asm volatile("" ::: "memory"); }
DEV unsigned f2bf(float f) { unsigned u = __float_as_uint(f); u += 0x7FFFu + ((u >> 16) & 1u); return u >> 16; }
DEV float bf2f(unsigned short b) { return __uint_as_float(((unsigned)b) << 16); }
typedef __bf16 bf16n2 __attribute__((ext_vector_type(2)));
DEV unsigned pk2(float lo, float hi) { f32x2 v = {lo, hi}; bf16n2 b = __builtin_convertvector(v, bf16n2); return __builtin_bit_cast(unsigned, b); }
DEV float bflo(unsigned u) { return __uint_as_float(u << 16); }
DEV float bfhi(unsigned u) { return __uint_as_float(u & 0xFFFF0000u); }
DEV float sigmoidf_(float x) { return 1.0f / (1.0f + __expf(-x)); }
DEV float siluf_(float x) { return x / (1.0f + __expf(-x)); }
DEV float softplusf_(float x) { return fmaxf(x, 0.f) + __logf(1.0f + __expf(-fabsf(x))); }
DEV float tanhf_(float x) { const float e = __expf(-2.0f * fabsf(x)); const float r = (1.0f - e) / (1.0f + e); return x < 0.f ? -r : r; }
DEV float wave_sum(float v) {
#pragma unroll
    for (int o = 32; o > 0; o >>= 1) v += __shfl_xor(v, o);
    return v;
}
DEV float sum16(float v) {
#pragma unroll
    for (int o = 8; o > 0; o >>= 1) v += __shfl_xor(v, o);
    return v;
}
template <int N> DEV float reduce_scatter(float (&v)[N], int lane) {
    int s = 1;
#pragma unroll
    for (int h = N / 2; h >= 1; h >>= 1) {
#pragma unroll
        for (int i = 0; i < h; ++i) {
            const bool up = (lane & s) != 0;
            const float send = up ? v[i] : v[i + h];
            const float keep = up ? v[i + h] : v[i];
            v[i] = keep + __shfl_xor(send, s);
        }
        s <<= 1;
    }
    float r = v[0];
    for (; s < 64; s <<= 1) r += __shfl_xor(r, s);
    return r;
}
template <int N> DEV int rs_index(int lane) {
    int o = 0, s = 1;
#pragma unroll
    for (int h = N / 2; h >= 1; h >>= 1) { if (lane & s) o += h; s <<= 1; }
    return o;
}

DEV bf16x8 frag_rm(const LAS bf16_t* base, int ld, int row0, int k0, int lane) {
    return *(const LAS bf16x8*)(base + (row0 + (lane & 15)) * ld + k0 + 8 * (lane >> 4));
}
DEV bf16x8 frag_tr(const LAS bf16_t* base, int ld, int k0, int c0, int lane) {
    const int g = lane >> 4, i = lane & 15, q = i >> 2, p = i & 3;
    const LAS bf16_t* a = base + (k0 + 8 * g + q) * ld + c0 + 4 * p;
    s16x4 lo = __builtin_amdgcn_ds_read_tr16_b64_v4i16((LAS s16x4*)a);
    s16x4 hi = __builtin_amdgcn_ds_read_tr16_b64_v4i16((LAS s16x4*)(a + 4 * ld));
    bf16x8 r; r[0] = lo[0]; r[1] = lo[1]; r[2] = lo[2]; r[3] = lo[3]; r[4] = hi[0]; r[5] = hi[1]; r[6] = hi[2]; r[7] = hi[3];
    return r;
}
#define MFMA16(a, b, c) __builtin_amdgcn_mfma_f32_16x16x32_bf16((a), (b), (c), 0, 0, 0)
DEV size_t fragmajor_off(int n, int k, int K) { return ((size_t)((n >> 4) * (K >> 5) + (k >> 5)) * 64 + (n & 15) + 16 * ((k & 31) >> 3)) * 8 + (k & 7); }

template <int N> DEV void skinny_group(const f32x4 (&z)[4], const LAS float* wt, int lane, LAS float* outw) {
    float pe[N];
#pragma unroll
    for (int o = 0; o < N; ++o) {
        float a = 0.f;
#pragma unroll
        for (int q = 0; q < 4; ++q) { const f32x4 w = *(const LAS f32x4*)(wt + o * 1028 + 256 * q + 4 * lane); a += z[q][0] * w[0] + z[q][1] * w[1] + z[q][2] * w[2] + z[q][3] * w[3]; }
        pe[o] = a;
    }
    const float r = reduce_scatter<N>(pe, lane);
    if (lane < N) outw[rs_index<N>(lane)] = r;
}
#ifndef SINGLE_LAUNCH
#define SINGLE_LAUNCH 1
#endif
constexpr size_t OFF_bar = 0ull;
constexpr size_t OFF_rw_rkv_t = 13824ull;
constexpr size_t OFF_rw_w1_t = 12596736ull;
constexpr size_t OFF_rw_a1_t = 13645312ull;
constexpr size_t OFF_rw_g1_t = 14693888ull;
constexpr size_t OFF_rw_w2_t = 15742464ull;
constexpr size_t OFF_rw_a2_t = 16791040ull;
constexpr size_t OFF_rw_g2_t = 17839616ull;
constexpr size_t OFF_rw_wo_t = 18888192ull;
constexpr size_t OFF_mb_win_t = 23082496ull;
constexpr size_t OFF_mb_wout_t = 33568256ull;
constexpr size_t OFF_gl_win_t = 37762560ull;
constexpr size_t OFF_gl_wout_t = 44054016ull;
constexpr size_t OFF_moe_w1_t = 46151168ull;
constexpr size_t OFF_moe_w2_t = 314586624ull;
constexpr size_t OFF_H = 448804352ull;
constexpr size_t OFF_H1 = 515913216ull;
constexpr size_t OFF_MIX = 583022080ull;
constexpr size_t OFF_BUF = 650130944ull;
constexpr size_t OFF_ACT = 734017024ull;
constexpr size_t OFF_YBUF = 775960064ull;
constexpr size_t OFF_CNT = 859846144ull;
constexpr size_t OFF_EIDX = 859878912ull;
constexpr size_t OFF_GATE = 860009984ull;
constexpr size_t OFF_DEST = 860141056ull;
constexpr size_t OFF_TAB = 860272128ull;
constexpr size_t OFF_YB = 860273152ull;
constexpr size_t OFF_X6 = 927382016ull;
constexpr size_t OFF_Rr = 1128708608ull;
constexpr size_t OFF_Kk = 1195817472ull;
constexpr size_t OFF_Vv = 1262926336ull;
constexpr size_t OFF_LW = 1330035200ull;
constexpr size_t OFF_Wd = 1355201024ull;
constexpr size_t OFF_Aa = 1422309888ull;
constexpr size_t OFF_Gg = 1489418752ull;
constexpr size_t OFF_RWf = 1556527616ull;
constexpr size_t OFF_RBf = 1590082048ull;
constexpr size_t OFF_RUt = 1623636480ull;
constexpr size_t OFF_RNa = 1657190912ull;
constexpr size_t OFF_RGc = 1690745344ull;
constexpr size_t OFF_RUa = 1691793920ull;
constexpr size_t OFF_RS0 = 1725348352ull;
constexpr size_t OFF_Z = 960936448ull;
constexpr size_t OFF_XBC = 1028045312ull;
constexpr size_t OFF_XC = 1128708608ull;
constexpr size_t OFF_DT = 1229371904ull;
constexpr size_t OFF_STATES = 1231469056ull;
constexpr size_t OFF_CD = 1365686784ull;
constexpr size_t OFF_PREV = 1365703168ull;
constexpr size_t OFF_LA = 1432812032ull;
constexpr size_t OFF_CDG = 1466366464ull;
constexpr size_t OFF_QKVG = OFF_XBC;
constexpr size_t WS_TOTAL = 1758902784ull;
typedef unsigned T_bar;
typedef bf16_t T_rw_rkv_t;
typedef bf16_t T_rw_w1_t;
typedef bf16_t T_rw_a1_t;
typedef bf16_t T_rw_g1_t;
typedef bf16_t T_rw_w2_t;
typedef bf16_t T_rw_a2_t;
typedef bf16_t T_rw_g2_t;
typedef bf16_t T_rw_wo_t;
typedef bf16_t T_mb_win_t;
typedef bf16_t T_mb_wout_t;
typedef bf16_t T_gl_win_t;
typedef bf16_t T_gl_wout_t;
typedef bf16_t T_moe_w1_t;
typedef bf16_t T_moe_w2_t;
typedef float T_H;
typedef float T_H1;
typedef float T_MIX;
typedef bf16_t T_BUF;
typedef bf16_t T_ACT;
typedef bf16_t T_YBUF;
typedef int T_CNT;
typedef int T_EIDX;
typedef float T_GATE;
typedef int T_DEST;
typedef int T_TAB;
typedef bf16_t T_YB;
typedef bf16_t T_X6;
typedef float T_Rr;
typedef float T_Kk;
typedef float T_Vv;
typedef bf16_t T_LW;
typedef float T_Wd;
typedef float T_Aa;
typedef float T_Gg;
typedef bf16_t T_RWf;
typedef bf16_t T_RBf;
typedef bf16_t T_RUt;
typedef bf16_t T_RNa;
typedef float T_RGc;
typedef bf16_t T_RUa;
typedef bf16_t T_RS0;
typedef bf16_t T_Z;
typedef bf16_t T_XBC;
typedef bf16_t T_XC;
typedef float T_DT;
typedef bf16_t T_STATES;
typedef float T_CD;
typedef bf16_t T_PREV;
typedef float T_LA;
typedef float T_CDG;
typedef bf16_t T_QKVG;
#define WS_(P, N) ((T_##N*)((P).ws + OFF_##N))
constexpr size_t OFF_Hb = OFF_H, OFF_H1b = OFF_H1, OFF_MIXb = OFF_MIX;
typedef bf16_t T_Hb; typedef bf16_t T_H1b; typedef bf16_t T_MIXb;
constexpr size_t OFF_moe_wr_t = OFF_H + 33554432ull;
typedef bf16_t T_moe_wr_t;
constexpr size_t OFF_mb_dt_t = OFF_moe_wr_t + 4ull * 48 * 1024 * 2, OFF_gl_lr_t = OFF_mb_dt_t + 32ull * 1024 * 2;
typedef bf16_t T_mb_dt_t; typedef bf16_t T_gl_lr_t;
constexpr size_t OFF_Rb = OFF_Rr, OFF_Kb = OFF_Kk, OFF_Vb = OFF_Vv, OFF_Ab = OFF_Aa, OFF_Gb = OFF_Gg;
typedef bf16_t T_Rb; typedef bf16_t T_Kb; typedef bf16_t T_Vb; typedef bf16_t T_Ab; typedef bf16_t T_Gb;
constexpr size_t OFF_Wb = OFF_Wd; typedef bf16_t T_Wb;
struct ConvJob {
    const float* src; bf16_t* dst;
    int K, N, src_ld, Kpad, Npad, perm, batch;
    long long src_bs, dst_bs;
    DEV int ntiles() const { return (Kpad / 64) * (Npad / 64) * batch; }
};
constexpr int NJOBS = 16;
constexpr int MOE_SPLIT = 40;

#define PARAM_LIST(X) \
    X(const float*, x) X(const float*, ln_g) X(const float*, ln_b) \
    X(const float*, rw_mu) X(const float*, rw_w_rkv) X(const float*, rw_w0) X(const float*, rw_w1) X(const float*, rw_w2) X(const float*, rw_a0) X(const float*, rw_a1) X(const float*, rw_a2) \
    X(const float*, rw_g1) X(const float*, rw_g2) X(const float*, rw_k_k) X(const float*, rw_k_a) X(const float*, rw_r_k) X(const float*, rw_lnx_g) X(const float*, rw_lnx_b) X(const float*, rw_w_o) \
    X(const float*, mb_w_in) X(const float*, mb_conv_w) X(const float*, mb_conv_b) X(const float*, mb_dt_bias) X(const float*, mb_a_log) X(const float*, mb_d) X(const float*, mb_norm_g) X(const float*, mb_w_out) \
    X(const float*, gl_w_in) X(const float*, gl_gk_w2) X(const float*, gl_gk_b) X(const float*, gl_norm_g) X(const float*, gl_w_out) \
    X(const float*, moe_w_group) X(const float*, moe_b_group) X(const float*, moe_w_route) X(const float*, moe_b_route) X(const float*, moe_w_in) X(const float*, moe_w_down) \
    X(float*, out) X(char*, ws)
struct Params {
#define X(t, n) t n;
    PARAM_LIST(X)
#undef X
};

enum Op : unsigned char { OP_CONVERT = 0, OP_PRE0, OP_RW_GEMM1, OP_RW_GEMM2, OP_RW_CHA, OP_RW_CHB, OP_RW_CHC, OP_RW_OUT,
    OP_LN1, OP_MOE_SCATTER, OP_MOE_GEMM1, OP_MOE_GEMM2, OP_LN2,
    OP_MB_GEMM_IN, OP_MB_CONV, OP_MB_STATES, OP_MB_SCAN, OP_MB_OUT, OP_MB_GEMM_OUT,
    OP_GL_GEMM_IN, OP_GL_KV, OP_GL_SCAN, OP_GL_OUT, OP_GL_GEMM_OUT };


DEV ConvJob make_job(const Params& p, int q) {
    const long long DD = (long long)D * D;
    switch (q) {
    case 0: return ConvJob{p.rw_w_rkv, WS_(p, rw_rkv_t), 1024, 1024, 1024, 1024, 1024, 0, 6, DD, DD};
    case 1: return ConvJob{p.rw_w1, WS_(p, rw_w1_t), 1024, 64, 64, 1024, 256, 0, 2, (long long)D * 64, (long long)256 * D};
    case 2: return ConvJob{p.rw_a1, WS_(p, rw_a1_t), 1024, 64, 64, 1024, 256, 0, 2, (long long)D * 64, (long long)256 * D};
    case 3: return ConvJob{p.rw_g1, WS_(p, rw_g1_t), 1024, 160, 160, 1024, 256, 0, 2, (long long)D * 160, (long long)256 * D};
    case 4: return ConvJob{p.rw_w2, WS_(p, rw_w2_t), 64, 1024, 1024, 256, 1024, 0, 2, (long long)64 * D, (long long)D * 256};
    case 5: return ConvJob{p.rw_a2, WS_(p, rw_a2_t), 64, 1024, 1024, 256, 1024, 0, 2, (long long)64 * D, (long long)D * 256};
    case 6: return ConvJob{p.rw_g2, WS_(p, rw_g2_t), 160, 1024, 1024, 256, 1024, 0, 2, (long long)160 * D, (long long)D * 256};
    case 7: return ConvJob{p.rw_w_o, WS_(p, rw_wo_t), 1024, 1024, 1024, 1024, 1024, 0, 2, DD, DD};
    case 8: return ConvJob{p.mb_w_in, WS_(p, mb_win_t), 1024, 5120, 5152, 1024, 5120, 0, 1, 0, 0};
    case 9: return ConvJob{p.mb_w_out, WS_(p, mb_wout_t), 2048, 1024, 1024, 2048, 1024, 0, 1, 0, 0};
    case 10: return ConvJob{p.gl_w_in, WS_(p, gl_win_t), 1024, 3072, 3088, 1024, 3072, 0, 1, 0, 0};
    case 11: return ConvJob{p.gl_w_out, WS_(p, gl_wout_t), 1024, 1024, 1024, 1024, 1024, 0, 1, 0, 0};
    case 12: return ConvJob{p.moe_w_in, WS_(p, moe_w1_t), 1024, 1024, 1024, 1024, 1024, 1, MOE_SPLIT, DD, DD};
    case 13: return ConvJob{p.moe_w_down, WS_(p, moe_w2_t), 512, 1024, 1024, 512, 1024, 0, MOE_SPLIT, (long long)512 * 1024, (long long)1024 * 512};
    case 14: return ConvJob{p.moe_w_in + (size_t)MOE_SPLIT * DD, WS_(p, moe_w1_t) + (size_t)MOE_SPLIT * DD, 1024, 1024, 1024, 1024, 1024, 1, 128 - MOE_SPLIT, DD, DD};
    default: return ConvJob{p.moe_w_down + (size_t)MOE_SPLIT * 512 * 1024, WS_(p, moe_w2_t) + (size_t)MOE_SPLIT * 512 * 1024, 512, 1024, 1024, 512, 1024, 0, 128 - MOE_SPLIT, (long long)512 * 1024, (long long)1024 * 512};
    }
}

template <int J0, int J1> DEV void convert_jobs(const Params& p, LAS unsigned char* lds, int B0, int NBW) {
    const int tid = tid_(), bid = bid_();
    const int lane = tid & 63, wv = tid >> 6; const int gw = (bid - B0) * 8 + wv, NW = NBW * 8;
    LAS bf16_t* tile = (LAS bf16_t*)lds + wv * (64 * 72);
    int tbeg = 0;
#pragma unroll
    for (int j = J0; j < J1; ++j) {
      const ConvJob J = make_job(p, j);
      const int jend = tbeg + J.ntiles();
      const int ti0 = tbeg + ((gw - tbeg) % NW + NW) % NW;
      const int jbeg = tbeg; tbeg = jend;
#pragma unroll 1
      for (int ti = ti0; ti < jend; ti += NW) {
        int local = ti - jbeg;
        const int tk = J.Kpad / 64, tn = J.Npad / 64;
        const int b = local / (tk * tn); local -= b * tk * tn;
        const int nt = local / tk, kt = local - nt * tk;
        const float* src = J.src + (size_t)b * J.src_bs;
        bf16_t* dst = J.dst + (size_t)b * J.dst_bs;
        const int k0 = kt * 64, n0 = nt * 64;
        const int nn = (lane & 15) * 4; const bool nok = n0 + nn < J.N;
        f32x4 v[16];
#pragma unroll
        for (int i = 0; i < 16; ++i) { const int kk = (lane >> 4) + 4 * i; v[i] = (nok && k0 + kk < J.K) ? *(const f32x4*)(src + (size_t)(k0 + kk) * J.src_ld + n0 + nn) : (f32x4){0.f, 0.f, 0.f, 0.f}; }
#pragma unroll
        for (int i = 0; i < 16; ++i) { const int kk = (lane >> 4) + 4 * i;
#pragma unroll
            for (int e = 0; e < 4; ++e) tile[(nn + e) * 72 + kk] = (bf16_t)f2bf(v[i][e]); }
#pragma unroll
        for (int i = 0; i < 8; ++i) { const int r = (lane >> 3) + 8 * i, kc = (lane & 7) * 8;
            int nsrc = n0 + r, ndst = nsrc;
            if (J.perm == 1) { const int up = nsrc >= 512, jj = nsrc - (up ? 512 : 0); ndst = (jj >> 7) * 256 + (up ? 128 : 0) + (jj & 127); }
            *(u32x4*)(dst + (size_t)ndst * J.Kpad + k0 + kc) = *(const LAS u32x4*)(tile + r * 72 + kc); }
      }
    }
}
DEV void phase_convert(const Params& p, LAS unsigned char* lds) {
    const int tid = tid_(), bid = bid_();
    convert_jobs<0, 14>(p, lds, 0, NB_);
    if (bid < 4 * 48) { const int layer = bid / 48, o = bid % 48;
        for (int k = tid; k < D; k += NTHR) { float v = 0.f;
            if (o < 32) v = p.moe_w_route[((size_t)layer * D + k) * 32 + o]; else if (o < 36) v = p.moe_w_group[((size_t)layer * D + k) * 4 + (o - 32)];
            WS_(p, moe_wr_t)[((size_t)layer * 48 + o) * D + k] = (bf16_t)f2bf(v); } }
    else if (bid < 4 * 48 + 32) { const int o = bid - 192;
        for (int k = tid; k < D; k += NTHR) WS_(p, mb_dt_t)[(size_t)o * D + k] = (bf16_t)f2bf(p.mb_w_in[(size_t)k * 5152 + 5120 + o]); }
    else if (bid < 4 * 48 + 48) { const int o = bid - 224;
        for (int k = tid; k < D; k += NTHR) WS_(p, gl_lr_t)[(size_t)o * D + k] = (bf16_t)f2bf(p.gl_w_in[(size_t)k * 3088 + 3072 + o]); }
}
namespace pg8 {
constexpr int BM = 256, BK = 64, HALF = 128, HTB = HALF * BK * 2, STAGE_BYTES = 8 * HTB;
DEV int lds_byte(int r, int c) { const int st = (r >> 4) * 2 + (c >> 5), rr = r & 15, cc = c & 31, ob = rr * 64 + cc * 2; return st * 1024 + (ob ^ (((ob >> 9) & 1) << 5)); }
DEV void stage_rc(int b, int& R, int& C) { const int st = b / 1024, sb = b % 1024, swz = sb ^ (((sb >> 9) & 1) << 5); R = (st >> 1) * 16 + swz / 64; C = (st & 1) * 32 + (swz % 64) / 2; }

struct Unit { const char* A; const char* B; int row0, col0, id, aux; };

DEV bool tile_order(int i, int G, int c, int nM, int nN, int& pm, int& pn) {
    const int nwg = nM * nN; const long L = (long)i * G + c; if (L >= nwg) return false;
    int wgid = (int)L; { const int q = nwg / 8, r = nwg % 8, xcd = wgid % 8, off = wgid / 8; wgid = (xcd < r ? xcd * (q + 1) : r * (q + 1) + (xcd - r) * q) + off; }
    const int nig = 8 * nN, gid = wgid / nig, fm = gid * 8, gsz = (nM - fm) < 8 ? (nM - fm) : 8;
    pm = fm + ((wgid % nig) % gsz); pn = (wgid % nig) / gsz; return true;
}

template <class Epi, class Sched>
DEV void gemm_phase(LAS unsigned char* lds, const int K, const Sched& S, const Epi& E) {
    const int tid = tid_(), wid = __builtin_amdgcn_readfirstlane(tid >> 6), lane = tid & 63, wr = wid >> 2, wc = wid & 3, fr = lane & 15, fq = lane >> 4;
    const int nt = K / BK;
    unsigned voff[2];
#pragma unroll
    for (int i = 0; i < 2; ++i) { int R, C; stage_rc(tid * 16 + i * 8192, R, C); voff[i] = (unsigned)(R * K + C) * 2u; }
    const size_t kstep = (size_t)(BK * 2);
    const size_t hstep = (size_t)HALF * K * 2;
    const unsigned ldsw = (unsigned)wid * 1024u;
    const int aoff = lds_byte(wr * 64 + fr, fq * 8), boff = lds_byte(wc * 32 + fr, fq * 8);
#define PG8_SA(b, h) (((b) * 2 + (h)) * HTB)
#define PG8_SB(b, h) ((4 + (b) * 2 + (h)) * HTB)
#define PG8_STAGE(bufoff, gbase) do { _Pragma("unroll") for (int _i = 0; _i < 2; ++_i) \
        __builtin_amdgcn_global_load_lds((const unsigned*)((const char*)(gbase) + voff[_i]), (LAS unsigned*)(lds + (bufoff) + ldsw + _i * 8192), 16, 0, 0); } while (0)
#define PG8_LDA(dst, b, h) do { _Pragma("unroll") for (int m = 0; m < 4; ++m) _Pragma("unroll") for (int k = 0; k < 2; ++k) dst[m][k] = *(const LAS bf16x8*)(lds + PG8_SA(b, h) + aoff + m * 2048 + k * 1024); } while (0)
#define PG8_LDB(dst, b, h) do { _Pragma("unroll") for (int n = 0; n < 2; ++n) _Pragma("unroll") for (int k = 0; k < 2; ++k) dst[n][k] = *(const LAS bf16x8*)(lds + PG8_SB(b, h) + boff + n * 2048 + k * 1024); } while (0)
#define PG8_MMA(ai, bj, At, Bt) do { __builtin_amdgcn_s_setprio(1); _Pragma("unroll") for (int m = 0; m < 4; ++m) _Pragma("unroll") for (int n = 0; n < 2; ++n) _Pragma("unroll") for (int k = 0; k < 2; ++k) \
        acc[ai][bj][m][n] = __builtin_amdgcn_mfma_f32_16x16x32_bf16(Bt[n][k], At[m][k], acc[ai][bj][m][n], 0, 0, 0); __builtin_amdgcn_s_setprio(0); } while (0)
#define PG8_WAIT_V(n) asm volatile("s_waitcnt vmcnt(" #n ")" ::: "memory")
#define PG8_WAIT_L(n) asm volatile("s_waitcnt lgkmcnt(" #n ")" ::: "memory")
#define PG8_BAR __builtin_amdgcn_s_barrier()
#define PG8_SCHED __builtin_amdgcn_sched_barrier(0)
    Unit cur, nxt; int ui = 0;
    if (!S.next(0, cur)) return;
    f32x4 acc[2][2][4][2];
#pragma unroll
    for (int a = 0; a < 2; ++a)
#pragma unroll
        for (int b = 0; b < 2; ++b)
#pragma unroll
            for (int m = 0; m < 4; ++m)
#pragma unroll
                for (int n = 0; n < 2; ++n) acc[a][b][m][n] = (f32x4){0.f, 0.f, 0.f, 0.f};
    bf16x8 At[4][2], B0[2][2], B1[2][2];
    const char* cA = cur.A; const char* cB = cur.B;
    PG8_STAGE(PG8_SB(0, 0), cB); PG8_STAGE(PG8_SA(0, 0), cA); PG8_STAGE(PG8_SB(0, 1), cB + hstep); PG8_STAGE(PG8_SA(0, 1), cA + hstep);
    if (wr == 1) PG8_BAR;
    PG8_WAIT_V(4); PG8_BAR;
    PG8_STAGE(PG8_SB(1, 0), cB + kstep); PG8_STAGE(PG8_SA(1, 0), cA + kstep); PG8_STAGE(PG8_SB(1, 1), cB + hstep + kstep);
    PG8_WAIT_V(6); PG8_BAR;
    for (;;) {
        const bool has_next = S.next(ui + 1, nxt);
        const char* nA = has_next ? nxt.A : cA; const char* nB = has_next ? nxt.B : cB;
#pragma unroll 1
        for (int t = 0; t < nt; t += 2) {
            const bool last = (t == nt - 2);
            const char* a1 = cA + (size_t)(t + 1) * kstep;
            const char* a2 = last ? nA : cA + (size_t)(t + 2) * kstep; const char* b2 = last ? nB : cB + (size_t)(t + 2) * kstep;
            const char* a3 = a2 + kstep; const char* b3 = b2 + kstep;
            PG8_LDB(B0, 0, 0); PG8_SCHED; PG8_LDA(At, 0, 0); PG8_STAGE(PG8_SA(1, 1), a1 + hstep);
            PG8_WAIT_L(8); PG8_BAR; PG8_WAIT_L(0); PG8_MMA(0, 0, At, B0); PG8_BAR; PG8_SCHED;
            PG8_LDB(B1, 0, 1); PG8_STAGE(PG8_SB(0, 0), b2);
            PG8_BAR; PG8_WAIT_L(0); PG8_MMA(0, 1, At, B1); PG8_BAR;
            PG8_LDA(At, 0, 1); PG8_STAGE(PG8_SA(0, 0), a2);
            PG8_BAR; PG8_WAIT_L(0); PG8_MMA(1, 0, At, B0); PG8_BAR; PG8_SCHED;
            PG8_STAGE(PG8_SB(0, 1), b2 + hstep);
            PG8_WAIT_V(6); PG8_BAR; PG8_MMA(1, 1, At, B1); PG8_BAR;
            PG8_LDB(B0, 1, 0); PG8_SCHED; PG8_LDA(At, 1, 0); PG8_STAGE(PG8_SA(0, 1), a2 + hstep);
            PG8_WAIT_L(8); PG8_BAR; PG8_WAIT_L(0); PG8_MMA(0, 0, At, B0); PG8_BAR; PG8_SCHED;
            PG8_LDB(B1, 1, 1); PG8_STAGE(PG8_SB(1, 0), b3);
            PG8_BAR; PG8_WAIT_L(0); PG8_MMA(0, 1, At, B1); PG8_BAR;
            PG8_LDA(At, 1, 1); PG8_STAGE(PG8_SA(1, 0), a3);
            PG8_BAR; PG8_WAIT_L(0); PG8_MMA(1, 0, At, B0); PG8_BAR; PG8_SCHED;
            PG8_STAGE(PG8_SB(1, 1), b3 + hstep);
            PG8_WAIT_V(6); PG8_BAR; PG8_MMA(1, 1, At, B1); PG8_BAR;
        }
        E(acc, cur, wr, wc, fr, fq);
        if (!has_next) break;
#pragma unroll
        for (int a = 0; a < 2; ++a)
#pragma unroll
            for (int b = 0; b < 2; ++b)
#pragma unroll
                for (int m = 0; m < 4; ++m)
#pragma unroll
                    for (int n = 0; n < 2; ++n) acc[a][b][m][n] = (f32x4){0.f, 0.f, 0.f, 0.f};
        cur = nxt; cA = nA; cB = nB; ++ui;
    }
    PG8_WAIT_V(0);
    if (wr == 0) PG8_BAR;
    PG8_BAR;
#undef PG8_SA
#undef PG8_SB
#undef PG8_STAGE
#undef PG8_LDA
#undef PG8_LDB
#undef PG8_MMA
#undef PG8_WAIT_V
#undef PG8_WAIT_L
#undef PG8_BAR
#undef PG8_SCHED
}
}
using pg8::Unit;
typedef f32x4 AccT[2][2][4][2];
#define FOR_ACC(ai, bj, m, n) _Pragma("unroll") for (int ai = 0; ai < 2; ++ai) _Pragma("unroll") for (int m = 0; m < 4; ++m) _Pragma("unroll") for (int bj = 0; bj < 2; ++bj) _Pragma("unroll") for (int n = 0; n < 2; ++n)
#define ACC_FENCE __builtin_amdgcn_sched_barrier(0)
#define ACC_ROW(u, ai, m) ((u).row0 + 128 * (ai) + 64 * wr + 16 * (m) + fr)
#define ACC_COL(u, bj, n) ((u).col0 + 128 * (bj) + 32 * wc + 16 * (n) + 4 * fq)
DEV void st_bf4(bf16_t* p, f32x4 v) { u32x2 w; w.x = pk2(v[0], v[1]); w.y = pk2(v[2], v[3]); *(u32x2*)p = w; }
DEV void load_row(const float* p, int lane, f32x4 (&v)[4]) {
#pragma unroll
    for (int q = 0; q < 4; ++q) v[q] = *(const f32x4*)(p + 256 * q + 4 * lane);
}

DEV void load_row_bf(const bf16_t* p, int lane, f32x4 (&v)[4]) {
#pragma unroll
    for (int q = 0; q < 4; ++q) { const u32x2 a = *(const u32x2*)(p + 256 * q + 4 * lane); v[q] = (f32x4){bflo(a.x), bfhi(a.x), bflo(a.y), bfhi(a.y)}; }
}
DEV void store_row_bf(bf16_t* p, int lane, const f32x4 (&v)[4]) {
#pragma unroll
    for (int q = 0; q < 4; ++q) st_bf4(p + 256 * q + 4 * lane, v[q]);
}
DEV void emit_mix6(const Params& p, int j, int t, int lane, const f32x4 (&x)[4], const f32x4 (&xp)[4]) {
    const float* mu = p.rw_mu + (size_t)j * 6 * D;
#pragma unroll
    for (int s = 0; s < 6; ++s) {
#pragma unroll
        for (int q = 0; q < 4; ++q) {
            const f32x4 m = *(const f32x4*)(mu + s * D + 256 * q + 4 * lane);
            st_bf4(WS_(p, X6) + (size_t)s * T * D + (size_t)t * D + 256 * q + 4 * lane, x[q] + (xp[q] - x[q]) * m);
        }
        __builtin_amdgcn_sched_barrier(0);
    }
}
DEV void phase_pre0(const Params& p) {
    const int tid = tid_(), bid = bid_(); const int lane = tid & 63, wid = tid >> 6;
    f32x4 x[4], xp[4];
    const int tfirst = bid * 64 + wid * 8;
    if (tfirst > 0) load_row(p.x + (size_t)(tfirst - 1) * D, lane, xp); else { for (int q = 0; q < 4; ++q) xp[q] = (f32x4){0.f, 0.f, 0.f, 0.f}; }
    f32x4 xn[4]; load_row(p.x + (size_t)tfirst * D, lane, xn);
#pragma unroll 1
    for (int r = 0; r < 8; ++r) {
        const int t = tfirst + r;
#pragma unroll
        for (int q = 0; q < 4; ++q) x[q] = xn[q];
        load_row(p.x + (size_t)(r < 7 ? t + 1 : t) * D, lane, xn);
        store_row_bf(WS_(p, Hb) + (size_t)t * D, lane, x);
        emit_mix6(p, 0, t, lane, x, xp);
#pragma unroll
        for (int q = 0; q < 4; ++q) xp[q] = x[q];
    }
}

struct SchedRW1 {
    const Params* p; int j;
    DEV bool next(int i, Unit& u) const {
        int pm, pn; if (!pg8::tile_order(i, NB_, bid_(), 64, 15, pm, pn)) return false;
        int id, lpn; if (pn < 12) { id = pn >> 2; lpn = pn & 3; } else { id = 3 + (pn - 12); lpn = 0; }
        u.A = (const char*)(WS_(*p, X6) + (size_t)id * T * D + (size_t)pm * 256 * D);
        const bf16_t* B;
        if (id < 3) B = WS_(*p, rw_rkv_t) + ((size_t)j * 3 + id) * D * D + (size_t)lpn * 256 * D;
        else B = WS_(*p, rw_w1_t) + (size_t)(id - 3) * (2 * 256 * D) + (size_t)j * 256 * D;
        u.B = (const char*)B; u.row0 = pm * 256; u.col0 = lpn * 256; u.id = id; u.aux = 0; return true;
    }
};
struct EpiRW1 {
    const Params* p;
    DEV void operator()(const AccT& acc, const Unit& u, int wr, int wc, int fr, int fq) const {
        if (u.id < 3) {
            bf16_t* O = WS_(*p, Rb) + (size_t)u.id * 2 * T * D;
            FOR_ACC(ai, bj, m, n) { st_bf4(O + (size_t)ACC_ROW(u, ai, m) * D + ACC_COL(u, bj, n), acc[ai][bj][m][n]); ACC_FENCE; }
        } else {
            bf16_t* O = WS_(*p, LW) + (size_t)(u.id - 3) * T * 256;
            FOR_ACC(ai, bj, m, n) {
                f32x4 v = acc[ai][bj][m][n];
                if (u.id == 3) { for (int e = 0; e < 4; ++e) v[e] = tanhf_(v[e]); }
                else if (u.id == 5) { for (int e = 0; e < 4; ++e) v[e] = sigmoidf_(v[e]); }
                st_bf4(O + (size_t)ACC_ROW(u, ai, m) * 256 + ACC_COL(u, bj, n), v); ACC_FENCE;
            }
        }
    }
};
struct SchedRW2 {
    const Params* p; int j;
    DEV bool next(int i, Unit& u) const {
        int pm, pn; if (!pg8::tile_order(i, NB_, bid_(), 64, 12, pm, pn)) return false;
        const int id = pn >> 2, lpn = pn & 3;
        u.A = (const char*)(WS_(*p, LW) + (size_t)id * T * 256 + (size_t)pm * 256 * 256);
        const bf16_t* B = WS_(*p, rw_w2_t) + (size_t)id * (2 * D * 256) + (size_t)j * D * 256 + (size_t)lpn * 256 * 256;
        u.B = (const char*)B; u.row0 = pm * 256; u.col0 = lpn * 256; u.id = id; u.aux = 0; return true;
    }
};
struct EpiRW2 {
    const Params* p; int j;
    DEV void operator()(const AccT& acc, const Unit& u, int wr, int wc, int fr, int fq) const {
        if (u.id == 0) { const float* bias = p->rw_w0 + (size_t)j * D; f32x4 bv[2][2];
#pragma unroll
            for (int bj = 0; bj < 2; ++bj)
#pragma unroll
                for (int n = 0; n < 2; ++n) bv[bj][n] = *(const f32x4*)(bias + ACC_COL(u, bj, n));
            FOR_ACC(ai, bj, m, n) { f32x4 v = acc[ai][bj][m][n]; const int c = ACC_COL(u, bj, n); const f32x4 b = bv[bj][n];
                for (int e = 0; e < 4; ++e) { const float x = -(b[e] + v[e]); const float wl = -(fmaxf(x, 0.f) + __logf(1.0f + __expf(-fabsf(x)))) - 0.5f; v[e] = -__expf(wl); }
                st_bf4(WS_(*p, Wb) + (size_t)ACC_ROW(u, ai, m) * D + c, v); ACC_FENCE; } }
        else if (u.id == 1) { const float* bias = p->rw_a0 + (size_t)j * D; f32x4 bv[2][2];
#pragma unroll
            for (int bj = 0; bj < 2; ++bj)
#pragma unroll
                for (int n = 0; n < 2; ++n) bv[bj][n] = *(const f32x4*)(bias + ACC_COL(u, bj, n));
            FOR_ACC(ai, bj, m, n) { f32x4 v = acc[ai][bj][m][n]; const int c = ACC_COL(u, bj, n); const f32x4 b = bv[bj][n];
                for (int e = 0; e < 4; ++e) v[e] = sigmoidf_(b[e] + v[e]);
                st_bf4(WS_(*p, Ab) + (size_t)ACC_ROW(u, ai, m) * D + c, v); ACC_FENCE; } }
        else { FOR_ACC(ai, bj, m, n) { st_bf4(WS_(*p, Gb) + (size_t)ACC_ROW(u, ai, m) * D + ACC_COL(u, bj, n), acc[ai][bj][m][n]); ACC_FENCE; } }
    }
};

struct SchedOut {
    const bf16_t* A; const bf16_t* Bt; int K;
    DEV bool next(int i, Unit& u) const {
        int pm, pn; if (!pg8::tile_order(i, NB_, bid_(), 64, 4, pm, pn)) return false;
        u.A = (const char*)(A + (size_t)pm * 256 * K); u.B = (const char*)(Bt + (size_t)pn * 256 * K); u.row0 = pm * 256; u.col0 = pn * 256; u.id = 0; u.aux = 0; return true;
    }
};
struct EpiOut {
    bf16_t* O;
    DEV void operator()(const AccT& acc, const Unit& u, int wr, int wc, int fr, int fq) const {
        FOR_ACC(ai, bj, m, n) { st_bf4(O + (size_t)ACC_ROW(u, ai, m) * D + ACC_COL(u, bj, n), acc[ai][bj][m][n]); ACC_FENCE; }
    }
};
constexpr int RC_LD = 72;
#ifdef DBG
#define DBGF(cond, bit) do { if (cond) atomicOr(&WS_(p, TAB)[200], (bit)); } while (0)
#else
#define DBGF(cond, bit) do {} while (0)
#endif
DEV bool bad_(float x) { return !(fabsf(x) < 1e30f); }
DEV int rc_pi(int g, int j) { return j < 4 ? 4 * g + j : 16 + 4 * g + (j - 4); }

DEV void rc_load_wd(const Params& p, int t0, int cb, float (&wd)[8]) {
    const int tid = tid_(); const int k = tid & 63, sg = tid >> 6;
#pragma unroll
    for (int i = 0; i < 8; ++i) wd[i] = bf2f(WS_(p, Wb)[(size_t)(t0 + sg * 8 + i) * D + cb + k]);
}
DEV void rc_cum_regs(const float (&wd)[8], LAS float* cum, LAS float* seg) {
    const int tid = tid_(); const int k = tid & 63, sg = tid >> 6;
    float v[8]; float s = 0.f;
#pragma unroll
    for (int i = 0; i < 8; ++i) { s += wd[i]; v[i] = s; }
    seg[sg * 64 + k] = s;
    lds_barrier();
    float off = 0.f;
#pragma unroll
    for (int q = 0; q < 8; ++q) off += (q < sg) ? seg[q * 64 + k] : 0.f;
#pragma unroll
    for (int i = 0; i < 8; ++i) cum[(sg * 8 + i) * 64 + k] = v[i] + off;
    lds_barrier();
}
DEV void ld8b(const bf16_t* p, float (&f)[8]) { const u32x4 v = *(const u32x4*)p; f[0] = bflo(v.x); f[1] = bfhi(v.x); f[2] = bflo(v.y); f[3] = bfhi(v.y); f[4] = bflo(v.z); f[5] = bfhi(v.z); f[6] = bflo(v.w); f[7] = bfhi(v.w); }
DEV void ld8(const float* p, float (&f)[8]) { const f32x4 a = *(const f32x4*)p, b = *(const f32x4*)(p + 4); f[0] = a[0]; f[1] = a[1]; f[2] = a[2]; f[3] = a[3]; f[4] = b[0]; f[5] = b[1]; f[6] = b[2]; f[7] = b[3]; }
DEV void lds8(const LAS float* p, float (&f)[8]) { const f32x4 a = *(const LAS f32x4*)p, b = *(const LAS f32x4*)(p + 4); f[0] = a[0]; f[1] = a[1]; f[2] = a[2]; f[3] = a[3]; f[4] = b[0]; f[5] = b[1]; f[6] = b[2]; f[7] = b[3]; }
DEV u32x4 pk8(const float (&f)[8]) { u32x4 o; o.x = pk2(f[0], f[1]); o.y = pk2(f[2], f[3]); o.z = pk2(f[4], f[5]); o.w = pk2(f[6], f[7]); return o; }

DEV bf16x8 frag_rm_pi(const LAS bf16_t* base, int ld, int row0, int k0, int lane) {
    const LAS bf16_t* a = base + (row0 + (lane & 15)) * ld + k0 + 4 * (lane >> 4);
    const s16x4 lo = *(const LAS s16x4*)a, hi = *(const LAS s16x4*)(a + 16);
    bf16x8 r; r[0] = lo[0]; r[1] = lo[1]; r[2] = lo[2]; r[3] = lo[3]; r[4] = hi[0]; r[5] = hi[1]; r[6] = hi[2]; r[7] = hi[3]; return r;
}
DEV void rc_prep8(const float (&k)[8], const float (&al)[8], const float (&kkw)[8], const float (&kaw)[8], float (&a)[8], float (&b)[8], float (&kh)[8]) {
    float kk[8]; float ss = 0.f;
#pragma unroll
    for (int e = 0; e < 8; ++e) { kk[e] = k[e] * kkw[e]; ss += kk[e] * kk[e]; }
    ss += __shfl_xor(ss, 1); ss += __shfl_xor(ss, 2); ss += __shfl_xor(ss, 4);
    const float inv = 1.0f / fmaxf(sqrtf(ss), 1e-12f);
#pragma unroll
    for (int e = 0; e < 8; ++e) { const float kn = kk[e] * inv; a[e] = -kn; b[e] = kn * al[e]; kh[e] = k[e] * (1.0f + (al[e] - 1.0f) * kaw[e]); }
}
DEV void phase_rw_cha(const Params& p, int jl, LAS unsigned char* lds) {
    const int tid = tid_(), bid = bid_(); const int lane = tid & 63, w = tid >> 6; const int fr = lane & 15, fq = lane >> 4;
    LAS float* cum = (LAS float*)lds;
    LAS float* seg = cum + 64 * 64;
    LAS float* Aab = seg + 8 * 64;
    LAS bf16_t* As = (LAS bf16_t*)(Aab + 64 * 68);
    LAS bf16_t* Bs = As + 64 * RC_LD; LAS bf16_t* Ks = Bs + 64 * RC_LD; LAS bf16_t* Vs = Ks + 64 * RC_LD; LAS bf16_t* Ke = Vs + 64 * RC_LD;
    LAS bf16_t* Aak = Ke + 64 * RC_LD; LAS bf16_t* Ts = Aak + 64 * RC_LD; LAS bf16_t* X1 = Ts + 64 * RC_LD; LAS bf16_t* Aabh = X1 + 64 * RC_LD;
    LAS bf16_t* Fimg = Aabh + 64 * RC_LD;
    LAS bf16_t* Wimg = Fimg + 4096;
    float pwd[8], pkr[8], pal[8], pv[8];
    float kkw[8], kaw[8];
    ld8(p.rw_k_k + (size_t)jl * D + (bid & 15) * 64 + (tid & 7) * 8, kkw); ld8(p.rw_k_a + (size_t)jl * D + (bid & 15) * 64 + (tid & 7) * 8, kaw);
    { const int c = bid >> 4, h = bid & 15; rc_load_wd(p, c * 64, h * 64, pwd);
      const size_t go = (size_t)(c * 64 + (tid >> 3)) * D + h * 64 + (tid & 7) * 8; ld8b(WS_(p, Kb) + go, pkr); ld8b(WS_(p, Ab) + go, pal); ld8b(WS_(p, Vb) + go, pv); }
    for (int u = bid; u < 4096; u += NB_) {
        const int c = u >> 4, h = u & 15; const int t0 = c * 64, cb = h * 64; const size_t ub = (size_t)c * 16 + h;
        lds_barrier();
        rc_cum_regs(pwd, cum, seg);
        {
            const int t = tid >> 3, k8 = (tid & 7) * 8;
            float a[8], b[8], kh[8], v[8], ct[8], cp[8], ce[8];
            rc_prep8(pkr, pal, kkw, kaw, a, b, kh);
#pragma unroll
            for (int e = 0; e < 8; ++e) v[e] = pv[e];
            if (u + NB_ < 4096) { const int un = u + NB_; const int cn = un >> 4, hn = un & 15; rc_load_wd(p, cn * 64, hn * 64, pwd);
                const size_t gn = (size_t)(cn * 64 + t) * D + hn * 64 + k8; ld8b(WS_(p, Kb) + gn, pkr); ld8b(WS_(p, Ab) + gn, pal); ld8b(WS_(p, Vb) + gn, pv); }
            lds8(cum + t * 64 + k8, ct); lds8(cum + 63 * 64 + k8, ce);
            if (t > 0) lds8(cum + (t - 1) * 64 + k8, cp); else { for (int e = 0; e < 8; ++e) cp[e] = 0.f; }
            float at[8], bt[8], kt[8], be[8], ke[8];
#pragma unroll
            for (int e = 0; e < 8; ++e) { const float ei = __expf(-ct[e]), ee = __expf(ce[e] - ct[e]); at[e] = a[e] * __expf(cp[e]); bt[e] = b[e] * ei; kt[e] = kh[e] * ei; be[e] = b[e] * ee; ke[e] = kh[e] * ee; }
            *(LAS u32x4*)(As + t * RC_LD + k8) = pk8(at); *(LAS u32x4*)(Bs + t * RC_LD + k8) = pk8(bt); *(LAS u32x4*)(Ks + t * RC_LD + k8) = pk8(kt);
            *(LAS u32x4*)(Ke + t * RC_LD + k8) = pk8(ke); *(LAS u32x4*)(Vs + t * RC_LD + k8) = pk8(v);
            const int tq = t & 31, g = (tq & 15) >> 2, j = (tq & 3) + ((tq >> 4) << 2);
#pragma unroll
            for (int e = 0; e < 8; ++e) { const int k = k8 + e; Fimg[(((k >> 4) * 2 + (t >> 5)) * 64 + g * 16 + (k & 15)) * 8 + j] = (bf16_t)f2bf(be[e]); }
            *(LAS u32x4*)(Ts + tid * 8) = (u32x4){0u, 0u, 0u, 0u}; if (tid < 64) *(LAS u32x4*)(Ts + (512 + tid) * 8) = (u32x4){0u, 0u, 0u, 0u};
            if (t == 63) { float gm[8]; for (int e = 0; e < 8; ++e) gm[e] = __expf(ce[e]); *(f32x4*)(WS_(p, RGc) + ub * 64 + k8) = (f32x4){gm[0], gm[1], gm[2], gm[3]}; *(f32x4*)(WS_(p, RGc) + ub * 64 + k8 + 4) = (f32x4){gm[4], gm[5], gm[6], gm[7]}; }
        }
        lds_barrier();
        {
            const int tb = w >> 1;
#pragma unroll
            for (int ii = 0; ii < 2; ++ii) { const int ib = 2 * (w & 1) + ii;
                f32x4 ab = {0.f, 0.f, 0.f, 0.f}, ak = {0.f, 0.f, 0.f, 0.f};
                if (ib <= tb) {
#pragma unroll
                    for (int ks = 0; ks < 2; ++ks) { const bf16x8 af = frag_rm(As, RC_LD, 16 * tb, 32 * ks, lane);
                        ab = MFMA16(af, frag_rm(Bs, RC_LD, 16 * ib, 32 * ks, lane), ab); ak = MFMA16(af, frag_rm(Ks, RC_LD, 16 * ib, 32 * ks, lane), ak); } }
#pragma unroll
                for (int r = 0; r < 4; ++r) { const int t = 16 * tb + 4 * fq + r, i = 16 * ib + fr; const bool keep = i < t;
                    Aab[t * 68 + i] = keep ? ab[r] : 0.f; Aabh[t * RC_LD + i] = (bf16_t)f2bf(keep ? ab[r] : 0.f); Aak[t * RC_LD + i] = (bf16_t)f2bf(keep ? ak[r] : 0.f); } }
            *(u32x4*)(WS_(p, RBf) + ub * 4096 + tid * 8) = *(const LAS u32x4*)(Fimg + tid * 8);
        }
        lds_barrier();
        if (w == 0) {
            const int blk = lane >> 4, jc = lane & 15;
            float Tc[16];
#pragma unroll
            for (int t = 0; t < 16; ++t) {
                float acc = jc == t ? 1.f : 0.f;
#pragma unroll
                for (int i4 = 0; i4 < (t + 3) / 4; ++i4) { const f32x4 a4 = *(const LAS f32x4*)(Aab + (16 * blk + t) * 68 + 16 * blk + i4 * 4);
#pragma unroll
                    for (int e = 0; e < 4; ++e) if (i4 * 4 + e < t) acc += a4[e] * Tc[i4 * 4 + e]; }
                Tc[t] = acc;
            }
#pragma unroll
            for (int t = 0; t < 16; ++t) Ts[(16 * blk + t) * RC_LD + 16 * blk + jc] = (bf16_t)f2bf(Tc[t]);
#pragma unroll
            for (int b = 1; b < 4; ++b) {
                const s16x4 dlo = *(const LAS s16x4*)(Ts + (16 * b + fr) * RC_LD + 16 * b + 4 * fq);
                bf16x8 dfr; dfr[0] = dlo[0]; dfr[1] = dlo[1]; dfr[2] = dlo[2]; dfr[3] = dlo[3]; dfr[4] = 0; dfr[5] = 0; dfr[6] = 0; dfr[7] = 0;
                f32x4 tt_[3];
#pragma unroll
                for (int cbk = 0; cbk < b; ++cbk) {
                    f32x4 x = {0.f, 0.f, 0.f, 0.f};
#pragma unroll
                    for (int ks = 0; ks < 2; ++ks) x = MFMA16(frag_rm(Aabh, RC_LD, 16 * b, 32 * ks, lane), frag_tr(Ts, RC_LD, 32 * ks, 16 * cbk, lane), x);
                    u32x4 xb; xb.x = pk2(x[0], x[1]); xb.y = pk2(x[2], x[3]); xb.z = 0u; xb.w = 0u;
                    tt_[cbk] = MFMA16(dfr, __builtin_bit_cast(bf16x8, xb), ((f32x4){0.f, 0.f, 0.f, 0.f}));
                }
#pragma unroll
                for (int cbk = 0; cbk < b; ++cbk)
#pragma unroll
                    for (int r = 0; r < 4; ++r) Ts[(16 * b + 4 * fq + r) * RC_LD + 16 * cbk + fr] = (bf16_t)f2bf(tt_[cbk][r]);
            }
        } else {
            for (int tl = w - 1; tl < 32; tl += 7) {
                const int rb = (tl & 15) >> 2, vbk = tl & 3; f32x4 acc = {0.f, 0.f, 0.f, 0.f};
                if (tl < 16) {
#pragma unroll
                    for (int ks = 0; ks < 2; ++ks) acc = MFMA16(frag_rm(Aak, RC_LD, 16 * rb, 32 * ks, lane), frag_tr(Vs, RC_LD, 32 * ks, 16 * vbk, lane), acc);
#pragma unroll
                    for (int r = 0; r < 4; ++r) X1[(16 * rb + 4 * fq + r) * RC_LD + 16 * vbk + fr] = (bf16_t)f2bf(acc[r]);
                } else {
#pragma unroll
                    for (int ks = 0; ks < 2; ++ks) acc = MFMA16(frag_tr(Ke, RC_LD, 32 * ks, 16 * rb, lane), frag_tr(Vs, RC_LD, 32 * ks, 16 * vbk, lane), acc);
                    { u32x2 o; o.x = pk2(acc[0], acc[1]); o.y = pk2(acc[2], acc[3]); *(u32x2*)(WS_(p, RNa) + (((ub * 4 + vbk) * 4 + rb) * 64 + lane) * 4) = o; }
                }
            }
        }
        lds_barrier();
#pragma unroll
        for (int q = 0; q < 4; ++q) { const int tl = w * 4 + q; const int tt = (tl & 15) >> 2, cbk = tl & 3; f32x4 acc = {0.f, 0.f, 0.f, 0.f};
            if (tl < 16) {
#pragma unroll
                for (int ks = 0; ks < 2; ++ks) acc = MFMA16(frag_rm(Ts, RC_LD, 16 * tt, 32 * ks, lane), frag_tr(As, RC_LD, 32 * ks, 16 * cbk, lane), acc);
                const int k = 16 * cbk + fr, kq = k & 31, g = (kq & 15) >> 2, j = (kq & 3) + ((kq >> 4) << 2);
#pragma unroll
                for (int r = 0; r < 4; ++r) Wimg[((tt * 2 + (k >> 5)) * 64 + g * 16 + 4 * fq + r) * 8 + j] = (bf16_t)f2bf(acc[r]);
            } else {
#pragma unroll
                for (int ks = 0; ks < 2; ++ks) acc = MFMA16(frag_rm(Ts, RC_LD, 16 * tt, 32 * ks, lane), frag_tr(X1, RC_LD, 32 * ks, 16 * cbk, lane), acc);
                { u32x2 o; o.x = pk2(acc[0], acc[1]); o.y = pk2(acc[2], acc[3]); *(u32x2*)(WS_(p, RUt) + (((ub * 4 + cbk) * 4 + tt) * 64 + lane) * 4) = o; }
            } }
        lds_barrier();
        *(u32x4*)(WS_(p, RWf) + ub * 4096 + tid * 8) = *(const LAS u32x4*)(Wimg + tid * 8);
    }
}

constexpr int RB_SLOT = 20992, RB_R = 6, RB_P = 5;
struct RbOpsA { bf16x8 wf[8]; u32x2 ut[4]; };
struct RbOpsB { bf16x8 bf[8]; u32x2 na[4]; f32x4 gc[4]; };
DEV void rb_read_a(const LAS unsigned char* slot, int lane, RbOpsA& O) {
#pragma unroll
    for (int f = 0; f < 8; ++f) O.wf[f] = *(const LAS bf16x8*)(slot + (f * 64 + lane) * 16);
#pragma unroll
    for (int q = 0; q < 4; ++q) O.ut[q] = *(const LAS u32x2*)(slot + 16384 + (q * 64 + lane) * 8);
}
DEV void rb_read_b(const LAS unsigned char* slot, int lane, RbOpsB& O) {
    const int fq = lane >> 4;
#pragma unroll
    for (int f = 0; f < 8; ++f) O.bf[f] = *(const LAS bf16x8*)(slot + 8192 + (f * 64 + lane) * 16);
#pragma unroll
    for (int q = 0; q < 4; ++q) { O.na[q] = *(const LAS u32x2*)(slot + 18432 + (q * 64 + lane) * 8); O.gc[q] = *(const LAS f32x4*)(slot + 20480 + (16 * q + 4 * fq) * 4); }
}
DEV void phase_rw_chb(const Params& p, int layer, LAS unsigned char* lds) {
    const int tid = tid_(), bid = bid_();
    if (bid >= 64) { if (layer == 0) convert_jobs<14, 16>(p, lds, 64, NB_ - 64); return; }
    const int lane = tid & 63, w = __builtin_amdgcn_readfirstlane(tid >> 6); const int head = bid & 15, vb = bid >> 4;
    auto issue = [&](int c) {
        const size_t ub = (size_t)c * 16 + head; LAS unsigned char* slot = lds + (c % RB_R) * RB_SLOT;
#pragma unroll
        for (int i = 0; i < 3; ++i) { const int pi = (w - 1) * 3 + i;
            if (pi < 8) __builtin_amdgcn_global_load_lds((const unsigned*)(WS_(p, RWf) + ub * 4096 + pi * 512 + lane * 8), (LAS unsigned*)(slot + pi * 1024), 16, 0, 0);
            else if (pi < 16) __builtin_amdgcn_global_load_lds((const unsigned*)(WS_(p, RBf) + ub * 4096 + (pi - 8) * 512 + lane * 8), (LAS unsigned*)(slot + 8192 + (pi - 8) * 1024), 16, 0, 0);
            else if (pi < 18) __builtin_amdgcn_global_load_lds((const unsigned*)(WS_(p, RUt) + (ub * 4 + vb) * 1024 + (pi - 16) * 512 + lane * 8), (LAS unsigned*)(slot + 16384 + (pi - 16) * 1024), 16, 0, 0);
            else if (pi < 20) __builtin_amdgcn_global_load_lds((const unsigned*)(WS_(p, RNa) + (ub * 4 + vb) * 1024 + (pi - 18) * 512 + lane * 8), (LAS unsigned*)(slot + 18432 + (pi - 18) * 1024), 16, 0, 0);
            else __builtin_amdgcn_global_load_lds((const unsigned*)(WS_(p, RGc) + ub * 64 + lane), (LAS unsigned*)(slot + 20480), 4, 0, 0);
        }
    };
    if (w > 0) {
#pragma unroll 1
        for (int c = 0; c < RB_P; ++c) issue(c);
        asm volatile("s_waitcnt vmcnt(9)" ::: "memory");
    }
    __builtin_amdgcn_s_barrier();
    f32x4 s[4]; for (int i = 0; i < 4; ++i) s[i] = (f32x4){0.f, 0.f, 0.f, 0.f};
    RbOpsA cur, nxt; RbOpsB cb_;
    if (w == 0) { rb_read_a(lds, lane, cur); }
#pragma unroll 1
    for (int c = 0; c < 256; ++c) {
        if (w > 0) {
            if (c + RB_P < 256) { issue(c + RB_P); asm volatile("s_waitcnt vmcnt(9)" ::: "memory"); }
            else asm volatile("s_waitcnt vmcnt(0)" ::: "memory");
        } else {
            const size_t ub = (size_t)c * 16 + head;
            rb_read_b(lds + (c % RB_R) * RB_SLOT, lane, cb_);
            rb_read_a(lds + ((c + 1 < 256 ? c + 1 : c) % RB_R) * RB_SLOT, lane, nxt);
#pragma unroll
            for (int kt = 0; kt < 4; ++kt) { u32x2 o; o.x = pk2(s[kt][0], s[kt][1]); o.y = pk2(s[kt][2], s[kt][3]); *(u32x2*)(WS_(p, RS0) + (((ub * 4 + vb) * 4 + kt) * 64 + lane) * 4) = o; }
            bf16x8 sb[2];
#pragma unroll
            for (int ks = 0; ks < 2; ++ks) { u32x4 o; o.x = pk2(s[2 * ks][0], s[2 * ks][1]); o.y = pk2(s[2 * ks][2], s[2 * ks][3]); o.z = pk2(s[2 * ks + 1][0], s[2 * ks + 1][1]); o.w = pk2(s[2 * ks + 1][2], s[2 * ks + 1][3]); sb[ks] = __builtin_bit_cast(bf16x8, o); }
            f32x4 uu[4];
#pragma unroll
            for (int tt = 0; tt < 4; ++tt) { uu[tt] = (f32x4){bflo(cur.ut[tt].x), bfhi(cur.ut[tt].x), bflo(cur.ut[tt].y), bfhi(cur.ut[tt].y)}; uu[tt] = MFMA16(cur.wf[tt * 2], sb[0], uu[tt]); uu[tt] = MFMA16(cur.wf[tt * 2 + 1], sb[1], uu[tt]); }
#pragma unroll
            for (int tt = 0; tt < 4; ++tt) { u32x2 o; o.x = pk2(uu[tt][0], uu[tt][1]); o.y = pk2(uu[tt][2], uu[tt][3]); *(u32x2*)(WS_(p, RUa) + (((ub * 4 + vb) * 4 + tt) * 64 + lane) * 4) = o; }
            bf16x8 ubf[2];
#pragma unroll
            for (int ks = 0; ks < 2; ++ks) { u32x4 o; o.x = pk2(uu[2 * ks][0], uu[2 * ks][1]); o.y = pk2(uu[2 * ks][2], uu[2 * ks][3]); o.z = pk2(uu[2 * ks + 1][0], uu[2 * ks + 1][1]); o.w = pk2(uu[2 * ks + 1][2], uu[2 * ks + 1][3]); ubf[ks] = __builtin_bit_cast(bf16x8, o); }
#pragma unroll
            for (int kt = 0; kt < 4; ++kt) { s[kt] = s[kt] * cb_.gc[kt] + (f32x4){bflo(cb_.na[kt].x), bfhi(cb_.na[kt].x), bflo(cb_.na[kt].y), bfhi(cb_.na[kt].y)}; s[kt] = MFMA16(cb_.bf[kt * 2], ubf[0], s[kt]); s[kt] = MFMA16(cb_.bf[kt * 2 + 1], ubf[1], s[kt]); }
            cur = nxt;
            asm volatile("s_waitcnt lgkmcnt(0)" ::: "memory");
        }
        __builtin_amdgcn_s_barrier();
    }
    asm volatile("s_waitcnt vmcnt(0)" ::: "memory");
}

DEV void phase_rw_chc(const Params& p, int j, LAS unsigned char* lds) {
    const int tid = tid_(), bid = bid_(); const int lane = tid & 63, w = tid >> 6; const int fr = lane & 15, fq = lane >> 4;
    LAS float* cum = (LAS float*)lds;
    LAS float* seg = cum + 64 * 64;
    LAS float* Ys = seg + 8 * 64;
    LAS bf16_t* Rs = (LAS bf16_t*)(Ys + 64 * 68);
    LAS bf16_t* Bs = Rs + 64 * RC_LD; LAS bf16_t* Ks = Bs + 64 * RC_LD; LAS bf16_t* Vs = Ks + 64 * RC_LD; LAS bf16_t* Arb = Vs + 64 * RC_LD; LAS bf16_t* Ark = Arb + 64 * RC_LD;
    float pwd[8], pr[8], pkr[8], pal[8], pv[8], pg[8];
    float kkw[8], kaw[8], rkw[8], lgw[8], lbw[8];
    { const size_t po = (size_t)j * D + (bid & 15) * 64 + (tid & 7) * 8; ld8(p.rw_k_k + po, kkw); ld8(p.rw_k_a + po, kaw); ld8(p.rw_r_k + po, rkw); ld8(p.rw_lnx_g + po, lgw); ld8(p.rw_lnx_b + po, lbw); }
    { const int c = bid >> 4, h = bid & 15; rc_load_wd(p, c * 64, h * 64, pwd);
      const size_t go = (size_t)(c * 64 + (tid >> 3)) * D + h * 64 + (tid & 7) * 8; ld8b(WS_(p, Rb) + go, pr); ld8b(WS_(p, Kb) + go, pkr); ld8b(WS_(p, Ab) + go, pal); ld8b(WS_(p, Vb) + go, pv); ld8b(WS_(p, Gb) + go, pg); }
    for (int u = bid; u < 4096; u += NB_) {
        const int c = u >> 4, h = u & 15; const int t0 = c * 64, cb = h * 64; const size_t ub = (size_t)c * 16 + h;
        const int tt = w & 3;
        u32x2 ufr[2][2][2], sfr[2][2][2];
#pragma unroll
        for (int q = 0; q < 2; ++q)
#pragma unroll
            for (int ks = 0; ks < 2; ++ks)
#pragma unroll
                for (int hf = 0; hf < 2; ++hf) { const size_t o = (((ub * 4 + 2 * (w >> 2) + q) * 4 + 2 * ks + hf) * 64 + lane) * 4;
                    ufr[q][ks][hf] = *(const u32x2*)(WS_(p, RUa) + o); sfr[q][ks][hf] = *(const u32x2*)(WS_(p, RS0) + o); }
        lds_barrier();
        rc_cum_regs(pwd, cum, seg);
#ifdef DBL_CUM
        rc_cum_regs(pwd, cum, seg);
#endif
        const int t = tid >> 3, k8 = (tid & 7) * 8; const size_t go = (size_t)(t0 + t) * D + cb + k8;
        float v[8], gg[8]; float bc;
        {   float r[8], a[8], b[8], kh[8], ct[8];
#pragma unroll
            for (int e = 0; e < 8; ++e) { r[e] = pr[e]; v[e] = pv[e]; gg[e] = pg[e]; }
            lds8(cum + t * 64 + k8, ct);
            rc_prep8(pkr, pal, kkw, kaw, a, b, kh);
            if (u + NB_ < 4096) { const int un = u + NB_; const int cn = un >> 4, hn = un & 15; rc_load_wd(p, cn * 64, hn * 64, pwd);
                const size_t gn = (size_t)(cn * 64 + t) * D + hn * 64 + k8; ld8b(WS_(p, Rb) + gn, pr); ld8b(WS_(p, Kb) + gn, pkr); ld8b(WS_(p, Ab) + gn, pal); ld8b(WS_(p, Vb) + gn, pv); ld8b(WS_(p, Gb) + gn, pg); }
            bc = 0.f;
#pragma unroll
            for (int e = 0; e < 8; ++e) bc += r[e] * kh[e] * rkw[e];
            bc += __shfl_xor(bc, 1); bc += __shfl_xor(bc, 2); bc += __shfl_xor(bc, 4);
#pragma unroll
            for (int e = 0; e < 8; ++e) { const float ei = __expf(-ct[e]); r[e] *= __expf(ct[e]); b[e] *= ei; kh[e] *= ei; }
            *(LAS u32x4*)(Rs + t * RC_LD + k8) = pk8(r); *(LAS u32x4*)(Bs + t * RC_LD + k8) = pk8(b); *(LAS u32x4*)(Ks + t * RC_LD + k8) = pk8(kh); *(LAS u32x4*)(Vs + t * RC_LD + k8) = pk8(v);
        }
        lds_barrier();
#ifdef DBL_S3
#pragma unroll 1
        for (int rep_ = 0; rep_ < 2; ++rep_)
#endif
        {   const int tb = w >> 1;
#pragma unroll
            for (int ii = 0; ii < 2; ++ii) { const int ib = 2 * (w & 1) + ii;
                f32x4 ab = {0.f, 0.f, 0.f, 0.f}, ak = {0.f, 0.f, 0.f, 0.f};
                if (ib <= tb) {
#pragma unroll
                    for (int ks = 0; ks < 2; ++ks) { const bf16x8 af = frag_rm(Rs, RC_LD, 16 * tb, 32 * ks, lane);
                        ab = MFMA16(af, frag_rm(Bs, RC_LD, 16 * ib, 32 * ks, lane), ab); ak = MFMA16(af, frag_rm(Ks, RC_LD, 16 * ib, 32 * ks, lane), ak); } }
#pragma unroll
                for (int r = 0; r < 4; ++r) { const int tr = 16 * tb + 4 * fq + r, i = 16 * ib + fr; const bool keep = i <= tr;
                    Arb[tr * RC_LD + i] = (bf16_t)f2bf(keep ? ab[r] : 0.f); Ark[tr * RC_LD + i] = (bf16_t)f2bf(keep ? ak[r] : 0.f); } }
        }
        lds_barrier();
#ifdef DBL_Y
#pragma unroll 1
        for (int rep_ = 0; rep_ < 2; ++rep_)
#endif
#pragma unroll
        for (int q = 0; q < 2; ++q) { const int vbk = 2 * (w >> 2) + q; f32x4 acc = {0.f, 0.f, 0.f, 0.f};
#pragma unroll
            for (int ks = 0; ks < 2; ++ks) {
                u32x4 bu, bs; bu.x = ufr[q][ks][0].x; bu.y = ufr[q][ks][0].y; bu.z = ufr[q][ks][1].x; bu.w = ufr[q][ks][1].y; bs.x = sfr[q][ks][0].x; bs.y = sfr[q][ks][0].y; bs.z = sfr[q][ks][1].x; bs.w = sfr[q][ks][1].y;
                acc = MFMA16(frag_rm_pi(Rs, RC_LD, 16 * tt, 32 * ks, lane), __builtin_bit_cast(bf16x8, bs), acc);
                acc = MFMA16(frag_rm_pi(Arb, RC_LD, 16 * tt, 32 * ks, lane), __builtin_bit_cast(bf16x8, bu), acc);
                acc = MFMA16(frag_rm(Ark, RC_LD, 16 * tt, 32 * ks, lane), frag_tr(Vs, RC_LD, 32 * ks, 16 * vbk, lane), acc); }
#pragma unroll
            for (int r = 0; r < 4; ++r) Ys[(16 * tt + 4 * fq + r) * 68 + 16 * vbk + fr] = acc[r]; }
        lds_barrier();
        {
            float y[8]; lds8(Ys + t * 68 + k8, y);
            float s1 = 0.f, s2 = 0.f;
#pragma unroll
            for (int e = 0; e < 8; ++e) { s1 += y[e]; s2 += y[e] * y[e]; }
            s1 += __shfl_xor(s1, 1); s1 += __shfl_xor(s1, 2); s1 += __shfl_xor(s1, 4); s2 += __shfl_xor(s2, 1); s2 += __shfl_xor(s2, 2); s2 += __shfl_xor(s2, 4);
            const float mean = s1 * (1.0f / 64.0f), var = s2 * (1.0f / 64.0f) - mean * mean; const float rs = rsqrtf(fmaxf(var, 0.f) + 64e-5f);
            float o[8];
#pragma unroll
            for (int e = 0; e < 8; ++e) o[e] = ((y[e] - mean) * rs * lgw[e] + lbw[e] + bc * v[e]) * gg[e];
            *(u32x4*)(WS_(p, YB) + go) = pk8(o);
        }
    }
}
DEV void phase_ln1(const Params& p, int layer, LAS unsigned char* lds) {
    const int tid = tid_(), bid = bid_(); (void)tid; (void)bid;
    const int lane = tid & 63, wid = tid >> 6; const int fr = lane & 15, fq = lane >> 4;
    LAS float* lgt = (LAS float*)lds;
    LAS int* cnt = (LAS int*)(lgt + 2 * 64 * 48);
    if (tid < 32) cnt[tid] = 0;
    const float* g = p.ln_g + ((size_t)layer * 2 + 0) * D; const float* be = p.ln_b + ((size_t)layer * 2 + 0) * D;
    const float* br = p.moe_b_route + layer * 32; const float* bg = p.moe_b_group + layer * 4;
    f32x4 gwv[4], bwv[4];
#pragma unroll
    for (int q = 0; q < 4; ++q) { gwv[q] = *(const f32x4*)(g + 256 * q + 4 * lane); bwv[q] = *(const f32x4*)(be + 256 * q + 4 * lane); }
    u32x2 rh[4], rm[4];
#pragma unroll
    for (int q = 0; q < 4; ++q) { rh[q] = *(const u32x2*)(WS_(p, Hb) + (size_t)(bid * 64 + wid * 8) * D + 256 * q + 4 * lane); rm[q] = *(const u32x2*)(WS_(p, MIXb) + (size_t)(bid * 64 + wid * 8) * D + 256 * q + 4 * lane); }
#pragma unroll 1
    for (int rr = 0; rr < 8; ++rr) {
        const int t = bid * 64 + wid * 8 + rr; const size_t ro = (size_t)t * D;
        f32x4 z[4], m[4];
#pragma unroll
        for (int q = 0; q < 4; ++q) { z[q] = (f32x4){bflo(rh[q].x), bfhi(rh[q].x), bflo(rh[q].y), bfhi(rh[q].y)}; m[q] = (f32x4){bflo(rm[q].x), bfhi(rm[q].x), bflo(rm[q].y), bfhi(rm[q].y)}; }
        { const size_t rn = (size_t)(rr < 7 ? t + 1 : t) * D;
#pragma unroll
          for (int q = 0; q < 4; ++q) { rh[q] = *(const u32x2*)(WS_(p, Hb) + rn + 256 * q + 4 * lane); rm[q] = *(const u32x2*)(WS_(p, MIXb) + rn + 256 * q + 4 * lane); } }
        float s = 0.f;
#pragma unroll
        for (int q = 0; q < 4; ++q) { z[q] = z[q] * ALPHA + m[q]; s += z[q][0] + z[q][1] + z[q][2] + z[q][3]; }
        const float mean = wave_sum(s) * (1.0f / D);
        float vs = 0.f;
#pragma unroll
        for (int q = 0; q < 4; ++q) { z[q] = z[q] - mean; vs += z[q][0] * z[q][0] + z[q][1] * z[q][1] + z[q][2] * z[q][2] + z[q][3] * z[q][3]; }
        const float rs = rsqrtf(wave_sum(vs) * (1.0f / D) + LN_EPS);
#pragma unroll
        for (int q = 0; q < 4; ++q) {
            st_bf4(WS_(p, H1b) + ro + 256 * q + 4 * lane, z[q] * rs * gwv[q] + bwv[q]);
        }
    }
    asm volatile("s_waitcnt vmcnt(0)" ::: "memory");
    __syncthreads();
    {   const int rt = wid & 3, kh = wid >> 2;
        const bf16_t* Ab = WS_(p, H1b) + (size_t)(bid * 64 + 16 * rt + fr) * D + 512 * kh + 8 * fq;
        const bf16_t* Wb = WS_(p, moe_wr_t) + (size_t)layer * 48 * D + (size_t)fr * D + 512 * kh + 8 * fq;
        f32x4 acc[3]; for (int i = 0; i < 3; ++i) acc[i] = (f32x4){0.f, 0.f, 0.f, 0.f};
#pragma unroll 8
        for (int ks = 0; ks < 16; ++ks) {
            const bf16x8 af = *(const bf16x8*)(Ab + 32 * ks);
#pragma unroll
            for (int ct = 0; ct < 3; ++ct) acc[ct] = MFMA16(af, *(const bf16x8*)(Wb + (size_t)16 * ct * D + 32 * ks), acc[ct]);
        }
#pragma unroll
        for (int ct = 0; ct < 3; ++ct)
#pragma unroll
            for (int r = 0; r < 4; ++r) lgt[(kh * 64 + 16 * rt + 4 * fq + r) * 48 + 16 * ct + fr] = acc[ct][r];
    }
    __syncthreads();
    if (tid < 64) {
        const int t = bid * 64 + tid; const LAS float* L0 = lgt + tid * 48; const LAS float* L1 = lgt + (64 + tid) * 48;
        const float q0 = L0[32] + L1[32] + bg[0], q1 = L0[33] + L1[33] + bg[1], q2 = L0[34] + L1[34] + bg[2], q3 = L0[35] + L1[35] + bg[3];
        int gi = 0; float gm = q0;
        if (q1 > gm) { gm = q1; gi = 1; } if (q2 > gm) { gm = q2; gi = 2; } if (q3 > gm) { gm = q3; gi = 3; }
        const float den = __expf(q0 - gm) + __expf(q1 - gm) + __expf(q2 - gm) + __expf(q3 - gm);
        const float pgrp = __builtin_amdgcn_rcpf(den);
        float l1 = -INFINITY, l2 = -INFINITY; int i1 = 0, i2 = 0;
#pragma unroll 1
        for (int o = 0; o < 8; ++o) { const float v = L0[gi * 8 + o] + L1[gi * 8 + o] + br[gi * 8 + o];
            if (v > l1) { l2 = l1; i2 = i1; l1 = v; i1 = o; } else if (v > l2) { l2 = v; i2 = o; } }
        const float e2 = __expf(l2 - l1), inv = __builtin_amdgcn_rcpf(1.0f + e2);
        const int e0 = gi * 8 + i1, e1 = gi * 8 + i2;
        WS_(p, EIDX)[2 * t] = e0; WS_(p, EIDX)[2 * t + 1] = e1; WS_(p, GATE)[2 * t] = pgrp * inv; WS_(p, GATE)[2 * t + 1] = pgrp * e2 * inv;
        atomicAdd((int*)&cnt[e0], 1); atomicAdd((int*)&cnt[e1], 1);
    }
    __syncthreads();
    if (tid < 32) WS_(p, CNT)[bid * 32 + tid] = cnt[tid];
}

DEV void phase_moe_scatter(const Params& p, LAS unsigned char* lds) {
    const int tid = tid_(), bid = bid_(); (void)tid; (void)bid;
    const int lane = tid & 63, wid = tid >> 6;
    LAS int* part = (LAS int*)lds;
    LAS int* pre = part + 512;
    LAS int* base = pre + 512;
    LAS int* pst = base + 32;
    LAS int* dst = pst + 40;
    LAS int* eid = dst + 128;
    { const int e = tid & 31, part_i = tid >> 5; int tot = 0, prf = 0;
      for (int b = part_i * 16; b < part_i * 16 + 16; ++b) { const int c = WS_(p, CNT)[b * 32 + e]; tot += c; if (b < (int)bid) prf += c; }
      part[part_i * 32 + e] = tot; pre[part_i * 32 + e] = prf; }
    if (tid < 128) eid[tid] = WS_(p, EIDX)[bid * 128 + tid];
    lds_barrier();
    if (tid < 32) { int tot = 0, prf = 0; for (int i = 0; i < 16; ++i) { tot += part[i * 32 + tid]; prf += pre[i * 32 + tid]; } part[tid] = tot; pre[tid] = prf; }
    lds_barrier();
    if (tid == 0) { int acc = 0; for (int e = 0; e < 32; ++e) { pst[e] = acc; acc += ((part[e] + 255) >> 8) << 8; } pst[32] = acc;
        if (bid == 0) { for (int e = 0; e <= 32; ++e) WS_(p, TAB)[e] = pst[e]; WS_(p, TAB)[33] = acc >> 8;
            for (int e = 0; e < 32; ++e) for (int mt = pst[e] >> 8; mt < (pst[e + 1] >> 8); ++mt) WS_(p, TAB)[64 + mt] = e; } }
    lds_barrier();
    if (tid < 32) { int run = pst[tid] + pre[tid]; for (int a = 0; a < 128; ++a) if (eid[a] == tid) dst[a] = run++; }
    lds_barrier();
    if (tid < 128) WS_(p, DEST)[bid * 128 + tid] = dst[tid];
#pragma unroll 4
    for (int a = wid * 16; a < wid * 16 + 16; ++a) {
        const int t = bid * 64 + (a >> 1); const int d = dst[a];
        const u32x4 v0 = *(const u32x4*)(WS_(p, H1b) + (size_t)t * D + lane * 8), v1 = *(const u32x4*)(WS_(p, H1b) + (size_t)t * D + 512 + lane * 8);
        *(u32x4*)(WS_(p, BUF) + (size_t)d * D + lane * 8) = v0; *(u32x4*)(WS_(p, BUF) + (size_t)d * D + 512 + lane * 8) = v1;
    }
}

template <int which> struct SchedMoe {
    const Params* p; int layer; const LAS int* tab;
    DEV bool next(int i, Unit& u) const {
        const int nmt = tab[33]; int pm, pn; if (!pg8::tile_order(i, NB_, bid_(), nmt, 4, pm, pn)) return false;
        const int row0 = pm * 256; const int e = tab[64 + pm];
        if constexpr (which == 0) { u.A = (const char*)(WS_(*p, BUF) + (size_t)row0 * D); u.B = (const char*)(WS_(*p, moe_w1_t) + ((size_t)layer * 32 + e) * 1024 * 1024 + (size_t)pn * 256 * 1024); }
        else { u.A = (const char*)(WS_(*p, ACT) + (size_t)row0 * 512); u.B = (const char*)(WS_(*p, moe_w2_t) + ((size_t)layer * 32 + e) * 1024 * 512 + (size_t)pn * 256 * 512); }
        u.row0 = row0; u.col0 = pn * 256; u.id = e; u.aux = 0; return true;
    }
};
struct EpiMoe1 {
    bf16_t* O;
    DEV void operator()(const AccT& acc, const Unit& u, int wr, int wc, int fr, int fq) const {
#pragma unroll
        for (int ai = 0; ai < 2; ++ai)
#pragma unroll
            for (int m = 0; m < 4; ++m)
#pragma unroll
                for (int n = 0; n < 2; ++n) {
                    const f32x4 gt = acc[ai][0][m][n], up = acc[ai][1][m][n]; f32x4 v;
                    for (int e = 0; e < 4; ++e) v[e] = siluf_(gt[e]) * up[e];
                    const int col = (u.col0 >> 1) + 32 * wc + 16 * n + 4 * fq;
                    st_bf4(O + (size_t)ACC_ROW(u, ai, m) * 512 + col, v); ACC_FENCE;
                }
    }
};
struct EpiMoe2 {
    bf16_t* O;
    DEV void operator()(const AccT& acc, const Unit& u, int wr, int wc, int fr, int fq) const {
        FOR_ACC(ai, bj, m, n) { st_bf4(O + (size_t)ACC_ROW(u, ai, m) * D + ACC_COL(u, bj, n), acc[ai][bj][m][n]); ACC_FENCE; }
    }
};

struct Ln2Raw { u32x2 h[4], a[4], b[4]; float g0, g1; };
DEV void ln2_issue(const Params& p, int t, int lane, Ln2Raw& R, int dpre, float gpre, int tbase) {
    const int i0 = 2 * (t - tbase); const int d0 = __shfl(dpre, i0), d1 = __shfl(dpre, i0 + 1); R.g0 = __shfl(gpre, i0); R.g1 = __shfl(gpre, i0 + 1);
#pragma unroll
    for (int q = 0; q < 4; ++q) { R.h[q] = *(const u32x2*)(WS_(p, H1b) + (size_t)t * D + 256 * q + 4 * lane);
        R.a[q] = *(const u32x2*)(WS_(p, YBUF) + (size_t)d0 * D + 256 * q + 4 * lane); R.b[q] = *(const u32x2*)(WS_(p, YBUF) + (size_t)d1 * D + 256 * q + 4 * lane); }
}
DEV void ln2_finish(const Ln2Raw& R, const f32x4 (&gwv)[4], const f32x4 (&bwv)[4], f32x4 (&z)[4]) {
    float s = 0.f; const float g0 = R.g0, g1 = R.g1;
#pragma unroll
    for (int q = 0; q < 4; ++q) {
        z[q][0] = bflo(R.h[q].x) * ALPHA + g0 * bflo(R.a[q].x) + g1 * bflo(R.b[q].x); z[q][1] = bfhi(R.h[q].x) * ALPHA + g0 * bfhi(R.a[q].x) + g1 * bfhi(R.b[q].x);
        z[q][2] = bflo(R.h[q].y) * ALPHA + g0 * bflo(R.a[q].y) + g1 * bflo(R.b[q].y); z[q][3] = bfhi(R.h[q].y) * ALPHA + g0 * bfhi(R.a[q].y) + g1 * bfhi(R.b[q].y);
        s += z[q][0] + z[q][1] + z[q][2] + z[q][3];
    }
    const float mean = wave_sum(s) * (1.0f / D);
    float vs = 0.f;
#pragma unroll
    for (int q = 0; q < 4; ++q) { z[q] = z[q] - mean; vs += z[q][0] * z[q][0] + z[q][1] * z[q][1] + z[q][2] * z[q][2] + z[q][3] * z[q][3]; }
    const float rs = rsqrtf(wave_sum(vs) * (1.0f / D) + LN_EPS);
#pragma unroll
    for (int q = 0; q < 4; ++q) z[q] = z[q] * rs * gwv[q] + bwv[q];
}
DEV void phase_ln2(const Params& p, int layer, LAS unsigned char* lds) {
    const int tid = tid_(), bid = bid_(); const int lane = tid & 63, wid = tid >> 6; const int fr = lane & 15, fq = lane >> 4;
    const float* g = p.ln_g + ((size_t)layer * 2 + 1) * D; const float* be = p.ln_b + ((size_t)layer * 2 + 1) * D;
    const int nk = layer == DEPTH - 1 ? 3 : (layer + 1) % 3;
    const int nj = (layer + 1) / 3;
    LAS float* lgt = (LAS float*)lds;
    LAS float* w2 = lgt + 2 * 64 * 32;
    if (nk == 2) { for (int i = tid; i < 16 * 512; i += NTHR) w2[i] = p.gl_gk_w2[(size_t)nj * 16 * 512 + i]; }
    const int tfirst = bid * 64 + wid * 8;
    f32x4 z[4], zp[4], gwv[4], bwv[4];
#pragma unroll
    for (int q = 0; q < 4; ++q) { gwv[q] = *(const f32x4*)(g + 256 * q + 4 * lane); bwv[q] = *(const f32x4*)(be + 256 * q + 4 * lane); }
    Ln2Raw R0, R1;
    const int tbase = tfirst > 0 ? tfirst - 1 : 0;
    const int dpre = lane < 18 ? WS_(p, DEST)[2 * tbase + lane] : 0; const float gpre = lane < 18 ? WS_(p, GATE)[2 * tbase + lane] : 0.f;
    ln2_issue(p, tfirst, lane, R0, dpre, gpre, tbase);
    if (nk == 0) { if (tfirst > 0) { ln2_issue(p, tfirst - 1, lane, R1, dpre, gpre, tbase); ln2_finish(R1, gwv, bwv, zp); } else { for (int q = 0; q < 4; ++q) zp[q] = (f32x4){0.f, 0.f, 0.f, 0.f}; } }
#pragma unroll 1
    for (int rr = 0; rr < 8; ++rr) {
        const int t = tfirst + rr; const size_t ro = (size_t)t * D;
        ln2_issue(p, rr < 7 ? t + 1 : t, lane, R1, dpre, gpre, tbase);
        ln2_finish(R0, gwv, bwv, z);
        R0 = R1;
        if (nk == 3) {
#pragma unroll
            for (int q = 0; q < 4; ++q) *(f32x4*)(p.out + ro + 256 * q + 4 * lane) = z[q];
        } else store_row_bf(WS_(p, Hb) + ro, lane, z);
        if (nk == 0) {
            emit_mix6(p, nj, t, lane, z, zp);
#pragma unroll
            for (int q = 0; q < 4; ++q) zp[q] = z[q];
        }
    }
    if (nk == 1 || nk == 2) {
        asm volatile("s_waitcnt vmcnt(0)" ::: "memory");
        __syncthreads();
        const int nct = nk == 1 ? 2 : 1; const int rt = wid & 3, kh = wid >> 2;
        const bf16_t* Ab = WS_(p, Hb) + (size_t)(bid * 64 + 16 * rt + fr) * D + 512 * kh + 8 * fq;
        const bf16_t* Wb = (nk == 1 ? WS_(p, mb_dt_t) : WS_(p, gl_lr_t)) + (size_t)fr * D + 512 * kh + 8 * fq;
        f32x4 acc[2]; acc[0] = (f32x4){0.f, 0.f, 0.f, 0.f}; acc[1] = acc[0];
#pragma unroll 4
        for (int ks = 0; ks < 16; ++ks) {
            const bf16x8 af = *(const bf16x8*)(Ab + 32 * ks);
            acc[0] = MFMA16(af, *(const bf16x8*)(Wb + 32 * ks), acc[0]);
            if (nct == 2) acc[1] = MFMA16(af, *(const bf16x8*)(Wb + (size_t)16 * D + 32 * ks), acc[1]);
        }
#pragma unroll
        for (int ct = 0; ct < 2; ++ct)
#pragma unroll
            for (int r = 0; r < 4; ++r) lgt[(kh * 64 + 16 * rt + 4 * fq + r) * 32 + 16 * ct + fr] = acc[ct][r];
        __syncthreads();
        if (nk == 1) {
#pragma unroll
            for (int i = 0; i < 4; ++i) { const int idx = tid + i * NTHR; const int row = idx >> 5, o = idx & 31;
                WS_(p, DT)[(size_t)(bid * 64 + row) * 32 + o] = softplusf_(lgt[row * 32 + o] + lgt[(64 + row) * 32 + o] + p.mb_dt_bias[nj * 32 + o]); }
        } else {
            const int row = tid >> 3, c0 = (tid & 7) * 64; float lr[16];
#pragma unroll
            for (int o = 0; o < 16; ++o) lr[o] = lgt[row * 32 + o] + lgt[(64 + row) * 32 + o];
#pragma unroll 1
            for (int c4 = 0; c4 < 16; ++c4) { const int c = c0 + 4 * c4; f32x4 a = *(const f32x4*)(p.gl_gk_b + nj * 512 + c);
#pragma unroll
                for (int o = 0; o < 16; ++o) { const f32x4 wv = *(const LAS f32x4*)(w2 + o * 512 + c); a = a + wv * lr[o]; }
                f32x4 r;
#pragma unroll
                for (int e = 0; e < 4; ++e) r[e] = (fminf(a[e], 0.f) - __logf(1.0f + __expf(-fabsf(a[e])))) * (1.0f / 16.0f);
                *(f32x4*)(WS_(p, LA) + (size_t)(bid * 64 + row) * 512 + c) = r; }
        }
    }
}
constexpr int MB_PROJ = 5152;
struct SchedMbIn {
    const Params* p;
    DEV bool next(int i, Unit& u) const {
        int pm, pn; if (!pg8::tile_order(i, NB_, bid_(), 64, 20, pm, pn)) return false;
        u.A = (const char*)(WS_(*p, Hb) + (size_t)pm * 256 * D); u.B = (const char*)(WS_(*p, mb_win_t) + (size_t)pn * 256 * D); u.row0 = pm * 256; u.col0 = pn * 256; u.id = 0; u.aux = 0; return true;
    }
};
struct EpiMbIn {
    const Params* p;
    DEV void operator()(const AccT& acc, const Unit& u, int wr, int wc, int fr, int fq) const {
        const bool isz = u.col0 < 2048; bf16_t* O = WS_(*p, Z) + (isz ? (size_t)0 : (size_t)T * 2048 - 2048); const int ld = isz ? 2048 : 3072;
        FOR_ACC(ai, bj, m, n) { st_bf4(O + (size_t)ACC_ROW(u, ai, m) * ld + ACC_COL(u, bj, n), acc[ai][bj][m][n]); ACC_FENCE; }
    }
};
DEV void phase_mb_conv(const Params& p, int j) {
    const int tid = tid_(), bid = bid_(); (void)tid; (void)bid;
    if (tid >= 384) return;
    const int c0 = tid * 8; const int t0 = bid * 64;
    const float* cw = p.mb_conv_w + (size_t)j * 4 * 3072; const float* cb = p.mb_conv_b + (size_t)j * 3072;
    float w[4][8], b[8];
#pragma unroll
    for (int i = 0; i < 4; ++i) { const f32x4 a = *(const f32x4*)(cw + i * 3072 + c0), bb = *(const f32x4*)(cw + i * 3072 + c0 + 4); for (int e = 0; e < 4; ++e) { w[i][e] = a[e]; w[i][4 + e] = bb[e]; } }
    { const f32x4 a = *(const f32x4*)(cb + c0), bb = *(const f32x4*)(cb + c0 + 4); for (int e = 0; e < 4; ++e) { b[e] = a[e]; b[4 + e] = bb[e]; } }
    float x0[8], x1[8], x2[8], x3[8];
    auto ld = [&](int t, float (&x)[8]) {
        if (t < 0) { for (int e = 0; e < 8; ++e) x[e] = 0.f; return; }
        const u32x4 v = *(const u32x4*)(WS_(p, XBC) + (size_t)t * 3072 + c0);
        x[0] = bflo(v.x); x[1] = bfhi(v.x); x[2] = bflo(v.y); x[3] = bfhi(v.y); x[4] = bflo(v.z); x[5] = bfhi(v.z); x[6] = bflo(v.w); x[7] = bfhi(v.w);
    };
    ld(t0 - 3, x0); ld(t0 - 2, x1); ld(t0 - 1, x2);
#pragma unroll 4
    for (int tt = 0; tt < 64; ++tt) {
        ld(t0 + tt, x3);
        float o[8];
#pragma unroll
        for (int e = 0; e < 8; ++e) o[e] = siluf_(b[e] + w[0][e] * x0[e] + w[1][e] * x1[e] + w[2][e] * x2[e] + w[3][e] * x3[e]);
        u32x4 r; r.x = pk2(o[0], o[1]); r.y = pk2(o[2], o[3]); r.z = pk2(o[4], o[5]); r.w = pk2(o[6], o[7]);
        *(u32x4*)(WS_(p, XC) + (size_t)(t0 + tt) * 3072 + c0) = r;
#pragma unroll
        for (int e = 0; e < 8; ++e) { x0[e] = x1[e]; x1[e] = x2[e]; x2[e] = x3[e]; }
    }
}

DEV void mb_dacs(const Params& p, int j, int c, int g, LAS float* dts, LAS float* dacs) {
    const int tid = tid_(); const int lane = tid & 63, h = tid >> 6;
    const int hh = 8 * g + h; const float a = -__expf(p.mb_a_log[j * 32 + hh]);
    const float d0 = WS_(p, DT)[(size_t)(c * 128 + 2 * lane) * 32 + hh], d1 = WS_(p, DT)[(size_t)(c * 128 + 2 * lane + 1) * 32 + hh];
    const float a0 = d0 * a, a1 = d1 * a;
    float s = a0 + a1;
#pragma unroll
    for (int o = 1; o < 64; o <<= 1) { const float v = __shfl_up(s, o); if (lane >= o) s += v; }
    dts[h * 128 + 2 * lane] = d0; dts[h * 128 + 2 * lane + 1] = d1;
    dacs[h * 128 + 2 * lane] = s - a1; dacs[h * 128 + 2 * lane + 1] = s;
}
constexpr int LDB = 136;
constexpr int LDX = 72;
DEV void ld_tile128(const bf16_t* src, int gld, LAS bf16_t* dst) {
    const int tid = tid_();
    for (int i = tid; i < 128 * 16; i += NTHR) { const int r = i >> 4, c8 = (i & 15) * 8; *(LAS u32x4*)(dst + r * LDB + c8) = *(const u32x4*)(src + (size_t)r * gld + c8); }
}

DEV void phase_mb_states(const Params& p, int j, LAS unsigned char* lds) {
    const int tid = tid_(), bid = bid_(); (void)tid; (void)bid;
    const int lane = tid & 63, w = tid >> 6;
    LAS bf16_t* Bm = (LAS bf16_t*)lds;
    LAS bf16_t* Xh = Bm + 128 * LDB;
    LAS float* dts = (LAS float*)(Xh + 128 * LDX);
    LAS float* dacs = dts + 1024;
    for (int u = bid; u < 512; u += NB_) {
        const int c = u >> 2, g = u & 3; const int t0 = c * 128;
        lds_barrier();
        mb_dacs(p, j, c, g, dts, dacs);
        ld_tile128(WS_(p, XC) + (size_t)t0 * 3072 + 2048 + 128 * g, 3072, Bm);
        lds_barrier();
        if (tid < 8) WS_(p, CD)[(c * 32) + 8 * g + tid] = __expf(dacs[tid * 128 + 127]);
        bf16x8 bfr[4];
#pragma unroll
        for (int ks = 0; ks < 4; ++ks) bfr[ks] = frag_tr(Bm, LDB, 32 * ks, 16 * w, lane);
        for (int h = 0; h < 8; ++h) {
            { const int l = tid >> 2, p0 = (tid & 3) * 16; const float sc = dts[h * 128 + l] * __expf(dacs[h * 128 + 127] - dacs[h * 128 + l]);
              const bf16_t* src = WS_(p, XC) + (size_t)(t0 + l) * 3072 + 64 * (8 * g + h) + p0;
#pragma unroll
              for (int hf = 0; hf < 2; ++hf) { const u32x4 v = *(const u32x4*)(src + 8 * hf); u32x4 r;
                  r.x = pk2(bflo(v.x) * sc, bfhi(v.x) * sc); r.y = pk2(bflo(v.y) * sc, bfhi(v.y) * sc); r.z = pk2(bflo(v.z) * sc, bfhi(v.z) * sc); r.w = pk2(bflo(v.w) * sc, bfhi(v.w) * sc);
                  *(LAS u32x4*)(Xh + l * LDX + p0 + 8 * hf) = r; } }
            lds_barrier();
            f32x4 acc[4];
#pragma unroll
            for (int pb = 0; pb < 4; ++pb) { acc[pb] = (f32x4){0.f, 0.f, 0.f, 0.f};
#pragma unroll
                for (int ks = 0; ks < 4; ++ks) { const bf16x8 af = frag_tr(Xh, LDX, 32 * ks, 16 * pb, lane); acc[pb] = MFMA16(af, bfr[ks], acc[pb]); } }
            bf16_t* S = WS_(p, STATES) + (((size_t)c * 32 + 8 * g + h) * 64) * 128;
#pragma unroll
            for (int pb = 0; pb < 4; ++pb)
#pragma unroll
                for (int r = 0; r < 4; ++r) S[(size_t)(16 * pb + 4 * (lane >> 4) + r) * 128 + 16 * w + (lane & 15)] = (bf16_t)f2bf(acc[pb][r]);
            lds_barrier();
        }
    }
}
DEV void phase_mb_scan(const Params& p) {
    const int tid = tid_(), bid = bid_(); (void)tid; (void)bid;
    const int gid = bid * NTHR + tid;
    if (gid >= 32 * 64 * 64) return;
    const int np = gid & 63, pp = (gid >> 6) & 63, h = gid >> 12; const int n = 2 * np;
    float r0 = 0.f, r1 = 0.f;
    const size_t eo = ((size_t)h * 64 + pp) * 128 + n;
    const size_t fo = (size_t)h * 64 * 128 + fragmajor_off(pp, n, 128);
#pragma unroll 16
    for (int c = 0; c < 128; ++c) {
        const unsigned sraw = *(const unsigned*)(WS_(p, STATES) + (size_t)c * 32 * 64 * 128 + eo); const f32x2 s = {bflo(sraw), bfhi(sraw)};
        const float cd = WS_(p, CD)[c * 32 + h];
        *(unsigned*)(WS_(p, PREV) + (size_t)c * 32 * 64 * 128 + fo) = pk2(r0, r1);
        r0 = r0 * cd + s[0]; r1 = r1 * cd + s[1];
    }
}
DEV void phase_mb_out(const Params& p, int j, LAS unsigned char* lds) {
    const int tid = tid_(), bid = bid_(); (void)tid; (void)bid;
    const int lane = tid & 63, w = tid >> 6; const int fr = lane & 15, fq = lane >> 4;
    LAS bf16_t* Cm = (LAS bf16_t*)lds;
    LAS bf16_t* Bm = Cm + 128 * LDB;
    LAS bf16_t* Xh = Bm + 128 * LDB;
    LAS bf16_t* Mw = Xh + 128 * LDX;
    LAS float* dts = (LAS float*)(Mw + 8 * 16 * LDB);
    LAS float* dacs = dts + 1024;
    LAS bf16_t* Mme = Mw + w * 16 * LDB;
    for (int u = bid; u < 512; u += NB_) {
        const int c = u >> 2, g = u & 3; const int t0 = c * 128;
        lds_barrier();
        mb_dacs(p, j, c, g, dts, dacs);
        ld_tile128(WS_(p, XC) + (size_t)t0 * 3072 + 2048 + 512 + 128 * g, 3072, Cm);
        ld_tile128(WS_(p, XC) + (size_t)t0 * 3072 + 2048 + 128 * g, 3072, Bm);
        lds_barrier();
        f32x4 sc[8]; bf16x8 cf[4];
#pragma unroll
        for (int ks = 0; ks < 4; ++ks) cf[ks] = frag_rm(Cm, LDB, 16 * w, 32 * ks, lane);
#pragma unroll
        for (int sb = 0; sb < 8; ++sb) { sc[sb] = (f32x4){0.f, 0.f, 0.f, 0.f};
#pragma unroll
            for (int ks = 0; ks < 4; ++ks) sc[sb] = MFMA16(cf[ks], frag_rm(Bm, LDB, 16 * sb, 32 * ks, lane), sc[sb]); }
        float ssq = 0.f;
        const int rl = tid >> 2, p0 = (tid & 3) * 16;
        const LAS float* Yrow = (const LAS float*)(Mw + (rl >> 4) * 16 * LDB) + (rl & 15) * 68 + p0;
        LAS float* Yw = (LAS float*)Mme;
        u32x4 xraw[2], zraw[2], xnx[2], znx[2]; bf16x8 pfc[16];
#define MB_LOADH(HH, XR, ZR) do { const int hh_ = 8 * g + (HH); \
            XR[0] = *(const u32x4*)(WS_(p, XC) + (size_t)(t0 + rl) * 3072 + 64 * hh_ + p0); XR[1] = *(const u32x4*)(WS_(p, XC) + (size_t)(t0 + rl) * 3072 + 64 * hh_ + p0 + 8); \
            ZR[0] = *(const u32x4*)(WS_(p, Z) + (size_t)(t0 + rl) * 2048 + 64 * hh_ + p0); ZR[1] = *(const u32x4*)(WS_(p, Z) + (size_t)(t0 + rl) * 2048 + 64 * hh_ + p0 + 8); } while (0)
        MB_LOADH(0, xraw, zraw);
#pragma unroll 1
        for (int h = 0; h < 8; ++h) {
            const int hh = 8 * g + h;
            MB_LOADH(h < 7 ? h + 1 : h, xnx, znx);
            { const bf16_t* pv_ = WS_(p, PREV) + ((size_t)c * 32 + hh) * 64 * 128;
#pragma unroll
              for (int i_ = 0; i_ < 16; ++i_) pfc[i_] = *(const bf16x8*)(pv_ + ((size_t)i_ * 64 + lane) * 8); }
            { const float scl = dts[h * 128 + rl];
#pragma unroll
              for (int hf = 0; hf < 2; ++hf) { const u32x4 v = xraw[hf]; u32x4 r;
                  r.x = pk2(bflo(v.x) * scl, bfhi(v.x) * scl); r.y = pk2(bflo(v.y) * scl, bfhi(v.y) * scl); r.z = pk2(bflo(v.z) * scl, bfhi(v.z) * scl); r.w = pk2(bflo(v.w) * scl, bfhi(v.w) * scl);
                  *(LAS u32x4*)(Xh + rl * LDX + p0 + 8 * hf) = r; } }
            const u32x4 zraw0 = zraw[0], zraw1 = zraw[1];
            float dl[4];
#pragma unroll
            for (int r = 0; r < 4; ++r) dl[r] = dacs[h * 128 + 16 * w + 4 * fq + r];
#pragma unroll
            for (int sb = 0; sb < 8; ++sb) { const int s_ = 16 * sb + fr; const float ds = dacs[h * 128 + s_];
#pragma unroll
                for (int r = 0; r < 4; ++r) { const int l = 16 * w + 4 * fq + r; const float m = (s_ <= l) ? sc[sb][r] * __expf(dl[r] - ds) : 0.f; Mme[(4 * fq + r) * LDB + s_] = (bf16_t)f2bf(m); } }
            lds_barrier();
            bf16x8 mf[4];
#pragma unroll
            for (int ks = 0; ks < 4; ++ks) mf[ks] = frag_rm(Mme, LDB, 0, 32 * ks, lane);
            f32x4 yv[4];
#pragma unroll
            for (int pb = 0; pb < 4; ++pb) {
                f32x4 a = {0.f, 0.f, 0.f, 0.f}, o = {0.f, 0.f, 0.f, 0.f};
#pragma unroll
                for (int ks = 0; ks < 4; ++ks) {
                    a = MFMA16(mf[ks], frag_tr(Xh, LDX, 32 * ks, 16 * pb, lane), a);
                    o = MFMA16(cf[ks], pfc[pb * 4 + ks], o);
                }
#pragma unroll
                for (int r = 0; r < 4; ++r) a[r] += o[r] * __expf(dl[r]);
                yv[pb] = a;
            }
#pragma unroll
            for (int pb = 0; pb < 4; ++pb)
#pragma unroll
                for (int r = 0; r < 4; ++r) Yw[(4 * fq + r) * 68 + 16 * pb + fr] = yv[pb][r];
            lds_barrier();
            {
                const float dsk = p.mb_d[j * 32 + hh]; const float* ng = p.mb_norm_g + (size_t)j * 2048 + 64 * hh + p0;
                float y[16], xs[16], zz[16];
#pragma unroll
                for (int q = 0; q < 4; ++q) { const f32x4 t4 = *(const LAS f32x4*)(Yrow + 4 * q); y[4 * q] = t4[0]; y[4 * q + 1] = t4[1]; y[4 * q + 2] = t4[2]; y[4 * q + 3] = t4[3]; }
                xs[0] = bflo(xraw[0].x); xs[1] = bfhi(xraw[0].x); xs[2] = bflo(xraw[0].y); xs[3] = bfhi(xraw[0].y); xs[4] = bflo(xraw[0].z); xs[5] = bfhi(xraw[0].z); xs[6] = bflo(xraw[0].w); xs[7] = bfhi(xraw[0].w);
                xs[8] = bflo(xraw[1].x); xs[9] = bfhi(xraw[1].x); xs[10] = bflo(xraw[1].y); xs[11] = bfhi(xraw[1].y); xs[12] = bflo(xraw[1].z); xs[13] = bfhi(xraw[1].z); xs[14] = bflo(xraw[1].w); xs[15] = bfhi(xraw[1].w);
                zz[0] = bflo(zraw0.x); zz[1] = bfhi(zraw0.x); zz[2] = bflo(zraw0.y); zz[3] = bfhi(zraw0.y); zz[4] = bflo(zraw0.z); zz[5] = bfhi(zraw0.z); zz[6] = bflo(zraw0.w); zz[7] = bfhi(zraw0.w);
                zz[8] = bflo(zraw1.x); zz[9] = bfhi(zraw1.x); zz[10] = bflo(zraw1.y); zz[11] = bfhi(zraw1.y); zz[12] = bflo(zraw1.z); zz[13] = bfhi(zraw1.z); zz[14] = bflo(zraw1.w); zz[15] = bfhi(zraw1.w);
                float o[16];
#pragma unroll
                for (int q = 0; q < 4; ++q) { const f32x4 n4 = *(const f32x4*)(ng + 4 * q);
#pragma unroll
                    for (int e = 0; e < 4; ++e) { const int i = 4 * q + e; const float v = (y[i] + xs[i] * dsk) * siluf_(zz[i]); ssq += v * v; o[i] = v * n4[e]; } }
                bf16_t* dst = WS_(p, YB) + (size_t)(t0 + rl) * 2048 + 64 * hh + p0;
                u32x4 w0, w1; w0.x = pk2(o[0], o[1]); w0.y = pk2(o[2], o[3]); w0.z = pk2(o[4], o[5]); w0.w = pk2(o[6], o[7]); w1.x = pk2(o[8], o[9]); w1.y = pk2(o[10], o[11]); w1.z = pk2(o[12], o[13]); w1.w = pk2(o[14], o[15]);
                *(u32x4*)dst = w0; *(u32x4*)(dst + 8) = w1;
            }
            xraw[0] = xnx[0]; xraw[1] = xnx[1]; zraw[0] = znx[0]; zraw[1] = znx[1];
            lds_barrier();
        }
#undef MB_LOADH
        ssq += __shfl_xor(ssq, 1); ssq += __shfl_xor(ssq, 2);
        const float rstd = rsqrtf(ssq * (1.0f / 512.0f) + 1e-5f);
#pragma unroll 1
        for (int h = 0; h < 8; ++h) {
            bf16_t* dst = WS_(p, YB) + (size_t)(t0 + rl) * 2048 + 64 * (8 * g + h) + p0;
#pragma unroll
            for (int hf = 0; hf < 2; ++hf) { const u32x4 v = *(const u32x4*)(dst + 8 * hf); u32x4 r;
                r.x = pk2(bflo(v.x) * rstd, bfhi(v.x) * rstd); r.y = pk2(bflo(v.y) * rstd, bfhi(v.y) * rstd); r.z = pk2(bflo(v.z) * rstd, bfhi(v.z) * rstd); r.w = pk2(bflo(v.w) * rstd, bfhi(v.w) * rstd);
                *(u32x4*)(dst + 8 * hf) = r; }
        }
    }
}
constexpr int GL_PROJ = 3088;
constexpr int LDV = 264;
struct SchedGlIn {
    const Params* p;
    DEV bool next(int i, Unit& u) const {
        int pm, pn; if (!pg8::tile_order(i, NB_, bid_(), 64, 12, pm, pn)) return false;
        u.A = (const char*)(WS_(*p, Hb) + (size_t)pm * 256 * D); u.B = (const char*)(WS_(*p, gl_win_t) + (size_t)pn * 256 * D); u.row0 = pm * 256; u.col0 = pn * 256; u.id = 0; u.aux = 0; return true;
    }
};
struct EpiGlIn {
    const Params* p;
    DEV void operator()(const AccT& acc, const Unit& u, int wr, int wc, int fr, int fq) const {
        FOR_ACC(ai, bj, m, n) { st_bf4(WS_(*p, QKVG) + (size_t)ACC_ROW(u, ai, m) * 3072 + ACC_COL(u, bj, n), acc[ai][bj][m][n]); ACC_FENCE; }
    }
};
DEV void gl_bcs(const Params& p, int n, int h, LAS float* bcs) {
    const int tid = tid_();
    for (int i = tid; i < 64 * 32; i += NTHR) { const int r = i >> 5, c4 = (i & 31) * 4; *(LAS f32x4*)(bcs + r * 128 + c4) = *(const f32x4*)(WS_(p, LA) + (size_t)(n * 64 + r) * 512 + 128 * h + c4); }
    lds_barrier();
    if (tid < 128) { float s = 0.f; for (int r = 0; r < 64; ++r) { s += bcs[r * 128 + tid]; bcs[r * 128 + tid] = s; } }
    lds_barrier();
}
DEV void phase_gl_kv(const Params& p, LAS unsigned char* lds) {
    const int tid = tid_(), bid = bid_(); (void)tid; (void)bid;
    const int lane = tid & 63, w = tid >> 6;
    LAS float* bcs = (LAS float*)lds;
    LAS bf16_t* Ke = (LAS bf16_t*)(bcs + 64 * 128);
    LAS bf16_t* Vs = Ke + 64 * LDB;
    for (int u = bid; u < 1024; u += NB_) {
        const int n = u >> 2, h = u & 3; const int t0 = n * 64;
        lds_barrier();
        gl_bcs(p, n, h, bcs);
        for (int i = tid; i < 64 * 16; i += NTHR) { const int r = i >> 4, c8 = (i & 15) * 8;
            const u32x4 v = *(const u32x4*)(WS_(p, QKVG) + (size_t)(t0 + r) * 3072 + 512 + 128 * h + c8); float f[8];
            f[0] = bflo(v.x); f[1] = bfhi(v.x); f[2] = bflo(v.y); f[3] = bfhi(v.y); f[4] = bflo(v.z); f[5] = bfhi(v.z); f[6] = bflo(v.w); f[7] = bfhi(v.w);
#pragma unroll
            for (int e = 0; e < 8; ++e) f[e] *= __expf(bcs[63 * 128 + c8 + e] - bcs[r * 128 + c8 + e]);
            u32x4 o; o.x = pk2(f[0], f[1]); o.y = pk2(f[2], f[3]); o.z = pk2(f[4], f[5]); o.w = pk2(f[6], f[7]);
            *(LAS u32x4*)(Ke + r * LDB + c8) = o; }
        for (int i = tid; i < 64 * 32; i += NTHR) { const int r = i >> 5, c8 = (i & 31) * 8; *(LAS u32x4*)(Vs + r * LDV + c8) = *(const u32x4*)(WS_(p, QKVG) + (size_t)(t0 + r) * 3072 + 1024 + 256 * h + c8); }
        if (tid < 128) WS_(p, CDG)[((size_t)n * 4 + h) * 128 + tid] = __expf(bcs[63 * 128 + tid]);
        lds_barrier();
        bf16x8 af[2];
#pragma unroll
        for (int ks = 0; ks < 2; ++ks) af[ks] = frag_tr(Ke, LDB, 32 * ks, 16 * w, lane);
        bf16_t* O = WS_(p, STATES) + (((size_t)n * 4 + h) * 128) * 256;
#pragma unroll
        for (int vb = 0; vb < 16; ++vb) {
            f32x4 acc = {0.f, 0.f, 0.f, 0.f};
#pragma unroll
            for (int ks = 0; ks < 2; ++ks) acc = MFMA16(af[ks], frag_tr(Vs, LDV, 32 * ks, 16 * vb, lane), acc);
#pragma unroll
            for (int r = 0; r < 4; ++r) O[(size_t)(16 * w + 4 * (lane >> 4) + r) * 256 + 16 * vb + (lane & 15)] = (bf16_t)f2bf(acc[r]);
        }
    }
}
DEV void phase_gl_scan(const Params& p) {
    const int tid = tid_(), bid = bid_(); (void)tid; (void)bid;
    const int gid = bid * NTHR + tid;
    if (gid >= 4 * 64 * 256) return;
    const int v = gid & 255, kp = (gid >> 8) & 63, h = gid >> 14; const int k = 2 * kp;
    float r0 = 0.f, r1 = 0.f;
    const size_t fo = (size_t)h * 128 * 256 + fragmajor_off(v, k, 128);
#pragma unroll 16
    for (int n = 0; n < 256; ++n) {
        const bf16_t* S = WS_(p, STATES) + (((size_t)n * 4 + h) * 128) * 256;
        const float s0 = bf2f(S[(size_t)k * 256 + v]), s1 = bf2f(S[(size_t)(k + 1) * 256 + v]);
        const f32x2 cd = *(const f32x2*)(WS_(p, CDG) + ((size_t)n * 4 + h) * 128 + k);
        *(unsigned*)(WS_(p, PREV) + (size_t)n * 4 * 128 * 256 + fo) = pk2(r0, r1);
        r0 = r0 * cd[0] + s0; r1 = r1 * cd[1] + s1;
    }
}
DEV void phase_gl_out(const Params& p, int j, LAS unsigned char* lds) {
    const int tid = tid_(), bid = bid_(); (void)tid; (void)bid;
    const int lane = tid & 63, w = tid >> 6; const int fr = lane & 15, fq = lane >> 4;
    LAS float* bcs = (LAS float*)lds;
    LAS bf16_t* Qs = (LAS bf16_t*)(bcs + 64 * 128);
    LAS bf16_t* Ks = Qs + 64 * LDB;
    LAS bf16_t* Vs = Ks + 64 * LDB;
    LAS bf16_t* At = Vs + 64 * LDV;
    LAS float* red = (LAS float*)(At + 64 * LDX);
    for (int u = bid; u < 1024; u += NB_) {
        const int n = u >> 2, h = u & 3; const int t0 = n * 64;
        lds_barrier();
        gl_bcs(p, n, h, bcs);
        for (int i = tid; i < 64 * 16; i += NTHR) { const int r = i >> 4, c8 = (i & 15) * 8;
            const u32x4 vq = *(const u32x4*)(WS_(p, QKVG) + (size_t)(t0 + r) * 3072 + 128 * h + c8), vk = *(const u32x4*)(WS_(p, QKVG) + (size_t)(t0 + r) * 3072 + 512 + 128 * h + c8);
            float fq_[8], fk_[8];
            fq_[0] = bflo(vq.x); fq_[1] = bfhi(vq.x); fq_[2] = bflo(vq.y); fq_[3] = bfhi(vq.y); fq_[4] = bflo(vq.z); fq_[5] = bfhi(vq.z); fq_[6] = bflo(vq.w); fq_[7] = bfhi(vq.w);
            fk_[0] = bflo(vk.x); fk_[1] = bfhi(vk.x); fk_[2] = bflo(vk.y); fk_[3] = bfhi(vk.y); fk_[4] = bflo(vk.z); fk_[5] = bfhi(vk.z); fk_[6] = bflo(vk.w); fk_[7] = bfhi(vk.w);
#pragma unroll
            for (int e = 0; e < 8; ++e) { const float b = bcs[r * 128 + c8 + e]; fq_[e] *= __expf(b) * 0.08838834764831845f; fk_[e] *= __expf(-b); }
            u32x4 o; o.x = pk2(fq_[0], fq_[1]); o.y = pk2(fq_[2], fq_[3]); o.z = pk2(fq_[4], fq_[5]); o.w = pk2(fq_[6], fq_[7]);
            *(LAS u32x4*)(Qs + r * LDB + c8) = o;
            o.x = pk2(fk_[0], fk_[1]); o.y = pk2(fk_[2], fk_[3]); o.z = pk2(fk_[4], fk_[5]); o.w = pk2(fk_[6], fk_[7]);
            *(LAS u32x4*)(Ks + r * LDB + c8) = o; }
        for (int i = tid; i < 64 * 32; i += NTHR) { const int r = i >> 5, c8 = (i & 31) * 8; *(LAS u32x4*)(Vs + r * LDV + c8) = *(const u32x4*)(WS_(p, QKVG) + (size_t)(t0 + r) * 3072 + 1024 + 256 * h + c8); }
        lds_barrier();
        { const int ib = w >> 1;
#pragma unroll
          for (int jj = 0; jj < 2; ++jj) { const int jb = 2 * (w & 1) + jj; f32x4 a = {0.f, 0.f, 0.f, 0.f};
#pragma unroll
              for (int ks = 0; ks < 4; ++ks) a = MFMA16(frag_rm(Qs, LDB, 16 * ib, 32 * ks, lane), frag_rm(Ks, LDB, 16 * jb, 32 * ks, lane), a);
#pragma unroll
              for (int r = 0; r < 4; ++r) { const int i = 16 * ib + 4 * fq + r, jx = 16 * jb + fr; At[i * LDX + jx] = (bf16_t)f2bf(jx <= i ? a[r] : 0.f); } } }
        lds_barrier();
        f32x4 o[4][2];
        const bf16_t* pv = WS_(p, PREV) + ((size_t)n * 4 + h) * 128 * 256;
#pragma unroll
        for (int vv = 0; vv < 2; ++vv) { const int vb = 2 * w + vv;
            bf16x8 bi[2], bp[4];
#pragma unroll
            for (int ks = 0; ks < 2; ++ks) bi[ks] = frag_tr(Vs, LDV, 32 * ks, 16 * vb, lane);
#pragma unroll
            for (int ks = 0; ks < 4; ++ks) bp[ks] = *(const bf16x8*)(pv + ((size_t)(vb * 4 + ks) * 64 + lane) * 8);
#pragma unroll
            for (int ib = 0; ib < 4; ++ib) { f32x4 a = {0.f, 0.f, 0.f, 0.f};
#pragma unroll
                for (int ks = 0; ks < 2; ++ks) a = MFMA16(frag_rm(At, LDX, 16 * ib, 32 * ks, lane), bi[ks], a);
#pragma unroll
                for (int ks = 0; ks < 4; ++ks) a = MFMA16(frag_rm(Qs, LDB, 16 * ib, 32 * ks, lane), bp[ks], a);
                o[ib][vv] = a; } }
#pragma unroll
        for (int ib = 0; ib < 4; ++ib)
#pragma unroll
            for (int r = 0; r < 4; ++r) { float s = o[ib][0][r] * o[ib][0][r] + o[ib][1][r] * o[ib][1][r]; s = sum16(s); if (fr == 0) red[w * 64 + 16 * ib + 4 * fq + r] = s; }
        lds_barrier();
        {   LAS bf16_t* Os = (LAS bf16_t*)bcs;
#pragma unroll
            for (int ib = 0; ib < 4; ++ib)
#pragma unroll
                for (int vv = 0; vv < 2; ++vv)
#pragma unroll
                    for (int r = 0; r < 4; ++r) Os[(16 * ib + 4 * fq + r) * LDV + 32 * w + 16 * vv + fr] = (bf16_t)f2bf(o[ib][vv][r]);
            lds_barrier();
            const int row = tid >> 3, c0 = (tid & 7) * 32; const int t = t0 + row; float s = 0.f;
#pragma unroll
            for (int ww = 0; ww < 8; ++ww) s += red[ww * 64 + row];
            const float rs = rsqrtf(s * (1.0f / 256.0f) + 1e-5f);
#pragma unroll
            for (int q = 0; q < 4; ++q) {
                const u32x4 ov = *(const LAS u32x4*)(Os + row * LDV + c0 + 8 * q), gv = *(const u32x4*)(WS_(p, QKVG) + (size_t)t * 3072 + 2048 + 256 * h + c0 + 8 * q);
                const f32x4 n0 = *(const f32x4*)(p.gl_norm_g + j * 256 + c0 + 8 * q), n1 = *(const f32x4*)(p.gl_norm_g + j * 256 + c0 + 8 * q + 4);
                float r8[8];
                r8[0] = bflo(ov.x) * rs * n0[0] * siluf_(bflo(gv.x)); r8[1] = bfhi(ov.x) * rs * n0[1] * siluf_(bfhi(gv.x)); r8[2] = bflo(ov.y) * rs * n0[2] * siluf_(bflo(gv.y)); r8[3] = bfhi(ov.y) * rs * n0[3] * siluf_(bfhi(gv.y));
                r8[4] = bflo(ov.z) * rs * n1[0] * siluf_(bflo(gv.z)); r8[5] = bfhi(ov.z) * rs * n1[1] * siluf_(bfhi(gv.z)); r8[6] = bflo(ov.w) * rs * n1[2] * siluf_(bflo(gv.w)); r8[7] = bfhi(ov.w) * rs * n1[3] * siluf_(bfhi(gv.w));
                u32x4 wv; wv.x = pk2(r8[0], r8[1]); wv.y = pk2(r8[2], r8[3]); wv.z = pk2(r8[4], r8[5]); wv.w = pk2(r8[6], r8[7]);
                *(u32x4*)(WS_(p, YB) + (size_t)t * D + 256 * h + c0 + 8 * q) = wv;
            }
        }
    }
}
#define XB_TMO      128
#define XB_XCNT(j)  (256  + 64 * (j))
#define XB_XSUB(j)  (1280 + 64 * (j))
#define XB_XGEN(j)  (2304 + 64 * (j))
#define XB_TOP      3328
#define XB_TOPGEN   3392
#define XCD_BAR_WORDS 3456
#define XB_SPIN_CAP (1u << 22)
DEV unsigned xb_ld(unsigned* p)              { return __hip_atomic_load(p, __ATOMIC_RELAXED, __HIP_MEMORY_SCOPE_AGENT); }
DEV unsigned xb_add(unsigned* p, unsigned v) { return __hip_atomic_fetch_add(p, v, __ATOMIC_RELAXED, __HIP_MEMORY_SCOPE_AGENT); }
DEV unsigned xb_xcc_id() { return (unsigned)__builtin_amdgcn_s_getreg((3 << 11) | 20) & 0xFu; }
#define XB_SPIN(cond, bar) do { unsigned _sp = 0; while (cond) { __builtin_amdgcn_s_sleep(1); \
    if ((++_sp & 255u) == 0u) { if (xb_ld(&(bar)[XB_TMO])) break; if (_sp > XB_SPIN_CAP) { atomicAdd(&(bar)[XB_TMO], 1u); break; } } } } while (0)
struct XcdBarrier { unsigned* bar; unsigned x; volatile LAS unsigned* st; };
DEV XcdBarrier xcd_barrier_post(unsigned* bar, volatile LAS unsigned* st) {
    XcdBarrier b; b.bar = bar; b.x = xb_xcc_id(); b.st = st;
    if (threadIdx.x == 0) (void)xb_add(&bar[XB_XCNT(b.x)], 1u);
    return b;
}
DEV void xcd_barrier_complete(unsigned* bar, unsigned x, unsigned& nloc, unsigned& nx) {
    const unsigned G = gridDim.x * gridDim.y * gridDim.z;
    unsigned sum, cnt, mine, sp = 0u;
    for (;;) {
        sum = 0u; cnt = 0u; mine = 0u;
#pragma unroll
        for (unsigned j = 0; j < 16; ++j) { const unsigned c = xb_ld(&bar[XB_XCNT(j)]); sum += c; cnt += (c > 0u) ? 1u : 0u; mine = (j == x) ? c : mine; }
        if (sum == G) break;
        __builtin_amdgcn_s_sleep(1);
        if ((++sp & 255u) == 0u) { if (xb_ld(&bar[XB_TMO])) break; if (sp > XB_SPIN_CAP) { atomicAdd(&bar[XB_TMO], 1u); break; } }
    }
    nloc = mine > 0u ? mine : 1u; nx = cnt > 0u ? cnt : 1u;
}
DEV void xcd_barrier(const XcdBarrier& b) {
    asm volatile("s_waitcnt vmcnt(0)" ::: "memory");
    __syncthreads();
    if (threadIdx.x == 0) {
        unsigned* bar = b.bar;
        __builtin_amdgcn_s_waitcnt(0);
        unsigned nloc = b.st[0], nx = b.st[1];
        if (nloc == 0u) { xcd_barrier_complete(bar, b.x, nloc, nx); b.st[0] = nloc; b.st[1] = nx; }
        const unsigned old = xb_add(&bar[XB_XSUB(b.x)], 1u);
        const unsigned gen = old / nloc;
        if (old + 1u == (gen + 1u) * nloc) {
            __builtin_amdgcn_fence(__ATOMIC_RELEASE, "agent");
            asm volatile("s_waitcnt vmcnt(0)" ::: "memory");
            const unsigned og = xb_add(&bar[XB_TOP], 1u);
            const unsigned tg = og / nx;
            if (og + 1u == (tg + 1u) * nx) xb_add(&bar[XB_TOPGEN], 1u);
            else XB_SPIN(xb_ld(&bar[XB_TOPGEN]) == tg, bar);
            __builtin_amdgcn_fence(__ATOMIC_ACQUIRE, "agent");
            xb_add(&bar[XB_XGEN(b.x)], 1u);
            asm volatile("s_waitcnt vmcnt(0)" ::: "memory");
        } else {
            XB_SPIN(xb_ld(&bar[XB_XGEN(b.x)]) == gen, bar);
            __builtin_amdgcn_fence(__ATOMIC_ACQUIRE, "agent");
            asm volatile("s_waitcnt vmcnt(0)" ::: "memory");
        }
    }
    __syncthreads();
}

DEV LAS int* moe_tab_to_lds(const Params& p, LAS unsigned char* lds) {
    LAS int* tab = (LAS int*)(lds + pg8::STAGE_BYTES);
    const int tid = tid_();
    if (tid < 256) tab[tid] = __hip_atomic_load(WS_(p, TAB) + tid, __ATOMIC_RELAXED, __HIP_MEMORY_SCOPE_AGENT);
    __syncthreads();
    return tab;
}
DEV void run_phase(const Params& pin, int op, int arg, LAS unsigned char* lds) {
    Params p = pin; asm volatile("" : "+s"(p.ws));
    const int layer = arg; const int jj = layer / 3;
#ifdef ONLY_OP
    if (op != ONLY_OP) return;
#endif
#ifdef OPMASK
    if (!((OPMASK >> op) & 1ull)) return;
#endif
    switch (op) {
    case OP_CONVERT: phase_pre0(p); phase_convert(p, lds);
#ifdef DBG
        if (blockIdx.x == 0 && threadIdx.x < 8) WS_(p, TAB)[200 + threadIdx.x] = 0;
#endif
        break;
    case OP_PRE0: break;
    case OP_RW_GEMM1: { SchedRW1 S{&p, jj}; EpiRW1 E{&p}; pg8::gemm_phase(lds, 1024, S, E); } break;
    case OP_RW_GEMM2: { SchedRW2 S{&p, jj}; EpiRW2 E{&p, jj}; pg8::gemm_phase(lds, 256, S, E); } break;
    case OP_RW_CHA: phase_rw_cha(p, jj, lds); break;
    case OP_RW_CHB: phase_rw_chb(p, layer, lds); break;
    case OP_RW_CHC: phase_rw_chc(p, jj, lds); break;
    case OP_RW_OUT: { SchedOut S{WS_(p, YB), WS_(p, rw_wo_t) + (size_t)jj * D * D, 1024}; EpiOut E{WS_(p, MIXb)}; pg8::gemm_phase(lds, 1024, S, E); } break;
    case OP_LN1: phase_ln1(p, layer, lds); break;
    case OP_MOE_SCATTER: phase_moe_scatter(p, lds); break;
    case OP_MOE_GEMM1: { LAS int* tab = moe_tab_to_lds(p, lds); SchedMoe<0> S{&p, layer, tab}; EpiMoe1 E{WS_(p, ACT)}; pg8::gemm_phase(lds, 1024, S, E); } break;
    case OP_MOE_GEMM2: { LAS int* tab = moe_tab_to_lds(p, lds); SchedMoe<1> S{&p, layer, tab}; EpiMoe2 E{WS_(p, YBUF)}; pg8::gemm_phase(lds, 512, S, E); } break;
    case OP_LN2: phase_ln2(p, layer, lds); break;
    case OP_MB_GEMM_IN: { SchedMbIn S{&p}; EpiMbIn E{&p}; pg8::gemm_phase(lds, 1024, S, E); } break;
    case OP_MB_CONV: phase_mb_conv(p, jj); break;
    case OP_MB_STATES: phase_mb_states(p, jj, lds); break;
    case OP_MB_SCAN: phase_mb_scan(p); break;
    case OP_MB_OUT: phase_mb_out(p, jj, lds); break;
    case OP_MB_GEMM_OUT: { SchedOut S{WS_(p, YB), WS_(p, mb_wout_t) + (size_t)jj * D * 2048, 2048}; EpiOut E{WS_(p, MIXb)}; pg8::gemm_phase(lds, 2048, S, E); } break;
    case OP_GL_GEMM_IN: { SchedGlIn S{&p}; EpiGlIn E{&p}; pg8::gemm_phase(lds, 1024, S, E); } break;
    case OP_GL_KV: phase_gl_kv(p, lds); break;
    case OP_GL_SCAN: phase_gl_scan(p); break;
    case OP_GL_OUT: phase_gl_out(p, jj, lds); break;
    case OP_GL_GEMM_OUT: { SchedOut S{WS_(p, YB), WS_(p, gl_wout_t) + (size_t)jj * D * D, 1024}; EpiOut E{WS_(p, MIXb)}; pg8::gemm_phase(lds, 1024, S, E); } break;
    default: break;
    }
}

constexpr int NPHASES = 1 + 11 + 11 + 10 + 11;
DEV void decode_phase(int ph, int& op, int& layer) {
    if (ph < 1) { op = OP_CONVERT; layer = 0; return; }
    int q = ph - 1; layer = 0;
    if (q >= 11) { q -= 11; layer = 1; if (q >= 11) { q -= 11; layer = 2; if (q >= 10) { q -= 10; layer = 3; } } }
    const int kind = layer % 3; const int nmix = kind == 2 ? 5 : 6;
    if (q < nmix) op = (kind == 0 ? OP_RW_GEMM1 : kind == 1 ? OP_MB_GEMM_IN : OP_GL_GEMM_IN) + q;
    else op = OP_LN1 + (q - nmix);
}

#define X(t, n) t n##_,
template <bool COOP>
__global__ void __launch_bounds__(NTHR, 2) mega(PARAM_LIST(X) const int ph0, const int ph1) {
#undef X
    Params p;
#define X(t, n) p.n = n##_;
    PARAM_LIST(X)
#undef X

    extern __shared__ __attribute__((aligned(16))) unsigned char smem_raw[];
    LAS unsigned char* lds = (LAS unsigned char*)smem_raw;
    if constexpr (COOP) {
        volatile LAS unsigned* st = (volatile LAS unsigned*)(lds + LDS_BYTES - 16);
        if (threadIdx.x == 0) { st[0] = 0u; st[1] = 0u; }
        __syncthreads();
        XcdBarrier xb = xcd_barrier_post(WS_(p, bar), st);
        if (ph0 < 0) cg::this_grid().sync();
        for (int ph = ph0; ph < ph1; ++ph) {
            int op, arg; decode_phase(ph, op, arg);
#ifdef REPEAT_MASK
            const int reps = 1 + (int)((REPEAT_MASK >> op) & 1ull);
#else
            const int reps = 1;
#endif
#pragma unroll 1
            for (int rep = 0; rep < reps; ++rep) {
                run_phase(p, op, arg, lds);
                if (ph + 1 < ph1 || rep + 1 < reps) { xcd_barrier(xb);
#ifdef BAR2
                    xcd_barrier(xb);
#endif
                }
            }
        }
#ifdef DBG
        xcd_barrier(xb);
        { const int code = __hip_atomic_load(WS_(p, TAB) + 200, __ATOMIC_RELAXED, __HIP_MEMORY_SCOPE_AGENT);
          for (size_t i = (size_t)blockIdx.x * NTHR + threadIdx.x; i < (size_t)T * D; i += (size_t)NB_ * NTHR) p.out[i] = 0.f;
          __syncthreads();
          if (blockIdx.x == 0 && threadIdx.x == 0) p.out[0] = sqrtf((float)DBG_DECODE(code) * 1.68e7f); }
#endif
    } else {
        for (int ph = ph0; ph < ph1; ++ph) { int op, arg; decode_phase(ph, op, arg); run_phase(p, op, arg, lds); }
    }
}


extern "C" void kernel_launch(void* const* d_in, const int* in_sizes, int n_in, void* d_out, int out_size, void* d_ws, size_t ws_size, hipStream_t stream) {
    (void)in_sizes; (void)n_in; (void)out_size;
    Params p; std::memset((void*)&p, 0, sizeof(p));
    auto F = [&](int i) { return (const float*)d_in[i]; };
    p.x = F(0); p.ln_g = F(1); p.ln_b = F(2);
    p.rw_mu = F(3); p.rw_w_rkv = F(4); p.rw_w0 = F(5); p.rw_w1 = F(6); p.rw_w2 = F(7); p.rw_a0 = F(8);
    p.rw_a1 = F(9); p.rw_a2 = F(10); p.rw_g1 = F(11); p.rw_g2 = F(12);
    p.rw_k_k = F(13); p.rw_k_a = F(14); p.rw_r_k = F(15); p.rw_lnx_g = F(16); p.rw_lnx_b = F(17); p.rw_w_o = F(18);
    p.mb_w_in = F(19); p.mb_conv_w = F(20); p.mb_conv_b = F(21); p.mb_dt_bias = F(22); p.mb_a_log = F(23); p.mb_d = F(24); p.mb_norm_g = F(25); p.mb_w_out = F(26);
    p.gl_w_in = F(27); p.gl_gk_w2 = F(28); p.gl_gk_b = F(29); p.gl_norm_g = F(30); p.gl_w_out = F(31);
    p.moe_w_group = F(32); p.moe_b_group = F(33); p.moe_w_route = F(34); p.moe_b_route = F(35); p.moe_w_in = F(36); p.moe_w_down = F(37);
    p.out = (float*)d_out;
    p.ws = (char*)d_ws;
    if (WS_TOTAL > ws_size) { fprintf(stderr, "workspace too small: need %zu have %zu\n", (size_t)WS_TOTAL, ws_size); return; }
    unsigned* bar_ptr = (unsigned*)(p.ws + OFF_bar);
    const int np = NPHASES;
#define X(t, n) (void*)&p.n,
#if SINGLE_LAUNCH
    (void)hipFuncSetAttribute((const void*)mega<true>, hipFuncAttributeMaxDynamicSharedMemorySize, LDS_BYTES);
    (void)hipMemsetAsync(bar_ptr, 0, XCD_BAR_WORDS * sizeof(unsigned), stream);
    int ph0 = 0, ph1 = np; void* args[] = {PARAM_LIST(X) (void*)&ph0, (void*)&ph1};
    hipError_t e = hipLaunchCooperativeKernel((const void*)mega<true>, dim3(NBLK), dim3(NTHR), args, LDS_BYTES, stream);
    if (e != hipSuccess) fprintf(stderr, "cooperative launch failed: %s\n", hipGetErrorString(e));
#else
    (void)hipFuncSetAttribute((const void*)mega<false>, hipFuncAttributeMaxDynamicSharedMemorySize, LDS_BYTES);
    for (int ph = 0; ph < np; ++ph) { int ph0 = ph, ph1 = ph + 1; void* args[] = {PARAM_LIST(X) (void*)&ph0, (void*)&ph1};
        hipError_t e = hipLaunchKernel((const void*)mega<false>, dim3(NBLK), dim3(NTHR), args, LDS_BYTES, stream);
        if (e != hipSuccess) fprintf(stderr, "launch failed: %s\n", hipGetErrorString(e)); }
#endif
#undef X
}
```

```cpp
#include <hip/hip_runtime.h>
#include <hip/hip_cooperative_groups.h>
#include <cstdint>
#include <cstdio>
#include <cstring>
namespace cg = cooperative_groups;

typedef unsigned short bf16_t;
typedef short bf16x8 __attribute__((ext_vector_type(8)));
typedef short s16x4 __attribute__((ext_vector_type(4)));
typedef float f32x4 __attribute__((ext_vector_type(4)));
typedef float f32x2 __attribute__((ext_vector_type(2)));
typedef unsigned u32x4 __attribute__((ext_vector_type(4)));
typedef unsigned u32x2 __attribute__((ext_vector_type(2)));
#define LAS __attribute__((address_space(3)))
#define DEV __device__ __forceinline__

constexpr int T = 16384, D = 1024, DEPTH = 4;
constexpr int NTHR = 512, NBLK = 256;
constexpr int LDS_BYTES = 155648;
constexpr float ALPHA = 1.681792830507429f;
constexpr float LN_EPS = 1e-5f;
constexpr int MOE_ROWS = 40960;

DEV int tid_() { int t = threadIdx.x; asm volatile("" : "+v"(t)); return t; }
DEV int bid_() { int b = blockIdx.x; asm volatile("" : "+s"(b)); return b; }
#define NB_ 256
DEV void lds_barrier() { asm volatile("s_waitcnt lgkmcnt(0)" ::: "memory"); __builtin_amdgcn_s_barrier(); asm volatile("" ::: "memory"); }
DEV unsigned f2bf(float f) { unsigned u = __float_as_uint(f); u += 0x7FFFu + ((u >> 16) & 1u); return u >> 16; }
DEV float bf2f(unsigned short b) { return __uint_as_float(((unsigned)b) << 16); }
typedef __bf16 bf16n2 __attribute__((ext_vector_type(2)));
DEV unsigned pk2(float lo, float hi) { f32x2 v = {lo, hi}; bf16n2 b = __builtin_convertvector(v, bf16n2); return __builtin_bit_cast(unsigned, b); }
DEV float bflo(unsigned u) { return __uint_as_float(u << 16); }
DEV float bfhi(unsigned u) { return __uint_as_float(u & 0xFFFF0000u); }
DEV float sigmoidf_(float x) { return 1.0f / (1.0f + __expf(-x)); }
DEV float siluf_(float x) { return x / (1.0f + __expf(-x)); }
DEV float softplusf_(float x) { return fmaxf(x, 0.f) + __logf(1.0f + __expf(-fabsf(x))); }
DEV float tanhf_(float x) { const float e = __expf(-2.0f * fabsf(x)); const float r = (1.0f - e) / (1.0f + e); return x < 0.f ? -r : r; }
DEV float wave_sum(float v) {
#pragma unroll
    for (int o = 32; o > 0; o >>= 1) v += __shfl_xor(v, o);
    return v;
}
DEV float sum16(float v) {
#pragma unroll
    for (int o = 8; o > 0; o >>= 1) v += __shfl_xor(v, o);
    return v;
}
template <int N> DEV float reduce_scatter(float (&v)[N], int lane) {
    int s = 1;
#pragma unroll
    for (int h = N / 2; h >= 1; h >>= 1) {
#pragma unroll
        for (int i = 0; i < h; ++i) {
            const bool up = (lane & s) != 0;
            const float send = up ? v[i] : v[i + h];
            const float keep = up ? v[i + h] : v[i];
            v[i] = keep + __shfl_xor(send, s);
        }
        s <<= 1;
    }
    float r = v[0];
    for (; s < 64; s <<= 1) r += __shfl_xor(r, s);
    return r;
}
template <int N> DEV int rs_index(int lane) {
    int o = 0, s = 1;
#pragma unroll
    for (int h = N / 2; h >= 1; h >>= 1) { if (lane & s) o += h; s <<= 1; }
    return o;
}

DEV bf16x8 frag_rm(const LAS bf16_t* base, int ld, int row0, int k0, int lane) {
    return *(const LAS bf16x8*)(base + (row0 + (lane & 15)) * ld + k0 + 8 * (lane >> 4));
}
DEV bf16x8 frag_tr(const LAS bf16_t* base, int ld, int k0, int c0, int lane) {
    const int g = lane >> 4, i = lane & 15, q = i >> 2, p = i & 3;
    const LAS bf16_t* a = base + (k0 + 8 * g + q) * ld + c0 + 4 * p;
    s16x4 lo = __builtin_amdgcn_ds_read_tr16_b64_v4i16((LAS s16x4*)a);
    s16x4 hi = __builtin_amdgcn_ds_read_tr16_b64_v4i16((LAS s16x4*)(a + 4 * ld));
    bf16x8 r; r[0] = lo[0]; r[1] = lo[1]; r[2] = lo[2]; r[3] = lo[3]; r[4] = hi[0]; r[5] = hi[1]; r[6] = hi[2]; r[7] = hi[3];
    return r;
}
#define MFMA16(a, b, c) __builtin_amdgcn_mfma_f32_16x16x32_bf16((a), (b), (c), 0, 0, 0)
DEV size_t fragmajor_off(int n, int k, int K) { return ((size_t)((n >> 4) * (K >> 5) + (k >> 5)) * 64 + (n & 15) + 16 * ((k & 31) >> 3)) * 8 + (k & 7); }

template <int N> DEV void skinny_group(const f32x4 (&z)[4], const LAS float* wt, int lane, LAS float* outw) {
    float pe[N];
#pragma unroll
    for (int o = 0; o < N; ++o) {
        float a = 0.f;
#pragma unroll
        for (int q = 0; q < 4; ++q) { const f32x4 w = *(const LAS f32x4*)(wt + o * 1028 + 256 * q + 4 * lane); a += z[q][0] * w[0] + z[q][1] * w[1] + z[q][2] * w[2] + z[q][3] * w[3]; }
        pe[o] = a;
    }
    const float r = reduce_scatter<N>(pe, lane);
    if (lane < N) outw[rs_index<N>(lane)] = r;
}
#ifndef SINGLE_LAUNCH
#define SINGLE_LAUNCH 1
#endif
constexpr size_t OFF_bar = 0ull;
constexpr size_t OFF_rw_rkv_t = 13824ull;
constexpr size_t OFF_rw_w1_t = 12596736ull;
constexpr size_t OFF_rw_a1_t = 13645312ull;
constexpr size_t OFF_rw_g1_t = 14693888ull;
constexpr size_t OFF_rw_w2_t = 15742464ull;
constexpr size_t OFF_rw_a2_t = 16791040ull;
constexpr size_t OFF_rw_g2_t = 17839616ull;
constexpr size_t OFF_rw_wo_t = 18888192ull;
constexpr size_t OFF_mb_win_t = 23082496ull;
constexpr size_t OFF_mb_wout_t = 33568256ull;
constexpr size_t OFF_gl_win_t = 37762560ull;
constexpr size_t OFF_gl_wout_t = 44054016ull;
constexpr size_t OFF_moe_w1_t = 46151168ull;
constexpr size_t OFF_moe_w2_t = 314586624ull;
constexpr size_t OFF_H = 448804352ull;
constexpr size_t OFF_H1 = 515913216ull;
constexpr size_t OFF_MIX = 583022080ull;
constexpr size_t OFF_BUF = 650130944ull;
constexpr size_t OFF_ACT = 734017024ull;
constexpr size_t OFF_YBUF = 775960064ull;
constexpr size_t OFF_CNT = 859846144ull;
constexpr size_t OFF_EIDX = 859878912ull;
constexpr size_t OFF_GATE = 860009984ull;
constexpr size_t OFF_DEST = 860141056ull;
constexpr size_t OFF_TAB = 860272128ull;
constexpr size_t OFF_YB = 860273152ull;
constexpr size_t OFF_X6 = 927382016ull;
constexpr size_t OFF_Rr = 1128708608ull;
constexpr size_t OFF_Kk = 1195817472ull;
constexpr size_t OFF_Vv = 1262926336ull;
constexpr size_t OFF_LW = 1330035200ull;
constexpr size_t OFF_Wd = 1355201024ull;
constexpr size_t OFF_Aa = 1422309888ull;
constexpr size_t OFF_Gg = 1489418752ull;
constexpr size_t OFF_RWf = 1556527616ull;
constexpr size_t OFF_RBf = 1590082048ull;
constexpr size_t OFF_RUt = 1623636480ull;
constexpr size_t OFF_RNa = 1657190912ull;
constexpr size_t OFF_RGc = 1690745344ull;
constexpr size_t OFF_RUa = 1691793920ull;
constexpr size_t OFF_RS0 = 1725348352ull;
constexpr size_t OFF_Z = 960936448ull;
constexpr size_t OFF_XBC = 1028045312ull;
constexpr size_t OFF_XC = 1128708608ull;
constexpr size_t OFF_DT = 1229371904ull;
constexpr size_t OFF_STATES = 1231469056ull;
constexpr size_t OFF_CD = 1365686784ull;
constexpr size_t OFF_PREV = 1365703168ull;
constexpr size_t OFF_LA = 1432812032ull;
constexpr size_t OFF_CDG = 1466366464ull;
constexpr size_t OFF_QKVG = OFF_XBC;
constexpr size_t WS_TOTAL = 1758902784ull;
typedef unsigned T_bar;
typedef bf16_t T_rw_rkv_t;
typedef bf16_t T_rw_w1_t;
typedef bf16_t T_rw_a1_t;
typedef bf16_t T_rw_g1_t;
typedef bf16_t T_rw_w2_t;
typedef bf16_t T_rw_a2_t;
typedef bf16_t T_rw_g2_t;
typedef bf16_t T_rw_wo_t;
typedef bf16_t T_mb_win_t;
typedef bf16_t T_mb_wout_t;
typedef bf16_t T_gl_win_t;
typedef bf16_t T_gl_wout_t;
typedef bf16_t T_moe_w1_t;
typedef bf16_t T_moe_w2_t;
typedef float T_H;
typedef float T_H1;
typedef float T_MIX;
typedef bf16_t T_BUF;
typedef bf16_t T_ACT;
typedef bf16_t T_YBUF;
typedef int T_CNT;
typedef int T_EIDX;
typedef float T_GATE;
typedef int T_DEST;
typedef int T_TAB;
typedef bf16_t T_YB;
typedef bf16_t T_X6;
typedef float T_Rr;
typedef float T_Kk;
typedef float T_Vv;
typedef bf16_t T_LW;
typedef float T_Wd;
typedef float T_Aa;
typedef float T_Gg;
typedef bf16_t T_RWf;
typedef bf16_t T_RBf;
typedef bf16_t T_RUt;
typedef bf16_t T_RNa;
typedef float T_RGc;
typedef bf16_t T_RUa;
typedef bf16_t T_RS0;
typedef bf16_t T_Z;
typedef bf16_t T_XBC;
typedef bf16_t T_XC;
typedef float T_DT;
typedef bf16_t T_STATES;
typedef float T_CD;
typedef bf16_t T_PREV;
typedef float T_LA;
typedef float T_CDG;
typedef bf16_t T_QKVG;
#define WS_(P, N) ((T_##N*)((P).ws + OFF_##N))
constexpr size_t OFF_Hb = OFF_H, OFF_H1b = OFF_H1, OFF_MIXb = OFF_MIX;
typedef bf16_t T_Hb; typedef bf16_t T_H1b; typedef bf16_t T_MIXb;
constexpr size_t OFF_moe_wr_t = OFF_H + 33554432ull;
typedef bf16_t T_moe_wr_t;
constexpr size_t OFF_mb_dt_t = OFF_moe_wr_t + 4ull * 48 * 1024 * 2, OFF_gl_lr_t = OFF_mb_dt_t + 32ull * 1024 * 2;
typedef bf16_t T_mb_dt_t; typedef bf16_t T_gl_lr_t;
constexpr size_t OFF_Rb = OFF_Rr, OFF_Kb = OFF_Kk, OFF_Vb = OFF_Vv, OFF_Ab = OFF_Aa, OFF_Gb = OFF_Gg;
typedef bf16_t T_Rb; typedef bf16_t T_Kb; typedef bf16_t T_Vb; typedef bf16_t T_Ab; typedef bf16_t T_Gb;
constexpr size_t OFF_Wb = OFF_Wd; typedef bf16_t T_Wb;
struct ConvJob {
    const float* src; bf16_t* dst;
    int K, N, src_ld, Kpad, Npad, perm, batch;
    long long src_bs, dst_bs;
    DEV int ntiles() const { return (Kpad / 64) * (Npad / 64) * batch; }
};
constexpr int NJOBS = 16;
constexpr int MOE_SPLIT = 40;

#define PARAM_LIST(X) \
    X(const float*, x) X(const float*, ln_g) X(const float*, ln_b) \
    X(const float*, rw_mu) X(const float*, rw_w_rkv) X(const float*, rw_w0) X(const float*, rw_w1) X(const float*, rw_w2) X(const float*, rw_a0) X(const float*, rw_a1) X(const float*, rw_a2) \
    X(const float*, rw_g1) X(const float*, rw_g2) X(const float*, rw_k_k) X(const float*, rw_k_a) X(const float*, rw_r_k) X(const float*, rw_lnx_g) X(const float*, rw_lnx_b) X(const float*, rw_w_o) \
    X(const float*, mb_w_in) X(const float*, mb_conv_w) X(const float*, mb_conv_b) X(const float*, mb_dt_bias) X(const float*, mb_a_log) X(const float*, mb_d) X(const float*, mb_norm_g) X(const float*, mb_w_out) \
    X(const float*, gl_w_in) X(const float*, gl_gk_w2) X(const float*, gl_gk_b) X(const float*, gl_norm_g) X(const float*, gl_w_out) \
    X(const float*, moe_w_group) X(const float*, moe_b_group) X(const float*, moe_w_route) X(const float*, moe_b_route) X(const float*, moe_w_in) X(const float*, moe_w_down) \
    X(float*, out) X(char*, ws)
struct Params {
#define X(t, n) t n;
    PARAM_LIST(X)
#undef X
};

enum Op : unsigned char { OP_CONVERT = 0, OP_PRE0, OP_RW_GEMM1, OP_RW_GEMM2, OP_RW_CHA, OP_RW_CHB, OP_RW_CHC, OP_RW_OUT,
    OP_LN1, OP_MOE_SCATTER, OP_MOE_GEMM1, OP_MOE_GEMM2, OP_LN2,
    OP_MB_GEMM_IN, OP_MB_CONV, OP_MB_STATES, OP_MB_SCAN, OP_MB_OUT, OP_MB_GEMM_OUT,
    OP_GL_GEMM_IN, OP_GL_KV, OP_GL_SCAN, OP_GL_OUT, OP_GL_GEMM_OUT };


DEV ConvJob make_job(const Params& p, int q) {
    const long long DD = (long long)D * D;
    switch (q) {
    case 0: return ConvJob{p.rw_w_rkv, WS_(p, rw_rkv_t), 1024, 1024, 1024, 1024, 1024, 0, 6, DD, DD};
    case 1: return ConvJob{p.rw_w1, WS_(p, rw_w1_t), 1024, 64, 64, 1024, 256, 0, 2, (long long)D * 64, (long long)256 * D};
    case 2: return ConvJob{p.rw_a1, WS_(p, rw_a1_t), 1024, 64, 64, 1024, 256, 0, 2, (long long)D * 64, (long long)256 * D};
    case 3: return ConvJob{p.rw_g1, WS_(p, rw_g1_t), 1024, 160, 160, 1024, 256, 0, 2, (long long)D * 160, (long long)256 * D};
    case 4: return ConvJob{p.rw_w2, WS_(p, rw_w2_t), 64, 1024, 1024, 256, 1024, 0, 2, (long long)64 * D, (long long)D * 256};
    case 5: return ConvJob{p.rw_a2, WS_(p, rw_a2_t), 64, 1024, 1024, 256, 1024, 0, 2, (long long)64 * D, (long long)D * 256};
    case 6: return ConvJob{p.rw_g2, WS_(p, rw_g2_t), 160, 1024, 1024, 256, 1024, 0, 2, (long long)160 * D, (long long)D * 256};
    case 7: return ConvJob{p.rw_w_o, WS_(p, rw_wo_t), 1024, 1024, 1024, 1024, 1024, 0, 2, DD, DD};
    case 8: return ConvJob{p.mb_w_in, WS_(p, mb_win_t), 1024, 5120, 5152, 1024, 5120, 0, 1, 0, 0};
    case 9: return ConvJob{p.mb_w_out, WS_(p, mb_wout_t), 2048, 1024, 1024, 2048, 1024, 0, 1, 0, 0};
    case 10: return ConvJob{p.gl_w_in, WS_(p, gl_win_t), 1024, 3072, 3088, 1024, 3072, 0, 1, 0, 0};
    case 11: return ConvJob{p.gl_w_out, WS_(p, gl_wout_t), 1024, 1024, 1024, 1024, 1024, 0, 1, 0, 0};
    case 12: return ConvJob{p.moe_w_in, WS_(p, moe_w1_t), 1024, 1024, 1024, 1024, 1024, 1, MOE_SPLIT, DD, DD};
    case 13: return ConvJob{p.moe_w_down, WS_(p, moe_w2_t), 512, 1024, 1024, 512, 1024, 0, MOE_SPLIT, (long long)512 * 1024, (long long)1024 * 512};
    case 14: return ConvJob{p.moe_w_in + (size_t)MOE_SPLIT * DD, WS_(p, moe_w1_t) + (size_t)MOE_SPLIT * DD, 1024, 1024, 1024, 1024, 1024, 1, 128 - MOE_SPLIT, DD, DD};
    default: return ConvJob{p.moe_w_down + (size_t)MOE_SPLIT * 512 * 1024, WS_(p, moe_w2_t) + (size_t)MOE_SPLIT * 512 * 1024, 512, 1024, 1024, 512, 1024, 0, 128 - MOE_SPLIT, (long long)512 * 1024, (long long)1024 * 512};
    }
}

template <int J0, int J1> DEV void convert_jobs(const Params& p, LAS unsigned char* lds, int B0, int NBW) {
    const int tid = tid_(), bid = bid_();
    const int lane = tid & 63, wv = tid >> 6; const int gw = (bid - B0) * 8 + wv, NW = NBW * 8;
    LAS bf16_t* tile = (LAS bf16_t*)lds + wv * (64 * 72);
    int tbeg = 0;
#pragma unroll
    for (int j = J0; j < J1; ++j) {
      const ConvJob J = make_job(p, j);
      const int jend = tbeg + J.ntiles();
      const int ti0 = tbeg + ((gw - tbeg) % NW + NW) % NW;
      const int jbeg = tbeg; tbeg = jend;
#pragma unroll 1
      for (int ti = ti0; ti < jend; ti += NW) {
        int local = ti - jbeg;
        const int tk = J.Kpad / 64, tn = J.Npad / 64;
        const int b = local / (tk * tn); local -= b * tk * tn;
        const int nt = local / tk, kt = local - nt * tk;
        const float* src = J.src + (size_t)b * J.src_bs;
        bf16_t* dst = J.dst + (size_t)b * J.dst_bs;
        const int k0 = kt * 64, n0 = nt * 64;
        const int nn = (lane & 15) * 4; const bool nok = n0 + nn < J.N;
        f32x4 v[16];
#pragma unroll
        for (int i = 0; i < 16; ++i) { const int kk = (lane >> 4) + 4 * i; v[i] = (nok && k0 + kk < J.K) ? *(const f32x4*)(src + (size_t)(k0 + kk) * J.src_ld + n0 + nn) : (f32x4){0.f, 0.f, 0.f, 0.f}; }
#pragma unroll
        for (int i = 0; i < 16; ++i) { const int kk = (lane >> 4) + 4 * i;
#pragma unroll
            for (int e = 0; e < 4; ++e) tile[(nn + e) * 72 + kk] = (bf16_t)f2bf(v[i][e]); }
#pragma unroll
        for (int i = 0; i < 8; ++i) { const int r = (lane >> 3) + 8 * i, kc = (lane & 7) * 8;
            int nsrc = n0 + r, ndst = nsrc;
            if (J.perm == 1) { const int up = nsrc >= 512, jj = nsrc - (up ? 512 : 0); ndst = (jj >> 7) * 256 + (up ? 128 : 0) + (jj & 127); }
            *(u32x4*)(dst + (size_t)ndst * J.Kpad + k0 + kc) = *(const LAS u32x4*)(tile + r * 72 + kc); }
      }
    }
}
DEV void phase_convert(const Params& p, LAS unsigned char* lds) {
    const int tid = tid_(), bid = bid_();
    convert_jobs<0, 14>(p, lds, 0, NB_);
    if (bid < 4 * 48) { const int layer = bid / 48, o = bid % 48;
        for (int k = tid; k < D; k += NTHR) { float v = 0.f;
            if (o < 32) v = p.moe_w_route[((size_t)layer * D + k) * 32 + o]; else if (o < 36) v = p.moe_w_group[((size_t)layer * D + k) * 4 + (o - 32)];
            WS_(p, moe_wr_t)[((size_t)layer * 48 + o) * D + k] = (bf16_t)f2bf(v); } }
    else if (bid < 4 * 48 + 32) { const int o = bid - 192;
        for (int k = tid; k < D; k += NTHR) WS_(p, mb_dt_t)[(size_t)o * D + k] = (bf16_t)f2bf(p.mb_w_in[(size_t)k * 5152 + 5120 + o]); }
    else if (bid < 4 * 48 + 48) { const int o = bid - 224;
        for (int k = tid; k < D; k += NTHR) WS_(p, gl_lr_t)[(size_t)o * D + k] = (bf16_t)f2bf(p.gl_w_in[(size_t)k * 3088 + 3072 + o]); }
}
namespace pg8 {
constexpr int BM = 256, BK = 64, HALF = 128, HTB = HALF * BK * 2, STAGE_BYTES = 8 * HTB;
DEV int lds_byte(int r, int c) { const int st = (r >> 4) * 2 + (c >> 5), rr = r & 15, cc = c & 31, ob = rr * 64 + cc * 2; return st * 1024 + (ob ^ (((ob >> 9) & 1) << 5)); }
DEV void stage_rc(int b, int& R, int& C) { const int st = b / 1024, sb = b % 1024, swz = sb ^ (((sb >> 9) & 1) << 5); R = (st >> 1) * 16 + swz / 64; C = (st & 1) * 32 + (swz % 64) / 2; }

struct Unit { const char* A; const char* B; int row0, col0, id, aux; };

DEV bool tile_order(int i, int G, int c, int nM, int nN, int& pm, int& pn) {
    const int nwg = nM * nN; const long L = (long)i * G + c; if (L >= nwg) return false;
    int wgid = (int)L; { const int q = nwg / 8, r = nwg % 8, xcd = wgid % 8, off = wgid / 8; wgid = (xcd < r ? xcd * (q + 1) : r * (q + 1) + (xcd - r) * q) + off; }
    const int nig = 8 * nN, gid = wgid / nig, fm = gid * 8, gsz = (nM - fm) < 8 ? (nM - fm) : 8;
    pm = fm + ((wgid % nig) % gsz); pn = (wgid % nig) / gsz; return true;
}

template <class Epi, class Sched>
DEV void gemm_phase(LAS unsigned char* lds, const int K, const Sched& S, const Epi& E) {
    const int tid = tid_(), wid = __builtin_amdgcn_readfirstlane(tid >> 6), lane = tid & 63, wr = wid >> 2, wc = wid & 3, fr = lane & 15, fq = lane >> 4;
    const int nt = K / BK;
    unsigned voff[2];
#pragma unroll
    for (int i = 0; i < 2; ++i) { int R, C; stage_rc(tid * 16 + i * 8192, R, C); voff[i] = (unsigned)(R * K + C) * 2u; }
    const size_t kstep = (size_t)(BK * 2);
    const size_t hstep = (size_t)HALF * K * 2;
    const unsigned ldsw = (unsigned)wid * 1024u;
    const int aoff = lds_byte(wr * 64 + fr, fq * 8), boff = lds_byte(wc * 32 + fr, fq * 8);
#define PG8_SA(b, h) (((b) * 2 + (h)) * HTB)
#define PG8_SB(b, h) ((4 + (b) * 2 + (h)) * HTB)
#define PG8_STAGE(bufoff, gbase) do { _Pragma("unroll") for (int _i = 0; _i < 2; ++_i) \
        __builtin_amdgcn_global_load_lds((const unsigned*)((const char*)(gbase) + voff[_i]), (LAS unsigned*)(lds + (bufoff) + ldsw + _i * 8192), 16, 0, 0); } while (0)
#define PG8_LDA(dst, b, h) do { _Pragma("unroll") for (int m = 0; m < 4; ++m) _Pragma("unroll") for (int k = 0; k < 2; ++k) dst[m][k] = *(const LAS bf16x8*)(lds + PG8_SA(b, h) + aoff + m * 2048 + k * 1024); } while (0)
#define PG8_LDB(dst, b, h) do { _Pragma("unroll") for (int n = 0; n < 2; ++n) _Pragma("unroll") for (int k = 0; k < 2; ++k) dst[n][k] = *(const LAS bf16x8*)(lds + PG8_SB(b, h) + boff + n * 2048 + k * 1024); } while (0)
#define PG8_MMA(ai, bj, At, Bt) do { __builtin_amdgcn_s_setprio(1); _Pragma("unroll") for (int m = 0; m < 4; ++m) _Pragma("unroll") for (int n = 0; n < 2; ++n) _Pragma("unroll") for (int k = 0; k < 2; ++k) \
        acc[ai][bj][m][n] = __builtin_amdgcn_mfma_f32_16x16x32_bf16(Bt[n][k], At[m][k], acc[ai][bj][m][n], 0, 0, 0); __builtin_amdgcn_s_setprio(0); } while (0)
#define PG8_WAIT_V(n) asm volatile("s_waitcnt vmcnt(" #n ")" ::: "memory")
#define PG8_WAIT_L(n) asm volatile("s_waitcnt lgkmcnt(" #n ")" ::: "memory")
#define PG8_BAR __builtin_amdgcn_s_barrier()
#define PG8_SCHED __builtin_amdgcn_sched_barrier(0)
    Unit cur, nxt; int ui = 0;
    if (!S.next(0, cur)) return;
    f32x4 acc[2][2][4][2];
#pragma unroll
    for (int a = 0; a < 2; ++a)
#pragma unroll
        for (int b = 0; b < 2; ++b)
#pragma unroll
            for (int m = 0; m < 4; ++m)
#pragma unroll
                for (int n = 0; n < 2; ++n) acc[a][b][m][n] = (f32x4){0.f, 0.f, 0.f, 0.f};
    bf16x8 At[4][2], B0[2][2], B1[2][2];
    const char* cA = cur.A; const char* cB = cur.B;
    PG8_STAGE(PG8_SB(0, 0), cB); PG8_STAGE(PG8_SA(0, 0), cA); PG8_STAGE(PG8_SB(0, 1), cB + hstep); PG8_STAGE(PG8_SA(0, 1), cA + hstep);
    if (wr == 1) PG8_BAR;
    PG8_WAIT_V(4); PG8_BAR;
    PG8_STAGE(PG8_SB(1, 0), cB + kstep); PG8_STAGE(PG8_SA(1, 0), cA + kstep); PG8_STAGE(PG8_SB(1, 1), cB + hstep + kstep);
    PG8_WAIT_V(6); PG8_BAR;
    for (;;) {
        const bool has_next = S.next(ui + 1, nxt);
        const char* nA = has_next ? nxt.A : cA; const char* nB = has_next ? nxt.B : cB;
#pragma unroll 1
        for (int t = 0; t < nt; t += 2) {
            const bool last = (t == nt - 2);
            const char* a1 = cA + (size_t)(t + 1) * kstep;
            const char* a2 = last ? nA : cA + (size_t)(t + 2) * kstep; const char* b2 = last ? nB : cB + (size_t)(t + 2) * kstep;
            const char* a3 = a2 + kstep; const char* b3 = b2 + kstep;
            PG8_LDB(B0, 0, 0); PG8_SCHED; PG8_LDA(At, 0, 0); PG8_STAGE(PG8_SA(1, 1), a1 + hstep);
            PG8_WAIT_L(8); PG8_BAR; PG8_WAIT_L(0); PG8_MMA(0, 0, At, B0); PG8_BAR; PG8_SCHED;
            PG8_LDB(B1, 0, 1); PG8_STAGE(PG8_SB(0, 0), b2);
            PG8_BAR; PG8_WAIT_L(0); PG8_MMA(0, 1, At, B1); PG8_BAR;
            PG8_LDA(At, 0, 1); PG8_STAGE(PG8_SA(0, 0), a2);
            PG8_BAR; PG8_WAIT_L(0); PG8_MMA(1, 0, At, B0); PG8_BAR; PG8_SCHED;
            PG8_STAGE(PG8_SB(0, 1), b2 + hstep);
            PG8_WAIT_V(6); PG8_BAR; PG8_MMA(1, 1, At, B1); PG8_BAR;
            PG8_LDB(B0, 1, 0); PG8_SCHED; PG8_LDA(At, 1, 0); PG8_STAGE(PG8_SA(0, 1), a2 + hstep);
            PG8_WAIT_L(8); PG8_BAR; PG8_WAIT_L(0); PG8_MMA(0, 0, At, B0); PG8_BAR; PG8_SCHED;
            PG8_LDB(B1, 1, 1); PG8_STAGE(PG8_SB(1, 0), b3);
            PG8_BAR; PG8_WAIT_L(0); PG8_MMA(0, 1, At, B1); PG8_BAR;
            PG8_LDA(At, 1, 1); PG8_STAGE(PG8_SA(1, 0), a3);
            PG8_BAR; PG8_WAIT_L(0); PG8_MMA(1, 0, At, B0); PG8_BAR; PG8_SCHED;
            PG8_STAGE(PG8_SB(1, 1), b3 + hstep);
            PG8_WAIT_V(6); PG8_BAR; PG8_MMA(1, 1, At, B1); PG8_BAR;
        }
        E(acc, cur, wr, wc, fr, fq);
        if (!has_next) break;
#pragma unroll
        for (int a = 0; a < 2; ++a)
#pragma unroll
            for (int b = 0; b < 2; ++b)
#pragma unroll
                for (int m = 0; m < 4; ++m)
#pragma unroll
                    for (int n = 0; n < 2; ++n) acc[a][b][m][n] = (f32x4){0.f, 0.f, 0.f, 0.f};
        cur = nxt; cA = nA; cB = nB; ++ui;
    }
    PG8_WAIT_V(0);
    if (wr == 0) PG8_BAR;
    PG8_BAR;
#undef PG8_SA
#undef PG8_SB
#undef PG8_STAGE
#undef PG8_LDA
#undef PG8_LDB
#undef PG8_MMA
#undef PG8_WAIT_V
#undef PG8_WAIT_L
#undef PG8_BAR
#undef PG8_SCHED
}
}
using pg8::Unit;
typedef f32x4 AccT[2][2][4][2];
#define FOR_ACC(ai, bj, m, n) _Pragma("unroll") for (int ai = 0; ai < 2; ++ai) _Pragma("unroll") for (int m = 0; m < 4; ++m) _Pragma("unroll") for (int bj = 0; bj < 2; ++bj) _Pragma("unroll") for (int n = 0; n < 2; ++n)
#define ACC_FENCE __builtin_amdgcn_sched_barrier(0)
#define ACC_ROW(u, ai, m) ((u).row0 + 128 * (ai) + 64 * wr + 16 * (m) + fr)
#define ACC_COL(u, bj, n) ((u).col0 + 128 * (bj) + 32 * wc + 16 * (n) + 4 * fq)
DEV void st_bf4(bf16_t* p, f32x4 v) { u32x2 w; w.x = pk2(v[0], v[1]); w.y = pk2(v[2], v[3]); *(u32x2*)p = w; }
DEV void load_row(const float* p, int lane, f32x4 (&v)[4]) {
#pragma unroll
    for (int q = 0; q < 4; ++q) v[q] = *(const f32x4*)(p + 256 * q + 4 * lane);
}

DEV void load_row_bf(const bf16_t* p, int lane, f32x4 (&v)[4]) {
#pragma unroll
    for (int q = 0; q < 4; ++q) { const u32x2 a = *(const u32x2*)(p + 256 * q + 4 * lane); v[q] = (f32x4){bflo(a.x), bfhi(a.x), bflo(a.y), bfhi(a.y)}; }
}
DEV void store_row_bf(bf16_t* p, int lane, const f32x4 (&v)[4]) {
#pragma unroll
    for (int q = 0; q < 4; ++q) st_bf4(p + 256 * q + 4 * lane, v[q]);
}
DEV void emit_mix6(const Params& p, int j, int t, int lane, const f32x4 (&x)[4], const f32x4 (&xp)[4]) {
    const float* mu = p.rw_mu + (size_t)j * 6 * D;
#pragma unroll
    for (int s = 0; s < 6; ++s) {
#pragma unroll
        for (int q = 0; q < 4; ++q) {
            const f32x4 m = *(const f32x4*)(mu + s * D + 256 * q + 4 * lane);
            st_bf4(WS_(p, X6) + (size_t)s * T * D + (size_t)t * D + 256 * q + 4 * lane, x[q] + (xp[q] - x[q]) * m);
        }
        __builtin_amdgcn_sched_barrier(0);
    }
}
DEV void phase_pre0(const Params& p) {
    const int tid = tid_(), bid = bid_(); const int lane = tid & 63, wid = tid >> 6;
    f32x4 x[4], xp[4];
    const int tfirst = bid * 64 + wid * 8;
    if (tfirst > 0) load_row(p.x + (size_t)(tfirst - 1) * D, lane, xp); else { for (int q = 0; q < 4; ++q) xp[q] = (f32x4){0.f, 0.f, 0.f, 0.f}; }
    f32x4 xn[4]; load_row(p.x + (size_t)tfirst * D, lane, xn);
#pragma unroll 1
    for (int r = 0; r < 8; ++r) {
        const int t = tfirst + r;
#pragma unroll
        for (int q = 0; q < 4; ++q) x[q] = xn[q];
        load_row(p.x + (size_t)(r < 7 ? t + 1 : t) * D, lane, xn);
        store_row_bf(WS_(p, Hb) + (size_t)t * D, lane, x);
        emit_mix6(p, 0, t, lane, x, xp);
#pragma unroll
        for (int q = 0; q < 4; ++q) xp[q] = x[q];
    }
}

struct SchedRW1 {
    const Params* p; int j;
    DEV bool next(int i, Unit& u) const {
        int pm, pn; if (!pg8::tile_order(i, NB_, bid_(), 64, 15, pm, pn)) return false;
        int id, lpn; if (pn < 12) { id = pn >> 2; lpn = pn & 3; } else { id = 3 + (pn - 12); lpn = 0; }
        u.A = (const char*)(WS_(*p, X6) + (size_t)id * T * D + (size_t)pm * 256 * D);
        const bf16_t* B;
        if (id < 3) B = WS_(*p, rw_rkv_t) + ((size_t)j * 3 + id) * D * D + (size_t)lpn * 256 * D;
        else B = WS_(*p, rw_w1_t) + (size_t)(id - 3) * (2 * 256 * D) + (size_t)j * 256 * D;
        u.B = (const char*)B; u.row0 = pm * 256; u.col0 = lpn * 256; u.id = id; u.aux = 0; return true;
    }
};
struct EpiRW1 {
    const Params* p;
    DEV void operator()(const AccT& acc, const Unit& u, int wr, int wc, int fr, int fq) const {
        if (u.id < 3) {
            bf16_t* O = WS_(*p, Rb) + (size_t)u.id * 2 * T * D;
            FOR_ACC(ai, bj, m, n) { st_bf4(O + (size_t)ACC_ROW(u, ai, m) * D + ACC_COL(u, bj, n), acc[ai][bj][m][n]); ACC_FENCE; }
        } else {
            bf16_t* O = WS_(*p, LW) + (size_t)(u.id - 3) * T * 256;
            FOR_ACC(ai, bj, m, n) {
                f32x4 v = acc[ai][bj][m][n];
                if (u.id == 3) { for (int e = 0; e < 4; ++e) v[e] = tanhf_(v[e]); }
                else if (u.id == 5) { for (int e = 0; e < 4; ++e) v[e] = sigmoidf_(v[e]); }
                st_bf4(O + (size_t)ACC_ROW(u, ai, m) * 256 + ACC_COL(u, bj, n), v); ACC_FENCE;
            }
        }
    }
};
struct SchedRW2 {
    const Params* p; int j;
    DEV bool next(int i, Unit& u) const {
        int pm, pn; if (!pg8::tile_order(i, NB_, bid_(), 64, 12, pm, pn)) return false;
        const int id = pn >> 2, lpn = pn & 3;
        u.A = (const char*)(WS_(*p, LW) + (size_t)id * T * 256 + (size_t)pm * 256 * 256);
        const bf16_t* B = WS_(*p, rw_w2_t) + (size_t)id * (2 * D * 256) + (size_t)j * D * 256 + (size_t)lpn * 256 * 256;
        u.B = (const char*)B; u.row0 = pm * 256; u.col0 = lpn * 256; u.id = id; u.aux = 0; return true;
    }
};
struct EpiRW2 {
    const Params* p; int j;
    DEV void operator()(const AccT& acc, const Unit& u, int wr, int wc, int fr, int fq) const {
        if (u.id == 0) { const float* bias = p->rw_w0 + (size_t)j * D; f32x4 bv[2][2];
#pragma unroll
            for (int bj = 0; bj < 2; ++bj)
#pragma unroll
                for (int n = 0; n < 2; ++n) bv[bj][n] = *(const f32x4*)(bias + ACC_COL(u, bj, n));
            FOR_ACC(ai, bj, m, n) { f32x4 v = acc[ai][bj][m][n]; const int c = ACC_COL(u, bj, n); const f32x4 b = bv[bj][n];
                for (int e = 0; e < 4; ++e) { const float x = -(b[e] + v[e]); const float wl = -(fmaxf(x, 0.f) + __logf(1.0f + __expf(-fabsf(x)))) - 0.5f; v[e] = -__expf(wl); }
                st_bf4(WS_(*p, Wb) + (size_t)ACC_ROW(u, ai, m) * D + c, v); ACC_FENCE; } }
        else if (u.id == 1) { const float* bias = p->rw_a0 + (size_t)j * D; f32x4 bv[2][2];
#pragma unroll
            for (int bj = 0; bj < 2; ++bj)
#pragma unroll
                for (int n = 0; n < 2; ++n) bv[bj][n] = *(const f32x4*)(bias + ACC_COL(u, bj, n));
            FOR_ACC(ai, bj, m, n) { f32x4 v = acc[ai][bj][m][n]; const int c = ACC_COL(u, bj, n); const f32x4 b = bv[bj][n];
                for (int e = 0; e < 4; ++e) v[e] = sigmoidf_(b[e] + v[e]);
                st_bf4(WS_(*p, Ab) + (size_t)ACC_ROW(u, ai, m) * D + c, v); ACC_FENCE; } }
        else { FOR_ACC(ai, bj, m, n) { st_bf4(WS_(*p, Gb) + (size_t)ACC_ROW(u, ai, m) * D + ACC_COL(u, bj, n), acc[ai][bj][m][n]); ACC_FENCE; } }
    }
};

struct SchedOut {
    const bf16_t* A; const bf16_t* Bt; int K;
    DEV bool next(int i, Unit& u) const {
        int pm, pn; if (!pg8::tile_order(i, NB_, bid_(), 64, 4, pm, pn)) return false;
        u.A = (const char*)(A + (size_t)pm * 256 * K); u.B = (const char*)(Bt + (size_t)pn * 256 * K); u.row0 = pm * 256; u.col0 = pn * 256; u.id = 0; u.aux = 0; return true;
    }
};
struct EpiOut {
    bf16_t* O;
    DEV void operator()(const AccT& acc, const Unit& u, int wr, int wc, int fr, int fq) const {
        FOR_ACC(ai, bj, m, n) { st_bf4(O + (size_t)ACC_ROW(u, ai, m) * D + ACC_COL(u, bj, n), acc[ai][bj][m][n]); ACC_FENCE; }
    }
};
constexpr int RC_LD = 72;
#ifdef DBG
#define DBGF(cond, bit) do { if (cond) atomicOr(&WS_(p, TAB)[200], (bit)); } while (0)
#else
#define DBGF(cond, bit) do {} while (0)
#endif
DEV bool bad_(float x) { return !(fabsf(x) < 1e30f); }
DEV int rc_pi(int g, int j) { return j < 4 ? 4 * g + j : 16 + 4 * g + (j - 4); }

DEV void rc_load_wd(const Params& p, int t0, int cb, float (&wd)[8]) {
    const int tid = tid_(); const int k = tid & 63, sg = tid >> 6;
#pragma unroll
    for (int i = 0; i < 8; ++i) wd[i] = bf2f(WS_(p, Wb)[(size_t)(t0 + sg * 8 + i) * D + cb + k]);
}
DEV void rc_cum_regs(const float (&wd)[8], LAS float* cum, LAS float* seg) {
    const int tid = tid_(); const int k = tid & 63, sg = tid >> 6;
    float v[8]; float s = 0.f;
#pragma unroll
    for (int i = 0; i < 8; ++i) { s += wd[i]; v[i] = s; }
    seg[sg * 64 + k] = s;
    lds_barrier();
    float off = 0.f;
#pragma unroll
    for (int q = 0; q < 8; ++q) off += (q < sg) ? seg[q * 64 + k] : 0.f;
#pragma unroll
    for (int i = 0; i < 8; ++i) cum[(sg * 8 + i) * 64 + k] = v[i] + off;
    lds_barrier();
}
DEV void ld8b(const bf16_t* p, float (&f)[8]) { const u32x4 v = *(const u32x4*)p; f[0] = bflo(v.x); f[1] = bfhi(v.x); f[2] = bflo(v.y); f[3] = bfhi(v.y); f[4] = bflo(v.z); f[5] = bfhi(v.z); f[6] = bflo(v.w); f[7] = bfhi(v.w); }
DEV void ld8(const float* p, float (&f)[8]) { const f32x4 a = *(const f32x4*)p, b = *(const f32x4*)(p + 4); f[0] = a[0]; f[1] = a[1]; f[2] = a[2]; f[3] = a[3]; f[4] = b[0]; f[5] = b[1]; f[6] = b[2]; f[7] = b[3]; }
DEV void lds8(const LAS float* p, float (&f)[8]) { const f32x4 a = *(const LAS f32x4*)p, b = *(const LAS f32x4*)(p + 4); f[0] = a[0]; f[1] = a[1]; f[2] = a[2]; f[3] = a[3]; f[4] = b[0]; f[5] = b[1]; f[6] = b[2]; f[7] = b[3]; }
DEV u32x4 pk8(const float (&f)[8]) { u32x4 o; o.x = pk2(f[0], f[1]); o.y = pk2(f[2], f[3]); o.z = pk2(f[4], f[5]); o.w = pk2(f[6], f[7]); return o; }

DEV bf16x8 frag_rm_pi(const LAS bf16_t* base, int ld, int row0, int k0, int lane) {
    const LAS bf16_t* a = base + (row0 + (lane & 15)) * ld + k0 + 4 * (lane >> 4);
    const s16x4 lo = *(const LAS s16x4*)a, hi = *(const LAS s16x4*)(a + 16);
    bf16x8 r; r[0] = lo[0]; r[1] = lo[1]; r[2] = lo[2]; r[3] = lo[3]; r[4] = hi[0]; r[5] = hi[1]; r[6] = hi[2]; r[7] = hi[3]; return r;
}
DEV void rc_prep8(const float (&k)[8], const float (&al)[8], const float (&kkw)[8], const float (&kaw)[8], float (&a)[8], float (&b)[8], float (&kh)[8]) {
    float kk[8]; float ss = 0.f;
#pragma unroll
    for (int e = 0; e < 8; ++e) { kk[e] = k[e] * kkw[e]; ss += kk[e] * kk[e]; }
    ss += __shfl_xor(ss, 1); ss += __shfl_xor(ss, 2); ss += __shfl_xor(ss, 4);
    const float inv = 1.0f / fmaxf(sqrtf(ss), 1e-12f);
#pragma unroll
    for (int e = 0; e < 8; ++e) { const float kn = kk[e] * inv; a[e] = -kn; b[e] = kn * al[e]; kh[e] = k[e] * (1.0f + (al[e] - 1.0f) * kaw[e]); }
}
DEV void phase_rw_cha(const Params& p, int jl, LAS unsigned char* lds) {
    const int tid = tid_(), bid = bid_(); const int lane = tid & 63, w = tid >> 6; const int fr = lane & 15, fq = lane >> 4;
    LAS float* cum = (LAS float*)lds;
    LAS float* seg = cum + 64 * 64;
    LAS float* Aab = seg + 8 * 64;
    LAS bf16_t* As = (LAS bf16_t*)(Aab + 64 * 68);
    LAS bf16_t* Bs = As + 64 * RC_LD; LAS bf16_t* Ks = Bs + 64 * RC_LD; LAS bf16_t* Vs = Ks + 64 * RC_LD; LAS bf16_t* Ke = Vs + 64 * RC_LD;
    LAS bf16_t* Aak = Ke + 64 * RC_LD; LAS bf16_t* Ts = Aak + 64 * RC_LD; LAS bf16_t* X1 = Ts + 64 * RC_LD; LAS bf16_t* Aabh = X1 + 64 * RC_LD;
    LAS bf16_t* Fimg = Aabh + 64 * RC_LD;
    LAS bf16_t* Wimg = Fimg + 4096;
    float pwd[8], pkr[8], pal[8], pv[8];
    float kkw[8], kaw[8];
    ld8(p.rw_k_k + (size_t)jl * D + (bid & 15) * 64 + (tid & 7) * 8, kkw); ld8(p.rw_k_a + (size_t)jl * D + (bid & 15) * 64 + (tid & 7) * 8, kaw);
    { const int c = bid >> 4, h = bid & 15; rc_load_wd(p, c * 64, h * 64, pwd);
      const size_t go = (size_t)(c * 64 + (tid >> 3)) * D + h * 64 + (tid & 7) * 8; ld8b(WS_(p, Kb) + go, pkr); ld8b(WS_(p, Ab) + go, pal); ld8b(WS_(p, Vb) + go, pv); }
    for (int u = bid; u < 4096; u += NB_) {
        const int c = u >> 4, h = u & 15; const int t0 = c * 64, cb = h * 64; const size_t ub = (size_t)c * 16 + h;
        lds_barrier();
        rc_cum_regs(pwd, cum, seg);
        {
            const int t = tid >> 3, k8 = (tid & 7) * 8;
            float a[8], b[8], kh[8], v[8], ct[8], cp[8], ce[8];
            rc_prep8(pkr, pal, kkw, kaw, a, b, kh);
#pragma unroll
            for (int e = 0; e < 8; ++e) v[e] = pv[e];
            if (u + NB_ < 4096) { const int un = u + NB_; const int cn = un >> 4, hn = un & 15; rc_load_wd(p, cn * 64, hn * 64, pwd);
                const size_t gn = (size_t)(cn * 64 + t) * D + hn * 64 + k8; ld8b(WS_(p, Kb) + gn, pkr); ld8b(WS_(p, Ab) + gn, pal); ld8b(WS_(p, Vb) + gn, pv); }
            lds8(cum + t * 64 + k8, ct); lds8(cum + 63 * 64 + k8, ce);
            if (t > 0) lds8(cum + (t - 1) * 64 + k8, cp); else { for (int e = 0; e < 8; ++e) cp[e] = 0.f; }
            float at[8], bt[8], kt[8], be[8], ke[8];
#pragma unroll
            for (int e = 0; e < 8; ++e) { const float ei = __expf(-ct[e]), ee = __expf(ce[e] - ct[e]); at[e] = a[e] * __expf(cp[e]); bt[e] = b[e] * ei; kt[e] = kh[e] * ei; be[e] = b[e] * ee; ke[e] = kh[e] * ee; }
            *(LAS u32x4*)(As + t * RC_LD + k8) = pk8(at); *(LAS u32x4*)(Bs + t * RC_LD + k8) = pk8(bt); *(LAS u32x4*)(Ks + t * RC_LD + k8) = pk8(kt);
            *(LAS u32x4*)(Ke + t * RC_LD + k8) = pk8(ke); *(LAS u32x4*)(Vs + t * RC_LD + k8) = pk8(v);
            const int tq = t & 31, g = (tq & 15) >> 2, j = (tq & 3) + ((tq >> 4) << 2);
#pragma unroll
            for (int e = 0; e < 8; ++e) { const int k = k8 + e; Fimg[(((k >> 4) * 2 + (t >> 5)) * 64 + g * 16 + (k & 15)) * 8 + j] = (bf16_t)f2bf(be[e]); }
            *(LAS u32x4*)(Ts + tid * 8) = (u32x4){0u, 0u, 0u, 0u}; if (tid < 64) *(LAS u32x4*)(Ts + (512 + tid) * 8) = (u32x4){0u, 0u, 0u, 0u};
            if (t == 63) { float gm[8]; for (int e = 0; e < 8; ++e) gm[e] = __expf(ce[e]); *(f32x4*)(WS_(p, RGc) + ub * 64 + k8) = (f32x4){gm[0], gm[1], gm[2], gm[3]}; *(f32x4*)(WS_(p, RGc) + ub * 64 + k8 + 4) = (f32x4){gm[4], gm[5], gm[6], gm[7]}; }
        }
        lds_barrier();
        {
            const int tb = w >> 1;
#pragma unroll
            for (int ii = 0; ii < 2; ++ii) { const int ib = 2 * (w & 1) + ii;
                f32x4 ab = {0.f, 0.f, 0.f, 0.f}, ak = {0.f, 0.f, 0.f, 0.f};
                if (ib <= tb) {
#pragma unroll
                    for (int ks = 0; ks < 2; ++ks) { const bf16x8 af = frag_rm(As, RC_LD, 16 * tb, 32 * ks, lane);
                        ab = MFMA16(af, frag_rm(Bs, RC_LD, 16 * ib, 32 * ks, lane), ab); ak = MFMA16(af, frag_rm(Ks, RC_LD, 16 * ib, 32 * ks, lane), ak); } }
#pragma unroll
                for (int r = 0; r < 4; ++r) { const int t = 16 * tb + 4 * fq + r, i = 16 * ib + fr; const bool keep = i < t;
                    Aab[t * 68 + i] = keep ? ab[r] : 0.f; Aabh[t * RC_LD + i] = (bf16_t)f2bf(keep ? ab[r] : 0.f); Aak[t * RC_LD + i] = (bf16_t)f2bf(keep ? ak[r] : 0.f); } }
            *(u32x4*)(WS_(p, RBf) + ub * 4096 + tid * 8) = *(const LAS u32x4*)(Fimg + tid * 8);
        }
        lds_barrier();
        if (w == 0) {
            const int blk = lane >> 4, jc = lane & 15;
            float Tc[16];
#pragma unroll
            for (int t = 0; t < 16; ++t) {
                float acc = jc == t ? 1.f : 0.f;
#pragma unroll
                for (int i4 = 0; i4 < (t + 3) / 4; ++i4) { const f32x4 a4 = *(const LAS f32x4*)(Aab + (16 * blk + t) * 68 + 16 * blk + i4 * 4);
#pragma unroll
                    for (int e = 0; e < 4; ++e) if (i4 * 4 + e < t) acc += a4[e] * Tc[i4 * 4 + e]; }
                Tc[t] = acc;
            }
#pragma unroll
            for (int t = 0; t < 16; ++t) Ts[(16 * blk + t) * RC_LD + 16 * blk + jc] = (bf16_t)f2bf(Tc[t]);
#pragma unroll
            for (int b = 1; b < 4; ++b) {
                const s16x4 dlo = *(const LAS s16x4*)(Ts + (16 * b + fr) * RC_LD + 16 * b + 4 * fq);
                bf16x8 dfr; dfr[0] = dlo[0]; dfr[1] = dlo[1]; dfr[2] = dlo[2]; dfr[3] = dlo[3]; dfr[4] = 0; dfr[5] = 0; dfr[6] = 0; dfr[7] = 0;
                f32x4 tt_[3];
#pragma unroll
                for (int cbk = 0; cbk < b; ++cbk) {
                    f32x4 x = {0.f, 0.f, 0.f, 0.f};
#pragma unroll
                    for (int ks = 0; ks < 2; ++ks) x = MFMA16(frag_rm(Aabh, RC_LD, 16 * b, 32 * ks, lane), frag_tr(Ts, RC_LD, 32 * ks, 16 * cbk, lane), x);
                    u32x4 xb; xb.x = pk2(x[0], x[1]); xb.y = pk2(x[2], x[3]); xb.z = 0u; xb.w = 0u;
                    tt_[cbk] = MFMA16(dfr, __builtin_bit_cast(bf16x8, xb), ((f32x4){0.f, 0.f, 0.f, 0.f}));
                }
#pragma unroll
                for (int cbk = 0; cbk < b; ++cbk)
#pragma unroll
                    for (int r = 0; r < 4; ++r) Ts[(16 * b + 4 * fq + r) * RC_LD + 16 * cbk + fr] = (bf16_t)f2bf(tt_[cbk][r]);
            }
        } else {
            for (int tl = w - 1; tl < 32; tl += 7) {
                const int rb = (tl & 15) >> 2, vbk = tl & 3; f32x4 acc = {0.f, 0.f, 0.f, 0.f};
                if (tl < 16) {
#pragma unroll
                    for (int ks = 0; ks < 2; ++ks) acc = MFMA16(frag_rm(Aak, RC_LD, 16 * rb, 32 * ks, lane), frag_tr(Vs, RC_LD, 32 * ks, 16 * vbk, lane), acc);
#pragma unroll
                    for (int r = 0; r < 4; ++r) X1[(16 * rb + 4 * fq + r) * RC_LD + 16 * vbk + fr] = (bf16_t)f2bf(acc[r]);
                } else {
#pragma unroll
                    for (int ks = 0; ks < 2; ++ks) acc = MFMA16(frag_tr(Ke, RC_LD, 32 * ks, 16 * rb, lane), frag_tr(Vs, RC_LD, 32 * ks, 16 * vbk, lane), acc);
                    { u32x2 o; o.x = pk2(acc[0], acc[1]); o.y = pk2(acc[2], acc[3]); *(u32x2*)(WS_(p, RNa) + (((ub * 4 + vbk) * 4 + rb) * 64 + lane) * 4) = o; }
                }
            }
        }
        lds_barrier();
#pragma unroll
        for (int q = 0; q < 4; ++q) { const int tl = w * 4 + q; const int tt = (tl & 15) >> 2, cbk = tl & 3; f32x4 acc = {0.f, 0.f, 0.f, 0.f};
            if (tl < 16) {
#pragma unroll
                for (int ks = 0; ks < 2; ++ks) acc = MFMA16(frag_rm(Ts, RC_LD, 16 * tt, 32 * ks, lane), frag_tr(As, RC_LD, 32 * ks, 16 * cbk, lane), acc);
                const int k = 16 * cbk + fr, kq = k & 31, g = (kq & 15) >> 2, j = (kq & 3) + ((kq >> 4) << 2);
#pragma unroll
                for (int r = 0; r < 4; ++r) Wimg[((tt * 2 + (k >> 5)) * 64 + g * 16 + 4 * fq + r) * 8 + j] = (bf16_t)f2bf(acc[r]);
            } else {
#pragma unroll
                for (int ks = 0; ks < 2; ++ks) acc = MFMA16(frag_rm(Ts, RC_LD, 16 * tt, 32 * ks, lane), frag_tr(X1, RC_LD, 32 * ks, 16 * cbk, lane), acc);
                { u32x2 o; o.x = pk2(acc[0], acc[1]); o.y = pk2(acc[2], acc[3]); *(u32x2*)(WS_(p, RUt) + (((ub * 4 + cbk) * 4 + tt) * 64 + lane) * 4) = o; }
            } }
        lds_barrier();
        *(u32x4*)(WS_(p, RWf) + ub * 4096 + tid * 8) = *(const LAS u32x4*)(Wimg + tid * 8);
    }
}

constexpr int RB_SLOT = 20992, RB_R = 6, RB_P = 5;
struct RbOpsA { bf16x8 wf[8]; u32x2 ut[4]; };
struct RbOpsB { bf16x8 bf[8]; u32x2 na[4]; f32x4 gc[4]; };
DEV void rb_read_a(const LAS unsigned char* slot, int lane, RbOpsA& O) {
#pragma unroll
    for (int f = 0; f < 8; ++f) O.wf[f] = *(const LAS bf16x8*)(slot + (f * 64 + lane) * 16);
#pragma unroll
    for (int q = 0; q < 4; ++q) O.ut[q] = *(const LAS u32x2*)(slot + 16384 + (q * 64 + lane) * 8);
}
DEV void rb_read_b(const LAS unsigned char* slot, int lane, RbOpsB& O) {
    const int fq = lane >> 4;
#pragma unroll
    for (int f = 0; f < 8; ++f) O.bf[f] = *(const LAS bf16x8*)(slot + 8192 + (f * 64 + lane) * 16);
#pragma unroll
    for (int q = 0; q < 4; ++q) { O.na[q] = *(const LAS u32x2*)(slot + 18432 + (q * 64 + lane) * 8); O.gc[q] = *(const LAS f32x4*)(slot + 20480 + (16 * q + 4 * fq) * 4); }
}
DEV void phase_rw_chb(const Params& p, int layer, LAS unsigned char* lds) {
    const int tid = tid_(), bid = bid_();
    if (bid >= 64) { if (layer == 0) convert_jobs<14, 16>(p, lds, 64, NB_ - 64); return; }
    const int lane = tid & 63, w = __builtin_amdgcn_readfirstlane(tid >> 6); const int head = bid & 15, vb = bid >> 4;
    auto issue = [&](int c) {
        const size_t ub = (size_t)c * 16 + head; LAS unsigned char* slot = lds + (c % RB_R) * RB_SLOT;
#pragma unroll
        for (int i = 0; i < 3; ++i) { const int pi = (w - 1) * 3 + i;
            if (pi < 8) __builtin_amdgcn_global_load_lds((const unsigned*)(WS_(p, RWf) + ub * 4096 + pi * 512 + lane * 8), (LAS unsigned*)(slot + pi * 1024), 16, 0, 0);
            else if (pi < 16) __builtin_amdgcn_global_load_lds((const unsigned*)(WS_(p, RBf) + ub * 4096 + (pi - 8) * 512 + lane * 8), (LAS unsigned*)(slot + 8192 + (pi - 8) * 1024), 16, 0, 0);
            else if (pi < 18) __builtin_amdgcn_global_load_lds((const unsigned*)(WS_(p, RUt) + (ub * 4 + vb) * 1024 + (pi - 16) * 512 + lane * 8), (LAS unsigned*)(slot + 16384 + (pi - 16) * 1024), 16, 0, 0);
            else if (pi < 20) __builtin_amdgcn_global_load_lds((const unsigned*)(WS_(p, RNa) + (ub * 4 + vb) * 1024 + (pi - 18) * 512 + lane * 8), (LAS unsigned*)(slot + 18432 + (pi - 18) * 1024), 16, 0, 0);
            else __builtin_amdgcn_global_load_lds((const unsigned*)(WS_(p, RGc) + ub * 64 + lane), (LAS unsigned*)(slot + 20480), 4, 0, 0);
        }
    };
    if (w > 0) {
#pragma unroll 1
        for (int c = 0; c < RB_P; ++c) issue(c);
        asm volatile("s_waitcnt vmcnt(9)" ::: "memory");
    }
    __builtin_amdgcn_s_barrier();
    f32x4 s[4]; for (int i = 0; i < 4; ++i) s[i] = (f32x4){0.f, 0.f, 0.f, 0.f};
    RbOpsA cur, nxt; RbOpsB cb_;
    if (w == 0) { rb_read_a(lds, lane, cur); }
#pragma unroll 1
    for (int c = 0; c < 256; ++c) {
        if (w > 0) {
            if (c + RB_P < 256) { issue(c + RB_P); asm volatile("s_waitcnt vmcnt(9)" ::: "memory"); }
            else asm volatile("s_waitcnt vmcnt(0)" ::: "memory");
        } else {
            const size_t ub = (size_t)c * 16 + head;
            rb_read_b(lds + (c % RB_R) * RB_SLOT, lane, cb_);
            rb_read_a(lds + ((c + 1 < 256 ? c + 1 : c) % RB_R) * RB_SLOT, lane, nxt);
#pragma unroll
            for (int kt = 0; kt < 4; ++kt) { u32x2 o; o.x = pk2(s[kt][0], s[kt][1]); o.y = pk2(s[kt][2], s[kt][3]); *(u32x2*)(WS_(p, RS0) + (((ub * 4 + vb) * 4 + kt) * 64 + lane) * 4) = o; }
            bf16x8 sb[2];
#pragma unroll
            for (int ks = 0; ks < 2; ++ks) { u32x4 o; o.x = pk2(s[2 * ks][0], s[2 * ks][1]); o.y = pk2(s[2 * ks][2], s[2 * ks][3]); o.z = pk2(s[2 * ks + 1][0], s[2 * ks + 1][1]); o.w = pk2(s[2 * ks + 1][2], s[2 * ks + 1][3]); sb[ks] = __builtin_bit_cast(bf16x8, o); }
            f32x4 uu[4];
#pragma unroll
            for (int tt = 0; tt < 4; ++tt) { uu[tt] = (f32x4){bflo(cur.ut[tt].x), bfhi(cur.ut[tt].x), bflo(cur.ut[tt].y), bfhi(cur.ut[tt].y)}; uu[tt] = MFMA16(cur.wf[tt * 2], sb[0], uu[tt]); uu[tt] = MFMA16(cur.wf[tt * 2 + 1], sb[1], uu[tt]); }
#pragma unroll
            for (int tt = 0; tt < 4; ++tt) { u32x2 o; o.x = pk2(uu[tt][0], uu[tt][1]); o.y = pk2(uu[tt][2], uu[tt][3]); *(u32x2*)(WS_(p, RUa) + (((ub * 4 + vb) * 4 + tt) * 64 + lane) * 4) = o; }
            bf16x8 ubf[2];
#pragma unroll
            for (int ks = 0; ks < 2; ++ks) { u32x4 o; o.x = pk2(uu[2 * ks][0], uu[2 * ks][1]); o.y = pk2(uu[2 * ks][2], uu[2 * ks][3]); o.z = pk2(uu[2 * ks + 1][0], uu[2 * ks + 1][1]); o.w = pk2(uu[2 * ks + 1][2], uu[2 * ks + 1][3]); ubf[ks] = __builtin_bit_cast(bf16x8, o); }
#pragma unroll
            for (int kt = 0; kt < 4; ++kt) { s[kt] = s[kt] * cb_.gc[kt] + (f32x4){bflo(cb_.na[kt].x), bfhi(cb_.na[kt].x), bflo(cb_.na[kt].y), bfhi(cb_.na[kt].y)}; s[kt] = MFMA16(cb_.bf[kt * 2], ubf[0], s[kt]); s[kt] = MFMA16(cb_.bf[kt * 2 + 1], ubf[1], s[kt]); }
            cur = nxt;
            asm volatile("s_waitcnt lgkmcnt(0)" ::: "memory");
        }
        __builtin_amdgcn_s_barrier();
    }
    asm volatile("s_waitcnt vmcnt(0)" ::: "memory");
}

DEV void phase_rw_chc(const Params& p, int j, LAS unsigned char* lds) {
    const int tid = tid_(), bid = bid_(); const int lane = tid & 63, w = tid >> 6; const int fr = lane & 15, fq = lane >> 4;
    LAS float* cum = (LAS float*)lds;
    LAS float* seg = cum + 64 * 64;
    LAS float* Ys = seg + 8 * 64;
    LAS bf16_t* Rs = (LAS bf16_t*)(Ys + 64 * 68);
    LAS bf16_t* Bs = Rs + 64 * RC_LD; LAS bf16_t* Ks = Bs + 64 * RC_LD; LAS bf16_t* Vs = Ks + 64 * RC_LD; LAS bf16_t* Arb = Vs + 64 * RC_LD; LAS bf16_t* Ark = Arb + 64 * RC_LD;
    float pwd[8], pr[8], pkr[8], pal[8], pv[8], pg[8];
    float kkw[8], kaw[8], rkw[8], lgw[8], lbw[8];
    { const size_t po = (size_t)j * D + (bid & 15) * 64 + (tid & 7) * 8; ld8(p.rw_k_k + po, kkw); ld8(p.rw_k_a + po, kaw); ld8(p.rw_r_k + po, rkw); ld8(p.rw_lnx_g + po, lgw); ld8(p.rw_lnx_b + po, lbw); }
    { const int c = bid >> 4, h = bid & 15; rc_load_wd(p, c * 64, h * 64, pwd);
      const size_t go = (size_t)(c * 64 + (tid >> 3)) * D + h * 64 + (tid & 7) * 8; ld8b(WS_(p, Rb) + go, pr); ld8b(WS_(p, Kb) + go, pkr); ld8b(WS_(p, Ab) + go, pal); ld8b(WS_(p, Vb) + go, pv); ld8b(WS_(p, Gb) + go, pg); }
    for (int u = bid; u < 4096; u += NB_) {
        const int c = u >> 4, h = u & 15; const int t0 = c * 64, cb = h * 64; const size_t ub = (size_t)c * 16 + h;
        const int tt = w & 3;
        u32x2 ufr[2][2][2], sfr[2][2][2];
#pragma unroll
        for (int q = 0; q < 2; ++q)
#pragma unroll
            for (int ks = 0; ks < 2; ++ks)
#pragma unroll
                for (int hf = 0; hf < 2; ++hf) { const size_t o = (((ub * 4 + 2 * (w >> 2) + q) * 4 + 2 * ks + hf) * 64 + lane) * 4;
                    ufr[q][ks][hf] = *(const u32x2*)(WS_(p, RUa) + o); sfr[q][ks][hf] = *(const u32x2*)(WS_(p, RS0) + o); }
        lds_barrier();
        rc_cum_regs(pwd, cum, seg);
#ifdef DBL_CUM
        rc_cum_regs(pwd, cum, seg);
#endif
        const int t = tid >> 3, k8 = (tid & 7) * 8; const size_t go = (size_t)(t0 + t) * D + cb + k8;
        float v[8], gg[8]; float bc;
        {   float r[8], a[8], b[8], kh[8], ct[8];
#pragma unroll
            for (int e = 0; e < 8; ++e) { r[e] = pr[e]; v[e] = pv[e]; gg[e] = pg[e]; }
            lds8(cum + t * 64 + k8, ct);
            rc_prep8(pkr, pal, kkw, kaw, a, b, kh);
            if (u + NB_ < 4096) { const int un = u + NB_; const int cn = un >> 4, hn = un & 15; rc_load_wd(p, cn * 64, hn * 64, pwd);
                const size_t gn = (size_t)(cn * 64 + t) * D + hn * 64 + k8; ld8b(WS_(p, Rb) + gn, pr); ld8b(WS_(p, Kb) + gn, pkr); ld8b(WS_(p, Ab) + gn, pal); ld8b(WS_(p, Vb) + gn, pv); ld8b(WS_(p, Gb) + gn, pg); }
            bc = 0.f;
#pragma unroll
            for (int e = 0; e < 8; ++e) bc += r[e] * kh[e] * rkw[e];
            bc += __shfl_xor(bc, 1); bc += __shfl_xor(bc, 2); bc += __shfl_xor(bc, 4);
#pragma unroll
            for (int e = 0; e < 8; ++e) { const float ei = __expf(-ct[e]); r[e] *= __expf(ct[e]); b[e] *= ei; kh[e] *= ei; }
            *(LAS u32x4*)(Rs + t * RC_LD + k8) = pk8(r); *(LAS u32x4*)(Bs + t * RC_LD + k8) = pk8(b); *(LAS u32x4*)(Ks + t * RC_LD + k8) = pk8(kh); *(LAS u32x4*)(Vs + t * RC_LD + k8) = pk8(v);
        }
        lds_barrier();
#ifdef DBL_S3
#pragma unroll 1
        for (int rep_ = 0; rep_ < 2; ++rep_)
#endif
        {   const int tb = w >> 1;
#pragma unroll
            for (int ii = 0; ii < 2; ++ii) { const int ib = 2 * (w & 1) + ii;
                f32x4 ab = {0.f, 0.f, 0.f, 0.f}, ak = {0.f, 0.f, 0.f, 0.f};
                if (ib <= tb) {
#pragma unroll
                    for (int ks = 0; ks < 2; ++ks) { const bf16x8 af = frag_rm(Rs, RC_LD, 16 * tb, 32 * ks, lane);
                        ab = MFMA16(af, frag_rm(Bs, RC_LD, 16 * ib, 32 * ks, lane), ab); ak = MFMA16(af, frag_rm(Ks, RC_LD, 16 * ib, 32 * ks, lane), ak); } }
#pragma unroll
                for (int r = 0; r < 4; ++r) { const int tr = 16 * tb + 4 * fq + r, i = 16 * ib + fr; const bool keep = i <= tr;
                    Arb[tr * RC_LD + i] = (bf16_t)f2bf(keep ? ab[r] : 0.f); Ark[tr * RC_LD + i] = (bf16_t)f2bf(keep ? ak[r] : 0.f); } }
        }
        lds_barrier();
#ifdef DBL_Y
#pragma unroll 1
        for (int rep_ = 0; rep_ < 2; ++rep_)
#endif
#pragma unroll
        for (int q = 0; q < 2; ++q) { const int vbk = 2 * (w >> 2) + q; f32x4 acc = {0.f, 0.f, 0.f, 0.f};
#pragma unroll
            for (int ks = 0; ks < 2; ++ks) {
                u32x4 bu, bs; bu.x = ufr[q][ks][0].x; bu.y = ufr[q][ks][0].y; bu.z = ufr[q][ks][1].x; bu.w = ufr[q][ks][1].y; bs.x = sfr[q][ks][0].x; bs.y = sfr[q][ks][0].y; bs.z = sfr[q][ks][1].x; bs.w = sfr[q][ks][1].y;
                acc = MFMA16(frag_rm_pi(Rs, RC_LD, 16 * tt, 32 * ks, lane), __builtin_bit_cast(bf16x8, bs), acc);
                acc = MFMA16(frag_rm_pi(Arb, RC_LD, 16 * tt, 32 * ks, lane), __builtin_bit_cast(bf16x8, bu), acc);
                acc = MFMA16(frag_rm(Ark, RC_LD, 16 * tt, 32 * ks, lane), frag_tr(Vs, RC_LD, 32 * ks, 16 * vbk, lane), acc); }
#pragma unroll
            for (int r = 0; r < 4; ++r) Ys[(16 * tt + 4 * fq + r) * 68 + 16 * vbk + fr] = acc[r]; }
        lds_barrier();
        {
            float y[8]; lds8(Ys + t * 68 + k8, y);
            float s1 = 0.f, s2 = 0.f;
#pragma unroll
            for (int e = 0; e < 8; ++e) { s1 += y[e]; s2 += y[e] * y[e]; }
            s1 += __shfl_xor(s1, 1); s1 += __shfl_xor(s1, 2); s1 += __shfl_xor(s1, 4); s2 += __shfl_xor(s2, 1); s2 += __shfl_xor(s2, 2); s2 += __shfl_xor(s2, 4);
            const float mean = s1 * (1.0f / 64.0f), var = s2 * (1.0f / 64.0f) - mean * mean; const float rs = rsqrtf(fmaxf(var, 0.f) + 64e-5f);
            float o[8];
#pragma unroll
            for (int e = 0; e < 8; ++e) o[e] = ((y[e] - mean) * rs * lgw[e] + lbw[e] + bc * v[e]) * gg[e];
            *(u32x4*)(WS_(p, YB) + go) = pk8(o);
        }
    }
}
DEV void phase_ln1(const Params& p, int layer, LAS unsigned char* lds) {
    const int tid = tid_(), bid = bid_(); (void)tid; (void)bid;
    const int lane = tid & 63, wid = tid >> 6; const int fr = lane & 15, fq = lane >> 4;
    LAS float* lgt = (LAS float*)lds;
    LAS int* cnt = (LAS int*)(lgt + 2 * 64 * 48);
    if (tid < 32) cnt[tid] = 0;
    const float* g = p.ln_g + ((size_t)layer * 2 + 0) * D; const float* be = p.ln_b + ((size_t)layer * 2 + 0) * D;
    const float* br = p.moe_b_route + layer * 32; const float* bg = p.moe_b_group + layer * 4;
    f32x4 gwv[4], bwv[4];
#pragma unroll
    for (int q = 0; q < 4; ++q) { gwv[q] = *(const f32x4*)(g + 256 * q + 4 * lane); bwv[q] = *(const f32x4*)(be + 256 * q + 4 * lane); }
    u32x2 rh[4], rm[4];
#pragma unroll
    for (int q = 0; q < 4; ++q) { rh[q] = *(const u32x2*)(WS_(p, Hb) + (size_t)(bid * 64 + wid * 8) * D + 256 * q + 4 * lane); rm[q] = *(const u32x2*)(WS_(p, MIXb) + (size_t)(bid * 64 + wid * 8) * D + 256 * q + 4 * lane); }
#pragma unroll 1
    for (int rr = 0; rr < 8; ++rr) {
        const int t = bid * 64 + wid * 8 + rr; const size_t ro = (size_t)t * D;
        f32x4 z[4], m[4];
#pragma unroll
        for (int q = 0; q < 4; ++q) { z[q] = (f32x4){bflo(rh[q].x), bfhi(rh[q].x), bflo(rh[q].y), bfhi(rh[q].y)}; m[q] = (f32x4){bflo(rm[q].x), bfhi(rm[q].x), bflo(rm[q].y), bfhi(rm[q].y)}; }
        { const size_t rn = (size_t)(rr < 7 ? t + 1 : t) * D;
#pragma unroll
          for (int q = 0; q < 4; ++q) { rh[q] = *(const u32x2*)(WS_(p, Hb) + rn + 256 * q + 4 * lane); rm[q] = *(const u32x2*)(WS_(p, MIXb) + rn + 256 * q + 4 * lane); } }
        float s = 0.f;
#pragma unroll
        for (int q = 0; q < 4; ++q) { z[q] = z[q] * ALPHA + m[q]; s += z[q][0] + z[q][1] + z[q][2] + z[q][3]; }
        const float mean = wave_sum(s) * (1.0f / D);
        float vs = 0.f;
#pragma unroll
        for (int q = 0; q < 4; ++q) { z[q] = z[q] - mean; vs += z[q][0] * z[q][0] + z[q][1] * z[q][1] + z[q][2] * z[q][2] + z[q][3] * z[q][3]; }
        const float rs = rsqrtf(wave_sum(vs) * (1.0f / D) + LN_EPS);
#pragma unroll
        for (int q = 0; q < 4; ++q) {
            st_bf4(WS_(p, H1b) + ro + 256 * q + 4 * lane, z[q] * rs * gwv[q] + bwv[q]);
        }
    }
    asm volatile("s_waitcnt vmcnt(0)" ::: "memory");
    __syncthreads();
    {   const int rt = wid & 3, kh = wid >> 2;
        const bf16_t* Ab = WS_(p, H1b) + (size_t)(bid * 64 + 16 * rt + fr) * D + 512 * kh + 8 * fq;
        const bf16_t* Wb = WS_(p, moe_wr_t) + (size_t)layer * 48 * D + (size_t)fr * D + 512 * kh + 8 * fq;
        f32x4 acc[3]; for (int i = 0; i < 3; ++i) acc[i] = (f32x4){0.f, 0.f, 0.f, 0.f};
#pragma unroll 8
        for (int ks = 0; ks < 16; ++ks) {
            const bf16x8 af = *(const bf16x8*)(Ab + 32 * ks);
#pragma unroll
            for (int ct = 0; ct < 3; ++ct) acc[ct] = MFMA16(af, *(const bf16x8*)(Wb + (size_t)16 * ct * D + 32 * ks), acc[ct]);
        }
#pragma unroll
        for (int ct = 0; ct < 3; ++ct)
#pragma unroll
            for (int r = 0; r < 4; ++r) lgt[(kh * 64 + 16 * rt + 4 * fq + r) * 48 + 16 * ct + fr] = acc[ct][r];
    }
    __syncthreads();
    if (tid < 64) {
        const int t = bid * 64 + tid; const LAS float* L0 = lgt + tid * 48; const LAS float* L1 = lgt + (64 + tid) * 48;
        const float q0 = L0[32] + L1[32] + bg[0], q1 = L0[33] + L1[33] + bg[1], q2 = L0[34] + L1[34] + bg[2], q3 = L0[35] + L1[35] + bg[3];
        int gi = 0; float gm = q0;
        if (q1 > gm) { gm = q1; gi = 1; } if (q2 > gm) { gm = q2; gi = 2; } if (q3 > gm) { gm = q3; gi = 3; }
        const float den = __expf(q0 - gm) + __expf(q1 - gm) + __expf(q2 - gm) + __expf(q3 - gm);
        const float pgrp = __builtin_amdgcn_rcpf(den);
        float l1 = -INFINITY, l2 = -INFINITY; int i1 = 0, i2 = 0;
#pragma unroll 1
        for (int o = 0; o < 8; ++o) { const float v = L0[gi * 8 + o] + L1[gi * 8 + o] + br[gi * 8 + o];
            if (v > l1) { l2 = l1; i2 = i1; l1 = v; i1 = o; } else if (v > l2) { l2 = v; i2 = o; } }
        const float e2 = __expf(l2 - l1), inv = __builtin_amdgcn_rcpf(1.0f + e2);
        const int e0 = gi * 8 + i1, e1 = gi * 8 + i2;
        WS_(p, EIDX)[2 * t] = e0; WS_(p, EIDX)[2 * t + 1] = e1; WS_(p, GATE)[2 * t] = pgrp * inv; WS_(p, GATE)[2 * t + 1] = pgrp * e2 * inv;
        atomicAdd((int*)&cnt[e0], 1); atomicAdd((int*)&cnt[e1], 1);
    }
    __syncthreads();
    if (tid < 32) WS_(p, CNT)[bid * 32 + tid] = cnt[tid];
}

DEV void phase_moe_scatter(const Params& p, LAS unsigned char* lds) {
    const int tid = tid_(), bid = bid_(); (void)tid; (void)bid;
    const int lane = tid & 63, wid = tid >> 6;
    LAS int* part = (LAS int*)lds;
    LAS int* pre = part + 512;
    LAS int* base = pre + 512;
    LAS int* pst = base + 32;
    LAS int* dst = pst + 40;
    LAS int* eid = dst + 128;
    { const int e = tid & 31, part_i = tid >> 5; int tot = 0, prf = 0;
      for (int b = part_i * 16; b < part_i * 16 + 16; ++b) { const int c = WS_(p, CNT)[b * 32 + e]; tot += c; if (b < (int)bid) prf += c; }
      part[part_i * 32 + e] = tot; pre[part_i * 32 + e] = prf; }
    if (tid < 128) eid[tid] = WS_(p, EIDX)[bid * 128 + tid];
    lds_barrier();
    if (tid < 32) { int tot = 0, prf = 0; for (int i = 0; i < 16; ++i) { tot += part[i * 32 + tid]; prf += pre[i * 32 + tid]; } part[tid] = tot; pre[tid] = prf; }
    lds_barrier();
    if (tid == 0) { int acc = 0; for (int e = 0; e < 32; ++e) { pst[e] = acc; acc += ((part[e] + 255) >> 8) << 8; } pst[32] = acc;
        if (bid == 0) { for (int e = 0; e <= 32; ++e) WS_(p, TAB)[e] = pst[e]; WS_(p, TAB)[33] = acc >> 8;
            for (int e = 0; e < 32; ++e) for (int mt = pst[e] >> 8; mt < (pst[e + 1] >> 8); ++mt) WS_(p, TAB)[64 + mt] = e; } }
    lds_barrier();
    if (tid < 32) { int run = pst[tid] + pre[tid];
#pragma unroll 16
        for (int a = 0; a < 128; ++a) if (eid[a] == tid) dst[a] = run++; }
    lds_barrier();
    if (tid < 128) WS_(p, DEST)[bid * 128 + tid] = dst[tid];
#pragma unroll 4
    for (int a = wid * 16; a < wid * 16 + 16; ++a) {
        const int t = bid * 64 + (a >> 1); const int d = dst[a];
        const u32x4 v0 = *(const u32x4*)(WS_(p, H1b) + (size_t)t * D + lane * 8), v1 = *(const u32x4*)(WS_(p, H1b) + (size_t)t * D + 512 + lane * 8);
        *(u32x4*)(WS_(p, BUF) + (size_t)d * D + lane * 8) = v0; *(u32x4*)(WS_(p, BUF) + (size_t)d * D + 512 + lane * 8) = v1;
    }
}

template <int which> struct SchedMoe {
    const Params* p; int layer; const LAS int* tab;
    DEV bool next(int i, Unit& u) const {
        const int nmt = tab[33]; int pm, pn; if (!pg8::tile_order(i, NB_, bid_(), nmt, 4, pm, pn)) return false;
        const int row0 = pm * 256; const int e = tab[64 + pm];
        if constexpr (which == 0) { u.A = (const char*)(WS_(*p, BUF) + (size_t)row0 * D); u.B = (const char*)(WS_(*p, moe_w1_t) + ((size_t)layer * 32 + e) * 1024 * 1024 + (size_t)pn * 256 * 1024); }
        else { u.A = (const char*)(WS_(*p, ACT) + (size_t)row0 * 512); u.B = (const char*)(WS_(*p, moe_w2_t) + ((size_t)layer * 32 + e) * 1024 * 512 + (size_t)pn * 256 * 512); }
        u.row0 = row0; u.col0 = pn * 256; u.id = e; u.aux = 0; return true;
    }
};
struct EpiMoe1 {
    bf16_t* O;
    DEV void operator()(const AccT& acc, const Unit& u, int wr, int wc, int fr, int fq) const {
#pragma unroll
        for (int ai = 0; ai < 2; ++ai)
#pragma unroll
            for (int m = 0; m < 4; ++m)
#pragma unroll
                for (int n = 0; n < 2; ++n) {
                    const f32x4 gt = acc[ai][0][m][n], up = acc[ai][1][m][n]; f32x4 v;
                    for (int e = 0; e < 4; ++e) v[e] = siluf_(gt[e]) * up[e];
                    const int col = (u.col0 >> 1) + 32 * wc + 16 * n + 4 * fq;
                    st_bf4(O + (size_t)ACC_ROW(u, ai, m) * 512 + col, v); ACC_FENCE;
                }
    }
};
struct EpiMoe2 {
    bf16_t* O;
    DEV void operator()(const AccT& acc, const Unit& u, int wr, int wc, int fr, int fq) const {
        FOR_ACC(ai, bj, m, n) { st_bf4(O + (size_t)ACC_ROW(u, ai, m) * D + ACC_COL(u, bj, n), acc[ai][bj][m][n]); ACC_FENCE; }
    }
};

struct Ln2Raw { u32x2 h[4], a[4], b[4]; float g0, g1; };
DEV void ln2_issue(const Params& p, int t, int lane, Ln2Raw& R, int dpre, float gpre, int tbase) {
    const int i0 = 2 * (t - tbase); const int d0 = __shfl(dpre, i0), d1 = __shfl(dpre, i0 + 1); R.g0 = __shfl(gpre, i0); R.g1 = __shfl(gpre, i0 + 1);
#pragma unroll
    for (int q = 0; q < 4; ++q) { R.h[q] = *(const u32x2*)(WS_(p, H1b) + (size_t)t * D + 256 * q + 4 * lane);
        R.a[q] = *(const u32x2*)(WS_(p, YBUF) + (size_t)d0 * D + 256 * q + 4 * lane); R.b[q] = *(const u32x2*)(WS_(p, YBUF) + (size_t)d1 * D + 256 * q + 4 * lane); }
}
DEV void ln2_finish(const Ln2Raw& R, const f32x4 (&gwv)[4], const f32x4 (&bwv)[4], f32x4 (&z)[4]) {
    float s = 0.f; const float g0 = R.g0, g1 = R.g1;
#pragma unroll
    for (int q = 0; q < 4; ++q) {
        z[q][0] = bflo(R.h[q].x) * ALPHA + g0 * bflo(R.a[q].x) + g1 * bflo(R.b[q].x); z[q][1] = bfhi(R.h[q].x) * ALPHA + g0 * bfhi(R.a[q].x) + g1 * bfhi(R.b[q].x);
        z[q][2] = bflo(R.h[q].y) * ALPHA + g0 * bflo(R.a[q].y) + g1 * bflo(R.b[q].y); z[q][3] = bfhi(R.h[q].y) * ALPHA + g0 * bfhi(R.a[q].y) + g1 * bfhi(R.b[q].y);
        s += z[q][0] + z[q][1] + z[q][2] + z[q][3];
    }
    const float mean = wave_sum(s) * (1.0f / D);
    float vs = 0.f;
#pragma unroll
    for (int q = 0; q < 4; ++q) { z[q] = z[q] - mean; vs += z[q][0] * z[q][0] + z[q][1] * z[q][1] + z[q][2] * z[q][2] + z[q][3] * z[q][3]; }
    const float rs = rsqrtf(wave_sum(vs) * (1.0f / D) + LN_EPS);
#pragma unroll
    for (int q = 0; q < 4; ++q) z[q] = z[q] * rs * gwv[q] + bwv[q];
}
DEV void phase_ln2(const Params& p, int layer, LAS unsigned char* lds) {
    const int tid = tid_(), bid = bid_(); const int lane = tid & 63, wid = tid >> 6; const int fr = lane & 15, fq = lane >> 4;
    const float* g = p.ln_g + ((size_t)layer * 2 + 1) * D; const float* be = p.ln_b + ((size_t)layer * 2 + 1) * D;
    const int nk = layer == DEPTH - 1 ? 3 : (layer + 1) % 3;
    const int nj = (layer + 1) / 3;
    LAS float* lgt = (LAS float*)lds;
    LAS float* w2 = lgt + 2 * 64 * 32;
    if (nk == 2) { for (int i = tid; i < 16 * 512; i += NTHR) w2[i] = p.gl_gk_w2[(size_t)nj * 16 * 512 + i]; }
    const int tfirst = bid * 64 + wid * 8;
    f32x4 z[4], zp[4], gwv[4], bwv[4];
#pragma unroll
    for (int q = 0; q < 4; ++q) { gwv[q] = *(const f32x4*)(g + 256 * q + 4 * lane); bwv[q] = *(const f32x4*)(be + 256 * q + 4 * lane); }
    Ln2Raw R[3];
    const int tbase = tfirst > 0 ? tfirst - 1 : 0;
    const int dpre = lane < 18 ? WS_(p, DEST)[2 * tbase + lane] : 0; const float gpre = lane < 18 ? WS_(p, GATE)[2 * tbase + lane] : 0.f;
    if (nk == 0) { if (tfirst > 0) { ln2_issue(p, tfirst - 1, lane, R[2], dpre, gpre, tbase); } }
    ln2_issue(p, tfirst, lane, R[0], dpre, gpre, tbase);
    ln2_issue(p, tfirst + 1, lane, R[1], dpre, gpre, tbase);
    if (nk == 0) { if (tfirst > 0) ln2_finish(R[2], gwv, bwv, zp); else { for (int q = 0; q < 4; ++q) zp[q] = (f32x4){0.f, 0.f, 0.f, 0.f}; } }
#pragma unroll
    for (int rr = 0; rr < 8; ++rr) {
        const int t = tfirst + rr; const size_t ro = (size_t)t * D;
        if (rr + 2 < 8) ln2_issue(p, t + 2, lane, R[(rr + 2) % 3], dpre, gpre, tbase);
        ln2_finish(R[rr % 3], gwv, bwv, z);
        if (nk == 3) {
#pragma unroll
            for (int q = 0; q < 4; ++q) *(f32x4*)(p.out + ro + 256 * q + 4 * lane) = z[q];
        } else store_row_bf(WS_(p, Hb) + ro, lane, z);
        if (nk == 0) {
            emit_mix6(p, nj, t, lane, z, zp);
#pragma unroll
            for (int q = 0; q < 4; ++q) zp[q] = z[q];
        }
    }
    if (nk == 1 || nk == 2) {
        asm volatile("s_waitcnt vmcnt(0)" ::: "memory");
        __syncthreads();
        const int nct = nk == 1 ? 2 : 1; const int rt = wid & 3, kh = wid >> 2;
        const bf16_t* Ab = WS_(p, Hb) + (size_t)(bid * 64 + 16 * rt + fr) * D + 512 * kh + 8 * fq;
        const bf16_t* Wb = (nk == 1 ? WS_(p, mb_dt_t) : WS_(p, gl_lr_t)) + (size_t)fr * D + 512 * kh + 8 * fq;
        f32x4 acc[2]; acc[0] = (f32x4){0.f, 0.f, 0.f, 0.f}; acc[1] = acc[0];
#pragma unroll 4
        for (int ks = 0; ks < 16; ++ks) {
            const bf16x8 af = *(const bf16x8*)(Ab + 32 * ks);
            acc[0] = MFMA16(af, *(const bf16x8*)(Wb + 32 * ks), acc[0]);
            if (nct == 2) acc[1] = MFMA16(af, *(const bf16x8*)(Wb + (size_t)16 * D + 32 * ks), acc[1]);
        }
#pragma unroll
        for (int ct = 0; ct < 2; ++ct)
#pragma unroll
            for (int r = 0; r < 4; ++r) lgt[(kh * 64 + 16 * rt + 4 * fq + r) * 32 + 16 * ct + fr] = acc[ct][r];
        __syncthreads();
        if (nk == 1) {
#pragma unroll
            for (int i = 0; i < 4; ++i) { const int idx = tid + i * NTHR; const int row = idx >> 5, o = idx & 31;
                WS_(p, DT)[(size_t)(bid * 64 + row) * 32 + o] = softplusf_(lgt[row * 32 + o] + lgt[(64 + row) * 32 + o] + p.mb_dt_bias[nj * 32 + o]); }
        } else {
            const int row = tid >> 3, c0 = (tid & 7) * 64; float lr[16];
#pragma unroll
            for (int o = 0; o < 16; ++o) lr[o] = lgt[row * 32 + o] + lgt[(64 + row) * 32 + o];
#pragma unroll 1
            for (int c4 = 0; c4 < 16; ++c4) { const int c = c0 + 4 * c4; f32x4 a = *(const f32x4*)(p.gl_gk_b + nj * 512 + c);
#pragma unroll
                for (int o = 0; o < 16; ++o) { const f32x4 wv = *(const LAS f32x4*)(w2 + o * 512 + c); a = a + wv * lr[o]; }
                f32x4 r;
#pragma unroll
                for (int e = 0; e < 4; ++e) r[e] = (fminf(a[e], 0.f) - __logf(1.0f + __expf(-fabsf(a[e])))) * (1.0f / 16.0f);
                *(f32x4*)(WS_(p, LA) + (size_t)(bid * 64 + row) * 512 + c) = r; }
        }
    }
}
constexpr int MB_PROJ = 5152;
struct SchedMbIn {
    const Params* p;
    DEV bool next(int i, Unit& u) const {
        int pm, pn; if (!pg8::tile_order(i, NB_, bid_(), 64, 20, pm, pn)) return false;
        u.A = (const char*)(WS_(*p, Hb) + (size_t)pm * 256 * D); u.B = (const char*)(WS_(*p, mb_win_t) + (size_t)pn * 256 * D); u.row0 = pm * 256; u.col0 = pn * 256; u.id = 0; u.aux = 0; return true;
    }
};
struct EpiMbIn {
    const Params* p;
    DEV void operator()(const AccT& acc, const Unit& u, int wr, int wc, int fr, int fq) const {
        const bool isz = u.col0 < 2048; bf16_t* O = WS_(*p, Z) + (isz ? (size_t)0 : (size_t)T * 2048 - 2048); const int ld = isz ? 2048 : 3072;
        FOR_ACC(ai, bj, m, n) { st_bf4(O + (size_t)ACC_ROW(u, ai, m) * ld + ACC_COL(u, bj, n), acc[ai][bj][m][n]); ACC_FENCE; }
    }
};
DEV void phase_mb_conv(const Params& p, int j) {
    const int tid = tid_(), bid = bid_(); (void)tid; (void)bid;
    if (tid >= 384) return;
    const int c0 = tid * 8; const int t0 = bid * 64;
    const float* cw = p.mb_conv_w + (size_t)j * 4 * 3072; const float* cb = p.mb_conv_b + (size_t)j * 3072;
    float w[4][8], b[8];
#pragma unroll
    for (int i = 0; i < 4; ++i) { const f32x4 a = *(const f32x4*)(cw + i * 3072 + c0), bb = *(const f32x4*)(cw + i * 3072 + c0 + 4); for (int e = 0; e < 4; ++e) { w[i][e] = a[e]; w[i][4 + e] = bb[e]; } }
    { const f32x4 a = *(const f32x4*)(cb + c0), bb = *(const f32x4*)(cb + c0 + 4); for (int e = 0; e < 4; ++e) { b[e] = a[e]; b[4 + e] = bb[e]; } }
    float x0[8], x1[8], x2[8], x3[8];
    auto ld = [&](int t, float (&x)[8]) {
        if (t < 0) { for (int e = 0; e < 8; ++e) x[e] = 0.f; return; }
        const u32x4 v = *(const u32x4*)(WS_(p, XBC) + (size_t)t * 3072 + c0);
        x[0] = bflo(v.x); x[1] = bfhi(v.x); x[2] = bflo(v.y); x[3] = bfhi(v.y); x[4] = bflo(v.z); x[5] = bfhi(v.z); x[6] = bflo(v.w); x[7] = bfhi(v.w);
    };
    ld(t0 - 3, x0); ld(t0 - 2, x1); ld(t0 - 1, x2);
#pragma unroll 4
    for (int tt = 0; tt < 64; ++tt) {
        ld(t0 + tt, x3);
        float o[8];
#pragma unroll
        for (int e = 0; e < 8; ++e) o[e] = siluf_(b[e] + w[0][e] * x0[e] + w[1][e] * x1[e] + w[2][e] * x2[e] + w[3][e] * x3[e]);
        u32x4 r; r.x = pk2(o[0], o[1]); r.y = pk2(o[2], o[3]); r.z = pk2(o[4], o[5]); r.w = pk2(o[6], o[7]);
        *(u32x4*)(WS_(p, XC) + (size_t)(t0 + tt) * 3072 + c0) = r;
#pragma unroll
        for (int e = 0; e < 8; ++e) { x0[e] = x1[e]; x1[e] = x2[e]; x2[e] = x3[e]; }
    }
}

DEV void mb_dacs(const Params& p, int j, int c, int g, LAS float* dts, LAS float* dacs) {
    const int tid = tid_(); const int lane = tid & 63, h = tid >> 6;
    const int hh = 8 * g + h; const float a = -__expf(p.mb_a_log[j * 32 + hh]);
    const float d0 = WS_(p, DT)[(size_t)(c * 128 + 2 * lane) * 32 + hh], d1 = WS_(p, DT)[(size_t)(c * 128 + 2 * lane + 1) * 32 + hh];
    const float a0 = d0 * a, a1 = d1 * a;
    float s = a0 + a1;
#pragma unroll
    for (int o = 1; o < 64; o <<= 1) { const float v = __shfl_up(s, o); if (lane >= o) s += v; }
    dts[h * 128 + 2 * lane] = d0; dts[h * 128 + 2 * lane + 1] = d1;
    dacs[h * 128 + 2 * lane] = s - a1; dacs[h * 128 + 2 * lane + 1] = s;
}
constexpr int LDB = 136;
constexpr int LDX = 72;
DEV void ld_tile128(const bf16_t* src, int gld, LAS bf16_t* dst) {
    const int tid = tid_();
    for (int i = tid; i < 128 * 16; i += NTHR) { const int r = i >> 4, c8 = (i & 15) * 8; *(LAS u32x4*)(dst + r * LDB + c8) = *(const u32x4*)(src + (size_t)r * gld + c8); }
}

DEV void phase_mb_states(const Params& p, int j, LAS unsigned char* lds) {
    const int tid = tid_(), bid = bid_(); (void)tid; (void)bid;
    const int lane = tid & 63, w = tid >> 6;
    LAS bf16_t* Bm = (LAS bf16_t*)lds;
    LAS bf16_t* Xh = Bm + 128 * LDB;
    LAS float* dts = (LAS float*)(Xh + 128 * LDX);
    LAS float* dacs = dts + 1024;
    for (int u = bid; u < 512; u += NB_) {
        const int c = u >> 2, g = u & 3; const int t0 = c * 128;
        lds_barrier();
        mb_dacs(p, j, c, g, dts, dacs);
        ld_tile128(WS_(p, XC) + (size_t)t0 * 3072 + 2048 + 128 * g, 3072, Bm);
        lds_barrier();
        if (tid < 8) WS_(p, CD)[(c * 32) + 8 * g + tid] = __expf(dacs[tid * 128 + 127]);
        bf16x8 bfr[4];
#pragma unroll
        for (int ks = 0; ks < 4; ++ks) bfr[ks] = frag_tr(Bm, LDB, 32 * ks, 16 * w, lane);
        for (int h = 0; h < 8; ++h) {
            { const int l = tid >> 2, p0 = (tid & 3) * 16; const float sc = dts[h * 128 + l] * __expf(dacs[h * 128 + 127] - dacs[h * 128 + l]);
              const bf16_t* src = WS_(p, XC) + (size_t)(t0 + l) * 3072 + 64 * (8 * g + h) + p0;
#pragma unroll
              for (int hf = 0; hf < 2; ++hf) { const u32x4 v = *(const u32x4*)(src + 8 * hf); u32x4 r;
                  r.x = pk2(bflo(v.x) * sc, bfhi(v.x) * sc); r.y = pk2(bflo(v.y) * sc, bfhi(v.y) * sc); r.z = pk2(bflo(v.z) * sc, bfhi(v.z) * sc); r.w = pk2(bflo(v.w) * sc, bfhi(v.w) * sc);
                  *(LAS u32x4*)(Xh + l * LDX + p0 + 8 * hf) = r; } }
            lds_barrier();
            f32x4 acc[4];
#pragma unroll
            for (int pb = 0; pb < 4; ++pb) { acc[pb] = (f32x4){0.f, 0.f, 0.f, 0.f};
#pragma unroll
                for (int ks = 0; ks < 4; ++ks) { const bf16x8 af = frag_tr(Xh, LDX, 32 * ks, 16 * pb, lane); acc[pb] = MFMA16(af, bfr[ks], acc[pb]); } }
            bf16_t* S = WS_(p, STATES) + (((size_t)c * 32 + 8 * g + h) * 64) * 128;
#pragma unroll
            for (int pb = 0; pb < 4; ++pb)
#pragma unroll
                for (int r = 0; r < 4; ++r) S[(size_t)(16 * pb + 4 * (lane >> 4) + r) * 128 + 16 * w + (lane & 15)] = (bf16_t)f2bf(acc[pb][r]);
            lds_barrier();
        }
    }
}
DEV void phase_mb_scan(const Params& p) {
    const int tid = tid_(), bid = bid_(); (void)tid; (void)bid;
    const int gid = bid * NTHR + tid;
    if (gid >= 32 * 64 * 64) return;
    const int np = gid & 63, pp = (gid >> 6) & 63, h = gid >> 12; const int n = 2 * np;
    float r0 = 0.f, r1 = 0.f;
    const size_t eo = ((size_t)h * 64 + pp) * 128 + n;
    const size_t fo = (size_t)h * 64 * 128 + fragmajor_off(pp, n, 128);
#pragma unroll 16
    for (int c = 0; c < 128; ++c) {
        const unsigned sraw = *(const unsigned*)(WS_(p, STATES) + (size_t)c * 32 * 64 * 128 + eo); const f32x2 s = {bflo(sraw), bfhi(sraw)};
        const float cd = WS_(p, CD)[c * 32 + h];
        *(unsigned*)(WS_(p, PREV) + (size_t)c * 32 * 64 * 128 + fo) = pk2(r0, r1);
        r0 = r0 * cd + s[0]; r1 = r1 * cd + s[1];
    }
}
DEV void phase_mb_out(const Params& p, int j, LAS unsigned char* lds) {
    const int tid = tid_(), bid = bid_(); (void)tid; (void)bid;
    const int lane = tid & 63, w = tid >> 6; const int fr = lane & 15, fq = lane >> 4;
    LAS bf16_t* Cm = (LAS bf16_t*)lds;
    LAS bf16_t* Bm = Cm + 128 * LDB;
    LAS bf16_t* Xh = Bm + 128 * LDB;
    LAS bf16_t* Mw = Xh + 128 * LDX;
    LAS float* dts = (LAS float*)(Mw + 8 * 16 * LDB);
    LAS float* dacs = dts + 1024;
    LAS bf16_t* Mme = Mw + w * 16 * LDB;
    for (int u = bid; u < 512; u += NB_) {
        const int c = u >> 2, g = u & 3; const int t0 = c * 128;
        lds_barrier();
        mb_dacs(p, j, c, g, dts, dacs);
        ld_tile128(WS_(p, XC) + (size_t)t0 * 3072 + 2048 + 512 + 128 * g, 3072, Cm);
        ld_tile128(WS_(p, XC) + (size_t)t0 * 3072 + 2048 + 128 * g, 3072, Bm);
        lds_barrier();
        f32x4 sc[8]; bf16x8 cf[4];
#pragma unroll
        for (int ks = 0; ks < 4; ++ks) cf[ks] = frag_rm(Cm, LDB, 16 * w, 32 * ks, lane);
#pragma unroll
        for (int sb = 0; sb < 8; ++sb) { sc[sb] = (f32x4){0.f, 0.f, 0.f, 0.f};
#pragma unroll
            for (int ks = 0; ks < 4; ++ks) sc[sb] = MFMA16(cf[ks], frag_rm(Bm, LDB, 16 * sb, 32 * ks, lane), sc[sb]); }
        float ssq = 0.f;
        const int rl = tid >> 2, p0 = (tid & 3) * 16;
        const LAS float* Yrow = (const LAS float*)(Mw + (rl >> 4) * 16 * LDB) + (rl & 15) * 68 + p0;
        LAS float* Yw = (LAS float*)Mme;
        u32x4 xraw[2], zraw[2], xnx[2], znx[2]; bf16x8 pfc[16];
#define MB_LOADH(HH, XR, ZR) do { const int hh_ = 8 * g + (HH); \
            XR[0] = *(const u32x4*)(WS_(p, XC) + (size_t)(t0 + rl) * 3072 + 64 * hh_ + p0); XR[1] = *(const u32x4*)(WS_(p, XC) + (size_t)(t0 + rl) * 3072 + 64 * hh_ + p0 + 8); \
            ZR[0] = *(const u32x4*)(WS_(p, Z) + (size_t)(t0 + rl) * 2048 + 64 * hh_ + p0); ZR[1] = *(const u32x4*)(WS_(p, Z) + (size_t)(t0 + rl) * 2048 + 64 * hh_ + p0 + 8); } while (0)
        MB_LOADH(0, xraw, zraw);
#pragma unroll 1
        for (int h = 0; h < 8; ++h) {
            const int hh = 8 * g + h;
            MB_LOADH(h < 7 ? h + 1 : h, xnx, znx);
            { const bf16_t* pv_ = WS_(p, PREV) + ((size_t)c * 32 + hh) * 64 * 128;
#pragma unroll
              for (int i_ = 0; i_ < 16; ++i_) pfc[i_] = *(const bf16x8*)(pv_ + ((size_t)i_ * 64 + lane) * 8); }
            { const float scl = dts[h * 128 + rl];
#pragma unroll
              for (int hf = 0; hf < 2; ++hf) { const u32x4 v = xraw[hf]; u32x4 r;
                  r.x = pk2(bflo(v.x) * scl, bfhi(v.x) * scl); r.y = pk2(bflo(v.y) * scl, bfhi(v.y) * scl); r.z = pk2(bflo(v.z) * scl, bfhi(v.z) * scl); r.w = pk2(bflo(v.w) * scl, bfhi(v.w) * scl);
                  *(LAS u32x4*)(Xh + rl * LDX + p0 + 8 * hf) = r; } }
            const u32x4 zraw0 = zraw[0], zraw1 = zraw[1];
            float dl[4];
#pragma unroll
            for (int r = 0; r < 4; ++r) dl[r] = dacs[h * 128 + 16 * w + 4 * fq + r];
#pragma unroll
            for (int sb = 0; sb < 8; ++sb) { const int s_ = 16 * sb + fr; const float ds = dacs[h * 128 + s_];
#pragma unroll
                for (int r = 0; r < 4; ++r) { const int l = 16 * w + 4 * fq + r; const float m = (s_ <= l) ? sc[sb][r] * __expf(dl[r] - ds) : 0.f; Mme[(4 * fq + r) * LDB + s_] = (bf16_t)f2bf(m); } }
            lds_barrier();
            bf16x8 mf[4];
#pragma unroll
            for (int ks = 0; ks < 4; ++ks) mf[ks] = frag_rm(Mme, LDB, 0, 32 * ks, lane);
            f32x4 yv[4];
#pragma unroll
            for (int pb = 0; pb < 4; ++pb) {
                f32x4 a = {0.f, 0.f, 0.f, 0.f}, o = {0.f, 0.f, 0.f, 0.f};
#pragma unroll
                for (int ks = 0; ks < 4; ++ks) {
                    a = MFMA16(mf[ks], frag_tr(Xh, LDX, 32 * ks, 16 * pb, lane), a);
                    o = MFMA16(cf[ks], pfc[pb * 4 + ks], o);
                }
#pragma unroll
                for (int r = 0; r < 4; ++r) a[r] += o[r] * __expf(dl[r]);
                yv[pb] = a;
            }
#pragma unroll
            for (int pb = 0; pb < 4; ++pb)
#pragma unroll
                for (int r = 0; r < 4; ++r) Yw[(4 * fq + r) * 68 + 16 * pb + fr] = yv[pb][r];
            lds_barrier();
            {
                const float dsk = p.mb_d[j * 32 + hh]; const float* ng = p.mb_norm_g + (size_t)j * 2048 + 64 * hh + p0;
                float y[16], xs[16], zz[16];
#pragma unroll
                for (int q = 0; q < 4; ++q) { const f32x4 t4 = *(const LAS f32x4*)(Yrow + 4 * q); y[4 * q] = t4[0]; y[4 * q + 1] = t4[1]; y[4 * q + 2] = t4[2]; y[4 * q + 3] = t4[3]; }
                xs[0] = bflo(xraw[0].x); xs[1] = bfhi(xraw[0].x); xs[2] = bflo(xraw[0].y); xs[3] = bfhi(xraw[0].y); xs[4] = bflo(xraw[0].z); xs[5] = bfhi(xraw[0].z); xs[6] = bflo(xraw[0].w); xs[7] = bfhi(xraw[0].w);
                xs[8] = bflo(xraw[1].x); xs[9] = bfhi(xraw[1].x); xs[10] = bflo(xraw[1].y); xs[11] = bfhi(xraw[1].y); xs[12] = bflo(xraw[1].z); xs[13] = bfhi(xraw[1].z); xs[14] = bflo(xraw[1].w); xs[15] = bfhi(xraw[1].w);
                zz[0] = bflo(zraw0.x); zz[1] = bfhi(zraw0.x); zz[2] = bflo(zraw0.y); zz[3] = bfhi(zraw0.y); zz[4] = bflo(zraw0.z); zz[5] = bfhi(zraw0.z); zz[6] = bflo(zraw0.w); zz[7] = bfhi(zraw0.w);
                zz[8] = bflo(zraw1.x); zz[9] = bfhi(zraw1.x); zz[10] = bflo(zraw1.y); zz[11] = bfhi(zraw1.y); zz[12] = bflo(zraw1.z); zz[13] = bfhi(zraw1.z); zz[14] = bflo(zraw1.w); zz[15] = bfhi(zraw1.w);
                float o[16];
#pragma unroll
                for (int q = 0; q < 4; ++q) { const f32x4 n4 = *(const f32x4*)(ng + 4 * q);
#pragma unroll
                    for (int e = 0; e < 4; ++e) { const int i = 4 * q + e; const float v = (y[i] + xs[i] * dsk) * siluf_(zz[i]); ssq += v * v; o[i] = v * n4[e]; } }
                bf16_t* dst = WS_(p, YB) + (size_t)(t0 + rl) * 2048 + 64 * hh + p0;
                u32x4 w0, w1; w0.x = pk2(o[0], o[1]); w0.y = pk2(o[2], o[3]); w0.z = pk2(o[4], o[5]); w0.w = pk2(o[6], o[7]); w1.x = pk2(o[8], o[9]); w1.y = pk2(o[10], o[11]); w1.z = pk2(o[12], o[13]); w1.w = pk2(o[14], o[15]);
                *(u32x4*)dst = w0; *(u32x4*)(dst + 8) = w1;
            }
            xraw[0] = xnx[0]; xraw[1] = xnx[1]; zraw[0] = znx[0]; zraw[1] = znx[1];
            lds_barrier();
        }
#undef MB_LOADH
        ssq += __shfl_xor(ssq, 1); ssq += __shfl_xor(ssq, 2);
        const float rstd = rsqrtf(ssq * (1.0f / 512.0f) + 1e-5f);
#pragma unroll 1
        for (int h = 0; h < 8; ++h) {
            bf16_t* dst = WS_(p, YB) + (size_t)(t0 + rl) * 2048 + 64 * (8 * g + h) + p0;
#pragma unroll
            for (int hf = 0; hf < 2; ++hf) { const u32x4 v = *(const u32x4*)(dst + 8 * hf); u32x4 r;
                r.x = pk2(bflo(v.x) * rstd, bfhi(v.x) * rstd); r.y = pk2(bflo(v.y) * rstd, bfhi(v.y) * rstd); r.z = pk2(bflo(v.z) * rstd, bfhi(v.z) * rstd); r.w = pk2(bflo(v.w) * rstd, bfhi(v.w) * rstd);
                *(u32x4*)(dst + 8 * hf) = r; }
        }
    }
}
constexpr int GL_PROJ = 3088;
constexpr int LDV = 264;
struct SchedGlIn {
    const Params* p;
    DEV bool next(int i, Unit& u) const {
        int pm, pn; if (!pg8::tile_order(i, NB_, bid_(), 64, 12, pm, pn)) return false;
        u.A = (const char*)(WS_(*p, Hb) + (size_t)pm * 256 * D); u.B = (const char*)(WS_(*p, gl_win_t) + (size_t)pn * 256 * D); u.row0 = pm * 256; u.col0 = pn * 256; u.id = 0; u.aux = 0; return true;
    }
};
struct EpiGlIn {
    const Params* p;
    DEV void operator()(const AccT& acc, const Unit& u, int wr, int wc, int fr, int fq) const {
        FOR_ACC(ai, bj, m, n) { st_bf4(WS_(*p, QKVG) + (size_t)ACC_ROW(u, ai, m) * 3072 + ACC_COL(u, bj, n), acc[ai][bj][m][n]); ACC_FENCE; }
    }
};
DEV void gl_bcs(const Params& p, int n, int h, LAS float* bcs) {
    const int tid = tid_();
    for (int i = tid; i < 64 * 32; i += NTHR) { const int r = i >> 5, c4 = (i & 31) * 4; *(LAS f32x4*)(bcs + r * 128 + c4) = *(const f32x4*)(WS_(p, LA) + (size_t)(n * 64 + r) * 512 + 128 * h + c4); }
    lds_barrier();
    if (tid < 128) { float s = 0.f; for (int r = 0; r < 64; ++r) { s += bcs[r * 128 + tid]; bcs[r * 128 + tid] = s; } }
    lds_barrier();
}
DEV void phase_gl_kv(const Params& p, LAS unsigned char* lds) {
    const int tid = tid_(), bid = bid_(); (void)tid; (void)bid;
    const int lane = tid & 63, w = tid >> 6;
    LAS float* bcs = (LAS float*)lds;
    LAS bf16_t* Ke = (LAS bf16_t*)(bcs + 64 * 128);
    LAS bf16_t* Vs = Ke + 64 * LDB;
    for (int u = bid; u < 1024; u += NB_) {
        const int n = u >> 2, h = u & 3; const int t0 = n * 64;
        lds_barrier();
        gl_bcs(p, n, h, bcs);
        for (int i = tid; i < 64 * 16; i += NTHR) { const int r = i >> 4, c8 = (i & 15) * 8;
            const u32x4 v = *(const u32x4*)(WS_(p, QKVG) + (size_t)(t0 + r) * 3072 + 512 + 128 * h + c8); float f[8];
            f[0] = bflo(v.x); f[1] = bfhi(v.x); f[2] = bflo(v.y); f[3] = bfhi(v.y); f[4] = bflo(v.z); f[5] = bfhi(v.z); f[6] = bflo(v.w); f[7] = bfhi(v.w);
#pragma unroll
            for (int e = 0; e < 8; ++e) f[e] *= __expf(bcs[63 * 128 + c8 + e] - bcs[r * 128 + c8 + e]);
            u32x4 o; o.x = pk2(f[0], f[1]); o.y = pk2(f[2], f[3]); o.z = pk2(f[4], f[5]); o.w = pk2(f[6], f[7]);
            *(LAS u32x4*)(Ke + r * LDB + c8) = o; }
        for (int i = tid; i < 64 * 32; i += NTHR) { const int r = i >> 5, c8 = (i & 31) * 8; *(LAS u32x4*)(Vs + r * LDV + c8) = *(const u32x4*)(WS_(p, QKVG) + (size_t)(t0 + r) * 3072 + 1024 + 256 * h + c8); }
        if (tid < 128) WS_(p, CDG)[((size_t)n * 4 + h) * 128 + tid] = __expf(bcs[63 * 128 + tid]);
        lds_barrier();
        bf16x8 af[2];
#pragma unroll
        for (int ks = 0; ks < 2; ++ks) af[ks] = frag_tr(Ke, LDB, 32 * ks, 16 * w, lane);
        bf16_t* O = WS_(p, STATES) + (((size_t)n * 4 + h) * 128) * 256;
#pragma unroll
        for (int vb = 0; vb < 16; ++vb) {
            f32x4 acc = {0.f, 0.f, 0.f, 0.f};
#pragma unroll
            for (int ks = 0; ks < 2; ++ks) acc = MFMA16(af[ks], frag_tr(Vs, LDV, 32 * ks, 16 * vb, lane), acc);
#pragma unroll
            for (int r = 0; r < 4; ++r) O[(size_t)(16 * w + 4 * (lane >> 4) + r) * 256 + 16 * vb + (lane & 15)] = (bf16_t)f2bf(acc[r]);
        }
    }
}
DEV void phase_gl_scan(const Params& p) {
    const int tid = tid_(), bid = bid_(); (void)tid; (void)bid;
    const int gid = bid * NTHR + tid;
    if (gid >= 4 * 64 * 256) return;
    const int v = gid & 255, kp = (gid >> 8) & 63, h = gid >> 14; const int k = 2 * kp;
    float r0 = 0.f, r1 = 0.f;
    const size_t fo = (size_t)h * 128 * 256 + fragmajor_off(v, k, 128);
#pragma unroll 16
    for (int n = 0; n < 256; ++n) {
        const bf16_t* S = WS_(p, STATES) + (((size_t)n * 4 + h) * 128) * 256;
        const float s0 = bf2f(S[(size_t)k * 256 + v]), s1 = bf2f(S[(size_t)(k + 1) * 256 + v]);
        const f32x2 cd = *(const f32x2*)(WS_(p, CDG) + ((size_t)n * 4 + h) * 128 + k);
        *(unsigned*)(WS_(p, PREV) + (size_t)n * 4 * 128 * 256 + fo) = pk2(r0, r1);
        r0 = r0 * cd[0] + s0; r1 = r1 * cd[1] + s1;
    }
}
DEV void phase_gl_out(const Params& p, int j, LAS unsigned char* lds) {
    const int tid = tid_(), bid = bid_(); (void)tid; (void)bid;
    const int lane = tid & 63, w = tid >> 6; const int fr = lane & 15, fq = lane >> 4;
    LAS float* bcs = (LAS float*)lds;
    LAS bf16_t* Qs = (LAS bf16_t*)(bcs + 64 * 128);
    LAS bf16_t* Ks = Qs + 64 * LDB;
    LAS bf16_t* Vs = Ks + 64 * LDB;
    LAS bf16_t* At = Vs + 64 * LDV;
    LAS float* red = (LAS float*)(At + 64 * LDX);
    for (int u = bid; u < 1024; u += NB_) {
        const int n = u >> 2, h = u & 3; const int t0 = n * 64;
        lds_barrier();
        gl_bcs(p, n, h, bcs);
        for (int i = tid; i < 64 * 16; i += NTHR) { const int r = i >> 4, c8 = (i & 15) * 8;
            const u32x4 vq = *(const u32x4*)(WS_(p, QKVG) + (size_t)(t0 + r) * 3072 + 128 * h + c8), vk = *(const u32x4*)(WS_(p, QKVG) + (size_t)(t0 + r) * 3072 + 512 + 128 * h + c8);
            float fq_[8], fk_[8];
            fq_[0] = bflo(vq.x); fq_[1] = bfhi(vq.x); fq_[2] = bflo(vq.y); fq_[3] = bfhi(vq.y); fq_[4] = bflo(vq.z); fq_[5] = bfhi(vq.z); fq_[6] = bflo(vq.w); fq_[7] = bfhi(vq.w);
            fk_[0] = bflo(vk.x); fk_[1] = bfhi(vk.x); fk_[2] = bflo(vk.y); fk_[3] = bfhi(vk.y); fk_[4] = bflo(vk.z); fk_[5] = bfhi(vk.z); fk_[6] = bflo(vk.w); fk_[7] = bfhi(vk.w);
#pragma unroll
            for (int e = 0; e < 8; ++e) { const float b = bcs[r * 128 + c8 + e]; fq_[e] *= __expf(b) * 0.08838834764831845f; fk_[e] *= __expf(-b); }
            u32x4 o; o.x = pk2(fq_[0], fq_[1]); o.y = pk2(fq_[2], fq_[3]); o.z = pk2(fq_[4], fq_[5]); o.w = pk2(fq_[6], fq_[7]);
            *(LAS u32x4*)(Qs + r * LDB + c8) = o;
            o.x = pk2(fk_[0], fk_[1]); o.y = pk2(fk_[2], fk_[3]); o.z = pk2(fk_[4], fk_[5]); o.w = pk2(fk_[6], fk_[7]);
            *(LAS u32x4*)(Ks + r * LDB + c8) = o; }
        for (int i = tid; i < 64 * 32; i += NTHR) { const int r = i >> 5, c8 = (i & 31) * 8; *(LAS u32x4*)(Vs + r * LDV + c8) = *(const u32x4*)(WS_(p, QKVG) + (size_t)(t0 + r) * 3072 + 1024 + 256 * h + c8); }
        lds_barrier();
        { const int ib = w >> 1;
#pragma unroll
          for (int jj = 0; jj < 2; ++jj) { const int jb = 2 * (w & 1) + jj; f32x4 a = {0.f, 0.f, 0.f, 0.f};
#pragma unroll
              for (int ks = 0; ks < 4; ++ks) a = MFMA16(frag_rm(Qs, LDB, 16 * ib, 32 * ks, lane), frag_rm(Ks, LDB, 16 * jb, 32 * ks, lane), a);
#pragma unroll
              for (int r = 0; r < 4; ++r) { const int i = 16 * ib + 4 * fq + r, jx = 16 * jb + fr; At[i * LDX + jx] = (bf16_t)f2bf(jx <= i ? a[r] : 0.f); } } }
        lds_barrier();
        f32x4 o[4][2];
        const bf16_t* pv = WS_(p, PREV) + ((size_t)n * 4 + h) * 128 * 256;
#pragma unroll
        for (int vv = 0; vv < 2; ++vv) { const int vb = 2 * w + vv;
            bf16x8 bi[2], bp[4];
#pragma unroll
            for (int ks = 0; ks < 2; ++ks) bi[ks] = frag_tr(Vs, LDV, 32 * ks, 16 * vb, lane);
#pragma unroll
            for (int ks = 0; ks < 4; ++ks) bp[ks] = *(const bf16x8*)(pv + ((size_t)(vb * 4 + ks) * 64 + lane) * 8);
#pragma unroll
            for (int ib = 0; ib < 4; ++ib) { f32x4 a = {0.f, 0.f, 0.f, 0.f};
#pragma unroll
                for (int ks = 0; ks < 2; ++ks) a = MFMA16(frag_rm(At, LDX, 16 * ib, 32 * ks, lane), bi[ks], a);
#pragma unroll
                for (int ks = 0; ks < 4; ++ks) a = MFMA16(frag_rm(Qs, LDB, 16 * ib, 32 * ks, lane), bp[ks], a);
                o[ib][vv] = a; } }
#pragma unroll
        for (int ib = 0; ib < 4; ++ib)
#pragma unroll
            for (int r = 0; r < 4; ++r) { float s = o[ib][0][r] * o[ib][0][r] + o[ib][1][r] * o[ib][1][r]; s = sum16(s); if (fr == 0) red[w * 64 + 16 * ib + 4 * fq + r] = s; }
        lds_barrier();
        {   LAS bf16_t* Os = (LAS bf16_t*)bcs;
#pragma unroll
            for (int ib = 0; ib < 4; ++ib)
#pragma unroll
                for (int vv = 0; vv < 2; ++vv)
#pragma unroll
                    for (int r = 0; r < 4; ++r) Os[(16 * ib + 4 * fq + r) * LDV + 32 * w + 16 * vv + fr] = (bf16_t)f2bf(o[ib][vv][r]);
            lds_barrier();
            const int row = tid >> 3, c0 = (tid & 7) * 32; const int t = t0 + row; float s = 0.f;
#pragma unroll
            for (int ww = 0; ww < 8; ++ww) s += red[ww * 64 + row];
            const float rs = rsqrtf(s * (1.0f / 256.0f) + 1e-5f);
#pragma unroll
            for (int q = 0; q < 4; ++q) {
                const u32x4 ov = *(const LAS u32x4*)(Os + row * LDV + c0 + 8 * q), gv = *(const u32x4*)(WS_(p, QKVG) + (size_t)t * 3072 + 2048 + 256 * h + c0 + 8 * q);
                const f32x4 n0 = *(const f32x4*)(p.gl_norm_g + j * 256 + c0 + 8 * q), n1 = *(const f32x4*)(p.gl_norm_g + j * 256 + c0 + 8 * q + 4);
                float r8[8];
                r8[0] = bflo(ov.x) * rs * n0[0] * siluf_(bflo(gv.x)); r8[1] = bfhi(ov.x) * rs * n0[1] * siluf_(bfhi(gv.x)); r8[2] = bflo(ov.y) * rs * n0[2] * siluf_(bflo(gv.y)); r8[3] = bfhi(ov.y) * rs * n0[3] * siluf_(bfhi(gv.y));
                r8[4] = bflo(ov.z) * rs * n1[0] * siluf_(bflo(gv.z)); r8[5] = bfhi(ov.z) * rs * n1[1] * siluf_(bfhi(gv.z)); r8[6] = bflo(ov.w) * rs * n1[2] * siluf_(bflo(gv.w)); r8[7] = bfhi(ov.w) * rs * n1[3] * siluf_(bfhi(gv.w));
                u32x4 wv; wv.x = pk2(r8[0], r8[1]); wv.y = pk2(r8[2], r8[3]); wv.z = pk2(r8[4], r8[5]); wv.w = pk2(r8[6], r8[7]);
                *(u32x4*)(WS_(p, YB) + (size_t)t * D + 256 * h + c0 + 8 * q) = wv;
            }
        }
    }
}
#define XB_TMO      128
#define XB_XCNT(j)  (256  + 64 * (j))
#define XB_XSUB(j)  (1280 + 64 * (j))
#define XB_XGEN(j)  (2304 + 64 * (j))
#define XB_TOP      3328
#define XB_TOPGEN   3392
#define XCD_BAR_WORDS 3456
#define XB_SPIN_CAP (1u << 22)
DEV unsigned xb_ld(unsigned* p)              { return __hip_atomic_load(p, __ATOMIC_RELAXED, __HIP_MEMORY_SCOPE_AGENT); }
DEV unsigned xb_add(unsigned* p, unsigned v) { return __hip_atomic_fetch_add(p, v, __ATOMIC_RELAXED, __HIP_MEMORY_SCOPE_AGENT); }
DEV unsigned xb_xcc_id() { return (unsigned)__builtin_amdgcn_s_getreg((3 << 11) | 20) & 0xFu; }
#define XB_SPIN(cond, bar) do { unsigned _sp = 0; while (cond) { __builtin_amdgcn_s_sleep(1); \
    if ((++_sp & 255u) == 0u) { if (xb_ld(&(bar)[XB_TMO])) break; if (_sp > XB_SPIN_CAP) { atomicAdd(&(bar)[XB_TMO], 1u); break; } } } } while (0)
struct XcdBarrier { unsigned* bar; unsigned x; volatile LAS unsigned* st; };
DEV XcdBarrier xcd_barrier_post(unsigned* bar, volatile LAS unsigned* st) {
    XcdBarrier b; b.bar = bar; b.x = xb_xcc_id(); b.st = st;
    if (threadIdx.x == 0) (void)xb_add(&bar[XB_XCNT(b.x)], 1u);
    return b;
}
DEV void xcd_barrier_complete(unsigned* bar, unsigned x, unsigned& nloc, unsigned& nx) {
    const unsigned G = gridDim.x * gridDim.y * gridDim.z;
    unsigned sum, cnt, mine, sp = 0u;
    for (;;) {
        sum = 0u; cnt = 0u; mine = 0u;
#pragma unroll
        for (unsigned j = 0; j < 16; ++j) { const unsigned c = xb_ld(&bar[XB_XCNT(j)]); sum += c; cnt += (c > 0u) ? 1u : 0u; mine = (j == x) ? c : mine; }
        if (sum == G) break;
        __builtin_amdgcn_s_sleep(1);
        if ((++sp & 255u) == 0u) { if (xb_ld(&bar[XB_TMO])) break; if (sp > XB_SPIN_CAP) { atomicAdd(&bar[XB_TMO], 1u); break; } }
    }
    nloc = mine > 0u ? mine : 1u; nx = cnt > 0u ? cnt : 1u;
}
DEV void xcd_barrier(const XcdBarrier& b) {
    asm volatile("s_waitcnt vmcnt(0)" ::: "memory");
    __syncthreads();
    if (threadIdx.x == 0) {
        unsigned* bar = b.bar;
        __builtin_amdgcn_s_waitcnt(0);
        unsigned nloc = b.st[0], nx = b.st[1];
        if (nloc == 0u) { xcd_barrier_complete(bar, b.x, nloc, nx); b.st[0] = nloc; b.st[1] = nx; }
        const unsigned old = xb_add(&bar[XB_XSUB(b.x)], 1u);
        const unsigned gen = old / nloc;
        if (old + 1u == (gen + 1u) * nloc) {
            __builtin_amdgcn_fence(__ATOMIC_RELEASE, "agent");
            asm volatile("s_waitcnt vmcnt(0)" ::: "memory");
            const unsigned og = xb_add(&bar[XB_TOP], 1u);
            const unsigned tg = og / nx;
            if (og + 1u == (tg + 1u) * nx) xb_add(&bar[XB_TOPGEN], 1u);
            else XB_SPIN(xb_ld(&bar[XB_TOPGEN]) == tg, bar);
            __builtin_amdgcn_fence(__ATOMIC_ACQUIRE, "agent");
            xb_add(&bar[XB_XGEN(b.x)], 1u);
            asm volatile("s_waitcnt vmcnt(0)" ::: "memory");
        } else {
            XB_SPIN(xb_ld(&bar[XB_XGEN(b.x)]) == gen, bar);
            __builtin_amdgcn_fence(__ATOMIC_ACQUIRE, "agent");
            asm volatile("s_waitcnt vmcnt(0)" ::: "memory");
        }
    }
    __syncthreads();
}

DEV LAS int* moe_tab_to_lds(const Params& p, LAS unsigned char* lds) {
    LAS int* tab = (LAS int*)(lds + pg8::STAGE_BYTES);
    const int tid = tid_();
    if (tid < 256) tab[tid] = __hip_atomic_load(WS_(p, TAB) + tid, __ATOMIC_RELAXED, __HIP_MEMORY_SCOPE_AGENT);
    __syncthreads();
    return tab;
}
DEV void run_phase(const Params& pin, int op, int arg, LAS unsigned char* lds) {
    Params p = pin; asm volatile("" : "+s"(p.ws));
    const int layer = arg; const int jj = layer / 3;
#ifdef ONLY_OP
    if (op != ONLY_OP) return;
#endif
#ifdef OPMASK
    if (!((OPMASK >> op) & 1ull)) return;
#endif
    switch (op) {
    case OP_CONVERT: phase_pre0(p); phase_convert(p, lds);
#ifdef DBG
        if (blockIdx.x == 0 && threadIdx.x < 8) WS_(p, TAB)[200 + threadIdx.x] = 0;
#endif
        break;
    case OP_PRE0: break;
    case OP_RW_GEMM1: { SchedRW1 S{&p, jj}; EpiRW1 E{&p}; pg8::gemm_phase(lds, 1024, S, E); } break;
    case OP_RW_GEMM2: { SchedRW2 S{&p, jj}; EpiRW2 E{&p, jj}; pg8::gemm_phase(lds, 256, S, E); } break;
    case OP_RW_CHA: phase_rw_cha(p, jj, lds); break;
    case OP_RW_CHB: phase_rw_chb(p, layer, lds); break;
    case OP_RW_CHC: phase_rw_chc(p, jj, lds); break;
    case OP_RW_OUT: { SchedOut S{WS_(p, YB), WS_(p, rw_wo_t) + (size_t)jj * D * D, 1024}; EpiOut E{WS_(p, MIXb)}; pg8::gemm_phase(lds, 1024, S, E); } break;
    case OP_LN1: phase_ln1(p, layer, lds); break;
    case OP_MOE_SCATTER: phase_moe_scatter(p, lds); break;
    case OP_MOE_GEMM1: { LAS int* tab = moe_tab_to_lds(p, lds); SchedMoe<0> S{&p, layer, tab}; EpiMoe1 E{WS_(p, ACT)}; pg8::gemm_phase(lds, 1024, S, E); } break;
    case OP_MOE_GEMM2: { LAS int* tab = moe_tab_to_lds(p, lds); SchedMoe<1> S{&p, layer, tab}; EpiMoe2 E{WS_(p, YBUF)}; pg8::gemm_phase(lds, 512, S, E); } break;
    case OP_LN2: phase_ln2(p, layer, lds); break;
    case OP_MB_GEMM_IN: { SchedMbIn S{&p}; EpiMbIn E{&p}; pg8::gemm_phase(lds, 1024, S, E); } break;
    case OP_MB_CONV: phase_mb_conv(p, jj); break;
    case OP_MB_STATES: phase_mb_states(p, jj, lds); break;
    case OP_MB_SCAN: phase_mb_scan(p); break;
    case OP_MB_OUT: phase_mb_out(p, jj, lds); break;
    case OP_MB_GEMM_OUT: { SchedOut S{WS_(p, YB), WS_(p, mb_wout_t) + (size_t)jj * D * 2048, 2048}; EpiOut E{WS_(p, MIXb)}; pg8::gemm_phase(lds, 2048, S, E); } break;
    case OP_GL_GEMM_IN: { SchedGlIn S{&p}; EpiGlIn E{&p}; pg8::gemm_phase(lds, 1024, S, E); } break;
    case OP_GL_KV: phase_gl_kv(p, lds); break;
    case OP_GL_SCAN: phase_gl_scan(p); break;
    case OP_GL_OUT: phase_gl_out(p, jj, lds); break;
    case OP_GL_GEMM_OUT: { SchedOut S{WS_(p, YB), WS_(p, gl_wout_t) + (size_t)jj * D * D, 1024}; EpiOut E{WS_(p, MIXb)}; pg8::gemm_phase(lds, 1024, S, E); } break;
    default: break;
    }
}

constexpr int NPHASES = 1 + 11 + 11 + 10 + 11;
DEV void decode_phase(int ph, int& op, int& layer) {
    if (ph < 1) { op = OP_CONVERT; layer = 0; return; }
    int q = ph - 1; layer = 0;
    if (q >= 11) { q -= 11; layer = 1; if (q >= 11) { q -= 11; layer = 2; if (q >= 10) { q -= 10; layer = 3; } } }
    const int kind = layer % 3; const int nmix = kind == 2 ? 5 : 6;
    if (q < nmix) op = (kind == 0 ? OP_RW_GEMM1 : kind == 1 ? OP_MB_GEMM_IN : OP_GL_GEMM_IN) + q;
    else op = OP_LN1 + (q - nmix);
}

#define X(t, n) t n##_,
template <bool COOP>
__global__ void __launch_bounds__(NTHR, 2) mega(PARAM_LIST(X) const int ph0, const int ph1) {
#undef X
    Params p;
#define X(t, n) p.n = n##_;
    PARAM_LIST(X)
#undef X

    extern __shared__ __attribute__((aligned(16))) unsigned char smem_raw[];
    LAS unsigned char* lds = (LAS unsigned char*)smem_raw;
    if constexpr (COOP) {
        volatile LAS unsigned* st = (volatile LAS unsigned*)(lds + LDS_BYTES - 16);
        if (threadIdx.x == 0) { st[0] = 0u; st[1] = 0u; }
        __syncthreads();
        XcdBarrier xb = xcd_barrier_post(WS_(p, bar), st);
        if (ph0 < 0) cg::this_grid().sync();
        for (int ph = ph0; ph < ph1; ++ph) {
            int op, arg; decode_phase(ph, op, arg);
#ifdef REPEAT_MASK
            const int reps = 1 + (int)((REPEAT_MASK >> op) & 1ull);
#else
            const int reps = 1;
#endif
#pragma unroll 1
            for (int rep = 0; rep < reps; ++rep) {
                run_phase(p, op, arg, lds);
                if (ph + 1 < ph1 || rep + 1 < reps) { xcd_barrier(xb);
#ifdef BAR2
                    xcd_barrier(xb);
#endif
                }
            }
        }
#ifdef DBG
        xcd_barrier(xb);
        { const int code = __hip_atomic_load(WS_(p, TAB) + 200, __ATOMIC_RELAXED, __HIP_MEMORY_SCOPE_AGENT);
          for (size_t i = (size_t)blockIdx.x * NTHR + threadIdx.x; i < (size_t)T * D; i += (size_t)NB_ * NTHR) p.out[i] = 0.f;
          __syncthreads();
          if (blockIdx.x == 0 && threadIdx.x == 0) p.out[0] = sqrtf((float)DBG_DECODE(code) * 1.68e7f); }
#endif
    } else {
        for (int ph = ph0; ph < ph1; ++ph) { int op, arg; decode_phase(ph, op, arg); run_phase(p, op, arg, lds); }
    }
}


extern "C" void kernel_launch(void* const* d_in, const int* in_sizes, int n_in, void* d_out, int out_size, void* d_ws, size_t ws_size, hipStream_t stream) {
    (void)in_sizes; (void)n_in; (void)out_size;
    Params p; std::memset((void*)&p, 0, sizeof(p));
    auto F = [&](int i) { return (const float*)d_in[i]; };
    p.x = F(0); p.ln_g = F(1); p.ln_b = F(2);
    p.rw_mu = F(3); p.rw_w_rkv = F(4); p.rw_w0 = F(5); p.rw_w1 = F(6); p.rw_w2 = F(7); p.rw_a0 = F(8);
    p.rw_a1 = F(9); p.rw_a2 = F(10); p.rw_g1 = F(11); p.rw_g2 = F(12);
    p.rw_k_k = F(13); p.rw_k_a = F(14); p.rw_r_k = F(15); p.rw_lnx_g = F(16); p.rw_lnx_b = F(17); p.rw_w_o = F(18);
    p.mb_w_in = F(19); p.mb_conv_w = F(20); p.mb_conv_b = F(21); p.mb_dt_bias = F(22); p.mb_a_log = F(23); p.mb_d = F(24); p.mb_norm_g = F(25); p.mb_w_out = F(26);
    p.gl_w_in = F(27); p.gl_gk_w2 = F(28); p.gl_gk_b = F(29); p.gl_norm_g = F(30); p.gl_w_out = F(31);
    p.moe_w_group = F(32); p.moe_b_group = F(33); p.moe_w_route = F(34); p.moe_b_route = F(35); p.moe_w_in = F(36); p.moe_w_down = F(37);
    p.out = (float*)d_out;
    p.ws = (char*)d_ws;
    if (WS_TOTAL > ws_size) { fprintf(stderr, "workspace too small: need %zu have %zu\n", (size_t)WS_TOTAL, ws_size); return; }
    unsigned* bar_ptr = (unsigned*)(p.ws + OFF_bar);
    const int np = NPHASES;
#define X(t, n) (void*)&p.n,
#if SINGLE_LAUNCH
    (void)hipFuncSetAttribute((const void*)mega<true>, hipFuncAttributeMaxDynamicSharedMemorySize, LDS_BYTES);
    (void)hipMemsetAsync(bar_ptr, 0, XCD_BAR_WORDS * sizeof(unsigned), stream);
    int ph0 = 0, ph1 = np; void* args[] = {PARAM_LIST(X) (void*)&ph0, (void*)&ph1};
    hipError_t e = hipLaunchCooperativeKernel((const void*)mega<true>, dim3(NBLK), dim3(NTHR), args, LDS_BYTES, stream);
    if (e != hipSuccess) fprintf(stderr, "cooperative launch failed: %s\n", hipGetErrorString(e));
#else
    (void)hipFuncSetAttribute((const void*)mega<false>, hipFuncAttributeMaxDynamicSharedMemorySize, LDS_BYTES);
    for (int ph = 0; ph < np; ++ph) { int ph0 = ph, ph1 = ph + 1; void* args[] = {PARAM_LIST(X) (void*)&ph0, (void*)&ph1};
        hipError_t e = hipLaunchKernel((const void*)mega<false>, dim3(NBLK), dim3(NTHR), args, LDS_BYTES, stream);
        if (e != hipSuccess) fprintf(stderr, "launch failed: %s\n", hipGetErrorString(e)); }
#endif
#undef X
}
```

```cpp
#include <hip/hip_runtime.h>
#include <hip/hip_cooperative_groups.h>
#include <cstdint>
#include <cstdio>
#include <cstring>
namespace cg = cooperative_groups;

typedef unsigned short bf16_t;
typedef short bf16x8 __attribute__((ext_vector_type(8)));
typedef short s16x4 __attribute__((ext_vector_type(4)));
typedef float f32x4 __attribute__((ext_vector_type(4)));
typedef float f32x2 __attribute__((ext_vector_type(2)));
typedef unsigned u32x4 __attribute__((ext_vector_type(4)));
typedef unsigned u32x2 __attribute__((ext_vector_type(2)));
#define LAS __attribute__((address_space(3)))
#define DEV __device__ __forceinline__

constexpr int T = 16384, D = 1024, DEPTH = 4;
constexpr int NTHR = 512, NBLK = 256;
constexpr int LDS_BYTES = 155648;
constexpr float ALPHA = 1.681792830507429f;
constexpr float LN_EPS = 1e-5f;
constexpr int MOE_ROWS = 40960;

DEV int tid_() { int t = threadIdx.x; asm volatile("" : "+v"(t)); return t; }
DEV int bid_() { int b = blockIdx.x; asm volatile("" : "+s"(b)); return b; }
#define NB_ 256
#define RCOL(q, lane) ((((q) >> 1) * 512) + 8 * (lane) + 4 * ((q) & 1))
DEV void lds_barrier() { asm volatile("s_waitcnt lgkmcnt(0)" ::: "memory"); __builtin_amdgcn_s_barrier(); asm volatile("" ::: "memory"); }
DEV unsigned f2bf(float f) { unsigned u = __float_as_uint(f); u += 0x7FFFu + ((u >> 16) & 1u); return u >> 16; }
DEV float bf2f(unsigned short b) { return __uint_as_float(((unsigned)b) << 16); }
typedef __bf16 bf16n2 __attribute__((ext_vector_type(2)));
DEV unsigned pk2(float lo, float hi) { f32x2 v = {lo, hi}; bf16n2 b = __builtin_convertvector(v, bf16n2); return __builtin_bit_cast(unsigned, b); }
DEV float bflo(unsigned u) { return __uint_as_float(u << 16); }
DEV float bfhi(unsigned u) { return __uint_as_float(u & 0xFFFF0000u); }
DEV float sigmoidf_(float x) { return 1.0f / (1.0f + __expf(-x)); }
DEV float siluf_(float x) { return x / (1.0f + __expf(-x)); }
DEV float softplusf_(float x) { return fmaxf(x, 0.f) + __logf(1.0f + __expf(-fabsf(x))); }
DEV float tanhf_(float x) { const float e = __expf(-2.0f * fabsf(x)); const float r = (1.0f - e) / (1.0f + e); return x < 0.f ? -r : r; }
DEV float wave_sum(float v) {
#pragma unroll
    for (int o = 32; o > 0; o >>= 1) v += __shfl_xor(v, o);
    return v;
}
DEV float sum16(float v) {
#pragma unroll
    for (int o = 8; o > 0; o >>= 1) v += __shfl_xor(v, o);
    return v;
}
template <int N> DEV float reduce_scatter(float (&v)[N], int lane) {
    int s = 1;
#pragma unroll
    for (int h = N / 2; h >= 1; h >>= 1) {
#pragma unroll
        for (int i = 0; i < h; ++i) {
            const bool up = (lane & s) != 0;
            const float send = up ? v[i] : v[i + h];
            const float keep = up ? v[i + h] : v[i];
            v[i] = keep + __shfl_xor(send, s);
        }
        s <<= 1;
    }
    float r = v[0];
    for (; s < 64; s <<= 1) r += __shfl_xor(r, s);
    return r;
}
template <int N> DEV int rs_index(int lane) {
    int o = 0, s = 1;
#pragma unroll
    for (int h = N / 2; h >= 1; h >>= 1) { if (lane & s) o += h; s <<= 1; }
    return o;
}

DEV bf16x8 frag_rm(const LAS bf16_t* base, int ld, int row0, int k0, int lane) {
    return *(const LAS bf16x8*)(base + (row0 + (lane & 15)) * ld + k0 + 8 * (lane >> 4));
}
DEV bf16x8 frag_tr(const LAS bf16_t* base, int ld, int k0, int c0, int lane) {
    const int g = lane >> 4, i = lane & 15, q = i >> 2, p = i & 3;
    const LAS bf16_t* a = base + (k0 + 8 * g + q) * ld + c0 + 4 * p;
    s16x4 lo = __builtin_amdgcn_ds_read_tr16_b64_v4i16((LAS s16x4*)a);
    s16x4 hi = __builtin_amdgcn_ds_read_tr16_b64_v4i16((LAS s16x4*)(a + 4 * ld));
    bf16x8 r; r[0] = lo[0]; r[1] = lo[1]; r[2] = lo[2]; r[3] = lo[3]; r[4] = hi[0]; r[5] = hi[1]; r[6] = hi[2]; r[7] = hi[3];
    return r;
}
#define MFMA16(a, b, c) __builtin_amdgcn_mfma_f32_16x16x32_bf16((a), (b), (c), 0, 0, 0)
DEV size_t fragmajor_off(int n, int k, int K) { return ((size_t)((n >> 4) * (K >> 5) + (k >> 5)) * 64 + (n & 15) + 16 * ((k & 31) >> 3)) * 8 + (k & 7); }

template <int N> DEV void skinny_group(const f32x4 (&z)[4], const LAS float* wt, int lane, LAS float* outw) {
    float pe[N];
#pragma unroll
    for (int o = 0; o < N; ++o) {
        float a = 0.f;
#pragma unroll
        for (int q = 0; q < 4; ++q) { const f32x4 w = *(const LAS f32x4*)(wt + o * 1028 + RCOL(q, lane)); a += z[q][0] * w[0] + z[q][1] * w[1] + z[q][2] * w[2] + z[q][3] * w[3]; }
        pe[o] = a;
    }
    const float r = reduce_scatter<N>(pe, lane);
    if (lane < N) outw[rs_index<N>(lane)] = r;
}
#ifndef SINGLE_LAUNCH
#define SINGLE_LAUNCH 1
#endif
constexpr size_t OFF_bar = 0ull;
constexpr size_t OFF_rw_rkv_t = 13824ull;
constexpr size_t OFF_rw_w1_t = 12596736ull;
constexpr size_t OFF_rw_a1_t = 13645312ull;
constexpr size_t OFF_rw_g1_t = 14693888ull;
constexpr size_t OFF_rw_w2_t = 15742464ull;
constexpr size_t OFF_rw_a2_t = 16791040ull;
constexpr size_t OFF_rw_g2_t = 17839616ull;
constexpr size_t OFF_rw_wo_t = 18888192ull;
constexpr size_t OFF_mb_win_t = 23082496ull;
constexpr size_t OFF_mb_wout_t = 33568256ull;
constexpr size_t OFF_gl_win_t = 37762560ull;
constexpr size_t OFF_gl_wout_t = 44054016ull;
constexpr size_t OFF_moe_w1_t = 46151168ull;
constexpr size_t OFF_moe_w2_t = 314586624ull;
constexpr size_t OFF_H = 448804352ull;
constexpr size_t OFF_H1 = 515913216ull;
constexpr size_t OFF_MIX = 583022080ull;
constexpr size_t OFF_BUF = 650130944ull;
constexpr size_t OFF_ACT = 734017024ull;
constexpr size_t OFF_YBUF = 775960064ull;
constexpr size_t OFF_CNT = 859846144ull;
constexpr size_t OFF_EIDX = 859878912ull;
constexpr size_t OFF_GATE = 860009984ull;
constexpr size_t OFF_DEST = 860141056ull;
constexpr size_t OFF_TAB = 860272128ull;
constexpr size_t OFF_YB = 860273152ull;
constexpr size_t OFF_X6 = 927382016ull;
constexpr size_t OFF_Rr = 1128708608ull;
constexpr size_t OFF_Kk = 1195817472ull;
constexpr size_t OFF_Vv = 1262926336ull;
constexpr size_t OFF_LW = 1330035200ull;
constexpr size_t OFF_Wd = 1355201024ull;
constexpr size_t OFF_Aa = 1422309888ull;
constexpr size_t OFF_Gg = 1489418752ull;
constexpr size_t OFF_RWf = 1556527616ull;
constexpr size_t OFF_RBf = 1590082048ull;
constexpr size_t OFF_RUt = 1623636480ull;
constexpr size_t OFF_RNa = 1657190912ull;
constexpr size_t OFF_RGc = 1690745344ull;
constexpr size_t OFF_RUa = 1691793920ull;
constexpr size_t OFF_RS0 = 1725348352ull;
constexpr size_t OFF_Z = 960936448ull;
constexpr size_t OFF_XBC = 1028045312ull;
constexpr size_t OFF_XC = 1128708608ull;
constexpr size_t OFF_DT = 1229371904ull;
constexpr size_t OFF_STATES = 1231469056ull;
constexpr size_t OFF_CD = 1365686784ull;
constexpr size_t OFF_PREV = 1365703168ull;
constexpr size_t OFF_LA = 1432812032ull;
constexpr size_t OFF_CDG = 1466366464ull;
constexpr size_t OFF_QKVG = OFF_XBC;
constexpr size_t WS_TOTAL = 1758902784ull;
typedef unsigned T_bar;
typedef bf16_t T_rw_rkv_t;
typedef bf16_t T_rw_w1_t;
typedef bf16_t T_rw_a1_t;
typedef bf16_t T_rw_g1_t;
typedef bf16_t T_rw_w2_t;
typedef bf16_t T_rw_a2_t;
typedef bf16_t T_rw_g2_t;
typedef bf16_t T_rw_wo_t;
typedef bf16_t T_mb_win_t;
typedef bf16_t T_mb_wout_t;
typedef bf16_t T_gl_win_t;
typedef bf16_t T_gl_wout_t;
typedef bf16_t T_moe_w1_t;
typedef bf16_t T_moe_w2_t;
typedef float T_H;
typedef float T_H1;
typedef float T_MIX;
typedef bf16_t T_BUF;
typedef bf16_t T_ACT;
typedef bf16_t T_YBUF;
typedef int T_CNT;
typedef int T_EIDX;
typedef float T_GATE;
typedef int T_DEST;
typedef int T_TAB;
typedef bf16_t T_YB;
typedef bf16_t T_X6;
typedef float T_Rr;
typedef float T_Kk;
typedef float T_Vv;
typedef bf16_t T_LW;
typedef float T_Wd;
typedef float T_Aa;
typedef float T_Gg;
typedef bf16_t T_RWf;
typedef bf16_t T_RBf;
typedef bf16_t T_RUt;
typedef bf16_t T_RNa;
typedef float T_RGc;
typedef bf16_t T_RUa;
typedef bf16_t T_RS0;
typedef bf16_t T_Z;
typedef bf16_t T_XBC;
typedef bf16_t T_XC;
typedef float T_DT;
typedef bf16_t T_STATES;
typedef float T_CD;
typedef bf16_t T_PREV;
typedef float T_LA;
typedef float T_CDG;
typedef bf16_t T_QKVG;
#define WS_(P, N) ((T_##N*)((P).ws + OFF_##N))
constexpr size_t OFF_Hb = OFF_H, OFF_H1b = OFF_H1, OFF_MIXb = OFF_MIX;
typedef bf16_t T_Hb; typedef bf16_t T_H1b; typedef bf16_t T_MIXb;
constexpr size_t OFF_moe_wr_t = OFF_H + 33554432ull;
typedef bf16_t T_moe_wr_t;
constexpr size_t OFF_mb_dt_t = OFF_moe_wr_t + 4ull * 48 * 1024 * 2, OFF_gl_lr_t = OFF_mb_dt_t + 32ull * 1024 * 2;
typedef bf16_t T_mb_dt_t; typedef bf16_t T_gl_lr_t;
constexpr size_t OFF_Rb = OFF_Rr, OFF_Kb = OFF_Kk, OFF_Vb = OFF_Vv, OFF_Ab = OFF_Aa, OFF_Gb = OFF_Gg;
typedef bf16_t T_Rb; typedef bf16_t T_Kb; typedef bf16_t T_Vb; typedef bf16_t T_Ab; typedef bf16_t T_Gb;
constexpr size_t OFF_Wb = OFF_Wd; typedef bf16_t T_Wb;
struct ConvJob {
    const float* src; bf16_t* dst;
    int K, N, src_ld, Kpad, Npad, perm, batch;
    long long src_bs, dst_bs;
    DEV int ntiles() const { return (Kpad / 64) * (Npad / 64) * batch; }
};
constexpr int NJOBS = 16;
constexpr int MOE_SPLIT = 40;

#define PARAM_LIST(X) \
    X(const float*, x) X(const float*, ln_g) X(const float*, ln_b) \
    X(const float*, rw_mu) X(const float*, rw_w_rkv) X(const float*, rw_w0) X(const float*, rw_w1) X(const float*, rw_w2) X(const float*, rw_a0) X(const float*, rw_a1) X(const float*, rw_a2) \
    X(const float*, rw_g1) X(const float*, rw_g2) X(const float*, rw_k_k) X(const float*, rw_k_a) X(const float*, rw_r_k) X(const float*, rw_lnx_g) X(const float*, rw_lnx_b) X(const float*, rw_w_o) \
    X(const float*, mb_w_in) X(const float*, mb_conv_w) X(const float*, mb_conv_b) X(const float*, mb_dt_bias) X(const float*, mb_a_log) X(const float*, mb_d) X(const float*, mb_norm_g) X(const float*, mb_w_out) \
    X(const float*, gl_w_in) X(const float*, gl_gk_w2) X(const float*, gl_gk_b) X(const float*, gl_norm_g) X(const float*, gl_w_out) \
    X(const float*, moe_w_group) X(const float*, moe_b_group) X(const float*, moe_w_route) X(const float*, moe_b_route) X(const float*, moe_w_in) X(const float*, moe_w_down) \
    X(float*, out) X(char*, ws)
struct Params {
#define X(t, n) t n;
    PARAM_LIST(X)
#undef X
};

enum Op : unsigned char { OP_CONVERT = 0, OP_PRE0, OP_RW_GEMM1, OP_RW_GEMM2, OP_RW_CHA, OP_RW_CHB, OP_RW_CHC, OP_RW_OUT,
    OP_LN1, OP_MOE_SCATTER, OP_MOE_GEMM1, OP_MOE_GEMM2, OP_LN2,
    OP_MB_GEMM_IN, OP_MB_CONV, OP_MB_STATES, OP_MB_SCAN, OP_MB_OUT, OP_MB_GEMM_OUT,
    OP_GL_GEMM_IN, OP_GL_KV, OP_GL_SCAN, OP_GL_OUT, OP_GL_GEMM_OUT };


DEV ConvJob make_job(const Params& p, int q) {
    const long long DD = (long long)D * D;
    switch (q) {
    case 0: return ConvJob{p.rw_w_rkv, WS_(p, rw_rkv_t), 1024, 1024, 1024, 1024, 1024, 0, 6, DD, DD};
    case 1: return ConvJob{p.rw_w1, WS_(p, rw_w1_t), 1024, 64, 64, 1024, 256, 0, 2, (long long)D * 64, (long long)256 * D};
    case 2: return ConvJob{p.rw_a1, WS_(p, rw_a1_t), 1024, 64, 64, 1024, 256, 0, 2, (long long)D * 64, (long long)256 * D};
    case 3: return ConvJob{p.rw_g1, WS_(p, rw_g1_t), 1024, 160, 160, 1024, 256, 0, 2, (long long)D * 160, (long long)256 * D};
    case 4: return ConvJob{p.rw_w2, WS_(p, rw_w2_t), 64, 1024, 1024, 256, 1024, 0, 2, (long long)64 * D, (long long)D * 256};
    case 5: return ConvJob{p.rw_a2, WS_(p, rw_a2_t), 64, 1024, 1024, 256, 1024, 0, 2, (long long)64 * D, (long long)D * 256};
    case 6: return ConvJob{p.rw_g2, WS_(p, rw_g2_t), 160, 1024, 1024, 256, 1024, 0, 2, (long long)160 * D, (long long)D * 256};
    case 7: return ConvJob{p.rw_w_o, WS_(p, rw_wo_t), 1024, 1024, 1024, 1024, 1024, 0, 2, DD, DD};
    case 8: return ConvJob{p.mb_w_in, WS_(p, mb_win_t), 1024, 5120, 5152, 1024, 5120, 0, 1, 0, 0};
    case 9: return ConvJob{p.mb_w_out, WS_(p, mb_wout_t), 2048, 1024, 1024, 2048, 1024, 0, 1, 0, 0};
    case 10: return ConvJob{p.gl_w_in, WS_(p, gl_win_t), 1024, 3072, 3088, 1024, 3072, 0, 1, 0, 0};
    case 11: return ConvJob{p.gl_w_out, WS_(p, gl_wout_t), 1024, 1024, 1024, 1024, 1024, 0, 1, 0, 0};
    case 12: return ConvJob{p.moe_w_in, WS_(p, moe_w1_t), 1024, 1024, 1024, 1024, 1024, 1, MOE_SPLIT, DD, DD};
    case 13: return ConvJob{p.moe_w_down, WS_(p, moe_w2_t), 512, 1024, 1024, 512, 1024, 0, MOE_SPLIT, (long long)512 * 1024, (long long)1024 * 512};
    case 14: return ConvJob{p.moe_w_in + (size_t)MOE_SPLIT * DD, WS_(p, moe_w1_t) + (size_t)MOE_SPLIT * DD, 1024, 1024, 1024, 1024, 1024, 1, 128 - MOE_SPLIT, DD, DD};
    default: return ConvJob{p.moe_w_down + (size_t)MOE_SPLIT * 512 * 1024, WS_(p, moe_w2_t) + (size_t)MOE_SPLIT * 512 * 1024, 512, 1024, 1024, 512, 1024, 0, 128 - MOE_SPLIT, (long long)512 * 1024, (long long)1024 * 512};
    }
}

template <int J0, int J1> DEV void convert_jobs(const Params& p, LAS unsigned char* lds, int B0, int NBW) {
    const int tid = tid_(), bid = bid_();
    const int lane = tid & 63, wv = tid >> 6; const int gw = (bid - B0) * 8 + wv, NW = NBW * 8;
    LAS bf16_t* tile = (LAS bf16_t*)lds + wv * (64 * 72);
    int tbeg = 0;
#pragma unroll
    for (int j = J0; j < J1; ++j) {
      const ConvJob J = make_job(p, j);
      const int jend = tbeg + J.ntiles();
      const int ti0 = tbeg + ((gw - tbeg) % NW + NW) % NW;
      const int jbeg = tbeg; tbeg = jend;
#pragma unroll 1
      for (int ti = ti0; ti < jend; ti += NW) {
        int local = ti - jbeg;
        const int tk = J.Kpad / 64, tn = J.Npad / 64;
        const int b = local / (tk * tn); local -= b * tk * tn;
        const int nt = local / tk, kt = local - nt * tk;
        const float* src = J.src + (size_t)b * J.src_bs;
        bf16_t* dst = J.dst + (size_t)b * J.dst_bs;
        const int k0 = kt * 64, n0 = nt * 64;
        const int nn = (lane & 15) * 4; const bool nok = n0 + nn < J.N;
        f32x4 v[16];
#pragma unroll
        for (int i = 0; i < 16; ++i) { const int kk = (lane >> 4) + 4 * i; v[i] = (nok && k0 + kk < J.K) ? *(const f32x4*)(src + (size_t)(k0 + kk) * J.src_ld + n0 + nn) : (f32x4){0.f, 0.f, 0.f, 0.f}; }
#pragma unroll
        for (int i = 0; i < 16; ++i) { const int kk = (lane >> 4) + 4 * i;
#pragma unroll
            for (int e = 0; e < 4; ++e) tile[(nn + e) * 72 + kk] = (bf16_t)f2bf(v[i][e]); }
#pragma unroll
        for (int i = 0; i < 8; ++i) { const int r = (lane >> 3) + 8 * i, kc = (lane & 7) * 8;
            int nsrc = n0 + r, ndst = nsrc;
            if (J.perm == 1) { const int up = nsrc >= 512, jj = nsrc - (up ? 512 : 0); ndst = (jj >> 7) * 256 + (up ? 128 : 0) + (jj & 127); }
            *(u32x4*)(dst + (size_t)ndst * J.Kpad + k0 + kc) = *(const LAS u32x4*)(tile + r * 72 + kc); }
      }
    }
}
DEV void phase_convert(const Params& p, LAS unsigned char* lds) {
    const int tid = tid_(), bid = bid_();
    convert_jobs<0, 14>(p, lds, 0, NB_);
    if (bid < 4 * 48) { const int layer = bid / 48, o = bid % 48;
        for (int k = tid; k < D; k += NTHR) { float v = 0.f;
            if (o < 32) v = p.moe_w_route[((size_t)layer * D + k) * 32 + o]; else if (o < 36) v = p.moe_w_group[((size_t)layer * D + k) * 4 + (o - 32)];
            WS_(p, moe_wr_t)[((size_t)layer * 48 + o) * D + k] = (bf16_t)f2bf(v); } }
    else if (bid < 4 * 48 + 32) { const int o = bid - 192;
        for (int k = tid; k < D; k += NTHR) WS_(p, mb_dt_t)[(size_t)o * D + k] = (bf16_t)f2bf(p.mb_w_in[(size_t)k * 5152 + 5120 + o]); }
    else if (bid < 4 * 48 + 48) { const int o = bid - 224;
        for (int k = tid; k < D; k += NTHR) WS_(p, gl_lr_t)[(size_t)o * D + k] = (bf16_t)f2bf(p.gl_w_in[(size_t)k * 3088 + 3072 + o]); }
}
namespace pg8 {
constexpr int BM = 256, BK = 64, HALF = 128, HTB = HALF * BK * 2, STAGE_BYTES = 8 * HTB;
DEV int lds_byte(int r, int c) { const int st = (r >> 4) * 2 + (c >> 5), rr = r & 15, cc = c & 31, ob = rr * 64 + cc * 2; return st * 1024 + (ob ^ (((ob >> 9) & 1) << 5)); }
DEV void stage_rc(int b, int& R, int& C) { const int st = b / 1024, sb = b % 1024, swz = sb ^ (((sb >> 9) & 1) << 5); R = (st >> 1) * 16 + swz / 64; C = (st & 1) * 32 + (swz % 64) / 2; }

struct Unit { const char* A; const char* B; int row0, col0, id, aux; };

DEV bool tile_order(int i, int G, int c, int nM, int nN, int& pm, int& pn) {
    const int nwg = nM * nN; const long L = (long)i * G + c; if (L >= nwg) return false;
    int wgid = (int)L; { const int q = nwg / 8, r = nwg % 8, xcd = wgid % 8, off = wgid / 8; wgid = (xcd < r ? xcd * (q + 1) : r * (q + 1) + (xcd - r) * q) + off; }
    const int nig = 8 * nN, gid = wgid / nig, fm = gid * 8, gsz = (nM - fm) < 8 ? (nM - fm) : 8;
    pm = fm + ((wgid % nig) % gsz); pn = (wgid % nig) / gsz; return true;
}

template <class Epi, class Sched>
DEV void gemm_phase(LAS unsigned char* lds, const int K, const Sched& S, const Epi& E) {
    const int tid = tid_(), wid = __builtin_amdgcn_readfirstlane(tid >> 6), lane = tid & 63, wr = wid >> 2, wc = wid & 3, fr = lane & 15, fq = lane >> 4;
    const int nt = K / BK;
    unsigned voff[2];
#pragma unroll
    for (int i = 0; i < 2; ++i) { int R, C; stage_rc(tid * 16 + i * 8192, R, C); voff[i] = (unsigned)(R * K + C) * 2u; }
    const size_t kstep = (size_t)(BK * 2);
    const size_t hstep = (size_t)HALF * K * 2;
    const unsigned ldsw = (unsigned)wid * 1024u;
    const int aoff = lds_byte(wr * 64 + fr, fq * 8), boff = lds_byte(wc * 32 + fr, fq * 8);
#define PG8_SA(b, h) (((b) * 2 + (h)) * HTB)
#define PG8_SB(b, h) ((4 + (b) * 2 + (h)) * HTB)
#define PG8_STAGE(bufoff, gbase) do { _Pragma("unroll") for (int _i = 0; _i < 2; ++_i) \
        __builtin_amdgcn_global_load_lds((const unsigned*)((const char*)(gbase) + voff[_i]), (LAS unsigned*)(lds + (bufoff) + ldsw + _i * 8192), 16, 0, 0); } while (0)
#define PG8_LDA(dst, b, h) do { _Pragma("unroll") for (int m = 0; m < 4; ++m) _Pragma("unroll") for (int k = 0; k < 2; ++k) dst[m][k] = *(const LAS bf16x8*)(lds + PG8_SA(b, h) + aoff + m * 2048 + k * 1024); } while (0)
#define PG8_LDB(dst, b, h) do { _Pragma("unroll") for (int n = 0; n < 2; ++n) _Pragma("unroll") for (int k = 0; k < 2; ++k) dst[n][k] = *(const LAS bf16x8*)(lds + PG8_SB(b, h) + boff + n * 2048 + k * 1024); } while (0)
#define PG8_MMA(ai, bj, At, Bt) do { __builtin_amdgcn_s_setprio(1); _Pragma("unroll") for (int m = 0; m < 4; ++m) _Pragma("unroll") for (int n = 0; n < 2; ++n) _Pragma("unroll") for (int k = 0; k < 2; ++k) \
        acc[ai][bj][m][n] = __builtin_amdgcn_mfma_f32_16x16x32_bf16(Bt[n][k], At[m][k], acc[ai][bj][m][n], 0, 0, 0); __builtin_amdgcn_s_setprio(0); } while (0)
#define PG8_WAIT_V(n) asm volatile("s_waitcnt vmcnt(" #n ")" ::: "memory")
#define PG8_WAIT_L(n) asm volatile("s_waitcnt lgkmcnt(" #n ")" ::: "memory")
#define PG8_BAR __builtin_amdgcn_s_barrier()
#define PG8_SCHED __builtin_amdgcn_sched_barrier(0)
    Unit cur, nxt; int ui = 0;
    if (!S.next(0, cur)) return;
    f32x4 acc[2][2][4][2];
#pragma unroll
    for (int a = 0; a < 2; ++a)
#pragma unroll
        for (int b = 0; b < 2; ++b)
#pragma unroll
            for (int m = 0; m < 4; ++m)
#pragma unroll
                for (int n = 0; n < 2; ++n) acc[a][b][m][n] = (f32x4){0.f, 0.f, 0.f, 0.f};
    bf16x8 At[4][2], B0[2][2], B1[2][2];
    const char* cA = cur.A; const char* cB = cur.B;
    PG8_STAGE(PG8_SB(0, 0), cB); PG8_STAGE(PG8_SA(0, 0), cA); PG8_STAGE(PG8_SB(0, 1), cB + hstep); PG8_STAGE(PG8_SA(0, 1), cA + hstep);
    if (wr == 1) PG8_BAR;
    PG8_WAIT_V(4); PG8_BAR;
    PG8_STAGE(PG8_SB(1, 0), cB + kstep); PG8_STAGE(PG8_SA(1, 0), cA + kstep); PG8_STAGE(PG8_SB(1, 1), cB + hstep + kstep);
    PG8_WAIT_V(6); PG8_BAR;
    for (;;) {
        const bool has_next = S.next(ui + 1, nxt);
        const char* nA = has_next ? nxt.A : cA; const char* nB = has_next ? nxt.B : cB;
#pragma unroll 1
        for (int t = 0; t < nt; t += 2) {
            const bool last = (t == nt - 2);
            const char* a1 = cA + (size_t)(t + 1) * kstep;
            const char* a2 = last ? nA : cA + (size_t)(t + 2) * kstep; const char* b2 = last ? nB : cB + (size_t)(t + 2) * kstep;
            const char* a3 = a2 + kstep; const char* b3 = b2 + kstep;
            PG8_LDB(B0, 0, 0); PG8_SCHED; PG8_LDA(At, 0, 0); PG8_STAGE(PG8_SA(1, 1), a1 + hstep);
            PG8_WAIT_L(8); PG8_BAR; PG8_WAIT_L(0); PG8_MMA(0, 0, At, B0); PG8_BAR; PG8_SCHED;
            PG8_LDB(B1, 0, 1); PG8_STAGE(PG8_SB(0, 0), b2);
            PG8_BAR; PG8_WAIT_L(0); PG8_MMA(0, 1, At, B1); PG8_BAR;
            PG8_LDA(At, 0, 1); PG8_STAGE(PG8_SA(0, 0), a2);
            PG8_BAR; PG8_WAIT_L(0); PG8_MMA(1, 0, At, B0); PG8_BAR; PG8_SCHED;
            PG8_STAGE(PG8_SB(0, 1), b2 + hstep);
            PG8_WAIT_V(6); PG8_BAR; PG8_MMA(1, 1, At, B1); PG8_BAR;
            PG8_LDB(B0, 1, 0); PG8_SCHED; PG8_LDA(At, 1, 0); PG8_STAGE(PG8_SA(0, 1), a2 + hstep);
            PG8_WAIT_L(8); PG8_BAR; PG8_WAIT_L(0); PG8_MMA(0, 0, At, B0); PG8_BAR; PG8_SCHED;
            PG8_LDB(B1, 1, 1); PG8_STAGE(PG8_SB(1, 0), b3);
            PG8_BAR; PG8_WAIT_L(0); PG8_MMA(0, 1, At, B1); PG8_BAR;
            PG8_LDA(At, 1, 1); PG8_STAGE(PG8_SA(1, 0), a3);
            PG8_BAR; PG8_WAIT_L(0); PG8_MMA(1, 0, At, B0); PG8_BAR; PG8_SCHED;
            PG8_STAGE(PG8_SB(1, 1), b3 + hstep);
            PG8_WAIT_V(6); PG8_BAR; PG8_MMA(1, 1, At, B1); PG8_BAR;
        }
        E(acc, cur, wr, wc, fr, fq);
        if (!has_next) break;
#pragma unroll
        for (int a = 0; a < 2; ++a)
#pragma unroll
            for (int b = 0; b < 2; ++b)
#pragma unroll
                for (int m = 0; m < 4; ++m)
#pragma unroll
                    for (int n = 0; n < 2; ++n) acc[a][b][m][n] = (f32x4){0.f, 0.f, 0.f, 0.f};
        cur = nxt; cA = nA; cB = nB; ++ui;
    }
    PG8_WAIT_V(0);
    if (wr == 0) PG8_BAR;
    PG8_BAR;
#undef PG8_SA
#undef PG8_SB
#undef PG8_STAGE
#undef PG8_LDA
#undef PG8_LDB
#undef PG8_MMA
#undef PG8_WAIT_V
#undef PG8_WAIT_L
#undef PG8_BAR
#undef PG8_SCHED
}
}
using pg8::Unit;
typedef f32x4 AccT[2][2][4][2];
#define FOR_ACC(ai, bj, m, n) _Pragma("unroll") for (int ai = 0; ai < 2; ++ai) _Pragma("unroll") for (int m = 0; m < 4; ++m) _Pragma("unroll") for (int bj = 0; bj < 2; ++bj) _Pragma("unroll") for (int n = 0; n < 2; ++n)
#define ACC_FENCE __builtin_amdgcn_sched_barrier(0)
#define ACC_ROW(u, ai, m) ((u).row0 + 128 * (ai) + 64 * wr + 16 * (m) + fr)
#define ACC_COL(u, bj, n) ((u).col0 + 128 * (bj) + 32 * wc + 16 * (n) + 4 * fq)
DEV void st_bf4(bf16_t* p, f32x4 v) { u32x2 w; w.x = pk2(v[0], v[1]); w.y = pk2(v[2], v[3]); *(u32x2*)p = w; }
DEV void load_row(const float* p, int lane, f32x4 (&v)[4]) {
#pragma unroll
    for (int q = 0; q < 4; ++q) v[q] = *(const f32x4*)(p + RCOL(q, lane));
}

DEV void load_row_bf(const bf16_t* p, int lane, f32x4 (&v)[4]) {
#pragma unroll
    for (int q = 0; q < 4; ++q) { const u32x2 a = *(const u32x2*)(p + RCOL(q, lane)); v[q] = (f32x4){bflo(a.x), bfhi(a.x), bflo(a.y), bfhi(a.y)}; }
}
DEV void store_row_bf(bf16_t* p, int lane, const f32x4 (&v)[4]) {
#pragma unroll
    for (int q = 0; q < 4; ++q) st_bf4(p + RCOL(q, lane), v[q]);
}
DEV void emit_mix6(const Params& p, int j, int t, int lane, const f32x4 (&x)[4], const f32x4 (&xp)[4]) {
    const float* mu = p.rw_mu + (size_t)j * 6 * D;
#pragma unroll
    for (int s = 0; s < 6; ++s) {
#pragma unroll
        for (int q = 0; q < 4; ++q) {
            const f32x4 m = *(const f32x4*)(mu + s * D + RCOL(q, lane));
            st_bf4(WS_(p, X6) + (size_t)s * T * D + (size_t)t * D + RCOL(q, lane), x[q] + (xp[q] - x[q]) * m);
        }
        __builtin_amdgcn_sched_barrier(0);
    }
}
DEV void phase_pre0(const Params& p) {
    const int tid = tid_(), bid = bid_(); const int lane = tid & 63, wid = tid >> 6;
    f32x4 x[4], xp[4];
    const int tfirst = bid * 64 + wid * 8;
    if (tfirst > 0) load_row(p.x + (size_t)(tfirst - 1) * D, lane, xp); else { for (int q = 0; q < 4; ++q) xp[q] = (f32x4){0.f, 0.f, 0.f, 0.f}; }
    f32x4 xn[4]; load_row(p.x + (size_t)tfirst * D, lane, xn);
#pragma unroll 1
    for (int r = 0; r < 8; ++r) {
        const int t = tfirst + r;
#pragma unroll
        for (int q = 0; q < 4; ++q) x[q] = xn[q];
        load_row(p.x + (size_t)(r < 7 ? t + 1 : t) * D, lane, xn);
        store_row_bf(WS_(p, Hb) + (size_t)t * D, lane, x);
        emit_mix6(p, 0, t, lane, x, xp);
#pragma unroll
        for (int q = 0; q < 4; ++q) xp[q] = x[q];
    }
}

struct SchedRW1 {
    const Params* p; int j;
    DEV bool next(int i, Unit& u) const {
        int pm, pn; if (!pg8::tile_order(i, NB_, bid_(), 64, 15, pm, pn)) return false;
        int id, lpn; if (pn < 12) { id = pn >> 2; lpn = pn & 3; } else { id = 3 + (pn - 12); lpn = 0; }
        u.A = (const char*)(WS_(*p, X6) + (size_t)id * T * D + (size_t)pm * 256 * D);
        const bf16_t* B;
        if (id < 3) B = WS_(*p, rw_rkv_t) + ((size_t)j * 3 + id) * D * D + (size_t)lpn * 256 * D;
        else B = WS_(*p, rw_w1_t) + (size_t)(id - 3) * (2 * 256 * D) + (size_t)j * 256 * D;
        u.B = (const char*)B; u.row0 = pm * 256; u.col0 = lpn * 256; u.id = id; u.aux = 0; return true;
    }
};
struct EpiRW1 {
    const Params* p;
    DEV void operator()(const AccT& acc, const Unit& u, int wr, int wc, int fr, int fq) const {
        if (u.id < 3) {
            bf16_t* O = WS_(*p, Rb) + (size_t)u.id * 2 * T * D;
            FOR_ACC(ai, bj, m, n) { st_bf4(O + (size_t)ACC_ROW(u, ai, m) * D + ACC_COL(u, bj, n), acc[ai][bj][m][n]); ACC_FENCE; }
        } else {
            bf16_t* O = WS_(*p, LW) + (size_t)(u.id - 3) * T * 256;
            FOR_ACC(ai, bj, m, n) {
                f32x4 v = acc[ai][bj][m][n];
                if (u.id == 3) { for (int e = 0; e < 4; ++e) v[e] = tanhf_(v[e]); }
                else if (u.id == 5) { for (int e = 0; e < 4; ++e) v[e] = sigmoidf_(v[e]); }
                st_bf4(O + (size_t)ACC_ROW(u, ai, m) * 256 + ACC_COL(u, bj, n), v); ACC_FENCE;
            }
        }
    }
};
struct SchedRW2 {
    const Params* p; int j;
    DEV bool next(int i, Unit& u) const {
        int pm, pn; if (!pg8::tile_order(i, NB_, bid_(), 64, 12, pm, pn)) return false;
        const int id = pn >> 2, lpn = pn & 3;
        u.A = (const char*)(WS_(*p, LW) + (size_t)id * T * 256 + (size_t)pm * 256 * 256);
        const bf16_t* B = WS_(*p, rw_w2_t) + (size_t)id * (2 * D * 256) + (size_t)j * D * 256 + (size_t)lpn * 256 * 256;
        u.B = (const char*)B; u.row0 = pm * 256; u.col0 = lpn * 256; u.id = id; u.aux = 0; return true;
    }
};
struct EpiRW2 {
    const Params* p; int j;
    DEV void operator()(const AccT& acc, const Unit& u, int wr, int wc, int fr, int fq) const {
        if (u.id == 0) { const float* bias = p->rw_w0 + (size_t)j * D; f32x4 bv[2][2];
#pragma unroll
            for (int bj = 0; bj < 2; ++bj)
#pragma unroll
                for (int n = 0; n < 2; ++n) bv[bj][n] = *(const f32x4*)(bias + ACC_COL(u, bj, n));
            FOR_ACC(ai, bj, m, n) { f32x4 v = acc[ai][bj][m][n]; const int c = ACC_COL(u, bj, n); const f32x4 b = bv[bj][n];
                for (int e = 0; e < 4; ++e) { const float x = -(b[e] + v[e]); const float wl = -(fmaxf(x, 0.f) + __logf(1.0f + __expf(-fabsf(x)))) - 0.5f; v[e] = -__expf(wl); }
                st_bf4(WS_(*p, Wb) + (size_t)ACC_ROW(u, ai, m) * D + c, v); ACC_FENCE; } }
        else if (u.id == 1) { const float* bias = p->rw_a0 + (size_t)j * D; f32x4 bv[2][2];
#pragma unroll
            for (int bj = 0; bj < 2; ++bj)
#pragma unroll
                for (int n = 0; n < 2; ++n) bv[bj][n] = *(const f32x4*)(bias + ACC_COL(u, bj, n));
            FOR_ACC(ai, bj, m, n) { f32x4 v = acc[ai][bj][m][n]; const int c = ACC_COL(u, bj, n); const f32x4 b = bv[bj][n];
                for (int e = 0; e < 4; ++e) v[e] = sigmoidf_(b[e] + v[e]);
                st_bf4(WS_(*p, Ab) + (size_t)ACC_ROW(u, ai, m) * D + c, v); ACC_FENCE; } }
        else { FOR_ACC(ai, bj, m, n) { st_bf4(WS_(*p, Gb) + (size_t)ACC_ROW(u, ai, m) * D + ACC_COL(u, bj, n), acc[ai][bj][m][n]); ACC_FENCE; } }
    }
};

struct SchedOut {
    const bf16_t* A; const bf16_t* Bt; int K;
    DEV bool next(int i, Unit& u) const {
        int pm, pn; if (!pg8::tile_order(i, NB_, bid_(), 64, 4, pm, pn)) return false;
        u.A = (const char*)(A + (size_t)pm * 256 * K); u.B = (const char*)(Bt + (size_t)pn * 256 * K); u.row0 = pm * 256; u.col0 = pn * 256; u.id = 0; u.aux = 0; return true;
    }
};
struct EpiOut {
    bf16_t* O;
    DEV void operator()(const AccT& acc, const Unit& u, int wr, int wc, int fr, int fq) const {
        FOR_ACC(ai, bj, m, n) { st_bf4(O + (size_t)ACC_ROW(u, ai, m) * D + ACC_COL(u, bj, n), acc[ai][bj][m][n]); ACC_FENCE; }
    }
};
constexpr int RC_LD = 72;
#ifdef DBG
#define DBGF(cond, bit) do { if (cond) atomicOr(&WS_(p, TAB)[200], (bit)); } while (0)
#else
#define DBGF(cond, bit) do {} while (0)
#endif
DEV bool bad_(float x) { return !(fabsf(x) < 1e30f); }
DEV int rc_pi(int g, int j) { return j < 4 ? 4 * g + j : 16 + 4 * g + (j - 4); }

DEV void rc_load_wd(const Params& p, int t0, int cb, float (&wd)[8]) {
    const int tid = tid_(); const int k = tid & 63, sg = tid >> 6;
#pragma unroll
    for (int i = 0; i < 8; ++i) wd[i] = bf2f(WS_(p, Wb)[(size_t)(t0 + sg * 8 + i) * D + cb + k]);
}
DEV void rc_cum_regs(const float (&wd)[8], LAS float* cum, LAS float* seg) {
    const int tid = tid_(); const int k = tid & 63, sg = tid >> 6;
    float v[8]; float s = 0.f;
#pragma unroll
    for (int i = 0; i < 8; ++i) { s += wd[i]; v[i] = s; }
    seg[sg * 64 + k] = s;
    lds_barrier();
    float off = 0.f;
#pragma unroll
    for (int q = 0; q < 8; ++q) off += (q < sg) ? seg[q * 64 + k] : 0.f;
#pragma unroll
    for (int i = 0; i < 8; ++i) cum[(sg * 8 + i) * 64 + k] = v[i] + off;
    lds_barrier();
}
DEV void ld8b(const bf16_t* p, float (&f)[8]) { const u32x4 v = *(const u32x4*)p; f[0] = bflo(v.x); f[1] = bfhi(v.x); f[2] = bflo(v.y); f[3] = bfhi(v.y); f[4] = bflo(v.z); f[5] = bfhi(v.z); f[6] = bflo(v.w); f[7] = bfhi(v.w); }
DEV void ld8(const float* p, float (&f)[8]) { const f32x4 a = *(const f32x4*)p, b = *(const f32x4*)(p + 4); f[0] = a[0]; f[1] = a[1]; f[2] = a[2]; f[3] = a[3]; f[4] = b[0]; f[5] = b[1]; f[6] = b[2]; f[7] = b[3]; }
DEV void lds8(const LAS float* p, float (&f)[8]) { const f32x4 a = *(const LAS f32x4*)p, b = *(const LAS f32x4*)(p + 4); f[0] = a[0]; f[1] = a[1]; f[2] = a[2]; f[3] = a[3]; f[4] = b[0]; f[5] = b[1]; f[6] = b[2]; f[7] = b[3]; }
DEV u32x4 pk8(const float (&f)[8]) { u32x4 o; o.x = pk2(f[0], f[1]); o.y = pk2(f[2], f[3]); o.z = pk2(f[4], f[5]); o.w = pk2(f[6], f[7]); return o; }

DEV bf16x8 frag_rm_pi(const LAS bf16_t* base, int ld, int row0, int k0, int lane) {
    const LAS bf16_t* a = base + (row0 + (lane & 15)) * ld + k0 + 4 * (lane >> 4);
    const s16x4 lo = *(const LAS s16x4*)a, hi = *(const LAS s16x4*)(a + 16);
    bf16x8 r; r[0] = lo[0]; r[1] = lo[1]; r[2] = lo[2]; r[3] = lo[3]; r[4] = hi[0]; r[5] = hi[1]; r[6] = hi[2]; r[7] = hi[3]; return r;
}
DEV void rc_prep8(const float (&k)[8], const float (&al)[8], const float (&kkw)[8], const float (&kaw)[8], float (&a)[8], float (&b)[8], float (&kh)[8]) {
    float kk[8]; float ss = 0.f;
#pragma unroll
    for (int e = 0; e < 8; ++e) { kk[e] = k[e] * kkw[e]; ss += kk[e] * kk[e]; }
    ss += __shfl_xor(ss, 1); ss += __shfl_xor(ss, 2); ss += __shfl_xor(ss, 4);
    const float inv = 1.0f / fmaxf(sqrtf(ss), 1e-12f);
#pragma unroll
    for (int e = 0; e < 8; ++e) { const float kn = kk[e] * inv; a[e] = -kn; b[e] = kn * al[e]; kh[e] = k[e] * (1.0f + (al[e] - 1.0f) * kaw[e]); }
}
DEV void phase_rw_cha(const Params& p, int jl, LAS unsigned char* lds) {
    const int tid = tid_(), bid = bid_(); const int lane = tid & 63, w = tid >> 6; const int fr = lane & 15, fq = lane >> 4;
    LAS float* cum = (LAS float*)lds;
    LAS float* seg = cum + 64 * 64;
    LAS float* Aab = seg + 8 * 64;
    LAS bf16_t* As = (LAS bf16_t*)(Aab + 64 * 68);
    LAS bf16_t* Bs = As + 64 * RC_LD; LAS bf16_t* Ks = Bs + 64 * RC_LD; LAS bf16_t* Vs = Ks + 64 * RC_LD; LAS bf16_t* Ke = Vs + 64 * RC_LD;
    LAS bf16_t* Aak = Ke + 64 * RC_LD; LAS bf16_t* Ts = Aak + 64 * RC_LD; LAS bf16_t* X1 = Ts + 64 * RC_LD; LAS bf16_t* Aabh = X1 + 64 * RC_LD;
    LAS bf16_t* Fimg = Aabh + 64 * RC_LD;
    LAS bf16_t* Wimg = Fimg + 4096;
    float pwd[8], pkr[8], pal[8], pv[8];
    float kkw[8], kaw[8];
    ld8(p.rw_k_k + (size_t)jl * D + (bid & 15) * 64 + (tid & 7) * 8, kkw); ld8(p.rw_k_a + (size_t)jl * D + (bid & 15) * 64 + (tid & 7) * 8, kaw);
    { const int c = bid >> 4, h = bid & 15; rc_load_wd(p, c * 64, h * 64, pwd);
      const size_t go = (size_t)(c * 64 + (tid >> 3)) * D + h * 64 + (tid & 7) * 8; ld8b(WS_(p, Kb) + go, pkr); ld8b(WS_(p, Ab) + go, pal); ld8b(WS_(p, Vb) + go, pv); }
    for (int u = bid; u < 4096; u += NB_) {
        const int c = u >> 4, h = u & 15; const int t0 = c * 64, cb = h * 64; const size_t ub = (size_t)c * 16 + h;
        lds_barrier();
        rc_cum_regs(pwd, cum, seg);
        {
            const int t = tid >> 3, k8 = (tid & 7) * 8;
            float a[8], b[8], kh[8], v[8], ct[8], cp[8], ce[8];
            rc_prep8(pkr, pal, kkw, kaw, a, b, kh);
#pragma unroll
            for (int e = 0; e < 8; ++e) v[e] = pv[e];
            if (u + NB_ < 4096) { const int un = u + NB_; const int cn = un >> 4, hn = un & 15; rc_load_wd(p, cn * 64, hn * 64, pwd);
                const size_t gn = (size_t)(cn * 64 + t) * D + hn * 64 + k8; ld8b(WS_(p, Kb) + gn, pkr); ld8b(WS_(p, Ab) + gn, pal); ld8b(WS_(p, Vb) + gn, pv); }
            lds8(cum + t * 64 + k8, ct); lds8(cum + 63 * 64 + k8, ce);
            if (t > 0) lds8(cum + (t - 1) * 64 + k8, cp); else { for (int e = 0; e < 8; ++e) cp[e] = 0.f; }
            float at[8], bt[8], kt[8], be[8], ke[8];
#pragma unroll
            for (int e = 0; e < 8; ++e) { const float ei = __expf(-ct[e]), ee = __expf(ce[e] - ct[e]); at[e] = a[e] * __expf(cp[e]); bt[e] = b[e] * ei; kt[e] = kh[e] * ei; be[e] = b[e] * ee; ke[e] = kh[e] * ee; }
            *(LAS u32x4*)(As + t * RC_LD + k8) = pk8(at); *(LAS u32x4*)(Bs + t * RC_LD + k8) = pk8(bt); *(LAS u32x4*)(Ks + t * RC_LD + k8) = pk8(kt);
            *(LAS u32x4*)(Ke + t * RC_LD + k8) = pk8(ke); *(LAS u32x4*)(Vs + t * RC_LD + k8) = pk8(v);
            const int tq = t & 31, g = (tq & 15) >> 2, j = (tq & 3) + ((tq >> 4) << 2);
#pragma unroll
            for (int e = 0; e < 8; ++e) { const int k = k8 + e; Fimg[(((k >> 4) * 2 + (t >> 5)) * 64 + g * 16 + (k & 15)) * 8 + j] = (bf16_t)f2bf(be[e]); }
            *(LAS u32x4*)(Ts + tid * 8) = (u32x4){0u, 0u, 0u, 0u}; if (tid < 64) *(LAS u32x4*)(Ts + (512 + tid) * 8) = (u32x4){0u, 0u, 0u, 0u};
            if (t == 63) { float gm[8]; for (int e = 0; e < 8; ++e) gm[e] = __expf(ce[e]); *(f32x4*)(WS_(p, RGc) + ub * 64 + k8) = (f32x4){gm[0], gm[1], gm[2], gm[3]}; *(f32x4*)(WS_(p, RGc) + ub * 64 + k8 + 4) = (f32x4){gm[4], gm[5], gm[6], gm[7]}; }
        }
        lds_barrier();
        {
            const int tb = w >> 1;
#pragma unroll
            for (int ii = 0; ii < 2; ++ii) { const int ib = 2 * (w & 1) + ii;
                f32x4 ab = {0.f, 0.f, 0.f, 0.f}, ak = {0.f, 0.f, 0.f, 0.f};
                if (ib <= tb) {
#pragma unroll
                    for (int ks = 0; ks < 2; ++ks) { const bf16x8 af = frag_rm(As, RC_LD, 16 * tb, 32 * ks, lane);
                        ab = MFMA16(af, frag_rm(Bs, RC_LD, 16 * ib, 32 * ks, lane), ab); ak = MFMA16(af, frag_rm(Ks, RC_LD, 16 * ib, 32 * ks, lane), ak); } }
#pragma unroll
                for (int r = 0; r < 4; ++r) { const int t = 16 * tb + 4 * fq + r, i = 16 * ib + fr; const bool keep = i < t;
                    Aab[t * 68 + i] = keep ? ab[r] : 0.f; Aabh[t * RC_LD + i] = (bf16_t)f2bf(keep ? ab[r] : 0.f); Aak[t * RC_LD + i] = (bf16_t)f2bf(keep ? ak[r] : 0.f); } }
            *(u32x4*)(WS_(p, RBf) + ub * 4096 + tid * 8) = *(const LAS u32x4*)(Fimg + tid * 8);
        }
        lds_barrier();
        if (w == 0) {
            const int blk = lane >> 4, jc = lane & 15;
            float Tc[16];
#pragma unroll
            for (int t = 0; t < 16; ++t) {
                float acc = jc == t ? 1.f : 0.f;
#pragma unroll
                for (int i4 = 0; i4 < (t + 3) / 4; ++i4) { const f32x4 a4 = *(const LAS f32x4*)(Aab + (16 * blk + t) * 68 + 16 * blk + i4 * 4);
#pragma unroll
                    for (int e = 0; e < 4; ++e) if (i4 * 4 + e < t) acc += a4[e] * Tc[i4 * 4 + e]; }
                Tc[t] = acc;
            }
#pragma unroll
            for (int t = 0; t < 16; ++t) Ts[(16 * blk + t) * RC_LD + 16 * blk + jc] = (bf16_t)f2bf(Tc[t]);
#pragma unroll
            for (int b = 1; b < 4; ++b) {
                const s16x4 dlo = *(const LAS s16x4*)(Ts + (16 * b + fr) * RC_LD + 16 * b + 4 * fq);
                bf16x8 dfr; dfr[0] = dlo[0]; dfr[1] = dlo[1]; dfr[2] = dlo[2]; dfr[3] = dlo[3]; dfr[4] = 0; dfr[5] = 0; dfr[6] = 0; dfr[7] = 0;
                f32x4 tt_[3];
#pragma unroll
                for (int cbk = 0; cbk < b; ++cbk) {
                    f32x4 x = {0.f, 0.f, 0.f, 0.f};
#pragma unroll
                    for (int ks = 0; ks < 2; ++ks) x = MFMA16(frag_rm(Aabh, RC_LD, 16 * b, 32 * ks, lane), frag_tr(Ts, RC_LD, 32 * ks, 16 * cbk, lane), x);
                    u32x4 xb; xb.x = pk2(x[0], x[1]); xb.y = pk2(x[2], x[3]); xb.z = 0u; xb.w = 0u;
                    tt_[cbk] = MFMA16(dfr, __builtin_bit_cast(bf16x8, xb), ((f32x4){0.f, 0.f, 0.f, 0.f}));
                }
#pragma unroll
                for (int cbk = 0; cbk < b; ++cbk)
#pragma unroll
                    for (int r = 0; r < 4; ++r) Ts[(16 * b + 4 * fq + r) * RC_LD + 16 * cbk + fr] = (bf16_t)f2bf(tt_[cbk][r]);
            }
        } else {
            for (int tl = w - 1; tl < 32; tl += 7) {
                const int rb = (tl & 15) >> 2, vbk = tl & 3; f32x4 acc = {0.f, 0.f, 0.f, 0.f};
                if (tl < 16) {
#pragma unroll
                    for (int ks = 0; ks < 2; ++ks) acc = MFMA16(frag_rm(Aak, RC_LD, 16 * rb, 32 * ks, lane), frag_tr(Vs, RC_LD, 32 * ks, 16 * vbk, lane), acc);
#pragma unroll
                    for (int r = 0; r < 4; ++r) X1[(16 * rb + 4 * fq + r) * RC_LD + 16 * vbk + fr] = (bf16_t)f2bf(acc[r]);
                } else {
#pragma unroll
                    for (int ks = 0; ks < 2; ++ks) acc = MFMA16(frag_tr(Ke, RC_LD, 32 * ks, 16 * rb, lane), frag_tr(Vs, RC_LD, 32 * ks, 16 * vbk, lane), acc);
                    { u32x2 o; o.x = pk2(acc[0], acc[1]); o.y = pk2(acc[2], acc[3]); *(u32x2*)(WS_(p, RNa) + (((ub * 4 + vbk) * 4 + rb) * 64 + lane) * 4) = o; }
                }
            }
        }
        lds_barrier();
#pragma unroll
        for (int q = 0; q < 4; ++q) { const int tl = w * 4 + q; const int tt = (tl & 15) >> 2, cbk = tl & 3; f32x4 acc = {0.f, 0.f, 0.f, 0.f};
            if (tl < 16) {
#pragma unroll
                for (int ks = 0; ks < 2; ++ks) acc = MFMA16(frag_rm(Ts, RC_LD, 16 * tt, 32 * ks, lane), frag_tr(As, RC_LD, 32 * ks, 16 * cbk, lane), acc);
                const int k = 16 * cbk + fr, kq = k & 31, g = (kq & 15) >> 2, j = (kq & 3) + ((kq >> 4) << 2);
#pragma unroll
                for (int r = 0; r < 4; ++r) Wimg[((tt * 2 + (k >> 5)) * 64 + g * 16 + 4 * fq + r) * 8 + j] = (bf16_t)f2bf(acc[r]);
            } else {
#pragma unroll
                for (int ks = 0; ks < 2; ++ks) acc = MFMA16(frag_rm(Ts, RC_LD, 16 * tt, 32 * ks, lane), frag_tr(X1, RC_LD, 32 * ks, 16 * cbk, lane), acc);
                { u32x2 o; o.x = pk2(acc[0], acc[1]); o.y = pk2(acc[2], acc[3]); *(u32x2*)(WS_(p, RUt) + (((ub * 4 + cbk) * 4 + tt) * 64 + lane) * 4) = o; }
            } }
        lds_barrier();
        *(u32x4*)(WS_(p, RWf) + ub * 4096 + tid * 8) = *(const LAS u32x4*)(Wimg + tid * 8);
    }
}

constexpr int RB_SLOT = 20992, RB_R = 6, RB_P = 5;
struct RbOpsA { bf16x8 wf[8]; u32x2 ut[4]; };
struct RbOpsB { bf16x8 bf[8]; u32x2 na[4]; f32x4 gc[4]; };
DEV void rb_read_a(const LAS unsigned char* slot, int lane, RbOpsA& O) {
#pragma unroll
    for (int f = 0; f < 8; ++f) O.wf[f] = *(const LAS bf16x8*)(slot + (f * 64 + lane) * 16);
#pragma unroll
    for (int q = 0; q < 4; ++q) O.ut[q] = *(const LAS u32x2*)(slot + 16384 + (q * 64 + lane) * 8);
}
DEV void rb_read_b(const LAS unsigned char* slot, int lane, RbOpsB& O) {
    const int fq = lane >> 4;
#pragma unroll
    for (int f = 0; f < 8; ++f) O.bf[f] = *(const LAS bf16x8*)(slot + 8192 + (f * 64 + lane) * 16);
#pragma unroll
    for (int q = 0; q < 4; ++q) { O.na[q] = *(const LAS u32x2*)(slot + 18432 + (q * 64 + lane) * 8); O.gc[q] = *(const LAS f32x4*)(slot + 20480 + (16 * q + 4 * fq) * 4); }
}
DEV void phase_rw_chb(const Params& p, int layer, LAS unsigned char* lds) {
    const int tid = tid_(), bid = bid_();
    if (bid >= 64) { if (layer == 0) convert_jobs<14, 16>(p, lds, 64, NB_ - 64); return; }
    const int lane = tid & 63, w = __builtin_amdgcn_readfirstlane(tid >> 6); const int head = bid & 15, vb = bid >> 4;
    auto issue = [&](int c) {
        const size_t ub = (size_t)c * 16 + head; LAS unsigned char* slot = lds + (c % RB_R) * RB_SLOT;
#pragma unroll
        for (int i = 0; i < 3; ++i) { const int pi = (w - 1) * 3 + i;
            if (pi < 8) __builtin_amdgcn_global_load_lds((const unsigned*)(WS_(p, RWf) + ub * 4096 + pi * 512 + lane * 8), (LAS unsigned*)(slot + pi * 1024), 16, 0, 0);
            else if (pi < 16) __builtin_amdgcn_global_load_lds((const unsigned*)(WS_(p, RBf) + ub * 4096 + (pi - 8) * 512 + lane * 8), (LAS unsigned*)(slot + 8192 + (pi - 8) * 1024), 16, 0, 0);
            else if (pi < 18) __builtin_amdgcn_global_load_lds((const unsigned*)(WS_(p, RUt) + (ub * 4 + vb) * 1024 + (pi - 16) * 512 + lane * 8), (LAS unsigned*)(slot + 16384 + (pi - 16) * 1024), 16, 0, 0);
            else if (pi < 20) __builtin_amdgcn_global_load_lds((const unsigned*)(WS_(p, RNa) + (ub * 4 + vb) * 1024 + (pi - 18) * 512 + lane * 8), (LAS unsigned*)(slot + 18432 + (pi - 18) * 1024), 16, 0, 0);
            else __builtin_amdgcn_global_load_lds((const unsigned*)(WS_(p, RGc) + ub * 64 + lane), (LAS unsigned*)(slot + 20480), 4, 0, 0);
        }
    };
    if (w > 0) {
#pragma unroll 1
        for (int c = 0; c < RB_P; ++c) issue(c);
        asm volatile("s_waitcnt vmcnt(9)" ::: "memory");
    }
    __builtin_amdgcn_s_barrier();
    f32x4 s[4]; for (int i = 0; i < 4; ++i) s[i] = (f32x4){0.f, 0.f, 0.f, 0.f};
    RbOpsA cur, nxt; RbOpsB cb_;
    if (w == 0) { rb_read_a(lds, lane, cur); }
#pragma unroll 1
    for (int c = 0; c < 256; ++c) {
        if (w > 0) {
            if (c + RB_P < 256) { issue(c + RB_P); asm volatile("s_waitcnt vmcnt(9)" ::: "memory"); }
            else asm volatile("s_waitcnt vmcnt(0)" ::: "memory");
        } else {
            const size_t ub = (size_t)c * 16 + head;
            rb_read_b(lds + (c % RB_R) * RB_SLOT, lane, cb_);
            rb_read_a(lds + ((c + 1 < 256 ? c + 1 : c) % RB_R) * RB_SLOT, lane, nxt);
            bf16x8 sb[2];
#pragma unroll
            for (int ks = 0; ks < 2; ++ks) { u32x4 o; o.x = pk2(s[2 * ks][0], s[2 * ks][1]); o.y = pk2(s[2 * ks][2], s[2 * ks][3]); o.z = pk2(s[2 * ks + 1][0], s[2 * ks + 1][1]); o.w = pk2(s[2 * ks + 1][2], s[2 * ks + 1][3]); sb[ks] = __builtin_bit_cast(bf16x8, o); *(u32x4*)(WS_(p, RS0) + (((ub * 4 + vb) * 2 + ks) * 64 + lane) * 8) = o; }
            f32x4 uu[4];
#pragma unroll
            for (int tt = 0; tt < 4; ++tt) { uu[tt] = (f32x4){bflo(cur.ut[tt].x), bfhi(cur.ut[tt].x), bflo(cur.ut[tt].y), bfhi(cur.ut[tt].y)}; uu[tt] = MFMA16(cur.wf[tt * 2], sb[0], uu[tt]); uu[tt] = MFMA16(cur.wf[tt * 2 + 1], sb[1], uu[tt]); }
            bf16x8 ubf[2];
#pragma unroll
            for (int ks = 0; ks < 2; ++ks) { u32x4 o; o.x = pk2(uu[2 * ks][0], uu[2 * ks][1]); o.y = pk2(uu[2 * ks][2], uu[2 * ks][3]); o.z = pk2(uu[2 * ks + 1][0], uu[2 * ks + 1][1]); o.w = pk2(uu[2 * ks + 1][2], uu[2 * ks + 1][3]); ubf[ks] = __builtin_bit_cast(bf16x8, o); *(u32x4*)(WS_(p, RUa) + (((ub * 4 + vb) * 2 + ks) * 64 + lane) * 8) = o; }
#pragma unroll
            for (int kt = 0; kt < 4; ++kt) { s[kt] = s[kt] * cb_.gc[kt] + (f32x4){bflo(cb_.na[kt].x), bfhi(cb_.na[kt].x), bflo(cb_.na[kt].y), bfhi(cb_.na[kt].y)}; s[kt] = MFMA16(cb_.bf[kt * 2], ubf[0], s[kt]); s[kt] = MFMA16(cb_.bf[kt * 2 + 1], ubf[1], s[kt]); }
            cur = nxt;
            asm volatile("s_waitcnt lgkmcnt(0)" ::: "memory");
        }
        __builtin_amdgcn_s_barrier();
    }
    asm volatile("s_waitcnt vmcnt(0)" ::: "memory");
}

DEV void phase_rw_chc(const Params& p, int j, LAS unsigned char* lds) {
    const int tid = tid_(), bid = bid_(); const int lane = tid & 63, w = tid >> 6; const int fr = lane & 15, fq = lane >> 4;
    LAS float* cum = (LAS float*)lds;
    LAS float* seg = cum + 64 * 64;
    LAS float* Ys = seg + 8 * 64;
    LAS bf16_t* Rs = (LAS bf16_t*)(Ys + 64 * 68);
    LAS bf16_t* Bs = Rs + 64 * RC_LD; LAS bf16_t* Ks = Bs + 64 * RC_LD; LAS bf16_t* Vs = Ks + 64 * RC_LD; LAS bf16_t* Arb = Vs + 64 * RC_LD; LAS bf16_t* Ark = Arb + 64 * RC_LD;
    float pwd[8], pr[8], pkr[8], pal[8], pv[8], pg[8];
    float kkw[8], kaw[8], rkw[8], lgw[8], lbw[8];
    { const size_t po = (size_t)j * D + (bid & 15) * 64 + (tid & 7) * 8; ld8(p.rw_k_k + po, kkw); ld8(p.rw_k_a + po, kaw); ld8(p.rw_r_k + po, rkw); ld8(p.rw_lnx_g + po, lgw); ld8(p.rw_lnx_b + po, lbw); }
    { const int c = bid >> 4, h = bid & 15; rc_load_wd(p, c * 64, h * 64, pwd);
      const size_t go = (size_t)(c * 64 + (tid >> 3)) * D + h * 64 + (tid & 7) * 8; ld8b(WS_(p, Rb) + go, pr); ld8b(WS_(p, Kb) + go, pkr); ld8b(WS_(p, Ab) + go, pal); ld8b(WS_(p, Vb) + go, pv); ld8b(WS_(p, Gb) + go, pg); }
    for (int u = bid; u < 4096; u += NB_) {
        const int c = u >> 4, h = u & 15; const int t0 = c * 64, cb = h * 64; const size_t ub = (size_t)c * 16 + h;
        const int tt = w & 3;
        bf16x8 ufr[2][2], sfr[2][2];
#pragma unroll
        for (int q = 0; q < 2; ++q)
#pragma unroll
            for (int ks = 0; ks < 2; ++ks) { const size_t o = (((ub * 4 + 2 * (w >> 2) + q) * 2 + ks) * 64 + lane) * 8;
                ufr[q][ks] = *(const bf16x8*)(WS_(p, RUa) + o); sfr[q][ks] = *(const bf16x8*)(WS_(p, RS0) + o); }
        lds_barrier();
        rc_cum_regs(pwd, cum, seg);
#ifdef DBL_CUM
        rc_cum_regs(pwd, cum, seg);
#endif
        const int t = tid >> 3, k8 = (tid & 7) * 8; const size_t go = (size_t)(t0 + t) * D + cb + k8;
        float v[8], gg[8]; float bc;
        {   float r[8], a[8], b[8], kh[8], ct[8];
#pragma unroll
            for (int e = 0; e < 8; ++e) { r[e] = pr[e]; v[e] = pv[e]; gg[e] = pg[e]; }
            lds8(cum + t * 64 + k8, ct);
            rc_prep8(pkr, pal, kkw, kaw, a, b, kh);
            if (u + NB_ < 4096) { const int un = u + NB_; const int cn = un >> 4, hn = un & 15; rc_load_wd(p, cn * 64, hn * 64, pwd);
                const size_t gn = (size_t)(cn * 64 + t) * D + hn * 64 + k8; ld8b(WS_(p, Rb) + gn, pr); ld8b(WS_(p, Kb) + gn, pkr); ld8b(WS_(p, Ab) + gn, pal); ld8b(WS_(p, Vb) + gn, pv); ld8b(WS_(p, Gb) + gn, pg); }
            bc = 0.f;
#pragma unroll
            for (int e = 0; e < 8; ++e) bc += r[e] * kh[e] * rkw[e];
            bc += __shfl_xor(bc, 1); bc += __shfl_xor(bc, 2); bc += __shfl_xor(bc, 4);
#pragma unroll
            for (int e = 0; e < 8; ++e) { const float ei = __expf(-ct[e]); r[e] *= __expf(ct[e]); b[e] *= ei; kh[e] *= ei; }
            *(LAS u32x4*)(Rs + t * RC_LD + k8) = pk8(r); *(LAS u32x4*)(Bs + t * RC_LD + k8) = pk8(b); *(LAS u32x4*)(Ks + t * RC_LD + k8) = pk8(kh); *(LAS u32x4*)(Vs + t * RC_LD + k8) = pk8(v);
        }
        lds_barrier();
#ifdef DBL_S3
#pragma unroll 1
        for (int rep_ = 0; rep_ < 2; ++rep_)
#endif
        {   const int tb = w >> 1;
#pragma unroll
            for (int ii = 0; ii < 2; ++ii) { const int ib = 2 * (w & 1) + ii;
                f32x4 ab = {0.f, 0.f, 0.f, 0.f}, ak = {0.f, 0.f, 0.f, 0.f};
                if (ib <= tb) {
#pragma unroll
                    for (int ks = 0; ks < 2; ++ks) { const bf16x8 af = frag_rm(Rs, RC_LD, 16 * tb, 32 * ks, lane);
                        ab = MFMA16(af, frag_rm(Bs, RC_LD, 16 * ib, 32 * ks, lane), ab); ak = MFMA16(af, frag_rm(Ks, RC_LD, 16 * ib, 32 * ks, lane), ak); } }
#pragma unroll
                for (int r = 0; r < 4; ++r) { const int tr = 16 * tb + 4 * fq + r, i = 16 * ib + fr; const bool keep = i <= tr;
                    Arb[tr * RC_LD + i] = (bf16_t)f2bf(keep ? ab[r] : 0.f); Ark[tr * RC_LD + i] = (bf16_t)f2bf(keep ? ak[r] : 0.f); } }
        }
        lds_barrier();
#ifdef DBL_Y
#pragma unroll 1
        for (int rep_ = 0; rep_ < 2; ++rep_)
#endif
#pragma unroll
        for (int q = 0; q < 2; ++q) { const int vbk = 2 * (w >> 2) + q; f32x4 acc = {0.f, 0.f, 0.f, 0.f};
#pragma unroll
            for (int ks = 0; ks < 2; ++ks) {
                acc = MFMA16(frag_rm_pi(Rs, RC_LD, 16 * tt, 32 * ks, lane), sfr[q][ks], acc);
                acc = MFMA16(frag_rm_pi(Arb, RC_LD, 16 * tt, 32 * ks, lane), ufr[q][ks], acc);
                acc = MFMA16(frag_rm(Ark, RC_LD, 16 * tt, 32 * ks, lane), frag_tr(Vs, RC_LD, 32 * ks, 16 * vbk, lane), acc); }
#pragma unroll
            for (int r = 0; r < 4; ++r) Ys[(16 * tt + 4 * fq + r) * 68 + 16 * vbk + fr] = acc[r]; }
        lds_barrier();
        {
            float y[8]; lds8(Ys + t * 68 + k8, y);
            float s1 = 0.f, s2 = 0.f;
#pragma unroll
            for (int e = 0; e < 8; ++e) { s1 += y[e]; s2 += y[e] * y[e]; }
            s1 += __shfl_xor(s1, 1); s1 += __shfl_xor(s1, 2); s1 += __shfl_xor(s1, 4); s2 += __shfl_xor(s2, 1); s2 += __shfl_xor(s2, 2); s2 += __shfl_xor(s2, 4);
            const float mean = s1 * (1.0f / 64.0f), var = s2 * (1.0f / 64.0f) - mean * mean; const float rs = rsqrtf(fmaxf(var, 0.f) + 64e-5f);
            float o[8];
#pragma unroll
            for (int e = 0; e < 8; ++e) o[e] = ((y[e] - mean) * rs * lgw[e] + lbw[e] + bc * v[e]) * gg[e];
            *(u32x4*)(WS_(p, YB) + go) = pk8(o);
        }
    }
}
DEV void phase_ln1(const Params& p, int layer, LAS unsigned char* lds) {
    const int tid = tid_(), bid = bid_(); (void)tid; (void)bid;
    const int lane = tid & 63, wid = tid >> 6; const int fr = lane & 15, fq = lane >> 4;
    LAS float* lgt = (LAS float*)lds;
    LAS int* cnt = (LAS int*)(lgt + 2 * 64 * 48);
    if (tid < 32) cnt[tid] = 0;
    const float* g = p.ln_g + ((size_t)layer * 2 + 0) * D; const float* be = p.ln_b + ((size_t)layer * 2 + 0) * D;
    const float* br = p.moe_b_route + layer * 32; const float* bg = p.moe_b_group + layer * 4;
    f32x4 gwv[4], bwv[4];
#pragma unroll
    for (int q = 0; q < 4; ++q) { gwv[q] = *(const f32x4*)(g + RCOL(q, lane)); bwv[q] = *(const f32x4*)(be + RCOL(q, lane)); }
    u32x2 rh[4], rm[4];
#pragma unroll
    for (int q = 0; q < 4; ++q) { rh[q] = *(const u32x2*)(WS_(p, Hb) + (size_t)(bid * 64 + wid * 8) * D + RCOL(q, lane)); rm[q] = *(const u32x2*)(WS_(p, MIXb) + (size_t)(bid * 64 + wid * 8) * D + RCOL(q, lane)); }
#pragma unroll 1
    for (int rr = 0; rr < 8; ++rr) {
        const int t = bid * 64 + wid * 8 + rr; const size_t ro = (size_t)t * D;
        f32x4 z[4], m[4];
#pragma unroll
        for (int q = 0; q < 4; ++q) { z[q] = (f32x4){bflo(rh[q].x), bfhi(rh[q].x), bflo(rh[q].y), bfhi(rh[q].y)}; m[q] = (f32x4){bflo(rm[q].x), bfhi(rm[q].x), bflo(rm[q].y), bfhi(rm[q].y)}; }
        { const size_t rn = (size_t)(rr < 7 ? t + 1 : t) * D;
#pragma unroll
          for (int q = 0; q < 4; ++q) { rh[q] = *(const u32x2*)(WS_(p, Hb) + rn + RCOL(q, lane)); rm[q] = *(const u32x2*)(WS_(p, MIXb) + rn + RCOL(q, lane)); } }
        float s = 0.f;
#pragma unroll
        for (int q = 0; q < 4; ++q) { z[q] = z[q] * ALPHA + m[q]; s += z[q][0] + z[q][1] + z[q][2] + z[q][3]; }
        const float mean = wave_sum(s) * (1.0f / D);
        float vs = 0.f;
#pragma unroll
        for (int q = 0; q < 4; ++q) { z[q] = z[q] - mean; vs += z[q][0] * z[q][0] + z[q][1] * z[q][1] + z[q][2] * z[q][2] + z[q][3] * z[q][3]; }
        const float rs = rsqrtf(wave_sum(vs) * (1.0f / D) + LN_EPS);
#pragma unroll
        for (int q = 0; q < 4; ++q) {
            st_bf4(WS_(p, H1b) + ro + RCOL(q, lane), z[q] * rs * gwv[q] + bwv[q]);
        }
    }
    asm volatile("s_waitcnt vmcnt(0)" ::: "memory");
    __syncthreads();
    {   const int rt = wid & 3, kh = wid >> 2;
        const bf16_t* Ab = WS_(p, H1b) + (size_t)(bid * 64 + 16 * rt + fr) * D + 512 * kh + 8 * fq;
        const bf16_t* Wb = WS_(p, moe_wr_t) + (size_t)layer * 48 * D + (size_t)fr * D + 512 * kh + 8 * fq;
        f32x4 acc[3]; for (int i = 0; i < 3; ++i) acc[i] = (f32x4){0.f, 0.f, 0.f, 0.f};
#pragma unroll 8
        for (int ks = 0; ks < 16; ++ks) {
            const bf16x8 af = *(const bf16x8*)(Ab + 32 * ks);
#pragma unroll
            for (int ct = 0; ct < 3; ++ct) acc[ct] = MFMA16(af, *(const bf16x8*)(Wb + (size_t)16 * ct * D + 32 * ks), acc[ct]);
        }
#pragma unroll
        for (int ct = 0; ct < 3; ++ct)
#pragma unroll
            for (int r = 0; r < 4; ++r) lgt[(kh * 64 + 16 * rt + 4 * fq + r) * 48 + 16 * ct + fr] = acc[ct][r];
    }
    __syncthreads();
    if (tid < 64) {
        const int t = bid * 64 + tid; const LAS float* L0 = lgt + tid * 48; const LAS float* L1 = lgt + (64 + tid) * 48;
        const float q0 = L0[32] + L1[32] + bg[0], q1 = L0[33] + L1[33] + bg[1], q2 = L0[34] + L1[34] + bg[2], q3 = L0[35] + L1[35] + bg[3];
        int gi = 0; float gm = q0;
        if (q1 > gm) { gm = q1; gi = 1; } if (q2 > gm) { gm = q2; gi = 2; } if (q3 > gm) { gm = q3; gi = 3; }
        const float den = __expf(q0 - gm) + __expf(q1 - gm) + __expf(q2 - gm) + __expf(q3 - gm);
        const float pgrp = __builtin_amdgcn_rcpf(den);
        float l1 = -INFINITY, l2 = -INFINITY; int i1 = 0, i2 = 0;
#pragma unroll 1
        for (int o = 0; o < 8; ++o) { const float v = L0[gi * 8 + o] + L1[gi * 8 + o] + br[gi * 8 + o];
            if (v > l1) { l2 = l1; i2 = i1; l1 = v; i1 = o; } else if (v > l2) { l2 = v; i2 = o; } }
        const float e2 = __expf(l2 - l1), inv = __builtin_amdgcn_rcpf(1.0f + e2);
        const int e0 = gi * 8 + i1, e1 = gi * 8 + i2;
        WS_(p, EIDX)[2 * t] = e0; WS_(p, EIDX)[2 * t + 1] = e1; WS_(p, GATE)[2 * t] = pgrp * inv; WS_(p, GATE)[2 * t + 1] = pgrp * e2 * inv;
        atomicAdd((int*)&cnt[e0], 1); atomicAdd((int*)&cnt[e1], 1);
    }
    __syncthreads();
    if (tid < 32) WS_(p, CNT)[bid * 32 + tid] = cnt[tid];
}

DEV void phase_moe_scatter(const Params& p, LAS unsigned char* lds) {
    const int tid = tid_(), bid = bid_(); (void)tid; (void)bid;
    const int lane = tid & 63, wid = tid >> 6;
    LAS int* part = (LAS int*)lds;
    LAS int* pre = part + 512;
    LAS int* base = pre + 512;
    LAS int* pst = base + 32;
    LAS int* dst = pst + 40;
    LAS int* eid = dst + 128;
    { const int e = tid & 31, part_i = tid >> 5; int tot = 0, prf = 0;
      for (int b = part_i * 16; b < part_i * 16 + 16; ++b) { const int c = WS_(p, CNT)[b * 32 + e]; tot += c; if (b < (int)bid) prf += c; }
      part[part_i * 32 + e] = tot; pre[part_i * 32 + e] = prf; }
    if (tid < 128) eid[tid] = WS_(p, EIDX)[bid * 128 + tid];
    lds_barrier();
    if (tid < 32) { int tot = 0, prf = 0; for (int i = 0; i < 16; ++i) { tot += part[i * 32 + tid]; prf += pre[i * 32 + tid]; } part[tid] = tot; pre[tid] = prf; }
    lds_barrier();
    if (tid == 0) { int acc = 0; for (int e = 0; e < 32; ++e) { pst[e] = acc; acc += ((part[e] + 255) >> 8) << 8; } pst[32] = acc;
        if (bid == 0) { for (int e = 0; e <= 32; ++e) WS_(p, TAB)[e] = pst[e]; WS_(p, TAB)[33] = acc >> 8;
            for (int e = 0; e < 32; ++e) for (int mt = pst[e] >> 8; mt < (pst[e + 1] >> 8); ++mt) WS_(p, TAB)[64 + mt] = e; } }
    lds_barrier();
    if (tid < 32) { int run = pst[tid] + pre[tid];
#pragma unroll 16
        for (int a = 0; a < 128; ++a) if (eid[a] == tid) dst[a] = run++; }
    lds_barrier();
    if (tid < 128) WS_(p, DEST)[bid * 128 + tid] = dst[tid];
#pragma unroll 4
    for (int a = wid * 16; a < wid * 16 + 16; ++a) {
        const int t = bid * 64 + (a >> 1); const int d = dst[a];
        const u32x4 v0 = *(const u32x4*)(WS_(p, H1b) + (size_t)t * D + lane * 8), v1 = *(const u32x4*)(WS_(p, H1b) + (size_t)t * D + 512 + lane * 8);
        *(u32x4*)(WS_(p, BUF) + (size_t)d * D + lane * 8) = v0; *(u32x4*)(WS_(p, BUF) + (size_t)d * D + 512 + lane * 8) = v1;
    }
}

template <int which> struct SchedMoe {
    const Params* p; int layer; const LAS int* tab;
    DEV bool next(int i, Unit& u) const {
        const int nmt = tab[33]; int pm, pn; if (!pg8::tile_order(i, NB_, bid_(), nmt, 4, pm, pn)) return false;
        const int row0 = pm * 256; const int e = tab[64 + pm];
        if constexpr (which == 0) { u.A = (const char*)(WS_(*p, BUF) + (size_t)row0 * D); u.B = (const char*)(WS_(*p, moe_w1_t) + ((size_t)layer * 32 + e) * 1024 * 1024 + (size_t)pn * 256 * 1024); }
        else { u.A = (const char*)(WS_(*p, ACT) + (size_t)row0 * 512); u.B = (const char*)(WS_(*p, moe_w2_t) + ((size_t)layer * 32 + e) * 1024 * 512 + (size_t)pn * 256 * 512); }
        u.row0 = row0; u.col0 = pn * 256; u.id = e; u.aux = 0; return true;
    }
};
struct EpiMoe1 {
    bf16_t* O;
    DEV void operator()(const AccT& acc, const Unit& u, int wr, int wc, int fr, int fq) const {
#pragma unroll
        for (int ai = 0; ai < 2; ++ai)
#pragma unroll
            for (int m = 0; m < 4; ++m)
#pragma unroll
                for (int n = 0; n < 2; ++n) {
                    const f32x4 gt = acc[ai][0][m][n], up = acc[ai][1][m][n]; f32x4 v;
                    for (int e = 0; e < 4; ++e) v[e] = siluf_(gt[e]) * up[e];
                    const int col = (u.col0 >> 1) + 32 * wc + 16 * n + 4 * fq;
                    st_bf4(O + (size_t)ACC_ROW(u, ai, m) * 512 + col, v); ACC_FENCE;
                }
    }
};
struct EpiMoe2 {
    bf16_t* O;
    DEV void operator()(const AccT& acc, const Unit& u, int wr, int wc, int fr, int fq) const {
        FOR_ACC(ai, bj, m, n) { st_bf4(O + (size_t)ACC_ROW(u, ai, m) * D + ACC_COL(u, bj, n), acc[ai][bj][m][n]); ACC_FENCE; }
    }
};

struct Ln2Raw { u32x2 h[4], a[4], b[4]; float g0, g1; };
DEV void ln2_issue(const Params& p, int t, int lane, Ln2Raw& R, int dpre, float gpre, int tbase) {
    const int i0 = 2 * (t - tbase); const int d0 = __shfl(dpre, i0), d1 = __shfl(dpre, i0 + 1); R.g0 = __shfl(gpre, i0); R.g1 = __shfl(gpre, i0 + 1);
#pragma unroll
    for (int q = 0; q < 4; ++q) { R.h[q] = *(const u32x2*)(WS_(p, H1b) + (size_t)t * D + RCOL(q, lane));
        R.a[q] = *(const u32x2*)(WS_(p, YBUF) + (size_t)d0 * D + RCOL(q, lane)); R.b[q] = *(const u32x2*)(WS_(p, YBUF) + (size_t)d1 * D + RCOL(q, lane)); }
}
DEV void ln2_finish(const Ln2Raw& R, const f32x4 (&gwv)[4], const f32x4 (&bwv)[4], f32x4 (&z)[4]) {
    float s = 0.f; const float g0 = R.g0, g1 = R.g1;
#pragma unroll
    for (int q = 0; q < 4; ++q) {
        z[q][0] = bflo(R.h[q].x) * ALPHA + g0 * bflo(R.a[q].x) + g1 * bflo(R.b[q].x); z[q][1] = bfhi(R.h[q].x) * ALPHA + g0 * bfhi(R.a[q].x) + g1 * bfhi(R.b[q].x);
        z[q][2] = bflo(R.h[q].y) * ALPHA + g0 * bflo(R.a[q].y) + g1 * bflo(R.b[q].y); z[q][3] = bfhi(R.h[q].y) * ALPHA + g0 * bfhi(R.a[q].y) + g1 * bfhi(R.b[q].y);
        s += z[q][0] + z[q][1] + z[q][2] + z[q][3];
    }
    const float mean = wave_sum(s) * (1.0f / D);
    float vs = 0.f;
#pragma unroll
    for (int q = 0; q < 4; ++q) { z[q] = z[q] - mean; vs += z[q][0] * z[q][0] + z[q][1] * z[q][1] + z[q][2] * z[q][2] + z[q][3] * z[q][3]; }
    const float rs = rsqrtf(wave_sum(vs) * (1.0f / D) + LN_EPS);
#pragma unroll
    for (int q = 0; q < 4; ++q) z[q] = z[q] * rs * gwv[q] + bwv[q];
}
DEV void phase_ln2(const Params& p, int layer, LAS unsigned char* lds) {
    const int tid = tid_(), bid = bid_(); const int lane = tid & 63, wid = tid >> 6; const int fr = lane & 15, fq = lane >> 4;
    const float* g = p.ln_g + ((size_t)layer * 2 + 1) * D; const float* be = p.ln_b + ((size_t)layer * 2 + 1) * D;
    const int nk = layer == DEPTH - 1 ? 3 : (layer + 1) % 3;
    const int nj = (layer + 1) / 3;
    LAS float* lgt = (LAS float*)lds;
    LAS float* w2 = lgt + 2 * 64 * 32;
    if (nk == 2) { for (int i = tid; i < 16 * 512; i += NTHR) w2[i] = p.gl_gk_w2[(size_t)nj * 16 * 512 + i]; }
    const int tfirst = bid * 64 + wid * 8;
    f32x4 z[4], zp[4], gwv[4], bwv[4];
#pragma unroll
    for (int q = 0; q < 4; ++q) { gwv[q] = *(const f32x4*)(g + RCOL(q, lane)); bwv[q] = *(const f32x4*)(be + RCOL(q, lane)); }
    Ln2Raw R[3];
    const int tbase = tfirst > 0 ? tfirst - 1 : 0;
    const int dpre = lane < 18 ? WS_(p, DEST)[2 * tbase + lane] : 0; const float gpre = lane < 18 ? WS_(p, GATE)[2 * tbase + lane] : 0.f;
    if (nk == 0) { if (tfirst > 0) { ln2_issue(p, tfirst - 1, lane, R[2], dpre, gpre, tbase); } }
    ln2_issue(p, tfirst, lane, R[0], dpre, gpre, tbase);
    ln2_issue(p, tfirst + 1, lane, R[1], dpre, gpre, tbase);
    if (nk == 0) { if (tfirst > 0) ln2_finish(R[2], gwv, bwv, zp); else { for (int q = 0; q < 4; ++q) zp[q] = (f32x4){0.f, 0.f, 0.f, 0.f}; } }
#pragma unroll
    for (int rr = 0; rr < 8; ++rr) {
        const int t = tfirst + rr; const size_t ro = (size_t)t * D;
        if (rr + 2 < 8) ln2_issue(p, t + 2, lane, R[(rr + 2) % 3], dpre, gpre, tbase);
        ln2_finish(R[rr % 3], gwv, bwv, z);
        if (nk == 3) {
#pragma unroll
            for (int q = 0; q < 4; ++q) *(f32x4*)(p.out + ro + RCOL(q, lane)) = z[q];
        } else store_row_bf(WS_(p, Hb) + ro, lane, z);
        if (nk == 0) {
            emit_mix6(p, nj, t, lane, z, zp);
#pragma unroll
            for (int q = 0; q < 4; ++q) zp[q] = z[q];
        }
    }
    if (nk == 1 || nk == 2) {
        asm volatile("s_waitcnt vmcnt(0)" ::: "memory");
        __syncthreads();
        const int nct = nk == 1 ? 2 : 1; const int rt = wid & 3, kh = wid >> 2;
        const bf16_t* Ab = WS_(p, Hb) + (size_t)(bid * 64 + 16 * rt + fr) * D + 512 * kh + 8 * fq;
        const bf16_t* Wb = (nk == 1 ? WS_(p, mb_dt_t) : WS_(p, gl_lr_t)) + (size_t)fr * D + 512 * kh + 8 * fq;
        f32x4 acc[2]; acc[0] = (f32x4){0.f, 0.f, 0.f, 0.f}; acc[1] = acc[0];
#pragma unroll 4
        for (int ks = 0; ks < 16; ++ks) {
            const bf16x8 af = *(const bf16x8*)(Ab + 32 * ks);
            acc[0] = MFMA16(af, *(const bf16x8*)(Wb + 32 * ks), acc[0]);
            if (nct == 2) acc[1] = MFMA16(af, *(const bf16x8*)(Wb + (size_t)16 * D + 32 * ks), acc[1]);
        }
#pragma unroll
        for (int ct = 0; ct < 2; ++ct)
#pragma unroll
            for (int r = 0; r < 4; ++r) lgt[(kh * 64 + 16 * rt + 4 * fq + r) * 32 + 16 * ct + fr] = acc[ct][r];
        __syncthreads();
        if (nk == 1) {
#pragma unroll
            for (int i = 0; i < 4; ++i) { const int idx = tid + i * NTHR; const int row = idx >> 5, o = idx & 31;
                WS_(p, DT)[(size_t)(bid * 64 + row) * 32 + o] = softplusf_(lgt[row * 32 + o] + lgt[(64 + row) * 32 + o] + p.mb_dt_bias[nj * 32 + o]); }
        } else {
            const int row = tid >> 3, c0 = (tid & 7) * 64; float lr[16];
#pragma unroll
            for (int o = 0; o < 16; ++o) lr[o] = lgt[row * 32 + o] + lgt[(64 + row) * 32 + o];
#pragma unroll 1
            for (int c4 = 0; c4 < 16; ++c4) { const int c = c0 + 4 * c4; f32x4 a = *(const f32x4*)(p.gl_gk_b + nj * 512 + c);
#pragma unroll
                for (int o = 0; o < 16; ++o) { const f32x4 wv = *(const LAS f32x4*)(w2 + o * 512 + c); a = a + wv * lr[o]; }
                f32x4 r;
#pragma unroll
                for (int e = 0; e < 4; ++e) r[e] = (fminf(a[e], 0.f) - __logf(1.0f + __expf(-fabsf(a[e])))) * (1.0f / 16.0f);
                *(f32x4*)(WS_(p, LA) + (size_t)(bid * 64 + row) * 512 + c) = r; }
        }
    }
}
constexpr int MB_PROJ = 5152;
struct SchedMbIn {
    const Params* p;
    DEV bool next(int i, Unit& u) const {
        int pm, pn; if (!pg8::tile_order(i, NB_, bid_(), 64, 20, pm, pn)) return false;
        u.A = (const char*)(WS_(*p, Hb) + (size_t)pm * 256 * D); u.B = (const char*)(WS_(*p, mb_win_t) + (size_t)pn * 256 * D); u.row0 = pm * 256; u.col0 = pn * 256; u.id = 0; u.aux = 0; return true;
    }
};
struct EpiMbIn {
    const Params* p;
    DEV void operator()(const AccT& acc, const Unit& u, int wr, int wc, int fr, int fq) const {
        const bool isz = u.col0 < 2048; bf16_t* O = WS_(*p, Z) + (isz ? (size_t)0 : (size_t)T * 2048 - 2048); const int ld = isz ? 2048 : 3072;
        FOR_ACC(ai, bj, m, n) { st_bf4(O + (size_t)ACC_ROW(u, ai, m) * ld + ACC_COL(u, bj, n), acc[ai][bj][m][n]); ACC_FENCE; }
    }
};
DEV void phase_mb_conv(const Params& p, int j) {
    const int tid = tid_(), bid = bid_(); (void)tid; (void)bid;
    if (tid >= 384) return;
    const int c0 = tid * 8; const int t0 = bid * 64;
    const float* cw = p.mb_conv_w + (size_t)j * 4 * 3072; const float* cb = p.mb_conv_b + (size_t)j * 3072;
    float w[4][8], b[8];
#pragma unroll
    for (int i = 0; i < 4; ++i) { const f32x4 a = *(const f32x4*)(cw + i * 3072 + c0), bb = *(const f32x4*)(cw + i * 3072 + c0 + 4); for (int e = 0; e < 4; ++e) { w[i][e] = a[e]; w[i][4 + e] = bb[e]; } }
    { const f32x4 a = *(const f32x4*)(cb + c0), bb = *(const f32x4*)(cb + c0 + 4); for (int e = 0; e < 4; ++e) { b[e] = a[e]; b[4 + e] = bb[e]; } }
    float x0[8], x1[8], x2[8], x3[8];
    auto ld = [&](int t, float (&x)[8]) {
        if (t < 0) { for (int e = 0; e < 8; ++e) x[e] = 0.f; return; }
        const u32x4 v = *(const u32x4*)(WS_(p, XBC) + (size_t)t * 3072 + c0);
        x[0] = bflo(v.x); x[1] = bfhi(v.x); x[2] = bflo(v.y); x[3] = bfhi(v.y); x[4] = bflo(v.z); x[5] = bfhi(v.z); x[6] = bflo(v.w); x[7] = bfhi(v.w);
    };
    ld(t0 - 3, x0); ld(t0 - 2, x1); ld(t0 - 1, x2);
#pragma unroll 4
    for (int tt = 0; tt < 64; ++tt) {
        ld(t0 + tt, x3);
        float o[8];
#pragma unroll
        for (int e = 0; e < 8; ++e) o[e] = siluf_(b[e] + w[0][e] * x0[e] + w[1][e] * x1[e] + w[2][e] * x2[e] + w[3][e] * x3[e]);
        u32x4 r; r.x = pk2(o[0], o[1]); r.y = pk2(o[2], o[3]); r.z = pk2(o[4], o[5]); r.w = pk2(o[6], o[7]);
        *(u32x4*)(WS_(p, XC) + (size_t)(t0 + tt) * 3072 + c0) = r;
#pragma unroll
        for (int e = 0; e < 8; ++e) { x0[e] = x1[e]; x1[e] = x2[e]; x2[e] = x3[e]; }
    }
}

DEV void mb_dacs(const Params& p, int j, int c, int g, LAS float* dts, LAS float* dacs) {
    const int tid = tid_(); const int lane = tid & 63, h = tid >> 6;
    const int hh = 8 * g + h; const float a = -__expf(p.mb_a_log[j * 32 + hh]);
    const float d0 = WS_(p, DT)[(size_t)(c * 128 + 2 * lane) * 32 + hh], d1 = WS_(p, DT)[(size_t)(c * 128 + 2 * lane + 1) * 32 + hh];
    const float a0 = d0 * a, a1 = d1 * a;
    float s = a0 + a1;
#pragma unroll
    for (int o = 1; o < 64; o <<= 1) { const float v = __shfl_up(s, o); if (lane >= o) s += v; }
    dts[h * 128 + 2 * lane] = d0; dts[h * 128 + 2 * lane + 1] = d1;
    dacs[h * 128 + 2 * lane] = s - a1; dacs[h * 128 + 2 * lane + 1] = s;
}
constexpr int LDB = 136;
constexpr int LDX = 72;
DEV void ld_tile128(const bf16_t* src, int gld, LAS bf16_t* dst) {
    const int tid = tid_();
    for (int i = tid; i < 128 * 16; i += NTHR) { const int r = i >> 4, c8 = (i & 15) * 8; *(LAS u32x4*)(dst + r * LDB + c8) = *(const u32x4*)(src + (size_t)r * gld + c8); }
}

DEV void phase_mb_states(const Params& p, int j, LAS unsigned char* lds) {
    const int tid = tid_(), bid = bid_(); (void)tid; (void)bid;
    const int lane = tid & 63, w = tid >> 6;
    LAS bf16_t* Bm = (LAS bf16_t*)lds;
    LAS bf16_t* Xh = Bm + 128 * LDB;
    LAS float* dts = (LAS float*)(Xh + 128 * LDX);
    LAS float* dacs = dts + 1024;
    for (int u = bid; u < 512; u += NB_) {
        const int c = u >> 2, g = u & 3; const int t0 = c * 128;
        lds_barrier();
        mb_dacs(p, j, c, g, dts, dacs);
        ld_tile128(WS_(p, XC) + (size_t)t0 * 3072 + 2048 + 128 * g, 3072, Bm);
        lds_barrier();
        if (tid < 8) WS_(p, CD)[(c * 32) + 8 * g + tid] = __expf(dacs[tid * 128 + 127]);
        bf16x8 bfr[4];
#pragma unroll
        for (int ks = 0; ks < 4; ++ks) bfr[ks] = frag_tr(Bm, LDB, 32 * ks, 16 * w, lane);
        for (int h = 0; h < 8; ++h) {
            { const int l = tid >> 2, p0 = (tid & 3) * 16; const float sc = dts[h * 128 + l] * __expf(dacs[h * 128 + 127] - dacs[h * 128 + l]);
              const bf16_t* src = WS_(p, XC) + (size_t)(t0 + l) * 3072 + 64 * (8 * g + h) + p0;
#pragma unroll
              for (int hf = 0; hf < 2; ++hf) { const u32x4 v = *(const u32x4*)(src + 8 * hf); u32x4 r;
                  r.x = pk2(bflo(v.x) * sc, bfhi(v.x) * sc); r.y = pk2(bflo(v.y) * sc, bfhi(v.y) * sc); r.z = pk2(bflo(v.z) * sc, bfhi(v.z) * sc); r.w = pk2(bflo(v.w) * sc, bfhi(v.w) * sc);
                  *(LAS u32x4*)(Xh + l * LDX + p0 + 8 * hf) = r; } }
            lds_barrier();
            f32x4 acc[4];
#pragma unroll
            for (int pb = 0; pb < 4; ++pb) { acc[pb] = (f32x4){0.f, 0.f, 0.f, 0.f};
#pragma unroll
                for (int ks = 0; ks < 4; ++ks) { const bf16x8 af = frag_tr(Xh, LDX, 32 * ks, 16 * pb, lane); acc[pb] = MFMA16(af, bfr[ks], acc[pb]); } }
            bf16_t* S = WS_(p, STATES) + (((size_t)c * 32 + 8 * g + h) * 64) * 128;
#pragma unroll
            for (int pb = 0; pb < 4; ++pb)
#pragma unroll
                for (int r = 0; r < 4; ++r) S[(size_t)(16 * pb + 4 * (lane >> 4) + r) * 128 + 16 * w + (lane & 15)] = (bf16_t)f2bf(acc[pb][r]);
            lds_barrier();
        }
    }
}
DEV void phase_mb_scan(const Params& p) {
    const int tid = tid_(), bid = bid_();
    if (tid >= 128) return;
    const int gid = bid * 128 + tid;
    const int n8 = gid & 15, pp = (gid >> 4) & 63, h = gid >> 10; const int n = 8 * n8;
    float r[8]; for (int e = 0; e < 8; ++e) r[e] = 0.f;
    const size_t eo = ((size_t)h * 64 + pp) * 128 + n;
    const size_t fo = (size_t)h * 64 * 128 + fragmajor_off(pp, n, 128);
#pragma unroll 8
    for (int c = 0; c < 128; ++c) {
        const u32x4 sr = *(const u32x4*)(WS_(p, STATES) + (size_t)c * 32 * 64 * 128 + eo);
        const float cd = WS_(p, CD)[c * 32 + h];
        u32x4 o; o.x = pk2(r[0], r[1]); o.y = pk2(r[2], r[3]); o.z = pk2(r[4], r[5]); o.w = pk2(r[6], r[7]);
        *(u32x4*)(WS_(p, PREV) + (size_t)c * 32 * 64 * 128 + fo) = o;
        r[0] = r[0] * cd + bflo(sr.x); r[1] = r[1] * cd + bfhi(sr.x); r[2] = r[2] * cd + bflo(sr.y); r[3] = r[3] * cd + bfhi(sr.y);
        r[4] = r[4] * cd + bflo(sr.z); r[5] = r[5] * cd + bfhi(sr.z); r[6] = r[6] * cd + bflo(sr.w); r[7] = r[7] * cd + bfhi(sr.w);
    }
}
DEV void phase_mb_out(const Params& p, int j, LAS unsigned char* lds) {
    const int tid = tid_(), bid = bid_(); (void)tid; (void)bid;
    const int lane = tid & 63, w = tid >> 6; const int fr = lane & 15, fq = lane >> 4;
    LAS bf16_t* Cm = (LAS bf16_t*)lds;
    LAS bf16_t* Bm = Cm + 128 * LDB;
    LAS bf16_t* Xh = Bm + 128 * LDB;
    LAS bf16_t* Mw = Xh + 128 * LDX;
    LAS float* dts = (LAS float*)(Mw + 8 * 16 * LDB);
    LAS float* dacs = dts + 1024;
    LAS bf16_t* Mme = Mw + w * 16 * LDB;
    for (int u = bid; u < 512; u += NB_) {
        const int c = u >> 2, g = u & 3; const int t0 = c * 128;
        lds_barrier();
        mb_dacs(p, j, c, g, dts, dacs);
        ld_tile128(WS_(p, XC) + (size_t)t0 * 3072 + 2048 + 512 + 128 * g, 3072, Cm);
        ld_tile128(WS_(p, XC) + (size_t)t0 * 3072 + 2048 + 128 * g, 3072, Bm);
        lds_barrier();
        f32x4 sc[8]; bf16x8 cf[4];
#pragma unroll
        for (int ks = 0; ks < 4; ++ks) cf[ks] = frag_rm(Cm, LDB, 16 * w, 32 * ks, lane);
#pragma unroll
        for (int sb = 0; sb < 8; ++sb) { sc[sb] = (f32x4){0.f, 0.f, 0.f, 0.f};
#pragma unroll
            for (int ks = 0; ks < 4; ++ks) sc[sb] = MFMA16(cf[ks], frag_rm(Bm, LDB, 16 * sb, 32 * ks, lane), sc[sb]); }
        float ssq = 0.f;
        const int rl = tid >> 2, p0 = (tid & 3) * 16;
        const LAS float* Yrow = (const LAS float*)(Mw + (rl >> 4) * 16 * LDB) + (rl & 15) * 68 + p0;
        LAS float* Yw = (LAS float*)Mme;
        u32x4 xraw[2], zraw[2], xnx[2], znx[2]; bf16x8 pfc[16];
#define MB_LOADH(HH, XR, ZR) do { const int hh_ = 8 * g + (HH); \
            XR[0] = *(const u32x4*)(WS_(p, XC) + (size_t)(t0 + rl) * 3072 + 64 * hh_ + p0); XR[1] = *(const u32x4*)(WS_(p, XC) + (size_t)(t0 + rl) * 3072 + 64 * hh_ + p0 + 8); \
            ZR[0] = *(const u32x4*)(WS_(p, Z) + (size_t)(t0 + rl) * 2048 + 64 * hh_ + p0); ZR[1] = *(const u32x4*)(WS_(p, Z) + (size_t)(t0 + rl) * 2048 + 64 * hh_ + p0 + 8); } while (0)
        MB_LOADH(0, xraw, zraw);
#pragma unroll 1
        for (int h = 0; h < 8; ++h) {
            const int hh = 8 * g + h;
            MB_LOADH(h < 7 ? h + 1 : h, xnx, znx);
            { const bf16_t* pv_ = WS_(p, PREV) + ((size_t)c * 32 + hh) * 64 * 128;
#pragma unroll
              for (int i_ = 0; i_ < 16; ++i_) pfc[i_] = *(const bf16x8*)(pv_ + ((size_t)i_ * 64 + lane) * 8); }
            { const float scl = dts[h * 128 + rl];
#pragma unroll
              for (int hf = 0; hf < 2; ++hf) { const u32x4 v = xraw[hf]; u32x4 r;
                  r.x = pk2(bflo(v.x) * scl, bfhi(v.x) * scl); r.y = pk2(bflo(v.y) * scl, bfhi(v.y) * scl); r.z = pk2(bflo(v.z) * scl, bfhi(v.z) * scl); r.w = pk2(bflo(v.w) * scl, bfhi(v.w) * scl);
                  *(LAS u32x4*)(Xh + rl * LDX + p0 + 8 * hf) = r; } }
            const u32x4 zraw0 = zraw[0], zraw1 = zraw[1];
            float dl[4];
#pragma unroll
            for (int r = 0; r < 4; ++r) dl[r] = dacs[h * 128 + 16 * w + 4 * fq + r];
#pragma unroll
            for (int sb = 0; sb < 8; ++sb) { const int s_ = 16 * sb + fr; const float ds = dacs[h * 128 + s_];
#pragma unroll
                for (int r = 0; r < 4; ++r) { const int l = 16 * w + 4 * fq + r; const float m = (s_ <= l) ? sc[sb][r] * __expf(dl[r] - ds) : 0.f; Mme[(4 * fq + r) * LDB + s_] = (bf16_t)f2bf(m); } }
            lds_barrier();
            bf16x8 mf[4];
#pragma unroll
            for (int ks = 0; ks < 4; ++ks) mf[ks] = frag_rm(Mme, LDB, 0, 32 * ks, lane);
            f32x4 yv[4];
#pragma unroll
            for (int pb = 0; pb < 4; ++pb) {
                f32x4 a = {0.f, 0.f, 0.f, 0.f}, o = {0.f, 0.f, 0.f, 0.f};
#pragma unroll
                for (int ks = 0; ks < 4; ++ks) {
                    a = MFMA16(mf[ks], frag_tr(Xh, LDX, 32 * ks, 16 * pb, lane), a);
                    o = MFMA16(cf[ks], pfc[pb * 4 + ks], o);
                }
#pragma unroll
                for (int r = 0; r < 4; ++r) a[r] += o[r] * __expf(dl[r]);
                yv[pb] = a;
            }
#pragma unroll
            for (int pb = 0; pb < 4; ++pb)
#pragma unroll
                for (int r = 0; r < 4; ++r) Yw[(4 * fq + r) * 68 + 16 * pb + fr] = yv[pb][r];
            lds_barrier();
            {
                const float dsk = p.mb_d[j * 32 + hh]; const float* ng = p.mb_norm_g + (size_t)j * 2048 + 64 * hh + p0;
                float y[16], xs[16], zz[16];
#pragma unroll
                for (int q = 0; q < 4; ++q) { const f32x4 t4 = *(const LAS f32x4*)(Yrow + 4 * q); y[4 * q] = t4[0]; y[4 * q + 1] = t4[1]; y[4 * q + 2] = t4[2]; y[4 * q + 3] = t4[3]; }
                xs[0] = bflo(xraw[0].x); xs[1] = bfhi(xraw[0].x); xs[2] = bflo(xraw[0].y); xs[3] = bfhi(xraw[0].y); xs[4] = bflo(xraw[0].z); xs[5] = bfhi(xraw[0].z); xs[6] = bflo(xraw[0].w); xs[7] = bfhi(xraw[0].w);
                xs[8] = bflo(xraw[1].x); xs[9] = bfhi(xraw[1].x); xs[10] = bflo(xraw[1].y); xs[11] = bfhi(xraw[1].y); xs[12] = bflo(xraw[1].z); xs[13] = bfhi(xraw[1].z); xs[14] = bflo(xraw[1].w); xs[15] = bfhi(xraw[1].w);
                zz[0] = bflo(zraw0.x); zz[1] = bfhi(zraw0.x); zz[2] = bflo(zraw0.y); zz[3] = bfhi(zraw0.y); zz[4] = bflo(zraw0.z); zz[5] = bfhi(zraw0.z); zz[6] = bflo(zraw0.w); zz[7] = bfhi(zraw0.w);
                zz[8] = bflo(zraw1.x); zz[9] = bfhi(zraw1.x); zz[10] = bflo(zraw1.y); zz[11] = bfhi(zraw1.y); zz[12] = bflo(zraw1.z); zz[13] = bfhi(zraw1.z); zz[14] = bflo(zraw1.w); zz[15] = bfhi(zraw1.w);
                float o[16];
#pragma unroll
                for (int q = 0; q < 4; ++q) { const f32x4 n4 = *(const f32x4*)(ng + 4 * q);
#pragma unroll
                    for (int e = 0; e < 4; ++e) { const int i = 4 * q + e; const float v = (y[i] + xs[i] * dsk) * siluf_(zz[i]); ssq += v * v; o[i] = v * n4[e]; } }
                bf16_t* dst = WS_(p, YB) + (size_t)(t0 + rl) * 2048 + 64 * hh + p0;
                u32x4 w0, w1; w0.x = pk2(o[0], o[1]); w0.y = pk2(o[2], o[3]); w0.z = pk2(o[4], o[5]); w0.w = pk2(o[6], o[7]); w1.x = pk2(o[8], o[9]); w1.y = pk2(o[10], o[11]); w1.z = pk2(o[12], o[13]); w1.w = pk2(o[14], o[15]);
                *(u32x4*)dst = w0; *(u32x4*)(dst + 8) = w1;
            }
            xraw[0] = xnx[0]; xraw[1] = xnx[1]; zraw[0] = znx[0]; zraw[1] = znx[1];
            lds_barrier();
        }
#undef MB_LOADH
        ssq += __shfl_xor(ssq, 1); ssq += __shfl_xor(ssq, 2);
        const float rstd = rsqrtf(ssq * (1.0f / 512.0f) + 1e-5f);
#pragma unroll 1
        for (int h = 0; h < 8; ++h) {
            bf16_t* dst = WS_(p, YB) + (size_t)(t0 + rl) * 2048 + 64 * (8 * g + h) + p0;
#pragma unroll
            for (int hf = 0; hf < 2; ++hf) { const u32x4 v = *(const u32x4*)(dst + 8 * hf); u32x4 r;
                r.x = pk2(bflo(v.x) * rstd, bfhi(v.x) * rstd); r.y = pk2(bflo(v.y) * rstd, bfhi(v.y) * rstd); r.z = pk2(bflo(v.z) * rstd, bfhi(v.z) * rstd); r.w = pk2(bflo(v.w) * rstd, bfhi(v.w) * rstd);
                *(u32x4*)(dst + 8 * hf) = r; }
        }
    }
}
constexpr int GL_PROJ = 3088;
constexpr int LDV = 264;
struct SchedGlIn {
    const Params* p;
    DEV bool next(int i, Unit& u) const {
        int pm, pn; if (!pg8::tile_order(i, NB_, bid_(), 64, 12, pm, pn)) return false;
        u.A = (const char*)(WS_(*p, Hb) + (size_t)pm * 256 * D); u.B = (const char*)(WS_(*p, gl_win_t) + (size_t)pn * 256 * D); u.row0 = pm * 256; u.col0 = pn * 256; u.id = 0; u.aux = 0; return true;
    }
};
struct EpiGlIn {
    const Params* p;
    DEV void operator()(const AccT& acc, const Unit& u, int wr, int wc, int fr, int fq) const {
        FOR_ACC(ai, bj, m, n) { st_bf4(WS_(*p, QKVG) + (size_t)ACC_ROW(u, ai, m) * 3072 + ACC_COL(u, bj, n), acc[ai][bj][m][n]); ACC_FENCE; }
    }
};
DEV void gl_bcs(const Params& p, int n, int h, LAS float* bcs) {
    const int tid = tid_();
    for (int i = tid; i < 64 * 32; i += NTHR) { const int r = i >> 5, c4 = (i & 31) * 4; *(LAS f32x4*)(bcs + r * 128 + c4) = *(const f32x4*)(WS_(p, LA) + (size_t)(n * 64 + r) * 512 + 128 * h + c4); }
    lds_barrier();
    if (tid < 128) { float s = 0.f; for (int r = 0; r < 64; ++r) { s += bcs[r * 128 + tid]; bcs[r * 128 + tid] = s; } }
    lds_barrier();
}
DEV void phase_gl_kv(const Params& p, LAS unsigned char* lds) {
    const int tid = tid_(), bid = bid_(); (void)tid; (void)bid;
    const int lane = tid & 63, w = tid >> 6;
    LAS float* bcs = (LAS float*)lds;
    LAS bf16_t* Ke = (LAS bf16_t*)(bcs + 64 * 128);
    LAS bf16_t* Vs = Ke + 64 * LDB;
    for (int u = bid; u < 1024; u += NB_) {
        const int n = u >> 2, h = u & 3; const int t0 = n * 64;
        lds_barrier();
        gl_bcs(p, n, h, bcs);
        for (int i = tid; i < 64 * 16; i += NTHR) { const int r = i >> 4, c8 = (i & 15) * 8;
            const u32x4 v = *(const u32x4*)(WS_(p, QKVG) + (size_t)(t0 + r) * 3072 + 512 + 128 * h + c8); float f[8];
            f[0] = bflo(v.x); f[1] = bfhi(v.x); f[2] = bflo(v.y); f[3] = bfhi(v.y); f[4] = bflo(v.z); f[5] = bfhi(v.z); f[6] = bflo(v.w); f[7] = bfhi(v.w);
#pragma unroll
            for (int e = 0; e < 8; ++e) f[e] *= __expf(bcs[63 * 128 + c8 + e] - bcs[r * 128 + c8 + e]);
            u32x4 o; o.x = pk2(f[0], f[1]); o.y = pk2(f[2], f[3]); o.z = pk2(f[4], f[5]); o.w = pk2(f[6], f[7]);
            *(LAS u32x4*)(Ke + r * LDB + c8) = o; }
        for (int i = tid; i < 64 * 32; i += NTHR) { const int r = i >> 5, c8 = (i & 31) * 8; *(LAS u32x4*)(Vs + r * LDV + c8) = *(const u32x4*)(WS_(p, QKVG) + (size_t)(t0 + r) * 3072 + 1024 + 256 * h + c8); }
        if (tid < 128) WS_(p, CDG)[((size_t)n * 4 + h) * 128 + tid] = __expf(bcs[63 * 128 + tid]);
        lds_barrier();
        bf16x8 af[2];
#pragma unroll
        for (int ks = 0; ks < 2; ++ks) af[ks] = frag_tr(Ke, LDB, 32 * ks, 16 * w, lane);
        bf16_t* O = WS_(p, STATES) + (((size_t)n * 4 + h) * 128) * 256;
#pragma unroll
        for (int vb = 0; vb < 16; ++vb) {
            f32x4 acc = {0.f, 0.f, 0.f, 0.f};
#pragma unroll
            for (int ks = 0; ks < 2; ++ks) acc = MFMA16(af[ks], frag_tr(Vs, LDV, 32 * ks, 16 * vb, lane), acc);
            { u32x2 o; o.x = pk2(acc[0], acc[1]); o.y = pk2(acc[2], acc[3]); *(u32x2*)(O + (size_t)(16 * vb + (lane & 15)) * 128 + 16 * w + 4 * (lane >> 4)) = o; }
        }
    }
}
DEV void phase_gl_scan(const Params& p) {
    const int tid = tid_(), bid = bid_();
    if (tid >= 64) return;
    const int gid = bid * 64 + tid;
    const int k8 = gid & 15, v = (gid >> 4) & 255, h = gid >> 12; const int k = 8 * k8;
    float r[8]; for (int e = 0; e < 8; ++e) r[e] = 0.f;
    const size_t fo = (size_t)h * 128 * 256 + fragmajor_off(v, k, 128);
#pragma unroll 8
    for (int n = 0; n < 256; ++n) {
        const u32x4 sr = *(const u32x4*)(WS_(p, STATES) + (((size_t)n * 4 + h) * 256 + v) * 128 + k);
        const f32x4 c0 = *(const f32x4*)(WS_(p, CDG) + ((size_t)n * 4 + h) * 128 + k), c1 = *(const f32x4*)(WS_(p, CDG) + ((size_t)n * 4 + h) * 128 + k + 4);
        u32x4 o; o.x = pk2(r[0], r[1]); o.y = pk2(r[2], r[3]); o.z = pk2(r[4], r[5]); o.w = pk2(r[6], r[7]);
        *(u32x4*)(WS_(p, PREV) + (size_t)n * 4 * 128 * 256 + fo) = o;
        r[0] = r[0] * c0[0] + bflo(sr.x); r[1] = r[1] * c0[1] + bfhi(sr.x); r[2] = r[2] * c0[2] + bflo(sr.y); r[3] = r[3] * c0[3] + bfhi(sr.y);
        r[4] = r[4] * c1[0] + bflo(sr.z); r[5] = r[5] * c1[1] + bfhi(sr.z); r[6] = r[6] * c1[2] + bflo(sr.w); r[7] = r[7] * c1[3] + bfhi(sr.w);
    }
}
DEV void phase_gl_out(const Params& p, int j, LAS unsigned char* lds) {
    const int tid = tid_(), bid = bid_(); (void)tid; (void)bid;
    const int lane = tid & 63, w = tid >> 6; const int fr = lane & 15, fq = lane >> 4;
    LAS float* bcs = (LAS float*)lds;
    LAS bf16_t* Qs = (LAS bf16_t*)(bcs + 64 * 128);
    LAS bf16_t* Ks = Qs + 64 * LDB;
    LAS bf16_t* Vs = Ks + 64 * LDB;
    LAS bf16_t* At = Vs + 64 * LDV;
    LAS float* red = (LAS float*)(At + 64 * LDX);
    for (int u = bid; u < 1024; u += NB_) {
        const int n = u >> 2, h = u & 3; const int t0 = n * 64;
        lds_barrier();
        gl_bcs(p, n, h, bcs);
        for (int i = tid; i < 64 * 16; i += NTHR) { const int r = i >> 4, c8 = (i & 15) * 8;
            const u32x4 vq = *(const u32x4*)(WS_(p, QKVG) + (size_t)(t0 + r) * 3072 + 128 * h + c8), vk = *(const u32x4*)(WS_(p, QKVG) + (size_t)(t0 + r) * 3072 + 512 + 128 * h + c8);
            float fq_[8], fk_[8];
            fq_[0] = bflo(vq.x); fq_[1] = bfhi(vq.x); fq_[2] = bflo(vq.y); fq_[3] = bfhi(vq.y); fq_[4] = bflo(vq.z); fq_[5] = bfhi(vq.z); fq_[6] = bflo(vq.w); fq_[7] = bfhi(vq.w);
            fk_[0] = bflo(vk.x); fk_[1] = bfhi(vk.x); fk_[2] = bflo(vk.y); fk_[3] = bfhi(vk.y); fk_[4] = bflo(vk.z); fk_[5] = bfhi(vk.z); fk_[6] = bflo(vk.w); fk_[7] = bfhi(vk.w);
#pragma unroll
            for (int e = 0; e < 8; ++e) { const float b = bcs[r * 128 + c8 + e]; fq_[e] *= __expf(b) * 0.08838834764831845f; fk_[e] *= __expf(-b); }
            u32x4 o; o.x = pk2(fq_[0], fq_[1]); o.y = pk2(fq_[2], fq_[3]); o.z = pk2(fq_[4], fq_[5]); o.w = pk2(fq_[6], fq_[7]);
            *(LAS u32x4*)(Qs + r * LDB + c8) = o;
            o.x = pk2(fk_[0], fk_[1]); o.y = pk2(fk_[2], fk_[3]); o.z = pk2(fk_[4], fk_[5]); o.w = pk2(fk_[6], fk_[7]);
            *(LAS u32x4*)(Ks + r * LDB + c8) = o; }
        for (int i = tid; i < 64 * 32; i += NTHR) { const int r = i >> 5, c8 = (i & 31) * 8; *(LAS u32x4*)(Vs + r * LDV + c8) = *(const u32x4*)(WS_(p, QKVG) + (size_t)(t0 + r) * 3072 + 1024 + 256 * h + c8); }
        lds_barrier();
        { const int ib = w >> 1;
#pragma unroll
          for (int jj = 0; jj < 2; ++jj) { const int jb = 2 * (w & 1) + jj; f32x4 a = {0.f, 0.f, 0.f, 0.f};
#pragma unroll
              for (int ks = 0; ks < 4; ++ks) a = MFMA16(frag_rm(Qs, LDB, 16 * ib, 32 * ks, lane), frag_rm(Ks, LDB, 16 * jb, 32 * ks, lane), a);
#pragma unroll
              for (int r = 0; r < 4; ++r) { const int i = 16 * ib + 4 * fq + r, jx = 16 * jb + fr; At[i * LDX + jx] = (bf16_t)f2bf(jx <= i ? a[r] : 0.f); } } }
        lds_barrier();
        f32x4 o[4][2];
        const bf16_t* pv = WS_(p, PREV) + ((size_t)n * 4 + h) * 128 * 256;
#pragma unroll
        for (int vv = 0; vv < 2; ++vv) { const int vb = 2 * w + vv;
            bf16x8 bi[2], bp[4];
#pragma unroll
            for (int ks = 0; ks < 2; ++ks) bi[ks] = frag_tr(Vs, LDV, 32 * ks, 16 * vb, lane);
#pragma unroll
            for (int ks = 0; ks < 4; ++ks) bp[ks] = *(const bf16x8*)(pv + ((size_t)(vb * 4 + ks) * 64 + lane) * 8);
#pragma unroll
            for (int ib = 0; ib < 4; ++ib) { f32x4 a = {0.f, 0.f, 0.f, 0.f};
#pragma unroll
                for (int ks = 0; ks < 2; ++ks) a = MFMA16(frag_rm(At, LDX, 16 * ib, 32 * ks, lane), bi[ks], a);
#pragma unroll
                for (int ks = 0; ks < 4; ++ks) a = MFMA16(frag_rm(Qs, LDB, 16 * ib, 32 * ks, lane), bp[ks], a);
                o[ib][vv] = a; } }
#pragma unroll
        for (int ib = 0; ib < 4; ++ib)
#pragma unroll
            for (int r = 0; r < 4; ++r) { float s = o[ib][0][r] * o[ib][0][r] + o[ib][1][r] * o[ib][1][r]; s = sum16(s); if (fr == 0) red[w * 64 + 16 * ib + 4 * fq + r] = s; }
        lds_barrier();
        {   LAS bf16_t* Os = (LAS bf16_t*)bcs;
#pragma unroll
            for (int ib = 0; ib < 4; ++ib)
#pragma unroll
                for (int vv = 0; vv < 2; ++vv)
#pragma unroll
                    for (int r = 0; r < 4; ++r) Os[(16 * ib + 4 * fq + r) * LDV + 32 * w + 16 * vv + fr] = (bf16_t)f2bf(o[ib][vv][r]);
            lds_barrier();
            const int row = tid >> 3, c0 = (tid & 7) * 32; const int t = t0 + row; float s = 0.f;
#pragma unroll
            for (int ww = 0; ww < 8; ++ww) s += red[ww * 64 + row];
            const float rs = rsqrtf(s * (1.0f / 256.0f) + 1e-5f);
#pragma unroll
            for (int q = 0; q < 4; ++q) {
                const u32x4 ov = *(const LAS u32x4*)(Os + row * LDV + c0 + 8 * q), gv = *(const u32x4*)(WS_(p, QKVG) + (size_t)t * 3072 + 2048 + 256 * h + c0 + 8 * q);
                const f32x4 n0 = *(const f32x4*)(p.gl_norm_g + j * 256 + c0 + 8 * q), n1 = *(const f32x4*)(p.gl_norm_g + j * 256 + c0 + 8 * q + 4);
                float r8[8];
                r8[0] = bflo(ov.x) * rs * n0[0] * siluf_(bflo(gv.x)); r8[1] = bfhi(ov.x) * rs * n0[1] * siluf_(bfhi(gv.x)); r8[2] = bflo(ov.y) * rs * n0[2] * siluf_(bflo(gv.y)); r8[3] = bfhi(ov.y) * rs * n0[3] * siluf_(bfhi(gv.y));
                r8[4] = bflo(ov.z) * rs * n1[0] * siluf_(bflo(gv.z)); r8[5] = bfhi(ov.z) * rs * n1[1] * siluf_(bfhi(gv.z)); r8[6] = bflo(ov.w) * rs * n1[2] * siluf_(bflo(gv.w)); r8[7] = bfhi(ov.w) * rs * n1[3] * siluf_(bfhi(gv.w));
                u32x4 wv; wv.x = pk2(r8[0], r8[1]); wv.y = pk2(r8[2], r8[3]); wv.z = pk2(r8[4], r8[5]); wv.w = pk2(r8[6], r8[7]);
                *(u32x4*)(WS_(p, YB) + (size_t)t * D + 256 * h + c0 + 8 * q) = wv;
            }
        }
    }
}
#define XB_TMO      128
#define XB_XCNT(j)  (256  + 64 * (j))
#define XB_XSUB(j)  (1280 + 64 * (j))
#define XB_XGEN(j)  (2304 + 64 * (j))
#define XB_TOP      3328
#define XB_TOPGEN   3392
#define XCD_BAR_WORDS 3456
#define XB_SPIN_CAP (1u << 22)
DEV unsigned xb_ld(unsigned* p)              { return __hip_atomic_load(p, __ATOMIC_RELAXED, __HIP_MEMORY_SCOPE_AGENT); }
DEV unsigned xb_add(unsigned* p, unsigned v) { return __hip_atomic_fetch_add(p, v, __ATOMIC_RELAXED, __HIP_MEMORY_SCOPE_AGENT); }
DEV unsigned xb_xcc_id() { return (unsigned)__builtin_amdgcn_s_getreg((3 << 11) | 20) & 0xFu; }
#define XB_SPIN(cond, bar) do { unsigned _sp = 0; while (cond) { __builtin_amdgcn_s_sleep(1); \
    if ((++_sp & 255u) == 0u) { if (xb_ld(&(bar)[XB_TMO])) break; if (_sp > XB_SPIN_CAP) { atomicAdd(&(bar)[XB_TMO], 1u); break; } } } } while (0)
struct XcdBarrier { unsigned* bar; unsigned x; volatile LAS unsigned* st; };
DEV XcdBarrier xcd_barrier_post(unsigned* bar, volatile LAS unsigned* st) {
    XcdBarrier b; b.bar = bar; b.x = xb_xcc_id(); b.st = st;
    if (threadIdx.x == 0) (void)xb_add(&bar[XB_XCNT(b.x)], 1u);
    return b;
}
DEV void xcd_barrier_complete(unsigned* bar, unsigned x, unsigned& nloc, unsigned& nx) {
    const unsigned G = gridDim.x * gridDim.y * gridDim.z;
    unsigned sum, cnt, mine, sp = 0u;
    for (;;) {
        sum = 0u; cnt = 0u; mine = 0u;
#pragma unroll
        for (unsigned j = 0; j < 16; ++j) { const unsigned c = xb_ld(&bar[XB_XCNT(j)]); sum += c; cnt += (c > 0u) ? 1u : 0u; mine = (j == x) ? c : mine; }
        if (sum == G) break;
        __builtin_amdgcn_s_sleep(1);
        if ((++sp & 255u) == 0u) { if (xb_ld(&bar[XB_TMO])) break; if (sp > XB_SPIN_CAP) { atomicAdd(&bar[XB_TMO], 1u); break; } }
    }
    nloc = mine > 0u ? mine : 1u; nx = cnt > 0u ? cnt : 1u;
}
DEV void xcd_barrier(const XcdBarrier& b) {
    asm volatile("s_waitcnt vmcnt(0)" ::: "memory");
    __syncthreads();
    if (threadIdx.x == 0) {
        unsigned* bar = b.bar;
        __builtin_amdgcn_s_waitcnt(0);
        unsigned nloc = b.st[0], nx = b.st[1];
        if (nloc == 0u) { xcd_barrier_complete(bar, b.x, nloc, nx); b.st[0] = nloc; b.st[1] = nx; }
        const unsigned old = xb_add(&bar[XB_XSUB(b.x)], 1u);
        const unsigned gen = old / nloc;
        if (old + 1u == (gen + 1u) * nloc) {
            __builtin_amdgcn_fence(__ATOMIC_RELEASE, "agent");
            asm volatile("s_waitcnt vmcnt(0)" ::: "memory");
            const unsigned og = xb_add(&bar[XB_TOP], 1u);
            const unsigned tg = og / nx;
            if (og + 1u == (tg + 1u) * nx) xb_add(&bar[XB_TOPGEN], 1u);
            else XB_SPIN(xb_ld(&bar[XB_TOPGEN]) == tg, bar);
            __builtin_amdgcn_fence(__ATOMIC_ACQUIRE, "agent");
            xb_add(&bar[XB_XGEN(b.x)], 1u);
            asm volatile("s_waitcnt vmcnt(0)" ::: "memory");
        } else {
            XB_SPIN(xb_ld(&bar[XB_XGEN(b.x)]) == gen, bar);
            __builtin_amdgcn_fence(__ATOMIC_ACQUIRE, "agent");
            asm volatile("s_waitcnt vmcnt(0)" ::: "memory");
        }
    }
    __syncthreads();
}

DEV LAS int* moe_tab_to_lds(const Params& p, LAS unsigned char* lds) {
    LAS int* tab = (LAS int*)(lds + pg8::STAGE_BYTES);
    const int tid = tid_();
    if (tid < 256) tab[tid] = __hip_atomic_load(WS_(p, TAB) + tid, __ATOMIC_RELAXED, __HIP_MEMORY_SCOPE_AGENT);
    __syncthreads();
    return tab;
}
DEV void run_phase(const Params& pin, int op, int arg, LAS unsigned char* lds) {
    Params p = pin; { size_t z_ = 0; asm volatile("" : "+s"(z_)); p.ws = pin.ws + z_; }
    const int layer = arg; const int jj = layer / 3;
#ifdef ONLY_OP
    if (op != ONLY_OP) return;
#endif
#ifdef OPMASK
    if (!((OPMASK >> op) & 1ull)) return;
#endif
    switch (op) {
    case OP_CONVERT: phase_pre0(p); phase_convert(p, lds);
#ifdef DBG
        if (blockIdx.x == 0 && threadIdx.x < 24) WS_(p, TAB)[200 + threadIdx.x] = 0;
#endif
        break;
    case OP_PRE0: break;
    case OP_RW_GEMM1: { SchedRW1 S{&p, jj}; EpiRW1 E{&p}; pg8::gemm_phase(lds, 1024, S, E); } break;
    case OP_RW_GEMM2: { SchedRW2 S{&p, jj}; EpiRW2 E{&p, jj}; pg8::gemm_phase(lds, 256, S, E); } break;
    case OP_RW_CHA: phase_rw_cha(p, jj, lds); break;
    case OP_RW_CHB: phase_rw_chb(p, layer, lds); break;
    case OP_RW_CHC: phase_rw_chc(p, jj, lds); break;
    case OP_RW_OUT: { SchedOut S{WS_(p, YB), WS_(p, rw_wo_t) + (size_t)jj * D * D, 1024}; EpiOut E{WS_(p, MIXb)}; pg8::gemm_phase(lds, 1024, S, E); } break;
    case OP_LN1: phase_ln1(p, layer, lds); break;
    case OP_MOE_SCATTER: phase_moe_scatter(p, lds); break;
    case OP_MOE_GEMM1: { LAS int* tab = moe_tab_to_lds(p, lds); SchedMoe<0> S{&p, layer, tab}; EpiMoe1 E{WS_(p, ACT)}; pg8::gemm_phase(lds, 1024, S, E); } break;
    case OP_MOE_GEMM2: { LAS int* tab = moe_tab_to_lds(p, lds); SchedMoe<1> S{&p, layer, tab}; EpiMoe2 E{WS_(p, YBUF)}; pg8::gemm_phase(lds, 512, S, E); } break;
    case OP_LN2: phase_ln2(p, layer, lds); break;
    case OP_MB_GEMM_IN: { SchedMbIn S{&p}; EpiMbIn E{&p}; pg8::gemm_phase(lds, 1024, S, E); } break;
    case OP_MB_CONV: phase_mb_conv(p, jj); break;
    case OP_MB_STATES: phase_mb_states(p, jj, lds); break;
    case OP_MB_SCAN: phase_mb_scan(p); break;
    case OP_MB_OUT: phase_mb_out(p, jj, lds); break;
    case OP_MB_GEMM_OUT: { SchedOut S{WS_(p, YB), WS_(p, mb_wout_t) + (size_t)jj * D * 2048, 2048}; EpiOut E{WS_(p, MIXb)}; pg8::gemm_phase(lds, 2048, S, E); } break;
    case OP_GL_GEMM_IN: { SchedGlIn S{&p}; EpiGlIn E{&p}; pg8::gemm_phase(lds, 1024, S, E); } break;
    case OP_GL_KV: phase_gl_kv(p, lds); break;
    case OP_GL_SCAN: phase_gl_scan(p); break;
    case OP_GL_OUT: phase_gl_out(p, jj, lds); break;
    case OP_GL_GEMM_OUT: { SchedOut S{WS_(p, YB), WS_(p, gl_wout_t) + (size_t)jj * D * D, 1024}; EpiOut E{WS_(p, MIXb)}; pg8::gemm_phase(lds, 1024, S, E); } break;
    default: break;
    }
}

constexpr int NPHASES = 1 + 11 + 11 + 10 + 11;
DEV void decode_phase(int ph, int& op, int& layer) {
    if (ph < 1) { op = OP_CONVERT; layer = 0; return; }
    int q = ph - 1; layer = 0;
    if (q >= 11) { q -= 11; layer = 1; if (q >= 11) { q -= 11; layer = 2; if (q >= 10) { q -= 10; layer = 3; } } }
    const int kind = layer % 3; const int nmix = kind == 2 ? 5 : 6;
    if (q < nmix) op = (kind == 0 ? OP_RW_GEMM1 : kind == 1 ? OP_MB_GEMM_IN : OP_GL_GEMM_IN) + q;
    else op = OP_LN1 + (q - nmix);
}

#define X(t, n) t n##_,
template <bool COOP>
__global__ void __launch_bounds__(NTHR, 2) mega(PARAM_LIST(X) const int ph0, const int ph1) {
#undef X
    Params p;
#define X(t, n) p.n = n##_;
    PARAM_LIST(X)
#undef X

    extern __shared__ __attribute__((aligned(16))) unsigned char smem_raw[];
    LAS unsigned char* lds = (LAS unsigned char*)smem_raw;
    if constexpr (COOP) {
        volatile LAS unsigned* st = (volatile LAS unsigned*)(lds + LDS_BYTES - 16);
        if (threadIdx.x == 0) { st[0] = 0u; st[1] = 0u; }
        __syncthreads();
        XcdBarrier xb = xcd_barrier_post(WS_(p, bar), st);
        if (ph0 < 0) cg::this_grid().sync();
        for (int ph = ph0; ph < ph1; ++ph) {
            int op, arg; decode_phase(ph, op, arg);
#ifdef REPEAT_MASK
            const int reps = 1 + (int)((REPEAT_MASK >> op) & 1ull);
#else
            const int reps = 1;
#endif
#pragma unroll 1
            for (int rep = 0; rep < reps; ++rep) {
                run_phase(p, op, arg, lds);
                if (ph + 1 < ph1 || rep + 1 < reps) { xcd_barrier(xb);
#ifdef BAR2
                    xcd_barrier(xb);
#endif
                }
            }
        }
#ifdef DBG
        xcd_barrier(xb);
#ifndef DBG_WORD
#define DBG_WORD 200
#endif
        { const int code = __hip_atomic_load(WS_(p, TAB) + DBG_WORD, __ATOMIC_RELAXED, __HIP_MEMORY_SCOPE_AGENT);
          for (size_t i = (size_t)blockIdx.x * NTHR + threadIdx.x; i < (size_t)T * D; i += (size_t)NB_ * NTHR) p.out[i] = 0.f;
          __syncthreads();
          if (blockIdx.x == 0 && threadIdx.x == 0) p.out[0] = sqrtf((float)DBG_DECODE(code) * 1.68e7f); }
#endif
    } else {
        for (int ph = ph0; ph < ph1; ++ph) { int op, arg; decode_phase(ph, op, arg); run_phase(p, op, arg, lds); }
    }
}


extern "C" void kernel_launch(void* const* d_in, const int* in_sizes, int n_in, void* d_out, int out_size, void* d_ws, size_t ws_size, hipStream_t stream) {
    (void)in_sizes; (void)n_in; (void)out_size;
    Params p; std::memset((void*)&p, 0, sizeof(p));
    auto F = [&](int i) { return (const float*)d_in[i]; };
    p.x = F(0); p.ln_g = F(1); p.ln_b = F(2);
    p.rw_mu = F(3); p.rw_w_rkv = F(4); p.rw_w0 = F(5); p.rw_w1 = F(6); p.rw_w2 = F(7); p.rw_a0 = F(8);
    p.rw_a1 = F(9); p.rw_a2 = F(10); p.rw_g1 = F(11); p.rw_g2 = F(12);
    p.rw_k_k = F(13); p.rw_k_a = F(14); p.rw_r_k = F(15); p.rw_lnx_g = F(16); p.rw_lnx_b = F(17); p.rw_w_o = F(18);
    p.mb_w_in = F(19); p.mb_conv_w = F(20); p.mb_conv_b = F(21); p.mb_dt_bias = F(22); p.mb_a_log = F(23); p.mb_d = F(24); p.mb_norm_g = F(25); p.mb_w_out = F(26);
    p.gl_w_in = F(27); p.gl_gk_w2 = F(28); p.gl_gk_b = F(29); p.gl_norm_g = F(30); p.gl_w_out = F(31);
    p.moe_w_group = F(32); p.moe_b_group = F(33); p.moe_w_route = F(34); p.moe_b_route = F(35); p.moe_w_in = F(36); p.moe_w_down = F(37);
    p.out = (float*)d_out;
    p.ws = (char*)d_ws;
    if (WS_TOTAL > ws_size) { fprintf(stderr, "workspace too small: need %zu have %zu\n", (size_t)WS_TOTAL, ws_size); return; }
    unsigned* bar_ptr = (unsigned*)(p.ws + OFF_bar);
    const int np = NPHASES;
#define X(t, n) (void*)&p.n,
#if SINGLE_LAUNCH
    (void)hipFuncSetAttribute((const void*)mega<true>, hipFuncAttributeMaxDynamicSharedMemorySize, LDS_BYTES);
    (void)hipMemsetAsync(bar_ptr, 0, XCD_BAR_WORDS * sizeof(unsigned), stream);
    int ph0 = 0, ph1 = np; void* args[] = {PARAM_LIST(X) (void*)&ph0, (void*)&ph1};
    hipError_t e = hipLaunchCooperativeKernel((const void*)mega<true>, dim3(NBLK), dim3(NTHR), args, LDS_BYTES, stream);
    if (e != hipSuccess) fprintf(stderr, "cooperative launch failed: %s\n", hipGetErrorString(e));
#else
    (void)hipFuncSetAttribute((const void*)mega<false>, hipFuncAttributeMaxDynamicSharedMemorySize, LDS_BYTES);
    for (int ph = 0; ph < np; ++ph) { int ph0 = ph, ph1 = ph + 1; void* args[] = {PARAM_LIST(X) (void*)&ph0, (void*)&ph1};
        hipError_t e = hipLaunchKernel((const void*)mega<false>, dim3(NBLK), dim3(NTHR), args, LDS_BYTES, stream);
        if (e != hipSuccess) fprintf(stderr, "launch failed: %s\n", hipGetErrorString(e)); }
#endif
#undef X
}
```

```cpp
#include <hip/hip_runtime.h>
#include <hip/hip_cooperative_groups.h>
#include <cstdint>
#include <cstdio>
#include <cstring>
namespace cg = cooperative_groups;

typedef unsigned short bf16_t;
typedef short bf16x8 __attribute__((ext_vector_type(8)));
typedef short s16x4 __attribute__((ext_vector_type(4)));
typedef float f32x4 __attribute__((ext_vector_type(4)));
typedef float f32x2 __attribute__((ext_vector_type(2)));
typedef unsigned u32x4 __attribute__((ext_vector_type(4)));
typedef unsigned u32x2 __attribute__((ext_vector_type(2)));
#define LAS __attribute__((address_space(3)))
#define DEV __device__ __forceinline__

constexpr int T = 16384, D = 1024, DEPTH = 4;
constexpr int NTHR = 512, NBLK = 256;
constexpr int LDS_BYTES = 155648;
constexpr float ALPHA = 1.681792830507429f;
constexpr float LN_EPS = 1e-5f;
constexpr int MOE_ROWS = 40960;

DEV int tid_() { int t = threadIdx.x; asm volatile("" : "+v"(t)); return t; }
DEV int bid_() { int b = blockIdx.x; asm volatile("" : "+s"(b)); return b; }
#define NB_ 256
#define RCOL(q, lane) ((((q) >> 1) * 512) + 8 * (lane) + 4 * ((q) & 1))
DEV void lds_barrier() { asm volatile("s_waitcnt lgkmcnt(0)" ::: "memory"); __builtin_amdgcn_s_barrier(); asm volatile("" ::: "memory"); }
DEV unsigned f2bf(float f) { unsigned u = __float_as_uint(f); u += 0x7FFFu + ((u >> 16) & 1u); return u >> 16; }
DEV float bf2f(unsigned short b) { return __uint_as_float(((unsigned)b) << 16); }
typedef __bf16 bf16n2 __attribute__((ext_vector_type(2)));
DEV unsigned pk2(float lo, float hi) { f32x2 v = {lo, hi}; bf16n2 b = __builtin_convertvector(v, bf16n2); return __builtin_bit_cast(unsigned, b); }
DEV float bflo(unsigned u) { return __uint_as_float(u << 16); }
DEV float bfhi(unsigned u) { return __uint_as_float(u & 0xFFFF0000u); }
DEV float sigmoidf_(float x) { return 1.0f / (1.0f + __expf(-x)); }
DEV float siluf_(float x) { return x / (1.0f + __expf(-x)); }
DEV float softplusf_(float x) { return fmaxf(x, 0.f) + __logf(1.0f + __expf(-fabsf(x))); }
DEV float tanhf_(float x) { const float e = __expf(-2.0f * fabsf(x)); const float r = (1.0f - e) / (1.0f + e); return x < 0.f ? -r : r; }
DEV float wave_sum(float v) {
#pragma unroll
    for (int o = 32; o > 0; o >>= 1) v += __shfl_xor(v, o);
    return v;
}
DEV float sum16(float v) {
#pragma unroll
    for (int o = 8; o > 0; o >>= 1) v += __shfl_xor(v, o);
    return v;
}
template <int N> DEV float reduce_scatter(float (&v)[N], int lane) {
    int s = 1;
#pragma unroll
    for (int h = N / 2; h >= 1; h >>= 1) {
#pragma unroll
        for (int i = 0; i < h; ++i) {
            const bool up = (lane & s) != 0;
            const float send = up ? v[i] : v[i + h];
            const float keep = up ? v[i + h] : v[i];
            v[i] = keep + __shfl_xor(send, s);
        }
        s <<= 1;
    }
    float r = v[0];
    for (; s < 64; s <<= 1) r += __shfl_xor(r, s);
    return r;
}
template <int N> DEV int rs_index(int lane) {
    int o = 0, s = 1;
#pragma unroll
    for (int h = N / 2; h >= 1; h >>= 1) { if (lane & s) o += h; s <<= 1; }
    return o;
}

DEV bf16x8 frag_rm(const LAS bf16_t* base, int ld, int row0, int k0, int lane) {
    return *(const LAS bf16x8*)(base + (row0 + (lane & 15)) * ld + k0 + 8 * (lane >> 4));
}
DEV bf16x8 frag_tr(const LAS bf16_t* base, int ld, int k0, int c0, int lane) {
    const int g = lane >> 4, i = lane & 15, q = i >> 2, p = i & 3;
    const LAS bf16_t* a = base + (k0 + 8 * g + q) * ld + c0 + 4 * p;
    s16x4 lo = __builtin_amdgcn_ds_read_tr16_b64_v4i16((LAS s16x4*)a);
    s16x4 hi = __builtin_amdgcn_ds_read_tr16_b64_v4i16((LAS s16x4*)(a + 4 * ld));
    bf16x8 r; r[0] = lo[0]; r[1] = lo[1]; r[2] = lo[2]; r[3] = lo[3]; r[4] = hi[0]; r[5] = hi[1]; r[6] = hi[2]; r[7] = hi[3];
    return r;
}
#define MFMA16(a, b, c) __builtin_amdgcn_mfma_f32_16x16x32_bf16((a), (b), (c), 0, 0, 0)
DEV size_t fragmajor_off(int n, int k, int K) { return ((size_t)((n >> 4) * (K >> 5) + (k >> 5)) * 64 + (n & 15) + 16 * ((k & 31) >> 3)) * 8 + (k & 7); }

template <int N> DEV void skinny_group(const f32x4 (&z)[4], const LAS float* wt, int lane, LAS float* outw) {
    float pe[N];
#pragma unroll
    for (int o = 0; o < N; ++o) {
        float a = 0.f;
#pragma unroll
        for (int q = 0; q < 4; ++q) { const f32x4 w = *(const LAS f32x4*)(wt + o * 1028 + RCOL(q, lane)); a += z[q][0] * w[0] + z[q][1] * w[1] + z[q][2] * w[2] + z[q][3] * w[3]; }
        pe[o] = a;
    }
    const float r = reduce_scatter<N>(pe, lane);
    if (lane < N) outw[rs_index<N>(lane)] = r;
}
#ifndef SINGLE_LAUNCH
#define SINGLE_LAUNCH 1
#endif
constexpr size_t OFF_bar = 0ull;
constexpr size_t OFF_rw_rkv_t = 13824ull;
constexpr size_t OFF_rw_w1_t = 12596736ull;
constexpr size_t OFF_rw_a1_t = 13645312ull;
constexpr size_t OFF_rw_g1_t = 14693888ull;
constexpr size_t OFF_rw_w2_t = 15742464ull;
constexpr size_t OFF_rw_a2_t = 16791040ull;
constexpr size_t OFF_rw_g2_t = 17839616ull;
constexpr size_t OFF_rw_wo_t = 18888192ull;
constexpr size_t OFF_mb_win_t = 23082496ull;
constexpr size_t OFF_mb_wout_t = 33568256ull;
constexpr size_t OFF_gl_win_t = 37762560ull;
constexpr size_t OFF_gl_wout_t = 44054016ull;
constexpr size_t OFF_moe_w1_t = 46151168ull;
constexpr size_t OFF_moe_w2_t = 314586624ull;
constexpr size_t OFF_H = 448804352ull;
constexpr size_t OFF_H1 = 515913216ull;
constexpr size_t OFF_MIX = 583022080ull;
constexpr size_t OFF_BUF = 650130944ull;
constexpr size_t OFF_ACT = 734017024ull;
constexpr size_t OFF_YBUF = 775960064ull;
constexpr size_t OFF_CNT = 859846144ull;
constexpr size_t OFF_EIDX = 859878912ull;
constexpr size_t OFF_GATE = 860009984ull;
constexpr size_t OFF_DEST = 860141056ull;
constexpr size_t OFF_TAB = 860272128ull;
constexpr size_t OFF_YB = 860273152ull;
constexpr size_t OFF_X6 = 927382016ull;
constexpr size_t OFF_Rr = 1128708608ull;
constexpr size_t OFF_Kk = 1195817472ull;
constexpr size_t OFF_Vv = 1262926336ull;
constexpr size_t OFF_LW = 1330035200ull;
constexpr size_t OFF_Wd = 1355201024ull;
constexpr size_t OFF_Aa = 1422309888ull;
constexpr size_t OFF_Gg = 1489418752ull;
constexpr size_t OFF_RWf = 1556527616ull;
constexpr size_t OFF_RBf = 1590082048ull;
constexpr size_t OFF_RUt = 1623636480ull;
constexpr size_t OFF_RNa = 1657190912ull;
constexpr size_t OFF_RGc = 1690745344ull;
constexpr size_t OFF_RUa = 1691793920ull;
constexpr size_t OFF_RS0 = 1725348352ull;
constexpr size_t OFF_Z = 960936448ull;
constexpr size_t OFF_XBC = 1028045312ull;
constexpr size_t OFF_XC = 1128708608ull;
constexpr size_t OFF_DT = 1229371904ull;
constexpr size_t OFF_STATES = 1231469056ull;
constexpr size_t OFF_CD = 1365686784ull;
constexpr size_t OFF_PREV = 1365703168ull;
constexpr size_t OFF_LA = 1432812032ull;
constexpr size_t OFF_CDG = 1466366464ull;
constexpr size_t OFF_QKVG = OFF_XBC;
constexpr size_t WS_TOTAL = 1758902784ull;
typedef unsigned T_bar;
typedef bf16_t T_rw_rkv_t;
typedef bf16_t T_rw_w1_t;
typedef bf16_t T_rw_a1_t;
typedef bf16_t T_rw_g1_t;
typedef bf16_t T_rw_w2_t;
typedef bf16_t T_rw_a2_t;
typedef bf16_t T_rw_g2_t;
typedef bf16_t T_rw_wo_t;
typedef bf16_t T_mb_win_t;
typedef bf16_t T_mb_wout_t;
typedef bf16_t T_gl_win_t;
typedef bf16_t T_gl_wout_t;
typedef bf16_t T_moe_w1_t;
typedef bf16_t T_moe_w2_t;
typedef float T_H;
typedef float T_H1;
typedef float T_MIX;
typedef bf16_t T_BUF;
typedef bf16_t T_ACT;
typedef bf16_t T_YBUF;
typedef int T_CNT;
typedef int T_EIDX;
typedef float T_GATE;
typedef int T_DEST;
typedef int T_TAB;
typedef bf16_t T_YB;
typedef bf16_t T_X6;
typedef float T_Rr;
typedef float T_Kk;
typedef float T_Vv;
typedef bf16_t T_LW;
typedef float T_Wd;
typedef float T_Aa;
typedef float T_Gg;
typedef bf16_t T_RWf;
typedef bf16_t T_RBf;
typedef bf16_t T_RUt;
typedef bf16_t T_RNa;
typedef float T_RGc;
typedef bf16_t T_RUa;
typedef bf16_t T_RS0;
typedef bf16_t T_Z;
typedef bf16_t T_XBC;
typedef bf16_t T_XC;
typedef float T_DT;
typedef bf16_t T_STATES;
typedef float T_CD;
typedef bf16_t T_PREV;
typedef float T_LA;
typedef float T_CDG;
typedef bf16_t T_QKVG;
#define WS_(P, N) ((T_##N*)((P).ws + OFF_##N))
constexpr size_t OFF_Hb = OFF_H, OFF_H1b = OFF_H1, OFF_MIXb = OFF_MIX;
typedef bf16_t T_Hb; typedef bf16_t T_H1b; typedef bf16_t T_MIXb;
constexpr size_t OFF_moe_wr_t = OFF_H + 33554432ull;
typedef bf16_t T_moe_wr_t;
constexpr size_t OFF_mb_dt_t = OFF_moe_wr_t + 4ull * 48 * 1024 * 2, OFF_gl_lr_t = OFF_mb_dt_t + 32ull * 1024 * 2;
typedef bf16_t T_mb_dt_t; typedef bf16_t T_gl_lr_t;
constexpr size_t OFF_Rb = OFF_Rr, OFF_Kb = OFF_Kk, OFF_Vb = OFF_Vv, OFF_Ab = OFF_Aa, OFF_Gb = OFF_Gg;
typedef bf16_t T_Rb; typedef bf16_t T_Kb; typedef bf16_t T_Vb; typedef bf16_t T_Ab; typedef bf16_t T_Gb;
constexpr size_t OFF_Wb = OFF_Wd; typedef bf16_t T_Wb;
struct ConvJob {
    const float* src; bf16_t* dst;
    int K, N, src_ld, Kpad, Npad, perm, batch;
    long long src_bs, dst_bs;
    DEV int ntiles() const { return (Kpad / 64) * (Npad / 64) * batch; }
};
constexpr int NJOBS = 16;
constexpr int MOE_SPLIT = 32;

#define PARAM_LIST(X) \
    X(const float*, x) X(const float*, ln_g) X(const float*, ln_b) \
    X(const float*, rw_mu) X(const float*, rw_w_rkv) X(const float*, rw_w0) X(const float*, rw_w1) X(const float*, rw_w2) X(const float*, rw_a0) X(const float*, rw_a1) X(const float*, rw_a2) \
    X(const float*, rw_g1) X(const float*, rw_g2) X(const float*, rw_k_k) X(const float*, rw_k_a) X(const float*, rw_r_k) X(const float*, rw_lnx_g) X(const float*, rw_lnx_b) X(const float*, rw_w_o) \
    X(const float*, mb_w_in) X(const float*, mb_conv_w) X(const float*, mb_conv_b) X(const float*, mb_dt_bias) X(const float*, mb_a_log) X(const float*, mb_d) X(const float*, mb_norm_g) X(const float*, mb_w_out) \
    X(const float*, gl_w_in) X(const float*, gl_gk_w2) X(const float*, gl_gk_b) X(const float*, gl_norm_g) X(const float*, gl_w_out) \
    X(const float*, moe_w_group) X(const float*, moe_b_group) X(const float*, moe_w_route) X(const float*, moe_b_route) X(const float*, moe_w_in) X(const float*, moe_w_down) \
    X(float*, out) X(char*, ws)
struct Params {
#define X(t, n) t n;
    PARAM_LIST(X)
#undef X
};

enum Op : unsigned char { OP_CONVERT = 0, OP_PRE0, OP_RW_GEMM1, OP_RW_GEMM2, OP_RW_CHA, OP_RW_CHB, OP_RW_CHC, OP_RW_OUT,
    OP_LN1, OP_MOE_SCATTER, OP_MOE_GEMM1, OP_MOE_GEMM2, OP_LN2,
    OP_MB_GEMM_IN, OP_MB_CONV, OP_MB_STATES, OP_MB_SCAN, OP_MB_OUT, OP_MB_GEMM_OUT,
    OP_GL_GEMM_IN, OP_GL_KV, OP_GL_SCAN, OP_GL_OUT, OP_GL_GEMM_OUT };


DEV ConvJob make_job(const Params& p, int q) {
    const long long DD = (long long)D * D;
    switch (q) {
    case 0: return ConvJob{p.rw_w_rkv, WS_(p, rw_rkv_t), 1024, 1024, 1024, 1024, 1024, 0, 6, DD, DD};
    case 1: return ConvJob{p.rw_w1, WS_(p, rw_w1_t), 1024, 64, 64, 1024, 256, 0, 2, (long long)D * 64, (long long)256 * D};
    case 2: return ConvJob{p.rw_a1, WS_(p, rw_a1_t), 1024, 64, 64, 1024, 256, 0, 2, (long long)D * 64, (long long)256 * D};
    case 3: return ConvJob{p.rw_g1, WS_(p, rw_g1_t), 1024, 160, 160, 1024, 256, 0, 2, (long long)D * 160, (long long)256 * D};
    case 4: return ConvJob{p.rw_w2, WS_(p, rw_w2_t), 64, 1024, 1024, 256, 1024, 0, 2, (long long)64 * D, (long long)D * 256};
    case 5: return ConvJob{p.rw_a2, WS_(p, rw_a2_t), 64, 1024, 1024, 256, 1024, 0, 2, (long long)64 * D, (long long)D * 256};
    case 6: return ConvJob{p.rw_g2, WS_(p, rw_g2_t), 160, 1024, 1024, 256, 1024, 0, 2, (long long)160 * D, (long long)D * 256};
    case 7: return ConvJob{p.rw_w_o, WS_(p, rw_wo_t), 1024, 1024, 1024, 1024, 1024, 0, 2, DD, DD};
    case 8: return ConvJob{p.mb_w_in, WS_(p, mb_win_t), 1024, 5120, 5152, 1024, 5120, 0, 1, 0, 0};
    case 9: return ConvJob{p.mb_w_out, WS_(p, mb_wout_t), 2048, 1024, 1024, 2048, 1024, 0, 1, 0, 0};
    case 10: return ConvJob{p.gl_w_in, WS_(p, gl_win_t), 1024, 3072, 3088, 1024, 3072, 0, 1, 0, 0};
    case 11: return ConvJob{p.gl_w_out, WS_(p, gl_wout_t), 1024, 1024, 1024, 1024, 1024, 0, 1, 0, 0};
    case 12: return ConvJob{p.moe_w_in, WS_(p, moe_w1_t), 1024, 1024, 1024, 1024, 1024, 1, MOE_SPLIT, DD, DD};
    case 13: return ConvJob{p.moe_w_down, WS_(p, moe_w2_t), 512, 1024, 1024, 512, 1024, 0, MOE_SPLIT, (long long)512 * 1024, (long long)1024 * 512};
    case 14: return ConvJob{p.moe_w_in + (size_t)MOE_SPLIT * DD, WS_(p, moe_w1_t) + (size_t)MOE_SPLIT * DD, 1024, 1024, 1024, 1024, 1024, 1, 128 - MOE_SPLIT, DD, DD};
    default: return ConvJob{p.moe_w_down + (size_t)MOE_SPLIT * 512 * 1024, WS_(p, moe_w2_t) + (size_t)MOE_SPLIT * 512 * 1024, 512, 1024, 1024, 512, 1024, 0, 128 - MOE_SPLIT, (long long)512 * 1024, (long long)1024 * 512};
    }
}

DEV void convert_one(const ConvJob& J, LAS unsigned char* lds, int B0, int NBW, int tbeg) {
    const int tid = tid_(), bid = bid_();
    const int lane = tid & 63, wv = tid >> 6; const int gw = (bid - B0) * 8 + wv, NW = NBW * 8;
    LAS bf16_t* tile = (LAS bf16_t*)lds + wv * (64 * 72);
    const int jend = tbeg + J.ntiles();
    const int ti0 = tbeg + ((gw - tbeg) % NW + NW) % NW;
#pragma unroll 1
    for (int ti = ti0; ti < jend; ti += NW) {
        int local = ti - tbeg;
        const int tk = J.Kpad / 64, tn = J.Npad / 64;
        const int b = local / (tk * tn); local -= b * tk * tn;
        const int nt = local / tk, kt = local - nt * tk;
        const float* src = J.src + (size_t)b * J.src_bs;
        bf16_t* dst = J.dst + (size_t)b * J.dst_bs;
        const int k0 = kt * 64, n0 = nt * 64;
        const int nn = (lane & 15) * 4; const bool nok = n0 + nn < J.N;
        f32x4 v[16];
#pragma unroll
        for (int i = 0; i < 16; ++i) { const int kk = (lane >> 4) + 4 * i; v[i] = (nok && k0 + kk < J.K) ? *(const f32x4*)(src + (size_t)(k0 + kk) * J.src_ld + n0 + nn) : (f32x4){0.f, 0.f, 0.f, 0.f}; }
#pragma unroll
        for (int i = 0; i < 16; ++i) { const int kk = (lane >> 4) + 4 * i;
#pragma unroll
            for (int e = 0; e < 4; ++e) tile[(nn + e) * 72 + kk] = (bf16_t)f2bf(v[i][e]); }
#pragma unroll
        for (int i = 0; i < 8; ++i) { const int r = (lane >> 3) + 8 * i, kc = (lane & 7) * 8;
            int nsrc = n0 + r, ndst = nsrc;
            if (J.perm == 1) { const int up = nsrc >= 512, jj = nsrc - (up ? 512 : 0); ndst = (jj >> 7) * 256 + (up ? 128 : 0) + (jj & 127); }
            *(u32x4*)(dst + (size_t)ndst * J.Kpad + k0 + kc) = *(const LAS u32x4*)(tile + r * 72 + kc); }
    }
}
template <int J0, int J1> DEV void convert_jobs(const Params& p, LAS unsigned char* lds, int B0, int NBW) {
    int tbeg = 0;
#pragma unroll
    for (int j = J0; j < J1; ++j) { const ConvJob J = make_job(p, j); convert_one(J, lds, B0, NBW, tbeg); tbeg += J.ntiles(); }
}
DEV ConvJob moe_job(const Params& p, int which, int ml) {
    const long long DD = (long long)D * D; const size_t b0 = (size_t)ml * 32;
    if (which == 0) return ConvJob{p.moe_w_in + b0 * DD, WS_(p, moe_w1_t) + b0 * DD, 1024, 1024, 1024, 1024, 1024, 1, 32, DD, DD};
    return ConvJob{p.moe_w_down + b0 * 512 * 1024, WS_(p, moe_w2_t) + b0 * 512 * 1024, 512, 1024, 1024, 512, 1024, 0, 32, (long long)512 * 1024, (long long)1024 * 512};
}
DEV void phase_convert(const Params& p, LAS unsigned char* lds) {
    const int tid = tid_(), bid = bid_();
    convert_jobs<0, 14>(p, lds, 0, NB_);
    if (bid < 4 * 48) { const int layer = bid / 48, o = bid % 48;
        for (int k = tid; k < D; k += NTHR) { float v = 0.f;
            if (o < 32) v = p.moe_w_route[((size_t)layer * D + k) * 32 + o]; else if (o < 36) v = p.moe_w_group[((size_t)layer * D + k) * 4 + (o - 32)];
            WS_(p, moe_wr_t)[((size_t)layer * 48 + o) * D + k] = (bf16_t)f2bf(v); } }
    else if (bid < 4 * 48 + 32) { const int o = bid - 192;
        for (int k = tid; k < D; k += NTHR) WS_(p, mb_dt_t)[(size_t)o * D + k] = (bf16_t)f2bf(p.mb_w_in[(size_t)k * 5152 + 5120 + o]); }
    else if (bid < 4 * 48 + 48) { const int o = bid - 224;
        for (int k = tid; k < D; k += NTHR) WS_(p, gl_lr_t)[(size_t)o * D + k] = (bf16_t)f2bf(p.gl_w_in[(size_t)k * 3088 + 3072 + o]); }
}
namespace pg8 {
constexpr int BM = 256, BK = 64, HALF = 128, HTB = HALF * BK * 2, STAGE_BYTES = 8 * HTB;
DEV int lds_byte(int r, int c) { const int st = (r >> 4) * 2 + (c >> 5), rr = r & 15, cc = c & 31, ob = rr * 64 + cc * 2; return st * 1024 + (ob ^ (((ob >> 9) & 1) << 5)); }
DEV void stage_rc(int b, int& R, int& C) { const int st = b / 1024, sb = b % 1024, swz = sb ^ (((sb >> 9) & 1) << 5); R = (st >> 1) * 16 + swz / 64; C = (st & 1) * 32 + (swz % 64) / 2; }

struct Unit { const char* A; const char* B; int row0, col0, id, aux; };

DEV bool tile_order(int i, int G, int c, int nM, int nN, int& pm, int& pn) {
    const int nwg = nM * nN; const long L = (long)i * G + c; if (L >= nwg) return false;
    int wgid = (int)L; { const int q = nwg / 8, r = nwg % 8, xcd = wgid % 8, off = wgid / 8; wgid = (xcd < r ? xcd * (q + 1) : r * (q + 1) + (xcd - r) * q) + off; }
    const int nig = 8 * nN, gid = wgid / nig, fm = gid * 8, gsz = (nM - fm) < 8 ? (nM - fm) : 8;
    pm = fm + ((wgid % nig) % gsz); pn = (wgid % nig) / gsz; return true;
}

template <class Epi, class Sched>
DEV void gemm_phase(LAS unsigned char* lds, const int K, const Sched& S, const Epi& E) {
    const int tid = tid_(), wid = __builtin_amdgcn_readfirstlane(tid >> 6), lane = tid & 63, wr = wid >> 2, wc = wid & 3, fr = lane & 15, fq = lane >> 4;
    const int nt = K / BK;
    unsigned voff[2];
#pragma unroll
    for (int i = 0; i < 2; ++i) { int R, C; stage_rc(tid * 16 + i * 8192, R, C); voff[i] = (unsigned)(R * K + C) * 2u; }
    const size_t kstep = (size_t)(BK * 2);
    const size_t hstep = (size_t)HALF * K * 2;
    const unsigned ldsw = (unsigned)wid * 1024u;
    const int aoff = lds_byte(wr * 64 + fr, fq * 8), boff = lds_byte(wc * 32 + fr, fq * 8);
#define PG8_SA(b, h) (((b) * 2 + (h)) * HTB)
#define PG8_SB(b, h) ((4 + (b) * 2 + (h)) * HTB)
#define PG8_STAGE(bufoff, gbase) do { _Pragma("unroll") for (int _i = 0; _i < 2; ++_i) \
        __builtin_amdgcn_global_load_lds((const unsigned*)((const char*)(gbase) + voff[_i]), (LAS unsigned*)(lds + (bufoff) + ldsw + _i * 8192), 16, 0, 0); } while (0)
#define PG8_LDA(dst, b, h) do { _Pragma("unroll") for (int m = 0; m < 4; ++m) _Pragma("unroll") for (int k = 0; k < 2; ++k) dst[m][k] = *(const LAS bf16x8*)(lds + PG8_SA(b, h) + aoff + m * 2048 + k * 1024); } while (0)
#define PG8_LDB(dst, b, h) do { _Pragma("unroll") for (int n = 0; n < 2; ++n) _Pragma("unroll") for (int k = 0; k < 2; ++k) dst[n][k] = *(const LAS bf16x8*)(lds + PG8_SB(b, h) + boff + n * 2048 + k * 1024); } while (0)
#define PG8_MMA(ai, bj, At, Bt) do { __builtin_amdgcn_s_setprio(1); _Pragma("unroll") for (int m = 0; m < 4; ++m) _Pragma("unroll") for (int n = 0; n < 2; ++n) _Pragma("unroll") for (int k = 0; k < 2; ++k) \
        acc[ai][bj][m][n] = __builtin_amdgcn_mfma_f32_16x16x32_bf16(Bt[n][k], At[m][k], acc[ai][bj][m][n], 0, 0, 0); __builtin_amdgcn_s_setprio(0); } while (0)
#define PG8_WAIT_V(n) asm volatile("s_waitcnt vmcnt(" #n ")" ::: "memory")
#define PG8_WAIT_L(n) asm volatile("s_waitcnt lgkmcnt(" #n ")" ::: "memory")
#define PG8_BAR __builtin_amdgcn_s_barrier()
#define PG8_SCHED __builtin_amdgcn_sched_barrier(0)
    Unit cur, nxt; int ui = 0;
    if (!S.next(0, cur)) return;
    f32x4 acc[2][2][4][2];
#pragma unroll
    for (int a = 0; a < 2; ++a)
#pragma unroll
        for (int b = 0; b < 2; ++b)
#pragma unroll
            for (int m = 0; m < 4; ++m)
#pragma unroll
                for (int n = 0; n < 2; ++n) acc[a][b][m][n] = (f32x4){0.f, 0.f, 0.f, 0.f};
    bf16x8 At[4][2], B0[2][2], B1[2][2];
    const char* cA = cur.A; const char* cB = cur.B;
    PG8_STAGE(PG8_SB(0, 0), cB); PG8_STAGE(PG8_SA(0, 0), cA); PG8_STAGE(PG8_SB(0, 1), cB + hstep); PG8_STAGE(PG8_SA(0, 1), cA + hstep);
    if (wr == 1) PG8_BAR;
    PG8_WAIT_V(4); PG8_BAR;
    PG8_STAGE(PG8_SB(1, 0), cB + kstep); PG8_STAGE(PG8_SA(1, 0), cA + kstep); PG8_STAGE(PG8_SB(1, 1), cB + hstep + kstep);
    PG8_WAIT_V(6); PG8_BAR;
    for (;;) {
        const bool has_next = S.next(ui + 1, nxt);
        const char* nA = has_next ? nxt.A : cA; const char* nB = has_next ? nxt.B : cB;
#pragma unroll 1
        for (int t = 0; t < nt; t += 2) {
            const bool last = (t == nt - 2);
            const char* a1 = cA + (size_t)(t + 1) * kstep;
            const char* a2 = last ? nA : cA + (size_t)(t + 2) * kstep; const char* b2 = last ? nB : cB + (size_t)(t + 2) * kstep;
            const char* a3 = a2 + kstep; const char* b3 = b2 + kstep;
            PG8_LDB(B0, 0, 0); PG8_SCHED; PG8_LDA(At, 0, 0); PG8_STAGE(PG8_SA(1, 1), a1 + hstep);
            PG8_WAIT_L(8); PG8_BAR; PG8_WAIT_L(0); PG8_MMA(0, 0, At, B0); PG8_BAR; PG8_SCHED;
            PG8_LDB(B1, 0, 1); PG8_STAGE(PG8_SB(0, 0), b2);
            PG8_BAR; PG8_WAIT_L(0); PG8_MMA(0, 1, At, B1); PG8_BAR;
            PG8_LDA(At, 0, 1); PG8_STAGE(PG8_SA(0, 0), a2);
            PG8_BAR; PG8_WAIT_L(0); PG8_MMA(1, 0, At, B0); PG8_BAR; PG8_SCHED;
            PG8_STAGE(PG8_SB(0, 1), b2 + hstep);
            PG8_WAIT_V(6); PG8_BAR; PG8_MMA(1, 1, At, B1); PG8_BAR;
            PG8_LDB(B0, 1, 0); PG8_SCHED; PG8_LDA(At, 1, 0); PG8_STAGE(PG8_SA(0, 1), a2 + hstep);
            PG8_WAIT_L(8); PG8_BAR; PG8_WAIT_L(0); PG8_MMA(0, 0, At, B0); PG8_BAR; PG8_SCHED;
            PG8_LDB(B1, 1, 1); PG8_STAGE(PG8_SB(1, 0), b3);
            PG8_BAR; PG8_WAIT_L(0); PG8_MMA(0, 1, At, B1); PG8_BAR;
            PG8_LDA(At, 1, 1); PG8_STAGE(PG8_SA(1, 0), a3);
            PG8_BAR; PG8_WAIT_L(0); PG8_MMA(1, 0, At, B0); PG8_BAR; PG8_SCHED;
            PG8_STAGE(PG8_SB(1, 1), b3 + hstep);
            PG8_WAIT_V(6); PG8_BAR; PG8_MMA(1, 1, At, B1); PG8_BAR;
        }
        E(acc, cur, wr, wc, fr, fq);
        if (!has_next) break;
#pragma unroll
        for (int a = 0; a < 2; ++a)
#pragma unroll
            for (int b = 0; b < 2; ++b)
#pragma unroll
                for (int m = 0; m < 4; ++m)
#pragma unroll
                    for (int n = 0; n < 2; ++n) acc[a][b][m][n] = (f32x4){0.f, 0.f, 0.f, 0.f};
        cur = nxt; cA = nA; cB = nB; ++ui;
    }
    PG8_WAIT_V(0);
    if (wr == 0) PG8_BAR;
    PG8_BAR;
#undef PG8_SA
#undef PG8_SB
#undef PG8_STAGE
#undef PG8_LDA
#undef PG8_LDB
#undef PG8_MMA
#undef PG8_WAIT_V
#undef PG8_WAIT_L
#undef PG8_BAR
#undef PG8_SCHED
}
}
using pg8::Unit;
typedef f32x4 AccT[2][2][4][2];
#define FOR_ACC(ai, bj, m, n) _Pragma("unroll") for (int ai = 0; ai < 2; ++ai) _Pragma("unroll") for (int m = 0; m < 4; ++m) _Pragma("unroll") for (int bj = 0; bj < 2; ++bj) _Pragma("unroll") for (int n = 0; n < 2; ++n)
#define ACC_FENCE __builtin_amdgcn_sched_barrier(0)
#define ACC_ROW(u, ai, m) ((u).row0 + 128 * (ai) + 64 * wr + 16 * (m) + fr)
#define ACC_COL(u, bj, n) ((u).col0 + 128 * (bj) + 32 * wc + 16 * (n) + 4 * fq)
DEV void st_bf4(bf16_t* p, f32x4 v) { u32x2 w; w.x = pk2(v[0], v[1]); w.y = pk2(v[2], v[3]); *(u32x2*)p = w; }
DEV void load_row(const float* p, int lane, f32x4 (&v)[4]) {
#pragma unroll
    for (int q = 0; q < 4; ++q) v[q] = *(const f32x4*)(p + RCOL(q, lane));
}

DEV void load_row_bf(const bf16_t* p, int lane, f32x4 (&v)[4]) {
#pragma unroll
    for (int q = 0; q < 4; ++q) { const u32x2 a = *(const u32x2*)(p + RCOL(q, lane)); v[q] = (f32x4){bflo(a.x), bfhi(a.x), bflo(a.y), bfhi(a.y)}; }
}
DEV void store_row_bf(bf16_t* p, int lane, const f32x4 (&v)[4]) {
#pragma unroll
    for (int q = 0; q < 4; ++q) st_bf4(p + RCOL(q, lane), v[q]);
}
DEV void emit_mix6(const Params& p, int j, int t, int lane, const f32x4 (&x)[4], const f32x4 (&xp)[4]) {
    const float* mu = p.rw_mu + (size_t)j * 6 * D;
#pragma unroll
    for (int s = 0; s < 6; ++s) {
#pragma unroll
        for (int q = 0; q < 4; ++q) {
            const f32x4 m = *(const f32x4*)(mu + s * D + RCOL(q, lane));
            st_bf4(WS_(p, X6) + (size_t)s * T * D + (size_t)t * D + RCOL(q, lane), x[q] + (xp[q] - x[q]) * m);
        }
        __builtin_amdgcn_sched_barrier(0);
    }
}
DEV void phase_pre0(const Params& p) {
    const int tid = tid_(), bid = bid_(); const int lane = tid & 63, wid = tid >> 6;
    f32x4 x[4], xp[4];
    const int tfirst = bid * 64 + wid * 8;
    if (tfirst > 0) load_row(p.x + (size_t)(tfirst - 1) * D, lane, xp); else { for (int q = 0; q < 4; ++q) xp[q] = (f32x4){0.f, 0.f, 0.f, 0.f}; }
    f32x4 xn[4]; load_row(p.x + (size_t)tfirst * D, lane, xn);
#pragma unroll 1
    for (int r = 0; r < 8; ++r) {
        const int t = tfirst + r;
#pragma unroll
        for (int q = 0; q < 4; ++q) x[q] = xn[q];
        load_row(p.x + (size_t)(r < 7 ? t + 1 : t) * D, lane, xn);
        store_row_bf(WS_(p, Hb) + (size_t)t * D, lane, x);
        emit_mix6(p, 0, t, lane, x, xp);
#pragma unroll
        for (int q = 0; q < 4; ++q) xp[q] = x[q];
    }
}

struct SchedRW1 {
    const Params* p; int j;
    DEV bool next(int i, Unit& u) const {
        int pm, pn; if (!pg8::tile_order(i, NB_, bid_(), 64, 15, pm, pn)) return false;
        int id, lpn; if (pn < 12) { id = pn >> 2; lpn = pn & 3; } else { id = 3 + (pn - 12); lpn = 0; }
        u.A = (const char*)(WS_(*p, X6) + (size_t)id * T * D + (size_t)pm * 256 * D);
        const bf16_t* B;
        if (id < 3) B = WS_(*p, rw_rkv_t) + ((size_t)j * 3 + id) * D * D + (size_t)lpn * 256 * D;
        else B = WS_(*p, rw_w1_t) + (size_t)(id - 3) * (2 * 256 * D) + (size_t)j * 256 * D;
        u.B = (const char*)B; u.row0 = pm * 256; u.col0 = lpn * 256; u.id = id; u.aux = 0; return true;
    }
};
struct EpiRW1 {
    const Params* p;
    DEV void operator()(const AccT& acc, const Unit& u, int wr, int wc, int fr, int fq) const {
        if (u.id < 3) {
            bf16_t* O = WS_(*p, Rb) + (size_t)u.id * 2 * T * D;
            FOR_ACC(ai, bj, m, n) { st_bf4(O + (size_t)ACC_ROW(u, ai, m) * D + ACC_COL(u, bj, n), acc[ai][bj][m][n]); ACC_FENCE; }
        } else {
            bf16_t* O = WS_(*p, LW) + (size_t)(u.id - 3) * T * 256;
            FOR_ACC(ai, bj, m, n) {
                f32x4 v = acc[ai][bj][m][n];
                if (u.id == 3) { for (int e = 0; e < 4; ++e) v[e] = tanhf_(v[e]); }
                else if (u.id == 5) { for (int e = 0; e < 4; ++e) v[e] = sigmoidf_(v[e]); }
                st_bf4(O + (size_t)ACC_ROW(u, ai, m) * 256 + ACC_COL(u, bj, n), v); ACC_FENCE;
            }
        }
    }
};
struct SchedRW2 {
    const Params* p; int j;
    DEV bool next(int i, Unit& u) const {
        int pm, pn; if (!pg8::tile_order(i, NB_, bid_(), 64, 12, pm, pn)) return false;
        const int id = pn >> 2, lpn = pn & 3;
        u.A = (const char*)(WS_(*p, LW) + (size_t)id * T * 256 + (size_t)pm * 256 * 256);
        const bf16_t* B = WS_(*p, rw_w2_t) + (size_t)id * (2 * D * 256) + (size_t)j * D * 256 + (size_t)lpn * 256 * 256;
        u.B = (const char*)B; u.row0 = pm * 256; u.col0 = lpn * 256; u.id = id; u.aux = 0; return true;
    }
};
struct EpiRW2 {
    const Params* p; int j;
    DEV void operator()(const AccT& acc, const Unit& u, int wr, int wc, int fr, int fq) const {
        if (u.id == 0) { const float* bias = p->rw_w0 + (size_t)j * D; f32x4 bv[2][2];
#pragma unroll
            for (int bj = 0; bj < 2; ++bj)
#pragma unroll
                for (int n = 0; n < 2; ++n) bv[bj][n] = *(const f32x4*)(bias + ACC_COL(u, bj, n));
            FOR_ACC(ai, bj, m, n) { f32x4 v = acc[ai][bj][m][n]; const int c = ACC_COL(u, bj, n); const f32x4 b = bv[bj][n];
                for (int e = 0; e < 4; ++e) { const float x = -(b[e] + v[e]); const float wl = -(fmaxf(x, 0.f) + __logf(1.0f + __expf(-fabsf(x)))) - 0.5f; v[e] = -__expf(wl); }
                st_bf4(WS_(*p, Wb) + (size_t)ACC_ROW(u, ai, m) * D + c, v); ACC_FENCE; } }
        else if (u.id == 1) { const float* bias = p->rw_a0 + (size_t)j * D; f32x4 bv[2][2];
#pragma unroll
            for (int bj = 0; bj < 2; ++bj)
#pragma unroll
                for (int n = 0; n < 2; ++n) bv[bj][n] = *(const f32x4*)(bias + ACC_COL(u, bj, n));
            FOR_ACC(ai, bj, m, n) { f32x4 v = acc[ai][bj][m][n]; const int c = ACC_COL(u, bj, n); const f32x4 b = bv[bj][n];
                for (int e = 0; e < 4; ++e) v[e] = sigmoidf_(b[e] + v[e]);
                st_bf4(WS_(*p, Ab) + (size_t)ACC_ROW(u, ai, m) * D + c, v); ACC_FENCE; } }
        else { FOR_ACC(ai, bj, m, n) { st_bf4(WS_(*p, Gb) + (size_t)ACC_ROW(u, ai, m) * D + ACC_COL(u, bj, n), acc[ai][bj][m][n]); ACC_FENCE; } }
    }
};

struct SchedOut {
    const bf16_t* A; const bf16_t* Bt; int K;
    DEV bool next(int i, Unit& u) const {
        int pm, pn; if (!pg8::tile_order(i, NB_, bid_(), 64, 4, pm, pn)) return false;
        u.A = (const char*)(A + (size_t)pm * 256 * K); u.B = (const char*)(Bt + (size_t)pn * 256 * K); u.row0 = pm * 256; u.col0 = pn * 256; u.id = 0; u.aux = 0; return true;
    }
};
struct EpiOut {
    bf16_t* O;
    DEV void operator()(const AccT& acc, const Unit& u, int wr, int wc, int fr, int fq) const {
        FOR_ACC(ai, bj, m, n) { st_bf4(O + (size_t)ACC_ROW(u, ai, m) * D + ACC_COL(u, bj, n), acc[ai][bj][m][n]); ACC_FENCE; }
    }
};
constexpr int RC_LD = 72;
#ifdef DBG
#define DBGF(cond, bit) do { if (cond) atomicOr(&WS_(p, TAB)[200], (bit)); } while (0)
#else
#define DBGF(cond, bit) do {} while (0)
#endif
DEV bool bad_(float x) { return !(fabsf(x) < 1e30f); }
DEV int rc_pi(int g, int j) { return j < 4 ? 4 * g + j : 16 + 4 * g + (j - 4); }

DEV void rc_load_wd(const Params& p, int t0, int cb, float (&wd)[8]) {
    const int tid = tid_(); const int k = tid & 63, sg = tid >> 6;
#pragma unroll
    for (int i = 0; i < 8; ++i) wd[i] = bf2f(WS_(p, Wb)[(size_t)(t0 + sg * 8 + i) * D + cb + k]);
}
DEV void rc_cum_regs(const float (&wd)[8], LAS float* cum, LAS float* seg) {
    const int tid = tid_(); const int k = tid & 63, sg = tid >> 6;
    float v[8]; float s = 0.f;
#pragma unroll
    for (int i = 0; i < 8; ++i) { s += wd[i]; v[i] = s; }
    seg[sg * 64 + k] = s;
    lds_barrier();
    float off = 0.f;
#pragma unroll
    for (int q = 0; q < 8; ++q) off += (q < sg) ? seg[q * 64 + k] : 0.f;
#pragma unroll
    for (int i = 0; i < 8; ++i) cum[(sg * 8 + i) * 64 + k] = v[i] + off;
    lds_barrier();
}
DEV void ld8b(const bf16_t* p, float (&f)[8]) { const u32x4 v = *(const u32x4*)p; f[0] = bflo(v.x); f[1] = bfhi(v.x); f[2] = bflo(v.y); f[3] = bfhi(v.y); f[4] = bflo(v.z); f[5] = bfhi(v.z); f[6] = bflo(v.w); f[7] = bfhi(v.w); }
DEV void ld8(const float* p, float (&f)[8]) { const f32x4 a = *(const f32x4*)p, b = *(const f32x4*)(p + 4); f[0] = a[0]; f[1] = a[1]; f[2] = a[2]; f[3] = a[3]; f[4] = b[0]; f[5] = b[1]; f[6] = b[2]; f[7] = b[3]; }
DEV void lds8(const LAS float* p, float (&f)[8]) { const f32x4 a = *(const LAS f32x4*)p, b = *(const LAS f32x4*)(p + 4); f[0] = a[0]; f[1] = a[1]; f[2] = a[2]; f[3] = a[3]; f[4] = b[0]; f[5] = b[1]; f[6] = b[2]; f[7] = b[3]; }
DEV u32x4 pk8(const float (&f)[8]) { u32x4 o; o.x = pk2(f[0], f[1]); o.y = pk2(f[2], f[3]); o.z = pk2(f[4], f[5]); o.w = pk2(f[6], f[7]); return o; }

DEV bf16x8 frag_rm_pi(const LAS bf16_t* base, int ld, int row0, int k0, int lane) {
    const LAS bf16_t* a = base + (row0 + (lane & 15)) * ld + k0 + 4 * (lane >> 4);
    const s16x4 lo = *(const LAS s16x4*)a, hi = *(const LAS s16x4*)(a + 16);
    bf16x8 r; r[0] = lo[0]; r[1] = lo[1]; r[2] = lo[2]; r[3] = lo[3]; r[4] = hi[0]; r[5] = hi[1]; r[6] = hi[2]; r[7] = hi[3]; return r;
}
DEV void rc_prep8(const float (&k)[8], const float (&al)[8], const float (&kkw)[8], const float (&kaw)[8], float (&a)[8], float (&b)[8], float (&kh)[8]) {
    float kk[8]; float ss = 0.f;
#pragma unroll
    for (int e = 0; e < 8; ++e) { kk[e] = k[e] * kkw[e]; ss += kk[e] * kk[e]; }
    ss += __shfl_xor(ss, 1); ss += __shfl_xor(ss, 2); ss += __shfl_xor(ss, 4);
    const float inv = 1.0f / fmaxf(sqrtf(ss), 1e-12f);
#pragma unroll
    for (int e = 0; e < 8; ++e) { const float kn = kk[e] * inv; a[e] = -kn; b[e] = kn * al[e]; kh[e] = k[e] * (1.0f + (al[e] - 1.0f) * kaw[e]); }
}
DEV void phase_rw_cha(const Params& p, int jl, LAS unsigned char* lds) {
    const int tid = tid_(), bid = bid_(); const int lane = tid & 63, w = tid >> 6; const int fr = lane & 15, fq = lane >> 4;
    LAS float* cum = (LAS float*)lds;
    LAS float* seg = cum + 64 * 64;
    LAS float* Aab = seg + 8 * 64;
    LAS bf16_t* As = (LAS bf16_t*)(Aab + 64 * 68);
    LAS bf16_t* Bs = As + 64 * RC_LD; LAS bf16_t* Ks = Bs + 64 * RC_LD; LAS bf16_t* Vs = Ks + 64 * RC_LD; LAS bf16_t* Ke = Vs + 64 * RC_LD;
    LAS bf16_t* Aak = Ke + 64 * RC_LD; LAS bf16_t* Ts = Aak + 64 * RC_LD; LAS bf16_t* X1 = Ts + 64 * RC_LD; LAS bf16_t* Aabh = X1 + 64 * RC_LD;
    LAS bf16_t* Fimg = Aabh + 64 * RC_LD;
    LAS bf16_t* Wimg = Fimg + 4096;
    float pwd[8], pkr[8], pal[8], pv[8];
    float kkw[8], kaw[8];
    ld8(p.rw_k_k + (size_t)jl * D + (bid & 15) * 64 + (tid & 7) * 8, kkw); ld8(p.rw_k_a + (size_t)jl * D + (bid & 15) * 64 + (tid & 7) * 8, kaw);
    { const int c = bid >> 4, h = bid & 15; rc_load_wd(p, c * 64, h * 64, pwd);
      const size_t go = (size_t)(c * 64 + (tid >> 3)) * D + h * 64 + (tid & 7) * 8; ld8b(WS_(p, Kb) + go, pkr); ld8b(WS_(p, Ab) + go, pal); ld8b(WS_(p, Vb) + go, pv); }
    for (int u = bid; u < 4096; u += NB_) {
        const int c = u >> 4, h = u & 15; const int t0 = c * 64, cb = h * 64; const size_t ub = (size_t)c * 16 + h;
        lds_barrier();
        rc_cum_regs(pwd, cum, seg);
        {
            const int t = tid >> 3, k8 = (tid & 7) * 8;
            float a[8], b[8], kh[8], v[8], ct[8], cp[8], ce[8];
            rc_prep8(pkr, pal, kkw, kaw, a, b, kh);
#pragma unroll
            for (int e = 0; e < 8; ++e) v[e] = pv[e];
            if (u + NB_ < 4096) { const int un = u + NB_; const int cn = un >> 4, hn = un & 15; rc_load_wd(p, cn * 64, hn * 64, pwd);
                const size_t gn = (size_t)(cn * 64 + t) * D + hn * 64 + k8; ld8b(WS_(p, Kb) + gn, pkr); ld8b(WS_(p, Ab) + gn, pal); ld8b(WS_(p, Vb) + gn, pv); }
            lds8(cum + t * 64 + k8, ct); lds8(cum + 63 * 64 + k8, ce);
            if (t > 0) lds8(cum + (t - 1) * 64 + k8, cp); else { for (int e = 0; e < 8; ++e) cp[e] = 0.f; }
            float at[8], bt[8], kt[8], be[8], ke[8];
#pragma unroll
            for (int e = 0; e < 8; ++e) { const float ei = __expf(-ct[e]), ee = __expf(ce[e] - ct[e]); at[e] = a[e] * __expf(cp[e]); bt[e] = b[e] * ei; kt[e] = kh[e] * ei; be[e] = b[e] * ee; ke[e] = kh[e] * ee; }
            *(LAS u32x4*)(As + t * RC_LD + k8) = pk8(at); *(LAS u32x4*)(Bs + t * RC_LD + k8) = pk8(bt); *(LAS u32x4*)(Ks + t * RC_LD + k8) = pk8(kt);
            *(LAS u32x4*)(Ke + t * RC_LD + k8) = pk8(ke); *(LAS u32x4*)(Vs + t * RC_LD + k8) = pk8(v);
            const int tq = t & 31, g = (tq & 15) >> 2, j = (tq & 3) + ((tq >> 4) << 2);
#pragma unroll
            for (int e = 0; e < 8; ++e) { const int k = k8 + e; Fimg[(((k >> 4) * 2 + (t >> 5)) * 64 + g * 16 + (k & 15)) * 8 + j] = (bf16_t)f2bf(be[e]); }
            *(LAS u32x4*)(Ts + tid * 8) = (u32x4){0u, 0u, 0u, 0u}; if (tid < 64) *(LAS u32x4*)(Ts + (512 + tid) * 8) = (u32x4){0u, 0u, 0u, 0u};
            if (t == 63) { float gm[8]; for (int e = 0; e < 8; ++e) gm[e] = __expf(ce[e]); *(f32x4*)(WS_(p, RGc) + ub * 64 + k8) = (f32x4){gm[0], gm[1], gm[2], gm[3]}; *(f32x4*)(WS_(p, RGc) + ub * 64 + k8 + 4) = (f32x4){gm[4], gm[5], gm[6], gm[7]}; }
        }
        lds_barrier();
        {
            const int tb = w >> 1;
#pragma unroll
            for (int ii = 0; ii < 2; ++ii) { const int ib = 2 * (w & 1) + ii;
                f32x4 ab = {0.f, 0.f, 0.f, 0.f}, ak = {0.f, 0.f, 0.f, 0.f};
                if (ib <= tb) {
#pragma unroll
                    for (int ks = 0; ks < 2; ++ks) { const bf16x8 af = frag_rm(As, RC_LD, 16 * tb, 32 * ks, lane);
                        ab = MFMA16(af, frag_rm(Bs, RC_LD, 16 * ib, 32 * ks, lane), ab); ak = MFMA16(af, frag_rm(Ks, RC_LD, 16 * ib, 32 * ks, lane), ak); } }
#pragma unroll
                for (int r = 0; r < 4; ++r) { const int t = 16 * tb + 4 * fq + r, i = 16 * ib + fr; const bool keep = i < t;
                    Aab[t * 68 + i] = keep ? ab[r] : 0.f; Aabh[t * RC_LD + i] = (bf16_t)f2bf(keep ? ab[r] : 0.f); Aak[t * RC_LD + i] = (bf16_t)f2bf(keep ? ak[r] : 0.f); } }
            *(u32x4*)(WS_(p, RBf) + ub * 4096 + tid * 8) = *(const LAS u32x4*)(Fimg + tid * 8);
        }
        lds_barrier();
        if (w == 0) {
            const int blk = lane >> 4, jc = lane & 15;
            float Tc[16];
#pragma unroll
            for (int t = 0; t < 16; ++t) {
                float acc = jc == t ? 1.f : 0.f;
#pragma unroll
                for (int i4 = 0; i4 < (t + 3) / 4; ++i4) { const f32x4 a4 = *(const LAS f32x4*)(Aab + (16 * blk + t) * 68 + 16 * blk + i4 * 4);
#pragma unroll
                    for (int e = 0; e < 4; ++e) if (i4 * 4 + e < t) acc += a4[e] * Tc[i4 * 4 + e]; }
                Tc[t] = acc;
            }
#pragma unroll
            for (int t = 0; t < 16; ++t) Ts[(16 * blk + t) * RC_LD + 16 * blk + jc] = (bf16_t)f2bf(Tc[t]);
#pragma unroll
            for (int b = 1; b < 4; ++b) {
                const s16x4 dlo = *(const LAS s16x4*)(Ts + (16 * b + fr) * RC_LD + 16 * b + 4 * fq);
                bf16x8 dfr; dfr[0] = dlo[0]; dfr[1] = dlo[1]; dfr[2] = dlo[2]; dfr[3] = dlo[3]; dfr[4] = 0; dfr[5] = 0; dfr[6] = 0; dfr[7] = 0;
                f32x4 tt_[3];
#pragma unroll
                for (int cbk = 0; cbk < b; ++cbk) {
                    f32x4 x = {0.f, 0.f, 0.f, 0.f};
#pragma unroll
                    for (int ks = 0; ks < 2; ++ks) x = MFMA16(frag_rm(Aabh, RC_LD, 16 * b, 32 * ks, lane), frag_tr(Ts, RC_LD, 32 * ks, 16 * cbk, lane), x);
                    u32x4 xb; xb.x = pk2(x[0], x[1]); xb.y = pk2(x[2], x[3]); xb.z = 0u; xb.w = 0u;
                    tt_[cbk] = MFMA16(dfr, __builtin_bit_cast(bf16x8, xb), ((f32x4){0.f, 0.f, 0.f, 0.f}));
                }
#pragma unroll
                for (int cbk = 0; cbk < b; ++cbk)
#pragma unroll
                    for (int r = 0; r < 4; ++r) Ts[(16 * b + 4 * fq + r) * RC_LD + 16 * cbk + fr] = (bf16_t)f2bf(tt_[cbk][r]);
            }
        } else {
            for (int tl = w - 1; tl < 32; tl += 7) {
                const int rb = (tl & 15) >> 2, vbk = tl & 3; f32x4 acc = {0.f, 0.f, 0.f, 0.f};
                if (tl < 16) {
#pragma unroll
                    for (int ks = 0; ks < 2; ++ks) acc = MFMA16(frag_rm(Aak, RC_LD, 16 * rb, 32 * ks, lane), frag_tr(Vs, RC_LD, 32 * ks, 16 * vbk, lane), acc);
#pragma unroll
                    for (int r = 0; r < 4; ++r) X1[(16 * rb + 4 * fq + r) * RC_LD + 16 * vbk + fr] = (bf16_t)f2bf(acc[r]);
                } else {
#pragma unroll
                    for (int ks = 0; ks < 2; ++ks) acc = MFMA16(frag_tr(Ke, RC_LD, 32 * ks, 16 * rb, lane), frag_tr(Vs, RC_LD, 32 * ks, 16 * vbk, lane), acc);
                    { u32x2 o; o.x = pk2(acc[0], acc[1]); o.y = pk2(acc[2], acc[3]); *(u32x2*)(WS_(p, RNa) + (((ub * 4 + vbk) * 4 + rb) * 64 + lane) * 4) = o; }
                }
            }
        }
        lds_barrier();
#pragma unroll
        for (int q = 0; q < 4; ++q) { const int tl = w * 4 + q; const int tt = (tl & 15) >> 2, cbk = tl & 3; f32x4 acc = {0.f, 0.f, 0.f, 0.f};
            if (tl < 16) {
#pragma unroll
                for (int ks = 0; ks < 2; ++ks) acc = MFMA16(frag_rm(Ts, RC_LD, 16 * tt, 32 * ks, lane), frag_tr(As, RC_LD, 32 * ks, 16 * cbk, lane), acc);
                const int k = 16 * cbk + fr, kq = k & 31, g = (kq & 15) >> 2, j = (kq & 3) + ((kq >> 4) << 2);
#pragma unroll
                for (int r = 0; r < 4; ++r) Wimg[((tt * 2 + (k >> 5)) * 64 + g * 16 + 4 * fq + r) * 8 + j] = (bf16_t)f2bf(acc[r]);
            } else {
#pragma unroll
                for (int ks = 0; ks < 2; ++ks) acc = MFMA16(frag_rm(Ts, RC_LD, 16 * tt, 32 * ks, lane), frag_tr(X1, RC_LD, 32 * ks, 16 * cbk, lane), acc);
                { u32x2 o; o.x = pk2(acc[0], acc[1]); o.y = pk2(acc[2], acc[3]); *(u32x2*)(WS_(p, RUt) + (((ub * 4 + cbk) * 4 + tt) * 64 + lane) * 4) = o; }
            } }
        lds_barrier();
        *(u32x4*)(WS_(p, RWf) + ub * 4096 + tid * 8) = *(const LAS u32x4*)(Wimg + tid * 8);
    }
}

constexpr int RB_SLOT = 20992, RB_R = 6, RB_P = 5;
struct RbOpsA { bf16x8 wf[8]; u32x2 ut[4]; };
struct RbOpsB { bf16x8 bf[8]; u32x2 na[4]; f32x4 gc[4]; };
DEV void rb_read_a(const LAS unsigned char* slot, int lane, RbOpsA& O) {
#pragma unroll
    for (int f = 0; f < 8; ++f) O.wf[f] = *(const LAS bf16x8*)(slot + (f * 64 + lane) * 16);
#pragma unroll
    for (int q = 0; q < 4; ++q) O.ut[q] = *(const LAS u32x2*)(slot + 16384 + (q * 64 + lane) * 8);
}
DEV void rb_read_b(const LAS unsigned char* slot, int lane, RbOpsB& O) {
    const int fq = lane >> 4;
#pragma unroll
    for (int f = 0; f < 8; ++f) O.bf[f] = *(const LAS bf16x8*)(slot + 8192 + (f * 64 + lane) * 16);
#pragma unroll
    for (int q = 0; q < 4; ++q) { O.na[q] = *(const LAS u32x2*)(slot + 18432 + (q * 64 + lane) * 8); O.gc[q] = *(const LAS f32x4*)(slot + 20480 + (16 * q + 4 * fq) * 4); }
}
DEV void phase_rw_chb(const Params& p, int layer, LAS unsigned char* lds) {
    const int tid = tid_(), bid = bid_();
    if (bid >= 64) {
        if (layer == 0) { const ConvJob J0 = moe_job(p, 0, 1), J1 = moe_job(p, 1, 1); convert_one(J0, lds, 64, NB_ - 64, 0); convert_one(J1, lds, 64, NB_ - 64, J0.ntiles()); }
        return; }
    const int lane = tid & 63, w = __builtin_amdgcn_readfirstlane(tid >> 6); const int head = bid & 15, vb = bid >> 4;
    auto issue = [&](int c) {
        const size_t ub = (size_t)c * 16 + head; LAS unsigned char* slot = lds + (c % RB_R) * RB_SLOT;
#pragma unroll
        for (int i = 0; i < 3; ++i) { const int pi = (w - 1) * 3 + i;
            if (pi < 8) __builtin_amdgcn_global_load_lds((const unsigned*)(WS_(p, RWf) + ub * 4096 + pi * 512 + lane * 8), (LAS unsigned*)(slot + pi * 1024), 16, 0, 0);
            else if (pi < 16) __builtin_amdgcn_global_load_lds((const unsigned*)(WS_(p, RBf) + ub * 4096 + (pi - 8) * 512 + lane * 8), (LAS unsigned*)(slot + 8192 + (pi - 8) * 1024), 16, 0, 0);
            else if (pi < 18) __builtin_amdgcn_global_load_lds((const unsigned*)(WS_(p, RUt) + (ub * 4 + vb) * 1024 + (pi - 16) * 512 + lane * 8), (LAS unsigned*)(slot + 16384 + (pi - 16) * 1024), 16, 0, 0);
            else if (pi < 20) __builtin_amdgcn_global_load_lds((const unsigned*)(WS_(p, RNa) + (ub * 4 + vb) * 1024 + (pi - 18) * 512 + lane * 8), (LAS unsigned*)(slot + 18432 + (pi - 18) * 1024), 16, 0, 0);
            else __builtin_amdgcn_global_load_lds((const unsigned*)(WS_(p, RGc) + ub * 64 + lane), (LAS unsigned*)(slot + 20480), 4, 0, 0);
        }
    };
    if (w > 0) {
#pragma unroll 1
        for (int c = 0; c < RB_P; ++c) issue(c);
        asm volatile("s_waitcnt vmcnt(9)" ::: "memory");
    }
    __builtin_amdgcn_s_barrier();
    f32x4 s[4]; for (int i = 0; i < 4; ++i) s[i] = (f32x4){0.f, 0.f, 0.f, 0.f};
    RbOpsA cur, nxt; RbOpsB cb_;
    if (w == 0) { rb_read_a(lds, lane, cur); }
#pragma unroll 1
    for (int c = 0; c < 256; ++c) {
        if (w > 0) {
            if (c + RB_P < 256) { issue(c + RB_P); asm volatile("s_waitcnt vmcnt(9)" ::: "memory"); }
            else asm volatile("s_waitcnt vmcnt(0)" ::: "memory");
        } else {
            const size_t ub = (size_t)c * 16 + head;
            rb_read_b(lds + (c % RB_R) * RB_SLOT, lane, cb_);
            rb_read_a(lds + ((c + 1 < 256 ? c + 1 : c) % RB_R) * RB_SLOT, lane, nxt);
            bf16x8 sb[2];
#pragma unroll
            for (int ks = 0; ks < 2; ++ks) { u32x4 o; o.x = pk2(s[2 * ks][0], s[2 * ks][1]); o.y = pk2(s[2 * ks][2], s[2 * ks][3]); o.z = pk2(s[2 * ks + 1][0], s[2 * ks + 1][1]); o.w = pk2(s[2 * ks + 1][2], s[2 * ks + 1][3]); sb[ks] = __builtin_bit_cast(bf16x8, o); *(u32x4*)(WS_(p, RS0) + (((ub * 4 + vb) * 2 + ks) * 64 + lane) * 8) = o; }
            f32x4 uu[4];
#pragma unroll
            for (int tt = 0; tt < 4; ++tt) { uu[tt] = (f32x4){bflo(cur.ut[tt].x), bfhi(cur.ut[tt].x), bflo(cur.ut[tt].y), bfhi(cur.ut[tt].y)}; uu[tt] = MFMA16(cur.wf[tt * 2], sb[0], uu[tt]); uu[tt] = MFMA16(cur.wf[tt * 2 + 1], sb[1], uu[tt]); }
            bf16x8 ubf[2];
#pragma unroll
            for (int ks = 0; ks < 2; ++ks) { u32x4 o; o.x = pk2(uu[2 * ks][0], uu[2 * ks][1]); o.y = pk2(uu[2 * ks][2], uu[2 * ks][3]); o.z = pk2(uu[2 * ks + 1][0], uu[2 * ks + 1][1]); o.w = pk2(uu[2 * ks + 1][2], uu[2 * ks + 1][3]); ubf[ks] = __builtin_bit_cast(bf16x8, o); *(u32x4*)(WS_(p, RUa) + (((ub * 4 + vb) * 2 + ks) * 64 + lane) * 8) = o; }
#pragma unroll
            for (int kt = 0; kt < 4; ++kt) { s[kt] = s[kt] * cb_.gc[kt] + (f32x4){bflo(cb_.na[kt].x), bfhi(cb_.na[kt].x), bflo(cb_.na[kt].y), bfhi(cb_.na[kt].y)}; s[kt] = MFMA16(cb_.bf[kt * 2], ubf[0], s[kt]); s[kt] = MFMA16(cb_.bf[kt * 2 + 1], ubf[1], s[kt]); }
            cur = nxt;
            asm volatile("s_waitcnt lgkmcnt(0)" ::: "memory");
        }
        __builtin_amdgcn_s_barrier();
    }
    asm volatile("s_waitcnt vmcnt(0)" ::: "memory");
}

DEV void phase_rw_chc(const Params& p, int j, LAS unsigned char* lds) {
    const int tid = tid_(), bid = bid_(); const int lane = tid & 63, w = tid >> 6; const int fr = lane & 15, fq = lane >> 4;
    LAS float* cum = (LAS float*)lds;
    LAS float* seg = cum + 64 * 64;
    LAS float* Ys = seg + 8 * 64;
    LAS bf16_t* Rs = (LAS bf16_t*)(Ys + 64 * 68);
    LAS bf16_t* Bs = Rs + 64 * RC_LD; LAS bf16_t* Ks = Bs + 64 * RC_LD; LAS bf16_t* Vs = Ks + 64 * RC_LD; LAS bf16_t* Arb = Vs + 64 * RC_LD; LAS bf16_t* Ark = Arb + 64 * RC_LD;
    float pwd[8], pr[8], pkr[8], pal[8], pv[8], pg[8];
    float kkw[8], kaw[8], rkw[8], lgw[8], lbw[8];
    { const size_t po = (size_t)j * D + (bid & 15) * 64 + (tid & 7) * 8; ld8(p.rw_k_k + po, kkw); ld8(p.rw_k_a + po, kaw); ld8(p.rw_r_k + po, rkw); ld8(p.rw_lnx_g + po, lgw); ld8(p.rw_lnx_b + po, lbw); }
    { const int c = bid >> 4, h = bid & 15; rc_load_wd(p, c * 64, h * 64, pwd);
      const size_t go = (size_t)(c * 64 + (tid >> 3)) * D + h * 64 + (tid & 7) * 8; ld8b(WS_(p, Rb) + go, pr); ld8b(WS_(p, Kb) + go, pkr); ld8b(WS_(p, Ab) + go, pal); ld8b(WS_(p, Vb) + go, pv); ld8b(WS_(p, Gb) + go, pg); }
    for (int u = bid; u < 4096; u += NB_) {
        const int c = u >> 4, h = u & 15; const int t0 = c * 64, cb = h * 64; const size_t ub = (size_t)c * 16 + h;
        const int tt = w & 3;
        bf16x8 ufr[2][2], sfr[2][2];
#pragma unroll
        for (int q = 0; q < 2; ++q)
#pragma unroll
            for (int ks = 0; ks < 2; ++ks) { const size_t o = (((ub * 4 + 2 * (w >> 2) + q) * 2 + ks) * 64 + lane) * 8;
                ufr[q][ks] = *(const bf16x8*)(WS_(p, RUa) + o); sfr[q][ks] = *(const bf16x8*)(WS_(p, RS0) + o); }
        lds_barrier();
        rc_cum_regs(pwd, cum, seg);
#ifdef DBL_CUM
        rc_cum_regs(pwd, cum, seg);
#endif
        const int t = tid >> 3, k8 = (tid & 7) * 8; const size_t go = (size_t)(t0 + t) * D + cb + k8;
        float v[8], gg[8]; float bc;
        {   float r[8], a[8], b[8], kh[8], ct[8];
#pragma unroll
            for (int e = 0; e < 8; ++e) { r[e] = pr[e]; v[e] = pv[e]; gg[e] = pg[e]; }
            lds8(cum + t * 64 + k8, ct);
            rc_prep8(pkr, pal, kkw, kaw, a, b, kh);
            if (u + NB_ < 4096) { const int un = u + NB_; const int cn = un >> 4, hn = un & 15; rc_load_wd(p, cn * 64, hn * 64, pwd);
                const size_t gn = (size_t)(cn * 64 + t) * D + hn * 64 + k8; ld8b(WS_(p, Rb) + gn, pr); ld8b(WS_(p, Kb) + gn, pkr); ld8b(WS_(p, Ab) + gn, pal); ld8b(WS_(p, Vb) + gn, pv); ld8b(WS_(p, Gb) + gn, pg); }
            bc = 0.f;
#pragma unroll
            for (int e = 0; e < 8; ++e) bc += r[e] * kh[e] * rkw[e];
            bc += __shfl_xor(bc, 1); bc += __shfl_xor(bc, 2); bc += __shfl_xor(bc, 4);
#pragma unroll
            for (int e = 0; e < 8; ++e) { const float ei = __expf(-ct[e]); r[e] *= __expf(ct[e]); b[e] *= ei; kh[e] *= ei; }
            *(LAS u32x4*)(Rs + t * RC_LD + k8) = pk8(r); *(LAS u32x4*)(Bs + t * RC_LD + k8) = pk8(b); *(LAS u32x4*)(Ks + t * RC_LD + k8) = pk8(kh); *(LAS u32x4*)(Vs + t * RC_LD + k8) = pk8(v);
        }
        lds_barrier();
#ifdef DBL_S3
#pragma unroll 1
        for (int rep_ = 0; rep_ < 2; ++rep_)
#endif
        {   const int tb = w >> 1;
#pragma unroll
            for (int ii = 0; ii < 2; ++ii) { const int ib = 2 * (w & 1) + ii;
                f32x4 ab = {0.f, 0.f, 0.f, 0.f}, ak = {0.f, 0.f, 0.f, 0.f};
                if (ib <= tb) {
#pragma unroll
                    for (int ks = 0; ks < 2; ++ks) { const bf16x8 af = frag_rm(Rs, RC_LD, 16 * tb, 32 * ks, lane);
                        ab = MFMA16(af, frag_rm(Bs, RC_LD, 16 * ib, 32 * ks, lane), ab); ak = MFMA16(af, frag_rm(Ks, RC_LD, 16 * ib, 32 * ks, lane), ak); } }
#pragma unroll
                for (int r = 0; r < 4; ++r) { const int tr = 16 * tb + 4 * fq + r, i = 16 * ib + fr; const bool keep = i <= tr;
                    Arb[tr * RC_LD + i] = (bf16_t)f2bf(keep ? ab[r] : 0.f); Ark[tr * RC_LD + i] = (bf16_t)f2bf(keep ? ak[r] : 0.f); } }
        }
        lds_barrier();
#ifdef DBL_Y
#pragma unroll 1
        for (int rep_ = 0; rep_ < 2; ++rep_)
#endif
#pragma unroll
        for (int q = 0; q < 2; ++q) { const int vbk = 2 * (w >> 2) + q; f32x4 acc = {0.f, 0.f, 0.f, 0.f};
#pragma unroll
            for (int ks = 0; ks < 2; ++ks) {
                acc = MFMA16(frag_rm_pi(Rs, RC_LD, 16 * tt, 32 * ks, lane), sfr[q][ks], acc);
                acc = MFMA16(frag_rm_pi(Arb, RC_LD, 16 * tt, 32 * ks, lane), ufr[q][ks], acc);
                acc = MFMA16(frag_rm(Ark, RC_LD, 16 * tt, 32 * ks, lane), frag_tr(Vs, RC_LD, 32 * ks, 16 * vbk, lane), acc); }
#pragma unroll
            for (int r = 0; r < 4; ++r) Ys[(16 * tt + 4 * fq + r) * 68 + 16 * vbk + fr] = acc[r]; }
        lds_barrier();
        {
            float y[8]; lds8(Ys + t * 68 + k8, y);
            float s1 = 0.f, s2 = 0.f;
#pragma unroll
            for (int e = 0; e < 8; ++e) { s1 += y[e]; s2 += y[e] * y[e]; }
            s1 += __shfl_xor(s1, 1); s1 += __shfl_xor(s1, 2); s1 += __shfl_xor(s1, 4); s2 += __shfl_xor(s2, 1); s2 += __shfl_xor(s2, 2); s2 += __shfl_xor(s2, 4);
            const float mean = s1 * (1.0f / 64.0f), var = s2 * (1.0f / 64.0f) - mean * mean; const float rs = rsqrtf(fmaxf(var, 0.f) + 64e-5f);
            float o[8];
#pragma unroll
            for (int e = 0; e < 8; ++e) o[e] = ((y[e] - mean) * rs * lgw[e] + lbw[e] + bc * v[e]) * gg[e];
            *(u32x4*)(WS_(p, YB) + go) = pk8(o);
        }
    }
}
DEV void phase_ln1(const Params& p, int layer, LAS unsigned char* lds) {
    const int tid = tid_(), bid = bid_(); (void)tid; (void)bid;
    const int lane = tid & 63, wid = tid >> 6; const int fr = lane & 15, fq = lane >> 4;
    LAS float* lgt = (LAS float*)lds;
    LAS int* cnt = (LAS int*)(lgt + 2 * 64 * 48);
    if (tid < 32) cnt[tid] = 0;
    const float* g = p.ln_g + ((size_t)layer * 2 + 0) * D; const float* be = p.ln_b + ((size_t)layer * 2 + 0) * D;
    const float* br = p.moe_b_route + layer * 32; const float* bg = p.moe_b_group + layer * 4;
    f32x4 gwv[4], bwv[4];
#pragma unroll
    for (int q = 0; q < 4; ++q) { gwv[q] = *(const f32x4*)(g + RCOL(q, lane)); bwv[q] = *(const f32x4*)(be + RCOL(q, lane)); }
    u32x2 rh[4], rm[4];
#pragma unroll
    for (int q = 0; q < 4; ++q) { rh[q] = *(const u32x2*)(WS_(p, Hb) + (size_t)(bid * 64 + wid * 8) * D + RCOL(q, lane)); rm[q] = *(const u32x2*)(WS_(p, MIXb) + (size_t)(bid * 64 + wid * 8) * D + RCOL(q, lane)); }
#pragma unroll 1
    for (int rr = 0; rr < 8; ++rr) {
        const int t = bid * 64 + wid * 8 + rr; const size_t ro = (size_t)t * D;
        f32x4 z[4], m[4];
#pragma unroll
        for (int q = 0; q < 4; ++q) { z[q] = (f32x4){bflo(rh[q].x), bfhi(rh[q].x), bflo(rh[q].y), bfhi(rh[q].y)}; m[q] = (f32x4){bflo(rm[q].x), bfhi(rm[q].x), bflo(rm[q].y), bfhi(rm[q].y)}; }
        { const size_t rn = (size_t)(rr < 7 ? t + 1 : t) * D;
#pragma unroll
          for (int q = 0; q < 4; ++q) { rh[q] = *(const u32x2*)(WS_(p, Hb) + rn + RCOL(q, lane)); rm[q] = *(const u32x2*)(WS_(p, MIXb) + rn + RCOL(q, lane)); } }
        float s = 0.f;
#pragma unroll
        for (int q = 0; q < 4; ++q) { z[q] = z[q] * ALPHA + m[q]; s += z[q][0] + z[q][1] + z[q][2] + z[q][3]; }
        const float mean = wave_sum(s) * (1.0f / D);
        float vs = 0.f;
#pragma unroll
        for (int q = 0; q < 4; ++q) { z[q] = z[q] - mean; vs += z[q][0] * z[q][0] + z[q][1] * z[q][1] + z[q][2] * z[q][2] + z[q][3] * z[q][3]; }
        const float rs = rsqrtf(wave_sum(vs) * (1.0f / D) + LN_EPS);
#pragma unroll
        for (int q = 0; q < 4; ++q) {
            st_bf4(WS_(p, H1b) + ro + RCOL(q, lane), z[q] * rs * gwv[q] + bwv[q]);
        }
    }
    asm volatile("s_waitcnt vmcnt(0)" ::: "memory");
    __syncthreads();
    {   const int rt = wid & 3, kh = wid >> 2;
        const bf16_t* Ab = WS_(p, H1b) + (size_t)(bid * 64 + 16 * rt + fr) * D + 512 * kh + 8 * fq;
        const bf16_t* Wb = WS_(p, moe_wr_t) + (size_t)layer * 48 * D + (size_t)fr * D + 512 * kh + 8 * fq;
        f32x4 acc[3]; for (int i = 0; i < 3; ++i) acc[i] = (f32x4){0.f, 0.f, 0.f, 0.f};
#pragma unroll 8
        for (int ks = 0; ks < 16; ++ks) {
            const bf16x8 af = *(const bf16x8*)(Ab + 32 * ks);
#pragma unroll
            for (int ct = 0; ct < 3; ++ct) acc[ct] = MFMA16(af, *(const bf16x8*)(Wb + (size_t)16 * ct * D + 32 * ks), acc[ct]);
        }
#pragma unroll
        for (int ct = 0; ct < 3; ++ct)
#pragma unroll
            for (int r = 0; r < 4; ++r) lgt[(kh * 64 + 16 * rt + 4 * fq + r) * 48 + 16 * ct + fr] = acc[ct][r];
    }
    __syncthreads();
    if (tid < 64) {
        const int t = bid * 64 + tid; const LAS float* L0 = lgt + tid * 48; const LAS float* L1 = lgt + (64 + tid) * 48;
        const float q0 = L0[32] + L1[32] + bg[0], q1 = L0[33] + L1[33] + bg[1], q2 = L0[34] + L1[34] + bg[2], q3 = L0[35] + L1[35] + bg[3];
        int gi = 0; float gm = q0;
        if (q1 > gm) { gm = q1; gi = 1; } if (q2 > gm) { gm = q2; gi = 2; } if (q3 > gm) { gm = q3; gi = 3; }
        const float den = __expf(q0 - gm) + __expf(q1 - gm) + __expf(q2 - gm) + __expf(q3 - gm);
        const float pgrp = __builtin_amdgcn_rcpf(den);
        float l1 = -INFINITY, l2 = -INFINITY; int i1 = 0, i2 = 0;
#pragma unroll 1
        for (int o = 0; o < 8; ++o) { const float v = L0[gi * 8 + o] + L1[gi * 8 + o] + br[gi * 8 + o];
            if (v > l1) { l2 = l1; i2 = i1; l1 = v; i1 = o; } else if (v > l2) { l2 = v; i2 = o; } }
        const float e2 = __expf(l2 - l1), inv = __builtin_amdgcn_rcpf(1.0f + e2);
        const int e0 = gi * 8 + i1, e1 = gi * 8 + i2;
        WS_(p, EIDX)[2 * t] = e0; WS_(p, EIDX)[2 * t + 1] = e1; WS_(p, GATE)[2 * t] = pgrp * inv; WS_(p, GATE)[2 * t + 1] = pgrp * e2 * inv;
        atomicAdd((int*)&cnt[e0], 1); atomicAdd((int*)&cnt[e1], 1);
    }
    __syncthreads();
    if (tid < 32) WS_(p, CNT)[bid * 32 + tid] = cnt[tid];
}

DEV void phase_moe_scatter(const Params& p, LAS unsigned char* lds) {
    const int tid = tid_(), bid = bid_(); (void)tid; (void)bid;
    const int lane = tid & 63, wid = tid >> 6;
    LAS int* part = (LAS int*)lds;
    LAS int* pre = part + 512;
    LAS int* base = pre + 512;
    LAS int* pst = base + 32;
    LAS int* dst = pst + 40;
    LAS int* eid = dst + 128;
    { const int e = tid & 31, part_i = tid >> 5; int tot = 0, prf = 0;
      for (int b = part_i * 16; b < part_i * 16 + 16; ++b) { const int c = WS_(p, CNT)[b * 32 + e]; tot += c; if (b < (int)bid) prf += c; }
      part[part_i * 32 + e] = tot; pre[part_i * 32 + e] = prf; }
    if (tid < 128) eid[tid] = WS_(p, EIDX)[bid * 128 + tid];
    lds_barrier();
    if (tid < 32) { int tot = 0, prf = 0; for (int i = 0; i < 16; ++i) { tot += part[i * 32 + tid]; prf += pre[i * 32 + tid]; } part[tid] = tot; pre[tid] = prf; }
    lds_barrier();
    if (tid == 0) { int acc = 0; for (int e = 0; e < 32; ++e) { pst[e] = acc; acc += ((part[e] + 255) >> 8) << 8; } pst[32] = acc;
        if (bid == 0) { for (int e = 0; e <= 32; ++e) WS_(p, TAB)[e] = pst[e]; WS_(p, TAB)[33] = acc >> 8;
            for (int e = 0; e < 32; ++e) for (int mt = pst[e] >> 8; mt < (pst[e + 1] >> 8); ++mt) WS_(p, TAB)[64 + mt] = e; } }
    lds_barrier();
    if (tid < 32) { int run = pst[tid] + pre[tid];
#pragma unroll 16
        for (int a = 0; a < 128; ++a) if (eid[a] == tid) dst[a] = run++; }
    lds_barrier();
    if (tid < 128) WS_(p, DEST)[bid * 128 + tid] = dst[tid];
#pragma unroll 4
    for (int a = wid * 16; a < wid * 16 + 16; ++a) {
        const int t = bid * 64 + (a >> 1); const int d = dst[a];
        const u32x4 v0 = *(const u32x4*)(WS_(p, H1b) + (size_t)t * D + lane * 8), v1 = *(const u32x4*)(WS_(p, H1b) + (size_t)t * D + 512 + lane * 8);
        *(u32x4*)(WS_(p, BUF) + (size_t)d * D + lane * 8) = v0; *(u32x4*)(WS_(p, BUF) + (size_t)d * D + 512 + lane * 8) = v1;
    }
}

template <int which> struct SchedMoe {
    const Params* p; int layer; const LAS int* tab;
    DEV bool next(int i, Unit& u) const {
        const int nmt = tab[33]; int pm, pn; if (!pg8::tile_order(i, NB_, bid_(), nmt, 4, pm, pn)) return false;
        const int row0 = pm * 256; const int e = tab[64 + pm];
        if constexpr (which == 0) { u.A = (const char*)(WS_(*p, BUF) + (size_t)row0 * D); u.B = (const char*)(WS_(*p, moe_w1_t) + ((size_t)layer * 32 + e) * 1024 * 1024 + (size_t)pn * 256 * 1024); }
        else { u.A = (const char*)(WS_(*p, ACT) + (size_t)row0 * 512); u.B = (const char*)(WS_(*p, moe_w2_t) + ((size_t)layer * 32 + e) * 1024 * 512 + (size_t)pn * 256 * 512); }
        u.row0 = row0; u.col0 = pn * 256; u.id = e; u.aux = 0; return true;
    }
};
struct EpiMoe1 {
    bf16_t* O;
    DEV void operator()(const AccT& acc, const Unit& u, int wr, int wc, int fr, int fq) const {
#pragma unroll
        for (int ai = 0; ai < 2; ++ai)
#pragma unroll
            for (int m = 0; m < 4; ++m)
#pragma unroll
                for (int n = 0; n < 2; ++n) {
                    const f32x4 gt = acc[ai][0][m][n], up = acc[ai][1][m][n]; f32x4 v;
                    for (int e = 0; e < 4; ++e) v[e] = siluf_(gt[e]) * up[e];
                    const int col = (u.col0 >> 1) + 32 * wc + 16 * n + 4 * fq;
                    st_bf4(O + (size_t)ACC_ROW(u, ai, m) * 512 + col, v); ACC_FENCE;
                }
    }
};
struct EpiMoe2 {
    bf16_t* O;
    DEV void operator()(const AccT& acc, const Unit& u, int wr, int wc, int fr, int fq) const {
        FOR_ACC(ai, bj, m, n) { st_bf4(O + (size_t)ACC_ROW(u, ai, m) * D + ACC_COL(u, bj, n), acc[ai][bj][m][n]); ACC_FENCE; }
    }
};

struct Ln2Raw { u32x2 h[4], a[4], b[4]; float g0, g1; };
DEV void ln2_issue(const Params& p, int t, int lane, Ln2Raw& R, int dpre, float gpre, int tbase) {
    const int i0 = 2 * (t - tbase); const int d0 = __shfl(dpre, i0), d1 = __shfl(dpre, i0 + 1); R.g0 = __shfl(gpre, i0); R.g1 = __shfl(gpre, i0 + 1);
#pragma unroll
    for (int q = 0; q < 4; ++q) { R.h[q] = *(const u32x2*)(WS_(p, H1b) + (size_t)t * D + RCOL(q, lane));
        R.a[q] = *(const u32x2*)(WS_(p, YBUF) + (size_t)d0 * D + RCOL(q, lane)); R.b[q] = *(const u32x2*)(WS_(p, YBUF) + (size_t)d1 * D + RCOL(q, lane)); }
}
DEV void ln2_finish(const Ln2Raw& R, const f32x4 (&gwv)[4], const f32x4 (&bwv)[4], f32x4 (&z)[4]) {
    float s = 0.f; const float g0 = R.g0, g1 = R.g1;
#pragma unroll
    for (int q = 0; q < 4; ++q) {
        z[q][0] = bflo(R.h[q].x) * ALPHA + g0 * bflo(R.a[q].x) + g1 * bflo(R.b[q].x); z[q][1] = bfhi(R.h[q].x) * ALPHA + g0 * bfhi(R.a[q].x) + g1 * bfhi(R.b[q].x);
        z[q][2] = bflo(R.h[q].y) * ALPHA + g0 * bflo(R.a[q].y) + g1 * bflo(R.b[q].y); z[q][3] = bfhi(R.h[q].y) * ALPHA + g0 * bfhi(R.a[q].y) + g1 * bfhi(R.b[q].y);
        s += z[q][0] + z[q][1] + z[q][2] + z[q][3];
    }
    const float mean = wave_sum(s) * (1.0f / D);
    float vs = 0.f;
#pragma unroll
    for (int q = 0; q < 4; ++q) { z[q] = z[q] - mean; vs += z[q][0] * z[q][0] + z[q][1] * z[q][1] + z[q][2] * z[q][2] + z[q][3] * z[q][3]; }
    const float rs = rsqrtf(wave_sum(vs) * (1.0f / D) + LN_EPS);
#pragma unroll
    for (int q = 0; q < 4; ++q) z[q] = z[q] * rs * gwv[q] + bwv[q];
}
DEV void phase_ln2(const Params& p, int layer, LAS unsigned char* lds) {
    const int tid = tid_(), bid = bid_(); const int lane = tid & 63, wid = tid >> 6; const int fr = lane & 15, fq = lane >> 4;
    const float* g = p.ln_g + ((size_t)layer * 2 + 1) * D; const float* be = p.ln_b + ((size_t)layer * 2 + 1) * D;
    const int nk = layer == DEPTH - 1 ? 3 : (layer + 1) % 3;
    const int nj = (layer + 1) / 3;
    LAS float* lgt = (LAS float*)lds;
    LAS float* w2 = lgt + 2 * 64 * 32;
    if (nk == 2) { for (int i = tid; i < 16 * 512; i += NTHR) w2[i] = p.gl_gk_w2[(size_t)nj * 16 * 512 + i]; }
    const int tfirst = bid * 64 + wid * 8;
    f32x4 z[4], zp[4], gwv[4], bwv[4];
#pragma unroll
    for (int q = 0; q < 4; ++q) { gwv[q] = *(const f32x4*)(g + RCOL(q, lane)); bwv[q] = *(const f32x4*)(be + RCOL(q, lane)); }
    Ln2Raw R[3];
    const int tbase = tfirst > 0 ? tfirst - 1 : 0;
    const int dpre = lane < 18 ? WS_(p, DEST)[2 * tbase + lane] : 0; const float gpre = lane < 18 ? WS_(p, GATE)[2 * tbase + lane] : 0.f;
    if (nk == 0) { if (tfirst > 0) { ln2_issue(p, tfirst - 1, lane, R[2], dpre, gpre, tbase); } }
    ln2_issue(p, tfirst, lane, R[0], dpre, gpre, tbase);
    ln2_issue(p, tfirst + 1, lane, R[1], dpre, gpre, tbase);
    if (nk == 0) { if (tfirst > 0) ln2_finish(R[2], gwv, bwv, zp); else { for (int q = 0; q < 4; ++q) zp[q] = (f32x4){0.f, 0.f, 0.f, 0.f}; } }
#pragma unroll
    for (int rr = 0; rr < 8; ++rr) {
        const int t = tfirst + rr; const size_t ro = (size_t)t * D;
        if (rr + 2 < 8) ln2_issue(p, t + 2, lane, R[(rr + 2) % 3], dpre, gpre, tbase);
        ln2_finish(R[rr % 3], gwv, bwv, z);
        if (nk == 3) {
#pragma unroll
            for (int q = 0; q < 4; ++q) *(f32x4*)(p.out + ro + RCOL(q, lane)) = z[q];
        } else store_row_bf(WS_(p, Hb) + ro, lane, z);
        if (nk == 0) {
            emit_mix6(p, nj, t, lane, z, zp);
#pragma unroll
            for (int q = 0; q < 4; ++q) zp[q] = z[q];
        }
    }
    if (nk == 1 || nk == 2) {
        asm volatile("s_waitcnt vmcnt(0)" ::: "memory");
        __syncthreads();
        const int nct = nk == 1 ? 2 : 1; const int rt = wid & 3, kh = wid >> 2;
        const bf16_t* Ab = WS_(p, Hb) + (size_t)(bid * 64 + 16 * rt + fr) * D + 512 * kh + 8 * fq;
        const bf16_t* Wb = (nk == 1 ? WS_(p, mb_dt_t) : WS_(p, gl_lr_t)) + (size_t)fr * D + 512 * kh + 8 * fq;
        f32x4 acc[2]; acc[0] = (f32x4){0.f, 0.f, 0.f, 0.f}; acc[1] = acc[0];
#pragma unroll 4
        for (int ks = 0; ks < 16; ++ks) {
            const bf16x8 af = *(const bf16x8*)(Ab + 32 * ks);
            acc[0] = MFMA16(af, *(const bf16x8*)(Wb + 32 * ks), acc[0]);
            if (nct == 2) acc[1] = MFMA16(af, *(const bf16x8*)(Wb + (size_t)16 * D + 32 * ks), acc[1]);
        }
#pragma unroll
        for (int ct = 0; ct < 2; ++ct)
#pragma unroll
            for (int r = 0; r < 4; ++r) lgt[(kh * 64 + 16 * rt + 4 * fq + r) * 32 + 16 * ct + fr] = acc[ct][r];
        __syncthreads();
        if (nk == 1) {
#pragma unroll
            for (int i = 0; i < 4; ++i) { const int idx = tid + i * NTHR; const int row = idx >> 5, o = idx & 31;
                WS_(p, DT)[(size_t)(bid * 64 + row) * 32 + o] = softplusf_(lgt[row * 32 + o] + lgt[(64 + row) * 32 + o] + p.mb_dt_bias[nj * 32 + o]); }
        } else {
            const int row = tid >> 3, c0 = (tid & 7) * 64; float lr[16];
#pragma unroll
            for (int o = 0; o < 16; ++o) lr[o] = lgt[row * 32 + o] + lgt[(64 + row) * 32 + o];
#pragma unroll 1
            for (int c4 = 0; c4 < 16; ++c4) { const int c = c0 + 4 * c4; f32x4 a = *(const f32x4*)(p.gl_gk_b + nj * 512 + c);
#pragma unroll
                for (int o = 0; o < 16; ++o) { const f32x4 wv = *(const LAS f32x4*)(w2 + o * 512 + c); a = a + wv * lr[o]; }
                f32x4 r;
#pragma unroll
                for (int e = 0; e < 4; ++e) r[e] = (fminf(a[e], 0.f) - __logf(1.0f + __expf(-fabsf(a[e])))) * (1.0f / 16.0f);
                *(f32x4*)(WS_(p, LA) + (size_t)(bid * 64 + row) * 512 + c) = r; }
        }
    }
}
constexpr int MB_PROJ = 5152;
struct SchedMbIn {
    const Params* p;
    DEV bool next(int i, Unit& u) const {
        int pm, pn; if (!pg8::tile_order(i, NB_, bid_(), 64, 20, pm, pn)) return false;
        u.A = (const char*)(WS_(*p, Hb) + (size_t)pm * 256 * D); u.B = (const char*)(WS_(*p, mb_win_t) + (size_t)pn * 256 * D); u.row0 = pm * 256; u.col0 = pn * 256; u.id = 0; u.aux = 0; return true;
    }
};
struct EpiMbIn {
    const Params* p;
    DEV void operator()(const AccT& acc, const Unit& u, int wr, int wc, int fr, int fq) const {
        const bool isz = u.col0 < 2048; bf16_t* O = WS_(*p, Z) + (isz ? (size_t)0 : (size_t)T * 2048 - 2048); const int ld = isz ? 2048 : 3072;
        FOR_ACC(ai, bj, m, n) { st_bf4(O + (size_t)ACC_ROW(u, ai, m) * ld + ACC_COL(u, bj, n), acc[ai][bj][m][n]); ACC_FENCE; }
    }
};
DEV void phase_mb_conv(const Params& p, int j) {
    const int tid = tid_(), bid = bid_(); (void)tid; (void)bid;
    if (tid >= 384) return;
    const int c0 = tid * 8; const int t0 = bid * 64;
    const float* cw = p.mb_conv_w + (size_t)j * 4 * 3072; const float* cb = p.mb_conv_b + (size_t)j * 3072;
    float w[4][8], b[8];
#pragma unroll
    for (int i = 0; i < 4; ++i) { const f32x4 a = *(const f32x4*)(cw + i * 3072 + c0), bb = *(const f32x4*)(cw + i * 3072 + c0 + 4); for (int e = 0; e < 4; ++e) { w[i][e] = a[e]; w[i][4 + e] = bb[e]; } }
    { const f32x4 a = *(const f32x4*)(cb + c0), bb = *(const f32x4*)(cb + c0 + 4); for (int e = 0; e < 4; ++e) { b[e] = a[e]; b[4 + e] = bb[e]; } }
    float x0[8], x1[8], x2[8], x3[8];
    auto ld = [&](int t, float (&x)[8]) {
        if (t < 0) { for (int e = 0; e < 8; ++e) x[e] = 0.f; return; }
        const u32x4 v = *(const u32x4*)(WS_(p, XBC) + (size_t)t * 3072 + c0);
        x[0] = bflo(v.x); x[1] = bfhi(v.x); x[2] = bflo(v.y); x[3] = bfhi(v.y); x[4] = bflo(v.z); x[5] = bfhi(v.z); x[6] = bflo(v.w); x[7] = bfhi(v.w);
    };
    ld(t0 - 3, x0); ld(t0 - 2, x1); ld(t0 - 1, x2);
#pragma unroll 4
    for (int tt = 0; tt < 64; ++tt) {
        ld(t0 + tt, x3);
        float o[8];
#pragma unroll
        for (int e = 0; e < 8; ++e) o[e] = siluf_(b[e] + w[0][e] * x0[e] + w[1][e] * x1[e] + w[2][e] * x2[e] + w[3][e] * x3[e]);
        u32x4 r; r.x = pk2(o[0], o[1]); r.y = pk2(o[2], o[3]); r.z = pk2(o[4], o[5]); r.w = pk2(o[6], o[7]);
        *(u32x4*)(WS_(p, XC) + (size_t)(t0 + tt) * 3072 + c0) = r;
#pragma unroll
        for (int e = 0; e < 8; ++e) { x0[e] = x1[e]; x1[e] = x2[e]; x2[e] = x3[e]; }
    }
}

DEV void mb_dacs(const Params& p, int j, int c, int g, LAS float* dts, LAS float* dacs) {
    const int tid = tid_(); const int lane = tid & 63, h = tid >> 6;
    const int hh = 8 * g + h; const float a = -__expf(p.mb_a_log[j * 32 + hh]);
    const float d0 = WS_(p, DT)[(size_t)(c * 128 + 2 * lane) * 32 + hh], d1 = WS_(p, DT)[(size_t)(c * 128 + 2 * lane + 1) * 32 + hh];
    const float a0 = d0 * a, a1 = d1 * a;
    float s = a0 + a1;
#pragma unroll
    for (int o = 1; o < 64; o <<= 1) { const float v = __shfl_up(s, o); if (lane >= o) s += v; }
    dts[h * 128 + 2 * lane] = d0; dts[h * 128 + 2 * lane + 1] = d1;
    dacs[h * 128 + 2 * lane] = s - a1; dacs[h * 128 + 2 * lane + 1] = s;
}
constexpr int LDB = 136;
constexpr int LDX = 72;
DEV void ld_tile128(const bf16_t* src, int gld, LAS bf16_t* dst) {
    const int tid = tid_();
    for (int i = tid; i < 128 * 16; i += NTHR) { const int r = i >> 4, c8 = (i & 15) * 8; *(LAS u32x4*)(dst + r * LDB + c8) = *(const u32x4*)(src + (size_t)r * gld + c8); }
}

DEV void phase_mb_states(const Params& p, int j, LAS unsigned char* lds) {
    const int tid = tid_(), bid = bid_(); (void)tid; (void)bid;
    const int lane = tid & 63, w = tid >> 6;
    LAS bf16_t* Bm = (LAS bf16_t*)lds;
    LAS bf16_t* Xh = Bm + 128 * LDB;
    LAS float* dts = (LAS float*)(Xh + 128 * LDX);
    LAS float* dacs = dts + 1024;
    for (int u = bid; u < 512; u += NB_) {
        const int c = u >> 2, g = u & 3; const int t0 = c * 128;
        lds_barrier();
        mb_dacs(p, j, c, g, dts, dacs);
        ld_tile128(WS_(p, XC) + (size_t)t0 * 3072 + 2048 + 128 * g, 3072, Bm);
        lds_barrier();
        if (tid < 8) WS_(p, CD)[(c * 32) + 8 * g + tid] = __expf(dacs[tid * 128 + 127]);
        bf16x8 bfr[4];
#pragma unroll
        for (int ks = 0; ks < 4; ++ks) bfr[ks] = frag_tr(Bm, LDB, 32 * ks, 16 * w, lane);
        for (int h = 0; h < 8; ++h) {
            { const int l = tid >> 2, p0 = (tid & 3) * 16; const float sc = dts[h * 128 + l] * __expf(dacs[h * 128 + 127] - dacs[h * 128 + l]);
              const bf16_t* src = WS_(p, XC) + (size_t)(t0 + l) * 3072 + 64 * (8 * g + h) + p0;
#pragma unroll
              for (int hf = 0; hf < 2; ++hf) { const u32x4 v = *(const u32x4*)(src + 8 * hf); u32x4 r;
                  r.x = pk2(bflo(v.x) * sc, bfhi(v.x) * sc); r.y = pk2(bflo(v.y) * sc, bfhi(v.y) * sc); r.z = pk2(bflo(v.z) * sc, bfhi(v.z) * sc); r.w = pk2(bflo(v.w) * sc, bfhi(v.w) * sc);
                  *(LAS u32x4*)(Xh + l * LDX + p0 + 8 * hf) = r; } }
            lds_barrier();
            f32x4 acc[4];
#pragma unroll
            for (int pb = 0; pb < 4; ++pb) { acc[pb] = (f32x4){0.f, 0.f, 0.f, 0.f};
#pragma unroll
                for (int ks = 0; ks < 4; ++ks) { const bf16x8 af = frag_tr(Xh, LDX, 32 * ks, 16 * pb, lane); acc[pb] = MFMA16(af, bfr[ks], acc[pb]); } }
            bf16_t* S = WS_(p, STATES) + (((size_t)c * 32 + 8 * g + h) * 64) * 128;
#pragma unroll
            for (int pb = 0; pb < 4; ++pb)
#pragma unroll
                for (int r = 0; r < 4; ++r) S[(size_t)(16 * pb + 4 * (lane >> 4) + r) * 128 + 16 * w + (lane & 15)] = (bf16_t)f2bf(acc[pb][r]);
            lds_barrier();
        }
    }
}
DEV void phase_mb_scan(const Params& p) {
    const int tid = tid_(), bid = bid_();
    if (tid >= 128) return;
    const int gid = bid * 128 + tid;
    const int n8 = gid & 15, pp = (gid >> 4) & 63, h = gid >> 10; const int n = 8 * n8;
    float r[8]; for (int e = 0; e < 8; ++e) r[e] = 0.f;
    const size_t eo = ((size_t)h * 64 + pp) * 128 + n;
    const size_t fo = (size_t)h * 64 * 128 + fragmajor_off(pp, n, 128);
#pragma unroll 8
    for (int c = 0; c < 128; ++c) {
        const u32x4 sr = *(const u32x4*)(WS_(p, STATES) + (size_t)c * 32 * 64 * 128 + eo);
        const float cd = WS_(p, CD)[c * 32 + h];
        u32x4 o; o.x = pk2(r[0], r[1]); o.y = pk2(r[2], r[3]); o.z = pk2(r[4], r[5]); o.w = pk2(r[6], r[7]);
        *(u32x4*)(WS_(p, PREV) + (size_t)c * 32 * 64 * 128 + fo) = o;
        r[0] = r[0] * cd + bflo(sr.x); r[1] = r[1] * cd + bfhi(sr.x); r[2] = r[2] * cd + bflo(sr.y); r[3] = r[3] * cd + bfhi(sr.y);
        r[4] = r[4] * cd + bflo(sr.z); r[5] = r[5] * cd + bfhi(sr.z); r[6] = r[6] * cd + bflo(sr.w); r[7] = r[7] * cd + bfhi(sr.w);
    }
}
DEV void phase_mb_out(const Params& p, int j, LAS unsigned char* lds) {
    const int tid = tid_(), bid = bid_(); (void)tid; (void)bid;
    const int lane = tid & 63, w = tid >> 6; const int fr = lane & 15, fq = lane >> 4;
    LAS bf16_t* Cm = (LAS bf16_t*)lds;
    LAS bf16_t* Bm = Cm + 128 * LDB;
    LAS bf16_t* Xh = Bm + 128 * LDB;
    LAS bf16_t* Mw = Xh + 128 * LDX;
    LAS float* dts = (LAS float*)(Mw + 8 * 16 * LDB);
    LAS float* dacs = dts + 1024;
    LAS bf16_t* Mme = Mw + w * 16 * LDB;
    for (int u = bid; u < 512; u += NB_) {
        const int c = u >> 2, g = u & 3; const int t0 = c * 128;
        lds_barrier();
        mb_dacs(p, j, c, g, dts, dacs);
        ld_tile128(WS_(p, XC) + (size_t)t0 * 3072 + 2048 + 512 + 128 * g, 3072, Cm);
        ld_tile128(WS_(p, XC) + (size_t)t0 * 3072 + 2048 + 128 * g, 3072, Bm);
        lds_barrier();
        f32x4 sc[8]; bf16x8 cf[4];
#pragma unroll
        for (int ks = 0; ks < 4; ++ks) cf[ks] = frag_rm(Cm, LDB, 16 * w, 32 * ks, lane);
#pragma unroll
        for (int sb = 0; sb < 8; ++sb) { sc[sb] = (f32x4){0.f, 0.f, 0.f, 0.f};
#pragma unroll
            for (int ks = 0; ks < 4; ++ks) sc[sb] = MFMA16(cf[ks], frag_rm(Bm, LDB, 16 * sb, 32 * ks, lane), sc[sb]); }
        float ssq = 0.f;
        const int rl = tid >> 2, p0 = (tid & 3) * 16;
        const LAS float* Yrow = (const LAS float*)(Mw + (rl >> 4) * 16 * LDB) + (rl & 15) * 68 + p0;
        LAS float* Yw = (LAS float*)Mme;
        u32x4 xraw[2], zraw[2], xnx[2], znx[2]; bf16x8 pfc[16];
#define MB_LOADH(HH, XR, ZR) do { const int hh_ = 8 * g + (HH); \
            XR[0] = *(const u32x4*)(WS_(p, XC) + (size_t)(t0 + rl) * 3072 + 64 * hh_ + p0); XR[1] = *(const u32x4*)(WS_(p, XC) + (size_t)(t0 + rl) * 3072 + 64 * hh_ + p0 + 8); \
            ZR[0] = *(const u32x4*)(WS_(p, Z) + (size_t)(t0 + rl) * 2048 + 64 * hh_ + p0); ZR[1] = *(const u32x4*)(WS_(p, Z) + (size_t)(t0 + rl) * 2048 + 64 * hh_ + p0 + 8); } while (0)
        MB_LOADH(0, xraw, zraw);
#pragma unroll 1
        for (int h = 0; h < 8; ++h) {
            const int hh = 8 * g + h;
            MB_LOADH(h < 7 ? h + 1 : h, xnx, znx);
            { const bf16_t* pv_ = WS_(p, PREV) + ((size_t)c * 32 + hh) * 64 * 128;
#pragma unroll
              for (int i_ = 0; i_ < 16; ++i_) pfc[i_] = *(const bf16x8*)(pv_ + ((size_t)i_ * 64 + lane) * 8); }
            { const float scl = dts[h * 128 + rl];
#pragma unroll
              for (int hf = 0; hf < 2; ++hf) { const u32x4 v = xraw[hf]; u32x4 r;
                  r.x = pk2(bflo(v.x) * scl, bfhi(v.x) * scl); r.y = pk2(bflo(v.y) * scl, bfhi(v.y) * scl); r.z = pk2(bflo(v.z) * scl, bfhi(v.z) * scl); r.w = pk2(bflo(v.w) * scl, bfhi(v.w) * scl);
                  *(LAS u32x4*)(Xh + rl * LDX + p0 + 8 * hf) = r; } }
            const u32x4 zraw0 = zraw[0], zraw1 = zraw[1];
            float dl[4];
#pragma unroll
            for (int r = 0; r < 4; ++r) dl[r] = dacs[h * 128 + 16 * w + 4 * fq + r];
#pragma unroll
            for (int sb = 0; sb < 8; ++sb) { const int s_ = 16 * sb + fr; const float ds = dacs[h * 128 + s_];
#pragma unroll
                for (int r = 0; r < 4; ++r) { const int l = 16 * w + 4 * fq + r; const float m = (s_ <= l) ? sc[sb][r] * __expf(dl[r] - ds) : 0.f; Mme[(4 * fq + r) * LDB + s_] = (bf16_t)f2bf(m); } }
            lds_barrier();
            bf16x8 mf[4];
#pragma unroll
            for (int ks = 0; ks < 4; ++ks) mf[ks] = frag_rm(Mme, LDB, 0, 32 * ks, lane);
            f32x4 yv[4];
#pragma unroll
            for (int pb = 0; pb < 4; ++pb) {
                f32x4 a = {0.f, 0.f, 0.f, 0.f}, o = {0.f, 0.f, 0.f, 0.f};
#pragma unroll
                for (int ks = 0; ks < 4; ++ks) {
                    a = MFMA16(mf[ks], frag_tr(Xh, LDX, 32 * ks, 16 * pb, lane), a);
                    o = MFMA16(cf[ks], pfc[pb * 4 + ks], o);
                }
#pragma unroll
                for (int r = 0; r < 4; ++r) a[r] += o[r] * __expf(dl[r]);
                yv[pb] = a;
            }
#pragma unroll
            for (int pb = 0; pb < 4; ++pb)
#pragma unroll
                for (int r = 0; r < 4; ++r) Yw[(4 * fq + r) * 68 + 16 * pb + fr] = yv[pb][r];
            lds_barrier();
            {
                const float dsk = p.mb_d[j * 32 + hh]; const float* ng = p.mb_norm_g + (size_t)j * 2048 + 64 * hh + p0;
                float y[16], xs[16], zz[16];
#pragma unroll
                for (int q = 0; q < 4; ++q) { const f32x4 t4 = *(const LAS f32x4*)(Yrow + 4 * q); y[4 * q] = t4[0]; y[4 * q + 1] = t4[1]; y[4 * q + 2] = t4[2]; y[4 * q + 3] = t4[3]; }
                xs[0] = bflo(xraw[0].x); xs[1] = bfhi(xraw[0].x); xs[2] = bflo(xraw[0].y); xs[3] = bfhi(xraw[0].y); xs[4] = bflo(xraw[0].z); xs[5] = bfhi(xraw[0].z); xs[6] = bflo(xraw[0].w); xs[7] = bfhi(xraw[0].w);
                xs[8] = bflo(xraw[1].x); xs[9] = bfhi(xraw[1].x); xs[10] = bflo(xraw[1].y); xs[11] = bfhi(xraw[1].y); xs[12] = bflo(xraw[1].z); xs[13] = bfhi(xraw[1].z); xs[14] = bflo(xraw[1].w); xs[15] = bfhi(xraw[1].w);
                zz[0] = bflo(zraw0.x); zz[1] = bfhi(zraw0.x); zz[2] = bflo(zraw0.y); zz[3] = bfhi(zraw0.y); zz[4] = bflo(zraw0.z); zz[5] = bfhi(zraw0.z); zz[6] = bflo(zraw0.w); zz[7] = bfhi(zraw0.w);
                zz[8] = bflo(zraw1.x); zz[9] = bfhi(zraw1.x); zz[10] = bflo(zraw1.y); zz[11] = bfhi(zraw1.y); zz[12] = bflo(zraw1.z); zz[13] = bfhi(zraw1.z); zz[14] = bflo(zraw1.w); zz[15] = bfhi(zraw1.w);
                float o[16];
#pragma unroll
                for (int q = 0; q < 4; ++q) { const f32x4 n4 = *(const f32x4*)(ng + 4 * q);
#pragma unroll
                    for (int e = 0; e < 4; ++e) { const int i = 4 * q + e; const float v = (y[i] + xs[i] * dsk) * siluf_(zz[i]); ssq += v * v; o[i] = v * n4[e]; } }
                bf16_t* dst = WS_(p, YB) + (size_t)(t0 + rl) * 2048 + 64 * hh + p0;
                u32x4 w0, w1; w0.x = pk2(o[0], o[1]); w0.y = pk2(o[2], o[3]); w0.z = pk2(o[4], o[5]); w0.w = pk2(o[6], o[7]); w1.x = pk2(o[8], o[9]); w1.y = pk2(o[10], o[11]); w1.z = pk2(o[12], o[13]); w1.w = pk2(o[14], o[15]);
                *(u32x4*)dst = w0; *(u32x4*)(dst + 8) = w1;
            }
            xraw[0] = xnx[0]; xraw[1] = xnx[1]; zraw[0] = znx[0]; zraw[1] = znx[1];
            lds_barrier();
        }
#undef MB_LOADH
        ssq += __shfl_xor(ssq, 1); ssq += __shfl_xor(ssq, 2);
        const float rstd = rsqrtf(ssq * (1.0f / 512.0f) + 1e-5f);
#pragma unroll 1
        for (int h = 0; h < 8; ++h) {
            bf16_t* dst = WS_(p, YB) + (size_t)(t0 + rl) * 2048 + 64 * (8 * g + h) + p0;
#pragma unroll
            for (int hf = 0; hf < 2; ++hf) { const u32x4 v = *(const u32x4*)(dst + 8 * hf); u32x4 r;
                r.x = pk2(bflo(v.x) * rstd, bfhi(v.x) * rstd); r.y = pk2(bflo(v.y) * rstd, bfhi(v.y) * rstd); r.z = pk2(bflo(v.z) * rstd, bfhi(v.z) * rstd); r.w = pk2(bflo(v.w) * rstd, bfhi(v.w) * rstd);
                *(u32x4*)(dst + 8 * hf) = r; }
        }
    }
}
constexpr int GL_PROJ = 3088;
constexpr int LDV = 264;
struct SchedGlIn {
    const Params* p;
    DEV bool next(int i, Unit& u) const {
        int pm, pn; if (!pg8::tile_order(i, NB_, bid_(), 64, 12, pm, pn)) return false;
        u.A = (const char*)(WS_(*p, Hb) + (size_t)pm * 256 * D); u.B = (const char*)(WS_(*p, gl_win_t) + (size_t)pn * 256 * D); u.row0 = pm * 256; u.col0 = pn * 256; u.id = 0; u.aux = 0; return true;
    }
};
struct EpiGlIn {
    const Params* p;
    DEV void operator()(const AccT& acc, const Unit& u, int wr, int wc, int fr, int fq) const {
        FOR_ACC(ai, bj, m, n) { st_bf4(WS_(*p, QKVG) + (size_t)ACC_ROW(u, ai, m) * 3072 + ACC_COL(u, bj, n), acc[ai][bj][m][n]); ACC_FENCE; }
    }
};
DEV void gl_bcs(const Params& p, int n, int h, LAS float* bcs) {
    const int tid = tid_();
    for (int i = tid; i < 64 * 32; i += NTHR) { const int r = i >> 5, c4 = (i & 31) * 4; *(LAS f32x4*)(bcs + r * 128 + c4) = *(const f32x4*)(WS_(p, LA) + (size_t)(n * 64 + r) * 512 + 128 * h + c4); }
    lds_barrier();
    if (tid < 128) { float s = 0.f; for (int r = 0; r < 64; ++r) { s += bcs[r * 128 + tid]; bcs[r * 128 + tid] = s; } }
    lds_barrier();
}
DEV void phase_gl_kv(const Params& p, LAS unsigned char* lds) {
    const int tid = tid_(), bid = bid_(); (void)tid; (void)bid;
    const int lane = tid & 63, w = tid >> 6;
    LAS float* bcs = (LAS float*)lds;
    LAS bf16_t* Ke = (LAS bf16_t*)(bcs + 64 * 128);
    LAS bf16_t* Vs = Ke + 64 * LDB;
    for (int u = bid; u < 1024; u += NB_) {
        const int n = u >> 2, h = u & 3; const int t0 = n * 64;
        lds_barrier();
        gl_bcs(p, n, h, bcs);
        for (int i = tid; i < 64 * 16; i += NTHR) { const int r = i >> 4, c8 = (i & 15) * 8;
            const u32x4 v = *(const u32x4*)(WS_(p, QKVG) + (size_t)(t0 + r) * 3072 + 512 + 128 * h + c8); float f[8];
            f[0] = bflo(v.x); f[1] = bfhi(v.x); f[2] = bflo(v.y); f[3] = bfhi(v.y); f[4] = bflo(v.z); f[5] = bfhi(v.z); f[6] = bflo(v.w); f[7] = bfhi(v.w);
#pragma unroll
            for (int e = 0; e < 8; ++e) f[e] *= __expf(bcs[63 * 128 + c8 + e] - bcs[r * 128 + c8 + e]);
            u32x4 o; o.x = pk2(f[0], f[1]); o.y = pk2(f[2], f[3]); o.z = pk2(f[4], f[5]); o.w = pk2(f[6], f[7]);
            *(LAS u32x4*)(Ke + r * LDB + c8) = o; }
        for (int i = tid; i < 64 * 32; i += NTHR) { const int r = i >> 5, c8 = (i & 31) * 8; *(LAS u32x4*)(Vs + r * LDV + c8) = *(const u32x4*)(WS_(p, QKVG) + (size_t)(t0 + r) * 3072 + 1024 + 256 * h + c8); }
        if (tid < 128) WS_(p, CDG)[((size_t)n * 4 + h) * 128 + tid] = __expf(bcs[63 * 128 + tid]);
        lds_barrier();
        bf16x8 af[2];
#pragma unroll
        for (int ks = 0; ks < 2; ++ks) af[ks] = frag_tr(Ke, LDB, 32 * ks, 16 * w, lane);
        bf16_t* O = WS_(p, STATES) + (((size_t)n * 4 + h) * 128) * 256;
#pragma unroll
        for (int vb = 0; vb < 16; ++vb) {
            f32x4 acc = {0.f, 0.f, 0.f, 0.f};
#pragma unroll
            for (int ks = 0; ks < 2; ++ks) acc = MFMA16(af[ks], frag_tr(Vs, LDV, 32 * ks, 16 * vb, lane), acc);
            { u32x2 o; o.x = pk2(acc[0], acc[1]); o.y = pk2(acc[2], acc[3]); *(u32x2*)(O + (size_t)(16 * vb + (lane & 15)) * 128 + 16 * w + 4 * (lane >> 4)) = o; }
        }
    }
}
DEV void phase_gl_scan(const Params& p) {
    const int tid = tid_(), bid = bid_();
    if (tid >= 64) return;
    const int gid = bid * 64 + tid;
    const int k8 = gid & 15, v = (gid >> 4) & 255, h = gid >> 12; const int k = 8 * k8;
    float r[8]; for (int e = 0; e < 8; ++e) r[e] = 0.f;
    const size_t fo = (size_t)h * 128 * 256 + fragmajor_off(v, k, 128);
#pragma unroll 8
    for (int n = 0; n < 256; ++n) {
        const u32x4 sr = *(const u32x4*)(WS_(p, STATES) + (((size_t)n * 4 + h) * 256 + v) * 128 + k);
        const f32x4 c0 = *(const f32x4*)(WS_(p, CDG) + ((size_t)n * 4 + h) * 128 + k), c1 = *(const f32x4*)(WS_(p, CDG) + ((size_t)n * 4 + h) * 128 + k + 4);
        u32x4 o; o.x = pk2(r[0], r[1]); o.y = pk2(r[2], r[3]); o.z = pk2(r[4], r[5]); o.w = pk2(r[6], r[7]);
        *(u32x4*)(WS_(p, PREV) + (size_t)n * 4 * 128 * 256 + fo) = o;
        r[0] = r[0] * c0[0] + bflo(sr.x); r[1] = r[1] * c0[1] + bfhi(sr.x); r[2] = r[2] * c0[2] + bflo(sr.y); r[3] = r[3] * c0[3] + bfhi(sr.y);
        r[4] = r[4] * c1[0] + bflo(sr.z); r[5] = r[5] * c1[1] + bfhi(sr.z); r[6] = r[6] * c1[2] + bflo(sr.w); r[7] = r[7] * c1[3] + bfhi(sr.w);
    }
}
DEV void phase_gl_out(const Params& p, int j, LAS unsigned char* lds) {
    const int tid = tid_(), bid = bid_(); (void)tid; (void)bid;
    const int lane = tid & 63, w = tid >> 6; const int fr = lane & 15, fq = lane >> 4;
    LAS float* bcs = (LAS float*)lds;
    LAS bf16_t* Qs = (LAS bf16_t*)(bcs + 64 * 128);
    LAS bf16_t* Ks = Qs + 64 * LDB;
    LAS bf16_t* Vs = Ks + 64 * LDB;
    LAS bf16_t* At = Vs + 64 * LDV;
    LAS float* red = (LAS float*)(At + 64 * LDX);
    for (int u = bid; u < 1024; u += NB_) {
        const int n = u >> 2, h = u & 3; const int t0 = n * 64;
        lds_barrier();
        gl_bcs(p, n, h, bcs);
        for (int i = tid; i < 64 * 16; i += NTHR) { const int r = i >> 4, c8 = (i & 15) * 8;
            const u32x4 vq = *(const u32x4*)(WS_(p, QKVG) + (size_t)(t0 + r) * 3072 + 128 * h + c8), vk = *(const u32x4*)(WS_(p, QKVG) + (size_t)(t0 + r) * 3072 + 512 + 128 * h + c8);
            float fq_[8], fk_[8];
            fq_[0] = bflo(vq.x); fq_[1] = bfhi(vq.x); fq_[2] = bflo(vq.y); fq_[3] = bfhi(vq.y); fq_[4] = bflo(vq.z); fq_[5] = bfhi(vq.z); fq_[6] = bflo(vq.w); fq_[7] = bfhi(vq.w);
            fk_[0] = bflo(vk.x); fk_[1] = bfhi(vk.x); fk_[2] = bflo(vk.y); fk_[3] = bfhi(vk.y); fk_[4] = bflo(vk.z); fk_[5] = bfhi(vk.z); fk_[6] = bflo(vk.w); fk_[7] = bfhi(vk.w);
#pragma unroll
            for (int e = 0; e < 8; ++e) { const float b = bcs[r * 128 + c8 + e]; fq_[e] *= __expf(b) * 0.08838834764831845f; fk_[e] *= __expf(-b); }
            u32x4 o; o.x = pk2(fq_[0], fq_[1]); o.y = pk2(fq_[2], fq_[3]); o.z = pk2(fq_[4], fq_[5]); o.w = pk2(fq_[6], fq_[7]);
            *(LAS u32x4*)(Qs + r * LDB + c8) = o;
            o.x = pk2(fk_[0], fk_[1]); o.y = pk2(fk_[2], fk_[3]); o.z = pk2(fk_[4], fk_[5]); o.w = pk2(fk_[6], fk_[7]);
            *(LAS u32x4*)(Ks + r * LDB + c8) = o; }
        for (int i = tid; i < 64 * 32; i += NTHR) { const int r = i >> 5, c8 = (i & 31) * 8; *(LAS u32x4*)(Vs + r * LDV + c8) = *(const u32x4*)(WS_(p, QKVG) + (size_t)(t0 + r) * 3072 + 1024 + 256 * h + c8); }
        lds_barrier();
        { const int ib = w >> 1;
#pragma unroll
          for (int jj = 0; jj < 2; ++jj) { const int jb = 2 * (w & 1) + jj; f32x4 a = {0.f, 0.f, 0.f, 0.f};
#pragma unroll
              for (int ks = 0; ks < 4; ++ks) a = MFMA16(frag_rm(Qs, LDB, 16 * ib, 32 * ks, lane), frag_rm(Ks, LDB, 16 * jb, 32 * ks, lane), a);
#pragma unroll
              for (int r = 0; r < 4; ++r) { const int i = 16 * ib + 4 * fq + r, jx = 16 * jb + fr; At[i * LDX + jx] = (bf16_t)f2bf(jx <= i ? a[r] : 0.f); } } }
        lds_barrier();
        f32x4 o[4][2];
        const bf16_t* pv = WS_(p, PREV) + ((size_t)n * 4 + h) * 128 * 256;
#pragma unroll
        for (int vv = 0; vv < 2; ++vv) { const int vb = 2 * w + vv;
            bf16x8 bi[2], bp[4];
#pragma unroll
            for (int ks = 0; ks < 2; ++ks) bi[ks] = frag_tr(Vs, LDV, 32 * ks, 16 * vb, lane);
#pragma unroll
            for (int ks = 0; ks < 4; ++ks) bp[ks] = *(const bf16x8*)(pv + ((size_t)(vb * 4 + ks) * 64 + lane) * 8);
#pragma unroll
            for (int ib = 0; ib < 4; ++ib) { f32x4 a = {0.f, 0.f, 0.f, 0.f};
#pragma unroll
                for (int ks = 0; ks < 2; ++ks) a = MFMA16(frag_rm(At, LDX, 16 * ib, 32 * ks, lane), bi[ks], a);
#pragma unroll
                for (int ks = 0; ks < 4; ++ks) a = MFMA16(frag_rm(Qs, LDB, 16 * ib, 32 * ks, lane), bp[ks], a);
                o[ib][vv] = a; } }
#pragma unroll
        for (int ib = 0; ib < 4; ++ib)
#pragma unroll
            for (int r = 0; r < 4; ++r) { float s = o[ib][0][r] * o[ib][0][r] + o[ib][1][r] * o[ib][1][r]; s = sum16(s); if (fr == 0) red[w * 64 + 16 * ib + 4 * fq + r] = s; }
        lds_barrier();
        {   LAS bf16_t* Os = (LAS bf16_t*)bcs;
#pragma unroll
            for (int ib = 0; ib < 4; ++ib)
#pragma unroll
                for (int vv = 0; vv < 2; ++vv)
#pragma unroll
                    for (int r = 0; r < 4; ++r) Os[(16 * ib + 4 * fq + r) * LDV + 32 * w + 16 * vv + fr] = (bf16_t)f2bf(o[ib][vv][r]);
            lds_barrier();
            const int row = tid >> 3, c0 = (tid & 7) * 32; const int t = t0 + row; float s = 0.f;
#pragma unroll
            for (int ww = 0; ww < 8; ++ww) s += red[ww * 64 + row];
            const float rs = rsqrtf(s * (1.0f / 256.0f) + 1e-5f);
#pragma unroll
            for (int q = 0; q < 4; ++q) {
                const u32x4 ov = *(const LAS u32x4*)(Os + row * LDV + c0 + 8 * q), gv = *(const u32x4*)(WS_(p, QKVG) + (size_t)t * 3072 + 2048 + 256 * h + c0 + 8 * q);
                const f32x4 n0 = *(const f32x4*)(p.gl_norm_g + j * 256 + c0 + 8 * q), n1 = *(const f32x4*)(p.gl_norm_g + j * 256 + c0 + 8 * q + 4);
                float r8[8];
                r8[0] = bflo(ov.x) * rs * n0[0] * siluf_(bflo(gv.x)); r8[1] = bfhi(ov.x) * rs * n0[1] * siluf_(bfhi(gv.x)); r8[2] = bflo(ov.y) * rs * n0[2] * siluf_(bflo(gv.y)); r8[3] = bfhi(ov.y) * rs * n0[3] * siluf_(bfhi(gv.y));
                r8[4] = bflo(ov.z) * rs * n1[0] * siluf_(bflo(gv.z)); r8[5] = bfhi(ov.z) * rs * n1[1] * siluf_(bfhi(gv.z)); r8[6] = bflo(ov.w) * rs * n1[2] * siluf_(bflo(gv.w)); r8[7] = bfhi(ov.w) * rs * n1[3] * siluf_(bfhi(gv.w));
                u32x4 wv; wv.x = pk2(r8[0], r8[1]); wv.y = pk2(r8[2], r8[3]); wv.z = pk2(r8[4], r8[5]); wv.w = pk2(r8[6], r8[7]);
                *(u32x4*)(WS_(p, YB) + (size_t)t * D + 256 * h + c0 + 8 * q) = wv;
            }
        }
    }
}
#define XB_TMO      128
#define XB_XCNT(j)  (256  + 64 * (j))
#define XB_XSUB(j)  (1280 + 64 * (j))
#define XB_XGEN(j)  (2304 + 64 * (j))
#define XB_TOP      3328
#define XB_TOPGEN   3392
#define XCD_BAR_WORDS 3456
#define XB_SPIN_CAP (1u << 22)
DEV unsigned xb_ld(unsigned* p)              { return __hip_atomic_load(p, __ATOMIC_RELAXED, __HIP_MEMORY_SCOPE_AGENT); }
DEV unsigned xb_add(unsigned* p, unsigned v) { return __hip_atomic_fetch_add(p, v, __ATOMIC_RELAXED, __HIP_MEMORY_SCOPE_AGENT); }
DEV unsigned xb_xcc_id() { return (unsigned)__builtin_amdgcn_s_getreg((3 << 11) | 20) & 0xFu; }
#define XB_SPIN(cond, bar) do { unsigned _sp = 0; while (cond) { __builtin_amdgcn_s_sleep(1); \
    if ((++_sp & 255u) == 0u) { if (xb_ld(&(bar)[XB_TMO])) break; if (_sp > XB_SPIN_CAP) { atomicAdd(&(bar)[XB_TMO], 1u); break; } } } } while (0)
struct XcdBarrier { unsigned* bar; unsigned x; volatile LAS unsigned* st; };
DEV XcdBarrier xcd_barrier_post(unsigned* bar, volatile LAS unsigned* st) {
    XcdBarrier b; b.bar = bar; b.x = xb_xcc_id(); b.st = st;
    if (threadIdx.x == 0) (void)xb_add(&bar[XB_XCNT(b.x)], 1u);
    return b;
}
DEV void xcd_barrier_complete(unsigned* bar, unsigned x, unsigned& nloc, unsigned& nx) {
    const unsigned G = gridDim.x * gridDim.y * gridDim.z;
    unsigned sum, cnt, mine, sp = 0u;
    for (;;) {
        sum = 0u; cnt = 0u; mine = 0u;
#pragma unroll
        for (unsigned j = 0; j < 16; ++j) { const unsigned c = xb_ld(&bar[XB_XCNT(j)]); sum += c; cnt += (c > 0u) ? 1u : 0u; mine = (j == x) ? c : mine; }
        if (sum == G) break;
        __builtin_amdgcn_s_sleep(1);
        if ((++sp & 255u) == 0u) { if (xb_ld(&bar[XB_TMO])) break; if (sp > XB_SPIN_CAP) { atomicAdd(&bar[XB_TMO], 1u); break; } }
    }
    nloc = mine > 0u ? mine : 1u; nx = cnt > 0u ? cnt : 1u;
}
DEV void xcd_barrier(const XcdBarrier& b) {
    asm volatile("s_waitcnt vmcnt(0)" ::: "memory");
    __syncthreads();
    if (threadIdx.x == 0) {
        unsigned* bar = b.bar;
        __builtin_amdgcn_s_waitcnt(0);
        unsigned nloc = b.st[0], nx = b.st[1];
        if (nloc == 0u) { xcd_barrier_complete(bar, b.x, nloc, nx); b.st[0] = nloc; b.st[1] = nx; }
        const unsigned old = xb_add(&bar[XB_XSUB(b.x)], 1u);
        const unsigned gen = old / nloc;
        if (old + 1u == (gen + 1u) * nloc) {
            __builtin_amdgcn_fence(__ATOMIC_RELEASE, "agent");
            asm volatile("s_waitcnt vmcnt(0)" ::: "memory");
            const unsigned og = xb_add(&bar[XB_TOP], 1u);
            const unsigned tg = og / nx;
            if (og + 1u == (tg + 1u) * nx) xb_add(&bar[XB_TOPGEN], 1u);
            else XB_SPIN(xb_ld(&bar[XB_TOPGEN]) == tg, bar);
            __builtin_amdgcn_fence(__ATOMIC_ACQUIRE, "agent");
            xb_add(&bar[XB_XGEN(b.x)], 1u);
            asm volatile("s_waitcnt vmcnt(0)" ::: "memory");
        } else {
            XB_SPIN(xb_ld(&bar[XB_XGEN(b.x)]) == gen, bar);
            __builtin_amdgcn_fence(__ATOMIC_ACQUIRE, "agent");
            asm volatile("s_waitcnt vmcnt(0)" ::: "memory");
        }
    }
    __syncthreads();
}

DEV void moe_tail_convert(const Params& p, LAS unsigned char* lds, const LAS int* tab, int layer, int which) {
    if (layer != 1 && layer != 2) return;
    const int total = tab[33] * 4, rem = total % NB_;
    const int B0 = rem, NBW = NB_ - rem;
    if (bid_() >= B0) { const ConvJob J = moe_job(p, which, layer + 1); convert_one(J, lds, B0, NBW, 0); }
}
DEV LAS int* moe_tab_to_lds(const Params& p, LAS unsigned char* lds) {
    LAS int* tab = (LAS int*)(lds + pg8::STAGE_BYTES);
    const int tid = tid_();
    if (tid < 256) tab[tid] = __hip_atomic_load(WS_(p, TAB) + tid, __ATOMIC_RELAXED, __HIP_MEMORY_SCOPE_AGENT);
    __syncthreads();
    return tab;
}
DEV void run_phase(const Params& pin, int op, int arg, LAS unsigned char* lds) {
    Params p = pin; { size_t z_ = 0; asm volatile("" : "+s"(z_)); p.ws = pin.ws + z_; }
    const int layer = arg; const int jj = layer / 3;
#ifdef ONLY_OP
    if (op != ONLY_OP) return;
#endif
#ifdef OPMASK
    if (!((OPMASK >> op) & 1ull)) return;
#endif
    switch (op) {
    case OP_CONVERT: phase_pre0(p); phase_convert(p, lds);
#ifdef DBG
        if (blockIdx.x == 0 && threadIdx.x < 24) WS_(p, TAB)[200 + threadIdx.x] = 0;
#endif
        break;
    case OP_PRE0: break;
    case OP_RW_GEMM1: { SchedRW1 S{&p, jj}; EpiRW1 E{&p}; pg8::gemm_phase(lds, 1024, S, E); } break;
    case OP_RW_GEMM2: { SchedRW2 S{&p, jj}; EpiRW2 E{&p, jj}; pg8::gemm_phase(lds, 256, S, E); } break;
    case OP_RW_CHA: phase_rw_cha(p, jj, lds); break;
    case OP_RW_CHB: phase_rw_chb(p, layer, lds); break;
    case OP_RW_CHC: phase_rw_chc(p, jj, lds); break;
    case OP_RW_OUT: { SchedOut S{WS_(p, YB), WS_(p, rw_wo_t) + (size_t)jj * D * D, 1024}; EpiOut E{WS_(p, MIXb)}; pg8::gemm_phase(lds, 1024, S, E); } break;
    case OP_LN1: phase_ln1(p, layer, lds); break;
    case OP_MOE_SCATTER: phase_moe_scatter(p, lds); break;
    case OP_MOE_GEMM1: { LAS int* tab = moe_tab_to_lds(p, lds); SchedMoe<0> S{&p, layer, tab}; EpiMoe1 E{WS_(p, ACT)}; pg8::gemm_phase(lds, 1024, S, E); moe_tail_convert(p, lds, tab, layer, 0); } break;
    case OP_MOE_GEMM2: { LAS int* tab = moe_tab_to_lds(p, lds); SchedMoe<1> S{&p, layer, tab}; EpiMoe2 E{WS_(p, YBUF)}; pg8::gemm_phase(lds, 512, S, E); moe_tail_convert(p, lds, tab, layer, 1); } break;
    case OP_LN2: phase_ln2(p, layer, lds); break;
    case OP_MB_GEMM_IN: { SchedMbIn S{&p}; EpiMbIn E{&p}; pg8::gemm_phase(lds, 1024, S, E); } break;
    case OP_MB_CONV: phase_mb_conv(p, jj); break;
    case OP_MB_STATES: phase_mb_states(p, jj, lds); break;
    case OP_MB_SCAN: phase_mb_scan(p); break;
    case OP_MB_OUT: phase_mb_out(p, jj, lds); break;
    case OP_MB_GEMM_OUT: { SchedOut S{WS_(p, YB), WS_(p, mb_wout_t) + (size_t)jj * D * 2048, 2048}; EpiOut E{WS_(p, MIXb)}; pg8::gemm_phase(lds, 2048, S, E); } break;
    case OP_GL_GEMM_IN: { SchedGlIn S{&p}; EpiGlIn E{&p}; pg8::gemm_phase(lds, 1024, S, E); } break;
    case OP_GL_KV: phase_gl_kv(p, lds); break;
    case OP_GL_SCAN: phase_gl_scan(p); break;
    case OP_GL_OUT: phase_gl_out(p, jj, lds); break;
    case OP_GL_GEMM_OUT: { SchedOut S{WS_(p, YB), WS_(p, gl_wout_t) + (size_t)jj * D * D, 1024}; EpiOut E{WS_(p, MIXb)}; pg8::gemm_phase(lds, 1024, S, E); } break;
    default: break;
    }
}

constexpr int NPHASES = 1 + 11 + 11 + 10 + 11;
DEV void decode_phase(int ph, int& op, int& layer) {
    if (ph < 1) { op = OP_CONVERT; layer = 0; return; }
    int q = ph - 1; layer = 0;
    if (q >= 11) { q -= 11; layer = 1; if (q >= 11) { q -= 11; layer = 2; if (q >= 10) { q -= 10; layer = 3; } } }
    const int kind = layer % 3; const int nmix = kind == 2 ? 5 : 6;
    if (q < nmix) op = (kind == 0 ? OP_RW_GEMM1 : kind == 1 ? OP_MB_GEMM_IN : OP_GL_GEMM_IN) + q;
    else op = OP_LN1 + (q - nmix);
}

#define X(t, n) t n##_,
template <bool COOP>
__global__ void __launch_bounds__(NTHR, 2) mega(PARAM_LIST(X) const int ph0, const int ph1) {
#undef X
    Params p;
#define X(t, n) p.n = n##_;
    PARAM_LIST(X)
#undef X

    extern __shared__ __attribute__((aligned(16))) unsigned char smem_raw[];
    LAS unsigned char* lds = (LAS unsigned char*)smem_raw;
    if constexpr (COOP) {
        volatile LAS unsigned* st = (volatile LAS unsigned*)(lds + LDS_BYTES - 16);
        if (threadIdx.x == 0) { st[0] = 0u; st[1] = 0u; }
        __syncthreads();
        XcdBarrier xb = xcd_barrier_post(WS_(p, bar), st);
        if (ph0 < 0) cg::this_grid().sync();
        for (int ph = ph0; ph < ph1; ++ph) {
            int op, arg; decode_phase(ph, op, arg);
#ifdef REPEAT_MASK
            const int reps = 1 + (int)((REPEAT_MASK >> op) & 1ull);
#else
            const int reps = 1;
#endif
#pragma unroll 1
            for (int rep = 0; rep < reps; ++rep) {
                run_phase(p, op, arg, lds);
                if (ph + 1 < ph1 || rep + 1 < reps) { xcd_barrier(xb);
#ifdef BAR2
                    xcd_barrier(xb);
#endif
                }
            }
        }
#ifdef DBG
        xcd_barrier(xb);
#ifndef DBG_WORD
#define DBG_WORD 200
#endif
        { const int code = __hip_atomic_load(WS_(p, TAB) + DBG_WORD, __ATOMIC_RELAXED, __HIP_MEMORY_SCOPE_AGENT);
          for (size_t i = (size_t)blockIdx.x * NTHR + threadIdx.x; i < (size_t)T * D; i += (size_t)NB_ * NTHR) p.out[i] = 0.f;
          __syncthreads();
          if (blockIdx.x == 0 && threadIdx.x == 0) p.out[0] = sqrtf((float)DBG_DECODE(code) * 1.68e7f); }
#endif
    } else {
        for (int ph = ph0; ph < ph1; ++ph) { int op, arg; decode_phase(ph, op, arg); run_phase(p, op, arg, lds); }
    }
}


extern "C" void kernel_launch(void* const* d_in, const int* in_sizes, int n_in, void* d_out, int out_size, void* d_ws, size_t ws_size, hipStream_t stream) {
    (void)in_sizes; (void)n_in; (void)out_size;
    Params p; std::memset((void*)&p, 0, sizeof(p));
    auto F = [&](int i) { return (const float*)d_in[i]; };
    p.x = F(0); p.ln_g = F(1); p.ln_b = F(2);
    p.rw_mu = F(3); p.rw_w_rkv = F(4); p.rw_w0 = F(5); p.rw_w1 = F(6); p.rw_w2 = F(7); p.rw_a0 = F(8);
    p.rw_a1 = F(9); p.rw_a2 = F(10); p.rw_g1 = F(11); p.rw_g2 = F(12);
    p.rw_k_k = F(13); p.rw_k_a = F(14); p.rw_r_k = F(15); p.rw_lnx_g = F(16); p.rw_lnx_b = F(17); p.rw_w_o = F(18);
    p.mb_w_in = F(19); p.mb_conv_w = F(20); p.mb_conv_b = F(21); p.mb_dt_bias = F(22); p.mb_a_log = F(23); p.mb_d = F(24); p.mb_norm_g = F(25); p.mb_w_out = F(26);
    p.gl_w_in = F(27); p.gl_gk_w2 = F(28); p.gl_gk_b = F(29); p.gl_norm_g = F(30); p.gl_w_out = F(31);
    p.moe_w_group = F(32); p.moe_b_group = F(33); p.moe_w_route = F(34); p.moe_b_route = F(35); p.moe_w_in = F(36); p.moe_w_down = F(37);
    p.out = (float*)d_out;
    p.ws = (char*)d_ws;
    if (WS_TOTAL > ws_size) { fprintf(stderr, "workspace too small: need %zu have %zu\n", (size_t)WS_TOTAL, ws_size); return; }
    unsigned* bar_ptr = (unsigned*)(p.ws + OFF_bar);
    const int np = NPHASES;
#define X(t, n) (void*)&p.n,
#if SINGLE_LAUNCH
    (void)hipFuncSetAttribute((const void*)mega<true>, hipFuncAttributeMaxDynamicSharedMemorySize, LDS_BYTES);
    (void)hipMemsetAsync(bar_ptr, 0, XCD_BAR_WORDS * sizeof(unsigned), stream);
    int ph0 = 0, ph1 = np; void* args[] = {PARAM_LIST(X) (void*)&ph0, (void*)&ph1};
    hipError_t e = hipLaunchCooperativeKernel((const void*)mega<true>, dim3(NBLK), dim3(NTHR), args, LDS_BYTES, stream);
    if (e != hipSuccess) fprintf(stderr, "cooperative launch failed: %s\n", hipGetErrorString(e));
#else
    (void)hipFuncSetAttribute((const void*)mega<false>, hipFuncAttributeMaxDynamicSharedMemorySize, LDS_BYTES);
    for (int ph = 0; ph < np; ++ph) { int ph0 = ph, ph1 = ph + 1; void* args[] = {PARAM_LIST(X) (void*)&ph0, (void*)&ph1};
        hipError_t e = hipLaunchKernel((const void*)mega<false>, dim3(NBLK), dim3(NTHR), args, LDS_BYTES, stream);
        if (e != hipSuccess) fprintf(stderr, "launch failed: %s\n", hipGetErrorString(e)); }
#endif
#undef X
}
```

```cpp
#include <hip/hip_runtime.h>
#include <hip/hip_cooperative_groups.h>
#include <cstdint>
#include <cstdio>
#include <cstring>
namespace cg = cooperative_groups;

typedef unsigned short bf16_t;
typedef short bf16x8 __attribute__((ext_vector_type(8)));
typedef short s16x4 __attribute__((ext_vector_type(4)));
typedef float f32x4 __attribute__((ext_vector_type(4)));
typedef float f32x2 __attribute__((ext_vector_type(2)));
typedef unsigned u32x4 __attribute__((ext_vector_type(4)));
typedef unsigned u32x2 __attribute__((ext_vector_type(2)));
#define LAS __attribute__((address_space(3)))
#define DEV __device__ __forceinline__

constexpr int T = 16384, D = 1024, DEPTH = 4;
constexpr int NTHR = 512, NBLK = 256;
constexpr int LDS_BYTES = 155648;
constexpr float ALPHA = 1.681792830507429f;
constexpr float LN_EPS = 1e-5f;
constexpr int MOE_ROWS = 40960;

DEV int tid_() { int t = threadIdx.x; asm volatile("" : "+v"(t)); return t; }
DEV int bid_() { int b = blockIdx.x; asm volatile("" : "+s"(b)); return b; }
#define NB_ 256
#define RCOL(q, lane) ((((q) >> 1) * 512) + 8 * (lane) + 4 * ((q) & 1))
DEV void lds_barrier() { asm volatile("s_waitcnt lgkmcnt(0)" ::: "memory"); __builtin_amdgcn_s_barrier(); asm volatile("" ::: "memory"); }
DEV unsigned f2bf(float f) { unsigned u = __float_as_uint(f); u += 0x7FFFu + ((u >> 16) & 1u); return u >> 16; }
DEV float bf2f(unsigned short b) { return __uint_as_float(((unsigned)b) << 16); }
typedef __bf16 bf16n2 __attribute__((ext_vector_type(2)));
DEV unsigned pk2(float lo, float hi) { f32x2 v = {lo, hi}; bf16n2 b = __builtin_convertvector(v, bf16n2); return __builtin_bit_cast(unsigned, b); }
DEV float bflo(unsigned u) { return __uint_as_float(u << 16); }
DEV float bfhi(unsigned u) { return __uint_as_float(u & 0xFFFF0000u); }
DEV float sigmoidf_(float x) { return 1.0f / (1.0f + __expf(-x)); }
DEV float siluf_(float x) { return x / (1.0f + __expf(-x)); }
DEV float softplusf_(float x) { return fmaxf(x, 0.f) + __logf(1.0f + __expf(-fabsf(x))); }
DEV float tanhf_(float x) { const float e = __expf(-2.0f * fabsf(x)); const float r = (1.0f - e) / (1.0f + e); return x < 0.f ? -r : r; }
DEV float wave_sum(float v) {
#pragma unroll
    for (int o = 32; o > 0; o >>= 1) v += __shfl_xor(v, o);
    return v;
}
DEV float sum16(float v) {
#pragma unroll
    for (int o = 8; o > 0; o >>= 1) v += __shfl_xor(v, o);
    return v;
}
template <int N> DEV float reduce_scatter(float (&v)[N], int lane) {
    int s = 1;
#pragma unroll
    for (int h = N / 2; h >= 1; h >>= 1) {
#pragma unroll
        for (int i = 0; i < h; ++i) {
            const bool up = (lane & s) != 0;
            const float send = up ? v[i] : v[i + h];
            const float keep = up ? v[i + h] : v[i];
            v[i] = keep + __shfl_xor(send, s);
        }
        s <<= 1;
    }
    float r = v[0];
    for (; s < 64; s <<= 1) r += __shfl_xor(r, s);
    return r;
}
template <int N> DEV int rs_index(int lane) {
    int o = 0, s = 1;
#pragma unroll
    for (int h = N / 2; h >= 1; h >>= 1) { if (lane & s) o += h; s <<= 1; }
    return o;
}

DEV bf16x8 frag_rm(const LAS bf16_t* base, int ld, int row0, int k0, int lane) {
    return *(const LAS bf16x8*)(base + (row0 + (lane & 15)) * ld + k0 + 8 * (lane >> 4));
}
DEV bf16x8 frag_tr(const LAS bf16_t* base, int ld, int k0, int c0, int lane) {
    const int g = lane >> 4, i = lane & 15, q = i >> 2, p = i & 3;
    const LAS bf16_t* a = base + (k0 + 8 * g + q) * ld + c0 + 4 * p;
    s16x4 lo = __builtin_amdgcn_ds_read_tr16_b64_v4i16((LAS s16x4*)a);
    s16x4 hi = __builtin_amdgcn_ds_read_tr16_b64_v4i16((LAS s16x4*)(a + 4 * ld));
    bf16x8 r; r[0] = lo[0]; r[1] = lo[1]; r[2] = lo[2]; r[3] = lo[3]; r[4] = hi[0]; r[5] = hi[1]; r[6] = hi[2]; r[7] = hi[3];
    return r;
}
#define MFMA16(a, b, c) __builtin_amdgcn_mfma_f32_16x16x32_bf16((a), (b), (c), 0, 0, 0)
DEV size_t fragmajor_off(int n, int k, int K) { return ((size_t)((n >> 4) * (K >> 5) + (k >> 5)) * 64 + (n & 15) + 16 * ((k & 31) >> 3)) * 8 + (k & 7); }

template <int N> DEV void skinny_group(const f32x4 (&z)[4], const LAS float* wt, int lane, LAS float* outw) {
    float pe[N];
#pragma unroll
    for (int o = 0; o < N; ++o) {
        float a = 0.f;
#pragma unroll
        for (int q = 0; q < 4; ++q) { const f32x4 w = *(const LAS f32x4*)(wt + o * 1028 + RCOL(q, lane)); a += z[q][0] * w[0] + z[q][1] * w[1] + z[q][2] * w[2] + z[q][3] * w[3]; }
        pe[o] = a;
    }
    const float r = reduce_scatter<N>(pe, lane);
    if (lane < N) outw[rs_index<N>(lane)] = r;
}
#ifndef SINGLE_LAUNCH
#define SINGLE_LAUNCH 1
#endif
constexpr size_t OFF_bar = 0ull;
constexpr size_t OFF_rw_rkv_t = 13824ull;
constexpr size_t OFF_rw_w1_t = 12596736ull;
constexpr size_t OFF_rw_a1_t = 13645312ull;
constexpr size_t OFF_rw_g1_t = 14693888ull;
constexpr size_t OFF_rw_w2_t = 15742464ull;
constexpr size_t OFF_rw_a2_t = 16791040ull;
constexpr size_t OFF_rw_g2_t = 17839616ull;
constexpr size_t OFF_rw_wo_t = 18888192ull;
constexpr size_t OFF_mb_win_t = 23082496ull;
constexpr size_t OFF_mb_wout_t = 33568256ull;
constexpr size_t OFF_gl_win_t = 37762560ull;
constexpr size_t OFF_gl_wout_t = 44054016ull;
constexpr size_t OFF_moe_w1_t = 46151168ull;
constexpr size_t OFF_moe_w2_t = 314586624ull;
constexpr size_t OFF_H = 448804352ull;
constexpr size_t OFF_H1 = 515913216ull;
constexpr size_t OFF_MIX = 583022080ull;
constexpr size_t OFF_BUF = 650130944ull;
constexpr size_t OFF_ACT = 734017024ull;
constexpr size_t OFF_YBUF = 775960064ull;
constexpr size_t OFF_CNT = 859846144ull;
constexpr size_t OFF_EIDX = 859878912ull;
constexpr size_t OFF_GATE = 860009984ull;
constexpr size_t OFF_DEST = 860141056ull;
constexpr size_t OFF_TAB = 860272128ull;
constexpr size_t OFF_YB = 860273152ull;
constexpr size_t OFF_X6 = 927382016ull;
constexpr size_t OFF_Rr = 1128708608ull;
constexpr size_t OFF_Kk = 1195817472ull;
constexpr size_t OFF_Vv = 1262926336ull;
constexpr size_t OFF_LW = 1330035200ull;
constexpr size_t OFF_Wd = 1355201024ull;
constexpr size_t OFF_Aa = 1422309888ull;
constexpr size_t OFF_Gg = 1489418752ull;
constexpr size_t OFF_RWf = 1556527616ull;
constexpr size_t OFF_RBf = 1590082048ull;
constexpr size_t OFF_RUt = 1623636480ull;
constexpr size_t OFF_RNa = 1657190912ull;
constexpr size_t OFF_RGc = 1690745344ull;
constexpr size_t OFF_RUa = 1691793920ull;
constexpr size_t OFF_RS0 = 1725348352ull;
constexpr size_t OFF_Z = 960936448ull;
constexpr size_t OFF_XBC = 1028045312ull;
constexpr size_t OFF_XC = 1128708608ull;
constexpr size_t OFF_DT = 1229371904ull;
constexpr size_t OFF_STATES = 1231469056ull;
constexpr size_t OFF_CD = 1365686784ull;
constexpr size_t OFF_PREV = 1365703168ull;
constexpr size_t OFF_LA = 1432812032ull;
constexpr size_t OFF_CDG = 1466366464ull;
constexpr size_t OFF_QKVG = OFF_XBC;
constexpr size_t WS_TOTAL = 1758902784ull;
typedef unsigned T_bar;
typedef bf16_t T_rw_rkv_t;
typedef bf16_t T_rw_w1_t;
typedef bf16_t T_rw_a1_t;
typedef bf16_t T_rw_g1_t;
typedef bf16_t T_rw_w2_t;
typedef bf16_t T_rw_a2_t;
typedef bf16_t T_rw_g2_t;
typedef bf16_t T_rw_wo_t;
typedef bf16_t T_mb_win_t;
typedef bf16_t T_mb_wout_t;
typedef bf16_t T_gl_win_t;
typedef bf16_t T_gl_wout_t;
typedef bf16_t T_moe_w1_t;
typedef bf16_t T_moe_w2_t;
typedef float T_H;
typedef float T_H1;
typedef float T_MIX;
typedef bf16_t T_BUF;
typedef bf16_t T_ACT;
typedef bf16_t T_YBUF;
typedef int T_CNT;
typedef int T_EIDX;
typedef float T_GATE;
typedef int T_DEST;
typedef int T_TAB;
typedef bf16_t T_YB;
typedef bf16_t T_X6;
typedef float T_Rr;
typedef float T_Kk;
typedef float T_Vv;
typedef bf16_t T_LW;
typedef float T_Wd;
typedef float T_Aa;
typedef float T_Gg;
typedef bf16_t T_RWf;
typedef bf16_t T_RBf;
typedef bf16_t T_RUt;
typedef bf16_t T_RNa;
typedef float T_RGc;
typedef bf16_t T_RUa;
typedef bf16_t T_RS0;
typedef bf16_t T_Z;
typedef bf16_t T_XBC;
typedef bf16_t T_XC;
typedef float T_DT;
typedef bf16_t T_STATES;
typedef float T_CD;
typedef bf16_t T_PREV;
typedef float T_LA;
typedef float T_CDG;
typedef bf16_t T_QKVG;
#define WS_(P, N) ((T_##N*)((P).ws + OFF_##N))
constexpr size_t OFF_Hb = OFF_H, OFF_H1b = OFF_H1, OFF_MIXb = OFF_MIX;
typedef bf16_t T_Hb; typedef bf16_t T_H1b; typedef bf16_t T_MIXb;
constexpr size_t OFF_moe_wr_t = OFF_H + 33554432ull;
typedef bf16_t T_moe_wr_t;
constexpr size_t OFF_mb_dt_t = OFF_moe_wr_t + 4ull * 48 * 1024 * 2, OFF_gl_lr_t = OFF_mb_dt_t + 32ull * 1024 * 2;
typedef bf16_t T_mb_dt_t; typedef bf16_t T_gl_lr_t;
constexpr size_t OFF_Rb = OFF_Rr, OFF_Kb = OFF_Kk, OFF_Vb = OFF_Vv, OFF_Ab = OFF_Aa, OFF_Gb = OFF_Gg;
typedef bf16_t T_Rb; typedef bf16_t T_Kb; typedef bf16_t T_Vb; typedef bf16_t T_Ab; typedef bf16_t T_Gb;
constexpr size_t OFF_Wb = OFF_Wd; typedef bf16_t T_Wb;
struct ConvJob {
    const float* src; bf16_t* dst;
    int K, N, src_ld, Kpad, Npad, perm, batch;
    long long src_bs, dst_bs;
    DEV int ntiles() const { return (Kpad / 64) * (Npad / 64) * batch; }
};
constexpr int NJOBS = 16;
constexpr int MOE_SPLIT = 32;

#define PARAM_LIST(X) \
    X(const float*, x) X(const float*, ln_g) X(const float*, ln_b) \
    X(const float*, rw_mu) X(const float*, rw_w_rkv) X(const float*, rw_w0) X(const float*, rw_w1) X(const float*, rw_w2) X(const float*, rw_a0) X(const float*, rw_a1) X(const float*, rw_a2) \
    X(const float*, rw_g1) X(const float*, rw_g2) X(const float*, rw_k_k) X(const float*, rw_k_a) X(const float*, rw_r_k) X(const float*, rw_lnx_g) X(const float*, rw_lnx_b) X(const float*, rw_w_o) \
    X(const float*, mb_w_in) X(const float*, mb_conv_w) X(const float*, mb_conv_b) X(const float*, mb_dt_bias) X(const float*, mb_a_log) X(const float*, mb_d) X(const float*, mb_norm_g) X(const float*, mb_w_out) \
    X(const float*, gl_w_in) X(const float*, gl_gk_w2) X(const float*, gl_gk_b) X(const float*, gl_norm_g) X(const float*, gl_w_out) \
    X(const float*, moe_w_group) X(const float*, moe_b_group) X(const float*, moe_w_route) X(const float*, moe_b_route) X(const float*, moe_w_in) X(const float*, moe_w_down) \
    X(float*, out) X(char*, ws)
struct Params {
#define X(t, n) t n;
    PARAM_LIST(X)
#undef X
};

enum Op : unsigned char { OP_CONVERT = 0, OP_PRE0, OP_RW_GEMM1, OP_RW_GEMM2, OP_RW_CHA, OP_RW_CHB, OP_RW_CHC, OP_RW_OUT,
    OP_LN1, OP_MOE_SCATTER, OP_MOE_GEMM1, OP_MOE_GEMM2, OP_LN2,
    OP_MB_GEMM_IN, OP_MB_CONV, OP_MB_STATES, OP_MB_SCAN, OP_MB_OUT, OP_MB_GEMM_OUT,
    OP_GL_GEMM_IN, OP_GL_KV, OP_GL_SCAN, OP_GL_OUT, OP_GL_GEMM_OUT };


DEV ConvJob make_job(const Params& p, int q) {
    const long long DD = (long long)D * D;
    switch (q) {
    case 0: return ConvJob{p.rw_w_rkv, WS_(p, rw_rkv_t), 1024, 1024, 1024, 1024, 1024, 0, 6, DD, DD};
    case 1: return ConvJob{p.rw_w1, WS_(p, rw_w1_t), 1024, 64, 64, 1024, 256, 0, 2, (long long)D * 64, (long long)256 * D};
    case 2: return ConvJob{p.rw_a1, WS_(p, rw_a1_t), 1024, 64, 64, 1024, 256, 0, 2, (long long)D * 64, (long long)256 * D};
    case 3: return ConvJob{p.rw_g1, WS_(p, rw_g1_t), 1024, 160, 160, 1024, 256, 0, 2, (long long)D * 160, (long long)256 * D};
    case 4: return ConvJob{p.rw_w2, WS_(p, rw_w2_t), 64, 1024, 1024, 256, 1024, 0, 2, (long long)64 * D, (long long)D * 256};
    case 5: return ConvJob{p.rw_a2, WS_(p, rw_a2_t), 64, 1024, 1024, 256, 1024, 0, 2, (long long)64 * D, (long long)D * 256};
    case 6: return ConvJob{p.rw_g2, WS_(p, rw_g2_t), 160, 1024, 1024, 256, 1024, 0, 2, (long long)160 * D, (long long)D * 256};
    case 7: return ConvJob{p.rw_w_o, WS_(p, rw_wo_t), 1024, 1024, 1024, 1024, 1024, 0, 2, DD, DD};
    case 8: return ConvJob{p.mb_w_in, WS_(p, mb_win_t), 1024, 5120, 5152, 1024, 5120, 0, 1, 0, 0};
    case 9: return ConvJob{p.mb_w_out, WS_(p, mb_wout_t), 2048, 1024, 1024, 2048, 1024, 0, 1, 0, 0};
    case 10: return ConvJob{p.gl_w_in, WS_(p, gl_win_t), 1024, 3072, 3088, 1024, 3072, 0, 1, 0, 0};
    case 11: return ConvJob{p.gl_w_out, WS_(p, gl_wout_t), 1024, 1024, 1024, 1024, 1024, 0, 1, 0, 0};
    case 12: return ConvJob{p.moe_w_in, WS_(p, moe_w1_t), 1024, 1024, 1024, 1024, 1024, 1, MOE_SPLIT, DD, DD};
    case 13: return ConvJob{p.moe_w_down, WS_(p, moe_w2_t), 512, 1024, 1024, 512, 1024, 0, MOE_SPLIT, (long long)512 * 1024, (long long)1024 * 512};
    case 14: return ConvJob{p.moe_w_in + (size_t)MOE_SPLIT * DD, WS_(p, moe_w1_t) + (size_t)MOE_SPLIT * DD, 1024, 1024, 1024, 1024, 1024, 1, 128 - MOE_SPLIT, DD, DD};
    default: return ConvJob{p.moe_w_down + (size_t)MOE_SPLIT * 512 * 1024, WS_(p, moe_w2_t) + (size_t)MOE_SPLIT * 512 * 1024, 512, 1024, 1024, 512, 1024, 0, 128 - MOE_SPLIT, (long long)512 * 1024, (long long)1024 * 512};
    }
}

DEV void convert_one(const ConvJob& J, LAS unsigned char* lds, int B0, int NBW, int tbeg) {
    const int tid = tid_(), bid = bid_();
    const int lane = tid & 63, wv = tid >> 6; const int gw = (bid - B0) * 8 + wv, NW = NBW * 8;
    LAS bf16_t* tile = (LAS bf16_t*)lds + wv * (64 * 72);
    const int jend = tbeg + J.ntiles();
    const int ti0 = tbeg + ((gw - tbeg) % NW + NW) % NW;
#pragma unroll 1
    for (int ti = ti0; ti < jend; ti += NW) {
        int local = ti - tbeg;
        const int tk = J.Kpad / 64, tn = J.Npad / 64;
        const int b = local / (tk * tn); local -= b * tk * tn;
        const int nt = local / tk, kt = local - nt * tk;
        const float* src = J.src + (size_t)b * J.src_bs;
        bf16_t* dst = J.dst + (size_t)b * J.dst_bs;
        const int k0 = kt * 64, n0 = nt * 64;
        const int nn = (lane & 15) * 4; const bool nok = n0 + nn < J.N;
        f32x4 v[16];
#pragma unroll
        for (int i = 0; i < 16; ++i) { const int kk = (lane >> 4) + 4 * i; v[i] = (nok && k0 + kk < J.K) ? *(const f32x4*)(src + (size_t)(k0 + kk) * J.src_ld + n0 + nn) : (f32x4){0.f, 0.f, 0.f, 0.f}; }
#pragma unroll
        for (int i = 0; i < 16; ++i) { const int kk = (lane >> 4) + 4 * i;
#pragma unroll
            for (int e = 0; e < 4; ++e) tile[(nn + e) * 72 + kk] = (bf16_t)f2bf(v[i][e]); }
#pragma unroll
        for (int i = 0; i < 8; ++i) { const int r = (lane >> 3) + 8 * i, kc = (lane & 7) * 8;
            int nsrc = n0 + r, ndst = nsrc;
            if (J.perm == 1) { const int up = nsrc >= 512, jj = nsrc - (up ? 512 : 0); ndst = (jj >> 7) * 256 + (up ? 128 : 0) + (jj & 127); }
            *(u32x4*)(dst + (size_t)ndst * J.Kpad + k0 + kc) = *(const LAS u32x4*)(tile + r * 72 + kc); }
    }
}
template <int J0, int J1> DEV void convert_jobs(const Params& p, LAS unsigned char* lds, int B0, int NBW) {
    int tbeg = 0;
#pragma unroll
    for (int j = J0; j < J1; ++j) { const ConvJob J = make_job(p, j); convert_one(J, lds, B0, NBW, tbeg); tbeg += J.ntiles(); }
}
DEV ConvJob moe_job(const Params& p, int which, int ml) {
    const long long DD = (long long)D * D; const size_t b0 = (size_t)ml * 32;
    if (which == 0) return ConvJob{p.moe_w_in + b0 * DD, WS_(p, moe_w1_t) + b0 * DD, 1024, 1024, 1024, 1024, 1024, 1, 32, DD, DD};
    return ConvJob{p.moe_w_down + b0 * 512 * 1024, WS_(p, moe_w2_t) + b0 * 512 * 1024, 512, 1024, 1024, 512, 1024, 0, 32, (long long)512 * 1024, (long long)1024 * 512};
}
DEV void phase_convert(const Params& p, LAS unsigned char* lds) {
    const int tid = tid_(), bid = bid_();
    convert_jobs<0, 12>(p, lds, 0, NB_);
    if (bid < 4 * 48) { const int layer = bid / 48, o = bid % 48;
        for (int k = tid; k < D; k += NTHR) { float v = 0.f;
            if (o < 32) v = p.moe_w_route[((size_t)layer * D + k) * 32 + o]; else if (o < 36) v = p.moe_w_group[((size_t)layer * D + k) * 4 + (o - 32)];
            WS_(p, moe_wr_t)[((size_t)layer * 48 + o) * D + k] = (bf16_t)f2bf(v); } }
    else if (bid < 4 * 48 + 32) { const int o = bid - 192;
        for (int k = tid; k < D; k += NTHR) WS_(p, mb_dt_t)[(size_t)o * D + k] = (bf16_t)f2bf(p.mb_w_in[(size_t)k * 5152 + 5120 + o]); }
    else if (bid < 4 * 48 + 48) { const int o = bid - 224;
        for (int k = tid; k < D; k += NTHR) WS_(p, gl_lr_t)[(size_t)o * D + k] = (bf16_t)f2bf(p.gl_w_in[(size_t)k * 3088 + 3072 + o]); }
}
namespace pg8 {
constexpr int BM = 256, BK = 64, HALF = 128, HTB = HALF * BK * 2, STAGE_BYTES = 8 * HTB;
DEV int lds_byte(int r, int c) { const int st = (r >> 4) * 2 + (c >> 5), rr = r & 15, cc = c & 31, ob = rr * 64 + cc * 2; return st * 1024 + (ob ^ (((ob >> 9) & 1) << 5)); }
DEV void stage_rc(int b, int& R, int& C) { const int st = b / 1024, sb = b % 1024, swz = sb ^ (((sb >> 9) & 1) << 5); R = (st >> 1) * 16 + swz / 64; C = (st & 1) * 32 + (swz % 64) / 2; }

struct Unit { const char* A; const char* B; int row0, col0, id, aux; };

DEV bool tile_order(int i, int G, int c, int nM, int nN, int& pm, int& pn) {
    const int nwg = nM * nN; const long L = (long)i * G + c; if (L >= nwg) return false;
    int wgid = (int)L; { const int q = nwg / 8, r = nwg % 8, xcd = wgid % 8, off = wgid / 8; wgid = (xcd < r ? xcd * (q + 1) : r * (q + 1) + (xcd - r) * q) + off; }
    const int nig = 8 * nN, gid = wgid / nig, fm = gid * 8, gsz = (nM - fm) < 8 ? (nM - fm) : 8;
    pm = fm + ((wgid % nig) % gsz); pn = (wgid % nig) / gsz; return true;
}

template <class Epi, class Sched>
DEV void gemm_phase(LAS unsigned char* lds, const int K, const Sched& S, const Epi& E) {
    const int tid = tid_(), wid = __builtin_amdgcn_readfirstlane(tid >> 6), lane = tid & 63, wr = wid >> 2, wc = wid & 3, fr = lane & 15, fq = lane >> 4;
    const int nt = K / BK;
    unsigned voff[2];
#pragma unroll
    for (int i = 0; i < 2; ++i) { int R, C; stage_rc(tid * 16 + i * 8192, R, C); voff[i] = (unsigned)(R * K + C) * 2u; }
    const size_t kstep = (size_t)(BK * 2);
    const size_t hstep = (size_t)HALF * K * 2;
    const unsigned ldsw = (unsigned)wid * 1024u;
    const int aoff = lds_byte(wr * 64 + fr, fq * 8), boff = lds_byte(wc * 32 + fr, fq * 8);
#define PG8_SA(b, h) (((b) * 2 + (h)) * HTB)
#define PG8_SB(b, h) ((4 + (b) * 2 + (h)) * HTB)
#define PG8_STAGE(bufoff, gbase) do { _Pragma("unroll") for (int _i = 0; _i < 2; ++_i) \
        __builtin_amdgcn_global_load_lds((const unsigned*)((const char*)(gbase) + voff[_i]), (LAS unsigned*)(lds + (bufoff) + ldsw + _i * 8192), 16, 0, 0); } while (0)
#define PG8_LDA(dst, b, h) do { _Pragma("unroll") for (int m = 0; m < 4; ++m) _Pragma("unroll") for (int k = 0; k < 2; ++k) dst[m][k] = *(const LAS bf16x8*)(lds + PG8_SA(b, h) + aoff + m * 2048 + k * 1024); } while (0)
#define PG8_LDB(dst, b, h) do { _Pragma("unroll") for (int n = 0; n < 2; ++n) _Pragma("unroll") for (int k = 0; k < 2; ++k) dst[n][k] = *(const LAS bf16x8*)(lds + PG8_SB(b, h) + boff + n * 2048 + k * 1024); } while (0)
#define PG8_MMA(ai, bj, At, Bt) do { __builtin_amdgcn_s_setprio(1); _Pragma("unroll") for (int m = 0; m < 4; ++m) _Pragma("unroll") for (int n = 0; n < 2; ++n) _Pragma("unroll") for (int k = 0; k < 2; ++k) \
        acc[ai][bj][m][n] = __builtin_amdgcn_mfma_f32_16x16x32_bf16(Bt[n][k], At[m][k], acc[ai][bj][m][n], 0, 0, 0); __builtin_amdgcn_s_setprio(0); } while (0)
#define PG8_WAIT_V(n) asm volatile("s_waitcnt vmcnt(" #n ")" ::: "memory")
#define PG8_WAIT_L(n) asm volatile("s_waitcnt lgkmcnt(" #n ")" ::: "memory")
#define PG8_BAR __builtin_amdgcn_s_barrier()
#define PG8_SCHED __builtin_amdgcn_sched_barrier(0)
    Unit cur, nxt; int ui = 0;
    if (!S.next(0, cur)) return;
    f32x4 acc[2][2][4][2];
#pragma unroll
    for (int a = 0; a < 2; ++a)
#pragma unroll
        for (int b = 0; b < 2; ++b)
#pragma unroll
            for (int m = 0; m < 4; ++m)
#pragma unroll
                for (int n = 0; n < 2; ++n) acc[a][b][m][n] = (f32x4){0.f, 0.f, 0.f, 0.f};
    bf16x8 At[4][2], B0[2][2], B1[2][2];
    const char* cA = cur.A; const char* cB = cur.B;
    PG8_STAGE(PG8_SB(0, 0), cB); PG8_STAGE(PG8_SA(0, 0), cA); PG8_STAGE(PG8_SB(0, 1), cB + hstep); PG8_STAGE(PG8_SA(0, 1), cA + hstep);
    if (wr == 1) PG8_BAR;
    PG8_WAIT_V(4); PG8_BAR;
    PG8_STAGE(PG8_SB(1, 0), cB + kstep); PG8_STAGE(PG8_SA(1, 0), cA + kstep); PG8_STAGE(PG8_SB(1, 1), cB + hstep + kstep);
    PG8_WAIT_V(6); PG8_BAR;
    for (;;) {
        const bool has_next = S.next(ui + 1, nxt);
        const char* nA = has_next ? nxt.A : cA; const char* nB = has_next ? nxt.B : cB;
#pragma unroll 1
        for (int t = 0; t < nt; t += 2) {
            const bool last = (t == nt - 2);
            const char* a1 = cA + (size_t)(t + 1) * kstep;
            const char* a2 = last ? nA : cA + (size_t)(t + 2) * kstep; const char* b2 = last ? nB : cB + (size_t)(t + 2) * kstep;
            const char* a3 = a2 + kstep; const char* b3 = b2 + kstep;
            PG8_LDB(B0, 0, 0); PG8_SCHED; PG8_LDA(At, 0, 0); PG8_STAGE(PG8_SA(1, 1), a1 + hstep);
            PG8_WAIT_L(8); PG8_BAR; PG8_WAIT_L(0); PG8_MMA(0, 0, At, B0); PG8_BAR; PG8_SCHED;
            PG8_LDB(B1, 0, 1); PG8_STAGE(PG8_SB(0, 0), b2);
            PG8_BAR; PG8_WAIT_L(0); PG8_MMA(0, 1, At, B1); PG8_BAR;
            PG8_LDA(At, 0, 1); PG8_STAGE(PG8_SA(0, 0), a2);
            PG8_BAR; PG8_WAIT_L(0); PG8_MMA(1, 0, At, B0); PG8_BAR; PG8_SCHED;
            PG8_STAGE(PG8_SB(0, 1), b2 + hstep);
            PG8_WAIT_V(6); PG8_BAR; PG8_MMA(1, 1, At, B1); PG8_BAR;
            PG8_LDB(B0, 1, 0); PG8_SCHED; PG8_LDA(At, 1, 0); PG8_STAGE(PG8_SA(0, 1), a2 + hstep);
            PG8_WAIT_L(8); PG8_BAR; PG8_WAIT_L(0); PG8_MMA(0, 0, At, B0); PG8_BAR; PG8_SCHED;
            PG8_LDB(B1, 1, 1); PG8_STAGE(PG8_SB(1, 0), b3);
            PG8_BAR; PG8_WAIT_L(0); PG8_MMA(0, 1, At, B1); PG8_BAR;
            PG8_LDA(At, 1, 1); PG8_STAGE(PG8_SA(1, 0), a3);
            PG8_BAR; PG8_WAIT_L(0); PG8_MMA(1, 0, At, B0); PG8_BAR; PG8_SCHED;
            PG8_STAGE(PG8_SB(1, 1), b3 + hstep);
            PG8_WAIT_V(6); PG8_BAR; PG8_MMA(1, 1, At, B1); PG8_BAR;
        }
        E(acc, cur, wr, wc, fr, fq);
        if (!has_next) break;
#pragma unroll
        for (int a = 0; a < 2; ++a)
#pragma unroll
            for (int b = 0; b < 2; ++b)
#pragma unroll
                for (int m = 0; m < 4; ++m)
#pragma unroll
                    for (int n = 0; n < 2; ++n) acc[a][b][m][n] = (f32x4){0.f, 0.f, 0.f, 0.f};
        cur = nxt; cA = nA; cB = nB; ++ui;
    }
    PG8_WAIT_V(0);
    if (wr == 0) PG8_BAR;
    PG8_BAR;
#undef PG8_SA
#undef PG8_SB
#undef PG8_STAGE
#undef PG8_LDA
#undef PG8_LDB
#undef PG8_MMA
#undef PG8_WAIT_V
#undef PG8_WAIT_L
#undef PG8_BAR
#undef PG8_SCHED
}
}
using pg8::Unit;
typedef f32x4 AccT[2][2][4][2];
#define FOR_ACC(ai, bj, m, n) _Pragma("unroll") for (int ai = 0; ai < 2; ++ai) _Pragma("unroll") for (int m = 0; m < 4; ++m) _Pragma("unroll") for (int bj = 0; bj < 2; ++bj) _Pragma("unroll") for (int n = 0; n < 2; ++n)
#define ACC_FENCE __builtin_amdgcn_sched_barrier(0)
#define ACC_ROW(u, ai, m) ((u).row0 + 128 * (ai) + 64 * wr + 16 * (m) + fr)
#define ACC_COL(u, bj, n) ((u).col0 + 128 * (bj) + 32 * wc + 16 * (n) + 4 * fq)
DEV void st_bf4(bf16_t* p, f32x4 v) { u32x2 w; w.x = pk2(v[0], v[1]); w.y = pk2(v[2], v[3]); *(u32x2*)p = w; }
DEV void load_row(const float* p, int lane, f32x4 (&v)[4]) {
#pragma unroll
    for (int q = 0; q < 4; ++q) v[q] = *(const f32x4*)(p + RCOL(q, lane));
}

DEV void load_row_bf(const bf16_t* p, int lane, f32x4 (&v)[4]) {
#pragma unroll
    for (int q = 0; q < 4; ++q) { const u32x2 a = *(const u32x2*)(p + RCOL(q, lane)); v[q] = (f32x4){bflo(a.x), bfhi(a.x), bflo(a.y), bfhi(a.y)}; }
}
DEV void store_row_bf(bf16_t* p, int lane, const f32x4 (&v)[4]) {
#pragma unroll
    for (int q = 0; q < 4; ++q) st_bf4(p + RCOL(q, lane), v[q]);
}
DEV void emit_mix6(const Params& p, int j, int t, int lane, const f32x4 (&x)[4], const f32x4 (&xp)[4]) {
    const float* mu = p.rw_mu + (size_t)j * 6 * D;
#pragma unroll
    for (int s = 0; s < 6; ++s) {
#pragma unroll
        for (int q = 0; q < 4; ++q) {
            const f32x4 m = *(const f32x4*)(mu + s * D + RCOL(q, lane));
            st_bf4(WS_(p, X6) + (size_t)s * T * D + (size_t)t * D + RCOL(q, lane), x[q] + (xp[q] - x[q]) * m);
        }
        __builtin_amdgcn_sched_barrier(0);
    }
}
DEV void phase_pre0(const Params& p) {
    const int tid = tid_(), bid = bid_(); const int lane = tid & 63, wid = tid >> 6;
    f32x4 x[4], xp[4];
    const int tfirst = bid * 64 + wid * 8;
    if (tfirst > 0) load_row(p.x + (size_t)(tfirst - 1) * D, lane, xp); else { for (int q = 0; q < 4; ++q) xp[q] = (f32x4){0.f, 0.f, 0.f, 0.f}; }
    f32x4 xn[4]; load_row(p.x + (size_t)tfirst * D, lane, xn);
#pragma unroll 1
    for (int r = 0; r < 8; ++r) {
        const int t = tfirst + r;
#pragma unroll
        for (int q = 0; q < 4; ++q) x[q] = xn[q];
        load_row(p.x + (size_t)(r < 7 ? t + 1 : t) * D, lane, xn);
        store_row_bf(WS_(p, Hb) + (size_t)t * D, lane, x);
        emit_mix6(p, 0, t, lane, x, xp);
#pragma unroll
        for (int q = 0; q < 4; ++q) xp[q] = x[q];
    }
}

struct SchedRW1 {
    const Params* p; int j;
    DEV bool next(int i, Unit& u) const {
        int pm, pn; if (!pg8::tile_order(i, NB_, bid_(), 64, 15, pm, pn)) return false;
        int id, lpn; if (pn < 12) { id = pn >> 2; lpn = pn & 3; } else { id = 3 + (pn - 12); lpn = 0; }
        u.A = (const char*)(WS_(*p, X6) + (size_t)id * T * D + (size_t)pm * 256 * D);
        const bf16_t* B;
        if (id < 3) B = WS_(*p, rw_rkv_t) + ((size_t)j * 3 + id) * D * D + (size_t)lpn * 256 * D;
        else B = WS_(*p, rw_w1_t) + (size_t)(id - 3) * (2 * 256 * D) + (size_t)j * 256 * D;
        u.B = (const char*)B; u.row0 = pm * 256; u.col0 = lpn * 256; u.id = id; u.aux = 0; return true;
    }
};
struct EpiRW1 {
    const Params* p;
    DEV void operator()(const AccT& acc, const Unit& u, int wr, int wc, int fr, int fq) const {
        if (u.id < 3) {
            bf16_t* O = WS_(*p, Rb) + (size_t)u.id * 2 * T * D;
            FOR_ACC(ai, bj, m, n) { st_bf4(O + (size_t)ACC_ROW(u, ai, m) * D + ACC_COL(u, bj, n), acc[ai][bj][m][n]); ACC_FENCE; }
        } else {
            bf16_t* O = WS_(*p, LW) + (size_t)(u.id - 3) * T * 256;
            FOR_ACC(ai, bj, m, n) {
                f32x4 v = acc[ai][bj][m][n];
                if (u.id == 3) { for (int e = 0; e < 4; ++e) v[e] = tanhf_(v[e]); }
                else if (u.id == 5) { for (int e = 0; e < 4; ++e) v[e] = sigmoidf_(v[e]); }
                st_bf4(O + (size_t)ACC_ROW(u, ai, m) * 256 + ACC_COL(u, bj, n), v); ACC_FENCE;
            }
        }
    }
};
struct SchedRW2 {
    const Params* p; int j;
    DEV bool next(int i, Unit& u) const {
        int pm, pn; if (!pg8::tile_order(i, NB_, bid_(), 64, 12, pm, pn)) return false;
        const int id = pn >> 2, lpn = pn & 3;
        u.A = (const char*)(WS_(*p, LW) + (size_t)id * T * 256 + (size_t)pm * 256 * 256);
        const bf16_t* B = WS_(*p, rw_w2_t) + (size_t)id * (2 * D * 256) + (size_t)j * D * 256 + (size_t)lpn * 256 * 256;
        u.B = (const char*)B; u.row0 = pm * 256; u.col0 = lpn * 256; u.id = id; u.aux = 0; return true;
    }
};
struct EpiRW2 {
    const Params* p; int j;
    DEV void operator()(const AccT& acc, const Unit& u, int wr, int wc, int fr, int fq) const {
        if (u.id == 0) { const float* bias = p->rw_w0 + (size_t)j * D; f32x4 bv[2][2];
#pragma unroll
            for (int bj = 0; bj < 2; ++bj)
#pragma unroll
                for (int n = 0; n < 2; ++n) bv[bj][n] = *(const f32x4*)(bias + ACC_COL(u, bj, n));
            FOR_ACC(ai, bj, m, n) { f32x4 v = acc[ai][bj][m][n]; const int c = ACC_COL(u, bj, n); const f32x4 b = bv[bj][n];
                for (int e = 0; e < 4; ++e) { const float x = -(b[e] + v[e]); const float wl = -(fmaxf(x, 0.f) + __logf(1.0f + __expf(-fabsf(x)))) - 0.5f; v[e] = -__expf(wl); }
                st_bf4(WS_(*p, Wb) + (size_t)ACC_ROW(u, ai, m) * D + c, v); ACC_FENCE; } }
        else if (u.id == 1) { const float* bias = p->rw_a0 + (size_t)j * D; f32x4 bv[2][2];
#pragma unroll
            for (int bj = 0; bj < 2; ++bj)
#pragma unroll
                for (int n = 0; n < 2; ++n) bv[bj][n] = *(const f32x4*)(bias + ACC_COL(u, bj, n));
            FOR_ACC(ai, bj, m, n) { f32x4 v = acc[ai][bj][m][n]; const int c = ACC_COL(u, bj, n); const f32x4 b = bv[bj][n];
                for (int e = 0; e < 4; ++e) v[e] = sigmoidf_(b[e] + v[e]);
                st_bf4(WS_(*p, Ab) + (size_t)ACC_ROW(u, ai, m) * D + c, v); ACC_FENCE; } }
        else { FOR_ACC(ai, bj, m, n) { st_bf4(WS_(*p, Gb) + (size_t)ACC_ROW(u, ai, m) * D + ACC_COL(u, bj, n), acc[ai][bj][m][n]); ACC_FENCE; } }
    }
};

struct SchedOut {
    const bf16_t* A; const bf16_t* Bt; int K;
    DEV bool next(int i, Unit& u) const {
        int pm, pn; if (!pg8::tile_order(i, NB_, bid_(), 64, 4, pm, pn)) return false;
        u.A = (const char*)(A + (size_t)pm * 256 * K); u.B = (const char*)(Bt + (size_t)pn * 256 * K); u.row0 = pm * 256; u.col0 = pn * 256; u.id = 0; u.aux = 0; return true;
    }
};
struct EpiOut {
    bf16_t* O;
    DEV void operator()(const AccT& acc, const Unit& u, int wr, int wc, int fr, int fq) const {
        FOR_ACC(ai, bj, m, n) { st_bf4(O + (size_t)ACC_ROW(u, ai, m) * D + ACC_COL(u, bj, n), acc[ai][bj][m][n]); ACC_FENCE; }
    }
};
constexpr int RC_LD = 72;
#ifdef DBG
#define DBGF(cond, bit) do { if (cond) atomicOr(&WS_(p, TAB)[200], (bit)); } while (0)
#else
#define DBGF(cond, bit) do {} while (0)
#endif
DEV bool bad_(float x) { return !(fabsf(x) < 1e30f); }
DEV int rc_pi(int g, int j) { return j < 4 ? 4 * g + j : 16 + 4 * g + (j - 4); }

DEV void rc_load_wd(const Params& p, int t0, int cb, float (&wd)[8]) {
    const int tid = tid_(); const int k = tid & 63, sg = tid >> 6;
#pragma unroll
    for (int i = 0; i < 8; ++i) wd[i] = bf2f(WS_(p, Wb)[(size_t)(t0 + sg * 8 + i) * D + cb + k]);
}
DEV void rc_cum_regs(const float (&wd)[8], LAS float* cum, LAS float* seg) {
    const int tid = tid_(); const int k = tid & 63, sg = tid >> 6;
    float v[8]; float s = 0.f;
#pragma unroll
    for (int i = 0; i < 8; ++i) { s += wd[i]; v[i] = s; }
    seg[sg * 64 + k] = s;
    lds_barrier();
    float off = 0.f;
#pragma unroll
    for (int q = 0; q < 8; ++q) off += (q < sg) ? seg[q * 64 + k] : 0.f;
#pragma unroll
    for (int i = 0; i < 8; ++i) cum[(sg * 8 + i) * 64 + k] = v[i] + off;
    lds_barrier();
}
DEV void ld8b(const bf16_t* p, float (&f)[8]) { const u32x4 v = *(const u32x4*)p; f[0] = bflo(v.x); f[1] = bfhi(v.x); f[2] = bflo(v.y); f[3] = bfhi(v.y); f[4] = bflo(v.z); f[5] = bfhi(v.z); f[6] = bflo(v.w); f[7] = bfhi(v.w); }
DEV void ld8(const float* p, float (&f)[8]) { const f32x4 a = *(const f32x4*)p, b = *(const f32x4*)(p + 4); f[0] = a[0]; f[1] = a[1]; f[2] = a[2]; f[3] = a[3]; f[4] = b[0]; f[5] = b[1]; f[6] = b[2]; f[7] = b[3]; }
DEV void lds8(const LAS float* p, float (&f)[8]) { const f32x4 a = *(const LAS f32x4*)p, b = *(const LAS f32x4*)(p + 4); f[0] = a[0]; f[1] = a[1]; f[2] = a[2]; f[3] = a[3]; f[4] = b[0]; f[5] = b[1]; f[6] = b[2]; f[7] = b[3]; }
DEV u32x4 pk8(const float (&f)[8]) { u32x4 o; o.x = pk2(f[0], f[1]); o.y = pk2(f[2], f[3]); o.z = pk2(f[4], f[5]); o.w = pk2(f[6], f[7]); return o; }

DEV bf16x8 frag_rm_pi(const LAS bf16_t* base, int ld, int row0, int k0, int lane) {
    const LAS bf16_t* a = base + (row0 + (lane & 15)) * ld + k0 + 4 * (lane >> 4);
    const s16x4 lo = *(const LAS s16x4*)a, hi = *(const LAS s16x4*)(a + 16);
    bf16x8 r; r[0] = lo[0]; r[1] = lo[1]; r[2] = lo[2]; r[3] = lo[3]; r[4] = hi[0]; r[5] = hi[1]; r[6] = hi[2]; r[7] = hi[3]; return r;
}
DEV void rc_prep8(const float (&k)[8], const float (&al)[8], const float (&kkw)[8], const float (&kaw)[8], float (&a)[8], float (&b)[8], float (&kh)[8]) {
    float kk[8]; float ss = 0.f;
#pragma unroll
    for (int e = 0; e < 8; ++e) { kk[e] = k[e] * kkw[e]; ss += kk[e] * kk[e]; }
    ss += __shfl_xor(ss, 1); ss += __shfl_xor(ss, 2); ss += __shfl_xor(ss, 4);
    const float inv = 1.0f / fmaxf(sqrtf(ss), 1e-12f);
#pragma unroll
    for (int e = 0; e < 8; ++e) { const float kn = kk[e] * inv; a[e] = -kn; b[e] = kn * al[e]; kh[e] = k[e] * (1.0f + (al[e] - 1.0f) * kaw[e]); }
}
DEV void phase_rw_cha(const Params& p, int jl, LAS unsigned char* lds) {
    const int tid = tid_(), bid = bid_(); const int lane = tid & 63, w = tid >> 6; const int fr = lane & 15, fq = lane >> 4;
    LAS float* cum = (LAS float*)lds;
    LAS float* seg = cum + 64 * 64;
    LAS float* Aab = seg + 8 * 64;
    LAS bf16_t* As = (LAS bf16_t*)(Aab + 64 * 68);
    LAS bf16_t* Bs = As + 64 * RC_LD; LAS bf16_t* Ks = Bs + 64 * RC_LD; LAS bf16_t* Vs = Ks + 64 * RC_LD; LAS bf16_t* Ke = Vs + 64 * RC_LD;
    LAS bf16_t* Aak = Ke + 64 * RC_LD; LAS bf16_t* Ts = Aak + 64 * RC_LD; LAS bf16_t* X1 = Ts + 64 * RC_LD; LAS bf16_t* Aabh = X1 + 64 * RC_LD;
    LAS bf16_t* Fimg = Aabh + 64 * RC_LD;
    LAS bf16_t* Wimg = Fimg + 4096;
    float pwd[8], pkr[8], pal[8], pv[8];
    float kkw[8], kaw[8];
    ld8(p.rw_k_k + (size_t)jl * D + (bid & 15) * 64 + (tid & 7) * 8, kkw); ld8(p.rw_k_a + (size_t)jl * D + (bid & 15) * 64 + (tid & 7) * 8, kaw);
    { const int c = bid >> 4, h = bid & 15; rc_load_wd(p, c * 64, h * 64, pwd);
      const size_t go = (size_t)(c * 64 + (tid >> 3)) * D + h * 64 + (tid & 7) * 8; ld8b(WS_(p, Kb) + go, pkr); ld8b(WS_(p, Ab) + go, pal); ld8b(WS_(p, Vb) + go, pv); }
    for (int u = bid; u < 4096; u += NB_) {
        const int c = u >> 4, h = u & 15; const int t0 = c * 64, cb = h * 64; const size_t ub = (size_t)c * 16 + h;
        lds_barrier();
        rc_cum_regs(pwd, cum, seg);
        {
            const int t = tid >> 3, k8 = (tid & 7) * 8;
            float a[8], b[8], kh[8], v[8], ct[8], cp[8], ce[8];
            rc_prep8(pkr, pal, kkw, kaw, a, b, kh);
#pragma unroll
            for (int e = 0; e < 8; ++e) v[e] = pv[e];
            if (u + NB_ < 4096) { const int un = u + NB_; const int cn = un >> 4, hn = un & 15; rc_load_wd(p, cn * 64, hn * 64, pwd);
                const size_t gn = (size_t)(cn * 64 + t) * D + hn * 64 + k8; ld8b(WS_(p, Kb) + gn, pkr); ld8b(WS_(p, Ab) + gn, pal); ld8b(WS_(p, Vb) + gn, pv); }
            lds8(cum + t * 64 + k8, ct); lds8(cum + 63 * 64 + k8, ce);
            if (t > 0) lds8(cum + (t - 1) * 64 + k8, cp); else { for (int e = 0; e < 8; ++e) cp[e] = 0.f; }
            float at[8], bt[8], kt[8], be[8], ke[8];
#pragma unroll
            for (int e = 0; e < 8; ++e) { const float ei = __expf(-ct[e]), ee = __expf(ce[e] - ct[e]); at[e] = a[e] * __expf(cp[e]); bt[e] = b[e] * ei; kt[e] = kh[e] * ei; be[e] = b[e] * ee; ke[e] = kh[e] * ee; }
            *(LAS u32x4*)(As + t * RC_LD + k8) = pk8(at); *(LAS u32x4*)(Bs + t * RC_LD + k8) = pk8(bt); *(LAS u32x4*)(Ks + t * RC_LD + k8) = pk8(kt);
            *(LAS u32x4*)(Ke + t * RC_LD + k8) = pk8(ke); *(LAS u32x4*)(Vs + t * RC_LD + k8) = pk8(v);
            const int tq = t & 31, g = (tq & 15) >> 2, j = (tq & 3) + ((tq >> 4) << 2);
#pragma unroll
            for (int e = 0; e < 8; ++e) { const int k = k8 + e; Fimg[(((k >> 4) * 2 + (t >> 5)) * 64 + g * 16 + (k & 15)) * 8 + j] = (bf16_t)f2bf(be[e]); }
            *(LAS u32x4*)(Ts + tid * 8) = (u32x4){0u, 0u, 0u, 0u}; if (tid < 64) *(LAS u32x4*)(Ts + (512 + tid) * 8) = (u32x4){0u, 0u, 0u, 0u};
            if (t == 63) { float gm[8]; for (int e = 0; e < 8; ++e) gm[e] = __expf(ce[e]); *(f32x4*)(WS_(p, RGc) + ub * 64 + k8) = (f32x4){gm[0], gm[1], gm[2], gm[3]}; *(f32x4*)(WS_(p, RGc) + ub * 64 + k8 + 4) = (f32x4){gm[4], gm[5], gm[6], gm[7]}; }
        }
        lds_barrier();
        {
            const int tb = w >> 1;
#pragma unroll
            for (int ii = 0; ii < 2; ++ii) { const int ib = 2 * (w & 1) + ii;
                f32x4 ab = {0.f, 0.f, 0.f, 0.f}, ak = {0.f, 0.f, 0.f, 0.f};
                if (ib <= tb) {
#pragma unroll
                    for (int ks = 0; ks < 2; ++ks) { const bf16x8 af = frag_rm(As, RC_LD, 16 * tb, 32 * ks, lane);
                        ab = MFMA16(af, frag_rm(Bs, RC_LD, 16 * ib, 32 * ks, lane), ab); ak = MFMA16(af, frag_rm(Ks, RC_LD, 16 * ib, 32 * ks, lane), ak); } }
#pragma unroll
                for (int r = 0; r < 4; ++r) { const int t = 16 * tb + 4 * fq + r, i = 16 * ib + fr; const bool keep = i < t;
                    Aab[t * 68 + i] = keep ? ab[r] : 0.f; Aabh[t * RC_LD + i] = (bf16_t)f2bf(keep ? ab[r] : 0.f); Aak[t * RC_LD + i] = (bf16_t)f2bf(keep ? ak[r] : 0.f); } }
            *(u32x4*)(WS_(p, RBf) + ub * 4096 + tid * 8) = *(const LAS u32x4*)(Fimg + tid * 8);
        }
        lds_barrier();
        if (w == 0) {
            const int blk = lane >> 4, jc = lane & 15;
            float Tc[16];
#pragma unroll
            for (int t = 0; t < 16; ++t) {
                float acc = jc == t ? 1.f : 0.f;
#pragma unroll
                for (int i4 = 0; i4 < (t + 3) / 4; ++i4) { const f32x4 a4 = *(const LAS f32x4*)(Aab + (16 * blk + t) * 68 + 16 * blk + i4 * 4);
#pragma unroll
                    for (int e = 0; e < 4; ++e) if (i4 * 4 + e < t) acc += a4[e] * Tc[i4 * 4 + e]; }
                Tc[t] = acc;
            }
#pragma unroll
            for (int t = 0; t < 16; ++t) Ts[(16 * blk + t) * RC_LD + 16 * blk + jc] = (bf16_t)f2bf(Tc[t]);
#pragma unroll
            for (int b = 1; b < 4; ++b) {
                const s16x4 dlo = *(const LAS s16x4*)(Ts + (16 * b + fr) * RC_LD + 16 * b + 4 * fq);
                bf16x8 dfr; dfr[0] = dlo[0]; dfr[1] = dlo[1]; dfr[2] = dlo[2]; dfr[3] = dlo[3]; dfr[4] = 0; dfr[5] = 0; dfr[6] = 0; dfr[7] = 0;
                f32x4 tt_[3];
#pragma unroll
                for (int cbk = 0; cbk < b; ++cbk) {
                    f32x4 x = {0.f, 0.f, 0.f, 0.f};
#pragma unroll
                    for (int ks = 0; ks < 2; ++ks) x = MFMA16(frag_rm(Aabh, RC_LD, 16 * b, 32 * ks, lane), frag_tr(Ts, RC_LD, 32 * ks, 16 * cbk, lane), x);
                    u32x4 xb; xb.x = pk2(x[0], x[1]); xb.y = pk2(x[2], x[3]); xb.z = 0u; xb.w = 0u;
                    tt_[cbk] = MFMA16(dfr, __builtin_bit_cast(bf16x8, xb), ((f32x4){0.f, 0.f, 0.f, 0.f}));
                }
#pragma unroll
                for (int cbk = 0; cbk < b; ++cbk)
#pragma unroll
                    for (int r = 0; r < 4; ++r) Ts[(16 * b + 4 * fq + r) * RC_LD + 16 * cbk + fr] = (bf16_t)f2bf(tt_[cbk][r]);
            }
        } else {
            for (int tl = w - 1; tl < 32; tl += 7) {
                const int rb = (tl & 15) >> 2, vbk = tl & 3; f32x4 acc = {0.f, 0.f, 0.f, 0.f};
                if (tl < 16) {
#pragma unroll
                    for (int ks = 0; ks < 2; ++ks) acc = MFMA16(frag_rm(Aak, RC_LD, 16 * rb, 32 * ks, lane), frag_tr(Vs, RC_LD, 32 * ks, 16 * vbk, lane), acc);
#pragma unroll
                    for (int r = 0; r < 4; ++r) X1[(16 * rb + 4 * fq + r) * RC_LD + 16 * vbk + fr] = (bf16_t)f2bf(acc[r]);
                } else {
#pragma unroll
                    for (int ks = 0; ks < 2; ++ks) acc = MFMA16(frag_tr(Ke, RC_LD, 32 * ks, 16 * rb, lane), frag_tr(Vs, RC_LD, 32 * ks, 16 * vbk, lane), acc);
                    { u32x2 o; o.x = pk2(acc[0], acc[1]); o.y = pk2(acc[2], acc[3]); *(u32x2*)(WS_(p, RNa) + (((ub * 4 + vbk) * 4 + rb) * 64 + lane) * 4) = o; }
                }
            }
        }
        lds_barrier();
#pragma unroll
        for (int q = 0; q < 4; ++q) { const int tl = w * 4 + q; const int tt = (tl & 15) >> 2, cbk = tl & 3; f32x4 acc = {0.f, 0.f, 0.f, 0.f};
            if (tl < 16) {
#pragma unroll
                for (int ks = 0; ks < 2; ++ks) acc = MFMA16(frag_rm(Ts, RC_LD, 16 * tt, 32 * ks, lane), frag_tr(As, RC_LD, 32 * ks, 16 * cbk, lane), acc);
                const int k = 16 * cbk + fr, kq = k & 31, g = (kq & 15) >> 2, j = (kq & 3) + ((kq >> 4) << 2);
#pragma unroll
                for (int r = 0; r < 4; ++r) Wimg[((tt * 2 + (k >> 5)) * 64 + g * 16 + 4 * fq + r) * 8 + j] = (bf16_t)f2bf(acc[r]);
            } else {
#pragma unroll
                for (int ks = 0; ks < 2; ++ks) acc = MFMA16(frag_rm(Ts, RC_LD, 16 * tt, 32 * ks, lane), frag_tr(X1, RC_LD, 32 * ks, 16 * cbk, lane), acc);
                { u32x2 o; o.x = pk2(acc[0], acc[1]); o.y = pk2(acc[2], acc[3]); *(u32x2*)(WS_(p, RUt) + (((ub * 4 + cbk) * 4 + tt) * 64 + lane) * 4) = o; }
            } }
        lds_barrier();
        *(u32x4*)(WS_(p, RWf) + ub * 4096 + tid * 8) = *(const LAS u32x4*)(Wimg + tid * 8);
    }
}

constexpr int RB_SLOT = 20992, RB_R = 6, RB_P = 5;
struct RbOpsA { bf16x8 wf[8]; u32x2 ut[4]; };
struct RbOpsB { bf16x8 bf[8]; u32x2 na[4]; f32x4 gc[4]; };
DEV void rb_read_a(const LAS unsigned char* slot, int lane, RbOpsA& O) {
#pragma unroll
    for (int f = 0; f < 8; ++f) O.wf[f] = *(const LAS bf16x8*)(slot + (f * 64 + lane) * 16);
#pragma unroll
    for (int q = 0; q < 4; ++q) O.ut[q] = *(const LAS u32x2*)(slot + 16384 + (q * 64 + lane) * 8);
}
DEV void rb_read_b(const LAS unsigned char* slot, int lane, RbOpsB& O) {
    const int fq = lane >> 4;
#pragma unroll
    for (int f = 0; f < 8; ++f) O.bf[f] = *(const LAS bf16x8*)(slot + 8192 + (f * 64 + lane) * 16);
#pragma unroll
    for (int q = 0; q < 4; ++q) { O.na[q] = *(const LAS u32x2*)(slot + 18432 + (q * 64 + lane) * 8); O.gc[q] = *(const LAS f32x4*)(slot + 20480 + (16 * q + 4 * fq) * 4); }
}
DEV void phase_rw_chb(const Params& p, int layer, LAS unsigned char* lds) {
    const int tid = tid_(), bid = bid_();
    if (bid >= 64) {
        if (layer == 0) { int tb = 0;
#pragma unroll 1
            for (int ml = 0; ml < 2; ++ml) { const ConvJob J0 = moe_job(p, 0, ml), J1 = moe_job(p, 1, ml); convert_one(J0, lds, 64, NB_ - 64, tb); tb += J0.ntiles(); convert_one(J1, lds, 64, NB_ - 64, tb); tb += J1.ntiles(); } }
        return; }
    const int lane = tid & 63, w = __builtin_amdgcn_readfirstlane(tid >> 6); const int head = bid & 15, vb = bid >> 4;
    auto issue = [&](int c) {
        const size_t ub = (size_t)c * 16 + head; LAS unsigned char* slot = lds + (c % RB_R) * RB_SLOT;
#pragma unroll
        for (int i = 0; i < 3; ++i) { const int pi = (w - 1) * 3 + i;
            if (pi < 8) __builtin_amdgcn_global_load_lds((const unsigned*)(WS_(p, RWf) + ub * 4096 + pi * 512 + lane * 8), (LAS unsigned*)(slot + pi * 1024), 16, 0, 0);
            else if (pi < 16) __builtin_amdgcn_global_load_lds((const unsigned*)(WS_(p, RBf) + ub * 4096 + (pi - 8) * 512 + lane * 8), (LAS unsigned*)(slot + 8192 + (pi - 8) * 1024), 16, 0, 0);
            else if (pi < 18) __builtin_amdgcn_global_load_lds((const unsigned*)(WS_(p, RUt) + (ub * 4 + vb) * 1024 + (pi - 16) * 512 + lane * 8), (LAS unsigned*)(slot + 16384 + (pi - 16) * 1024), 16, 0, 0);
            else if (pi < 20) __builtin_amdgcn_global_load_lds((const unsigned*)(WS_(p, RNa) + (ub * 4 + vb) * 1024 + (pi - 18) * 512 + lane * 8), (LAS unsigned*)(slot + 18432 + (pi - 18) * 1024), 16, 0, 0);
            else __builtin_amdgcn_global_load_lds((const unsigned*)(WS_(p, RGc) + ub * 64 + lane), (LAS unsigned*)(slot + 20480), 4, 0, 0);
        }
    };
    if (w > 0) {
#pragma unroll 1
        for (int c = 0; c < RB_P; ++c) issue(c);
        asm volatile("s_waitcnt vmcnt(9)" ::: "memory");
    }
    __builtin_amdgcn_s_barrier();
    f32x4 s[4]; for (int i = 0; i < 4; ++i) s[i] = (f32x4){0.f, 0.f, 0.f, 0.f};
    RbOpsA cur, nxt; RbOpsB cb_;
    if (w == 0) { rb_read_a(lds, lane, cur); }
#pragma unroll 1
    for (int c = 0; c < 256; ++c) {
        if (w > 0) {
            if (c + RB_P < 256) { issue(c + RB_P); asm volatile("s_waitcnt vmcnt(9)" ::: "memory"); }
            else asm volatile("s_waitcnt vmcnt(0)" ::: "memory");
        } else {
            const size_t ub = (size_t)c * 16 + head;
            rb_read_b(lds + (c % RB_R) * RB_SLOT, lane, cb_);
            rb_read_a(lds + ((c + 1 < 256 ? c + 1 : c) % RB_R) * RB_SLOT, lane, nxt);
            bf16x8 sb[2];
#pragma unroll
            for (int ks = 0; ks < 2; ++ks) { u32x4 o; o.x = pk2(s[2 * ks][0], s[2 * ks][1]); o.y = pk2(s[2 * ks][2], s[2 * ks][3]); o.z = pk2(s[2 * ks + 1][0], s[2 * ks + 1][1]); o.w = pk2(s[2 * ks + 1][2], s[2 * ks + 1][3]); sb[ks] = __builtin_bit_cast(bf16x8, o); *(u32x4*)(WS_(p, RS0) + (((ub * 4 + vb) * 2 + ks) * 64 + lane) * 8) = o; }
            f32x4 uu[4];
#pragma unroll
            for (int tt = 0; tt < 4; ++tt) { uu[tt] = (f32x4){bflo(cur.ut[tt].x), bfhi(cur.ut[tt].x), bflo(cur.ut[tt].y), bfhi(cur.ut[tt].y)}; uu[tt] = MFMA16(cur.wf[tt * 2], sb[0], uu[tt]); uu[tt] = MFMA16(cur.wf[tt * 2 + 1], sb[1], uu[tt]); }
            bf16x8 ubf[2];
#pragma unroll
            for (int ks = 0; ks < 2; ++ks) { u32x4 o; o.x = pk2(uu[2 * ks][0], uu[2 * ks][1]); o.y = pk2(uu[2 * ks][2], uu[2 * ks][3]); o.z = pk2(uu[2 * ks + 1][0], uu[2 * ks + 1][1]); o.w = pk2(uu[2 * ks + 1][2], uu[2 * ks + 1][3]); ubf[ks] = __builtin_bit_cast(bf16x8, o); *(u32x4*)(WS_(p, RUa) + (((ub * 4 + vb) * 2 + ks) * 64 + lane) * 8) = o; }
#pragma unroll
            for (int kt = 0; kt < 4; ++kt) { s[kt] = s[kt] * cb_.gc[kt] + (f32x4){bflo(cb_.na[kt].x), bfhi(cb_.na[kt].x), bflo(cb_.na[kt].y), bfhi(cb_.na[kt].y)}; s[kt] = MFMA16(cb_.bf[kt * 2], ubf[0], s[kt]); s[kt] = MFMA16(cb_.bf[kt * 2 + 1], ubf[1], s[kt]); }
            cur = nxt;
            asm volatile("s_waitcnt lgkmcnt(0)" ::: "memory");
        }
        __builtin_amdgcn_s_barrier();
    }
    asm volatile("s_waitcnt vmcnt(0)" ::: "memory");
}

DEV void phase_rw_chc(const Params& p, int j, LAS unsigned char* lds) {
    const int tid = tid_(), bid = bid_(); const int lane = tid & 63, w = tid >> 6; const int fr = lane & 15, fq = lane >> 4;
    LAS float* cum = (LAS float*)lds;
    LAS float* seg = cum + 64 * 64;
    LAS float* Ys = seg + 8 * 64;
    LAS bf16_t* Rs = (LAS bf16_t*)(Ys + 64 * 68);
    LAS bf16_t* Bs = Rs + 64 * RC_LD; LAS bf16_t* Ks = Bs + 64 * RC_LD; LAS bf16_t* Vs = Ks + 64 * RC_LD; LAS bf16_t* Arb = Vs + 64 * RC_LD; LAS bf16_t* Ark = Arb + 64 * RC_LD;
    float pwd[8], pr[8], pkr[8], pal[8], pv[8], pg[8];
    float kkw[8], kaw[8], rkw[8], lgw[8], lbw[8];
    { const size_t po = (size_t)j * D + (bid & 15) * 64 + (tid & 7) * 8; ld8(p.rw_k_k + po, kkw); ld8(p.rw_k_a + po, kaw); ld8(p.rw_r_k + po, rkw); ld8(p.rw_lnx_g + po, lgw); ld8(p.rw_lnx_b + po, lbw); }
    { const int c = bid >> 4, h = bid & 15; rc_load_wd(p, c * 64, h * 64, pwd);
      const size_t go = (size_t)(c * 64 + (tid >> 3)) * D + h * 64 + (tid & 7) * 8; ld8b(WS_(p, Rb) + go, pr); ld8b(WS_(p, Kb) + go, pkr); ld8b(WS_(p, Ab) + go, pal); ld8b(WS_(p, Vb) + go, pv); ld8b(WS_(p, Gb) + go, pg); }
    for (int u = bid; u < 4096; u += NB_) {
        const int c = u >> 4, h = u & 15; const int t0 = c * 64, cb = h * 64; const size_t ub = (size_t)c * 16 + h;
        const int tt = w & 3;
        bf16x8 ufr[2][2], sfr[2][2];
#pragma unroll
        for (int q = 0; q < 2; ++q)
#pragma unroll
            for (int ks = 0; ks < 2; ++ks) { const size_t o = (((ub * 4 + 2 * (w >> 2) + q) * 2 + ks) * 64 + lane) * 8;
                ufr[q][ks] = *(const bf16x8*)(WS_(p, RUa) + o); sfr[q][ks] = *(const bf16x8*)(WS_(p, RS0) + o); }
        lds_barrier();
        rc_cum_regs(pwd, cum, seg);
#ifdef DBL_CUM
        rc_cum_regs(pwd, cum, seg);
#endif
        const int t = tid >> 3, k8 = (tid & 7) * 8; const size_t go = (size_t)(t0 + t) * D + cb + k8;
        float v[8], gg[8]; float bc;
        {   float r[8], a[8], b[8], kh[8], ct[8];
#pragma unroll
            for (int e = 0; e < 8; ++e) { r[e] = pr[e]; v[e] = pv[e]; gg[e] = pg[e]; }
            lds8(cum + t * 64 + k8, ct);
            rc_prep8(pkr, pal, kkw, kaw, a, b, kh);
            if (u + NB_ < 4096) { const int un = u + NB_; const int cn = un >> 4, hn = un & 15; rc_load_wd(p, cn * 64, hn * 64, pwd);
                const size_t gn = (size_t)(cn * 64 + t) * D + hn * 64 + k8; ld8b(WS_(p, Rb) + gn, pr); ld8b(WS_(p, Kb) + gn, pkr); ld8b(WS_(p, Ab) + gn, pal); ld8b(WS_(p, Vb) + gn, pv); ld8b(WS_(p, Gb) + gn, pg); }
            bc = 0.f;
#pragma unroll
            for (int e = 0; e < 8; ++e) bc += r[e] * kh[e] * rkw[e];
            bc += __shfl_xor(bc, 1); bc += __shfl_xor(bc, 2); bc += __shfl_xor(bc, 4);
#pragma unroll
            for (int e = 0; e < 8; ++e) { const float ei = __expf(-ct[e]); r[e] *= __expf(ct[e]); b[e] *= ei; kh[e] *= ei; }
            *(LAS u32x4*)(Rs + t * RC_LD + k8) = pk8(r); *(LAS u32x4*)(Bs + t * RC_LD + k8) = pk8(b); *(LAS u32x4*)(Ks + t * RC_LD + k8) = pk8(kh); *(LAS u32x4*)(Vs + t * RC_LD + k8) = pk8(v);
        }
        lds_barrier();
#ifdef DBL_S3
#pragma unroll 1
        for (int rep_ = 0; rep_ < 2; ++rep_)
#endif
        {   const int tb = w >> 1;
#pragma unroll
            for (int ii = 0; ii < 2; ++ii) { const int ib = 2 * (w & 1) + ii;
                f32x4 ab = {0.f, 0.f, 0.f, 0.f}, ak = {0.f, 0.f, 0.f, 0.f};
                if (ib <= tb) {
#pragma unroll
                    for (int ks = 0; ks < 2; ++ks) { const bf16x8 af = frag_rm(Rs, RC_LD, 16 * tb, 32 * ks, lane);
                        ab = MFMA16(af, frag_rm(Bs, RC_LD, 16 * ib, 32 * ks, lane), ab); ak = MFMA16(af, frag_rm(Ks, RC_LD, 16 * ib, 32 * ks, lane), ak); } }
#pragma unroll
                for (int r = 0; r < 4; ++r) { const int tr = 16 * tb + 4 * fq + r, i = 16 * ib + fr; const bool keep = i <= tr;
                    Arb[tr * RC_LD + i] = (bf16_t)f2bf(keep ? ab[r] : 0.f); Ark[tr * RC_LD + i] = (bf16_t)f2bf(keep ? ak[r] : 0.f); } }
        }
        lds_barrier();
#ifdef DBL_Y
#pragma unroll 1
        for (int rep_ = 0; rep_ < 2; ++rep_)
#endif
#pragma unroll
        for (int q = 0; q < 2; ++q) { const int vbk = 2 * (w >> 2) + q; f32x4 acc = {0.f, 0.f, 0.f, 0.f};
#pragma unroll
            for (int ks = 0; ks < 2; ++ks) {
                acc = MFMA16(frag_rm_pi(Rs, RC_LD, 16 * tt, 32 * ks, lane), sfr[q][ks], acc);
                acc = MFMA16(frag_rm_pi(Arb, RC_LD, 16 * tt, 32 * ks, lane), ufr[q][ks], acc);
                acc = MFMA16(frag_rm(Ark, RC_LD, 16 * tt, 32 * ks, lane), frag_tr(Vs, RC_LD, 32 * ks, 16 * vbk, lane), acc); }
#pragma unroll
            for (int r = 0; r < 4; ++r) Ys[(16 * tt + 4 * fq + r) * 68 + 16 * vbk + fr] = acc[r]; }
        lds_barrier();
        {
            float y[8]; lds8(Ys + t * 68 + k8, y);
            float s1 = 0.f, s2 = 0.f;
#pragma unroll
            for (int e = 0; e < 8; ++e) { s1 += y[e]; s2 += y[e] * y[e]; }
            s1 += __shfl_xor(s1, 1); s1 += __shfl_xor(s1, 2); s1 += __shfl_xor(s1, 4); s2 += __shfl_xor(s2, 1); s2 += __shfl_xor(s2, 2); s2 += __shfl_xor(s2, 4);
            const float mean = s1 * (1.0f / 64.0f), var = s2 * (1.0f / 64.0f) - mean * mean; const float rs = rsqrtf(fmaxf(var, 0.f) + 64e-5f);
            float o[8];
#pragma unroll
            for (int e = 0; e < 8; ++e) o[e] = ((y[e] - mean) * rs * lgw[e] + lbw[e] + bc * v[e]) * gg[e];
            *(u32x4*)(WS_(p, YB) + go) = pk8(o);
        }
    }
}
DEV void phase_ln1(const Params& p, int layer, LAS unsigned char* lds) {
    const int tid = tid_(), bid = bid_(); (void)tid; (void)bid;
    const int lane = tid & 63, wid = tid >> 6; const int fr = lane & 15, fq = lane >> 4;
    LAS float* lgt = (LAS float*)lds;
    LAS int* cnt = (LAS int*)(lgt + 2 * 64 * 48);
    if (tid < 32) cnt[tid] = 0;
    const float* g = p.ln_g + ((size_t)layer * 2 + 0) * D; const float* be = p.ln_b + ((size_t)layer * 2 + 0) * D;
    const float* br = p.moe_b_route + layer * 32; const float* bg = p.moe_b_group + layer * 4;
    f32x4 gwv[4], bwv[4];
#pragma unroll
    for (int q = 0; q < 4; ++q) { gwv[q] = *(const f32x4*)(g + RCOL(q, lane)); bwv[q] = *(const f32x4*)(be + RCOL(q, lane)); }
    u32x2 rh[4], rm[4];
#pragma unroll
    for (int q = 0; q < 4; ++q) { rh[q] = *(const u32x2*)(WS_(p, Hb) + (size_t)(bid * 64 + wid * 8) * D + RCOL(q, lane)); rm[q] = *(const u32x2*)(WS_(p, MIXb) + (size_t)(bid * 64 + wid * 8) * D + RCOL(q, lane)); }
#pragma unroll 1
    for (int rr = 0; rr < 8; ++rr) {
        const int t = bid * 64 + wid * 8 + rr; const size_t ro = (size_t)t * D;
        f32x4 z[4], m[4];
#pragma unroll
        for (int q = 0; q < 4; ++q) { z[q] = (f32x4){bflo(rh[q].x), bfhi(rh[q].x), bflo(rh[q].y), bfhi(rh[q].y)}; m[q] = (f32x4){bflo(rm[q].x), bfhi(rm[q].x), bflo(rm[q].y), bfhi(rm[q].y)}; }
        { const size_t rn = (size_t)(rr < 7 ? t + 1 : t) * D;
#pragma unroll
          for (int q = 0; q < 4; ++q) { rh[q] = *(const u32x2*)(WS_(p, Hb) + rn + RCOL(q, lane)); rm[q] = *(const u32x2*)(WS_(p, MIXb) + rn + RCOL(q, lane)); } }
        float s = 0.f;
#pragma unroll
        for (int q = 0; q < 4; ++q) { z[q] = z[q] * ALPHA + m[q]; s += z[q][0] + z[q][1] + z[q][2] + z[q][3]; }
        const float mean = wave_sum(s) * (1.0f / D);
        float vs = 0.f;
#pragma unroll
        for (int q = 0; q < 4; ++q) { z[q] = z[q] - mean; vs += z[q][0] * z[q][0] + z[q][1] * z[q][1] + z[q][2] * z[q][2] + z[q][3] * z[q][3]; }
        const float rs = rsqrtf(wave_sum(vs) * (1.0f / D) + LN_EPS);
#pragma unroll
        for (int q = 0; q < 4; ++q) {
            st_bf4(WS_(p, H1b) + ro + RCOL(q, lane), z[q] * rs * gwv[q] + bwv[q]);
        }
    }
    asm volatile("s_waitcnt vmcnt(0)" ::: "memory");
    __syncthreads();
    {   const int rt = wid & 3, kh = wid >> 2;
        const bf16_t* Ab = WS_(p, H1b) + (size_t)(bid * 64 + 16 * rt + fr) * D + 512 * kh + 8 * fq;
        const bf16_t* Wb = WS_(p, moe_wr_t) + (size_t)layer * 48 * D + (size_t)fr * D + 512 * kh + 8 * fq;
        f32x4 acc[3]; for (int i = 0; i < 3; ++i) acc[i] = (f32x4){0.f, 0.f, 0.f, 0.f};
#pragma unroll 8
        for (int ks = 0; ks < 16; ++ks) {
            const bf16x8 af = *(const bf16x8*)(Ab + 32 * ks);
#pragma unroll
            for (int ct = 0; ct < 3; ++ct) acc[ct] = MFMA16(af, *(const bf16x8*)(Wb + (size_t)16 * ct * D + 32 * ks), acc[ct]);
        }
#pragma unroll
        for (int ct = 0; ct < 3; ++ct)
#pragma unroll
            for (int r = 0; r < 4; ++r) lgt[(kh * 64 + 16 * rt + 4 * fq + r) * 48 + 16 * ct + fr] = acc[ct][r];
    }
    __syncthreads();
    if (tid < 64) {
        const int t = bid * 64 + tid; const LAS float* L0 = lgt + tid * 48; const LAS float* L1 = lgt + (64 + tid) * 48;
        const float q0 = L0[32] + L1[32] + bg[0], q1 = L0[33] + L1[33] + bg[1], q2 = L0[34] + L1[34] + bg[2], q3 = L0[35] + L1[35] + bg[3];
        int gi = 0; float gm = q0;
        if (q1 > gm) { gm = q1; gi = 1; } if (q2 > gm) { gm = q2; gi = 2; } if (q3 > gm) { gm = q3; gi = 3; }
        const float den = __expf(q0 - gm) + __expf(q1 - gm) + __expf(q2 - gm) + __expf(q3 - gm);
        const float pgrp = __builtin_amdgcn_rcpf(den);
        float l1 = -INFINITY, l2 = -INFINITY; int i1 = 0, i2 = 0;
#pragma unroll 1
        for (int o = 0; o < 8; ++o) { const float v = L0[gi * 8 + o] + L1[gi * 8 + o] + br[gi * 8 + o];
            if (v > l1) { l2 = l1; i2 = i1; l1 = v; i1 = o; } else if (v > l2) { l2 = v; i2 = o; } }
        const float e2 = __expf(l2 - l1), inv = __builtin_amdgcn_rcpf(1.0f + e2);
        const int e0 = gi * 8 + i1, e1 = gi * 8 + i2;
        WS_(p, EIDX)[2 * t] = e0; WS_(p, EIDX)[2 * t + 1] = e1; WS_(p, GATE)[2 * t] = pgrp * inv; WS_(p, GATE)[2 * t + 1] = pgrp * e2 * inv;
        atomicAdd((int*)&cnt[e0], 1); atomicAdd((int*)&cnt[e1], 1);
    }
    __syncthreads();
    if (tid < 32) WS_(p, CNT)[bid * 32 + tid] = cnt[tid];
}

DEV void phase_moe_scatter(const Params& p, LAS unsigned char* lds) {
    const int tid = tid_(), bid = bid_(); (void)tid; (void)bid;
    const int lane = tid & 63, wid = tid >> 6;
    LAS int* part = (LAS int*)lds;
    LAS int* pre = part + 512;
    LAS int* base = pre + 512;
    LAS int* pst = base + 32;
    LAS int* dst = pst + 40;
    LAS int* eid = dst + 128;
    { const int e = tid & 31, part_i = tid >> 5; int tot = 0, prf = 0;
      for (int b = part_i * 16; b < part_i * 16 + 16; ++b) { const int c = WS_(p, CNT)[b * 32 + e]; tot += c; if (b < (int)bid) prf += c; }
      part[part_i * 32 + e] = tot; pre[part_i * 32 + e] = prf; }
    if (tid < 128) eid[tid] = WS_(p, EIDX)[bid * 128 + tid];
    lds_barrier();
    if (tid < 32) { int tot = 0, prf = 0; for (int i = 0; i < 16; ++i) { tot += part[i * 32 + tid]; prf += pre[i * 32 + tid]; } part[tid] = tot; pre[tid] = prf; }
    lds_barrier();
    if (tid == 0) { int acc = 0; for (int e = 0; e < 32; ++e) { pst[e] = acc; acc += ((part[e] + 255) >> 8) << 8; } pst[32] = acc;
        if (bid == 0) { for (int e = 0; e <= 32; ++e) WS_(p, TAB)[e] = pst[e]; WS_(p, TAB)[33] = acc >> 8;
            for (int e = 0; e < 32; ++e) for (int mt = pst[e] >> 8; mt < (pst[e + 1] >> 8); ++mt) WS_(p, TAB)[64 + mt] = e; } }
    lds_barrier();
    if (tid < 32) { int run = pst[tid] + pre[tid];
#pragma unroll 16
        for (int a = 0; a < 128; ++a) if (eid[a] == tid) dst[a] = run++; }
    lds_barrier();
    if (tid < 128) WS_(p, DEST)[bid * 128 + tid] = dst[tid];
#pragma unroll 4
    for (int a = wid * 16; a < wid * 16 + 16; ++a) {
        const int t = bid * 64 + (a >> 1); const int d = dst[a];
        const u32x4 v0 = *(const u32x4*)(WS_(p, H1b) + (size_t)t * D + lane * 8), v1 = *(const u32x4*)(WS_(p, H1b) + (size_t)t * D + 512 + lane * 8);
        *(u32x4*)(WS_(p, BUF) + (size_t)d * D + lane * 8) = v0; *(u32x4*)(WS_(p, BUF) + (size_t)d * D + 512 + lane * 8) = v1;
    }
}

template <int which> struct SchedMoe {
    const Params* p; int layer; const LAS int* tab;
    DEV bool next(int i, Unit& u) const {
        const int nmt = tab[33]; int pm, pn; if (!pg8::tile_order(i, NB_, bid_(), nmt, 4, pm, pn)) return false;
        const int row0 = pm * 256; const int e = tab[64 + pm];
        if constexpr (which == 0) { u.A = (const char*)(WS_(*p, BUF) + (size_t)row0 * D); u.B = (const char*)(WS_(*p, moe_w1_t) + ((size_t)layer * 32 + e) * 1024 * 1024 + (size_t)pn * 256 * 1024); }
        else { u.A = (const char*)(WS_(*p, ACT) + (size_t)row0 * 512); u.B = (const char*)(WS_(*p, moe_w2_t) + ((size_t)layer * 32 + e) * 1024 * 512 + (size_t)pn * 256 * 512); }
        u.row0 = row0; u.col0 = pn * 256; u.id = e; u.aux = 0; return true;
    }
};
struct EpiMoe1 {
    bf16_t* O;
    DEV void operator()(const AccT& acc, const Unit& u, int wr, int wc, int fr, int fq) const {
#pragma unroll
        for (int ai = 0; ai < 2; ++ai)
#pragma unroll
            for (int m = 0; m < 4; ++m)
#pragma unroll
                for (int n = 0; n < 2; ++n) {
                    const f32x4 gt = acc[ai][0][m][n], up = acc[ai][1][m][n]; f32x4 v;
                    for (int e = 0; e < 4; ++e) v[e] = siluf_(gt[e]) * up[e];
                    const int col = (u.col0 >> 1) + 32 * wc + 16 * n + 4 * fq;
                    st_bf4(O + (size_t)ACC_ROW(u, ai, m) * 512 + col, v); ACC_FENCE;
                }
    }
};
struct EpiMoe2 {
    bf16_t* O;
    DEV void operator()(const AccT& acc, const Unit& u, int wr, int wc, int fr, int fq) const {
        FOR_ACC(ai, bj, m, n) { st_bf4(O + (size_t)ACC_ROW(u, ai, m) * D + ACC_COL(u, bj, n), acc[ai][bj][m][n]); ACC_FENCE; }
    }
};

struct Ln2Raw { u32x2 h[4], a[4], b[4]; float g0, g1; };
DEV void ln2_issue(const Params& p, int t, int lane, Ln2Raw& R, int dpre, float gpre, int tbase) {
    const int i0 = 2 * (t - tbase); const int d0 = __shfl(dpre, i0), d1 = __shfl(dpre, i0 + 1); R.g0 = __shfl(gpre, i0); R.g1 = __shfl(gpre, i0 + 1);
#pragma unroll
    for (int q = 0; q < 4; ++q) { R.h[q] = *(const u32x2*)(WS_(p, H1b) + (size_t)t * D + RCOL(q, lane));
        R.a[q] = *(const u32x2*)(WS_(p, YBUF) + (size_t)d0 * D + RCOL(q, lane)); R.b[q] = *(const u32x2*)(WS_(p, YBUF) + (size_t)d1 * D + RCOL(q, lane)); }
}
DEV void ln2_finish(const Ln2Raw& R, const f32x4 (&gwv)[4], const f32x4 (&bwv)[4], f32x4 (&z)[4]) {
    float s = 0.f; const float g0 = R.g0, g1 = R.g1;
#pragma unroll
    for (int q = 0; q < 4; ++q) {
        z[q][0] = bflo(R.h[q].x) * ALPHA + g0 * bflo(R.a[q].x) + g1 * bflo(R.b[q].x); z[q][1] = bfhi(R.h[q].x) * ALPHA + g0 * bfhi(R.a[q].x) + g1 * bfhi(R.b[q].x);
        z[q][2] = bflo(R.h[q].y) * ALPHA + g0 * bflo(R.a[q].y) + g1 * bflo(R.b[q].y); z[q][3] = bfhi(R.h[q].y) * ALPHA + g0 * bfhi(R.a[q].y) + g1 * bfhi(R.b[q].y);
        s += z[q][0] + z[q][1] + z[q][2] + z[q][3];
    }
    const float mean = wave_sum(s) * (1.0f / D);
    float vs = 0.f;
#pragma unroll
    for (int q = 0; q < 4; ++q) { z[q] = z[q] - mean; vs += z[q][0] * z[q][0] + z[q][1] * z[q][1] + z[q][2] * z[q][2] + z[q][3] * z[q][3]; }
    const float rs = rsqrtf(wave_sum(vs) * (1.0f / D) + LN_EPS);
#pragma unroll
    for (int q = 0; q < 4; ++q) z[q] = z[q] * rs * gwv[q] + bwv[q];
}
DEV void phase_ln2(const Params& p, int layer, LAS unsigned char* lds) {
    const int tid = tid_(), bid = bid_(); const int lane = tid & 63, wid = tid >> 6; const int fr = lane & 15, fq = lane >> 4;
    const float* g = p.ln_g + ((size_t)layer * 2 + 1) * D; const float* be = p.ln_b + ((size_t)layer * 2 + 1) * D;
    const int nk = layer == DEPTH - 1 ? 3 : (layer + 1) % 3;
    const int nj = (layer + 1) / 3;
    LAS float* lgt = (LAS float*)lds;
    LAS float* w2 = lgt + 2 * 64 * 32;
    if (nk == 2) { for (int i = tid; i < 16 * 512; i += NTHR) w2[i] = p.gl_gk_w2[(size_t)nj * 16 * 512 + i]; }
    const int tfirst = bid * 64 + wid * 8;
    f32x4 z[4], zp[4], gwv[4], bwv[4];
#pragma unroll
    for (int q = 0; q < 4; ++q) { gwv[q] = *(const f32x4*)(g + RCOL(q, lane)); bwv[q] = *(const f32x4*)(be + RCOL(q, lane)); }
    Ln2Raw R[3];
    const int tbase = tfirst > 0 ? tfirst - 1 : 0;
    const int dpre = lane < 18 ? WS_(p, DEST)[2 * tbase + lane] : 0; const float gpre = lane < 18 ? WS_(p, GATE)[2 * tbase + lane] : 0.f;
    if (nk == 0) { if (tfirst > 0) { ln2_issue(p, tfirst - 1, lane, R[2], dpre, gpre, tbase); } }
    ln2_issue(p, tfirst, lane, R[0], dpre, gpre, tbase);
    ln2_issue(p, tfirst + 1, lane, R[1], dpre, gpre, tbase);
    if (nk == 0) { if (tfirst > 0) ln2_finish(R[2], gwv, bwv, zp); else { for (int q = 0; q < 4; ++q) zp[q] = (f32x4){0.f, 0.f, 0.f, 0.f}; } }
#pragma unroll
    for (int rr = 0; rr < 8; ++rr) {
        const int t = tfirst + rr; const size_t ro = (size_t)t * D;
        if (rr + 2 < 8) ln2_issue(p, t + 2, lane, R[(rr + 2) % 3], dpre, gpre, tbase);
        ln2_finish(R[rr % 3], gwv, bwv, z);
        if (nk == 3) {
#pragma unroll
            for (int q = 0; q < 4; ++q) *(f32x4*)(p.out + ro + RCOL(q, lane)) = z[q];
        } else store_row_bf(WS_(p, Hb) + ro, lane, z);
        if (nk == 0) {
            emit_mix6(p, nj, t, lane, z, zp);
#pragma unroll
            for (int q = 0; q < 4; ++q) zp[q] = z[q];
        }
    }
    if (nk == 1 || nk == 2) {
        asm volatile("s_waitcnt vmcnt(0)" ::: "memory");
        __syncthreads();
        const int nct = nk == 1 ? 2 : 1; const int rt = wid & 3, kh = wid >> 2;
        const bf16_t* Ab = WS_(p, Hb) + (size_t)(bid * 64 + 16 * rt + fr) * D + 512 * kh + 8 * fq;
        const bf16_t* Wb = (nk == 1 ? WS_(p, mb_dt_t) : WS_(p, gl_lr_t)) + (size_t)fr * D + 512 * kh + 8 * fq;
        f32x4 acc[2]; acc[0] = (f32x4){0.f, 0.f, 0.f, 0.f}; acc[1] = acc[0];
#pragma unroll 4
        for (int ks = 0; ks < 16; ++ks) {
            const bf16x8 af = *(const bf16x8*)(Ab + 32 * ks);
            acc[0] = MFMA16(af, *(const bf16x8*)(Wb + 32 * ks), acc[0]);
            if (nct == 2) acc[1] = MFMA16(af, *(const bf16x8*)(Wb + (size_t)16 * D + 32 * ks), acc[1]);
        }
#pragma unroll
        for (int ct = 0; ct < 2; ++ct)
#pragma unroll
            for (int r = 0; r < 4; ++r) lgt[(kh * 64 + 16 * rt + 4 * fq + r) * 32 + 16 * ct + fr] = acc[ct][r];
        __syncthreads();
        if (nk == 1) {
#pragma unroll
            for (int i = 0; i < 4; ++i) { const int idx = tid + i * NTHR; const int row = idx >> 5, o = idx & 31;
                WS_(p, DT)[(size_t)(bid * 64 + row) * 32 + o] = softplusf_(lgt[row * 32 + o] + lgt[(64 + row) * 32 + o] + p.mb_dt_bias[nj * 32 + o]); }
        } else {
            const int row = tid >> 3, c0 = (tid & 7) * 64; float lr[16];
#pragma unroll
            for (int o = 0; o < 16; ++o) lr[o] = lgt[row * 32 + o] + lgt[(64 + row) * 32 + o];
#pragma unroll 1
            for (int c4 = 0; c4 < 16; ++c4) { const int c = c0 + 4 * c4; f32x4 a = *(const f32x4*)(p.gl_gk_b + nj * 512 + c);
#pragma unroll
                for (int o = 0; o < 16; ++o) { const f32x4 wv = *(const LAS f32x4*)(w2 + o * 512 + c); a = a + wv * lr[o]; }
                f32x4 r;
#pragma unroll
                for (int e = 0; e < 4; ++e) r[e] = (fminf(a[e], 0.f) - __logf(1.0f + __expf(-fabsf(a[e])))) * (1.0f / 16.0f);
                *(f32x4*)(WS_(p, LA) + (size_t)(bid * 64 + row) * 512 + c) = r; }
        }
    }
}
constexpr int MB_PROJ = 5152;
struct SchedMbIn {
    const Params* p;
    DEV bool next(int i, Unit& u) const {
        int pm, pn; if (!pg8::tile_order(i, NB_, bid_(), 64, 20, pm, pn)) return false;
        u.A = (const char*)(WS_(*p, Hb) + (size_t)pm * 256 * D); u.B = (const char*)(WS_(*p, mb_win_t) + (size_t)pn * 256 * D); u.row0 = pm * 256; u.col0 = pn * 256; u.id = 0; u.aux = 0; return true;
    }
};
struct EpiMbIn {
    const Params* p;
    DEV void operator()(const AccT& acc, const Unit& u, int wr, int wc, int fr, int fq) const {
        const bool isz = u.col0 < 2048; bf16_t* O = WS_(*p, Z) + (isz ? (size_t)0 : (size_t)T * 2048 - 2048); const int ld = isz ? 2048 : 3072;
        FOR_ACC(ai, bj, m, n) { st_bf4(O + (size_t)ACC_ROW(u, ai, m) * ld + ACC_COL(u, bj, n), acc[ai][bj][m][n]); ACC_FENCE; }
    }
};
DEV void phase_mb_conv(const Params& p, int j) {
    const int tid = tid_(), bid = bid_(); (void)tid; (void)bid;
    if (tid >= 384) return;
    const int c0 = tid * 8; const int t0 = bid * 64;
    const float* cw = p.mb_conv_w + (size_t)j * 4 * 3072; const float* cb = p.mb_conv_b + (size_t)j * 3072;
    float w[4][8], b[8];
#pragma unroll
    for (int i = 0; i < 4; ++i) { const f32x4 a = *(const f32x4*)(cw + i * 3072 + c0), bb = *(const f32x4*)(cw + i * 3072 + c0 + 4); for (int e = 0; e < 4; ++e) { w[i][e] = a[e]; w[i][4 + e] = bb[e]; } }
    { const f32x4 a = *(const f32x4*)(cb + c0), bb = *(const f32x4*)(cb + c0 + 4); for (int e = 0; e < 4; ++e) { b[e] = a[e]; b[4 + e] = bb[e]; } }
    float x0[8], x1[8], x2[8], x3[8];
    auto ld = [&](int t, float (&x)[8]) {
        if (t < 0) { for (int e = 0; e < 8; ++e) x[e] = 0.f; return; }
        const u32x4 v = *(const u32x4*)(WS_(p, XBC) + (size_t)t * 3072 + c0);
        x[0] = bflo(v.x); x[1] = bfhi(v.x); x[2] = bflo(v.y); x[3] = bfhi(v.y); x[4] = bflo(v.z); x[5] = bfhi(v.z); x[6] = bflo(v.w); x[7] = bfhi(v.w);
    };
    ld(t0 - 3, x0); ld(t0 - 2, x1); ld(t0 - 1, x2);
#pragma unroll 4
    for (int tt = 0; tt < 64; ++tt) {
        ld(t0 + tt, x3);
        float o[8];
#pragma unroll
        for (int e = 0; e < 8; ++e) o[e] = siluf_(b[e] + w[0][e] * x0[e] + w[1][e] * x1[e] + w[2][e] * x2[e] + w[3][e] * x3[e]);
        u32x4 r; r.x = pk2(o[0], o[1]); r.y = pk2(o[2], o[3]); r.z = pk2(o[4], o[5]); r.w = pk2(o[6], o[7]);
        *(u32x4*)(WS_(p, XC) + (size_t)(t0 + tt) * 3072 + c0) = r;
#pragma unroll
        for (int e = 0; e < 8; ++e) { x0[e] = x1[e]; x1[e] = x2[e]; x2[e] = x3[e]; }
    }
}

DEV void mb_dacs(const Params& p, int j, int c, int g, LAS float* dts, LAS float* dacs) {
    const int tid = tid_(); const int lane = tid & 63, h = tid >> 6;
    const int hh = 8 * g + h; const float a = -__expf(p.mb_a_log[j * 32 + hh]);
    const float d0 = WS_(p, DT)[(size_t)(c * 128 + 2 * lane) * 32 + hh], d1 = WS_(p, DT)[(size_t)(c * 128 + 2 * lane + 1) * 32 + hh];
    const float a0 = d0 * a, a1 = d1 * a;
    float s = a0 + a1;
#pragma unroll
    for (int o = 1; o < 64; o <<= 1) { const float v = __shfl_up(s, o); if (lane >= o) s += v; }
    dts[h * 128 + 2 * lane] = d0; dts[h * 128 + 2 * lane + 1] = d1;
    dacs[h * 128 + 2 * lane] = s - a1; dacs[h * 128 + 2 * lane + 1] = s;
}
constexpr int LDB = 136;
constexpr int LDX = 72;
DEV void ld_tile128(const bf16_t* src, int gld, LAS bf16_t* dst) {
    const int tid = tid_();
    for (int i = tid; i < 128 * 16; i += NTHR) { const int r = i >> 4, c8 = (i & 15) * 8; *(LAS u32x4*)(dst + r * LDB + c8) = *(const u32x4*)(src + (size_t)r * gld + c8); }
}

DEV void phase_mb_states(const Params& p, int j, LAS unsigned char* lds) {
    const int tid = tid_(), bid = bid_(); (void)tid; (void)bid;
    const int lane = tid & 63, w = tid >> 6;
    LAS bf16_t* Bm = (LAS bf16_t*)lds;
    LAS bf16_t* Xh = Bm + 128 * LDB;
    LAS float* dts = (LAS float*)(Xh + 128 * LDX);
    LAS float* dacs = dts + 1024;
    for (int u = bid; u < 512; u += NB_) {
        const int c = u >> 2, g = u & 3; const int t0 = c * 128;
        lds_barrier();
        mb_dacs(p, j, c, g, dts, dacs);
        ld_tile128(WS_(p, XC) + (size_t)t0 * 3072 + 2048 + 128 * g, 3072, Bm);
        lds_barrier();
        if (tid < 8) WS_(p, CD)[(c * 32) + 8 * g + tid] = __expf(dacs[tid * 128 + 127]);
        bf16x8 bfr[4];
#pragma unroll
        for (int ks = 0; ks < 4; ++ks) bfr[ks] = frag_tr(Bm, LDB, 32 * ks, 16 * w, lane);
        for (int h = 0; h < 8; ++h) {
            { const int l = tid >> 2, p0 = (tid & 3) * 16; const float sc = dts[h * 128 + l] * __expf(dacs[h * 128 + 127] - dacs[h * 128 + l]);
              const bf16_t* src = WS_(p, XC) + (size_t)(t0 + l) * 3072 + 64 * (8 * g + h) + p0;
#pragma unroll
              for (int hf = 0; hf < 2; ++hf) { const u32x4 v = *(const u32x4*)(src + 8 * hf); u32x4 r;
                  r.x = pk2(bflo(v.x) * sc, bfhi(v.x) * sc); r.y = pk2(bflo(v.y) * sc, bfhi(v.y) * sc); r.z = pk2(bflo(v.z) * sc, bfhi(v.z) * sc); r.w = pk2(bflo(v.w) * sc, bfhi(v.w) * sc);
                  *(LAS u32x4*)(Xh + l * LDX + p0 + 8 * hf) = r; } }
            lds_barrier();
            f32x4 acc[4];
#pragma unroll
            for (int pb = 0; pb < 4; ++pb) { acc[pb] = (f32x4){0.f, 0.f, 0.f, 0.f};
#pragma unroll
                for (int ks = 0; ks < 4; ++ks) { const bf16x8 af = frag_tr(Xh, LDX, 32 * ks, 16 * pb, lane); acc[pb] = MFMA16(af, bfr[ks], acc[pb]); } }
            bf16_t* S = WS_(p, STATES) + (((size_t)c * 32 + 8 * g + h) * 64) * 128;
#pragma unroll
            for (int pb = 0; pb < 4; ++pb)
#pragma unroll
                for (int r = 0; r < 4; ++r) S[(size_t)(16 * pb + 4 * (lane >> 4) + r) * 128 + 16 * w + (lane & 15)] = (bf16_t)f2bf(acc[pb][r]);
            lds_barrier();
        }
    }
}
DEV void phase_mb_scan(const Params& p) {
    const int tid = tid_(), bid = bid_();
    if (tid >= 128) return;
    const int gid = bid * 128 + tid;
    const int n8 = gid & 15, pp = (gid >> 4) & 63, h = gid >> 10; const int n = 8 * n8;
    float r[8]; for (int e = 0; e < 8; ++e) r[e] = 0.f;
    const size_t eo = ((size_t)h * 64 + pp) * 128 + n;
    const size_t fo = (size_t)h * 64 * 128 + fragmajor_off(pp, n, 128);
#pragma unroll 8
    for (int c = 0; c < 128; ++c) {
        const u32x4 sr = *(const u32x4*)(WS_(p, STATES) + (size_t)c * 32 * 64 * 128 + eo);
        const float cd = WS_(p, CD)[c * 32 + h];
        u32x4 o; o.x = pk2(r[0], r[1]); o.y = pk2(r[2], r[3]); o.z = pk2(r[4], r[5]); o.w = pk2(r[6], r[7]);
        *(u32x4*)(WS_(p, PREV) + (size_t)c * 32 * 64 * 128 + fo) = o;
        r[0] = r[0] * cd + bflo(sr.x); r[1] = r[1] * cd + bfhi(sr.x); r[2] = r[2] * cd + bflo(sr.y); r[3] = r[3] * cd + bfhi(sr.y);
        r[4] = r[4] * cd + bflo(sr.z); r[5] = r[5] * cd + bfhi(sr.z); r[6] = r[6] * cd + bflo(sr.w); r[7] = r[7] * cd + bfhi(sr.w);
    }
}
DEV void phase_mb_out(const Params& p, int j, LAS unsigned char* lds) {
    const int tid = tid_(), bid = bid_(); (void)tid; (void)bid;
    const int lane = tid & 63, w = tid >> 6; const int fr = lane & 15, fq = lane >> 4;
    LAS bf16_t* Cm = (LAS bf16_t*)lds;
    LAS bf16_t* Bm = Cm + 128 * LDB;
    LAS bf16_t* Xh = Bm + 128 * LDB;
    LAS bf16_t* Mw = Xh + 128 * LDX;
    LAS float* dts = (LAS float*)(Mw + 8 * 16 * LDB);
    LAS float* dacs = dts + 1024;
    LAS bf16_t* Mme = Mw + w * 16 * LDB;
    for (int u = bid; u < 512; u += NB_) {
        const int c = u >> 2, g = u & 3; const int t0 = c * 128;
        lds_barrier();
        mb_dacs(p, j, c, g, dts, dacs);
        ld_tile128(WS_(p, XC) + (size_t)t0 * 3072 + 2048 + 512 + 128 * g, 3072, Cm);
        ld_tile128(WS_(p, XC) + (size_t)t0 * 3072 + 2048 + 128 * g, 3072, Bm);
        lds_barrier();
        f32x4 sc[8]; bf16x8 cf[4];
#pragma unroll
        for (int ks = 0; ks < 4; ++ks) cf[ks] = frag_rm(Cm, LDB, 16 * w, 32 * ks, lane);
#pragma unroll
        for (int sb = 0; sb < 8; ++sb) { sc[sb] = (f32x4){0.f, 0.f, 0.f, 0.f};
#pragma unroll
            for (int ks = 0; ks < 4; ++ks) sc[sb] = MFMA16(cf[ks], frag_rm(Bm, LDB, 16 * sb, 32 * ks, lane), sc[sb]); }
        float ssq = 0.f;
        const int rl = tid >> 2, p0 = (tid & 3) * 16;
        const LAS float* Yrow = (const LAS float*)(Mw + (rl >> 4) * 16 * LDB) + (rl & 15) * 68 + p0;
        LAS float* Yw = (LAS float*)Mme;
        u32x4 xraw[2], zraw[2], xnx[2], znx[2]; bf16x8 pfc[16];
#define MB_LOADH(HH, XR, ZR) do { const int hh_ = 8 * g + (HH); \
            XR[0] = *(const u32x4*)(WS_(p, XC) + (size_t)(t0 + rl) * 3072 + 64 * hh_ + p0); XR[1] = *(const u32x4*)(WS_(p, XC) + (size_t)(t0 + rl) * 3072 + 64 * hh_ + p0 + 8); \
            ZR[0] = *(const u32x4*)(WS_(p, Z) + (size_t)(t0 + rl) * 2048 + 64 * hh_ + p0); ZR[1] = *(const u32x4*)(WS_(p, Z) + (size_t)(t0 + rl) * 2048 + 64 * hh_ + p0 + 8); } while (0)
        MB_LOADH(0, xraw, zraw);
#pragma unroll 1
        for (int h = 0; h < 8; ++h) {
            const int hh = 8 * g + h;
            MB_LOADH(h < 7 ? h + 1 : h, xnx, znx);
            { const bf16_t* pv_ = WS_(p, PREV) + ((size_t)c * 32 + hh) * 64 * 128;
#pragma unroll
              for (int i_ = 0; i_ < 16; ++i_) pfc[i_] = *(const bf16x8*)(pv_ + ((size_t)i_ * 64 + lane) * 8); }
            { const float scl = dts[h * 128 + rl];
#pragma unroll
              for (int hf = 0; hf < 2; ++hf) { const u32x4 v = xraw[hf]; u32x4 r;
                  r.x = pk2(bflo(v.x) * scl, bfhi(v.x) * scl); r.y = pk2(bflo(v.y) * scl, bfhi(v.y) * scl); r.z = pk2(bflo(v.z) * scl, bfhi(v.z) * scl); r.w = pk2(bflo(v.w) * scl, bfhi(v.w) * scl);
                  *(LAS u32x4*)(Xh + rl * LDX + p0 + 8 * hf) = r; } }
            const u32x4 zraw0 = zraw[0], zraw1 = zraw[1];
            float dl[4];
#pragma unroll
            for (int r = 0; r < 4; ++r) dl[r] = dacs[h * 128 + 16 * w + 4 * fq + r];
#pragma unroll
            for (int sb = 0; sb < 8; ++sb) { const int s_ = 16 * sb + fr; const float ds = dacs[h * 128 + s_];
#pragma unroll
                for (int r = 0; r < 4; ++r) { const int l = 16 * w + 4 * fq + r; const float m = (s_ <= l) ? sc[sb][r] * __expf(dl[r] - ds) : 0.f; Mme[(4 * fq + r) * LDB + s_] = (bf16_t)f2bf(m); } }
            lds_barrier();
            bf16x8 mf[4];
#pragma unroll
            for (int ks = 0; ks < 4; ++ks) mf[ks] = frag_rm(Mme, LDB, 0, 32 * ks, lane);
            f32x4 yv[4];
#pragma unroll
            for (int pb = 0; pb < 4; ++pb) {
                f32x4 a = {0.f, 0.f, 0.f, 0.f}, o = {0.f, 0.f, 0.f, 0.f};
#pragma unroll
                for (int ks = 0; ks < 4; ++ks) {
                    a = MFMA16(mf[ks], frag_tr(Xh, LDX, 32 * ks, 16 * pb, lane), a);
                    o = MFMA16(cf[ks], pfc[pb * 4 + ks], o);
                }
#pragma unroll
                for (int r = 0; r < 4; ++r) a[r] += o[r] * __expf(dl[r]);
                yv[pb] = a;
            }
#pragma unroll
            for (int pb = 0; pb < 4; ++pb)
#pragma unroll
                for (int r = 0; r < 4; ++r) Yw[(4 * fq + r) * 68 + 16 * pb + fr] = yv[pb][r];
            lds_barrier();
            {
                const float dsk = p.mb_d[j * 32 + hh]; const float* ng = p.mb_norm_g + (size_t)j * 2048 + 64 * hh + p0;
                float y[16], xs[16], zz[16];
#pragma unroll
                for (int q = 0; q < 4; ++q) { const f32x4 t4 = *(const LAS f32x4*)(Yrow + 4 * q); y[4 * q] = t4[0]; y[4 * q + 1] = t4[1]; y[4 * q + 2] = t4[2]; y[4 * q + 3] = t4[3]; }
                xs[0] = bflo(xraw[0].x); xs[1] = bfhi(xraw[0].x); xs[2] = bflo(xraw[0].y); xs[3] = bfhi(xraw[0].y); xs[4] = bflo(xraw[0].z); xs[5] = bfhi(xraw[0].z); xs[6] = bflo(xraw[0].w); xs[7] = bfhi(xraw[0].w);
                xs[8] = bflo(xraw[1].x); xs[9] = bfhi(xraw[1].x); xs[10] = bflo(xraw[1].y); xs[11] = bfhi(xraw[1].y); xs[12] = bflo(xraw[1].z); xs[13] = bfhi(xraw[1].z); xs[14] = bflo(xraw[1].w); xs[15] = bfhi(xraw[1].w);
                zz[0] = bflo(zraw0.x); zz[1] = bfhi(zraw0.x); zz[2] = bflo(zraw0.y); zz[3] = bfhi(zraw0.y); zz[4] = bflo(zraw0.z); zz[5] = bfhi(zraw0.z); zz[6] = bflo(zraw0.w); zz[7] = bfhi(zraw0.w);
                zz[8] = bflo(zraw1.x); zz[9] = bfhi(zraw1.x); zz[10] = bflo(zraw1.y); zz[11] = bfhi(zraw1.y); zz[12] = bflo(zraw1.z); zz[13] = bfhi(zraw1.z); zz[14] = bflo(zraw1.w); zz[15] = bfhi(zraw1.w);
                float o[16];
#pragma unroll
                for (int q = 0; q < 4; ++q) { const f32x4 n4 = *(const f32x4*)(ng + 4 * q);
#pragma unroll
                    for (int e = 0; e < 4; ++e) { const int i = 4 * q + e; const float v = (y[i] + xs[i] * dsk) * siluf_(zz[i]); ssq += v * v; o[i] = v * n4[e]; } }
                bf16_t* dst = WS_(p, YB) + (size_t)(t0 + rl) * 2048 + 64 * hh + p0;
                u32x4 w0, w1; w0.x = pk2(o[0], o[1]); w0.y = pk2(o[2], o[3]); w0.z = pk2(o[4], o[5]); w0.w = pk2(o[6], o[7]); w1.x = pk2(o[8], o[9]); w1.y = pk2(o[10], o[11]); w1.z = pk2(o[12], o[13]); w1.w = pk2(o[14], o[15]);
                *(u32x4*)dst = w0; *(u32x4*)(dst + 8) = w1;
            }
            xraw[0] = xnx[0]; xraw[1] = xnx[1]; zraw[0] = znx[0]; zraw[1] = znx[1];
            lds_barrier();
        }
#undef MB_LOADH
        ssq += __shfl_xor(ssq, 1); ssq += __shfl_xor(ssq, 2);
        const float rstd = rsqrtf(ssq * (1.0f / 512.0f) + 1e-5f);
#pragma unroll 1
        for (int h = 0; h < 8; ++h) {
            bf16_t* dst = WS_(p, YB) + (size_t)(t0 + rl) * 2048 + 64 * (8 * g + h) + p0;
#pragma unroll
            for (int hf = 0; hf < 2; ++hf) { const u32x4 v = *(const u32x4*)(dst + 8 * hf); u32x4 r;
                r.x = pk2(bflo(v.x) * rstd, bfhi(v.x) * rstd); r.y = pk2(bflo(v.y) * rstd, bfhi(v.y) * rstd); r.z = pk2(bflo(v.z) * rstd, bfhi(v.z) * rstd); r.w = pk2(bflo(v.w) * rstd, bfhi(v.w) * rstd);
                *(u32x4*)(dst + 8 * hf) = r; }
        }
    }
}
constexpr int GL_PROJ = 3088;
constexpr int LDV = 264;
struct SchedGlIn {
    const Params* p;
    DEV bool next(int i, Unit& u) const {
        int pm, pn; if (!pg8::tile_order(i, NB_, bid_(), 64, 12, pm, pn)) return false;
        u.A = (const char*)(WS_(*p, Hb) + (size_t)pm * 256 * D); u.B = (const char*)(WS_(*p, gl_win_t) + (size_t)pn * 256 * D); u.row0 = pm * 256; u.col0 = pn * 256; u.id = 0; u.aux = 0; return true;
    }
};
struct EpiGlIn {
    const Params* p;
    DEV void operator()(const AccT& acc, const Unit& u, int wr, int wc, int fr, int fq) const {
        FOR_ACC(ai, bj, m, n) { st_bf4(WS_(*p, QKVG) + (size_t)ACC_ROW(u, ai, m) * 3072 + ACC_COL(u, bj, n), acc[ai][bj][m][n]); ACC_FENCE; }
    }
};
DEV void gl_bcs(const Params& p, int n, int h, LAS float* bcs) {
    const int tid = tid_();
    for (int i = tid; i < 64 * 32; i += NTHR) { const int r = i >> 5, c4 = (i & 31) * 4; *(LAS f32x4*)(bcs + r * 128 + c4) = *(const f32x4*)(WS_(p, LA) + (size_t)(n * 64 + r) * 512 + 128 * h + c4); }
    lds_barrier();
    if (tid < 128) { float s = 0.f; for (int r = 0; r < 64; ++r) { s += bcs[r * 128 + tid]; bcs[r * 128 + tid] = s; } }
    lds_barrier();
}
DEV void phase_gl_kv(const Params& p, LAS unsigned char* lds) {
    const int tid = tid_(), bid = bid_(); (void)tid; (void)bid;
    const int lane = tid & 63, w = tid >> 6;
    LAS float* bcs = (LAS float*)lds;
    LAS bf16_t* Ke = (LAS bf16_t*)(bcs + 64 * 128);
    LAS bf16_t* Vs = Ke + 64 * LDB;
    for (int u = bid; u < 1024; u += NB_) {
        const int n = u >> 2, h = u & 3; const int t0 = n * 64;
        lds_barrier();
        gl_bcs(p, n, h, bcs);
        for (int i = tid; i < 64 * 16; i += NTHR) { const int r = i >> 4, c8 = (i & 15) * 8;
            const u32x4 v = *(const u32x4*)(WS_(p, QKVG) + (size_t)(t0 + r) * 3072 + 512 + 128 * h + c8); float f[8];
            f[0] = bflo(v.x); f[1] = bfhi(v.x); f[2] = bflo(v.y); f[3] = bfhi(v.y); f[4] = bflo(v.z); f[5] = bfhi(v.z); f[6] = bflo(v.w); f[7] = bfhi(v.w);
#pragma unroll
            for (int e = 0; e < 8; ++e) f[e] *= __expf(bcs[63 * 128 + c8 + e] - bcs[r * 128 + c8 + e]);
            u32x4 o; o.x = pk2(f[0], f[1]); o.y = pk2(f[2], f[3]); o.z = pk2(f[4], f[5]); o.w = pk2(f[6], f[7]);
            *(LAS u32x4*)(Ke + r * LDB + c8) = o; }
        for (int i = tid; i < 64 * 32; i += NTHR) { const int r = i >> 5, c8 = (i & 31) * 8; *(LAS u32x4*)(Vs + r * LDV + c8) = *(const u32x4*)(WS_(p, QKVG) + (size_t)(t0 + r) * 3072 + 1024 + 256 * h + c8); }
        if (tid < 128) WS_(p, CDG)[((size_t)n * 4 + h) * 128 + tid] = __expf(bcs[63 * 128 + tid]);
        lds_barrier();
        bf16x8 af[2];
#pragma unroll
        for (int ks = 0; ks < 2; ++ks) af[ks] = frag_tr(Ke, LDB, 32 * ks, 16 * w, lane);
        bf16_t* O = WS_(p, STATES) + (((size_t)n * 4 + h) * 128) * 256;
#pragma unroll
        for (int vb = 0; vb < 16; ++vb) {
            f32x4 acc = {0.f, 0.f, 0.f, 0.f};
#pragma unroll
            for (int ks = 0; ks < 2; ++ks) acc = MFMA16(af[ks], frag_tr(Vs, LDV, 32 * ks, 16 * vb, lane), acc);
            { u32x2 o; o.x = pk2(acc[0], acc[1]); o.y = pk2(acc[2], acc[3]); *(u32x2*)(O + (size_t)(16 * vb + (lane & 15)) * 128 + 16 * w + 4 * (lane >> 4)) = o; }
        }
    }
}
DEV void phase_gl_scan(const Params& p) {
    const int tid = tid_(), bid = bid_();
    if (tid >= 64) return;
    const int gid = bid * 64 + tid;
    const int k8 = gid & 15, v = (gid >> 4) & 255, h = gid >> 12; const int k = 8 * k8;
    float r[8]; for (int e = 0; e < 8; ++e) r[e] = 0.f;
    const size_t fo = (size_t)h * 128 * 256 + fragmajor_off(v, k, 128);
#pragma unroll 8
    for (int n = 0; n < 256; ++n) {
        const u32x4 sr = *(const u32x4*)(WS_(p, STATES) + (((size_t)n * 4 + h) * 256 + v) * 128 + k);
        const f32x4 c0 = *(const f32x4*)(WS_(p, CDG) + ((size_t)n * 4 + h) * 128 + k), c1 = *(const f32x4*)(WS_(p, CDG) + ((size_t)n * 4 + h) * 128 + k + 4);
        u32x4 o; o.x = pk2(r[0], r[1]); o.y = pk2(r[2], r[3]); o.z = pk2(r[4], r[5]); o.w = pk2(r[6], r[7]);
        *(u32x4*)(WS_(p, PREV) + (size_t)n * 4 * 128 * 256 + fo) = o;
        r[0] = r[0] * c0[0] + bflo(sr.x); r[1] = r[1] * c0[1] + bfhi(sr.x); r[2] = r[2] * c0[2] + bflo(sr.y); r[3] = r[3] * c0[3] + bfhi(sr.y);
        r[4] = r[4] * c1[0] + bflo(sr.z); r[5] = r[5] * c1[1] + bfhi(sr.z); r[6] = r[6] * c1[2] + bflo(sr.w); r[7] = r[7] * c1[3] + bfhi(sr.w);
    }
}
DEV void phase_gl_out(const Params& p, int j, LAS unsigned char* lds) {
    const int tid = tid_(), bid = bid_(); (void)tid; (void)bid;
    const int lane = tid & 63, w = tid >> 6; const int fr = lane & 15, fq = lane >> 4;
    LAS float* bcs = (LAS float*)lds;
    LAS bf16_t* Qs = (LAS bf16_t*)(bcs + 64 * 128);
    LAS bf16_t* Ks = Qs + 64 * LDB;
    LAS bf16_t* Vs = Ks + 64 * LDB;
    LAS bf16_t* At = Vs + 64 * LDV;
    LAS float* red = (LAS float*)(At + 64 * LDX);
    for (int u = bid; u < 1024; u += NB_) {
        const int n = u >> 2, h = u & 3; const int t0 = n * 64;
        lds_barrier();
        gl_bcs(p, n, h, bcs);
        for (int i = tid; i < 64 * 16; i += NTHR) { const int r = i >> 4, c8 = (i & 15) * 8;
            const u32x4 vq = *(const u32x4*)(WS_(p, QKVG) + (size_t)(t0 + r) * 3072 + 128 * h + c8), vk = *(const u32x4*)(WS_(p, QKVG) + (size_t)(t0 + r) * 3072 + 512 + 128 * h + c8);
            float fq_[8], fk_[8];
            fq_[0] = bflo(vq.x); fq_[1] = bfhi(vq.x); fq_[2] = bflo(vq.y); fq_[3] = bfhi(vq.y); fq_[4] = bflo(vq.z); fq_[5] = bfhi(vq.z); fq_[6] = bflo(vq.w); fq_[7] = bfhi(vq.w);
            fk_[0] = bflo(vk.x); fk_[1] = bfhi(vk.x); fk_[2] = bflo(vk.y); fk_[3] = bfhi(vk.y); fk_[4] = bflo(vk.z); fk_[5] = bfhi(vk.z); fk_[6] = bflo(vk.w); fk_[7] = bfhi(vk.w);
#pragma unroll
            for (int e = 0; e < 8; ++e) { const float b = bcs[r * 128 + c8 + e]; fq_[e] *= __expf(b) * 0.08838834764831845f; fk_[e] *= __expf(-b); }
            u32x4 o; o.x = pk2(fq_[0], fq_[1]); o.y = pk2(fq_[2], fq_[3]); o.z = pk2(fq_[4], fq_[5]); o.w = pk2(fq_[6], fq_[7]);
            *(LAS u32x4*)(Qs + r * LDB + c8) = o;
            o.x = pk2(fk_[0], fk_[1]); o.y = pk2(fk_[2], fk_[3]); o.z = pk2(fk_[4], fk_[5]); o.w = pk2(fk_[6], fk_[7]);
            *(LAS u32x4*)(Ks + r * LDB + c8) = o; }
        for (int i = tid; i < 64 * 32; i += NTHR) { const int r = i >> 5, c8 = (i & 31) * 8; *(LAS u32x4*)(Vs + r * LDV + c8) = *(const u32x4*)(WS_(p, QKVG) + (size_t)(t0 + r) * 3072 + 1024 + 256 * h + c8); }
        lds_barrier();
        { const int ib = w >> 1;
#pragma unroll
          for (int jj = 0; jj < 2; ++jj) { const int jb = 2 * (w & 1) + jj; f32x4 a = {0.f, 0.f, 0.f, 0.f};
#pragma unroll
              for (int ks = 0; ks < 4; ++ks) a = MFMA16(frag_rm(Qs, LDB, 16 * ib, 32 * ks, lane), frag_rm(Ks, LDB, 16 * jb, 32 * ks, lane), a);
#pragma unroll
              for (int r = 0; r < 4; ++r) { const int i = 16 * ib + 4 * fq + r, jx = 16 * jb + fr; At[i * LDX + jx] = (bf16_t)f2bf(jx <= i ? a[r] : 0.f); } } }
        lds_barrier();
        f32x4 o[4][2];
        const bf16_t* pv = WS_(p, PREV) + ((size_t)n * 4 + h) * 128 * 256;
#pragma unroll
        for (int vv = 0; vv < 2; ++vv) { const int vb = 2 * w + vv;
            bf16x8 bi[2], bp[4];
#pragma unroll
            for (int ks = 0; ks < 2; ++ks) bi[ks] = frag_tr(Vs, LDV, 32 * ks, 16 * vb, lane);
#pragma unroll
            for (int ks = 0; ks < 4; ++ks) bp[ks] = *(const bf16x8*)(pv + ((size_t)(vb * 4 + ks) * 64 + lane) * 8);
#pragma unroll
            for (int ib = 0; ib < 4; ++ib) { f32x4 a = {0.f, 0.f, 0.f, 0.f};
#pragma unroll
                for (int ks = 0; ks < 2; ++ks) a = MFMA16(frag_rm(At, LDX, 16 * ib, 32 * ks, lane), bi[ks], a);
#pragma unroll
                for (int ks = 0; ks < 4; ++ks) a = MFMA16(frag_rm(Qs, LDB, 16 * ib, 32 * ks, lane), bp[ks], a);
                o[ib][vv] = a; } }
#pragma unroll
        for (int ib = 0; ib < 4; ++ib)
#pragma unroll
            for (int r = 0; r < 4; ++r) { float s = o[ib][0][r] * o[ib][0][r] + o[ib][1][r] * o[ib][1][r]; s = sum16(s); if (fr == 0) red[w * 64 + 16 * ib + 4 * fq + r] = s; }
        lds_barrier();
        {   LAS bf16_t* Os = (LAS bf16_t*)bcs;
#pragma unroll
            for (int ib = 0; ib < 4; ++ib)
#pragma unroll
                for (int vv = 0; vv < 2; ++vv)
#pragma unroll
                    for (int r = 0; r < 4; ++r) Os[(16 * ib + 4 * fq + r) * LDV + 32 * w + 16 * vv + fr] = (bf16_t)f2bf(o[ib][vv][r]);
            lds_barrier();
            const int row = tid >> 3, c0 = (tid & 7) * 32; const int t = t0 + row; float s = 0.f;
#pragma unroll
            for (int ww = 0; ww < 8; ++ww) s += red[ww * 64 + row];
            const float rs = rsqrtf(s * (1.0f / 256.0f) + 1e-5f);
#pragma unroll
            for (int q = 0; q < 4; ++q) {
                const u32x4 ov = *(const LAS u32x4*)(Os + row * LDV + c0 + 8 * q), gv = *(const u32x4*)(WS_(p, QKVG) + (size_t)t * 3072 + 2048 + 256 * h + c0 + 8 * q);
                const f32x4 n0 = *(const f32x4*)(p.gl_norm_g + j * 256 + c0 + 8 * q), n1 = *(const f32x4*)(p.gl_norm_g + j * 256 + c0 + 8 * q + 4);
                float r8[8];
                r8[0] = bflo(ov.x) * rs * n0[0] * siluf_(bflo(gv.x)); r8[1] = bfhi(ov.x) * rs * n0[1] * siluf_(bfhi(gv.x)); r8[2] = bflo(ov.y) * rs * n0[2] * siluf_(bflo(gv.y)); r8[3] = bfhi(ov.y) * rs * n0[3] * siluf_(bfhi(gv.y));
                r8[4] = bflo(ov.z) * rs * n1[0] * siluf_(bflo(gv.z)); r8[5] = bfhi(ov.z) * rs * n1[1] * siluf_(bfhi(gv.z)); r8[6] = bflo(ov.w) * rs * n1[2] * siluf_(bflo(gv.w)); r8[7] = bfhi(ov.w) * rs * n1[3] * siluf_(bfhi(gv.w));
                u32x4 wv; wv.x = pk2(r8[0], r8[1]); wv.y = pk2(r8[2], r8[3]); wv.z = pk2(r8[4], r8[5]); wv.w = pk2(r8[6], r8[7]);
                *(u32x4*)(WS_(p, YB) + (size_t)t * D + 256 * h + c0 + 8 * q) = wv;
            }
        }
    }
}
#define XB_TMO      128
#define XB_XCNT(j)  (256  + 64 * (j))
#define XB_XSUB(j)  (1280 + 64 * (j))
#define XB_XGEN(j)  (2304 + 64 * (j))
#define XB_TOP      3328
#define XB_TOPGEN   3392
#define XCD_BAR_WORDS 3456
#define XB_SPIN_CAP (1u << 22)
DEV unsigned xb_ld(unsigned* p)              { return __hip_atomic_load(p, __ATOMIC_RELAXED, __HIP_MEMORY_SCOPE_AGENT); }
DEV unsigned xb_add(unsigned* p, unsigned v) { return __hip_atomic_fetch_add(p, v, __ATOMIC_RELAXED, __HIP_MEMORY_SCOPE_AGENT); }
DEV unsigned xb_xcc_id() { return (unsigned)__builtin_amdgcn_s_getreg((3 << 11) | 20) & 0xFu; }
#define XB_SPIN(cond, bar) do { unsigned _sp = 0; while (cond) { __builtin_amdgcn_s_sleep(1); \
    if ((++_sp & 255u) == 0u) { if (xb_ld(&(bar)[XB_TMO])) break; if (_sp > XB_SPIN_CAP) { atomicAdd(&(bar)[XB_TMO], 1u); break; } } } } while (0)
struct XcdBarrier { unsigned* bar; unsigned x; volatile LAS unsigned* st; };
DEV XcdBarrier xcd_barrier_post(unsigned* bar, volatile LAS unsigned* st) {
    XcdBarrier b; b.bar = bar; b.x = xb_xcc_id(); b.st = st;
    if (threadIdx.x == 0) (void)xb_add(&bar[XB_XCNT(b.x)], 1u);
    return b;
}
DEV void xcd_barrier_complete(unsigned* bar, unsigned x, unsigned& nloc, unsigned& nx) {
    const unsigned G = gridDim.x * gridDim.y * gridDim.z;
    unsigned sum, cnt, mine, sp = 0u;
    for (;;) {
        sum = 0u; cnt = 0u; mine = 0u;
#pragma unroll
        for (unsigned j = 0; j < 16; ++j) { const unsigned c = xb_ld(&bar[XB_XCNT(j)]); sum += c; cnt += (c > 0u) ? 1u : 0u; mine = (j == x) ? c : mine; }
        if (sum == G) break;
        __builtin_amdgcn_s_sleep(1);
        if ((++sp & 255u) == 0u) { if (xb_ld(&bar[XB_TMO])) break; if (sp > XB_SPIN_CAP) { atomicAdd(&bar[XB_TMO], 1u); break; } }
    }
    nloc = mine > 0u ? mine : 1u; nx = cnt > 0u ? cnt : 1u;
}
DEV void xcd_barrier(const XcdBarrier& b) {
    asm volatile("s_waitcnt vmcnt(0)" ::: "memory");
    __syncthreads();
    if (threadIdx.x == 0) {
        unsigned* bar = b.bar;
        __builtin_amdgcn_s_waitcnt(0);
        unsigned nloc = b.st[0], nx = b.st[1];
        if (nloc == 0u) { xcd_barrier_complete(bar, b.x, nloc, nx); b.st[0] = nloc; b.st[1] = nx; }
        const unsigned old = xb_add(&bar[XB_XSUB(b.x)], 1u);
        const unsigned gen = old / nloc;
        if (old + 1u == (gen + 1u) * nloc) {
            __builtin_amdgcn_fence(__ATOMIC_RELEASE, "agent");
            asm volatile("s_waitcnt vmcnt(0)" ::: "memory");
            const unsigned og = xb_add(&bar[XB_TOP], 1u);
            const unsigned tg = og / nx;
            if (og + 1u == (tg + 1u) * nx) xb_add(&bar[XB_TOPGEN], 1u);
            else XB_SPIN(xb_ld(&bar[XB_TOPGEN]) == tg, bar);
            __builtin_amdgcn_fence(__ATOMIC_ACQUIRE, "agent");
            xb_add(&bar[XB_XGEN(b.x)], 1u);
            asm volatile("s_waitcnt vmcnt(0)" ::: "memory");
        } else {
            XB_SPIN(xb_ld(&bar[XB_XGEN(b.x)]) == gen, bar);
            __builtin_amdgcn_fence(__ATOMIC_ACQUIRE, "agent");
            asm volatile("s_waitcnt vmcnt(0)" ::: "memory");
        }
    }
    __syncthreads();
}

DEV void moe_tail_convert(const Params& p, LAS unsigned char* lds, const LAS int* tab, int layer, int which) {
    if (layer != 1 && layer != 2) return;
    const int total = tab[33] * 4, rem = total % NB_;
    const int B0 = rem, NBW = NB_ - rem;
    if (bid_() >= B0) { const ConvJob J = moe_job(p, which, layer + 1); convert_one(J, lds, B0, NBW, 0); }
}
DEV LAS int* moe_tab_to_lds(const Params& p, LAS unsigned char* lds) {
    LAS int* tab = (LAS int*)(lds + pg8::STAGE_BYTES);
    const int tid = tid_();
    if (tid < 256) tab[tid] = __hip_atomic_load(WS_(p, TAB) + tid, __ATOMIC_RELAXED, __HIP_MEMORY_SCOPE_AGENT);
    __syncthreads();
    return tab;
}
DEV void run_phase(const Params& pin, int op, int arg, LAS unsigned char* lds) {
    Params p = pin; { size_t z_ = 0; asm volatile("" : "+s"(z_)); p.ws = pin.ws + z_; }
    const int layer = arg; const int jj = layer / 3;
#ifdef ONLY_OP
    if (op != ONLY_OP) return;
#endif
#ifdef OPMASK
    if (!((OPMASK >> op) & 1ull)) return;
#endif
    switch (op) {
    case OP_CONVERT: phase_pre0(p); phase_convert(p, lds);
#ifdef DBG
        if (blockIdx.x == 0 && threadIdx.x < 24) WS_(p, TAB)[200 + threadIdx.x] = 0;
#endif
        break;
    case OP_PRE0: break;
    case OP_RW_GEMM1: { SchedRW1 S{&p, jj}; EpiRW1 E{&p}; pg8::gemm_phase(lds, 1024, S, E); } break;
    case OP_RW_GEMM2: { SchedRW2 S{&p, jj}; EpiRW2 E{&p, jj}; pg8::gemm_phase(lds, 256, S, E); } break;
    case OP_RW_CHA: phase_rw_cha(p, jj, lds); break;
    case OP_RW_CHB: phase_rw_chb(p, layer, lds); break;
    case OP_RW_CHC: phase_rw_chc(p, jj, lds); break;
    case OP_RW_OUT: { SchedOut S{WS_(p, YB), WS_(p, rw_wo_t) + (size_t)jj * D * D, 1024}; EpiOut E{WS_(p, MIXb)}; pg8::gemm_phase(lds, 1024, S, E); } break;
    case OP_LN1: phase_ln1(p, layer, lds); break;
    case OP_MOE_SCATTER: phase_moe_scatter(p, lds); break;
    case OP_MOE_GEMM1: { LAS int* tab = moe_tab_to_lds(p, lds); SchedMoe<0> S{&p, layer, tab}; EpiMoe1 E{WS_(p, ACT)}; pg8::gemm_phase(lds, 1024, S, E); moe_tail_convert(p, lds, tab, layer, 0); } break;
    case OP_MOE_GEMM2: { LAS int* tab = moe_tab_to_lds(p, lds); SchedMoe<1> S{&p, layer, tab}; EpiMoe2 E{WS_(p, YBUF)}; pg8::gemm_phase(lds, 512, S, E); moe_tail_convert(p, lds, tab, layer, 1); } break;
    case OP_LN2: phase_ln2(p, layer, lds); break;
    case OP_MB_GEMM_IN: { SchedMbIn S{&p}; EpiMbIn E{&p}; pg8::gemm_phase(lds, 1024, S, E); } break;
    case OP_MB_CONV: phase_mb_conv(p, jj); break;
    case OP_MB_STATES: phase_mb_states(p, jj, lds); break;
    case OP_MB_SCAN: phase_mb_scan(p); break;
    case OP_MB_OUT: phase_mb_out(p, jj, lds); break;
    case OP_MB_GEMM_OUT: { SchedOut S{WS_(p, YB), WS_(p, mb_wout_t) + (size_t)jj * D * 2048, 2048}; EpiOut E{WS_(p, MIXb)}; pg8::gemm_phase(lds, 2048, S, E); } break;
    case OP_GL_GEMM_IN: { SchedGlIn S{&p}; EpiGlIn E{&p}; pg8::gemm_phase(lds, 1024, S, E); } break;
    case OP_GL_KV: phase_gl_kv(p, lds); break;
    case OP_GL_SCAN: phase_gl_scan(p); break;
    case OP_GL_OUT: phase_gl_out(p, jj, lds); break;
    case OP_GL_GEMM_OUT: { SchedOut S{WS_(p, YB), WS_(p, gl_wout_t) + (size_t)jj * D * D, 1024}; EpiOut E{WS_(p, MIXb)}; pg8::gemm_phase(lds, 1024, S, E); } break;
    default: break;
    }
}

constexpr int NPHASES = 1 + 11 + 11 + 10 + 11;
DEV void decode_phase(int ph, int& op, int& layer) {
    if (ph < 1) { op = OP_CONVERT; layer = 0; return; }
    int q = ph - 1; layer = 0;
    if (q >= 11) { q -= 11; layer = 1; if (q >= 11) { q -= 11; layer = 2; if (q >= 10) { q -= 10; layer = 3; } } }
    const int kind = layer % 3; const int nmix = kind == 2 ? 5 : 6;
    if (q < nmix) op = (kind == 0 ? OP_RW_GEMM1 : kind == 1 ? OP_MB_GEMM_IN : OP_GL_GEMM_IN) + q;
    else op = OP_LN1 + (q - nmix);
}

#define X(t, n) t n##_,
template <bool COOP>
__global__ void __launch_bounds__(NTHR, 2) mega(PARAM_LIST(X) const int ph0, const int ph1) {
#undef X
    Params p;
#define X(t, n) p.n = n##_;
    PARAM_LIST(X)
#undef X

    extern __shared__ __attribute__((aligned(16))) unsigned char smem_raw[];
    LAS unsigned char* lds = (LAS unsigned char*)smem_raw;
    if constexpr (COOP) {
        volatile LAS unsigned* st = (volatile LAS unsigned*)(lds + LDS_BYTES - 16);
        if (threadIdx.x == 0) { st[0] = 0u; st[1] = 0u; }
        __syncthreads();
        XcdBarrier xb = xcd_barrier_post(WS_(p, bar), st);
        if (ph0 < 0) cg::this_grid().sync();
        for (int ph = ph0; ph < ph1; ++ph) {
            int op, arg; decode_phase(ph, op, arg);
#ifdef REPEAT_MASK
            const int reps = 1 + (int)((REPEAT_MASK >> op) & 1ull);
#else
            const int reps = 1;
#endif
#pragma unroll 1
            for (int rep = 0; rep < reps; ++rep) {
                run_phase(p, op, arg, lds);
                if (ph + 1 < ph1 || rep + 1 < reps) { xcd_barrier(xb);
#ifdef BAR2
                    xcd_barrier(xb);
#endif
                }
            }
        }
#ifdef DBG
        xcd_barrier(xb);
#ifndef DBG_WORD
#define DBG_WORD 200
#endif
        { const int code = __hip_atomic_load(WS_(p, TAB) + DBG_WORD, __ATOMIC_RELAXED, __HIP_MEMORY_SCOPE_AGENT);
          for (size_t i = (size_t)blockIdx.x * NTHR + threadIdx.x; i < (size_t)T * D; i += (size_t)NB_ * NTHR) p.out[i] = 0.f;
          __syncthreads();
          if (blockIdx.x == 0 && threadIdx.x == 0) p.out[0] = sqrtf((float)DBG_DECODE(code) * 1.68e7f); }
#endif
    } else {
        for (int ph = ph0; ph < ph1; ++ph) { int op, arg; decode_phase(ph, op, arg); run_phase(p, op, arg, lds); }
    }
}


extern "C" void kernel_launch(void* const* d_in, const int* in_sizes, int n_in, void* d_out, int out_size, void* d_ws, size_t ws_size, hipStream_t stream) {
    (void)in_sizes; (void)n_in; (void)out_size;
    Params p; std::memset((void*)&p, 0, sizeof(p));
    auto F = [&](int i) { return (const float*)d_in[i]; };
    p.x = F(0); p.ln_g = F(1); p.ln_b = F(2);
    p.rw_mu = F(3); p.rw_w_rkv = F(4); p.rw_w0 = F(5); p.rw_w1 = F(6); p.rw_w2 = F(7); p.rw_a0 = F(8);
    p.rw_a1 = F(9); p.rw_a2 = F(10); p.rw_g1 = F(11); p.rw_g2 = F(12);
    p.rw_k_k = F(13); p.rw_k_a = F(14); p.rw_r_k = F(15); p.rw_lnx_g = F(16); p.rw_lnx_b = F(17); p.rw_w_o = F(18);
    p.mb_w_in = F(19); p.mb_conv_w = F(20); p.mb_conv_b = F(21); p.mb_dt_bias = F(22); p.mb_a_log = F(23); p.mb_d = F(24); p.mb_norm_g = F(25); p.mb_w_out = F(26);
    p.gl_w_in = F(27); p.gl_gk_w2 = F(28); p.gl_gk_b = F(29); p.gl_norm_g = F(30); p.gl_w_out = F(31);
    p.moe_w_group = F(32); p.moe_b_group = F(33); p.moe_w_route = F(34); p.moe_b_route = F(35); p.moe_w_in = F(36); p.moe_w_down = F(37);
    p.out = (float*)d_out;
    p.ws = (char*)d_ws;
    if (WS_TOTAL > ws_size) { fprintf(stderr, "workspace too small: need %zu have %zu\n", (size_t)WS_TOTAL, ws_size); return; }
    unsigned* bar_ptr = (unsigned*)(p.ws + OFF_bar);
    const int np = NPHASES;
#define X(t, n) (void*)&p.n,
#if SINGLE_LAUNCH
    (void)hipFuncSetAttribute((const void*)mega<true>, hipFuncAttributeMaxDynamicSharedMemorySize, LDS_BYTES);
    (void)hipMemsetAsync(bar_ptr, 0, XCD_BAR_WORDS * sizeof(unsigned), stream);
    int ph0 = 0, ph1 = np; void* args[] = {PARAM_LIST(X) (void*)&ph0, (void*)&ph1};
    hipError_t e = hipLaunchCooperativeKernel((const void*)mega<true>, dim3(NBLK), dim3(NTHR), args, LDS_BYTES, stream);
    if (e != hipSuccess) fprintf(stderr, "cooperative launch failed: %s\n", hipGetErrorString(e));
#else
    (void)hipFuncSetAttribute((const void*)mega<false>, hipFuncAttributeMaxDynamicSharedMemorySize, LDS_BYTES);
    for (int ph = 0; ph < np; ++ph) { int ph0 = ph, ph1 = ph + 1; void* args[] = {PARAM_LIST(X) (void*)&ph0, (void*)&ph1};
        hipError_t e = hipLaunchKernel((const void*)mega<false>, dim3(NBLK), dim3(NTHR), args, LDS_BYTES, stream);
        if (e != hipSuccess) fprintf(stderr, "launch failed: %s\n", hipGetErrorString(e)); }
#endif
#undef X
}
```

```cpp
#include <hip/hip_runtime.h>
#include <hip/hip_cooperative_groups.h>
#include <cstdint>
#include <cstdio>
#include <cstring>
namespace cg = cooperative_groups;

typedef unsigned short bf16_t;
typedef short bf16x8 __attribute__((ext_vector_type(8)));
typedef short s16x4 __attribute__((ext_vector_type(4)));
typedef float f32x4 __attribute__((ext_vector_type(4)));
typedef float f32x2 __attribute__((ext_vector_type(2)));
typedef unsigned u32x4 __attribute__((ext_vector_type(4)));
typedef unsigned u32x2 __attribute__((ext_vector_type(2)));
#define LAS __attribute__((address_space(3)))
#define DEV __device__ __forceinline__

constexpr int T = 16384, D = 1024, DEPTH = 4;
constexpr int NTHR = 512, NBLK = 256;
constexpr int LDS_BYTES = 155648;
constexpr float ALPHA = 1.681792830507429f;
constexpr float LN_EPS = 1e-5f;
constexpr int MOE_ROWS = 40960;

DEV int tid_() { int t = threadIdx.x; asm volatile("" : "+v"(t)); return t; }
DEV int bid_() { int b = blockIdx.x; asm volatile("" : "+s"(b)); return b; }
#define NB_ 256
#define RCOL(q, lane) ((((q) >> 1) * 512) + 8 * (lane) + 4 * ((q) & 1))
DEV void lds_barrier() { asm volatile("s_waitcnt lgkmcnt(0)" ::: "memory"); __builtin_amdgcn_s_barrier(); asm volatile("" ::: "memory"); }
DEV unsigned f2bf(float f) { unsigned u = __float_as_uint(f); u += 0x7FFFu + ((u >> 16) & 1u); return u >> 16; }
DEV float bf2f(unsigned short b) { return __uint_as_float(((unsigned)b) << 16); }
typedef __bf16 bf16n2 __attribute__((ext_vector_type(2)));
DEV unsigned pk2(float lo, float hi) { f32x2 v = {lo, hi}; bf16n2 b = __builtin_convertvector(v, bf16n2); return __builtin_bit_cast(unsigned, b); }
DEV float bflo(unsigned u) { return __uint_as_float(u << 16); }
DEV float bfhi(unsigned u) { return __uint_as_float(u & 0xFFFF0000u); }
DEV float sigmoidf_(float x) { return 1.0f / (1.0f + __expf(-x)); }
DEV float siluf_(float x) { return x / (1.0f + __expf(-x)); }
DEV float softplusf_(float x) { return fmaxf(x, 0.f) + __logf(1.0f + __expf(-fabsf(x))); }
DEV float tanhf_(float x) { const float e = __expf(-2.0f * fabsf(x)); const float r = (1.0f - e) / (1.0f + e); return x < 0.f ? -r : r; }
DEV float wave_sum(float v) {
#pragma unroll
    for (int o = 32; o > 0; o >>= 1) v += __shfl_xor(v, o);
    return v;
}
DEV float sum16(float v) {
#pragma unroll
    for (int o = 8; o > 0; o >>= 1) v += __shfl_xor(v, o);
    return v;
}
template <int N> DEV float reduce_scatter(float (&v)[N], int lane) {
    int s = 1;
#pragma unroll
    for (int h = N / 2; h >= 1; h >>= 1) {
#pragma unroll
        for (int i = 0; i < h; ++i) {
            const bool up = (lane & s) != 0;
            const float send = up ? v[i] : v[i + h];
            const float keep = up ? v[i + h] : v[i];
            v[i] = keep + __shfl_xor(send, s);
        }
        s <<= 1;
    }
    float r = v[0];
    for (; s < 64; s <<= 1) r += __shfl_xor(r, s);
    return r;
}
template <int N> DEV int rs_index(int lane) {
    int o = 0, s = 1;
#pragma unroll
    for (int h = N / 2; h >= 1; h >>= 1) { if (lane & s) o += h; s <<= 1; }
    return o;
}

DEV bf16x8 frag_rm(const LAS bf16_t* base, int ld, int row0, int k0, int lane) {
    return *(const LAS bf16x8*)(base + (row0 + (lane & 15)) * ld + k0 + 8 * (lane >> 4));
}
DEV bf16x8 frag_tr(const LAS bf16_t* base, int ld, int k0, int c0, int lane) {
    const int g = lane >> 4, i = lane & 15, q = i >> 2, p = i & 3;
    const LAS bf16_t* a = base + (k0 + 8 * g + q) * ld + c0 + 4 * p;
    s16x4 lo = __builtin_amdgcn_ds_read_tr16_b64_v4i16((LAS s16x4*)a);
    s16x4 hi = __builtin_amdgcn_ds_read_tr16_b64_v4i16((LAS s16x4*)(a + 4 * ld));
    bf16x8 r; r[0] = lo[0]; r[1] = lo[1]; r[2] = lo[2]; r[3] = lo[3]; r[4] = hi[0]; r[5] = hi[1]; r[6] = hi[2]; r[7] = hi[3];
    return r;
}
#define MFMA16(a, b, c) __builtin_amdgcn_mfma_f32_16x16x32_bf16((a), (b), (c), 0, 0, 0)
DEV size_t fragmajor_off(int n, int k, int K) { return ((size_t)((n >> 4) * (K >> 5) + (k >> 5)) * 64 + (n & 15) + 16 * ((k & 31) >> 3)) * 8 + (k & 7); }

template <int N> DEV void skinny_group(const f32x4 (&z)[4], const LAS float* wt, int lane, LAS float* outw) {
    float pe[N];
#pragma unroll
    for (int o = 0; o < N; ++o) {
        float a = 0.f;
#pragma unroll
        for (int q = 0; q < 4; ++q) { const f32x4 w = *(const LAS f32x4*)(wt + o * 1028 + RCOL(q, lane)); a += z[q][0] * w[0] + z[q][1] * w[1] + z[q][2] * w[2] + z[q][3] * w[3]; }
        pe[o] = a;
    }
    const float r = reduce_scatter<N>(pe, lane);
    if (lane < N) outw[rs_index<N>(lane)] = r;
}
#ifndef SINGLE_LAUNCH
#define SINGLE_LAUNCH 1
#endif
constexpr size_t OFF_bar = 0ull;
constexpr size_t OFF_rw_rkv_t = 13824ull;
constexpr size_t OFF_rw_w1_t = 12596736ull;
constexpr size_t OFF_rw_a1_t = 13645312ull;
constexpr size_t OFF_rw_g1_t = 14693888ull;
constexpr size_t OFF_rw_w2_t = 15742464ull;
constexpr size_t OFF_rw_a2_t = 16791040ull;
constexpr size_t OFF_rw_g2_t = 17839616ull;
constexpr size_t OFF_rw_wo_t = 18888192ull;
constexpr size_t OFF_mb_win_t = 23082496ull;
constexpr size_t OFF_mb_wout_t = 33568256ull;
constexpr size_t OFF_gl_win_t = 37762560ull;
constexpr size_t OFF_gl_wout_t = 44054016ull;
constexpr size_t OFF_moe_w1_t = 46151168ull;
constexpr size_t OFF_moe_w2_t = 314586624ull;
constexpr size_t OFF_H = 448804352ull;
constexpr size_t OFF_H1 = 515913216ull;
constexpr size_t OFF_MIX = 583022080ull;
constexpr size_t OFF_BUF = 650130944ull;
constexpr size_t OFF_ACT = 734017024ull;
constexpr size_t OFF_YBUF = 775960064ull;
constexpr size_t OFF_CNT = 859846144ull;
constexpr size_t OFF_EIDX = 859878912ull;
constexpr size_t OFF_GATE = 860009984ull;
constexpr size_t OFF_DEST = 860141056ull;
constexpr size_t OFF_TAB = 860272128ull;
constexpr size_t OFF_YB = 860273152ull;
constexpr size_t OFF_X6 = 927382016ull;
constexpr size_t OFF_Rr = 1128708608ull;
constexpr size_t OFF_Kk = 1195817472ull;
constexpr size_t OFF_Vv = 1262926336ull;
constexpr size_t OFF_LW = 1330035200ull;
constexpr size_t OFF_Wd = 1355201024ull;
constexpr size_t OFF_Aa = 1422309888ull;
constexpr size_t OFF_Gg = 1489418752ull;
constexpr size_t OFF_RWf = 1556527616ull;
constexpr size_t OFF_RBf = 1590082048ull;
constexpr size_t OFF_RUt = 1623636480ull;
constexpr size_t OFF_RNa = 1657190912ull;
constexpr size_t OFF_RGc = 1690745344ull;
constexpr size_t OFF_RUa = 1691793920ull;
constexpr size_t OFF_RS0 = 1725348352ull;
constexpr size_t OFF_Z = 960936448ull;
constexpr size_t OFF_XBC = 1028045312ull;
constexpr size_t OFF_XC = 1128708608ull;
constexpr size_t OFF_DT = 1229371904ull;
constexpr size_t OFF_STATES = 1231469056ull;
constexpr size_t OFF_CD = 1365686784ull;
constexpr size_t OFF_PREV = 1365703168ull;
constexpr size_t OFF_LA = 1432812032ull;
constexpr size_t OFF_CDG = 1466366464ull;
constexpr size_t OFF_QKVG = OFF_XBC;
constexpr size_t WS_TOTAL = 1758902784ull;
typedef unsigned T_bar;
typedef bf16_t T_rw_rkv_t;
typedef bf16_t T_rw_w1_t;
typedef bf16_t T_rw_a1_t;
typedef bf16_t T_rw_g1_t;
typedef bf16_t T_rw_w2_t;
typedef bf16_t T_rw_a2_t;
typedef bf16_t T_rw_g2_t;
typedef bf16_t T_rw_wo_t;
typedef bf16_t T_mb_win_t;
typedef bf16_t T_mb_wout_t;
typedef bf16_t T_gl_win_t;
typedef bf16_t T_gl_wout_t;
typedef bf16_t T_moe_w1_t;
typedef bf16_t T_moe_w2_t;
typedef float T_H;
typedef float T_H1;
typedef float T_MIX;
typedef bf16_t T_BUF;
typedef bf16_t T_ACT;
typedef bf16_t T_YBUF;
typedef int T_CNT;
typedef int T_EIDX;
typedef float T_GATE;
typedef int T_DEST;
typedef int T_TAB;
typedef bf16_t T_YB;
typedef bf16_t T_X6;
typedef float T_Rr;
typedef float T_Kk;
typedef float T_Vv;
typedef bf16_t T_LW;
typedef float T_Wd;
typedef float T_Aa;
typedef float T_Gg;
typedef bf16_t T_RWf;
typedef bf16_t T_RBf;
typedef bf16_t T_RUt;
typedef bf16_t T_RNa;
typedef float T_RGc;
typedef bf16_t T_RUa;
typedef bf16_t T_RS0;
typedef bf16_t T_Z;
typedef bf16_t T_XBC;
typedef bf16_t T_XC;
typedef float T_DT;
typedef bf16_t T_STATES;
typedef float T_CD;
typedef bf16_t T_PREV;
typedef float T_LA;
typedef float T_CDG;
typedef bf16_t T_QKVG;
#define WS_(P, N) ((T_##N*)((P).ws + OFF_##N))
constexpr size_t OFF_Hb = OFF_H, OFF_H1b = OFF_H1, OFF_MIXb = OFF_MIX;
typedef bf16_t T_Hb; typedef bf16_t T_H1b; typedef bf16_t T_MIXb;
constexpr size_t OFF_moe_wr_t = OFF_H + 33554432ull;
typedef bf16_t T_moe_wr_t;
constexpr size_t OFF_mb_dt_t = OFF_moe_wr_t + 4ull * 48 * 1024 * 2, OFF_gl_lr_t = OFF_mb_dt_t + 32ull * 1024 * 2;
typedef bf16_t T_mb_dt_t; typedef bf16_t T_gl_lr_t;
constexpr size_t OFF_Rb = OFF_Rr, OFF_Kb = OFF_Kk, OFF_Vb = OFF_Vv, OFF_Ab = OFF_Aa, OFF_Gb = OFF_Gg;
typedef bf16_t T_Rb; typedef bf16_t T_Kb; typedef bf16_t T_Vb; typedef bf16_t T_Ab; typedef bf16_t T_Gb;
constexpr size_t OFF_Wb = OFF_Wd; typedef bf16_t T_Wb;
struct ConvJob {
    const float* src; bf16_t* dst;
    int K, N, src_ld, Kpad, Npad, perm, batch;
    long long src_bs, dst_bs;
    DEV int ntiles() const { return (Kpad / 64) * (Npad / 64) * batch; }
};
constexpr int NJOBS = 16;
constexpr int MOE_SPLIT = 32;

#define PARAM_LIST(X) \
    X(const float*, x) X(const float*, ln_g) X(const float*, ln_b) \
    X(const float*, rw_mu) X(const float*, rw_w_rkv) X(const float*, rw_w0) X(const float*, rw_w1) X(const float*, rw_w2) X(const float*, rw_a0) X(const float*, rw_a1) X(const float*, rw_a2) \
    X(const float*, rw_g1) X(const float*, rw_g2) X(const float*, rw_k_k) X(const float*, rw_k_a) X(const float*, rw_r_k) X(const float*, rw_lnx_g) X(const float*, rw_lnx_b) X(const float*, rw_w_o) \
    X(const float*, mb_w_in) X(const float*, mb_conv_w) X(const float*, mb_conv_b) X(const float*, mb_dt_bias) X(const float*, mb_a_log) X(const float*, mb_d) X(const float*, mb_norm_g) X(const float*, mb_w_out) \
    X(const float*, gl_w_in) X(const float*, gl_gk_w2) X(const float*, gl_gk_b) X(const float*, gl_norm_g) X(const float*, gl_w_out) \
    X(const float*, moe_w_group) X(const float*, moe_b_group) X(const float*, moe_w_route) X(const float*, moe_b_route) X(const float*, moe_w_in) X(const float*, moe_w_down) \
    X(float*, out) X(char*, ws)
struct Params {
#define X(t, n) t n;
    PARAM_LIST(X)
#undef X
};

enum Op : unsigned char { OP_CONVERT = 0, OP_PRE0, OP_RW_GEMM1, OP_RW_GEMM2, OP_RW_CHA, OP_RW_CHB, OP_RW_CHC, OP_RW_OUT,
    OP_LN1, OP_MOE_SCATTER, OP_MOE_GEMM1, OP_MOE_GEMM2, OP_LN2,
    OP_MB_GEMM_IN, OP_MB_CONV, OP_MB_STATES, OP_MB_SCAN, OP_MB_OUT, OP_MB_GEMM_OUT,
    OP_GL_GEMM_IN, OP_GL_KV, OP_GL_SCAN, OP_GL_OUT, OP_GL_GEMM_OUT };


DEV ConvJob make_job(const Params& p, int q) {
    const long long DD = (long long)D * D;
    switch (q) {
    case 0: return ConvJob{p.rw_w_rkv, WS_(p, rw_rkv_t), 1024, 1024, 1024, 1024, 1024, 0, 6, DD, DD};
    case 1: return ConvJob{p.rw_w1, WS_(p, rw_w1_t), 1024, 64, 64, 1024, 256, 0, 2, (long long)D * 64, (long long)256 * D};
    case 2: return ConvJob{p.rw_a1, WS_(p, rw_a1_t), 1024, 64, 64, 1024, 256, 0, 2, (long long)D * 64, (long long)256 * D};
    case 3: return ConvJob{p.rw_g1, WS_(p, rw_g1_t), 1024, 160, 160, 1024, 256, 0, 2, (long long)D * 160, (long long)256 * D};
    case 4: return ConvJob{p.rw_w2, WS_(p, rw_w2_t), 64, 1024, 1024, 256, 1024, 0, 2, (long long)64 * D, (long long)D * 256};
    case 5: return ConvJob{p.rw_a2, WS_(p, rw_a2_t), 64, 1024, 1024, 256, 1024, 0, 2, (long long)64 * D, (long long)D * 256};
    case 6: return ConvJob{p.rw_g2, WS_(p, rw_g2_t), 160, 1024, 1024, 256, 1024, 0, 2, (long long)160 * D, (long long)D * 256};
    case 7: return ConvJob{p.rw_w_o, WS_(p, rw_wo_t), 1024, 1024, 1024, 1024, 1024, 0, 2, DD, DD};
    case 8: return ConvJob{p.mb_w_in, WS_(p, mb_win_t), 1024, 5120, 5152, 1024, 5120, 0, 1, 0, 0};
    case 9: return ConvJob{p.mb_w_out, WS_(p, mb_wout_t), 2048, 1024, 1024, 2048, 1024, 0, 1, 0, 0};
    case 10: return ConvJob{p.gl_w_in, WS_(p, gl_win_t), 1024, 3072, 3088, 1024, 3072, 0, 1, 0, 0};
    case 11: return ConvJob{p.gl_w_out, WS_(p, gl_wout_t), 1024, 1024, 1024, 1024, 1024, 0, 1, 0, 0};
    case 12: return ConvJob{p.moe_w_in, WS_(p, moe_w1_t), 1024, 1024, 1024, 1024, 1024, 1, MOE_SPLIT, DD, DD};
    case 13: return ConvJob{p.moe_w_down, WS_(p, moe_w2_t), 512, 1024, 1024, 512, 1024, 0, MOE_SPLIT, (long long)512 * 1024, (long long)1024 * 512};
    case 14: return ConvJob{p.moe_w_in + (size_t)MOE_SPLIT * DD, WS_(p, moe_w1_t) + (size_t)MOE_SPLIT * DD, 1024, 1024, 1024, 1024, 1024, 1, 128 - MOE_SPLIT, DD, DD};
    default: return ConvJob{p.moe_w_down + (size_t)MOE_SPLIT * 512 * 1024, WS_(p, moe_w2_t) + (size_t)MOE_SPLIT * 512 * 1024, 512, 1024, 1024, 512, 1024, 0, 128 - MOE_SPLIT, (long long)512 * 1024, (long long)1024 * 512};
    }
}

DEV void convert_one(const ConvJob& J, LAS unsigned char* lds, int B0, int NBW, int tbeg) {
    const int tid = tid_(), bid = bid_();
    const int lane = tid & 63, wv = tid >> 6; const int gw = (bid - B0) * 8 + wv, NW = NBW * 8;
    LAS bf16_t* tile = (LAS bf16_t*)lds + wv * (64 * 72);
    const int jend = tbeg + J.ntiles();
    const int ti0 = tbeg + ((gw - tbeg) % NW + NW) % NW;
#pragma unroll 1
    for (int ti = ti0; ti < jend; ti += NW) {
        int local = ti - tbeg;
        const int tk = J.Kpad / 64, tn = J.Npad / 64;
        const int b = local / (tk * tn); local -= b * tk * tn;
        const int nt = local / tk, kt = local - nt * tk;
        const float* src = J.src + (size_t)b * J.src_bs;
        bf16_t* dst = J.dst + (size_t)b * J.dst_bs;
        const int k0 = kt * 64, n0 = nt * 64;
        const int nn = (lane & 15) * 4; const bool nok = n0 + nn < J.N;
        f32x4 v[16];
#pragma unroll
        for (int i = 0; i < 16; ++i) { const int kk = (lane >> 4) + 4 * i; v[i] = (nok && k0 + kk < J.K) ? *(const f32x4*)(src + (size_t)(k0 + kk) * J.src_ld + n0 + nn) : (f32x4){0.f, 0.f, 0.f, 0.f}; }
#pragma unroll
        for (int i = 0; i < 16; ++i) { const int kk = (lane >> 4) + 4 * i;
#pragma unroll
            for (int e = 0; e < 4; ++e) tile[(nn + e) * 72 + kk] = (bf16_t)f2bf(v[i][e]); }
#pragma unroll
        for (int i = 0; i < 8; ++i) { const int r = (lane >> 3) + 8 * i, kc = (lane & 7) * 8;
            int nsrc = n0 + r, ndst = nsrc;
            if (J.perm == 1) { const int up = nsrc >= 512, jj = nsrc - (up ? 512 : 0); ndst = (jj >> 7) * 256 + (up ? 128 : 0) + (jj & 127); }
            *(u32x4*)(dst + (size_t)ndst * J.Kpad + k0 + kc) = *(const LAS u32x4*)(tile + r * 72 + kc); }
    }
}
template <int J0, int J1> DEV int convert_jobs(const Params& p, LAS unsigned char* lds, int B0, int NBW, int tbeg = 0) {
#pragma unroll
    for (int j = J0; j < J1; ++j) { const ConvJob J = make_job(p, j); convert_one(J, lds, B0, NBW, tbeg); tbeg += J.ntiles(); }
    return tbeg;
}
DEV ConvJob moe_job(const Params& p, int which, int ml) {
    const long long DD = (long long)D * D; const size_t b0 = (size_t)ml * 32;
    if (which == 0) return ConvJob{p.moe_w_in + b0 * DD, WS_(p, moe_w1_t) + b0 * DD, 1024, 1024, 1024, 1024, 1024, 1, 32, DD, DD};
    return ConvJob{p.moe_w_down + b0 * 512 * 1024, WS_(p, moe_w2_t) + b0 * 512 * 1024, 512, 1024, 1024, 512, 1024, 0, 32, (long long)512 * 1024, (long long)1024 * 512};
}
DEV void phase_convert(const Params& p, LAS unsigned char* lds) {
    const int tid = tid_(), bid = bid_();
    convert_jobs<0, 8>(p, lds, 0, NB_);
    if (bid < 4 * 48) { const int layer = bid / 48, o = bid % 48;
        for (int k = tid; k < D; k += NTHR) { float v = 0.f;
            if (o < 32) v = p.moe_w_route[((size_t)layer * D + k) * 32 + o]; else if (o < 36) v = p.moe_w_group[((size_t)layer * D + k) * 4 + (o - 32)];
            WS_(p, moe_wr_t)[((size_t)layer * 48 + o) * D + k] = (bf16_t)f2bf(v); } }
    else if (bid < 4 * 48 + 32) { const int o = bid - 192;
        for (int k = tid; k < D; k += NTHR) WS_(p, mb_dt_t)[(size_t)o * D + k] = (bf16_t)f2bf(p.mb_w_in[(size_t)k * 5152 + 5120 + o]); }
    else if (bid < 4 * 48 + 48) { const int o = bid - 224;
        for (int k = tid; k < D; k += NTHR) WS_(p, gl_lr_t)[(size_t)o * D + k] = (bf16_t)f2bf(p.gl_w_in[(size_t)k * 3088 + 3072 + o]); }
}
namespace pg8 {
constexpr int BM = 256, BK = 64, HALF = 128, HTB = HALF * BK * 2, STAGE_BYTES = 8 * HTB;
DEV int lds_byte(int r, int c) { const int st = (r >> 4) * 2 + (c >> 5), rr = r & 15, cc = c & 31, ob = rr * 64 + cc * 2; return st * 1024 + (ob ^ (((ob >> 9) & 1) << 5)); }
DEV void stage_rc(int b, int& R, int& C) { const int st = b / 1024, sb = b % 1024, swz = sb ^ (((sb >> 9) & 1) << 5); R = (st >> 1) * 16 + swz / 64; C = (st & 1) * 32 + (swz % 64) / 2; }

struct Unit { const char* A; const char* B; int row0, col0, id, aux; };

DEV bool tile_order(int i, int G, int c, int nM, int nN, int& pm, int& pn) {
    const int nwg = nM * nN; const long L = (long)i * G + c; if (L >= nwg) return false;
    int wgid = (int)L; { const int q = nwg / 8, r = nwg % 8, xcd = wgid % 8, off = wgid / 8; wgid = (xcd < r ? xcd * (q + 1) : r * (q + 1) + (xcd - r) * q) + off; }
    const int nig = 8 * nN, gid = wgid / nig, fm = gid * 8, gsz = (nM - fm) < 8 ? (nM - fm) : 8;
    pm = fm + ((wgid % nig) % gsz); pn = (wgid % nig) / gsz; return true;
}

template <class Epi, class Sched>
DEV void gemm_phase(LAS unsigned char* lds, const int K, const Sched& S, const Epi& E) {
    const int tid = tid_(), wid = __builtin_amdgcn_readfirstlane(tid >> 6), lane = tid & 63, wr = wid >> 2, wc = wid & 3, fr = lane & 15, fq = lane >> 4;
    const int nt = K / BK;
    unsigned voff[2];
#pragma unroll
    for (int i = 0; i < 2; ++i) { int R, C; stage_rc(tid * 16 + i * 8192, R, C); voff[i] = (unsigned)(R * K + C) * 2u; }
    const size_t kstep = (size_t)(BK * 2);
    const size_t hstep = (size_t)HALF * K * 2;
    const unsigned ldsw = (unsigned)wid * 1024u;
    const int aoff = lds_byte(wr * 64 + fr, fq * 8), boff = lds_byte(wc * 32 + fr, fq * 8);
#define PG8_SA(b, h) (((b) * 2 + (h)) * HTB)
#define PG8_SB(b, h) ((4 + (b) * 2 + (h)) * HTB)
#define PG8_STAGE(bufoff, gbase) do { _Pragma("unroll") for (int _i = 0; _i < 2; ++_i) \
        __builtin_amdgcn_global_load_lds((const unsigned*)((const char*)(gbase) + voff[_i]), (LAS unsigned*)(lds + (bufoff) + ldsw + _i * 8192), 16, 0, 0); } while (0)
#define PG8_LDA(dst, b, h) do { _Pragma("unroll") for (int m = 0; m < 4; ++m) _Pragma("unroll") for (int k = 0; k < 2; ++k) dst[m][k] = *(const LAS bf16x8*)(lds + PG8_SA(b, h) + aoff + m * 2048 + k * 1024); } while (0)
#define PG8_LDB(dst, b, h) do { _Pragma("unroll") for (int n = 0; n < 2; ++n) _Pragma("unroll") for (int k = 0; k < 2; ++k) dst[n][k] = *(const LAS bf16x8*)(lds + PG8_SB(b, h) + boff + n * 2048 + k * 1024); } while (0)
#define PG8_MMA(ai, bj, At, Bt) do { __builtin_amdgcn_s_setprio(1); _Pragma("unroll") for (int m = 0; m < 4; ++m) _Pragma("unroll") for (int n = 0; n < 2; ++n) _Pragma("unroll") for (int k = 0; k < 2; ++k) \
        acc[ai][bj][m][n] = __builtin_amdgcn_mfma_f32_16x16x32_bf16(Bt[n][k], At[m][k], acc[ai][bj][m][n], 0, 0, 0); __builtin_amdgcn_s_setprio(0); } while (0)
#define PG8_WAIT_V(n) asm volatile("s_waitcnt vmcnt(" #n ")" ::: "memory")
#define PG8_WAIT_L(n) asm volatile("s_waitcnt lgkmcnt(" #n ")" ::: "memory")
#define PG8_BAR __builtin_amdgcn_s_barrier()
#define PG8_SCHED __builtin_amdgcn_sched_barrier(0)
    Unit cur, nxt; int ui = 0;
    if (!S.next(0, cur)) return;
    f32x4 acc[2][2][4][2];
#pragma unroll
    for (int a = 0; a < 2; ++a)
#pragma unroll
        for (int b = 0; b < 2; ++b)
#pragma unroll
            for (int m = 0; m < 4; ++m)
#pragma unroll
                for (int n = 0; n < 2; ++n) acc[a][b][m][n] = (f32x4){0.f, 0.f, 0.f, 0.f};
    bf16x8 At[4][2], B0[2][2], B1[2][2];
    const char* cA = cur.A; const char* cB = cur.B;
    PG8_STAGE(PG8_SB(0, 0), cB); PG8_STAGE(PG8_SA(0, 0), cA); PG8_STAGE(PG8_SB(0, 1), cB + hstep); PG8_STAGE(PG8_SA(0, 1), cA + hstep);
    if (wr == 1) PG8_BAR;
    PG8_WAIT_V(4); PG8_BAR;
    PG8_STAGE(PG8_SB(1, 0), cB + kstep); PG8_STAGE(PG8_SA(1, 0), cA + kstep); PG8_STAGE(PG8_SB(1, 1), cB + hstep + kstep);
    PG8_WAIT_V(6); PG8_BAR;
    for (;;) {
        const bool has_next = S.next(ui + 1, nxt);
        const char* nA = has_next ? nxt.A : cA; const char* nB = has_next ? nxt.B : cB;
#pragma unroll 1
        for (int t = 0; t < nt; t += 2) {
            const bool last = (t == nt - 2);
            const char* a1 = cA + (size_t)(t + 1) * kstep;
            const char* a2 = last ? nA : cA + (size_t)(t + 2) * kstep; const char* b2 = last ? nB : cB + (size_t)(t + 2) * kstep;
            const char* a3 = a2 + kstep; const char* b3 = b2 + kstep;
            PG8_LDB(B0, 0, 0); PG8_SCHED; PG8_LDA(At, 0, 0); PG8_STAGE(PG8_SA(1, 1), a1 + hstep);
            PG8_WAIT_L(8); PG8_BAR; PG8_WAIT_L(0); PG8_MMA(0, 0, At, B0); PG8_BAR; PG8_SCHED;
            PG8_LDB(B1, 0, 1); PG8_STAGE(PG8_SB(0, 0), b2);
            PG8_BAR; PG8_WAIT_L(0); PG8_MMA(0, 1, At, B1); PG8_BAR;
            PG8_LDA(At, 0, 1); PG8_STAGE(PG8_SA(0, 0), a2);
            PG8_BAR; PG8_WAIT_L(0); PG8_MMA(1, 0, At, B0); PG8_BAR; PG8_SCHED;
            PG8_STAGE(PG8_SB(0, 1), b2 + hstep);
            PG8_WAIT_V(6); PG8_BAR; PG8_MMA(1, 1, At, B1); PG8_BAR;
            PG8_LDB(B0, 1, 0); PG8_SCHED; PG8_LDA(At, 1, 0); PG8_STAGE(PG8_SA(0, 1), a2 + hstep);
            PG8_WAIT_L(8); PG8_BAR; PG8_WAIT_L(0); PG8_MMA(0, 0, At, B0); PG8_BAR; PG8_SCHED;
            PG8_LDB(B1, 1, 1); PG8_STAGE(PG8_SB(1, 0), b3);
            PG8_BAR; PG8_WAIT_L(0); PG8_MMA(0, 1, At, B1); PG8_BAR;
            PG8_LDA(At, 1, 1); PG8_STAGE(PG8_SA(1, 0), a3);
            PG8_BAR; PG8_WAIT_L(0); PG8_MMA(1, 0, At, B0); PG8_BAR; PG8_SCHED;
            PG8_STAGE(PG8_SB(1, 1), b3 + hstep);
            PG8_WAIT_V(6); PG8_BAR; PG8_MMA(1, 1, At, B1); PG8_BAR;
        }
        E(acc, cur, wr, wc, fr, fq);
        if (!has_next) break;
#pragma unroll
        for (int a = 0; a < 2; ++a)
#pragma unroll
            for (int b = 0; b < 2; ++b)
#pragma unroll
                for (int m = 0; m < 4; ++m)
#pragma unroll
                    for (int n = 0; n < 2; ++n) acc[a][b][m][n] = (f32x4){0.f, 0.f, 0.f, 0.f};
        cur = nxt; cA = nA; cB = nB; ++ui;
    }
    PG8_WAIT_V(0);
    if (wr == 0) PG8_BAR;
    PG8_BAR;
#undef PG8_SA
#undef PG8_SB
#undef PG8_STAGE
#undef PG8_LDA
#undef PG8_LDB
#undef PG8_MMA
#undef PG8_WAIT_V
#undef PG8_WAIT_L
#undef PG8_BAR
#undef PG8_SCHED
}
}
using pg8::Unit;
typedef f32x4 AccT[2][2][4][2];
#define FOR_ACC(ai, bj, m, n) _Pragma("unroll") for (int ai = 0; ai < 2; ++ai) _Pragma("unroll") for (int m = 0; m < 4; ++m) _Pragma("unroll") for (int bj = 0; bj < 2; ++bj) _Pragma("unroll") for (int n = 0; n < 2; ++n)
#define ACC_FENCE __builtin_amdgcn_sched_barrier(0)
#define ACC_ROW(u, ai, m) ((u).row0 + 128 * (ai) + 64 * wr + 16 * (m) + fr)
#define ACC_COL(u, bj, n) ((u).col0 + 128 * (bj) + 32 * wc + 16 * (n) + 4 * fq)
DEV void st_bf4(bf16_t* p, f32x4 v) { u32x2 w; w.x = pk2(v[0], v[1]); w.y = pk2(v[2], v[3]); *(u32x2*)p = w; }
DEV void load_row(const float* p, int lane, f32x4 (&v)[4]) {
#pragma unroll
    for (int q = 0; q < 4; ++q) v[q] = *(const f32x4*)(p + RCOL(q, lane));
}

DEV void load_row_bf(const bf16_t* p, int lane, f32x4 (&v)[4]) {
#pragma unroll
    for (int q = 0; q < 4; ++q) { const u32x2 a = *(const u32x2*)(p + RCOL(q, lane)); v[q] = (f32x4){bflo(a.x), bfhi(a.x), bflo(a.y), bfhi(a.y)}; }
}
DEV void store_row_bf(bf16_t* p, int lane, const f32x4 (&v)[4]) {
#pragma unroll
    for (int q = 0; q < 4; ++q) st_bf4(p + RCOL(q, lane), v[q]);
}
DEV void emit_mix6(const Params& p, int j, int t, int lane, const f32x4 (&x)[4], const f32x4 (&xp)[4]) {
    const float* mu = p.rw_mu + (size_t)j * 6 * D;
#pragma unroll
    for (int s = 0; s < 6; ++s) {
#pragma unroll
        for (int q = 0; q < 4; ++q) {
            const f32x4 m = *(const f32x4*)(mu + s * D + RCOL(q, lane));
            st_bf4(WS_(p, X6) + (size_t)s * T * D + (size_t)t * D + RCOL(q, lane), x[q] + (xp[q] - x[q]) * m);
        }
        __builtin_amdgcn_sched_barrier(0);
    }
}
DEV void phase_pre0(const Params& p) {
    const int tid = tid_(), bid = bid_(); const int lane = tid & 63, wid = tid >> 6;
    f32x4 x[4], xp[4];
    const int tfirst = bid * 64 + wid * 8;
    if (tfirst > 0) load_row(p.x + (size_t)(tfirst - 1) * D, lane, xp); else { for (int q = 0; q < 4; ++q) xp[q] = (f32x4){0.f, 0.f, 0.f, 0.f}; }
    f32x4 xn[4]; load_row(p.x + (size_t)tfirst * D, lane, xn);
#pragma unroll 1
    for (int r = 0; r < 8; ++r) {
        const int t = tfirst + r;
#pragma unroll
        for (int q = 0; q < 4; ++q) x[q] = xn[q];
        load_row(p.x + (size_t)(r < 7 ? t + 1 : t) * D, lane, xn);
        store_row_bf(WS_(p, Hb) + (size_t)t * D, lane, x);
        emit_mix6(p, 0, t, lane, x, xp);
#pragma unroll
        for (int q = 0; q < 4; ++q) xp[q] = x[q];
    }
}

struct SchedRW1 {
    const Params* p; int j;
    DEV bool next(int i, Unit& u) const {
        int pm, pn; if (!pg8::tile_order(i, NB_, bid_(), 64, 15, pm, pn)) return false;
        int id, lpn; if (pn < 12) { id = pn >> 2; lpn = pn & 3; } else { id = 3 + (pn - 12); lpn = 0; }
        u.A = (const char*)(WS_(*p, X6) + (size_t)id * T * D + (size_t)pm * 256 * D);
        const bf16_t* B;
        if (id < 3) B = WS_(*p, rw_rkv_t) + ((size_t)j * 3 + id) * D * D + (size_t)lpn * 256 * D;
        else B = WS_(*p, rw_w1_t) + (size_t)(id - 3) * (2 * 256 * D) + (size_t)j * 256 * D;
        u.B = (const char*)B; u.row0 = pm * 256; u.col0 = lpn * 256; u.id = id; u.aux = 0; return true;
    }
};
struct EpiRW1 {
    const Params* p;
    DEV void operator()(const AccT& acc, const Unit& u, int wr, int wc, int fr, int fq) const {
        if (u.id < 3) {
            bf16_t* O = WS_(*p, Rb) + (size_t)u.id * 2 * T * D;
            FOR_ACC(ai, bj, m, n) { st_bf4(O + (size_t)ACC_ROW(u, ai, m) * D + ACC_COL(u, bj, n), acc[ai][bj][m][n]); ACC_FENCE; }
        } else {
            bf16_t* O = WS_(*p, LW) + (size_t)(u.id - 3) * T * 256;
            FOR_ACC(ai, bj, m, n) {
                f32x4 v = acc[ai][bj][m][n];
                if (u.id == 3) { for (int e = 0; e < 4; ++e) v[e] = tanhf_(v[e]); }
                else if (u.id == 5) { for (int e = 0; e < 4; ++e) v[e] = sigmoidf_(v[e]); }
                st_bf4(O + (size_t)ACC_ROW(u, ai, m) * 256 + ACC_COL(u, bj, n), v); ACC_FENCE;
            }
        }
    }
};
struct SchedRW2 {
    const Params* p; int j;
    DEV bool next(int i, Unit& u) const {
        int pm, pn; if (!pg8::tile_order(i, NB_, bid_(), 64, 12, pm, pn)) return false;
        const int id = pn >> 2, lpn = pn & 3;
        u.A = (const char*)(WS_(*p, LW) + (size_t)id * T * 256 + (size_t)pm * 256 * 256);
        const bf16_t* B = WS_(*p, rw_w2_t) + (size_t)id * (2 * D * 256) + (size_t)j * D * 256 + (size_t)lpn * 256 * 256;
        u.B = (const char*)B; u.row0 = pm * 256; u.col0 = lpn * 256; u.id = id; u.aux = 0; return true;
    }
};
struct EpiRW2 {
    const Params* p; int j;
    DEV void operator()(const AccT& acc, const Unit& u, int wr, int wc, int fr, int fq) const {
        if (u.id == 0) { const float* bias = p->rw_w0 + (size_t)j * D; f32x4 bv[2][2];
#pragma unroll
            for (int bj = 0; bj < 2; ++bj)
#pragma unroll
                for (int n = 0; n < 2; ++n) bv[bj][n] = *(const f32x4*)(bias + ACC_COL(u, bj, n));
            FOR_ACC(ai, bj, m, n) { f32x4 v = acc[ai][bj][m][n]; const int c = ACC_COL(u, bj, n); const f32x4 b = bv[bj][n];
                for (int e = 0; e < 4; ++e) { const float x = -(b[e] + v[e]); const float wl = -(fmaxf(x, 0.f) + __logf(1.0f + __expf(-fabsf(x)))) - 0.5f; v[e] = -__expf(wl); }
                st_bf4(WS_(*p, Wb) + (size_t)ACC_ROW(u, ai, m) * D + c, v); ACC_FENCE; } }
        else if (u.id == 1) { const float* bias = p->rw_a0 + (size_t)j * D; f32x4 bv[2][2];
#pragma unroll
            for (int bj = 0; bj < 2; ++bj)
#pragma unroll
                for (int n = 0; n < 2; ++n) bv[bj][n] = *(const f32x4*)(bias + ACC_COL(u, bj, n));
            FOR_ACC(ai, bj, m, n) { f32x4 v = acc[ai][bj][m][n]; const int c = ACC_COL(u, bj, n); const f32x4 b = bv[bj][n];
                for (int e = 0; e < 4; ++e) v[e] = sigmoidf_(b[e] + v[e]);
                st_bf4(WS_(*p, Ab) + (size_t)ACC_ROW(u, ai, m) * D + c, v); ACC_FENCE; } }
        else { FOR_ACC(ai, bj, m, n) { st_bf4(WS_(*p, Gb) + (size_t)ACC_ROW(u, ai, m) * D + ACC_COL(u, bj, n), acc[ai][bj][m][n]); ACC_FENCE; } }
    }
};

struct SchedOut {
    const bf16_t* A; const bf16_t* Bt; int K;
    DEV bool next(int i, Unit& u) const {
        int pm, pn; if (!pg8::tile_order(i, NB_, bid_(), 64, 4, pm, pn)) return false;
        u.A = (const char*)(A + (size_t)pm * 256 * K); u.B = (const char*)(Bt + (size_t)pn * 256 * K); u.row0 = pm * 256; u.col0 = pn * 256; u.id = 0; u.aux = 0; return true;
    }
};
struct EpiOut {
    bf16_t* O;
    DEV void operator()(const AccT& acc, const Unit& u, int wr, int wc, int fr, int fq) const {
        FOR_ACC(ai, bj, m, n) { st_bf4(O + (size_t)ACC_ROW(u, ai, m) * D + ACC_COL(u, bj, n), acc[ai][bj][m][n]); ACC_FENCE; }
    }
};
constexpr int RC_LD = 72;
#ifdef DBG
#define DBGF(cond, bit) do { if (cond) atomicOr(&WS_(p, TAB)[200], (bit)); } while (0)
#else
#define DBGF(cond, bit) do {} while (0)
#endif
DEV bool bad_(float x) { return !(fabsf(x) < 1e30f); }
DEV int rc_pi(int g, int j) { return j < 4 ? 4 * g + j : 16 + 4 * g + (j - 4); }

DEV void rc_load_wd(const Params& p, int t0, int cb, float (&wd)[8]) {
    const int tid = tid_(); const int k = tid & 63, sg = tid >> 6;
#pragma unroll
    for (int i = 0; i < 8; ++i) wd[i] = bf2f(WS_(p, Wb)[(size_t)(t0 + sg * 8 + i) * D + cb + k]);
}
DEV void rc_cum_regs(const float (&wd)[8], LAS float* cum, LAS float* seg) {
    const int tid = tid_(); const int k = tid & 63, sg = tid >> 6;
    float v[8]; float s = 0.f;
#pragma unroll
    for (int i = 0; i < 8; ++i) { s += wd[i]; v[i] = s; }
    seg[sg * 64 + k] = s;
    lds_barrier();
    float off = 0.f;
#pragma unroll
    for (int q = 0; q < 8; ++q) off += (q < sg) ? seg[q * 64 + k] : 0.f;
#pragma unroll
    for (int i = 0; i < 8; ++i) cum[(sg * 8 + i) * 64 + k] = v[i] + off;
    lds_barrier();
}
DEV void ld8b(const bf16_t* p, float (&f)[8]) { const u32x4 v = *(const u32x4*)p; f[0] = bflo(v.x); f[1] = bfhi(v.x); f[2] = bflo(v.y); f[3] = bfhi(v.y); f[4] = bflo(v.z); f[5] = bfhi(v.z); f[6] = bflo(v.w); f[7] = bfhi(v.w); }
DEV void ld8(const float* p, float (&f)[8]) { const f32x4 a = *(const f32x4*)p, b = *(const f32x4*)(p + 4); f[0] = a[0]; f[1] = a[1]; f[2] = a[2]; f[3] = a[3]; f[4] = b[0]; f[5] = b[1]; f[6] = b[2]; f[7] = b[3]; }
DEV void lds8(const LAS float* p, float (&f)[8]) { const f32x4 a = *(const LAS f32x4*)p, b = *(const LAS f32x4*)(p + 4); f[0] = a[0]; f[1] = a[1]; f[2] = a[2]; f[3] = a[3]; f[4] = b[0]; f[5] = b[1]; f[6] = b[2]; f[7] = b[3]; }
DEV u32x4 pk8(const float (&f)[8]) { u32x4 o; o.x = pk2(f[0], f[1]); o.y = pk2(f[2], f[3]); o.z = pk2(f[4], f[5]); o.w = pk2(f[6], f[7]); return o; }

DEV bf16x8 frag_rm_pi(const LAS bf16_t* base, int ld, int row0, int k0, int lane) {
    const LAS bf16_t* a = base + (row0 + (lane & 15)) * ld + k0 + 4 * (lane >> 4);
    const s16x4 lo = *(const LAS s16x4*)a, hi = *(const LAS s16x4*)(a + 16);
    bf16x8 r; r[0] = lo[0]; r[1] = lo[1]; r[2] = lo[2]; r[3] = lo[3]; r[4] = hi[0]; r[5] = hi[1]; r[6] = hi[2]; r[7] = hi[3]; return r;
}
DEV void rc_prep8(const float (&k)[8], const float (&al)[8], const float (&kkw)[8], const float (&kaw)[8], float (&a)[8], float (&b)[8], float (&kh)[8]) {
    float kk[8]; float ss = 0.f;
#pragma unroll
    for (int e = 0; e < 8; ++e) { kk[e] = k[e] * kkw[e]; ss += kk[e] * kk[e]; }
    ss += __shfl_xor(ss, 1); ss += __shfl_xor(ss, 2); ss += __shfl_xor(ss, 4);
    const float inv = 1.0f / fmaxf(sqrtf(ss), 1e-12f);
#pragma unroll
    for (int e = 0; e < 8; ++e) { const float kn = kk[e] * inv; a[e] = -kn; b[e] = kn * al[e]; kh[e] = k[e] * (1.0f + (al[e] - 1.0f) * kaw[e]); }
}
DEV void phase_rw_cha(const Params& p, int jl, LAS unsigned char* lds) {
    const int tid = tid_(), bid = bid_(); const int lane = tid & 63, w = tid >> 6; const int fr = lane & 15, fq = lane >> 4;
    LAS float* cum = (LAS float*)lds;
    LAS float* seg = cum + 64 * 64;
    LAS float* Aab = seg + 8 * 64;
    LAS bf16_t* As = (LAS bf16_t*)(Aab + 64 * 68);
    LAS bf16_t* Bs = As + 64 * RC_LD; LAS bf16_t* Ks = Bs + 64 * RC_LD; LAS bf16_t* Vs = Ks + 64 * RC_LD; LAS bf16_t* Ke = Vs + 64 * RC_LD;
    LAS bf16_t* Aak = Ke + 64 * RC_LD; LAS bf16_t* Ts = Aak + 64 * RC_LD; LAS bf16_t* X1 = Ts + 64 * RC_LD; LAS bf16_t* Aabh = X1 + 64 * RC_LD;
    LAS bf16_t* Fimg = Aabh + 64 * RC_LD;
    LAS bf16_t* Wimg = Fimg + 4096;
    float pwd[8], pkr[8], pal[8], pv[8];
    float kkw[8], kaw[8];
    ld8(p.rw_k_k + (size_t)jl * D + (bid & 15) * 64 + (tid & 7) * 8, kkw); ld8(p.rw_k_a + (size_t)jl * D + (bid & 15) * 64 + (tid & 7) * 8, kaw);
    { const int c = bid >> 4, h = bid & 15; rc_load_wd(p, c * 64, h * 64, pwd);
      const size_t go = (size_t)(c * 64 + (tid >> 3)) * D + h * 64 + (tid & 7) * 8; ld8b(WS_(p, Kb) + go, pkr); ld8b(WS_(p, Ab) + go, pal); ld8b(WS_(p, Vb) + go, pv); }
    for (int u = bid; u < 4096; u += NB_) {
        const int c = u >> 4, h = u & 15; const int t0 = c * 64, cb = h * 64; const size_t ub = (size_t)c * 16 + h;
        lds_barrier();
        rc_cum_regs(pwd, cum, seg);
        {
            const int t = tid >> 3, k8 = (tid & 7) * 8;
            float a[8], b[8], kh[8], v[8], ct[8], cp[8], ce[8];
            rc_prep8(pkr, pal, kkw, kaw, a, b, kh);
#pragma unroll
            for (int e = 0; e < 8; ++e) v[e] = pv[e];
            if (u + NB_ < 4096) { const int un = u + NB_; const int cn = un >> 4, hn = un & 15; rc_load_wd(p, cn * 64, hn * 64, pwd);
                const size_t gn = (size_t)(cn * 64 + t) * D + hn * 64 + k8; ld8b(WS_(p, Kb) + gn, pkr); ld8b(WS_(p, Ab) + gn, pal); ld8b(WS_(p, Vb) + gn, pv); }
            lds8(cum + t * 64 + k8, ct); lds8(cum + 63 * 64 + k8, ce);
            if (t > 0) lds8(cum + (t - 1) * 64 + k8, cp); else { for (int e = 0; e < 8; ++e) cp[e] = 0.f; }
            float at[8], bt[8], kt[8], be[8], ke[8];
#pragma unroll
            for (int e = 0; e < 8; ++e) { const float ei = __expf(-ct[e]), ee = __expf(ce[e] - ct[e]); at[e] = a[e] * __expf(cp[e]); bt[e] = b[e] * ei; kt[e] = kh[e] * ei; be[e] = b[e] * ee; ke[e] = kh[e] * ee; }
            *(LAS u32x4*)(As + t * RC_LD + k8) = pk8(at); *(LAS u32x4*)(Bs + t * RC_LD + k8) = pk8(bt); *(LAS u32x4*)(Ks + t * RC_LD + k8) = pk8(kt);
            *(LAS u32x4*)(Ke + t * RC_LD + k8) = pk8(ke); *(LAS u32x4*)(Vs + t * RC_LD + k8) = pk8(v);
            const int tq = t & 31, g = (tq & 15) >> 2, j = (tq & 3) + ((tq >> 4) << 2);
#pragma unroll
            for (int e = 0; e < 8; ++e) { const int k = k8 + e; Fimg[(((k >> 4) * 2 + (t >> 5)) * 64 + g * 16 + (k & 15)) * 8 + j] = (bf16_t)f2bf(be[e]); }
            *(LAS u32x4*)(Ts + tid * 8) = (u32x4){0u, 0u, 0u, 0u}; if (tid < 64) *(LAS u32x4*)(Ts + (512 + tid) * 8) = (u32x4){0u, 0u, 0u, 0u};
            if (t == 63) { float gm[8]; for (int e = 0; e < 8; ++e) gm[e] = __expf(ce[e]); *(f32x4*)(WS_(p, RGc) + ub * 64 + k8) = (f32x4){gm[0], gm[1], gm[2], gm[3]}; *(f32x4*)(WS_(p, RGc) + ub * 64 + k8 + 4) = (f32x4){gm[4], gm[5], gm[6], gm[7]}; }
        }
        lds_barrier();
        {
            const int tb = w >> 1;
#pragma unroll
            for (int ii = 0; ii < 2; ++ii) { const int ib = 2 * (w & 1) + ii;
                f32x4 ab = {0.f, 0.f, 0.f, 0.f}, ak = {0.f, 0.f, 0.f, 0.f};
                if (ib <= tb) {
#pragma unroll
                    for (int ks = 0; ks < 2; ++ks) { const bf16x8 af = frag_rm(As, RC_LD, 16 * tb, 32 * ks, lane);
                        ab = MFMA16(af, frag_rm(Bs, RC_LD, 16 * ib, 32 * ks, lane), ab); ak = MFMA16(af, frag_rm(Ks, RC_LD, 16 * ib, 32 * ks, lane), ak); } }
#pragma unroll
                for (int r = 0; r < 4; ++r) { const int t = 16 * tb + 4 * fq + r, i = 16 * ib + fr; const bool keep = i < t;
                    Aab[t * 68 + i] = keep ? ab[r] : 0.f; Aabh[t * RC_LD + i] = (bf16_t)f2bf(keep ? ab[r] : 0.f); Aak[t * RC_LD + i] = (bf16_t)f2bf(keep ? ak[r] : 0.f); } }
            *(u32x4*)(WS_(p, RBf) + ub * 4096 + tid * 8) = *(const LAS u32x4*)(Fimg + tid * 8);
        }
        lds_barrier();
        if (w == 0) {
            const int blk = lane >> 4, jc = lane & 15;
            float Tc[16];
#pragma unroll
            for (int t = 0; t < 16; ++t) {
                float acc = jc == t ? 1.f : 0.f;
#pragma unroll
                for (int i4 = 0; i4 < (t + 3) / 4; ++i4) { const f32x4 a4 = *(const LAS f32x4*)(Aab + (16 * blk + t) * 68 + 16 * blk + i4 * 4);
#pragma unroll
                    for (int e = 0; e < 4; ++e) if (i4 * 4 + e < t) acc += a4[e] * Tc[i4 * 4 + e]; }
                Tc[t] = acc;
            }
#pragma unroll
            for (int t = 0; t < 16; ++t) Ts[(16 * blk + t) * RC_LD + 16 * blk + jc] = (bf16_t)f2bf(Tc[t]);
#pragma unroll
            for (int b = 1; b < 4; ++b) {
                const s16x4 dlo = *(const LAS s16x4*)(Ts + (16 * b + fr) * RC_LD + 16 * b + 4 * fq);
                bf16x8 dfr; dfr[0] = dlo[0]; dfr[1] = dlo[1]; dfr[2] = dlo[2]; dfr[3] = dlo[3]; dfr[4] = 0; dfr[5] = 0; dfr[6] = 0; dfr[7] = 0;
                f32x4 tt_[3];
#pragma unroll
                for (int cbk = 0; cbk < b; ++cbk) {
                    f32x4 x = {0.f, 0.f, 0.f, 0.f};
#pragma unroll
                    for (int ks = 0; ks < 2; ++ks) x = MFMA16(frag_rm(Aabh, RC_LD, 16 * b, 32 * ks, lane), frag_tr(Ts, RC_LD, 32 * ks, 16 * cbk, lane), x);
                    u32x4 xb; xb.x = pk2(x[0], x[1]); xb.y = pk2(x[2], x[3]); xb.z = 0u; xb.w = 0u;
                    tt_[cbk] = MFMA16(dfr, __builtin_bit_cast(bf16x8, xb), ((f32x4){0.f, 0.f, 0.f, 0.f}));
                }
#pragma unroll
                for (int cbk = 0; cbk < b; ++cbk)
#pragma unroll
                    for (int r = 0; r < 4; ++r) Ts[(16 * b + 4 * fq + r) * RC_LD + 16 * cbk + fr] = (bf16_t)f2bf(tt_[cbk][r]);
            }
        } else {
            for (int tl = w - 1; tl < 32; tl += 7) {
                const int rb = (tl & 15) >> 2, vbk = tl & 3; f32x4 acc = {0.f, 0.f, 0.f, 0.f};
                if (tl < 16) {
#pragma unroll
                    for (int ks = 0; ks < 2; ++ks) acc = MFMA16(frag_rm(Aak, RC_LD, 16 * rb, 32 * ks, lane), frag_tr(Vs, RC_LD, 32 * ks, 16 * vbk, lane), acc);
#pragma unroll
                    for (int r = 0; r < 4; ++r) X1[(16 * rb + 4 * fq + r) * RC_LD + 16 * vbk + fr] = (bf16_t)f2bf(acc[r]);
                } else {
#pragma unroll
                    for (int ks = 0; ks < 2; ++ks) acc = MFMA16(frag_tr(Ke, RC_LD, 32 * ks, 16 * rb, lane), frag_tr(Vs, RC_LD, 32 * ks, 16 * vbk, lane), acc);
                    { u32x2 o; o.x = pk2(acc[0], acc[1]); o.y = pk2(acc[2], acc[3]); *(u32x2*)(WS_(p, RNa) + (((ub * 4 + vbk) * 4 + rb) * 64 + lane) * 4) = o; }
                }
            }
        }
        lds_barrier();
#pragma unroll
        for (int q = 0; q < 4; ++q) { const int tl = w * 4 + q; const int tt = (tl & 15) >> 2, cbk = tl & 3; f32x4 acc = {0.f, 0.f, 0.f, 0.f};
            if (tl < 16) {
#pragma unroll
                for (int ks = 0; ks < 2; ++ks) acc = MFMA16(frag_rm(Ts, RC_LD, 16 * tt, 32 * ks, lane), frag_tr(As, RC_LD, 32 * ks, 16 * cbk, lane), acc);
                const int k = 16 * cbk + fr, kq = k & 31, g = (kq & 15) >> 2, j = (kq & 3) + ((kq >> 4) << 2);
#pragma unroll
                for (int r = 0; r < 4; ++r) Wimg[((tt * 2 + (k >> 5)) * 64 + g * 16 + 4 * fq + r) * 8 + j] = (bf16_t)f2bf(acc[r]);
            } else {
#pragma unroll
                for (int ks = 0; ks < 2; ++ks) acc = MFMA16(frag_rm(Ts, RC_LD, 16 * tt, 32 * ks, lane), frag_tr(X1, RC_LD, 32 * ks, 16 * cbk, lane), acc);
                { u32x2 o; o.x = pk2(acc[0], acc[1]); o.y = pk2(acc[2], acc[3]); *(u32x2*)(WS_(p, RUt) + (((ub * 4 + cbk) * 4 + tt) * 64 + lane) * 4) = o; }
            } }
        lds_barrier();
        *(u32x4*)(WS_(p, RWf) + ub * 4096 + tid * 8) = *(const LAS u32x4*)(Wimg + tid * 8);
    }
}

constexpr int RB_SLOT = 20992, RB_R = 6, RB_P = 5;
struct RbOpsA { bf16x8 wf[8]; u32x2 ut[4]; };
struct RbOpsB { bf16x8 bf[8]; u32x2 na[4]; f32x4 gc[4]; };
DEV void rb_read_a(const LAS unsigned char* slot, int lane, RbOpsA& O) {
#pragma unroll
    for (int f = 0; f < 8; ++f) O.wf[f] = *(const LAS bf16x8*)(slot + (f * 64 + lane) * 16);
#pragma unroll
    for (int q = 0; q < 4; ++q) O.ut[q] = *(const LAS u32x2*)(slot + 16384 + (q * 64 + lane) * 8);
}
DEV void rb_read_b(const LAS unsigned char* slot, int lane, RbOpsB& O) {
    const int fq = lane >> 4;
#pragma unroll
    for (int f = 0; f < 8; ++f) O.bf[f] = *(const LAS bf16x8*)(slot + 8192 + (f * 64 + lane) * 16);
#pragma unroll
    for (int q = 0; q < 4; ++q) { O.na[q] = *(const LAS u32x2*)(slot + 18432 + (q * 64 + lane) * 8); O.gc[q] = *(const LAS f32x4*)(slot + 20480 + (16 * q + 4 * fq) * 4); }
}
DEV void phase_rw_chb(const Params& p, int layer, LAS unsigned char* lds) {
    const int tid = tid_(), bid = bid_();
    if (bid >= 64) {
        if (layer == 0) { int tb = convert_jobs<8, 12>(p, lds, 64, NB_ - 64);
#pragma unroll 1
            for (int ml = 0; ml < 2; ++ml) { const ConvJob J0 = moe_job(p, 0, ml), J1 = moe_job(p, 1, ml); convert_one(J0, lds, 64, NB_ - 64, tb); tb += J0.ntiles(); convert_one(J1, lds, 64, NB_ - 64, tb); tb += J1.ntiles(); } }
        return; }
    const int lane = tid & 63, w = __builtin_amdgcn_readfirstlane(tid >> 6); const int head = bid & 15, vb = bid >> 4;
    auto issue = [&](int c) {
        const size_t ub = (size_t)c * 16 + head; LAS unsigned char* slot = lds + (c % RB_R) * RB_SLOT;
#pragma unroll
        for (int i = 0; i < 3; ++i) { const int pi = (w - 1) * 3 + i;
            if (pi < 8) __builtin_amdgcn_global_load_lds((const unsigned*)(WS_(p, RWf) + ub * 4096 + pi * 512 + lane * 8), (LAS unsigned*)(slot + pi * 1024), 16, 0, 0);
            else if (pi < 16) __builtin_amdgcn_global_load_lds((const unsigned*)(WS_(p, RBf) + ub * 4096 + (pi - 8) * 512 + lane * 8), (LAS unsigned*)(slot + 8192 + (pi - 8) * 1024), 16, 0, 0);
            else if (pi < 18) __builtin_amdgcn_global_load_lds((const unsigned*)(WS_(p, RUt) + (ub * 4 + vb) * 1024 + (pi - 16) * 512 + lane * 8), (LAS unsigned*)(slot + 16384 + (pi - 16) * 1024), 16, 0, 0);
            else if (pi < 20) __builtin_amdgcn_global_load_lds((const unsigned*)(WS_(p, RNa) + (ub * 4 + vb) * 1024 + (pi - 18) * 512 + lane * 8), (LAS unsigned*)(slot + 18432 + (pi - 18) * 1024), 16, 0, 0);
            else __builtin_amdgcn_global_load_lds((const unsigned*)(WS_(p, RGc) + ub * 64 + lane), (LAS unsigned*)(slot + 20480), 4, 0, 0);
        }
    };
    if (w > 0) {
#pragma unroll 1
        for (int c = 0; c < RB_P; ++c) issue(c);
        asm volatile("s_waitcnt vmcnt(9)" ::: "memory");
    }
    __builtin_amdgcn_s_barrier();
    f32x4 s[4]; for (int i = 0; i < 4; ++i) s[i] = (f32x4){0.f, 0.f, 0.f, 0.f};
    RbOpsA cur, nxt; RbOpsB cb_;
    if (w == 0) { rb_read_a(lds, lane, cur); }
#pragma unroll 1
    for (int c = 0; c < 256; ++c) {
        if (w > 0) {
            if (c + RB_P < 256) { issue(c + RB_P); asm volatile("s_waitcnt vmcnt(9)" ::: "memory"); }
            else asm volatile("s_waitcnt vmcnt(0)" ::: "memory");
        } else {
            const size_t ub = (size_t)c * 16 + head;
            rb_read_b(lds + (c % RB_R) * RB_SLOT, lane, cb_);
            rb_read_a(lds + ((c + 1 < 256 ? c + 1 : c) % RB_R) * RB_SLOT, lane, nxt);
            bf16x8 sb[2];
#pragma unroll
            for (int ks = 0; ks < 2; ++ks) { u32x4 o; o.x = pk2(s[2 * ks][0], s[2 * ks][1]); o.y = pk2(s[2 * ks][2], s[2 * ks][3]); o.z = pk2(s[2 * ks + 1][0], s[2 * ks + 1][1]); o.w = pk2(s[2 * ks + 1][2], s[2 * ks + 1][3]); sb[ks] = __builtin_bit_cast(bf16x8, o); *(u32x4*)(WS_(p, RS0) + (((ub * 4 + vb) * 2 + ks) * 64 + lane) * 8) = o; }
            f32x4 uu[4];
#pragma unroll
            for (int tt = 0; tt < 4; ++tt) { uu[tt] = (f32x4){bflo(cur.ut[tt].x), bfhi(cur.ut[tt].x), bflo(cur.ut[tt].y), bfhi(cur.ut[tt].y)}; uu[tt] = MFMA16(cur.wf[tt * 2], sb[0], uu[tt]); uu[tt] = MFMA16(cur.wf[tt * 2 + 1], sb[1], uu[tt]); }
            bf16x8 ubf[2];
#pragma unroll
            for (int ks = 0; ks < 2; ++ks) { u32x4 o; o.x = pk2(uu[2 * ks][0], uu[2 * ks][1]); o.y = pk2(uu[2 * ks][2], uu[2 * ks][3]); o.z = pk2(uu[2 * ks + 1][0], uu[2 * ks + 1][1]); o.w = pk2(uu[2 * ks + 1][2], uu[2 * ks + 1][3]); ubf[ks] = __builtin_bit_cast(bf16x8, o); *(u32x4*)(WS_(p, RUa) + (((ub * 4 + vb) * 2 + ks) * 64 + lane) * 8) = o; }
#pragma unroll
            for (int kt = 0; kt < 4; ++kt) { s[kt] = s[kt] * cb_.gc[kt] + (f32x4){bflo(cb_.na[kt].x), bfhi(cb_.na[kt].x), bflo(cb_.na[kt].y), bfhi(cb_.na[kt].y)}; s[kt] = MFMA16(cb_.bf[kt * 2], ubf[0], s[kt]); s[kt] = MFMA16(cb_.bf[kt * 2 + 1], ubf[1], s[kt]); }
            cur = nxt;
            asm volatile("s_waitcnt lgkmcnt(0)" ::: "memory");
        }
        __builtin_amdgcn_s_barrier();
    }
    asm volatile("s_waitcnt vmcnt(0)" ::: "memory");
}

DEV void phase_rw_chc(const Params& p, int j, LAS unsigned char* lds) {
    const int tid = tid_(), bid = bid_(); const int lane = tid & 63, w = tid >> 6; const int fr = lane & 15, fq = lane >> 4;
    LAS float* cum = (LAS float*)lds;
    LAS float* seg = cum + 64 * 64;
    LAS float* Ys = seg + 8 * 64;
    LAS bf16_t* Rs = (LAS bf16_t*)(Ys + 64 * 68);
    LAS bf16_t* Bs = Rs + 64 * RC_LD; LAS bf16_t* Ks = Bs + 64 * RC_LD; LAS bf16_t* Vs = Ks + 64 * RC_LD; LAS bf16_t* Arb = Vs + 64 * RC_LD; LAS bf16_t* Ark = Arb + 64 * RC_LD;
    float pwd[8], pr[8], pkr[8], pal[8], pv[8], pg[8];
    float kkw[8], kaw[8], rkw[8], lgw[8], lbw[8];
    { const size_t po = (size_t)j * D + (bid & 15) * 64 + (tid & 7) * 8; ld8(p.rw_k_k + po, kkw); ld8(p.rw_k_a + po, kaw); ld8(p.rw_r_k + po, rkw); ld8(p.rw_lnx_g + po, lgw); ld8(p.rw_lnx_b + po, lbw); }
    { const int c = bid >> 4, h = bid & 15; rc_load_wd(p, c * 64, h * 64, pwd);
      const size_t go = (size_t)(c * 64 + (tid >> 3)) * D + h * 64 + (tid & 7) * 8; ld8b(WS_(p, Rb) + go, pr); ld8b(WS_(p, Kb) + go, pkr); ld8b(WS_(p, Ab) + go, pal); ld8b(WS_(p, Vb) + go, pv); ld8b(WS_(p, Gb) + go, pg); }
    for (int u = bid; u < 4096; u += NB_) {
        const int c = u >> 4, h = u & 15; const int t0 = c * 64, cb = h * 64; const size_t ub = (size_t)c * 16 + h;
        const int tt = w & 3;
        bf16x8 ufr[2][2], sfr[2][2];
#pragma unroll
        for (int q = 0; q < 2; ++q)
#pragma unroll
            for (int ks = 0; ks < 2; ++ks) { const size_t o = (((ub * 4 + 2 * (w >> 2) + q) * 2 + ks) * 64 + lane) * 8;
                ufr[q][ks] = *(const bf16x8*)(WS_(p, RUa) + o); sfr[q][ks] = *(const bf16x8*)(WS_(p, RS0) + o); }
        lds_barrier();
        rc_cum_regs(pwd, cum, seg);
#ifdef DBL_CUM
        rc_cum_regs(pwd, cum, seg);
#endif
        const int t = tid >> 3, k8 = (tid & 7) * 8; const size_t go = (size_t)(t0 + t) * D + cb + k8;
        float v[8], gg[8]; float bc;
        {   float r[8], a[8], b[8], kh[8], ct[8];
#pragma unroll
            for (int e = 0; e < 8; ++e) { r[e] = pr[e]; v[e] = pv[e]; gg[e] = pg[e]; }
            lds8(cum + t * 64 + k8, ct);
            rc_prep8(pkr, pal, kkw, kaw, a, b, kh);
            if (u + NB_ < 4096) { const int un = u + NB_; const int cn = un >> 4, hn = un & 15; rc_load_wd(p, cn * 64, hn * 64, pwd);
                const size_t gn = (size_t)(cn * 64 + t) * D + hn * 64 + k8; ld8b(WS_(p, Rb) + gn, pr); ld8b(WS_(p, Kb) + gn, pkr); ld8b(WS_(p, Ab) + gn, pal); ld8b(WS_(p, Vb) + gn, pv); ld8b(WS_(p, Gb) + gn, pg); }
            bc = 0.f;
#pragma unroll
            for (int e = 0; e < 8; ++e) bc += r[e] * kh[e] * rkw[e];
            bc += __shfl_xor(bc, 1); bc += __shfl_xor(bc, 2); bc += __shfl_xor(bc, 4);
#pragma unroll
            for (int e = 0; e < 8; ++e) { const float ei = __expf(-ct[e]); r[e] *= __expf(ct[e]); b[e] *= ei; kh[e] *= ei; }
            *(LAS u32x4*)(Rs + t * RC_LD + k8) = pk8(r); *(LAS u32x4*)(Bs + t * RC_LD + k8) = pk8(b); *(LAS u32x4*)(Ks + t * RC_LD + k8) = pk8(kh); *(LAS u32x4*)(Vs + t * RC_LD + k8) = pk8(v);
        }
        lds_barrier();
#ifdef DBL_S3
#pragma unroll 1
        for (int rep_ = 0; rep_ < 2; ++rep_)
#endif
        {   const int tb = w >> 1;
#pragma unroll
            for (int ii = 0; ii < 2; ++ii) { const int ib = 2 * (w & 1) + ii;
                f32x4 ab = {0.f, 0.f, 0.f, 0.f}, ak = {0.f, 0.f, 0.f, 0.f};
                if (ib <= tb) {
#pragma unroll
                    for (int ks = 0; ks < 2; ++ks) { const bf16x8 af = frag_rm(Rs, RC_LD, 16 * tb, 32 * ks, lane);
                        ab = MFMA16(af, frag_rm(Bs, RC_LD, 16 * ib, 32 * ks, lane), ab); ak = MFMA16(af, frag_rm(Ks, RC_LD, 16 * ib, 32 * ks, lane), ak); } }
#pragma unroll
                for (int r = 0; r < 4; ++r) { const int tr = 16 * tb + 4 * fq + r, i = 16 * ib + fr; const bool keep = i <= tr;
                    Arb[tr * RC_LD + i] = (bf16_t)f2bf(keep ? ab[r] : 0.f); Ark[tr * RC_LD + i] = (bf16_t)f2bf(keep ? ak[r] : 0.f); } }
        }
        lds_barrier();
#ifdef DBL_Y
#pragma unroll 1
        for (int rep_ = 0; rep_ < 2; ++rep_)
#endif
#pragma unroll
        for (int q = 0; q < 2; ++q) { const int vbk = 2 * (w >> 2) + q; f32x4 acc = {0.f, 0.f, 0.f, 0.f};
#pragma unroll
            for (int ks = 0; ks < 2; ++ks) {
                acc = MFMA16(frag_rm_pi(Rs, RC_LD, 16 * tt, 32 * ks, lane), sfr[q][ks], acc);
                acc = MFMA16(frag_rm_pi(Arb, RC_LD, 16 * tt, 32 * ks, lane), ufr[q][ks], acc);
                acc = MFMA16(frag_rm(Ark, RC_LD, 16 * tt, 32 * ks, lane), frag_tr(Vs, RC_LD, 32 * ks, 16 * vbk, lane), acc); }
#pragma unroll
            for (int r = 0; r < 4; ++r) Ys[(16 * tt + 4 * fq + r) * 68 + 16 * vbk + fr] = acc[r]; }
        lds_barrier();
        {
            float y[8]; lds8(Ys + t * 68 + k8, y);
            float s1 = 0.f, s2 = 0.f;
#pragma unroll
            for (int e = 0; e < 8; ++e) { s1 += y[e]; s2 += y[e] * y[e]; }
            s1 += __shfl_xor(s1, 1); s1 += __shfl_xor(s1, 2); s1 += __shfl_xor(s1, 4); s2 += __shfl_xor(s2, 1); s2 += __shfl_xor(s2, 2); s2 += __shfl_xor(s2, 4);
            const float mean = s1 * (1.0f / 64.0f), var = s2 * (1.0f / 64.0f) - mean * mean; const float rs = rsqrtf(fmaxf(var, 0.f) + 64e-5f);
            float o[8];
#pragma unroll
            for (int e = 0; e < 8; ++e) o[e] = ((y[e] - mean) * rs * lgw[e] + lbw[e] + bc * v[e]) * gg[e];
            *(u32x4*)(WS_(p, YB) + go) = pk8(o);
        }
    }
}
DEV void phase_ln1(const Params& p, int layer, LAS unsigned char* lds) {
    const int tid = tid_(), bid = bid_(); (void)tid; (void)bid;
    const int lane = tid & 63, wid = tid >> 6; const int fr = lane & 15, fq = lane >> 4;
    LAS float* lgt = (LAS float*)lds;
    LAS int* cnt = (LAS int*)(lgt + 2 * 64 * 48);
    if (tid < 32) cnt[tid] = 0;
    const float* g = p.ln_g + ((size_t)layer * 2 + 0) * D; const float* be = p.ln_b + ((size_t)layer * 2 + 0) * D;
    const float* br = p.moe_b_route + layer * 32; const float* bg = p.moe_b_group + layer * 4;
    f32x4 gwv[4], bwv[4];
#pragma unroll
    for (int q = 0; q < 4; ++q) { gwv[q] = *(const f32x4*)(g + RCOL(q, lane)); bwv[q] = *(const f32x4*)(be + RCOL(q, lane)); }
    u32x2 rh[4], rm[4];
#pragma unroll
    for (int q = 0; q < 4; ++q) { rh[q] = *(const u32x2*)(WS_(p, Hb) + (size_t)(bid * 64 + wid * 8) * D + RCOL(q, lane)); rm[q] = *(const u32x2*)(WS_(p, MIXb) + (size_t)(bid * 64 + wid * 8) * D + RCOL(q, lane)); }
#pragma unroll 1
    for (int rr = 0; rr < 8; ++rr) {
        const int t = bid * 64 + wid * 8 + rr; const size_t ro = (size_t)t * D;
        f32x4 z[4], m[4];
#pragma unroll
        for (int q = 0; q < 4; ++q) { z[q] = (f32x4){bflo(rh[q].x), bfhi(rh[q].x), bflo(rh[q].y), bfhi(rh[q].y)}; m[q] = (f32x4){bflo(rm[q].x), bfhi(rm[q].x), bflo(rm[q].y), bfhi(rm[q].y)}; }
        { const size_t rn = (size_t)(rr < 7 ? t + 1 : t) * D;
#pragma unroll
          for (int q = 0; q < 4; ++q) { rh[q] = *(const u32x2*)(WS_(p, Hb) + rn + RCOL(q, lane)); rm[q] = *(const u32x2*)(WS_(p, MIXb) + rn + RCOL(q, lane)); } }
        float s = 0.f;
#pragma unroll
        for (int q = 0; q < 4; ++q) { z[q] = z[q] * ALPHA + m[q]; s += z[q][0] + z[q][1] + z[q][2] + z[q][3]; }
        const float mean = wave_sum(s) * (1.0f / D);
        float vs = 0.f;
#pragma unroll
        for (int q = 0; q < 4; ++q) { z[q] = z[q] - mean; vs += z[q][0] * z[q][0] + z[q][1] * z[q][1] + z[q][2] * z[q][2] + z[q][3] * z[q][3]; }
        const float rs = rsqrtf(wave_sum(vs) * (1.0f / D) + LN_EPS);
#pragma unroll
        for (int q = 0; q < 4; ++q) {
            st_bf4(WS_(p, H1b) + ro + RCOL(q, lane), z[q] * rs * gwv[q] + bwv[q]);
        }
    }
    asm volatile("s_waitcnt vmcnt(0)" ::: "memory");
    __syncthreads();
    {   const int rt = wid & 3, kh = wid >> 2;
        const bf16_t* Ab = WS_(p, H1b) + (size_t)(bid * 64 + 16 * rt + fr) * D + 512 * kh + 8 * fq;
        const bf16_t* Wb = WS_(p, moe_wr_t) + (size_t)layer * 48 * D + (size_t)fr * D + 512 * kh + 8 * fq;
        f32x4 acc[3]; for (int i = 0; i < 3; ++i) acc[i] = (f32x4){0.f, 0.f, 0.f, 0.f};
#pragma unroll 8
        for (int ks = 0; ks < 16; ++ks) {
            const bf16x8 af = *(const bf16x8*)(Ab + 32 * ks);
#pragma unroll
            for (int ct = 0; ct < 3; ++ct) acc[ct] = MFMA16(af, *(const bf16x8*)(Wb + (size_t)16 * ct * D + 32 * ks), acc[ct]);
        }
#pragma unroll
        for (int ct = 0; ct < 3; ++ct)
#pragma unroll
            for (int r = 0; r < 4; ++r) lgt[(kh * 64 + 16 * rt + 4 * fq + r) * 48 + 16 * ct + fr] = acc[ct][r];
    }
    __syncthreads();
    if (tid < 64) {
        const int t = bid * 64 + tid; const LAS float* L0 = lgt + tid * 48; const LAS float* L1 = lgt + (64 + tid) * 48;
        const float q0 = L0[32] + L1[32] + bg[0], q1 = L0[33] + L1[33] + bg[1], q2 = L0[34] + L1[34] + bg[2], q3 = L0[35] + L1[35] + bg[3];
        int gi = 0; float gm = q0;
        if (q1 > gm) { gm = q1; gi = 1; } if (q2 > gm) { gm = q2; gi = 2; } if (q3 > gm) { gm = q3; gi = 3; }
        const float den = __expf(q0 - gm) + __expf(q1 - gm) + __expf(q2 - gm) + __expf(q3 - gm);
        const float pgrp = __builtin_amdgcn_rcpf(den);
        float l1 = -INFINITY, l2 = -INFINITY; int i1 = 0, i2 = 0;
#pragma unroll 1
        for (int o = 0; o < 8; ++o) { const float v = L0[gi * 8 + o] + L1[gi * 8 + o] + br[gi * 8 + o];
            if (v > l1) { l2 = l1; i2 = i1; l1 = v; i1 = o; } else if (v > l2) { l2 = v; i2 = o; } }
        const float e2 = __expf(l2 - l1), inv = __builtin_amdgcn_rcpf(1.0f + e2);
        const int e0 = gi * 8 + i1, e1 = gi * 8 + i2;
        WS_(p, EIDX)[2 * t] = e0; WS_(p, EIDX)[2 * t + 1] = e1; WS_(p, GATE)[2 * t] = pgrp * inv; WS_(p, GATE)[2 * t + 1] = pgrp * e2 * inv;
        atomicAdd((int*)&cnt[e0], 1); atomicAdd((int*)&cnt[e1], 1);
    }
    __syncthreads();
    if (tid < 32) WS_(p, CNT)[bid * 32 + tid] = cnt[tid];
}

DEV void phase_moe_scatter(const Params& p, LAS unsigned char* lds) {
    const int tid = tid_(), bid = bid_(); (void)tid; (void)bid;
    const int lane = tid & 63, wid = tid >> 6;
    LAS int* part = (LAS int*)lds;
    LAS int* pre = part + 512;
    LAS int* base = pre + 512;
    LAS int* pst = base + 32;
    LAS int* dst = pst + 40;
    LAS int* eid = dst + 128;
    { const int e = tid & 31, part_i = tid >> 5; int tot = 0, prf = 0;
      for (int b = part_i * 16; b < part_i * 16 + 16; ++b) { const int c = WS_(p, CNT)[b * 32 + e]; tot += c; if (b < (int)bid) prf += c; }
      part[part_i * 32 + e] = tot; pre[part_i * 32 + e] = prf; }
    if (tid < 128) eid[tid] = WS_(p, EIDX)[bid * 128 + tid];
    lds_barrier();
    if (tid < 32) { int tot = 0, prf = 0; for (int i = 0; i < 16; ++i) { tot += part[i * 32 + tid]; prf += pre[i * 32 + tid]; } part[tid] = tot; pre[tid] = prf; }
    lds_barrier();
    if (tid == 0) { int acc = 0; for (int e = 0; e < 32; ++e) { pst[e] = acc; acc += ((part[e] + 255) >> 8) << 8; } pst[32] = acc;
        if (bid == 0) { for (int e = 0; e <= 32; ++e) WS_(p, TAB)[e] = pst[e]; WS_(p, TAB)[33] = acc >> 8;
            for (int e = 0; e < 32; ++e) for (int mt = pst[e] >> 8; mt < (pst[e + 1] >> 8); ++mt) WS_(p, TAB)[64 + mt] = e; } }
    lds_barrier();
    if (tid < 32) { int run = pst[tid] + pre[tid];
#pragma unroll 16
        for (int a = 0; a < 128; ++a) if (eid[a] == tid) dst[a] = run++; }
    lds_barrier();
    if (tid < 128) WS_(p, DEST)[bid * 128 + tid] = dst[tid];
#pragma unroll 4
    for (int a = wid * 16; a < wid * 16 + 16; ++a) {
        const int t = bid * 64 + (a >> 1); const int d = dst[a];
        const u32x4 v0 = *(const u32x4*)(WS_(p, H1b) + (size_t)t * D + lane * 8), v1 = *(const u32x4*)(WS_(p, H1b) + (size_t)t * D + 512 + lane * 8);
        *(u32x4*)(WS_(p, BUF) + (size_t)d * D + lane * 8) = v0; *(u32x4*)(WS_(p, BUF) + (size_t)d * D + 512 + lane * 8) = v1;
    }
}

template <int which> struct SchedMoe {
    const Params* p; int layer; const LAS int* tab;
    DEV bool next(int i, Unit& u) const {
        const int nmt = tab[33]; int pm, pn; if (!pg8::tile_order(i, NB_, bid_(), nmt, 4, pm, pn)) return false;
        const int row0 = pm * 256; const int e = tab[64 + pm];
        if constexpr (which == 0) { u.A = (const char*)(WS_(*p, BUF) + (size_t)row0 * D); u.B = (const char*)(WS_(*p, moe_w1_t) + ((size_t)layer * 32 + e) * 1024 * 1024 + (size_t)pn * 256 * 1024); }
        else { u.A = (const char*)(WS_(*p, ACT) + (size_t)row0 * 512); u.B = (const char*)(WS_(*p, moe_w2_t) + ((size_t)layer * 32 + e) * 1024 * 512 + (size_t)pn * 256 * 512); }
        u.row0 = row0; u.col0 = pn * 256; u.id = e; u.aux = 0; return true;
    }
};
struct EpiMoe1 {
    bf16_t* O;
    DEV void operator()(const AccT& acc, const Unit& u, int wr, int wc, int fr, int fq) const {
#pragma unroll
        for (int ai = 0; ai < 2; ++ai)
#pragma unroll
            for (int m = 0; m < 4; ++m)
#pragma unroll
                for (int n = 0; n < 2; ++n) {
                    const f32x4 gt = acc[ai][0][m][n], up = acc[ai][1][m][n]; f32x4 v;
                    for (int e = 0; e < 4; ++e) v[e] = siluf_(gt[e]) * up[e];
                    const int col = (u.col0 >> 1) + 32 * wc + 16 * n + 4 * fq;
                    st_bf4(O + (size_t)ACC_ROW(u, ai, m) * 512 + col, v); ACC_FENCE;
                }
    }
};
struct EpiMoe2 {
    bf16_t* O;
    DEV void operator()(const AccT& acc, const Unit& u, int wr, int wc, int fr, int fq) const {
        FOR_ACC(ai, bj, m, n) { st_bf4(O + (size_t)ACC_ROW(u, ai, m) * D + ACC_COL(u, bj, n), acc[ai][bj][m][n]); ACC_FENCE; }
    }
};

struct Ln2Raw { u32x2 h[4], a[4], b[4]; float g0, g1; };
DEV void ln2_issue(const Params& p, int t, int lane, Ln2Raw& R, int dpre, float gpre, int tbase) {
    const int i0 = 2 * (t - tbase); const int d0 = __shfl(dpre, i0), d1 = __shfl(dpre, i0 + 1); R.g0 = __shfl(gpre, i0); R.g1 = __shfl(gpre, i0 + 1);
#pragma unroll
    for (int q = 0; q < 4; ++q) { R.h[q] = *(const u32x2*)(WS_(p, H1b) + (size_t)t * D + RCOL(q, lane));
        R.a[q] = *(const u32x2*)(WS_(p, YBUF) + (size_t)d0 * D + RCOL(q, lane)); R.b[q] = *(const u32x2*)(WS_(p, YBUF) + (size_t)d1 * D + RCOL(q, lane)); }
}
DEV void ln2_finish(const Ln2Raw& R, const f32x4 (&gwv)[4], const f32x4 (&bwv)[4], f32x4 (&z)[4]) {
    float s = 0.f; const float g0 = R.g0, g1 = R.g1;
#pragma unroll
    for (int q = 0; q < 4; ++q) {
        z[q][0] = bflo(R.h[q].x) * ALPHA + g0 * bflo(R.a[q].x) + g1 * bflo(R.b[q].x); z[q][1] = bfhi(R.h[q].x) * ALPHA + g0 * bfhi(R.a[q].x) + g1 * bfhi(R.b[q].x);
        z[q][2] = bflo(R.h[q].y) * ALPHA + g0 * bflo(R.a[q].y) + g1 * bflo(R.b[q].y); z[q][3] = bfhi(R.h[q].y) * ALPHA + g0 * bfhi(R.a[q].y) + g1 * bfhi(R.b[q].y);
        s += z[q][0] + z[q][1] + z[q][2] + z[q][3];
    }
    const float mean = wave_sum(s) * (1.0f / D);
    float vs = 0.f;
#pragma unroll
    for (int q = 0; q < 4; ++q) { z[q] = z[q] - mean; vs += z[q][0] * z[q][0] + z[q][1] * z[q][1] + z[q][2] * z[q][2] + z[q][3] * z[q][3]; }
    const float rs = rsqrtf(wave_sum(vs) * (1.0f / D) + LN_EPS);
#pragma unroll
    for (int q = 0; q < 4; ++q) z[q] = z[q] * rs * gwv[q] + bwv[q];
}
DEV void phase_ln2(const Params& p, int layer, LAS unsigned char* lds) {
    const int tid = tid_(), bid = bid_(); const int lane = tid & 63, wid = tid >> 6; const int fr = lane & 15, fq = lane >> 4;
    const float* g = p.ln_g + ((size_t)layer * 2 + 1) * D; const float* be = p.ln_b + ((size_t)layer * 2 + 1) * D;
    const int nk = layer == DEPTH - 1 ? 3 : (layer + 1) % 3;
    const int nj = (layer + 1) / 3;
    LAS float* lgt = (LAS float*)lds;
    LAS float* w2 = lgt + 2 * 64 * 32;
    if (nk == 2) { for (int i = tid; i < 16 * 512; i += NTHR) w2[i] = p.gl_gk_w2[(size_t)nj * 16 * 512 + i]; }
    const int tfirst = bid * 64 + wid * 8;
    f32x4 z[4], zp[4], gwv[4], bwv[4];
#pragma unroll
    for (int q = 0; q < 4; ++q) { gwv[q] = *(const f32x4*)(g + RCOL(q, lane)); bwv[q] = *(const f32x4*)(be + RCOL(q, lane)); }
    Ln2Raw R[3];
    const int tbase = tfirst > 0 ? tfirst - 1 : 0;
    const int dpre = lane < 18 ? WS_(p, DEST)[2 * tbase + lane] : 0; const float gpre = lane < 18 ? WS_(p, GATE)[2 * tbase + lane] : 0.f;
    if (nk == 0) { if (tfirst > 0) { ln2_issue(p, tfirst - 1, lane, R[2], dpre, gpre, tbase); } }
    ln2_issue(p, tfirst, lane, R[0], dpre, gpre, tbase);
    ln2_issue(p, tfirst + 1, lane, R[1], dpre, gpre, tbase);
    if (nk == 0) { if (tfirst > 0) ln2_finish(R[2], gwv, bwv, zp); else { for (int q = 0; q < 4; ++q) zp[q] = (f32x4){0.f, 0.f, 0.f, 0.f}; } }
#pragma unroll
    for (int rr = 0; rr < 8; ++rr) {
        const int t = tfirst + rr; const size_t ro = (size_t)t * D;
        if (rr + 2 < 8) ln2_issue(p, t + 2, lane, R[(rr + 2) % 3], dpre, gpre, tbase);
        ln2_finish(R[rr % 3], gwv, bwv, z);
        if (nk == 3) {
#pragma unroll
            for (int q = 0; q < 4; ++q) *(f32x4*)(p.out + ro + RCOL(q, lane)) = z[q];
        } else store_row_bf(WS_(p, Hb) + ro, lane, z);
        if (nk == 0) {
            emit_mix6(p, nj, t, lane, z, zp);
#pragma unroll
            for (int q = 0; q < 4; ++q) zp[q] = z[q];
        }
    }
    if (nk == 1 || nk == 2) {
        asm volatile("s_waitcnt vmcnt(0)" ::: "memory");
        __syncthreads();
        const int nct = nk == 1 ? 2 : 1; const int rt = wid & 3, kh = wid >> 2;
        const bf16_t* Ab = WS_(p, Hb) + (size_t)(bid * 64 + 16 * rt + fr) * D + 512 * kh + 8 * fq;
        const bf16_t* Wb = (nk == 1 ? WS_(p, mb_dt_t) : WS_(p, gl_lr_t)) + (size_t)fr * D + 512 * kh + 8 * fq;
        f32x4 acc[2]; acc[0] = (f32x4){0.f, 0.f, 0.f, 0.f}; acc[1] = acc[0];
#pragma unroll 4
        for (int ks = 0; ks < 16; ++ks) {
            const bf16x8 af = *(const bf16x8*)(Ab + 32 * ks);
            acc[0] = MFMA16(af, *(const bf16x8*)(Wb + 32 * ks), acc[0]);
            if (nct == 2) acc[1] = MFMA16(af, *(const bf16x8*)(Wb + (size_t)16 * D + 32 * ks), acc[1]);
        }
#pragma unroll
        for (int ct = 0; ct < 2; ++ct)
#pragma unroll
            for (int r = 0; r < 4; ++r) lgt[(kh * 64 + 16 * rt + 4 * fq + r) * 32 + 16 * ct + fr] = acc[ct][r];
        __syncthreads();
        if (nk == 1) {
#pragma unroll
            for (int i = 0; i < 4; ++i) { const int idx = tid + i * NTHR; const int row = idx >> 5, o = idx & 31;
                WS_(p, DT)[(size_t)(bid * 64 + row) * 32 + o] = softplusf_(lgt[row * 32 + o] + lgt[(64 + row) * 32 + o] + p.mb_dt_bias[nj * 32 + o]); }
        } else {
            const int row = tid >> 3, c0 = (tid & 7) * 64; float lr[16];
#pragma unroll
            for (int o = 0; o < 16; ++o) lr[o] = lgt[row * 32 + o] + lgt[(64 + row) * 32 + o];
#pragma unroll 1
            for (int c4 = 0; c4 < 16; ++c4) { const int c = c0 + 4 * c4; f32x4 a = *(const f32x4*)(p.gl_gk_b + nj * 512 + c);
#pragma unroll
                for (int o = 0; o < 16; ++o) { const f32x4 wv = *(const LAS f32x4*)(w2 + o * 512 + c); a = a + wv * lr[o]; }
                f32x4 r;
#pragma unroll
                for (int e = 0; e < 4; ++e) r[e] = (fminf(a[e], 0.f) - __logf(1.0f + __expf(-fabsf(a[e])))) * (1.0f / 16.0f);
                *(f32x4*)(WS_(p, LA) + (size_t)(bid * 64 + row) * 512 + c) = r; }
        }
    }
}
constexpr int MB_PROJ = 5152;
struct SchedMbIn {
    const Params* p;
    DEV bool next(int i, Unit& u) const {
        int pm, pn; if (!pg8::tile_order(i, NB_, bid_(), 64, 20, pm, pn)) return false;
        u.A = (const char*)(WS_(*p, Hb) + (size_t)pm * 256 * D); u.B = (const char*)(WS_(*p, mb_win_t) + (size_t)pn * 256 * D); u.row0 = pm * 256; u.col0 = pn * 256; u.id = 0; u.aux = 0; return true;
    }
};
struct EpiMbIn {
    const Params* p;
    DEV void operator()(const AccT& acc, const Unit& u, int wr, int wc, int fr, int fq) const {
        const bool isz = u.col0 < 2048; bf16_t* O = WS_(*p, Z) + (isz ? (size_t)0 : (size_t)T * 2048 - 2048); const int ld = isz ? 2048 : 3072;
        FOR_ACC(ai, bj, m, n) { st_bf4(O + (size_t)ACC_ROW(u, ai, m) * ld + ACC_COL(u, bj, n), acc[ai][bj][m][n]); ACC_FENCE; }
    }
};
DEV void phase_mb_conv(const Params& p, int j) {
    const int tid = tid_(), bid = bid_(); (void)tid; (void)bid;
    if (tid >= 384) return;
    const int c0 = tid * 8; const int t0 = bid * 64;
    const float* cw = p.mb_conv_w + (size_t)j * 4 * 3072; const float* cb = p.mb_conv_b + (size_t)j * 3072;
    float w[4][8], b[8];
#pragma unroll
    for (int i = 0; i < 4; ++i) { const f32x4 a = *(const f32x4*)(cw + i * 3072 + c0), bb = *(const f32x4*)(cw + i * 3072 + c0 + 4); for (int e = 0; e < 4; ++e) { w[i][e] = a[e]; w[i][4 + e] = bb[e]; } }
    { const f32x4 a = *(const f32x4*)(cb + c0), bb = *(const f32x4*)(cb + c0 + 4); for (int e = 0; e < 4; ++e) { b[e] = a[e]; b[4 + e] = bb[e]; } }
    float x0[8], x1[8], x2[8], x3[8];
    auto ld = [&](int t, float (&x)[8]) {
        if (t < 0) { for (int e = 0; e < 8; ++e) x[e] = 0.f; return; }
        const u32x4 v = *(const u32x4*)(WS_(p, XBC) + (size_t)t * 3072 + c0);
        x[0] = bflo(v.x); x[1] = bfhi(v.x); x[2] = bflo(v.y); x[3] = bfhi(v.y); x[4] = bflo(v.z); x[5] = bfhi(v.z); x[6] = bflo(v.w); x[7] = bfhi(v.w);
    };
    ld(t0 - 3, x0); ld(t0 - 2, x1); ld(t0 - 1, x2);
#pragma unroll 4
    for (int tt = 0; tt < 64; ++tt) {
        ld(t0 + tt, x3);
        float o[8];
#pragma unroll
        for (int e = 0; e < 8; ++e) o[e] = siluf_(b[e] + w[0][e] * x0[e] + w[1][e] * x1[e] + w[2][e] * x2[e] + w[3][e] * x3[e]);
        u32x4 r; r.x = pk2(o[0], o[1]); r.y = pk2(o[2], o[3]); r.z = pk2(o[4], o[5]); r.w = pk2(o[6], o[7]);
        *(u32x4*)(WS_(p, XC) + (size_t)(t0 + tt) * 3072 + c0) = r;
#pragma unroll
        for (int e = 0; e < 8; ++e) { x0[e] = x1[e]; x1[e] = x2[e]; x2[e] = x3[e]; }
    }
}

DEV void mb_dacs(const Params& p, int j, int c, int g, LAS float* dts, LAS float* dacs) {
    const int tid = tid_(); const int lane = tid & 63, h = tid >> 6;
    const int hh = 8 * g + h; const float a = -__expf(p.mb_a_log[j * 32 + hh]);
    const float d0 = WS_(p, DT)[(size_t)(c * 128 + 2 * lane) * 32 + hh], d1 = WS_(p, DT)[(size_t)(c * 128 + 2 * lane + 1) * 32 + hh];
    const float a0 = d0 * a, a1 = d1 * a;
    float s = a0 + a1;
#pragma unroll
    for (int o = 1; o < 64; o <<= 1) { const float v = __shfl_up(s, o); if (lane >= o) s += v; }
    dts[h * 128 + 2 * lane] = d0; dts[h * 128 + 2 * lane + 1] = d1;
    dacs[h * 128 + 2 * lane] = s - a1; dacs[h * 128 + 2 * lane + 1] = s;
}
constexpr int LDB = 136;
constexpr int LDX = 72;
DEV void ld_tile128(const bf16_t* src, int gld, LAS bf16_t* dst) {
    const int tid = tid_();
    for (int i = tid; i < 128 * 16; i += NTHR) { const int r = i >> 4, c8 = (i & 15) * 8; *(LAS u32x4*)(dst + r * LDB + c8) = *(const u32x4*)(src + (size_t)r * gld + c8); }
}

DEV void phase_mb_states(const Params& p, int j, LAS unsigned char* lds) {
    const int tid = tid_(), bid = bid_(); (void)tid; (void)bid;
    const int lane = tid & 63, w = tid >> 6;
    LAS bf16_t* Bm = (LAS bf16_t*)lds;
    LAS bf16_t* Xh = Bm + 128 * LDB;
    LAS float* dts = (LAS float*)(Xh + 128 * LDX);
    LAS float* dacs = dts + 1024;
    for (int u = bid; u < 512; u += NB_) {
        const int c = u >> 2, g = u & 3; const int t0 = c * 128;
        lds_barrier();
        mb_dacs(p, j, c, g, dts, dacs);
        ld_tile128(WS_(p, XC) + (size_t)t0 * 3072 + 2048 + 128 * g, 3072, Bm);
        lds_barrier();
        if (tid < 8) WS_(p, CD)[(c * 32) + 8 * g + tid] = __expf(dacs[tid * 128 + 127]);
        bf16x8 bfr[4];
#pragma unroll
        for (int ks = 0; ks < 4; ++ks) bfr[ks] = frag_tr(Bm, LDB, 32 * ks, 16 * w, lane);
        for (int h = 0; h < 8; ++h) {
            { const int l = tid >> 2, p0 = (tid & 3) * 16; const float sc = dts[h * 128 + l] * __expf(dacs[h * 128 + 127] - dacs[h * 128 + l]);
              const bf16_t* src = WS_(p, XC) + (size_t)(t0 + l) * 3072 + 64 * (8 * g + h) + p0;
#pragma unroll
              for (int hf = 0; hf < 2; ++hf) { const u32x4 v = *(const u32x4*)(src + 8 * hf); u32x4 r;
                  r.x = pk2(bflo(v.x) * sc, bfhi(v.x) * sc); r.y = pk2(bflo(v.y) * sc, bfhi(v.y) * sc); r.z = pk2(bflo(v.z) * sc, bfhi(v.z) * sc); r.w = pk2(bflo(v.w) * sc, bfhi(v.w) * sc);
                  *(LAS u32x4*)(Xh + l * LDX + p0 + 8 * hf) = r; } }
            lds_barrier();
            f32x4 acc[4];
#pragma unroll
            for (int pb = 0; pb < 4; ++pb) { acc[pb] = (f32x4){0.f, 0.f, 0.f, 0.f};
#pragma unroll
                for (int ks = 0; ks < 4; ++ks) { const bf16x8 af = frag_tr(Xh, LDX, 32 * ks, 16 * pb, lane); acc[pb] = MFMA16(af, bfr[ks], acc[pb]); } }
            bf16_t* S = WS_(p, STATES) + (((size_t)c * 32 + 8 * g + h) * 64) * 128;
#pragma unroll
            for (int pb = 0; pb < 4; ++pb)
#pragma unroll
                for (int r = 0; r < 4; ++r) S[(size_t)(16 * pb + 4 * (lane >> 4) + r) * 128 + 16 * w + (lane & 15)] = (bf16_t)f2bf(acc[pb][r]);
            lds_barrier();
        }
    }
}
DEV void phase_mb_scan(const Params& p) {
    const int tid = tid_(), bid = bid_();
    if (tid >= 128) return;
    const int gid = bid * 128 + tid;
    const int n8 = gid & 15, pp = (gid >> 4) & 63, h = gid >> 10; const int n = 8 * n8;
    float r[8]; for (int e = 0; e < 8; ++e) r[e] = 0.f;
    const size_t eo = ((size_t)h * 64 + pp) * 128 + n;
    const size_t fo = (size_t)h * 64 * 128 + fragmajor_off(pp, n, 128);
#pragma unroll 8
    for (int c = 0; c < 128; ++c) {
        const u32x4 sr = *(const u32x4*)(WS_(p, STATES) + (size_t)c * 32 * 64 * 128 + eo);
        const float cd = WS_(p, CD)[c * 32 + h];
        u32x4 o; o.x = pk2(r[0], r[1]); o.y = pk2(r[2], r[3]); o.z = pk2(r[4], r[5]); o.w = pk2(r[6], r[7]);
        *(u32x4*)(WS_(p, PREV) + (size_t)c * 32 * 64 * 128 + fo) = o;
        r[0] = r[0] * cd + bflo(sr.x); r[1] = r[1] * cd + bfhi(sr.x); r[2] = r[2] * cd + bflo(sr.y); r[3] = r[3] * cd + bfhi(sr.y);
        r[4] = r[4] * cd + bflo(sr.z); r[5] = r[5] * cd + bfhi(sr.z); r[6] = r[6] * cd + bflo(sr.w); r[7] = r[7] * cd + bfhi(sr.w);
    }
}
DEV void phase_mb_out(const Params& p, int j, LAS unsigned char* lds) {
    const int tid = tid_(), bid = bid_(); (void)tid; (void)bid;
    const int lane = tid & 63, w = tid >> 6; const int fr = lane & 15, fq = lane >> 4;
    LAS bf16_t* Cm = (LAS bf16_t*)lds;
    LAS bf16_t* Bm = Cm + 128 * LDB;
    LAS bf16_t* Xh = Bm + 128 * LDB;
    LAS bf16_t* Mw = Xh + 128 * LDX;
    LAS float* dts = (LAS float*)(Mw + 8 * 16 * LDB);
    LAS float* dacs = dts + 1024;
    LAS bf16_t* Mme = Mw + w * 16 * LDB;
    for (int u = bid; u < 512; u += NB_) {
        const int c = u >> 2, g = u & 3; const int t0 = c * 128;
        lds_barrier();
        mb_dacs(p, j, c, g, dts, dacs);
        ld_tile128(WS_(p, XC) + (size_t)t0 * 3072 + 2048 + 512 + 128 * g, 3072, Cm);
        ld_tile128(WS_(p, XC) + (size_t)t0 * 3072 + 2048 + 128 * g, 3072, Bm);
        lds_barrier();
        f32x4 sc[8]; bf16x8 cf[4];
#pragma unroll
        for (int ks = 0; ks < 4; ++ks) cf[ks] = frag_rm(Cm, LDB, 16 * w, 32 * ks, lane);
#pragma unroll
        for (int sb = 0; sb < 8; ++sb) { sc[sb] = (f32x4){0.f, 0.f, 0.f, 0.f};
#pragma unroll
            for (int ks = 0; ks < 4; ++ks) sc[sb] = MFMA16(cf[ks], frag_rm(Bm, LDB, 16 * sb, 32 * ks, lane), sc[sb]); }
        float ssq = 0.f;
        const int rl = tid >> 2, p0 = (tid & 3) * 16;
        const LAS float* Yrow = (const LAS float*)(Mw + (rl >> 4) * 16 * LDB) + (rl & 15) * 68 + p0;
        LAS float* Yw = (LAS float*)Mme;
        u32x4 xraw[2], zraw[2], xnx[2], znx[2]; bf16x8 pfc[16];
#define MB_LOADH(HH, XR, ZR) do { const int hh_ = 8 * g + (HH); \
            XR[0] = *(const u32x4*)(WS_(p, XC) + (size_t)(t0 + rl) * 3072 + 64 * hh_ + p0); XR[1] = *(const u32x4*)(WS_(p, XC) + (size_t)(t0 + rl) * 3072 + 64 * hh_ + p0 + 8); \
            ZR[0] = *(const u32x4*)(WS_(p, Z) + (size_t)(t0 + rl) * 2048 + 64 * hh_ + p0); ZR[1] = *(const u32x4*)(WS_(p, Z) + (size_t)(t0 + rl) * 2048 + 64 * hh_ + p0 + 8); } while (0)
        MB_LOADH(0, xraw, zraw);
#pragma unroll 1
        for (int h = 0; h < 8; ++h) {
            const int hh = 8 * g + h;
            MB_LOADH(h < 7 ? h + 1 : h, xnx, znx);
            { const bf16_t* pv_ = WS_(p, PREV) + ((size_t)c * 32 + hh) * 64 * 128;
#pragma unroll
              for (int i_ = 0; i_ < 16; ++i_) pfc[i_] = *(const bf16x8*)(pv_ + ((size_t)i_ * 64 + lane) * 8); }
            { const float scl = dts[h * 128 + rl];
#pragma unroll
              for (int hf = 0; hf < 2; ++hf) { const u32x4 v = xraw[hf]; u32x4 r;
                  r.x = pk2(bflo(v.x) * scl, bfhi(v.x) * scl); r.y = pk2(bflo(v.y) * scl, bfhi(v.y) * scl); r.z = pk2(bflo(v.z) * scl, bfhi(v.z) * scl); r.w = pk2(bflo(v.w) * scl, bfhi(v.w) * scl);
                  *(LAS u32x4*)(Xh + rl * LDX + p0 + 8 * hf) = r; } }
            const u32x4 zraw0 = zraw[0], zraw1 = zraw[1];
            float dl[4];
#pragma unroll
            for (int r = 0; r < 4; ++r) dl[r] = dacs[h * 128 + 16 * w + 4 * fq + r];
#pragma unroll
            for (int sb = 0; sb < 8; ++sb) { const int s_ = 16 * sb + fr; const float ds = dacs[h * 128 + s_];
#pragma unroll
                for (int r = 0; r < 4; ++r) { const int l = 16 * w + 4 * fq + r; const float m = (s_ <= l) ? sc[sb][r] * __expf(dl[r] - ds) : 0.f; Mme[(4 * fq + r) * LDB + s_] = (bf16_t)f2bf(m); } }
            lds_barrier();
            bf16x8 mf[4];
#pragma unroll
            for (int ks = 0; ks < 4; ++ks) mf[ks] = frag_rm(Mme, LDB, 0, 32 * ks, lane);
            f32x4 yv[4];
#pragma unroll
            for (int pb = 0; pb < 4; ++pb) {
                f32x4 a = {0.f, 0.f, 0.f, 0.f}, o = {0.f, 0.f, 0.f, 0.f};
#pragma unroll
                for (int ks = 0; ks < 4; ++ks) {
                    a = MFMA16(mf[ks], frag_tr(Xh, LDX, 32 * ks, 16 * pb, lane), a);
                    o = MFMA16(cf[ks], pfc[pb * 4 + ks], o);
                }
#pragma unroll
                for (int r = 0; r < 4; ++r) a[r] += o[r] * __expf(dl[r]);
                yv[pb] = a;
            }
#pragma unroll
            for (int pb = 0; pb < 4; ++pb)
#pragma unroll
                for (int r = 0; r < 4; ++r) Yw[(4 * fq + r) * 68 + 16 * pb + fr] = yv[pb][r];
            lds_barrier();
            {
                const float dsk = p.mb_d[j * 32 + hh]; const float* ng = p.mb_norm_g + (size_t)j * 2048 + 64 * hh + p0;
                float y[16], xs[16], zz[16];
#pragma unroll
                for (int q = 0; q < 4; ++q) { const f32x4 t4 = *(const LAS f32x4*)(Yrow + 4 * q); y[4 * q] = t4[0]; y[4 * q + 1] = t4[1]; y[4 * q + 2] = t4[2]; y[4 * q + 3] = t4[3]; }
                xs[0] = bflo(xraw[0].x); xs[1] = bfhi(xraw[0].x); xs[2] = bflo(xraw[0].y); xs[3] = bfhi(xraw[0].y); xs[4] = bflo(xraw[0].z); xs[5] = bfhi(xraw[0].z); xs[6] = bflo(xraw[0].w); xs[7] = bfhi(xraw[0].w);
                xs[8] = bflo(xraw[1].x); xs[9] = bfhi(xraw[1].x); xs[10] = bflo(xraw[1].y); xs[11] = bfhi(xraw[1].y); xs[12] = bflo(xraw[1].z); xs[13] = bfhi(xraw[1].z); xs[14] = bflo(xraw[1].w); xs[15] = bfhi(xraw[1].w);
                zz[0] = bflo(zraw0.x); zz[1] = bfhi(zraw0.x); zz[2] = bflo(zraw0.y); zz[3] = bfhi(zraw0.y); zz[4] = bflo(zraw0.z); zz[5] = bfhi(zraw0.z); zz[6] = bflo(zraw0.w); zz[7] = bfhi(zraw0.w);
                zz[8] = bflo(zraw1.x); zz[9] = bfhi(zraw1.x); zz[10] = bflo(zraw1.y); zz[11] = bfhi(zraw1.y); zz[12] = bflo(zraw1.z); zz[13] = bfhi(zraw1.z); zz[14] = bflo(zraw1.w); zz[15] = bfhi(zraw1.w);
                float o[16];
#pragma unroll
                for (int q = 0; q < 4; ++q) { const f32x4 n4 = *(const f32x4*)(ng + 4 * q);
#pragma unroll
                    for (int e = 0; e < 4; ++e) { const int i = 4 * q + e; const float v = (y[i] + xs[i] * dsk) * siluf_(zz[i]); ssq += v * v; o[i] = v * n4[e]; } }
                bf16_t* dst = WS_(p, YB) + (size_t)(t0 + rl) * 2048 + 64 * hh + p0;
                u32x4 w0, w1; w0.x = pk2(o[0], o[1]); w0.y = pk2(o[2], o[3]); w0.z = pk2(o[4], o[5]); w0.w = pk2(o[6], o[7]); w1.x = pk2(o[8], o[9]); w1.y = pk2(o[10], o[11]); w1.z = pk2(o[12], o[13]); w1.w = pk2(o[14], o[15]);
                *(u32x4*)dst = w0; *(u32x4*)(dst + 8) = w1;
            }
            xraw[0] = xnx[0]; xraw[1] = xnx[1]; zraw[0] = znx[0]; zraw[1] = znx[1];
            lds_barrier();
        }
#undef MB_LOADH
        ssq += __shfl_xor(ssq, 1); ssq += __shfl_xor(ssq, 2);
        const float rstd = rsqrtf(ssq * (1.0f / 512.0f) + 1e-5f);
#pragma unroll 1
        for (int h = 0; h < 8; ++h) {
            bf16_t* dst = WS_(p, YB) + (size_t)(t0 + rl) * 2048 + 64 * (8 * g + h) + p0;
#pragma unroll
            for (int hf = 0; hf < 2; ++hf) { const u32x4 v = *(const u32x4*)(dst + 8 * hf); u32x4 r;
                r.x = pk2(bflo(v.x) * rstd, bfhi(v.x) * rstd); r.y = pk2(bflo(v.y) * rstd, bfhi(v.y) * rstd); r.z = pk2(bflo(v.z) * rstd, bfhi(v.z) * rstd); r.w = pk2(bflo(v.w) * rstd, bfhi(v.w) * rstd);
                *(u32x4*)(dst + 8 * hf) = r; }
        }
    }
}
constexpr int GL_PROJ = 3088;
constexpr int LDV = 264;
struct SchedGlIn {
    const Params* p;
    DEV bool next(int i, Unit& u) const {
        int pm, pn; if (!pg8::tile_order(i, NB_, bid_(), 64, 12, pm, pn)) return false;
        u.A = (const char*)(WS_(*p, Hb) + (size_t)pm * 256 * D); u.B = (const char*)(WS_(*p, gl_win_t) + (size_t)pn * 256 * D); u.row0 = pm * 256; u.col0 = pn * 256; u.id = 0; u.aux = 0; return true;
    }
};
struct EpiGlIn {
    const Params* p;
    DEV void operator()(const AccT& acc, const Unit& u, int wr, int wc, int fr, int fq) const {
        FOR_ACC(ai, bj, m, n) { st_bf4(WS_(*p, QKVG) + (size_t)ACC_ROW(u, ai, m) * 3072 + ACC_COL(u, bj, n), acc[ai][bj][m][n]); ACC_FENCE; }
    }
};
DEV void gl_bcs(const Params& p, int n, int h, LAS float* bcs) {
    const int tid = tid_();
    for (int i = tid; i < 64 * 32; i += NTHR) { const int r = i >> 5, c4 = (i & 31) * 4; *(LAS f32x4*)(bcs + r * 128 + c4) = *(const f32x4*)(WS_(p, LA) + (size_t)(n * 64 + r) * 512 + 128 * h + c4); }
    lds_barrier();
    if (tid < 128) { float s = 0.f; for (int r = 0; r < 64; ++r) { s += bcs[r * 128 + tid]; bcs[r * 128 + tid] = s; } }
    lds_barrier();
}
DEV void phase_gl_kv(const Params& p, LAS unsigned char* lds) {
    const int tid = tid_(), bid = bid_(); (void)tid; (void)bid;
    const int lane = tid & 63, w = tid >> 6;
    LAS float* bcs = (LAS float*)lds;
    LAS bf16_t* Ke = (LAS bf16_t*)(bcs + 64 * 128);
    LAS bf16_t* Vs = Ke + 64 * LDB;
    for (int u = bid; u < 1024; u += NB_) {
        const int n = u >> 2, h = u & 3; const int t0 = n * 64;
        lds_barrier();
        gl_bcs(p, n, h, bcs);
        for (int i = tid; i < 64 * 16; i += NTHR) { const int r = i >> 4, c8 = (i & 15) * 8;
            const u32x4 v = *(const u32x4*)(WS_(p, QKVG) + (size_t)(t0 + r) * 3072 + 512 + 128 * h + c8); float f[8];
            f[0] = bflo(v.x); f[1] = bfhi(v.x); f[2] = bflo(v.y); f[3] = bfhi(v.y); f[4] = bflo(v.z); f[5] = bfhi(v.z); f[6] = bflo(v.w); f[7] = bfhi(v.w);
#pragma unroll
            for (int e = 0; e < 8; ++e) f[e] *= __expf(bcs[63 * 128 + c8 + e] - bcs[r * 128 + c8 + e]);
            u32x4 o; o.x = pk2(f[0], f[1]); o.y = pk2(f[2], f[3]); o.z = pk2(f[4], f[5]); o.w = pk2(f[6], f[7]);
            *(LAS u32x4*)(Ke + r * LDB + c8) = o; }
        for (int i = tid; i < 64 * 32; i += NTHR) { const int r = i >> 5, c8 = (i & 31) * 8; *(LAS u32x4*)(Vs + r * LDV + c8) = *(const u32x4*)(WS_(p, QKVG) + (size_t)(t0 + r) * 3072 + 1024 + 256 * h + c8); }
        if (tid < 128) WS_(p, CDG)[((size_t)n * 4 + h) * 128 + tid] = __expf(bcs[63 * 128 + tid]);
        lds_barrier();
        bf16x8 af[2];
#pragma unroll
        for (int ks = 0; ks < 2; ++ks) af[ks] = frag_tr(Ke, LDB, 32 * ks, 16 * w, lane);
        bf16_t* O = WS_(p, STATES) + (((size_t)n * 4 + h) * 128) * 256;
#pragma unroll
        for (int vb = 0; vb < 16; ++vb) {
            f32x4 acc = {0.f, 0.f, 0.f, 0.f};
#pragma unroll
            for (int ks = 0; ks < 2; ++ks) acc = MFMA16(af[ks], frag_tr(Vs, LDV, 32 * ks, 16 * vb, lane), acc);
            { u32x2 o; o.x = pk2(acc[0], acc[1]); o.y = pk2(acc[2], acc[3]); *(u32x2*)(O + (size_t)(16 * vb + (lane & 15)) * 128 + 16 * w + 4 * (lane >> 4)) = o; }
        }
    }
}
DEV void phase_gl_scan(const Params& p) {
    const int tid = tid_(), bid = bid_();
    if (tid >= 64) return;
    const int gid = bid * 64 + tid;
    const int k8 = gid & 15, v = (gid >> 4) & 255, h = gid >> 12; const int k = 8 * k8;
    float r[8]; for (int e = 0; e < 8; ++e) r[e] = 0.f;
    const size_t fo = (size_t)h * 128 * 256 + fragmajor_off(v, k, 128);
#pragma unroll 8
    for (int n = 0; n < 256; ++n) {
        const u32x4 sr = *(const u32x4*)(WS_(p, STATES) + (((size_t)n * 4 + h) * 256 + v) * 128 + k);
        const f32x4 c0 = *(const f32x4*)(WS_(p, CDG) + ((size_t)n * 4 + h) * 128 + k), c1 = *(const f32x4*)(WS_(p, CDG) + ((size_t)n * 4 + h) * 128 + k + 4);
        u32x4 o; o.x = pk2(r[0], r[1]); o.y = pk2(r[2], r[3]); o.z = pk2(r[4], r[5]); o.w = pk2(r[6], r[7]);
        *(u32x4*)(WS_(p, PREV) + (size_t)n * 4 * 128 * 256 + fo) = o;
        r[0] = r[0] * c0[0] + bflo(sr.x); r[1] = r[1] * c0[1] + bfhi(sr.x); r[2] = r[2] * c0[2] + bflo(sr.y); r[3] = r[3] * c0[3] + bfhi(sr.y);
        r[4] = r[4] * c1[0] + bflo(sr.z); r[5] = r[5] * c1[1] + bfhi(sr.z); r[6] = r[6] * c1[2] + bflo(sr.w); r[7] = r[7] * c1[3] + bfhi(sr.w);
    }
}
DEV void phase_gl_out(const Params& p, int j, LAS unsigned char* lds) {
    const int tid = tid_(), bid = bid_(); (void)tid; (void)bid;
    const int lane = tid & 63, w = tid >> 6; const int fr = lane & 15, fq = lane >> 4;
    LAS float* bcs = (LAS float*)lds;
    LAS bf16_t* Qs = (LAS bf16_t*)(bcs + 64 * 128);
    LAS bf16_t* Ks = Qs + 64 * LDB;
    LAS bf16_t* Vs = Ks + 64 * LDB;
    LAS bf16_t* At = Vs + 64 * LDV;
    LAS float* red = (LAS float*)(At + 64 * LDX);
    for (int u = bid; u < 1024; u += NB_) {
        const int n = u >> 2, h = u & 3; const int t0 = n * 64;
        lds_barrier();
        gl_bcs(p, n, h, bcs);
        for (int i = tid; i < 64 * 16; i += NTHR) { const int r = i >> 4, c8 = (i & 15) * 8;
            const u32x4 vq = *(const u32x4*)(WS_(p, QKVG) + (size_t)(t0 + r) * 3072 + 128 * h + c8), vk = *(const u32x4*)(WS_(p, QKVG) + (size_t)(t0 + r) * 3072 + 512 + 128 * h + c8);
            float fq_[8], fk_[8];
            fq_[0] = bflo(vq.x); fq_[1] = bfhi(vq.x); fq_[2] = bflo(vq.y); fq_[3] = bfhi(vq.y); fq_[4] = bflo(vq.z); fq_[5] = bfhi(vq.z); fq_[6] = bflo(vq.w); fq_[7] = bfhi(vq.w);
            fk_[0] = bflo(vk.x); fk_[1] = bfhi(vk.x); fk_[2] = bflo(vk.y); fk_[3] = bfhi(vk.y); fk_[4] = bflo(vk.z); fk_[5] = bfhi(vk.z); fk_[6] = bflo(vk.w); fk_[7] = bfhi(vk.w);
#pragma unroll
            for (int e = 0; e < 8; ++e) { const float b = bcs[r * 128 + c8 + e]; fq_[e] *= __expf(b) * 0.08838834764831845f; fk_[e] *= __expf(-b); }
            u32x4 o; o.x = pk2(fq_[0], fq_[1]); o.y = pk2(fq_[2], fq_[3]); o.z = pk2(fq_[4], fq_[5]); o.w = pk2(fq_[6], fq_[7]);
            *(LAS u32x4*)(Qs + r * LDB + c8) = o;
            o.x = pk2(fk_[0], fk_[1]); o.y = pk2(fk_[2], fk_[3]); o.z = pk2(fk_[4], fk_[5]); o.w = pk2(fk_[6], fk_[7]);
            *(LAS u32x4*)(Ks + r * LDB + c8) = o; }
        for (int i = tid; i < 64 * 32; i += NTHR) { const int r = i >> 5, c8 = (i & 31) * 8; *(LAS u32x4*)(Vs + r * LDV + c8) = *(const u32x4*)(WS_(p, QKVG) + (size_t)(t0 + r) * 3072 + 1024 + 256 * h + c8); }
        lds_barrier();
        { const int ib = w >> 1;
#pragma unroll
          for (int jj = 0; jj < 2; ++jj) { const int jb = 2 * (w & 1) + jj; f32x4 a = {0.f, 0.f, 0.f, 0.f};
#pragma unroll
              for (int ks = 0; ks < 4; ++ks) a = MFMA16(frag_rm(Qs, LDB, 16 * ib, 32 * ks, lane), frag_rm(Ks, LDB, 16 * jb, 32 * ks, lane), a);
#pragma unroll
              for (int r = 0; r < 4; ++r) { const int i = 16 * ib + 4 * fq + r, jx = 16 * jb + fr; At[i * LDX + jx] = (bf16_t)f2bf(jx <= i ? a[r] : 0.f); } } }
        lds_barrier();
        f32x4 o[4][2];
        const bf16_t* pv = WS_(p, PREV) + ((size_t)n * 4 + h) * 128 * 256;
#pragma unroll
        for (int vv = 0; vv < 2; ++vv) { const int vb = 2 * w + vv;
            bf16x8 bi[2], bp[4];
#pragma unroll
            for (int ks = 0; ks < 2; ++ks) bi[ks] = frag_tr(Vs, LDV, 32 * ks, 16 * vb, lane);
#pragma unroll
            for (int ks = 0; ks < 4; ++ks) bp[ks] = *(const bf16x8*)(pv + ((size_t)(vb * 4 + ks) * 64 + lane) * 8);
#pragma unroll
            for (int ib = 0; ib < 4; ++ib) { f32x4 a = {0.f, 0.f, 0.f, 0.f};
#pragma unroll
                for (int ks = 0; ks < 2; ++ks) a = MFMA16(frag_rm(At, LDX, 16 * ib, 32 * ks, lane), bi[ks], a);
#pragma unroll
                for (int ks = 0; ks < 4; ++ks) a = MFMA16(frag_rm(Qs, LDB, 16 * ib, 32 * ks, lane), bp[ks], a);
                o[ib][vv] = a; } }
#pragma unroll
        for (int ib = 0; ib < 4; ++ib)
#pragma unroll
            for (int r = 0; r < 4; ++r) { float s = o[ib][0][r] * o[ib][0][r] + o[ib][1][r] * o[ib][1][r]; s = sum16(s); if (fr == 0) red[w * 64 + 16 * ib + 4 * fq + r] = s; }
        lds_barrier();
        {   LAS bf16_t* Os = (LAS bf16_t*)bcs;
#pragma unroll
            for (int ib = 0; ib < 4; ++ib)
#pragma unroll
                for (int vv = 0; vv < 2; ++vv)
#pragma unroll
                    for (int r = 0; r < 4; ++r) Os[(16 * ib + 4 * fq + r) * LDV + 32 * w + 16 * vv + fr] = (bf16_t)f2bf(o[ib][vv][r]);
            lds_barrier();
            const int row = tid >> 3, c0 = (tid & 7) * 32; const int t = t0 + row; float s = 0.f;
#pragma unroll
            for (int ww = 0; ww < 8; ++ww) s += red[ww * 64 + row];
            const float rs = rsqrtf(s * (1.0f / 256.0f) + 1e-5f);
#pragma unroll
            for (int q = 0; q < 4; ++q) {
                const u32x4 ov = *(const LAS u32x4*)(Os + row * LDV + c0 + 8 * q), gv = *(const u32x4*)(WS_(p, QKVG) + (size_t)t * 3072 + 2048 + 256 * h + c0 + 8 * q);
                const f32x4 n0 = *(const f32x4*)(p.gl_norm_g + j * 256 + c0 + 8 * q), n1 = *(const f32x4*)(p.gl_norm_g + j * 256 + c0 + 8 * q + 4);
                float r8[8];
                r8[0] = bflo(ov.x) * rs * n0[0] * siluf_(bflo(gv.x)); r8[1] = bfhi(ov.x) * rs * n0[1] * siluf_(bfhi(gv.x)); r8[2] = bflo(ov.y) * rs * n0[2] * siluf_(bflo(gv.y)); r8[3] = bfhi(ov.y) * rs * n0[3] * siluf_(bfhi(gv.y));
                r8[4] = bflo(ov.z) * rs * n1[0] * siluf_(bflo(gv.z)); r8[5] = bfhi(ov.z) * rs * n1[1] * siluf_(bfhi(gv.z)); r8[6] = bflo(ov.w) * rs * n1[2] * siluf_(bflo(gv.w)); r8[7] = bfhi(ov.w) * rs * n1[3] * siluf_(bfhi(gv.w));
                u32x4 wv; wv.x = pk2(r8[0], r8[1]); wv.y = pk2(r8[2], r8[3]); wv.z = pk2(r8[4], r8[5]); wv.w = pk2(r8[6], r8[7]);
                *(u32x4*)(WS_(p, YB) + (size_t)t * D + 256 * h + c0 + 8 * q) = wv;
            }
        }
    }
}
#define XB_TMO      128
#define XB_XCNT(j)  (256  + 64 * (j))
#define XB_XSUB(j)  (1280 + 64 * (j))
#define XB_XGEN(j)  (2304 + 64 * (j))
#define XB_TOP      3328
#define XB_TOPGEN   3392
#define XCD_BAR_WORDS 3456
#define XB_SPIN_CAP (1u << 22)
DEV unsigned xb_ld(unsigned* p)              { return __hip_atomic_load(p, __ATOMIC_RELAXED, __HIP_MEMORY_SCOPE_AGENT); }
DEV unsigned xb_add(unsigned* p, unsigned v) { return __hip_atomic_fetch_add(p, v, __ATOMIC_RELAXED, __HIP_MEMORY_SCOPE_AGENT); }
DEV unsigned xb_xcc_id() { return (unsigned)__builtin_amdgcn_s_getreg((3 << 11) | 20) & 0xFu; }
#define XB_SPIN(cond, bar) do { unsigned _sp = 0; while (cond) { __builtin_amdgcn_s_sleep(1); \
    if ((++_sp & 255u) == 0u) { if (xb_ld(&(bar)[XB_TMO])) break; if (_sp > XB_SPIN_CAP) { atomicAdd(&(bar)[XB_TMO], 1u); break; } } } } while (0)
struct XcdBarrier { unsigned* bar; unsigned x; volatile LAS unsigned* st; };
DEV XcdBarrier xcd_barrier_post(unsigned* bar, volatile LAS unsigned* st) {
    XcdBarrier b; b.bar = bar; b.x = xb_xcc_id(); b.st = st;
    if (threadIdx.x == 0) (void)xb_add(&bar[XB_XCNT(b.x)], 1u);
    return b;
}
DEV void xcd_barrier_complete(unsigned* bar, unsigned x, unsigned& nloc, unsigned& nx) {
    const unsigned G = gridDim.x * gridDim.y * gridDim.z;
    unsigned sum, cnt, mine, sp = 0u;
    for (;;) {
        sum = 0u; cnt = 0u; mine = 0u;
#pragma unroll
        for (unsigned j = 0; j < 16; ++j) { const unsigned c = xb_ld(&bar[XB_XCNT(j)]); sum += c; cnt += (c > 0u) ? 1u : 0u; mine = (j == x) ? c : mine; }
        if (sum == G) break;
        __builtin_amdgcn_s_sleep(1);
        if ((++sp & 255u) == 0u) { if (xb_ld(&bar[XB_TMO])) break; if (sp > XB_SPIN_CAP) { atomicAdd(&bar[XB_TMO], 1u); break; } }
    }
    nloc = mine > 0u ? mine : 1u; nx = cnt > 0u ? cnt : 1u;
}
DEV void xcd_barrier(const XcdBarrier& b) {
    asm volatile("s_waitcnt vmcnt(0)" ::: "memory");
    __syncthreads();
    if (threadIdx.x == 0) {
        unsigned* bar = b.bar;
        __builtin_amdgcn_s_waitcnt(0);
        unsigned nloc = b.st[0], nx = b.st[1];
        if (nloc == 0u) { xcd_barrier_complete(bar, b.x, nloc, nx); b.st[0] = nloc; b.st[1] = nx; }
        const unsigned old = xb_add(&bar[XB_XSUB(b.x)], 1u);
        const unsigned gen = old / nloc;
        if (old + 1u == (gen + 1u) * nloc) {
            __builtin_amdgcn_fence(__ATOMIC_RELEASE, "agent");
            asm volatile("s_waitcnt vmcnt(0)" ::: "memory");
            const unsigned og = xb_add(&bar[XB_TOP], 1u);
            const unsigned tg = og / nx;
            if (og + 1u == (tg + 1u) * nx) xb_add(&bar[XB_TOPGEN], 1u);
            else XB_SPIN(xb_ld(&bar[XB_TOPGEN]) == tg, bar);
            __builtin_amdgcn_fence(__ATOMIC_ACQUIRE, "agent");
            xb_add(&bar[XB_XGEN(b.x)], 1u);
            asm volatile("s_waitcnt vmcnt(0)" ::: "memory");
        } else {
            XB_SPIN(xb_ld(&bar[XB_XGEN(b.x)]) == gen, bar);
            __builtin_amdgcn_fence(__ATOMIC_ACQUIRE, "agent");
            asm volatile("s_waitcnt vmcnt(0)" ::: "memory");
        }
    }
    __syncthreads();
}

DEV void moe_tail_convert(const Params& p, LAS unsigned char* lds, const LAS int* tab, int layer, int which) {
    if (layer != 1 && layer != 2) return;
    const int total = tab[33] * 4, rem = total % NB_;
    const int B0 = rem, NBW = NB_ - rem;
    if (bid_() >= B0) { const ConvJob J = moe_job(p, which, layer + 1); convert_one(J, lds, B0, NBW, 0); }
}
DEV LAS int* moe_tab_to_lds(const Params& p, LAS unsigned char* lds) {
    LAS int* tab = (LAS int*)(lds + pg8::STAGE_BYTES);
    const int tid = tid_();
    if (tid < 256) tab[tid] = __hip_atomic_load(WS_(p, TAB) + tid, __ATOMIC_RELAXED, __HIP_MEMORY_SCOPE_AGENT);
    __syncthreads();
    return tab;
}
DEV void run_phase(const Params& pin, int op, int arg, LAS unsigned char* lds) {
    Params p = pin; { size_t z_ = 0; asm volatile("" : "+s"(z_)); p.ws = pin.ws + z_; }
    const int layer = arg; const int jj = layer / 3;
#ifdef ONLY_OP
    if (op != ONLY_OP) return;
#endif
#ifdef OPMASK
    if (!((OPMASK >> op) & 1ull)) return;
#endif
    switch (op) {
    case OP_CONVERT: phase_pre0(p); phase_convert(p, lds);
#ifdef DBG
        if (blockIdx.x == 0 && threadIdx.x < 24) WS_(p, TAB)[200 + threadIdx.x] = 0;
#endif
        break;
    case OP_PRE0: break;
    case OP_RW_GEMM1: { SchedRW1 S{&p, jj}; EpiRW1 E{&p}; pg8::gemm_phase(lds, 1024, S, E); } break;
    case OP_RW_GEMM2: { SchedRW2 S{&p, jj}; EpiRW2 E{&p, jj}; pg8::gemm_phase(lds, 256, S, E); } break;
    case OP_RW_CHA: phase_rw_cha(p, jj, lds); break;
    case OP_RW_CHB: phase_rw_chb(p, layer, lds); break;
    case OP_RW_CHC: phase_rw_chc(p, jj, lds); break;
    case OP_RW_OUT: { SchedOut S{WS_(p, YB), WS_(p, rw_wo_t) + (size_t)jj * D * D, 1024}; EpiOut E{WS_(p, MIXb)}; pg8::gemm_phase(lds, 1024, S, E); } break;
    case OP_LN1: phase_ln1(p, layer, lds); break;
    case OP_MOE_SCATTER: phase_moe_scatter(p, lds); break;
    case OP_MOE_GEMM1: { LAS int* tab = moe_tab_to_lds(p, lds); SchedMoe<0> S{&p, layer, tab}; EpiMoe1 E{WS_(p, ACT)}; pg8::gemm_phase(lds, 1024, S, E); moe_tail_convert(p, lds, tab, layer, 0); } break;
    case OP_MOE_GEMM2: { LAS int* tab = moe_tab_to_lds(p, lds); SchedMoe<1> S{&p, layer, tab}; EpiMoe2 E{WS_(p, YBUF)}; pg8::gemm_phase(lds, 512, S, E); moe_tail_convert(p, lds, tab, layer, 1); } break;
    case OP_LN2: phase_ln2(p, layer, lds); break;
    case OP_MB_GEMM_IN: { SchedMbIn S{&p}; EpiMbIn E{&p}; pg8::gemm_phase(lds, 1024, S, E); } break;
    case OP_MB_CONV: phase_mb_conv(p, jj); break;
    case OP_MB_STATES: phase_mb_states(p, jj, lds); break;
    case OP_MB_SCAN: phase_mb_scan(p); break;
    case OP_MB_OUT: phase_mb_out(p, jj, lds); break;
    case OP_MB_GEMM_OUT: { SchedOut S{WS_(p, YB), WS_(p, mb_wout_t) + (size_t)jj * D * 2048, 2048}; EpiOut E{WS_(p, MIXb)}; pg8::gemm_phase(lds, 2048, S, E); } break;
    case OP_GL_GEMM_IN: { SchedGlIn S{&p}; EpiGlIn E{&p}; pg8::gemm_phase(lds, 1024, S, E); } break;
    case OP_GL_KV: phase_gl_kv(p, lds); break;
    case OP_GL_SCAN: phase_gl_scan(p); break;
    case OP_GL_OUT: phase_gl_out(p, jj, lds); break;
    case OP_GL_GEMM_OUT: { SchedOut S{WS_(p, YB), WS_(p, gl_wout_t) + (size_t)jj * D * D, 1024}; EpiOut E{WS_(p, MIXb)}; pg8::gemm_phase(lds, 1024, S, E); } break;
    default: break;
    }
}

constexpr int NPHASES = 1 + 11 + 11 + 10 + 11;
DEV void decode_phase(int ph, int& op, int& layer) {
    if (ph < 1) { op = OP_CONVERT; layer = 0; return; }
    int q = ph - 1; layer = 0;
    if (q >= 11) { q -= 11; layer = 1; if (q >= 11) { q -= 11; layer = 2; if (q >= 10) { q -= 10; layer = 3; } } }
    const int kind = layer % 3; const int nmix = kind == 2 ? 5 : 6;
    if (q < nmix) op = (kind == 0 ? OP_RW_GEMM1 : kind == 1 ? OP_MB_GEMM_IN : OP_GL_GEMM_IN) + q;
    else op = OP_LN1 + (q - nmix);
}

#define X(t, n) t n##_,
template <bool COOP>
__global__ void __launch_bounds__(NTHR, 2) mega(PARAM_LIST(X) const int ph0, const int ph1) {
#undef X
    Params p;
#define X(t, n) p.n = n##_;
    PARAM_LIST(X)
#undef X

    extern __shared__ __attribute__((aligned(16))) unsigned char smem_raw[];
    LAS unsigned char* lds = (LAS unsigned char*)smem_raw;
    if constexpr (COOP) {
        volatile LAS unsigned* st = (volatile LAS unsigned*)(lds + LDS_BYTES - 16);
        if (threadIdx.x == 0) { st[0] = 0u; st[1] = 0u; }
        __syncthreads();
        XcdBarrier xb = xcd_barrier_post(WS_(p, bar), st);
        if (ph0 < 0) cg::this_grid().sync();
        for (int ph = ph0; ph < ph1; ++ph) {
            int op, arg; decode_phase(ph, op, arg);
#ifdef REPEAT_MASK
            const int reps = 1 + (int)((REPEAT_MASK >> op) & 1ull);
#else
            const int reps = 1;
#endif
#pragma unroll 1
            for (int rep = 0; rep < reps; ++rep) {
                run_phase(p, op, arg, lds);
                if (ph + 1 < ph1 || rep + 1 < reps) { xcd_barrier(xb);
#ifdef BAR2
                    xcd_barrier(xb);
#endif
                }
            }
        }
#ifdef DBG
        xcd_barrier(xb);
#ifndef DBG_WORD
#define DBG_WORD 200
#endif
        { const int code = __hip_atomic_load(WS_(p, TAB) + DBG_WORD, __ATOMIC_RELAXED, __HIP_MEMORY_SCOPE_AGENT);
          for (size_t i = (size_t)blockIdx.x * NTHR + threadIdx.x; i < (size_t)T * D; i += (size_t)NB_ * NTHR) p.out[i] = 0.f;
          __syncthreads();
          if (blockIdx.x == 0 && threadIdx.x == 0) p.out[0] = sqrtf((float)DBG_DECODE(code) * 1.68e7f); }
#endif
    } else {
        for (int ph = ph0; ph < ph1; ++ph) { int op, arg; decode_phase(ph, op, arg); run_phase(p, op, arg, lds); }
    }
}


extern "C" void kernel_launch(void* const* d_in, const int* in_sizes, int n_in, void* d_out, int out_size, void* d_ws, size_t ws_size, hipStream_t stream) {
    (void)in_sizes; (void)n_in; (void)out_size;
    Params p; std::memset((void*)&p, 0, sizeof(p));
    auto F = [&](int i) { return (const float*)d_in[i]; };
    p.x = F(0); p.ln_g = F(1); p.ln_b = F(2);
    p.rw_mu = F(3); p.rw_w_rkv = F(4); p.rw_w0 = F(5); p.rw_w1 = F(6); p.rw_w2 = F(7); p.rw_a0 = F(8);
    p.rw_a1 = F(9); p.rw_a2 = F(10); p.rw_g1 = F(11); p.rw_g2 = F(12);
    p.rw_k_k = F(13); p.rw_k_a = F(14); p.rw_r_k = F(15); p.rw_lnx_g = F(16); p.rw_lnx_b = F(17); p.rw_w_o = F(18);
    p.mb_w_in = F(19); p.mb_conv_w = F(20); p.mb_conv_b = F(21); p.mb_dt_bias = F(22); p.mb_a_log = F(23); p.mb_d = F(24); p.mb_norm_g = F(25); p.mb_w_out = F(26);
    p.gl_w_in = F(27); p.gl_gk_w2 = F(28); p.gl_gk_b = F(29); p.gl_norm_g = F(30); p.gl_w_out = F(31);
    p.moe_w_group = F(32); p.moe_b_group = F(33); p.moe_w_route = F(34); p.moe_b_route = F(35); p.moe_w_in = F(36); p.moe_w_down = F(37);
    p.out = (float*)d_out;
    p.ws = (char*)d_ws;
    if (WS_TOTAL > ws_size) { fprintf(stderr, "workspace too small: need %zu have %zu\n", (size_t)WS_TOTAL, ws_size); return; }
    unsigned* bar_ptr = (unsigned*)(p.ws + OFF_bar);
    const int np = NPHASES;
#define X(t, n) (void*)&p.n,
#if SINGLE_LAUNCH
    (void)hipFuncSetAttribute((const void*)mega<true>, hipFuncAttributeMaxDynamicSharedMemorySize, LDS_BYTES);
    (void)hipMemsetAsync(bar_ptr, 0, XCD_BAR_WORDS * sizeof(unsigned), stream);
    int ph0 = 0, ph1 = np; void* args[] = {PARAM_LIST(X) (void*)&ph0, (void*)&ph1};
    hipError_t e = hipLaunchCooperativeKernel((const void*)mega<true>, dim3(NBLK), dim3(NTHR), args, LDS_BYTES, stream);
    if (e != hipSuccess) fprintf(stderr, "cooperative launch failed: %s\n", hipGetErrorString(e));
#else
    (void)hipFuncSetAttribute((const void*)mega<false>, hipFuncAttributeMaxDynamicSharedMemorySize, LDS_BYTES);
    for (int ph = 0; ph < np; ++ph) { int ph0 = ph, ph1 = ph + 1; void* args[] = {PARAM_LIST(X) (void*)&ph0, (void*)&ph1};
        hipError_t e = hipLaunchKernel((const void*)mega<false>, dim3(NBLK), dim3(NTHR), args, LDS_BYTES, stream);
        if (e != hipSuccess) fprintf(stderr, "launch failed: %s\n", hipGetErrorString(e)); }
#endif
#undef X
}
```

```cpp
#include <hip/hip_runtime.h>
#include <hip/hip_cooperative_groups.h>
#include <cstdint>
#include <cstdio>
#include <cstring>
namespace cg = cooperative_groups;

typedef unsigned short bf16_t;
typedef short bf16x8 __attribute__((ext_vector_type(8)));
typedef short s16x4 __attribute__((ext_vector_type(4)));
typedef float f32x4 __attribute__((ext_vector_type(4)));
typedef float f32x2 __attribute__((ext_vector_type(2)));
typedef unsigned u32x4 __attribute__((ext_vector_type(4)));
typedef unsigned u32x2 __attribute__((ext_vector_type(2)));
#define LAS __attribute__((address_space(3)))
#define DEV __device__ __forceinline__

constexpr int T = 16384, D = 1024, DEPTH = 4;
constexpr int NTHR = 512, NBLK = 256;
constexpr int LDS_BYTES = 155648;
constexpr float ALPHA = 1.681792830507429f;
constexpr float LN_EPS = 1e-5f;
constexpr int MOE_ROWS = 40960;

DEV int tid_() { int t = threadIdx.x; asm volatile("" : "+v"(t)); return t; }
DEV int bid_() { int b = blockIdx.x; asm volatile("" : "+s"(b)); return b; }
#define NB_ 256
#define RCOL(q, lane) ((((q) >> 1) * 512) + 8 * (lane) + 4 * ((q) & 1))
DEV void lds_barrier() { asm volatile("s_waitcnt lgkmcnt(0)" ::: "memory"); __builtin_amdgcn_s_barrier(); asm volatile("" ::: "memory"); }
DEV unsigned f2bf(float f) { unsigned u = __float_as_uint(f); u += 0x7FFFu + ((u >> 16) & 1u); return u >> 16; }
DEV float bf2f(unsigned short b) { return __uint_as_float(((unsigned)b) << 16); }
typedef __bf16 bf16n2 __attribute__((ext_vector_type(2)));
DEV unsigned pk2(float lo, float hi) { f32x2 v = {lo, hi}; bf16n2 b = __builtin_convertvector(v, bf16n2); return __builtin_bit_cast(unsigned, b); }
DEV float bflo(unsigned u) { return __uint_as_float(u << 16); }
DEV float bfhi(unsigned u) { return __uint_as_float(u & 0xFFFF0000u); }
DEV float sigmoidf_(float x) { return 1.0f / (1.0f + __expf(-x)); }
DEV float siluf_(float x) { return x / (1.0f + __expf(-x)); }
DEV float softplusf_(float x) { return fmaxf(x, 0.f) + __logf(1.0f + __expf(-fabsf(x))); }
DEV float tanhf_(float x) { const float e = __expf(-2.0f * fabsf(x)); const float r = (1.0f - e) / (1.0f + e); return x < 0.f ? -r : r; }
DEV float wave_sum(float v) {
#pragma unroll
    for (int o = 32; o > 0; o >>= 1) v += __shfl_xor(v, o);
    return v;
}
DEV float sum16(float v) {
#pragma unroll
    for (int o = 8; o > 0; o >>= 1) v += __shfl_xor(v, o);
    return v;
}
template <int N> DEV float reduce_scatter(float (&v)[N], int lane) {
    int s = 1;
#pragma unroll
    for (int h = N / 2; h >= 1; h >>= 1) {
#pragma unroll
        for (int i = 0; i < h; ++i) {
            const bool up = (lane & s) != 0;
            const float send = up ? v[i] : v[i + h];
            const float keep = up ? v[i + h] : v[i];
            v[i] = keep + __shfl_xor(send, s);
        }
        s <<= 1;
    }
    float r = v[0];
    for (; s < 64; s <<= 1) r += __shfl_xor(r, s);
    return r;
}
template <int N> DEV int rs_index(int lane) {
    int o = 0, s = 1;
#pragma unroll
    for (int h = N / 2; h >= 1; h >>= 1) { if (lane & s) o += h; s <<= 1; }
    return o;
}

DEV bf16x8 frag_rm(const LAS bf16_t* base, int ld, int row0, int k0, int lane) {
    return *(const LAS bf16x8*)(base + (row0 + (lane & 15)) * ld + k0 + 8 * (lane >> 4));
}
DEV bf16x8 frag_tr(const LAS bf16_t* base, int ld, int k0, int c0, int lane) {
    const int g = lane >> 4, i = lane & 15, q = i >> 2, p = i & 3;
    const LAS bf16_t* a = base + (k0 + 8 * g + q) * ld + c0 + 4 * p;
    s16x4 lo = __builtin_amdgcn_ds_read_tr16_b64_v4i16((LAS s16x4*)a);
    s16x4 hi = __builtin_amdgcn_ds_read_tr16_b64_v4i16((LAS s16x4*)(a + 4 * ld));
    bf16x8 r; r[0] = lo[0]; r[1] = lo[1]; r[2] = lo[2]; r[3] = lo[3]; r[4] = hi[0]; r[5] = hi[1]; r[6] = hi[2]; r[7] = hi[3];
    return r;
}
#define MFMA16(a, b, c) __builtin_amdgcn_mfma_f32_16x16x32_bf16((a), (b), (c), 0, 0, 0)
DEV size_t fragmajor_off(int n, int k, int K) { return ((size_t)((n >> 4) * (K >> 5) + (k >> 5)) * 64 + (n & 15) + 16 * ((k & 31) >> 3)) * 8 + (k & 7); }

template <int N> DEV void skinny_group(const f32x4 (&z)[4], const LAS float* wt, int lane, LAS float* outw) {
    float pe[N];
#pragma unroll
    for (int o = 0; o < N; ++o) {
        float a = 0.f;
#pragma unroll
        for (int q = 0; q < 4; ++q) { const f32x4 w = *(const LAS f32x4*)(wt + o * 1028 + RCOL(q, lane)); a += z[q][0] * w[0] + z[q][1] * w[1] + z[q][2] * w[2] + z[q][3] * w[3]; }
        pe[o] = a;
    }
    const float r = reduce_scatter<N>(pe, lane);
    if (lane < N) outw[rs_index<N>(lane)] = r;
}
#ifndef SINGLE_LAUNCH
#define SINGLE_LAUNCH 1
#endif
constexpr size_t OFF_bar = 0ull;
constexpr size_t OFF_rw_rkv_t = 13824ull;
constexpr size_t OFF_rw_w1_t = 12596736ull;
constexpr size_t OFF_rw_a1_t = 13645312ull;
constexpr size_t OFF_rw_g1_t = 14693888ull;
constexpr size_t OFF_rw_w2_t = 15742464ull;
constexpr size_t OFF_rw_a2_t = 16791040ull;
constexpr size_t OFF_rw_g2_t = 17839616ull;
constexpr size_t OFF_rw_wo_t = 18888192ull;
constexpr size_t OFF_mb_win_t = 23082496ull;
constexpr size_t OFF_mb_wout_t = 33568256ull;
constexpr size_t OFF_gl_win_t = 37762560ull;
constexpr size_t OFF_gl_wout_t = 44054016ull;
constexpr size_t OFF_moe_w1_t = 46151168ull;
constexpr size_t OFF_moe_w2_t = 314586624ull;
constexpr size_t OFF_H = 448804352ull;
constexpr size_t OFF_H1 = 515913216ull;
constexpr size_t OFF_MIX = 583022080ull;
constexpr size_t OFF_BUF = 650130944ull;
constexpr size_t OFF_ACT = 734017024ull;
constexpr size_t OFF_YBUF = 775960064ull;
constexpr size_t OFF_CNT = 859846144ull;
constexpr size_t OFF_EIDX = 859878912ull;
constexpr size_t OFF_GATE = 860009984ull;
constexpr size_t OFF_DEST = 860141056ull;
constexpr size_t OFF_TAB = 860272128ull;
constexpr size_t OFF_YB = 860273152ull;
constexpr size_t OFF_X6 = 927382016ull;
constexpr size_t OFF_Rr = 1128708608ull;
constexpr size_t OFF_Kk = 1195817472ull;
constexpr size_t OFF_Vv = 1262926336ull;
constexpr size_t OFF_LW = 1330035200ull;
constexpr size_t OFF_Wd = 1355201024ull;
constexpr size_t OFF_Aa = 1422309888ull;
constexpr size_t OFF_Gg = 1489418752ull;
constexpr size_t OFF_RWf = 1556527616ull;
constexpr size_t OFF_RBf = 1590082048ull;
constexpr size_t OFF_RUt = 1623636480ull;
constexpr size_t OFF_RNa = 1657190912ull;
constexpr size_t OFF_RGc = 1690745344ull;
constexpr size_t OFF_RUa = 1691793920ull;
constexpr size_t OFF_RS0 = 1725348352ull;
constexpr size_t OFF_Z = 960936448ull;
constexpr size_t OFF_XBC = 1028045312ull;
constexpr size_t OFF_XC = 1128708608ull;
constexpr size_t OFF_DT = 1229371904ull;
constexpr size_t OFF_STATES = 1231469056ull;
constexpr size_t OFF_CD = 1365686784ull;
constexpr size_t OFF_PREV = 1365703168ull;
constexpr size_t OFF_LA = 1432812032ull;
constexpr size_t OFF_CDG = 1466366464ull;
constexpr size_t OFF_QKVG = OFF_XBC;
constexpr size_t WS_TOTAL = 1758902784ull;
typedef unsigned T_bar;
typedef bf16_t T_rw_rkv_t;
typedef bf16_t T_rw_w1_t;
typedef bf16_t T_rw_a1_t;
typedef bf16_t T_rw_g1_t;
typedef bf16_t T_rw_w2_t;
typedef bf16_t T_rw_a2_t;
typedef bf16_t T_rw_g2_t;
typedef bf16_t T_rw_wo_t;
typedef bf16_t T_mb_win_t;
typedef bf16_t T_mb_wout_t;
typedef bf16_t T_gl_win_t;
typedef bf16_t T_gl_wout_t;
typedef bf16_t T_moe_w1_t;
typedef bf16_t T_moe_w2_t;
typedef float T_H;
typedef float T_H1;
typedef float T_MIX;
typedef bf16_t T_BUF;
typedef bf16_t T_ACT;
typedef bf16_t T_YBUF;
typedef int T_CNT;
typedef int T_EIDX;
typedef float T_GATE;
typedef int T_DEST;
typedef int T_TAB;
typedef bf16_t T_YB;
typedef bf16_t T_X6;
typedef float T_Rr;
typedef float T_Kk;
typedef float T_Vv;
typedef bf16_t T_LW;
typedef float T_Wd;
typedef float T_Aa;
typedef float T_Gg;
typedef bf16_t T_RWf;
typedef bf16_t T_RBf;
typedef bf16_t T_RUt;
typedef bf16_t T_RNa;
typedef float T_RGc;
typedef bf16_t T_RUa;
typedef bf16_t T_RS0;
typedef bf16_t T_Z;
typedef bf16_t T_XBC;
typedef bf16_t T_XC;
typedef float T_DT;
typedef bf16_t T_STATES;
typedef float T_CD;
typedef bf16_t T_PREV;
typedef float T_LA;
typedef float T_CDG;
typedef bf16_t T_QKVG;
#define WS_(P, N) ((T_##N*)((P).ws + OFF_##N))
constexpr size_t OFF_Hb = OFF_H, OFF_H1b = OFF_H1, OFF_MIXb = OFF_MIX;
typedef bf16_t T_Hb; typedef bf16_t T_H1b; typedef bf16_t T_MIXb;
constexpr size_t OFF_moe_wr_t = OFF_H + 33554432ull;
typedef bf16_t T_moe_wr_t;
constexpr size_t OFF_mb_dt_t = OFF_moe_wr_t + 4ull * 48 * 1024 * 2, OFF_gl_lr_t = OFF_mb_dt_t + 32ull * 1024 * 2;
typedef bf16_t T_mb_dt_t; typedef bf16_t T_gl_lr_t;
constexpr size_t OFF_MFLAG = OFF_gl_lr_t + 16ull * 1024 * 2;
typedef unsigned T_MFLAG;
constexpr int MFLAG_STRIDE = 16, MFLAG_TICKET = 256;
constexpr size_t OFF_Rb = OFF_Rr, OFF_Kb = OFF_Kk, OFF_Vb = OFF_Vv, OFF_Ab = OFF_Aa, OFF_Gb = OFF_Gg;
typedef bf16_t T_Rb; typedef bf16_t T_Kb; typedef bf16_t T_Vb; typedef bf16_t T_Ab; typedef bf16_t T_Gb;
constexpr size_t OFF_Wb = OFF_Wd; typedef bf16_t T_Wb;
struct ConvJob {
    const float* src; bf16_t* dst;
    int K, N, src_ld, Kpad, Npad, perm, batch;
    long long src_bs, dst_bs;
    DEV int ntiles() const { return (Kpad / 64) * (Npad / 64) * batch; }
};
#ifndef PERMF
#define PERMF 0xDF
#endif
#define PF(bit) (((PERMF) >> (bit)) & 1)
constexpr int NJOBS = 16;
constexpr int MOE_SPLIT = 32;

#define PARAM_LIST(X) \
    X(const float*, x) X(const float*, ln_g) X(const float*, ln_b) \
    X(const float*, rw_mu) X(const float*, rw_w_rkv) X(const float*, rw_w0) X(const float*, rw_w1) X(const float*, rw_w2) X(const float*, rw_a0) X(const float*, rw_a1) X(const float*, rw_a2) \
    X(const float*, rw_g1) X(const float*, rw_g2) X(const float*, rw_k_k) X(const float*, rw_k_a) X(const float*, rw_r_k) X(const float*, rw_lnx_g) X(const float*, rw_lnx_b) X(const float*, rw_w_o) \
    X(const float*, mb_w_in) X(const float*, mb_conv_w) X(const float*, mb_conv_b) X(const float*, mb_dt_bias) X(const float*, mb_a_log) X(const float*, mb_d) X(const float*, mb_norm_g) X(const float*, mb_w_out) \
    X(const float*, gl_w_in) X(const float*, gl_gk_w2) X(const float*, gl_gk_b) X(const float*, gl_norm_g) X(const float*, gl_w_out) \
    X(const float*, moe_w_group) X(const float*, moe_b_group) X(const float*, moe_w_route) X(const float*, moe_b_route) X(const float*, moe_w_in) X(const float*, moe_w_down) \
    X(float*, out) X(char*, ws)
struct Params {
#define X(t, n) t n;
    PARAM_LIST(X)
#undef X
};

enum Op : unsigned char { OP_CONVERT = 0, OP_PRE0, OP_RW_GEMM1, OP_RW_GEMM2, OP_RW_CHA, OP_RW_CHB, OP_RW_CHC, OP_RW_OUT,
    OP_LN1, OP_MOE_SCATTER, OP_MOE_GEMM1, OP_MOE_GEMM2, OP_LN2,
    OP_MB_GEMM_IN, OP_MB_CONV, OP_MB_STATES, OP_MB_SCAN, OP_MB_OUT, OP_MB_GEMM_OUT,
    OP_GL_GEMM_IN, OP_GL_KV, OP_GL_SCAN, OP_GL_OUT, OP_GL_GEMM_OUT };


DEV ConvJob make_job(const Params& p, int q) {
    const long long DD = (long long)D * D;
    switch (q) {
    case 0: return ConvJob{p.rw_w_rkv, WS_(p, rw_rkv_t), 1024, 1024, 1024, 1024, 1024, 0 | 2 * PF(0), 6, DD, DD};
    case 1: return ConvJob{p.rw_w1, WS_(p, rw_w1_t), 1024, 64, 64, 1024, 256, 0 | 2 * PF(1), 2, (long long)D * 64, (long long)256 * D};
    case 2: return ConvJob{p.rw_a1, WS_(p, rw_a1_t), 1024, 64, 64, 1024, 256, 0 | 2 * PF(1), 2, (long long)D * 64, (long long)256 * D};
    case 3: return ConvJob{p.rw_g1, WS_(p, rw_g1_t), 1024, 160, 160, 1024, 256, 0 | 2 * PF(1), 2, (long long)D * 160, (long long)256 * D};
    case 4: return ConvJob{p.rw_w2, WS_(p, rw_w2_t), 64, 1024, 1024, 256, 1024, 0 | 2 * PF(2), 2, (long long)64 * D, (long long)D * 256};
    case 5: return ConvJob{p.rw_a2, WS_(p, rw_a2_t), 64, 1024, 1024, 256, 1024, 0 | 2 * PF(2), 2, (long long)64 * D, (long long)D * 256};
    case 6: return ConvJob{p.rw_g2, WS_(p, rw_g2_t), 160, 1024, 1024, 256, 1024, 0 | 2 * PF(2), 2, (long long)160 * D, (long long)D * 256};
    case 7: return ConvJob{p.rw_w_o, WS_(p, rw_wo_t), 1024, 1024, 1024, 1024, 1024, 0 | 2 * PF(3), 2, DD, DD};
    case 8: return ConvJob{p.mb_w_in, WS_(p, mb_win_t), 1024, 5120, 5152, 1024, 5120, 0 | 2 * PF(4), 1, 0, 0};
    case 9: return ConvJob{p.mb_w_out, WS_(p, mb_wout_t), 2048, 1024, 1024, 2048, 1024, 0 | 2 * PF(3), 1, 0, 0};
    case 10: return ConvJob{p.gl_w_in, WS_(p, gl_win_t), 1024, 3072, 3088, 1024, 3072, 0 | 2 * PF(5), 1, 0, 0};
    case 11: return ConvJob{p.gl_w_out, WS_(p, gl_wout_t), 1024, 1024, 1024, 1024, 1024, 0 | 2 * PF(3), 1, 0, 0};
    case 12: return ConvJob{p.moe_w_in, WS_(p, moe_w1_t), 1024, 1024, 1024, 1024, 1024, 1 | 2 * PF(6), MOE_SPLIT, DD, DD};
    case 13: return ConvJob{p.moe_w_down, WS_(p, moe_w2_t), 512, 1024, 1024, 512, 1024, 0 | 2 * PF(7), MOE_SPLIT, (long long)512 * 1024, (long long)1024 * 512};
    case 14: return ConvJob{p.moe_w_in + (size_t)MOE_SPLIT * DD, WS_(p, moe_w1_t) + (size_t)MOE_SPLIT * DD, 1024, 1024, 1024, 1024, 1024, 1 | 2 * PF(6), 128 - MOE_SPLIT, DD, DD};
    default: return ConvJob{p.moe_w_down + (size_t)MOE_SPLIT * 512 * 1024, WS_(p, moe_w2_t) + (size_t)MOE_SPLIT * 512 * 1024, 512, 1024, 1024, 512, 1024, 0 | 2 * PF(7), 128 - MOE_SPLIT, (long long)512 * 1024, (long long)1024 * 512};
    }
}

DEV void convert_tile(const ConvJob& J, LAS bf16_t* tile, int local, int lane) {
    const int tk = J.Kpad / 64, tn = J.Npad / 64;
    const int b = local / (tk * tn); local -= b * tk * tn;
    const int nt = local / tk, kt = local - nt * tk;
    const float* src = J.src + (size_t)b * J.src_bs;
    bf16_t* dst = J.dst + (size_t)b * J.dst_bs;
    const int k0 = kt * 64, n0 = nt * 64;
    const int nn = (lane & 15) * 4; const bool nok = n0 + nn < J.N;
    f32x4 v[16];
#pragma unroll
    for (int i = 0; i < 16; ++i) { const int kk = (lane >> 4) + 4 * i; v[i] = (nok && k0 + kk < J.K) ? *(const f32x4*)(src + (size_t)(k0 + kk) * J.src_ld + n0 + nn) : (f32x4){0.f, 0.f, 0.f, 0.f}; }
#pragma unroll
    for (int i = 0; i < 16; ++i) { const int kk = (lane >> 4) + 4 * i;
#pragma unroll
        for (int e = 0; e < 4; ++e) tile[(nn + e) * 72 + kk] = (bf16_t)f2bf(v[i][e]); }
#pragma unroll
    for (int i = 0; i < 8; ++i) { const int r = (lane >> 3) + 8 * i, kc = (lane & 7) * 8;
        int nsrc = n0 + r, ndst = nsrc;
        if (J.perm & 1) { const int up = nsrc >= 512, jj = nsrc - (up ? 512 : 0); ndst = (jj >> 7) * 256 + (up ? 128 : 0) + (jj & 127); }
        if (J.perm & 2) { const int cc = ndst & 31; ndst = (ndst & ~31) | (((cc >> 2) & 1) << 4) | ((cc >> 3) << 2) | (cc & 3); }
        *(u32x4*)(dst + (size_t)ndst * J.Kpad + k0 + kc) = *(const LAS u32x4*)(tile + r * 72 + kc); }
}
DEV void convert_one(const ConvJob& J, LAS unsigned char* lds, int B0, int NBW, int tbeg) {
    const int tid = tid_(), bid = bid_();
    const int lane = tid & 63, wv = tid >> 6; const int gw = (bid - B0) * 8 + wv, NW = NBW * 8;
    LAS bf16_t* tile = (LAS bf16_t*)lds + wv * (64 * 72);
    const int jend = tbeg + J.ntiles();
    const int ti0 = tbeg + ((gw - tbeg) % NW + NW) % NW;
#pragma unroll 1
    for (int ti = ti0; ti < jend; ti += NW) convert_tile(J, tile, ti - tbeg, lane);
}
DEV void convert_tickets(const ConvJob& J0, const ConvJob& J1, LAS unsigned char* lds, unsigned* ctrs, int stride) {
    constexpr int NG = 32;
    const int tid = tid_(); const int lane = tid & 63, wv = tid >> 6; const int g = bid_() & (NG - 1);
    unsigned* ctr = ctrs + g * stride;
    LAS bf16_t* tile = (LAS bf16_t*)lds + wv * (64 * 72);
    const int n0 = J0.ntiles(), n = n0 + J1.ntiles();
    int cur = 0; if (lane == 0) cur = (int)__hip_atomic_fetch_add(ctr, 1u, __ATOMIC_RELAXED, __HIP_MEMORY_SCOPE_AGENT);
    cur = __builtin_amdgcn_readfirstlane(cur) * NG + g;
#pragma unroll 1
    while (cur < n) {
        int nx = 0; if (lane == 0) nx = (int)__hip_atomic_fetch_add(ctr, 1u, __ATOMIC_RELAXED, __HIP_MEMORY_SCOPE_AGENT);
        const bool first = cur < n0; const ConvJob J = first ? J0 : J1;
        convert_tile(J, tile, first ? cur : cur - n0, lane);
        cur = __builtin_amdgcn_readfirstlane(nx) * NG + g;
    }
}
template <int J0, int J1> DEV int convert_jobs(const Params& p, LAS unsigned char* lds, int B0, int NBW, int tbeg = 0) {
#pragma unroll
    for (int j = J0; j < J1; ++j) { const ConvJob J = make_job(p, j); convert_one(J, lds, B0, NBW, tbeg); tbeg += J.ntiles(); }
    return tbeg;
}
DEV ConvJob moe_job(const Params& p, int which, int ml) {
    const long long DD = (long long)D * D; const size_t b0 = (size_t)ml * 32;
    if (which == 0) return ConvJob{p.moe_w_in + b0 * DD, WS_(p, moe_w1_t) + b0 * DD, 1024, 1024, 1024, 1024, 1024, 1 | 2 * PF(6), 32, DD, DD};
    return ConvJob{p.moe_w_down + b0 * 512 * 1024, WS_(p, moe_w2_t) + b0 * 512 * 1024, 512, 1024, 1024, 512, 1024, 0 | 2 * PF(7), 32, (long long)512 * 1024, (long long)1024 * 512};
}
DEV void phase_convert(const Params& p, LAS unsigned char* lds) {
    const int tid = tid_(), bid = bid_();
    convert_jobs<0, 8>(p, lds, 0, NB_);
    if (bid < 4 * 48) { const int layer = bid / 48, o = bid % 48;
        for (int k = tid; k < D; k += NTHR) { float v = 0.f;
            if (o < 32) v = p.moe_w_route[((size_t)layer * D + k) * 32 + o]; else if (o < 36) v = p.moe_w_group[((size_t)layer * D + k) * 4 + (o - 32)];
            WS_(p, moe_wr_t)[((size_t)layer * 48 + o) * D + k] = (bf16_t)f2bf(v); } }
    else if (bid < 4 * 48 + 32) { const int o = bid - 192;
        for (int k = tid; k < D; k += NTHR) WS_(p, mb_dt_t)[(size_t)o * D + k] = (bf16_t)f2bf(p.mb_w_in[(size_t)k * 5152 + 5120 + o]); }
    else if (bid < 4 * 48 + 48) { const int o = bid - 224;
        for (int k = tid; k < D; k += NTHR) WS_(p, gl_lr_t)[(size_t)o * D + k] = (bf16_t)f2bf(p.gl_w_in[(size_t)k * 3088 + 3072 + o]); }
}
namespace pg8 {
constexpr int BM = 256, BK = 64, HALF = 128, HTB = HALF * BK * 2, STAGE_BYTES = 8 * HTB;
DEV int lds_byte(int r, int c) { const int st = (r >> 4) * 2 + (c >> 5), rr = r & 15, cc = c & 31, ob = rr * 64 + cc * 2; return st * 1024 + (ob ^ (((ob >> 9) & 1) << 5)); }
DEV void stage_rc(int b, int& R, int& C) { const int st = b / 1024, sb = b % 1024, swz = sb ^ (((sb >> 9) & 1) << 5); R = (st >> 1) * 16 + swz / 64; C = (st & 1) * 32 + (swz % 64) / 2; }

struct Unit { const char* A; const char* B; int row0, col0, id, aux; };

DEV bool tile_order(int i, int G, int c, int nM, int nN, int& pm, int& pn) {
    const int nwg = nM * nN; const long L = (long)i * G + c; if (L >= nwg) return false;
    int wgid = (int)L; { const int q = nwg / 8, r = nwg % 8, xcd = wgid % 8, off = wgid / 8; wgid = (xcd < r ? xcd * (q + 1) : r * (q + 1) + (xcd - r) * q) + off; }
    const int nig = 8 * nN, gid = wgid / nig, fm = gid * 8, gsz = (nM - fm) < 8 ? (nM - fm) : 8;
    pm = fm + ((wgid % nig) % gsz); pn = (wgid % nig) / gsz; return true;
}

template <class Epi, class Sched>
DEV void gemm_phase(LAS unsigned char* lds, const int K, const Sched& S, const Epi& E) {
    const int tid = tid_(), wid = __builtin_amdgcn_readfirstlane(tid >> 6), lane = tid & 63, wr = wid >> 2, wc = wid & 3, fr = lane & 15, fq = lane >> 4;
    const int nt = K / BK;
    unsigned voff[2];
#pragma unroll
    for (int i = 0; i < 2; ++i) { int R, C; stage_rc(tid * 16 + i * 8192, R, C); voff[i] = (unsigned)(R * K + C) * 2u; }
    const size_t kstep = (size_t)(BK * 2);
    const size_t hstep = (size_t)HALF * K * 2;
    const unsigned ldsw = (unsigned)wid * 1024u;
    const int aoff = lds_byte(wr * 64 + fr, fq * 8), boff = lds_byte(wc * 32 + fr, fq * 8);
#define PG8_SA(b, h) (((b) * 2 + (h)) * HTB)
#define PG8_SB(b, h) ((4 + (b) * 2 + (h)) * HTB)
#define PG8_STAGE(bufoff, gbase) do { _Pragma("unroll") for (int _i = 0; _i < 2; ++_i) \
        __builtin_amdgcn_global_load_lds((const unsigned*)((const char*)(gbase) + voff[_i]), (LAS unsigned*)(lds + (bufoff) + ldsw + _i * 8192), 16, 0, 0); } while (0)
#define PG8_LDA(dst, b, h) do { _Pragma("unroll") for (int m = 0; m < 4; ++m) _Pragma("unroll") for (int k = 0; k < 2; ++k) dst[m][k] = *(const LAS bf16x8*)(lds + PG8_SA(b, h) + aoff + m * 2048 + k * 1024); } while (0)
#define PG8_LDB(dst, b, h) do { _Pragma("unroll") for (int n = 0; n < 2; ++n) _Pragma("unroll") for (int k = 0; k < 2; ++k) dst[n][k] = *(const LAS bf16x8*)(lds + PG8_SB(b, h) + boff + n * 2048 + k * 1024); } while (0)
#define PG8_MMA(ai, bj, At, Bt) do { __builtin_amdgcn_s_setprio(1); _Pragma("unroll") for (int m = 0; m < 4; ++m) _Pragma("unroll") for (int n = 0; n < 2; ++n) _Pragma("unroll") for (int k = 0; k < 2; ++k) \
        acc[ai][bj][m][n] = __builtin_amdgcn_mfma_f32_16x16x32_bf16(Bt[n][k], At[m][k], acc[ai][bj][m][n], 0, 0, 0); __builtin_amdgcn_s_setprio(0); } while (0)
#define PG8_WAIT_V(n) asm volatile("s_waitcnt vmcnt(" #n ")" ::: "memory")
#define PG8_WAIT_L(n) asm volatile("s_waitcnt lgkmcnt(" #n ")" ::: "memory")
#define PG8_BAR __builtin_amdgcn_s_barrier()
#define PG8_SCHED __builtin_amdgcn_sched_barrier(0)
    Unit cur, nxt; int ui = 0;
    if (!S.next(0, cur)) return;
    f32x4 acc[2][2][4][2];
#pragma unroll
    for (int a = 0; a < 2; ++a)
#pragma unroll
        for (int b = 0; b < 2; ++b)
#pragma unroll
            for (int m = 0; m < 4; ++m)
#pragma unroll
                for (int n = 0; n < 2; ++n) acc[a][b][m][n] = (f32x4){0.f, 0.f, 0.f, 0.f};
    bf16x8 At[4][2], B0[2][2], B1[2][2];
    const char* cA = cur.A; const char* cB = cur.B;
    PG8_STAGE(PG8_SB(0, 0), cB); PG8_STAGE(PG8_SA(0, 0), cA); PG8_STAGE(PG8_SB(0, 1), cB + hstep); PG8_STAGE(PG8_SA(0, 1), cA + hstep);
    if (wr == 1) PG8_BAR;
    PG8_WAIT_V(4); PG8_BAR;
    PG8_STAGE(PG8_SB(1, 0), cB + kstep); PG8_STAGE(PG8_SA(1, 0), cA + kstep); PG8_STAGE(PG8_SB(1, 1), cB + hstep + kstep);
    PG8_WAIT_V(6); PG8_BAR;
    for (;;) {
        const bool has_next = S.next(ui + 1, nxt);
        const char* nA = has_next ? nxt.A : cA; const char* nB = has_next ? nxt.B : cB;
#pragma unroll 1
        for (int t = 0; t < nt; t += 2) {
            const bool last = (t == nt - 2);
            const char* a1 = cA + (size_t)(t + 1) * kstep;
            const char* a2 = last ? nA : cA + (size_t)(t + 2) * kstep; const char* b2 = last ? nB : cB + (size_t)(t + 2) * kstep;
            const char* a3 = a2 + kstep; const char* b3 = b2 + kstep;
            PG8_LDB(B0, 0, 0); PG8_SCHED; PG8_LDA(At, 0, 0); PG8_STAGE(PG8_SA(1, 1), a1 + hstep);
            PG8_WAIT_L(8); PG8_BAR; PG8_WAIT_L(0); PG8_MMA(0, 0, At, B0); PG8_BAR; PG8_SCHED;
            PG8_LDB(B1, 0, 1); PG8_STAGE(PG8_SB(0, 0), b2);
            PG8_BAR; PG8_WAIT_L(0); PG8_MMA(0, 1, At, B1); PG8_BAR;
            PG8_LDA(At, 0, 1); PG8_STAGE(PG8_SA(0, 0), a2);
            PG8_BAR; PG8_WAIT_L(0); PG8_MMA(1, 0, At, B0); PG8_BAR; PG8_SCHED;
            PG8_STAGE(PG8_SB(0, 1), b2 + hstep);
            PG8_WAIT_V(6); PG8_BAR; PG8_MMA(1, 1, At, B1); PG8_BAR;
            PG8_LDB(B0, 1, 0); PG8_SCHED; PG8_LDA(At, 1, 0); PG8_STAGE(PG8_SA(0, 1), a2 + hstep);
            PG8_WAIT_L(8); PG8_BAR; PG8_WAIT_L(0); PG8_MMA(0, 0, At, B0); PG8_BAR; PG8_SCHED;
            PG8_LDB(B1, 1, 1); PG8_STAGE(PG8_SB(1, 0), b3);
            PG8_BAR; PG8_WAIT_L(0); PG8_MMA(0, 1, At, B1); PG8_BAR;
            PG8_LDA(At, 1, 1); PG8_STAGE(PG8_SA(1, 0), a3);
            PG8_BAR; PG8_WAIT_L(0); PG8_MMA(1, 0, At, B0); PG8_BAR; PG8_SCHED;
            PG8_STAGE(PG8_SB(1, 1), b3 + hstep);
            PG8_WAIT_V(6); PG8_BAR; PG8_MMA(1, 1, At, B1); PG8_BAR;
        }
        E(acc, cur, wr, wc, fr, fq);
        if (!has_next) break;
#pragma unroll
        for (int a = 0; a < 2; ++a)
#pragma unroll
            for (int b = 0; b < 2; ++b)
#pragma unroll
                for (int m = 0; m < 4; ++m)
#pragma unroll
                    for (int n = 0; n < 2; ++n) acc[a][b][m][n] = (f32x4){0.f, 0.f, 0.f, 0.f};
        cur = nxt; cA = nA; cB = nB; ++ui;
    }
    PG8_WAIT_V(0);
    if (wr == 0) PG8_BAR;
    PG8_BAR;
#undef PG8_SA
#undef PG8_SB
#undef PG8_STAGE
#undef PG8_LDA
#undef PG8_LDB
#undef PG8_MMA
#undef PG8_WAIT_V
#undef PG8_WAIT_L
#undef PG8_BAR
#undef PG8_SCHED
}
}
using pg8::Unit;
typedef f32x4 AccT[2][2][4][2];
#define FOR_ACC(ai, bj, m, n) _Pragma("unroll") for (int ai = 0; ai < 2; ++ai) _Pragma("unroll") for (int m = 0; m < 4; ++m) _Pragma("unroll") for (int bj = 0; bj < 2; ++bj) _Pragma("unroll") for (int n = 0; n < 2; ++n)
#define ACC_FENCE __builtin_amdgcn_sched_barrier(0)
#define ACC_ROW(u, ai, m) ((u).row0 + 128 * (ai) + 64 * wr + 16 * (m) + fr)
#define ACC_COLP(u, bj, n, P) ((P) ? ((u).col0 + 128 * (bj) + 32 * wc + 8 * fq + 4 * (n)) : ((u).col0 + 128 * (bj) + 32 * wc + 16 * (n) + 4 * fq))
#define ACC_COL8P(u, bj, P) ACC_COLP(u, bj, 0, P)
#define FOR_ACC2(ai, bj, m) _Pragma("unroll") for (int ai = 0; ai < 2; ++ai) _Pragma("unroll") for (int m = 0; m < 4; ++m) _Pragma("unroll") for (int bj = 0; bj < 2; ++bj)
DEV void st_bf4(bf16_t* p, f32x4 v) { u32x2 w; w.x = pk2(v[0], v[1]); w.y = pk2(v[2], v[3]); *(u32x2*)p = w; }
DEV u32x4 pk8v(f32x4 a, f32x4 b) { u32x4 w; w.x = pk2(a[0], a[1]); w.y = pk2(a[2], a[3]); w.z = pk2(b[0], b[1]); w.w = pk2(b[2], b[3]); return w; }
#ifdef ST8
DEV void st_bf8p(bf16_t* p, f32x4 a, f32x4 b, bool P) { if (P) { st_bf4(p, a); st_bf4(p + 4, b); } else { st_bf4(p, a); st_bf4(p + 16, b); } }
#else
DEV void st_bf8p(bf16_t* p, f32x4 a, f32x4 b, bool P) { if (P) *(u32x4*)p = pk8v(a, b); else { st_bf4(p, a); st_bf4(p + 16, b); } }
#endif
DEV void load_row(const float* p, int lane, f32x4 (&v)[4]) {
#pragma unroll
    for (int q = 0; q < 4; ++q) v[q] = *(const f32x4*)(p + RCOL(q, lane));
}

DEV void load_row_bf(const bf16_t* p, int lane, f32x4 (&v)[4]) {
#pragma unroll
    for (int q = 0; q < 4; ++q) { const u32x2 a = *(const u32x2*)(p + RCOL(q, lane)); v[q] = (f32x4){bflo(a.x), bfhi(a.x), bflo(a.y), bfhi(a.y)}; }
}
DEV void store_row_bf(bf16_t* p, int lane, const f32x4 (&v)[4]) {
#pragma unroll
    for (int q = 0; q < 4; ++q) st_bf4(p + RCOL(q, lane), v[q]);
}
DEV void emit_mix6(const Params& p, int j, int t, int lane, const f32x4 (&x)[4], const f32x4 (&xp)[4]) {
    const float* mu = p.rw_mu + (size_t)j * 6 * D;
#pragma unroll
    for (int s = 0; s < 6; ++s) {
#pragma unroll
        for (int q = 0; q < 4; ++q) {
            const f32x4 m = *(const f32x4*)(mu + s * D + RCOL(q, lane));
            st_bf4(WS_(p, X6) + (size_t)s * T * D + (size_t)t * D + RCOL(q, lane), x[q] + (xp[q] - x[q]) * m);
        }
        __builtin_amdgcn_sched_barrier(0);
    }
}
DEV void phase_pre0(const Params& p) {
    const int tid = tid_(), bid = bid_(); const int lane = tid & 63, wid = tid >> 6;
    f32x4 x[4], xp[4];
    const int tfirst = bid * 64 + wid * 8;
    if (tfirst > 0) load_row(p.x + (size_t)(tfirst - 1) * D, lane, xp); else { for (int q = 0; q < 4; ++q) xp[q] = (f32x4){0.f, 0.f, 0.f, 0.f}; }
    f32x4 xn[4]; load_row(p.x + (size_t)tfirst * D, lane, xn);
#pragma unroll 1
    for (int r = 0; r < 8; ++r) {
        const int t = tfirst + r;
#pragma unroll
        for (int q = 0; q < 4; ++q) x[q] = xn[q];
        load_row(p.x + (size_t)(r < 7 ? t + 1 : t) * D, lane, xn);
        store_row_bf(WS_(p, Hb) + (size_t)t * D, lane, x);
        emit_mix6(p, 0, t, lane, x, xp);
#pragma unroll
        for (int q = 0; q < 4; ++q) xp[q] = x[q];
    }
}

struct SchedRW1 {
    const Params* p; int j;
    DEV bool next(int i, Unit& u) const {
        int pm, pn; if (!pg8::tile_order(i, NB_, bid_(), 64, 15, pm, pn)) return false;
        int id, lpn; if (pn < 12) { id = pn >> 2; lpn = pn & 3; } else { id = 3 + (pn - 12); lpn = 0; }
        u.A = (const char*)(WS_(*p, X6) + (size_t)id * T * D + (size_t)pm * 256 * D);
        const bf16_t* B;
        if (id < 3) B = WS_(*p, rw_rkv_t) + ((size_t)j * 3 + id) * D * D + (size_t)lpn * 256 * D;
        else B = WS_(*p, rw_w1_t) + (size_t)(id - 3) * (2 * 256 * D) + (size_t)j * 256 * D;
        u.B = (const char*)B; u.row0 = pm * 256; u.col0 = lpn * 256; u.id = id; u.aux = 0; return true;
    }
};
struct EpiRW1 {
    const Params* p;
    DEV void operator()(const AccT& acc, const Unit& u, int wr, int wc, int fr, int fq) const {
        if (u.id < 3) {
            bf16_t* O = WS_(*p, Rb) + (size_t)u.id * 2 * T * D;
            FOR_ACC2(ai, bj, m) { st_bf8p(O + (size_t)ACC_ROW(u, ai, m) * D + ACC_COL8P(u, bj, PF(0)), acc[ai][bj][m][0], acc[ai][bj][m][1], PF(0)); ACC_FENCE; }
        } else {
            bf16_t* O = WS_(*p, LW) + (size_t)(u.id - 3) * T * 256;
            FOR_ACC2(ai, bj, m) {
                f32x4 v0 = acc[ai][bj][m][0], v1 = acc[ai][bj][m][1];
                if (u.id == 3) { for (int e = 0; e < 4; ++e) { v0[e] = tanhf_(v0[e]); v1[e] = tanhf_(v1[e]); } }
                else if (u.id == 5) { for (int e = 0; e < 4; ++e) { v0[e] = sigmoidf_(v0[e]); v1[e] = sigmoidf_(v1[e]); } }
                st_bf8p(O + (size_t)ACC_ROW(u, ai, m) * 256 + ACC_COL8P(u, bj, PF(1)), v0, v1, PF(1)); ACC_FENCE;
            }
        }
    }
};
struct SchedRW2 {
    const Params* p; int j;
    DEV bool next(int i, Unit& u) const {
        int pm, pn; if (!pg8::tile_order(i, NB_, bid_(), 64, 12, pm, pn)) return false;
        const int id = pn >> 2, lpn = pn & 3;
        u.A = (const char*)(WS_(*p, LW) + (size_t)id * T * 256 + (size_t)pm * 256 * 256);
        const bf16_t* B = WS_(*p, rw_w2_t) + (size_t)id * (2 * D * 256) + (size_t)j * D * 256 + (size_t)lpn * 256 * 256;
        u.B = (const char*)B; u.row0 = pm * 256; u.col0 = lpn * 256; u.id = id; u.aux = 0; return true;
    }
};
struct EpiRW2 {
    const Params* p; int j;
    DEV void operator()(const AccT& acc, const Unit& u, int wr, int wc, int fr, int fq) const {
        if (u.id == 0) { const float* bias = p->rw_w0 + (size_t)j * D; f32x4 bv[2][2];
#pragma unroll
            for (int bj = 0; bj < 2; ++bj)
#pragma unroll
                for (int n = 0; n < 2; ++n) bv[bj][n] = *(const f32x4*)(bias + ACC_COLP(u, bj, n, PF(2)));
            FOR_ACC2(ai, bj, m) { f32x4 vv[2];
#pragma unroll
                for (int n = 0; n < 2; ++n) { f32x4 v = acc[ai][bj][m][n]; const f32x4 b = bv[bj][n];
                    for (int e = 0; e < 4; ++e) { const float x = -(b[e] + v[e]); const float wl = -(fmaxf(x, 0.f) + __logf(1.0f + __expf(-fabsf(x)))) - 0.5f; v[e] = -__expf(wl); }
                    vv[n] = v; }
                st_bf8p(WS_(*p, Wb) + (size_t)ACC_ROW(u, ai, m) * D + ACC_COL8P(u, bj, PF(2)), vv[0], vv[1], PF(2)); ACC_FENCE; } }
        else if (u.id == 1) { const float* bias = p->rw_a0 + (size_t)j * D; f32x4 bv[2][2];
#pragma unroll
            for (int bj = 0; bj < 2; ++bj)
#pragma unroll
                for (int n = 0; n < 2; ++n) bv[bj][n] = *(const f32x4*)(bias + ACC_COLP(u, bj, n, PF(2)));
            FOR_ACC2(ai, bj, m) { f32x4 vv[2];
#pragma unroll
                for (int n = 0; n < 2; ++n) { f32x4 v = acc[ai][bj][m][n]; const f32x4 b = bv[bj][n];
                    for (int e = 0; e < 4; ++e) v[e] = sigmoidf_(b[e] + v[e]);
                    vv[n] = v; }
                st_bf8p(WS_(*p, Ab) + (size_t)ACC_ROW(u, ai, m) * D + ACC_COL8P(u, bj, PF(2)), vv[0], vv[1], PF(2)); ACC_FENCE; } }
        else { FOR_ACC2(ai, bj, m) { st_bf8p(WS_(*p, Gb) + (size_t)ACC_ROW(u, ai, m) * D + ACC_COL8P(u, bj, PF(2)), acc[ai][bj][m][0], acc[ai][bj][m][1], PF(2)); ACC_FENCE; } }
    }
};

struct SchedOut {
    const bf16_t* A; const bf16_t* Bt; int K;
    DEV bool next(int i, Unit& u) const {
        int pm, pn; if (!pg8::tile_order(i, NB_, bid_(), 64, 4, pm, pn)) return false;
        u.A = (const char*)(A + (size_t)pm * 256 * K); u.B = (const char*)(Bt + (size_t)pn * 256 * K); u.row0 = pm * 256; u.col0 = pn * 256; u.id = 0; u.aux = 0; return true;
    }
};
struct EpiOut {
    bf16_t* O;
    DEV void operator()(const AccT& acc, const Unit& u, int wr, int wc, int fr, int fq) const {
        FOR_ACC2(ai, bj, m) { st_bf8p(O + (size_t)ACC_ROW(u, ai, m) * D + ACC_COL8P(u, bj, PF(3)), acc[ai][bj][m][0], acc[ai][bj][m][1], PF(3)); ACC_FENCE; }
    }
};
constexpr int RC_LD = 72;
#ifdef DBG
#define DBGF(cond, bit) do { if (cond) atomicOr(&WS_(p, TAB)[200], (bit)); } while (0)
#else
#define DBGF(cond, bit) do {} while (0)
#endif
DEV bool bad_(float x) { return !(fabsf(x) < 1e30f); }
DEV int rc_pi(int g, int j) { return j < 4 ? 4 * g + j : 16 + 4 * g + (j - 4); }

DEV void rc_load_wd(const Params& p, int t0, int cb, float (&wd)[8]) {
    const int tid = tid_(); const int k = tid & 63, sg = tid >> 6;
#pragma unroll
    for (int i = 0; i < 8; ++i) wd[i] = bf2f(WS_(p, Wb)[(size_t)(t0 + sg * 8 + i) * D + cb + k]);
}
DEV void rc_cum_regs(const float (&wd)[8], LAS float* cum, LAS float* seg) {
    const int tid = tid_(); const int k = tid & 63, sg = tid >> 6;
    float v[8]; float s = 0.f;
#pragma unroll
    for (int i = 0; i < 8; ++i) { s += wd[i]; v[i] = s; }
    seg[sg * 64 + k] = s;
    lds_barrier();
    float off = 0.f;
#pragma unroll
    for (int q = 0; q < 8; ++q) off += (q < sg) ? seg[q * 64 + k] : 0.f;
#pragma unroll
    for (int i = 0; i < 8; ++i) cum[(sg * 8 + i) * 64 + k] = v[i] + off;
    lds_barrier();
}
DEV void ld8b(const bf16_t* p, float (&f)[8]) { const u32x4 v = *(const u32x4*)p; f[0] = bflo(v.x); f[1] = bfhi(v.x); f[2] = bflo(v.y); f[3] = bfhi(v.y); f[4] = bflo(v.z); f[5] = bfhi(v.z); f[6] = bflo(v.w); f[7] = bfhi(v.w); }
DEV void ld8(const float* p, float (&f)[8]) { const f32x4 a = *(const f32x4*)p, b = *(const f32x4*)(p + 4); f[0] = a[0]; f[1] = a[1]; f[2] = a[2]; f[3] = a[3]; f[4] = b[0]; f[5] = b[1]; f[6] = b[2]; f[7] = b[3]; }
DEV void lds8(const LAS float* p, float (&f)[8]) { const f32x4 a = *(const LAS f32x4*)p, b = *(const LAS f32x4*)(p + 4); f[0] = a[0]; f[1] = a[1]; f[2] = a[2]; f[3] = a[3]; f[4] = b[0]; f[5] = b[1]; f[6] = b[2]; f[7] = b[3]; }
DEV u32x4 pk8(const float (&f)[8]) { u32x4 o; o.x = pk2(f[0], f[1]); o.y = pk2(f[2], f[3]); o.z = pk2(f[4], f[5]); o.w = pk2(f[6], f[7]); return o; }

DEV bf16x8 frag_rm_pi(const LAS bf16_t* base, int ld, int row0, int k0, int lane) {
    const LAS bf16_t* a = base + (row0 + (lane & 15)) * ld + k0 + 4 * (lane >> 4);
    const s16x4 lo = *(const LAS s16x4*)a, hi = *(const LAS s16x4*)(a + 16);
    bf16x8 r; r[0] = lo[0]; r[1] = lo[1]; r[2] = lo[2]; r[3] = lo[3]; r[4] = hi[0]; r[5] = hi[1]; r[6] = hi[2]; r[7] = hi[3]; return r;
}
DEV void rc_prep8(const float (&k)[8], const float (&al)[8], const float (&kkw)[8], const float (&kaw)[8], float (&a)[8], float (&b)[8], float (&kh)[8]) {
    float kk[8]; float ss = 0.f;
#pragma unroll
    for (int e = 0; e < 8; ++e) { kk[e] = k[e] * kkw[e]; ss += kk[e] * kk[e]; }
    ss += __shfl_xor(ss, 1); ss += __shfl_xor(ss, 2); ss += __shfl_xor(ss, 4);
    const float inv = 1.0f / fmaxf(sqrtf(ss), 1e-12f);
#pragma unroll
    for (int e = 0; e < 8; ++e) { const float kn = kk[e] * inv; a[e] = -kn; b[e] = kn * al[e]; kh[e] = k[e] * (1.0f + (al[e] - 1.0f) * kaw[e]); }
}
DEV void phase_rw_cha(const Params& p, int jl, LAS unsigned char* lds) {
    const int tid = tid_(), bid = bid_(); const int lane = tid & 63, w = tid >> 6; const int fr = lane & 15, fq = lane >> 4;
    LAS float* cum = (LAS float*)lds;
    LAS float* seg = cum + 64 * 64;
    LAS float* Aab = seg + 8 * 64;
    LAS bf16_t* As = (LAS bf16_t*)(Aab + 64 * 68);
    LAS bf16_t* Bs = As + 64 * RC_LD; LAS bf16_t* Ks = Bs + 64 * RC_LD; LAS bf16_t* Vs = Ks + 64 * RC_LD; LAS bf16_t* Ke = Vs + 64 * RC_LD;
    LAS bf16_t* Aak = Ke + 64 * RC_LD; LAS bf16_t* Ts = Aak + 64 * RC_LD; LAS bf16_t* X1 = Ts + 64 * RC_LD; LAS bf16_t* Aabh = X1 + 64 * RC_LD;
    LAS bf16_t* Fimg = Aabh + 64 * RC_LD;
    LAS bf16_t* Wimg = Fimg + 4096;
    float pwd[8], pkr[8], pal[8], pv[8];
    float kkw[8], kaw[8];
    ld8(p.rw_k_k + (size_t)jl * D + (bid & 15) * 64 + (tid & 7) * 8, kkw); ld8(p.rw_k_a + (size_t)jl * D + (bid & 15) * 64 + (tid & 7) * 8, kaw);
    { const int c = bid >> 4, h = bid & 15; rc_load_wd(p, c * 64, h * 64, pwd);
      const size_t go = (size_t)(c * 64 + (tid >> 3)) * D + h * 64 + (tid & 7) * 8; ld8b(WS_(p, Kb) + go, pkr); ld8b(WS_(p, Ab) + go, pal); ld8b(WS_(p, Vb) + go, pv); }
    for (int u = bid; u < 4096; u += NB_) {
        const int c = u >> 4, h = u & 15; const int t0 = c * 64, cb = h * 64; const size_t ub = (size_t)c * 16 + h;
        lds_barrier();
        rc_cum_regs(pwd, cum, seg);
        {
            const int t = tid >> 3, k8 = (tid & 7) * 8;
            float a[8], b[8], kh[8], v[8], ct[8], cp[8], ce[8];
            rc_prep8(pkr, pal, kkw, kaw, a, b, kh);
#pragma unroll
            for (int e = 0; e < 8; ++e) v[e] = pv[e];
            if (u + NB_ < 4096) { const int un = u + NB_; const int cn = un >> 4, hn = un & 15; rc_load_wd(p, cn * 64, hn * 64, pwd);
                const size_t gn = (size_t)(cn * 64 + t) * D + hn * 64 + k8; ld8b(WS_(p, Kb) + gn, pkr); ld8b(WS_(p, Ab) + gn, pal); ld8b(WS_(p, Vb) + gn, pv); }
            lds8(cum + t * 64 + k8, ct); lds8(cum + 63 * 64 + k8, ce);
            if (t > 0) lds8(cum + (t - 1) * 64 + k8, cp); else { for (int e = 0; e < 8; ++e) cp[e] = 0.f; }
            float at[8], bt[8], kt[8], be[8], ke[8];
#pragma unroll
            for (int e = 0; e < 8; ++e) { const float ei = __expf(-ct[e]), ee = __expf(ce[e] - ct[e]); at[e] = a[e] * __expf(cp[e]); bt[e] = b[e] * ei; kt[e] = kh[e] * ei; be[e] = b[e] * ee; ke[e] = kh[e] * ee; }
            *(LAS u32x4*)(As + t * RC_LD + k8) = pk8(at); *(LAS u32x4*)(Bs + t * RC_LD + k8) = pk8(bt); *(LAS u32x4*)(Ks + t * RC_LD + k8) = pk8(kt);
            *(LAS u32x4*)(Ke + t * RC_LD + k8) = pk8(ke); *(LAS u32x4*)(Vs + t * RC_LD + k8) = pk8(v);
            const int tq = t & 31, g = (tq & 15) >> 2, j = (tq & 3) + ((tq >> 4) << 2);
#pragma unroll
            for (int e = 0; e < 8; ++e) { const int k = k8 + e; Fimg[(((k >> 4) * 2 + (t >> 5)) * 64 + g * 16 + (k & 15)) * 8 + j] = (bf16_t)f2bf(be[e]); }
            *(LAS u32x4*)(Ts + tid * 8) = (u32x4){0u, 0u, 0u, 0u}; if (tid < 64) *(LAS u32x4*)(Ts + (512 + tid) * 8) = (u32x4){0u, 0u, 0u, 0u};
            if (t == 63) { float gm[8]; for (int e = 0; e < 8; ++e) gm[e] = __expf(ce[e]); *(f32x4*)(WS_(p, RGc) + ub * 64 + k8) = (f32x4){gm[0], gm[1], gm[2], gm[3]}; *(f32x4*)(WS_(p, RGc) + ub * 64 + k8 + 4) = (f32x4){gm[4], gm[5], gm[6], gm[7]}; }
        }
        lds_barrier();
        {
            const int tb = w >> 1;
#pragma unroll
            for (int ii = 0; ii < 2; ++ii) { const int ib = 2 * (w & 1) + ii;
                f32x4 ab = {0.f, 0.f, 0.f, 0.f}, ak = {0.f, 0.f, 0.f, 0.f};
                if (ib <= tb) {
#pragma unroll
                    for (int ks = 0; ks < 2; ++ks) { const bf16x8 af = frag_rm(As, RC_LD, 16 * tb, 32 * ks, lane);
                        ab = MFMA16(af, frag_rm(Bs, RC_LD, 16 * ib, 32 * ks, lane), ab); ak = MFMA16(af, frag_rm(Ks, RC_LD, 16 * ib, 32 * ks, lane), ak); } }
#pragma unroll
                for (int r = 0; r < 4; ++r) { const int t = 16 * tb + 4 * fq + r, i = 16 * ib + fr; const bool keep = i < t;
                    Aab[t * 68 + i] = keep ? ab[r] : 0.f; Aabh[t * RC_LD + i] = (bf16_t)f2bf(keep ? ab[r] : 0.f); Aak[t * RC_LD + i] = (bf16_t)f2bf(keep ? ak[r] : 0.f); } }
            *(u32x4*)(WS_(p, RBf) + ub * 4096 + tid * 8) = *(const LAS u32x4*)(Fimg + tid * 8);
        }
        lds_barrier();
        if (w == 0) {
            const int blk = lane >> 4, jc = lane & 15;
            float Tc[16];
#pragma unroll
            for (int t = 0; t < 16; ++t) {
                float acc = jc == t ? 1.f : 0.f;
#pragma unroll
                for (int i4 = 0; i4 < (t + 3) / 4; ++i4) { const f32x4 a4 = *(const LAS f32x4*)(Aab + (16 * blk + t) * 68 + 16 * blk + i4 * 4);
#pragma unroll
                    for (int e = 0; e < 4; ++e) if (i4 * 4 + e < t) acc += a4[e] * Tc[i4 * 4 + e]; }
                Tc[t] = acc;
            }
#pragma unroll
            for (int t = 0; t < 16; ++t) Ts[(16 * blk + t) * RC_LD + 16 * blk + jc] = (bf16_t)f2bf(Tc[t]);
#pragma unroll
            for (int b = 1; b < 4; ++b) {
                const s16x4 dlo = *(const LAS s16x4*)(Ts + (16 * b + fr) * RC_LD + 16 * b + 4 * fq);
                bf16x8 dfr; dfr[0] = dlo[0]; dfr[1] = dlo[1]; dfr[2] = dlo[2]; dfr[3] = dlo[3]; dfr[4] = 0; dfr[5] = 0; dfr[6] = 0; dfr[7] = 0;
                f32x4 tt_[3];
#pragma unroll
                for (int cbk = 0; cbk < b; ++cbk) {
                    f32x4 x = {0.f, 0.f, 0.f, 0.f};
#pragma unroll
                    for (int ks = 0; ks < 2; ++ks) x = MFMA16(frag_rm(Aabh, RC_LD, 16 * b, 32 * ks, lane), frag_tr(Ts, RC_LD, 32 * ks, 16 * cbk, lane), x);
                    u32x4 xb; xb.x = pk2(x[0], x[1]); xb.y = pk2(x[2], x[3]); xb.z = 0u; xb.w = 0u;
                    tt_[cbk] = MFMA16(dfr, __builtin_bit_cast(bf16x8, xb), ((f32x4){0.f, 0.f, 0.f, 0.f}));
                }
#pragma unroll
                for (int cbk = 0; cbk < b; ++cbk)
#pragma unroll
                    for (int r = 0; r < 4; ++r) Ts[(16 * b + 4 * fq + r) * RC_LD + 16 * cbk + fr] = (bf16_t)f2bf(tt_[cbk][r]);
            }
        } else {
            for (int tl = w - 1; tl < 32; tl += 7) {
                const int rb = (tl & 15) >> 2, vbk = tl & 3; f32x4 acc = {0.f, 0.f, 0.f, 0.f};
                if (tl < 16) {
#pragma unroll
                    for (int ks = 0; ks < 2; ++ks) acc = MFMA16(frag_rm(Aak, RC_LD, 16 * rb, 32 * ks, lane), frag_tr(Vs, RC_LD, 32 * ks, 16 * vbk, lane), acc);
#pragma unroll
                    for (int r = 0; r < 4; ++r) X1[(16 * rb + 4 * fq + r) * RC_LD + 16 * vbk + fr] = (bf16_t)f2bf(acc[r]);
                } else {
#pragma unroll
                    for (int ks = 0; ks < 2; ++ks) acc = MFMA16(frag_tr(Ke, RC_LD, 32 * ks, 16 * rb, lane), frag_tr(Vs, RC_LD, 32 * ks, 16 * vbk, lane), acc);
                    { u32x2 o; o.x = pk2(acc[0], acc[1]); o.y = pk2(acc[2], acc[3]); *(u32x2*)(WS_(p, RNa) + (((ub * 4 + vbk) * 4 + rb) * 64 + lane) * 4) = o; }
                }
            }
        }
        lds_barrier();
#pragma unroll
        for (int q = 0; q < 4; ++q) { const int tl = w * 4 + q; const int tt = (tl & 15) >> 2, cbk = tl & 3; f32x4 acc = {0.f, 0.f, 0.f, 0.f};
            if (tl < 16) {
#pragma unroll
                for (int ks = 0; ks < 2; ++ks) acc = MFMA16(frag_rm(Ts, RC_LD, 16 * tt, 32 * ks, lane), frag_tr(As, RC_LD, 32 * ks, 16 * cbk, lane), acc);
                const int k = 16 * cbk + fr, kq = k & 31, g = (kq & 15) >> 2, j = (kq & 3) + ((kq >> 4) << 2);
#pragma unroll
                for (int r = 0; r < 4; ++r) Wimg[((tt * 2 + (k >> 5)) * 64 + g * 16 + 4 * fq + r) * 8 + j] = (bf16_t)f2bf(acc[r]);
            } else {
#pragma unroll
                for (int ks = 0; ks < 2; ++ks) acc = MFMA16(frag_rm(Ts, RC_LD, 16 * tt, 32 * ks, lane), frag_tr(X1, RC_LD, 32 * ks, 16 * cbk, lane), acc);
                { u32x2 o; o.x = pk2(acc[0], acc[1]); o.y = pk2(acc[2], acc[3]); *(u32x2*)(WS_(p, RUt) + (((ub * 4 + cbk) * 4 + tt) * 64 + lane) * 4) = o; }
            } }
        lds_barrier();
        *(u32x4*)(WS_(p, RWf) + ub * 4096 + tid * 8) = *(const LAS u32x4*)(Wimg + tid * 8);
    }
}

constexpr int RB_SLOT = 20992, RB_R = 6, RB_P = 5;
struct RbOpsA { bf16x8 wf[8]; u32x2 ut[4]; };
struct RbOpsB { bf16x8 bf[8]; u32x2 na[4]; f32x4 gc[4]; };
DEV void rb_read_a(const LAS unsigned char* slot, int lane, RbOpsA& O) {
#pragma unroll
    for (int f = 0; f < 8; ++f) O.wf[f] = *(const LAS bf16x8*)(slot + (f * 64 + lane) * 16);
#pragma unroll
    for (int q = 0; q < 4; ++q) O.ut[q] = *(const LAS u32x2*)(slot + 16384 + (q * 64 + lane) * 8);
}
DEV void rb_read_b(const LAS unsigned char* slot, int lane, RbOpsB& O) {
    const int fq = lane >> 4;
#pragma unroll
    for (int f = 0; f < 8; ++f) O.bf[f] = *(const LAS bf16x8*)(slot + 8192 + (f * 64 + lane) * 16);
#pragma unroll
    for (int q = 0; q < 4; ++q) { O.na[q] = *(const LAS u32x2*)(slot + 18432 + (q * 64 + lane) * 8); O.gc[q] = *(const LAS f32x4*)(slot + 20480 + (16 * q + 4 * fq) * 4); }
}
DEV void phase_rw_chb(const Params& p, int layer, LAS unsigned char* lds) {
    const int tid = tid_(), bid = bid_();
    if (bid >= 64) {
        if (layer == 0) { int tb = convert_jobs<8, 12>(p, lds, 64, NB_ - 64);
#pragma unroll 1
            for (int ml = 0; ml < 2; ++ml) { const ConvJob J0 = moe_job(p, 0, ml), J1 = moe_job(p, 1, ml); convert_one(J0, lds, 64, NB_ - 64, tb); tb += J0.ntiles(); convert_one(J1, lds, 64, NB_ - 64, tb); tb += J1.ntiles(); } }
        else { const ConvJob J0 = moe_job(p, 0, layer), J1 = moe_job(p, 1, layer); convert_one(J0, lds, 64, NB_ - 64, 0); convert_one(J1, lds, 64, NB_ - 64, J0.ntiles()); }
        return; }
    const int lane = tid & 63, w = __builtin_amdgcn_readfirstlane(tid >> 6); const int head = bid & 15, vb = bid >> 4;
    auto issue = [&](int c) {
        const size_t ub = (size_t)c * 16 + head; LAS unsigned char* slot = lds + (c % RB_R) * RB_SLOT;
#pragma unroll
        for (int i = 0; i < 3; ++i) { const int pi = (w - 1) * 3 + i;
            if (pi < 8) __builtin_amdgcn_global_load_lds((const unsigned*)(WS_(p, RWf) + ub * 4096 + pi * 512 + lane * 8), (LAS unsigned*)(slot + pi * 1024), 16, 0, 0);
            else if (pi < 16) __builtin_amdgcn_global_load_lds((const unsigned*)(WS_(p, RBf) + ub * 4096 + (pi - 8) * 512 + lane * 8), (LAS unsigned*)(slot + 8192 + (pi - 8) * 1024), 16, 0, 0);
            else if (pi < 18) __builtin_amdgcn_global_load_lds((const unsigned*)(WS_(p, RUt) + (ub * 4 + vb) * 1024 + (pi - 16) * 512 + lane * 8), (LAS unsigned*)(slot + 16384 + (pi - 16) * 1024), 16, 0, 0);
            else if (pi < 20) __builtin_amdgcn_global_load_lds((const unsigned*)(WS_(p, RNa) + (ub * 4 + vb) * 1024 + (pi - 18) * 512 + lane * 8), (LAS unsigned*)(slot + 18432 + (pi - 18) * 1024), 16, 0, 0);
            else __builtin_amdgcn_global_load_lds((const unsigned*)(WS_(p, RGc) + ub * 64 + lane), (LAS unsigned*)(slot + 20480), 4, 0, 0);
        }
    };
    if (w > 0) {
#pragma unroll 1
        for (int c = 0; c < RB_P; ++c) issue(c);
        asm volatile("s_waitcnt vmcnt(9)" ::: "memory");
    }
    __builtin_amdgcn_s_barrier();
    f32x4 s[4]; for (int i = 0; i < 4; ++i) s[i] = (f32x4){0.f, 0.f, 0.f, 0.f};
    RbOpsA cur, nxt; RbOpsB cb_;
    if (w == 0) { rb_read_a(lds, lane, cur); }
#pragma unroll 1
    for (int c = 0; c < 256; ++c) {
        if (w > 0) {
            if (c + RB_P < 256) { issue(c + RB_P); asm volatile("s_waitcnt vmcnt(9)" ::: "memory"); }
            else asm volatile("s_waitcnt vmcnt(0)" ::: "memory");
        } else {
            const size_t ub = (size_t)c * 16 + head;
            rb_read_b(lds + (c % RB_R) * RB_SLOT, lane, cb_);
            rb_read_a(lds + ((c + 1 < 256 ? c + 1 : c) % RB_R) * RB_SLOT, lane, nxt);
            bf16x8 sb[2];
#pragma unroll
            for (int ks = 0; ks < 2; ++ks) { u32x4 o; o.x = pk2(s[2 * ks][0], s[2 * ks][1]); o.y = pk2(s[2 * ks][2], s[2 * ks][3]); o.z = pk2(s[2 * ks + 1][0], s[2 * ks + 1][1]); o.w = pk2(s[2 * ks + 1][2], s[2 * ks + 1][3]); sb[ks] = __builtin_bit_cast(bf16x8, o); *(u32x4*)(WS_(p, RS0) + (((ub * 4 + vb) * 2 + ks) * 64 + lane) * 8) = o; }
            f32x4 uu[4];
#pragma unroll
            for (int tt = 0; tt < 4; ++tt) { uu[tt] = (f32x4){bflo(cur.ut[tt].x), bfhi(cur.ut[tt].x), bflo(cur.ut[tt].y), bfhi(cur.ut[tt].y)}; uu[tt] = MFMA16(cur.wf[tt * 2], sb[0], uu[tt]); uu[tt] = MFMA16(cur.wf[tt * 2 + 1], sb[1], uu[tt]); }
            bf16x8 ubf[2];
#pragma unroll
            for (int ks = 0; ks < 2; ++ks) { u32x4 o; o.x = pk2(uu[2 * ks][0], uu[2 * ks][1]); o.y = pk2(uu[2 * ks][2], uu[2 * ks][3]); o.z = pk2(uu[2 * ks + 1][0], uu[2 * ks + 1][1]); o.w = pk2(uu[2 * ks + 1][2], uu[2 * ks + 1][3]); ubf[ks] = __builtin_bit_cast(bf16x8, o); *(u32x4*)(WS_(p, RUa) + (((ub * 4 + vb) * 2 + ks) * 64 + lane) * 8) = o; }
#pragma unroll
            for (int kt = 0; kt < 4; ++kt) { s[kt] = s[kt] * cb_.gc[kt] + (f32x4){bflo(cb_.na[kt].x), bfhi(cb_.na[kt].x), bflo(cb_.na[kt].y), bfhi(cb_.na[kt].y)}; s[kt] = MFMA16(cb_.bf[kt * 2], ubf[0], s[kt]); s[kt] = MFMA16(cb_.bf[kt * 2 + 1], ubf[1], s[kt]); }
            cur = nxt;
            asm volatile("s_waitcnt lgkmcnt(0)" ::: "memory");
        }
        __builtin_amdgcn_s_barrier();
    }
    asm volatile("s_waitcnt vmcnt(0)" ::: "memory");
}

DEV void phase_rw_chc(const Params& p, int j, LAS unsigned char* lds) {
    const int tid = tid_(), bid = bid_(); const int lane = tid & 63, w = tid >> 6; const int fr = lane & 15, fq = lane >> 4;
    LAS float* cum = (LAS float*)lds;
    LAS float* seg = cum + 64 * 64;
    LAS float* Ys = seg + 8 * 64;
    LAS bf16_t* Rs = (LAS bf16_t*)(Ys + 64 * 68);
    LAS bf16_t* Bs = Rs + 64 * RC_LD; LAS bf16_t* Ks = Bs + 64 * RC_LD; LAS bf16_t* Vs = Ks + 64 * RC_LD; LAS bf16_t* Arb = Vs + 64 * RC_LD; LAS bf16_t* Ark = Arb + 64 * RC_LD;
    float pwd[8], pr[8], pkr[8], pal[8], pv[8], pg[8];
    float kkw[8], kaw[8], rkw[8], lgw[8], lbw[8];
    { const size_t po = (size_t)j * D + (bid & 15) * 64 + (tid & 7) * 8; ld8(p.rw_k_k + po, kkw); ld8(p.rw_k_a + po, kaw); ld8(p.rw_r_k + po, rkw); ld8(p.rw_lnx_g + po, lgw); ld8(p.rw_lnx_b + po, lbw); }
    { const int c = bid >> 4, h = bid & 15; rc_load_wd(p, c * 64, h * 64, pwd);
      const size_t go = (size_t)(c * 64 + (tid >> 3)) * D + h * 64 + (tid & 7) * 8; ld8b(WS_(p, Rb) + go, pr); ld8b(WS_(p, Kb) + go, pkr); ld8b(WS_(p, Ab) + go, pal); ld8b(WS_(p, Vb) + go, pv); ld8b(WS_(p, Gb) + go, pg); }
    for (int u = bid; u < 4096; u += NB_) {
        const int c = u >> 4, h = u & 15; const int t0 = c * 64, cb = h * 64; const size_t ub = (size_t)c * 16 + h;
        const int tt = w & 3;
        bf16x8 ufr[2][2], sfr[2][2];
#pragma unroll
        for (int q = 0; q < 2; ++q)
#pragma unroll
            for (int ks = 0; ks < 2; ++ks) { const size_t o = (((ub * 4 + 2 * (w >> 2) + q) * 2 + ks) * 64 + lane) * 8;
                ufr[q][ks] = *(const bf16x8*)(WS_(p, RUa) + o); sfr[q][ks] = *(const bf16x8*)(WS_(p, RS0) + o); }
        lds_barrier();
        rc_cum_regs(pwd, cum, seg);
#ifdef DBL_CUM
        rc_cum_regs(pwd, cum, seg);
#endif
        const int t = tid >> 3, k8 = (tid & 7) * 8; const size_t go = (size_t)(t0 + t) * D + cb + k8;
        float v[8], gg[8]; float bc;
        {   float r[8], a[8], b[8], kh[8], ct[8];
#pragma unroll
            for (int e = 0; e < 8; ++e) { r[e] = pr[e]; v[e] = pv[e]; gg[e] = pg[e]; }
            lds8(cum + t * 64 + k8, ct);
            rc_prep8(pkr, pal, kkw, kaw, a, b, kh);
            if (u + NB_ < 4096) { const int un = u + NB_; const int cn = un >> 4, hn = un & 15; rc_load_wd(p, cn * 64, hn * 64, pwd);
                const size_t gn = (size_t)(cn * 64 + t) * D + hn * 64 + k8; ld8b(WS_(p, Rb) + gn, pr); ld8b(WS_(p, Kb) + gn, pkr); ld8b(WS_(p, Ab) + gn, pal); ld8b(WS_(p, Vb) + gn, pv); ld8b(WS_(p, Gb) + gn, pg); }
            bc = 0.f;
#pragma unroll
            for (int e = 0; e < 8; ++e) bc += r[e] * kh[e] * rkw[e];
            bc += __shfl_xor(bc, 1); bc += __shfl_xor(bc, 2); bc += __shfl_xor(bc, 4);
#pragma unroll
            for (int e = 0; e < 8; ++e) { const float ei = __expf(-ct[e]); r[e] *= __expf(ct[e]); b[e] *= ei; kh[e] *= ei; }
            *(LAS u32x4*)(Rs + t * RC_LD + k8) = pk8(r); *(LAS u32x4*)(Bs + t * RC_LD + k8) = pk8(b); *(LAS u32x4*)(Ks + t * RC_LD + k8) = pk8(kh); *(LAS u32x4*)(Vs + t * RC_LD + k8) = pk8(v);
        }
        lds_barrier();
#ifdef DBL_S3
#pragma unroll 1
        for (int rep_ = 0; rep_ < 2; ++rep_)
#endif
        {   const int tb = w >> 1;
#pragma unroll
            for (int ii = 0; ii < 2; ++ii) { const int ib = 2 * (w & 1) + ii;
                f32x4 ab = {0.f, 0.f, 0.f, 0.f}, ak = {0.f, 0.f, 0.f, 0.f};
                if (ib <= tb) {
#pragma unroll
                    for (int ks = 0; ks < 2; ++ks) { const bf16x8 af = frag_rm(Rs, RC_LD, 16 * tb, 32 * ks, lane);
                        ab = MFMA16(af, frag_rm(Bs, RC_LD, 16 * ib, 32 * ks, lane), ab); ak = MFMA16(af, frag_rm(Ks, RC_LD, 16 * ib, 32 * ks, lane), ak); } }
#pragma unroll
                for (int r = 0; r < 4; ++r) { const int tr = 16 * tb + 4 * fq + r, i = 16 * ib + fr; const bool keep = i <= tr;
                    Arb[tr * RC_LD + i] = (bf16_t)f2bf(keep ? ab[r] : 0.f); Ark[tr * RC_LD + i] = (bf16_t)f2bf(keep ? ak[r] : 0.f); } }
        }
        lds_barrier();
#ifdef DBL_Y
#pragma unroll 1
        for (int rep_ = 0; rep_ < 2; ++rep_)
#endif
#pragma unroll
        for (int q = 0; q < 2; ++q) { const int vbk = 2 * (w >> 2) + q; f32x4 acc = {0.f, 0.f, 0.f, 0.f};
#pragma unroll
            for (int ks = 0; ks < 2; ++ks) {
                acc = MFMA16(frag_rm_pi(Rs, RC_LD, 16 * tt, 32 * ks, lane), sfr[q][ks], acc);
                acc = MFMA16(frag_rm_pi(Arb, RC_LD, 16 * tt, 32 * ks, lane), ufr[q][ks], acc);
                acc = MFMA16(frag_rm(Ark, RC_LD, 16 * tt, 32 * ks, lane), frag_tr(Vs, RC_LD, 32 * ks, 16 * vbk, lane), acc); }
#pragma unroll
            for (int r = 0; r < 4; ++r) Ys[(16 * tt + 4 * fq + r) * 68 + 16 * vbk + fr] = acc[r]; }
        lds_barrier();
        {
            float y[8]; lds8(Ys + t * 68 + k8, y);
            float s1 = 0.f, s2 = 0.f;
#pragma unroll
            for (int e = 0; e < 8; ++e) { s1 += y[e]; s2 += y[e] * y[e]; }
            s1 += __shfl_xor(s1, 1); s1 += __shfl_xor(s1, 2); s1 += __shfl_xor(s1, 4); s2 += __shfl_xor(s2, 1); s2 += __shfl_xor(s2, 2); s2 += __shfl_xor(s2, 4);
            const float mean = s1 * (1.0f / 64.0f), var = s2 * (1.0f / 64.0f) - mean * mean; const float rs = rsqrtf(fmaxf(var, 0.f) + 64e-5f);
            float o[8];
#pragma unroll
            for (int e = 0; e < 8; ++e) o[e] = ((y[e] - mean) * rs * lgw[e] + lbw[e] + bc * v[e]) * gg[e];
            *(u32x4*)(WS_(p, YB) + go) = pk8(o);
        }
    }
}
DEV void phase_ln1(const Params& p, int layer, LAS unsigned char* lds) {
    const int tid = tid_(), bid = bid_(); (void)tid; (void)bid;
    const int lane = tid & 63, wid = tid >> 6; const int fr = lane & 15, fq = lane >> 4;
    LAS float* lgt = (LAS float*)lds;
    LAS int* cnt = (LAS int*)(lgt + 2 * 64 * 48);
    if (tid < 32) cnt[tid] = 0;
    const float* g = p.ln_g + ((size_t)layer * 2 + 0) * D; const float* be = p.ln_b + ((size_t)layer * 2 + 0) * D;
    const float* br = p.moe_b_route + layer * 32; const float* bg = p.moe_b_group + layer * 4;
    f32x4 gwv[4], bwv[4];
#pragma unroll
    for (int q = 0; q < 4; ++q) { gwv[q] = *(const f32x4*)(g + RCOL(q, lane)); bwv[q] = *(const f32x4*)(be + RCOL(q, lane)); }
    u32x2 rh[4], rm[4];
#pragma unroll
    for (int q = 0; q < 4; ++q) { rh[q] = *(const u32x2*)(WS_(p, Hb) + (size_t)(bid * 64 + wid * 8) * D + RCOL(q, lane)); rm[q] = *(const u32x2*)(WS_(p, MIXb) + (size_t)(bid * 64 + wid * 8) * D + RCOL(q, lane)); }
#pragma unroll 1
    for (int rr = 0; rr < 8; ++rr) {
        const int t = bid * 64 + wid * 8 + rr; const size_t ro = (size_t)t * D;
        f32x4 z[4], m[4];
#pragma unroll
        for (int q = 0; q < 4; ++q) { z[q] = (f32x4){bflo(rh[q].x), bfhi(rh[q].x), bflo(rh[q].y), bfhi(rh[q].y)}; m[q] = (f32x4){bflo(rm[q].x), bfhi(rm[q].x), bflo(rm[q].y), bfhi(rm[q].y)}; }
        { const size_t rn = (size_t)(rr < 7 ? t + 1 : t) * D;
#pragma unroll
          for (int q = 0; q < 4; ++q) { rh[q] = *(const u32x2*)(WS_(p, Hb) + rn + RCOL(q, lane)); rm[q] = *(const u32x2*)(WS_(p, MIXb) + rn + RCOL(q, lane)); } }
        float s = 0.f;
#pragma unroll
        for (int q = 0; q < 4; ++q) { z[q] = z[q] * ALPHA + m[q]; s += z[q][0] + z[q][1] + z[q][2] + z[q][3]; }
        const float mean = wave_sum(s) * (1.0f / D);
        float vs = 0.f;
#pragma unroll
        for (int q = 0; q < 4; ++q) { z[q] = z[q] - mean; vs += z[q][0] * z[q][0] + z[q][1] * z[q][1] + z[q][2] * z[q][2] + z[q][3] * z[q][3]; }
        const float rs = rsqrtf(wave_sum(vs) * (1.0f / D) + LN_EPS);
#pragma unroll
        for (int q = 0; q < 4; ++q) {
            st_bf4(WS_(p, H1b) + ro + RCOL(q, lane), z[q] * rs * gwv[q] + bwv[q]);
        }
    }
    asm volatile("s_waitcnt vmcnt(0)" ::: "memory");
    __syncthreads();
    {   const int rt = wid & 3, kh = wid >> 2;
        const bf16_t* Ab = WS_(p, H1b) + (size_t)(bid * 64 + 16 * rt + fr) * D + 512 * kh + 8 * fq;
        const bf16_t* Wb = WS_(p, moe_wr_t) + (size_t)layer * 48 * D + (size_t)fr * D + 512 * kh + 8 * fq;
        f32x4 acc[3]; for (int i = 0; i < 3; ++i) acc[i] = (f32x4){0.f, 0.f, 0.f, 0.f};
#pragma unroll 8
        for (int ks = 0; ks < 16; ++ks) {
            const bf16x8 af = *(const bf16x8*)(Ab + 32 * ks);
#pragma unroll
            for (int ct = 0; ct < 3; ++ct) acc[ct] = MFMA16(af, *(const bf16x8*)(Wb + (size_t)16 * ct * D + 32 * ks), acc[ct]);
        }
#pragma unroll
        for (int ct = 0; ct < 3; ++ct)
#pragma unroll
            for (int r = 0; r < 4; ++r) lgt[(kh * 64 + 16 * rt + 4 * fq + r) * 48 + 16 * ct + fr] = acc[ct][r];
    }
    __syncthreads();
    if (tid < 64) {
        const int t = bid * 64 + tid; const LAS float* L0 = lgt + tid * 48; const LAS float* L1 = lgt + (64 + tid) * 48;
        const float q0 = L0[32] + L1[32] + bg[0], q1 = L0[33] + L1[33] + bg[1], q2 = L0[34] + L1[34] + bg[2], q3 = L0[35] + L1[35] + bg[3];
        int gi = 0; float gm = q0;
        if (q1 > gm) { gm = q1; gi = 1; } if (q2 > gm) { gm = q2; gi = 2; } if (q3 > gm) { gm = q3; gi = 3; }
        const float den = __expf(q0 - gm) + __expf(q1 - gm) + __expf(q2 - gm) + __expf(q3 - gm);
        const float pgrp = __builtin_amdgcn_rcpf(den);
        float l1 = -INFINITY, l2 = -INFINITY; int i1 = 0, i2 = 0;
#pragma unroll 1
        for (int o = 0; o < 8; ++o) { const float v = L0[gi * 8 + o] + L1[gi * 8 + o] + br[gi * 8 + o];
            if (v > l1) { l2 = l1; i2 = i1; l1 = v; i1 = o; } else if (v > l2) { l2 = v; i2 = o; } }
        const float e2 = __expf(l2 - l1), inv = __builtin_amdgcn_rcpf(1.0f + e2);
        const int e0 = gi * 8 + i1, e1 = gi * 8 + i2;
        WS_(p, EIDX)[2 * t] = e0; WS_(p, EIDX)[2 * t + 1] = e1; WS_(p, GATE)[2 * t] = pgrp * inv; WS_(p, GATE)[2 * t + 1] = pgrp * e2 * inv;
        atomicAdd((int*)&cnt[e0], 1); atomicAdd((int*)&cnt[e1], 1);
    }
    __syncthreads();
    if (tid < 32) WS_(p, CNT)[bid * 32 + tid] = cnt[tid];
}

DEV void phase_moe_scatter(const Params& p, LAS unsigned char* lds) {
    const int tid = tid_(), bid = bid_(); (void)tid; (void)bid;
    const int lane = tid & 63, wid = tid >> 6;
    LAS int* part = (LAS int*)lds;
    LAS int* pre = part + 512;
    LAS int* base = pre + 512;
    LAS int* pst = base + 32;
    LAS int* dst = pst + 40;
    LAS int* eid = dst + 128;
    { const int e = tid & 31, part_i = tid >> 5; int tot = 0, prf = 0;
      for (int b = part_i * 16; b < part_i * 16 + 16; ++b) { const int c = WS_(p, CNT)[b * 32 + e]; tot += c; if (b < (int)bid) prf += c; }
      part[part_i * 32 + e] = tot; pre[part_i * 32 + e] = prf; }
    if (tid < 128) eid[tid] = WS_(p, EIDX)[bid * 128 + tid];
    if (bid == 1 && tid < MFLAG_TICKET + 32) __hip_atomic_store(WS_(p, MFLAG) + tid * MFLAG_STRIDE, 0u, __ATOMIC_RELAXED, __HIP_MEMORY_SCOPE_AGENT);
    lds_barrier();
    if (tid < 32) { int tot = 0, prf = 0; for (int i = 0; i < 16; ++i) { tot += part[i * 32 + tid]; prf += pre[i * 32 + tid]; } part[tid] = tot; pre[tid] = prf; }
    lds_barrier();
    if (tid == 0) { int acc = 0; for (int e = 0; e < 32; ++e) { pst[e] = acc; acc += ((part[e] + 255) >> 8) << 8; } pst[32] = acc;
        if (bid == 0) { for (int e = 0; e <= 32; ++e) WS_(p, TAB)[e] = pst[e]; WS_(p, TAB)[33] = acc >> 8;
            for (int e = 0; e < 32; ++e) for (int mt = pst[e] >> 8; mt < (pst[e + 1] >> 8); ++mt) WS_(p, TAB)[64 + mt] = e; } }
    lds_barrier();
    if (tid < 32) { int run = pst[tid] + pre[tid];
#pragma unroll 16
        for (int a = 0; a < 128; ++a) if (eid[a] == tid) dst[a] = run++; }
    lds_barrier();
    if (tid < 128) WS_(p, DEST)[bid * 128 + tid] = dst[tid];
#pragma unroll 4
    for (int a = wid * 16; a < wid * 16 + 16; ++a) {
        const int t = bid * 64 + (a >> 1); const int d = dst[a];
        const u32x4 v0 = *(const u32x4*)(WS_(p, H1b) + (size_t)t * D + lane * 8), v1 = *(const u32x4*)(WS_(p, H1b) + (size_t)t * D + 512 + lane * 8);
        *(u32x4*)(WS_(p, BUF) + (size_t)d * D + lane * 8) = v0; *(u32x4*)(WS_(p, BUF) + (size_t)d * D + 512 + lane * 8) = v1;
    }
}

template <int which> struct SchedMoe {
    const Params* p; int layer; const LAS int* tab;
    DEV bool next(int i, Unit& u) const {
        const int nmt = tab[33]; int pm, pn; if (!pg8::tile_order(i, NB_, which == 0 ? bid_() : ((bid_() + 128) & 255), nmt, 4, pm, pn)) return false;
        const int row0 = pm * 256; const int e = tab[64 + pm];
        if constexpr (which == 0) { u.A = (const char*)(WS_(*p, BUF) + (size_t)row0 * D); u.B = (const char*)(WS_(*p, moe_w1_t) + ((size_t)layer * 32 + e) * 1024 * 1024 + (size_t)pn * 256 * 1024); }
        else {
            if (tid_() == 0) { unsigned* f = WS_(*p, MFLAG) + pm * MFLAG_STRIDE; unsigned sp = 0;
                while (__hip_atomic_load(f, __ATOMIC_RELAXED, __HIP_MEMORY_SCOPE_AGENT) < 4u) { __builtin_amdgcn_s_sleep(1); if (++sp > (1u << 24)) break; }
                __builtin_amdgcn_fence(__ATOMIC_ACQUIRE, "agent");
                asm volatile("s_waitcnt vmcnt(0)" ::: "memory"); }
            __builtin_amdgcn_s_barrier();
            u.A = (const char*)(WS_(*p, ACT) + (size_t)row0 * 512); u.B = (const char*)(WS_(*p, moe_w2_t) + ((size_t)layer * 32 + e) * 1024 * 512 + (size_t)pn * 256 * 512); }
        u.row0 = row0; u.col0 = pn * 256; u.id = e; u.aux = 0; return true;
    }
};
struct EpiMoe1 {
    bf16_t* O; unsigned* flag;
    DEV void operator()(const AccT& acc, const Unit& u, int wr, int wc, int fr, int fq) const {
        const __amdgpu_buffer_rsrc_t rs = __builtin_amdgcn_make_buffer_rsrc(O, 0, MOE_ROWS * 512 * 2, 0x00020000);
#pragma unroll
        for (int ai = 0; ai < 2; ++ai)
#pragma unroll
            for (int m = 0; m < 4; ++m) {
                f32x4 v[2];
#pragma unroll
                for (int n = 0; n < 2; ++n) { const f32x4 gt = acc[ai][0][m][n], up = acc[ai][1][m][n]; for (int e = 0; e < 4; ++e) v[n][e] = siluf_(gt[e]) * up[e]; }
                const int col = (u.col0 >> 1) + 32 * wc + (PF(6) ? 8 * fq : 4 * fq);
                if (PF(6)) __builtin_amdgcn_raw_buffer_store_b128(pk8v(v[0], v[1]), rs, (unsigned)((ACC_ROW(u, ai, m) * 512 + col) * 2), 0, 16);
                else { const u32x4 w = pk8v(v[0], v[1]); unsigned long long* q = (unsigned long long*)(O + (size_t)ACC_ROW(u, ai, m) * 512 + col);
                  __hip_atomic_store(q, (unsigned long long)w.x | ((unsigned long long)w.y << 32), __ATOMIC_RELAXED, __HIP_MEMORY_SCOPE_AGENT);
                  __hip_atomic_store(q + 4, (unsigned long long)w.z | ((unsigned long long)w.w << 32), __ATOMIC_RELAXED, __HIP_MEMORY_SCOPE_AGENT); }
                ACC_FENCE;
            }
        asm volatile("s_waitcnt vmcnt(0)" ::: "memory");
        __builtin_amdgcn_s_barrier();
        if (wr == 1 && wc == 0 && fr == 0 && fq == 0) __hip_atomic_fetch_add(flag + (u.row0 >> 8) * MFLAG_STRIDE, 1u, __ATOMIC_RELAXED, __HIP_MEMORY_SCOPE_AGENT);
    }
};
struct EpiMoe2 {
    bf16_t* O;
    DEV void operator()(const AccT& acc, const Unit& u, int wr, int wc, int fr, int fq) const {
        FOR_ACC2(ai, bj, m) { st_bf8p(O + (size_t)ACC_ROW(u, ai, m) * D + ACC_COL8P(u, bj, PF(7)), acc[ai][bj][m][0], acc[ai][bj][m][1], PF(7)); ACC_FENCE; }
    }
};

struct Ln2Raw { u32x2 h[4], a[4], b[4]; float g0, g1; };
DEV void ln2_issue(const Params& p, int t, int lane, Ln2Raw& R, int dpre, float gpre, int tbase) {
    const int i0 = 2 * (t - tbase); const int d0 = __shfl(dpre, i0), d1 = __shfl(dpre, i0 + 1); R.g0 = __shfl(gpre, i0); R.g1 = __shfl(gpre, i0 + 1);
#pragma unroll
    for (int q = 0; q < 4; ++q) { R.h[q] = *(const u32x2*)(WS_(p, H1b) + (size_t)t * D + RCOL(q, lane));
        R.a[q] = *(const u32x2*)(WS_(p, YBUF) + (size_t)d0 * D + RCOL(q, lane)); R.b[q] = *(const u32x2*)(WS_(p, YBUF) + (size_t)d1 * D + RCOL(q, lane)); }
}
DEV void ln2_finish(const Ln2Raw& R, const f32x4 (&gwv)[4], const f32x4 (&bwv)[4], f32x4 (&z)[4]) {
    float s = 0.f; const float g0 = R.g0, g1 = R.g1;
#pragma unroll
    for (int q = 0; q < 4; ++q) {
        z[q][0] = bflo(R.h[q].x) * ALPHA + g0 * bflo(R.a[q].x) + g1 * bflo(R.b[q].x); z[q][1] = bfhi(R.h[q].x) * ALPHA + g0 * bfhi(R.a[q].x) + g1 * bfhi(R.b[q].x);
        z[q][2] = bflo(R.h[q].y) * ALPHA + g0 * bflo(R.a[q].y) + g1 * bflo(R.b[q].y); z[q][3] = bfhi(R.h[q].y) * ALPHA + g0 * bfhi(R.a[q].y) + g1 * bfhi(R.b[q].y);
        s += z[q][0] + z[q][1] + z[q][2] + z[q][3];
    }
    const float mean = wave_sum(s) * (1.0f / D);
    float vs = 0.f;
#pragma unroll
    for (int q = 0; q < 4; ++q) { z[q] = z[q] - mean; vs += z[q][0] * z[q][0] + z[q][1] * z[q][1] + z[q][2] * z[q][2] + z[q][3] * z[q][3]; }
    const float rs = rsqrtf(wave_sum(vs) * (1.0f / D) + LN_EPS);
#pragma unroll
    for (int q = 0; q < 4; ++q) z[q] = z[q] * rs * gwv[q] + bwv[q];
}
DEV void phase_ln2(const Params& p, int layer, LAS unsigned char* lds) {
    const int tid = tid_(), bid = bid_(); const int lane = tid & 63, wid = tid >> 6; const int fr = lane & 15, fq = lane >> 4;
    const float* g = p.ln_g + ((size_t)layer * 2 + 1) * D; const float* be = p.ln_b + ((size_t)layer * 2 + 1) * D;
    const int nk = layer == DEPTH - 1 ? 3 : (layer + 1) % 3;
    const int nj = (layer + 1) / 3;
    LAS float* lgt = (LAS float*)lds;
    LAS float* w2 = lgt + 2 * 64 * 32;
    if (nk == 2) { for (int i = tid; i < 16 * 512; i += NTHR) w2[i] = p.gl_gk_w2[(size_t)nj * 16 * 512 + i]; }
    const int tfirst = bid * 64 + wid * 8;
    f32x4 z[4], zp[4], gwv[4], bwv[4];
#pragma unroll
    for (int q = 0; q < 4; ++q) { gwv[q] = *(const f32x4*)(g + RCOL(q, lane)); bwv[q] = *(const f32x4*)(be + RCOL(q, lane)); }
    Ln2Raw R[3];
    const int tbase = tfirst > 0 ? tfirst - 1 : 0;
    const int dpre = lane < 18 ? WS_(p, DEST)[2 * tbase + lane] : 0; const float gpre = lane < 18 ? WS_(p, GATE)[2 * tbase + lane] : 0.f;
    if (nk == 0) { if (tfirst > 0) { ln2_issue(p, tfirst - 1, lane, R[2], dpre, gpre, tbase); } }
    ln2_issue(p, tfirst, lane, R[0], dpre, gpre, tbase);
    ln2_issue(p, tfirst + 1, lane, R[1], dpre, gpre, tbase);
    if (nk == 0) { if (tfirst > 0) ln2_finish(R[2], gwv, bwv, zp); else { for (int q = 0; q < 4; ++q) zp[q] = (f32x4){0.f, 0.f, 0.f, 0.f}; } }
#pragma unroll
    for (int rr = 0; rr < 8; ++rr) {
        const int t = tfirst + rr; const size_t ro = (size_t)t * D;
        if (rr + 2 < 8) ln2_issue(p, t + 2, lane, R[(rr + 2) % 3], dpre, gpre, tbase);
        ln2_finish(R[rr % 3], gwv, bwv, z);
        if (nk == 3) {
#pragma unroll
            for (int q = 0; q < 4; ++q) *(f32x4*)(p.out + ro + RCOL(q, lane)) = z[q];
        } else store_row_bf(WS_(p, Hb) + ro, lane, z);
        if (nk == 0) {
            emit_mix6(p, nj, t, lane, z, zp);
#pragma unroll
            for (int q = 0; q < 4; ++q) zp[q] = z[q];
        }
    }
    if (nk == 1 || nk == 2) {
        asm volatile("s_waitcnt vmcnt(0)" ::: "memory");
        __syncthreads();
        const int nct = nk == 1 ? 2 : 1; const int rt = wid & 3, kh = wid >> 2;
        const bf16_t* Ab = WS_(p, Hb) + (size_t)(bid * 64 + 16 * rt + fr) * D + 512 * kh + 8 * fq;
        const bf16_t* Wb = (nk == 1 ? WS_(p, mb_dt_t) : WS_(p, gl_lr_t)) + (size_t)fr * D + 512 * kh + 8 * fq;
        f32x4 acc[2]; acc[0] = (f32x4){0.f, 0.f, 0.f, 0.f}; acc[1] = acc[0];
#pragma unroll 4
        for (int ks = 0; ks < 16; ++ks) {
            const bf16x8 af = *(const bf16x8*)(Ab + 32 * ks);
            acc[0] = MFMA16(af, *(const bf16x8*)(Wb + 32 * ks), acc[0]);
            if (nct == 2) acc[1] = MFMA16(af, *(const bf16x8*)(Wb + (size_t)16 * D + 32 * ks), acc[1]);
        }
#pragma unroll
        for (int ct = 0; ct < 2; ++ct)
#pragma unroll
            for (int r = 0; r < 4; ++r) lgt[(kh * 64 + 16 * rt + 4 * fq + r) * 32 + 16 * ct + fr] = acc[ct][r];
        __syncthreads();
        if (nk == 1) {
#pragma unroll
            for (int i = 0; i < 4; ++i) { const int idx = tid + i * NTHR; const int row = idx >> 5, o = idx & 31;
                WS_(p, DT)[(size_t)(bid * 64 + row) * 32 + o] = softplusf_(lgt[row * 32 + o] + lgt[(64 + row) * 32 + o] + p.mb_dt_bias[nj * 32 + o]); }
        } else {
            const int row = tid >> 3, c0 = (tid & 7) * 64; float lr[16];
#pragma unroll
            for (int o = 0; o < 16; ++o) lr[o] = lgt[row * 32 + o] + lgt[(64 + row) * 32 + o];
#pragma unroll 1
            for (int c4 = 0; c4 < 16; ++c4) { const int c = c0 + 4 * c4; f32x4 a = *(const f32x4*)(p.gl_gk_b + nj * 512 + c);
#pragma unroll
                for (int o = 0; o < 16; ++o) { const f32x4 wv = *(const LAS f32x4*)(w2 + o * 512 + c); a = a + wv * lr[o]; }
                f32x4 r;
#pragma unroll
                for (int e = 0; e < 4; ++e) r[e] = (fminf(a[e], 0.f) - __logf(1.0f + __expf(-fabsf(a[e])))) * (1.0f / 16.0f);
                *(f32x4*)(WS_(p, LA) + (size_t)(bid * 64 + row) * 512 + c) = r; }
        }
    }
}
constexpr int MB_PROJ = 5152;
struct SchedMbIn {
    const Params* p;
    DEV bool next(int i, Unit& u) const {
        int pm, pn; if (!pg8::tile_order(i, NB_, bid_(), 64, 20, pm, pn)) return false;
        u.A = (const char*)(WS_(*p, Hb) + (size_t)pm * 256 * D); u.B = (const char*)(WS_(*p, mb_win_t) + (size_t)pn * 256 * D); u.row0 = pm * 256; u.col0 = pn * 256; u.id = 0; u.aux = 0; return true;
    }
};
struct EpiMbIn {
    const Params* p;
    DEV void operator()(const AccT& acc, const Unit& u, int wr, int wc, int fr, int fq) const {
        const bool isz = u.col0 < 2048; bf16_t* O = WS_(*p, Z) + (isz ? (size_t)0 : (size_t)T * 2048 - 2048); const int ld = isz ? 2048 : 3072;
        FOR_ACC2(ai, bj, m) { st_bf8p(O + (size_t)ACC_ROW(u, ai, m) * ld + ACC_COL8P(u, bj, PF(4)), acc[ai][bj][m][0], acc[ai][bj][m][1], PF(4)); ACC_FENCE; }
    }
};
DEV void phase_mb_conv(const Params& p, int j) {
    const int tid = tid_(), bid = bid_(); (void)tid; (void)bid;
    if (tid >= 384) return;
    const int c0 = tid * 8; const int t0 = bid * 64;
    const float* cw = p.mb_conv_w + (size_t)j * 4 * 3072; const float* cb = p.mb_conv_b + (size_t)j * 3072;
    float w[4][8], b[8];
#pragma unroll
    for (int i = 0; i < 4; ++i) { const f32x4 a = *(const f32x4*)(cw + i * 3072 + c0), bb = *(const f32x4*)(cw + i * 3072 + c0 + 4); for (int e = 0; e < 4; ++e) { w[i][e] = a[e]; w[i][4 + e] = bb[e]; } }
    { const f32x4 a = *(const f32x4*)(cb + c0), bb = *(const f32x4*)(cb + c0 + 4); for (int e = 0; e < 4; ++e) { b[e] = a[e]; b[4 + e] = bb[e]; } }
    float x0[8], x1[8], x2[8], x3[8];
    auto ld = [&](int t, float (&x)[8]) {
        if (t < 0) { for (int e = 0; e < 8; ++e) x[e] = 0.f; return; }
        const u32x4 v = *(const u32x4*)(WS_(p, XBC) + (size_t)t * 3072 + c0);
        x[0] = bflo(v.x); x[1] = bfhi(v.x); x[2] = bflo(v.y); x[3] = bfhi(v.y); x[4] = bflo(v.z); x[5] = bfhi(v.z); x[6] = bflo(v.w); x[7] = bfhi(v.w);
    };
    ld(t0 - 3, x0); ld(t0 - 2, x1); ld(t0 - 1, x2);
#pragma unroll 4
    for (int tt = 0; tt < 64; ++tt) {
        ld(t0 + tt, x3);
        float o[8];
#pragma unroll
        for (int e = 0; e < 8; ++e) o[e] = siluf_(b[e] + w[0][e] * x0[e] + w[1][e] * x1[e] + w[2][e] * x2[e] + w[3][e] * x3[e]);
        u32x4 r; r.x = pk2(o[0], o[1]); r.y = pk2(o[2], o[3]); r.z = pk2(o[4], o[5]); r.w = pk2(o[6], o[7]);
        *(u32x4*)(WS_(p, XC) + (size_t)(t0 + tt) * 3072 + c0) = r;
#pragma unroll
        for (int e = 0; e < 8; ++e) { x0[e] = x1[e]; x1[e] = x2[e]; x2[e] = x3[e]; }
    }
}

DEV void mb_dacs(const Params& p, int j, int c, int g, LAS float* dts, LAS float* dacs) {
    const int tid = tid_(); const int lane = tid & 63, h = tid >> 6;
    const int hh = 8 * g + h; const float a = -__expf(p.mb_a_log[j * 32 + hh]);
    const float d0 = WS_(p, DT)[(size_t)(c * 128 + 2 * lane) * 32 + hh], d1 = WS_(p, DT)[(size_t)(c * 128 + 2 * lane + 1) * 32 + hh];
    const float a0 = d0 * a, a1 = d1 * a;
    float s = a0 + a1;
#pragma unroll
    for (int o = 1; o < 64; o <<= 1) { const float v = __shfl_up(s, o); if (lane >= o) s += v; }
    dts[h * 128 + 2 * lane] = d0; dts[h * 128 + 2 * lane + 1] = d1;
    dacs[h * 128 + 2 * lane] = s - a1; dacs[h * 128 + 2 * lane + 1] = s;
}
constexpr int LDB = 136;
constexpr int LDX = 72;
DEV void ld_tile128(const bf16_t* src, int gld, LAS bf16_t* dst) {
    const int tid = tid_();
    for (int i = tid; i < 128 * 16; i += NTHR) { const int r = i >> 4, c8 = (i & 15) * 8; *(LAS u32x4*)(dst + r * LDB + c8) = *(const u32x4*)(src + (size_t)r * gld + c8); }
}

DEV void phase_mb_states(const Params& p, int j, LAS unsigned char* lds) {
    const int tid = tid_(), bid = bid_(); (void)tid; (void)bid;
    const int lane = tid & 63, w = tid >> 6;
    LAS bf16_t* Bm = (LAS bf16_t*)lds;
    LAS bf16_t* Xh = Bm + 128 * LDB;
    LAS float* dts = (LAS float*)(Xh + 128 * LDX);
    LAS float* dacs = dts + 1024;
    for (int u = bid; u < 512; u += NB_) {
        const int c = u >> 2, g = u & 3; const int t0 = c * 128;
        lds_barrier();
        mb_dacs(p, j, c, g, dts, dacs);
        ld_tile128(WS_(p, XC) + (size_t)t0 * 3072 + 2048 + 128 * g, 3072, Bm);
        lds_barrier();
        if (tid < 8) WS_(p, CD)[(c * 32) + 8 * g + tid] = __expf(dacs[tid * 128 + 127]);
        bf16x8 bfr[4];
#pragma unroll
        for (int ks = 0; ks < 4; ++ks) bfr[ks] = frag_tr(Bm, LDB, 32 * ks, 16 * w, lane);
        for (int h = 0; h < 8; ++h) {
            { const int l = tid >> 2, p0 = (tid & 3) * 16; const float sc = dts[h * 128 + l] * __expf(dacs[h * 128 + 127] - dacs[h * 128 + l]);
              const bf16_t* src = WS_(p, XC) + (size_t)(t0 + l) * 3072 + 64 * (8 * g + h) + p0;
#pragma unroll
              for (int hf = 0; hf < 2; ++hf) { const u32x4 v = *(const u32x4*)(src + 8 * hf); u32x4 r;
                  r.x = pk2(bflo(v.x) * sc, bfhi(v.x) * sc); r.y = pk2(bflo(v.y) * sc, bfhi(v.y) * sc); r.z = pk2(bflo(v.z) * sc, bfhi(v.z) * sc); r.w = pk2(bflo(v.w) * sc, bfhi(v.w) * sc);
                  *(LAS u32x4*)(Xh + l * LDX + p0 + 8 * hf) = r; } }
            lds_barrier();
            f32x4 acc[4];
#pragma unroll
            for (int pb = 0; pb < 4; ++pb) { acc[pb] = (f32x4){0.f, 0.f, 0.f, 0.f};
#pragma unroll
                for (int ks = 0; ks < 4; ++ks) { const bf16x8 af = frag_tr(Xh, LDX, 32 * ks, 16 * pb, lane); acc[pb] = MFMA16(af, bfr[ks], acc[pb]); } }
            bf16_t* S = WS_(p, STATES) + (((size_t)c * 32 + 8 * g + h) * 64) * 128;
#pragma unroll
            for (int pb = 0; pb < 4; ++pb)
#pragma unroll
                for (int r = 0; r < 4; ++r) S[(size_t)(16 * pb + 4 * (lane >> 4) + r) * 128 + 16 * w + (lane & 15)] = (bf16_t)f2bf(acc[pb][r]);
            lds_barrier();
        }
    }
}
DEV void phase_mb_scan(const Params& p) {
    const int tid = tid_(), bid = bid_();
    if (tid >= 128) return;
    const int gid = bid * 128 + tid;
    const int n8 = gid & 15, pp = (gid >> 4) & 63, h = gid >> 10; const int n = 8 * n8;
    float r[8]; for (int e = 0; e < 8; ++e) r[e] = 0.f;
    const size_t eo = ((size_t)h * 64 + pp) * 128 + n;
    const size_t fo = (size_t)h * 64 * 128 + fragmajor_off(pp, n, 128);
#pragma unroll 8
    for (int c = 0; c < 128; ++c) {
        const u32x4 sr = *(const u32x4*)(WS_(p, STATES) + (size_t)c * 32 * 64 * 128 + eo);
        const float cd = WS_(p, CD)[c * 32 + h];
        u32x4 o; o.x = pk2(r[0], r[1]); o.y = pk2(r[2], r[3]); o.z = pk2(r[4], r[5]); o.w = pk2(r[6], r[7]);
        *(u32x4*)(WS_(p, PREV) + (size_t)c * 32 * 64 * 128 + fo) = o;
        r[0] = r[0] * cd + bflo(sr.x); r[1] = r[1] * cd + bfhi(sr.x); r[2] = r[2] * cd + bflo(sr.y); r[3] = r[3] * cd + bfhi(sr.y);
        r[4] = r[4] * cd + bflo(sr.z); r[5] = r[5] * cd + bfhi(sr.z); r[6] = r[6] * cd + bflo(sr.w); r[7] = r[7] * cd + bfhi(sr.w);
    }
}
DEV void phase_mb_out(const Params& p, int j, LAS unsigned char* lds) {
    const int tid = tid_(), bid = bid_(); (void)tid; (void)bid;
    const int lane = tid & 63, w = tid >> 6; const int fr = lane & 15, fq = lane >> 4;
    LAS bf16_t* Cm = (LAS bf16_t*)lds;
    LAS bf16_t* Bm = Cm + 128 * LDB;
    LAS bf16_t* Xh = Bm + 128 * LDB;
    LAS bf16_t* Mw = Xh + 128 * LDX;
    LAS float* dts = (LAS float*)(Mw + 8 * 16 * LDB);
    LAS float* dacs = dts + 1024;
    LAS bf16_t* Mme = Mw + w * 16 * LDB;
    for (int u = bid; u < 512; u += NB_) {
        const int c = u >> 2, g = u & 3; const int t0 = c * 128;
        lds_barrier();
        mb_dacs(p, j, c, g, dts, dacs);
        ld_tile128(WS_(p, XC) + (size_t)t0 * 3072 + 2048 + 512 + 128 * g, 3072, Cm);
        ld_tile128(WS_(p, XC) + (size_t)t0 * 3072 + 2048 + 128 * g, 3072, Bm);
        lds_barrier();
        f32x4 sc[8]; bf16x8 cf[4];
#pragma unroll
        for (int ks = 0; ks < 4; ++ks) cf[ks] = frag_rm(Cm, LDB, 16 * w, 32 * ks, lane);
#pragma unroll
        for (int sb = 0; sb < 8; ++sb) { sc[sb] = (f32x4){0.f, 0.f, 0.f, 0.f};
#pragma unroll
            for (int ks = 0; ks < 4; ++ks) sc[sb] = MFMA16(cf[ks], frag_rm(Bm, LDB, 16 * sb, 32 * ks, lane), sc[sb]); }
        float ssq = 0.f;
        const int rl = tid >> 2, p0 = (tid & 3) * 16;
        const LAS float* Yrow = (const LAS float*)(Mw + (rl >> 4) * 16 * LDB) + (rl & 15) * 68 + p0;
        LAS float* Yw = (LAS float*)Mme;
        u32x4 xraw[2], zraw[2], xnx[2], znx[2]; bf16x8 pfc[16];
#define MB_LOADH(HH, XR, ZR) do { const int hh_ = 8 * g + (HH); \
            XR[0] = *(const u32x4*)(WS_(p, XC) + (size_t)(t0 + rl) * 3072 + 64 * hh_ + p0); XR[1] = *(const u32x4*)(WS_(p, XC) + (size_t)(t0 + rl) * 3072 + 64 * hh_ + p0 + 8); \
            ZR[0] = *(const u32x4*)(WS_(p, Z) + (size_t)(t0 + rl) * 2048 + 64 * hh_ + p0); ZR[1] = *(const u32x4*)(WS_(p, Z) + (size_t)(t0 + rl) * 2048 + 64 * hh_ + p0 + 8); } while (0)
        MB_LOADH(0, xraw, zraw);
#pragma unroll 1
        for (int h = 0; h < 8; ++h) {
            const int hh = 8 * g + h;
            MB_LOADH(h < 7 ? h + 1 : h, xnx, znx);
            { const bf16_t* pv_ = WS_(p, PREV) + ((size_t)c * 32 + hh) * 64 * 128;
#pragma unroll
              for (int i_ = 0; i_ < 16; ++i_) pfc[i_] = *(const bf16x8*)(pv_ + ((size_t)i_ * 64 + lane) * 8); }
            { const float scl = dts[h * 128 + rl];
#pragma unroll
              for (int hf = 0; hf < 2; ++hf) { const u32x4 v = xraw[hf]; u32x4 r;
                  r.x = pk2(bflo(v.x) * scl, bfhi(v.x) * scl); r.y = pk2(bflo(v.y) * scl, bfhi(v.y) * scl); r.z = pk2(bflo(v.z) * scl, bfhi(v.z) * scl); r.w = pk2(bflo(v.w) * scl, bfhi(v.w) * scl);
                  *(LAS u32x4*)(Xh + rl * LDX + p0 + 8 * hf) = r; } }
            const u32x4 zraw0 = zraw[0], zraw1 = zraw[1];
            float dl[4];
#pragma unroll
            for (int r = 0; r < 4; ++r) dl[r] = dacs[h * 128 + 16 * w + 4 * fq + r];
#pragma unroll
            for (int sb = 0; sb < 8; ++sb) { const int s_ = 16 * sb + fr; const float ds = dacs[h * 128 + s_];
#pragma unroll
                for (int r = 0; r < 4; ++r) { const int l = 16 * w + 4 * fq + r; const float m = (s_ <= l) ? sc[sb][r] * __expf(dl[r] - ds) : 0.f; Mme[(4 * fq + r) * LDB + s_] = (bf16_t)f2bf(m); } }
            lds_barrier();
            bf16x8 mf[4];
#pragma unroll
            for (int ks = 0; ks < 4; ++ks) mf[ks] = frag_rm(Mme, LDB, 0, 32 * ks, lane);
            f32x4 yv[4];
#pragma unroll
            for (int pb = 0; pb < 4; ++pb) {
                f32x4 a = {0.f, 0.f, 0.f, 0.f}, o = {0.f, 0.f, 0.f, 0.f};
#pragma unroll
                for (int ks = 0; ks < 4; ++ks) {
                    a = MFMA16(mf[ks], frag_tr(Xh, LDX, 32 * ks, 16 * pb, lane), a);
                    o = MFMA16(cf[ks], pfc[pb * 4 + ks], o);
                }
#pragma unroll
                for (int r = 0; r < 4; ++r) a[r] += o[r] * __expf(dl[r]);
                yv[pb] = a;
            }
#pragma unroll
            for (int pb = 0; pb < 4; ++pb)
#pragma unroll
                for (int r = 0; r < 4; ++r) Yw[(4 * fq + r) * 68 + 16 * pb + fr] = yv[pb][r];
            lds_barrier();
            {
                const float dsk = p.mb_d[j * 32 + hh]; const float* ng = p.mb_norm_g + (size_t)j * 2048 + 64 * hh + p0;
                float y[16], xs[16], zz[16];
#pragma unroll
                for (int q = 0; q < 4; ++q) { const f32x4 t4 = *(const LAS f32x4*)(Yrow + 4 * q); y[4 * q] = t4[0]; y[4 * q + 1] = t4[1]; y[4 * q + 2] = t4[2]; y[4 * q + 3] = t4[3]; }
                xs[0] = bflo(xraw[0].x); xs[1] = bfhi(xraw[0].x); xs[2] = bflo(xraw[0].y); xs[3] = bfhi(xraw[0].y); xs[4] = bflo(xraw[0].z); xs[5] = bfhi(xraw[0].z); xs[6] = bflo(xraw[0].w); xs[7] = bfhi(xraw[0].w);
                xs[8] = bflo(xraw[1].x); xs[9] = bfhi(xraw[1].x); xs[10] = bflo(xraw[1].y); xs[11] = bfhi(xraw[1].y); xs[12] = bflo(xraw[1].z); xs[13] = bfhi(xraw[1].z); xs[14] = bflo(xraw[1].w); xs[15] = bfhi(xraw[1].w);
                zz[0] = bflo(zraw0.x); zz[1] = bfhi(zraw0.x); zz[2] = bflo(zraw0.y); zz[3] = bfhi(zraw0.y); zz[4] = bflo(zraw0.z); zz[5] = bfhi(zraw0.z); zz[6] = bflo(zraw0.w); zz[7] = bfhi(zraw0.w);
                zz[8] = bflo(zraw1.x); zz[9] = bfhi(zraw1.x); zz[10] = bflo(zraw1.y); zz[11] = bfhi(zraw1.y); zz[12] = bflo(zraw1.z); zz[13] = bfhi(zraw1.z); zz[14] = bflo(zraw1.w); zz[15] = bfhi(zraw1.w);
                float o[16];
#pragma unroll
                for (int q = 0; q < 4; ++q) { const f32x4 n4 = *(const f32x4*)(ng + 4 * q);
#pragma unroll
                    for (int e = 0; e < 4; ++e) { const int i = 4 * q + e; const float v = (y[i] + xs[i] * dsk) * siluf_(zz[i]); ssq += v * v; o[i] = v * n4[e]; } }
                bf16_t* dst = WS_(p, YB) + (size_t)(t0 + rl) * 2048 + 64 * hh + p0;
                u32x4 w0, w1; w0.x = pk2(o[0], o[1]); w0.y = pk2(o[2], o[3]); w0.z = pk2(o[4], o[5]); w0.w = pk2(o[6], o[7]); w1.x = pk2(o[8], o[9]); w1.y = pk2(o[10], o[11]); w1.z = pk2(o[12], o[13]); w1.w = pk2(o[14], o[15]);
                *(u32x4*)dst = w0; *(u32x4*)(dst + 8) = w1;
            }
            xraw[0] = xnx[0]; xraw[1] = xnx[1]; zraw[0] = znx[0]; zraw[1] = znx[1];
            lds_barrier();
        }
#undef MB_LOADH
        ssq += __shfl_xor(ssq, 1); ssq += __shfl_xor(ssq, 2);
        const float rstd = rsqrtf(ssq * (1.0f / 512.0f) + 1e-5f);
#pragma unroll 1
        for (int h = 0; h < 8; ++h) {
            bf16_t* dst = WS_(p, YB) + (size_t)(t0 + rl) * 2048 + 64 * (8 * g + h) + p0;
#pragma unroll
            for (int hf = 0; hf < 2; ++hf) { const u32x4 v = *(const u32x4*)(dst + 8 * hf); u32x4 r;
                r.x = pk2(bflo(v.x) * rstd, bfhi(v.x) * rstd); r.y = pk2(bflo(v.y) * rstd, bfhi(v.y) * rstd); r.z = pk2(bflo(v.z) * rstd, bfhi(v.z) * rstd); r.w = pk2(bflo(v.w) * rstd, bfhi(v.w) * rstd);
                *(u32x4*)(dst + 8 * hf) = r; }
        }
    }
}
constexpr int GL_PROJ = 3088;
constexpr int LDV = 264;
struct SchedGlIn {
    const Params* p;
    DEV bool next(int i, Unit& u) const {
        int pm, pn; if (!pg8::tile_order(i, NB_, bid_(), 64, 12, pm, pn)) return false;
        u.A = (const char*)(WS_(*p, Hb) + (size_t)pm * 256 * D); u.B = (const char*)(WS_(*p, gl_win_t) + (size_t)pn * 256 * D); u.row0 = pm * 256; u.col0 = pn * 256; u.id = 0; u.aux = 0; return true;
    }
};
struct EpiGlIn {
    const Params* p;
    DEV void operator()(const AccT& acc, const Unit& u, int wr, int wc, int fr, int fq) const {
        FOR_ACC2(ai, bj, m) { st_bf8p(WS_(*p, QKVG) + (size_t)ACC_ROW(u, ai, m) * 3072 + ACC_COL8P(u, bj, PF(5)), acc[ai][bj][m][0], acc[ai][bj][m][1], PF(5)); ACC_FENCE; }
    }
};
DEV void gl_bcs(const Params& p, int n, int h, LAS float* bcs) {
    const int tid = tid_();
    for (int i = tid; i < 64 * 32; i += NTHR) { const int r = i >> 5, c4 = (i & 31) * 4; *(LAS f32x4*)(bcs + r * 128 + c4) = *(const f32x4*)(WS_(p, LA) + (size_t)(n * 64 + r) * 512 + 128 * h + c4); }
    lds_barrier();
    if (tid < 128) { float s = 0.f; for (int r = 0; r < 64; ++r) { s += bcs[r * 128 + tid]; bcs[r * 128 + tid] = s; } }
    lds_barrier();
}
DEV void phase_gl_kv(const Params& p, LAS unsigned char* lds) {
    const int tid = tid_(), bid = bid_(); (void)tid; (void)bid;
    const int lane = tid & 63, w = tid >> 6;
    LAS float* bcs = (LAS float*)lds;
    LAS bf16_t* Ke = (LAS bf16_t*)(bcs + 64 * 128);
    LAS bf16_t* Vs = Ke + 64 * LDB;
    for (int u = bid; u < 1024; u += NB_) {
        const int n = u >> 2, h = u & 3; const int t0 = n * 64;
        lds_barrier();
        gl_bcs(p, n, h, bcs);
        for (int i = tid; i < 64 * 16; i += NTHR) { const int r = i >> 4, c8 = (i & 15) * 8;
            const u32x4 v = *(const u32x4*)(WS_(p, QKVG) + (size_t)(t0 + r) * 3072 + 512 + 128 * h + c8); float f[8];
            f[0] = bflo(v.x); f[1] = bfhi(v.x); f[2] = bflo(v.y); f[3] = bfhi(v.y); f[4] = bflo(v.z); f[5] = bfhi(v.z); f[6] = bflo(v.w); f[7] = bfhi(v.w);
#pragma unroll
            for (int e = 0; e < 8; ++e) f[e] *= __expf(bcs[63 * 128 + c8 + e] - bcs[r * 128 + c8 + e]);
            u32x4 o; o.x = pk2(f[0], f[1]); o.y = pk2(f[2], f[3]); o.z = pk2(f[4], f[5]); o.w = pk2(f[6], f[7]);
            *(LAS u32x4*)(Ke + r * LDB + c8) = o; }
        for (int i = tid; i < 64 * 32; i += NTHR) { const int r = i >> 5, c8 = (i & 31) * 8; *(LAS u32x4*)(Vs + r * LDV + c8) = *(const u32x4*)(WS_(p, QKVG) + (size_t)(t0 + r) * 3072 + 1024 + 256 * h + c8); }
        if (tid < 128) WS_(p, CDG)[((size_t)n * 4 + h) * 128 + tid] = __expf(bcs[63 * 128 + tid]);
        lds_barrier();
        bf16x8 af[2];
#pragma unroll
        for (int ks = 0; ks < 2; ++ks) af[ks] = frag_tr(Ke, LDB, 32 * ks, 16 * w, lane);
        bf16_t* O = WS_(p, STATES) + (((size_t)n * 4 + h) * 128) * 256;
#pragma unroll
        for (int vb = 0; vb < 16; ++vb) {
            f32x4 acc = {0.f, 0.f, 0.f, 0.f};
#pragma unroll
            for (int ks = 0; ks < 2; ++ks) acc = MFMA16(af[ks], frag_tr(Vs, LDV, 32 * ks, 16 * vb, lane), acc);
            { u32x2 o; o.x = pk2(acc[0], acc[1]); o.y = pk2(acc[2], acc[3]); *(u32x2*)(O + (size_t)(16 * vb + (lane & 15)) * 128 + 16 * w + 4 * (lane >> 4)) = o; }
        }
    }
}
DEV void phase_gl_scan(const Params& p) {
    const int tid = tid_(), bid = bid_();
    if (tid >= 64) return;
    const int gid = bid * 64 + tid;
    const int k8 = gid & 15, v = (gid >> 4) & 255, h = gid >> 12; const int k = 8 * k8;
    float r[8]; for (int e = 0; e < 8; ++e) r[e] = 0.f;
    const size_t fo = (size_t)h * 128 * 256 + fragmajor_off(v, k, 128);
#pragma unroll 8
    for (int n = 0; n < 256; ++n) {
        const u32x4 sr = *(const u32x4*)(WS_(p, STATES) + (((size_t)n * 4 + h) * 256 + v) * 128 + k);
        const f32x4 c0 = *(const f32x4*)(WS_(p, CDG) + ((size_t)n * 4 + h) * 128 + k), c1 = *(const f32x4*)(WS_(p, CDG) + ((size_t)n * 4 + h) * 128 + k + 4);
        u32x4 o; o.x = pk2(r[0], r[1]); o.y = pk2(r[2], r[3]); o.z = pk2(r[4], r[5]); o.w = pk2(r[6], r[7]);
        *(u32x4*)(WS_(p, PREV) + (size_t)n * 4 * 128 * 256 + fo) = o;
        r[0] = r[0] * c0[0] + bflo(sr.x); r[1] = r[1] * c0[1] + bfhi(sr.x); r[2] = r[2] * c0[2] + bflo(sr.y); r[3] = r[3] * c0[3] + bfhi(sr.y);
        r[4] = r[4] * c1[0] + bflo(sr.z); r[5] = r[5] * c1[1] + bfhi(sr.z); r[6] = r[6] * c1[2] + bflo(sr.w); r[7] = r[7] * c1[3] + bfhi(sr.w);
    }
}
DEV void phase_gl_out(const Params& p, int j, LAS unsigned char* lds) {
    const int tid = tid_(), bid = bid_(); (void)tid; (void)bid;
    const int lane = tid & 63, w = tid >> 6; const int fr = lane & 15, fq = lane >> 4;
    LAS float* bcs = (LAS float*)lds;
    LAS bf16_t* Qs = (LAS bf16_t*)(bcs + 64 * 128);
    LAS bf16_t* Ks = Qs + 64 * LDB;
    LAS bf16_t* Vs = Ks + 64 * LDB;
    LAS bf16_t* At = Vs + 64 * LDV;
    LAS float* red = (LAS float*)(At + 64 * LDX);
    for (int u = bid; u < 1024; u += NB_) {
        const int n = u >> 2, h = u & 3; const int t0 = n * 64;
        lds_barrier();
        gl_bcs(p, n, h, bcs);
        for (int i = tid; i < 64 * 16; i += NTHR) { const int r = i >> 4, c8 = (i & 15) * 8;
            const u32x4 vq = *(const u32x4*)(WS_(p, QKVG) + (size_t)(t0 + r) * 3072 + 128 * h + c8), vk = *(const u32x4*)(WS_(p, QKVG) + (size_t)(t0 + r) * 3072 + 512 + 128 * h + c8);
            float fq_[8], fk_[8];
            fq_[0] = bflo(vq.x); fq_[1] = bfhi(vq.x); fq_[2] = bflo(vq.y); fq_[3] = bfhi(vq.y); fq_[4] = bflo(vq.z); fq_[5] = bfhi(vq.z); fq_[6] = bflo(vq.w); fq_[7] = bfhi(vq.w);
            fk_[0] = bflo(vk.x); fk_[1] = bfhi(vk.x); fk_[2] = bflo(vk.y); fk_[3] = bfhi(vk.y); fk_[4] = bflo(vk.z); fk_[5] = bfhi(vk.z); fk_[6] = bflo(vk.w); fk_[7] = bfhi(vk.w);
#pragma unroll
            for (int e = 0; e < 8; ++e) { const float b = bcs[r * 128 + c8 + e]; fq_[e] *= __expf(b) * 0.08838834764831845f; fk_[e] *= __expf(-b); }
            u32x4 o; o.x = pk2(fq_[0], fq_[1]); o.y = pk2(fq_[2], fq_[3]); o.z = pk2(fq_[4], fq_[5]); o.w = pk2(fq_[6], fq_[7]);
            *(LAS u32x4*)(Qs + r * LDB + c8) = o;
            o.x = pk2(fk_[0], fk_[1]); o.y = pk2(fk_[2], fk_[3]); o.z = pk2(fk_[4], fk_[5]); o.w = pk2(fk_[6], fk_[7]);
            *(LAS u32x4*)(Ks + r * LDB + c8) = o; }
        for (int i = tid; i < 64 * 32; i += NTHR) { const int r = i >> 5, c8 = (i & 31) * 8; *(LAS u32x4*)(Vs + r * LDV + c8) = *(const u32x4*)(WS_(p, QKVG) + (size_t)(t0 + r) * 3072 + 1024 + 256 * h + c8); }
        lds_barrier();
        { const int ib = w >> 1;
#pragma unroll
          for (int jj = 0; jj < 2; ++jj) { const int jb = 2 * (w & 1) + jj; f32x4 a = {0.f, 0.f, 0.f, 0.f};
#pragma unroll
              for (int ks = 0; ks < 4; ++ks) a = MFMA16(frag_rm(Qs, LDB, 16 * ib, 32 * ks, lane), frag_rm(Ks, LDB, 16 * jb, 32 * ks, lane), a);
#pragma unroll
              for (int r = 0; r < 4; ++r) { const int i = 16 * ib + 4 * fq + r, jx = 16 * jb + fr; At[i * LDX + jx] = (bf16_t)f2bf(jx <= i ? a[r] : 0.f); } } }
        lds_barrier();
        f32x4 o[4][2];
        const bf16_t* pv = WS_(p, PREV) + ((size_t)n * 4 + h) * 128 * 256;
#pragma unroll
        for (int vv = 0; vv < 2; ++vv) { const int vb = 2 * w + vv;
            bf16x8 bi[2], bp[4];
#pragma unroll
            for (int ks = 0; ks < 2; ++ks) bi[ks] = frag_tr(Vs, LDV, 32 * ks, 16 * vb, lane);
#pragma unroll
            for (int ks = 0; ks < 4; ++ks) bp[ks] = *(const bf16x8*)(pv + ((size_t)(vb * 4 + ks) * 64 + lane) * 8);
#pragma unroll
            for (int ib = 0; ib < 4; ++ib) { f32x4 a = {0.f, 0.f, 0.f, 0.f};
#pragma unroll
                for (int ks = 0; ks < 2; ++ks) a = MFMA16(frag_rm(At, LDX, 16 * ib, 32 * ks, lane), bi[ks], a);
#pragma unroll
                for (int ks = 0; ks < 4; ++ks) a = MFMA16(frag_rm(Qs, LDB, 16 * ib, 32 * ks, lane), bp[ks], a);
                o[ib][vv] = a; } }
#pragma unroll
        for (int ib = 0; ib < 4; ++ib)
#pragma unroll
            for (int r = 0; r < 4; ++r) { float s = o[ib][0][r] * o[ib][0][r] + o[ib][1][r] * o[ib][1][r]; s = sum16(s); if (fr == 0) red[w * 64 + 16 * ib + 4 * fq + r] = s; }
        lds_barrier();
        {   LAS bf16_t* Os = (LAS bf16_t*)bcs;
#pragma unroll
            for (int ib = 0; ib < 4; ++ib)
#pragma unroll
                for (int vv = 0; vv < 2; ++vv)
#pragma unroll
                    for (int r = 0; r < 4; ++r) Os[(16 * ib + 4 * fq + r) * LDV + 32 * w + 16 * vv + fr] = (bf16_t)f2bf(o[ib][vv][r]);
            lds_barrier();
            const int row = tid >> 3, c0 = (tid & 7) * 32; const int t = t0 + row; float s = 0.f;
#pragma unroll
            for (int ww = 0; ww < 8; ++ww) s += red[ww * 64 + row];
            const float rs = rsqrtf(s * (1.0f / 256.0f) + 1e-5f);
#pragma unroll
            for (int q = 0; q < 4; ++q) {
                const u32x4 ov = *(const LAS u32x4*)(Os + row * LDV + c0 + 8 * q), gv = *(const u32x4*)(WS_(p, QKVG) + (size_t)t * 3072 + 2048 + 256 * h + c0 + 8 * q);
                const f32x4 n0 = *(const f32x4*)(p.gl_norm_g + j * 256 + c0 + 8 * q), n1 = *(const f32x4*)(p.gl_norm_g + j * 256 + c0 + 8 * q + 4);
                float r8[8];
                r8[0] = bflo(ov.x) * rs * n0[0] * siluf_(bflo(gv.x)); r8[1] = bfhi(ov.x) * rs * n0[1] * siluf_(bfhi(gv.x)); r8[2] = bflo(ov.y) * rs * n0[2] * siluf_(bflo(gv.y)); r8[3] = bfhi(ov.y) * rs * n0[3] * siluf_(bfhi(gv.y));
                r8[4] = bflo(ov.z) * rs * n1[0] * siluf_(bflo(gv.z)); r8[5] = bfhi(ov.z) * rs * n1[1] * siluf_(bfhi(gv.z)); r8[6] = bflo(ov.w) * rs * n1[2] * siluf_(bflo(gv.w)); r8[7] = bfhi(ov.w) * rs * n1[3] * siluf_(bfhi(gv.w));
                u32x4 wv; wv.x = pk2(r8[0], r8[1]); wv.y = pk2(r8[2], r8[3]); wv.z = pk2(r8[4], r8[5]); wv.w = pk2(r8[6], r8[7]);
                *(u32x4*)(WS_(p, YB) + (size_t)t * D + 256 * h + c0 + 8 * q) = wv;
            }
        }
    }
}
#define XB_TMO      128
#define XB_XCNT(j)  (256  + 64 * (j))
#define XB_XSUB(j)  (1280 + 64 * (j))
#define XB_XGEN(j)  (2304 + 64 * (j))
#define XB_TOP      3328
#define XB_TOPGEN   3392
#define XCD_BAR_WORDS 3456
#define XB_SPIN_CAP (1u << 22)
DEV unsigned xb_ld(unsigned* p)              { return __hip_atomic_load(p, __ATOMIC_RELAXED, __HIP_MEMORY_SCOPE_AGENT); }
DEV unsigned xb_add(unsigned* p, unsigned v) { return __hip_atomic_fetch_add(p, v, __ATOMIC_RELAXED, __HIP_MEMORY_SCOPE_AGENT); }
DEV unsigned xb_xcc_id() { return (unsigned)__builtin_amdgcn_s_getreg((3 << 11) | 20) & 0xFu; }
#define XB_SPIN(cond, bar) do { unsigned _sp = 0; while (cond) { __builtin_amdgcn_s_sleep(1); \
    if ((++_sp & 255u) == 0u) { if (xb_ld(&(bar)[XB_TMO])) break; if (_sp > XB_SPIN_CAP) { atomicAdd(&(bar)[XB_TMO], 1u); break; } } } } while (0)
struct XcdBarrier { unsigned* bar; unsigned x; volatile LAS unsigned* st; };
DEV XcdBarrier xcd_barrier_post(unsigned* bar, volatile LAS unsigned* st) {
    XcdBarrier b; b.bar = bar; b.x = xb_xcc_id(); b.st = st;
    if (threadIdx.x == 0) (void)xb_add(&bar[XB_XCNT(b.x)], 1u);
    return b;
}
DEV void xcd_barrier_complete(unsigned* bar, unsigned x, unsigned& nloc, unsigned& nx) {
    const unsigned G = gridDim.x * gridDim.y * gridDim.z;
    unsigned sum, cnt, mine, sp = 0u;
    for (;;) {
        sum = 0u; cnt = 0u; mine = 0u;
#pragma unroll
        for (unsigned j = 0; j < 16; ++j) { const unsigned c = xb_ld(&bar[XB_XCNT(j)]); sum += c; cnt += (c > 0u) ? 1u : 0u; mine = (j == x) ? c : mine; }
        if (sum == G) break;
        __builtin_amdgcn_s_sleep(1);
        if ((++sp & 255u) == 0u) { if (xb_ld(&bar[XB_TMO])) break; if (sp > XB_SPIN_CAP) { atomicAdd(&bar[XB_TMO], 1u); break; } }
    }
    nloc = mine > 0u ? mine : 1u; nx = cnt > 0u ? cnt : 1u;
}
DEV void xcd_barrier(const XcdBarrier& b) {
    asm volatile("s_waitcnt vmcnt(0)" ::: "memory");
    __syncthreads();
    if (threadIdx.x == 0) {
        unsigned* bar = b.bar;
        __builtin_amdgcn_s_waitcnt(0);
        unsigned nloc = b.st[0], nx = b.st[1];
        if (nloc == 0u) { xcd_barrier_complete(bar, b.x, nloc, nx); b.st[0] = nloc; b.st[1] = nx; }
        const unsigned old = xb_add(&bar[XB_XSUB(b.x)], 1u);
        const unsigned gen = old / nloc;
        if (old + 1u == (gen + 1u) * nloc) {
            __builtin_amdgcn_fence(__ATOMIC_RELEASE, "agent");
            asm volatile("s_waitcnt vmcnt(0)" ::: "memory");
            const unsigned og = xb_add(&bar[XB_TOP], 1u);
            const unsigned tg = og / nx;
            if (og + 1u == (tg + 1u) * nx) xb_add(&bar[XB_TOPGEN], 1u);
            else XB_SPIN(xb_ld(&bar[XB_TOPGEN]) == tg, bar);
            __builtin_amdgcn_fence(__ATOMIC_ACQUIRE, "agent");
            xb_add(&bar[XB_XGEN(b.x)], 1u);
            asm volatile("s_waitcnt vmcnt(0)" ::: "memory");
        } else {
            XB_SPIN(xb_ld(&bar[XB_XGEN(b.x)]) == gen, bar);
            __builtin_amdgcn_fence(__ATOMIC_ACQUIRE, "agent");
            asm volatile("s_waitcnt vmcnt(0)" ::: "memory");
        }
    }
    __syncthreads();
}

DEV void moe_tail_convert(const Params& p, LAS unsigned char* lds, int layer) {
    if (layer != 1) return;
    convert_tickets(moe_job(p, 0, layer + 1), moe_job(p, 1, layer + 1), lds, WS_(p, MFLAG) + MFLAG_TICKET * MFLAG_STRIDE, MFLAG_STRIDE);
}
DEV LAS int* moe_tab_to_lds(const Params& p, LAS unsigned char* lds) {
    LAS int* tab = (LAS int*)(lds + pg8::STAGE_BYTES);
    const int tid = tid_();
    if (tid < 256) tab[tid] = __hip_atomic_load(WS_(p, TAB) + tid, __ATOMIC_RELAXED, __HIP_MEMORY_SCOPE_AGENT);
    __syncthreads();
    return tab;
}
DEV void run_phase(const Params& pin, int op, int arg, LAS unsigned char* lds) {
    Params p = pin; { size_t z_ = 0; asm volatile("" : "+s"(z_)); p.ws = pin.ws + z_; }
    const int layer = arg; const int jj = layer / 3;
#ifdef ONLY_OP
    if (op != ONLY_OP) return;
#endif
#ifdef OPMASK
    if (!((OPMASK >> op) & 1ull)) return;
#endif
    switch (op) {
    case OP_CONVERT: phase_pre0(p); phase_convert(p, lds);
#ifdef DBG
        if (blockIdx.x == 0 && threadIdx.x < 24) WS_(p, TAB)[200 + threadIdx.x] = 0;
#endif
        break;
    case OP_PRE0: break;
    case OP_RW_GEMM1: { SchedRW1 S{&p, jj}; EpiRW1 E{&p}; pg8::gemm_phase(lds, 1024, S, E); } break;
    case OP_RW_GEMM2: { SchedRW2 S{&p, jj}; EpiRW2 E{&p, jj}; pg8::gemm_phase(lds, 256, S, E); } break;
    case OP_RW_CHA: phase_rw_cha(p, jj, lds); break;
    case OP_RW_CHB: phase_rw_chb(p, layer, lds);
#ifdef REP_B
        if (layer == REP_B) { __syncthreads(); phase_rw_chb(p, layer, lds); }
#endif
        break;
    case OP_RW_CHC: phase_rw_chc(p, jj, lds); break;
    case OP_RW_OUT: { SchedOut S{WS_(p, YB), WS_(p, rw_wo_t) + (size_t)jj * D * D, 1024}; EpiOut E{WS_(p, MIXb)}; pg8::gemm_phase(lds, 1024, S, E); } break;
    case OP_LN1: phase_ln1(p, layer, lds); break;
    case OP_MOE_SCATTER: phase_moe_scatter(p, lds); break;
    case OP_MOE_GEMM1: { LAS int* tab = moe_tab_to_lds(p, lds);
#ifdef REP_MOE
#pragma unroll 1
        for (int rep_ = 0; rep_ < REP_MOE; ++rep_) {
#endif
        { SchedMoe<0> S{&p, layer, tab}; EpiMoe1 E{WS_(p, ACT), WS_(p, MFLAG)}; pg8::gemm_phase(lds, 1024, S, E); }
        { SchedMoe<1> S{&p, layer, tab}; EpiMoe2 E{WS_(p, YBUF)}; pg8::gemm_phase(lds, 512, S, E); }
#ifdef REP_MOE
        }
#endif
        moe_tail_convert(p, lds, layer); } break;
    case OP_MOE_GEMM2: break;
    case OP_LN2: phase_ln2(p, layer, lds); break;
    case OP_MB_GEMM_IN: { SchedMbIn S{&p}; EpiMbIn E{&p}; pg8::gemm_phase(lds, 1024, S, E); } break;
    case OP_MB_CONV: phase_mb_conv(p, jj); break;
    case OP_MB_STATES: phase_mb_states(p, jj, lds); break;
    case OP_MB_SCAN: phase_mb_scan(p); break;
    case OP_MB_OUT: phase_mb_out(p, jj, lds); break;
    case OP_MB_GEMM_OUT: { SchedOut S{WS_(p, YB), WS_(p, mb_wout_t) + (size_t)jj * D * 2048, 2048}; EpiOut E{WS_(p, MIXb)}; pg8::gemm_phase(lds, 2048, S, E); } break;
    case OP_GL_GEMM_IN: { SchedGlIn S{&p}; EpiGlIn E{&p}; pg8::gemm_phase(lds, 1024, S, E); } break;
    case OP_GL_KV: phase_gl_kv(p, lds); break;
    case OP_GL_SCAN: phase_gl_scan(p); break;
    case OP_GL_OUT: phase_gl_out(p, jj, lds); break;
    case OP_GL_GEMM_OUT: { SchedOut S{WS_(p, YB), WS_(p, gl_wout_t) + (size_t)jj * D * D, 1024}; EpiOut E{WS_(p, MIXb)}; pg8::gemm_phase(lds, 1024, S, E); } break;
    default: break;
    }
}

constexpr int NPHASES = 1 + 10 + 10 + 9 + 10;
DEV void decode_phase(int ph, int& op, int& layer) {
    if (ph < 1) { op = OP_CONVERT; layer = 0; return; }
    int q = ph - 1; layer = 0;
    if (q >= 10) { q -= 10; layer = 1; if (q >= 10) { q -= 10; layer = 2; if (q >= 9) { q -= 9; layer = 3; } } }
    const int kind = layer % 3; const int nmix = kind == 2 ? 5 : 6;
    if (q < nmix) op = (kind == 0 ? OP_RW_GEMM1 : kind == 1 ? OP_MB_GEMM_IN : OP_GL_GEMM_IN) + q;
    else { const int m = q - nmix; op = m < 3 ? OP_LN1 + m : OP_LN2; }
}

#define X(t, n) t n##_,
template <bool COOP>
__global__ void __launch_bounds__(NTHR, 2) mega(PARAM_LIST(X) const int ph0, const int ph1) {
#undef X
    Params p;
#define X(t, n) p.n = n##_;
    PARAM_LIST(X)
#undef X

    extern __shared__ __attribute__((aligned(16))) unsigned char smem_raw[];
    LAS unsigned char* lds = (LAS unsigned char*)smem_raw;
    if constexpr (COOP) {
        volatile LAS unsigned* st = (volatile LAS unsigned*)(lds + LDS_BYTES - 16);
        if (threadIdx.x == 0) { st[0] = 0u; st[1] = 0u; }
        __syncthreads();
        XcdBarrier xb = xcd_barrier_post(WS_(p, bar), st);
        if (ph0 < 0) cg::this_grid().sync();
        for (int ph = ph0; ph < ph1; ++ph) {
            int op, arg; decode_phase(ph, op, arg);
#ifdef REPEAT_MASK
            const int reps = 1 + (int)((REPEAT_MASK >> op) & 1ull);
#else
            const int reps = 1;
#endif
#pragma unroll 1
            for (int rep = 0; rep < reps; ++rep) {
                run_phase(p, op, arg, lds);
                if (ph + 1 < ph1 || rep + 1 < reps) { xcd_barrier(xb);
#ifdef BAR2
                    xcd_barrier(xb);
#endif
                }
            }
        }
#ifdef DBG
        xcd_barrier(xb);
#ifndef DBG_WORD
#define DBG_WORD 200
#endif
        { const int code = __hip_atomic_load(WS_(p, TAB) + DBG_WORD, __ATOMIC_RELAXED, __HIP_MEMORY_SCOPE_AGENT);
          for (size_t i = (size_t)blockIdx.x * NTHR + threadIdx.x; i < (size_t)T * D; i += (size_t)NB_ * NTHR) p.out[i] = 0.f;
          __syncthreads();
          if (blockIdx.x == 0 && threadIdx.x == 0) p.out[0] = sqrtf((float)DBG_DECODE(code) * 1.68e7f); }
#endif
    } else {
        for (int ph = ph0; ph < ph1; ++ph) { int op, arg; decode_phase(ph, op, arg); run_phase(p, op, arg, lds); }
    }
}


extern "C" void kernel_launch(void* const* d_in, const int* in_sizes, int n_in, void* d_out, int out_size, void* d_ws, size_t ws_size, hipStream_t stream) {
    (void)in_sizes; (void)n_in; (void)out_size;
    Params p; std::memset((void*)&p, 0, sizeof(p));
    auto F = [&](int i) { return (const float*)d_in[i]; };
    p.x = F(0); p.ln_g = F(1); p.ln_b = F(2);
    p.rw_mu = F(3); p.rw_w_rkv = F(4); p.rw_w0 = F(5); p.rw_w1 = F(6); p.rw_w2 = F(7); p.rw_a0 = F(8);
    p.rw_a1 = F(9); p.rw_a2 = F(10); p.rw_g1 = F(11); p.rw_g2 = F(12);
    p.rw_k_k = F(13); p.rw_k_a = F(14); p.rw_r_k = F(15); p.rw_lnx_g = F(16); p.rw_lnx_b = F(17); p.rw_w_o = F(18);
    p.mb_w_in = F(19); p.mb_conv_w = F(20); p.mb_conv_b = F(21); p.mb_dt_bias = F(22); p.mb_a_log = F(23); p.mb_d = F(24); p.mb_norm_g = F(25); p.mb_w_out = F(26);
    p.gl_w_in = F(27); p.gl_gk_w2 = F(28); p.gl_gk_b = F(29); p.gl_norm_g = F(30); p.gl_w_out = F(31);
    p.moe_w_group = F(32); p.moe_b_group = F(33); p.moe_w_route = F(34); p.moe_b_route = F(35); p.moe_w_in = F(36); p.moe_w_down = F(37);
    p.out = (float*)d_out;
    p.ws = (char*)d_ws;
    if (WS_TOTAL > ws_size) { fprintf(stderr, "workspace too small: need %zu have %zu\n", (size_t)WS_TOTAL, ws_size); return; }
    unsigned* bar_ptr = (unsigned*)(p.ws + OFF_bar);
    const int np = NPHASES;
#define X(t, n) (void*)&p.n,
#if SINGLE_LAUNCH
    (void)hipFuncSetAttribute((const void*)mega<true>, hipFuncAttributeMaxDynamicSharedMemorySize, LDS_BYTES);
    (void)hipMemsetAsync(bar_ptr, 0, XCD_BAR_WORDS * sizeof(unsigned), stream);
    int ph0 = 0, ph1 = np; void* args[] = {PARAM_LIST(X) (void*)&ph0, (void*)&ph1};
    hipError_t e = hipLaunchCooperativeKernel((const void*)mega<true>, dim3(NBLK), dim3(NTHR), args, LDS_BYTES, stream);
    if (e != hipSuccess) fprintf(stderr, "cooperative launch failed: %s\n", hipGetErrorString(e));
#else
    (void)hipFuncSetAttribute((const void*)mega<false>, hipFuncAttributeMaxDynamicSharedMemorySize, LDS_BYTES);
    for (int ph = 0; ph < np; ++ph) { int ph0 = ph, ph1 = ph + 1; void* args[] = {PARAM_LIST(X) (void*)&ph0, (void*)&ph1};
        hipError_t e = hipLaunchKernel((const void*)mega<false>, dim3(NBLK), dim3(NTHR), args, LDS_BYTES, stream);
        if (e != hipSuccess) fprintf(stderr, "launch failed: %s\n", hipGetErrorString(e)); }
#endif
#undef X
}
```

```cpp
#include <hip/hip_runtime.h>
#include <hip/hip_cooperative_groups.h>
#include <cstdint>
#include <cstdio>
#include <cstring>
namespace cg = cooperative_groups;

typedef unsigned short bf16_t;
typedef short bf16x8 __attribute__((ext_vector_type(8)));
typedef short s16x4 __attribute__((ext_vector_type(4)));
typedef float f32x4 __attribute__((ext_vector_type(4)));
typedef float f32x2 __attribute__((ext_vector_type(2)));
typedef unsigned u32x4 __attribute__((ext_vector_type(4)));
typedef unsigned u32x2 __attribute__((ext_vector_type(2)));
#define LAS __attribute__((address_space(3)))
#define DEV __device__ __forceinline__

constexpr int T = 16384, D = 1024, DEPTH = 4;
constexpr int NTHR = 512, NBLK = 256;
constexpr int LDS_BYTES = 155648;
constexpr float ALPHA = 1.681792830507429f;
constexpr float LN_EPS = 1e-5f;
constexpr int MOE_ROWS = 40960;

DEV int tid_() { int t = threadIdx.x; asm volatile("" : "+v"(t)); return t; }
DEV int bid_() { int b = blockIdx.x; asm volatile("" : "+s"(b)); return b; }
#define NB_ 256
#define RCOL(q, lane) ((((q) >> 1) * 512) + 8 * (lane) + 4 * ((q) & 1))
DEV void lds_barrier() { asm volatile("s_waitcnt lgkmcnt(0)" ::: "memory"); __builtin_amdgcn_s_barrier(); asm volatile("" ::: "memory"); }
DEV unsigned f2bf(float f) { unsigned u = __float_as_uint(f); u += 0x7FFFu + ((u >> 16) & 1u); return u >> 16; }
DEV float bf2f(unsigned short b) { return __uint_as_float(((unsigned)b) << 16); }
typedef __bf16 bf16n2 __attribute__((ext_vector_type(2)));
DEV unsigned pk2(float lo, float hi) { f32x2 v = {lo, hi}; bf16n2 b = __builtin_convertvector(v, bf16n2); return __builtin_bit_cast(unsigned, b); }
DEV float bflo(unsigned u) { return __uint_as_float(u << 16); }
DEV float bfhi(unsigned u) { return __uint_as_float(u & 0xFFFF0000u); }
DEV float sigmoidf_(float x) { return 1.0f / (1.0f + __expf(-x)); }
DEV float siluf_(float x) { return x / (1.0f + __expf(-x)); }
DEV float softplusf_(float x) { return fmaxf(x, 0.f) + __logf(1.0f + __expf(-fabsf(x))); }
DEV float tanhf_(float x) { const float e = __expf(-2.0f * fabsf(x)); const float r = (1.0f - e) / (1.0f + e); return x < 0.f ? -r : r; }
DEV float wave_sum(float v) {
#pragma unroll
    for (int o = 32; o > 0; o >>= 1) v += __shfl_xor(v, o);
    return v;
}
DEV float sum16(float v) {
#pragma unroll
    for (int o = 8; o > 0; o >>= 1) v += __shfl_xor(v, o);
    return v;
}
template <int N> DEV float reduce_scatter(float (&v)[N], int lane) {
    int s = 1;
#pragma unroll
    for (int h = N / 2; h >= 1; h >>= 1) {
#pragma unroll
        for (int i = 0; i < h; ++i) {
            const bool up = (lane & s) != 0;
            const float send = up ? v[i] : v[i + h];
            const float keep = up ? v[i + h] : v[i];
            v[i] = keep + __shfl_xor(send, s);
        }
        s <<= 1;
    }
    float r = v[0];
    for (; s < 64; s <<= 1) r += __shfl_xor(r, s);
    return r;
}
template <int N> DEV int rs_index(int lane) {
    int o = 0, s = 1;
#pragma unroll
    for (int h = N / 2; h >= 1; h >>= 1) { if (lane & s) o += h; s <<= 1; }
    return o;
}

DEV bf16x8 frag_rm(const LAS bf16_t* base, int ld, int row0, int k0, int lane) {
    return *(const LAS bf16x8*)(base + (row0 + (lane & 15)) * ld + k0 + 8 * (lane >> 4));
}
DEV bf16x8 frag_tr(const LAS bf16_t* base, int ld, int k0, int c0, int lane) {
    const int g = lane >> 4, i = lane & 15, q = i >> 2, p = i & 3;
    const LAS bf16_t* a = base + (k0 + 8 * g + q) * ld + c0 + 4 * p;
    s16x4 lo = __builtin_amdgcn_ds_read_tr16_b64_v4i16((LAS s16x4*)a);
    s16x4 hi = __builtin_amdgcn_ds_read_tr16_b64_v4i16((LAS s16x4*)(a + 4 * ld));
    bf16x8 r; r[0] = lo[0]; r[1] = lo[1]; r[2] = lo[2]; r[3] = lo[3]; r[4] = hi[0]; r[5] = hi[1]; r[6] = hi[2]; r[7] = hi[3];
    return r;
}
#define MFMA16(a, b, c) __builtin_amdgcn_mfma_f32_16x16x32_bf16((a), (b), (c), 0, 0, 0)
DEV size_t fragmajor_off(int n, int k, int K) { return ((size_t)((n >> 4) * (K >> 5) + (k >> 5)) * 64 + (n & 15) + 16 * ((k & 31) >> 3)) * 8 + (k & 7); }

template <int N> DEV void skinny_group(const f32x4 (&z)[4], const LAS float* wt, int lane, LAS float* outw) {
    float pe[N];
#pragma unroll
    for (int o = 0; o < N; ++o) {
        float a = 0.f;
#pragma unroll
        for (int q = 0; q < 4; ++q) { const f32x4 w = *(const LAS f32x4*)(wt + o * 1028 + RCOL(q, lane)); a += z[q][0] * w[0] + z[q][1] * w[1] + z[q][2] * w[2] + z[q][3] * w[3]; }
        pe[o] = a;
    }
    const float r = reduce_scatter<N>(pe, lane);
    if (lane < N) outw[rs_index<N>(lane)] = r;
}
#ifndef SINGLE_LAUNCH
#define SINGLE_LAUNCH 1
#endif
constexpr size_t OFF_bar = 0ull;
constexpr size_t OFF_rw_rkv_t = 13824ull;
constexpr size_t OFF_rw_w1_t = 12596736ull;
constexpr size_t OFF_rw_a1_t = 13645312ull;
constexpr size_t OFF_rw_g1_t = 14693888ull;
constexpr size_t OFF_rw_w2_t = 15742464ull;
constexpr size_t OFF_rw_a2_t = 16791040ull;
constexpr size_t OFF_rw_g2_t = 17839616ull;
constexpr size_t OFF_rw_wo_t = 18888192ull;
constexpr size_t OFF_mb_win_t = 23082496ull;
constexpr size_t OFF_mb_wout_t = 33568256ull;
constexpr size_t OFF_gl_win_t = 37762560ull;
constexpr size_t OFF_gl_wout_t = 44054016ull;
constexpr size_t OFF_moe_w1_t = 46151168ull;
constexpr size_t OFF_moe_w2_t = 314586624ull;
constexpr size_t OFF_H = 448804352ull;
constexpr size_t OFF_H1 = 515913216ull;
constexpr size_t OFF_MIX = 583022080ull;
constexpr size_t OFF_BUF = 650130944ull;
constexpr size_t OFF_ACT = 734017024ull;
constexpr size_t OFF_YBUF = 775960064ull;
constexpr size_t OFF_CNT = 859846144ull;
constexpr size_t OFF_EIDX = 859878912ull;
constexpr size_t OFF_GATE = 860009984ull;
constexpr size_t OFF_DEST = 860141056ull;
constexpr size_t OFF_TAB = 860272128ull;
constexpr size_t OFF_YB = 860273152ull;
constexpr size_t OFF_X6 = 927382016ull;
constexpr size_t OFF_Rr = 1128708608ull;
constexpr size_t OFF_Kk = 1195817472ull;
constexpr size_t OFF_Vv = 1262926336ull;
constexpr size_t OFF_LW = 1330035200ull;
constexpr size_t OFF_Wd = 1355201024ull;
constexpr size_t OFF_Aa = 1422309888ull;
constexpr size_t OFF_Gg = 1489418752ull;
constexpr size_t OFF_RWf = 1556527616ull;
constexpr size_t OFF_RBf = 1590082048ull;
constexpr size_t OFF_RUt = 1623636480ull;
constexpr size_t OFF_RNa = 1657190912ull;
constexpr size_t OFF_RGc = 1690745344ull;
constexpr size_t OFF_RUa = 1691793920ull;
constexpr size_t OFF_RS0 = 1725348352ull;
constexpr size_t OFF_Z = 960936448ull;
constexpr size_t OFF_XBC = 1028045312ull;
constexpr size_t OFF_XC = 1128708608ull;
constexpr size_t OFF_DT = 1229371904ull;
constexpr size_t OFF_STATES = 1231469056ull;
constexpr size_t OFF_CD = 1365686784ull;
constexpr size_t OFF_PREV = 1365703168ull;
constexpr size_t OFF_LA = 1432812032ull;
constexpr size_t OFF_CDG = 1466366464ull;
constexpr size_t OFF_QKVG = OFF_XBC;
constexpr size_t WS_TOTAL = 1758902784ull;
typedef unsigned T_bar;
typedef bf16_t T_rw_rkv_t;
typedef bf16_t T_rw_w1_t;
typedef bf16_t T_rw_a1_t;
typedef bf16_t T_rw_g1_t;
typedef bf16_t T_rw_w2_t;
typedef bf16_t T_rw_a2_t;
typedef bf16_t T_rw_g2_t;
typedef bf16_t T_rw_wo_t;
typedef bf16_t T_mb_win_t;
typedef bf16_t T_mb_wout_t;
typedef bf16_t T_gl_win_t;
typedef bf16_t T_gl_wout_t;
typedef bf16_t T_moe_w1_t;
typedef bf16_t T_moe_w2_t;
typedef float T_H;
typedef float T_H1;
typedef float T_MIX;
typedef bf16_t T_BUF;
typedef bf16_t T_ACT;
typedef bf16_t T_YBUF;
typedef int T_CNT;
typedef int T_EIDX;
typedef float T_GATE;
typedef int T_DEST;
typedef int T_TAB;
typedef bf16_t T_YB;
typedef bf16_t T_X6;
typedef float T_Rr;
typedef float T_Kk;
typedef float T_Vv;
typedef bf16_t T_LW;
typedef float T_Wd;
typedef float T_Aa;
typedef float T_Gg;
typedef bf16_t T_RWf;
typedef bf16_t T_RBf;
typedef bf16_t T_RUt;
typedef bf16_t T_RNa;
typedef float T_RGc;
typedef bf16_t T_RUa;
typedef bf16_t T_RS0;
typedef bf16_t T_Z;
typedef bf16_t T_XBC;
typedef bf16_t T_XC;
typedef float T_DT;
typedef bf16_t T_STATES;
typedef float T_CD;
typedef bf16_t T_PREV;
typedef float T_LA;
typedef float T_CDG;
typedef bf16_t T_QKVG;
#define WS_(P, N) ((T_##N*)((P).ws + OFF_##N))
constexpr size_t OFF_Hb = OFF_H, OFF_H1b = OFF_H1, OFF_MIXb = OFF_MIX;
typedef bf16_t T_Hb; typedef bf16_t T_H1b; typedef bf16_t T_MIXb;
constexpr size_t OFF_moe_wr_t = OFF_H + 33554432ull;
typedef bf16_t T_moe_wr_t;
constexpr size_t OFF_mb_dt_t = OFF_moe_wr_t + 4ull * 48 * 1024 * 2, OFF_gl_lr_t = OFF_mb_dt_t + 32ull * 1024 * 2;
typedef bf16_t T_mb_dt_t; typedef bf16_t T_gl_lr_t;
constexpr size_t OFF_MFLAG = OFF_gl_lr_t + 16ull * 1024 * 2;
typedef unsigned T_MFLAG;
constexpr int MFLAG_STRIDE = 16, MFLAG_TICKET = 256;
constexpr size_t OFF_Rb = OFF_Rr, OFF_Kb = OFF_Kk, OFF_Vb = OFF_Vv, OFF_Ab = OFF_Aa, OFF_Gb = OFF_Gg;
typedef bf16_t T_Rb; typedef bf16_t T_Kb; typedef bf16_t T_Vb; typedef bf16_t T_Ab; typedef bf16_t T_Gb;
constexpr size_t OFF_Wb = OFF_Wd; typedef bf16_t T_Wb;
struct ConvJob {
    const float* src; bf16_t* dst;
    int K, N, src_ld, Kpad, Npad, perm, batch;
    long long src_bs, dst_bs;
    DEV int ntiles() const { return (Kpad / 64) * (Npad / 64) * batch; }
};
#ifndef PERMF
#define PERMF 0xDF
#endif
#define PF(bit) (((PERMF) >> (bit)) & 1)
constexpr int NJOBS = 16;
constexpr int MOE_SPLIT = 32;

#define PARAM_LIST(X) \
    X(const float*, x) X(const float*, ln_g) X(const float*, ln_b) \
    X(const float*, rw_mu) X(const float*, rw_w_rkv) X(const float*, rw_w0) X(const float*, rw_w1) X(const float*, rw_w2) X(const float*, rw_a0) X(const float*, rw_a1) X(const float*, rw_a2) \
    X(const float*, rw_g1) X(const float*, rw_g2) X(const float*, rw_k_k) X(const float*, rw_k_a) X(const float*, rw_r_k) X(const float*, rw_lnx_g) X(const float*, rw_lnx_b) X(const float*, rw_w_o) \
    X(const float*, mb_w_in) X(const float*, mb_conv_w) X(const float*, mb_conv_b) X(const float*, mb_dt_bias) X(const float*, mb_a_log) X(const float*, mb_d) X(const float*, mb_norm_g) X(const float*, mb_w_out) \
    X(const float*, gl_w_in) X(const float*, gl_gk_w2) X(const float*, gl_gk_b) X(const float*, gl_norm_g) X(const float*, gl_w_out) \
    X(const float*, moe_w_group) X(const float*, moe_b_group) X(const float*, moe_w_route) X(const float*, moe_b_route) X(const float*, moe_w_in) X(const float*, moe_w_down) \
    X(float*, out) X(char*, ws)
struct Params {
#define X(t, n) t n;
    PARAM_LIST(X)
#undef X
};

enum Op : unsigned char { OP_CONVERT = 0, OP_PRE0, OP_RW_GEMM1, OP_RW_GEMM2, OP_RW_CHA, OP_RW_CHB, OP_RW_CHC, OP_RW_OUT,
    OP_LN1, OP_MOE_SCATTER, OP_MOE_GEMM1, OP_MOE_GEMM2, OP_LN2,
    OP_MB_GEMM_IN, OP_MB_CONV, OP_MB_STATES, OP_MB_SCAN, OP_MB_OUT, OP_MB_GEMM_OUT,
    OP_GL_GEMM_IN, OP_GL_KV, OP_GL_SCAN, OP_GL_OUT, OP_GL_GEMM_OUT };


DEV ConvJob make_job(const Params& p, int q) {
    const long long DD = (long long)D * D;
    switch (q) {
    case 0: return ConvJob{p.rw_w_rkv, WS_(p, rw_rkv_t), 1024, 1024, 1024, 1024, 1024, 0 | 2 * PF(0), 6, DD, DD};
    case 1: return ConvJob{p.rw_w1, WS_(p, rw_w1_t), 1024, 64, 64, 1024, 256, 0 | 2 * PF(1), 2, (long long)D * 64, (long long)256 * D};
    case 2: return ConvJob{p.rw_a1, WS_(p, rw_a1_t), 1024, 64, 64, 1024, 256, 0 | 2 * PF(1), 2, (long long)D * 64, (long long)256 * D};
    case 3: return ConvJob{p.rw_g1, WS_(p, rw_g1_t), 1024, 160, 160, 1024, 256, 0 | 2 * PF(1), 2, (long long)D * 160, (long long)256 * D};
    case 4: return ConvJob{p.rw_w2, WS_(p, rw_w2_t), 64, 1024, 1024, 256, 1024, 0 | 2 * PF(2), 2, (long long)64 * D, (long long)D * 256};
    case 5: return ConvJob{p.rw_a2, WS_(p, rw_a2_t), 64, 1024, 1024, 256, 1024, 0 | 2 * PF(2), 2, (long long)64 * D, (long long)D * 256};
    case 6: return ConvJob{p.rw_g2, WS_(p, rw_g2_t), 160, 1024, 1024, 256, 1024, 0 | 2 * PF(2), 2, (long long)160 * D, (long long)D * 256};
    case 7: return ConvJob{p.rw_w_o, WS_(p, rw_wo_t), 1024, 1024, 1024, 1024, 1024, 0 | 2 * PF(3), 2, DD, DD};
    case 8: return ConvJob{p.mb_w_in, WS_(p, mb_win_t), 1024, 5120, 5152, 1024, 5120, 0 | 2 * PF(4), 1, 0, 0};
    case 9: return ConvJob{p.mb_w_out, WS_(p, mb_wout_t), 2048, 1024, 1024, 2048, 1024, 0 | 2 * PF(3), 1, 0, 0};
    case 10: return ConvJob{p.gl_w_in, WS_(p, gl_win_t), 1024, 3072, 3088, 1024, 3072, 0 | 2 * PF(5), 1, 0, 0};
    case 11: return ConvJob{p.gl_w_out, WS_(p, gl_wout_t), 1024, 1024, 1024, 1024, 1024, 0 | 2 * PF(3), 1, 0, 0};
    case 12: return ConvJob{p.moe_w_in, WS_(p, moe_w1_t), 1024, 1024, 1024, 1024, 1024, 1 | 2 * PF(6), MOE_SPLIT, DD, DD};
    case 13: return ConvJob{p.moe_w_down, WS_(p, moe_w2_t), 512, 1024, 1024, 512, 1024, 0 | 2 * PF(7), MOE_SPLIT, (long long)512 * 1024, (long long)1024 * 512};
    case 14: return ConvJob{p.moe_w_in + (size_t)MOE_SPLIT * DD, WS_(p, moe_w1_t) + (size_t)MOE_SPLIT * DD, 1024, 1024, 1024, 1024, 1024, 1 | 2 * PF(6), 128 - MOE_SPLIT, DD, DD};
    default: return ConvJob{p.moe_w_down + (size_t)MOE_SPLIT * 512 * 1024, WS_(p, moe_w2_t) + (size_t)MOE_SPLIT * 512 * 1024, 512, 1024, 1024, 512, 1024, 0 | 2 * PF(7), 128 - MOE_SPLIT, (long long)512 * 1024, (long long)1024 * 512};
    }
}

DEV void convert_tile(const ConvJob& J, LAS bf16_t* tile, int local, int lane) {
    const int tk = J.Kpad / 64, tn = J.Npad / 64;
    const int b = local / (tk * tn); local -= b * tk * tn;
    const int nt = local / tk, kt = local - nt * tk;
    const float* src = J.src + (size_t)b * J.src_bs;
    bf16_t* dst = J.dst + (size_t)b * J.dst_bs;
    const int k0 = kt * 64, n0 = nt * 64;
    const int nn = (lane & 15) * 4; const bool nok = n0 + nn < J.N;
    f32x4 v[16];
#pragma unroll
    for (int i = 0; i < 16; ++i) { const int kk = (lane >> 4) + 4 * i; v[i] = (nok && k0 + kk < J.K) ? *(const f32x4*)(src + (size_t)(k0 + kk) * J.src_ld + n0 + nn) : (f32x4){0.f, 0.f, 0.f, 0.f}; }
#pragma unroll
    for (int i = 0; i < 16; ++i) { const int kk = (lane >> 4) + 4 * i;
#pragma unroll
        for (int e = 0; e < 4; ++e) tile[(nn + e) * 72 + kk] = (bf16_t)f2bf(v[i][e]); }
#pragma unroll
    for (int i = 0; i < 8; ++i) { const int r = (lane >> 3) + 8 * i, kc = (lane & 7) * 8;
        int nsrc = n0 + r, ndst = nsrc;
        if (J.perm & 1) { const int up = nsrc >= 512, jj = nsrc - (up ? 512 : 0); ndst = (jj >> 7) * 256 + (up ? 128 : 0) + (jj & 127); }
        if (J.perm & 2) { const int cc = ndst & 31; ndst = (ndst & ~31) | (((cc >> 2) & 1) << 4) | ((cc >> 3) << 2) | (cc & 3); }
        *(u32x4*)(dst + (size_t)ndst * J.Kpad + k0 + kc) = *(const LAS u32x4*)(tile + r * 72 + kc); }
}
DEV void convert_one(const ConvJob& J, LAS unsigned char* lds, int B0, int NBW, int tbeg, int WL = 8) {
    const int tid = tid_(), bid = bid_();
    const int lane = tid & 63, wv = tid >> 6; const int gw = (bid - B0) * WL + wv, NW = NBW * WL;
    if (wv >= WL) return;
    LAS bf16_t* tile = (LAS bf16_t*)lds + wv * (64 * 72);
    const int jend = tbeg + J.ntiles();
    const int ti0 = tbeg + ((gw - tbeg) % NW + NW) % NW;
#pragma unroll 1
    for (int ti = ti0; ti < jend; ti += NW) convert_tile(J, tile, ti - tbeg, lane);
}
DEV void convert_tickets(const ConvJob& J0, const ConvJob& J1, LAS unsigned char* lds, unsigned* ctrs, int stride) {
    constexpr int NG = 32;
    const int tid = tid_(); const int lane = tid & 63, wv = tid >> 6; const int g = bid_() & (NG - 1);
    unsigned* ctr = ctrs + g * stride;
    LAS bf16_t* tile = (LAS bf16_t*)lds + wv * (64 * 72);
    const int n0 = J0.ntiles(), n = n0 + J1.ntiles();
    int cur = 0; if (lane == 0) cur = (int)__hip_atomic_fetch_add(ctr, 1u, __ATOMIC_RELAXED, __HIP_MEMORY_SCOPE_AGENT);
    cur = __builtin_amdgcn_readfirstlane(cur) * NG + g;
#pragma unroll 1
    while (cur < n) {
        int nx = 0; if (lane == 0) nx = (int)__hip_atomic_fetch_add(ctr, 1u, __ATOMIC_RELAXED, __HIP_MEMORY_SCOPE_AGENT);
        const bool first = cur < n0; const ConvJob J = first ? J0 : J1;
        convert_tile(J, tile, first ? cur : cur - n0, lane);
        cur = __builtin_amdgcn_readfirstlane(nx) * NG + g;
    }
}
template <int J0, int J1> DEV int convert_jobs(const Params& p, LAS unsigned char* lds, int B0, int NBW, int tbeg = 0, int WL = 8) {
#pragma unroll
    for (int j = J0; j < J1; ++j) { const ConvJob J = make_job(p, j); convert_one(J, lds, B0, NBW, tbeg, WL); tbeg += J.ntiles(); }
    return tbeg;
}
DEV ConvJob moe_job(const Params& p, int which, int ml) {
    const long long DD = (long long)D * D; const size_t b0 = (size_t)ml * 32;
    if (which == 0) return ConvJob{p.moe_w_in + b0 * DD, WS_(p, moe_w1_t) + b0 * DD, 1024, 1024, 1024, 1024, 1024, 1 | 2 * PF(6), 32, DD, DD};
    return ConvJob{p.moe_w_down + b0 * 512 * 1024, WS_(p, moe_w2_t) + b0 * 512 * 1024, 512, 1024, 1024, 512, 1024, 0 | 2 * PF(7), 32, (long long)512 * 1024, (long long)1024 * 512};
}
DEV void phase_convert(const Params& p, LAS unsigned char* lds) {
    const int tid = tid_(), bid = bid_();
    convert_jobs<0, 8>(p, lds, 0, NB_);
    if (bid < 4 * 48) { const int layer = bid / 48, o = bid % 48;
        for (int k = tid; k < D; k += NTHR) { float v = 0.f;
            if (o < 32) v = p.moe_w_route[((size_t)layer * D + k) * 32 + o]; else if (o < 36) v = p.moe_w_group[((size_t)layer * D + k) * 4 + (o - 32)];
            WS_(p, moe_wr_t)[((size_t)layer * 48 + o) * D + k] = (bf16_t)f2bf(v); } }
    else if (bid < 4 * 48 + 32) { const int o = bid - 192;
        for (int k = tid; k < D; k += NTHR) WS_(p, mb_dt_t)[(size_t)o * D + k] = (bf16_t)f2bf(p.mb_w_in[(size_t)k * 5152 + 5120 + o]); }
    else if (bid < 4 * 48 + 48) { const int o = bid - 224;
        for (int k = tid; k < D; k += NTHR) WS_(p, gl_lr_t)[(size_t)o * D + k] = (bf16_t)f2bf(p.gl_w_in[(size_t)k * 3088 + 3072 + o]); }
}
namespace pg8 {
constexpr int BM = 256, BK = 64, HALF = 128, HTB = HALF * BK * 2, STAGE_BYTES = 8 * HTB;
DEV int lds_byte(int r, int c) { const int st = (r >> 4) * 2 + (c >> 5), rr = r & 15, cc = c & 31, ob = rr * 64 + cc * 2; return st * 1024 + (ob ^ (((ob >> 9) & 1) << 5)); }
DEV void stage_rc(int b, int& R, int& C) { const int st = b / 1024, sb = b % 1024, swz = sb ^ (((sb >> 9) & 1) << 5); R = (st >> 1) * 16 + swz / 64; C = (st & 1) * 32 + (swz % 64) / 2; }

struct Unit { const char* A; const char* B; int row0, col0, id, aux; };

DEV bool tile_order(int i, int G, int c, int nM, int nN, int& pm, int& pn) {
    const int nwg = nM * nN; const long L = (long)i * G + c; if (L >= nwg) return false;
    int wgid = (int)L; { const int q = nwg / 8, r = nwg % 8, xcd = wgid % 8, off = wgid / 8; wgid = (xcd < r ? xcd * (q + 1) : r * (q + 1) + (xcd - r) * q) + off; }
    const int nig = 8 * nN, gid = wgid / nig, fm = gid * 8, gsz = (nM - fm) < 8 ? (nM - fm) : 8;
    pm = fm + ((wgid % nig) % gsz); pn = (wgid % nig) / gsz; return true;
}

template <class Epi, class Sched>
DEV void gemm_phase(LAS unsigned char* lds, const int K, const Sched& S, const Epi& E) {
    const int tid = tid_(), wid = __builtin_amdgcn_readfirstlane(tid >> 6), lane = tid & 63, wr = wid >> 2, wc = wid & 3, fr = lane & 15, fq = lane >> 4;
    const int nt = K / BK;
    unsigned voff[2];
#pragma unroll
    for (int i = 0; i < 2; ++i) { int R, C; stage_rc(tid * 16 + i * 8192, R, C); voff[i] = (unsigned)(R * K + C) * 2u; }
    const size_t kstep = (size_t)(BK * 2);
    const size_t hstep = (size_t)HALF * K * 2;
    const unsigned ldsw = (unsigned)wid * 1024u;
    const int aoff = lds_byte(wr * 64 + fr, fq * 8), boff = lds_byte(wc * 32 + fr, fq * 8);
#define PG8_SA(b, h) (((b) * 2 + (h)) * HTB)
#define PG8_SB(b, h) ((4 + (b) * 2 + (h)) * HTB)
#define PG8_STAGE(bufoff, gbase) do { _Pragma("unroll") for (int _i = 0; _i < 2; ++_i) \
        __builtin_amdgcn_global_load_lds((const unsigned*)((const char*)(gbase) + voff[_i]), (LAS unsigned*)(lds + (bufoff) + ldsw + _i * 8192), 16, 0, 0); } while (0)
#define PG8_LDA(dst, b, h) do { _Pragma("unroll") for (int m = 0; m < 4; ++m) _Pragma("unroll") for (int k = 0; k < 2; ++k) dst[m][k] = *(const LAS bf16x8*)(lds + PG8_SA(b, h) + aoff + m * 2048 + k * 1024); } while (0)
#define PG8_LDB(dst, b, h) do { _Pragma("unroll") for (int n = 0; n < 2; ++n) _Pragma("unroll") for (int k = 0; k < 2; ++k) dst[n][k] = *(const LAS bf16x8*)(lds + PG8_SB(b, h) + boff + n * 2048 + k * 1024); } while (0)
#define PG8_MMA(ai, bj, At, Bt) do { __builtin_amdgcn_s_setprio(1); _Pragma("unroll") for (int m = 0; m < 4; ++m) _Pragma("unroll") for (int n = 0; n < 2; ++n) _Pragma("unroll") for (int k = 0; k < 2; ++k) \
        acc[ai][bj][m][n] = __builtin_amdgcn_mfma_f32_16x16x32_bf16(Bt[n][k], At[m][k], acc[ai][bj][m][n], 0, 0, 0); __builtin_amdgcn_s_setprio(0); } while (0)
#define PG8_WAIT_V(n) asm volatile("s_waitcnt vmcnt(" #n ")" ::: "memory")
#define PG8_WAIT_L(n) asm volatile("s_waitcnt lgkmcnt(" #n ")" ::: "memory")
#define PG8_BAR __builtin_amdgcn_s_barrier()
#define PG8_SCHED __builtin_amdgcn_sched_barrier(0)
    Unit cur, nxt; int ui = 0;
    if (!S.next(0, cur)) return;
    f32x4 acc[2][2][4][2];
#pragma unroll
    for (int a = 0; a < 2; ++a)
#pragma unroll
        for (int b = 0; b < 2; ++b)
#pragma unroll
            for (int m = 0; m < 4; ++m)
#pragma unroll
                for (int n = 0; n < 2; ++n) acc[a][b][m][n] = (f32x4){0.f, 0.f, 0.f, 0.f};
    bf16x8 At[4][2], B0[2][2], B1[2][2];
    const char* cA = cur.A; const char* cB = cur.B;
    PG8_STAGE(PG8_SB(0, 0), cB); PG8_STAGE(PG8_SA(0, 0), cA); PG8_STAGE(PG8_SB(0, 1), cB + hstep); PG8_STAGE(PG8_SA(0, 1), cA + hstep);
    if (wr == 1) PG8_BAR;
    PG8_WAIT_V(4); PG8_BAR;
    PG8_STAGE(PG8_SB(1, 0), cB + kstep); PG8_STAGE(PG8_SA(1, 0), cA + kstep); PG8_STAGE(PG8_SB(1, 1), cB + hstep + kstep);
    PG8_WAIT_V(6); PG8_BAR;
    for (;;) {
        const bool has_next = S.next(ui + 1, nxt);
        const char* nA = has_next ? nxt.A : cA; const char* nB = has_next ? nxt.B : cB;
#pragma unroll 1
        for (int t = 0; t < nt; t += 2) {
            const bool last = (t == nt - 2);
            const char* a1 = cA + (size_t)(t + 1) * kstep;
            const char* a2 = last ? nA : cA + (size_t)(t + 2) * kstep; const char* b2 = last ? nB : cB + (size_t)(t + 2) * kstep;
            const char* a3 = a2 + kstep; const char* b3 = b2 + kstep;
            PG8_LDB(B0, 0, 0); PG8_SCHED; PG8_LDA(At, 0, 0); PG8_STAGE(PG8_SA(1, 1), a1 + hstep);
            PG8_WAIT_L(8); PG8_BAR; PG8_WAIT_L(0); PG8_MMA(0, 0, At, B0); PG8_BAR; PG8_SCHED;
            PG8_LDB(B1, 0, 1); PG8_STAGE(PG8_SB(0, 0), b2);
            PG8_BAR; PG8_WAIT_L(0); PG8_MMA(0, 1, At, B1); PG8_BAR;
            PG8_LDA(At, 0, 1); PG8_STAGE(PG8_SA(0, 0), a2);
            PG8_BAR; PG8_WAIT_L(0); PG8_MMA(1, 0, At, B0); PG8_BAR; PG8_SCHED;
            PG8_STAGE(PG8_SB(0, 1), b2 + hstep);
            PG8_WAIT_V(6); PG8_BAR; PG8_MMA(1, 1, At, B1); PG8_BAR;
            PG8_LDB(B0, 1, 0); PG8_SCHED; PG8_LDA(At, 1, 0); PG8_STAGE(PG8_SA(0, 1), a2 + hstep);
            PG8_WAIT_L(8); PG8_BAR; PG8_WAIT_L(0); PG8_MMA(0, 0, At, B0); PG8_BAR; PG8_SCHED;
            PG8_LDB(B1, 1, 1); PG8_STAGE(PG8_SB(1, 0), b3);
            PG8_BAR; PG8_WAIT_L(0); PG8_MMA(0, 1, At, B1); PG8_BAR;
            PG8_LDA(At, 1, 1); PG8_STAGE(PG8_SA(1, 0), a3);
            PG8_BAR; PG8_WAIT_L(0); PG8_MMA(1, 0, At, B0); PG8_BAR; PG8_SCHED;
            PG8_STAGE(PG8_SB(1, 1), b3 + hstep);
            PG8_WAIT_V(6); PG8_BAR; PG8_MMA(1, 1, At, B1); PG8_BAR;
        }
        E(acc, cur, wr, wc, fr, fq);
        if (!has_next) break;
#pragma unroll
        for (int a = 0; a < 2; ++a)
#pragma unroll
            for (int b = 0; b < 2; ++b)
#pragma unroll
                for (int m = 0; m < 4; ++m)
#pragma unroll
                    for (int n = 0; n < 2; ++n) acc[a][b][m][n] = (f32x4){0.f, 0.f, 0.f, 0.f};
        cur = nxt; cA = nA; cB = nB; ++ui;
    }
    PG8_WAIT_V(0);
    if (wr == 0) PG8_BAR;
    PG8_BAR;
#undef PG8_SA
#undef PG8_SB
#undef PG8_STAGE
#undef PG8_LDA
#undef PG8_LDB
#undef PG8_MMA
#undef PG8_WAIT_V
#undef PG8_WAIT_L
#undef PG8_BAR
#undef PG8_SCHED
}
}
using pg8::Unit;
typedef f32x4 AccT[2][2][4][2];
#define FOR_ACC(ai, bj, m, n) _Pragma("unroll") for (int ai = 0; ai < 2; ++ai) _Pragma("unroll") for (int m = 0; m < 4; ++m) _Pragma("unroll") for (int bj = 0; bj < 2; ++bj) _Pragma("unroll") for (int n = 0; n < 2; ++n)
#define ACC_FENCE __builtin_amdgcn_sched_barrier(0)
#define ACC_ROW(u, ai, m) ((u).row0 + 128 * (ai) + 64 * wr + 16 * (m) + fr)
#define ACC_COLP(u, bj, n, P) ((P) ? ((u).col0 + 128 * (bj) + 32 * wc + 8 * fq + 4 * (n)) : ((u).col0 + 128 * (bj) + 32 * wc + 16 * (n) + 4 * fq))
#define ACC_COL8P(u, bj, P) ACC_COLP(u, bj, 0, P)
#define FOR_ACC2(ai, bj, m) _Pragma("unroll") for (int ai = 0; ai < 2; ++ai) _Pragma("unroll") for (int m = 0; m < 4; ++m) _Pragma("unroll") for (int bj = 0; bj < 2; ++bj)
DEV void st_bf4(bf16_t* p, f32x4 v) { u32x2 w; w.x = pk2(v[0], v[1]); w.y = pk2(v[2], v[3]); *(u32x2*)p = w; }
DEV u32x4 pk8v(f32x4 a, f32x4 b) { u32x4 w; w.x = pk2(a[0], a[1]); w.y = pk2(a[2], a[3]); w.z = pk2(b[0], b[1]); w.w = pk2(b[2], b[3]); return w; }
#ifdef ST8
DEV void st_bf8p(bf16_t* p, f32x4 a, f32x4 b, bool P) { if (P) { st_bf4(p, a); st_bf4(p + 4, b); } else { st_bf4(p, a); st_bf4(p + 16, b); } }
#else
DEV void st_bf8p(bf16_t* p, f32x4 a, f32x4 b, bool P) { if (P) *(u32x4*)p = pk8v(a, b); else { st_bf4(p, a); st_bf4(p + 16, b); } }
#endif
DEV void load_row(const float* p, int lane, f32x4 (&v)[4]) {
#pragma unroll
    for (int q = 0; q < 4; ++q) v[q] = *(const f32x4*)(p + RCOL(q, lane));
}

DEV void load_row_bf(const bf16_t* p, int lane, f32x4 (&v)[4]) {
#pragma unroll
    for (int q = 0; q < 4; ++q) { const u32x2 a = *(const u32x2*)(p + RCOL(q, lane)); v[q] = (f32x4){bflo(a.x), bfhi(a.x), bflo(a.y), bfhi(a.y)}; }
}
DEV void store_row_bf(bf16_t* p, int lane, const f32x4 (&v)[4]) {
#pragma unroll
    for (int q = 0; q < 4; ++q) st_bf4(p + RCOL(q, lane), v[q]);
}
DEV void emit_mix6(const Params& p, int j, int t, int lane, const f32x4 (&x)[4], const f32x4 (&xp)[4]) {
    const float* mu = p.rw_mu + (size_t)j * 6 * D;
#pragma unroll
    for (int s = 0; s < 6; ++s) {
#pragma unroll
        for (int q = 0; q < 4; ++q) {
            const f32x4 m = *(const f32x4*)(mu + s * D + RCOL(q, lane));
            st_bf4(WS_(p, X6) + (size_t)s * T * D + (size_t)t * D + RCOL(q, lane), x[q] + (xp[q] - x[q]) * m);
        }
        __builtin_amdgcn_sched_barrier(0);
    }
}
DEV void phase_pre0(const Params& p) {
    const int tid = tid_(), bid = bid_(); const int lane = tid & 63, wid = tid >> 6;
    f32x4 x[4], xp[4];
    const int tfirst = bid * 64 + wid * 8;
    if (tfirst > 0) load_row(p.x + (size_t)(tfirst - 1) * D, lane, xp); else { for (int q = 0; q < 4; ++q) xp[q] = (f32x4){0.f, 0.f, 0.f, 0.f}; }
    f32x4 xn[4]; load_row(p.x + (size_t)tfirst * D, lane, xn);
#pragma unroll 1
    for (int r = 0; r < 8; ++r) {
        const int t = tfirst + r;
#pragma unroll
        for (int q = 0; q < 4; ++q) x[q] = xn[q];
        load_row(p.x + (size_t)(r < 7 ? t + 1 : t) * D, lane, xn);
        store_row_bf(WS_(p, Hb) + (size_t)t * D, lane, x);
        emit_mix6(p, 0, t, lane, x, xp);
#pragma unroll
        for (int q = 0; q < 4; ++q) xp[q] = x[q];
    }
}

struct SchedRW1 {
    const Params* p; int j;
    DEV bool next(int i, Unit& u) const {
        int pm, pn; if (!pg8::tile_order(i, NB_, bid_(), 64, 15, pm, pn)) return false;
        int id, lpn; if (pn < 12) { id = pn >> 2; lpn = pn & 3; } else { id = 3 + (pn - 12); lpn = 0; }
        u.A = (const char*)(WS_(*p, X6) + (size_t)id * T * D + (size_t)pm * 256 * D);
        const bf16_t* B;
        if (id < 3) B = WS_(*p, rw_rkv_t) + ((size_t)j * 3 + id) * D * D + (size_t)lpn * 256 * D;
        else B = WS_(*p, rw_w1_t) + (size_t)(id - 3) * (2 * 256 * D) + (size_t)j * 256 * D;
        u.B = (const char*)B; u.row0 = pm * 256; u.col0 = lpn * 256; u.id = id; u.aux = 0; return true;
    }
};
struct EpiRW1 {
    const Params* p;
    DEV void operator()(const AccT& acc, const Unit& u, int wr, int wc, int fr, int fq) const {
        if (u.id < 3) {
            bf16_t* O = WS_(*p, Rb) + (size_t)u.id * 2 * T * D;
            FOR_ACC2(ai, bj, m) { st_bf8p(O + (size_t)ACC_ROW(u, ai, m) * D + ACC_COL8P(u, bj, PF(0)), acc[ai][bj][m][0], acc[ai][bj][m][1], PF(0)); ACC_FENCE; }
        } else {
            bf16_t* O = WS_(*p, LW) + (size_t)(u.id - 3) * T * 256;
            FOR_ACC2(ai, bj, m) {
                f32x4 v0 = acc[ai][bj][m][0], v1 = acc[ai][bj][m][1];
                if (u.id == 3) { for (int e = 0; e < 4; ++e) { v0[e] = tanhf_(v0[e]); v1[e] = tanhf_(v1[e]); } }
                else if (u.id == 5) { for (int e = 0; e < 4; ++e) { v0[e] = sigmoidf_(v0[e]); v1[e] = sigmoidf_(v1[e]); } }
                st_bf8p(O + (size_t)ACC_ROW(u, ai, m) * 256 + ACC_COL8P(u, bj, PF(1)), v0, v1, PF(1)); ACC_FENCE;
            }
        }
    }
};
struct SchedRW2 {
    const Params* p; int j;
    DEV bool next(int i, Unit& u) const {
        int pm, pn; if (!pg8::tile_order(i, NB_, bid_(), 64, 12, pm, pn)) return false;
        const int id = pn >> 2, lpn = pn & 3;
        u.A = (const char*)(WS_(*p, LW) + (size_t)id * T * 256 + (size_t)pm * 256 * 256);
        const bf16_t* B = WS_(*p, rw_w2_t) + (size_t)id * (2 * D * 256) + (size_t)j * D * 256 + (size_t)lpn * 256 * 256;
        u.B = (const char*)B; u.row0 = pm * 256; u.col0 = lpn * 256; u.id = id; u.aux = 0; return true;
    }
};
struct EpiRW2 {
    const Params* p; int j;
    DEV void operator()(const AccT& acc, const Unit& u, int wr, int wc, int fr, int fq) const {
        if (u.id == 0) { const float* bias = p->rw_w0 + (size_t)j * D; f32x4 bv[2][2];
#pragma unroll
            for (int bj = 0; bj < 2; ++bj)
#pragma unroll
                for (int n = 0; n < 2; ++n) bv[bj][n] = *(const f32x4*)(bias + ACC_COLP(u, bj, n, PF(2)));
            FOR_ACC2(ai, bj, m) { f32x4 vv[2];
#pragma unroll
                for (int n = 0; n < 2; ++n) { f32x4 v = acc[ai][bj][m][n]; const f32x4 b = bv[bj][n];
                    for (int e = 0; e < 4; ++e) { const float x = -(b[e] + v[e]); const float wl = -(fmaxf(x, 0.f) + __logf(1.0f + __expf(-fabsf(x)))) - 0.5f; v[e] = -__expf(wl); }
                    vv[n] = v; }
                st_bf8p(WS_(*p, Wb) + (size_t)ACC_ROW(u, ai, m) * D + ACC_COL8P(u, bj, PF(2)), vv[0], vv[1], PF(2)); ACC_FENCE; } }
        else if (u.id == 1) { const float* bias = p->rw_a0 + (size_t)j * D; f32x4 bv[2][2];
#pragma unroll
            for (int bj = 0; bj < 2; ++bj)
#pragma unroll
                for (int n = 0; n < 2; ++n) bv[bj][n] = *(const f32x4*)(bias + ACC_COLP(u, bj, n, PF(2)));
            FOR_ACC2(ai, bj, m) { f32x4 vv[2];
#pragma unroll
                for (int n = 0; n < 2; ++n) { f32x4 v = acc[ai][bj][m][n]; const f32x4 b = bv[bj][n];
                    for (int e = 0; e < 4; ++e) v[e] = sigmoidf_(b[e] + v[e]);
                    vv[n] = v; }
                st_bf8p(WS_(*p, Ab) + (size_t)ACC_ROW(u, ai, m) * D + ACC_COL8P(u, bj, PF(2)), vv[0], vv[1], PF(2)); ACC_FENCE; } }
        else { FOR_ACC2(ai, bj, m) { st_bf8p(WS_(*p, Gb) + (size_t)ACC_ROW(u, ai, m) * D + ACC_COL8P(u, bj, PF(2)), acc[ai][bj][m][0], acc[ai][bj][m][1], PF(2)); ACC_FENCE; } }
    }
};

struct SchedOut {
    const bf16_t* A; const bf16_t* Bt; int K;
    DEV bool next(int i, Unit& u) const {
        int pm, pn; if (!pg8::tile_order(i, NB_, bid_(), 64, 4, pm, pn)) return false;
        u.A = (const char*)(A + (size_t)pm * 256 * K); u.B = (const char*)(Bt + (size_t)pn * 256 * K); u.row0 = pm * 256; u.col0 = pn * 256; u.id = 0; u.aux = 0; return true;
    }
};
struct EpiOut {
    bf16_t* O;
    DEV void operator()(const AccT& acc, const Unit& u, int wr, int wc, int fr, int fq) const {
        FOR_ACC2(ai, bj, m) { st_bf8p(O + (size_t)ACC_ROW(u, ai, m) * D + ACC_COL8P(u, bj, PF(3)), acc[ai][bj][m][0], acc[ai][bj][m][1], PF(3)); ACC_FENCE; }
    }
};
constexpr int RC_LD = 72;
#ifdef DBG
#define DBGF(cond, bit) do { if (cond) atomicOr(&WS_(p, TAB)[200], (bit)); } while (0)
#else
#define DBGF(cond, bit) do {} while (0)
#endif
DEV bool bad_(float x) { return !(fabsf(x) < 1e30f); }
DEV int rc_pi(int g, int j) { return j < 4 ? 4 * g + j : 16 + 4 * g + (j - 4); }

DEV void rc_load_wd(const Params& p, int t0, int cb, float (&wd)[8]) {
    const int tid = tid_(); const int k = tid & 63, sg = tid >> 6;
#pragma unroll
    for (int i = 0; i < 8; ++i) wd[i] = bf2f(WS_(p, Wb)[(size_t)(t0 + sg * 8 + i) * D + cb + k]);
}
DEV void rc_cum_regs(const float (&wd)[8], LAS float* cum, LAS float* seg) {
    const int tid = tid_(); const int k = tid & 63, sg = tid >> 6;
    float v[8]; float s = 0.f;
#pragma unroll
    for (int i = 0; i < 8; ++i) { s += wd[i]; v[i] = s; }
    seg[sg * 64 + k] = s;
    lds_barrier();
    float off = 0.f;
#pragma unroll
    for (int q = 0; q < 8; ++q) off += (q < sg) ? seg[q * 64 + k] : 0.f;
#pragma unroll
    for (int i = 0; i < 8; ++i) cum[(sg * 8 + i) * 64 + k] = v[i] + off;
    lds_barrier();
}
DEV void ld8b(const bf16_t* p, float (&f)[8]) { const u32x4 v = *(const u32x4*)p; f[0] = bflo(v.x); f[1] = bfhi(v.x); f[2] = bflo(v.y); f[3] = bfhi(v.y); f[4] = bflo(v.z); f[5] = bfhi(v.z); f[6] = bflo(v.w); f[7] = bfhi(v.w); }
DEV void ld8(const float* p, float (&f)[8]) { const f32x4 a = *(const f32x4*)p, b = *(const f32x4*)(p + 4); f[0] = a[0]; f[1] = a[1]; f[2] = a[2]; f[3] = a[3]; f[4] = b[0]; f[5] = b[1]; f[6] = b[2]; f[7] = b[3]; }
DEV void lds8(const LAS float* p, float (&f)[8]) { const f32x4 a = *(const LAS f32x4*)p, b = *(const LAS f32x4*)(p + 4); f[0] = a[0]; f[1] = a[1]; f[2] = a[2]; f[3] = a[3]; f[4] = b[0]; f[5] = b[1]; f[6] = b[2]; f[7] = b[3]; }
DEV u32x4 pk8(const float (&f)[8]) { u32x4 o; o.x = pk2(f[0], f[1]); o.y = pk2(f[2], f[3]); o.z = pk2(f[4], f[5]); o.w = pk2(f[6], f[7]); return o; }

DEV bf16x8 frag_rm_pi(const LAS bf16_t* base, int ld, int row0, int k0, int lane) {
    const LAS bf16_t* a = base + (row0 + (lane & 15)) * ld + k0 + 4 * (lane >> 4);
    const s16x4 lo = *(const LAS s16x4*)a, hi = *(const LAS s16x4*)(a + 16);
    bf16x8 r; r[0] = lo[0]; r[1] = lo[1]; r[2] = lo[2]; r[3] = lo[3]; r[4] = hi[0]; r[5] = hi[1]; r[6] = hi[2]; r[7] = hi[3]; return r;
}
DEV void rc_prep8(const float (&k)[8], const float (&al)[8], const float (&kkw)[8], const float (&kaw)[8], float (&a)[8], float (&b)[8], float (&kh)[8]) {
    float kk[8]; float ss = 0.f;
#pragma unroll
    for (int e = 0; e < 8; ++e) { kk[e] = k[e] * kkw[e]; ss += kk[e] * kk[e]; }
    ss += __shfl_xor(ss, 1); ss += __shfl_xor(ss, 2); ss += __shfl_xor(ss, 4);
    const float inv = 1.0f / fmaxf(sqrtf(ss), 1e-12f);
#pragma unroll
    for (int e = 0; e < 8; ++e) { const float kn = kk[e] * inv; a[e] = -kn; b[e] = kn * al[e]; kh[e] = k[e] * (1.0f + (al[e] - 1.0f) * kaw[e]); }
}
DEV void phase_rw_cha(const Params& p, int jl, LAS unsigned char* lds) {
    const int tid = tid_(), bid = bid_(); const int lane = tid & 63, w = tid >> 6; const int fr = lane & 15, fq = lane >> 4;
    LAS float* cum = (LAS float*)lds;
    LAS float* seg = cum + 64 * 64;
    LAS float* Aab = seg + 8 * 64;
    LAS bf16_t* As = (LAS bf16_t*)(Aab + 64 * 68);
    LAS bf16_t* Bs = As + 64 * RC_LD; LAS bf16_t* Ks = Bs + 64 * RC_LD; LAS bf16_t* Vs = Ks + 64 * RC_LD; LAS bf16_t* Ke = Vs + 64 * RC_LD;
    LAS bf16_t* Aak = Ke + 64 * RC_LD; LAS bf16_t* Ts = Aak + 64 * RC_LD; LAS bf16_t* X1 = Ts + 64 * RC_LD; LAS bf16_t* Aabh = X1 + 64 * RC_LD;
    LAS bf16_t* Fimg = Aabh + 64 * RC_LD;
    LAS bf16_t* Wimg = Fimg + 4096;
    float pwd[8], pkr[8], pal[8], pv[8];
    float kkw[8], kaw[8];
    ld8(p.rw_k_k + (size_t)jl * D + (bid & 15) * 64 + (tid & 7) * 8, kkw); ld8(p.rw_k_a + (size_t)jl * D + (bid & 15) * 64 + (tid & 7) * 8, kaw);
    { const int c = bid >> 4, h = bid & 15; rc_load_wd(p, c * 64, h * 64, pwd);
      const size_t go = (size_t)(c * 64 + (tid >> 3)) * D + h * 64 + (tid & 7) * 8; ld8b(WS_(p, Kb) + go, pkr); ld8b(WS_(p, Ab) + go, pal); ld8b(WS_(p, Vb) + go, pv); }
    for (int u = bid; u < 4096; u += NB_) {
        const int c = u >> 4, h = u & 15; const int t0 = c * 64, cb = h * 64; const size_t ub = (size_t)c * 16 + h;
        lds_barrier();
        rc_cum_regs(pwd, cum, seg);
        {
            const int t = tid >> 3, k8 = (tid & 7) * 8;
            float a[8], b[8], kh[8], v[8], ct[8], cp[8], ce[8];
            rc_prep8(pkr, pal, kkw, kaw, a, b, kh);
#pragma unroll
            for (int e = 0; e < 8; ++e) v[e] = pv[e];
            if (u + NB_ < 4096) { const int un = u + NB_; const int cn = un >> 4, hn = un & 15; rc_load_wd(p, cn * 64, hn * 64, pwd);
                const size_t gn = (size_t)(cn * 64 + t) * D + hn * 64 + k8; ld8b(WS_(p, Kb) + gn, pkr); ld8b(WS_(p, Ab) + gn, pal); ld8b(WS_(p, Vb) + gn, pv); }
            lds8(cum + t * 64 + k8, ct); lds8(cum + 63 * 64 + k8, ce);
            if (t > 0) lds8(cum + (t - 1) * 64 + k8, cp); else { for (int e = 0; e < 8; ++e) cp[e] = 0.f; }
            float at[8], bt[8], kt[8], be[8], ke[8];
#pragma unroll
            for (int e = 0; e < 8; ++e) { const float ei = __expf(-ct[e]), ee = __expf(ce[e] - ct[e]); at[e] = a[e] * __expf(cp[e]); bt[e] = b[e] * ei; kt[e] = kh[e] * ei; be[e] = b[e] * ee; ke[e] = kh[e] * ee; }
            *(LAS u32x4*)(As + t * RC_LD + k8) = pk8(at); *(LAS u32x4*)(Bs + t * RC_LD + k8) = pk8(bt); *(LAS u32x4*)(Ks + t * RC_LD + k8) = pk8(kt);
            *(LAS u32x4*)(Ke + t * RC_LD + k8) = pk8(ke); *(LAS u32x4*)(Vs + t * RC_LD + k8) = pk8(v);
            const int tq = t & 31, g = (tq & 15) >> 2, j = (tq & 3) + ((tq >> 4) << 2);
#pragma unroll
            for (int e = 0; e < 8; ++e) { const int k = k8 + e; Fimg[(((k >> 4) * 2 + (t >> 5)) * 64 + g * 16 + (k & 15)) * 8 + j] = (bf16_t)f2bf(be[e]); }
            *(LAS u32x4*)(Ts + tid * 8) = (u32x4){0u, 0u, 0u, 0u}; if (tid < 64) *(LAS u32x4*)(Ts + (512 + tid) * 8) = (u32x4){0u, 0u, 0u, 0u};
            if (t == 63) { float gm[8]; for (int e = 0; e < 8; ++e) gm[e] = __expf(ce[e]); *(f32x4*)(WS_(p, RGc) + ub * 64 + k8) = (f32x4){gm[0], gm[1], gm[2], gm[3]}; *(f32x4*)(WS_(p, RGc) + ub * 64 + k8 + 4) = (f32x4){gm[4], gm[5], gm[6], gm[7]}; }
        }
        lds_barrier();
        {
            const int tb = w >> 1;
#pragma unroll
            for (int ii = 0; ii < 2; ++ii) { const int ib = 2 * (w & 1) + ii;
                f32x4 ab = {0.f, 0.f, 0.f, 0.f}, ak = {0.f, 0.f, 0.f, 0.f};
                if (ib <= tb) {
#pragma unroll
                    for (int ks = 0; ks < 2; ++ks) { const bf16x8 af = frag_rm(As, RC_LD, 16 * tb, 32 * ks, lane);
                        ab = MFMA16(af, frag_rm(Bs, RC_LD, 16 * ib, 32 * ks, lane), ab); ak = MFMA16(af, frag_rm(Ks, RC_LD, 16 * ib, 32 * ks, lane), ak); } }
#pragma unroll
                for (int r = 0; r < 4; ++r) { const int t = 16 * tb + 4 * fq + r, i = 16 * ib + fr; const bool keep = i < t;
                    Aab[t * 68 + i] = keep ? ab[r] : 0.f; Aabh[t * RC_LD + i] = (bf16_t)f2bf(keep ? ab[r] : 0.f); Aak[t * RC_LD + i] = (bf16_t)f2bf(keep ? ak[r] : 0.f); } }
            *(u32x4*)(WS_(p, RBf) + ub * 4096 + tid * 8) = *(const LAS u32x4*)(Fimg + tid * 8);
        }
        lds_barrier();
        if (w == 0) {
            const int blk = lane >> 4, jc = lane & 15;
            float Tc[16];
#pragma unroll
            for (int t = 0; t < 16; ++t) {
                float acc = jc == t ? 1.f : 0.f;
#pragma unroll
                for (int i4 = 0; i4 < (t + 3) / 4; ++i4) { const f32x4 a4 = *(const LAS f32x4*)(Aab + (16 * blk + t) * 68 + 16 * blk + i4 * 4);
#pragma unroll
                    for (int e = 0; e < 4; ++e) if (i4 * 4 + e < t) acc += a4[e] * Tc[i4 * 4 + e]; }
                Tc[t] = acc;
            }
#pragma unroll
            for (int t = 0; t < 16; ++t) Ts[(16 * blk + t) * RC_LD + 16 * blk + jc] = (bf16_t)f2bf(Tc[t]);
#pragma unroll
            for (int b = 1; b < 4; ++b) {
                const s16x4 dlo = *(const LAS s16x4*)(Ts + (16 * b + fr) * RC_LD + 16 * b + 4 * fq);
                bf16x8 dfr; dfr[0] = dlo[0]; dfr[1] = dlo[1]; dfr[2] = dlo[2]; dfr[3] = dlo[3]; dfr[4] = 0; dfr[5] = 0; dfr[6] = 0; dfr[7] = 0;
                f32x4 tt_[3];
#pragma unroll
                for (int cbk = 0; cbk < b; ++cbk) {
                    f32x4 x = {0.f, 0.f, 0.f, 0.f};
#pragma unroll
                    for (int ks = 0; ks < 2; ++ks) x = MFMA16(frag_rm(Aabh, RC_LD, 16 * b, 32 * ks, lane), frag_tr(Ts, RC_LD, 32 * ks, 16 * cbk, lane), x);
                    u32x4 xb; xb.x = pk2(x[0], x[1]); xb.y = pk2(x[2], x[3]); xb.z = 0u; xb.w = 0u;
                    tt_[cbk] = MFMA16(dfr, __builtin_bit_cast(bf16x8, xb), ((f32x4){0.f, 0.f, 0.f, 0.f}));
                }
#pragma unroll
                for (int cbk = 0; cbk < b; ++cbk)
#pragma unroll
                    for (int r = 0; r < 4; ++r) Ts[(16 * b + 4 * fq + r) * RC_LD + 16 * cbk + fr] = (bf16_t)f2bf(tt_[cbk][r]);
            }
        } else {
            for (int tl = w - 1; tl < 32; tl += 7) {
                const int rb = (tl & 15) >> 2, vbk = tl & 3; f32x4 acc = {0.f, 0.f, 0.f, 0.f};
                if (tl < 16) {
#pragma unroll
                    for (int ks = 0; ks < 2; ++ks) acc = MFMA16(frag_rm(Aak, RC_LD, 16 * rb, 32 * ks, lane), frag_tr(Vs, RC_LD, 32 * ks, 16 * vbk, lane), acc);
#pragma unroll
                    for (int r = 0; r < 4; ++r) X1[(16 * rb + 4 * fq + r) * RC_LD + 16 * vbk + fr] = (bf16_t)f2bf(acc[r]);
                } else {
#pragma unroll
                    for (int ks = 0; ks < 2; ++ks) acc = MFMA16(frag_tr(Ke, RC_LD, 32 * ks, 16 * rb, lane), frag_tr(Vs, RC_LD, 32 * ks, 16 * vbk, lane), acc);
                    { u32x2 o; o.x = pk2(acc[0], acc[1]); o.y = pk2(acc[2], acc[3]); *(u32x2*)(WS_(p, RNa) + (((ub * 4 + vbk) * 4 + rb) * 64 + lane) * 4) = o; }
                }
            }
        }
        lds_barrier();
#pragma unroll
        for (int q = 0; q < 4; ++q) { const int tl = w * 4 + q; const int tt = (tl & 15) >> 2, cbk = tl & 3; f32x4 acc = {0.f, 0.f, 0.f, 0.f};
            if (tl < 16) {
#pragma unroll
                for (int ks = 0; ks < 2; ++ks) acc = MFMA16(frag_rm(Ts, RC_LD, 16 * tt, 32 * ks, lane), frag_tr(As, RC_LD, 32 * ks, 16 * cbk, lane), acc);
                const int k = 16 * cbk + fr, kq = k & 31, g = (kq & 15) >> 2, j = (kq & 3) + ((kq >> 4) << 2);
#pragma unroll
                for (int r = 0; r < 4; ++r) Wimg[((tt * 2 + (k >> 5)) * 64 + g * 16 + 4 * fq + r) * 8 + j] = (bf16_t)f2bf(acc[r]);
            } else {
#pragma unroll
                for (int ks = 0; ks < 2; ++ks) acc = MFMA16(frag_rm(Ts, RC_LD, 16 * tt, 32 * ks, lane), frag_tr(X1, RC_LD, 32 * ks, 16 * cbk, lane), acc);
                { u32x2 o; o.x = pk2(acc[0], acc[1]); o.y = pk2(acc[2], acc[3]); *(u32x2*)(WS_(p, RUt) + (((ub * 4 + cbk) * 4 + tt) * 64 + lane) * 4) = o; }
            } }
        lds_barrier();
        *(u32x4*)(WS_(p, RWf) + ub * 4096 + tid * 8) = *(const LAS u32x4*)(Wimg + tid * 8);
    }
}

constexpr int RB_SLOT = 20992, RB_R = 6, RB_P = 5;
struct RbOpsA { bf16x8 wf[8]; u32x2 ut[4]; };
struct RbOpsB { bf16x8 bf[8]; u32x2 na[4]; f32x4 gc[4]; };
DEV void rb_read_a(const LAS unsigned char* slot, int lane, RbOpsA& O) {
#pragma unroll
    for (int f = 0; f < 8; ++f) O.wf[f] = *(const LAS bf16x8*)(slot + (f * 64 + lane) * 16);
#pragma unroll
    for (int q = 0; q < 4; ++q) O.ut[q] = *(const LAS u32x2*)(slot + 16384 + (q * 64 + lane) * 8);
}
DEV void rb_read_b(const LAS unsigned char* slot, int lane, RbOpsB& O) {
    const int fq = lane >> 4;
#pragma unroll
    for (int f = 0; f < 8; ++f) O.bf[f] = *(const LAS bf16x8*)(slot + 8192 + (f * 64 + lane) * 16);
#pragma unroll
    for (int q = 0; q < 4; ++q) { O.na[q] = *(const LAS u32x2*)(slot + 18432 + (q * 64 + lane) * 8); O.gc[q] = *(const LAS f32x4*)(slot + 20480 + (16 * q + 4 * fq) * 4); }
}
DEV void phase_rw_chb(const Params& p, int layer, LAS unsigned char* lds) {
    const int tid = tid_(), bid = bid_();
    if (bid >= 64) {
        if (layer == 0) { int tb = convert_jobs<8, 12>(p, lds, 64, NB_ - 64);
#pragma unroll 1
            for (int ml = 0; ml < 2; ++ml) { const ConvJob J0 = moe_job(p, 0, ml), J1 = moe_job(p, 1, ml); convert_one(J0, lds, 64, NB_ - 64, tb); tb += J0.ntiles(); convert_one(J1, lds, 64, NB_ - 64, tb); tb += J1.ntiles(); } }
        else { const ConvJob J0 = moe_job(p, 0, layer), J1 = moe_job(p, 1, layer); convert_one(J0, lds, 64, NB_ - 64, 0, 2); convert_one(J1, lds, 64, NB_ - 64, J0.ntiles(), 2); }
        return; }
    const int lane = tid & 63, w = __builtin_amdgcn_readfirstlane(tid >> 6); const int head = bid & 15, vb = bid >> 4;
    auto issue = [&](int c) {
        const size_t ub = (size_t)c * 16 + head; LAS unsigned char* slot = lds + (c % RB_R) * RB_SLOT;
#pragma unroll
        for (int i = 0; i < 3; ++i) { const int pi = (w - 1) * 3 + i;
            if (pi < 8) __builtin_amdgcn_global_load_lds((const unsigned*)(WS_(p, RWf) + ub * 4096 + pi * 512 + lane * 8), (LAS unsigned*)(slot + pi * 1024), 16, 0, 0);
            else if (pi < 16) __builtin_amdgcn_global_load_lds((const unsigned*)(WS_(p, RBf) + ub * 4096 + (pi - 8) * 512 + lane * 8), (LAS unsigned*)(slot + 8192 + (pi - 8) * 1024), 16, 0, 0);
            else if (pi < 18) __builtin_amdgcn_global_load_lds((const unsigned*)(WS_(p, RUt) + (ub * 4 + vb) * 1024 + (pi - 16) * 512 + lane * 8), (LAS unsigned*)(slot + 16384 + (pi - 16) * 1024), 16, 0, 0);
            else if (pi < 20) __builtin_amdgcn_global_load_lds((const unsigned*)(WS_(p, RNa) + (ub * 4 + vb) * 1024 + (pi - 18) * 512 + lane * 8), (LAS unsigned*)(slot + 18432 + (pi - 18) * 1024), 16, 0, 0);
            else __builtin_amdgcn_global_load_lds((const unsigned*)(WS_(p, RGc) + ub * 64 + lane), (LAS unsigned*)(slot + 20480), 4, 0, 0);
        }
    };
    if (w > 0) {
#pragma unroll 1
        for (int c = 0; c < RB_P; ++c) issue(c);
        asm volatile("s_waitcnt vmcnt(9)" ::: "memory");
    }
    __builtin_amdgcn_s_barrier();
    f32x4 s[4]; for (int i = 0; i < 4; ++i) s[i] = (f32x4){0.f, 0.f, 0.f, 0.f};
    RbOpsA cur, nxt; RbOpsB cb_;
    if (w == 0) { rb_read_a(lds, lane, cur); }
#pragma unroll 1
    for (int c = 0; c < 256; ++c) {
        if (w > 0) {
            if (c + RB_P < 256) { issue(c + RB_P); asm volatile("s_waitcnt vmcnt(9)" ::: "memory"); }
            else asm volatile("s_waitcnt vmcnt(0)" ::: "memory");
        } else {
            const size_t ub = (size_t)c * 16 + head;
            rb_read_b(lds + (c % RB_R) * RB_SLOT, lane, cb_);
            rb_read_a(lds + ((c + 1 < 256 ? c + 1 : c) % RB_R) * RB_SLOT, lane, nxt);
            bf16x8 sb[2];
#pragma unroll
            for (int ks = 0; ks < 2; ++ks) { u32x4 o; o.x = pk2(s[2 * ks][0], s[2 * ks][1]); o.y = pk2(s[2 * ks][2], s[2 * ks][3]); o.z = pk2(s[2 * ks + 1][0], s[2 * ks + 1][1]); o.w = pk2(s[2 * ks + 1][2], s[2 * ks + 1][3]); sb[ks] = __builtin_bit_cast(bf16x8, o); *(u32x4*)(WS_(p, RS0) + (((ub * 4 + vb) * 2 + ks) * 64 + lane) * 8) = o; }
            f32x4 uu[4];
#pragma unroll
            for (int tt = 0; tt < 4; ++tt) { uu[tt] = (f32x4){bflo(cur.ut[tt].x), bfhi(cur.ut[tt].x), bflo(cur.ut[tt].y), bfhi(cur.ut[tt].y)}; uu[tt] = MFMA16(cur.wf[tt * 2], sb[0], uu[tt]); uu[tt] = MFMA16(cur.wf[tt * 2 + 1], sb[1], uu[tt]); }
            bf16x8 ubf[2];
#pragma unroll
            for (int ks = 0; ks < 2; ++ks) { u32x4 o; o.x = pk2(uu[2 * ks][0], uu[2 * ks][1]); o.y = pk2(uu[2 * ks][2], uu[2 * ks][3]); o.z = pk2(uu[2 * ks + 1][0], uu[2 * ks + 1][1]); o.w = pk2(uu[2 * ks + 1][2], uu[2 * ks + 1][3]); ubf[ks] = __builtin_bit_cast(bf16x8, o); *(u32x4*)(WS_(p, RUa) + (((ub * 4 + vb) * 2 + ks) * 64 + lane) * 8) = o; }
#pragma unroll
            for (int kt = 0; kt < 4; ++kt) { s[kt] = s[kt] * cb_.gc[kt] + (f32x4){bflo(cb_.na[kt].x), bfhi(cb_.na[kt].x), bflo(cb_.na[kt].y), bfhi(cb_.na[kt].y)}; s[kt] = MFMA16(cb_.bf[kt * 2], ubf[0], s[kt]); s[kt] = MFMA16(cb_.bf[kt * 2 + 1], ubf[1], s[kt]); }
            cur = nxt;
            asm volatile("s_waitcnt lgkmcnt(0)" ::: "memory");
        }
        __builtin_amdgcn_s_barrier();
    }
    asm volatile("s_waitcnt vmcnt(0)" ::: "memory");
}

DEV void phase_rw_chc(const Params& p, int j, LAS unsigned char* lds) {
    const int tid = tid_(), bid = bid_(); const int lane = tid & 63, w = tid >> 6; const int fr = lane & 15, fq = lane >> 4;
    LAS float* cum = (LAS float*)lds;
    LAS float* seg = cum + 64 * 64;
    LAS float* Ys = seg + 8 * 64;
    LAS bf16_t* Rs = (LAS bf16_t*)(Ys + 64 * 68);
    LAS bf16_t* Bs = Rs + 64 * RC_LD; LAS bf16_t* Ks = Bs + 64 * RC_LD; LAS bf16_t* Vs = Ks + 64 * RC_LD; LAS bf16_t* Arb = Vs + 64 * RC_LD; LAS bf16_t* Ark = Arb + 64 * RC_LD;
    float pwd[8], pr[8], pkr[8], pal[8], pv[8], pg[8];
    float kkw[8], kaw[8], rkw[8], lgw[8], lbw[8];
    { const size_t po = (size_t)j * D + (bid & 15) * 64 + (tid & 7) * 8; ld8(p.rw_k_k + po, kkw); ld8(p.rw_k_a + po, kaw); ld8(p.rw_r_k + po, rkw); ld8(p.rw_lnx_g + po, lgw); ld8(p.rw_lnx_b + po, lbw); }
    { const int c = bid >> 4, h = bid & 15; rc_load_wd(p, c * 64, h * 64, pwd);
      const size_t go = (size_t)(c * 64 + (tid >> 3)) * D + h * 64 + (tid & 7) * 8; ld8b(WS_(p, Rb) + go, pr); ld8b(WS_(p, Kb) + go, pkr); ld8b(WS_(p, Ab) + go, pal); ld8b(WS_(p, Vb) + go, pv); ld8b(WS_(p, Gb) + go, pg); }
    for (int u = bid; u < 4096; u += NB_) {
        const int c = u >> 4, h = u & 15; const int t0 = c * 64, cb = h * 64; const size_t ub = (size_t)c * 16 + h;
        const int tt = w & 3;
        bf16x8 ufr[2][2], sfr[2][2];
#pragma unroll
        for (int q = 0; q < 2; ++q)
#pragma unroll
            for (int ks = 0; ks < 2; ++ks) { const size_t o = (((ub * 4 + 2 * (w >> 2) + q) * 2 + ks) * 64 + lane) * 8;
                ufr[q][ks] = *(const bf16x8*)(WS_(p, RUa) + o); sfr[q][ks] = *(const bf16x8*)(WS_(p, RS0) + o); }
        lds_barrier();
        rc_cum_regs(pwd, cum, seg);
#ifdef DBL_CUM
        rc_cum_regs(pwd, cum, seg);
#endif
        const int t = tid >> 3, k8 = (tid & 7) * 8; const size_t go = (size_t)(t0 + t) * D + cb + k8;
        float v[8], gg[8]; float bc;
        {   float r[8], a[8], b[8], kh[8], ct[8];
#pragma unroll
            for (int e = 0; e < 8; ++e) { r[e] = pr[e]; v[e] = pv[e]; gg[e] = pg[e]; }
            lds8(cum + t * 64 + k8, ct);
            rc_prep8(pkr, pal, kkw, kaw, a, b, kh);
            if (u + NB_ < 4096) { const int un = u + NB_; const int cn = un >> 4, hn = un & 15; rc_load_wd(p, cn * 64, hn * 64, pwd);
                const size_t gn = (size_t)(cn * 64 + t) * D + hn * 64 + k8; ld8b(WS_(p, Rb) + gn, pr); ld8b(WS_(p, Kb) + gn, pkr); ld8b(WS_(p, Ab) + gn, pal); ld8b(WS_(p, Vb) + gn, pv); ld8b(WS_(p, Gb) + gn, pg); }
            bc = 0.f;
#pragma unroll
            for (int e = 0; e < 8; ++e) bc += r[e] * kh[e] * rkw[e];
            bc += __shfl_xor(bc, 1); bc += __shfl_xor(bc, 2); bc += __shfl_xor(bc, 4);
#pragma unroll
            for (int e = 0; e < 8; ++e) { const float ei = __expf(-ct[e]); r[e] *= __expf(ct[e]); b[e] *= ei; kh[e] *= ei; }
            *(LAS u32x4*)(Rs + t * RC_LD + k8) = pk8(r); *(LAS u32x4*)(Bs + t * RC_LD + k8) = pk8(b); *(LAS u32x4*)(Ks + t * RC_LD + k8) = pk8(kh); *(LAS u32x4*)(Vs + t * RC_LD + k8) = pk8(v);
        }
        lds_barrier();
#ifdef DBL_S3
#pragma unroll 1
        for (int rep_ = 0; rep_ < 2; ++rep_)
#endif
        {   const int tb = w >> 1;
#pragma unroll
            for (int ii = 0; ii < 2; ++ii) { const int ib = 2 * (w & 1) + ii;
                f32x4 ab = {0.f, 0.f, 0.f, 0.f}, ak = {0.f, 0.f, 0.f, 0.f};
                if (ib <= tb) {
#pragma unroll
                    for (int ks = 0; ks < 2; ++ks) { const bf16x8 af = frag_rm(Rs, RC_LD, 16 * tb, 32 * ks, lane);
                        ab = MFMA16(af, frag_rm(Bs, RC_LD, 16 * ib, 32 * ks, lane), ab); ak = MFMA16(af, frag_rm(Ks, RC_LD, 16 * ib, 32 * ks, lane), ak); } }
#pragma unroll
                for (int r = 0; r < 4; ++r) { const int tr = 16 * tb + 4 * fq + r, i = 16 * ib + fr; const bool keep = i <= tr;
                    Arb[tr * RC_LD + i] = (bf16_t)f2bf(keep ? ab[r] : 0.f); Ark[tr * RC_LD + i] = (bf16_t)f2bf(keep ? ak[r] : 0.f); } }
        }
        lds_barrier();
#ifdef DBL_Y
#pragma unroll 1
        for (int rep_ = 0; rep_ < 2; ++rep_)
#endif
#pragma unroll
        for (int q = 0; q < 2; ++q) { const int vbk = 2 * (w >> 2) + q; f32x4 acc = {0.f, 0.f, 0.f, 0.f};
#pragma unroll
            for (int ks = 0; ks < 2; ++ks) {
                acc = MFMA16(frag_rm_pi(Rs, RC_LD, 16 * tt, 32 * ks, lane), sfr[q][ks], acc);
                acc = MFMA16(frag_rm_pi(Arb, RC_LD, 16 * tt, 32 * ks, lane), ufr[q][ks], acc);
                acc = MFMA16(frag_rm(Ark, RC_LD, 16 * tt, 32 * ks, lane), frag_tr(Vs, RC_LD, 32 * ks, 16 * vbk, lane), acc); }
#pragma unroll
            for (int r = 0; r < 4; ++r) Ys[(16 * tt + 4 * fq + r) * 68 + 16 * vbk + fr] = acc[r]; }
        lds_barrier();
        {
            float y[8]; lds8(Ys + t * 68 + k8, y);
            float s1 = 0.f, s2 = 0.f;
#pragma unroll
            for (int e = 0; e < 8; ++e) { s1 += y[e]; s2 += y[e] * y[e]; }
            s1 += __shfl_xor(s1, 1); s1 += __shfl_xor(s1, 2); s1 += __shfl_xor(s1, 4); s2 += __shfl_xor(s2, 1); s2 += __shfl_xor(s2, 2); s2 += __shfl_xor(s2, 4);
            const float mean = s1 * (1.0f / 64.0f), var = s2 * (1.0f / 64.0f) - mean * mean; const float rs = rsqrtf(fmaxf(var, 0.f) + 64e-5f);
            float o[8];
#pragma unroll
            for (int e = 0; e < 8; ++e) o[e] = ((y[e] - mean) * rs * lgw[e] + lbw[e] + bc * v[e]) * gg[e];
            *(u32x4*)(WS_(p, YB) + go) = pk8(o);
        }
    }
}
DEV void phase_ln1(const Params& p, int layer, LAS unsigned char* lds) {
    const int tid = tid_(), bid = bid_(); (void)tid; (void)bid;
    const int lane = tid & 63, wid = tid >> 6; const int fr = lane & 15, fq = lane >> 4;
    LAS float* lgt = (LAS float*)lds;
    LAS int* cnt = (LAS int*)(lgt + 2 * 64 * 48);
    if (tid < 32) cnt[tid] = 0;
    const float* g = p.ln_g + ((size_t)layer * 2 + 0) * D; const float* be = p.ln_b + ((size_t)layer * 2 + 0) * D;
    const float* br = p.moe_b_route + layer * 32; const float* bg = p.moe_b_group + layer * 4;
    f32x4 gwv[4], bwv[4];
#pragma unroll
    for (int q = 0; q < 4; ++q) { gwv[q] = *(const f32x4*)(g + RCOL(q, lane)); bwv[q] = *(const f32x4*)(be + RCOL(q, lane)); }
    u32x2 rh[4], rm[4];
#pragma unroll
    for (int q = 0; q < 4; ++q) { rh[q] = *(const u32x2*)(WS_(p, Hb) + (size_t)(bid * 64 + wid * 8) * D + RCOL(q, lane)); rm[q] = *(const u32x2*)(WS_(p, MIXb) + (size_t)(bid * 64 + wid * 8) * D + RCOL(q, lane)); }
#pragma unroll 1
    for (int rr = 0; rr < 8; ++rr) {
        const int t = bid * 64 + wid * 8 + rr; const size_t ro = (size_t)t * D;
        f32x4 z[4], m[4];
#pragma unroll
        for (int q = 0; q < 4; ++q) { z[q] = (f32x4){bflo(rh[q].x), bfhi(rh[q].x), bflo(rh[q].y), bfhi(rh[q].y)}; m[q] = (f32x4){bflo(rm[q].x), bfhi(rm[q].x), bflo(rm[q].y), bfhi(rm[q].y)}; }
        { const size_t rn = (size_t)(rr < 7 ? t + 1 : t) * D;
#pragma unroll
          for (int q = 0; q < 4; ++q) { rh[q] = *(const u32x2*)(WS_(p, Hb) + rn + RCOL(q, lane)); rm[q] = *(const u32x2*)(WS_(p, MIXb) + rn + RCOL(q, lane)); } }
        float s = 0.f;
#pragma unroll
        for (int q = 0; q < 4; ++q) { z[q] = z[q] * ALPHA + m[q]; s += z[q][0] + z[q][1] + z[q][2] + z[q][3]; }
        const float mean = wave_sum(s) * (1.0f / D);
        float vs = 0.f;
#pragma unroll
        for (int q = 0; q < 4; ++q) { z[q] = z[q] - mean; vs += z[q][0] * z[q][0] + z[q][1] * z[q][1] + z[q][2] * z[q][2] + z[q][3] * z[q][3]; }
        const float rs = rsqrtf(wave_sum(vs) * (1.0f / D) + LN_EPS);
#pragma unroll
        for (int q = 0; q < 4; ++q) {
            st_bf4(WS_(p, H1b) + ro + RCOL(q, lane), z[q] * rs * gwv[q] + bwv[q]);
        }
    }
    asm volatile("s_waitcnt vmcnt(0)" ::: "memory");
    __syncthreads();
    {   const int rt = wid & 3, kh = wid >> 2;
        const bf16_t* Ab = WS_(p, H1b) + (size_t)(bid * 64 + 16 * rt + fr) * D + 512 * kh + 8 * fq;
        const bf16_t* Wb = WS_(p, moe_wr_t) + (size_t)layer * 48 * D + (size_t)fr * D + 512 * kh + 8 * fq;
        f32x4 acc[3]; for (int i = 0; i < 3; ++i) acc[i] = (f32x4){0.f, 0.f, 0.f, 0.f};
#pragma unroll 8
        for (int ks = 0; ks < 16; ++ks) {
            const bf16x8 af = *(const bf16x8*)(Ab + 32 * ks);
#pragma unroll
            for (int ct = 0; ct < 3; ++ct) acc[ct] = MFMA16(af, *(const bf16x8*)(Wb + (size_t)16 * ct * D + 32 * ks), acc[ct]);
        }
#pragma unroll
        for (int ct = 0; ct < 3; ++ct)
#pragma unroll
            for (int r = 0; r < 4; ++r) lgt[(kh * 64 + 16 * rt + 4 * fq + r) * 48 + 16 * ct + fr] = acc[ct][r];
    }
    __syncthreads();
    if (tid < 64) {
        const int t = bid * 64 + tid; const LAS float* L0 = lgt + tid * 48; const LAS float* L1 = lgt + (64 + tid) * 48;
        const float q0 = L0[32] + L1[32] + bg[0], q1 = L0[33] + L1[33] + bg[1], q2 = L0[34] + L1[34] + bg[2], q3 = L0[35] + L1[35] + bg[3];
        int gi = 0; float gm = q0;
        if (q1 > gm) { gm = q1; gi = 1; } if (q2 > gm) { gm = q2; gi = 2; } if (q3 > gm) { gm = q3; gi = 3; }
        const float den = __expf(q0 - gm) + __expf(q1 - gm) + __expf(q2 - gm) + __expf(q3 - gm);
        const float pgrp = __builtin_amdgcn_rcpf(den);
        float l1 = -INFINITY, l2 = -INFINITY; int i1 = 0, i2 = 0;
#pragma unroll 1
        for (int o = 0; o < 8; ++o) { const float v = L0[gi * 8 + o] + L1[gi * 8 + o] + br[gi * 8 + o];
            if (v > l1) { l2 = l1; i2 = i1; l1 = v; i1 = o; } else if (v > l2) { l2 = v; i2 = o; } }
        const float e2 = __expf(l2 - l1), inv = __builtin_amdgcn_rcpf(1.0f + e2);
        const int e0 = gi * 8 + i1, e1 = gi * 8 + i2;
        WS_(p, EIDX)[2 * t] = e0; WS_(p, EIDX)[2 * t + 1] = e1; WS_(p, GATE)[2 * t] = pgrp * inv; WS_(p, GATE)[2 * t + 1] = pgrp * e2 * inv;
        atomicAdd((int*)&cnt[e0], 1); atomicAdd((int*)&cnt[e1], 1);
    }
    __syncthreads();
    if (tid < 32) WS_(p, CNT)[bid * 32 + tid] = cnt[tid];
}

DEV void phase_moe_scatter(const Params& p, LAS unsigned char* lds) {
    const int tid = tid_(), bid = bid_(); (void)tid; (void)bid;
    const int lane = tid & 63, wid = tid >> 6;
    LAS int* part = (LAS int*)lds;
    LAS int* pre = part + 512;
    LAS int* base = pre + 512;
    LAS int* pst = base + 32;
    LAS int* dst = pst + 40;
    LAS int* eid = dst + 128;
    { const int e = tid & 31, part_i = tid >> 5; int tot = 0, prf = 0;
      for (int b = part_i * 16; b < part_i * 16 + 16; ++b) { const int c = WS_(p, CNT)[b * 32 + e]; tot += c; if (b < (int)bid) prf += c; }
      part[part_i * 32 + e] = tot; pre[part_i * 32 + e] = prf; }
    if (tid < 128) eid[tid] = WS_(p, EIDX)[bid * 128 + tid];
    if (bid == 1 && tid < MFLAG_TICKET + 32) __hip_atomic_store(WS_(p, MFLAG) + tid * MFLAG_STRIDE, 0u, __ATOMIC_RELAXED, __HIP_MEMORY_SCOPE_AGENT);
    lds_barrier();
    if (tid < 32) { int tot = 0, prf = 0; for (int i = 0; i < 16; ++i) { tot += part[i * 32 + tid]; prf += pre[i * 32 + tid]; } part[tid] = tot; pre[tid] = prf; }
    lds_barrier();
    if (tid == 0) { int acc = 0; for (int e = 0; e < 32; ++e) { pst[e] = acc; acc += ((part[e] + 255) >> 8) << 8; } pst[32] = acc;
        if (bid == 0) { for (int e = 0; e <= 32; ++e) WS_(p, TAB)[e] = pst[e]; WS_(p, TAB)[33] = acc >> 8;
            for (int e = 0; e < 32; ++e) for (int mt = pst[e] >> 8; mt < (pst[e + 1] >> 8); ++mt) WS_(p, TAB)[64 + mt] = e; } }
    lds_barrier();
    if (tid < 32) { int run = pst[tid] + pre[tid];
#pragma unroll 16
        for (int a = 0; a < 128; ++a) if (eid[a] == tid) dst[a] = run++; }
    lds_barrier();
    if (tid < 128) WS_(p, DEST)[bid * 128 + tid] = dst[tid];
#pragma unroll 4
    for (int a = wid * 16; a < wid * 16 + 16; ++a) {
        const int t = bid * 64 + (a >> 1); const int d = dst[a];
        const u32x4 v0 = *(const u32x4*)(WS_(p, H1b) + (size_t)t * D + lane * 8), v1 = *(const u32x4*)(WS_(p, H1b) + (size_t)t * D + 512 + lane * 8);
        *(u32x4*)(WS_(p, BUF) + (size_t)d * D + lane * 8) = v0; *(u32x4*)(WS_(p, BUF) + (size_t)d * D + 512 + lane * 8) = v1;
    }
}

template <int which> struct SchedMoe {
    const Params* p; int layer; const LAS int* tab;
    DEV bool next(int i, Unit& u) const {
        const int nmt = tab[33]; int pm, pn; if (!pg8::tile_order(i, NB_, which == 0 ? bid_() : ((bid_() + 128) & 255), nmt, 4, pm, pn)) return false;
        const int row0 = pm * 256; const int e = tab[64 + pm];
        if constexpr (which == 0) { u.A = (const char*)(WS_(*p, BUF) + (size_t)row0 * D); u.B = (const char*)(WS_(*p, moe_w1_t) + ((size_t)layer * 32 + e) * 1024 * 1024 + (size_t)pn * 256 * 1024); }
        else {
            if (tid_() == 0) { unsigned* f = WS_(*p, MFLAG) + pm * MFLAG_STRIDE; unsigned sp = 0;
                while (__hip_atomic_load(f, __ATOMIC_RELAXED, __HIP_MEMORY_SCOPE_AGENT) < 4u) { __builtin_amdgcn_s_sleep(1); if (++sp > (1u << 24)) break; }
                __builtin_amdgcn_fence(__ATOMIC_ACQUIRE, "agent");
                asm volatile("s_waitcnt vmcnt(0)" ::: "memory"); }
            __builtin_amdgcn_s_barrier();
            u.A = (const char*)(WS_(*p, ACT) + (size_t)row0 * 512); u.B = (const char*)(WS_(*p, moe_w2_t) + ((size_t)layer * 32 + e) * 1024 * 512 + (size_t)pn * 256 * 512); }
        u.row0 = row0; u.col0 = pn * 256; u.id = e; u.aux = 0; return true;
    }
};
struct EpiMoe1 {
    bf16_t* O; unsigned* flag;
    DEV void operator()(const AccT& acc, const Unit& u, int wr, int wc, int fr, int fq) const {
        const __amdgpu_buffer_rsrc_t rs = __builtin_amdgcn_make_buffer_rsrc(O, 0, MOE_ROWS * 512 * 2, 0x00020000);
#pragma unroll
        for (int ai = 0; ai < 2; ++ai)
#pragma unroll
            for (int m = 0; m < 4; ++m) {
                f32x4 v[2];
#pragma unroll
                for (int n = 0; n < 2; ++n) { const f32x4 gt = acc[ai][0][m][n], up = acc[ai][1][m][n]; for (int e = 0; e < 4; ++e) v[n][e] = siluf_(gt[e]) * up[e]; }
                const int col = (u.col0 >> 1) + 32 * wc + (PF(6) ? 8 * fq : 4 * fq);
                if (PF(6)) __builtin_amdgcn_raw_buffer_store_b128(pk8v(v[0], v[1]), rs, (unsigned)((ACC_ROW(u, ai, m) * 512 + col) * 2), 0, 16);
                else { const u32x4 w = pk8v(v[0], v[1]); unsigned long long* q = (unsigned long long*)(O + (size_t)ACC_ROW(u, ai, m) * 512 + col);
                  __hip_atomic_store(q, (unsigned long long)w.x | ((unsigned long long)w.y << 32), __ATOMIC_RELAXED, __HIP_MEMORY_SCOPE_AGENT);
                  __hip_atomic_store(q + 4, (unsigned long long)w.z | ((unsigned long long)w.w << 32), __ATOMIC_RELAXED, __HIP_MEMORY_SCOPE_AGENT); }
                ACC_FENCE;
            }
        asm volatile("s_waitcnt vmcnt(0)" ::: "memory");
        __builtin_amdgcn_s_barrier();
        if (wr == 1 && wc == 0 && fr == 0 && fq == 0) __hip_atomic_fetch_add(flag + (u.row0 >> 8) * MFLAG_STRIDE, 1u, __ATOMIC_RELAXED, __HIP_MEMORY_SCOPE_AGENT);
    }
};
struct EpiMoe2 {
    bf16_t* O;
    DEV void operator()(const AccT& acc, const Unit& u, int wr, int wc, int fr, int fq) const {
        FOR_ACC2(ai, bj, m) { st_bf8p(O + (size_t)ACC_ROW(u, ai, m) * D + ACC_COL8P(u, bj, PF(7)), acc[ai][bj][m][0], acc[ai][bj][m][1], PF(7)); ACC_FENCE; }
    }
};

struct Ln2Raw { u32x2 h[4], a[4], b[4]; float g0, g1; };
DEV void ln2_issue(const Params& p, int t, int lane, Ln2Raw& R, int dpre, float gpre, int tbase) {
    const int i0 = 2 * (t - tbase); const int d0 = __shfl(dpre, i0), d1 = __shfl(dpre, i0 + 1); R.g0 = __shfl(gpre, i0); R.g1 = __shfl(gpre, i0 + 1);
#pragma unroll
    for (int q = 0; q < 4; ++q) { R.h[q] = *(const u32x2*)(WS_(p, H1b) + (size_t)t * D + RCOL(q, lane));
        R.a[q] = *(const u32x2*)(WS_(p, YBUF) + (size_t)d0 * D + RCOL(q, lane)); R.b[q] = *(const u32x2*)(WS_(p, YBUF) + (size_t)d1 * D + RCOL(q, lane)); }
}
DEV void ln2_finish(const Ln2Raw& R, const f32x4 (&gwv)[4], const f32x4 (&bwv)[4], f32x4 (&z)[4]) {
    float s = 0.f; const float g0 = R.g0, g1 = R.g1;
#pragma unroll
    for (int q = 0; q < 4; ++q) {
        z[q][0] = bflo(R.h[q].x) * ALPHA + g0 * bflo(R.a[q].x) + g1 * bflo(R.b[q].x); z[q][1] = bfhi(R.h[q].x) * ALPHA + g0 * bfhi(R.a[q].x) + g1 * bfhi(R.b[q].x);
        z[q][2] = bflo(R.h[q].y) * ALPHA + g0 * bflo(R.a[q].y) + g1 * bflo(R.b[q].y); z[q][3] = bfhi(R.h[q].y) * ALPHA + g0 * bfhi(R.a[q].y) + g1 * bfhi(R.b[q].y);
        s += z[q][0] + z[q][1] + z[q][2] + z[q][3];
    }
    const float mean = wave_sum(s) * (1.0f / D);
    float vs = 0.f;
#pragma unroll
    for (int q = 0; q < 4; ++q) { z[q] = z[q] - mean; vs += z[q][0] * z[q][0] + z[q][1] * z[q][1] + z[q][2] * z[q][2] + z[q][3] * z[q][3]; }
    const float rs = rsqrtf(wave_sum(vs) * (1.0f / D) + LN_EPS);
#pragma unroll
    for (int q = 0; q < 4; ++q) z[q] = z[q] * rs * gwv[q] + bwv[q];
}
DEV void phase_ln2(const Params& p, int layer, LAS unsigned char* lds) {
    const int tid = tid_(), bid = bid_(); const int lane = tid & 63, wid = tid >> 6; const int fr = lane & 15, fq = lane >> 4;
    const float* g = p.ln_g + ((size_t)layer * 2 + 1) * D; const float* be = p.ln_b + ((size_t)layer * 2 + 1) * D;
    const int nk = layer == DEPTH - 1 ? 3 : (layer + 1) % 3;
    const int nj = (layer + 1) / 3;
    LAS float* lgt = (LAS float*)lds;
    LAS float* w2 = lgt + 2 * 64 * 32;
    if (nk == 2) { for (int i = tid; i < 16 * 512; i += NTHR) w2[i] = p.gl_gk_w2[(size_t)nj * 16 * 512 + i]; }
    const int tfirst = bid * 64 + wid * 8;
    f32x4 z[4], zp[4], gwv[4], bwv[4];
#pragma unroll
    for (int q = 0; q < 4; ++q) { gwv[q] = *(const f32x4*)(g + RCOL(q, lane)); bwv[q] = *(const f32x4*)(be + RCOL(q, lane)); }
    Ln2Raw R[3];
    const int tbase = tfirst > 0 ? tfirst - 1 : 0;
    const int dpre = lane < 18 ? WS_(p, DEST)[2 * tbase + lane] : 0; const float gpre = lane < 18 ? WS_(p, GATE)[2 * tbase + lane] : 0.f;
    if (nk == 0) { if (tfirst > 0) { ln2_issue(p, tfirst - 1, lane, R[2], dpre, gpre, tbase); } }
    ln2_issue(p, tfirst, lane, R[0], dpre, gpre, tbase);
    ln2_issue(p, tfirst + 1, lane, R[1], dpre, gpre, tbase);
    if (nk == 0) { if (tfirst > 0) ln2_finish(R[2], gwv, bwv, zp); else { for (int q = 0; q < 4; ++q) zp[q] = (f32x4){0.f, 0.f, 0.f, 0.f}; } }
#pragma unroll
    for (int rr = 0; rr < 8; ++rr) {
        const int t = tfirst + rr; const size_t ro = (size_t)t * D;
        if (rr + 2 < 8) ln2_issue(p, t + 2, lane, R[(rr + 2) % 3], dpre, gpre, tbase);
        ln2_finish(R[rr % 3], gwv, bwv, z);
        if (nk == 3) {
#pragma unroll
            for (int q = 0; q < 4; ++q) *(f32x4*)(p.out + ro + RCOL(q, lane)) = z[q];
        } else store_row_bf(WS_(p, Hb) + ro, lane, z);
        if (nk == 0) {
            emit_mix6(p, nj, t, lane, z, zp);
#pragma unroll
            for (int q = 0; q < 4; ++q) zp[q] = z[q];
        }
    }
    if (nk == 1 || nk == 2) {
        asm volatile("s_waitcnt vmcnt(0)" ::: "memory");
        __syncthreads();
        const int nct = nk == 1 ? 2 : 1; const int rt = wid & 3, kh = wid >> 2;
        const bf16_t* Ab = WS_(p, Hb) + (size_t)(bid * 64 + 16 * rt + fr) * D + 512 * kh + 8 * fq;
        const bf16_t* Wb = (nk == 1 ? WS_(p, mb_dt_t) : WS_(p, gl_lr_t)) + (size_t)fr * D + 512 * kh + 8 * fq;
        f32x4 acc[2]; acc[0] = (f32x4){0.f, 0.f, 0.f, 0.f}; acc[1] = acc[0];
#pragma unroll 4
        for (int ks = 0; ks < 16; ++ks) {
            const bf16x8 af = *(const bf16x8*)(Ab + 32 * ks);
            acc[0] = MFMA16(af, *(const bf16x8*)(Wb + 32 * ks), acc[0]);
            if (nct == 2) acc[1] = MFMA16(af, *(const bf16x8*)(Wb + (size_t)16 * D + 32 * ks), acc[1]);
        }
#pragma unroll
        for (int ct = 0; ct < 2; ++ct)
#pragma unroll
            for (int r = 0; r < 4; ++r) lgt[(kh * 64 + 16 * rt + 4 * fq + r) * 32 + 16 * ct + fr] = acc[ct][r];
        __syncthreads();
        if (nk == 1) {
#pragma unroll
            for (int i = 0; i < 4; ++i) { const int idx = tid + i * NTHR; const int row = idx >> 5, o = idx & 31;
                WS_(p, DT)[(size_t)(bid * 64 + row) * 32 + o] = softplusf_(lgt[row * 32 + o] + lgt[(64 + row) * 32 + o] + p.mb_dt_bias[nj * 32 + o]); }
        } else {
            const int row = tid >> 3, c0 = (tid & 7) * 64; float lr[16];
#pragma unroll
            for (int o = 0; o < 16; ++o) lr[o] = lgt[row * 32 + o] + lgt[(64 + row) * 32 + o];
#pragma unroll 1
            for (int c4 = 0; c4 < 16; ++c4) { const int c = c0 + 4 * c4; f32x4 a = *(const f32x4*)(p.gl_gk_b + nj * 512 + c);
#pragma unroll
                for (int o = 0; o < 16; ++o) { const f32x4 wv = *(const LAS f32x4*)(w2 + o * 512 + c); a = a + wv * lr[o]; }
                f32x4 r;
#pragma unroll
                for (int e = 0; e < 4; ++e) r[e] = (fminf(a[e], 0.f) - __logf(1.0f + __expf(-fabsf(a[e])))) * (1.0f / 16.0f);
                *(f32x4*)(WS_(p, LA) + (size_t)(bid * 64 + row) * 512 + c) = r; }
        }
    }
}
constexpr int MB_PROJ = 5152;
struct SchedMbIn {
    const Params* p;
    DEV bool next(int i, Unit& u) const {
        int pm, pn; if (!pg8::tile_order(i, NB_, bid_(), 64, 20, pm, pn)) return false;
        u.A = (const char*)(WS_(*p, Hb) + (size_t)pm * 256 * D); u.B = (const char*)(WS_(*p, mb_win_t) + (size_t)pn * 256 * D); u.row0 = pm * 256; u.col0 = pn * 256; u.id = 0; u.aux = 0; return true;
    }
};
struct EpiMbIn {
    const Params* p;
    DEV void operator()(const AccT& acc, const Unit& u, int wr, int wc, int fr, int fq) const {
        const bool isz = u.col0 < 2048; bf16_t* O = WS_(*p, Z) + (isz ? (size_t)0 : (size_t)T * 2048 - 2048); const int ld = isz ? 2048 : 3072;
        FOR_ACC2(ai, bj, m) { st_bf8p(O + (size_t)ACC_ROW(u, ai, m) * ld + ACC_COL8P(u, bj, PF(4)), acc[ai][bj][m][0], acc[ai][bj][m][1], PF(4)); ACC_FENCE; }
    }
};
DEV void phase_mb_conv(const Params& p, int j) {
    const int tid = tid_(), bid = bid_(); (void)tid; (void)bid;
    if (tid >= 384) return;
    const int c0 = tid * 8; const int t0 = bid * 64;
    const float* cw = p.mb_conv_w + (size_t)j * 4 * 3072; const float* cb = p.mb_conv_b + (size_t)j * 3072;
    float w[4][8], b[8];
#pragma unroll
    for (int i = 0; i < 4; ++i) { const f32x4 a = *(const f32x4*)(cw + i * 3072 + c0), bb = *(const f32x4*)(cw + i * 3072 + c0 + 4); for (int e = 0; e < 4; ++e) { w[i][e] = a[e]; w[i][4 + e] = bb[e]; } }
    { const f32x4 a = *(const f32x4*)(cb + c0), bb = *(const f32x4*)(cb + c0 + 4); for (int e = 0; e < 4; ++e) { b[e] = a[e]; b[4 + e] = bb[e]; } }
    float x0[8], x1[8], x2[8], x3[8];
    auto ld = [&](int t, float (&x)[8]) {
        if (t < 0) { for (int e = 0; e < 8; ++e) x[e] = 0.f; return; }
        const u32x4 v = *(const u32x4*)(WS_(p, XBC) + (size_t)t * 3072 + c0);
        x[0] = bflo(v.x); x[1] = bfhi(v.x); x[2] = bflo(v.y); x[3] = bfhi(v.y); x[4] = bflo(v.z); x[5] = bfhi(v.z); x[6] = bflo(v.w); x[7] = bfhi(v.w);
    };
    ld(t0 - 3, x0); ld(t0 - 2, x1); ld(t0 - 1, x2);
#pragma unroll 4
    for (int tt = 0; tt < 64; ++tt) {
        ld(t0 + tt, x3);
        float o[8];
#pragma unroll
        for (int e = 0; e < 8; ++e) o[e] = siluf_(b[e] + w[0][e] * x0[e] + w[1][e] * x1[e] + w[2][e] * x2[e] + w[3][e] * x3[e]);
        u32x4 r; r.x = pk2(o[0], o[1]); r.y = pk2(o[2], o[3]); r.z = pk2(o[4], o[5]); r.w = pk2(o[6], o[7]);
        *(u32x4*)(WS_(p, XC) + (size_t)(t0 + tt) * 3072 + c0) = r;
#pragma unroll
        for (int e = 0; e < 8; ++e) { x0[e] = x1[e]; x1[e] = x2[e]; x2[e] = x3[e]; }
    }
}

DEV void mb_dacs(const Params& p, int j, int c, int g, LAS float* dts, LAS float* dacs) {
    const int tid = tid_(); const int lane = tid & 63, h = tid >> 6;
    const int hh = 8 * g + h; const float a = -__expf(p.mb_a_log[j * 32 + hh]);
    const float d0 = WS_(p, DT)[(size_t)(c * 128 + 2 * lane) * 32 + hh], d1 = WS_(p, DT)[(size_t)(c * 128 + 2 * lane + 1) * 32 + hh];
    const float a0 = d0 * a, a1 = d1 * a;
    float s = a0 + a1;
#pragma unroll
    for (int o = 1; o < 64; o <<= 1) { const float v = __shfl_up(s, o); if (lane >= o) s += v; }
    dts[h * 128 + 2 * lane] = d0; dts[h * 128 + 2 * lane + 1] = d1;
    dacs[h * 128 + 2 * lane] = s - a1; dacs[h * 128 + 2 * lane + 1] = s;
}
constexpr int LDB = 136;
constexpr int LDX = 72;
DEV void ld_tile128(const bf16_t* src, int gld, LAS bf16_t* dst) {
    const int tid = tid_();
    for (int i = tid; i < 128 * 16; i += NTHR) { const int r = i >> 4, c8 = (i & 15) * 8; *(LAS u32x4*)(dst + r * LDB + c8) = *(const u32x4*)(src + (size_t)r * gld + c8); }
}

DEV void phase_mb_states(const Params& p, int j, LAS unsigned char* lds) {
    const int tid = tid_(), bid = bid_(); (void)tid; (void)bid;
    const int lane = tid & 63, w = tid >> 6;
    LAS bf16_t* Bm = (LAS bf16_t*)lds;
    LAS bf16_t* Xh = Bm + 128 * LDB;
    LAS float* dts = (LAS float*)(Xh + 128 * LDX);
    LAS float* dacs = dts + 1024;
    for (int u = bid; u < 512; u += NB_) {
        const int c = u >> 2, g = u & 3; const int t0 = c * 128;
        lds_barrier();
        mb_dacs(p, j, c, g, dts, dacs);
        ld_tile128(WS_(p, XC) + (size_t)t0 * 3072 + 2048 + 128 * g, 3072, Bm);
        lds_barrier();
        if (tid < 8) WS_(p, CD)[(c * 32) + 8 * g + tid] = __expf(dacs[tid * 128 + 127]);
        bf16x8 bfr[4];
#pragma unroll
        for (int ks = 0; ks < 4; ++ks) bfr[ks] = frag_tr(Bm, LDB, 32 * ks, 16 * w, lane);
        for (int h = 0; h < 8; ++h) {
            { const int l = tid >> 2, p0 = (tid & 3) * 16; const float sc = dts[h * 128 + l] * __expf(dacs[h * 128 + 127] - dacs[h * 128 + l]);
              const bf16_t* src = WS_(p, XC) + (size_t)(t0 + l) * 3072 + 64 * (8 * g + h) + p0;
#pragma unroll
              for (int hf = 0; hf < 2; ++hf) { const u32x4 v = *(const u32x4*)(src + 8 * hf); u32x4 r;
                  r.x = pk2(bflo(v.x) * sc, bfhi(v.x) * sc); r.y = pk2(bflo(v.y) * sc, bfhi(v.y) * sc); r.z = pk2(bflo(v.z) * sc, bfhi(v.z) * sc); r.w = pk2(bflo(v.w) * sc, bfhi(v.w) * sc);
                  *(LAS u32x4*)(Xh + l * LDX + p0 + 8 * hf) = r; } }
            lds_barrier();
            f32x4 acc[4];
#pragma unroll
            for (int pb = 0; pb < 4; ++pb) { acc[pb] = (f32x4){0.f, 0.f, 0.f, 0.f};
#pragma unroll
                for (int ks = 0; ks < 4; ++ks) { const bf16x8 af = frag_tr(Xh, LDX, 32 * ks, 16 * pb, lane); acc[pb] = MFMA16(af, bfr[ks], acc[pb]); } }
            bf16_t* S = WS_(p, STATES) + (((size_t)c * 32 + 8 * g + h) * 64) * 128;
#pragma unroll
            for (int pb = 0; pb < 4; ++pb)
#pragma unroll
                for (int r = 0; r < 4; ++r) S[(size_t)(16 * pb + 4 * (lane >> 4) + r) * 128 + 16 * w + (lane & 15)] = (bf16_t)f2bf(acc[pb][r]);
            lds_barrier();
        }
    }
}
DEV void phase_mb_scan(const Params& p) {
    const int tid = tid_(), bid = bid_();
    if (tid >= 128) return;
    const int gid = bid * 128 + tid;
    const int n8 = gid & 15, pp = (gid >> 4) & 63, h = gid >> 10; const int n = 8 * n8;
    float r[8]; for (int e = 0; e < 8; ++e) r[e] = 0.f;
    const size_t eo = ((size_t)h * 64 + pp) * 128 + n;
    const size_t fo = (size_t)h * 64 * 128 + fragmajor_off(pp, n, 128);
#pragma unroll 8
    for (int c = 0; c < 128; ++c) {
        const u32x4 sr = *(const u32x4*)(WS_(p, STATES) + (size_t)c * 32 * 64 * 128 + eo);
        const float cd = WS_(p, CD)[c * 32 + h];
        u32x4 o; o.x = pk2(r[0], r[1]); o.y = pk2(r[2], r[3]); o.z = pk2(r[4], r[5]); o.w = pk2(r[6], r[7]);
        *(u32x4*)(WS_(p, PREV) + (size_t)c * 32 * 64 * 128 + fo) = o;
        r[0] = r[0] * cd + bflo(sr.x); r[1] = r[1] * cd + bfhi(sr.x); r[2] = r[2] * cd + bflo(sr.y); r[3] = r[3] * cd + bfhi(sr.y);
        r[4] = r[4] * cd + bflo(sr.z); r[5] = r[5] * cd + bfhi(sr.z); r[6] = r[6] * cd + bflo(sr.w); r[7] = r[7] * cd + bfhi(sr.w);
    }
}
DEV void phase_mb_out(const Params& p, int j, LAS unsigned char* lds) {
    const int tid = tid_(), bid = bid_(); (void)tid; (void)bid;
    const int lane = tid & 63, w = tid >> 6; const int fr = lane & 15, fq = lane >> 4;
    LAS bf16_t* Cm = (LAS bf16_t*)lds;
    LAS bf16_t* Bm = Cm + 128 * LDB;
    LAS bf16_t* Xh = Bm + 128 * LDB;
    LAS bf16_t* Mw = Xh + 128 * LDX;
    LAS float* dts = (LAS float*)(Mw + 8 * 16 * LDB);
    LAS float* dacs = dts + 1024;
    LAS bf16_t* Mme = Mw + w * 16 * LDB;
    for (int u = bid; u < 512; u += NB_) {
        const int c = u >> 2, g = u & 3; const int t0 = c * 128;
        lds_barrier();
        mb_dacs(p, j, c, g, dts, dacs);
        ld_tile128(WS_(p, XC) + (size_t)t0 * 3072 + 2048 + 512 + 128 * g, 3072, Cm);
        ld_tile128(WS_(p, XC) + (size_t)t0 * 3072 + 2048 + 128 * g, 3072, Bm);
        lds_barrier();
        f32x4 sc[8]; bf16x8 cf[4];
#pragma unroll
        for (int ks = 0; ks < 4; ++ks) cf[ks] = frag_rm(Cm, LDB, 16 * w, 32 * ks, lane);
#pragma unroll
        for (int sb = 0; sb < 8; ++sb) { sc[sb] = (f32x4){0.f, 0.f, 0.f, 0.f};
#pragma unroll
            for (int ks = 0; ks < 4; ++ks) sc[sb] = MFMA16(cf[ks], frag_rm(Bm, LDB, 16 * sb, 32 * ks, lane), sc[sb]); }
        float ssq = 0.f;
        const int rl = tid >> 2, p0 = (tid & 3) * 16;
        const LAS float* Yrow = (const LAS float*)(Mw + (rl >> 4) * 16 * LDB) + (rl & 15) * 68 + p0;
        LAS float* Yw = (LAS float*)Mme;
        u32x4 xraw[2], zraw[2], xnx[2], znx[2]; bf16x8 pfc[16];
#define MB_LOADH(HH, XR, ZR) do { const int hh_ = 8 * g + (HH); \
            XR[0] = *(const u32x4*)(WS_(p, XC) + (size_t)(t0 + rl) * 3072 + 64 * hh_ + p0); XR[1] = *(const u32x4*)(WS_(p, XC) + (size_t)(t0 + rl) * 3072 + 64 * hh_ + p0 + 8); \
            ZR[0] = *(const u32x4*)(WS_(p, Z) + (size_t)(t0 + rl) * 2048 + 64 * hh_ + p0); ZR[1] = *(const u32x4*)(WS_(p, Z) + (size_t)(t0 + rl) * 2048 + 64 * hh_ + p0 + 8); } while (0)
        MB_LOADH(0, xraw, zraw);
#pragma unroll 1
        for (int h = 0; h < 8; ++h) {
            const int hh = 8 * g + h;
            MB_LOADH(h < 7 ? h + 1 : h, xnx, znx);
            { const bf16_t* pv_ = WS_(p, PREV) + ((size_t)c * 32 + hh) * 64 * 128;
#pragma unroll
              for (int i_ = 0; i_ < 16; ++i_) pfc[i_] = *(const bf16x8*)(pv_ + ((size_t)i_ * 64 + lane) * 8); }
            { const float scl = dts[h * 128 + rl];
#pragma unroll
              for (int hf = 0; hf < 2; ++hf) { const u32x4 v = xraw[hf]; u32x4 r;
                  r.x = pk2(bflo(v.x) * scl, bfhi(v.x) * scl); r.y = pk2(bflo(v.y) * scl, bfhi(v.y) * scl); r.z = pk2(bflo(v.z) * scl, bfhi(v.z) * scl); r.w = pk2(bflo(v.w) * scl, bfhi(v.w) * scl);
                  *(LAS u32x4*)(Xh + rl * LDX + p0 + 8 * hf) = r; } }
            const u32x4 zraw0 = zraw[0], zraw1 = zraw[1];
            float dl[4];
#pragma unroll
            for (int r = 0; r < 4; ++r) dl[r] = dacs[h * 128 + 16 * w + 4 * fq + r];
#pragma unroll
            for (int sb = 0; sb < 8; ++sb) { const int s_ = 16 * sb + fr; const float ds = dacs[h * 128 + s_];
#pragma unroll
                for (int r = 0; r < 4; ++r) { const int l = 16 * w + 4 * fq + r; const float m = (s_ <= l) ? sc[sb][r] * __expf(dl[r] - ds) : 0.f; Mme[(4 * fq + r) * LDB + s_] = (bf16_t)f2bf(m); } }
            lds_barrier();
            bf16x8 mf[4];
#pragma unroll
            for (int ks = 0; ks < 4; ++ks) mf[ks] = frag_rm(Mme, LDB, 0, 32 * ks, lane);
            f32x4 yv[4];
#pragma unroll
            for (int pb = 0; pb < 4; ++pb) {
                f32x4 a = {0.f, 0.f, 0.f, 0.f}, o = {0.f, 0.f, 0.f, 0.f};
#pragma unroll
                for (int ks = 0; ks < 4; ++ks) {
                    a = MFMA16(mf[ks], frag_tr(Xh, LDX, 32 * ks, 16 * pb, lane), a);
                    o = MFMA16(cf[ks], pfc[pb * 4 + ks], o);
                }
#pragma unroll
                for (int r = 0; r < 4; ++r) a[r] += o[r] * __expf(dl[r]);
                yv[pb] = a;
            }
#pragma unroll
            for (int pb = 0; pb < 4; ++pb)
#pragma unroll
                for (int r = 0; r < 4; ++r) Yw[(4 * fq + r) * 68 + 16 * pb + fr] = yv[pb][r];
            lds_barrier();
            {
                const float dsk = p.mb_d[j * 32 + hh]; const float* ng = p.mb_norm_g + (size_t)j * 2048 + 64 * hh + p0;
                float y[16], xs[16], zz[16];
#pragma unroll
                for (int q = 0; q < 4; ++q) { const f32x4 t4 = *(const LAS f32x4*)(Yrow + 4 * q); y[4 * q] = t4[0]; y[4 * q + 1] = t4[1]; y[4 * q + 2] = t4[2]; y[4 * q + 3] = t4[3]; }
                xs[0] = bflo(xraw[0].x); xs[1] = bfhi(xraw[0].x); xs[2] = bflo(xraw[0].y); xs[3] = bfhi(xraw[0].y); xs[4] = bflo(xraw[0].z); xs[5] = bfhi(xraw[0].z); xs[6] = bflo(xraw[0].w); xs[7] = bfhi(xraw[0].w);
                xs[8] = bflo(xraw[1].x); xs[9] = bfhi(xraw[1].x); xs[10] = bflo(xraw[1].y); xs[11] = bfhi(xraw[1].y); xs[12] = bflo(xraw[1].z); xs[13] = bfhi(xraw[1].z); xs[14] = bflo(xraw[1].w); xs[15] = bfhi(xraw[1].w);
                zz[0] = bflo(zraw0.x); zz[1] = bfhi(zraw0.x); zz[2] = bflo(zraw0.y); zz[3] = bfhi(zraw0.y); zz[4] = bflo(zraw0.z); zz[5] = bfhi(zraw0.z); zz[6] = bflo(zraw0.w); zz[7] = bfhi(zraw0.w);
                zz[8] = bflo(zraw1.x); zz[9] = bfhi(zraw1.x); zz[10] = bflo(zraw1.y); zz[11] = bfhi(zraw1.y); zz[12] = bflo(zraw1.z); zz[13] = bfhi(zraw1.z); zz[14] = bflo(zraw1.w); zz[15] = bfhi(zraw1.w);
                float o[16];
#pragma unroll
                for (int q = 0; q < 4; ++q) { const f32x4 n4 = *(const f32x4*)(ng + 4 * q);
#pragma unroll
                    for (int e = 0; e < 4; ++e) { const int i = 4 * q + e; const float v = (y[i] + xs[i] * dsk) * siluf_(zz[i]); ssq += v * v; o[i] = v * n4[e]; } }
                bf16_t* dst = WS_(p, YB) + (size_t)(t0 + rl) * 2048 + 64 * hh + p0;
                u32x4 w0, w1; w0.x = pk2(o[0], o[1]); w0.y = pk2(o[2], o[3]); w0.z = pk2(o[4], o[5]); w0.w = pk2(o[6], o[7]); w1.x = pk2(o[8], o[9]); w1.y = pk2(o[10], o[11]); w1.z = pk2(o[12], o[13]); w1.w = pk2(o[14], o[15]);
                *(u32x4*)dst = w0; *(u32x4*)(dst + 8) = w1;
            }
            xraw[0] = xnx[0]; xraw[1] = xnx[1]; zraw[0] = znx[0]; zraw[1] = znx[1];
            lds_barrier();
        }
#undef MB_LOADH
        ssq += __shfl_xor(ssq, 1); ssq += __shfl_xor(ssq, 2);
        const float rstd = rsqrtf(ssq * (1.0f / 512.0f) + 1e-5f);
#pragma unroll 1
        for (int h = 0; h < 8; ++h) {
            bf16_t* dst = WS_(p, YB) + (size_t)(t0 + rl) * 2048 + 64 * (8 * g + h) + p0;
#pragma unroll
            for (int hf = 0; hf < 2; ++hf) { const u32x4 v = *(const u32x4*)(dst + 8 * hf); u32x4 r;
                r.x = pk2(bflo(v.x) * rstd, bfhi(v.x) * rstd); r.y = pk2(bflo(v.y) * rstd, bfhi(v.y) * rstd); r.z = pk2(bflo(v.z) * rstd, bfhi(v.z) * rstd); r.w = pk2(bflo(v.w) * rstd, bfhi(v.w) * rstd);
                *(u32x4*)(dst + 8 * hf) = r; }
        }
    }
}
constexpr int GL_PROJ = 3088;
constexpr int LDV = 264;
struct SchedGlIn {
    const Params* p;
    DEV bool next(int i, Unit& u) const {
        int pm, pn; if (!pg8::tile_order(i, NB_, bid_(), 64, 12, pm, pn)) return false;
        u.A = (const char*)(WS_(*p, Hb) + (size_t)pm * 256 * D); u.B = (const char*)(WS_(*p, gl_win_t) + (size_t)pn * 256 * D); u.row0 = pm * 256; u.col0 = pn * 256; u.id = 0; u.aux = 0; return true;
    }
};
struct EpiGlIn {
    const Params* p;
    DEV void operator()(const AccT& acc, const Unit& u, int wr, int wc, int fr, int fq) const {
        FOR_ACC2(ai, bj, m) { st_bf8p(WS_(*p, QKVG) + (size_t)ACC_ROW(u, ai, m) * 3072 + ACC_COL8P(u, bj, PF(5)), acc[ai][bj][m][0], acc[ai][bj][m][1], PF(5)); ACC_FENCE; }
    }
};
DEV void gl_bcs(const Params& p, int n, int h, LAS float* bcs) {
    const int tid = tid_();
    for (int i = tid; i < 64 * 32; i += NTHR) { const int r = i >> 5, c4 = (i & 31) * 4; *(LAS f32x4*)(bcs + r * 128 + c4) = *(const f32x4*)(WS_(p, LA) + (size_t)(n * 64 + r) * 512 + 128 * h + c4); }
    lds_barrier();
    if (tid < 128) { float s = 0.f; for (int r = 0; r < 64; ++r) { s += bcs[r * 128 + tid]; bcs[r * 128 + tid] = s; } }
    lds_barrier();
}
DEV void phase_gl_kv(const Params& p, LAS unsigned char* lds) {
    const int tid = tid_(), bid = bid_(); (void)tid; (void)bid;
    const int lane = tid & 63, w = tid >> 6;
    LAS float* bcs = (LAS float*)lds;
    LAS bf16_t* Ke = (LAS bf16_t*)(bcs + 64 * 128);
    LAS bf16_t* Vs = Ke + 64 * LDB;
    for (int u = bid; u < 1024; u += NB_) {
        const int n = u >> 2, h = u & 3; const int t0 = n * 64;
        lds_barrier();
        gl_bcs(p, n, h, bcs);
        for (int i = tid; i < 64 * 16; i += NTHR) { const int r = i >> 4, c8 = (i & 15) * 8;
            const u32x4 v = *(const u32x4*)(WS_(p, QKVG) + (size_t)(t0 + r) * 3072 + 512 + 128 * h + c8); float f[8];
            f[0] = bflo(v.x); f[1] = bfhi(v.x); f[2] = bflo(v.y); f[3] = bfhi(v.y); f[4] = bflo(v.z); f[5] = bfhi(v.z); f[6] = bflo(v.w); f[7] = bfhi(v.w);
#pragma unroll
            for (int e = 0; e < 8; ++e) f[e] *= __expf(bcs[63 * 128 + c8 + e] - bcs[r * 128 + c8 + e]);
            u32x4 o; o.x = pk2(f[0], f[1]); o.y = pk2(f[2], f[3]); o.z = pk2(f[4], f[5]); o.w = pk2(f[6], f[7]);
            *(LAS u32x4*)(Ke + r * LDB + c8) = o; }
        for (int i = tid; i < 64 * 32; i += NTHR) { const int r = i >> 5, c8 = (i & 31) * 8; *(LAS u32x4*)(Vs + r * LDV + c8) = *(const u32x4*)(WS_(p, QKVG) + (size_t)(t0 + r) * 3072 + 1024 + 256 * h + c8); }
        if (tid < 128) WS_(p, CDG)[((size_t)n * 4 + h) * 128 + tid] = __expf(bcs[63 * 128 + tid]);
        lds_barrier();
        bf16x8 af[2];
#pragma unroll
        for (int ks = 0; ks < 2; ++ks) af[ks] = frag_tr(Ke, LDB, 32 * ks, 16 * w, lane);
        bf16_t* O = WS_(p, STATES) + (((size_t)n * 4 + h) * 128) * 256;
#pragma unroll
        for (int vb = 0; vb < 16; ++vb) {
            f32x4 acc = {0.f, 0.f, 0.f, 0.f};
#pragma unroll
            for (int ks = 0; ks < 2; ++ks) acc = MFMA16(af[ks], frag_tr(Vs, LDV, 32 * ks, 16 * vb, lane), acc);
            { u32x2 o; o.x = pk2(acc[0], acc[1]); o.y = pk2(acc[2], acc[3]); *(u32x2*)(O + (size_t)(16 * vb + (lane & 15)) * 128 + 16 * w + 4 * (lane >> 4)) = o; }
        }
    }
}
DEV void phase_gl_scan(const Params& p) {
    const int tid = tid_(), bid = bid_();
    if (tid >= 64) return;
    const int gid = bid * 64 + tid;
    const int k8 = gid & 15, v = (gid >> 4) & 255, h = gid >> 12; const int k = 8 * k8;
    float r[8]; for (int e = 0; e < 8; ++e) r[e] = 0.f;
    const size_t fo = (size_t)h * 128 * 256 + fragmajor_off(v, k, 128);
#pragma unroll 8
    for (int n = 0; n < 256; ++n) {
        const u32x4 sr = *(const u32x4*)(WS_(p, STATES) + (((size_t)n * 4 + h) * 256 + v) * 128 + k);
        const f32x4 c0 = *(const f32x4*)(WS_(p, CDG) + ((size_t)n * 4 + h) * 128 + k), c1 = *(const f32x4*)(WS_(p, CDG) + ((size_t)n * 4 + h) * 128 + k + 4);
        u32x4 o; o.x = pk2(r[0], r[1]); o.y = pk2(r[2], r[3]); o.z = pk2(r[4], r[5]); o.w = pk2(r[6], r[7]);
        *(u32x4*)(WS_(p, PREV) + (size_t)n * 4 * 128 * 256 + fo) = o;
        r[0] = r[0] * c0[0] + bflo(sr.x); r[1] = r[1] * c0[1] + bfhi(sr.x); r[2] = r[2] * c0[2] + bflo(sr.y); r[3] = r[3] * c0[3] + bfhi(sr.y);
        r[4] = r[4] * c1[0] + bflo(sr.z); r[5] = r[5] * c1[1] + bfhi(sr.z); r[6] = r[6] * c1[2] + bflo(sr.w); r[7] = r[7] * c1[3] + bfhi(sr.w);
    }
}
DEV void phase_gl_out(const Params& p, int j, LAS unsigned char* lds) {
    const int tid = tid_(), bid = bid_(); (void)tid; (void)bid;
    const int lane = tid & 63, w = tid >> 6; const int fr = lane & 15, fq = lane >> 4;
    LAS float* bcs = (LAS float*)lds;
    LAS bf16_t* Qs = (LAS bf16_t*)(bcs + 64 * 128);
    LAS bf16_t* Ks = Qs + 64 * LDB;
    LAS bf16_t* Vs = Ks + 64 * LDB;
    LAS bf16_t* At = Vs + 64 * LDV;
    LAS float* red = (LAS float*)(At + 64 * LDX);
    for (int u = bid; u < 1024; u += NB_) {
        const int n = u >> 2, h = u & 3; const int t0 = n * 64;
        lds_barrier();
        gl_bcs(p, n, h, bcs);
        for (int i = tid; i < 64 * 16; i += NTHR) { const int r = i >> 4, c8 = (i & 15) * 8;
            const u32x4 vq = *(const u32x4*)(WS_(p, QKVG) + (size_t)(t0 + r) * 3072 + 128 * h + c8), vk = *(const u32x4*)(WS_(p, QKVG) + (size_t)(t0 + r) * 3072 + 512 + 128 * h + c8);
            float fq_[8], fk_[8];
            fq_[0] = bflo(vq.x); fq_[1] = bfhi(vq.x); fq_[2] = bflo(vq.y); fq_[3] = bfhi(vq.y); fq_[4] = bflo(vq.z); fq_[5] = bfhi(vq.z); fq_[6] = bflo(vq.w); fq_[7] = bfhi(vq.w);
            fk_[0] = bflo(vk.x); fk_[1] = bfhi(vk.x); fk_[2] = bflo(vk.y); fk_[3] = bfhi(vk.y); fk_[4] = bflo(vk.z); fk_[5] = bfhi(vk.z); fk_[6] = bflo(vk.w); fk_[7] = bfhi(vk.w);
#pragma unroll
            for (int e = 0; e < 8; ++e) { const float b = bcs[r * 128 + c8 + e]; fq_[e] *= __expf(b) * 0.08838834764831845f; fk_[e] *= __expf(-b); }
            u32x4 o; o.x = pk2(fq_[0], fq_[1]); o.y = pk2(fq_[2], fq_[3]); o.z = pk2(fq_[4], fq_[5]); o.w = pk2(fq_[6], fq_[7]);
            *(LAS u32x4*)(Qs + r * LDB + c8) = o;
            o.x = pk2(fk_[0], fk_[1]); o.y = pk2(fk_[2], fk_[3]); o.z = pk2(fk_[4], fk_[5]); o.w = pk2(fk_[6], fk_[7]);
            *(LAS u32x4*)(Ks + r * LDB + c8) = o; }
        for (int i = tid; i < 64 * 32; i += NTHR) { const int r = i >> 5, c8 = (i & 31) * 8; *(LAS u32x4*)(Vs + r * LDV + c8) = *(const u32x4*)(WS_(p, QKVG) + (size_t)(t0 + r) * 3072 + 1024 + 256 * h + c8); }
        lds_barrier();
        { const int ib = w >> 1;
#pragma unroll
          for (int jj = 0; jj < 2; ++jj) { const int jb = 2 * (w & 1) + jj; f32x4 a = {0.f, 0.f, 0.f, 0.f};
#pragma unroll
              for (int ks = 0; ks < 4; ++ks) a = MFMA16(frag_rm(Qs, LDB, 16 * ib, 32 * ks, lane), frag_rm(Ks, LDB, 16 * jb, 32 * ks, lane), a);
#pragma unroll
              for (int r = 0; r < 4; ++r) { const int i = 16 * ib + 4 * fq + r, jx = 16 * jb + fr; At[i * LDX + jx] = (bf16_t)f2bf(jx <= i ? a[r] : 0.f); } } }
        lds_barrier();
        f32x4 o[4][2];
        const bf16_t* pv = WS_(p, PREV) + ((size_t)n * 4 + h) * 128 * 256;
#pragma unroll
        for (int vv = 0; vv < 2; ++vv) { const int vb = 2 * w + vv;
            bf16x8 bi[2], bp[4];
#pragma unroll
            for (int ks = 0; ks < 2; ++ks) bi[ks] = frag_tr(Vs, LDV, 32 * ks, 16 * vb, lane);
#pragma unroll
            for (int ks = 0; ks < 4; ++ks) bp[ks] = *(const bf16x8*)(pv + ((size_t)(vb * 4 + ks) * 64 + lane) * 8);
#pragma unroll
            for (int ib = 0; ib < 4; ++ib) { f32x4 a = {0.f, 0.f, 0.f, 0.f};
#pragma unroll
                for (int ks = 0; ks < 2; ++ks) a = MFMA16(frag_rm(At, LDX, 16 * ib, 32 * ks, lane), bi[ks], a);
#pragma unroll
                for (int ks = 0; ks < 4; ++ks) a = MFMA16(frag_rm(Qs, LDB, 16 * ib, 32 * ks, lane), bp[ks], a);
                o[ib][vv] = a; } }
#pragma unroll
        for (int ib = 0; ib < 4; ++ib)
#pragma unroll
            for (int r = 0; r < 4; ++r) { float s = o[ib][0][r] * o[ib][0][r] + o[ib][1][r] * o[ib][1][r]; s = sum16(s); if (fr == 0) red[w * 64 + 16 * ib + 4 * fq + r] = s; }
        lds_barrier();
        {   LAS bf16_t* Os = (LAS bf16_t*)bcs;
#pragma unroll
            for (int ib = 0; ib < 4; ++ib)
#pragma unroll
                for (int vv = 0; vv < 2; ++vv)
#pragma unroll
                    for (int r = 0; r < 4; ++r) Os[(16 * ib + 4 * fq + r) * LDV + 32 * w + 16 * vv + fr] = (bf16_t)f2bf(o[ib][vv][r]);
            lds_barrier();
            const int row = tid >> 3, c0 = (tid & 7) * 32; const int t = t0 + row; float s = 0.f;
#pragma unroll
            for (int ww = 0; ww < 8; ++ww) s += red[ww * 64 + row];
            const float rs = rsqrtf(s * (1.0f / 256.0f) + 1e-5f);
#pragma unroll
            for (int q = 0; q < 4; ++q) {
                const u32x4 ov = *(const LAS u32x4*)(Os + row * LDV + c0 + 8 * q), gv = *(const u32x4*)(WS_(p, QKVG) + (size_t)t * 3072 + 2048 + 256 * h + c0 + 8 * q);
                const f32x4 n0 = *(const f32x4*)(p.gl_norm_g + j * 256 + c0 + 8 * q), n1 = *(const f32x4*)(p.gl_norm_g + j * 256 + c0 + 8 * q + 4);
                float r8[8];
                r8[0] = bflo(ov.x) * rs * n0[0] * siluf_(bflo(gv.x)); r8[1] = bfhi(ov.x) * rs * n0[1] * siluf_(bfhi(gv.x)); r8[2] = bflo(ov.y) * rs * n0[2] * siluf_(bflo(gv.y)); r8[3] = bfhi(ov.y) * rs * n0[3] * siluf_(bfhi(gv.y));
                r8[4] = bflo(ov.z) * rs * n1[0] * siluf_(bflo(gv.z)); r8[5] = bfhi(ov.z) * rs * n1[1] * siluf_(bfhi(gv.z)); r8[6] = bflo(ov.w) * rs * n1[2] * siluf_(bflo(gv.w)); r8[7] = bfhi(ov.w) * rs * n1[3] * siluf_(bfhi(gv.w));
                u32x4 wv; wv.x = pk2(r8[0], r8[1]); wv.y = pk2(r8[2], r8[3]); wv.z = pk2(r8[4], r8[5]); wv.w = pk2(r8[6], r8[7]);
                *(u32x4*)(WS_(p, YB) + (size_t)t * D + 256 * h + c0 + 8 * q) = wv;
            }
        }
    }
}
#define XB_TMO      128
#define XB_XCNT(j)  (256  + 64 * (j))
#define XB_XSUB(j)  (1280 + 64 * (j))
#define XB_XGEN(j)  (2304 + 64 * (j))
#define XB_TOP      3328
#define XB_TOPGEN   3392
#define XCD_BAR_WORDS 3456
#define XB_SPIN_CAP (1u << 22)
DEV unsigned xb_ld(unsigned* p)              { return __hip_atomic_load(p, __ATOMIC_RELAXED, __HIP_MEMORY_SCOPE_AGENT); }
DEV unsigned xb_add(unsigned* p, unsigned v) { return __hip_atomic_fetch_add(p, v, __ATOMIC_RELAXED, __HIP_MEMORY_SCOPE_AGENT); }
DEV unsigned xb_xcc_id() { return (unsigned)__builtin_amdgcn_s_getreg((3 << 11) | 20) & 0xFu; }
#define XB_SPIN(cond, bar) do { unsigned _sp = 0; while (cond) { __builtin_amdgcn_s_sleep(1); \
    if ((++_sp & 255u) == 0u) { if (xb_ld(&(bar)[XB_TMO])) break; if (_sp > XB_SPIN_CAP) { atomicAdd(&(bar)[XB_TMO], 1u); break; } } } } while (0)
struct XcdBarrier { unsigned* bar; unsigned x; volatile LAS unsigned* st; };
DEV XcdBarrier xcd_barrier_post(unsigned* bar, volatile LAS unsigned* st) {
    XcdBarrier b; b.bar = bar; b.x = xb_xcc_id(); b.st = st;
    if (threadIdx.x == 0) (void)xb_add(&bar[XB_XCNT(b.x)], 1u);
    return b;
}
DEV void xcd_barrier_complete(unsigned* bar, unsigned x, unsigned& nloc, unsigned& nx) {
    const unsigned G = gridDim.x * gridDim.y * gridDim.z;
    unsigned sum, cnt, mine, sp = 0u;
    for (;;) {
        sum = 0u; cnt = 0u; mine = 0u;
#pragma unroll
        for (unsigned j = 0; j < 16; ++j) { const unsigned c = xb_ld(&bar[XB_XCNT(j)]); sum += c; cnt += (c > 0u) ? 1u : 0u; mine = (j == x) ? c : mine; }
        if (sum == G) break;
        __builtin_amdgcn_s_sleep(1);
        if ((++sp & 255u) == 0u) { if (xb_ld(&bar[XB_TMO])) break; if (sp > XB_SPIN_CAP) { atomicAdd(&bar[XB_TMO], 1u); break; } }
    }
    nloc = mine > 0u ? mine : 1u; nx = cnt > 0u ? cnt : 1u;
}
DEV void xcd_barrier(const XcdBarrier& b) {
    asm volatile("s_waitcnt vmcnt(0)" ::: "memory");
    __syncthreads();
    if (threadIdx.x == 0) {
        unsigned* bar = b.bar;
        __builtin_amdgcn_s_waitcnt(0);
        unsigned nloc = b.st[0], nx = b.st[1];
        if (nloc == 0u) { xcd_barrier_complete(bar, b.x, nloc, nx); b.st[0] = nloc; b.st[1] = nx; }
        const unsigned old = xb_add(&bar[XB_XSUB(b.x)], 1u);
        const unsigned gen = old / nloc;
        if (old + 1u == (gen + 1u) * nloc) {
            __builtin_amdgcn_fence(__ATOMIC_RELEASE, "agent");
            asm volatile("s_waitcnt vmcnt(0)" ::: "memory");
            const unsigned og = xb_add(&bar[XB_TOP], 1u);
            const unsigned tg = og / nx;
            if (og + 1u == (tg + 1u) * nx) xb_add(&bar[XB_TOPGEN], 1u);
            else XB_SPIN(xb_ld(&bar[XB_TOPGEN]) == tg, bar);
            __builtin_amdgcn_fence(__ATOMIC_ACQUIRE, "agent");
            xb_add(&bar[XB_XGEN(b.x)], 1u);
            asm volatile("s_waitcnt vmcnt(0)" ::: "memory");
        } else {
            XB_SPIN(xb_ld(&bar[XB_XGEN(b.x)]) == gen, bar);
            __builtin_amdgcn_fence(__ATOMIC_ACQUIRE, "agent");
            asm volatile("s_waitcnt vmcnt(0)" ::: "memory");
        }
    }
    __syncthreads();
}

DEV void moe_tail_convert(const Params& p, LAS unsigned char* lds, int layer) {
    if (layer != 1) return;
    convert_tickets(moe_job(p, 0, layer + 1), moe_job(p, 1, layer + 1), lds, WS_(p, MFLAG) + MFLAG_TICKET * MFLAG_STRIDE, MFLAG_STRIDE);
}
DEV LAS int* moe_tab_to_lds(const Params& p, LAS unsigned char* lds) {
    LAS int* tab = (LAS int*)(lds + pg8::STAGE_BYTES);
    const int tid = tid_();
    if (tid < 256) tab[tid] = __hip_atomic_load(WS_(p, TAB) + tid, __ATOMIC_RELAXED, __HIP_MEMORY_SCOPE_AGENT);
    __syncthreads();
    return tab;
}
DEV void run_phase(const Params& pin, int op, int arg, LAS unsigned char* lds) {
    Params p = pin; { size_t z_ = 0; asm volatile("" : "+s"(z_)); p.ws = pin.ws + z_; }
    const int layer = arg; const int jj = layer / 3;
#ifdef ONLY_OP
    if (op != ONLY_OP) return;
#endif
#ifdef OPMASK
    if (!((OPMASK >> op) & 1ull)) return;
#endif
    switch (op) {
    case OP_CONVERT: phase_pre0(p); phase_convert(p, lds);
#ifdef DBG
        if (blockIdx.x == 0 && threadIdx.x < 24) WS_(p, TAB)[200 + threadIdx.x] = 0;
#endif
        break;
    case OP_PRE0: break;
    case OP_RW_GEMM1: { SchedRW1 S{&p, jj}; EpiRW1 E{&p}; pg8::gemm_phase(lds, 1024, S, E); } break;
    case OP_RW_GEMM2: { SchedRW2 S{&p, jj}; EpiRW2 E{&p, jj}; pg8::gemm_phase(lds, 256, S, E); } break;
    case OP_RW_CHA: phase_rw_cha(p, jj, lds); break;
    case OP_RW_CHB: phase_rw_chb(p, layer, lds);
#ifdef REP_B
        if (layer == REP_B) { __syncthreads(); phase_rw_chb(p, layer, lds); }
#endif
        break;
    case OP_RW_CHC: phase_rw_chc(p, jj, lds); break;
    case OP_RW_OUT: { SchedOut S{WS_(p, YB), WS_(p, rw_wo_t) + (size_t)jj * D * D, 1024}; EpiOut E{WS_(p, MIXb)}; pg8::gemm_phase(lds, 1024, S, E); } break;
    case OP_LN1: phase_ln1(p, layer, lds); break;
    case OP_MOE_SCATTER: phase_moe_scatter(p, lds); break;
    case OP_MOE_GEMM1: { LAS int* tab = moe_tab_to_lds(p, lds);
#ifdef REP_MOE
#pragma unroll 1
        for (int rep_ = 0; rep_ < REP_MOE; ++rep_) {
#endif
        { SchedMoe<0> S{&p, layer, tab}; EpiMoe1 E{WS_(p, ACT), WS_(p, MFLAG)}; pg8::gemm_phase(lds, 1024, S, E); }
        { SchedMoe<1> S{&p, layer, tab}; EpiMoe2 E{WS_(p, YBUF)}; pg8::gemm_phase(lds, 512, S, E); }
#ifdef REP_MOE
        }
#endif
        moe_tail_convert(p, lds, layer); } break;
    case OP_MOE_GEMM2: break;
    case OP_LN2: phase_ln2(p, layer, lds); break;
    case OP_MB_GEMM_IN: { SchedMbIn S{&p}; EpiMbIn E{&p}; pg8::gemm_phase(lds, 1024, S, E); } break;
    case OP_MB_CONV: phase_mb_conv(p, jj); break;
    case OP_MB_STATES: phase_mb_states(p, jj, lds); break;
    case OP_MB_SCAN: phase_mb_scan(p); break;
    case OP_MB_OUT: phase_mb_out(p, jj, lds); break;
    case OP_MB_GEMM_OUT: { SchedOut S{WS_(p, YB), WS_(p, mb_wout_t) + (size_t)jj * D * 2048, 2048}; EpiOut E{WS_(p, MIXb)}; pg8::gemm_phase(lds, 2048, S, E); } break;
    case OP_GL_GEMM_IN: { SchedGlIn S{&p}; EpiGlIn E{&p}; pg8::gemm_phase(lds, 1024, S, E); } break;
    case OP_GL_KV: phase_gl_kv(p, lds); break;
    case OP_GL_SCAN: phase_gl_scan(p); break;
    case OP_GL_OUT: phase_gl_out(p, jj, lds); break;
    case OP_GL_GEMM_OUT: { SchedOut S{WS_(p, YB), WS_(p, gl_wout_t) + (size_t)jj * D * D, 1024}; EpiOut E{WS_(p, MIXb)}; pg8::gemm_phase(lds, 1024, S, E); } break;
    default: break;
    }
}

constexpr int NPHASES = 1 + 10 + 10 + 9 + 10;
DEV void decode_phase(int ph, int& op, int& layer) {
    if (ph < 1) { op = OP_CONVERT; layer = 0; return; }
    int q = ph - 1; layer = 0;
    if (q >= 10) { q -= 10; layer = 1; if (q >= 10) { q -= 10; layer = 2; if (q >= 9) { q -= 9; layer = 3; } } }
    const int kind = layer % 3; const int nmix = kind == 2 ? 5 : 6;
    if (q < nmix) op = (kind == 0 ? OP_RW_GEMM1 : kind == 1 ? OP_MB_GEMM_IN : OP_GL_GEMM_IN) + q;
    else { const int m = q - nmix; op = m < 3 ? OP_LN1 + m : OP_LN2; }
}

#define X(t, n) t n##_,
template <bool COOP>
__global__ void __launch_bounds__(NTHR, 2) mega(PARAM_LIST(X) const int ph0, const int ph1) {
#undef X
    Params p;
#define X(t, n) p.n = n##_;
    PARAM_LIST(X)
#undef X

    extern __shared__ __attribute__((aligned(16))) unsigned char smem_raw[];
    LAS unsigned char* lds = (LAS unsigned char*)smem_raw;
    if constexpr (COOP) {
        volatile LAS unsigned* st = (volatile LAS unsigned*)(lds + LDS_BYTES - 16);
        if (threadIdx.x == 0) { st[0] = 0u; st[1] = 0u; }
        __syncthreads();
        XcdBarrier xb = xcd_barrier_post(WS_(p, bar), st);
        if (ph0 < 0) cg::this_grid().sync();
        for (int ph = ph0; ph < ph1; ++ph) {
            int op, arg; decode_phase(ph, op, arg);
#ifdef REPEAT_MASK
            const int reps = 1 + (int)((REPEAT_MASK >> op) & 1ull);
#else
            const int reps = 1;
#endif
#pragma unroll 1
            for (int rep = 0; rep < reps; ++rep) {
                run_phase(p, op, arg, lds);
                if (ph + 1 < ph1 || rep + 1 < reps) { xcd_barrier(xb);
#ifdef BAR2
                    xcd_barrier(xb);
#endif
                }
            }
        }
#ifdef DBG
        xcd_barrier(xb);
#ifndef DBG_WORD
#define DBG_WORD 200
#endif
        { const int code = __hip_atomic_load(WS_(p, TAB) + DBG_WORD, __ATOMIC_RELAXED, __HIP_MEMORY_SCOPE_AGENT);
          for (size_t i = (size_t)blockIdx.x * NTHR + threadIdx.x; i < (size_t)T * D; i += (size_t)NB_ * NTHR) p.out[i] = 0.f;
          __syncthreads();
          if (blockIdx.x == 0 && threadIdx.x == 0) p.out[0] = sqrtf((float)DBG_DECODE(code) * 1.68e7f); }
#endif
    } else {
        for (int ph = ph0; ph < ph1; ++ph) { int op, arg; decode_phase(ph, op, arg); run_phase(p, op, arg, lds); }
    }
}


extern "C" void kernel_launch(void* const* d_in, const int* in_sizes, int n_in, void* d_out, int out_size, void* d_ws, size_t ws_size, hipStream_t stream) {
    (void)in_sizes; (void)n_in; (void)out_size;
    Params p; std::memset((void*)&p, 0, sizeof(p));
    auto F = [&](int i) { return (const float*)d_in[i]; };
    p.x = F(0); p.ln_g = F(1); p.ln_b = F(2);
    p.rw_mu = F(3); p.rw_w_rkv = F(4); p.rw_w0 = F(5); p.rw_w1 = F(6); p.rw_w2 = F(7); p.rw_a0 = F(8);
    p.rw_a1 = F(9); p.rw_a2 = F(10); p.rw_g1 = F(11); p.rw_g2 = F(12);
    p.rw_k_k = F(13); p.rw_k_a = F(14); p.rw_r_k = F(15); p.rw_lnx_g = F(16); p.rw_lnx_b = F(17); p.rw_w_o = F(18);
    p.mb_w_in = F(19); p.mb_conv_w = F(20); p.mb_conv_b = F(21); p.mb_dt_bias = F(22); p.mb_a_log = F(23); p.mb_d = F(24); p.mb_norm_g = F(25); p.mb_w_out = F(26);
    p.gl_w_in = F(27); p.gl_gk_w2 = F(28); p.gl_gk_b = F(29); p.gl_norm_g = F(30); p.gl_w_out = F(31);
    p.moe_w_group = F(32); p.moe_b_group = F(33); p.moe_w_route = F(34); p.moe_b_route = F(35); p.moe_w_in = F(36); p.moe_w_down = F(37);
    p.out = (float*)d_out;
    p.ws = (char*)d_ws;
    if (WS_TOTAL > ws_size) { fprintf(stderr, "workspace too small: need %zu have %zu\n", (size_t)WS_TOTAL, ws_size); return; }
    unsigned* bar_ptr = (unsigned*)(p.ws + OFF_bar);
    const int np = NPHASES;
#define X(t, n) (void*)&p.n,
#if SINGLE_LAUNCH
    (void)hipFuncSetAttribute((const void*)mega<true>, hipFuncAttributeMaxDynamicSharedMemorySize, LDS_BYTES);
    (void)hipMemsetAsync(bar_ptr, 0, XCD_BAR_WORDS * sizeof(unsigned), stream);
    int ph0 = 0, ph1 = np; void* args[] = {PARAM_LIST(X) (void*)&ph0, (void*)&ph1};
    hipError_t e = hipLaunchCooperativeKernel((const void*)mega<true>, dim3(NBLK), dim3(NTHR), args, LDS_BYTES, stream);
    if (e != hipSuccess) fprintf(stderr, "cooperative launch failed: %s\n", hipGetErrorString(e));
#else
    (void)hipFuncSetAttribute((const void*)mega<false>, hipFuncAttributeMaxDynamicSharedMemorySize, LDS_BYTES);
    for (int ph = 0; ph < np; ++ph) { int ph0 = ph, ph1 = ph + 1; void* args[] = {PARAM_LIST(X) (void*)&ph0, (void*)&ph1};
        hipError_t e = hipLaunchKernel((const void*)mega<false>, dim3(NBLK), dim3(NTHR), args, LDS_BYTES, stream);
        if (e != hipSuccess) fprintf(stderr, "launch failed: %s\n", hipGetErrorString(e)); }
#endif
#undef X
}
```

```cpp
#include <hip/hip_runtime.h>
#include <hip/hip_cooperative_groups.h>
#include <cstdint>
#include <cstdio>
#include <cstring>
namespace cg = cooperative_groups;

typedef unsigned short bf16_t;
typedef short bf16x8 __attribute__((ext_vector_type(8)));
typedef short s16x4 __attribute__((ext_vector_type(4)));
typedef float f32x4 __attribute__((ext_vector_type(4)));
typedef float f32x2 __attribute__((ext_vector_type(2)));
typedef unsigned u32x4 __attribute__((ext_vector_type(4)));
typedef unsigned u32x2 __attribute__((ext_vector_type(2)));
#define LAS __attribute__((address_space(3)))
#define DEV __device__ __forceinline__

constexpr int T = 16384, D = 1024, DEPTH = 4;
constexpr int NTHR = 512, NBLK = 256;
constexpr int LDS_BYTES = 155648;
constexpr float ALPHA = 1.681792830507429f;
constexpr float LN_EPS = 1e-5f;
constexpr int MOE_ROWS = 40960;

DEV int tid_() { int t = threadIdx.x; asm volatile("" : "+v"(t)); return t; }
DEV int bid_() { int b = blockIdx.x; asm volatile("" : "+s"(b)); return b; }
#define NB_ 256
#define RCOL(q, lane) ((((q) >> 1) * 512) + 8 * (lane) + 4 * ((q) & 1))
DEV void lds_barrier() { asm volatile("s_waitcnt lgkmcnt(0)" ::: "memory"); __builtin_amdgcn_s_barrier(); asm volatile("" ::: "memory"); }
DEV unsigned f2bf(float f) { unsigned u = __float_as_uint(f); u += 0x7FFFu + ((u >> 16) & 1u); return u >> 16; }
DEV float bf2f(unsigned short b) { return __uint_as_float(((unsigned)b) << 16); }
typedef __bf16 bf16n2 __attribute__((ext_vector_type(2)));
DEV unsigned pk2(float lo, float hi) { f32x2 v = {lo, hi}; bf16n2 b = __builtin_convertvector(v, bf16n2); return __builtin_bit_cast(unsigned, b); }
DEV float bflo(unsigned u) { return __uint_as_float(u << 16); }
DEV float bfhi(unsigned u) { return __uint_as_float(u & 0xFFFF0000u); }
DEV float sigmoidf_(float x) { return 1.0f / (1.0f + __expf(-x)); }
DEV float siluf_(float x) { return x / (1.0f + __expf(-x)); }
DEV float softplusf_(float x) { return fmaxf(x, 0.f) + __logf(1.0f + __expf(-fabsf(x))); }
DEV float tanhf_(float x) { const float e = __expf(-2.0f * fabsf(x)); const float r = (1.0f - e) / (1.0f + e); return x < 0.f ? -r : r; }
DEV float wave_sum(float v) {
#pragma unroll
    for (int o = 32; o > 0; o >>= 1) v += __shfl_xor(v, o);
    return v;
}
DEV float sum16(float v) {
#pragma unroll
    for (int o = 8; o > 0; o >>= 1) v += __shfl_xor(v, o);
    return v;
}
template <int N> DEV float reduce_scatter(float (&v)[N], int lane) {
    int s = 1;
#pragma unroll
    for (int h = N / 2; h >= 1; h >>= 1) {
#pragma unroll
        for (int i = 0; i < h; ++i) {
            const bool up = (lane & s) != 0;
            const float send = up ? v[i] : v[i + h];
            const float keep = up ? v[i + h] : v[i];
            v[i] = keep + __shfl_xor(send, s);
        }
        s <<= 1;
    }
    float r = v[0];
    for (; s < 64; s <<= 1) r += __shfl_xor(r, s);
    return r;
}
template <int N> DEV int rs_index(int lane) {
    int o = 0, s = 1;
#pragma unroll
    for (int h = N / 2; h >= 1; h >>= 1) { if (lane & s) o += h; s <<= 1; }
    return o;
}

DEV bf16x8 frag_rm(const LAS bf16_t* base, int ld, int row0, int k0, int lane) {
    return *(const LAS bf16x8*)(base + (row0 + (lane & 15)) * ld + k0 + 8 * (lane >> 4));
}
DEV bf16x8 frag_tr(const LAS bf16_t* base, int ld, int k0, int c0, int lane) {
    const int g = lane >> 4, i = lane & 15, q = i >> 2, p = i & 3;
    const LAS bf16_t* a = base + (k0 + 8 * g + q) * ld + c0 + 4 * p;
    s16x4 lo = __builtin_amdgcn_ds_read_tr16_b64_v4i16((LAS s16x4*)a);
    s16x4 hi = __builtin_amdgcn_ds_read_tr16_b64_v4i16((LAS s16x4*)(a + 4 * ld));
    bf16x8 r; r[0] = lo[0]; r[1] = lo[1]; r[2] = lo[2]; r[3] = lo[3]; r[4] = hi[0]; r[5] = hi[1]; r[6] = hi[2]; r[7] = hi[3];
    return r;
}
#define MFMA16(a, b, c) __builtin_amdgcn_mfma_f32_16x16x32_bf16((a), (b), (c), 0, 0, 0)
DEV size_t fragmajor_off(int n, int k, int K) { return ((size_t)((n >> 4) * (K >> 5) + (k >> 5)) * 64 + (n & 15) + 16 * ((k & 31) >> 3)) * 8 + (k & 7); }

template <int N> DEV void skinny_group(const f32x4 (&z)[4], const LAS float* wt, int lane, LAS float* outw) {
    float pe[N];
#pragma unroll
    for (int o = 0; o < N; ++o) {
        float a = 0.f;
#pragma unroll
        for (int q = 0; q < 4; ++q) { const f32x4 w = *(const LAS f32x4*)(wt + o * 1028 + RCOL(q, lane)); a += z[q][0] * w[0] + z[q][1] * w[1] + z[q][2] * w[2] + z[q][3] * w[3]; }
        pe[o] = a;
    }
    const float r = reduce_scatter<N>(pe, lane);
    if (lane < N) outw[rs_index<N>(lane)] = r;
}
#ifndef SINGLE_LAUNCH
#define SINGLE_LAUNCH 1
#endif
constexpr size_t OFF_bar = 0ull;
constexpr size_t OFF_rw_rkv_t = 13824ull;
constexpr size_t OFF_rw_w1_t = 12596736ull;
constexpr size_t OFF_rw_a1_t = 13645312ull;
constexpr size_t OFF_rw_g1_t = 14693888ull;
constexpr size_t OFF_rw_w2_t = 15742464ull;
constexpr size_t OFF_rw_a2_t = 16791040ull;
constexpr size_t OFF_rw_g2_t = 17839616ull;
constexpr size_t OFF_rw_wo_t = 18888192ull;
constexpr size_t OFF_mb_win_t = 23082496ull;
constexpr size_t OFF_mb_wout_t = 33568256ull;
constexpr size_t OFF_gl_win_t = 37762560ull;
constexpr size_t OFF_gl_wout_t = 44054016ull;
constexpr size_t OFF_moe_w1_t = 46151168ull;
constexpr size_t OFF_moe_w2_t = 314586624ull;
constexpr size_t OFF_H = 448804352ull;
constexpr size_t OFF_H1 = 515913216ull;
constexpr size_t OFF_MIX = 583022080ull;
constexpr size_t OFF_BUF = 650130944ull;
constexpr size_t OFF_ACT = 734017024ull;
constexpr size_t OFF_YBUF = 775960064ull;
constexpr size_t OFF_CNT = 859846144ull;
constexpr size_t OFF_EIDX = 859878912ull;
constexpr size_t OFF_GATE = 860009984ull;
constexpr size_t OFF_DEST = 860141056ull;
constexpr size_t OFF_TAB = 860272128ull;
constexpr size_t OFF_YB = 860273152ull;
constexpr size_t OFF_X6 = 927382016ull;
constexpr size_t OFF_Rr = 1128708608ull;
constexpr size_t OFF_Kk = 1195817472ull;
constexpr size_t OFF_Vv = 1262926336ull;
constexpr size_t OFF_LW = 1330035200ull;
constexpr size_t OFF_Wd = 1355201024ull;
constexpr size_t OFF_Aa = 1422309888ull;
constexpr size_t OFF_Gg = 1489418752ull;
constexpr size_t OFF_RWf = 1556527616ull;
constexpr size_t OFF_RBf = 1590082048ull;
constexpr size_t OFF_RUt = 1623636480ull;
constexpr size_t OFF_RNa = 1657190912ull;
constexpr size_t OFF_RGc = 1690745344ull;
constexpr size_t OFF_RUa = 1691793920ull;
constexpr size_t OFF_RS0 = 1725348352ull;
constexpr size_t OFF_Z = 960936448ull;
constexpr size_t OFF_XBC = 1028045312ull;
constexpr size_t OFF_XC = 1128708608ull;
constexpr size_t OFF_DT = 1229371904ull;
constexpr size_t OFF_STATES = 1231469056ull;
constexpr size_t OFF_CD = 1365686784ull;
constexpr size_t OFF_PREV = 1365703168ull;
constexpr size_t OFF_LA = 1432812032ull;
constexpr size_t OFF_CDG = 1466366464ull;
constexpr size_t OFF_QKVG = OFF_XBC;
constexpr size_t WS_TOTAL = 1758902784ull;
typedef unsigned T_bar;
typedef bf16_t T_rw_rkv_t;
typedef bf16_t T_rw_w1_t;
typedef bf16_t T_rw_a1_t;
typedef bf16_t T_rw_g1_t;
typedef bf16_t T_rw_w2_t;
typedef bf16_t T_rw_a2_t;
typedef bf16_t T_rw_g2_t;
typedef bf16_t T_rw_wo_t;
typedef bf16_t T_mb_win_t;
typedef bf16_t T_mb_wout_t;
typedef bf16_t T_gl_win_t;
typedef bf16_t T_gl_wout_t;
typedef bf16_t T_moe_w1_t;
typedef bf16_t T_moe_w2_t;
typedef float T_H;
typedef float T_H1;
typedef float T_MIX;
typedef bf16_t T_BUF;
typedef bf16_t T_ACT;
typedef bf16_t T_YBUF;
typedef int T_CNT;
typedef int T_EIDX;
typedef float T_GATE;
typedef int T_DEST;
typedef int T_TAB;
typedef bf16_t T_YB;
typedef bf16_t T_X6;
typedef float T_Rr;
typedef float T_Kk;
typedef float T_Vv;
typedef bf16_t T_LW;
typedef float T_Wd;
typedef float T_Aa;
typedef float T_Gg;
typedef bf16_t T_RWf;
typedef bf16_t T_RBf;
typedef bf16_t T_RUt;
typedef bf16_t T_RNa;
typedef float T_RGc;
typedef bf16_t T_RUa;
typedef bf16_t T_RS0;
typedef bf16_t T_Z;
typedef bf16_t T_XBC;
typedef bf16_t T_XC;
typedef float T_DT;
typedef bf16_t T_STATES;
typedef float T_CD;
typedef bf16_t T_PREV;
typedef float T_LA;
typedef float T_CDG;
typedef bf16_t T_QKVG;
#define WS_(P, N) ((T_##N*)((P).ws + OFF_##N))
constexpr size_t OFF_Hb = OFF_H, OFF_H1b = OFF_H1, OFF_MIXb = OFF_MIX;
typedef bf16_t T_Hb; typedef bf16_t T_H1b; typedef bf16_t T_MIXb;
constexpr size_t OFF_moe_wr_t = OFF_H + 33554432ull;
typedef bf16_t T_moe_wr_t;
constexpr size_t OFF_mb_dt_t = OFF_moe_wr_t + 4ull * 48 * 1024 * 2, OFF_gl_lr_t = OFF_mb_dt_t + 32ull * 1024 * 2;
typedef bf16_t T_mb_dt_t; typedef bf16_t T_gl_lr_t;
constexpr size_t OFF_MFLAG = OFF_gl_lr_t + 16ull * 1024 * 2;
typedef unsigned T_MFLAG;
constexpr int MFLAG_STRIDE = 16, MFLAG_TICKET = 256, MFLAG_SIDE = 320;
constexpr size_t OFF_RBST = OFF_MFLAG + 65536;
typedef f32x4 T_RBST;
constexpr size_t OFF_Rb = OFF_Rr, OFF_Kb = OFF_Kk, OFF_Vb = OFF_Vv, OFF_Ab = OFF_Aa, OFF_Gb = OFF_Gg;
typedef bf16_t T_Rb; typedef bf16_t T_Kb; typedef bf16_t T_Vb; typedef bf16_t T_Ab; typedef bf16_t T_Gb;
constexpr size_t OFF_Wb = OFF_Wd; typedef bf16_t T_Wb;
struct ConvJob {
    const float* src; bf16_t* dst;
    int K, N, src_ld, Kpad, Npad, perm, batch;
    long long src_bs, dst_bs;
    DEV int ntiles() const { return (Kpad / 64) * (Npad / 64) * batch; }
};
#ifndef PERMF
#define PERMF 0xDF
#endif
#define PF(bit) (((PERMF) >> (bit)) & 1)
constexpr int NJOBS = 16;
constexpr int MOE_SPLIT = 32;

#define PARAM_LIST(X) \
    X(const float*, x) X(const float*, ln_g) X(const float*, ln_b) \
    X(const float*, rw_mu) X(const float*, rw_w_rkv) X(const float*, rw_w0) X(const float*, rw_w1) X(const float*, rw_w2) X(const float*, rw_a0) X(const float*, rw_a1) X(const float*, rw_a2) \
    X(const float*, rw_g1) X(const float*, rw_g2) X(const float*, rw_k_k) X(const float*, rw_k_a) X(const float*, rw_r_k) X(const float*, rw_lnx_g) X(const float*, rw_lnx_b) X(const float*, rw_w_o) \
    X(const float*, mb_w_in) X(const float*, mb_conv_w) X(const float*, mb_conv_b) X(const float*, mb_dt_bias) X(const float*, mb_a_log) X(const float*, mb_d) X(const float*, mb_norm_g) X(const float*, mb_w_out) \
    X(const float*, gl_w_in) X(const float*, gl_gk_w2) X(const float*, gl_gk_b) X(const float*, gl_norm_g) X(const float*, gl_w_out) \
    X(const float*, moe_w_group) X(const float*, moe_b_group) X(const float*, moe_w_route) X(const float*, moe_b_route) X(const float*, moe_w_in) X(const float*, moe_w_down) \
    X(float*, out) X(char*, ws)
struct Params {
#define X(t, n) t n;
    PARAM_LIST(X)
#undef X
};

enum Op : unsigned char { OP_CONVERT = 0, OP_PRE0, OP_RW_GEMM1, OP_RW_GEMM2, OP_RW_CHA, OP_RW_CHB, OP_RW_CHC, OP_RW_CHD, OP_RW_OUT,
    OP_LN1, OP_MOE_SCATTER, OP_MOE_GEMM1, OP_MOE_GEMM2, OP_LN2,
    OP_MB_GEMM_IN, OP_MB_CONV, OP_MB_STATES, OP_MB_SCAN, OP_MB_OUT, OP_MB_GEMM_OUT,
    OP_GL_GEMM_IN, OP_GL_KV, OP_GL_SCAN, OP_GL_OUT, OP_GL_GEMM_OUT };


DEV ConvJob make_job(const Params& p, int q) {
    const long long DD = (long long)D * D;
    switch (q) {
    case 0: return ConvJob{p.rw_w_rkv, WS_(p, rw_rkv_t), 1024, 1024, 1024, 1024, 1024, 0 | 2 * PF(0), 6, DD, DD};
    case 1: return ConvJob{p.rw_w1, WS_(p, rw_w1_t), 1024, 64, 64, 1024, 256, 0 | 2 * PF(1), 2, (long long)D * 64, (long long)256 * D};
    case 2: return ConvJob{p.rw_a1, WS_(p, rw_a1_t), 1024, 64, 64, 1024, 256, 0 | 2 * PF(1), 2, (long long)D * 64, (long long)256 * D};
    case 3: return ConvJob{p.rw_g1, WS_(p, rw_g1_t), 1024, 160, 160, 1024, 256, 0 | 2 * PF(1), 2, (long long)D * 160, (long long)256 * D};
    case 4: return ConvJob{p.rw_w2, WS_(p, rw_w2_t), 64, 1024, 1024, 256, 1024, 0 | 2 * PF(2), 2, (long long)64 * D, (long long)D * 256};
    case 5: return ConvJob{p.rw_a2, WS_(p, rw_a2_t), 64, 1024, 1024, 256, 1024, 0 | 2 * PF(2), 2, (long long)64 * D, (long long)D * 256};
    case 6: return ConvJob{p.rw_g2, WS_(p, rw_g2_t), 160, 1024, 1024, 256, 1024, 0 | 2 * PF(2), 2, (long long)160 * D, (long long)D * 256};
    case 7: return ConvJob{p.rw_w_o, WS_(p, rw_wo_t), 1024, 1024, 1024, 1024, 1024, 0 | 2 * PF(3), 2, DD, DD};
    case 8: return ConvJob{p.mb_w_in, WS_(p, mb_win_t), 1024, 5120, 5152, 1024, 5120, 0 | 2 * PF(4), 1, 0, 0};
    case 9: return ConvJob{p.mb_w_out, WS_(p, mb_wout_t), 2048, 1024, 1024, 2048, 1024, 0 | 2 * PF(3), 1, 0, 0};
    case 10: return ConvJob{p.gl_w_in, WS_(p, gl_win_t), 1024, 3072, 3088, 1024, 3072, 0 | 2 * PF(5), 1, 0, 0};
    case 11: return ConvJob{p.gl_w_out, WS_(p, gl_wout_t), 1024, 1024, 1024, 1024, 1024, 0 | 2 * PF(3), 1, 0, 0};
    case 12: return ConvJob{p.moe_w_in, WS_(p, moe_w1_t), 1024, 1024, 1024, 1024, 1024, 1 | 2 * PF(6), MOE_SPLIT, DD, DD};
    case 13: return ConvJob{p.moe_w_down, WS_(p, moe_w2_t), 512, 1024, 1024, 512, 1024, 0 | 2 * PF(7), MOE_SPLIT, (long long)512 * 1024, (long long)1024 * 512};
    case 14: return ConvJob{p.moe_w_in + (size_t)MOE_SPLIT * DD, WS_(p, moe_w1_t) + (size_t)MOE_SPLIT * DD, 1024, 1024, 1024, 1024, 1024, 1 | 2 * PF(6), 128 - MOE_SPLIT, DD, DD};
    default: return ConvJob{p.moe_w_down + (size_t)MOE_SPLIT * 512 * 1024, WS_(p, moe_w2_t) + (size_t)MOE_SPLIT * 512 * 1024, 512, 1024, 1024, 512, 1024, 0 | 2 * PF(7), 128 - MOE_SPLIT, (long long)512 * 1024, (long long)1024 * 512};
    }
}

DEV void convert_tile(const ConvJob& J, LAS bf16_t* tile, int local, int lane) {
    const int tk = J.Kpad / 64, tn = J.Npad / 64;
    const int b = local / (tk * tn); local -= b * tk * tn;
    const int nt = local / tk, kt = local - nt * tk;
    const float* src = J.src + (size_t)b * J.src_bs;
    bf16_t* dst = J.dst + (size_t)b * J.dst_bs;
    const int k0 = kt * 64, n0 = nt * 64;
    const int nn = (lane & 15) * 4; const bool nok = n0 + nn < J.N;
    f32x4 v[16];
#pragma unroll
    for (int i = 0; i < 16; ++i) { const int kk = (lane >> 4) + 4 * i; v[i] = (nok && k0 + kk < J.K) ? *(const f32x4*)(src + (size_t)(k0 + kk) * J.src_ld + n0 + nn) : (f32x4){0.f, 0.f, 0.f, 0.f}; }
#pragma unroll
    for (int i = 0; i < 16; ++i) { const int kk = (lane >> 4) + 4 * i;
#pragma unroll
        for (int e = 0; e < 4; ++e) tile[(nn + e) * 72 + kk] = (bf16_t)f2bf(v[i][e]); }
#pragma unroll
    for (int i = 0; i < 8; ++i) { const int r = (lane >> 3) + 8 * i, kc = (lane & 7) * 8;
        int nsrc = n0 + r, ndst = nsrc;
        if (J.perm & 1) { const int up = nsrc >= 512, jj = nsrc - (up ? 512 : 0); ndst = (jj >> 7) * 256 + (up ? 128 : 0) + (jj & 127); }
        if (J.perm & 2) { const int cc = ndst & 31; ndst = (ndst & ~31) | (((cc >> 2) & 1) << 4) | ((cc >> 3) << 2) | (cc & 3); }
        *(u32x4*)(dst + (size_t)ndst * J.Kpad + k0 + kc) = *(const LAS u32x4*)(tile + r * 72 + kc); }
}
DEV void convert_one(const ConvJob& J, LAS unsigned char* lds, int B0, int NBW, int tbeg, int WL = 8) {
    const int tid = tid_(), bid = bid_();
    const int lane = tid & 63, wv = tid >> 6; const int gw = (bid - B0) * WL + wv, NW = NBW * WL;
    if (wv >= WL) return;
    LAS bf16_t* tile = (LAS bf16_t*)lds + wv * (64 * 72);
    const int jend = tbeg + J.ntiles();
    const int ti0 = tbeg + ((gw - tbeg) % NW + NW) % NW;
#pragma unroll 1
    for (int ti = ti0; ti < jend; ti += NW) convert_tile(J, tile, ti - tbeg, lane);
}
DEV void convert_tickets(const ConvJob& J0, const ConvJob& J1, LAS unsigned char* lds, unsigned* ctrs, int stride) {
    constexpr int NG = 32;
    const int tid = tid_(); const int lane = tid & 63, wv = tid >> 6; const int g = bid_() & (NG - 1);
    unsigned* ctr = ctrs + g * stride;
    LAS bf16_t* tile = (LAS bf16_t*)lds + wv * (64 * 72);
    const int n0 = J0.ntiles(), n = n0 + J1.ntiles();
    int cur = 0; if (lane == 0) cur = (int)__hip_atomic_fetch_add(ctr, 1u, __ATOMIC_RELAXED, __HIP_MEMORY_SCOPE_AGENT);
    cur = __builtin_amdgcn_readfirstlane(cur) * NG + g;
#pragma unroll 1
    while (cur < n) {
        int nx = 0; if (lane == 0) nx = (int)__hip_atomic_fetch_add(ctr, 1u, __ATOMIC_RELAXED, __HIP_MEMORY_SCOPE_AGENT);
        const bool first = cur < n0; const ConvJob J = first ? J0 : J1;
        convert_tile(J, tile, first ? cur : cur - n0, lane);
        cur = __builtin_amdgcn_readfirstlane(nx) * NG + g;
    }
}
template <int J0, int J1> DEV int convert_jobs(const Params& p, LAS unsigned char* lds, int B0, int NBW, int tbeg = 0, int WL = 8) {
#pragma unroll
    for (int j = J0; j < J1; ++j) { const ConvJob J = make_job(p, j); convert_one(J, lds, B0, NBW, tbeg, WL); tbeg += J.ntiles(); }
    return tbeg;
}
DEV ConvJob moe_job(const Params& p, int which, int ml) {
    const long long DD = (long long)D * D; const size_t b0 = (size_t)ml * 32;
    if (which == 0) return ConvJob{p.moe_w_in + b0 * DD, WS_(p, moe_w1_t) + b0 * DD, 1024, 1024, 1024, 1024, 1024, 1 | 2 * PF(6), 32, DD, DD};
    return ConvJob{p.moe_w_down + b0 * 512 * 1024, WS_(p, moe_w2_t) + b0 * 512 * 1024, 512, 1024, 1024, 512, 1024, 0 | 2 * PF(7), 32, (long long)512 * 1024, (long long)1024 * 512};
}
DEV void phase_convert(const Params& p, LAS unsigned char* lds) {
    const int tid = tid_(), bid = bid_();
    if (bid == 1 && tid < 5 * 32) __hip_atomic_store(WS_(p, MFLAG) + (MFLAG_SIDE + tid) * MFLAG_STRIDE, 0u, __ATOMIC_RELAXED, __HIP_MEMORY_SCOPE_AGENT);
    convert_jobs<0, 8>(p, lds, 0, NB_);
    if (bid < 4 * 48) { const int layer = bid / 48, o = bid % 48;
        for (int k = tid; k < D; k += NTHR) { float v = 0.f;
            if (o < 32) v = p.moe_w_route[((size_t)layer * D + k) * 32 + o]; else if (o < 36) v = p.moe_w_group[((size_t)layer * D + k) * 4 + (o - 32)];
            WS_(p, moe_wr_t)[((size_t)layer * 48 + o) * D + k] = (bf16_t)f2bf(v); } }
    else if (bid < 4 * 48 + 32) { const int o = bid - 192;
        for (int k = tid; k < D; k += NTHR) WS_(p, mb_dt_t)[(size_t)o * D + k] = (bf16_t)f2bf(p.mb_w_in[(size_t)k * 5152 + 5120 + o]); }
    else if (bid < 4 * 48 + 48) { const int o = bid - 224;
        for (int k = tid; k < D; k += NTHR) WS_(p, gl_lr_t)[(size_t)o * D + k] = (bf16_t)f2bf(p.gl_w_in[(size_t)k * 3088 + 3072 + o]); }
}
namespace pg8 {
constexpr int BM = 256, BK = 64, HALF = 128, HTB = HALF * BK * 2, STAGE_BYTES = 8 * HTB;
DEV int lds_byte(int r, int c) { const int st = (r >> 4) * 2 + (c >> 5), rr = r & 15, cc = c & 31, ob = rr * 64 + cc * 2; return st * 1024 + (ob ^ (((ob >> 9) & 1) << 5)); }
DEV void stage_rc(int b, int& R, int& C) { const int st = b / 1024, sb = b % 1024, swz = sb ^ (((sb >> 9) & 1) << 5); R = (st >> 1) * 16 + swz / 64; C = (st & 1) * 32 + (swz % 64) / 2; }

struct Unit { const char* A; const char* B; int row0, col0, id, aux; };

DEV bool tile_order(int i, int G, int c, int nM, int nN, int& pm, int& pn) {
    const int nwg = nM * nN; const long L = (long)i * G + c; if (L >= nwg) return false;
    int wgid = (int)L; { const int q = nwg / 8, r = nwg % 8, xcd = wgid % 8, off = wgid / 8; wgid = (xcd < r ? xcd * (q + 1) : r * (q + 1) + (xcd - r) * q) + off; }
    const int nig = 8 * nN, gid = wgid / nig, fm = gid * 8, gsz = (nM - fm) < 8 ? (nM - fm) : 8;
    pm = fm + ((wgid % nig) % gsz); pn = (wgid % nig) / gsz; return true;
}

template <class Epi, class Sched>
DEV void gemm_phase(LAS unsigned char* lds, const int K, const Sched& S, const Epi& E) {
    const int tid = tid_(), wid = __builtin_amdgcn_readfirstlane(tid >> 6), lane = tid & 63, wr = wid >> 2, wc = wid & 3, fr = lane & 15, fq = lane >> 4;
    const int nt = K / BK;
    unsigned voff[2];
#pragma unroll
    for (int i = 0; i < 2; ++i) { int R, C; stage_rc(tid * 16 + i * 8192, R, C); voff[i] = (unsigned)(R * K + C) * 2u; }
    const size_t kstep = (size_t)(BK * 2);
    const size_t hstep = (size_t)HALF * K * 2;
    const unsigned ldsw = (unsigned)wid * 1024u;
    const int aoff = lds_byte(wr * 64 + fr, fq * 8), boff = lds_byte(wc * 32 + fr, fq * 8);
#define PG8_SA(b, h) (((b) * 2 + (h)) * HTB)
#define PG8_SB(b, h) ((4 + (b) * 2 + (h)) * HTB)
#define PG8_STAGE(bufoff, gbase) do { _Pragma("unroll") for (int _i = 0; _i < 2; ++_i) \
        __builtin_amdgcn_global_load_lds((const unsigned*)((const char*)(gbase) + voff[_i]), (LAS unsigned*)(lds + (bufoff) + ldsw + _i * 8192), 16, 0, 0); } while (0)
#define PG8_LDA(dst, b, h) do { _Pragma("unroll") for (int m = 0; m < 4; ++m) _Pragma("unroll") for (int k = 0; k < 2; ++k) dst[m][k] = *(const LAS bf16x8*)(lds + PG8_SA(b, h) + aoff + m * 2048 + k * 1024); } while (0)
#define PG8_LDB(dst, b, h) do { _Pragma("unroll") for (int n = 0; n < 2; ++n) _Pragma("unroll") for (int k = 0; k < 2; ++k) dst[n][k] = *(const LAS bf16x8*)(lds + PG8_SB(b, h) + boff + n * 2048 + k * 1024); } while (0)
#define PG8_MMA(ai, bj, At, Bt) do { __builtin_amdgcn_s_setprio(1); _Pragma("unroll") for (int m = 0; m < 4; ++m) _Pragma("unroll") for (int n = 0; n < 2; ++n) _Pragma("unroll") for (int k = 0; k < 2; ++k) \
        acc[ai][bj][m][n] = __builtin_amdgcn_mfma_f32_16x16x32_bf16(Bt[n][k], At[m][k], acc[ai][bj][m][n], 0, 0, 0); __builtin_amdgcn_s_setprio(0); } while (0)
#define PG8_WAIT_V(n) asm volatile("s_waitcnt vmcnt(" #n ")" ::: "memory")
#define PG8_WAIT_L(n) asm volatile("s_waitcnt lgkmcnt(" #n ")" ::: "memory")
#define PG8_BAR __builtin_amdgcn_s_barrier()
#define PG8_SCHED __builtin_amdgcn_sched_barrier(0)
    Unit cur, nxt; int ui = 0;
    if (!S.next(0, cur)) return;
    f32x4 acc[2][2][4][2];
#pragma unroll
    for (int a = 0; a < 2; ++a)
#pragma unroll
        for (int b = 0; b < 2; ++b)
#pragma unroll
            for (int m = 0; m < 4; ++m)
#pragma unroll
                for (int n = 0; n < 2; ++n) acc[a][b][m][n] = (f32x4){0.f, 0.f, 0.f, 0.f};
    bf16x8 At[4][2], B0[2][2], B1[2][2];
    const char* cA = cur.A; const char* cB = cur.B;
    PG8_STAGE(PG8_SB(0, 0), cB); PG8_STAGE(PG8_SA(0, 0), cA); PG8_STAGE(PG8_SB(0, 1), cB + hstep); PG8_STAGE(PG8_SA(0, 1), cA + hstep);
    if (wr == 1) PG8_BAR;
    PG8_WAIT_V(4); PG8_BAR;
    PG8_STAGE(PG8_SB(1, 0), cB + kstep); PG8_STAGE(PG8_SA(1, 0), cA + kstep); PG8_STAGE(PG8_SB(1, 1), cB + hstep + kstep);
    PG8_WAIT_V(6); PG8_BAR;
    for (;;) {
        const bool has_next = S.next(ui + 1, nxt);
        const char* nA = has_next ? nxt.A : cA; const char* nB = has_next ? nxt.B : cB;
#pragma unroll 1
        for (int t = 0; t < nt; t += 2) {
            const bool last = (t == nt - 2);
            const char* a1 = cA + (size_t)(t + 1) * kstep;
            const char* a2 = last ? nA : cA + (size_t)(t + 2) * kstep; const char* b2 = last ? nB : cB + (size_t)(t + 2) * kstep;
            const char* a3 = a2 + kstep; const char* b3 = b2 + kstep;
            PG8_LDB(B0, 0, 0); PG8_SCHED; PG8_LDA(At, 0, 0); PG8_STAGE(PG8_SA(1, 1), a1 + hstep);
            PG8_WAIT_L(8); PG8_BAR; PG8_WAIT_L(0); PG8_MMA(0, 0, At, B0); PG8_BAR; PG8_SCHED;
            PG8_LDB(B1, 0, 1); PG8_STAGE(PG8_SB(0, 0), b2);
            PG8_BAR; PG8_WAIT_L(0); PG8_MMA(0, 1, At, B1); PG8_BAR;
            PG8_LDA(At, 0, 1); PG8_STAGE(PG8_SA(0, 0), a2);
            PG8_BAR; PG8_WAIT_L(0); PG8_MMA(1, 0, At, B0); PG8_BAR; PG8_SCHED;
            PG8_STAGE(PG8_SB(0, 1), b2 + hstep);
            PG8_WAIT_V(6); PG8_BAR; PG8_MMA(1, 1, At, B1); PG8_BAR;
            PG8_LDB(B0, 1, 0); PG8_SCHED; PG8_LDA(At, 1, 0); PG8_STAGE(PG8_SA(0, 1), a2 + hstep);
            PG8_WAIT_L(8); PG8_BAR; PG8_WAIT_L(0); PG8_MMA(0, 0, At, B0); PG8_BAR; PG8_SCHED;
            PG8_LDB(B1, 1, 1); PG8_STAGE(PG8_SB(1, 0), b3);
            PG8_BAR; PG8_WAIT_L(0); PG8_MMA(0, 1, At, B1); PG8_BAR;
            PG8_LDA(At, 1, 1); PG8_STAGE(PG8_SA(1, 0), a3);
            PG8_BAR; PG8_WAIT_L(0); PG8_MMA(1, 0, At, B0); PG8_BAR; PG8_SCHED;
            PG8_STAGE(PG8_SB(1, 1), b3 + hstep);
            PG8_WAIT_V(6); PG8_BAR; PG8_MMA(1, 1, At, B1); PG8_BAR;
        }
        E(acc, cur, wr, wc, fr, fq);
        if (!has_next) break;
#pragma unroll
        for (int a = 0; a < 2; ++a)
#pragma unroll
            for (int b = 0; b < 2; ++b)
#pragma unroll
                for (int m = 0; m < 4; ++m)
#pragma unroll
                    for (int n = 0; n < 2; ++n) acc[a][b][m][n] = (f32x4){0.f, 0.f, 0.f, 0.f};
        cur = nxt; cA = nA; cB = nB; ++ui;
    }
    PG8_WAIT_V(0);
    if (wr == 0) PG8_BAR;
    PG8_BAR;
#undef PG8_SA
#undef PG8_SB
#undef PG8_STAGE
#undef PG8_LDA
#undef PG8_LDB
#undef PG8_MMA
#undef PG8_WAIT_V
#undef PG8_WAIT_L
#undef PG8_BAR
#undef PG8_SCHED
}
}
using pg8::Unit;
typedef f32x4 AccT[2][2][4][2];
#define FOR_ACC(ai, bj, m, n) _Pragma("unroll") for (int ai = 0; ai < 2; ++ai) _Pragma("unroll") for (int m = 0; m < 4; ++m) _Pragma("unroll") for (int bj = 0; bj < 2; ++bj) _Pragma("unroll") for (int n = 0; n < 2; ++n)
#define ACC_FENCE __builtin_amdgcn_sched_barrier(0)
#define ACC_ROW(u, ai, m) ((u).row0 + 128 * (ai) + 64 * wr + 16 * (m) + fr)
#define ACC_COLP(u, bj, n, P) ((P) ? ((u).col0 + 128 * (bj) + 32 * wc + 8 * fq + 4 * (n)) : ((u).col0 + 128 * (bj) + 32 * wc + 16 * (n) + 4 * fq))
#define ACC_COL8P(u, bj, P) ACC_COLP(u, bj, 0, P)
#define FOR_ACC2(ai, bj, m) _Pragma("unroll") for (int ai = 0; ai < 2; ++ai) _Pragma("unroll") for (int m = 0; m < 4; ++m) _Pragma("unroll") for (int bj = 0; bj < 2; ++bj)
DEV void st_bf4(bf16_t* p, f32x4 v) { u32x2 w; w.x = pk2(v[0], v[1]); w.y = pk2(v[2], v[3]); *(u32x2*)p = w; }
DEV u32x4 pk8v(f32x4 a, f32x4 b) { u32x4 w; w.x = pk2(a[0], a[1]); w.y = pk2(a[2], a[3]); w.z = pk2(b[0], b[1]); w.w = pk2(b[2], b[3]); return w; }
#ifdef ST8
DEV void st_bf8p(bf16_t* p, f32x4 a, f32x4 b, bool P) { if (P) { st_bf4(p, a); st_bf4(p + 4, b); } else { st_bf4(p, a); st_bf4(p + 16, b); } }
#else
DEV void st_bf8p(bf16_t* p, f32x4 a, f32x4 b, bool P) { if (P) *(u32x4*)p = pk8v(a, b); else { st_bf4(p, a); st_bf4(p + 16, b); } }
#endif
DEV void load_row(const float* p, int lane, f32x4 (&v)[4]) {
#pragma unroll
    for (int q = 0; q < 4; ++q) v[q] = *(const f32x4*)(p + RCOL(q, lane));
}

DEV void load_row_bf(const bf16_t* p, int lane, f32x4 (&v)[4]) {
#pragma unroll
    for (int q = 0; q < 4; ++q) { const u32x2 a = *(const u32x2*)(p + RCOL(q, lane)); v[q] = (f32x4){bflo(a.x), bfhi(a.x), bflo(a.y), bfhi(a.y)}; }
}
DEV void store_row_bf(bf16_t* p, int lane, const f32x4 (&v)[4]) {
#pragma unroll
    for (int q = 0; q < 4; ++q) st_bf4(p + RCOL(q, lane), v[q]);
}
DEV void emit_mix6(const Params& p, int j, int t, int lane, const f32x4 (&x)[4], const f32x4 (&xp)[4]) {
    const float* mu = p.rw_mu + (size_t)j * 6 * D;
#pragma unroll
    for (int s = 0; s < 6; ++s) {
#pragma unroll
        for (int q = 0; q < 4; ++q) {
            const f32x4 m = *(const f32x4*)(mu + s * D + RCOL(q, lane));
            st_bf4(WS_(p, X6) + (size_t)s * T * D + (size_t)t * D + RCOL(q, lane), x[q] + (xp[q] - x[q]) * m);
        }
        __builtin_amdgcn_sched_barrier(0);
    }
}
DEV void phase_pre0(const Params& p) {
    const int tid = tid_(), bid = bid_(); const int lane = tid & 63, wid = tid >> 6;
    f32x4 x[4], xp[4];
    const int tfirst = bid * 64 + wid * 8;
    if (tfirst > 0) load_row(p.x + (size_t)(tfirst - 1) * D, lane, xp); else { for (int q = 0; q < 4; ++q) xp[q] = (f32x4){0.f, 0.f, 0.f, 0.f}; }
    f32x4 xn[4]; load_row(p.x + (size_t)tfirst * D, lane, xn);
#pragma unroll 1
    for (int r = 0; r < 8; ++r) {
        const int t = tfirst + r;
#pragma unroll
        for (int q = 0; q < 4; ++q) x[q] = xn[q];
        load_row(p.x + (size_t)(r < 7 ? t + 1 : t) * D, lane, xn);
        store_row_bf(WS_(p, Hb) + (size_t)t * D, lane, x);
        emit_mix6(p, 0, t, lane, x, xp);
#pragma unroll
        for (int q = 0; q < 4; ++q) xp[q] = x[q];
    }
}

struct SchedRW1 {
    const Params* p; int j;
    DEV bool next(int i, Unit& u) const {
        int pm, pn; if (!pg8::tile_order(i, NB_, bid_(), 64, 15, pm, pn)) return false;
        int id, lpn; if (pn < 12) { id = pn >> 2; lpn = pn & 3; } else { id = 3 + (pn - 12); lpn = 0; }
        u.A = (const char*)(WS_(*p, X6) + (size_t)id * T * D + (size_t)pm * 256 * D);
        const bf16_t* B;
        if (id < 3) B = WS_(*p, rw_rkv_t) + ((size_t)j * 3 + id) * D * D + (size_t)lpn * 256 * D;
        else B = WS_(*p, rw_w1_t) + (size_t)(id - 3) * (2 * 256 * D) + (size_t)j * 256 * D;
        u.B = (const char*)B; u.row0 = pm * 256; u.col0 = lpn * 256; u.id = id; u.aux = 0; return true;
    }
};
struct EpiRW1 {
    const Params* p;
    DEV void operator()(const AccT& acc, const Unit& u, int wr, int wc, int fr, int fq) const {
        if (u.id < 3) {
            bf16_t* O = WS_(*p, Rb) + (size_t)u.id * 2 * T * D;
            FOR_ACC2(ai, bj, m) { st_bf8p(O + (size_t)ACC_ROW(u, ai, m) * D + ACC_COL8P(u, bj, PF(0)), acc[ai][bj][m][0], acc[ai][bj][m][1], PF(0)); ACC_FENCE; }
        } else {
            bf16_t* O = WS_(*p, LW) + (size_t)(u.id - 3) * T * 256;
            FOR_ACC2(ai, bj, m) {
                f32x4 v0 = acc[ai][bj][m][0], v1 = acc[ai][bj][m][1];
                if (u.id == 3) { for (int e = 0; e < 4; ++e) { v0[e] = tanhf_(v0[e]); v1[e] = tanhf_(v1[e]); } }
                else if (u.id == 5) { for (int e = 0; e < 4; ++e) { v0[e] = sigmoidf_(v0[e]); v1[e] = sigmoidf_(v1[e]); } }
                st_bf8p(O + (size_t)ACC_ROW(u, ai, m) * 256 + ACC_COL8P(u, bj, PF(1)), v0, v1, PF(1)); ACC_FENCE;
            }
        }
    }
};
struct SchedRW2 {
    const Params* p; int j;
    DEV bool next(int i, Unit& u) const {
        int pm, pn; if (!pg8::tile_order(i, NB_, bid_(), 64, 12, pm, pn)) return false;
        const int id = pn >> 2, lpn = pn & 3;
        u.A = (const char*)(WS_(*p, LW) + (size_t)id * T * 256 + (size_t)pm * 256 * 256);
        const bf16_t* B = WS_(*p, rw_w2_t) + (size_t)id * (2 * D * 256) + (size_t)j * D * 256 + (size_t)lpn * 256 * 256;
        u.B = (const char*)B; u.row0 = pm * 256; u.col0 = lpn * 256; u.id = id; u.aux = 0; return true;
    }
};
struct EpiRW2 {
    const Params* p; int j;
    DEV void operator()(const AccT& acc, const Unit& u, int wr, int wc, int fr, int fq) const {
        if (u.id == 0) { const float* bias = p->rw_w0 + (size_t)j * D; f32x4 bv[2][2];
#pragma unroll
            for (int bj = 0; bj < 2; ++bj)
#pragma unroll
                for (int n = 0; n < 2; ++n) bv[bj][n] = *(const f32x4*)(bias + ACC_COLP(u, bj, n, PF(2)));
            FOR_ACC2(ai, bj, m) { f32x4 vv[2];
#pragma unroll
                for (int n = 0; n < 2; ++n) { f32x4 v = acc[ai][bj][m][n]; const f32x4 b = bv[bj][n];
                    for (int e = 0; e < 4; ++e) { const float x = -(b[e] + v[e]); const float wl = -(fmaxf(x, 0.f) + __logf(1.0f + __expf(-fabsf(x)))) - 0.5f; v[e] = -__expf(wl); }
                    vv[n] = v; }
                st_bf8p(WS_(*p, Wb) + (size_t)ACC_ROW(u, ai, m) * D + ACC_COL8P(u, bj, PF(2)), vv[0], vv[1], PF(2)); ACC_FENCE; } }
        else if (u.id == 1) { const float* bias = p->rw_a0 + (size_t)j * D; f32x4 bv[2][2];
#pragma unroll
            for (int bj = 0; bj < 2; ++bj)
#pragma unroll
                for (int n = 0; n < 2; ++n) bv[bj][n] = *(const f32x4*)(bias + ACC_COLP(u, bj, n, PF(2)));
            FOR_ACC2(ai, bj, m) { f32x4 vv[2];
#pragma unroll
                for (int n = 0; n < 2; ++n) { f32x4 v = acc[ai][bj][m][n]; const f32x4 b = bv[bj][n];
                    for (int e = 0; e < 4; ++e) v[e] = sigmoidf_(b[e] + v[e]);
                    vv[n] = v; }
                st_bf8p(WS_(*p, Ab) + (size_t)ACC_ROW(u, ai, m) * D + ACC_COL8P(u, bj, PF(2)), vv[0], vv[1], PF(2)); ACC_FENCE; } }
        else { FOR_ACC2(ai, bj, m) { st_bf8p(WS_(*p, Gb) + (size_t)ACC_ROW(u, ai, m) * D + ACC_COL8P(u, bj, PF(2)), acc[ai][bj][m][0], acc[ai][bj][m][1], PF(2)); ACC_FENCE; } }
    }
};

struct SchedOut {
    const bf16_t* A; const bf16_t* Bt; int K;
    DEV bool next(int i, Unit& u) const {
        int pm, pn; if (!pg8::tile_order(i, NB_, bid_(), 64, 4, pm, pn)) return false;
        u.A = (const char*)(A + (size_t)pm * 256 * K); u.B = (const char*)(Bt + (size_t)pn * 256 * K); u.row0 = pm * 256; u.col0 = pn * 256; u.id = 0; u.aux = 0; return true;
    }
};
struct EpiOut {
    bf16_t* O;
    DEV void operator()(const AccT& acc, const Unit& u, int wr, int wc, int fr, int fq) const {
        FOR_ACC2(ai, bj, m) { st_bf8p(O + (size_t)ACC_ROW(u, ai, m) * D + ACC_COL8P(u, bj, PF(3)), acc[ai][bj][m][0], acc[ai][bj][m][1], PF(3)); ACC_FENCE; }
    }
};
constexpr int RC_LD = 72;
#ifdef DBG
#define DBGF(cond, bit) do { if (cond) atomicOr(&WS_(p, TAB)[200], (bit)); } while (0)
#else
#define DBGF(cond, bit) do {} while (0)
#endif
DEV bool bad_(float x) { return !(fabsf(x) < 1e30f); }
DEV int rc_pi(int g, int j) { return j < 4 ? 4 * g + j : 16 + 4 * g + (j - 4); }

DEV void rc_load_wd(const Params& p, int t0, int cb, float (&wd)[8]) {
    const int tid = tid_(); const int k = tid & 63, sg = tid >> 6;
#pragma unroll
    for (int i = 0; i < 8; ++i) wd[i] = bf2f(WS_(p, Wb)[(size_t)(t0 + sg * 8 + i) * D + cb + k]);
}
DEV void rc_cum_regs(const float (&wd)[8], LAS float* cum, LAS float* seg) {
    const int tid = tid_(); const int k = tid & 63, sg = tid >> 6;
    float v[8]; float s = 0.f;
#pragma unroll
    for (int i = 0; i < 8; ++i) { s += wd[i]; v[i] = s; }
    seg[sg * 64 + k] = s;
    lds_barrier();
    float off = 0.f;
#pragma unroll
    for (int q = 0; q < 8; ++q) off += (q < sg) ? seg[q * 64 + k] : 0.f;
#pragma unroll
    for (int i = 0; i < 8; ++i) cum[(sg * 8 + i) * 64 + k] = v[i] + off;
    lds_barrier();
}
DEV void ld8b(const bf16_t* p, float (&f)[8]) { const u32x4 v = *(const u32x4*)p; f[0] = bflo(v.x); f[1] = bfhi(v.x); f[2] = bflo(v.y); f[3] = bfhi(v.y); f[4] = bflo(v.z); f[5] = bfhi(v.z); f[6] = bflo(v.w); f[7] = bfhi(v.w); }
DEV void ld8(const float* p, float (&f)[8]) { const f32x4 a = *(const f32x4*)p, b = *(const f32x4*)(p + 4); f[0] = a[0]; f[1] = a[1]; f[2] = a[2]; f[3] = a[3]; f[4] = b[0]; f[5] = b[1]; f[6] = b[2]; f[7] = b[3]; }
DEV void lds8(const LAS float* p, float (&f)[8]) { const f32x4 a = *(const LAS f32x4*)p, b = *(const LAS f32x4*)(p + 4); f[0] = a[0]; f[1] = a[1]; f[2] = a[2]; f[3] = a[3]; f[4] = b[0]; f[5] = b[1]; f[6] = b[2]; f[7] = b[3]; }
DEV u32x4 pk8(const float (&f)[8]) { u32x4 o; o.x = pk2(f[0], f[1]); o.y = pk2(f[2], f[3]); o.z = pk2(f[4], f[5]); o.w = pk2(f[6], f[7]); return o; }

DEV bf16x8 frag_rm_pi(const LAS bf16_t* base, int ld, int row0, int k0, int lane) {
    const LAS bf16_t* a = base + (row0 + (lane & 15)) * ld + k0 + 4 * (lane >> 4);
    const s16x4 lo = *(const LAS s16x4*)a, hi = *(const LAS s16x4*)(a + 16);
    bf16x8 r; r[0] = lo[0]; r[1] = lo[1]; r[2] = lo[2]; r[3] = lo[3]; r[4] = hi[0]; r[5] = hi[1]; r[6] = hi[2]; r[7] = hi[3]; return r;
}
DEV void rc_prep8(const float (&k)[8], const float (&al)[8], const float (&kkw)[8], const float (&kaw)[8], float (&a)[8], float (&b)[8], float (&kh)[8]) {
    float kk[8]; float ss = 0.f;
#pragma unroll
    for (int e = 0; e < 8; ++e) { kk[e] = k[e] * kkw[e]; ss += kk[e] * kk[e]; }
    ss += __shfl_xor(ss, 1); ss += __shfl_xor(ss, 2); ss += __shfl_xor(ss, 4);
    const float inv = 1.0f / fmaxf(sqrtf(ss), 1e-12f);
#pragma unroll
    for (int e = 0; e < 8; ++e) { const float kn = kk[e] * inv; a[e] = -kn; b[e] = kn * al[e]; kh[e] = k[e] * (1.0f + (al[e] - 1.0f) * kaw[e]); }
}
constexpr int RW_NB = 64, RW_NW = NBLK - RW_NB;
DEV void phase_rw_cha(const Params& p, int jl, LAS unsigned char* lds, int half) {
    const int tid = tid_(), bid = bid_(); const int u0 = half * 2048 + (bid - RW_NB), ue = half * 2048 + 2048; const int lane = tid & 63, w = tid >> 6; const int fr = lane & 15, fq = lane >> 4;
    LAS float* cum = (LAS float*)lds;
    LAS float* seg = cum + 64 * 64;
    LAS float* Aab = seg + 8 * 64;
    LAS bf16_t* As = (LAS bf16_t*)(Aab + 64 * 68);
    LAS bf16_t* Bs = As + 64 * RC_LD; LAS bf16_t* Ks = Bs + 64 * RC_LD; LAS bf16_t* Vs = Ks + 64 * RC_LD; LAS bf16_t* Ke = Vs + 64 * RC_LD;
    LAS bf16_t* Aak = Ke + 64 * RC_LD; LAS bf16_t* Ts = Aak + 64 * RC_LD; LAS bf16_t* X1 = Ts + 64 * RC_LD; LAS bf16_t* Aabh = X1 + 64 * RC_LD;
    LAS bf16_t* Fimg = Aabh + 64 * RC_LD;
    LAS bf16_t* Wimg = Fimg + 4096;
    float pwd[8], pkr[8], pal[8], pv[8];
    float kkw[8], kaw[8];
    ld8(p.rw_k_k + (size_t)jl * D + (u0 & 15) * 64 + (tid & 7) * 8, kkw); ld8(p.rw_k_a + (size_t)jl * D + (u0 & 15) * 64 + (tid & 7) * 8, kaw);
    { const int c = u0 >> 4, h = u0 & 15; rc_load_wd(p, c * 64, h * 64, pwd);
      const size_t go = (size_t)(c * 64 + (tid >> 3)) * D + h * 64 + (tid & 7) * 8; ld8b(WS_(p, Kb) + go, pkr); ld8b(WS_(p, Ab) + go, pal); ld8b(WS_(p, Vb) + go, pv); }
    for (int u = u0; u < ue; u += RW_NW) {
        const int c = u >> 4, h = u & 15; const int t0 = c * 64, cb = h * 64; const size_t ub = (size_t)c * 16 + h;
        lds_barrier();
        rc_cum_regs(pwd, cum, seg);
        {
            const int t = tid >> 3, k8 = (tid & 7) * 8;
            float a[8], b[8], kh[8], v[8], ct[8], cp[8], ce[8];
            rc_prep8(pkr, pal, kkw, kaw, a, b, kh);
#pragma unroll
            for (int e = 0; e < 8; ++e) v[e] = pv[e];
            if (u + RW_NW < ue) { const int un = u + RW_NW; const int cn = un >> 4, hn = un & 15; rc_load_wd(p, cn * 64, hn * 64, pwd);
                const size_t gn = (size_t)(cn * 64 + t) * D + hn * 64 + k8; ld8b(WS_(p, Kb) + gn, pkr); ld8b(WS_(p, Ab) + gn, pal); ld8b(WS_(p, Vb) + gn, pv); }
            lds8(cum + t * 64 + k8, ct); lds8(cum + 63 * 64 + k8, ce);
            if (t > 0) lds8(cum + (t - 1) * 64 + k8, cp); else { for (int e = 0; e < 8; ++e) cp[e] = 0.f; }
            float at[8], bt[8], kt[8], be[8], ke[8];
#pragma unroll
            for (int e = 0; e < 8; ++e) { const float ei = __expf(-ct[e]), ee = __expf(ce[e] - ct[e]); at[e] = a[e] * __expf(cp[e]); bt[e] = b[e] * ei; kt[e] = kh[e] * ei; be[e] = b[e] * ee; ke[e] = kh[e] * ee; }
            *(LAS u32x4*)(As + t * RC_LD + k8) = pk8(at); *(LAS u32x4*)(Bs + t * RC_LD + k8) = pk8(bt); *(LAS u32x4*)(Ks + t * RC_LD + k8) = pk8(kt);
            *(LAS u32x4*)(Ke + t * RC_LD + k8) = pk8(ke); *(LAS u32x4*)(Vs + t * RC_LD + k8) = pk8(v);
            const int tq = t & 31, g = (tq & 15) >> 2, j = (tq & 3) + ((tq >> 4) << 2);
#pragma unroll
            for (int e = 0; e < 8; ++e) { const int k = k8 + e; Fimg[(((k >> 4) * 2 + (t >> 5)) * 64 + g * 16 + (k & 15)) * 8 + j] = (bf16_t)f2bf(be[e]); }
            *(LAS u32x4*)(Ts + tid * 8) = (u32x4){0u, 0u, 0u, 0u}; if (tid < 64) *(LAS u32x4*)(Ts + (512 + tid) * 8) = (u32x4){0u, 0u, 0u, 0u};
            if (t == 63) { float gm[8]; for (int e = 0; e < 8; ++e) gm[e] = __expf(ce[e]); *(f32x4*)(WS_(p, RGc) + ub * 64 + k8) = (f32x4){gm[0], gm[1], gm[2], gm[3]}; *(f32x4*)(WS_(p, RGc) + ub * 64 + k8 + 4) = (f32x4){gm[4], gm[5], gm[6], gm[7]}; }
        }
        lds_barrier();
        {
            const int tb = w >> 1;
#pragma unroll
            for (int ii = 0; ii < 2; ++ii) { const int ib = 2 * (w & 1) + ii;
                f32x4 ab = {0.f, 0.f, 0.f, 0.f}, ak = {0.f, 0.f, 0.f, 0.f};
                if (ib <= tb) {
#pragma unroll
                    for (int ks = 0; ks < 2; ++ks) { const bf16x8 af = frag_rm(As, RC_LD, 16 * tb, 32 * ks, lane);
                        ab = MFMA16(af, frag_rm(Bs, RC_LD, 16 * ib, 32 * ks, lane), ab); ak = MFMA16(af, frag_rm(Ks, RC_LD, 16 * ib, 32 * ks, lane), ak); } }
#pragma unroll
                for (int r = 0; r < 4; ++r) { const int t = 16 * tb + 4 * fq + r, i = 16 * ib + fr; const bool keep = i < t;
                    Aab[t * 68 + i] = keep ? ab[r] : 0.f; Aabh[t * RC_LD + i] = (bf16_t)f2bf(keep ? ab[r] : 0.f); Aak[t * RC_LD + i] = (bf16_t)f2bf(keep ? ak[r] : 0.f); } }
            *(u32x4*)(WS_(p, RBf) + ub * 4096 + tid * 8) = *(const LAS u32x4*)(Fimg + tid * 8);
        }
        lds_barrier();
        if (w == 0) {
            const int blk = lane >> 4, jc = lane & 15;
            float Tc[16];
#pragma unroll
            for (int t = 0; t < 16; ++t) {
                float acc = jc == t ? 1.f : 0.f;
#pragma unroll
                for (int i4 = 0; i4 < (t + 3) / 4; ++i4) { const f32x4 a4 = *(const LAS f32x4*)(Aab + (16 * blk + t) * 68 + 16 * blk + i4 * 4);
#pragma unroll
                    for (int e = 0; e < 4; ++e) if (i4 * 4 + e < t) acc += a4[e] * Tc[i4 * 4 + e]; }
                Tc[t] = acc;
            }
#pragma unroll
            for (int t = 0; t < 16; ++t) Ts[(16 * blk + t) * RC_LD + 16 * blk + jc] = (bf16_t)f2bf(Tc[t]);
#pragma unroll
            for (int b = 1; b < 4; ++b) {
                const s16x4 dlo = *(const LAS s16x4*)(Ts + (16 * b + fr) * RC_LD + 16 * b + 4 * fq);
                bf16x8 dfr; dfr[0] = dlo[0]; dfr[1] = dlo[1]; dfr[2] = dlo[2]; dfr[3] = dlo[3]; dfr[4] = 0; dfr[5] = 0; dfr[6] = 0; dfr[7] = 0;
                f32x4 tt_[3];
#pragma unroll
                for (int cbk = 0; cbk < b; ++cbk) {
                    f32x4 x = {0.f, 0.f, 0.f, 0.f};
#pragma unroll
                    for (int ks = 0; ks < 2; ++ks) x = MFMA16(frag_rm(Aabh, RC_LD, 16 * b, 32 * ks, lane), frag_tr(Ts, RC_LD, 32 * ks, 16 * cbk, lane), x);
                    u32x4 xb; xb.x = pk2(x[0], x[1]); xb.y = pk2(x[2], x[3]); xb.z = 0u; xb.w = 0u;
                    tt_[cbk] = MFMA16(dfr, __builtin_bit_cast(bf16x8, xb), ((f32x4){0.f, 0.f, 0.f, 0.f}));
                }
#pragma unroll
                for (int cbk = 0; cbk < b; ++cbk)
#pragma unroll
                    for (int r = 0; r < 4; ++r) Ts[(16 * b + 4 * fq + r) * RC_LD + 16 * cbk + fr] = (bf16_t)f2bf(tt_[cbk][r]);
            }
        } else {
            for (int tl = w - 1; tl < 32; tl += 7) {
                const int rb = (tl & 15) >> 2, vbk = tl & 3; f32x4 acc = {0.f, 0.f, 0.f, 0.f};
                if (tl < 16) {
#pragma unroll
                    for (int ks = 0; ks < 2; ++ks) acc = MFMA16(frag_rm(Aak, RC_LD, 16 * rb, 32 * ks, lane), frag_tr(Vs, RC_LD, 32 * ks, 16 * vbk, lane), acc);
#pragma unroll
                    for (int r = 0; r < 4; ++r) X1[(16 * rb + 4 * fq + r) * RC_LD + 16 * vbk + fr] = (bf16_t)f2bf(acc[r]);
                } else {
#pragma unroll
                    for (int ks = 0; ks < 2; ++ks) acc = MFMA16(frag_tr(Ke, RC_LD, 32 * ks, 16 * rb, lane), frag_tr(Vs, RC_LD, 32 * ks, 16 * vbk, lane), acc);
                    { u32x2 o; o.x = pk2(acc[0], acc[1]); o.y = pk2(acc[2], acc[3]); *(u32x2*)(WS_(p, RNa) + (((ub * 4 + vbk) * 4 + rb) * 64 + lane) * 4) = o; }
                }
            }
        }
        lds_barrier();
#pragma unroll
        for (int q = 0; q < 4; ++q) { const int tl = w * 4 + q; const int tt = (tl & 15) >> 2, cbk = tl & 3; f32x4 acc = {0.f, 0.f, 0.f, 0.f};
            if (tl < 16) {
#pragma unroll
                for (int ks = 0; ks < 2; ++ks) acc = MFMA16(frag_rm(Ts, RC_LD, 16 * tt, 32 * ks, lane), frag_tr(As, RC_LD, 32 * ks, 16 * cbk, lane), acc);
                const int k = 16 * cbk + fr, kq = k & 31, g = (kq & 15) >> 2, j = (kq & 3) + ((kq >> 4) << 2);
#pragma unroll
                for (int r = 0; r < 4; ++r) Wimg[((tt * 2 + (k >> 5)) * 64 + g * 16 + 4 * fq + r) * 8 + j] = (bf16_t)f2bf(acc[r]);
            } else {
#pragma unroll
                for (int ks = 0; ks < 2; ++ks) acc = MFMA16(frag_rm(Ts, RC_LD, 16 * tt, 32 * ks, lane), frag_tr(X1, RC_LD, 32 * ks, 16 * cbk, lane), acc);
                { u32x2 o; o.x = pk2(acc[0], acc[1]); o.y = pk2(acc[2], acc[3]); *(u32x2*)(WS_(p, RUt) + (((ub * 4 + cbk) * 4 + tt) * 64 + lane) * 4) = o; }
            } }
        lds_barrier();
        *(u32x4*)(WS_(p, RWf) + ub * 4096 + tid * 8) = *(const LAS u32x4*)(Wimg + tid * 8);
    }
}

constexpr int RB_SLOT = 20992, RB_R = 6, RB_P = 5;
struct RbOpsA { bf16x8 wf[8]; u32x2 ut[4]; };
struct RbOpsB { bf16x8 bf[8]; u32x2 na[4]; f32x4 gc[4]; };
DEV void rb_read_a(const LAS unsigned char* slot, int lane, RbOpsA& O) {
#pragma unroll
    for (int f = 0; f < 8; ++f) O.wf[f] = *(const LAS bf16x8*)(slot + (f * 64 + lane) * 16);
#pragma unroll
    for (int q = 0; q < 4; ++q) O.ut[q] = *(const LAS u32x2*)(slot + 16384 + (q * 64 + lane) * 8);
}
DEV void rb_read_b(const LAS unsigned char* slot, int lane, RbOpsB& O) {
    const int fq = lane >> 4;
#pragma unroll
    for (int f = 0; f < 8; ++f) O.bf[f] = *(const LAS bf16x8*)(slot + 8192 + (f * 64 + lane) * 16);
#pragma unroll
    for (int q = 0; q < 4; ++q) { O.na[q] = *(const LAS u32x2*)(slot + 18432 + (q * 64 + lane) * 8); O.gc[q] = *(const LAS f32x4*)(slot + 20480 + (16 * q + 4 * fq) * 4); }
}
DEV void phase_rw_chb(const Params& p, LAS unsigned char* lds, int half) {
    const int tid = tid_(), bid = bid_(); const int cbeg = half * 128, cend = cbeg + 128;
    const int lane = tid & 63, w = __builtin_amdgcn_readfirstlane(tid >> 6); const int head = bid & 15, vb = bid >> 4;
    auto issue = [&](int c) {
        const size_t ub = (size_t)c * 16 + head; LAS unsigned char* slot = lds + (c % RB_R) * RB_SLOT;
#pragma unroll
        for (int i = 0; i < 3; ++i) { const int pi = (w - 1) * 3 + i;
            if (pi < 8) __builtin_amdgcn_global_load_lds((const unsigned*)(WS_(p, RWf) + ub * 4096 + pi * 512 + lane * 8), (LAS unsigned*)(slot + pi * 1024), 16, 0, 0);
            else if (pi < 16) __builtin_amdgcn_global_load_lds((const unsigned*)(WS_(p, RBf) + ub * 4096 + (pi - 8) * 512 + lane * 8), (LAS unsigned*)(slot + 8192 + (pi - 8) * 1024), 16, 0, 0);
            else if (pi < 18) __builtin_amdgcn_global_load_lds((const unsigned*)(WS_(p, RUt) + (ub * 4 + vb) * 1024 + (pi - 16) * 512 + lane * 8), (LAS unsigned*)(slot + 16384 + (pi - 16) * 1024), 16, 0, 0);
            else if (pi < 20) __builtin_amdgcn_global_load_lds((const unsigned*)(WS_(p, RNa) + (ub * 4 + vb) * 1024 + (pi - 18) * 512 + lane * 8), (LAS unsigned*)(slot + 18432 + (pi - 18) * 1024), 16, 0, 0);
            else __builtin_amdgcn_global_load_lds((const unsigned*)(WS_(p, RGc) + ub * 64 + lane), (LAS unsigned*)(slot + 20480), 4, 0, 0);
        }
    };
    if (w > 0) {
#pragma unroll 1
        for (int c = cbeg; c < cbeg + RB_P; ++c) issue(c);
        asm volatile("s_waitcnt vmcnt(9)" ::: "memory");
    }
    __builtin_amdgcn_s_barrier();
    f32x4 s[4]; for (int i = 0; i < 4; ++i) s[i] = (f32x4){0.f, 0.f, 0.f, 0.f};
    f32x4* sst = WS_(p, RBST) + ((size_t)bid * 4) * 64 + lane;
    if (w > 0) {
#pragma unroll 1
        for (int c = cbeg; c < cend; ++c) {
            if (c + RB_P < cend) { issue(c + RB_P); asm volatile("s_waitcnt vmcnt(9)" ::: "memory"); }
            else asm volatile("s_waitcnt vmcnt(0)" ::: "memory");
            __builtin_amdgcn_s_barrier();
        }
    } else {
        RbOpsA A0, A1;
        rb_read_a(lds + (cbeg % RB_R) * RB_SLOT, lane, A0); if (half) { for (int i = 0; i < 4; ++i) s[i] = sst[i * 64]; }
#define RB_CHUNK(CA, NA, cc) do { const int c_ = (cc); const size_t ub = (size_t)c_ * 16 + head; RbOpsB cb_; \
            bf16x8 sb[2]; \
            _Pragma("unroll") for (int ks = 0; ks < 2; ++ks) { u32x4 o; o.x = pk2(s[2 * ks][0], s[2 * ks][1]); o.y = pk2(s[2 * ks][2], s[2 * ks][3]); o.z = pk2(s[2 * ks + 1][0], s[2 * ks + 1][1]); o.w = pk2(s[2 * ks + 1][2], s[2 * ks + 1][3]); sb[ks] = __builtin_bit_cast(bf16x8, o); *(u32x4*)(WS_(p, RS0) + (((ub * 4 + vb) * 2 + ks) * 64 + lane) * 8) = o; }       \
            f32x4 uu[4]; \
            _Pragma("unroll") for (int tt = 0; tt < 4; ++tt) { uu[tt] = (f32x4){bflo(CA.ut[tt].x), bfhi(CA.ut[tt].x), bflo(CA.ut[tt].y), bfhi(CA.ut[tt].y)}; uu[tt] = MFMA16(CA.wf[tt * 2], sb[0], uu[tt]); uu[tt] = MFMA16(CA.wf[tt * 2 + 1], sb[1], uu[tt]); } \
            __builtin_amdgcn_sched_barrier(0); \
              \
            rb_read_b(lds + (c_ % RB_R) * RB_SLOT, lane, cb_); \
            rb_read_a(lds + ((c_ + 1 < cend ? c_ + 1 : c_) % RB_R) * RB_SLOT, lane, NA); \
            __builtin_amdgcn_sched_barrier(0); \
            bf16x8 ubf[2]; \
            _Pragma("unroll") for (int ks = 0; ks < 2; ++ks) { u32x4 o; o.x = pk2(uu[2 * ks][0], uu[2 * ks][1]); o.y = pk2(uu[2 * ks][2], uu[2 * ks][3]); o.z = pk2(uu[2 * ks + 1][0], uu[2 * ks + 1][1]); o.w = pk2(uu[2 * ks + 1][2], uu[2 * ks + 1][3]); ubf[ks] = __builtin_bit_cast(bf16x8, o); *(u32x4*)(WS_(p, RUa) + (((ub * 4 + vb) * 2 + ks) * 64 + lane) * 8) = o; }      \
            _Pragma("unroll") for (int kt = 0; kt < 4; ++kt) { s[kt] = s[kt] * cb_.gc[kt] + (f32x4){bflo(cb_.na[kt].x), bfhi(cb_.na[kt].x), bflo(cb_.na[kt].y), bfhi(cb_.na[kt].y)}; s[kt] = MFMA16(cb_.bf[kt * 2], ubf[0], s[kt]); s[kt] = MFMA16(cb_.bf[kt * 2 + 1], ubf[1], s[kt]); } \
            __builtin_amdgcn_s_barrier(); \
        } while (0)
#pragma unroll 1
        for (int c = cbeg; c < cend; c += 2) { RB_CHUNK(A0, A1, c); RB_CHUNK(A1, A0, c + 1); }
#undef RB_CHUNK
    }
    if (w == 0 && !half) { for (int i = 0; i < 4; ++i) sst[i * 64] = s[i]; }
    asm volatile("s_waitcnt vmcnt(0)" ::: "memory");
}

DEV void phase_rw_chc(const Params& p, int j, LAS unsigned char* lds, int half) {
    const int tid = tid_(), bid = bid_(); const int u0 = half * 2048 + (bid - RW_NB), ue = half * 2048 + 2048; const int lane = tid & 63, w = tid >> 6; const int fr = lane & 15, fq = lane >> 4;
    LAS float* cum = (LAS float*)lds;
    LAS float* seg = cum + 64 * 64;
    LAS float* Ys = seg + 8 * 64;
    LAS bf16_t* Rs = (LAS bf16_t*)(Ys + 64 * 68);
    LAS bf16_t* Bs = Rs + 64 * RC_LD; LAS bf16_t* Ks = Bs + 64 * RC_LD; LAS bf16_t* Vs = Ks + 64 * RC_LD; LAS bf16_t* Arb = Vs + 64 * RC_LD; LAS bf16_t* Ark = Arb + 64 * RC_LD;
    float pwd[8], pr[8], pkr[8], pal[8], pv[8], pg[8];
    float kkw[8], kaw[8], rkw[8], lgw[8], lbw[8];
    { const size_t po = (size_t)j * D + (u0 & 15) * 64 + (tid & 7) * 8; ld8(p.rw_k_k + po, kkw); ld8(p.rw_k_a + po, kaw); ld8(p.rw_r_k + po, rkw); ld8(p.rw_lnx_g + po, lgw); ld8(p.rw_lnx_b + po, lbw); }
    { const int c = u0 >> 4, h = u0 & 15; rc_load_wd(p, c * 64, h * 64, pwd);
      const size_t go = (size_t)(c * 64 + (tid >> 3)) * D + h * 64 + (tid & 7) * 8; ld8b(WS_(p, Rb) + go, pr); ld8b(WS_(p, Kb) + go, pkr); ld8b(WS_(p, Ab) + go, pal); ld8b(WS_(p, Vb) + go, pv); ld8b(WS_(p, Gb) + go, pg); }
    for (int u = u0; u < ue; u += RW_NW) {
        const int c = u >> 4, h = u & 15; const int t0 = c * 64, cb = h * 64; const size_t ub = (size_t)c * 16 + h;
        const int tt = w & 3;
        bf16x8 ufr[2][2], sfr[2][2];
#pragma unroll
        for (int q = 0; q < 2; ++q)
#pragma unroll
            for (int ks = 0; ks < 2; ++ks) { const size_t o = (((ub * 4 + 2 * (w >> 2) + q) * 2 + ks) * 64 + lane) * 8;
                ufr[q][ks] = *(const bf16x8*)(WS_(p, RUa) + o); sfr[q][ks] = *(const bf16x8*)(WS_(p, RS0) + o); }
        lds_barrier();
        rc_cum_regs(pwd, cum, seg);
#ifdef DBL_CUM
        rc_cum_regs(pwd, cum, seg);
#endif
        const int t = tid >> 3, k8 = (tid & 7) * 8; const size_t go = (size_t)(t0 + t) * D + cb + k8;
        float v[8], gg[8]; float bc;
        {   float r[8], a[8], b[8], kh[8], ct[8];
#pragma unroll
            for (int e = 0; e < 8; ++e) { r[e] = pr[e]; v[e] = pv[e]; gg[e] = pg[e]; }
            lds8(cum + t * 64 + k8, ct);
            rc_prep8(pkr, pal, kkw, kaw, a, b, kh);
            if (u + RW_NW < ue) { const int un = u + RW_NW; const int cn = un >> 4, hn = un & 15; rc_load_wd(p, cn * 64, hn * 64, pwd);
                const size_t gn = (size_t)(cn * 64 + t) * D + hn * 64 + k8; ld8b(WS_(p, Rb) + gn, pr); ld8b(WS_(p, Kb) + gn, pkr); ld8b(WS_(p, Ab) + gn, pal); ld8b(WS_(p, Vb) + gn, pv); ld8b(WS_(p, Gb) + gn, pg); }
            bc = 0.f;
#pragma unroll
            for (int e = 0; e < 8; ++e) bc += r[e] * kh[e] * rkw[e];
            bc += __shfl_xor(bc, 1); bc += __shfl_xor(bc, 2); bc += __shfl_xor(bc, 4);
#pragma unroll
            for (int e = 0; e < 8; ++e) { const float ei = __expf(-ct[e]); r[e] *= __expf(ct[e]); b[e] *= ei; kh[e] *= ei; }
            *(LAS u32x4*)(Rs + t * RC_LD + k8) = pk8(r); *(LAS u32x4*)(Bs + t * RC_LD + k8) = pk8(b); *(LAS u32x4*)(Ks + t * RC_LD + k8) = pk8(kh); *(LAS u32x4*)(Vs + t * RC_LD + k8) = pk8(v);
        }
        lds_barrier();
#ifdef DBL_S3
#pragma unroll 1
        for (int rep_ = 0; rep_ < 2; ++rep_)
#endif
        {   const int tb = w >> 1;
#pragma unroll
            for (int ii = 0; ii < 2; ++ii) { const int ib = 2 * (w & 1) + ii;
                f32x4 ab = {0.f, 0.f, 0.f, 0.f}, ak = {0.f, 0.f, 0.f, 0.f};
                if (ib <= tb) {
#pragma unroll
                    for (int ks = 0; ks < 2; ++ks) { const bf16x8 af = frag_rm(Rs, RC_LD, 16 * tb, 32 * ks, lane);
                        ab = MFMA16(af, frag_rm(Bs, RC_LD, 16 * ib, 32 * ks, lane), ab); ak = MFMA16(af, frag_rm(Ks, RC_LD, 16 * ib, 32 * ks, lane), ak); } }
#pragma unroll
                for (int r = 0; r < 4; ++r) { const int tr = 16 * tb + 4 * fq + r, i = 16 * ib + fr; const bool keep = i <= tr;
                    Arb[tr * RC_LD + i] = (bf16_t)f2bf(keep ? ab[r] : 0.f); Ark[tr * RC_LD + i] = (bf16_t)f2bf(keep ? ak[r] : 0.f); } }
        }
        lds_barrier();
#ifdef DBL_Y
#pragma unroll 1
        for (int rep_ = 0; rep_ < 2; ++rep_)
#endif
#pragma unroll
        for (int q = 0; q < 2; ++q) { const int vbk = 2 * (w >> 2) + q; f32x4 acc = {0.f, 0.f, 0.f, 0.f};
#pragma unroll
            for (int ks = 0; ks < 2; ++ks) {
                acc = MFMA16(frag_rm_pi(Rs, RC_LD, 16 * tt, 32 * ks, lane), sfr[q][ks], acc);
                acc = MFMA16(frag_rm_pi(Arb, RC_LD, 16 * tt, 32 * ks, lane), ufr[q][ks], acc);
                acc = MFMA16(frag_rm(Ark, RC_LD, 16 * tt, 32 * ks, lane), frag_tr(Vs, RC_LD, 32 * ks, 16 * vbk, lane), acc); }
#pragma unroll
            for (int r = 0; r < 4; ++r) Ys[(16 * tt + 4 * fq + r) * 68 + 16 * vbk + fr] = acc[r]; }
        lds_barrier();
        {
            float y[8]; lds8(Ys + t * 68 + k8, y);
            float s1 = 0.f, s2 = 0.f;
#pragma unroll
            for (int e = 0; e < 8; ++e) { s1 += y[e]; s2 += y[e] * y[e]; }
            s1 += __shfl_xor(s1, 1); s1 += __shfl_xor(s1, 2); s1 += __shfl_xor(s1, 4); s2 += __shfl_xor(s2, 1); s2 += __shfl_xor(s2, 2); s2 += __shfl_xor(s2, 4);
            const float mean = s1 * (1.0f / 64.0f), var = s2 * (1.0f / 64.0f) - mean * mean; const float rs = rsqrtf(fmaxf(var, 0.f) + 64e-5f);
            float o[8];
#pragma unroll
            for (int e = 0; e < 8; ++e) o[e] = ((y[e] - mean) * rs * lgw[e] + lbw[e] + bc * v[e]) * gg[e];
            *(u32x4*)(WS_(p, YB) + go) = pk8(o);
        }
    }
}
DEV void phase_ln1(const Params& p, int layer, LAS unsigned char* lds) {
    const int tid = tid_(), bid = bid_(); (void)tid; (void)bid;
    const int lane = tid & 63, wid = tid >> 6; const int fr = lane & 15, fq = lane >> 4;
    LAS float* lgt = (LAS float*)lds;
    LAS int* cnt = (LAS int*)(lgt + 2 * 64 * 48);
    if (tid < 32) cnt[tid] = 0;
    const float* g = p.ln_g + ((size_t)layer * 2 + 0) * D; const float* be = p.ln_b + ((size_t)layer * 2 + 0) * D;
    const float* br = p.moe_b_route + layer * 32; const float* bg = p.moe_b_group + layer * 4;
    f32x4 gwv[4], bwv[4];
#pragma unroll
    for (int q = 0; q < 4; ++q) { gwv[q] = *(const f32x4*)(g + RCOL(q, lane)); bwv[q] = *(const f32x4*)(be + RCOL(q, lane)); }
    u32x2 rh[4], rm[4];
#pragma unroll
    for (int q = 0; q < 4; ++q) { rh[q] = *(const u32x2*)(WS_(p, Hb) + (size_t)(bid * 64 + wid * 8) * D + RCOL(q, lane)); rm[q] = *(const u32x2*)(WS_(p, MIXb) + (size_t)(bid * 64 + wid * 8) * D + RCOL(q, lane)); }
#pragma unroll 1
    for (int rr = 0; rr < 8; ++rr) {
        const int t = bid * 64 + wid * 8 + rr; const size_t ro = (size_t)t * D;
        f32x4 z[4], m[4];
#pragma unroll
        for (int q = 0; q < 4; ++q) { z[q] = (f32x4){bflo(rh[q].x), bfhi(rh[q].x), bflo(rh[q].y), bfhi(rh[q].y)}; m[q] = (f32x4){bflo(rm[q].x), bfhi(rm[q].x), bflo(rm[q].y), bfhi(rm[q].y)}; }
        { const size_t rn = (size_t)(rr < 7 ? t + 1 : t) * D;
#pragma unroll
          for (int q = 0; q < 4; ++q) { rh[q] = *(const u32x2*)(WS_(p, Hb) + rn + RCOL(q, lane)); rm[q] = *(const u32x2*)(WS_(p, MIXb) + rn + RCOL(q, lane)); } }
        float s = 0.f;
#pragma unroll
        for (int q = 0; q < 4; ++q) { z[q] = z[q] * ALPHA + m[q]; s += z[q][0] + z[q][1] + z[q][2] + z[q][3]; }
        const float mean = wave_sum(s) * (1.0f / D);
        float vs = 0.f;
#pragma unroll
        for (int q = 0; q < 4; ++q) { z[q] = z[q] - mean; vs += z[q][0] * z[q][0] + z[q][1] * z[q][1] + z[q][2] * z[q][2] + z[q][3] * z[q][3]; }
        const float rs = rsqrtf(wave_sum(vs) * (1.0f / D) + LN_EPS);
#pragma unroll
        for (int q = 0; q < 4; ++q) {
            st_bf4(WS_(p, H1b) + ro + RCOL(q, lane), z[q] * rs * gwv[q] + bwv[q]);
        }
    }
    asm volatile("s_waitcnt vmcnt(0)" ::: "memory");
    __syncthreads();
    {   const int rt = wid & 3, kh = wid >> 2;
        const bf16_t* Ab = WS_(p, H1b) + (size_t)(bid * 64 + 16 * rt + fr) * D + 512 * kh + 8 * fq;
        const bf16_t* Wb = WS_(p, moe_wr_t) + (size_t)layer * 48 * D + (size_t)fr * D + 512 * kh + 8 * fq;
        f32x4 acc[3]; for (int i = 0; i < 3; ++i) acc[i] = (f32x4){0.f, 0.f, 0.f, 0.f};
#pragma unroll 8
        for (int ks = 0; ks < 16; ++ks) {
            const bf16x8 af = *(const bf16x8*)(Ab + 32 * ks);
#pragma unroll
            for (int ct = 0; ct < 3; ++ct) acc[ct] = MFMA16(af, *(const bf16x8*)(Wb + (size_t)16 * ct * D + 32 * ks), acc[ct]);
        }
#pragma unroll
        for (int ct = 0; ct < 3; ++ct)
#pragma unroll
            for (int r = 0; r < 4; ++r) lgt[(kh * 64 + 16 * rt + 4 * fq + r) * 48 + 16 * ct + fr] = acc[ct][r];
    }
    __syncthreads();
    if (tid < 64) {
        const int t = bid * 64 + tid; const LAS float* L0 = lgt + tid * 48; const LAS float* L1 = lgt + (64 + tid) * 48;
        const float q0 = L0[32] + L1[32] + bg[0], q1 = L0[33] + L1[33] + bg[1], q2 = L0[34] + L1[34] + bg[2], q3 = L0[35] + L1[35] + bg[3];
        int gi = 0; float gm = q0;
        if (q1 > gm) { gm = q1; gi = 1; } if (q2 > gm) { gm = q2; gi = 2; } if (q3 > gm) { gm = q3; gi = 3; }
        const float den = __expf(q0 - gm) + __expf(q1 - gm) + __expf(q2 - gm) + __expf(q3 - gm);
        const float pgrp = __builtin_amdgcn_rcpf(den);
        float l1 = -INFINITY, l2 = -INFINITY; int i1 = 0, i2 = 0;
#pragma unroll 1
        for (int o = 0; o < 8; ++o) { const float v = L0[gi * 8 + o] + L1[gi * 8 + o] + br[gi * 8 + o];
            if (v > l1) { l2 = l1; i2 = i1; l1 = v; i1 = o; } else if (v > l2) { l2 = v; i2 = o; } }
        const float e2 = __expf(l2 - l1), inv = __builtin_amdgcn_rcpf(1.0f + e2);
        const int e0 = gi * 8 + i1, e1 = gi * 8 + i2;
        WS_(p, EIDX)[2 * t] = e0; WS_(p, EIDX)[2 * t + 1] = e1; WS_(p, GATE)[2 * t] = pgrp * inv; WS_(p, GATE)[2 * t + 1] = pgrp * e2 * inv;
        atomicAdd((int*)&cnt[e0], 1); atomicAdd((int*)&cnt[e1], 1);
    }
    __syncthreads();
    if (tid < 32) WS_(p, CNT)[bid * 32 + tid] = cnt[tid];
}

DEV void phase_moe_scatter(const Params& p, LAS unsigned char* lds) {
    const int tid = tid_(), bid = bid_(); (void)tid; (void)bid;
    const int lane = tid & 63, wid = tid >> 6;
    LAS int* part = (LAS int*)lds;
    LAS int* pre = part + 512;
    LAS int* base = pre + 512;
    LAS int* pst = base + 32;
    LAS int* dst = pst + 40;
    LAS int* eid = dst + 128;
    { const int e = tid & 31, part_i = tid >> 5; int tot = 0, prf = 0;
      for (int b = part_i * 16; b < part_i * 16 + 16; ++b) { const int c = WS_(p, CNT)[b * 32 + e]; tot += c; if (b < (int)bid) prf += c; }
      part[part_i * 32 + e] = tot; pre[part_i * 32 + e] = prf; }
    if (tid < 128) eid[tid] = WS_(p, EIDX)[bid * 128 + tid];
    if (bid == 1 && tid < MFLAG_TICKET + 32) __hip_atomic_store(WS_(p, MFLAG) + tid * MFLAG_STRIDE, 0u, __ATOMIC_RELAXED, __HIP_MEMORY_SCOPE_AGENT);
    lds_barrier();
    if (tid < 32) { int tot = 0, prf = 0; for (int i = 0; i < 16; ++i) { tot += part[i * 32 + tid]; prf += pre[i * 32 + tid]; } part[tid] = tot; pre[tid] = prf; }
    lds_barrier();
    if (tid == 0) { int acc = 0; for (int e = 0; e < 32; ++e) { pst[e] = acc; acc += ((part[e] + 255) >> 8) << 8; } pst[32] = acc;
        if (bid == 0) { for (int e = 0; e <= 32; ++e) WS_(p, TAB)[e] = pst[e]; WS_(p, TAB)[33] = acc >> 8;
            for (int e = 0; e < 32; ++e) for (int mt = pst[e] >> 8; mt < (pst[e + 1] >> 8); ++mt) WS_(p, TAB)[64 + mt] = e; } }
    lds_barrier();
    if (tid < 32) { int run = pst[tid] + pre[tid];
#pragma unroll 16
        for (int a = 0; a < 128; ++a) if (eid[a] == tid) dst[a] = run++; }
    lds_barrier();
    if (tid < 128) WS_(p, DEST)[bid * 128 + tid] = dst[tid];
#pragma unroll 4
    for (int a = wid * 16; a < wid * 16 + 16; ++a) {
        const int t = bid * 64 + (a >> 1); const int d = dst[a];
        const u32x4 v0 = *(const u32x4*)(WS_(p, H1b) + (size_t)t * D + lane * 8), v1 = *(const u32x4*)(WS_(p, H1b) + (size_t)t * D + 512 + lane * 8);
        *(u32x4*)(WS_(p, BUF) + (size_t)d * D + lane * 8) = v0; *(u32x4*)(WS_(p, BUF) + (size_t)d * D + 512 + lane * 8) = v1;
    }
}

template <int which> struct SchedMoe {
    const Params* p; int layer; const LAS int* tab;
    DEV bool next(int i, Unit& u) const {
        const int nmt = tab[33]; int pm, pn; if (!pg8::tile_order(i, NB_, which == 0 ? bid_() : ((bid_() + 128) & 255), nmt, 4, pm, pn)) return false;
        const int row0 = pm * 256; const int e = tab[64 + pm];
        if constexpr (which == 0) { u.A = (const char*)(WS_(*p, BUF) + (size_t)row0 * D); u.B = (const char*)(WS_(*p, moe_w1_t) + ((size_t)layer * 32 + e) * 1024 * 1024 + (size_t)pn * 256 * 1024); }
        else {
            if (tid_() == 0) { unsigned* f = WS_(*p, MFLAG) + pm * MFLAG_STRIDE; unsigned sp = 0;
                while (__hip_atomic_load(f, __ATOMIC_RELAXED, __HIP_MEMORY_SCOPE_AGENT) < 4u) { __builtin_amdgcn_s_sleep(1); if (++sp > (1u << 24)) break; }
                __builtin_amdgcn_fence(__ATOMIC_ACQUIRE, "agent");
                asm volatile("s_waitcnt vmcnt(0)" ::: "memory"); }
            __builtin_amdgcn_s_barrier();
            u.A = (const char*)(WS_(*p, ACT) + (size_t)row0 * 512); u.B = (const char*)(WS_(*p, moe_w2_t) + ((size_t)layer * 32 + e) * 1024 * 512 + (size_t)pn * 256 * 512); }
        u.row0 = row0; u.col0 = pn * 256; u.id = e; u.aux = 0; return true;
    }
};
struct EpiMoe1 {
    bf16_t* O; unsigned* flag;
    DEV void operator()(const AccT& acc, const Unit& u, int wr, int wc, int fr, int fq) const {
        const __amdgpu_buffer_rsrc_t rs = __builtin_amdgcn_make_buffer_rsrc(O, 0, MOE_ROWS * 512 * 2, 0x00020000);
#pragma unroll
        for (int ai = 0; ai < 2; ++ai)
#pragma unroll
            for (int m = 0; m < 4; ++m) {
                f32x4 v[2];
#pragma unroll
                for (int n = 0; n < 2; ++n) { const f32x4 gt = acc[ai][0][m][n], up = acc[ai][1][m][n]; for (int e = 0; e < 4; ++e) v[n][e] = siluf_(gt[e]) * up[e]; }
                const int col = (u.col0 >> 1) + 32 * wc + (PF(6) ? 8 * fq : 4 * fq);
                if (PF(6)) __builtin_amdgcn_raw_buffer_store_b128(pk8v(v[0], v[1]), rs, (unsigned)((ACC_ROW(u, ai, m) * 512 + col) * 2), 0, 16);
                else { const u32x4 w = pk8v(v[0], v[1]); unsigned long long* q = (unsigned long long*)(O + (size_t)ACC_ROW(u, ai, m) * 512 + col);
                  __hip_atomic_store(q, (unsigned long long)w.x | ((unsigned long long)w.y << 32), __ATOMIC_RELAXED, __HIP_MEMORY_SCOPE_AGENT);
                  __hip_atomic_store(q + 4, (unsigned long long)w.z | ((unsigned long long)w.w << 32), __ATOMIC_RELAXED, __HIP_MEMORY_SCOPE_AGENT); }
                ACC_FENCE;
            }
        asm volatile("s_waitcnt vmcnt(0)" ::: "memory");
        __builtin_amdgcn_s_barrier();
        if (wr == 1 && wc == 0 && fr == 0 && fq == 0) __hip_atomic_fetch_add(flag + (u.row0 >> 8) * MFLAG_STRIDE, 1u, __ATOMIC_RELAXED, __HIP_MEMORY_SCOPE_AGENT);
    }
};
struct EpiMoe2 {
    bf16_t* O;
    DEV void operator()(const AccT& acc, const Unit& u, int wr, int wc, int fr, int fq) const {
        FOR_ACC2(ai, bj, m) { st_bf8p(O + (size_t)ACC_ROW(u, ai, m) * D + ACC_COL8P(u, bj, PF(7)), acc[ai][bj][m][0], acc[ai][bj][m][1], PF(7)); ACC_FENCE; }
    }
};

struct Ln2Raw { u32x2 h[4], a[4], b[4]; float g0, g1; };
DEV void ln2_issue(const Params& p, int t, int lane, Ln2Raw& R, int dpre, float gpre, int tbase) {
    const int i0 = 2 * (t - tbase); const int d0 = __shfl(dpre, i0), d1 = __shfl(dpre, i0 + 1); R.g0 = __shfl(gpre, i0); R.g1 = __shfl(gpre, i0 + 1);
#pragma unroll
    for (int q = 0; q < 4; ++q) { R.h[q] = *(const u32x2*)(WS_(p, H1b) + (size_t)t * D + RCOL(q, lane));
        R.a[q] = *(const u32x2*)(WS_(p, YBUF) + (size_t)d0 * D + RCOL(q, lane)); R.b[q] = *(const u32x2*)(WS_(p, YBUF) + (size_t)d1 * D + RCOL(q, lane)); }
}
DEV void ln2_finish(const Ln2Raw& R, const f32x4 (&gwv)[4], const f32x4 (&bwv)[4], f32x4 (&z)[4]) {
    float s = 0.f; const float g0 = R.g0, g1 = R.g1;
#pragma unroll
    for (int q = 0; q < 4; ++q) {
        z[q][0] = bflo(R.h[q].x) * ALPHA + g0 * bflo(R.a[q].x) + g1 * bflo(R.b[q].x); z[q][1] = bfhi(R.h[q].x) * ALPHA + g0 * bfhi(R.a[q].x) + g1 * bfhi(R.b[q].x);
        z[q][2] = bflo(R.h[q].y) * ALPHA + g0 * bflo(R.a[q].y) + g1 * bflo(R.b[q].y); z[q][3] = bfhi(R.h[q].y) * ALPHA + g0 * bfhi(R.a[q].y) + g1 * bfhi(R.b[q].y);
        s += z[q][0] + z[q][1] + z[q][2] + z[q][3];
    }
    const float mean = wave_sum(s) * (1.0f / D);
    float vs = 0.f;
#pragma unroll
    for (int q = 0; q < 4; ++q) { z[q] = z[q] - mean; vs += z[q][0] * z[q][0] + z[q][1] * z[q][1] + z[q][2] * z[q][2] + z[q][3] * z[q][3]; }
    const float rs = rsqrtf(wave_sum(vs) * (1.0f / D) + LN_EPS);
#pragma unroll
    for (int q = 0; q < 4; ++q) z[q] = z[q] * rs * gwv[q] + bwv[q];
}
DEV void phase_ln2(const Params& p, int layer, LAS unsigned char* lds) {
    const int tid = tid_(), bid = bid_(); const int lane = tid & 63, wid = tid >> 6; const int fr = lane & 15, fq = lane >> 4;
    const float* g = p.ln_g + ((size_t)layer * 2 + 1) * D; const float* be = p.ln_b + ((size_t)layer * 2 + 1) * D;
    const int nk = layer == DEPTH - 1 ? 3 : (layer + 1) % 3;
    const int nj = (layer + 1) / 3;
    LAS float* lgt = (LAS float*)lds;
    LAS float* w2 = lgt + 2 * 64 * 32;
    if (nk == 2) { for (int i = tid; i < 16 * 512; i += NTHR) w2[i] = p.gl_gk_w2[(size_t)nj * 16 * 512 + i]; }
    const int tfirst = bid * 64 + wid * 8;
    f32x4 z[4], zp[4], gwv[4], bwv[4];
#pragma unroll
    for (int q = 0; q < 4; ++q) { gwv[q] = *(const f32x4*)(g + RCOL(q, lane)); bwv[q] = *(const f32x4*)(be + RCOL(q, lane)); }
    Ln2Raw R[3];
    const int tbase = tfirst > 0 ? tfirst - 1 : 0;
    const int dpre = lane < 18 ? WS_(p, DEST)[2 * tbase + lane] : 0; const float gpre = lane < 18 ? WS_(p, GATE)[2 * tbase + lane] : 0.f;
    if (nk == 0) { if (tfirst > 0) { ln2_issue(p, tfirst - 1, lane, R[2], dpre, gpre, tbase); } }
    ln2_issue(p, tfirst, lane, R[0], dpre, gpre, tbase);
    ln2_issue(p, tfirst + 1, lane, R[1], dpre, gpre, tbase);
    if (nk == 0) { if (tfirst > 0) ln2_finish(R[2], gwv, bwv, zp); else { for (int q = 0; q < 4; ++q) zp[q] = (f32x4){0.f, 0.f, 0.f, 0.f}; } }
#pragma unroll
    for (int rr = 0; rr < 8; ++rr) {
        const int t = tfirst + rr; const size_t ro = (size_t)t * D;
        if (rr + 2 < 8) ln2_issue(p, t + 2, lane, R[(rr + 2) % 3], dpre, gpre, tbase);
        ln2_finish(R[rr % 3], gwv, bwv, z);
        if (nk == 3) {
#pragma unroll
            for (int q = 0; q < 4; ++q) *(f32x4*)(p.out + ro + RCOL(q, lane)) = z[q];
        } else store_row_bf(WS_(p, Hb) + ro, lane, z);
        if (nk == 0) {
            emit_mix6(p, nj, t, lane, z, zp);
#pragma unroll
            for (int q = 0; q < 4; ++q) zp[q] = z[q];
        }
    }
    if (nk == 1 || nk == 2) {
        asm volatile("s_waitcnt vmcnt(0)" ::: "memory");
        __syncthreads();
        const int nct = nk == 1 ? 2 : 1; const int rt = wid & 3, kh = wid >> 2;
        const bf16_t* Ab = WS_(p, Hb) + (size_t)(bid * 64 + 16 * rt + fr) * D + 512 * kh + 8 * fq;
        const bf16_t* Wb = (nk == 1 ? WS_(p, mb_dt_t) : WS_(p, gl_lr_t)) + (size_t)fr * D + 512 * kh + 8 * fq;
        f32x4 acc[2]; acc[0] = (f32x4){0.f, 0.f, 0.f, 0.f}; acc[1] = acc[0];
#pragma unroll 4
        for (int ks = 0; ks < 16; ++ks) {
            const bf16x8 af = *(const bf16x8*)(Ab + 32 * ks);
            acc[0] = MFMA16(af, *(const bf16x8*)(Wb + 32 * ks), acc[0]);
            if (nct == 2) acc[1] = MFMA16(af, *(const bf16x8*)(Wb + (size_t)16 * D + 32 * ks), acc[1]);
        }
#pragma unroll
        for (int ct = 0; ct < 2; ++ct)
#pragma unroll
            for (int r = 0; r < 4; ++r) lgt[(kh * 64 + 16 * rt + 4 * fq + r) * 32 + 16 * ct + fr] = acc[ct][r];
        __syncthreads();
        if (nk == 1) {
#pragma unroll
            for (int i = 0; i < 4; ++i) { const int idx = tid + i * NTHR; const int row = idx >> 5, o = idx & 31;
                WS_(p, DT)[(size_t)(bid * 64 + row) * 32 + o] = softplusf_(lgt[row * 32 + o] + lgt[(64 + row) * 32 + o] + p.mb_dt_bias[nj * 32 + o]); }
        } else {
            const int row = tid >> 3, c0 = (tid & 7) * 64; float lr[16];
#pragma unroll
            for (int o = 0; o < 16; ++o) lr[o] = lgt[row * 32 + o] + lgt[(64 + row) * 32 + o];
#pragma unroll 1
            for (int c4 = 0; c4 < 16; ++c4) { const int c = c0 + 4 * c4; f32x4 a = *(const f32x4*)(p.gl_gk_b + nj * 512 + c);
#pragma unroll
                for (int o = 0; o < 16; ++o) { const f32x4 wv = *(const LAS f32x4*)(w2 + o * 512 + c); a = a + wv * lr[o]; }
                f32x4 r;
#pragma unroll
                for (int e = 0; e < 4; ++e) r[e] = (fminf(a[e], 0.f) - __logf(1.0f + __expf(-fabsf(a[e])))) * (1.0f / 16.0f);
                *(f32x4*)(WS_(p, LA) + (size_t)(bid * 64 + row) * 512 + c) = r; }
        }
    }
}
constexpr int MB_PROJ = 5152;
struct SchedMbIn {
    const Params* p;
    DEV bool next(int i, Unit& u) const {
        int pm, pn; if (!pg8::tile_order(i, NB_, bid_(), 64, 20, pm, pn)) return false;
        u.A = (const char*)(WS_(*p, Hb) + (size_t)pm * 256 * D); u.B = (const char*)(WS_(*p, mb_win_t) + (size_t)pn * 256 * D); u.row0 = pm * 256; u.col0 = pn * 256; u.id = 0; u.aux = 0; return true;
    }
};
struct EpiMbIn {
    const Params* p;
    DEV void operator()(const AccT& acc, const Unit& u, int wr, int wc, int fr, int fq) const {
        const bool isz = u.col0 < 2048; bf16_t* O = WS_(*p, Z) + (isz ? (size_t)0 : (size_t)T * 2048 - 2048); const int ld = isz ? 2048 : 3072;
        FOR_ACC2(ai, bj, m) { st_bf8p(O + (size_t)ACC_ROW(u, ai, m) * ld + ACC_COL8P(u, bj, PF(4)), acc[ai][bj][m][0], acc[ai][bj][m][1], PF(4)); ACC_FENCE; }
    }
};
DEV void phase_mb_conv(const Params& p, int j) {
    const int tid = tid_(), bid = bid_(); (void)tid; (void)bid;
    if (tid >= 384) return;
    const int c0 = tid * 8; const int t0 = bid * 64;
    const float* cw = p.mb_conv_w + (size_t)j * 4 * 3072; const float* cb = p.mb_conv_b + (size_t)j * 3072;
    float w[4][8], b[8];
#pragma unroll
    for (int i = 0; i < 4; ++i) { const f32x4 a = *(const f32x4*)(cw + i * 3072 + c0), bb = *(const f32x4*)(cw + i * 3072 + c0 + 4); for (int e = 0; e < 4; ++e) { w[i][e] = a[e]; w[i][4 + e] = bb[e]; } }
    { const f32x4 a = *(const f32x4*)(cb + c0), bb = *(const f32x4*)(cb + c0 + 4); for (int e = 0; e < 4; ++e) { b[e] = a[e]; b[4 + e] = bb[e]; } }
    float x0[8], x1[8], x2[8], x3[8];
    auto ld = [&](int t, float (&x)[8]) {
        if (t < 0) { for (int e = 0; e < 8; ++e) x[e] = 0.f; return; }
        const u32x4 v = *(const u32x4*)(WS_(p, XBC) + (size_t)t * 3072 + c0);
        x[0] = bflo(v.x); x[1] = bfhi(v.x); x[2] = bflo(v.y); x[3] = bfhi(v.y); x[4] = bflo(v.z); x[5] = bfhi(v.z); x[6] = bflo(v.w); x[7] = bfhi(v.w);
    };
    ld(t0 - 3, x0); ld(t0 - 2, x1); ld(t0 - 1, x2);
#pragma unroll 4
    for (int tt = 0; tt < 64; ++tt) {
        ld(t0 + tt, x3);
        float o[8];
#pragma unroll
        for (int e = 0; e < 8; ++e) o[e] = siluf_(b[e] + w[0][e] * x0[e] + w[1][e] * x1[e] + w[2][e] * x2[e] + w[3][e] * x3[e]);
        u32x4 r; r.x = pk2(o[0], o[1]); r.y = pk2(o[2], o[3]); r.z = pk2(o[4], o[5]); r.w = pk2(o[6], o[7]);
        *(u32x4*)(WS_(p, XC) + (size_t)(t0 + tt) * 3072 + c0) = r;
#pragma unroll
        for (int e = 0; e < 8; ++e) { x0[e] = x1[e]; x1[e] = x2[e]; x2[e] = x3[e]; }
    }
}

DEV void mb_dacs(const Params& p, int j, int c, int g, LAS float* dts, LAS float* dacs) {
    const int tid = tid_(); const int lane = tid & 63, h = tid >> 6;
    const int hh = 8 * g + h; const float a = -__expf(p.mb_a_log[j * 32 + hh]);
    const float d0 = WS_(p, DT)[(size_t)(c * 128 + 2 * lane) * 32 + hh], d1 = WS_(p, DT)[(size_t)(c * 128 + 2 * lane + 1) * 32 + hh];
    const float a0 = d0 * a, a1 = d1 * a;
    float s = a0 + a1;
#pragma unroll
    for (int o = 1; o < 64; o <<= 1) { const float v = __shfl_up(s, o); if (lane >= o) s += v; }
    dts[h * 128 + 2 * lane] = d0; dts[h * 128 + 2 * lane + 1] = d1;
    dacs[h * 128 + 2 * lane] = s - a1; dacs[h * 128 + 2 * lane + 1] = s;
}
constexpr int LDB = 136;
constexpr int LDX = 72;
DEV void ld_tile128(const bf16_t* src, int gld, LAS bf16_t* dst) {
    const int tid = tid_();
    for (int i = tid; i < 128 * 16; i += NTHR) { const int r = i >> 4, c8 = (i & 15) * 8; *(LAS u32x4*)(dst + r * LDB + c8) = *(const u32x4*)(src + (size_t)r * gld + c8); }
}

DEV void phase_mb_states(const Params& p, int j, LAS unsigned char* lds) {
    const int tid = tid_(), bid = bid_(); (void)tid; (void)bid;
    const int lane = tid & 63, w = tid >> 6;
    LAS bf16_t* Bm = (LAS bf16_t*)lds;
    LAS bf16_t* Xh = Bm + 128 * LDB;
    LAS float* dts = (LAS float*)(Xh + 128 * LDX);
    LAS float* dacs = dts + 1024;
    for (int u = bid; u < 512; u += NB_) {
        const int c = u >> 2, g = u & 3; const int t0 = c * 128;
        lds_barrier();
        mb_dacs(p, j, c, g, dts, dacs);
        ld_tile128(WS_(p, XC) + (size_t)t0 * 3072 + 2048 + 128 * g, 3072, Bm);
        lds_barrier();
        if (tid < 8) WS_(p, CD)[(c * 32) + 8 * g + tid] = __expf(dacs[tid * 128 + 127]);
        bf16x8 bfr[4];
#pragma unroll
        for (int ks = 0; ks < 4; ++ks) bfr[ks] = frag_tr(Bm, LDB, 32 * ks, 16 * w, lane);
        for (int h = 0; h < 8; ++h) {
            { const int l = tid >> 2, p0 = (tid & 3) * 16; const float sc = dts[h * 128 + l] * __expf(dacs[h * 128 + 127] - dacs[h * 128 + l]);
              const bf16_t* src = WS_(p, XC) + (size_t)(t0 + l) * 3072 + 64 * (8 * g + h) + p0;
#pragma unroll
              for (int hf = 0; hf < 2; ++hf) { const u32x4 v = *(const u32x4*)(src + 8 * hf); u32x4 r;
                  r.x = pk2(bflo(v.x) * sc, bfhi(v.x) * sc); r.y = pk2(bflo(v.y) * sc, bfhi(v.y) * sc); r.z = pk2(bflo(v.z) * sc, bfhi(v.z) * sc); r.w = pk2(bflo(v.w) * sc, bfhi(v.w) * sc);
                  *(LAS u32x4*)(Xh + l * LDX + p0 + 8 * hf) = r; } }
            lds_barrier();
            f32x4 acc[4];
#pragma unroll
            for (int pb = 0; pb < 4; ++pb) { acc[pb] = (f32x4){0.f, 0.f, 0.f, 0.f};
#pragma unroll
                for (int ks = 0; ks < 4; ++ks) { const bf16x8 af = frag_tr(Xh, LDX, 32 * ks, 16 * pb, lane); acc[pb] = MFMA16(af, bfr[ks], acc[pb]); } }
            bf16_t* S = WS_(p, STATES) + (((size_t)c * 32 + 8 * g + h) * 64) * 128;
#pragma unroll
            for (int pb = 0; pb < 4; ++pb)
#pragma unroll
                for (int r = 0; r < 4; ++r) S[(size_t)(16 * pb + 4 * (lane >> 4) + r) * 128 + 16 * w + (lane & 15)] = (bf16_t)f2bf(acc[pb][r]);
            lds_barrier();
        }
    }
}
DEV void phase_mb_scan(const Params& p) {
    const int tid = tid_(), bid = bid_();
    if (tid >= 128) return;
    const int gid = bid * 128 + tid;
    const int n8 = gid & 15, pp = (gid >> 4) & 63, h = gid >> 10; const int n = 8 * n8;
    float r[8]; for (int e = 0; e < 8; ++e) r[e] = 0.f;
    const size_t eo = ((size_t)h * 64 + pp) * 128 + n;
    const size_t fo = (size_t)h * 64 * 128 + fragmajor_off(pp, n, 128);
#pragma unroll 8
    for (int c = 0; c < 128; ++c) {
        const u32x4 sr = *(const u32x4*)(WS_(p, STATES) + (size_t)c * 32 * 64 * 128 + eo);
        const float cd = WS_(p, CD)[c * 32 + h];
        u32x4 o; o.x = pk2(r[0], r[1]); o.y = pk2(r[2], r[3]); o.z = pk2(r[4], r[5]); o.w = pk2(r[6], r[7]);
        *(u32x4*)(WS_(p, PREV) + (size_t)c * 32 * 64 * 128 + fo) = o;
        r[0] = r[0] * cd + bflo(sr.x); r[1] = r[1] * cd + bfhi(sr.x); r[2] = r[2] * cd + bflo(sr.y); r[3] = r[3] * cd + bfhi(sr.y);
        r[4] = r[4] * cd + bflo(sr.z); r[5] = r[5] * cd + bfhi(sr.z); r[6] = r[6] * cd + bflo(sr.w); r[7] = r[7] * cd + bfhi(sr.w);
    }
}
DEV void phase_mb_out(const Params& p, int j, LAS unsigned char* lds) {
    const int tid = tid_(), bid = bid_(); (void)tid; (void)bid;
    const int lane = tid & 63, w = tid >> 6; const int fr = lane & 15, fq = lane >> 4;
    LAS bf16_t* Cm = (LAS bf16_t*)lds;
    LAS bf16_t* Bm = Cm + 128 * LDB;
    LAS bf16_t* Xh = Bm + 128 * LDB;
    LAS bf16_t* Mw = Xh + 128 * LDX;
    LAS float* dts = (LAS float*)(Mw + 8 * 16 * LDB);
    LAS float* dacs = dts + 1024;
    LAS bf16_t* Mme = Mw + w * 16 * LDB;
    for (int u = bid; u < 512; u += NB_) {
        const int c = u >> 2, g = u & 3; const int t0 = c * 128;
        lds_barrier();
        mb_dacs(p, j, c, g, dts, dacs);
        ld_tile128(WS_(p, XC) + (size_t)t0 * 3072 + 2048 + 512 + 128 * g, 3072, Cm);
        ld_tile128(WS_(p, XC) + (size_t)t0 * 3072 + 2048 + 128 * g, 3072, Bm);
        lds_barrier();
        f32x4 sc[8]; bf16x8 cf[4];
#pragma unroll
        for (int ks = 0; ks < 4; ++ks) cf[ks] = frag_rm(Cm, LDB, 16 * w, 32 * ks, lane);
#pragma unroll
        for (int sb = 0; sb < 8; ++sb) { sc[sb] = (f32x4){0.f, 0.f, 0.f, 0.f};
#pragma unroll
            for (int ks = 0; ks < 4; ++ks) sc[sb] = MFMA16(cf[ks], frag_rm(Bm, LDB, 16 * sb, 32 * ks, lane), sc[sb]); }
        float ssq = 0.f;
        const int rl = tid >> 2, p0 = (tid & 3) * 16;
        const LAS float* Yrow = (const LAS float*)(Mw + (rl >> 4) * 16 * LDB) + (rl & 15) * 68 + p0;
        LAS float* Yw = (LAS float*)Mme;
        u32x4 xraw[2], zraw[2], xnx[2], znx[2]; bf16x8 pfc[16];
#define MB_LOADH(HH, XR, ZR) do { const int hh_ = 8 * g + (HH); \
            XR[0] = *(const u32x4*)(WS_(p, XC) + (size_t)(t0 + rl) * 3072 + 64 * hh_ + p0); XR[1] = *(const u32x4*)(WS_(p, XC) + (size_t)(t0 + rl) * 3072 + 64 * hh_ + p0 + 8); \
            ZR[0] = *(const u32x4*)(WS_(p, Z) + (size_t)(t0 + rl) * 2048 + 64 * hh_ + p0); ZR[1] = *(const u32x4*)(WS_(p, Z) + (size_t)(t0 + rl) * 2048 + 64 * hh_ + p0 + 8); } while (0)
        MB_LOADH(0, xraw, zraw);
#pragma unroll 1
        for (int h = 0; h < 8; ++h) {
            const int hh = 8 * g + h;
            MB_LOADH(h < 7 ? h + 1 : h, xnx, znx);
            { const bf16_t* pv_ = WS_(p, PREV) + ((size_t)c * 32 + hh) * 64 * 128;
#pragma unroll
              for (int i_ = 0; i_ < 16; ++i_) pfc[i_] = *(const bf16x8*)(pv_ + ((size_t)i_ * 64 + lane) * 8); }
            { const float scl = dts[h * 128 + rl];
#pragma unroll
              for (int hf = 0; hf < 2; ++hf) { const u32x4 v = xraw[hf]; u32x4 r;
                  r.x = pk2(bflo(v.x) * scl, bfhi(v.x) * scl); r.y = pk2(bflo(v.y) * scl, bfhi(v.y) * scl); r.z = pk2(bflo(v.z) * scl, bfhi(v.z) * scl); r.w = pk2(bflo(v.w) * scl, bfhi(v.w) * scl);
                  *(LAS u32x4*)(Xh + rl * LDX + p0 + 8 * hf) = r; } }
            const u32x4 zraw0 = zraw[0], zraw1 = zraw[1];
            float dl[4];
#pragma unroll
            for (int r = 0; r < 4; ++r) dl[r] = dacs[h * 128 + 16 * w + 4 * fq + r];
#pragma unroll
            for (int sb = 0; sb < 8; ++sb) { const int s_ = 16 * sb + fr; const float ds = dacs[h * 128 + s_];
#pragma unroll
                for (int r = 0; r < 4; ++r) { const int l = 16 * w + 4 * fq + r; const float m = (s_ <= l) ? sc[sb][r] * __expf(dl[r] - ds) : 0.f; Mme[(4 * fq + r) * LDB + s_] = (bf16_t)f2bf(m); } }
            lds_barrier();
            bf16x8 mf[4];
#pragma unroll
            for (int ks = 0; ks < 4; ++ks) mf[ks] = frag_rm(Mme, LDB, 0, 32 * ks, lane);
            f32x4 yv[4];
#pragma unroll
            for (int pb = 0; pb < 4; ++pb) {
                f32x4 a = {0.f, 0.f, 0.f, 0.f}, o = {0.f, 0.f, 0.f, 0.f};
#pragma unroll
                for (int ks = 0; ks < 4; ++ks) {
                    a = MFMA16(mf[ks], frag_tr(Xh, LDX, 32 * ks, 16 * pb, lane), a);
                    o = MFMA16(cf[ks], pfc[pb * 4 + ks], o);
                }
#pragma unroll
                for (int r = 0; r < 4; ++r) a[r] += o[r] * __expf(dl[r]);
                yv[pb] = a;
            }
#pragma unroll
            for (int pb = 0; pb < 4; ++pb)
#pragma unroll
                for (int r = 0; r < 4; ++r) Yw[(4 * fq + r) * 68 + 16 * pb + fr] = yv[pb][r];
            lds_barrier();
            {
                const float dsk = p.mb_d[j * 32 + hh]; const float* ng = p.mb_norm_g + (size_t)j * 2048 + 64 * hh + p0;
                float y[16], xs[16], zz[16];
#pragma unroll
                for (int q = 0; q < 4; ++q) { const f32x4 t4 = *(const LAS f32x4*)(Yrow + 4 * q); y[4 * q] = t4[0]; y[4 * q + 1] = t4[1]; y[4 * q + 2] = t4[2]; y[4 * q + 3] = t4[3]; }
                xs[0] = bflo(xraw[0].x); xs[1] = bfhi(xraw[0].x); xs[2] = bflo(xraw[0].y); xs[3] = bfhi(xraw[0].y); xs[4] = bflo(xraw[0].z); xs[5] = bfhi(xraw[0].z); xs[6] = bflo(xraw[0].w); xs[7] = bfhi(xraw[0].w);
                xs[8] = bflo(xraw[1].x); xs[9] = bfhi(xraw[1].x); xs[10] = bflo(xraw[1].y); xs[11] = bfhi(xraw[1].y); xs[12] = bflo(xraw[1].z); xs[13] = bfhi(xraw[1].z); xs[14] = bflo(xraw[1].w); xs[15] = bfhi(xraw[1].w);
                zz[0] = bflo(zraw0.x); zz[1] = bfhi(zraw0.x); zz[2] = bflo(zraw0.y); zz[3] = bfhi(zraw0.y); zz[4] = bflo(zraw0.z); zz[5] = bfhi(zraw0.z); zz[6] = bflo(zraw0.w); zz[7] = bfhi(zraw0.w);
                zz[8] = bflo(zraw1.x); zz[9] = bfhi(zraw1.x); zz[10] = bflo(zraw1.y); zz[11] = bfhi(zraw1.y); zz[12] = bflo(zraw1.z); zz[13] = bfhi(zraw1.z); zz[14] = bflo(zraw1.w); zz[15] = bfhi(zraw1.w);
                float o[16];
#pragma unroll
                for (int q = 0; q < 4; ++q) { const f32x4 n4 = *(const f32x4*)(ng + 4 * q);
#pragma unroll
                    for (int e = 0; e < 4; ++e) { const int i = 4 * q + e; const float v = (y[i] + xs[i] * dsk) * siluf_(zz[i]); ssq += v * v; o[i] = v * n4[e]; } }
                bf16_t* dst = WS_(p, YB) + (size_t)(t0 + rl) * 2048 + 64 * hh + p0;
                u32x4 w0, w1; w0.x = pk2(o[0], o[1]); w0.y = pk2(o[2], o[3]); w0.z = pk2(o[4], o[5]); w0.w = pk2(o[6], o[7]); w1.x = pk2(o[8], o[9]); w1.y = pk2(o[10], o[11]); w1.z = pk2(o[12], o[13]); w1.w = pk2(o[14], o[15]);
                *(u32x4*)dst = w0; *(u32x4*)(dst + 8) = w1;
            }
            xraw[0] = xnx[0]; xraw[1] = xnx[1]; zraw[0] = znx[0]; zraw[1] = znx[1];
            lds_barrier();
        }
#undef MB_LOADH
        ssq += __shfl_xor(ssq, 1); ssq += __shfl_xor(ssq, 2);
        const float rstd = rsqrtf(ssq * (1.0f / 512.0f) + 1e-5f);
#pragma unroll 1
        for (int h = 0; h < 8; ++h) {
            bf16_t* dst = WS_(p, YB) + (size_t)(t0 + rl) * 2048 + 64 * (8 * g + h) + p0;
#pragma unroll
            for (int hf = 0; hf < 2; ++hf) { const u32x4 v = *(const u32x4*)(dst + 8 * hf); u32x4 r;
                r.x = pk2(bflo(v.x) * rstd, bfhi(v.x) * rstd); r.y = pk2(bflo(v.y) * rstd, bfhi(v.y) * rstd); r.z = pk2(bflo(v.z) * rstd, bfhi(v.z) * rstd); r.w = pk2(bflo(v.w) * rstd, bfhi(v.w) * rstd);
                *(u32x4*)(dst + 8 * hf) = r; }
        }
    }
}
constexpr int GL_PROJ = 3088;
constexpr int LDV = 264;
struct SchedGlIn {
    const Params* p;
    DEV bool next(int i, Unit& u) const {
        int pm, pn; if (!pg8::tile_order(i, NB_, bid_(), 64, 12, pm, pn)) return false;
        u.A = (const char*)(WS_(*p, Hb) + (size_t)pm * 256 * D); u.B = (const char*)(WS_(*p, gl_win_t) + (size_t)pn * 256 * D); u.row0 = pm * 256; u.col0 = pn * 256; u.id = 0; u.aux = 0; return true;
    }
};
struct EpiGlIn {
    const Params* p;
    DEV void operator()(const AccT& acc, const Unit& u, int wr, int wc, int fr, int fq) const {
        FOR_ACC2(ai, bj, m) { st_bf8p(WS_(*p, QKVG) + (size_t)ACC_ROW(u, ai, m) * 3072 + ACC_COL8P(u, bj, PF(5)), acc[ai][bj][m][0], acc[ai][bj][m][1], PF(5)); ACC_FENCE; }
    }
};
DEV void gl_bcs(const Params& p, int n, int h, LAS float* bcs) {
    const int tid = tid_();
    for (int i = tid; i < 64 * 32; i += NTHR) { const int r = i >> 5, c4 = (i & 31) * 4; *(LAS f32x4*)(bcs + r * 128 + c4) = *(const f32x4*)(WS_(p, LA) + (size_t)(n * 64 + r) * 512 + 128 * h + c4); }
    lds_barrier();
    if (tid < 128) { float s = 0.f; for (int r = 0; r < 64; ++r) { s += bcs[r * 128 + tid]; bcs[r * 128 + tid] = s; } }
    lds_barrier();
}
DEV void phase_gl_kv(const Params& p, LAS unsigned char* lds) {
    const int tid = tid_(), bid = bid_(); (void)tid; (void)bid;
    const int lane = tid & 63, w = tid >> 6;
    LAS float* bcs = (LAS float*)lds;
    LAS bf16_t* Ke = (LAS bf16_t*)(bcs + 64 * 128);
    LAS bf16_t* Vs = Ke + 64 * LDB;
    for (int u = bid; u < 1024; u += NB_) {
        const int n = u >> 2, h = u & 3; const int t0 = n * 64;
        lds_barrier();
        gl_bcs(p, n, h, bcs);
        for (int i = tid; i < 64 * 16; i += NTHR) { const int r = i >> 4, c8 = (i & 15) * 8;
            const u32x4 v = *(const u32x4*)(WS_(p, QKVG) + (size_t)(t0 + r) * 3072 + 512 + 128 * h + c8); float f[8];
            f[0] = bflo(v.x); f[1] = bfhi(v.x); f[2] = bflo(v.y); f[3] = bfhi(v.y); f[4] = bflo(v.z); f[5] = bfhi(v.z); f[6] = bflo(v.w); f[7] = bfhi(v.w);
#pragma unroll
            for (int e = 0; e < 8; ++e) f[e] *= __expf(bcs[63 * 128 + c8 + e] - bcs[r * 128 + c8 + e]);
            u32x4 o; o.x = pk2(f[0], f[1]); o.y = pk2(f[2], f[3]); o.z = pk2(f[4], f[5]); o.w = pk2(f[6], f[7]);
            *(LAS u32x4*)(Ke + r * LDB + c8) = o; }
        for (int i = tid; i < 64 * 32; i += NTHR) { const int r = i >> 5, c8 = (i & 31) * 8; *(LAS u32x4*)(Vs + r * LDV + c8) = *(const u32x4*)(WS_(p, QKVG) + (size_t)(t0 + r) * 3072 + 1024 + 256 * h + c8); }
        if (tid < 128) WS_(p, CDG)[((size_t)n * 4 + h) * 128 + tid] = __expf(bcs[63 * 128 + tid]);
        lds_barrier();
        bf16x8 af[2];
#pragma unroll
        for (int ks = 0; ks < 2; ++ks) af[ks] = frag_tr(Ke, LDB, 32 * ks, 16 * w, lane);
        bf16_t* O = WS_(p, STATES) + (((size_t)n * 4 + h) * 128) * 256;
#pragma unroll
        for (int vb = 0; vb < 16; ++vb) {
            f32x4 acc = {0.f, 0.f, 0.f, 0.f};
#pragma unroll
            for (int ks = 0; ks < 2; ++ks) acc = MFMA16(af[ks], frag_tr(Vs, LDV, 32 * ks, 16 * vb, lane), acc);
            { u32x2 o; o.x = pk2(acc[0], acc[1]); o.y = pk2(acc[2], acc[3]); *(u32x2*)(O + (size_t)(16 * vb + (lane & 15)) * 128 + 16 * w + 4 * (lane >> 4)) = o; }
        }
    }
}
DEV void phase_gl_scan(const Params& p) {
    const int tid = tid_(), bid = bid_();
    if (tid >= 64) return;
    const int gid = bid * 64 + tid;
    const int k8 = gid & 15, v = (gid >> 4) & 255, h = gid >> 12; const int k = 8 * k8;
    float r[8]; for (int e = 0; e < 8; ++e) r[e] = 0.f;
    const size_t fo = (size_t)h * 128 * 256 + fragmajor_off(v, k, 128);
#pragma unroll 8
    for (int n = 0; n < 256; ++n) {
        const u32x4 sr = *(const u32x4*)(WS_(p, STATES) + (((size_t)n * 4 + h) * 256 + v) * 128 + k);
        const f32x4 c0 = *(const f32x4*)(WS_(p, CDG) + ((size_t)n * 4 + h) * 128 + k), c1 = *(const f32x4*)(WS_(p, CDG) + ((size_t)n * 4 + h) * 128 + k + 4);
        u32x4 o; o.x = pk2(r[0], r[1]); o.y = pk2(r[2], r[3]); o.z = pk2(r[4], r[5]); o.w = pk2(r[6], r[7]);
        *(u32x4*)(WS_(p, PREV) + (size_t)n * 4 * 128 * 256 + fo) = o;
        r[0] = r[0] * c0[0] + bflo(sr.x); r[1] = r[1] * c0[1] + bfhi(sr.x); r[2] = r[2] * c0[2] + bflo(sr.y); r[3] = r[3] * c0[3] + bfhi(sr.y);
        r[4] = r[4] * c1[0] + bflo(sr.z); r[5] = r[5] * c1[1] + bfhi(sr.z); r[6] = r[6] * c1[2] + bflo(sr.w); r[7] = r[7] * c1[3] + bfhi(sr.w);
    }
}
DEV void phase_gl_out(const Params& p, int j, LAS unsigned char* lds) {
    const int tid = tid_(), bid = bid_(); (void)tid; (void)bid;
    const int lane = tid & 63, w = tid >> 6; const int fr = lane & 15, fq = lane >> 4;
    LAS float* bcs = (LAS float*)lds;
    LAS bf16_t* Qs = (LAS bf16_t*)(bcs + 64 * 128);
    LAS bf16_t* Ks = Qs + 64 * LDB;
    LAS bf16_t* Vs = Ks + 64 * LDB;
    LAS bf16_t* At = Vs + 64 * LDV;
    LAS float* red = (LAS float*)(At + 64 * LDX);
    for (int u = bid; u < 1024; u += NB_) {
        const int n = u >> 2, h = u & 3; const int t0 = n * 64;
        lds_barrier();
        gl_bcs(p, n, h, bcs);
        for (int i = tid; i < 64 * 16; i += NTHR) { const int r = i >> 4, c8 = (i & 15) * 8;
            const u32x4 vq = *(const u32x4*)(WS_(p, QKVG) + (size_t)(t0 + r) * 3072 + 128 * h + c8), vk = *(const u32x4*)(WS_(p, QKVG) + (size_t)(t0 + r) * 3072 + 512 + 128 * h + c8);
            float fq_[8], fk_[8];
            fq_[0] = bflo(vq.x); fq_[1] = bfhi(vq.x); fq_[2] = bflo(vq.y); fq_[3] = bfhi(vq.y); fq_[4] = bflo(vq.z); fq_[5] = bfhi(vq.z); fq_[6] = bflo(vq.w); fq_[7] = bfhi(vq.w);
            fk_[0] = bflo(vk.x); fk_[1] = bfhi(vk.x); fk_[2] = bflo(vk.y); fk_[3] = bfhi(vk.y); fk_[4] = bflo(vk.z); fk_[5] = bfhi(vk.z); fk_[6] = bflo(vk.w); fk_[7] = bfhi(vk.w);
#pragma unroll
            for (int e = 0; e < 8; ++e) { const float b = bcs[r * 128 + c8 + e]; fq_[e] *= __expf(b) * 0.08838834764831845f; fk_[e] *= __expf(-b); }
            u32x4 o; o.x = pk2(fq_[0], fq_[1]); o.y = pk2(fq_[2], fq_[3]); o.z = pk2(fq_[4], fq_[5]); o.w = pk2(fq_[6], fq_[7]);
            *(LAS u32x4*)(Qs + r * LDB + c8) = o;
            o.x = pk2(fk_[0], fk_[1]); o.y = pk2(fk_[2], fk_[3]); o.z = pk2(fk_[4], fk_[5]); o.w = pk2(fk_[6], fk_[7]);
            *(LAS u32x4*)(Ks + r * LDB + c8) = o; }
        for (int i = tid; i < 64 * 32; i += NTHR) { const int r = i >> 5, c8 = (i & 31) * 8; *(LAS u32x4*)(Vs + r * LDV + c8) = *(const u32x4*)(WS_(p, QKVG) + (size_t)(t0 + r) * 3072 + 1024 + 256 * h + c8); }
        lds_barrier();
        { const int ib = w >> 1;
#pragma unroll
          for (int jj = 0; jj < 2; ++jj) { const int jb = 2 * (w & 1) + jj; f32x4 a = {0.f, 0.f, 0.f, 0.f};
#pragma unroll
              for (int ks = 0; ks < 4; ++ks) a = MFMA16(frag_rm(Qs, LDB, 16 * ib, 32 * ks, lane), frag_rm(Ks, LDB, 16 * jb, 32 * ks, lane), a);
#pragma unroll
              for (int r = 0; r < 4; ++r) { const int i = 16 * ib + 4 * fq + r, jx = 16 * jb + fr; At[i * LDX + jx] = (bf16_t)f2bf(jx <= i ? a[r] : 0.f); } } }
        lds_barrier();
        f32x4 o[4][2];
        const bf16_t* pv = WS_(p, PREV) + ((size_t)n * 4 + h) * 128 * 256;
#pragma unroll
        for (int vv = 0; vv < 2; ++vv) { const int vb = 2 * w + vv;
            bf16x8 bi[2], bp[4];
#pragma unroll
            for (int ks = 0; ks < 2; ++ks) bi[ks] = frag_tr(Vs, LDV, 32 * ks, 16 * vb, lane);
#pragma unroll
            for (int ks = 0; ks < 4; ++ks) bp[ks] = *(const bf16x8*)(pv + ((size_t)(vb * 4 + ks) * 64 + lane) * 8);
#pragma unroll
            for (int ib = 0; ib < 4; ++ib) { f32x4 a = {0.f, 0.f, 0.f, 0.f};
#pragma unroll
                for (int ks = 0; ks < 2; ++ks) a = MFMA16(frag_rm(At, LDX, 16 * ib, 32 * ks, lane), bi[ks], a);
#pragma unroll
                for (int ks = 0; ks < 4; ++ks) a = MFMA16(frag_rm(Qs, LDB, 16 * ib, 32 * ks, lane), bp[ks], a);
                o[ib][vv] = a; } }
#pragma unroll
        for (int ib = 0; ib < 4; ++ib)
#pragma unroll
            for (int r = 0; r < 4; ++r) { float s = o[ib][0][r] * o[ib][0][r] + o[ib][1][r] * o[ib][1][r]; s = sum16(s); if (fr == 0) red[w * 64 + 16 * ib + 4 * fq + r] = s; }
        lds_barrier();
        {   LAS bf16_t* Os = (LAS bf16_t*)bcs;
#pragma unroll
            for (int ib = 0; ib < 4; ++ib)
#pragma unroll
                for (int vv = 0; vv < 2; ++vv)
#pragma unroll
                    for (int r = 0; r < 4; ++r) Os[(16 * ib + 4 * fq + r) * LDV + 32 * w + 16 * vv + fr] = (bf16_t)f2bf(o[ib][vv][r]);
            lds_barrier();
            const int row = tid >> 3, c0 = (tid & 7) * 32; const int t = t0 + row; float s = 0.f;
#pragma unroll
            for (int ww = 0; ww < 8; ++ww) s += red[ww * 64 + row];
            const float rs = rsqrtf(s * (1.0f / 256.0f) + 1e-5f);
#pragma unroll
            for (int q = 0; q < 4; ++q) {
                const u32x4 ov = *(const LAS u32x4*)(Os + row * LDV + c0 + 8 * q), gv = *(const u32x4*)(WS_(p, QKVG) + (size_t)t * 3072 + 2048 + 256 * h + c0 + 8 * q);
                const f32x4 n0 = *(const f32x4*)(p.gl_norm_g + j * 256 + c0 + 8 * q), n1 = *(const f32x4*)(p.gl_norm_g + j * 256 + c0 + 8 * q + 4);
                float r8[8];
                r8[0] = bflo(ov.x) * rs * n0[0] * siluf_(bflo(gv.x)); r8[1] = bfhi(ov.x) * rs * n0[1] * siluf_(bfhi(gv.x)); r8[2] = bflo(ov.y) * rs * n0[2] * siluf_(bflo(gv.y)); r8[3] = bfhi(ov.y) * rs * n0[3] * siluf_(bfhi(gv.y));
                r8[4] = bflo(ov.z) * rs * n1[0] * siluf_(bflo(gv.z)); r8[5] = bfhi(ov.z) * rs * n1[1] * siluf_(bfhi(gv.z)); r8[6] = bflo(ov.w) * rs * n1[2] * siluf_(bflo(gv.w)); r8[7] = bfhi(ov.w) * rs * n1[3] * siluf_(bfhi(gv.w));
                u32x4 wv; wv.x = pk2(r8[0], r8[1]); wv.y = pk2(r8[2], r8[3]); wv.z = pk2(r8[4], r8[5]); wv.w = pk2(r8[6], r8[7]);
                *(u32x4*)(WS_(p, YB) + (size_t)t * D + 256 * h + c0 + 8 * q) = wv;
            }
        }
    }
}
#define XB_TMO      128
#define XB_XCNT(j)  (256  + 64 * (j))
#define XB_XSUB(j)  (1280 + 64 * (j))
#define XB_XGEN(j)  (2304 + 64 * (j))
#define XB_TOP      3328
#define XB_TOPGEN   3392
#define XCD_BAR_WORDS 3456
#define XB_SPIN_CAP (1u << 22)
DEV unsigned xb_ld(unsigned* p)              { return __hip_atomic_load(p, __ATOMIC_RELAXED, __HIP_MEMORY_SCOPE_AGENT); }
DEV unsigned xb_add(unsigned* p, unsigned v) { return __hip_atomic_fetch_add(p, v, __ATOMIC_RELAXED, __HIP_MEMORY_SCOPE_AGENT); }
DEV unsigned xb_xcc_id() { return (unsigned)__builtin_amdgcn_s_getreg((3 << 11) | 20) & 0xFu; }
#define XB_SPIN(cond, bar) do { unsigned _sp = 0; while (cond) { __builtin_amdgcn_s_sleep(1); \
    if ((++_sp & 255u) == 0u) { if (xb_ld(&(bar)[XB_TMO])) break; if (_sp > XB_SPIN_CAP) { atomicAdd(&(bar)[XB_TMO], 1u); break; } } } } while (0)
struct XcdBarrier { unsigned* bar; unsigned x; volatile LAS unsigned* st; };
DEV XcdBarrier xcd_barrier_post(unsigned* bar, volatile LAS unsigned* st) {
    XcdBarrier b; b.bar = bar; b.x = xb_xcc_id(); b.st = st;
    if (threadIdx.x == 0) (void)xb_add(&bar[XB_XCNT(b.x)], 1u);
    return b;
}
DEV void xcd_barrier_complete(unsigned* bar, unsigned x, unsigned& nloc, unsigned& nx) {
    const unsigned G = gridDim.x * gridDim.y * gridDim.z;
    unsigned sum, cnt, mine, sp = 0u;
    for (;;) {
        sum = 0u; cnt = 0u; mine = 0u;
#pragma unroll
        for (unsigned j = 0; j < 16; ++j) { const unsigned c = xb_ld(&bar[XB_XCNT(j)]); sum += c; cnt += (c > 0u) ? 1u : 0u; mine = (j == x) ? c : mine; }
        if (sum == G) break;
        __builtin_amdgcn_s_sleep(1);
        if ((++sp & 255u) == 0u) { if (xb_ld(&bar[XB_TMO])) break; if (sp > XB_SPIN_CAP) { atomicAdd(&bar[XB_TMO], 1u); break; } }
    }
    nloc = mine > 0u ? mine : 1u; nx = cnt > 0u ? cnt : 1u;
}
DEV void xcd_barrier(const XcdBarrier& b) {
    asm volatile("s_waitcnt vmcnt(0)" ::: "memory");
    __syncthreads();
    if (threadIdx.x == 0) {
        unsigned* bar = b.bar;
        __builtin_amdgcn_s_waitcnt(0);
        unsigned nloc = b.st[0], nx = b.st[1];
        if (nloc == 0u) { xcd_barrier_complete(bar, b.x, nloc, nx); b.st[0] = nloc; b.st[1] = nx; }
        const unsigned old = xb_add(&bar[XB_XSUB(b.x)], 1u);
        const unsigned gen = old / nloc;
        if (old + 1u == (gen + 1u) * nloc) {
            __builtin_amdgcn_fence(__ATOMIC_RELEASE, "agent");
            asm volatile("s_waitcnt vmcnt(0)" ::: "memory");
            const unsigned og = xb_add(&bar[XB_TOP], 1u);
            const unsigned tg = og / nx;
            if (og + 1u == (tg + 1u) * nx) xb_add(&bar[XB_TOPGEN], 1u);
            else XB_SPIN(xb_ld(&bar[XB_TOPGEN]) == tg, bar);
            __builtin_amdgcn_fence(__ATOMIC_ACQUIRE, "agent");
            xb_add(&bar[XB_XGEN(b.x)], 1u);
            asm volatile("s_waitcnt vmcnt(0)" ::: "memory");
        } else {
            XB_SPIN(xb_ld(&bar[XB_XGEN(b.x)]) == gen, bar);
            __builtin_amdgcn_fence(__ATOMIC_ACQUIRE, "agent");
            asm volatile("s_waitcnt vmcnt(0)" ::: "memory");
        }
    }
    __syncthreads();
}

DEV void moe_tail_convert(const Params& p, LAS unsigned char* lds, int layer) {
    if (layer != 1) return;
    convert_tickets(moe_job(p, 0, layer + 1), moe_job(p, 1, layer + 1), lds, WS_(p, MFLAG) + MFLAG_TICKET * MFLAG_STRIDE, MFLAG_STRIDE);
}
DEV LAS int* moe_tab_to_lds(const Params& p, LAS unsigned char* lds) {
    LAS int* tab = (LAS int*)(lds + pg8::STAGE_BYTES);
    const int tid = tid_();
    if (tid < 256) tab[tid] = __hip_atomic_load(WS_(p, TAB) + tid, __ATOMIC_RELAXED, __HIP_MEMORY_SCOPE_AGENT);
    __syncthreads();
    return tab;
}
DEV void rw_side_convert(const Params& p, LAS unsigned char* lds, int c0, int n) {
#pragma unroll 1
    for (int c = c0; c < c0 + n; ++c) {
        const int ml = c == 0 ? 0 : c == 3 ? 1 : 3;
        const ConvJob J0 = (c == 1 || c == 2) ? make_job(p, 6 + 2 * c) : moe_job(p, 0, ml), J1 = (c == 1 || c == 2) ? make_job(p, 7 + 2 * c) : moe_job(p, 1, ml);
        convert_tickets(J0, J1, lds, WS_(p, MFLAG) + (MFLAG_SIDE + 32 * c) * MFLAG_STRIDE, MFLAG_STRIDE);
    }
}
DEV void run_phase(const Params& pin, int op, int arg, LAS unsigned char* lds) {
    Params p = pin; { size_t z_ = 0; asm volatile("" : "+s"(z_)); p.ws = pin.ws + z_; }
    const int layer = arg; const int jj = layer / 3;
#ifdef ONLY_OP
    if (op != ONLY_OP) return;
#endif
#ifdef OPMASK
    if (!((OPMASK >> op) & 1ull)) return;
#endif
    switch (op) {
    case OP_CONVERT: phase_pre0(p); phase_convert(p, lds);
#ifdef DBG
        if (blockIdx.x == 0 && threadIdx.x < 24) WS_(p, TAB)[200 + threadIdx.x] = 0;
#endif
        break;
    case OP_PRE0: break;
    case OP_RW_GEMM1: { SchedRW1 S{&p, jj}; EpiRW1 E{&p}; pg8::gemm_phase(lds, 1024, S, E); } break;
    case OP_RW_GEMM2: { SchedRW2 S{&p, jj}; EpiRW2 E{&p, jj}; pg8::gemm_phase(lds, 256, S, E); } break;
#ifdef REP_RW
#define REPL_(OPX) _Pragma("unroll 1") for (int rep_ = 0; rep_ < ((OPX) == REP_RW && layer == REP_L ? 2 : 1); ++rep_)
#else
#define REPL_(OPX)
#endif
    case OP_RW_CHA: REPL_(0) { if (bid_() >= RW_NB) phase_rw_cha(p, jj, lds, 0); __syncthreads(); } rw_side_convert(p, lds, layer == 0 ? 0 : 4, 1); break;
    case OP_RW_CHB: REPL_(1) { if (bid_() >= RW_NB) phase_rw_cha(p, jj, lds, 1); else phase_rw_chb(p, lds, 0); __syncthreads(); } if (layer == 0) rw_side_convert(p, lds, 1, 2); break;
    case OP_RW_CHC: REPL_(2) { if (bid_() >= RW_NB) phase_rw_chc(p, jj, lds, 0); else phase_rw_chb(p, lds, 1); __syncthreads(); } break;
    case OP_RW_CHD: REPL_(3) { if (bid_() >= RW_NB) phase_rw_chc(p, jj, lds, 1); __syncthreads(); } if (layer == 0) rw_side_convert(p, lds, 3, 1); break;
    case OP_RW_OUT: { SchedOut S{WS_(p, YB), WS_(p, rw_wo_t) + (size_t)jj * D * D, 1024}; EpiOut E{WS_(p, MIXb)}; pg8::gemm_phase(lds, 1024, S, E); } break;
    case OP_LN1: phase_ln1(p, layer, lds); break;
    case OP_MOE_SCATTER: phase_moe_scatter(p, lds); break;
    case OP_MOE_GEMM1: { LAS int* tab = moe_tab_to_lds(p, lds);
#ifdef REP_MOE
#pragma unroll 1
        for (int rep_ = 0; rep_ < REP_MOE; ++rep_) {
#endif
        { SchedMoe<0> S{&p, layer, tab}; EpiMoe1 E{WS_(p, ACT), WS_(p, MFLAG)}; pg8::gemm_phase(lds, 1024, S, E); }
        { SchedMoe<1> S{&p, layer, tab}; EpiMoe2 E{WS_(p, YBUF)}; pg8::gemm_phase(lds, 512, S, E); }
#ifdef REP_MOE
        }
#endif
        moe_tail_convert(p, lds, layer); } break;
    case OP_MOE_GEMM2: break;
    case OP_LN2: phase_ln2(p, layer, lds); break;
    case OP_MB_GEMM_IN: { SchedMbIn S{&p}; EpiMbIn E{&p}; pg8::gemm_phase(lds, 1024, S, E); } break;
    case OP_MB_CONV: phase_mb_conv(p, jj); break;
    case OP_MB_STATES: phase_mb_states(p, jj, lds); break;
    case OP_MB_SCAN: phase_mb_scan(p); break;
    case OP_MB_OUT: phase_mb_out(p, jj, lds); break;
    case OP_MB_GEMM_OUT: { SchedOut S{WS_(p, YB), WS_(p, mb_wout_t) + (size_t)jj * D * 2048, 2048}; EpiOut E{WS_(p, MIXb)}; pg8::gemm_phase(lds, 2048, S, E); } break;
    case OP_GL_GEMM_IN: { SchedGlIn S{&p}; EpiGlIn E{&p}; pg8::gemm_phase(lds, 1024, S, E); } break;
    case OP_GL_KV: phase_gl_kv(p, lds); break;
    case OP_GL_SCAN: phase_gl_scan(p); break;
    case OP_GL_OUT: phase_gl_out(p, jj, lds); break;
    case OP_GL_GEMM_OUT: { SchedOut S{WS_(p, YB), WS_(p, gl_wout_t) + (size_t)jj * D * D, 1024}; EpiOut E{WS_(p, MIXb)}; pg8::gemm_phase(lds, 1024, S, E); } break;
    default: break;
    }
}

constexpr int NPHASES = 1 + 11 + 10 + 9 + 11;
DEV void decode_phase(int ph, int& op, int& layer) {
    if (ph < 1) { op = OP_CONVERT; layer = 0; return; }
    int q = ph - 1; layer = 0;
    if (q >= 11) { q -= 11; layer = 1; if (q >= 10) { q -= 10; layer = 2; if (q >= 9) { q -= 9; layer = 3; } } }
    const int kind = layer % 3; const int nmix = kind == 0 ? 7 : kind == 1 ? 6 : 5;
    if (q < nmix) op = (kind == 0 ? OP_RW_GEMM1 : kind == 1 ? OP_MB_GEMM_IN : OP_GL_GEMM_IN) + q;
    else { const int m = q - nmix; op = m < 3 ? OP_LN1 + m : OP_LN2; }
}

#define X(t, n) t n##_,
template <bool COOP>
__global__ void __launch_bounds__(NTHR, 2) mega(PARAM_LIST(X) const int ph0, const int ph1) {
#undef X
    Params p;
#define X(t, n) p.n = n##_;
    PARAM_LIST(X)
#undef X

    extern __shared__ __attribute__((aligned(16))) unsigned char smem_raw[];
    LAS unsigned char* lds = (LAS unsigned char*)smem_raw;
    if constexpr (COOP) {
        volatile LAS unsigned* st = (volatile LAS unsigned*)(lds + LDS_BYTES - 16);
        if (threadIdx.x == 0) { st[0] = 0u; st[1] = 0u; }
        __syncthreads();
        XcdBarrier xb = xcd_barrier_post(WS_(p, bar), st);
        if (ph0 < 0) cg::this_grid().sync();
        for (int ph = ph0; ph < ph1; ++ph) {
            int op, arg; decode_phase(ph, op, arg);
#ifdef REPEAT_MASK
            const int reps = 1 + (int)((REPEAT_MASK >> op) & 1ull);
#else
            const int reps = 1;
#endif
#pragma unroll 1
            for (int rep = 0; rep < reps; ++rep) {
                run_phase(p, op, arg, lds);
                if (ph + 1 < ph1 || rep + 1 < reps) { xcd_barrier(xb);
#ifdef BAR2
                    xcd_barrier(xb);
#endif
                }
            }
        }
#ifdef DBG
        xcd_barrier(xb);
#ifndef DBG_WORD
#define DBG_WORD 200
#endif
        { const int code = __hip_atomic_load(WS_(p, TAB) + DBG_WORD, __ATOMIC_RELAXED, __HIP_MEMORY_SCOPE_AGENT);
          for (size_t i = (size_t)blockIdx.x * NTHR + threadIdx.x; i < (size_t)T * D; i += (size_t)NB_ * NTHR) p.out[i] = 0.f;
          __syncthreads();
          if (blockIdx.x == 0 && threadIdx.x == 0) p.out[0] = sqrtf((float)DBG_DECODE(code) * 1.68e7f); }
#endif
    } else {
        for (int ph = ph0; ph < ph1; ++ph) { int op, arg; decode_phase(ph, op, arg); run_phase(p, op, arg, lds); }
    }
}


extern "C" void kernel_launch(void* const* d_in, const int* in_sizes, int n_in, void* d_out, int out_size, void* d_ws, size_t ws_size, hipStream_t stream) {
    (void)in_sizes; (void)n_in; (void)out_size;
    Params p; std::memset((void*)&p, 0, sizeof(p));
    auto F = [&](int i) { return (const float*)d_in[i]; };
    p.x = F(0); p.ln_g = F(1); p.ln_b = F(2);
    p.rw_mu = F(3); p.rw_w_rkv = F(4); p.rw_w0 = F(5); p.rw_w1 = F(6); p.rw_w2 = F(7); p.rw_a0 = F(8);
    p.rw_a1 = F(9); p.rw_a2 = F(10); p.rw_g1 = F(11); p.rw_g2 = F(12);
    p.rw_k_k = F(13); p.rw_k_a = F(14); p.rw_r_k = F(15); p.rw_lnx_g = F(16); p.rw_lnx_b = F(17); p.rw_w_o = F(18);
    p.mb_w_in = F(19); p.mb_conv_w = F(20); p.mb_conv_b = F(21); p.mb_dt_bias = F(22); p.mb_a_log = F(23); p.mb_d = F(24); p.mb_norm_g = F(25); p.mb_w_out = F(26);
    p.gl_w_in = F(27); p.gl_gk_w2 = F(28); p.gl_gk_b = F(29); p.gl_norm_g = F(30); p.gl_w_out = F(31);
    p.moe_w_group = F(32); p.moe_b_group = F(33); p.moe_w_route = F(34); p.moe_b_route = F(35); p.moe_w_in = F(36); p.moe_w_down = F(37);
    p.out = (float*)d_out;
    p.ws = (char*)d_ws;
    if (WS_TOTAL > ws_size) { fprintf(stderr, "workspace too small: need %zu have %zu\n", (size_t)WS_TOTAL, ws_size); return; }
    unsigned* bar_ptr = (unsigned*)(p.ws + OFF_bar);
    const int np = NPHASES;
#define X(t, n) (void*)&p.n,
#if SINGLE_LAUNCH
    (void)hipFuncSetAttribute((const void*)mega<true>, hipFuncAttributeMaxDynamicSharedMemorySize, LDS_BYTES);
    (void)hipMemsetAsync(bar_ptr, 0, XCD_BAR_WORDS * sizeof(unsigned), stream);
    int ph0 = 0, ph1 = np; void* args[] = {PARAM_LIST(X) (void*)&ph0, (void*)&ph1};
    hipError_t e = hipLaunchCooperativeKernel((const void*)mega<true>, dim3(NBLK), dim3(NTHR), args, LDS_BYTES, stream);
    if (e != hipSuccess) fprintf(stderr, "cooperative launch failed: %s\n", hipGetErrorString(e));
#else
    (void)hipFuncSetAttribute((const void*)mega<false>, hipFuncAttributeMaxDynamicSharedMemorySize, LDS_BYTES);
    for (int ph = 0; ph < np; ++ph) { int ph0 = ph, ph1 = ph + 1; void* args[] = {PARAM_LIST(X) (void*)&ph0, (void*)&ph1};
        hipError_t e = hipLaunchKernel((const void*)mega<false>, dim3(NBLK), dim3(NTHR), args, LDS_BYTES, stream);
        if (e != hipSuccess) fprintf(stderr, "launch failed: %s\n", hipGetErrorString(e)); }
#endif
#undef X
}
```

```cpp
#include <hip/hip_runtime.h>
#include <hip/hip_cooperative_groups.h>
#include <cstdint>
#include <cstdio>
#include <cstring>
namespace cg = cooperative_groups;

typedef unsigned short bf16_t;
typedef short bf16x8 __attribute__((ext_vector_type(8)));
typedef short s16x4 __attribute__((ext_vector_type(4)));
typedef float f32x4 __attribute__((ext_vector_type(4)));
typedef float f32x2 __attribute__((ext_vector_type(2)));
typedef unsigned u32x4 __attribute__((ext_vector_type(4)));
typedef unsigned u32x2 __attribute__((ext_vector_type(2)));
#define LAS __attribute__((address_space(3)))
#define DEV __device__ __forceinline__

constexpr int T = 16384, D = 1024, DEPTH = 4;
constexpr int NTHR = 512, NBLK = 256;
constexpr int LDS_BYTES = 155648;
constexpr float ALPHA = 1.681792830507429f;
constexpr float LN_EPS = 1e-5f;
constexpr int MOE_ROWS = 40960;

DEV int tid_() { int t = threadIdx.x; asm volatile("" : "+v"(t)); return t; }
DEV int bid_() { int b = blockIdx.x; asm volatile("" : "+s"(b)); return b; }
#define NB_ 256
#define RCOL(q, lane) ((((q) >> 1) * 512) + 8 * (lane) + 4 * ((q) & 1))
DEV void lds_barrier() { asm volatile("s_waitcnt lgkmcnt(0)" ::: "memory"); __builtin_amdgcn_s_barrier(); asm volatile("" ::: "memory"); }
DEV unsigned f2bf(float f) { unsigned u = __float_as_uint(f); u += 0x7FFFu + ((u >> 16) & 1u); return u >> 16; }
DEV float bf2f(unsigned short b) { return __uint_as_float(((unsigned)b) << 16); }
typedef __bf16 bf16n2 __attribute__((ext_vector_type(2)));
DEV unsigned pk2(float lo, float hi) { f32x2 v = {lo, hi}; bf16n2 b = __builtin_convertvector(v, bf16n2); return __builtin_bit_cast(unsigned, b); }
DEV float bflo(unsigned u) { return __uint_as_float(u << 16); }
DEV float bfhi(unsigned u) { return __uint_as_float(u & 0xFFFF0000u); }
DEV float sigmoidf_(float x) { return 1.0f / (1.0f + __expf(-x)); }
DEV float siluf_(float x) { return x / (1.0f + __expf(-x)); }
DEV float softplusf_(float x) { return fmaxf(x, 0.f) + __logf(1.0f + __expf(-fabsf(x))); }
DEV float tanhf_(float x) { const float e = __expf(-2.0f * fabsf(x)); const float r = (1.0f - e) / (1.0f + e); return x < 0.f ? -r : r; }
DEV float wave_sum(float v) {
#pragma unroll
    for (int o = 32; o > 0; o >>= 1) v += __shfl_xor(v, o);
    return v;
}
DEV float sum16(float v) {
#pragma unroll
    for (int o = 8; o > 0; o >>= 1) v += __shfl_xor(v, o);
    return v;
}
template <int N> DEV float reduce_scatter(float (&v)[N], int lane) {
    int s = 1;
#pragma unroll
    for (int h = N / 2; h >= 1; h >>= 1) {
#pragma unroll
        for (int i = 0; i < h; ++i) {
            const bool up = (lane & s) != 0;
            const float send = up ? v[i] : v[i + h];
            const float keep = up ? v[i + h] : v[i];
            v[i] = keep + __shfl_xor(send, s);
        }
        s <<= 1;
    }
    float r = v[0];
    for (; s < 64; s <<= 1) r += __shfl_xor(r, s);
    return r;
}
template <int N> DEV int rs_index(int lane) {
    int o = 0, s = 1;
#pragma unroll
    for (int h = N / 2; h >= 1; h >>= 1) { if (lane & s) o += h; s <<= 1; }
    return o;
}

DEV bf16x8 frag_rm(const LAS bf16_t* base, int ld, int row0, int k0, int lane) {
    return *(const LAS bf16x8*)(base + (row0 + (lane & 15)) * ld + k0 + 8 * (lane >> 4));
}
DEV bf16x8 frag_tr(const LAS bf16_t* base, int ld, int k0, int c0, int lane) {
    const int g = lane >> 4, i = lane & 15, q = i >> 2, p = i & 3;
    const LAS bf16_t* a = base + (k0 + 8 * g + q) * ld + c0 + 4 * p;
    s16x4 lo = __builtin_amdgcn_ds_read_tr16_b64_v4i16((LAS s16x4*)a);
    s16x4 hi = __builtin_amdgcn_ds_read_tr16_b64_v4i16((LAS s16x4*)(a + 4 * ld));
    bf16x8 r; r[0] = lo[0]; r[1] = lo[1]; r[2] = lo[2]; r[3] = lo[3]; r[4] = hi[0]; r[5] = hi[1]; r[6] = hi[2]; r[7] = hi[3];
    return r;
}
#define MFMA16(a, b, c) __builtin_amdgcn_mfma_f32_16x16x32_bf16((a), (b), (c), 0, 0, 0)
DEV size_t fragmajor_off(int n, int k, int K) { return ((size_t)((n >> 4) * (K >> 5) + (k >> 5)) * 64 + (n & 15) + 16 * ((k & 31) >> 3)) * 8 + (k & 7); }

template <int N> DEV void skinny_group(const f32x4 (&z)[4], const LAS float* wt, int lane, LAS float* outw) {
    float pe[N];
#pragma unroll
    for (int o = 0; o < N; ++o) {
        float a = 0.f;
#pragma unroll
        for (int q = 0; q < 4; ++q) { const f32x4 w = *(const LAS f32x4*)(wt + o * 1028 + RCOL(q, lane)); a += z[q][0] * w[0] + z[q][1] * w[1] + z[q][2] * w[2] + z[q][3] * w[3]; }
        pe[o] = a;
    }
    const float r = reduce_scatter<N>(pe, lane);
    if (lane < N) outw[rs_index<N>(lane)] = r;
}
#ifndef SINGLE_LAUNCH
#define SINGLE_LAUNCH 1
#endif
constexpr size_t OFF_bar = 0ull;
constexpr size_t OFF_rw_rkv_t = 13824ull;
constexpr size_t OFF_rw_w1_t = 12596736ull;
constexpr size_t OFF_rw_a1_t = 13645312ull;
constexpr size_t OFF_rw_g1_t = 14693888ull;
constexpr size_t OFF_rw_w2_t = 15742464ull;
constexpr size_t OFF_rw_a2_t = 16791040ull;
constexpr size_t OFF_rw_g2_t = 17839616ull;
constexpr size_t OFF_rw_wo_t = 18888192ull;
constexpr size_t OFF_mb_win_t = 23082496ull;
constexpr size_t OFF_mb_wout_t = 33568256ull;
constexpr size_t OFF_gl_win_t = 37762560ull;
constexpr size_t OFF_gl_wout_t = 44054016ull;
constexpr size_t OFF_moe_w1_t = 46151168ull;
constexpr size_t OFF_moe_w2_t = 314586624ull;
constexpr size_t OFF_H = 448804352ull;
constexpr size_t OFF_H1 = 515913216ull;
constexpr size_t OFF_MIX = 583022080ull;
constexpr size_t OFF_BUF = 650130944ull;
constexpr size_t OFF_ACT = 734017024ull;
constexpr size_t OFF_YBUF = 775960064ull;
constexpr size_t OFF_CNT = 859846144ull;
constexpr size_t OFF_EIDX = 859878912ull;
constexpr size_t OFF_GATE = 860009984ull;
constexpr size_t OFF_DEST = 860141056ull;
constexpr size_t OFF_TAB = 860272128ull;
constexpr size_t OFF_YB = 860273152ull;
constexpr size_t OFF_X6 = 927382016ull;
constexpr size_t OFF_Rr = 1128708608ull;
constexpr size_t OFF_Kk = 1195817472ull;
constexpr size_t OFF_Vv = 1262926336ull;
constexpr size_t OFF_LW = 1330035200ull;
constexpr size_t OFF_Wd = 1355201024ull;
constexpr size_t OFF_Aa = 1422309888ull;
constexpr size_t OFF_Gg = 1489418752ull;
constexpr size_t OFF_RWf = 1556527616ull;
constexpr size_t OFF_RBf = 1590082048ull;
constexpr size_t OFF_RUt = 1623636480ull;
constexpr size_t OFF_RNa = 1657190912ull;
constexpr size_t OFF_RGc = 1690745344ull;
constexpr size_t OFF_RUa = 1691793920ull;
constexpr size_t OFF_RS0 = 1725348352ull;
constexpr size_t OFF_Z = 960936448ull;
constexpr size_t OFF_XBC = 1028045312ull;
constexpr size_t OFF_XC = 1128708608ull;
constexpr size_t OFF_DT = 1229371904ull;
constexpr size_t OFF_STATES = 1231469056ull;
constexpr size_t OFF_CD = 1365686784ull;
constexpr size_t OFF_PREV = 1365703168ull;
constexpr size_t OFF_LA = 1432812032ull;
constexpr size_t OFF_CDG = 1466366464ull;
constexpr size_t OFF_QKVG = OFF_XBC;
constexpr size_t WS_TOTAL = 1758902784ull;
typedef unsigned T_bar;
typedef bf16_t T_rw_rkv_t;
typedef bf16_t T_rw_w1_t;
typedef bf16_t T_rw_a1_t;
typedef bf16_t T_rw_g1_t;
typedef bf16_t T_rw_w2_t;
typedef bf16_t T_rw_a2_t;
typedef bf16_t T_rw_g2_t;
typedef bf16_t T_rw_wo_t;
typedef bf16_t T_mb_win_t;
typedef bf16_t T_mb_wout_t;
typedef bf16_t T_gl_win_t;
typedef bf16_t T_gl_wout_t;
typedef bf16_t T_moe_w1_t;
typedef bf16_t T_moe_w2_t;
typedef float T_H;
typedef float T_H1;
typedef float T_MIX;
typedef bf16_t T_BUF;
typedef bf16_t T_ACT;
typedef bf16_t T_YBUF;
typedef int T_CNT;
typedef int T_EIDX;
typedef float T_GATE;
typedef int T_DEST;
typedef int T_TAB;
typedef bf16_t T_YB;
typedef bf16_t T_X6;
typedef float T_Rr;
typedef float T_Kk;
typedef float T_Vv;
typedef bf16_t T_LW;
typedef float T_Wd;
typedef float T_Aa;
typedef float T_Gg;
typedef bf16_t T_RWf;
typedef bf16_t T_RBf;
typedef bf16_t T_RUt;
typedef bf16_t T_RNa;
typedef float T_RGc;
typedef bf16_t T_RUa;
typedef bf16_t T_RS0;
typedef bf16_t T_Z;
typedef bf16_t T_XBC;
typedef bf16_t T_XC;
typedef float T_DT;
typedef bf16_t T_STATES;
typedef float T_CD;
typedef bf16_t T_PREV;
typedef float T_LA;
typedef float T_CDG;
typedef bf16_t T_QKVG;
#define WS_(P, N) ((T_##N*)((P).ws + OFF_##N))
constexpr size_t OFF_Hb = OFF_H, OFF_H1b = OFF_H1, OFF_MIXb = OFF_MIX;
typedef bf16_t T_Hb; typedef bf16_t T_H1b; typedef bf16_t T_MIXb;
constexpr size_t OFF_moe_wr_t = OFF_H + 33554432ull;
typedef bf16_t T_moe_wr_t;
constexpr size_t OFF_mb_dt_t = OFF_moe_wr_t + 4ull * 48 * 1024 * 2, OFF_gl_lr_t = OFF_mb_dt_t + 32ull * 1024 * 2;
typedef bf16_t T_mb_dt_t; typedef bf16_t T_gl_lr_t;
constexpr size_t OFF_MFLAG = OFF_gl_lr_t + 16ull * 1024 * 2;
typedef unsigned T_MFLAG;
constexpr int MFLAG_STRIDE = 16, MFLAG_TICKET = 256, MFLAG_SIDE = 320;
constexpr size_t OFF_RBST = OFF_MFLAG + 65536;
typedef f32x4 T_RBST;
constexpr size_t OFF_Rb = OFF_Rr, OFF_Kb = OFF_Kk, OFF_Vb = OFF_Vv, OFF_Ab = OFF_Aa, OFF_Gb = OFF_Gg;
typedef bf16_t T_Rb; typedef bf16_t T_Kb; typedef bf16_t T_Vb; typedef bf16_t T_Ab; typedef bf16_t T_Gb;
constexpr size_t OFF_Wb = OFF_Wd; typedef bf16_t T_Wb;
struct ConvJob {
    const float* src; bf16_t* dst;
    int K, N, src_ld, Kpad, Npad, perm, batch;
    long long src_bs, dst_bs;
    DEV int ntiles() const { return (Kpad / 64) * (Npad / 64) * batch; }
};
#ifndef PERMF
#define PERMF 0xDF
#endif
#define PF(bit) (((PERMF) >> (bit)) & 1)
constexpr int NJOBS = 16;
constexpr int MOE_SPLIT = 32;

#define PARAM_LIST(X) \
    X(const float*, x) X(const float*, ln_g) X(const float*, ln_b) \
    X(const float*, rw_mu) X(const float*, rw_w_rkv) X(const float*, rw_w0) X(const float*, rw_w1) X(const float*, rw_w2) X(const float*, rw_a0) X(const float*, rw_a1) X(const float*, rw_a2) \
    X(const float*, rw_g1) X(const float*, rw_g2) X(const float*, rw_k_k) X(const float*, rw_k_a) X(const float*, rw_r_k) X(const float*, rw_lnx_g) X(const float*, rw_lnx_b) X(const float*, rw_w_o) \
    X(const float*, mb_w_in) X(const float*, mb_conv_w) X(const float*, mb_conv_b) X(const float*, mb_dt_bias) X(const float*, mb_a_log) X(const float*, mb_d) X(const float*, mb_norm_g) X(const float*, mb_w_out) \
    X(const float*, gl_w_in) X(const float*, gl_gk_w2) X(const float*, gl_gk_b) X(const float*, gl_norm_g) X(const float*, gl_w_out) \
    X(const float*, moe_w_group) X(const float*, moe_b_group) X(const float*, moe_w_route) X(const float*, moe_b_route) X(const float*, moe_w_in) X(const float*, moe_w_down) \
    X(float*, out) X(char*, ws)
struct Params {
#define X(t, n) t n;
    PARAM_LIST(X)
#undef X
};

enum Op : unsigned char { OP_CONVERT = 0, OP_PRE0, OP_RW_GEMM1, OP_RW_GEMM2, OP_RW_CHA, OP_RW_CHB, OP_RW_CHC, OP_RW_CHD, OP_RW_OUT,
    OP_LN1, OP_MOE_SCATTER, OP_MOE_GEMM1, OP_MOE_GEMM2, OP_LN2,
    OP_MB_GEMM_IN, OP_MB_CONV, OP_MB_STATES, OP_MB_SCAN, OP_MB_OUT, OP_MB_GEMM_OUT,
    OP_GL_GEMM_IN, OP_GL_KV, OP_GL_SCAN, OP_GL_OUT, OP_GL_GEMM_OUT };


DEV ConvJob make_job(const Params& p, int q) {
    const long long DD = (long long)D * D;
    switch (q) {
    case 0: return ConvJob{p.rw_w_rkv, WS_(p, rw_rkv_t), 1024, 1024, 1024, 1024, 1024, 0 | 2 * PF(0), 6, DD, DD};
    case 1: return ConvJob{p.rw_w1, WS_(p, rw_w1_t), 1024, 64, 64, 1024, 256, 0 | 2 * PF(1), 2, (long long)D * 64, (long long)256 * D};
    case 2: return ConvJob{p.rw_a1, WS_(p, rw_a1_t), 1024, 64, 64, 1024, 256, 0 | 2 * PF(1), 2, (long long)D * 64, (long long)256 * D};
    case 3: return ConvJob{p.rw_g1, WS_(p, rw_g1_t), 1024, 160, 160, 1024, 256, 0 | 2 * PF(1), 2, (long long)D * 160, (long long)256 * D};
    case 4: return ConvJob{p.rw_w2, WS_(p, rw_w2_t), 64, 1024, 1024, 256, 1024, 0 | 2 * PF(2), 2, (long long)64 * D, (long long)D * 256};
    case 5: return ConvJob{p.rw_a2, WS_(p, rw_a2_t), 64, 1024, 1024, 256, 1024, 0 | 2 * PF(2), 2, (long long)64 * D, (long long)D * 256};
    case 6: return ConvJob{p.rw_g2, WS_(p, rw_g2_t), 160, 1024, 1024, 256, 1024, 0 | 2 * PF(2), 2, (long long)160 * D, (long long)D * 256};
    case 7: return ConvJob{p.rw_w_o, WS_(p, rw_wo_t), 1024, 1024, 1024, 1024, 1024, 0 | 2 * PF(3), 2, DD, DD};
    case 8: return ConvJob{p.mb_w_in, WS_(p, mb_win_t), 1024, 5120, 5152, 1024, 5120, 0 | 2 * PF(4), 1, 0, 0};
    case 9: return ConvJob{p.mb_w_out, WS_(p, mb_wout_t), 2048, 1024, 1024, 2048, 1024, 0 | 2 * PF(3), 1, 0, 0};
    case 10: return ConvJob{p.gl_w_in, WS_(p, gl_win_t), 1024, 3072, 3088, 1024, 3072, 0 | 2 * PF(5), 1, 0, 0};
    case 11: return ConvJob{p.gl_w_out, WS_(p, gl_wout_t), 1024, 1024, 1024, 1024, 1024, 0 | 2 * PF(3), 1, 0, 0};
    case 12: return ConvJob{p.moe_w_in, WS_(p, moe_w1_t), 1024, 1024, 1024, 1024, 1024, 1 | 2 * PF(6), MOE_SPLIT, DD, DD};
    case 13: return ConvJob{p.moe_w_down, WS_(p, moe_w2_t), 512, 1024, 1024, 512, 1024, 0 | 2 * PF(7), MOE_SPLIT, (long long)512 * 1024, (long long)1024 * 512};
    case 14: return ConvJob{p.moe_w_in + (size_t)MOE_SPLIT * DD, WS_(p, moe_w1_t) + (size_t)MOE_SPLIT * DD, 1024, 1024, 1024, 1024, 1024, 1 | 2 * PF(6), 128 - MOE_SPLIT, DD, DD};
    default: return ConvJob{p.moe_w_down + (size_t)MOE_SPLIT * 512 * 1024, WS_(p, moe_w2_t) + (size_t)MOE_SPLIT * 512 * 1024, 512, 1024, 1024, 512, 1024, 0 | 2 * PF(7), 128 - MOE_SPLIT, (long long)512 * 1024, (long long)1024 * 512};
    }
}

DEV void convert_tile(const ConvJob& J, LAS bf16_t* tile, int local, int lane) {
    const int tk = J.Kpad / 64, tn = J.Npad / 64;
    const int b = local / (tk * tn); local -= b * tk * tn;
    const int nt = local / tk, kt = local - nt * tk;
    const float* src = J.src + (size_t)b * J.src_bs;
    bf16_t* dst = J.dst + (size_t)b * J.dst_bs;
    const int k0 = kt * 64, n0 = nt * 64;
    const int nn = (lane & 15) * 4; const bool nok = n0 + nn < J.N;
    f32x4 v[16];
#pragma unroll
    for (int i = 0; i < 16; ++i) { const int kk = (lane >> 4) + 4 * i; v[i] = (nok && k0 + kk < J.K) ? *(const f32x4*)(src + (size_t)(k0 + kk) * J.src_ld + n0 + nn) : (f32x4){0.f, 0.f, 0.f, 0.f}; }
#pragma unroll
    for (int i = 0; i < 16; ++i) { const int kk = (lane >> 4) + 4 * i;
#pragma unroll
        for (int e = 0; e < 4; ++e) tile[(nn + e) * 72 + kk] = (bf16_t)f2bf(v[i][e]); }
#pragma unroll
    for (int i = 0; i < 8; ++i) { const int r = (lane >> 3) + 8 * i, kc = (lane & 7) * 8;
        int nsrc = n0 + r, ndst = nsrc;
        if (J.perm & 1) { const int up = nsrc >= 512, jj = nsrc - (up ? 512 : 0); ndst = (jj >> 7) * 256 + (up ? 128 : 0) + (jj & 127); }
        if (J.perm & 2) { const int cc = ndst & 31; ndst = (ndst & ~31) | (((cc >> 2) & 1) << 4) | ((cc >> 3) << 2) | (cc & 3); }
        *(u32x4*)(dst + (size_t)ndst * J.Kpad + k0 + kc) = *(const LAS u32x4*)(tile + r * 72 + kc); }
}
DEV void convert_one(const ConvJob& J, LAS unsigned char* lds, int B0, int NBW, int tbeg, int WL = 8) {
    const int tid = tid_(), bid = bid_();
    const int lane = tid & 63, wv = tid >> 6; const int gw = (bid - B0) * WL + wv, NW = NBW * WL;
    if (wv >= WL) return;
    LAS bf16_t* tile = (LAS bf16_t*)lds + wv * (64 * 72);
    const int jend = tbeg + J.ntiles();
    const int ti0 = tbeg + ((gw - tbeg) % NW + NW) % NW;
#pragma unroll 1
    for (int ti = ti0; ti < jend; ti += NW) convert_tile(J, tile, ti - tbeg, lane);
}
DEV void convert_tickets(const ConvJob& J0, const ConvJob& J1, LAS unsigned char* lds, unsigned* ctrs, int stride) {
    constexpr int NG = 32;
    const int tid = tid_(); const int lane = tid & 63, wv = tid >> 6; const int g = bid_() & (NG - 1);
    unsigned* ctr = ctrs + g * stride;
    LAS bf16_t* tile = (LAS bf16_t*)lds + wv * (64 * 72);
    const int n0 = J0.ntiles(), n = n0 + J1.ntiles();
    int cur = 0; if (lane == 0) cur = (int)__hip_atomic_fetch_add(ctr, 1u, __ATOMIC_RELAXED, __HIP_MEMORY_SCOPE_AGENT);
    cur = __builtin_amdgcn_readfirstlane(cur) * NG + g;
#pragma unroll 1
    while (cur < n) {
        int nx = 0; if (lane == 0) nx = (int)__hip_atomic_fetch_add(ctr, 1u, __ATOMIC_RELAXED, __HIP_MEMORY_SCOPE_AGENT);
        const bool first = cur < n0; const ConvJob J = first ? J0 : J1;
        convert_tile(J, tile, first ? cur : cur - n0, lane);
        cur = __builtin_amdgcn_readfirstlane(nx) * NG + g;
    }
}
template <int J0, int J1> DEV int convert_jobs(const Params& p, LAS unsigned char* lds, int B0, int NBW, int tbeg = 0, int WL = 8) {
#pragma unroll
    for (int j = J0; j < J1; ++j) { const ConvJob J = make_job(p, j); convert_one(J, lds, B0, NBW, tbeg, WL); tbeg += J.ntiles(); }
    return tbeg;
}
DEV ConvJob moe_job(const Params& p, int which, int ml) {
    const long long DD = (long long)D * D; const size_t b0 = (size_t)ml * 32;
    if (which == 0) return ConvJob{p.moe_w_in + b0 * DD, WS_(p, moe_w1_t) + b0 * DD, 1024, 1024, 1024, 1024, 1024, 1 | 2 * PF(6), 32, DD, DD};
    return ConvJob{p.moe_w_down + b0 * 512 * 1024, WS_(p, moe_w2_t) + b0 * 512 * 1024, 512, 1024, 1024, 512, 1024, 0 | 2 * PF(7), 32, (long long)512 * 1024, (long long)1024 * 512};
}
DEV void phase_convert(const Params& p, LAS unsigned char* lds) {
    const int tid = tid_(), bid = bid_();
    if (bid == 1 && tid < 5 * 32) __hip_atomic_store(WS_(p, MFLAG) + (MFLAG_SIDE + tid) * MFLAG_STRIDE, 0u, __ATOMIC_RELAXED, __HIP_MEMORY_SCOPE_AGENT);
    convert_jobs<0, 8>(p, lds, 0, NB_);
    if (bid < 4 * 48) { const int layer = bid / 48, o = bid % 48;
        for (int k = tid; k < D; k += NTHR) { float v = 0.f;
            if (o < 32) v = p.moe_w_route[((size_t)layer * D + k) * 32 + o]; else if (o < 36) v = p.moe_w_group[((size_t)layer * D + k) * 4 + (o - 32)];
            WS_(p, moe_wr_t)[((size_t)layer * 48 + o) * D + k] = (bf16_t)f2bf(v); } }
    else if (bid < 4 * 48 + 32) { const int o = bid - 192;
        for (int k = tid; k < D; k += NTHR) WS_(p, mb_dt_t)[(size_t)o * D + k] = (bf16_t)f2bf(p.mb_w_in[(size_t)k * 5152 + 5120 + o]); }
    else if (bid < 4 * 48 + 48) { const int o = bid - 224;
        for (int k = tid; k < D; k += NTHR) WS_(p, gl_lr_t)[(size_t)o * D + k] = (bf16_t)f2bf(p.gl_w_in[(size_t)k * 3088 + 3072 + o]); }
}
namespace pg8 {
constexpr int BM = 256, BK = 64, HALF = 128, HTB = HALF * BK * 2, STAGE_BYTES = 8 * HTB;
DEV int lds_byte(int r, int c) { const int st = (r >> 4) * 2 + (c >> 5), rr = r & 15, cc = c & 31, ob = rr * 64 + cc * 2; return st * 1024 + (ob ^ (((ob >> 9) & 1) << 5)); }
DEV void stage_rc(int b, int& R, int& C) { const int st = b / 1024, sb = b % 1024, swz = sb ^ (((sb >> 9) & 1) << 5); R = (st >> 1) * 16 + swz / 64; C = (st & 1) * 32 + (swz % 64) / 2; }

struct Unit { const char* A; const char* B; int row0, col0, id, aux; };

DEV bool tile_order(int i, int G, int c, int nM, int nN, int& pm, int& pn) {
    const int nwg = nM * nN; const long L = (long)i * G + c; if (L >= nwg) return false;
    int wgid = (int)L; { const int q = nwg / 8, r = nwg % 8, xcd = wgid % 8, off = wgid / 8; wgid = (xcd < r ? xcd * (q + 1) : r * (q + 1) + (xcd - r) * q) + off; }
    const int nig = 8 * nN, gid = wgid / nig, fm = gid * 8, gsz = (nM - fm) < 8 ? (nM - fm) : 8;
    pm = fm + ((wgid % nig) % gsz); pn = (wgid % nig) / gsz; return true;
}

template <class Epi, class Sched>
DEV void gemm_phase(LAS unsigned char* lds, const int K, const Sched& S, const Epi& E) {
    const int tid = tid_(), wid = __builtin_amdgcn_readfirstlane(tid >> 6), lane = tid & 63, wr = wid >> 2, wc = wid & 3, fr = lane & 15, fq = lane >> 4;
    const int nt = K / BK;
    unsigned voff[2];
#pragma unroll
    for (int i = 0; i < 2; ++i) { int R, C; stage_rc(tid * 16 + i * 8192, R, C); voff[i] = (unsigned)(R * K + C) * 2u; }
    const size_t kstep = (size_t)(BK * 2);
    const size_t hstep = (size_t)HALF * K * 2;
    const unsigned ldsw = (unsigned)wid * 1024u;
    const int aoff = lds_byte(wr * 64 + fr, fq * 8), boff = lds_byte(wc * 32 + fr, fq * 8);
#define PG8_SA(b, h) (((b) * 2 + (h)) * HTB)
#define PG8_SB(b, h) ((4 + (b) * 2 + (h)) * HTB)
#define PG8_STAGE(bufoff, gbase) do { _Pragma("unroll") for (int _i = 0; _i < 2; ++_i) \
        __builtin_amdgcn_global_load_lds((const unsigned*)((const char*)(gbase) + voff[_i]), (LAS unsigned*)(lds + (bufoff) + ldsw + _i * 8192), 16, 0, 0); } while (0)
#define PG8_LDA(dst, b, h) do { _Pragma("unroll") for (int m = 0; m < 4; ++m) _Pragma("unroll") for (int k = 0; k < 2; ++k) dst[m][k] = *(const LAS bf16x8*)(lds + PG8_SA(b, h) + aoff + m * 2048 + k * 1024); } while (0)
#define PG8_LDB(dst, b, h) do { _Pragma("unroll") for (int n = 0; n < 2; ++n) _Pragma("unroll") for (int k = 0; k < 2; ++k) dst[n][k] = *(const LAS bf16x8*)(lds + PG8_SB(b, h) + boff + n * 2048 + k * 1024); } while (0)
#define PG8_MMA(ai, bj, At, Bt) do { __builtin_amdgcn_s_setprio(1); _Pragma("unroll") for (int m = 0; m < 4; ++m) _Pragma("unroll") for (int n = 0; n < 2; ++n) _Pragma("unroll") for (int k = 0; k < 2; ++k) \
        acc[ai][bj][m][n] = __builtin_amdgcn_mfma_f32_16x16x32_bf16(Bt[n][k], At[m][k], acc[ai][bj][m][n], 0, 0, 0); __builtin_amdgcn_s_setprio(0); } while (0)
#define PG8_WAIT_V(n) asm volatile("s_waitcnt vmcnt(" #n ")" ::: "memory")
#define PG8_WAIT_L(n) asm volatile("s_waitcnt lgkmcnt(" #n ")" ::: "memory")
#define PG8_BAR __builtin_amdgcn_s_barrier()
#define PG8_SCHED __builtin_amdgcn_sched_barrier(0)
    Unit cur, nxt; int ui = 0;
    if (!S.next(0, cur)) return;
    f32x4 acc[2][2][4][2];
#pragma unroll
    for (int a = 0; a < 2; ++a)
#pragma unroll
        for (int b = 0; b < 2; ++b)
#pragma unroll
            for (int m = 0; m < 4; ++m)
#pragma unroll
                for (int n = 0; n < 2; ++n) acc[a][b][m][n] = (f32x4){0.f, 0.f, 0.f, 0.f};
    bf16x8 At[4][2], B0[2][2], B1[2][2];
    const char* cA = cur.A; const char* cB = cur.B;
    PG8_STAGE(PG8_SB(0, 0), cB); PG8_STAGE(PG8_SA(0, 0), cA); PG8_STAGE(PG8_SB(0, 1), cB + hstep); PG8_STAGE(PG8_SA(0, 1), cA + hstep);
    if (wr == 1) PG8_BAR;
    PG8_WAIT_V(4); PG8_BAR;
    PG8_STAGE(PG8_SB(1, 0), cB + kstep); PG8_STAGE(PG8_SA(1, 0), cA + kstep); PG8_STAGE(PG8_SB(1, 1), cB + hstep + kstep);
    PG8_WAIT_V(6); PG8_BAR;
    for (;;) {
        const bool has_next = S.next(ui + 1, nxt);
        const char* nA = has_next ? nxt.A : cA; const char* nB = has_next ? nxt.B : cB;
#pragma unroll 1
        for (int t = 0; t < nt; t += 2) {
            const bool last = (t == nt - 2);
            const char* a1 = cA + (size_t)(t + 1) * kstep;
            const char* a2 = last ? nA : cA + (size_t)(t + 2) * kstep; const char* b2 = last ? nB : cB + (size_t)(t + 2) * kstep;
            const char* a3 = a2 + kstep; const char* b3 = b2 + kstep;
            PG8_LDB(B0, 0, 0); PG8_SCHED; PG8_LDA(At, 0, 0); PG8_STAGE(PG8_SA(1, 1), a1 + hstep);
            PG8_WAIT_L(8); PG8_BAR; PG8_WAIT_L(0); PG8_MMA(0, 0, At, B0); PG8_BAR; PG8_SCHED;
            PG8_LDB(B1, 0, 1); PG8_STAGE(PG8_SB(0, 0), b2);
            PG8_BAR; PG8_WAIT_L(0); PG8_MMA(0, 1, At, B1); PG8_BAR;
            PG8_LDA(At, 0, 1); PG8_STAGE(PG8_SA(0, 0), a2);
            PG8_BAR; PG8_WAIT_L(0); PG8_MMA(1, 0, At, B0); PG8_BAR; PG8_SCHED;
            PG8_STAGE(PG8_SB(0, 1), b2 + hstep);
            PG8_WAIT_V(6); PG8_BAR; PG8_MMA(1, 1, At, B1); PG8_BAR;
            PG8_LDB(B0, 1, 0); PG8_SCHED; PG8_LDA(At, 1, 0); PG8_STAGE(PG8_SA(0, 1), a2 + hstep);
            PG8_WAIT_L(8); PG8_BAR; PG8_WAIT_L(0); PG8_MMA(0, 0, At, B0); PG8_BAR; PG8_SCHED;
            PG8_LDB(B1, 1, 1); PG8_STAGE(PG8_SB(1, 0), b3);
            PG8_BAR; PG8_WAIT_L(0); PG8_MMA(0, 1, At, B1); PG8_BAR;
            PG8_LDA(At, 1, 1); PG8_STAGE(PG8_SA(1, 0), a3);
            PG8_BAR; PG8_WAIT_L(0); PG8_MMA(1, 0, At, B0); PG8_BAR; PG8_SCHED;
            PG8_STAGE(PG8_SB(1, 1), b3 + hstep);
            PG8_WAIT_V(6); PG8_BAR; PG8_MMA(1, 1, At, B1); PG8_BAR;
        }
        E(acc, cur, wr, wc, fr, fq);
        if (!has_next) break;
#pragma unroll
        for (int a = 0; a < 2; ++a)
#pragma unroll
            for (int b = 0; b < 2; ++b)
#pragma unroll
                for (int m = 0; m < 4; ++m)
#pragma unroll
                    for (int n = 0; n < 2; ++n) acc[a][b][m][n] = (f32x4){0.f, 0.f, 0.f, 0.f};
        cur = nxt; cA = nA; cB = nB; ++ui;
    }
    PG8_WAIT_V(0);
    if (wr == 0) PG8_BAR;
    PG8_BAR;
#undef PG8_SA
#undef PG8_SB
#undef PG8_STAGE
#undef PG8_LDA
#undef PG8_LDB
#undef PG8_MMA
#undef PG8_WAIT_V
#undef PG8_WAIT_L
#undef PG8_BAR
#undef PG8_SCHED
}
}
using pg8::Unit;
typedef f32x4 AccT[2][2][4][2];
#define FOR_ACC(ai, bj, m, n) _Pragma("unroll") for (int ai = 0; ai < 2; ++ai) _Pragma("unroll") for (int m = 0; m < 4; ++m) _Pragma("unroll") for (int bj = 0; bj < 2; ++bj) _Pragma("unroll") for (int n = 0; n < 2; ++n)
#define ACC_FENCE __builtin_amdgcn_sched_barrier(0)
#define ACC_ROW(u, ai, m) ((u).row0 + 128 * (ai) + 64 * wr + 16 * (m) + fr)
#define ACC_COLP(u, bj, n, P) ((P) ? ((u).col0 + 128 * (bj) + 32 * wc + 8 * fq + 4 * (n)) : ((u).col0 + 128 * (bj) + 32 * wc + 16 * (n) + 4 * fq))
#define ACC_COL8P(u, bj, P) ACC_COLP(u, bj, 0, P)
#define FOR_ACC2(ai, bj, m) _Pragma("unroll") for (int ai = 0; ai < 2; ++ai) _Pragma("unroll") for (int m = 0; m < 4; ++m) _Pragma("unroll") for (int bj = 0; bj < 2; ++bj)
DEV void st_bf4(bf16_t* p, f32x4 v) { u32x2 w; w.x = pk2(v[0], v[1]); w.y = pk2(v[2], v[3]); *(u32x2*)p = w; }
DEV u32x4 pk8v(f32x4 a, f32x4 b) { u32x4 w; w.x = pk2(a[0], a[1]); w.y = pk2(a[2], a[3]); w.z = pk2(b[0], b[1]); w.w = pk2(b[2], b[3]); return w; }
#ifdef ST8
DEV void st_bf8p(bf16_t* p, f32x4 a, f32x4 b, bool P) { if (P) { st_bf4(p, a); st_bf4(p + 4, b); } else { st_bf4(p, a); st_bf4(p + 16, b); } }
#else
DEV void st_bf8p(bf16_t* p, f32x4 a, f32x4 b, bool P) { if (P) *(u32x4*)p = pk8v(a, b); else { st_bf4(p, a); st_bf4(p + 16, b); } }
#endif
DEV void load_row(const float* p, int lane, f32x4 (&v)[4]) {
#pragma unroll
    for (int q = 0; q < 4; ++q) v[q] = *(const f32x4*)(p + RCOL(q, lane));
}

DEV void load_row_bf(const bf16_t* p, int lane, f32x4 (&v)[4]) {
#pragma unroll
    for (int q = 0; q < 4; ++q) { const u32x2 a = *(const u32x2*)(p + RCOL(q, lane)); v[q] = (f32x4){bflo(a.x), bfhi(a.x), bflo(a.y), bfhi(a.y)}; }
}
DEV void store_row_bf(bf16_t* p, int lane, const f32x4 (&v)[4]) {
#pragma unroll
    for (int q = 0; q < 4; ++q) st_bf4(p + RCOL(q, lane), v[q]);
}
DEV void emit_mix6(const Params& p, int j, int t, int lane, const f32x4 (&x)[4], const f32x4 (&xp)[4]) {
    const float* mu = p.rw_mu + (size_t)j * 6 * D;
#pragma unroll
    for (int s = 0; s < 6; ++s) {
#pragma unroll
        for (int q = 0; q < 4; ++q) {
            const f32x4 m = *(const f32x4*)(mu + s * D + RCOL(q, lane));
            st_bf4(WS_(p, X6) + (size_t)s * T * D + (size_t)t * D + RCOL(q, lane), x[q] + (xp[q] - x[q]) * m);
        }
        __builtin_amdgcn_sched_barrier(0);
    }
}
DEV void phase_pre0(const Params& p) {
    const int tid = tid_(), bid = bid_(); const int lane = tid & 63, wid = tid >> 6;
    f32x4 x[4], xp[4];
    const int tfirst = bid * 64 + wid * 8;
    if (tfirst > 0) load_row(p.x + (size_t)(tfirst - 1) * D, lane, xp); else { for (int q = 0; q < 4; ++q) xp[q] = (f32x4){0.f, 0.f, 0.f, 0.f}; }
    f32x4 xn[4]; load_row(p.x + (size_t)tfirst * D, lane, xn);
#pragma unroll 1
    for (int r = 0; r < 8; ++r) {
        const int t = tfirst + r;
#pragma unroll
        for (int q = 0; q < 4; ++q) x[q] = xn[q];
        load_row(p.x + (size_t)(r < 7 ? t + 1 : t) * D, lane, xn);
        store_row_bf(WS_(p, Hb) + (size_t)t * D, lane, x);
        emit_mix6(p, 0, t, lane, x, xp);
#pragma unroll
        for (int q = 0; q < 4; ++q) xp[q] = x[q];
    }
}

struct SchedRW1 {
    const Params* p; int j;
    DEV bool next(int i, Unit& u) const {
        int pm, pn; if (!pg8::tile_order(i, NB_, bid_(), 64, 15, pm, pn)) return false;
        int id, lpn; if (pn < 12) { id = pn >> 2; lpn = pn & 3; } else { id = 3 + (pn - 12); lpn = 0; }
        u.A = (const char*)(WS_(*p, X6) + (size_t)id * T * D + (size_t)pm * 256 * D);
        const bf16_t* B;
        if (id < 3) B = WS_(*p, rw_rkv_t) + ((size_t)j * 3 + id) * D * D + (size_t)lpn * 256 * D;
        else B = WS_(*p, rw_w1_t) + (size_t)(id - 3) * (2 * 256 * D) + (size_t)j * 256 * D;
        u.B = (const char*)B; u.row0 = pm * 256; u.col0 = lpn * 256; u.id = id; u.aux = 0; return true;
    }
};
struct EpiRW1 {
    const Params* p;
    DEV void operator()(const AccT& acc, const Unit& u, int wr, int wc, int fr, int fq) const {
        if (u.id < 3) {
            bf16_t* O = WS_(*p, Rb) + (size_t)u.id * 2 * T * D;
            FOR_ACC2(ai, bj, m) { st_bf8p(O + (size_t)ACC_ROW(u, ai, m) * D + ACC_COL8P(u, bj, PF(0)), acc[ai][bj][m][0], acc[ai][bj][m][1], PF(0)); ACC_FENCE; }
        } else {
            bf16_t* O = WS_(*p, LW) + (size_t)(u.id - 3) * T * 256;
            FOR_ACC2(ai, bj, m) {
                f32x4 v0 = acc[ai][bj][m][0], v1 = acc[ai][bj][m][1];
                if (u.id == 3) { for (int e = 0; e < 4; ++e) { v0[e] = tanhf_(v0[e]); v1[e] = tanhf_(v1[e]); } }
                else if (u.id == 5) { for (int e = 0; e < 4; ++e) { v0[e] = sigmoidf_(v0[e]); v1[e] = sigmoidf_(v1[e]); } }
                st_bf8p(O + (size_t)ACC_ROW(u, ai, m) * 256 + ACC_COL8P(u, bj, PF(1)), v0, v1, PF(1)); ACC_FENCE;
            }
        }
    }
};
struct SchedRW2 {
    const Params* p; int j;
    DEV bool next(int i, Unit& u) const {
        int pm, pn; if (!pg8::tile_order(i, NB_, bid_(), 64, 12, pm, pn)) return false;
        const int id = pn >> 2, lpn = pn & 3;
        u.A = (const char*)(WS_(*p, LW) + (size_t)id * T * 256 + (size_t)pm * 256 * 256);
        const bf16_t* B = WS_(*p, rw_w2_t) + (size_t)id * (2 * D * 256) + (size_t)j * D * 256 + (size_t)lpn * 256 * 256;
        u.B = (const char*)B; u.row0 = pm * 256; u.col0 = lpn * 256; u.id = id; u.aux = 0; return true;
    }
};
struct EpiRW2 {
    const Params* p; int j;
    DEV void operator()(const AccT& acc, const Unit& u, int wr, int wc, int fr, int fq) const {
        if (u.id == 0) { const float* bias = p->rw_w0 + (size_t)j * D; f32x4 bv[2][2];
#pragma unroll
            for (int bj = 0; bj < 2; ++bj)
#pragma unroll
                for (int n = 0; n < 2; ++n) bv[bj][n] = *(const f32x4*)(bias + ACC_COLP(u, bj, n, PF(2)));
            FOR_ACC2(ai, bj, m) { f32x4 vv[2];
#pragma unroll
                for (int n = 0; n < 2; ++n) { f32x4 v = acc[ai][bj][m][n]; const f32x4 b = bv[bj][n];
                    for (int e = 0; e < 4; ++e) { const float x = -(b[e] + v[e]); const float wl = -(fmaxf(x, 0.f) + __logf(1.0f + __expf(-fabsf(x)))) - 0.5f; v[e] = -__expf(wl); }
                    vv[n] = v; }
                st_bf8p(WS_(*p, Wb) + (size_t)ACC_ROW(u, ai, m) * D + ACC_COL8P(u, bj, PF(2)), vv[0], vv[1], PF(2)); ACC_FENCE; } }
        else if (u.id == 1) { const float* bias = p->rw_a0 + (size_t)j * D; f32x4 bv[2][2];
#pragma unroll
            for (int bj = 0; bj < 2; ++bj)
#pragma unroll
                for (int n = 0; n < 2; ++n) bv[bj][n] = *(const f32x4*)(bias + ACC_COLP(u, bj, n, PF(2)));
            FOR_ACC2(ai, bj, m) { f32x4 vv[2];
#pragma unroll
                for (int n = 0; n < 2; ++n) { f32x4 v = acc[ai][bj][m][n]; const f32x4 b = bv[bj][n];
                    for (int e = 0; e < 4; ++e) v[e] = sigmoidf_(b[e] + v[e]);
                    vv[n] = v; }
                st_bf8p(WS_(*p, Ab) + (size_t)ACC_ROW(u, ai, m) * D + ACC_COL8P(u, bj, PF(2)), vv[0], vv[1], PF(2)); ACC_FENCE; } }
        else { FOR_ACC2(ai, bj, m) { st_bf8p(WS_(*p, Gb) + (size_t)ACC_ROW(u, ai, m) * D + ACC_COL8P(u, bj, PF(2)), acc[ai][bj][m][0], acc[ai][bj][m][1], PF(2)); ACC_FENCE; } }
    }
};

struct SchedOut {
    const bf16_t* A; const bf16_t* Bt; int K;
    DEV bool next(int i, Unit& u) const {
        int pm, pn; if (!pg8::tile_order(i, NB_, bid_(), 64, 4, pm, pn)) return false;
        u.A = (const char*)(A + (size_t)pm * 256 * K); u.B = (const char*)(Bt + (size_t)pn * 256 * K); u.row0 = pm * 256; u.col0 = pn * 256; u.id = 0; u.aux = 0; return true;
    }
};
struct EpiOut {
    bf16_t* O;
    DEV void operator()(const AccT& acc, const Unit& u, int wr, int wc, int fr, int fq) const {
        FOR_ACC2(ai, bj, m) { st_bf8p(O + (size_t)ACC_ROW(u, ai, m) * D + ACC_COL8P(u, bj, PF(3)), acc[ai][bj][m][0], acc[ai][bj][m][1], PF(3)); ACC_FENCE; }
    }
};
constexpr int RC_LD = 72;
#ifdef DBG
#define DBGF(cond, bit) do { if (cond) atomicOr(&WS_(p, TAB)[200], (bit)); } while (0)
#else
#define DBGF(cond, bit) do {} while (0)
#endif
DEV bool bad_(float x) { return !(fabsf(x) < 1e30f); }
DEV int rc_pi(int g, int j) { return j < 4 ? 4 * g + j : 16 + 4 * g + (j - 4); }

DEV void rc_load_wd(const Params& p, int t0, int cb, float (&wd)[8]) {
    const int tid = tid_(); const int k = tid & 63, sg = tid >> 6;
#pragma unroll
    for (int i = 0; i < 8; ++i) wd[i] = bf2f(WS_(p, Wb)[(size_t)(t0 + sg * 8 + i) * D + cb + k]);
}
DEV void rc_cum_regs(const float (&wd)[8], LAS float* cum, LAS float* seg) {
    const int tid = tid_(); const int k = tid & 63, sg = tid >> 6;
    float v[8]; float s = 0.f;
#pragma unroll
    for (int i = 0; i < 8; ++i) { s += wd[i]; v[i] = s; }
    seg[sg * 64 + k] = s;
    lds_barrier();
    float off = 0.f;
#pragma unroll
    for (int q = 0; q < 8; ++q) off += (q < sg) ? seg[q * 64 + k] : 0.f;
#pragma unroll
    for (int i = 0; i < 8; ++i) cum[(sg * 8 + i) * 64 + k] = v[i] + off;
    lds_barrier();
}
DEV void ld8b(const bf16_t* p, float (&f)[8]) { const u32x4 v = *(const u32x4*)p; f[0] = bflo(v.x); f[1] = bfhi(v.x); f[2] = bflo(v.y); f[3] = bfhi(v.y); f[4] = bflo(v.z); f[5] = bfhi(v.z); f[6] = bflo(v.w); f[7] = bfhi(v.w); }
DEV void ld8(const float* p, float (&f)[8]) { const f32x4 a = *(const f32x4*)p, b = *(const f32x4*)(p + 4); f[0] = a[0]; f[1] = a[1]; f[2] = a[2]; f[3] = a[3]; f[4] = b[0]; f[5] = b[1]; f[6] = b[2]; f[7] = b[3]; }
DEV void lds8(const LAS float* p, float (&f)[8]) { const f32x4 a = *(const LAS f32x4*)p, b = *(const LAS f32x4*)(p + 4); f[0] = a[0]; f[1] = a[1]; f[2] = a[2]; f[3] = a[3]; f[4] = b[0]; f[5] = b[1]; f[6] = b[2]; f[7] = b[3]; }
DEV u32x4 pk8(const float (&f)[8]) { u32x4 o; o.x = pk2(f[0], f[1]); o.y = pk2(f[2], f[3]); o.z = pk2(f[4], f[5]); o.w = pk2(f[6], f[7]); return o; }

DEV bf16x8 frag_rm_pi(const LAS bf16_t* base, int ld, int row0, int k0, int lane) {
    const LAS bf16_t* a = base + (row0 + (lane & 15)) * ld + k0 + 4 * (lane >> 4);
    const s16x4 lo = *(const LAS s16x4*)a, hi = *(const LAS s16x4*)(a + 16);
    bf16x8 r; r[0] = lo[0]; r[1] = lo[1]; r[2] = lo[2]; r[3] = lo[3]; r[4] = hi[0]; r[5] = hi[1]; r[6] = hi[2]; r[7] = hi[3]; return r;
}
DEV void rc_prep8(const float (&k)[8], const float (&al)[8], const float (&kkw)[8], const float (&kaw)[8], float (&a)[8], float (&b)[8], float (&kh)[8]) {
    float kk[8]; float ss = 0.f;
#pragma unroll
    for (int e = 0; e < 8; ++e) { kk[e] = k[e] * kkw[e]; ss += kk[e] * kk[e]; }
    ss += __shfl_xor(ss, 1); ss += __shfl_xor(ss, 2); ss += __shfl_xor(ss, 4);
    const float inv = 1.0f / fmaxf(sqrtf(ss), 1e-12f);
#pragma unroll
    for (int e = 0; e < 8; ++e) { const float kn = kk[e] * inv; a[e] = -kn; b[e] = kn * al[e]; kh[e] = k[e] * (1.0f + (al[e] - 1.0f) * kaw[e]); }
}
constexpr int RW_NB = 64, RW_NW = NBLK - RW_NB;
DEV void phase_rw_cha(const Params& p, int jl, LAS unsigned char* lds, const int u0, const int ue, const int us) {
    const int tid = tid_(), bid = bid_(); (void)bid; const int lane = tid & 63, w = tid >> 6; const int fr = lane & 15, fq = lane >> 4;
    LAS float* cum = (LAS float*)lds;
    LAS float* seg = cum + 64 * 64;
    LAS float* Aab = seg + 8 * 64;
    LAS bf16_t* As = (LAS bf16_t*)(Aab + 64 * 68);
    LAS bf16_t* Bs = As + 64 * RC_LD; LAS bf16_t* Ks = Bs + 64 * RC_LD; LAS bf16_t* Vs = Ks + 64 * RC_LD; LAS bf16_t* Ke = Vs + 64 * RC_LD;
    LAS bf16_t* Aak = Ke + 64 * RC_LD; LAS bf16_t* Ts = Aak + 64 * RC_LD; LAS bf16_t* X1 = Ts + 64 * RC_LD; LAS bf16_t* Aabh = X1 + 64 * RC_LD;
    LAS bf16_t* Fimg = Aabh + 64 * RC_LD;
    LAS bf16_t* Wimg = Fimg + 4096;
    float pwd[8], pkr[8], pal[8], pv[8];
    float kkw[8], kaw[8];
    ld8(p.rw_k_k + (size_t)jl * D + (u0 & 15) * 64 + (tid & 7) * 8, kkw); ld8(p.rw_k_a + (size_t)jl * D + (u0 & 15) * 64 + (tid & 7) * 8, kaw);
    { const int c = u0 >> 4, h = u0 & 15; rc_load_wd(p, c * 64, h * 64, pwd);
      const size_t go = (size_t)(c * 64 + (tid >> 3)) * D + h * 64 + (tid & 7) * 8; ld8b(WS_(p, Kb) + go, pkr); ld8b(WS_(p, Ab) + go, pal); ld8b(WS_(p, Vb) + go, pv); }
    for (int u = u0; u < ue; u += us) {
        const int c = u >> 4, h = u & 15; const int t0 = c * 64, cb = h * 64; const size_t ub = (size_t)c * 16 + h;
        lds_barrier();
        rc_cum_regs(pwd, cum, seg);
        {
            const int t = tid >> 3, k8 = (tid & 7) * 8;
            float a[8], b[8], kh[8], v[8], ct[8], cp[8], ce[8];
            rc_prep8(pkr, pal, kkw, kaw, a, b, kh);
#pragma unroll
            for (int e = 0; e < 8; ++e) v[e] = pv[e];
            if (u + us < ue) { const int un = u + us; const int cn = un >> 4, hn = un & 15; rc_load_wd(p, cn * 64, hn * 64, pwd);
                const size_t gn = (size_t)(cn * 64 + t) * D + hn * 64 + k8; ld8b(WS_(p, Kb) + gn, pkr); ld8b(WS_(p, Ab) + gn, pal); ld8b(WS_(p, Vb) + gn, pv); }
            lds8(cum + t * 64 + k8, ct); lds8(cum + 63 * 64 + k8, ce);
            if (t > 0) lds8(cum + (t - 1) * 64 + k8, cp); else { for (int e = 0; e < 8; ++e) cp[e] = 0.f; }
            float at[8], bt[8], kt[8], be[8], ke[8];
#pragma unroll
            for (int e = 0; e < 8; ++e) { const float ei = __expf(-ct[e]), ee = __expf(ce[e] - ct[e]); at[e] = a[e] * __expf(cp[e]); bt[e] = b[e] * ei; kt[e] = kh[e] * ei; be[e] = b[e] * ee; ke[e] = kh[e] * ee; }
            *(LAS u32x4*)(As + t * RC_LD + k8) = pk8(at); *(LAS u32x4*)(Bs + t * RC_LD + k8) = pk8(bt); *(LAS u32x4*)(Ks + t * RC_LD + k8) = pk8(kt);
            *(LAS u32x4*)(Ke + t * RC_LD + k8) = pk8(ke); *(LAS u32x4*)(Vs + t * RC_LD + k8) = pk8(v);
            const int tq = t & 31, g = (tq & 15) >> 2, j = (tq & 3) + ((tq >> 4) << 2);
#pragma unroll
            for (int e = 0; e < 8; ++e) { const int k = k8 + e; Fimg[(((k >> 4) * 2 + (t >> 5)) * 64 + g * 16 + (k & 15)) * 8 + j] = (bf16_t)f2bf(be[e]); }
            *(LAS u32x4*)(Ts + tid * 8) = (u32x4){0u, 0u, 0u, 0u}; if (tid < 64) *(LAS u32x4*)(Ts + (512 + tid) * 8) = (u32x4){0u, 0u, 0u, 0u};
            if (t == 63) { float gm[8]; for (int e = 0; e < 8; ++e) gm[e] = __expf(ce[e]); *(f32x4*)(WS_(p, RGc) + ub * 64 + k8) = (f32x4){gm[0], gm[1], gm[2], gm[3]}; *(f32x4*)(WS_(p, RGc) + ub * 64 + k8 + 4) = (f32x4){gm[4], gm[5], gm[6], gm[7]}; }
        }
        lds_barrier();
        {
            const int tb = w >> 1;
#pragma unroll
            for (int ii = 0; ii < 2; ++ii) { const int ib = 2 * (w & 1) + ii;
                f32x4 ab = {0.f, 0.f, 0.f, 0.f}, ak = {0.f, 0.f, 0.f, 0.f};
                if (ib <= tb) {
#pragma unroll
                    for (int ks = 0; ks < 2; ++ks) { const bf16x8 af = frag_rm(As, RC_LD, 16 * tb, 32 * ks, lane);
                        ab = MFMA16(af, frag_rm(Bs, RC_LD, 16 * ib, 32 * ks, lane), ab); ak = MFMA16(af, frag_rm(Ks, RC_LD, 16 * ib, 32 * ks, lane), ak); } }
#pragma unroll
                for (int r = 0; r < 4; ++r) { const int t = 16 * tb + 4 * fq + r, i = 16 * ib + fr; const bool keep = i < t;
                    Aab[t * 68 + i] = keep ? ab[r] : 0.f; Aabh[t * RC_LD + i] = (bf16_t)f2bf(keep ? ab[r] : 0.f); Aak[t * RC_LD + i] = (bf16_t)f2bf(keep ? ak[r] : 0.f); } }
            *(u32x4*)(WS_(p, RBf) + ub * 4096 + tid * 8) = *(const LAS u32x4*)(Fimg + tid * 8);
        }
        lds_barrier();
        if (w == 0) {
            const int blk = lane >> 4, jc = lane & 15;
            float Tc[16];
#pragma unroll
            for (int t = 0; t < 16; ++t) {
                float acc = jc == t ? 1.f : 0.f;
#pragma unroll
                for (int i4 = 0; i4 < (t + 3) / 4; ++i4) { const f32x4 a4 = *(const LAS f32x4*)(Aab + (16 * blk + t) * 68 + 16 * blk + i4 * 4);
#pragma unroll
                    for (int e = 0; e < 4; ++e) if (i4 * 4 + e < t) acc += a4[e] * Tc[i4 * 4 + e]; }
                Tc[t] = acc;
            }
#pragma unroll
            for (int t = 0; t < 16; ++t) Ts[(16 * blk + t) * RC_LD + 16 * blk + jc] = (bf16_t)f2bf(Tc[t]);
#pragma unroll
            for (int b = 1; b < 4; ++b) {
                const s16x4 dlo = *(const LAS s16x4*)(Ts + (16 * b + fr) * RC_LD + 16 * b + 4 * fq);
                bf16x8 dfr; dfr[0] = dlo[0]; dfr[1] = dlo[1]; dfr[2] = dlo[2]; dfr[3] = dlo[3]; dfr[4] = 0; dfr[5] = 0; dfr[6] = 0; dfr[7] = 0;
                f32x4 tt_[3];
#pragma unroll
                for (int cbk = 0; cbk < b; ++cbk) {
                    f32x4 x = {0.f, 0.f, 0.f, 0.f};
#pragma unroll
                    for (int ks = 0; ks < 2; ++ks) x = MFMA16(frag_rm(Aabh, RC_LD, 16 * b, 32 * ks, lane), frag_tr(Ts, RC_LD, 32 * ks, 16 * cbk, lane), x);
                    u32x4 xb; xb.x = pk2(x[0], x[1]); xb.y = pk2(x[2], x[3]); xb.z = 0u; xb.w = 0u;
                    tt_[cbk] = MFMA16(dfr, __builtin_bit_cast(bf16x8, xb), ((f32x4){0.f, 0.f, 0.f, 0.f}));
                }
#pragma unroll
                for (int cbk = 0; cbk < b; ++cbk)
#pragma unroll
                    for (int r = 0; r < 4; ++r) Ts[(16 * b + 4 * fq + r) * RC_LD + 16 * cbk + fr] = (bf16_t)f2bf(tt_[cbk][r]);
            }
        } else {
            for (int tl = w - 1; tl < 32; tl += 7) {
                const int rb = (tl & 15) >> 2, vbk = tl & 3; f32x4 acc = {0.f, 0.f, 0.f, 0.f};
                if (tl < 16) {
#pragma unroll
                    for (int ks = 0; ks < 2; ++ks) acc = MFMA16(frag_rm(Aak, RC_LD, 16 * rb, 32 * ks, lane), frag_tr(Vs, RC_LD, 32 * ks, 16 * vbk, lane), acc);
#pragma unroll
                    for (int r = 0; r < 4; ++r) X1[(16 * rb + 4 * fq + r) * RC_LD + 16 * vbk + fr] = (bf16_t)f2bf(acc[r]);
                } else {
#pragma unroll
                    for (int ks = 0; ks < 2; ++ks) acc = MFMA16(frag_tr(Ke, RC_LD, 32 * ks, 16 * rb, lane), frag_tr(Vs, RC_LD, 32 * ks, 16 * vbk, lane), acc);
                    { u32x2 o; o.x = pk2(acc[0], acc[1]); o.y = pk2(acc[2], acc[3]); *(u32x2*)(WS_(p, RNa) + (((ub * 4 + vbk) * 4 + rb) * 64 + lane) * 4) = o; }
                }
            }
        }
        lds_barrier();
#pragma unroll
        for (int q = 0; q < 4; ++q) { const int tl = w * 4 + q; const int tt = (tl & 15) >> 2, cbk = tl & 3; f32x4 acc = {0.f, 0.f, 0.f, 0.f};
            if (tl < 16) {
#pragma unroll
                for (int ks = 0; ks < 2; ++ks) acc = MFMA16(frag_rm(Ts, RC_LD, 16 * tt, 32 * ks, lane), frag_tr(As, RC_LD, 32 * ks, 16 * cbk, lane), acc);
                const int k = 16 * cbk + fr, kq = k & 31, g = (kq & 15) >> 2, j = (kq & 3) + ((kq >> 4) << 2);
#pragma unroll
                for (int r = 0; r < 4; ++r) Wimg[((tt * 2 + (k >> 5)) * 64 + g * 16 + 4 * fq + r) * 8 + j] = (bf16_t)f2bf(acc[r]);
            } else {
#pragma unroll
                for (int ks = 0; ks < 2; ++ks) acc = MFMA16(frag_rm(Ts, RC_LD, 16 * tt, 32 * ks, lane), frag_tr(X1, RC_LD, 32 * ks, 16 * cbk, lane), acc);
                { u32x2 o; o.x = pk2(acc[0], acc[1]); o.y = pk2(acc[2], acc[3]); *(u32x2*)(WS_(p, RUt) + (((ub * 4 + cbk) * 4 + tt) * 64 + lane) * 4) = o; }
            } }
        lds_barrier();
        *(u32x4*)(WS_(p, RWf) + ub * 4096 + tid * 8) = *(const LAS u32x4*)(Wimg + tid * 8);
    }
}

constexpr int RB_SLOT = 20992, RB_R = 6, RB_P = 5;
struct RbOpsA { bf16x8 wf[8]; u32x2 ut[4]; };
struct RbOpsB { bf16x8 bf[8]; u32x2 na[4]; f32x4 gc[4]; };
DEV void rb_read_a(const LAS unsigned char* slot, int lane, RbOpsA& O) {
#pragma unroll
    for (int f = 0; f < 8; ++f) O.wf[f] = *(const LAS bf16x8*)(slot + (f * 64 + lane) * 16);
#pragma unroll
    for (int q = 0; q < 4; ++q) O.ut[q] = *(const LAS u32x2*)(slot + 16384 + (q * 64 + lane) * 8);
}
DEV void rb_read_b(const LAS unsigned char* slot, int lane, RbOpsB& O) {
    const int fq = lane >> 4;
#pragma unroll
    for (int f = 0; f < 8; ++f) O.bf[f] = *(const LAS bf16x8*)(slot + 8192 + (f * 64 + lane) * 16);
#pragma unroll
    for (int q = 0; q < 4; ++q) { O.na[q] = *(const LAS u32x2*)(slot + 18432 + (q * 64 + lane) * 8); O.gc[q] = *(const LAS f32x4*)(slot + 20480 + (16 * q + 4 * fq) * 4); }
}
DEV void phase_rw_chb(const Params& p, LAS unsigned char* lds, int half) {
    const int tid = tid_(), bid = bid_(); const int cbeg = half * 128, cend = cbeg + 128;
    const int lane = tid & 63, w = __builtin_amdgcn_readfirstlane(tid >> 6); const int head = bid & 15, vb = bid >> 4;
    auto issue = [&](int c) {
        const size_t ub = (size_t)c * 16 + head; LAS unsigned char* slot = lds + (c % RB_R) * RB_SLOT;
#pragma unroll
        for (int i = 0; i < 3; ++i) { const int pi = (w - 1) * 3 + i;
            if (pi < 8) __builtin_amdgcn_global_load_lds((const unsigned*)(WS_(p, RWf) + ub * 4096 + pi * 512 + lane * 8), (LAS unsigned*)(slot + pi * 1024), 16, 0, 0);
            else if (pi < 16) __builtin_amdgcn_global_load_lds((const unsigned*)(WS_(p, RBf) + ub * 4096 + (pi - 8) * 512 + lane * 8), (LAS unsigned*)(slot + 8192 + (pi - 8) * 1024), 16, 0, 0);
            else if (pi < 18) __builtin_amdgcn_global_load_lds((const unsigned*)(WS_(p, RUt) + (ub * 4 + vb) * 1024 + (pi - 16) * 512 + lane * 8), (LAS unsigned*)(slot + 16384 + (pi - 16) * 1024), 16, 0, 0);
            else if (pi < 20) __builtin_amdgcn_global_load_lds((const unsigned*)(WS_(p, RNa) + (ub * 4 + vb) * 1024 + (pi - 18) * 512 + lane * 8), (LAS unsigned*)(slot + 18432 + (pi - 18) * 1024), 16, 0, 0);
            else __builtin_amdgcn_global_load_lds((const unsigned*)(WS_(p, RGc) + ub * 64 + lane), (LAS unsigned*)(slot + 20480), 4, 0, 0);
        }
    };
    if (w > 0) {
#pragma unroll 1
        for (int c = cbeg; c < cbeg + RB_P; ++c) issue(c);
        asm volatile("s_waitcnt vmcnt(9)" ::: "memory");
    }
    __builtin_amdgcn_s_barrier();
    f32x4 s[4]; for (int i = 0; i < 4; ++i) s[i] = (f32x4){0.f, 0.f, 0.f, 0.f};
    f32x4* sst = WS_(p, RBST) + ((size_t)bid * 4) * 64 + lane;
    if (w > 0) {
#pragma unroll 1
        for (int c = cbeg; c < cend; ++c) {
            if (c + RB_P < cend) { issue(c + RB_P); asm volatile("s_waitcnt vmcnt(9)" ::: "memory"); }
            else asm volatile("s_waitcnt vmcnt(0)" ::: "memory");
            __builtin_amdgcn_s_barrier();
        }
    } else {
        RbOpsA A0, A1;
        rb_read_a(lds + (cbeg % RB_R) * RB_SLOT, lane, A0); if (half) { for (int i = 0; i < 4; ++i) s[i] = sst[i * 64]; }
#define RB_CHUNK(CA, NA, cc) do { const int c_ = (cc); const size_t ub = (size_t)c_ * 16 + head; RbOpsB cb_; \
            bf16x8 sb[2]; \
            _Pragma("unroll") for (int ks = 0; ks < 2; ++ks) { u32x4 o; o.x = pk2(s[2 * ks][0], s[2 * ks][1]); o.y = pk2(s[2 * ks][2], s[2 * ks][3]); o.z = pk2(s[2 * ks + 1][0], s[2 * ks + 1][1]); o.w = pk2(s[2 * ks + 1][2], s[2 * ks + 1][3]); sb[ks] = __builtin_bit_cast(bf16x8, o); *(u32x4*)(WS_(p, RS0) + (((ub * 4 + vb) * 2 + ks) * 64 + lane) * 8) = o; }       \
            f32x4 uu[4]; \
            _Pragma("unroll") for (int tt = 0; tt < 4; ++tt) { uu[tt] = (f32x4){bflo(CA.ut[tt].x), bfhi(CA.ut[tt].x), bflo(CA.ut[tt].y), bfhi(CA.ut[tt].y)}; uu[tt] = MFMA16(CA.wf[tt * 2], sb[0], uu[tt]); uu[tt] = MFMA16(CA.wf[tt * 2 + 1], sb[1], uu[tt]); } \
            __builtin_amdgcn_sched_barrier(0); \
              \
            rb_read_b(lds + (c_ % RB_R) * RB_SLOT, lane, cb_); \
            rb_read_a(lds + ((c_ + 1 < cend ? c_ + 1 : c_) % RB_R) * RB_SLOT, lane, NA); \
            __builtin_amdgcn_sched_barrier(0); \
            bf16x8 ubf[2]; \
            _Pragma("unroll") for (int ks = 0; ks < 2; ++ks) { u32x4 o; o.x = pk2(uu[2 * ks][0], uu[2 * ks][1]); o.y = pk2(uu[2 * ks][2], uu[2 * ks][3]); o.z = pk2(uu[2 * ks + 1][0], uu[2 * ks + 1][1]); o.w = pk2(uu[2 * ks + 1][2], uu[2 * ks + 1][3]); ubf[ks] = __builtin_bit_cast(bf16x8, o); *(u32x4*)(WS_(p, RUa) + (((ub * 4 + vb) * 2 + ks) * 64 + lane) * 8) = o; }      \
            _Pragma("unroll") for (int kt = 0; kt < 4; ++kt) { s[kt] = s[kt] * cb_.gc[kt] + (f32x4){bflo(cb_.na[kt].x), bfhi(cb_.na[kt].x), bflo(cb_.na[kt].y), bfhi(cb_.na[kt].y)}; s[kt] = MFMA16(cb_.bf[kt * 2], ubf[0], s[kt]); s[kt] = MFMA16(cb_.bf[kt * 2 + 1], ubf[1], s[kt]); } \
            __builtin_amdgcn_s_barrier(); \
        } while (0)
#pragma unroll 1
        for (int c = cbeg; c < cend; c += 2) { RB_CHUNK(A0, A1, c); RB_CHUNK(A1, A0, c + 1); }
#undef RB_CHUNK
    }
    if (w == 0 && !half) { for (int i = 0; i < 4; ++i) sst[i * 64] = s[i]; }
    asm volatile("s_waitcnt vmcnt(0)" ::: "memory");
}

DEV void phase_rw_chc(const Params& p, int j, LAS unsigned char* lds, const int u0, const int ue, const int us) {
    const int tid = tid_(), bid = bid_(); (void)bid; const int lane = tid & 63, w = tid >> 6; const int fr = lane & 15, fq = lane >> 4;
    LAS float* cum = (LAS float*)lds;
    LAS float* seg = cum + 64 * 64;
    LAS float* Ys = seg + 8 * 64;
    LAS bf16_t* Rs = (LAS bf16_t*)(Ys + 64 * 68);
    LAS bf16_t* Bs = Rs + 64 * RC_LD; LAS bf16_t* Ks = Bs + 64 * RC_LD; LAS bf16_t* Vs = Ks + 64 * RC_LD; LAS bf16_t* Arb = Vs + 64 * RC_LD; LAS bf16_t* Ark = Arb + 64 * RC_LD;
    float pwd[8], pr[8], pkr[8], pal[8], pv[8], pg[8];
    float kkw[8], kaw[8], rkw[8], lgw[8], lbw[8];
    { const size_t po = (size_t)j * D + (u0 & 15) * 64 + (tid & 7) * 8; ld8(p.rw_k_k + po, kkw); ld8(p.rw_k_a + po, kaw); ld8(p.rw_r_k + po, rkw); ld8(p.rw_lnx_g + po, lgw); ld8(p.rw_lnx_b + po, lbw); }
    { const int c = u0 >> 4, h = u0 & 15; rc_load_wd(p, c * 64, h * 64, pwd);
      const size_t go = (size_t)(c * 64 + (tid >> 3)) * D + h * 64 + (tid & 7) * 8; ld8b(WS_(p, Rb) + go, pr); ld8b(WS_(p, Kb) + go, pkr); ld8b(WS_(p, Ab) + go, pal); ld8b(WS_(p, Vb) + go, pv); ld8b(WS_(p, Gb) + go, pg); }
    for (int u = u0; u < ue; u += us) {
        const int c = u >> 4, h = u & 15; const int t0 = c * 64, cb = h * 64; const size_t ub = (size_t)c * 16 + h;
        const int tt = w & 3;
        bf16x8 ufr[2][2], sfr[2][2];
#pragma unroll
        for (int q = 0; q < 2; ++q)
#pragma unroll
            for (int ks = 0; ks < 2; ++ks) { const size_t o = (((ub * 4 + 2 * (w >> 2) + q) * 2 + ks) * 64 + lane) * 8;
                ufr[q][ks] = *(const bf16x8*)(WS_(p, RUa) + o); sfr[q][ks] = *(const bf16x8*)(WS_(p, RS0) + o); }
        lds_barrier();
        rc_cum_regs(pwd, cum, seg);
#ifdef DBL_CUM
        rc_cum_regs(pwd, cum, seg);
#endif
        const int t = tid >> 3, k8 = (tid & 7) * 8; const size_t go = (size_t)(t0 + t) * D + cb + k8;
        float v[8], gg[8]; float bc;
        {   float r[8], a[8], b[8], kh[8], ct[8];
#pragma unroll
            for (int e = 0; e < 8; ++e) { r[e] = pr[e]; v[e] = pv[e]; gg[e] = pg[e]; }
            lds8(cum + t * 64 + k8, ct);
            rc_prep8(pkr, pal, kkw, kaw, a, b, kh);
            if (u + us < ue) { const int un = u + us; const int cn = un >> 4, hn = un & 15; rc_load_wd(p, cn * 64, hn * 64, pwd);
                const size_t gn = (size_t)(cn * 64 + t) * D + hn * 64 + k8; ld8b(WS_(p, Rb) + gn, pr); ld8b(WS_(p, Kb) + gn, pkr); ld8b(WS_(p, Ab) + gn, pal); ld8b(WS_(p, Vb) + gn, pv); ld8b(WS_(p, Gb) + gn, pg); }
            bc = 0.f;
#pragma unroll
            for (int e = 0; e < 8; ++e) bc += r[e] * kh[e] * rkw[e];
            bc += __shfl_xor(bc, 1); bc += __shfl_xor(bc, 2); bc += __shfl_xor(bc, 4);
#pragma unroll
            for (int e = 0; e < 8; ++e) { const float ei = __expf(-ct[e]); r[e] *= __expf(ct[e]); b[e] *= ei; kh[e] *= ei; }
            *(LAS u32x4*)(Rs + t * RC_LD + k8) = pk8(r); *(LAS u32x4*)(Bs + t * RC_LD + k8) = pk8(b); *(LAS u32x4*)(Ks + t * RC_LD + k8) = pk8(kh); *(LAS u32x4*)(Vs + t * RC_LD + k8) = pk8(v);
        }
        lds_barrier();
#ifdef DBL_S3
#pragma unroll 1
        for (int rep_ = 0; rep_ < 2; ++rep_)
#endif
        {   const int tb = w >> 1;
#pragma unroll
            for (int ii = 0; ii < 2; ++ii) { const int ib = 2 * (w & 1) + ii;
                f32x4 ab = {0.f, 0.f, 0.f, 0.f}, ak = {0.f, 0.f, 0.f, 0.f};
                if (ib <= tb) {
#pragma unroll
                    for (int ks = 0; ks < 2; ++ks) { const bf16x8 af = frag_rm(Rs, RC_LD, 16 * tb, 32 * ks, lane);
                        ab = MFMA16(af, frag_rm(Bs, RC_LD, 16 * ib, 32 * ks, lane), ab); ak = MFMA16(af, frag_rm(Ks, RC_LD, 16 * ib, 32 * ks, lane), ak); } }
#pragma unroll
                for (int r = 0; r < 4; ++r) { const int tr = 16 * tb + 4 * fq + r, i = 16 * ib + fr; const bool keep = i <= tr;
                    Arb[tr * RC_LD + i] = (bf16_t)f2bf(keep ? ab[r] : 0.f); Ark[tr * RC_LD + i] = (bf16_t)f2bf(keep ? ak[r] : 0.f); } }
        }
        lds_barrier();
#ifdef DBL_Y
#pragma unroll 1
        for (int rep_ = 0; rep_ < 2; ++rep_)
#endif
#pragma unroll
        for (int q = 0; q < 2; ++q) { const int vbk = 2 * (w >> 2) + q; f32x4 acc = {0.f, 0.f, 0.f, 0.f};
#pragma unroll
            for (int ks = 0; ks < 2; ++ks) {
                acc = MFMA16(frag_rm_pi(Rs, RC_LD, 16 * tt, 32 * ks, lane), sfr[q][ks], acc);
                acc = MFMA16(frag_rm_pi(Arb, RC_LD, 16 * tt, 32 * ks, lane), ufr[q][ks], acc);
                acc = MFMA16(frag_rm(Ark, RC_LD, 16 * tt, 32 * ks, lane), frag_tr(Vs, RC_LD, 32 * ks, 16 * vbk, lane), acc); }
#pragma unroll
            for (int r = 0; r < 4; ++r) Ys[(16 * tt + 4 * fq + r) * 68 + 16 * vbk + fr] = acc[r]; }
        lds_barrier();
        {
            float y[8]; lds8(Ys + t * 68 + k8, y);
            float s1 = 0.f, s2 = 0.f;
#pragma unroll
            for (int e = 0; e < 8; ++e) { s1 += y[e]; s2 += y[e] * y[e]; }
            s1 += __shfl_xor(s1, 1); s1 += __shfl_xor(s1, 2); s1 += __shfl_xor(s1, 4); s2 += __shfl_xor(s2, 1); s2 += __shfl_xor(s2, 2); s2 += __shfl_xor(s2, 4);
            const float mean = s1 * (1.0f / 64.0f), var = s2 * (1.0f / 64.0f) - mean * mean; const float rs = rsqrtf(fmaxf(var, 0.f) + 64e-5f);
            float o[8];
#pragma unroll
            for (int e = 0; e < 8; ++e) o[e] = ((y[e] - mean) * rs * lgw[e] + lbw[e] + bc * v[e]) * gg[e];
            *(u32x4*)(WS_(p, YB) + go) = pk8(o);
        }
    }
}
DEV void phase_ln1(const Params& p, int layer, LAS unsigned char* lds) {
    const int tid = tid_(), bid = bid_(); (void)tid; (void)bid;
    const int lane = tid & 63, wid = tid >> 6; const int fr = lane & 15, fq = lane >> 4;
    LAS float* lgt = (LAS float*)lds;
    LAS int* cnt = (LAS int*)(lgt + 2 * 64 * 48);
    if (tid < 32) cnt[tid] = 0;
    const float* g = p.ln_g + ((size_t)layer * 2 + 0) * D; const float* be = p.ln_b + ((size_t)layer * 2 + 0) * D;
    const float* br = p.moe_b_route + layer * 32; const float* bg = p.moe_b_group + layer * 4;
    f32x4 gwv[4], bwv[4];
#pragma unroll
    for (int q = 0; q < 4; ++q) { gwv[q] = *(const f32x4*)(g + RCOL(q, lane)); bwv[q] = *(const f32x4*)(be + RCOL(q, lane)); }
    u32x2 rh[4], rm[4];
#pragma unroll
    for (int q = 0; q < 4; ++q) { rh[q] = *(const u32x2*)(WS_(p, Hb) + (size_t)(bid * 64 + wid * 8) * D + RCOL(q, lane)); rm[q] = *(const u32x2*)(WS_(p, MIXb) + (size_t)(bid * 64 + wid * 8) * D + RCOL(q, lane)); }
#pragma unroll 1
    for (int rr = 0; rr < 8; ++rr) {
        const int t = bid * 64 + wid * 8 + rr; const size_t ro = (size_t)t * D;
        f32x4 z[4], m[4];
#pragma unroll
        for (int q = 0; q < 4; ++q) { z[q] = (f32x4){bflo(rh[q].x), bfhi(rh[q].x), bflo(rh[q].y), bfhi(rh[q].y)}; m[q] = (f32x4){bflo(rm[q].x), bfhi(rm[q].x), bflo(rm[q].y), bfhi(rm[q].y)}; }
        { const size_t rn = (size_t)(rr < 7 ? t + 1 : t) * D;
#pragma unroll
          for (int q = 0; q < 4; ++q) { rh[q] = *(const u32x2*)(WS_(p, Hb) + rn + RCOL(q, lane)); rm[q] = *(const u32x2*)(WS_(p, MIXb) + rn + RCOL(q, lane)); } }
        float s = 0.f;
#pragma unroll
        for (int q = 0; q < 4; ++q) { z[q] = z[q] * ALPHA + m[q]; s += z[q][0] + z[q][1] + z[q][2] + z[q][3]; }
        const float mean = wave_sum(s) * (1.0f / D);
        float vs = 0.f;
#pragma unroll
        for (int q = 0; q < 4; ++q) { z[q] = z[q] - mean; vs += z[q][0] * z[q][0] + z[q][1] * z[q][1] + z[q][2] * z[q][2] + z[q][3] * z[q][3]; }
        const float rs = rsqrtf(wave_sum(vs) * (1.0f / D) + LN_EPS);
#pragma unroll
        for (int q = 0; q < 4; ++q) {
            st_bf4(WS_(p, H1b) + ro + RCOL(q, lane), z[q] * rs * gwv[q] + bwv[q]);
        }
    }
    asm volatile("s_waitcnt vmcnt(0)" ::: "memory");
    __syncthreads();
    {   const int rt = wid & 3, kh = wid >> 2;
        const bf16_t* Ab = WS_(p, H1b) + (size_t)(bid * 64 + 16 * rt + fr) * D + 512 * kh + 8 * fq;
        const bf16_t* Wb = WS_(p, moe_wr_t) + (size_t)layer * 48 * D + (size_t)fr * D + 512 * kh + 8 * fq;
        f32x4 acc[3]; for (int i = 0; i < 3; ++i) acc[i] = (f32x4){0.f, 0.f, 0.f, 0.f};
#pragma unroll 8
        for (int ks = 0; ks < 16; ++ks) {
            const bf16x8 af = *(const bf16x8*)(Ab + 32 * ks);
#pragma unroll
            for (int ct = 0; ct < 3; ++ct) acc[ct] = MFMA16(af, *(const bf16x8*)(Wb + (size_t)16 * ct * D + 32 * ks), acc[ct]);
        }
#pragma unroll
        for (int ct = 0; ct < 3; ++ct)
#pragma unroll
            for (int r = 0; r < 4; ++r) lgt[(kh * 64 + 16 * rt + 4 * fq + r) * 48 + 16 * ct + fr] = acc[ct][r];
    }
    __syncthreads();
    if (tid < 64) {
        const int t = bid * 64 + tid; const LAS float* L0 = lgt + tid * 48; const LAS float* L1 = lgt + (64 + tid) * 48;
        const float q0 = L0[32] + L1[32] + bg[0], q1 = L0[33] + L1[33] + bg[1], q2 = L0[34] + L1[34] + bg[2], q3 = L0[35] + L1[35] + bg[3];
        int gi = 0; float gm = q0;
        if (q1 > gm) { gm = q1; gi = 1; } if (q2 > gm) { gm = q2; gi = 2; } if (q3 > gm) { gm = q3; gi = 3; }
        const float den = __expf(q0 - gm) + __expf(q1 - gm) + __expf(q2 - gm) + __expf(q3 - gm);
        const float pgrp = __builtin_amdgcn_rcpf(den);
        float l1 = -INFINITY, l2 = -INFINITY; int i1 = 0, i2 = 0;
#pragma unroll 1
        for (int o = 0; o < 8; ++o) { const float v = L0[gi * 8 + o] + L1[gi * 8 + o] + br[gi * 8 + o];
            if (v > l1) { l2 = l1; i2 = i1; l1 = v; i1 = o; } else if (v > l2) { l2 = v; i2 = o; } }
        const float e2 = __expf(l2 - l1), inv = __builtin_amdgcn_rcpf(1.0f + e2);
        const int e0 = gi * 8 + i1, e1 = gi * 8 + i2;
        WS_(p, EIDX)[2 * t] = e0; WS_(p, EIDX)[2 * t + 1] = e1; WS_(p, GATE)[2 * t] = pgrp * inv; WS_(p, GATE)[2 * t + 1] = pgrp * e2 * inv;
        atomicAdd((int*)&cnt[e0], 1); atomicAdd((int*)&cnt[e1], 1);
    }
    __syncthreads();
    if (tid < 32) WS_(p, CNT)[bid * 32 + tid] = cnt[tid];
}

DEV void phase_moe_scatter(const Params& p, LAS unsigned char* lds) {
    const int tid = tid_(), bid = bid_(); (void)tid; (void)bid;
    const int lane = tid & 63, wid = tid >> 6;
    LAS int* part = (LAS int*)lds;
    LAS int* pre = part + 512;
    LAS int* base = pre + 512;
    LAS int* pst = base + 32;
    LAS int* dst = pst + 40;
    LAS int* eid = dst + 128;
    { const int e = tid & 31, part_i = tid >> 5; int tot = 0, prf = 0;
      for (int b = part_i * 16; b < part_i * 16 + 16; ++b) { const int c = WS_(p, CNT)[b * 32 + e]; tot += c; if (b < (int)bid) prf += c; }
      part[part_i * 32 + e] = tot; pre[part_i * 32 + e] = prf; }
    if (tid < 128) eid[tid] = WS_(p, EIDX)[bid * 128 + tid];
    if (bid == 1 && tid < MFLAG_TICKET + 32) __hip_atomic_store(WS_(p, MFLAG) + tid * MFLAG_STRIDE, 0u, __ATOMIC_RELAXED, __HIP_MEMORY_SCOPE_AGENT);
    lds_barrier();
    if (tid < 32) { int tot = 0, prf = 0; for (int i = 0; i < 16; ++i) { tot += part[i * 32 + tid]; prf += pre[i * 32 + tid]; } part[tid] = tot; pre[tid] = prf; }
    lds_barrier();
    if (tid == 0) { int acc = 0; for (int e = 0; e < 32; ++e) { pst[e] = acc; acc += ((part[e] + 255) >> 8) << 8; } pst[32] = acc;
        if (bid == 0) { for (int e = 0; e <= 32; ++e) WS_(p, TAB)[e] = pst[e]; WS_(p, TAB)[33] = acc >> 8;
            for (int e = 0; e < 32; ++e) for (int mt = pst[e] >> 8; mt < (pst[e + 1] >> 8); ++mt) WS_(p, TAB)[64 + mt] = e; } }
    lds_barrier();
    if (tid < 32) { int run = pst[tid] + pre[tid];
#pragma unroll 16
        for (int a = 0; a < 128; ++a) if (eid[a] == tid) dst[a] = run++; }
    lds_barrier();
    if (tid < 128) WS_(p, DEST)[bid * 128 + tid] = dst[tid];
#pragma unroll 4
    for (int a = wid * 16; a < wid * 16 + 16; ++a) {
        const int t = bid * 64 + (a >> 1); const int d = dst[a];
        const u32x4 v0 = *(const u32x4*)(WS_(p, H1b) + (size_t)t * D + lane * 8), v1 = *(const u32x4*)(WS_(p, H1b) + (size_t)t * D + 512 + lane * 8);
        *(u32x4*)(WS_(p, BUF) + (size_t)d * D + lane * 8) = v0; *(u32x4*)(WS_(p, BUF) + (size_t)d * D + 512 + lane * 8) = v1;
    }
}

template <int which> struct SchedMoe {
    const Params* p; int layer; const LAS int* tab;
    DEV bool next(int i, Unit& u) const {
        const int nmt = tab[33]; int pm, pn; if (!pg8::tile_order(i, NB_, which == 0 ? bid_() : ((bid_() + 128) & 255), nmt, 4, pm, pn)) return false;
        const int row0 = pm * 256; const int e = tab[64 + pm];
        if constexpr (which == 0) { u.A = (const char*)(WS_(*p, BUF) + (size_t)row0 * D); u.B = (const char*)(WS_(*p, moe_w1_t) + ((size_t)layer * 32 + e) * 1024 * 1024 + (size_t)pn * 256 * 1024); }
        else {
            if (tid_() == 0) { unsigned* f = WS_(*p, MFLAG) + pm * MFLAG_STRIDE; unsigned sp = 0;
                while (__hip_atomic_load(f, __ATOMIC_RELAXED, __HIP_MEMORY_SCOPE_AGENT) < 4u) { __builtin_amdgcn_s_sleep(1); if (++sp > (1u << 24)) break; }
                __builtin_amdgcn_fence(__ATOMIC_ACQUIRE, "agent");
                asm volatile("s_waitcnt vmcnt(0)" ::: "memory"); }
            __builtin_amdgcn_s_barrier();
            u.A = (const char*)(WS_(*p, ACT) + (size_t)row0 * 512); u.B = (const char*)(WS_(*p, moe_w2_t) + ((size_t)layer * 32 + e) * 1024 * 512 + (size_t)pn * 256 * 512); }
        u.row0 = row0; u.col0 = pn * 256; u.id = e; u.aux = 0; return true;
    }
};
struct EpiMoe1 {
    bf16_t* O; unsigned* flag;
    DEV void operator()(const AccT& acc, const Unit& u, int wr, int wc, int fr, int fq) const {
        const __amdgpu_buffer_rsrc_t rs = __builtin_amdgcn_make_buffer_rsrc(O, 0, MOE_ROWS * 512 * 2, 0x00020000);
#pragma unroll
        for (int ai = 0; ai < 2; ++ai)
#pragma unroll
            for (int m = 0; m < 4; ++m) {
                f32x4 v[2];
#pragma unroll
                for (int n = 0; n < 2; ++n) { const f32x4 gt = acc[ai][0][m][n], up = acc[ai][1][m][n]; for (int e = 0; e < 4; ++e) v[n][e] = siluf_(gt[e]) * up[e]; }
                const int col = (u.col0 >> 1) + 32 * wc + (PF(6) ? 8 * fq : 4 * fq);
                if (PF(6)) __builtin_amdgcn_raw_buffer_store_b128(pk8v(v[0], v[1]), rs, (unsigned)((ACC_ROW(u, ai, m) * 512 + col) * 2), 0, 16);
                else { const u32x4 w = pk8v(v[0], v[1]); unsigned long long* q = (unsigned long long*)(O + (size_t)ACC_ROW(u, ai, m) * 512 + col);
                  __hip_atomic_store(q, (unsigned long long)w.x | ((unsigned long long)w.y << 32), __ATOMIC_RELAXED, __HIP_MEMORY_SCOPE_AGENT);
                  __hip_atomic_store(q + 4, (unsigned long long)w.z | ((unsigned long long)w.w << 32), __ATOMIC_RELAXED, __HIP_MEMORY_SCOPE_AGENT); }
                ACC_FENCE;
            }
        asm volatile("s_waitcnt vmcnt(0)" ::: "memory");
        __builtin_amdgcn_s_barrier();
        if (wr == 1 && wc == 0 && fr == 0 && fq == 0) __hip_atomic_fetch_add(flag + (u.row0 >> 8) * MFLAG_STRIDE, 1u, __ATOMIC_RELAXED, __HIP_MEMORY_SCOPE_AGENT);
    }
};
struct EpiMoe2 {
    bf16_t* O;
    DEV void operator()(const AccT& acc, const Unit& u, int wr, int wc, int fr, int fq) const {
        FOR_ACC2(ai, bj, m) { st_bf8p(O + (size_t)ACC_ROW(u, ai, m) * D + ACC_COL8P(u, bj, PF(7)), acc[ai][bj][m][0], acc[ai][bj][m][1], PF(7)); ACC_FENCE; }
    }
};

struct Ln2Raw { u32x2 h[4], a[4], b[4]; float g0, g1; };
DEV void ln2_issue(const Params& p, int t, int lane, Ln2Raw& R, int dpre, float gpre, int tbase) {
    const int i0 = 2 * (t - tbase); const int d0 = __shfl(dpre, i0), d1 = __shfl(dpre, i0 + 1); R.g0 = __shfl(gpre, i0); R.g1 = __shfl(gpre, i0 + 1);
#pragma unroll
    for (int q = 0; q < 4; ++q) { R.h[q] = *(const u32x2*)(WS_(p, H1b) + (size_t)t * D + RCOL(q, lane));
        R.a[q] = *(const u32x2*)(WS_(p, YBUF) + (size_t)d0 * D + RCOL(q, lane)); R.b[q] = *(const u32x2*)(WS_(p, YBUF) + (size_t)d1 * D + RCOL(q, lane)); }
}
DEV void ln2_finish(const Ln2Raw& R, const f32x4 (&gwv)[4], const f32x4 (&bwv)[4], f32x4 (&z)[4]) {
    float s = 0.f; const float g0 = R.g0, g1 = R.g1;
#pragma unroll
    for (int q = 0; q < 4; ++q) {
        z[q][0] = bflo(R.h[q].x) * ALPHA + g0 * bflo(R.a[q].x) + g1 * bflo(R.b[q].x); z[q][1] = bfhi(R.h[q].x) * ALPHA + g0 * bfhi(R.a[q].x) + g1 * bfhi(R.b[q].x);
        z[q][2] = bflo(R.h[q].y) * ALPHA + g0 * bflo(R.a[q].y) + g1 * bflo(R.b[q].y); z[q][3] = bfhi(R.h[q].y) * ALPHA + g0 * bfhi(R.a[q].y) + g1 * bfhi(R.b[q].y);
        s += z[q][0] + z[q][1] + z[q][2] + z[q][3];
    }
    const float mean = wave_sum(s) * (1.0f / D);
    float vs = 0.f;
#pragma unroll
    for (int q = 0; q < 4; ++q) { z[q] = z[q] - mean; vs += z[q][0] * z[q][0] + z[q][1] * z[q][1] + z[q][2] * z[q][2] + z[q][3] * z[q][3]; }
    const float rs = rsqrtf(wave_sum(vs) * (1.0f / D) + LN_EPS);
#pragma unroll
    for (int q = 0; q < 4; ++q) z[q] = z[q] * rs * gwv[q] + bwv[q];
}
DEV void phase_ln2(const Params& p, int layer, LAS unsigned char* lds) {
    const int tid = tid_(), bid = bid_(); const int lane = tid & 63, wid = tid >> 6; const int fr = lane & 15, fq = lane >> 4;
    const float* g = p.ln_g + ((size_t)layer * 2 + 1) * D; const float* be = p.ln_b + ((size_t)layer * 2 + 1) * D;
    const int nk = layer == DEPTH - 1 ? 3 : (layer + 1) % 3;
    const int nj = (layer + 1) / 3;
    LAS float* lgt = (LAS float*)lds;
    LAS float* w2 = lgt + 2 * 64 * 32;
    if (nk == 2) { for (int i = tid; i < 16 * 512; i += NTHR) w2[i] = p.gl_gk_w2[(size_t)nj * 16 * 512 + i]; }
    const int tfirst = bid * 64 + wid * 8;
    f32x4 z[4], zp[4], gwv[4], bwv[4];
#pragma unroll
    for (int q = 0; q < 4; ++q) { gwv[q] = *(const f32x4*)(g + RCOL(q, lane)); bwv[q] = *(const f32x4*)(be + RCOL(q, lane)); }
    Ln2Raw R[3];
    const int tbase = tfirst > 0 ? tfirst - 1 : 0;
    const int dpre = lane < 18 ? WS_(p, DEST)[2 * tbase + lane] : 0; const float gpre = lane < 18 ? WS_(p, GATE)[2 * tbase + lane] : 0.f;
    if (nk == 0) { if (tfirst > 0) { ln2_issue(p, tfirst - 1, lane, R[2], dpre, gpre, tbase); } }
    ln2_issue(p, tfirst, lane, R[0], dpre, gpre, tbase);
    ln2_issue(p, tfirst + 1, lane, R[1], dpre, gpre, tbase);
    if (nk == 0) { if (tfirst > 0) ln2_finish(R[2], gwv, bwv, zp); else { for (int q = 0; q < 4; ++q) zp[q] = (f32x4){0.f, 0.f, 0.f, 0.f}; } }
#pragma unroll
    for (int rr = 0; rr < 8; ++rr) {
        const int t = tfirst + rr; const size_t ro = (size_t)t * D;
        if (rr + 2 < 8) ln2_issue(p, t + 2, lane, R[(rr + 2) % 3], dpre, gpre, tbase);
        ln2_finish(R[rr % 3], gwv, bwv, z);
        if (nk == 3) {
#pragma unroll
            for (int q = 0; q < 4; ++q) *(f32x4*)(p.out + ro + RCOL(q, lane)) = z[q];
        } else store_row_bf(WS_(p, Hb) + ro, lane, z);
        if (nk == 0) {
            emit_mix6(p, nj, t, lane, z, zp);
#pragma unroll
            for (int q = 0; q < 4; ++q) zp[q] = z[q];
        }
    }
    if (nk == 1 || nk == 2) {
        asm volatile("s_waitcnt vmcnt(0)" ::: "memory");
        __syncthreads();
        const int nct = nk == 1 ? 2 : 1; const int rt = wid & 3, kh = wid >> 2;
        const bf16_t* Ab = WS_(p, Hb) + (size_t)(bid * 64 + 16 * rt + fr) * D + 512 * kh + 8 * fq;
        const bf16_t* Wb = (nk == 1 ? WS_(p, mb_dt_t) : WS_(p, gl_lr_t)) + (size_t)fr * D + 512 * kh + 8 * fq;
        f32x4 acc[2]; acc[0] = (f32x4){0.f, 0.f, 0.f, 0.f}; acc[1] = acc[0];
#pragma unroll 4
        for (int ks = 0; ks < 16; ++ks) {
            const bf16x8 af = *(const bf16x8*)(Ab + 32 * ks);
            acc[0] = MFMA16(af, *(const bf16x8*)(Wb + 32 * ks), acc[0]);
            if (nct == 2) acc[1] = MFMA16(af, *(const bf16x8*)(Wb + (size_t)16 * D + 32 * ks), acc[1]);
        }
#pragma unroll
        for (int ct = 0; ct < 2; ++ct)
#pragma unroll
            for (int r = 0; r < 4; ++r) lgt[(kh * 64 + 16 * rt + 4 * fq + r) * 32 + 16 * ct + fr] = acc[ct][r];
        __syncthreads();
        if (nk == 1) {
#pragma unroll
            for (int i = 0; i < 4; ++i) { const int idx = tid + i * NTHR; const int row = idx >> 5, o = idx & 31;
                WS_(p, DT)[(size_t)(bid * 64 + row) * 32 + o] = softplusf_(lgt[row * 32 + o] + lgt[(64 + row) * 32 + o] + p.mb_dt_bias[nj * 32 + o]); }
        } else {
            const int row = tid >> 3, c0 = (tid & 7) * 64; float lr[16];
#pragma unroll
            for (int o = 0; o < 16; ++o) lr[o] = lgt[row * 32 + o] + lgt[(64 + row) * 32 + o];
#pragma unroll 1
            for (int c4 = 0; c4 < 16; ++c4) { const int c = c0 + 4 * c4; f32x4 a = *(const f32x4*)(p.gl_gk_b + nj * 512 + c);
#pragma unroll
                for (int o = 0; o < 16; ++o) { const f32x4 wv = *(const LAS f32x4*)(w2 + o * 512 + c); a = a + wv * lr[o]; }
                f32x4 r;
#pragma unroll
                for (int e = 0; e < 4; ++e) r[e] = (fminf(a[e], 0.f) - __logf(1.0f + __expf(-fabsf(a[e])))) * (1.0f / 16.0f);
                *(f32x4*)(WS_(p, LA) + (size_t)(bid * 64 + row) * 512 + c) = r; }
        }
    }
}
constexpr int MB_PROJ = 5152;
struct SchedMbIn {
    const Params* p;
    DEV bool next(int i, Unit& u) const {
        int pm, pn; if (!pg8::tile_order(i, NB_, bid_(), 64, 20, pm, pn)) return false;
        u.A = (const char*)(WS_(*p, Hb) + (size_t)pm * 256 * D); u.B = (const char*)(WS_(*p, mb_win_t) + (size_t)pn * 256 * D); u.row0 = pm * 256; u.col0 = pn * 256; u.id = 0; u.aux = 0; return true;
    }
};
struct EpiMbIn {
    const Params* p;
    DEV void operator()(const AccT& acc, const Unit& u, int wr, int wc, int fr, int fq) const {
        const bool isz = u.col0 < 2048; bf16_t* O = WS_(*p, Z) + (isz ? (size_t)0 : (size_t)T * 2048 - 2048); const int ld = isz ? 2048 : 3072;
        FOR_ACC2(ai, bj, m) { st_bf8p(O + (size_t)ACC_ROW(u, ai, m) * ld + ACC_COL8P(u, bj, PF(4)), acc[ai][bj][m][0], acc[ai][bj][m][1], PF(4)); ACC_FENCE; }
    }
};
DEV void phase_mb_conv(const Params& p, int j) {
    const int tid = tid_(), bid = bid_(); (void)tid; (void)bid;
    if (tid >= 384) return;
    const int c0 = tid * 8; const int t0 = bid * 64;
    const float* cw = p.mb_conv_w + (size_t)j * 4 * 3072; const float* cb = p.mb_conv_b + (size_t)j * 3072;
    float w[4][8], b[8];
#pragma unroll
    for (int i = 0; i < 4; ++i) { const f32x4 a = *(const f32x4*)(cw + i * 3072 + c0), bb = *(const f32x4*)(cw + i * 3072 + c0 + 4); for (int e = 0; e < 4; ++e) { w[i][e] = a[e]; w[i][4 + e] = bb[e]; } }
    { const f32x4 a = *(const f32x4*)(cb + c0), bb = *(const f32x4*)(cb + c0 + 4); for (int e = 0; e < 4; ++e) { b[e] = a[e]; b[4 + e] = bb[e]; } }
    float x0[8], x1[8], x2[8], x3[8];
    auto ld = [&](int t, float (&x)[8]) {
        if (t < 0) { for (int e = 0; e < 8; ++e) x[e] = 0.f; return; }
        const u32x4 v = *(const u32x4*)(WS_(p, XBC) + (size_t)t * 3072 + c0);
        x[0] = bflo(v.x); x[1] = bfhi(v.x); x[2] = bflo(v.y); x[3] = bfhi(v.y); x[4] = bflo(v.z); x[5] = bfhi(v.z); x[6] = bflo(v.w); x[7] = bfhi(v.w);
    };
    ld(t0 - 3, x0); ld(t0 - 2, x1); ld(t0 - 1, x2);
#pragma unroll 4
    for (int tt = 0; tt < 64; ++tt) {
        ld(t0 + tt, x3);
        float o[8];
#pragma unroll
        for (int e = 0; e < 8; ++e) o[e] = siluf_(b[e] + w[0][e] * x0[e] + w[1][e] * x1[e] + w[2][e] * x2[e] + w[3][e] * x3[e]);
        u32x4 r; r.x = pk2(o[0], o[1]); r.y = pk2(o[2], o[3]); r.z = pk2(o[4], o[5]); r.w = pk2(o[6], o[7]);
        *(u32x4*)(WS_(p, XC) + (size_t)(t0 + tt) * 3072 + c0) = r;
#pragma unroll
        for (int e = 0; e < 8; ++e) { x0[e] = x1[e]; x1[e] = x2[e]; x2[e] = x3[e]; }
    }
}

DEV void mb_dacs(const Params& p, int j, int c, int g, LAS float* dts, LAS float* dacs) {
    const int tid = tid_(); const int lane = tid & 63, h = tid >> 6;
    const int hh = 8 * g + h; const float a = -__expf(p.mb_a_log[j * 32 + hh]);
    const float d0 = WS_(p, DT)[(size_t)(c * 128 + 2 * lane) * 32 + hh], d1 = WS_(p, DT)[(size_t)(c * 128 + 2 * lane + 1) * 32 + hh];
    const float a0 = d0 * a, a1 = d1 * a;
    float s = a0 + a1;
#pragma unroll
    for (int o = 1; o < 64; o <<= 1) { const float v = __shfl_up(s, o); if (lane >= o) s += v; }
    dts[h * 128 + 2 * lane] = d0; dts[h * 128 + 2 * lane + 1] = d1;
    dacs[h * 128 + 2 * lane] = s - a1; dacs[h * 128 + 2 * lane + 1] = s;
}
constexpr int LDB = 136;
constexpr int LDX = 72;
DEV void ld_tile128(const bf16_t* src, int gld, LAS bf16_t* dst) {
    const int tid = tid_();
    for (int i = tid; i < 128 * 16; i += NTHR) { const int r = i >> 4, c8 = (i & 15) * 8; *(LAS u32x4*)(dst + r * LDB + c8) = *(const u32x4*)(src + (size_t)r * gld + c8); }
}

DEV void phase_mb_states(const Params& p, int j, LAS unsigned char* lds) {
    const int tid = tid_(), bid = bid_(); (void)tid; (void)bid;
    const int lane = tid & 63, w = tid >> 6;
    LAS bf16_t* Bm = (LAS bf16_t*)lds;
    LAS bf16_t* Xh = Bm + 128 * LDB;
    LAS float* dts = (LAS float*)(Xh + 128 * LDX);
    LAS float* dacs = dts + 1024;
    for (int u = bid; u < 512; u += NB_) {
        const int c = u >> 2, g = u & 3; const int t0 = c * 128;
        lds_barrier();
        mb_dacs(p, j, c, g, dts, dacs);
        ld_tile128(WS_(p, XC) + (size_t)t0 * 3072 + 2048 + 128 * g, 3072, Bm);
        lds_barrier();
        if (tid < 8) WS_(p, CD)[(c * 32) + 8 * g + tid] = __expf(dacs[tid * 128 + 127]);
        bf16x8 bfr[4];
#pragma unroll
        for (int ks = 0; ks < 4; ++ks) bfr[ks] = frag_tr(Bm, LDB, 32 * ks, 16 * w, lane);
        for (int h = 0; h < 8; ++h) {
            { const int l = tid >> 2, p0 = (tid & 3) * 16; const float sc = dts[h * 128 + l] * __expf(dacs[h * 128 + 127] - dacs[h * 128 + l]);
              const bf16_t* src = WS_(p, XC) + (size_t)(t0 + l) * 3072 + 64 * (8 * g + h) + p0;
#pragma unroll
              for (int hf = 0; hf < 2; ++hf) { const u32x4 v = *(const u32x4*)(src + 8 * hf); u32x4 r;
                  r.x = pk2(bflo(v.x) * sc, bfhi(v.x) * sc); r.y = pk2(bflo(v.y) * sc, bfhi(v.y) * sc); r.z = pk2(bflo(v.z) * sc, bfhi(v.z) * sc); r.w = pk2(bflo(v.w) * sc, bfhi(v.w) * sc);
                  *(LAS u32x4*)(Xh + l * LDX + p0 + 8 * hf) = r; } }
            lds_barrier();
            f32x4 acc[4];
#pragma unroll
            for (int pb = 0; pb < 4; ++pb) { acc[pb] = (f32x4){0.f, 0.f, 0.f, 0.f};
#pragma unroll
                for (int ks = 0; ks < 4; ++ks) { const bf16x8 af = frag_tr(Xh, LDX, 32 * ks, 16 * pb, lane); acc[pb] = MFMA16(af, bfr[ks], acc[pb]); } }
            bf16_t* S = WS_(p, STATES) + (((size_t)c * 32 + 8 * g + h) * 64) * 128;
#pragma unroll
            for (int pb = 0; pb < 4; ++pb)
#pragma unroll
                for (int r = 0; r < 4; ++r) S[(size_t)(16 * pb + 4 * (lane >> 4) + r) * 128 + 16 * w + (lane & 15)] = (bf16_t)f2bf(acc[pb][r]);
            lds_barrier();
        }
    }
}
DEV void phase_mb_scan(const Params& p) {
    const int tid = tid_(), bid = bid_();
    if (tid >= 128) return;
    const int gid = bid * 128 + tid;
    const int n8 = gid & 15, pp = (gid >> 4) & 63, h = gid >> 10; const int n = 8 * n8;
    float r[8]; for (int e = 0; e < 8; ++e) r[e] = 0.f;
    const size_t eo = ((size_t)h * 64 + pp) * 128 + n;
    const size_t fo = (size_t)h * 64 * 128 + fragmajor_off(pp, n, 128);
#pragma unroll 8
    for (int c = 0; c < 128; ++c) {
        const u32x4 sr = *(const u32x4*)(WS_(p, STATES) + (size_t)c * 32 * 64 * 128 + eo);
        const float cd = WS_(p, CD)[c * 32 + h];
        u32x4 o; o.x = pk2(r[0], r[1]); o.y = pk2(r[2], r[3]); o.z = pk2(r[4], r[5]); o.w = pk2(r[6], r[7]);
        *(u32x4*)(WS_(p, PREV) + (size_t)c * 32 * 64 * 128 + fo) = o;
        r[0] = r[0] * cd + bflo(sr.x); r[1] = r[1] * cd + bfhi(sr.x); r[2] = r[2] * cd + bflo(sr.y); r[3] = r[3] * cd + bfhi(sr.y);
        r[4] = r[4] * cd + bflo(sr.z); r[5] = r[5] * cd + bfhi(sr.z); r[6] = r[6] * cd + bflo(sr.w); r[7] = r[7] * cd + bfhi(sr.w);
    }
}
DEV void phase_mb_out(const Params& p, int j, LAS unsigned char* lds) {
    const int tid = tid_(), bid = bid_(); (void)tid; (void)bid;
    const int lane = tid & 63, w = tid >> 6; const int fr = lane & 15, fq = lane >> 4;
    LAS bf16_t* Cm = (LAS bf16_t*)lds;
    LAS bf16_t* Bm = Cm + 128 * LDB;
    LAS bf16_t* Xh = Bm + 128 * LDB;
    LAS bf16_t* Mw = Xh + 128 * LDX;
    LAS float* dts = (LAS float*)(Mw + 8 * 16 * LDB);
    LAS float* dacs = dts + 1024;
    LAS bf16_t* Mme = Mw + w * 16 * LDB;
    for (int u = bid; u < 512; u += NB_) {
        const int c = u >> 2, g = u & 3; const int t0 = c * 128;
        lds_barrier();
        mb_dacs(p, j, c, g, dts, dacs);
        ld_tile128(WS_(p, XC) + (size_t)t0 * 3072 + 2048 + 512 + 128 * g, 3072, Cm);
        ld_tile128(WS_(p, XC) + (size_t)t0 * 3072 + 2048 + 128 * g, 3072, Bm);
        lds_barrier();
        f32x4 sc[8]; bf16x8 cf[4];
#pragma unroll
        for (int ks = 0; ks < 4; ++ks) cf[ks] = frag_rm(Cm, LDB, 16 * w, 32 * ks, lane);
#pragma unroll
        for (int sb = 0; sb < 8; ++sb) { sc[sb] = (f32x4){0.f, 0.f, 0.f, 0.f};
#pragma unroll
            for (int ks = 0; ks < 4; ++ks) sc[sb] = MFMA16(cf[ks], frag_rm(Bm, LDB, 16 * sb, 32 * ks, lane), sc[sb]); }
        float ssq = 0.f;
        const int rl = tid >> 2, p0 = (tid & 3) * 16;
        const LAS float* Yrow = (const LAS float*)(Mw + (rl >> 4) * 16 * LDB) + (rl & 15) * 68 + p0;
        LAS float* Yw = (LAS float*)Mme;
        u32x4 xraw[2], zraw[2], xnx[2], znx[2]; bf16x8 pfc[16];
#define MB_LOADH(HH, XR, ZR) do { const int hh_ = 8 * g + (HH); \
            XR[0] = *(const u32x4*)(WS_(p, XC) + (size_t)(t0 + rl) * 3072 + 64 * hh_ + p0); XR[1] = *(const u32x4*)(WS_(p, XC) + (size_t)(t0 + rl) * 3072 + 64 * hh_ + p0 + 8); \
            ZR[0] = *(const u32x4*)(WS_(p, Z) + (size_t)(t0 + rl) * 2048 + 64 * hh_ + p0); ZR[1] = *(const u32x4*)(WS_(p, Z) + (size_t)(t0 + rl) * 2048 + 64 * hh_ + p0 + 8); } while (0)
        MB_LOADH(0, xraw, zraw);
#pragma unroll 1
        for (int h = 0; h < 8; ++h) {
            const int hh = 8 * g + h;
            MB_LOADH(h < 7 ? h + 1 : h, xnx, znx);
            { const bf16_t* pv_ = WS_(p, PREV) + ((size_t)c * 32 + hh) * 64 * 128;
#pragma unroll
              for (int i_ = 0; i_ < 16; ++i_) pfc[i_] = *(const bf16x8*)(pv_ + ((size_t)i_ * 64 + lane) * 8); }
            { const float scl = dts[h * 128 + rl];
#pragma unroll
              for (int hf = 0; hf < 2; ++hf) { const u32x4 v = xraw[hf]; u32x4 r;
                  r.x = pk2(bflo(v.x) * scl, bfhi(v.x) * scl); r.y = pk2(bflo(v.y) * scl, bfhi(v.y) * scl); r.z = pk2(bflo(v.z) * scl, bfhi(v.z) * scl); r.w = pk2(bflo(v.w) * scl, bfhi(v.w) * scl);
                  *(LAS u32x4*)(Xh + rl * LDX + p0 + 8 * hf) = r; } }
            const u32x4 zraw0 = zraw[0], zraw1 = zraw[1];
            float dl[4];
#pragma unroll
            for (int r = 0; r < 4; ++r) dl[r] = dacs[h * 128 + 16 * w + 4 * fq + r];
#pragma unroll
            for (int sb = 0; sb < 8; ++sb) { const int s_ = 16 * sb + fr; const float ds = dacs[h * 128 + s_];
#pragma unroll
                for (int r = 0; r < 4; ++r) { const int l = 16 * w + 4 * fq + r; const float m = (s_ <= l) ? sc[sb][r] * __expf(dl[r] - ds) : 0.f; Mme[(4 * fq + r) * LDB + s_] = (bf16_t)f2bf(m); } }
            lds_barrier();
            bf16x8 mf[4];
#pragma unroll
            for (int ks = 0; ks < 4; ++ks) mf[ks] = frag_rm(Mme, LDB, 0, 32 * ks, lane);
            f32x4 yv[4];
#pragma unroll
            for (int pb = 0; pb < 4; ++pb) {
                f32x4 a = {0.f, 0.f, 0.f, 0.f}, o = {0.f, 0.f, 0.f, 0.f};
#pragma unroll
                for (int ks = 0; ks < 4; ++ks) {
                    a = MFMA16(mf[ks], frag_tr(Xh, LDX, 32 * ks, 16 * pb, lane), a);
                    o = MFMA16(cf[ks], pfc[pb * 4 + ks], o);
                }
#pragma unroll
                for (int r = 0; r < 4; ++r) a[r] += o[r] * __expf(dl[r]);
                yv[pb] = a;
            }
#pragma unroll
            for (int pb = 0; pb < 4; ++pb)
#pragma unroll
                for (int r = 0; r < 4; ++r) Yw[(4 * fq + r) * 68 + 16 * pb + fr] = yv[pb][r];
            lds_barrier();
            {
                const float dsk = p.mb_d[j * 32 + hh]; const float* ng = p.mb_norm_g + (size_t)j * 2048 + 64 * hh + p0;
                float y[16], xs[16], zz[16];
#pragma unroll
                for (int q = 0; q < 4; ++q) { const f32x4 t4 = *(const LAS f32x4*)(Yrow + 4 * q); y[4 * q] = t4[0]; y[4 * q + 1] = t4[1]; y[4 * q + 2] = t4[2]; y[4 * q + 3] = t4[3]; }
                xs[0] = bflo(xraw[0].x); xs[1] = bfhi(xraw[0].x); xs[2] = bflo(xraw[0].y); xs[3] = bfhi(xraw[0].y); xs[4] = bflo(xraw[0].z); xs[5] = bfhi(xraw[0].z); xs[6] = bflo(xraw[0].w); xs[7] = bfhi(xraw[0].w);
                xs[8] = bflo(xraw[1].x); xs[9] = bfhi(xraw[1].x); xs[10] = bflo(xraw[1].y); xs[11] = bfhi(xraw[1].y); xs[12] = bflo(xraw[1].z); xs[13] = bfhi(xraw[1].z); xs[14] = bflo(xraw[1].w); xs[15] = bfhi(xraw[1].w);
                zz[0] = bflo(zraw0.x); zz[1] = bfhi(zraw0.x); zz[2] = bflo(zraw0.y); zz[3] = bfhi(zraw0.y); zz[4] = bflo(zraw0.z); zz[5] = bfhi(zraw0.z); zz[6] = bflo(zraw0.w); zz[7] = bfhi(zraw0.w);
                zz[8] = bflo(zraw1.x); zz[9] = bfhi(zraw1.x); zz[10] = bflo(zraw1.y); zz[11] = bfhi(zraw1.y); zz[12] = bflo(zraw1.z); zz[13] = bfhi(zraw1.z); zz[14] = bflo(zraw1.w); zz[15] = bfhi(zraw1.w);
                float o[16];
#pragma unroll
                for (int q = 0; q < 4; ++q) { const f32x4 n4 = *(const f32x4*)(ng + 4 * q);
#pragma unroll
                    for (int e = 0; e < 4; ++e) { const int i = 4 * q + e; const float v = (y[i] + xs[i] * dsk) * siluf_(zz[i]); ssq += v * v; o[i] = v * n4[e]; } }
                bf16_t* dst = WS_(p, YB) + (size_t)(t0 + rl) * 2048 + 64 * hh + p0;
                u32x4 w0, w1; w0.x = pk2(o[0], o[1]); w0.y = pk2(o[2], o[3]); w0.z = pk2(o[4], o[5]); w0.w = pk2(o[6], o[7]); w1.x = pk2(o[8], o[9]); w1.y = pk2(o[10], o[11]); w1.z = pk2(o[12], o[13]); w1.w = pk2(o[14], o[15]);
                *(u32x4*)dst = w0; *(u32x4*)(dst + 8) = w1;
            }
            xraw[0] = xnx[0]; xraw[1] = xnx[1]; zraw[0] = znx[0]; zraw[1] = znx[1];
            lds_barrier();
        }
#undef MB_LOADH
        ssq += __shfl_xor(ssq, 1); ssq += __shfl_xor(ssq, 2);
        const float rstd = rsqrtf(ssq * (1.0f / 512.0f) + 1e-5f);
#pragma unroll 1
        for (int h = 0; h < 8; ++h) {
            bf16_t* dst = WS_(p, YB) + (size_t)(t0 + rl) * 2048 + 64 * (8 * g + h) + p0;
#pragma unroll
            for (int hf = 0; hf < 2; ++hf) { const u32x4 v = *(const u32x4*)(dst + 8 * hf); u32x4 r;
                r.x = pk2(bflo(v.x) * rstd, bfhi(v.x) * rstd); r.y = pk2(bflo(v.y) * rstd, bfhi(v.y) * rstd); r.z = pk2(bflo(v.z) * rstd, bfhi(v.z) * rstd); r.w = pk2(bflo(v.w) * rstd, bfhi(v.w) * rstd);
                *(u32x4*)(dst + 8 * hf) = r; }
        }
    }
}
constexpr int GL_PROJ = 3088;
constexpr int LDV = 264;
struct SchedGlIn {
    const Params* p;
    DEV bool next(int i, Unit& u) const {
        int pm, pn; if (!pg8::tile_order(i, NB_, bid_(), 64, 12, pm, pn)) return false;
        u.A = (const char*)(WS_(*p, Hb) + (size_t)pm * 256 * D); u.B = (const char*)(WS_(*p, gl_win_t) + (size_t)pn * 256 * D); u.row0 = pm * 256; u.col0 = pn * 256; u.id = 0; u.aux = 0; return true;
    }
};
struct EpiGlIn {
    const Params* p;
    DEV void operator()(const AccT& acc, const Unit& u, int wr, int wc, int fr, int fq) const {
        FOR_ACC2(ai, bj, m) { st_bf8p(WS_(*p, QKVG) + (size_t)ACC_ROW(u, ai, m) * 3072 + ACC_COL8P(u, bj, PF(5)), acc[ai][bj][m][0], acc[ai][bj][m][1], PF(5)); ACC_FENCE; }
    }
};
DEV void gl_bcs(const Params& p, int n, int h, LAS float* bcs) {
    const int tid = tid_();
    for (int i = tid; i < 64 * 32; i += NTHR) { const int r = i >> 5, c4 = (i & 31) * 4; *(LAS f32x4*)(bcs + r * 128 + c4) = *(const f32x4*)(WS_(p, LA) + (size_t)(n * 64 + r) * 512 + 128 * h + c4); }
    lds_barrier();
    if (tid < 128) { float s = 0.f; for (int r = 0; r < 64; ++r) { s += bcs[r * 128 + tid]; bcs[r * 128 + tid] = s; } }
    lds_barrier();
}
DEV void phase_gl_kv(const Params& p, LAS unsigned char* lds) {
    const int tid = tid_(), bid = bid_(); (void)tid; (void)bid;
    const int lane = tid & 63, w = tid >> 6;
    LAS float* bcs = (LAS float*)lds;
    LAS bf16_t* Ke = (LAS bf16_t*)(bcs + 64 * 128);
    LAS bf16_t* Vs = Ke + 64 * LDB;
    for (int u = bid; u < 1024; u += NB_) {
        const int n = u >> 2, h = u & 3; const int t0 = n * 64;
        lds_barrier();
        gl_bcs(p, n, h, bcs);
        for (int i = tid; i < 64 * 16; i += NTHR) { const int r = i >> 4, c8 = (i & 15) * 8;
            const u32x4 v = *(const u32x4*)(WS_(p, QKVG) + (size_t)(t0 + r) * 3072 + 512 + 128 * h + c8); float f[8];
            f[0] = bflo(v.x); f[1] = bfhi(v.x); f[2] = bflo(v.y); f[3] = bfhi(v.y); f[4] = bflo(v.z); f[5] = bfhi(v.z); f[6] = bflo(v.w); f[7] = bfhi(v.w);
#pragma unroll
            for (int e = 0; e < 8; ++e) f[e] *= __expf(bcs[63 * 128 + c8 + e] - bcs[r * 128 + c8 + e]);
            u32x4 o; o.x = pk2(f[0], f[1]); o.y = pk2(f[2], f[3]); o.z = pk2(f[4], f[5]); o.w = pk2(f[6], f[7]);
            *(LAS u32x4*)(Ke + r * LDB + c8) = o; }
        for (int i = tid; i < 64 * 32; i += NTHR) { const int r = i >> 5, c8 = (i & 31) * 8; *(LAS u32x4*)(Vs + r * LDV + c8) = *(const u32x4*)(WS_(p, QKVG) + (size_t)(t0 + r) * 3072 + 1024 + 256 * h + c8); }
        if (tid < 128) WS_(p, CDG)[((size_t)n * 4 + h) * 128 + tid] = __expf(bcs[63 * 128 + tid]);
        lds_barrier();
        bf16x8 af[2];
#pragma unroll
        for (int ks = 0; ks < 2; ++ks) af[ks] = frag_tr(Ke, LDB, 32 * ks, 16 * w, lane);
        bf16_t* O = WS_(p, STATES) + (((size_t)n * 4 + h) * 128) * 256;
#pragma unroll
        for (int vb = 0; vb < 16; ++vb) {
            f32x4 acc = {0.f, 0.f, 0.f, 0.f};
#pragma unroll
            for (int ks = 0; ks < 2; ++ks) acc = MFMA16(af[ks], frag_tr(Vs, LDV, 32 * ks, 16 * vb, lane), acc);
            { u32x2 o; o.x = pk2(acc[0], acc[1]); o.y = pk2(acc[2], acc[3]); *(u32x2*)(O + (size_t)(16 * vb + (lane & 15)) * 128 + 16 * w + 4 * (lane >> 4)) = o; }
        }
    }
}
DEV void phase_gl_scan(const Params& p) {
    const int tid = tid_(), bid = bid_();
    if (tid >= 64) return;
    const int gid = bid * 64 + tid;
    const int k8 = gid & 15, v = (gid >> 4) & 255, h = gid >> 12; const int k = 8 * k8;
    float r[8]; for (int e = 0; e < 8; ++e) r[e] = 0.f;
    const size_t fo = (size_t)h * 128 * 256 + fragmajor_off(v, k, 128);
#pragma unroll 8
    for (int n = 0; n < 256; ++n) {
        const u32x4 sr = *(const u32x4*)(WS_(p, STATES) + (((size_t)n * 4 + h) * 256 + v) * 128 + k);
        const f32x4 c0 = *(const f32x4*)(WS_(p, CDG) + ((size_t)n * 4 + h) * 128 + k), c1 = *(const f32x4*)(WS_(p, CDG) + ((size_t)n * 4 + h) * 128 + k + 4);
        u32x4 o; o.x = pk2(r[0], r[1]); o.y = pk2(r[2], r[3]); o.z = pk2(r[4], r[5]); o.w = pk2(r[6], r[7]);
        *(u32x4*)(WS_(p, PREV) + (size_t)n * 4 * 128 * 256 + fo) = o;
        r[0] = r[0] * c0[0] + bflo(sr.x); r[1] = r[1] * c0[1] + bfhi(sr.x); r[2] = r[2] * c0[2] + bflo(sr.y); r[3] = r[3] * c0[3] + bfhi(sr.y);
        r[4] = r[4] * c1[0] + bflo(sr.z); r[5] = r[5] * c1[1] + bfhi(sr.z); r[6] = r[6] * c1[2] + bflo(sr.w); r[7] = r[7] * c1[3] + bfhi(sr.w);
    }
}
DEV void phase_gl_out(const Params& p, int j, LAS unsigned char* lds) {
    const int tid = tid_(), bid = bid_(); (void)tid; (void)bid;
    const int lane = tid & 63, w = tid >> 6; const int fr = lane & 15, fq = lane >> 4;
    LAS float* bcs = (LAS float*)lds;
    LAS bf16_t* Qs = (LAS bf16_t*)(bcs + 64 * 128);
    LAS bf16_t* Ks = Qs + 64 * LDB;
    LAS bf16_t* Vs = Ks + 64 * LDB;
    LAS bf16_t* At = Vs + 64 * LDV;
    LAS float* red = (LAS float*)(At + 64 * LDX);
    for (int u = bid; u < 1024; u += NB_) {
        const int n = u >> 2, h = u & 3; const int t0 = n * 64;
        lds_barrier();
        gl_bcs(p, n, h, bcs);
        for (int i = tid; i < 64 * 16; i += NTHR) { const int r = i >> 4, c8 = (i & 15) * 8;
            const u32x4 vq = *(const u32x4*)(WS_(p, QKVG) + (size_t)(t0 + r) * 3072 + 128 * h + c8), vk = *(const u32x4*)(WS_(p, QKVG) + (size_t)(t0 + r) * 3072 + 512 + 128 * h + c8);
            float fq_[8], fk_[8];
            fq_[0] = bflo(vq.x); fq_[1] = bfhi(vq.x); fq_[2] = bflo(vq.y); fq_[3] = bfhi(vq.y); fq_[4] = bflo(vq.z); fq_[5] = bfhi(vq.z); fq_[6] = bflo(vq.w); fq_[7] = bfhi(vq.w);
            fk_[0] = bflo(vk.x); fk_[1] = bfhi(vk.x); fk_[2] = bflo(vk.y); fk_[3] = bfhi(vk.y); fk_[4] = bflo(vk.z); fk_[5] = bfhi(vk.z); fk_[6] = bflo(vk.w); fk_[7] = bfhi(vk.w);
#pragma unroll
            for (int e = 0; e < 8; ++e) { const float b = bcs[r * 128 + c8 + e]; fq_[e] *= __expf(b) * 0.08838834764831845f; fk_[e] *= __expf(-b); }
            u32x4 o; o.x = pk2(fq_[0], fq_[1]); o.y = pk2(fq_[2], fq_[3]); o.z = pk2(fq_[4], fq_[5]); o.w = pk2(fq_[6], fq_[7]);
            *(LAS u32x4*)(Qs + r * LDB + c8) = o;
            o.x = pk2(fk_[0], fk_[1]); o.y = pk2(fk_[2], fk_[3]); o.z = pk2(fk_[4], fk_[5]); o.w = pk2(fk_[6], fk_[7]);
            *(LAS u32x4*)(Ks + r * LDB + c8) = o; }
        for (int i = tid; i < 64 * 32; i += NTHR) { const int r = i >> 5, c8 = (i & 31) * 8; *(LAS u32x4*)(Vs + r * LDV + c8) = *(const u32x4*)(WS_(p, QKVG) + (size_t)(t0 + r) * 3072 + 1024 + 256 * h + c8); }
        lds_barrier();
        { const int ib = w >> 1;
#pragma unroll
          for (int jj = 0; jj < 2; ++jj) { const int jb = 2 * (w & 1) + jj; f32x4 a = {0.f, 0.f, 0.f, 0.f};
#pragma unroll
              for (int ks = 0; ks < 4; ++ks) a = MFMA16(frag_rm(Qs, LDB, 16 * ib, 32 * ks, lane), frag_rm(Ks, LDB, 16 * jb, 32 * ks, lane), a);
#pragma unroll
              for (int r = 0; r < 4; ++r) { const int i = 16 * ib + 4 * fq + r, jx = 16 * jb + fr; At[i * LDX + jx] = (bf16_t)f2bf(jx <= i ? a[r] : 0.f); } } }
        lds_barrier();
        f32x4 o[4][2];
        const bf16_t* pv = WS_(p, PREV) + ((size_t)n * 4 + h) * 128 * 256;
#pragma unroll
        for (int vv = 0; vv < 2; ++vv) { const int vb = 2 * w + vv;
            bf16x8 bi[2], bp[4];
#pragma unroll
            for (int ks = 0; ks < 2; ++ks) bi[ks] = frag_tr(Vs, LDV, 32 * ks, 16 * vb, lane);
#pragma unroll
            for (int ks = 0; ks < 4; ++ks) bp[ks] = *(const bf16x8*)(pv + ((size_t)(vb * 4 + ks) * 64 + lane) * 8);
#pragma unroll
            for (int ib = 0; ib < 4; ++ib) { f32x4 a = {0.f, 0.f, 0.f, 0.f};
#pragma unroll
                for (int ks = 0; ks < 2; ++ks) a = MFMA16(frag_rm(At, LDX, 16 * ib, 32 * ks, lane), bi[ks], a);
#pragma unroll
                for (int ks = 0; ks < 4; ++ks) a = MFMA16(frag_rm(Qs, LDB, 16 * ib, 32 * ks, lane), bp[ks], a);
                o[ib][vv] = a; } }
#pragma unroll
        for (int ib = 0; ib < 4; ++ib)
#pragma unroll
            for (int r = 0; r < 4; ++r) { float s = o[ib][0][r] * o[ib][0][r] + o[ib][1][r] * o[ib][1][r]; s = sum16(s); if (fr == 0) red[w * 64 + 16 * ib + 4 * fq + r] = s; }
        lds_barrier();
        {   LAS bf16_t* Os = (LAS bf16_t*)bcs;
#pragma unroll
            for (int ib = 0; ib < 4; ++ib)
#pragma unroll
                for (int vv = 0; vv < 2; ++vv)
#pragma unroll
                    for (int r = 0; r < 4; ++r) Os[(16 * ib + 4 * fq + r) * LDV + 32 * w + 16 * vv + fr] = (bf16_t)f2bf(o[ib][vv][r]);
            lds_barrier();
            const int row = tid >> 3, c0 = (tid & 7) * 32; const int t = t0 + row; float s = 0.f;
#pragma unroll
            for (int ww = 0; ww < 8; ++ww) s += red[ww * 64 + row];
            const float rs = rsqrtf(s * (1.0f / 256.0f) + 1e-5f);
#pragma unroll
            for (int q = 0; q < 4; ++q) {
                const u32x4 ov = *(const LAS u32x4*)(Os + row * LDV + c0 + 8 * q), gv = *(const u32x4*)(WS_(p, QKVG) + (size_t)t * 3072 + 2048 + 256 * h + c0 + 8 * q);
                const f32x4 n0 = *(const f32x4*)(p.gl_norm_g + j * 256 + c0 + 8 * q), n1 = *(const f32x4*)(p.gl_norm_g + j * 256 + c0 + 8 * q + 4);
                float r8[8];
                r8[0] = bflo(ov.x) * rs * n0[0] * siluf_(bflo(gv.x)); r8[1] = bfhi(ov.x) * rs * n0[1] * siluf_(bfhi(gv.x)); r8[2] = bflo(ov.y) * rs * n0[2] * siluf_(bflo(gv.y)); r8[3] = bfhi(ov.y) * rs * n0[3] * siluf_(bfhi(gv.y));
                r8[4] = bflo(ov.z) * rs * n1[0] * siluf_(bflo(gv.z)); r8[5] = bfhi(ov.z) * rs * n1[1] * siluf_(bfhi(gv.z)); r8[6] = bflo(ov.w) * rs * n1[2] * siluf_(bflo(gv.w)); r8[7] = bfhi(ov.w) * rs * n1[3] * siluf_(bfhi(gv.w));
                u32x4 wv; wv.x = pk2(r8[0], r8[1]); wv.y = pk2(r8[2], r8[3]); wv.z = pk2(r8[4], r8[5]); wv.w = pk2(r8[6], r8[7]);
                *(u32x4*)(WS_(p, YB) + (size_t)t * D + 256 * h + c0 + 8 * q) = wv;
            }
        }
    }
}
#define XB_TMO      128
#define XB_XCNT(j)  (256  + 64 * (j))
#define XB_XSUB(j)  (1280 + 64 * (j))
#define XB_XGEN(j)  (2304 + 64 * (j))
#define XB_TOP      3328
#define XB_TOPGEN   3392
#define XCD_BAR_WORDS 3456
#define XB_SPIN_CAP (1u << 22)
DEV unsigned xb_ld(unsigned* p)              { return __hip_atomic_load(p, __ATOMIC_RELAXED, __HIP_MEMORY_SCOPE_AGENT); }
DEV unsigned xb_add(unsigned* p, unsigned v) { return __hip_atomic_fetch_add(p, v, __ATOMIC_RELAXED, __HIP_MEMORY_SCOPE_AGENT); }
DEV unsigned xb_xcc_id() { return (unsigned)__builtin_amdgcn_s_getreg((3 << 11) | 20) & 0xFu; }
#define XB_SPIN(cond, bar) do { unsigned _sp = 0; while (cond) { __builtin_amdgcn_s_sleep(1); \
    if ((++_sp & 255u) == 0u) { if (xb_ld(&(bar)[XB_TMO])) break; if (_sp > XB_SPIN_CAP) { atomicAdd(&(bar)[XB_TMO], 1u); break; } } } } while (0)
struct XcdBarrier { unsigned* bar; unsigned x; volatile LAS unsigned* st; };
DEV XcdBarrier xcd_barrier_post(unsigned* bar, volatile LAS unsigned* st) {
    XcdBarrier b; b.bar = bar; b.x = xb_xcc_id(); b.st = st;
    if (threadIdx.x == 0) (void)xb_add(&bar[XB_XCNT(b.x)], 1u);
    return b;
}
DEV void xcd_barrier_complete(unsigned* bar, unsigned x, unsigned& nloc, unsigned& nx) {
    const unsigned G = gridDim.x * gridDim.y * gridDim.z;
    unsigned sum, cnt, mine, sp = 0u;
    for (;;) {
        sum = 0u; cnt = 0u; mine = 0u;
#pragma unroll
        for (unsigned j = 0; j < 16; ++j) { const unsigned c = xb_ld(&bar[XB_XCNT(j)]); sum += c; cnt += (c > 0u) ? 1u : 0u; mine = (j == x) ? c : mine; }
        if (sum == G) break;
        __builtin_amdgcn_s_sleep(1);
        if ((++sp & 255u) == 0u) { if (xb_ld(&bar[XB_TMO])) break; if (sp > XB_SPIN_CAP) { atomicAdd(&bar[XB_TMO], 1u); break; } }
    }
    nloc = mine > 0u ? mine : 1u; nx = cnt > 0u ? cnt : 1u;
}
DEV void xcd_barrier(const XcdBarrier& b) {
    asm volatile("s_waitcnt vmcnt(0)" ::: "memory");
    __syncthreads();
    if (threadIdx.x == 0) {
        unsigned* bar = b.bar;
        __builtin_amdgcn_s_waitcnt(0);
        unsigned nloc = b.st[0], nx = b.st[1];
        if (nloc == 0u) { xcd_barrier_complete(bar, b.x, nloc, nx); b.st[0] = nloc; b.st[1] = nx; }
        const unsigned old = xb_add(&bar[XB_XSUB(b.x)], 1u);
        const unsigned gen = old / nloc;
        if (old + 1u == (gen + 1u) * nloc) {
            __builtin_amdgcn_fence(__ATOMIC_RELEASE, "agent");
            asm volatile("s_waitcnt vmcnt(0)" ::: "memory");
            const unsigned og = xb_add(&bar[XB_TOP], 1u);
            const unsigned tg = og / nx;
            if (og + 1u == (tg + 1u) * nx) xb_add(&bar[XB_TOPGEN], 1u);
            else XB_SPIN(xb_ld(&bar[XB_TOPGEN]) == tg, bar);
            __builtin_amdgcn_fence(__ATOMIC_ACQUIRE, "agent");
            xb_add(&bar[XB_XGEN(b.x)], 1u);
            asm volatile("s_waitcnt vmcnt(0)" ::: "memory");
        } else {
            XB_SPIN(xb_ld(&bar[XB_XGEN(b.x)]) == gen, bar);
            __builtin_amdgcn_fence(__ATOMIC_ACQUIRE, "agent");
            asm volatile("s_waitcnt vmcnt(0)" ::: "memory");
        }
    }
    __syncthreads();
}

DEV void moe_tail_convert(const Params& p, LAS unsigned char* lds, int layer) {
    if (layer != 1) return;
    convert_tickets(moe_job(p, 0, layer + 1), moe_job(p, 1, layer + 1), lds, WS_(p, MFLAG) + MFLAG_TICKET * MFLAG_STRIDE, MFLAG_STRIDE);
}
DEV LAS int* moe_tab_to_lds(const Params& p, LAS unsigned char* lds) {
    LAS int* tab = (LAS int*)(lds + pg8::STAGE_BYTES);
    const int tid = tid_();
    if (tid < 256) tab[tid] = __hip_atomic_load(WS_(p, TAB) + tid, __ATOMIC_RELAXED, __HIP_MEMORY_SCOPE_AGENT);
    __syncthreads();
    return tab;
}
DEV void rw_side_convert(const Params& p, LAS unsigned char* lds, int c0, int n) {
#pragma unroll 1
    for (int c = c0; c < c0 + n; ++c) {
        const int ml = c == 0 ? 0 : c == 3 ? 1 : 3;
        const ConvJob J0 = (c == 1 || c == 2) ? make_job(p, 6 + 2 * c) : moe_job(p, 0, ml), J1 = (c == 1 || c == 2) ? make_job(p, 7 + 2 * c) : moe_job(p, 1, ml);
        convert_tickets(J0, J1, lds, WS_(p, MFLAG) + (MFLAG_SIDE + 32 * c) * MFLAG_STRIDE, MFLAG_STRIDE);
    }
}
DEV void run_phase(const Params& pin, int op, int arg, LAS unsigned char* lds) {
    Params p = pin; { size_t z_ = 0; asm volatile("" : "+s"(z_)); p.ws = pin.ws + z_; }
    const int layer = arg; const int jj = layer / 3;
#ifdef ONLY_OP
    if (op != ONLY_OP) return;
#endif
#ifdef OPMASK
    if (!((OPMASK >> op) & 1ull)) return;
#endif
    switch (op) {
    case OP_CONVERT: phase_pre0(p); phase_convert(p, lds);
#ifdef DBG
        if (blockIdx.x == 0 && threadIdx.x < 24) WS_(p, TAB)[200 + threadIdx.x] = 0;
#endif
        break;
    case OP_PRE0: break;
    case OP_RW_GEMM1: { SchedRW1 S{&p, jj}; EpiRW1 E{&p}; pg8::gemm_phase(lds, 1024, S, E); } break;
    case OP_RW_GEMM2: { SchedRW2 S{&p, jj}; EpiRW2 E{&p, jj}; pg8::gemm_phase(lds, 256, S, E); } break;
#ifdef REP_RW
#define REPL_(OPX) _Pragma("unroll 1") for (int rep_ = 0; rep_ < ((OPX) == REP_RW && layer == REP_L ? 2 : 1); ++rep_)
#else
#define REPL_(OPX)
#endif
#define RW_AC(FN, half, k) do { const int hs_ = (half) * 2048, tl_ = hs_ + 2048 - 64 * (k); \
        if (bid_() >= RW_NB) FN(p, jj, lds, hs_ + bid_() - RW_NB, tl_, RW_NW); else if ((k) > 0) { __syncthreads(); FN(p, jj, lds, tl_ + bid_(), hs_ + 2048, RW_NB); } } while (0)
    case OP_RW_CHA: if (bid_() >= RW_NB) phase_rw_cha(p, jj, lds, bid_() - RW_NB, 2048, RW_NW); __syncthreads(); rw_side_convert(p, lds, layer == 0 ? 0 : 4, 1); break;
    case OP_RW_CHB: if (bid_() < RW_NB) phase_rw_chb(p, lds, 0); RW_AC(phase_rw_cha, 1, 0); __syncthreads(); if (layer == 0) rw_side_convert(p, lds, 1, 2); break;
    case OP_RW_CHC: if (bid_() < RW_NB) phase_rw_chb(p, lds, 1); RW_AC(phase_rw_chc, 0, 0); break;
    case OP_RW_CHD: RW_AC(phase_rw_chc, 1, 8); __syncthreads(); if (layer == 0) rw_side_convert(p, lds, 3, 1); break;
    case OP_RW_OUT: { SchedOut S{WS_(p, YB), WS_(p, rw_wo_t) + (size_t)jj * D * D, 1024}; EpiOut E{WS_(p, MIXb)}; pg8::gemm_phase(lds, 1024, S, E); } break;
    case OP_LN1: phase_ln1(p, layer, lds); break;
    case OP_MOE_SCATTER: phase_moe_scatter(p, lds); break;
    case OP_MOE_GEMM1: { LAS int* tab = moe_tab_to_lds(p, lds);
#ifdef REP_MOE
#pragma unroll 1
        for (int rep_ = 0; rep_ < REP_MOE; ++rep_) {
#endif
        { SchedMoe<0> S{&p, layer, tab}; EpiMoe1 E{WS_(p, ACT), WS_(p, MFLAG)}; pg8::gemm_phase(lds, 1024, S, E); }
        { SchedMoe<1> S{&p, layer, tab}; EpiMoe2 E{WS_(p, YBUF)}; pg8::gemm_phase(lds, 512, S, E); }
#ifdef REP_MOE
        }
#endif
        moe_tail_convert(p, lds, layer); } break;
    case OP_MOE_GEMM2: break;
    case OP_LN2: phase_ln2(p, layer, lds); break;
    case OP_MB_GEMM_IN: { SchedMbIn S{&p}; EpiMbIn E{&p}; pg8::gemm_phase(lds, 1024, S, E); } break;
    case OP_MB_CONV: phase_mb_conv(p, jj); break;
    case OP_MB_STATES: phase_mb_states(p, jj, lds); break;
    case OP_MB_SCAN: phase_mb_scan(p); break;
    case OP_MB_OUT: phase_mb_out(p, jj, lds); break;
    case OP_MB_GEMM_OUT: { SchedOut S{WS_(p, YB), WS_(p, mb_wout_t) + (size_t)jj * D * 2048, 2048}; EpiOut E{WS_(p, MIXb)}; pg8::gemm_phase(lds, 2048, S, E); } break;
    case OP_GL_GEMM_IN: { SchedGlIn S{&p}; EpiGlIn E{&p}; pg8::gemm_phase(lds, 1024, S, E); } break;
    case OP_GL_KV: phase_gl_kv(p, lds); break;
    case OP_GL_SCAN: phase_gl_scan(p); break;
    case OP_GL_OUT: phase_gl_out(p, jj, lds); break;
    case OP_GL_GEMM_OUT: { SchedOut S{WS_(p, YB), WS_(p, gl_wout_t) + (size_t)jj * D * D, 1024}; EpiOut E{WS_(p, MIXb)}; pg8::gemm_phase(lds, 1024, S, E); } break;
    default: break;
    }
}

constexpr int NPHASES = 1 + 11 + 10 + 9 + 11;
DEV void decode_phase(int ph, int& op, int& layer) {
    if (ph < 1) { op = OP_CONVERT; layer = 0; return; }
    int q = ph - 1; layer = 0;
    if (q >= 11) { q -= 11; layer = 1; if (q >= 10) { q -= 10; layer = 2; if (q >= 9) { q -= 9; layer = 3; } } }
    const int kind = layer % 3; const int nmix = kind == 0 ? 7 : kind == 1 ? 6 : 5;
    if (q < nmix) op = (kind == 0 ? OP_RW_GEMM1 : kind == 1 ? OP_MB_GEMM_IN : OP_GL_GEMM_IN) + q;
    else { const int m = q - nmix; op = m < 3 ? OP_LN1 + m : OP_LN2; }
}

#define X(t, n) t n##_,
template <bool COOP>
__global__ void __launch_bounds__(NTHR, 2) mega(PARAM_LIST(X) const int ph0, const int ph1) {
#undef X
    Params p;
#define X(t, n) p.n = n##_;
    PARAM_LIST(X)
#undef X

    extern __shared__ __attribute__((aligned(16))) unsigned char smem_raw[];
    LAS unsigned char* lds = (LAS unsigned char*)smem_raw;
    if constexpr (COOP) {
        volatile LAS unsigned* st = (volatile LAS unsigned*)(lds + LDS_BYTES - 16);
        if (threadIdx.x == 0) { st[0] = 0u; st[1] = 0u; }
        __syncthreads();
        XcdBarrier xb = xcd_barrier_post(WS_(p, bar), st);
        if (ph0 < 0) cg::this_grid().sync();
        for (int ph = ph0; ph < ph1; ++ph) {
            int op, arg; decode_phase(ph, op, arg);
#ifdef REPEAT_MASK
            const int reps = 1 + (int)((REPEAT_MASK >> op) & 1ull);
#else
            const int reps = 1;
#endif
#pragma unroll 1
            for (int rep = 0; rep < reps; ++rep) {
                run_phase(p, op, arg, lds);
                if (ph + 1 < ph1 || rep + 1 < reps) { xcd_barrier(xb);
#ifdef BAR2
                    xcd_barrier(xb);
#endif
                }
            }
        }
#ifdef DBG
        xcd_barrier(xb);
#ifndef DBG_WORD
#define DBG_WORD 200
#endif
        { const int code = __hip_atomic_load(WS_(p, TAB) + DBG_WORD, __ATOMIC_RELAXED, __HIP_MEMORY_SCOPE_AGENT);
          for (size_t i = (size_t)blockIdx.x * NTHR + threadIdx.x; i < (size_t)T * D; i += (size_t)NB_ * NTHR) p.out[i] = 0.f;
          __syncthreads();
          if (blockIdx.x == 0 && threadIdx.x == 0) p.out[0] = sqrtf((float)DBG_DECODE(code) * 1.68e7f); }
#endif
    } else {
        for (int ph = ph0; ph < ph1; ++ph) { int op, arg; decode_phase(ph, op, arg); run_phase(p, op, arg, lds); }
    }
}


extern "C" void kernel_launch(void* const* d_in, const int* in_sizes, int n_in, void* d_out, int out_size, void* d_ws, size_t ws_size, hipStream_t stream) {
    (void)in_sizes; (void)n_in; (void)out_size;
    Params p; std::memset((void*)&p, 0, sizeof(p));
    auto F = [&](int i) { return (const float*)d_in[i]; };
    p.x = F(0); p.ln_g = F(1); p.ln_b = F(2);
    p.rw_mu = F(3); p.rw_w_rkv = F(4); p.rw_w0 = F(5); p.rw_w1 = F(6); p.rw_w2 = F(7); p.rw_a0 = F(8);
    p.rw_a1 = F(9); p.rw_a2 = F(10); p.rw_g1 = F(11); p.rw_g2 = F(12);
    p.rw_k_k = F(13); p.rw_k_a = F(14); p.rw_r_k = F(15); p.rw_lnx_g = F(16); p.rw_lnx_b = F(17); p.rw_w_o = F(18);
    p.mb_w_in = F(19); p.mb_conv_w = F(20); p.mb_conv_b = F(21); p.mb_dt_bias = F(22); p.mb_a_log = F(23); p.mb_d = F(24); p.mb_norm_g = F(25); p.mb_w_out = F(26);
    p.gl_w_in = F(27); p.gl_gk_w2 = F(28); p.gl_gk_b = F(29); p.gl_norm_g = F(30); p.gl_w_out = F(31);
    p.moe_w_group = F(32); p.moe_b_group = F(33); p.moe_w_route = F(34); p.moe_b_route = F(35); p.moe_w_in = F(36); p.moe_w_down = F(37);
    p.out = (float*)d_out;
    p.ws = (char*)d_ws;
    if (WS_TOTAL > ws_size) { fprintf(stderr, "workspace too small: need %zu have %zu\n", (size_t)WS_TOTAL, ws_size); return; }
    unsigned* bar_ptr = (unsigned*)(p.ws + OFF_bar);
    const int np = NPHASES;
#define X(t, n) (void*)&p.n,
#if SINGLE_LAUNCH
    (void)hipFuncSetAttribute((const void*)mega<true>, hipFuncAttributeMaxDynamicSharedMemorySize, LDS_BYTES);
    (void)hipMemsetAsync(bar_ptr, 0, XCD_BAR_WORDS * sizeof(unsigned), stream);
    int ph0 = 0, ph1 = np; void* args[] = {PARAM_LIST(X) (void*)&ph0, (void*)&ph1};
    hipError_t e = hipLaunchCooperativeKernel((const void*)mega<true>, dim3(NBLK), dim3(NTHR), args, LDS_BYTES, stream);
    if (e != hipSuccess) fprintf(stderr, "cooperative launch failed: %s\n", hipGetErrorString(e));
#else
    (void)hipFuncSetAttribute((const void*)mega<false>, hipFuncAttributeMaxDynamicSharedMemorySize, LDS_BYTES);
    for (int ph = 0; ph < np; ++ph) { int ph0 = ph, ph1 = ph + 1; void* args[] = {PARAM_LIST(X) (void*)&ph0, (void*)&ph1};
        hipError_t e = hipLaunchKernel((const void*)mega<false>, dim3(NBLK), dim3(NTHR), args, LDS_BYTES, stream);
        if (e != hipSuccess) fprintf(stderr, "launch failed: %s\n", hipGetErrorString(e)); }
#endif
#undef X
}
```

```cpp
#include <hip/hip_runtime.h>
#include <hip/hip_cooperative_groups.h>
#include <cstdint>
#include <cstdio>
#include <cstring>
namespace cg = cooperative_groups;

typedef unsigned short bf16_t;
typedef short bf16x8 __attribute__((ext_vector_type(8)));
typedef short s16x4 __attribute__((ext_vector_type(4)));
typedef float f32x4 __attribute__((ext_vector_type(4)));
typedef float f32x2 __attribute__((ext_vector_type(2)));
typedef unsigned u32x4 __attribute__((ext_vector_type(4)));
typedef unsigned u32x2 __attribute__((ext_vector_type(2)));
#define LAS __attribute__((address_space(3)))
#define DEV __device__ __forceinline__

constexpr int T = 16384, D = 1024, DEPTH = 4;
constexpr int NTHR = 512, NBLK = 256;
constexpr int LDS_BYTES = 155648;
constexpr float ALPHA = 1.681792830507429f;
constexpr float LN_EPS = 1e-5f;
constexpr int MOE_ROWS = 40960;

DEV int tid_() { int t = threadIdx.x; asm volatile("" : "+v"(t)); return t; }
DEV int bid_() { int b = blockIdx.x; asm volatile("" : "+s"(b)); return b; }
#define NB_ 256
#define RCOL(q, lane) ((((q) >> 1) * 512) + 8 * (lane) + 4 * ((q) & 1))
DEV void lds_barrier() { asm volatile("s_waitcnt lgkmcnt(0)" ::: "memory"); __builtin_amdgcn_s_barrier(); asm volatile("" ::: "memory"); }
DEV unsigned f2bf(float f) { unsigned u = __float_as_uint(f); u += 0x7FFFu + ((u >> 16) & 1u); return u >> 16; }
DEV float bf2f(unsigned short b) { return __uint_as_float(((unsigned)b) << 16); }
typedef __bf16 bf16n2 __attribute__((ext_vector_type(2)));
DEV unsigned pk2(float lo, float hi) { f32x2 v = {lo, hi}; bf16n2 b = __builtin_convertvector(v, bf16n2); return __builtin_bit_cast(unsigned, b); }
DEV float bflo(unsigned u) { return __uint_as_float(u << 16); }
DEV float bfhi(unsigned u) { return __uint_as_float(u & 0xFFFF0000u); }
DEV float sigmoidf_(float x) { return 1.0f / (1.0f + __expf(-x)); }
DEV float siluf_(float x) { return x / (1.0f + __expf(-x)); }
DEV float softplusf_(float x) { return fmaxf(x, 0.f) + __logf(1.0f + __expf(-fabsf(x))); }
DEV float tanhf_(float x) { const float e = __expf(-2.0f * fabsf(x)); const float r = (1.0f - e) / (1.0f + e); return x < 0.f ? -r : r; }
DEV float wave_sum(float v) {
#pragma unroll
    for (int o = 32; o > 0; o >>= 1) v += __shfl_xor(v, o);
    return v;
}
DEV float sum16(float v) {
#pragma unroll
    for (int o = 8; o > 0; o >>= 1) v += __shfl_xor(v, o);
    return v;
}
template <int N> DEV float reduce_scatter(float (&v)[N], int lane) {
    int s = 1;
#pragma unroll
    for (int h = N / 2; h >= 1; h >>= 1) {
#pragma unroll
        for (int i = 0; i < h; ++i) {
            const bool up = (lane & s) != 0;
            const float send = up ? v[i] : v[i + h];
            const float keep = up ? v[i + h] : v[i];
            v[i] = keep + __shfl_xor(send, s);
        }
        s <<= 1;
    }
    float r = v[0];
    for (; s < 64; s <<= 1) r += __shfl_xor(r, s);
    return r;
}
template <int N> DEV int rs_index(int lane) {
    int o = 0, s = 1;
#pragma unroll
    for (int h = N / 2; h >= 1; h >>= 1) { if (lane & s) o += h; s <<= 1; }
    return o;
}

DEV bf16x8 frag_rm(const LAS bf16_t* base, int ld, int row0, int k0, int lane) {
    return *(const LAS bf16x8*)(base + (row0 + (lane & 15)) * ld + k0 + 8 * (lane >> 4));
}
DEV bf16x8 frag_tr(const LAS bf16_t* base, int ld, int k0, int c0, int lane) {
    const int g = lane >> 4, i = lane & 15, q = i >> 2, p = i & 3;
    const LAS bf16_t* a = base + (k0 + 8 * g + q) * ld + c0 + 4 * p;
    s16x4 lo = __builtin_amdgcn_ds_read_tr16_b64_v4i16((LAS s16x4*)a);
    s16x4 hi = __builtin_amdgcn_ds_read_tr16_b64_v4i16((LAS s16x4*)(a + 4 * ld));
    bf16x8 r; r[0] = lo[0]; r[1] = lo[1]; r[2] = lo[2]; r[3] = lo[3]; r[4] = hi[0]; r[5] = hi[1]; r[6] = hi[2]; r[7] = hi[3];
    return r;
}
#define MFMA16(a, b, c) __builtin_amdgcn_mfma_f32_16x16x32_bf16((a), (b), (c), 0, 0, 0)
DEV size_t fragmajor_off(int n, int k, int K) { return ((size_t)((n >> 4) * (K >> 5) + (k >> 5)) * 64 + (n & 15) + 16 * ((k & 31) >> 3)) * 8 + (k & 7); }

template <int N> DEV void skinny_group(const f32x4 (&z)[4], const LAS float* wt, int lane, LAS float* outw) {
    float pe[N];
#pragma unroll
    for (int o = 0; o < N; ++o) {
        float a = 0.f;
#pragma unroll
        for (int q = 0; q < 4; ++q) { const f32x4 w = *(const LAS f32x4*)(wt + o * 1028 + RCOL(q, lane)); a += z[q][0] * w[0] + z[q][1] * w[1] + z[q][2] * w[2] + z[q][3] * w[3]; }
        pe[o] = a;
    }
    const float r = reduce_scatter<N>(pe, lane);
    if (lane < N) outw[rs_index<N>(lane)] = r;
}
#ifndef SINGLE_LAUNCH
#define SINGLE_LAUNCH 1
#endif
constexpr size_t OFF_bar = 0ull;
constexpr size_t OFF_rw_rkv_t = 13824ull;
constexpr size_t OFF_rw_w1_t = 12596736ull;
constexpr size_t OFF_rw_a1_t = 13645312ull;
constexpr size_t OFF_rw_g1_t = 14693888ull;
constexpr size_t OFF_rw_w2_t = 15742464ull;
constexpr size_t OFF_rw_a2_t = 16791040ull;
constexpr size_t OFF_rw_g2_t = 17839616ull;
constexpr size_t OFF_rw_wo_t = 18888192ull;
constexpr size_t OFF_mb_win_t = 23082496ull;
constexpr size_t OFF_mb_wout_t = 33568256ull;
constexpr size_t OFF_gl_win_t = 37762560ull;
constexpr size_t OFF_gl_wout_t = 44054016ull;
constexpr size_t OFF_moe_w1_t = 46151168ull;
constexpr size_t OFF_moe_w2_t = 314586624ull;
constexpr size_t OFF_H = 448804352ull;
constexpr size_t OFF_H1 = 515913216ull;
constexpr size_t OFF_MIX = 583022080ull;
constexpr size_t OFF_BUF = 650130944ull;
constexpr size_t OFF_ACT = 734017024ull;
constexpr size_t OFF_YBUF = 775960064ull;
constexpr size_t OFF_CNT = 859846144ull;
constexpr size_t OFF_EIDX = 859878912ull;
constexpr size_t OFF_GATE = 860009984ull;
constexpr size_t OFF_DEST = 860141056ull;
constexpr size_t OFF_TAB = 860272128ull;
constexpr size_t OFF_YB = 860273152ull;
constexpr size_t OFF_X6 = 927382016ull;
constexpr size_t OFF_Rr = 1128708608ull;
constexpr size_t OFF_Kk = 1195817472ull;
constexpr size_t OFF_Vv = 1262926336ull;
constexpr size_t OFF_LW = 1330035200ull;
constexpr size_t OFF_Wd = 1355201024ull;
constexpr size_t OFF_Aa = 1422309888ull;
constexpr size_t OFF_Gg = 1489418752ull;
constexpr size_t OFF_RWf = 1556527616ull;
constexpr size_t OFF_RBf = 1590082048ull;
constexpr size_t OFF_RUt = 1623636480ull;
constexpr size_t OFF_RNa = 1657190912ull;
constexpr size_t OFF_RGc = 1690745344ull;
constexpr size_t OFF_RUa = 1691793920ull;
constexpr size_t OFF_RS0 = 1725348352ull;
constexpr size_t OFF_Z = 960936448ull;
constexpr size_t OFF_XBC = 1028045312ull;
constexpr size_t OFF_XC = 1128708608ull;
constexpr size_t OFF_DT = 1229371904ull;
constexpr size_t OFF_STATES = 1231469056ull;
constexpr size_t OFF_CD = 1365686784ull;
constexpr size_t OFF_PREV = 1365703168ull;
constexpr size_t OFF_LA = 1432812032ull;
constexpr size_t OFF_CDG = 1466366464ull;
constexpr size_t OFF_QKVG = OFF_XBC;
constexpr size_t WS_TOTAL = 1758902784ull;
typedef unsigned T_bar;
typedef bf16_t T_rw_rkv_t;
typedef bf16_t T_rw_w1_t;
typedef bf16_t T_rw_a1_t;
typedef bf16_t T_rw_g1_t;
typedef bf16_t T_rw_w2_t;
typedef bf16_t T_rw_a2_t;
typedef bf16_t T_rw_g2_t;
typedef bf16_t T_rw_wo_t;
typedef bf16_t T_mb_win_t;
typedef bf16_t T_mb_wout_t;
typedef bf16_t T_gl_win_t;
typedef bf16_t T_gl_wout_t;
typedef bf16_t T_moe_w1_t;
typedef bf16_t T_moe_w2_t;
typedef float T_H;
typedef float T_H1;
typedef float T_MIX;
typedef bf16_t T_BUF;
typedef bf16_t T_ACT;
typedef bf16_t T_YBUF;
typedef int T_CNT;
typedef int T_EIDX;
typedef float T_GATE;
typedef int T_DEST;
typedef int T_TAB;
typedef bf16_t T_YB;
typedef bf16_t T_X6;
typedef float T_Rr;
typedef float T_Kk;
typedef float T_Vv;
typedef bf16_t T_LW;
typedef float T_Wd;
typedef float T_Aa;
typedef float T_Gg;
typedef bf16_t T_RWf;
typedef bf16_t T_RBf;
typedef bf16_t T_RUt;
typedef bf16_t T_RNa;
typedef float T_RGc;
typedef bf16_t T_RUa;
typedef bf16_t T_RS0;
typedef bf16_t T_Z;
typedef bf16_t T_XBC;
typedef bf16_t T_XC;
typedef float T_DT;
typedef bf16_t T_STATES;
typedef float T_CD;
typedef bf16_t T_PREV;
typedef float T_LA;
typedef float T_CDG;
typedef bf16_t T_QKVG;
#define WS_(P, N) ((T_##N*)((P).ws + OFF_##N))
constexpr size_t OFF_Hb = OFF_H, OFF_H1b = OFF_H1, OFF_MIXb = OFF_MIX;
typedef bf16_t T_Hb; typedef bf16_t T_H1b; typedef bf16_t T_MIXb;
constexpr size_t OFF_moe_wr_t = OFF_H + 33554432ull;
typedef bf16_t T_moe_wr_t;
constexpr size_t OFF_mb_dt_t = OFF_moe_wr_t + 4ull * 48 * 1024 * 2, OFF_gl_lr_t = OFF_mb_dt_t + 32ull * 1024 * 2;
typedef bf16_t T_mb_dt_t; typedef bf16_t T_gl_lr_t;
constexpr size_t OFF_MFLAG = OFF_gl_lr_t + 16ull * 1024 * 2;
typedef unsigned T_MFLAG;
constexpr int MFLAG_STRIDE = 16, MFLAG_TICKET = 256, MFLAG_SIDE = 320;
constexpr size_t OFF_RBST = OFF_MFLAG + 65536;
typedef f32x4 T_RBST;
constexpr size_t OFF_Rb = OFF_Rr, OFF_Kb = OFF_Kk, OFF_Vb = OFF_Vv, OFF_Ab = OFF_Aa, OFF_Gb = OFF_Gg;
typedef bf16_t T_Rb; typedef bf16_t T_Kb; typedef bf16_t T_Vb; typedef bf16_t T_Ab; typedef bf16_t T_Gb;
constexpr size_t OFF_Wb = OFF_Wd; typedef bf16_t T_Wb;
struct ConvJob {
    const float* src; bf16_t* dst;
    int K, N, src_ld, Kpad, Npad, perm, batch;
    long long src_bs, dst_bs;
    DEV int ntiles() const { return (Kpad / 64) * (Npad / 64) * batch; }
};
#ifndef PERMF
#define PERMF 0xDF
#endif
#define PF(bit) (((PERMF) >> (bit)) & 1)
constexpr int NJOBS = 16;
constexpr int MOE_SPLIT = 32;

#define PARAM_LIST(X) \
    X(const float*, x) X(const float*, ln_g) X(const float*, ln_b) \
    X(const float*, rw_mu) X(const float*, rw_w_rkv) X(const float*, rw_w0) X(const float*, rw_w1) X(const float*, rw_w2) X(const float*, rw_a0) X(const float*, rw_a1) X(const float*, rw_a2) \
    X(const float*, rw_g1) X(const float*, rw_g2) X(const float*, rw_k_k) X(const float*, rw_k_a) X(const float*, rw_r_k) X(const float*, rw_lnx_g) X(const float*, rw_lnx_b) X(const float*, rw_w_o) \
    X(const float*, mb_w_in) X(const float*, mb_conv_w) X(const float*, mb_conv_b) X(const float*, mb_dt_bias) X(const float*, mb_a_log) X(const float*, mb_d) X(const float*, mb_norm_g) X(const float*, mb_w_out) \
    X(const float*, gl_w_in) X(const float*, gl_gk_w2) X(const float*, gl_gk_b) X(const float*, gl_norm_g) X(const float*, gl_w_out) \
    X(const float*, moe_w_group) X(const float*, moe_b_group) X(const float*, moe_w_route) X(const float*, moe_b_route) X(const float*, moe_w_in) X(const float*, moe_w_down) \
    X(float*, out) X(char*, ws)
struct Params {
#define X(t, n) t n;
    PARAM_LIST(X)
#undef X
};

enum Op : unsigned char { OP_CONVERT = 0, OP_PRE0, OP_RW_GEMM1, OP_RW_GEMM2, OP_RW_CHA, OP_RW_CHB, OP_RW_CHC, OP_RW_CHD, OP_RW_OUT,
    OP_LN1, OP_MOE_SCATTER, OP_MOE_GEMM1, OP_MOE_GEMM2, OP_LN2,
    OP_MB_GEMM_IN, OP_MB_CONV, OP_MB_STATES, OP_MB_SCAN, OP_MB_OUT, OP_MB_GEMM_OUT,
    OP_GL_GEMM_IN, OP_GL_KV, OP_GL_SCAN, OP_GL_OUT, OP_GL_GEMM_OUT };


DEV ConvJob make_job(const Params& p, int q) {
    const long long DD = (long long)D * D;
    switch (q) {
    case 0: return ConvJob{p.rw_w_rkv, WS_(p, rw_rkv_t), 1024, 1024, 1024, 1024, 1024, 0 | 2 * PF(0), 6, DD, DD};
    case 1: return ConvJob{p.rw_w1, WS_(p, rw_w1_t), 1024, 64, 64, 1024, 256, 0 | 2 * PF(1), 2, (long long)D * 64, (long long)256 * D};
    case 2: return ConvJob{p.rw_a1, WS_(p, rw_a1_t), 1024, 64, 64, 1024, 256, 0 | 2 * PF(1), 2, (long long)D * 64, (long long)256 * D};
    case 3: return ConvJob{p.rw_g1, WS_(p, rw_g1_t), 1024, 160, 160, 1024, 256, 0 | 2 * PF(1), 2, (long long)D * 160, (long long)256 * D};
    case 4: return ConvJob{p.rw_w2, WS_(p, rw_w2_t), 64, 1024, 1024, 256, 1024, 0 | 2 * PF(2), 2, (long long)64 * D, (long long)D * 256};
    case 5: return ConvJob{p.rw_a2, WS_(p, rw_a2_t), 64, 1024, 1024, 256, 1024, 0 | 2 * PF(2), 2, (long long)64 * D, (long long)D * 256};
    case 6: return ConvJob{p.rw_g2, WS_(p, rw_g2_t), 160, 1024, 1024, 256, 1024, 0 | 2 * PF(2), 2, (long long)160 * D, (long long)D * 256};
    case 7: return ConvJob{p.rw_w_o, WS_(p, rw_wo_t), 1024, 1024, 1024, 1024, 1024, 0 | 2 * PF(3), 2, DD, DD};
    case 8: return ConvJob{p.mb_w_in, WS_(p, mb_win_t), 1024, 5120, 5152, 1024, 5120, 0 | 2 * PF(4), 1, 0, 0};
    case 9: return ConvJob{p.mb_w_out, WS_(p, mb_wout_t), 2048, 1024, 1024, 2048, 1024, 0 | 2 * PF(3), 1, 0, 0};
    case 10: return ConvJob{p.gl_w_in, WS_(p, gl_win_t), 1024, 3072, 3088, 1024, 3072, 0 | 2 * PF(5), 1, 0, 0};
    case 11: return ConvJob{p.gl_w_out, WS_(p, gl_wout_t), 1024, 1024, 1024, 1024, 1024, 0 | 2 * PF(3), 1, 0, 0};
    case 12: return ConvJob{p.moe_w_in, WS_(p, moe_w1_t), 1024, 1024, 1024, 1024, 1024, 1 | 2 * PF(6), MOE_SPLIT, DD, DD};
    case 13: return ConvJob{p.moe_w_down, WS_(p, moe_w2_t), 512, 1024, 1024, 512, 1024, 0 | 2 * PF(7), MOE_SPLIT, (long long)512 * 1024, (long long)1024 * 512};
    case 14: return ConvJob{p.moe_w_in + (size_t)MOE_SPLIT * DD, WS_(p, moe_w1_t) + (size_t)MOE_SPLIT * DD, 1024, 1024, 1024, 1024, 1024, 1 | 2 * PF(6), 128 - MOE_SPLIT, DD, DD};
    default: return ConvJob{p.moe_w_down + (size_t)MOE_SPLIT * 512 * 1024, WS_(p, moe_w2_t) + (size_t)MOE_SPLIT * 512 * 1024, 512, 1024, 1024, 512, 1024, 0 | 2 * PF(7), 128 - MOE_SPLIT, (long long)512 * 1024, (long long)1024 * 512};
    }
}

DEV void convert_tile(const ConvJob& J, LAS bf16_t* tile, int local, int lane) {
    const int tk = J.Kpad / 64, tn = J.Npad / 64;
    const int b = local / (tk * tn); local -= b * tk * tn;
    const int nt = local / tk, kt = local - nt * tk;
    const float* src = J.src + (size_t)b * J.src_bs;
    bf16_t* dst = J.dst + (size_t)b * J.dst_bs;
    const int k0 = kt * 64, n0 = nt * 64;
    const int nn = (lane & 15) * 4; const bool nok = n0 + nn < J.N;
    f32x4 v[16];
#pragma unroll
    for (int i = 0; i < 16; ++i) { const int kk = (lane >> 4) + 4 * i; v[i] = (nok && k0 + kk < J.K) ? *(const f32x4*)(src + (size_t)(k0 + kk) * J.src_ld + n0 + nn) : (f32x4){0.f, 0.f, 0.f, 0.f}; }
#pragma unroll
    for (int i = 0; i < 16; ++i) { const int kk = (lane >> 4) + 4 * i;
#pragma unroll
        for (int e = 0; e < 4; ++e) tile[(nn + e) * 72 + kk] = (bf16_t)f2bf(v[i][e]); }
#pragma unroll
    for (int i = 0; i < 8; ++i) { const int r = (lane >> 3) + 8 * i, kc = (lane & 7) * 8;
        int nsrc = n0 + r, ndst = nsrc;
        if (J.perm & 1) { const int up = nsrc >= 512, jj = nsrc - (up ? 512 : 0); ndst = (jj >> 7) * 256 + (up ? 128 : 0) + (jj & 127); }
        if (J.perm & 2) { const int cc = ndst & 31; ndst = (ndst & ~31) | (((cc >> 2) & 1) << 4) | ((cc >> 3) << 2) | (cc & 3); }
        *(u32x4*)(dst + (size_t)ndst * J.Kpad + k0 + kc) = *(const LAS u32x4*)(tile + r * 72 + kc); }
}
DEV void convert_one(const ConvJob& J, LAS unsigned char* lds, int B0, int NBW, int tbeg, int WL = 8) {
    const int tid = tid_(), bid = bid_();
    const int lane = tid & 63, wv = tid >> 6; const int gw = (bid - B0) * WL + wv, NW = NBW * WL;
    if (wv >= WL) return;
    LAS bf16_t* tile = (LAS bf16_t*)lds + wv * (64 * 72);
    const int jend = tbeg + J.ntiles();
    const int ti0 = tbeg + ((gw - tbeg) % NW + NW) % NW;
#pragma unroll 1
    for (int ti = ti0; ti < jend; ti += NW) convert_tile(J, tile, ti - tbeg, lane);
}
DEV void convert_tickets(const ConvJob& J0, const ConvJob& J1, LAS unsigned char* lds, unsigned* ctrs, int stride, int t0 = 0, int t1 = 1 << 30) {
    constexpr int NG = 32;
    const int tid = tid_(); const int lane = tid & 63, wv = tid >> 6; const int g = bid_() & (NG - 1);
    unsigned* ctr = ctrs + g * stride;
    LAS bf16_t* tile = (LAS bf16_t*)lds + wv * (64 * 72);
    const int n0 = J0.ntiles(); const int n = t1 < n0 + J1.ntiles() ? t1 : n0 + J1.ntiles();
    int cur = 0; if (lane == 0) cur = (int)__hip_atomic_fetch_add(ctr, 1u, __ATOMIC_RELAXED, __HIP_MEMORY_SCOPE_AGENT);
    cur = t0 + __builtin_amdgcn_readfirstlane(cur) * NG + g;
#pragma unroll 1
    while (cur < n) {
        int nx = 0; if (lane == 0) nx = (int)__hip_atomic_fetch_add(ctr, 1u, __ATOMIC_RELAXED, __HIP_MEMORY_SCOPE_AGENT);
        const bool first = cur < n0; const ConvJob J = first ? J0 : J1;
        convert_tile(J, tile, first ? cur : cur - n0, lane);
        cur = t0 + __builtin_amdgcn_readfirstlane(nx) * NG + g;
    }
}
template <int J0, int J1> DEV int convert_jobs(const Params& p, LAS unsigned char* lds, int B0, int NBW, int tbeg = 0, int WL = 8) {
#pragma unroll
    for (int j = J0; j < J1; ++j) { const ConvJob J = make_job(p, j); convert_one(J, lds, B0, NBW, tbeg, WL); tbeg += J.ntiles(); }
    return tbeg;
}
DEV ConvJob moe_job(const Params& p, int which, int ml) {
    const long long DD = (long long)D * D; const size_t b0 = (size_t)ml * 32;
    if (which == 0) return ConvJob{p.moe_w_in + b0 * DD, WS_(p, moe_w1_t) + b0 * DD, 1024, 1024, 1024, 1024, 1024, 1 | 2 * PF(6), 32, DD, DD};
    return ConvJob{p.moe_w_down + b0 * 512 * 1024, WS_(p, moe_w2_t) + b0 * 512 * 1024, 512, 1024, 1024, 512, 1024, 0 | 2 * PF(7), 32, (long long)512 * 1024, (long long)1024 * 512};
}
DEV void phase_convert(const Params& p, LAS unsigned char* lds) {
    const int tid = tid_(), bid = bid_();
    if (bid == 1 && tid < 7 * 32) __hip_atomic_store(WS_(p, MFLAG) + (MFLAG_SIDE + tid) * MFLAG_STRIDE, 0u, __ATOMIC_RELAXED, __HIP_MEMORY_SCOPE_AGENT);
    convert_jobs<0, 8>(p, lds, 0, NB_);
    if (bid < 4 * 48) { const int layer = bid / 48, o = bid % 48;
        for (int k = tid; k < D; k += NTHR) { float v = 0.f;
            if (o < 32) v = p.moe_w_route[((size_t)layer * D + k) * 32 + o]; else if (o < 36) v = p.moe_w_group[((size_t)layer * D + k) * 4 + (o - 32)];
            WS_(p, moe_wr_t)[((size_t)layer * 48 + o) * D + k] = (bf16_t)f2bf(v); } }
    else if (bid < 4 * 48 + 32) { const int o = bid - 192;
        for (int k = tid; k < D; k += NTHR) WS_(p, mb_dt_t)[(size_t)o * D + k] = (bf16_t)f2bf(p.mb_w_in[(size_t)k * 5152 + 5120 + o]); }
    else if (bid < 4 * 48 + 48) { const int o = bid - 224;
        for (int k = tid; k < D; k += NTHR) WS_(p, gl_lr_t)[(size_t)o * D + k] = (bf16_t)f2bf(p.gl_w_in[(size_t)k * 3088 + 3072 + o]); }
}
namespace pg8 {
constexpr int BM = 256, BK = 64, HALF = 128, HTB = HALF * BK * 2, STAGE_BYTES = 8 * HTB;
DEV int lds_byte(int r, int c) { const int st = (r >> 4) * 2 + (c >> 5), rr = r & 15, cc = c & 31, ob = rr * 64 + cc * 2; return st * 1024 + (ob ^ (((ob >> 9) & 1) << 5)); }
DEV void stage_rc(int b, int& R, int& C) { const int st = b / 1024, sb = b % 1024, swz = sb ^ (((sb >> 9) & 1) << 5); R = (st >> 1) * 16 + swz / 64; C = (st & 1) * 32 + (swz % 64) / 2; }

struct Unit { const char* A; const char* B; int row0, col0, id, aux; };

DEV bool tile_order(int i, int G, int c, int nM, int nN, int& pm, int& pn) {
    const int nwg = nM * nN; const long L = (long)i * G + c; if (L >= nwg) return false;
    int wgid = (int)L; { const int q = nwg / 8, r = nwg % 8, xcd = wgid % 8, off = wgid / 8; wgid = (xcd < r ? xcd * (q + 1) : r * (q + 1) + (xcd - r) * q) + off; }
    const int nig = 8 * nN, gid = wgid / nig, fm = gid * 8, gsz = (nM - fm) < 8 ? (nM - fm) : 8;
    pm = fm + ((wgid % nig) % gsz); pn = (wgid % nig) / gsz; return true;
}

template <class Epi, class Sched>
DEV void gemm_phase(LAS unsigned char* lds, const int K, const Sched& S, const Epi& E) {
    const int tid = tid_(), wid = __builtin_amdgcn_readfirstlane(tid >> 6), lane = tid & 63, wr = wid >> 2, wc = wid & 3, fr = lane & 15, fq = lane >> 4;
    const int nt = K / BK;
    unsigned voff[2];
#pragma unroll
    for (int i = 0; i < 2; ++i) { int R, C; stage_rc(tid * 16 + i * 8192, R, C); voff[i] = (unsigned)(R * K + C) * 2u; }
    const size_t kstep = (size_t)(BK * 2);
    const size_t hstep = (size_t)HALF * K * 2;
    const unsigned ldsw = (unsigned)wid * 1024u;
    const int aoff = lds_byte(wr * 64 + fr, fq * 8), boff = lds_byte(wc * 32 + fr, fq * 8);
#define PG8_SA(b, h) (((b) * 2 + (h)) * HTB)
#define PG8_SB(b, h) ((4 + (b) * 2 + (h)) * HTB)
#define PG8_STAGE(bufoff, gbase) do { _Pragma("unroll") for (int _i = 0; _i < 2; ++_i) \
        __builtin_amdgcn_global_load_lds((const unsigned*)((const char*)(gbase) + voff[_i]), (LAS unsigned*)(lds + (bufoff) + ldsw + _i * 8192), 16, 0, 0); } while (0)
#define PG8_LDA(dst, b, h) do { _Pragma("unroll") for (int m = 0; m < 4; ++m) _Pragma("unroll") for (int k = 0; k < 2; ++k) dst[m][k] = *(const LAS bf16x8*)(lds + PG8_SA(b, h) + aoff + m * 2048 + k * 1024); } while (0)
#define PG8_LDB(dst, b, h) do { _Pragma("unroll") for (int n = 0; n < 2; ++n) _Pragma("unroll") for (int k = 0; k < 2; ++k) dst[n][k] = *(const LAS bf16x8*)(lds + PG8_SB(b, h) + boff + n * 2048 + k * 1024); } while (0)
#define PG8_MMA(ai, bj, At, Bt) do { __builtin_amdgcn_s_setprio(1); _Pragma("unroll") for (int m = 0; m < 4; ++m) _Pragma("unroll") for (int n = 0; n < 2; ++n) _Pragma("unroll") for (int k = 0; k < 2; ++k) \
        acc[ai][bj][m][n] = __builtin_amdgcn_mfma_f32_16x16x32_bf16(Bt[n][k], At[m][k], acc[ai][bj][m][n], 0, 0, 0); __builtin_amdgcn_s_setprio(0); } while (0)
#define PG8_WAIT_V(n) asm volatile("s_waitcnt vmcnt(" #n ")" ::: "memory")
#define PG8_WAIT_L(n) asm volatile("s_waitcnt lgkmcnt(" #n ")" ::: "memory")
#define PG8_BAR __builtin_amdgcn_s_barrier()
#define PG8_SCHED __builtin_amdgcn_sched_barrier(0)
    Unit cur, nxt; int ui = 0;
    if (!S.next(0, cur)) return;
    f32x4 acc[2][2][4][2];
#pragma unroll
    for (int a = 0; a < 2; ++a)
#pragma unroll
        for (int b = 0; b < 2; ++b)
#pragma unroll
            for (int m = 0; m < 4; ++m)
#pragma unroll
                for (int n = 0; n < 2; ++n) acc[a][b][m][n] = (f32x4){0.f, 0.f, 0.f, 0.f};
    bf16x8 At[4][2], B0[2][2], B1[2][2];
    const char* cA = cur.A; const char* cB = cur.B;
    PG8_STAGE(PG8_SB(0, 0), cB); PG8_STAGE(PG8_SA(0, 0), cA); PG8_STAGE(PG8_SB(0, 1), cB + hstep); PG8_STAGE(PG8_SA(0, 1), cA + hstep);
    if (wr == 1) PG8_BAR;
    PG8_WAIT_V(4); PG8_BAR;
    PG8_STAGE(PG8_SB(1, 0), cB + kstep); PG8_STAGE(PG8_SA(1, 0), cA + kstep); PG8_STAGE(PG8_SB(1, 1), cB + hstep + kstep);
    PG8_WAIT_V(6); PG8_BAR;
    for (;;) {
        const bool has_next = S.next(ui + 1, nxt);
        const char* nA = has_next ? nxt.A : cA; const char* nB = has_next ? nxt.B : cB;
#pragma unroll 1
        for (int t = 0; t < nt; t += 2) {
            const bool last = (t == nt - 2);
            const char* a1 = cA + (size_t)(t + 1) * kstep;
            const char* a2 = last ? nA : cA + (size_t)(t + 2) * kstep; const char* b2 = last ? nB : cB + (size_t)(t + 2) * kstep;
            const char* a3 = a2 + kstep; const char* b3 = b2 + kstep;
            PG8_LDB(B0, 0, 0); PG8_SCHED; PG8_LDA(At, 0, 0); PG8_STAGE(PG8_SA(1, 1), a1 + hstep);
            PG8_WAIT_L(8); PG8_BAR; PG8_WAIT_L(0); PG8_MMA(0, 0, At, B0); PG8_BAR; PG8_SCHED;
            PG8_LDB(B1, 0, 1); PG8_STAGE(PG8_SB(0, 0), b2);
            PG8_BAR; PG8_WAIT_L(0); PG8_MMA(0, 1, At, B1); PG8_BAR;
            PG8_LDA(At, 0, 1); PG8_STAGE(PG8_SA(0, 0), a2);
            PG8_BAR; PG8_WAIT_L(0); PG8_MMA(1, 0, At, B0); PG8_BAR; PG8_SCHED;
            PG8_STAGE(PG8_SB(0, 1), b2 + hstep);
            PG8_WAIT_V(6); PG8_BAR; PG8_MMA(1, 1, At, B1); PG8_BAR;
            PG8_LDB(B0, 1, 0); PG8_SCHED; PG8_LDA(At, 1, 0); PG8_STAGE(PG8_SA(0, 1), a2 + hstep);
            PG8_WAIT_L(8); PG8_BAR; PG8_WAIT_L(0); PG8_MMA(0, 0, At, B0); PG8_BAR; PG8_SCHED;
            PG8_LDB(B1, 1, 1); PG8_STAGE(PG8_SB(1, 0), b3);
            PG8_BAR; PG8_WAIT_L(0); PG8_MMA(0, 1, At, B1); PG8_BAR;
            PG8_LDA(At, 1, 1); PG8_STAGE(PG8_SA(1, 0), a3);
            PG8_BAR; PG8_WAIT_L(0); PG8_MMA(1, 0, At, B0); PG8_BAR; PG8_SCHED;
            PG8_STAGE(PG8_SB(1, 1), b3 + hstep);
            PG8_WAIT_V(6); PG8_BAR; PG8_MMA(1, 1, At, B1); PG8_BAR;
        }
        E(acc, cur, wr, wc, fr, fq);
        if (!has_next) break;
#pragma unroll
        for (int a = 0; a < 2; ++a)
#pragma unroll
            for (int b = 0; b < 2; ++b)
#pragma unroll
                for (int m = 0; m < 4; ++m)
#pragma unroll
                    for (int n = 0; n < 2; ++n) acc[a][b][m][n] = (f32x4){0.f, 0.f, 0.f, 0.f};
        cur = nxt; cA = nA; cB = nB; ++ui;
    }
    PG8_WAIT_V(0);
    if (wr == 0) PG8_BAR;
    PG8_BAR;
#undef PG8_SA
#undef PG8_SB
#undef PG8_STAGE
#undef PG8_LDA
#undef PG8_LDB
#undef PG8_MMA
#undef PG8_WAIT_V
#undef PG8_WAIT_L
#undef PG8_BAR
#undef PG8_SCHED
}
}
using pg8::Unit;
typedef f32x4 AccT[2][2][4][2];
#define FOR_ACC(ai, bj, m, n) _Pragma("unroll") for (int ai = 0; ai < 2; ++ai) _Pragma("unroll") for (int m = 0; m < 4; ++m) _Pragma("unroll") for (int bj = 0; bj < 2; ++bj) _Pragma("unroll") for (int n = 0; n < 2; ++n)
#define ACC_FENCE __builtin_amdgcn_sched_barrier(0)
#define ACC_ROW(u, ai, m) ((u).row0 + 128 * (ai) + 64 * wr + 16 * (m) + fr)
#define ACC_COLP(u, bj, n, P) ((P) ? ((u).col0 + 128 * (bj) + 32 * wc + 8 * fq + 4 * (n)) : ((u).col0 + 128 * (bj) + 32 * wc + 16 * (n) + 4 * fq))
#define ACC_COL8P(u, bj, P) ACC_COLP(u, bj, 0, P)
#define FOR_ACC2(ai, bj, m) _Pragma("unroll") for (int ai = 0; ai < 2; ++ai) _Pragma("unroll") for (int m = 0; m < 4; ++m) _Pragma("unroll") for (int bj = 0; bj < 2; ++bj)
DEV void st_bf4(bf16_t* p, f32x4 v) { u32x2 w; w.x = pk2(v[0], v[1]); w.y = pk2(v[2], v[3]); *(u32x2*)p = w; }
DEV u32x4 pk8v(f32x4 a, f32x4 b) { u32x4 w; w.x = pk2(a[0], a[1]); w.y = pk2(a[2], a[3]); w.z = pk2(b[0], b[1]); w.w = pk2(b[2], b[3]); return w; }
#ifdef ST8
DEV void st_bf8p(bf16_t* p, f32x4 a, f32x4 b, bool P) { if (P) { st_bf4(p, a); st_bf4(p + 4, b); } else { st_bf4(p, a); st_bf4(p + 16, b); } }
#else
DEV void st_bf8p(bf16_t* p, f32x4 a, f32x4 b, bool P) { if (P) *(u32x4*)p = pk8v(a, b); else { st_bf4(p, a); st_bf4(p + 16, b); } }
#endif
DEV void load_row(const float* p, int lane, f32x4 (&v)[4]) {
#pragma unroll
    for (int q = 0; q < 4; ++q) v[q] = *(const f32x4*)(p + RCOL(q, lane));
}

DEV void load_row_bf(const bf16_t* p, int lane, f32x4 (&v)[4]) {
#pragma unroll
    for (int q = 0; q < 4; ++q) { const u32x2 a = *(const u32x2*)(p + RCOL(q, lane)); v[q] = (f32x4){bflo(a.x), bfhi(a.x), bflo(a.y), bfhi(a.y)}; }
}
DEV void store_row_bf(bf16_t* p, int lane, const f32x4 (&v)[4]) {
#pragma unroll
    for (int q = 0; q < 4; ++q) st_bf4(p + RCOL(q, lane), v[q]);
}
DEV void emit_mix6(const Params& p, int j, int t, int lane, const f32x4 (&x)[4], const f32x4 (&xp)[4]) {
    const float* mu = p.rw_mu + (size_t)j * 6 * D;
#pragma unroll
    for (int s = 0; s < 6; ++s) {
#pragma unroll
        for (int q = 0; q < 4; ++q) {
            const f32x4 m = *(const f32x4*)(mu + s * D + RCOL(q, lane));
            st_bf4(WS_(p, X6) + (size_t)s * T * D + (size_t)t * D + RCOL(q, lane), x[q] + (xp[q] - x[q]) * m);
        }
        __builtin_amdgcn_sched_barrier(0);
    }
}
DEV void phase_pre0(const Params& p) {
    const int tid = tid_(), bid = bid_(); const int lane = tid & 63, wid = tid >> 6;
    f32x4 x[4], xp[4];
    const int tfirst = bid * 64 + wid * 8;
    if (tfirst > 0) load_row(p.x + (size_t)(tfirst - 1) * D, lane, xp); else { for (int q = 0; q < 4; ++q) xp[q] = (f32x4){0.f, 0.f, 0.f, 0.f}; }
    f32x4 xn[4]; load_row(p.x + (size_t)tfirst * D, lane, xn);
#pragma unroll 1
    for (int r = 0; r < 8; ++r) {
        const int t = tfirst + r;
#pragma unroll
        for (int q = 0; q < 4; ++q) x[q] = xn[q];
        load_row(p.x + (size_t)(r < 7 ? t + 1 : t) * D, lane, xn);
        store_row_bf(WS_(p, Hb) + (size_t)t * D, lane, x);
        emit_mix6(p, 0, t, lane, x, xp);
#pragma unroll
        for (int q = 0; q < 4; ++q) xp[q] = x[q];
    }
}

struct SchedRW1 {
    const Params* p; int j;
    DEV bool next(int i, Unit& u) const {
        int pm, pn; if (!pg8::tile_order(i, NB_, bid_(), 64, 15, pm, pn)) return false;
        int id, lpn; if (pn < 12) { id = pn >> 2; lpn = pn & 3; } else { id = 3 + (pn - 12); lpn = 0; }
        u.A = (const char*)(WS_(*p, X6) + (size_t)id * T * D + (size_t)pm * 256 * D);
        const bf16_t* B;
        if (id < 3) B = WS_(*p, rw_rkv_t) + ((size_t)j * 3 + id) * D * D + (size_t)lpn * 256 * D;
        else B = WS_(*p, rw_w1_t) + (size_t)(id - 3) * (2 * 256 * D) + (size_t)j * 256 * D;
        u.B = (const char*)B; u.row0 = pm * 256; u.col0 = lpn * 256; u.id = id; u.aux = 0; return true;
    }
};
struct EpiRW1 {
    const Params* p;
    DEV void operator()(const AccT& acc, const Unit& u, int wr, int wc, int fr, int fq) const {
        if (u.id < 3) {
            bf16_t* O = WS_(*p, Rb) + (size_t)u.id * 2 * T * D;
            FOR_ACC2(ai, bj, m) { st_bf8p(O + (size_t)ACC_ROW(u, ai, m) * D + ACC_COL8P(u, bj, PF(0)), acc[ai][bj][m][0], acc[ai][bj][m][1], PF(0)); ACC_FENCE; }
        } else {
            bf16_t* O = WS_(*p, LW) + (size_t)(u.id - 3) * T * 256;
            FOR_ACC2(ai, bj, m) {
                f32x4 v0 = acc[ai][bj][m][0], v1 = acc[ai][bj][m][1];
                if (u.id == 3) { for (int e = 0; e < 4; ++e) { v0[e] = tanhf_(v0[e]); v1[e] = tanhf_(v1[e]); } }
                else if (u.id == 5) { for (int e = 0; e < 4; ++e) { v0[e] = sigmoidf_(v0[e]); v1[e] = sigmoidf_(v1[e]); } }
                st_bf8p(O + (size_t)ACC_ROW(u, ai, m) * 256 + ACC_COL8P(u, bj, PF(1)), v0, v1, PF(1)); ACC_FENCE;
            }
        }
    }
};
struct SchedRW2 {
    const Params* p; int j;
    DEV bool next(int i, Unit& u) const {
        int pm, pn; if (!pg8::tile_order(i, NB_, bid_(), 64, 12, pm, pn)) return false;
        const int id = pn >> 2, lpn = pn & 3;
        u.A = (const char*)(WS_(*p, LW) + (size_t)id * T * 256 + (size_t)pm * 256 * 256);
        const bf16_t* B = WS_(*p, rw_w2_t) + (size_t)id * (2 * D * 256) + (size_t)j * D * 256 + (size_t)lpn * 256 * 256;
        u.B = (const char*)B; u.row0 = pm * 256; u.col0 = lpn * 256; u.id = id; u.aux = 0; return true;
    }
};
struct EpiRW2 {
    const Params* p; int j;
    DEV void operator()(const AccT& acc, const Unit& u, int wr, int wc, int fr, int fq) const {
        if (u.id == 0) { const float* bias = p->rw_w0 + (size_t)j * D; f32x4 bv[2][2];
#pragma unroll
            for (int bj = 0; bj < 2; ++bj)
#pragma unroll
                for (int n = 0; n < 2; ++n) bv[bj][n] = *(const f32x4*)(bias + ACC_COLP(u, bj, n, PF(2)));
            FOR_ACC2(ai, bj, m) { f32x4 vv[2];
#pragma unroll
                for (int n = 0; n < 2; ++n) { f32x4 v = acc[ai][bj][m][n]; const f32x4 b = bv[bj][n];
                    for (int e = 0; e < 4; ++e) { const float x = -(b[e] + v[e]); const float wl = -(fmaxf(x, 0.f) + __logf(1.0f + __expf(-fabsf(x)))) - 0.5f; v[e] = -__expf(wl); }
                    vv[n] = v; }
                st_bf8p(WS_(*p, Wb) + (size_t)ACC_ROW(u, ai, m) * D + ACC_COL8P(u, bj, PF(2)), vv[0], vv[1], PF(2)); ACC_FENCE; } }
        else if (u.id == 1) { const float* bias = p->rw_a0 + (size_t)j * D; f32x4 bv[2][2];
#pragma unroll
            for (int bj = 0; bj < 2; ++bj)
#pragma unroll
                for (int n = 0; n < 2; ++n) bv[bj][n] = *(const f32x4*)(bias + ACC_COLP(u, bj, n, PF(2)));
            FOR_ACC2(ai, bj, m) { f32x4 vv[2];
#pragma unroll
                for (int n = 0; n < 2; ++n) { f32x4 v = acc[ai][bj][m][n]; const f32x4 b = bv[bj][n];
                    for (int e = 0; e < 4; ++e) v[e] = sigmoidf_(b[e] + v[e]);
                    vv[n] = v; }
                st_bf8p(WS_(*p, Ab) + (size_t)ACC_ROW(u, ai, m) * D + ACC_COL8P(u, bj, PF(2)), vv[0], vv[1], PF(2)); ACC_FENCE; } }
        else { FOR_ACC2(ai, bj, m) { st_bf8p(WS_(*p, Gb) + (size_t)ACC_ROW(u, ai, m) * D + ACC_COL8P(u, bj, PF(2)), acc[ai][bj][m][0], acc[ai][bj][m][1], PF(2)); ACC_FENCE; } }
    }
};

struct SchedOut {
    const bf16_t* A; const bf16_t* Bt; int K;
    DEV bool next(int i, Unit& u) const {
        int pm, pn; if (!pg8::tile_order(i, NB_, bid_(), 64, 4, pm, pn)) return false;
        u.A = (const char*)(A + (size_t)pm * 256 * K); u.B = (const char*)(Bt + (size_t)pn * 256 * K); u.row0 = pm * 256; u.col0 = pn * 256; u.id = 0; u.aux = 0; return true;
    }
};
struct EpiOut {
    bf16_t* O;
    DEV void operator()(const AccT& acc, const Unit& u, int wr, int wc, int fr, int fq) const {
        FOR_ACC2(ai, bj, m) { st_bf8p(O + (size_t)ACC_ROW(u, ai, m) * D + ACC_COL8P(u, bj, PF(3)), acc[ai][bj][m][0], acc[ai][bj][m][1], PF(3)); ACC_FENCE; }
    }
};
constexpr int RC_LD = 72;
#ifdef DBG
#define DBGF(cond, bit) do { if (cond) atomicOr(&WS_(p, TAB)[200], (bit)); } while (0)
#else
#define DBGF(cond, bit) do {} while (0)
#endif
DEV bool bad_(float x) { return !(fabsf(x) < 1e30f); }
DEV int rc_pi(int g, int j) { return j < 4 ? 4 * g + j : 16 + 4 * g + (j - 4); }

DEV void rc_load_wd(const Params& p, int t0, int cb, float (&wd)[8]) {
    const int tid = tid_(); const int k = tid & 63, sg = tid >> 6;
#pragma unroll
    for (int i = 0; i < 8; ++i) wd[i] = bf2f(WS_(p, Wb)[(size_t)(t0 + sg * 8 + i) * D + cb + k]);
}
DEV void rc_cum_regs(const float (&wd)[8], LAS float* cum, LAS float* seg) {
    const int tid = tid_(); const int k = tid & 63, sg = tid >> 6;
    float v[8]; float s = 0.f;
#pragma unroll
    for (int i = 0; i < 8; ++i) { s += wd[i]; v[i] = s; }
    seg[sg * 64 + k] = s;
    lds_barrier();
    float off = 0.f;
#pragma unroll
    for (int q = 0; q < 8; ++q) off += (q < sg) ? seg[q * 64 + k] : 0.f;
#pragma unroll
    for (int i = 0; i < 8; ++i) cum[(sg * 8 + i) * 64 + k] = v[i] + off;
    lds_barrier();
}
DEV void ld8b(const bf16_t* p, float (&f)[8]) { const u32x4 v = *(const u32x4*)p; f[0] = bflo(v.x); f[1] = bfhi(v.x); f[2] = bflo(v.y); f[3] = bfhi(v.y); f[4] = bflo(v.z); f[5] = bfhi(v.z); f[6] = bflo(v.w); f[7] = bfhi(v.w); }
DEV void ld8(const float* p, float (&f)[8]) { const f32x4 a = *(const f32x4*)p, b = *(const f32x4*)(p + 4); f[0] = a[0]; f[1] = a[1]; f[2] = a[2]; f[3] = a[3]; f[4] = b[0]; f[5] = b[1]; f[6] = b[2]; f[7] = b[3]; }
DEV void lds8(const LAS float* p, float (&f)[8]) { const f32x4 a = *(const LAS f32x4*)p, b = *(const LAS f32x4*)(p + 4); f[0] = a[0]; f[1] = a[1]; f[2] = a[2]; f[3] = a[3]; f[4] = b[0]; f[5] = b[1]; f[6] = b[2]; f[7] = b[3]; }
DEV u32x4 pk8(const float (&f)[8]) { u32x4 o; o.x = pk2(f[0], f[1]); o.y = pk2(f[2], f[3]); o.z = pk2(f[4], f[5]); o.w = pk2(f[6], f[7]); return o; }

DEV bf16x8 frag_rm_pi(const LAS bf16_t* base, int ld, int row0, int k0, int lane) {
    const LAS bf16_t* a = base + (row0 + (lane & 15)) * ld + k0 + 4 * (lane >> 4);
    const s16x4 lo = *(const LAS s16x4*)a, hi = *(const LAS s16x4*)(a + 16);
    bf16x8 r; r[0] = lo[0]; r[1] = lo[1]; r[2] = lo[2]; r[3] = lo[3]; r[4] = hi[0]; r[5] = hi[1]; r[6] = hi[2]; r[7] = hi[3]; return r;
}
DEV void rc_prep8(const float (&k)[8], const float (&al)[8], const float (&kkw)[8], const float (&kaw)[8], float (&a)[8], float (&b)[8], float (&kh)[8]) {
    float kk[8]; float ss = 0.f;
#pragma unroll
    for (int e = 0; e < 8; ++e) { kk[e] = k[e] * kkw[e]; ss += kk[e] * kk[e]; }
    ss += __shfl_xor(ss, 1); ss += __shfl_xor(ss, 2); ss += __shfl_xor(ss, 4);
    const float inv = 1.0f / fmaxf(sqrtf(ss), 1e-12f);
#pragma unroll
    for (int e = 0; e < 8; ++e) { const float kn = kk[e] * inv; a[e] = -kn; b[e] = kn * al[e]; kh[e] = k[e] * (1.0f + (al[e] - 1.0f) * kaw[e]); }
}
constexpr int RW_NB = 64, RW_NW = NBLK - RW_NB;
DEV void phase_rw_cha(const Params& p, int jl, LAS unsigned char* lds, const int u0, const int ue, const int us) {
    const int tid = tid_(), bid = bid_(); (void)bid; const int lane = tid & 63, w = tid >> 6; const int fr = lane & 15, fq = lane >> 4;
    LAS float* cum = (LAS float*)lds;
    LAS float* seg = cum + 64 * 64;
    LAS float* Aab = seg + 8 * 64;
    LAS bf16_t* As = (LAS bf16_t*)(Aab + 64 * 68);
    LAS bf16_t* Bs = As + 64 * RC_LD; LAS bf16_t* Ks = Bs + 64 * RC_LD; LAS bf16_t* Vs = Ks + 64 * RC_LD; LAS bf16_t* Ke = Vs + 64 * RC_LD;
    LAS bf16_t* Aak = Ke + 64 * RC_LD; LAS bf16_t* Ts = Aak + 64 * RC_LD; LAS bf16_t* X1 = Ts + 64 * RC_LD; LAS bf16_t* Aabh = X1 + 64 * RC_LD;
    LAS bf16_t* Fimg = Aabh + 64 * RC_LD;
    LAS bf16_t* Wimg = Fimg + 4096;
    float pwd[8], pkr[8], pal[8], pv[8];
    float kkw[8], kaw[8];
    ld8(p.rw_k_k + (size_t)jl * D + (u0 & 15) * 64 + (tid & 7) * 8, kkw); ld8(p.rw_k_a + (size_t)jl * D + (u0 & 15) * 64 + (tid & 7) * 8, kaw);
    { const int c = u0 >> 4, h = u0 & 15; rc_load_wd(p, c * 64, h * 64, pwd);
      const size_t go = (size_t)(c * 64 + (tid >> 3)) * D + h * 64 + (tid & 7) * 8; ld8b(WS_(p, Kb) + go, pkr); ld8b(WS_(p, Ab) + go, pal); ld8b(WS_(p, Vb) + go, pv); }
    for (int u = u0; u < ue; u += us) {
        const int c = u >> 4, h = u & 15; const int t0 = c * 64, cb = h * 64; const size_t ub = (size_t)c * 16 + h;
        lds_barrier();
        rc_cum_regs(pwd, cum, seg);
        {
            const int t = tid >> 3, k8 = (tid & 7) * 8;
            float a[8], b[8], kh[8], v[8], ct[8], cp[8], ce[8];
            rc_prep8(pkr, pal, kkw, kaw, a, b, kh);
#pragma unroll
            for (int e = 0; e < 8; ++e) v[e] = pv[e];
            if (u + us < ue) { const int un = u + us; const int cn = un >> 4, hn = un & 15; rc_load_wd(p, cn * 64, hn * 64, pwd);
                const size_t gn = (size_t)(cn * 64 + t) * D + hn * 64 + k8; ld8b(WS_(p, Kb) + gn, pkr); ld8b(WS_(p, Ab) + gn, pal); ld8b(WS_(p, Vb) + gn, pv); }
            lds8(cum + t * 64 + k8, ct); lds8(cum + 63 * 64 + k8, ce);
            if (t > 0) lds8(cum + (t - 1) * 64 + k8, cp); else { for (int e = 0; e < 8; ++e) cp[e] = 0.f; }
            float at[8], bt[8], kt[8], be[8], ke[8];
#pragma unroll
            for (int e = 0; e < 8; ++e) { const float ei = __expf(-ct[e]), ee = __expf(ce[e] - ct[e]); at[e] = a[e] * __expf(cp[e]); bt[e] = b[e] * ei; kt[e] = kh[e] * ei; be[e] = b[e] * ee; ke[e] = kh[e] * ee; }
            *(LAS u32x4*)(As + t * RC_LD + k8) = pk8(at); *(LAS u32x4*)(Bs + t * RC_LD + k8) = pk8(bt); *(LAS u32x4*)(Ks + t * RC_LD + k8) = pk8(kt);
            *(LAS u32x4*)(Ke + t * RC_LD + k8) = pk8(ke); *(LAS u32x4*)(Vs + t * RC_LD + k8) = pk8(v);
            const int tq = t & 31, g = (tq & 15) >> 2, j = (tq & 3) + ((tq >> 4) << 2);
#pragma unroll
            for (int e = 0; e < 8; ++e) { const int k = k8 + e; Fimg[(((k >> 4) * 2 + (t >> 5)) * 64 + g * 16 + (k & 15)) * 8 + j] = (bf16_t)f2bf(be[e]); }
            *(LAS u32x4*)(Ts + tid * 8) = (u32x4){0u, 0u, 0u, 0u}; if (tid < 64) *(LAS u32x4*)(Ts + (512 + tid) * 8) = (u32x4){0u, 0u, 0u, 0u};
            if (t == 63) { float gm[8]; for (int e = 0; e < 8; ++e) gm[e] = __expf(ce[e]); *(f32x4*)(WS_(p, RGc) + ub * 64 + k8) = (f32x4){gm[0], gm[1], gm[2], gm[3]}; *(f32x4*)(WS_(p, RGc) + ub * 64 + k8 + 4) = (f32x4){gm[4], gm[5], gm[6], gm[7]}; }
        }
        lds_barrier();
        {
            const int tb = w >> 1;
#pragma unroll
            for (int ii = 0; ii < 2; ++ii) { const int ib = 2 * (w & 1) + ii;
                f32x4 ab = {0.f, 0.f, 0.f, 0.f}, ak = {0.f, 0.f, 0.f, 0.f};
                if (ib <= tb) {
#pragma unroll
                    for (int ks = 0; ks < 2; ++ks) { const bf16x8 af = frag_rm(As, RC_LD, 16 * tb, 32 * ks, lane);
                        ab = MFMA16(af, frag_rm(Bs, RC_LD, 16 * ib, 32 * ks, lane), ab); ak = MFMA16(af, frag_rm(Ks, RC_LD, 16 * ib, 32 * ks, lane), ak); } }
#pragma unroll
                for (int r = 0; r < 4; ++r) { const int t = 16 * tb + 4 * fq + r, i = 16 * ib + fr; const bool keep = i < t;
                    Aab[t * 68 + i] = keep ? ab[r] : 0.f; Aabh[t * RC_LD + i] = (bf16_t)f2bf(keep ? ab[r] : 0.f); Aak[t * RC_LD + i] = (bf16_t)f2bf(keep ? ak[r] : 0.f); } }
            *(u32x4*)(WS_(p, RBf) + ub * 4096 + tid * 8) = *(const LAS u32x4*)(Fimg + tid * 8);
        }
        lds_barrier();
        if (w == 0) {
            const int blk = lane >> 4, jc = lane & 15;
            float Tc[16];
#pragma unroll
            for (int t = 0; t < 16; ++t) {
                float acc = jc == t ? 1.f : 0.f;
#pragma unroll
                for (int i4 = 0; i4 < (t + 3) / 4; ++i4) { const f32x4 a4 = *(const LAS f32x4*)(Aab + (16 * blk + t) * 68 + 16 * blk + i4 * 4);
#pragma unroll
                    for (int e = 0; e < 4; ++e) if (i4 * 4 + e < t) acc += a4[e] * Tc[i4 * 4 + e]; }
                Tc[t] = acc;
            }
#pragma unroll
            for (int t = 0; t < 16; ++t) Ts[(16 * blk + t) * RC_LD + 16 * blk + jc] = (bf16_t)f2bf(Tc[t]);
#pragma unroll
            for (int b = 1; b < 4; ++b) {
                const s16x4 dlo = *(const LAS s16x4*)(Ts + (16 * b + fr) * RC_LD + 16 * b + 4 * fq);
                bf16x8 dfr; dfr[0] = dlo[0]; dfr[1] = dlo[1]; dfr[2] = dlo[2]; dfr[3] = dlo[3]; dfr[4] = 0; dfr[5] = 0; dfr[6] = 0; dfr[7] = 0;
                f32x4 tt_[3];
#pragma unroll
                for (int cbk = 0; cbk < b; ++cbk) {
                    f32x4 x = {0.f, 0.f, 0.f, 0.f};
#pragma unroll
                    for (int ks = 0; ks < 2; ++ks) x = MFMA16(frag_rm(Aabh, RC_LD, 16 * b, 32 * ks, lane), frag_tr(Ts, RC_LD, 32 * ks, 16 * cbk, lane), x);
                    u32x4 xb; xb.x = pk2(x[0], x[1]); xb.y = pk2(x[2], x[3]); xb.z = 0u; xb.w = 0u;
                    tt_[cbk] = MFMA16(dfr, __builtin_bit_cast(bf16x8, xb), ((f32x4){0.f, 0.f, 0.f, 0.f}));
                }
#pragma unroll
                for (int cbk = 0; cbk < b; ++cbk)
#pragma unroll
                    for (int r = 0; r < 4; ++r) Ts[(16 * b + 4 * fq + r) * RC_LD + 16 * cbk + fr] = (bf16_t)f2bf(tt_[cbk][r]);
            }
        } else {
            for (int tl = w - 1; tl < 32; tl += 7) {
                const int rb = (tl & 15) >> 2, vbk = tl & 3; f32x4 acc = {0.f, 0.f, 0.f, 0.f};
                if (tl < 16) {
#pragma unroll
                    for (int ks = 0; ks < 2; ++ks) acc = MFMA16(frag_rm(Aak, RC_LD, 16 * rb, 32 * ks, lane), frag_tr(Vs, RC_LD, 32 * ks, 16 * vbk, lane), acc);
#pragma unroll
                    for (int r = 0; r < 4; ++r) X1[(16 * rb + 4 * fq + r) * RC_LD + 16 * vbk + fr] = (bf16_t)f2bf(acc[r]);
                } else {
#pragma unroll
                    for (int ks = 0; ks < 2; ++ks) acc = MFMA16(frag_tr(Ke, RC_LD, 32 * ks, 16 * rb, lane), frag_tr(Vs, RC_LD, 32 * ks, 16 * vbk, lane), acc);
                    { u32x2 o; o.x = pk2(acc[0], acc[1]); o.y = pk2(acc[2], acc[3]); *(u32x2*)(WS_(p, RNa) + (((ub * 4 + vbk) * 4 + rb) * 64 + lane) * 4) = o; }
                }
            }
        }
        lds_barrier();
#pragma unroll
        for (int q = 0; q < 4; ++q) { const int tl = w * 4 + q; const int tt = (tl & 15) >> 2, cbk = tl & 3; f32x4 acc = {0.f, 0.f, 0.f, 0.f};
            if (tl < 16) {
#pragma unroll
                for (int ks = 0; ks < 2; ++ks) acc = MFMA16(frag_rm(Ts, RC_LD, 16 * tt, 32 * ks, lane), frag_tr(As, RC_LD, 32 * ks, 16 * cbk, lane), acc);
                const int k = 16 * cbk + fr, kq = k & 31, g = (kq & 15) >> 2, j = (kq & 3) + ((kq >> 4) << 2);
#pragma unroll
                for (int r = 0; r < 4; ++r) Wimg[((tt * 2 + (k >> 5)) * 64 + g * 16 + 4 * fq + r) * 8 + j] = (bf16_t)f2bf(acc[r]);
            } else {
#pragma unroll
                for (int ks = 0; ks < 2; ++ks) acc = MFMA16(frag_rm(Ts, RC_LD, 16 * tt, 32 * ks, lane), frag_tr(X1, RC_LD, 32 * ks, 16 * cbk, lane), acc);
                { u32x2 o; o.x = pk2(acc[0], acc[1]); o.y = pk2(acc[2], acc[3]); *(u32x2*)(WS_(p, RUt) + (((ub * 4 + cbk) * 4 + tt) * 64 + lane) * 4) = o; }
            } }
        lds_barrier();
        *(u32x4*)(WS_(p, RWf) + ub * 4096 + tid * 8) = *(const LAS u32x4*)(Wimg + tid * 8);
    }
}

constexpr int RB_SLOT = 20992, RB_R = 6, RB_P = 5;
struct RbOpsA { bf16x8 wf[8]; u32x2 ut[4]; };
struct RbOpsB { bf16x8 bf[8]; u32x2 na[4]; f32x4 gc[4]; };
DEV void rb_read_a(const LAS unsigned char* slot, int lane, RbOpsA& O) {
#pragma unroll
    for (int f = 0; f < 8; ++f) O.wf[f] = *(const LAS bf16x8*)(slot + (f * 64 + lane) * 16);
#pragma unroll
    for (int q = 0; q < 4; ++q) O.ut[q] = *(const LAS u32x2*)(slot + 16384 + (q * 64 + lane) * 8);
}
DEV void rb_read_b(const LAS unsigned char* slot, int lane, RbOpsB& O) {
    const int fq = lane >> 4;
#pragma unroll
    for (int f = 0; f < 8; ++f) O.bf[f] = *(const LAS bf16x8*)(slot + 8192 + (f * 64 + lane) * 16);
#pragma unroll
    for (int q = 0; q < 4; ++q) { O.na[q] = *(const LAS u32x2*)(slot + 18432 + (q * 64 + lane) * 8); O.gc[q] = *(const LAS f32x4*)(slot + 20480 + (16 * q + 4 * fq) * 4); }
}
DEV void phase_rw_chb(const Params& p, LAS unsigned char* lds, int half) {
    const int tid = tid_(), bid = bid_(); const int cbeg = half * 128, cend = cbeg + 128;
    const int lane = tid & 63, w = __builtin_amdgcn_readfirstlane(tid >> 6); const int head = bid & 15, vb = bid >> 4;
    auto issue = [&](int c) {
        const size_t ub = (size_t)c * 16 + head; LAS unsigned char* slot = lds + (c % RB_R) * RB_SLOT;
#pragma unroll
        for (int i = 0; i < 3; ++i) { const int pi = (w - 1) * 3 + i;
            if (pi < 8) __builtin_amdgcn_global_load_lds((const unsigned*)(WS_(p, RWf) + ub * 4096 + pi * 512 + lane * 8), (LAS unsigned*)(slot + pi * 1024), 16, 0, 0);
            else if (pi < 16) __builtin_amdgcn_global_load_lds((const unsigned*)(WS_(p, RBf) + ub * 4096 + (pi - 8) * 512 + lane * 8), (LAS unsigned*)(slot + 8192 + (pi - 8) * 1024), 16, 0, 0);
            else if (pi < 18) __builtin_amdgcn_global_load_lds((const unsigned*)(WS_(p, RUt) + (ub * 4 + vb) * 1024 + (pi - 16) * 512 + lane * 8), (LAS unsigned*)(slot + 16384 + (pi - 16) * 1024), 16, 0, 0);
            else if (pi < 20) __builtin_amdgcn_global_load_lds((const unsigned*)(WS_(p, RNa) + (ub * 4 + vb) * 1024 + (pi - 18) * 512 + lane * 8), (LAS unsigned*)(slot + 18432 + (pi - 18) * 1024), 16, 0, 0);
            else __builtin_amdgcn_global_load_lds((const unsigned*)(WS_(p, RGc) + ub * 64 + lane), (LAS unsigned*)(slot + 20480), 4, 0, 0);
        }
    };
    if (w > 0) {
#pragma unroll 1
        for (int c = cbeg; c < cbeg + RB_P; ++c) issue(c);
        asm volatile("s_waitcnt vmcnt(9)" ::: "memory");
    }
    __builtin_amdgcn_s_barrier();
    f32x4 s[4]; for (int i = 0; i < 4; ++i) s[i] = (f32x4){0.f, 0.f, 0.f, 0.f};
    f32x4* sst = WS_(p, RBST) + ((size_t)bid * 4) * 64 + lane;
    if (w > 0) {
#pragma unroll 1
        for (int c = cbeg; c < cend; ++c) {
            if (c + RB_P < cend) { issue(c + RB_P); asm volatile("s_waitcnt vmcnt(9)" ::: "memory"); }
            else asm volatile("s_waitcnt vmcnt(0)" ::: "memory");
            __builtin_amdgcn_s_barrier();
        }
    } else {
        RbOpsA A0, A1;
        rb_read_a(lds + (cbeg % RB_R) * RB_SLOT, lane, A0); if (half) { for (int i = 0; i < 4; ++i) s[i] = sst[i * 64]; }
#define RB_CHUNK(CA, NA, cc) do { const int c_ = (cc); const size_t ub = (size_t)c_ * 16 + head; RbOpsB cb_; \
            bf16x8 sb[2]; \
            _Pragma("unroll") for (int ks = 0; ks < 2; ++ks) { u32x4 o; o.x = pk2(s[2 * ks][0], s[2 * ks][1]); o.y = pk2(s[2 * ks][2], s[2 * ks][3]); o.z = pk2(s[2 * ks + 1][0], s[2 * ks + 1][1]); o.w = pk2(s[2 * ks + 1][2], s[2 * ks + 1][3]); sb[ks] = __builtin_bit_cast(bf16x8, o); *(u32x4*)(WS_(p, RS0) + (((ub * 4 + vb) * 2 + ks) * 64 + lane) * 8) = o; }       \
            f32x4 uu[4]; \
            _Pragma("unroll") for (int tt = 0; tt < 4; ++tt) { uu[tt] = (f32x4){bflo(CA.ut[tt].x), bfhi(CA.ut[tt].x), bflo(CA.ut[tt].y), bfhi(CA.ut[tt].y)}; uu[tt] = MFMA16(CA.wf[tt * 2], sb[0], uu[tt]); uu[tt] = MFMA16(CA.wf[tt * 2 + 1], sb[1], uu[tt]); } \
            __builtin_amdgcn_sched_barrier(0); \
              \
            rb_read_b(lds + (c_ % RB_R) * RB_SLOT, lane, cb_); \
            rb_read_a(lds + ((c_ + 1 < cend ? c_ + 1 : c_) % RB_R) * RB_SLOT, lane, NA); \
            __builtin_amdgcn_sched_barrier(0); \
            bf16x8 ubf[2]; \
            _Pragma("unroll") for (int ks = 0; ks < 2; ++ks) { u32x4 o; o.x = pk2(uu[2 * ks][0], uu[2 * ks][1]); o.y = pk2(uu[2 * ks][2], uu[2 * ks][3]); o.z = pk2(uu[2 * ks + 1][0], uu[2 * ks + 1][1]); o.w = pk2(uu[2 * ks + 1][2], uu[2 * ks + 1][3]); ubf[ks] = __builtin_bit_cast(bf16x8, o); *(u32x4*)(WS_(p, RUa) + (((ub * 4 + vb) * 2 + ks) * 64 + lane) * 8) = o; }      \
            _Pragma("unroll") for (int kt = 0; kt < 4; ++kt) { s[kt] = s[kt] * cb_.gc[kt] + (f32x4){bflo(cb_.na[kt].x), bfhi(cb_.na[kt].x), bflo(cb_.na[kt].y), bfhi(cb_.na[kt].y)}; s[kt] = MFMA16(cb_.bf[kt * 2], ubf[0], s[kt]); s[kt] = MFMA16(cb_.bf[kt * 2 + 1], ubf[1], s[kt]); } \
            __builtin_amdgcn_s_barrier(); \
        } while (0)
#pragma unroll 1
        for (int c = cbeg; c < cend; c += 2) { RB_CHUNK(A0, A1, c); RB_CHUNK(A1, A0, c + 1); }
#undef RB_CHUNK
    }
    if (w == 0 && !half) { for (int i = 0; i < 4; ++i) sst[i * 64] = s[i]; }
    asm volatile("s_waitcnt vmcnt(0)" ::: "memory");
}

DEV void phase_rw_chc(const Params& p, int j, LAS unsigned char* lds, const int u0, const int ue, const int us) {
    const int tid = tid_(), bid = bid_(); (void)bid; const int lane = tid & 63, w = tid >> 6; const int fr = lane & 15, fq = lane >> 4;
    LAS float* cum = (LAS float*)lds;
    LAS float* seg = cum + 64 * 64;
    LAS float* Ys = seg + 8 * 64;
    LAS bf16_t* Rs = (LAS bf16_t*)(Ys + 64 * 68);
    LAS bf16_t* Bs = Rs + 64 * RC_LD; LAS bf16_t* Ks = Bs + 64 * RC_LD; LAS bf16_t* Vs = Ks + 64 * RC_LD; LAS bf16_t* Arb = Vs + 64 * RC_LD; LAS bf16_t* Ark = Arb + 64 * RC_LD;
    float pwd[8], pr[8], pkr[8], pal[8], pv[8], pg[8];
    float kkw[8], kaw[8], rkw[8], lgw[8], lbw[8];
    { const size_t po = (size_t)j * D + (u0 & 15) * 64 + (tid & 7) * 8; ld8(p.rw_k_k + po, kkw); ld8(p.rw_k_a + po, kaw); ld8(p.rw_r_k + po, rkw); ld8(p.rw_lnx_g + po, lgw); ld8(p.rw_lnx_b + po, lbw); }
    { const int c = u0 >> 4, h = u0 & 15; rc_load_wd(p, c * 64, h * 64, pwd);
      const size_t go = (size_t)(c * 64 + (tid >> 3)) * D + h * 64 + (tid & 7) * 8; ld8b(WS_(p, Rb) + go, pr); ld8b(WS_(p, Kb) + go, pkr); ld8b(WS_(p, Ab) + go, pal); ld8b(WS_(p, Vb) + go, pv); ld8b(WS_(p, Gb) + go, pg); }
    for (int u = u0; u < ue; u += us) {
        const int c = u >> 4, h = u & 15; const int t0 = c * 64, cb = h * 64; const size_t ub = (size_t)c * 16 + h;
        const int tt = w & 3;
        bf16x8 ufr[2][2], sfr[2][2];
#pragma unroll
        for (int q = 0; q < 2; ++q)
#pragma unroll
            for (int ks = 0; ks < 2; ++ks) { const size_t o = (((ub * 4 + 2 * (w >> 2) + q) * 2 + ks) * 64 + lane) * 8;
                ufr[q][ks] = *(const bf16x8*)(WS_(p, RUa) + o); sfr[q][ks] = *(const bf16x8*)(WS_(p, RS0) + o); }
        lds_barrier();
        rc_cum_regs(pwd, cum, seg);
#ifdef DBL_CUM
        rc_cum_regs(pwd, cum, seg);
#endif
        const int t = tid >> 3, k8 = (tid & 7) * 8; const size_t go = (size_t)(t0 + t) * D + cb + k8;
        float v[8], gg[8]; float bc;
        {   float r[8], a[8], b[8], kh[8], ct[8];
#pragma unroll
            for (int e = 0; e < 8; ++e) { r[e] = pr[e]; v[e] = pv[e]; gg[e] = pg[e]; }
            lds8(cum + t * 64 + k8, ct);
            rc_prep8(pkr, pal, kkw, kaw, a, b, kh);
            if (u + us < ue) { const int un = u + us; const int cn = un >> 4, hn = un & 15; rc_load_wd(p, cn * 64, hn * 64, pwd);
                const size_t gn = (size_t)(cn * 64 + t) * D + hn * 64 + k8; ld8b(WS_(p, Rb) + gn, pr); ld8b(WS_(p, Kb) + gn, pkr); ld8b(WS_(p, Ab) + gn, pal); ld8b(WS_(p, Vb) + gn, pv); ld8b(WS_(p, Gb) + gn, pg); }
            bc = 0.f;
#pragma unroll
            for (int e = 0; e < 8; ++e) bc += r[e] * kh[e] * rkw[e];
            bc += __shfl_xor(bc, 1); bc += __shfl_xor(bc, 2); bc += __shfl_xor(bc, 4);
#pragma unroll
            for (int e = 0; e < 8; ++e) { const float ei = __expf(-ct[e]); r[e] *= __expf(ct[e]); b[e] *= ei; kh[e] *= ei; }
            *(LAS u32x4*)(Rs + t * RC_LD + k8) = pk8(r); *(LAS u32x4*)(Bs + t * RC_LD + k8) = pk8(b); *(LAS u32x4*)(Ks + t * RC_LD + k8) = pk8(kh); *(LAS u32x4*)(Vs + t * RC_LD + k8) = pk8(v);
        }
        lds_barrier();
#ifdef DBL_S3
#pragma unroll 1
        for (int rep_ = 0; rep_ < 2; ++rep_)
#endif
        {   const int tb = w >> 1;
#pragma unroll
            for (int ii = 0; ii < 2; ++ii) { const int ib = 2 * (w & 1) + ii;
                f32x4 ab = {0.f, 0.f, 0.f, 0.f}, ak = {0.f, 0.f, 0.f, 0.f};
                if (ib <= tb) {
#pragma unroll
                    for (int ks = 0; ks < 2; ++ks) { const bf16x8 af = frag_rm(Rs, RC_LD, 16 * tb, 32 * ks, lane);
                        ab = MFMA16(af, frag_rm(Bs, RC_LD, 16 * ib, 32 * ks, lane), ab); ak = MFMA16(af, frag_rm(Ks, RC_LD, 16 * ib, 32 * ks, lane), ak); } }
#pragma unroll
                for (int r = 0; r < 4; ++r) { const int tr = 16 * tb + 4 * fq + r, i = 16 * ib + fr; const bool keep = i <= tr;
                    Arb[tr * RC_LD + i] = (bf16_t)f2bf(keep ? ab[r] : 0.f); Ark[tr * RC_LD + i] = (bf16_t)f2bf(keep ? ak[r] : 0.f); } }
        }
        lds_barrier();
#ifdef DBL_Y
#pragma unroll 1
        for (int rep_ = 0; rep_ < 2; ++rep_)
#endif
#pragma unroll
        for (int q = 0; q < 2; ++q) { const int vbk = 2 * (w >> 2) + q; f32x4 acc = {0.f, 0.f, 0.f, 0.f};
#pragma unroll
            for (int ks = 0; ks < 2; ++ks) {
                acc = MFMA16(frag_rm_pi(Rs, RC_LD, 16 * tt, 32 * ks, lane), sfr[q][ks], acc);
                acc = MFMA16(frag_rm_pi(Arb, RC_LD, 16 * tt, 32 * ks, lane), ufr[q][ks], acc);
                acc = MFMA16(frag_rm(Ark, RC_LD, 16 * tt, 32 * ks, lane), frag_tr(Vs, RC_LD, 32 * ks, 16 * vbk, lane), acc); }
#pragma unroll
            for (int r = 0; r < 4; ++r) Ys[(16 * tt + 4 * fq + r) * 68 + 16 * vbk + fr] = acc[r]; }
        lds_barrier();
        {
            float y[8]; lds8(Ys + t * 68 + k8, y);
            float s1 = 0.f, s2 = 0.f;
#pragma unroll
            for (int e = 0; e < 8; ++e) { s1 += y[e]; s2 += y[e] * y[e]; }
            s1 += __shfl_xor(s1, 1); s1 += __shfl_xor(s1, 2); s1 += __shfl_xor(s1, 4); s2 += __shfl_xor(s2, 1); s2 += __shfl_xor(s2, 2); s2 += __shfl_xor(s2, 4);
            const float mean = s1 * (1.0f / 64.0f), var = s2 * (1.0f / 64.0f) - mean * mean; const float rs = rsqrtf(fmaxf(var, 0.f) + 64e-5f);
            float o[8];
#pragma unroll
            for (int e = 0; e < 8; ++e) o[e] = ((y[e] - mean) * rs * lgw[e] + lbw[e] + bc * v[e]) * gg[e];
            *(u32x4*)(WS_(p, YB) + go) = pk8(o);
        }
    }
}
DEV void phase_ln1(const Params& p, int layer, LAS unsigned char* lds) {
    const int tid = tid_(), bid = bid_(); (void)tid; (void)bid;
    const int lane = tid & 63, wid = tid >> 6; const int fr = lane & 15, fq = lane >> 4;
    LAS float* lgt = (LAS float*)lds;
    LAS int* cnt = (LAS int*)(lgt + 2 * 64 * 48);
    if (tid < 32) cnt[tid] = 0;
    const float* g = p.ln_g + ((size_t)layer * 2 + 0) * D; const float* be = p.ln_b + ((size_t)layer * 2 + 0) * D;
    const float* br = p.moe_b_route + layer * 32; const float* bg = p.moe_b_group + layer * 4;
    f32x4 gwv[4], bwv[4];
#pragma unroll
    for (int q = 0; q < 4; ++q) { gwv[q] = *(const f32x4*)(g + RCOL(q, lane)); bwv[q] = *(const f32x4*)(be + RCOL(q, lane)); }
    u32x2 rh[4], rm[4];
#pragma unroll
    for (int q = 0; q < 4; ++q) { rh[q] = *(const u32x2*)(WS_(p, Hb) + (size_t)(bid * 64 + wid * 8) * D + RCOL(q, lane)); rm[q] = *(const u32x2*)(WS_(p, MIXb) + (size_t)(bid * 64 + wid * 8) * D + RCOL(q, lane)); }
#pragma unroll 1
    for (int rr = 0; rr < 8; ++rr) {
        const int t = bid * 64 + wid * 8 + rr; const size_t ro = (size_t)t * D;
        f32x4 z[4], m[4];
#pragma unroll
        for (int q = 0; q < 4; ++q) { z[q] = (f32x4){bflo(rh[q].x), bfhi(rh[q].x), bflo(rh[q].y), bfhi(rh[q].y)}; m[q] = (f32x4){bflo(rm[q].x), bfhi(rm[q].x), bflo(rm[q].y), bfhi(rm[q].y)}; }
        { const size_t rn = (size_t)(rr < 7 ? t + 1 : t) * D;
#pragma unroll
          for (int q = 0; q < 4; ++q) { rh[q] = *(const u32x2*)(WS_(p, Hb) + rn + RCOL(q, lane)); rm[q] = *(const u32x2*)(WS_(p, MIXb) + rn + RCOL(q, lane)); } }
        float s = 0.f;
#pragma unroll
        for (int q = 0; q < 4; ++q) { z[q] = z[q] * ALPHA + m[q]; s += z[q][0] + z[q][1] + z[q][2] + z[q][3]; }
        const float mean = wave_sum(s) * (1.0f / D);
        float vs = 0.f;
#pragma unroll
        for (int q = 0; q < 4; ++q) { z[q] = z[q] - mean; vs += z[q][0] * z[q][0] + z[q][1] * z[q][1] + z[q][2] * z[q][2] + z[q][3] * z[q][3]; }
        const float rs = rsqrtf(wave_sum(vs) * (1.0f / D) + LN_EPS);
#pragma unroll
        for (int q = 0; q < 4; ++q) {
            st_bf4(WS_(p, H1b) + ro + RCOL(q, lane), z[q] * rs * gwv[q] + bwv[q]);
        }
    }
    asm volatile("s_waitcnt vmcnt(0)" ::: "memory");
    __syncthreads();
    {   const int rt = wid & 3, kh = wid >> 2;
        const bf16_t* Ab = WS_(p, H1b) + (size_t)(bid * 64 + 16 * rt + fr) * D + 512 * kh + 8 * fq;
        const bf16_t* Wb = WS_(p, moe_wr_t) + (size_t)layer * 48 * D + (size_t)fr * D + 512 * kh + 8 * fq;
        f32x4 acc[3]; for (int i = 0; i < 3; ++i) acc[i] = (f32x4){0.f, 0.f, 0.f, 0.f};
#pragma unroll 8
        for (int ks = 0; ks < 16; ++ks) {
            const bf16x8 af = *(const bf16x8*)(Ab + 32 * ks);
#pragma unroll
            for (int ct = 0; ct < 3; ++ct) acc[ct] = MFMA16(af, *(const bf16x8*)(Wb + (size_t)16 * ct * D + 32 * ks), acc[ct]);
        }
#pragma unroll
        for (int ct = 0; ct < 3; ++ct)
#pragma unroll
            for (int r = 0; r < 4; ++r) lgt[(kh * 64 + 16 * rt + 4 * fq + r) * 48 + 16 * ct + fr] = acc[ct][r];
    }
    __syncthreads();
    if (tid < 64) {
        const int t = bid * 64 + tid; const LAS float* L0 = lgt + tid * 48; const LAS float* L1 = lgt + (64 + tid) * 48;
        const float q0 = L0[32] + L1[32] + bg[0], q1 = L0[33] + L1[33] + bg[1], q2 = L0[34] + L1[34] + bg[2], q3 = L0[35] + L1[35] + bg[3];
        int gi = 0; float gm = q0;
        if (q1 > gm) { gm = q1; gi = 1; } if (q2 > gm) { gm = q2; gi = 2; } if (q3 > gm) { gm = q3; gi = 3; }
        const float den = __expf(q0 - gm) + __expf(q1 - gm) + __expf(q2 - gm) + __expf(q3 - gm);
        const float pgrp = __builtin_amdgcn_rcpf(den);
        float l1 = -INFINITY, l2 = -INFINITY; int i1 = 0, i2 = 0;
#pragma unroll 1
        for (int o = 0; o < 8; ++o) { const float v = L0[gi * 8 + o] + L1[gi * 8 + o] + br[gi * 8 + o];
            if (v > l1) { l2 = l1; i2 = i1; l1 = v; i1 = o; } else if (v > l2) { l2 = v; i2 = o; } }
        const float e2 = __expf(l2 - l1), inv = __builtin_amdgcn_rcpf(1.0f + e2);
        const int e0 = gi * 8 + i1, e1 = gi * 8 + i2;
        WS_(p, EIDX)[2 * t] = e0; WS_(p, EIDX)[2 * t + 1] = e1; WS_(p, GATE)[2 * t] = pgrp * inv; WS_(p, GATE)[2 * t + 1] = pgrp * e2 * inv;
        atomicAdd((int*)&cnt[e0], 1); atomicAdd((int*)&cnt[e1], 1);
    }
    __syncthreads();
    if (tid < 32) WS_(p, CNT)[bid * 32 + tid] = cnt[tid];
}

DEV void phase_moe_scatter(const Params& p, LAS unsigned char* lds) {
    const int tid = tid_(), bid = bid_(); (void)tid; (void)bid;
    const int lane = tid & 63, wid = tid >> 6;
    LAS int* part = (LAS int*)lds;
    LAS int* pre = part + 512;
    LAS int* base = pre + 512;
    LAS int* pst = base + 32;
    LAS int* dst = pst + 40;
    LAS int* eid = dst + 128;
    { const int e = tid & 31, part_i = tid >> 5; int tot = 0, prf = 0;
      for (int b = part_i * 16; b < part_i * 16 + 16; ++b) { const int c = WS_(p, CNT)[b * 32 + e]; tot += c; if (b < (int)bid) prf += c; }
      part[part_i * 32 + e] = tot; pre[part_i * 32 + e] = prf; }
    if (tid < 128) eid[tid] = WS_(p, EIDX)[bid * 128 + tid];
    if (bid == 1 && tid < MFLAG_TICKET + 32) __hip_atomic_store(WS_(p, MFLAG) + tid * MFLAG_STRIDE, 0u, __ATOMIC_RELAXED, __HIP_MEMORY_SCOPE_AGENT);
    lds_barrier();
    if (tid < 32) { int tot = 0, prf = 0; for (int i = 0; i < 16; ++i) { tot += part[i * 32 + tid]; prf += pre[i * 32 + tid]; } part[tid] = tot; pre[tid] = prf; }
    lds_barrier();
    if (tid == 0) { int acc = 0; for (int e = 0; e < 32; ++e) { pst[e] = acc; acc += ((part[e] + 255) >> 8) << 8; } pst[32] = acc;
        if (bid == 0) { for (int e = 0; e <= 32; ++e) WS_(p, TAB)[e] = pst[e]; WS_(p, TAB)[33] = acc >> 8;
            for (int e = 0; e < 32; ++e) for (int mt = pst[e] >> 8; mt < (pst[e + 1] >> 8); ++mt) WS_(p, TAB)[64 + mt] = e; } }
    lds_barrier();
    if (tid < 32) { int run = pst[tid] + pre[tid];
#pragma unroll 16
        for (int a = 0; a < 128; ++a) if (eid[a] == tid) dst[a] = run++; }
    lds_barrier();
    if (tid < 128) WS_(p, DEST)[bid * 128 + tid] = dst[tid];
#pragma unroll 4
    for (int a = wid * 16; a < wid * 16 + 16; ++a) {
        const int t = bid * 64 + (a >> 1); const int d = dst[a];
        const u32x4 v0 = *(const u32x4*)(WS_(p, H1b) + (size_t)t * D + lane * 8), v1 = *(const u32x4*)(WS_(p, H1b) + (size_t)t * D + 512 + lane * 8);
        *(u32x4*)(WS_(p, BUF) + (size_t)d * D + lane * 8) = v0; *(u32x4*)(WS_(p, BUF) + (size_t)d * D + 512 + lane * 8) = v1;
    }
}

template <int which> struct SchedMoe {
    const Params* p; int layer; const LAS int* tab;
    DEV bool next(int i, Unit& u) const {
        const int nmt = tab[33]; int pm, pn; if (!pg8::tile_order(i, NB_, which == 0 ? bid_() : ((bid_() + 128) & 255), nmt, 4, pm, pn)) return false;
        const int row0 = pm * 256; const int e = tab[64 + pm];
        if constexpr (which == 0) { u.A = (const char*)(WS_(*p, BUF) + (size_t)row0 * D); u.B = (const char*)(WS_(*p, moe_w1_t) + ((size_t)layer * 32 + e) * 1024 * 1024 + (size_t)pn * 256 * 1024); }
        else {
            if (tid_() == 0) { unsigned* f = WS_(*p, MFLAG) + pm * MFLAG_STRIDE; unsigned sp = 0;
                while (__hip_atomic_load(f, __ATOMIC_RELAXED, __HIP_MEMORY_SCOPE_AGENT) < 4u) { __builtin_amdgcn_s_sleep(1); if (++sp > (1u << 24)) break; }
                __builtin_amdgcn_fence(__ATOMIC_ACQUIRE, "agent");
                asm volatile("s_waitcnt vmcnt(0)" ::: "memory"); }
            __builtin_amdgcn_s_barrier();
            u.A = (const char*)(WS_(*p, ACT) + (size_t)row0 * 512); u.B = (const char*)(WS_(*p, moe_w2_t) + ((size_t)layer * 32 + e) * 1024 * 512 + (size_t)pn * 256 * 512); }
        u.row0 = row0; u.col0 = pn * 256; u.id = e; u.aux = 0; return true;
    }
};
struct EpiMoe1 {
    bf16_t* O; unsigned* flag;
    DEV void operator()(const AccT& acc, const Unit& u, int wr, int wc, int fr, int fq) const {
        const __amdgpu_buffer_rsrc_t rs = __builtin_amdgcn_make_buffer_rsrc(O, 0, MOE_ROWS * 512 * 2, 0x00020000);
#pragma unroll
        for (int ai = 0; ai < 2; ++ai)
#pragma unroll
            for (int m = 0; m < 4; ++m) {
                f32x4 v[2];
#pragma unroll
                for (int n = 0; n < 2; ++n) { const f32x4 gt = acc[ai][0][m][n], up = acc[ai][1][m][n]; for (int e = 0; e < 4; ++e) v[n][e] = siluf_(gt[e]) * up[e]; }
                const int col = (u.col0 >> 1) + 32 * wc + (PF(6) ? 8 * fq : 4 * fq);
                if (PF(6)) __builtin_amdgcn_raw_buffer_store_b128(pk8v(v[0], v[1]), rs, (unsigned)((ACC_ROW(u, ai, m) * 512 + col) * 2), 0, 16);
                else { const u32x4 w = pk8v(v[0], v[1]); unsigned long long* q = (unsigned long long*)(O + (size_t)ACC_ROW(u, ai, m) * 512 + col);
                  __hip_atomic_store(q, (unsigned long long)w.x | ((unsigned long long)w.y << 32), __ATOMIC_RELAXED, __HIP_MEMORY_SCOPE_AGENT);
                  __hip_atomic_store(q + 4, (unsigned long long)w.z | ((unsigned long long)w.w << 32), __ATOMIC_RELAXED, __HIP_MEMORY_SCOPE_AGENT); }
                ACC_FENCE;
            }
        asm volatile("s_waitcnt vmcnt(0)" ::: "memory");
        __builtin_amdgcn_s_barrier();
        if (wr == 1 && wc == 0 && fr == 0 && fq == 0) __hip_atomic_fetch_add(flag + (u.row0 >> 8) * MFLAG_STRIDE, 1u, __ATOMIC_RELAXED, __HIP_MEMORY_SCOPE_AGENT);
    }
};
struct EpiMoe2 {
    bf16_t* O;
    DEV void operator()(const AccT& acc, const Unit& u, int wr, int wc, int fr, int fq) const {
        FOR_ACC2(ai, bj, m) { st_bf8p(O + (size_t)ACC_ROW(u, ai, m) * D + ACC_COL8P(u, bj, PF(7)), acc[ai][bj][m][0], acc[ai][bj][m][1], PF(7)); ACC_FENCE; }
    }
};

struct Ln2Raw { u32x2 h[4], a[4], b[4]; float g0, g1; };
DEV void ln2_issue(const Params& p, int t, int lane, Ln2Raw& R, int dpre, float gpre, int tbase) {
    const int i0 = 2 * (t - tbase); const int d0 = __shfl(dpre, i0), d1 = __shfl(dpre, i0 + 1); R.g0 = __shfl(gpre, i0); R.g1 = __shfl(gpre, i0 + 1);
#pragma unroll
    for (int q = 0; q < 4; ++q) { R.h[q] = *(const u32x2*)(WS_(p, H1b) + (size_t)t * D + RCOL(q, lane));
        R.a[q] = *(const u32x2*)(WS_(p, YBUF) + (size_t)d0 * D + RCOL(q, lane)); R.b[q] = *(const u32x2*)(WS_(p, YBUF) + (size_t)d1 * D + RCOL(q, lane)); }
}
DEV void ln2_finish(const Ln2Raw& R, const f32x4 (&gwv)[4], const f32x4 (&bwv)[4], f32x4 (&z)[4]) {
    float s = 0.f; const float g0 = R.g0, g1 = R.g1;
#pragma unroll
    for (int q = 0; q < 4; ++q) {
        z[q][0] = bflo(R.h[q].x) * ALPHA + g0 * bflo(R.a[q].x) + g1 * bflo(R.b[q].x); z[q][1] = bfhi(R.h[q].x) * ALPHA + g0 * bfhi(R.a[q].x) + g1 * bfhi(R.b[q].x);
        z[q][2] = bflo(R.h[q].y) * ALPHA + g0 * bflo(R.a[q].y) + g1 * bflo(R.b[q].y); z[q][3] = bfhi(R.h[q].y) * ALPHA + g0 * bfhi(R.a[q].y) + g1 * bfhi(R.b[q].y);
        s += z[q][0] + z[q][1] + z[q][2] + z[q][3];
    }
    const float mean = wave_sum(s) * (1.0f / D);
    float vs = 0.f;
#pragma unroll
    for (int q = 0; q < 4; ++q) { z[q] = z[q] - mean; vs += z[q][0] * z[q][0] + z[q][1] * z[q][1] + z[q][2] * z[q][2] + z[q][3] * z[q][3]; }
    const float rs = rsqrtf(wave_sum(vs) * (1.0f / D) + LN_EPS);
#pragma unroll
    for (int q = 0; q < 4; ++q) z[q] = z[q] * rs * gwv[q] + bwv[q];
}
DEV void phase_ln2(const Params& p, int layer, LAS unsigned char* lds) {
    const int tid = tid_(), bid = bid_(); const int lane = tid & 63, wid = tid >> 6; const int fr = lane & 15, fq = lane >> 4;
    const float* g = p.ln_g + ((size_t)layer * 2 + 1) * D; const float* be = p.ln_b + ((size_t)layer * 2 + 1) * D;
    const int nk = layer == DEPTH - 1 ? 3 : (layer + 1) % 3;
    const int nj = (layer + 1) / 3;
    LAS float* lgt = (LAS float*)lds;
    LAS float* w2 = lgt + 2 * 64 * 32;
    if (nk == 2) { for (int i = tid; i < 16 * 512; i += NTHR) w2[i] = p.gl_gk_w2[(size_t)nj * 16 * 512 + i]; }
    const int tfirst = bid * 64 + wid * 8;
    f32x4 z[4], zp[4], gwv[4], bwv[4];
#pragma unroll
    for (int q = 0; q < 4; ++q) { gwv[q] = *(const f32x4*)(g + RCOL(q, lane)); bwv[q] = *(const f32x4*)(be + RCOL(q, lane)); }
    Ln2Raw R[3];
    const int tbase = tfirst > 0 ? tfirst - 1 : 0;
    const int dpre = lane < 18 ? WS_(p, DEST)[2 * tbase + lane] : 0; const float gpre = lane < 18 ? WS_(p, GATE)[2 * tbase + lane] : 0.f;
    if (nk == 0) { if (tfirst > 0) { ln2_issue(p, tfirst - 1, lane, R[2], dpre, gpre, tbase); } }
    ln2_issue(p, tfirst, lane, R[0], dpre, gpre, tbase);
    ln2_issue(p, tfirst + 1, lane, R[1], dpre, gpre, tbase);
    if (nk == 0) { if (tfirst > 0) ln2_finish(R[2], gwv, bwv, zp); else { for (int q = 0; q < 4; ++q) zp[q] = (f32x4){0.f, 0.f, 0.f, 0.f}; } }
#pragma unroll
    for (int rr = 0; rr < 8; ++rr) {
        const int t = tfirst + rr; const size_t ro = (size_t)t * D;
        if (rr + 2 < 8) ln2_issue(p, t + 2, lane, R[(rr + 2) % 3], dpre, gpre, tbase);
        ln2_finish(R[rr % 3], gwv, bwv, z);
        if (nk == 3) {
#pragma unroll
            for (int q = 0; q < 4; ++q) *(f32x4*)(p.out + ro + RCOL(q, lane)) = z[q];
        } else store_row_bf(WS_(p, Hb) + ro, lane, z);
        if (nk == 0) {
            emit_mix6(p, nj, t, lane, z, zp);
#pragma unroll
            for (int q = 0; q < 4; ++q) zp[q] = z[q];
        }
    }
    if (nk == 1 || nk == 2) {
        asm volatile("s_waitcnt vmcnt(0)" ::: "memory");
        __syncthreads();
        const int nct = nk == 1 ? 2 : 1; const int rt = wid & 3, kh = wid >> 2;
        const bf16_t* Ab = WS_(p, Hb) + (size_t)(bid * 64 + 16 * rt + fr) * D + 512 * kh + 8 * fq;
        const bf16_t* Wb = (nk == 1 ? WS_(p, mb_dt_t) : WS_(p, gl_lr_t)) + (size_t)fr * D + 512 * kh + 8 * fq;
        f32x4 acc[2]; acc[0] = (f32x4){0.f, 0.f, 0.f, 0.f}; acc[1] = acc[0];
#pragma unroll 4
        for (int ks = 0; ks < 16; ++ks) {
            const bf16x8 af = *(const bf16x8*)(Ab + 32 * ks);
            acc[0] = MFMA16(af, *(const bf16x8*)(Wb + 32 * ks), acc[0]);
            if (nct == 2) acc[1] = MFMA16(af, *(const bf16x8*)(Wb + (size_t)16 * D + 32 * ks), acc[1]);
        }
#pragma unroll
        for (int ct = 0; ct < 2; ++ct)
#pragma unroll
            for (int r = 0; r < 4; ++r) lgt[(kh * 64 + 16 * rt + 4 * fq + r) * 32 + 16 * ct + fr] = acc[ct][r];
        __syncthreads();
        if (nk == 1) {
#pragma unroll
            for (int i = 0; i < 4; ++i) { const int idx = tid + i * NTHR; const int row = idx >> 5, o = idx & 31;
                WS_(p, DT)[(size_t)(bid * 64 + row) * 32 + o] = softplusf_(lgt[row * 32 + o] + lgt[(64 + row) * 32 + o] + p.mb_dt_bias[nj * 32 + o]); }
        } else {
            const int row = tid >> 3, c0 = (tid & 7) * 64; float lr[16];
#pragma unroll
            for (int o = 0; o < 16; ++o) lr[o] = lgt[row * 32 + o] + lgt[(64 + row) * 32 + o];
#pragma unroll 1
            for (int c4 = 0; c4 < 16; ++c4) { const int c = c0 + 4 * c4; f32x4 a = *(const f32x4*)(p.gl_gk_b + nj * 512 + c);
#pragma unroll
                for (int o = 0; o < 16; ++o) { const f32x4 wv = *(const LAS f32x4*)(w2 + o * 512 + c); a = a + wv * lr[o]; }
                f32x4 r;
#pragma unroll
                for (int e = 0; e < 4; ++e) r[e] = (fminf(a[e], 0.f) - __logf(1.0f + __expf(-fabsf(a[e])))) * (1.0f / 16.0f);
                *(f32x4*)(WS_(p, LA) + (size_t)(bid * 64 + row) * 512 + c) = r; }
        }
    }
}
constexpr int MB_PROJ = 5152;
struct SchedMbIn {
    const Params* p;
    DEV bool next(int i, Unit& u) const {
        int pm, pn; if (!pg8::tile_order(i, NB_, bid_(), 64, 20, pm, pn)) return false;
        u.A = (const char*)(WS_(*p, Hb) + (size_t)pm * 256 * D); u.B = (const char*)(WS_(*p, mb_win_t) + (size_t)pn * 256 * D); u.row0 = pm * 256; u.col0 = pn * 256; u.id = 0; u.aux = 0; return true;
    }
};
struct EpiMbIn {
    const Params* p;
    DEV void operator()(const AccT& acc, const Unit& u, int wr, int wc, int fr, int fq) const {
        const bool isz = u.col0 < 2048; bf16_t* O = WS_(*p, Z) + (isz ? (size_t)0 : (size_t)T * 2048 - 2048); const int ld = isz ? 2048 : 3072;
        FOR_ACC2(ai, bj, m) { st_bf8p(O + (size_t)ACC_ROW(u, ai, m) * ld + ACC_COL8P(u, bj, PF(4)), acc[ai][bj][m][0], acc[ai][bj][m][1], PF(4)); ACC_FENCE; }
    }
};
DEV void phase_mb_conv(const Params& p, int j) {
    const int tid = tid_(), bid = bid_(); (void)tid; (void)bid;
    if (tid >= 384) return;
    const int c0 = tid * 8; const int t0 = bid * 64;
    const float* cw = p.mb_conv_w + (size_t)j * 4 * 3072; const float* cb = p.mb_conv_b + (size_t)j * 3072;
    float w[4][8], b[8];
#pragma unroll
    for (int i = 0; i < 4; ++i) { const f32x4 a = *(const f32x4*)(cw + i * 3072 + c0), bb = *(const f32x4*)(cw + i * 3072 + c0 + 4); for (int e = 0; e < 4; ++e) { w[i][e] = a[e]; w[i][4 + e] = bb[e]; } }
    { const f32x4 a = *(const f32x4*)(cb + c0), bb = *(const f32x4*)(cb + c0 + 4); for (int e = 0; e < 4; ++e) { b[e] = a[e]; b[4 + e] = bb[e]; } }
    float x0[8], x1[8], x2[8], x3[8];
    auto ld = [&](int t, float (&x)[8]) {
        if (t < 0) { for (int e = 0; e < 8; ++e) x[e] = 0.f; return; }
        const u32x4 v = *(const u32x4*)(WS_(p, XBC) + (size_t)t * 3072 + c0);
        x[0] = bflo(v.x); x[1] = bfhi(v.x); x[2] = bflo(v.y); x[3] = bfhi(v.y); x[4] = bflo(v.z); x[5] = bfhi(v.z); x[6] = bflo(v.w); x[7] = bfhi(v.w);
    };
    ld(t0 - 3, x0); ld(t0 - 2, x1); ld(t0 - 1, x2);
#pragma unroll 4
    for (int tt = 0; tt < 64; ++tt) {
        ld(t0 + tt, x3);
        float o[8];
#pragma unroll
        for (int e = 0; e < 8; ++e) o[e] = siluf_(b[e] + w[0][e] * x0[e] + w[1][e] * x1[e] + w[2][e] * x2[e] + w[3][e] * x3[e]);
        u32x4 r; r.x = pk2(o[0], o[1]); r.y = pk2(o[2], o[3]); r.z = pk2(o[4], o[5]); r.w = pk2(o[6], o[7]);
        *(u32x4*)(WS_(p, XC) + (size_t)(t0 + tt) * 3072 + c0) = r;
#pragma unroll
        for (int e = 0; e < 8; ++e) { x0[e] = x1[e]; x1[e] = x2[e]; x2[e] = x3[e]; }
    }
}

DEV void mb_dacs(const Params& p, int j, int c, int g, LAS float* dts, LAS float* dacs) {
    const int tid = tid_(); const int lane = tid & 63, h = tid >> 6;
    const int hh = 8 * g + h; const float a = -__expf(p.mb_a_log[j * 32 + hh]);
    const float d0 = WS_(p, DT)[(size_t)(c * 128 + 2 * lane) * 32 + hh], d1 = WS_(p, DT)[(size_t)(c * 128 + 2 * lane + 1) * 32 + hh];
    const float a0 = d0 * a, a1 = d1 * a;
    float s = a0 + a1;
#pragma unroll
    for (int o = 1; o < 64; o <<= 1) { const float v = __shfl_up(s, o); if (lane >= o) s += v; }
    dts[h * 128 + 2 * lane] = d0; dts[h * 128 + 2 * lane + 1] = d1;
    dacs[h * 128 + 2 * lane] = s - a1; dacs[h * 128 + 2 * lane + 1] = s;
}
constexpr int LDB = 136;
constexpr int LDX = 72;
DEV void ld_tile128(const bf16_t* src, int gld, LAS bf16_t* dst) {
    const int tid = tid_();
    for (int i = tid; i < 128 * 16; i += NTHR) { const int r = i >> 4, c8 = (i & 15) * 8; *(LAS u32x4*)(dst + r * LDB + c8) = *(const u32x4*)(src + (size_t)r * gld + c8); }
}

DEV void phase_mb_states(const Params& p, int j, LAS unsigned char* lds) {
    const int tid = tid_(), bid = bid_(); (void)tid; (void)bid;
    const int lane = tid & 63, w = tid >> 6;
    LAS bf16_t* Bm = (LAS bf16_t*)lds;
    LAS bf16_t* Xh = Bm + 128 * LDB;
    LAS float* dts = (LAS float*)(Xh + 128 * LDX);
    LAS float* dacs = dts + 1024;
    for (int u = bid; u < 512; u += NB_) {
        const int c = u >> 2, g = u & 3; const int t0 = c * 128;
        lds_barrier();
        mb_dacs(p, j, c, g, dts, dacs);
        ld_tile128(WS_(p, XC) + (size_t)t0 * 3072 + 2048 + 128 * g, 3072, Bm);
        lds_barrier();
        if (tid < 8) WS_(p, CD)[(c * 32) + 8 * g + tid] = __expf(dacs[tid * 128 + 127]);
        bf16x8 bfr[4];
#pragma unroll
        for (int ks = 0; ks < 4; ++ks) bfr[ks] = frag_tr(Bm, LDB, 32 * ks, 16 * w, lane);
        for (int h = 0; h < 8; ++h) {
            { const int l = tid >> 2, p0 = (tid & 3) * 16; const float sc = dts[h * 128 + l] * __expf(dacs[h * 128 + 127] - dacs[h * 128 + l]);
              const bf16_t* src = WS_(p, XC) + (size_t)(t0 + l) * 3072 + 64 * (8 * g + h) + p0;
#pragma unroll
              for (int hf = 0; hf < 2; ++hf) { const u32x4 v = *(const u32x4*)(src + 8 * hf); u32x4 r;
                  r.x = pk2(bflo(v.x) * sc, bfhi(v.x) * sc); r.y = pk2(bflo(v.y) * sc, bfhi(v.y) * sc); r.z = pk2(bflo(v.z) * sc, bfhi(v.z) * sc); r.w = pk2(bflo(v.w) * sc, bfhi(v.w) * sc);
                  *(LAS u32x4*)(Xh + l * LDX + p0 + 8 * hf) = r; } }
            lds_barrier();
            f32x4 acc[4];
#pragma unroll
            for (int pb = 0; pb < 4; ++pb) { acc[pb] = (f32x4){0.f, 0.f, 0.f, 0.f};
#pragma unroll
                for (int ks = 0; ks < 4; ++ks) { const bf16x8 af = frag_tr(Xh, LDX, 32 * ks, 16 * pb, lane); acc[pb] = MFMA16(af, bfr[ks], acc[pb]); } }
            bf16_t* S = WS_(p, STATES) + (((size_t)c * 32 + 8 * g + h) * 64) * 128;
#pragma unroll
            for (int pb = 0; pb < 4; ++pb)
#pragma unroll
                for (int r = 0; r < 4; ++r) S[(size_t)(16 * pb + 4 * (lane >> 4) + r) * 128 + 16 * w + (lane & 15)] = (bf16_t)f2bf(acc[pb][r]);
            lds_barrier();
        }
    }
}
DEV void phase_mb_scan(const Params& p) {
    const int tid = tid_(), bid = bid_();
    if (tid >= 128) return;
    const int gid = bid * 128 + tid;
    const int n8 = gid & 15, pp = (gid >> 4) & 63, h = gid >> 10; const int n = 8 * n8;
    float r[8]; for (int e = 0; e < 8; ++e) r[e] = 0.f;
    const size_t eo = ((size_t)h * 64 + pp) * 128 + n;
    const size_t fo = (size_t)h * 64 * 128 + fragmajor_off(pp, n, 128);
#pragma unroll 8
    for (int c = 0; c < 128; ++c) {
        const u32x4 sr = *(const u32x4*)(WS_(p, STATES) + (size_t)c * 32 * 64 * 128 + eo);
        const float cd = WS_(p, CD)[c * 32 + h];
        u32x4 o; o.x = pk2(r[0], r[1]); o.y = pk2(r[2], r[3]); o.z = pk2(r[4], r[5]); o.w = pk2(r[6], r[7]);
        *(u32x4*)(WS_(p, PREV) + (size_t)c * 32 * 64 * 128 + fo) = o;
        r[0] = r[0] * cd + bflo(sr.x); r[1] = r[1] * cd + bfhi(sr.x); r[2] = r[2] * cd + bflo(sr.y); r[3] = r[3] * cd + bfhi(sr.y);
        r[4] = r[4] * cd + bflo(sr.z); r[5] = r[5] * cd + bfhi(sr.z); r[6] = r[6] * cd + bflo(sr.w); r[7] = r[7] * cd + bfhi(sr.w);
    }
}
DEV void phase_mb_out(const Params& p, int j, LAS unsigned char* lds) {
    const int tid = tid_(), bid = bid_(); (void)tid; (void)bid;
    const int lane = tid & 63, w = tid >> 6; const int fr = lane & 15, fq = lane >> 4;
    LAS bf16_t* Cm = (LAS bf16_t*)lds;
    LAS bf16_t* Bm = Cm + 128 * LDB;
    LAS bf16_t* Xh = Bm + 128 * LDB;
    LAS bf16_t* Mw = Xh + 128 * LDX;
    LAS float* dts = (LAS float*)(Mw + 8 * 16 * LDB);
    LAS float* dacs = dts + 1024;
    LAS bf16_t* Mme = Mw + w * 16 * LDB;
    for (int u = bid; u < 512; u += NB_) {
        const int c = u >> 2, g = u & 3; const int t0 = c * 128;
        lds_barrier();
        mb_dacs(p, j, c, g, dts, dacs);
        ld_tile128(WS_(p, XC) + (size_t)t0 * 3072 + 2048 + 512 + 128 * g, 3072, Cm);
        ld_tile128(WS_(p, XC) + (size_t)t0 * 3072 + 2048 + 128 * g, 3072, Bm);
        lds_barrier();
        f32x4 sc[8]; bf16x8 cf[4];
#pragma unroll
        for (int ks = 0; ks < 4; ++ks) cf[ks] = frag_rm(Cm, LDB, 16 * w, 32 * ks, lane);
#pragma unroll
        for (int sb = 0; sb < 8; ++sb) { sc[sb] = (f32x4){0.f, 0.f, 0.f, 0.f};
#pragma unroll
            for (int ks = 0; ks < 4; ++ks) sc[sb] = MFMA16(cf[ks], frag_rm(Bm, LDB, 16 * sb, 32 * ks, lane), sc[sb]); }
        float ssq = 0.f;
        const int rl = tid >> 2, p0 = (tid & 3) * 16;
        const LAS float* Yrow = (const LAS float*)(Mw + (rl >> 4) * 16 * LDB) + (rl & 15) * 68 + p0;
        LAS float* Yw = (LAS float*)Mme;
        u32x4 xraw[2], zraw[2], xnx[2], znx[2]; bf16x8 pfc[16];
#define MB_LOADH(HH, XR, ZR) do { const int hh_ = 8 * g + (HH); \
            XR[0] = *(const u32x4*)(WS_(p, XC) + (size_t)(t0 + rl) * 3072 + 64 * hh_ + p0); XR[1] = *(const u32x4*)(WS_(p, XC) + (size_t)(t0 + rl) * 3072 + 64 * hh_ + p0 + 8); \
            ZR[0] = *(const u32x4*)(WS_(p, Z) + (size_t)(t0 + rl) * 2048 + 64 * hh_ + p0); ZR[1] = *(const u32x4*)(WS_(p, Z) + (size_t)(t0 + rl) * 2048 + 64 * hh_ + p0 + 8); } while (0)
        MB_LOADH(0, xraw, zraw);
#pragma unroll 1
        for (int h = 0; h < 8; ++h) {
            const int hh = 8 * g + h;
            MB_LOADH(h < 7 ? h + 1 : h, xnx, znx);
            { const bf16_t* pv_ = WS_(p, PREV) + ((size_t)c * 32 + hh) * 64 * 128;
#pragma unroll
              for (int i_ = 0; i_ < 16; ++i_) pfc[i_] = *(const bf16x8*)(pv_ + ((size_t)i_ * 64 + lane) * 8); }
            { const float scl = dts[h * 128 + rl];
#pragma unroll
              for (int hf = 0; hf < 2; ++hf) { const u32x4 v = xraw[hf]; u32x4 r;
                  r.x = pk2(bflo(v.x) * scl, bfhi(v.x) * scl); r.y = pk2(bflo(v.y) * scl, bfhi(v.y) * scl); r.z = pk2(bflo(v.z) * scl, bfhi(v.z) * scl); r.w = pk2(bflo(v.w) * scl, bfhi(v.w) * scl);
                  *(LAS u32x4*)(Xh + rl * LDX + p0 + 8 * hf) = r; } }
            const u32x4 zraw0 = zraw[0], zraw1 = zraw[1];
            float dl[4];
#pragma unroll
            for (int r = 0; r < 4; ++r) dl[r] = dacs[h * 128 + 16 * w + 4 * fq + r];
#pragma unroll
            for (int sb = 0; sb < 8; ++sb) { const int s_ = 16 * sb + fr; const float ds = dacs[h * 128 + s_];
#pragma unroll
                for (int r = 0; r < 4; ++r) { const int l = 16 * w + 4 * fq + r; const float m = (s_ <= l) ? sc[sb][r] * __expf(dl[r] - ds) : 0.f; Mme[(4 * fq + r) * LDB + s_] = (bf16_t)f2bf(m); } }
            lds_barrier();
            bf16x8 mf[4];
#pragma unroll
            for (int ks = 0; ks < 4; ++ks) mf[ks] = frag_rm(Mme, LDB, 0, 32 * ks, lane);
            f32x4 yv[4];
#pragma unroll
            for (int pb = 0; pb < 4; ++pb) {
                f32x4 a = {0.f, 0.f, 0.f, 0.f}, o = {0.f, 0.f, 0.f, 0.f};
#pragma unroll
                for (int ks = 0; ks < 4; ++ks) {
                    a = MFMA16(mf[ks], frag_tr(Xh, LDX, 32 * ks, 16 * pb, lane), a);
                    o = MFMA16(cf[ks], pfc[pb * 4 + ks], o);
                }
#pragma unroll
                for (int r = 0; r < 4; ++r) a[r] += o[r] * __expf(dl[r]);
                yv[pb] = a;
            }
#pragma unroll
            for (int pb = 0; pb < 4; ++pb)
#pragma unroll
                for (int r = 0; r < 4; ++r) Yw[(4 * fq + r) * 68 + 16 * pb + fr] = yv[pb][r];
            lds_barrier();
            {
                const float dsk = p.mb_d[j * 32 + hh]; const float* ng = p.mb_norm_g + (size_t)j * 2048 + 64 * hh + p0;
                float y[16], xs[16], zz[16];
#pragma unroll
                for (int q = 0; q < 4; ++q) { const f32x4 t4 = *(const LAS f32x4*)(Yrow + 4 * q); y[4 * q] = t4[0]; y[4 * q + 1] = t4[1]; y[4 * q + 2] = t4[2]; y[4 * q + 3] = t4[3]; }
                xs[0] = bflo(xraw[0].x); xs[1] = bfhi(xraw[0].x); xs[2] = bflo(xraw[0].y); xs[3] = bfhi(xraw[0].y); xs[4] = bflo(xraw[0].z); xs[5] = bfhi(xraw[0].z); xs[6] = bflo(xraw[0].w); xs[7] = bfhi(xraw[0].w);
                xs[8] = bflo(xraw[1].x); xs[9] = bfhi(xraw[1].x); xs[10] = bflo(xraw[1].y); xs[11] = bfhi(xraw[1].y); xs[12] = bflo(xraw[1].z); xs[13] = bfhi(xraw[1].z); xs[14] = bflo(xraw[1].w); xs[15] = bfhi(xraw[1].w);
                zz[0] = bflo(zraw0.x); zz[1] = bfhi(zraw0.x); zz[2] = bflo(zraw0.y); zz[3] = bfhi(zraw0.y); zz[4] = bflo(zraw0.z); zz[5] = bfhi(zraw0.z); zz[6] = bflo(zraw0.w); zz[7] = bfhi(zraw0.w);
                zz[8] = bflo(zraw1.x); zz[9] = bfhi(zraw1.x); zz[10] = bflo(zraw1.y); zz[11] = bfhi(zraw1.y); zz[12] = bflo(zraw1.z); zz[13] = bfhi(zraw1.z); zz[14] = bflo(zraw1.w); zz[15] = bfhi(zraw1.w);
                float o[16];
#pragma unroll
                for (int q = 0; q < 4; ++q) { const f32x4 n4 = *(const f32x4*)(ng + 4 * q);
#pragma unroll
                    for (int e = 0; e < 4; ++e) { const int i = 4 * q + e; const float v = (y[i] + xs[i] * dsk) * siluf_(zz[i]); ssq += v * v; o[i] = v * n4[e]; } }
                bf16_t* dst = WS_(p, YB) + (size_t)(t0 + rl) * 2048 + 64 * hh + p0;
                u32x4 w0, w1; w0.x = pk2(o[0], o[1]); w0.y = pk2(o[2], o[3]); w0.z = pk2(o[4], o[5]); w0.w = pk2(o[6], o[7]); w1.x = pk2(o[8], o[9]); w1.y = pk2(o[10], o[11]); w1.z = pk2(o[12], o[13]); w1.w = pk2(o[14], o[15]);
                *(u32x4*)dst = w0; *(u32x4*)(dst + 8) = w1;
            }
            xraw[0] = xnx[0]; xraw[1] = xnx[1]; zraw[0] = znx[0]; zraw[1] = znx[1];
            lds_barrier();
        }
#undef MB_LOADH
        ssq += __shfl_xor(ssq, 1); ssq += __shfl_xor(ssq, 2);
        const float rstd = rsqrtf(ssq * (1.0f / 512.0f) + 1e-5f);
#pragma unroll 1
        for (int h = 0; h < 8; ++h) {
            bf16_t* dst = WS_(p, YB) + (size_t)(t0 + rl) * 2048 + 64 * (8 * g + h) + p0;
#pragma unroll
            for (int hf = 0; hf < 2; ++hf) { const u32x4 v = *(const u32x4*)(dst + 8 * hf); u32x4 r;
                r.x = pk2(bflo(v.x) * rstd, bfhi(v.x) * rstd); r.y = pk2(bflo(v.y) * rstd, bfhi(v.y) * rstd); r.z = pk2(bflo(v.z) * rstd, bfhi(v.z) * rstd); r.w = pk2(bflo(v.w) * rstd, bfhi(v.w) * rstd);
                *(u32x4*)(dst + 8 * hf) = r; }
        }
    }
}
constexpr int GL_PROJ = 3088;
constexpr int LDV = 264;
struct SchedGlIn {
    const Params* p;
    DEV bool next(int i, Unit& u) const {
        int pm, pn; if (!pg8::tile_order(i, NB_, bid_(), 64, 12, pm, pn)) return false;
        u.A = (const char*)(WS_(*p, Hb) + (size_t)pm * 256 * D); u.B = (const char*)(WS_(*p, gl_win_t) + (size_t)pn * 256 * D); u.row0 = pm * 256; u.col0 = pn * 256; u.id = 0; u.aux = 0; return true;
    }
};
struct EpiGlIn {
    const Params* p;
    DEV void operator()(const AccT& acc, const Unit& u, int wr, int wc, int fr, int fq) const {
        FOR_ACC2(ai, bj, m) { st_bf8p(WS_(*p, QKVG) + (size_t)ACC_ROW(u, ai, m) * 3072 + ACC_COL8P(u, bj, PF(5)), acc[ai][bj][m][0], acc[ai][bj][m][1], PF(5)); ACC_FENCE; }
    }
};
DEV void gl_bcs(const Params& p, int n, int h, LAS float* bcs) {
    const int tid = tid_();
    for (int i = tid; i < 64 * 32; i += NTHR) { const int r = i >> 5, c4 = (i & 31) * 4; *(LAS f32x4*)(bcs + r * 128 + c4) = *(const f32x4*)(WS_(p, LA) + (size_t)(n * 64 + r) * 512 + 128 * h + c4); }
    lds_barrier();
    if (tid < 128) { float s = 0.f; for (int r = 0; r < 64; ++r) { s += bcs[r * 128 + tid]; bcs[r * 128 + tid] = s; } }
    lds_barrier();
}
DEV void phase_gl_kv(const Params& p, LAS unsigned char* lds) {
    const int tid = tid_(), bid = bid_(); (void)tid; (void)bid;
    const int lane = tid & 63, w = tid >> 6;
    LAS float* bcs = (LAS float*)lds;
    LAS bf16_t* Ke = (LAS bf16_t*)(bcs + 64 * 128);
    LAS bf16_t* Vs = Ke + 64 * LDB;
    for (int u = bid; u < 1024; u += NB_) {
        const int n = u >> 2, h = u & 3; const int t0 = n * 64;
        lds_barrier();
        gl_bcs(p, n, h, bcs);
        for (int i = tid; i < 64 * 16; i += NTHR) { const int r = i >> 4, c8 = (i & 15) * 8;
            const u32x4 v = *(const u32x4*)(WS_(p, QKVG) + (size_t)(t0 + r) * 3072 + 512 + 128 * h + c8); float f[8];
            f[0] = bflo(v.x); f[1] = bfhi(v.x); f[2] = bflo(v.y); f[3] = bfhi(v.y); f[4] = bflo(v.z); f[5] = bfhi(v.z); f[6] = bflo(v.w); f[7] = bfhi(v.w);
#pragma unroll
            for (int e = 0; e < 8; ++e) f[e] *= __expf(bcs[63 * 128 + c8 + e] - bcs[r * 128 + c8 + e]);
            u32x4 o; o.x = pk2(f[0], f[1]); o.y = pk2(f[2], f[3]); o.z = pk2(f[4], f[5]); o.w = pk2(f[6], f[7]);
            *(LAS u32x4*)(Ke + r * LDB + c8) = o; }
        for (int i = tid; i < 64 * 32; i += NTHR) { const int r = i >> 5, c8 = (i & 31) * 8; *(LAS u32x4*)(Vs + r * LDV + c8) = *(const u32x4*)(WS_(p, QKVG) + (size_t)(t0 + r) * 3072 + 1024 + 256 * h + c8); }
        if (tid < 128) WS_(p, CDG)[((size_t)n * 4 + h) * 128 + tid] = __expf(bcs[63 * 128 + tid]);
        lds_barrier();
        bf16x8 af[2];
#pragma unroll
        for (int ks = 0; ks < 2; ++ks) af[ks] = frag_tr(Ke, LDB, 32 * ks, 16 * w, lane);
        bf16_t* O = WS_(p, STATES) + (((size_t)n * 4 + h) * 128) * 256;
#pragma unroll
        for (int vb = 0; vb < 16; ++vb) {
            f32x4 acc = {0.f, 0.f, 0.f, 0.f};
#pragma unroll
            for (int ks = 0; ks < 2; ++ks) acc = MFMA16(af[ks], frag_tr(Vs, LDV, 32 * ks, 16 * vb, lane), acc);
            { u32x2 o; o.x = pk2(acc[0], acc[1]); o.y = pk2(acc[2], acc[3]); *(u32x2*)(O + (size_t)(16 * vb + (lane & 15)) * 128 + 16 * w + 4 * (lane >> 4)) = o; }
        }
    }
}
DEV void phase_gl_scan(const Params& p) {
    const int tid = tid_(), bid = bid_();
    if (tid >= 64) return;
    const int gid = bid * 64 + tid;
    const int k8 = gid & 15, v = (gid >> 4) & 255, h = gid >> 12; const int k = 8 * k8;
    float r[8]; for (int e = 0; e < 8; ++e) r[e] = 0.f;
    const size_t fo = (size_t)h * 128 * 256 + fragmajor_off(v, k, 128);
#pragma unroll 8
    for (int n = 0; n < 256; ++n) {
        const u32x4 sr = *(const u32x4*)(WS_(p, STATES) + (((size_t)n * 4 + h) * 256 + v) * 128 + k);
        const f32x4 c0 = *(const f32x4*)(WS_(p, CDG) + ((size_t)n * 4 + h) * 128 + k), c1 = *(const f32x4*)(WS_(p, CDG) + ((size_t)n * 4 + h) * 128 + k + 4);
        u32x4 o; o.x = pk2(r[0], r[1]); o.y = pk2(r[2], r[3]); o.z = pk2(r[4], r[5]); o.w = pk2(r[6], r[7]);
        *(u32x4*)(WS_(p, PREV) + (size_t)n * 4 * 128 * 256 + fo) = o;
        r[0] = r[0] * c0[0] + bflo(sr.x); r[1] = r[1] * c0[1] + bfhi(sr.x); r[2] = r[2] * c0[2] + bflo(sr.y); r[3] = r[3] * c0[3] + bfhi(sr.y);
        r[4] = r[4] * c1[0] + bflo(sr.z); r[5] = r[5] * c1[1] + bfhi(sr.z); r[6] = r[6] * c1[2] + bflo(sr.w); r[7] = r[7] * c1[3] + bfhi(sr.w);
    }
}
DEV void phase_gl_out(const Params& p, int j, LAS unsigned char* lds) {
    const int tid = tid_(), bid = bid_(); (void)tid; (void)bid;
    const int lane = tid & 63, w = tid >> 6; const int fr = lane & 15, fq = lane >> 4;
    LAS float* bcs = (LAS float*)lds;
    LAS bf16_t* Qs = (LAS bf16_t*)(bcs + 64 * 128);
    LAS bf16_t* Ks = Qs + 64 * LDB;
    LAS bf16_t* Vs = Ks + 64 * LDB;
    LAS bf16_t* At = Vs + 64 * LDV;
    LAS float* red = (LAS float*)(At + 64 * LDX);
    for (int u = bid; u < 1024; u += NB_) {
        const int n = u >> 2, h = u & 3; const int t0 = n * 64;
        lds_barrier();
        gl_bcs(p, n, h, bcs);
        for (int i = tid; i < 64 * 16; i += NTHR) { const int r = i >> 4, c8 = (i & 15) * 8;
            const u32x4 vq = *(const u32x4*)(WS_(p, QKVG) + (size_t)(t0 + r) * 3072 + 128 * h + c8), vk = *(const u32x4*)(WS_(p, QKVG) + (size_t)(t0 + r) * 3072 + 512 + 128 * h + c8);
            float fq_[8], fk_[8];
            fq_[0] = bflo(vq.x); fq_[1] = bfhi(vq.x); fq_[2] = bflo(vq.y); fq_[3] = bfhi(vq.y); fq_[4] = bflo(vq.z); fq_[5] = bfhi(vq.z); fq_[6] = bflo(vq.w); fq_[7] = bfhi(vq.w);
            fk_[0] = bflo(vk.x); fk_[1] = bfhi(vk.x); fk_[2] = bflo(vk.y); fk_[3] = bfhi(vk.y); fk_[4] = bflo(vk.z); fk_[5] = bfhi(vk.z); fk_[6] = bflo(vk.w); fk_[7] = bfhi(vk.w);
#pragma unroll
            for (int e = 0; e < 8; ++e) { const float b = bcs[r * 128 + c8 + e]; fq_[e] *= __expf(b) * 0.08838834764831845f; fk_[e] *= __expf(-b); }
            u32x4 o; o.x = pk2(fq_[0], fq_[1]); o.y = pk2(fq_[2], fq_[3]); o.z = pk2(fq_[4], fq_[5]); o.w = pk2(fq_[6], fq_[7]);
            *(LAS u32x4*)(Qs + r * LDB + c8) = o;
            o.x = pk2(fk_[0], fk_[1]); o.y = pk2(fk_[2], fk_[3]); o.z = pk2(fk_[4], fk_[5]); o.w = pk2(fk_[6], fk_[7]);
            *(LAS u32x4*)(Ks + r * LDB + c8) = o; }
        for (int i = tid; i < 64 * 32; i += NTHR) { const int r = i >> 5, c8 = (i & 31) * 8; *(LAS u32x4*)(Vs + r * LDV + c8) = *(const u32x4*)(WS_(p, QKVG) + (size_t)(t0 + r) * 3072 + 1024 + 256 * h + c8); }
        lds_barrier();
        { const int ib = w >> 1;
#pragma unroll
          for (int jj = 0; jj < 2; ++jj) { const int jb = 2 * (w & 1) + jj; f32x4 a = {0.f, 0.f, 0.f, 0.f};
#pragma unroll
              for (int ks = 0; ks < 4; ++ks) a = MFMA16(frag_rm(Qs, LDB, 16 * ib, 32 * ks, lane), frag_rm(Ks, LDB, 16 * jb, 32 * ks, lane), a);
#pragma unroll
              for (int r = 0; r < 4; ++r) { const int i = 16 * ib + 4 * fq + r, jx = 16 * jb + fr; At[i * LDX + jx] = (bf16_t)f2bf(jx <= i ? a[r] : 0.f); } } }
        lds_barrier();
        f32x4 o[4][2];
        const bf16_t* pv = WS_(p, PREV) + ((size_t)n * 4 + h) * 128 * 256;
#pragma unroll
        for (int vv = 0; vv < 2; ++vv) { const int vb = 2 * w + vv;
            bf16x8 bi[2], bp[4];
#pragma unroll
            for (int ks = 0; ks < 2; ++ks) bi[ks] = frag_tr(Vs, LDV, 32 * ks, 16 * vb, lane);
#pragma unroll
            for (int ks = 0; ks < 4; ++ks) bp[ks] = *(const bf16x8*)(pv + ((size_t)(vb * 4 + ks) * 64 + lane) * 8);
#pragma unroll
            for (int ib = 0; ib < 4; ++ib) { f32x4 a = {0.f, 0.f, 0.f, 0.f};
#pragma unroll
                for (int ks = 0; ks < 2; ++ks) a = MFMA16(frag_rm(At, LDX, 16 * ib, 32 * ks, lane), bi[ks], a);
#pragma unroll
                for (int ks = 0; ks < 4; ++ks) a = MFMA16(frag_rm(Qs, LDB, 16 * ib, 32 * ks, lane), bp[ks], a);
                o[ib][vv] = a; } }
#pragma unroll
        for (int ib = 0; ib < 4; ++ib)
#pragma unroll
            for (int r = 0; r < 4; ++r) { float s = o[ib][0][r] * o[ib][0][r] + o[ib][1][r] * o[ib][1][r]; s = sum16(s); if (fr == 0) red[w * 64 + 16 * ib + 4 * fq + r] = s; }
        lds_barrier();
        {   LAS bf16_t* Os = (LAS bf16_t*)bcs;
#pragma unroll
            for (int ib = 0; ib < 4; ++ib)
#pragma unroll
                for (int vv = 0; vv < 2; ++vv)
#pragma unroll
                    for (int r = 0; r < 4; ++r) Os[(16 * ib + 4 * fq + r) * LDV + 32 * w + 16 * vv + fr] = (bf16_t)f2bf(o[ib][vv][r]);
            lds_barrier();
            const int row = tid >> 3, c0 = (tid & 7) * 32; const int t = t0 + row; float s = 0.f;
#pragma unroll
            for (int ww = 0; ww < 8; ++ww) s += red[ww * 64 + row];
            const float rs = rsqrtf(s * (1.0f / 256.0f) + 1e-5f);
#pragma unroll
            for (int q = 0; q < 4; ++q) {
                const u32x4 ov = *(const LAS u32x4*)(Os + row * LDV + c0 + 8 * q), gv = *(const u32x4*)(WS_(p, QKVG) + (size_t)t * 3072 + 2048 + 256 * h + c0 + 8 * q);
                const f32x4 n0 = *(const f32x4*)(p.gl_norm_g + j * 256 + c0 + 8 * q), n1 = *(const f32x4*)(p.gl_norm_g + j * 256 + c0 + 8 * q + 4);
                float r8[8];
                r8[0] = bflo(ov.x) * rs * n0[0] * siluf_(bflo(gv.x)); r8[1] = bfhi(ov.x) * rs * n0[1] * siluf_(bfhi(gv.x)); r8[2] = bflo(ov.y) * rs * n0[2] * siluf_(bflo(gv.y)); r8[3] = bfhi(ov.y) * rs * n0[3] * siluf_(bfhi(gv.y));
                r8[4] = bflo(ov.z) * rs * n1[0] * siluf_(bflo(gv.z)); r8[5] = bfhi(ov.z) * rs * n1[1] * siluf_(bfhi(gv.z)); r8[6] = bflo(ov.w) * rs * n1[2] * siluf_(bflo(gv.w)); r8[7] = bfhi(ov.w) * rs * n1[3] * siluf_(bfhi(gv.w));
                u32x4 wv; wv.x = pk2(r8[0], r8[1]); wv.y = pk2(r8[2], r8[3]); wv.z = pk2(r8[4], r8[5]); wv.w = pk2(r8[6], r8[7]);
                *(u32x4*)(WS_(p, YB) + (size_t)t * D + 256 * h + c0 + 8 * q) = wv;
            }
        }
    }
}
#define XB_TMO      128
#define XB_XCNT(j)  (256  + 64 * (j))
#define XB_XSUB(j)  (1280 + 64 * (j))
#define XB_XGEN(j)  (2304 + 64 * (j))
#define XB_TOP      3328
#define XB_TOPGEN   3392
#define XCD_BAR_WORDS 3456
#define XB_SPIN_CAP (1u << 22)
DEV unsigned xb_ld(unsigned* p)              { return __hip_atomic_load(p, __ATOMIC_RELAXED, __HIP_MEMORY_SCOPE_AGENT); }
DEV unsigned xb_add(unsigned* p, unsigned v) { return __hip_atomic_fetch_add(p, v, __ATOMIC_RELAXED, __HIP_MEMORY_SCOPE_AGENT); }
DEV unsigned xb_xcc_id() { return (unsigned)__builtin_amdgcn_s_getreg((3 << 11) | 20) & 0xFu; }
#define XB_SPIN(cond, bar) do { unsigned _sp = 0; while (cond) { __builtin_amdgcn_s_sleep(1); \
    if ((++_sp & 255u) == 0u) { if (xb_ld(&(bar)[XB_TMO])) break; if (_sp > XB_SPIN_CAP) { atomicAdd(&(bar)[XB_TMO], 1u); break; } } } } while (0)
struct XcdBarrier { unsigned* bar; unsigned x; volatile LAS unsigned* st; };
DEV XcdBarrier xcd_barrier_post(unsigned* bar, volatile LAS unsigned* st) {
    XcdBarrier b; b.bar = bar; b.x = xb_xcc_id(); b.st = st;
    if (threadIdx.x == 0) (void)xb_add(&bar[XB_XCNT(b.x)], 1u);
    return b;
}
DEV void xcd_barrier_complete(unsigned* bar, unsigned x, unsigned& nloc, unsigned& nx) {
    const unsigned G = gridDim.x * gridDim.y * gridDim.z;
    unsigned sum, cnt, mine, sp = 0u;
    for (;;) {
        sum = 0u; cnt = 0u; mine = 0u;
#pragma unroll
        for (unsigned j = 0; j < 16; ++j) { const unsigned c = xb_ld(&bar[XB_XCNT(j)]); sum += c; cnt += (c > 0u) ? 1u : 0u; mine = (j == x) ? c : mine; }
        if (sum == G) break;
        __builtin_amdgcn_s_sleep(1);
        if ((++sp & 255u) == 0u) { if (xb_ld(&bar[XB_TMO])) break; if (sp > XB_SPIN_CAP) { atomicAdd(&bar[XB_TMO], 1u); break; } }
    }
    nloc = mine > 0u ? mine : 1u; nx = cnt > 0u ? cnt : 1u;
}
DEV void xcd_barrier(const XcdBarrier& b) {
    asm volatile("s_waitcnt vmcnt(0)" ::: "memory");
    __syncthreads();
    if (threadIdx.x == 0) {
        unsigned* bar = b.bar;
        __builtin_amdgcn_s_waitcnt(0);
        unsigned nloc = b.st[0], nx = b.st[1];
        if (nloc == 0u) { xcd_barrier_complete(bar, b.x, nloc, nx); b.st[0] = nloc; b.st[1] = nx; }
        const unsigned old = xb_add(&bar[XB_XSUB(b.x)], 1u);
        const unsigned gen = old / nloc;
        if (old + 1u == (gen + 1u) * nloc) {
            __builtin_amdgcn_fence(__ATOMIC_RELEASE, "agent");
            asm volatile("s_waitcnt vmcnt(0)" ::: "memory");
            const unsigned og = xb_add(&bar[XB_TOP], 1u);
            const unsigned tg = og / nx;
            if (og + 1u == (tg + 1u) * nx) xb_add(&bar[XB_TOPGEN], 1u);
            else XB_SPIN(xb_ld(&bar[XB_TOPGEN]) == tg, bar);
            __builtin_amdgcn_fence(__ATOMIC_ACQUIRE, "agent");
            xb_add(&bar[XB_XGEN(b.x)], 1u);
            asm volatile("s_waitcnt vmcnt(0)" ::: "memory");
        } else {
            XB_SPIN(xb_ld(&bar[XB_XGEN(b.x)]) == gen, bar);
            __builtin_amdgcn_fence(__ATOMIC_ACQUIRE, "agent");
            asm volatile("s_waitcnt vmcnt(0)" ::: "memory");
        }
    }
    __syncthreads();
}

constexpr int RW1_TAIL_TILES = 3584, MOE1_SPLIT_TILES = 5632;
DEV void moe_tail_convert(const Params& p, LAS unsigned char* lds, int layer) {
    if (layer > 1) return;
    convert_tickets(moe_job(p, 0, layer + 1), moe_job(p, 1, layer + 1), lds, WS_(p, MFLAG) + MFLAG_TICKET * MFLAG_STRIDE, MFLAG_STRIDE, layer == 0 ? MOE1_SPLIT_TILES : 0);
}
DEV LAS int* moe_tab_to_lds(const Params& p, LAS unsigned char* lds) {
    LAS int* tab = (LAS int*)(lds + pg8::STAGE_BYTES);
    const int tid = tid_();
    if (tid < 256) tab[tid] = __hip_atomic_load(WS_(p, TAB) + tid, __ATOMIC_RELAXED, __HIP_MEMORY_SCOPE_AGENT);
    __syncthreads();
    return tab;
}
DEV void rw_side_convert(const Params& p, LAS unsigned char* lds, int c0, int n) {
#pragma unroll 1
    for (int c = c0; c < c0 + n; ++c) {
        const int ml = c == 0 ? 0 : c == 3 ? 1 : 3;
        const ConvJob J0 = (c == 1 || c == 2) ? make_job(p, 6 + 2 * c) : moe_job(p, 0, ml), J1 = (c == 1 || c == 2) ? make_job(p, 7 + 2 * c) : moe_job(p, 1, ml);
        const int t0 = (c == 0 || c == 4) ? RW1_TAIL_TILES : 0, t1 = c == 3 ? MOE1_SPLIT_TILES : 1 << 30;
        convert_tickets(J0, J1, lds, WS_(p, MFLAG) + (MFLAG_SIDE + 32 * c) * MFLAG_STRIDE, MFLAG_STRIDE, t0, t1);
    }
}
DEV void run_phase(const Params& pin, int op, int arg, LAS unsigned char* lds) {
    Params p = pin; { size_t z_ = 0; asm volatile("" : "+s"(z_)); p.ws = pin.ws + z_; }
    const int layer = arg; const int jj = layer / 3;
#ifdef ONLY_OP
    if (op != ONLY_OP) return;
#endif
#ifdef OPMASK
    if (!((OPMASK >> op) & 1ull)) return;
#endif
    switch (op) {
    case OP_CONVERT: phase_pre0(p); phase_convert(p, lds);
#ifdef DBG
        if (blockIdx.x == 0 && threadIdx.x < 24) WS_(p, TAB)[200 + threadIdx.x] = 0;
#endif
        break;
    case OP_PRE0: break;
    case OP_RW_GEMM1: { SchedRW1 S{&p, jj}; EpiRW1 E{&p}; pg8::gemm_phase(lds, 1024, S, E); }
        convert_tickets(moe_job(p, 0, layer), moe_job(p, 1, layer), lds, WS_(p, MFLAG) + (MFLAG_SIDE + 32 * (layer == 0 ? 5 : 6)) * MFLAG_STRIDE, MFLAG_STRIDE, 0, RW1_TAIL_TILES); break;
    case OP_RW_GEMM2: { SchedRW2 S{&p, jj}; EpiRW2 E{&p, jj}; pg8::gemm_phase(lds, 256, S, E); } break;
#ifdef REP_RW
#define REPL_(OPX) _Pragma("unroll 1") for (int rep_ = 0; rep_ < ((OPX) == REP_RW && layer == REP_L ? 2 : 1); ++rep_)
#else
#define REPL_(OPX)
#endif
#define RW_AC(FN, half, k) do { const int hs_ = (half) * 2048, tl_ = hs_ + 2048 - 64 * (k); \
        if (bid_() >= RW_NB) FN(p, jj, lds, hs_ + bid_() - RW_NB, tl_, RW_NW); else if ((k) > 0) { __syncthreads(); FN(p, jj, lds, tl_ + bid_(), hs_ + 2048, RW_NB); } } while (0)
    case OP_RW_CHA: if (bid_() >= RW_NB) phase_rw_cha(p, jj, lds, bid_() - RW_NB, 2048, RW_NW); __syncthreads(); rw_side_convert(p, lds, layer == 0 ? 0 : 4, 1); break;
    case OP_RW_CHB: if (bid_() < RW_NB) phase_rw_chb(p, lds, 0); RW_AC(phase_rw_cha, 1, 0); __syncthreads(); if (layer == 0) rw_side_convert(p, lds, 1, 2); break;
    case OP_RW_CHC: if (bid_() < RW_NB) phase_rw_chb(p, lds, 1); RW_AC(phase_rw_chc, 0, 0); break;
    case OP_RW_CHD: RW_AC(phase_rw_chc, 1, 8); __syncthreads(); if (layer == 0) rw_side_convert(p, lds, 3, 1); break;
    case OP_RW_OUT: { SchedOut S{WS_(p, YB), WS_(p, rw_wo_t) + (size_t)jj * D * D, 1024}; EpiOut E{WS_(p, MIXb)}; pg8::gemm_phase(lds, 1024, S, E); } break;
    case OP_LN1: phase_ln1(p, layer, lds); break;
    case OP_MOE_SCATTER: phase_moe_scatter(p, lds); break;
    case OP_MOE_GEMM1: { LAS int* tab = moe_tab_to_lds(p, lds);
#ifdef REP_MOE
#pragma unroll 1
        for (int rep_ = 0; rep_ < REP_MOE; ++rep_) {
#endif
        { SchedMoe<0> S{&p, layer, tab}; EpiMoe1 E{WS_(p, ACT), WS_(p, MFLAG)}; pg8::gemm_phase(lds, 1024, S, E); }
        { SchedMoe<1> S{&p, layer, tab}; EpiMoe2 E{WS_(p, YBUF)}; pg8::gemm_phase(lds, 512, S, E); }
#ifdef REP_MOE
        }
#endif
        moe_tail_convert(p, lds, layer); } break;
    case OP_MOE_GEMM2: break;
    case OP_LN2: phase_ln2(p, layer, lds); break;
    case OP_MB_GEMM_IN: { SchedMbIn S{&p}; EpiMbIn E{&p}; pg8::gemm_phase(lds, 1024, S, E); } break;
    case OP_MB_CONV: phase_mb_conv(p, jj); break;
    case OP_MB_STATES: phase_mb_states(p, jj, lds); break;
    case OP_MB_SCAN: phase_mb_scan(p); break;
    case OP_MB_OUT: phase_mb_out(p, jj, lds); break;
    case OP_MB_GEMM_OUT: { SchedOut S{WS_(p, YB), WS_(p, mb_wout_t) + (size_t)jj * D * 2048, 2048}; EpiOut E{WS_(p, MIXb)}; pg8::gemm_phase(lds, 2048, S, E); } break;
    case OP_GL_GEMM_IN: { SchedGlIn S{&p}; EpiGlIn E{&p}; pg8::gemm_phase(lds, 1024, S, E); } break;
    case OP_GL_KV: phase_gl_kv(p, lds); break;
    case OP_GL_SCAN: phase_gl_scan(p); break;
    case OP_GL_OUT: phase_gl_out(p, jj, lds); break;
    case OP_GL_GEMM_OUT: { SchedOut S{WS_(p, YB), WS_(p, gl_wout_t) + (size_t)jj * D * D, 1024}; EpiOut E{WS_(p, MIXb)}; pg8::gemm_phase(lds, 1024, S, E); } break;
    default: break;
    }
}

constexpr int NPHASES = 1 + 11 + 10 + 9 + 11;
DEV void decode_phase(int ph, int& op, int& layer) {
    if (ph < 1) { op = OP_CONVERT; layer = 0; return; }
    int q = ph - 1; layer = 0;
    if (q >= 11) { q -= 11; layer = 1; if (q >= 10) { q -= 10; layer = 2; if (q >= 9) { q -= 9; layer = 3; } } }
    const int kind = layer % 3; const int nmix = kind == 0 ? 7 : kind == 1 ? 6 : 5;
    if (q < nmix) op = (kind == 0 ? OP_RW_GEMM1 : kind == 1 ? OP_MB_GEMM_IN : OP_GL_GEMM_IN) + q;
    else { const int m = q - nmix; op = m < 3 ? OP_LN1 + m : OP_LN2; }
}

#define X(t, n) t n##_,
template <bool COOP>
__global__ void __launch_bounds__(NTHR, 2) mega(PARAM_LIST(X) const int ph0, const int ph1) {
#undef X
    Params p;
#define X(t, n) p.n = n##_;
    PARAM_LIST(X)
#undef X

    extern __shared__ __attribute__((aligned(16))) unsigned char smem_raw[];
    LAS unsigned char* lds = (LAS unsigned char*)smem_raw;
    if constexpr (COOP) {
        volatile LAS unsigned* st = (volatile LAS unsigned*)(lds + LDS_BYTES - 16);
        if (threadIdx.x == 0) { st[0] = 0u; st[1] = 0u; }
        __syncthreads();
        XcdBarrier xb = xcd_barrier_post(WS_(p, bar), st);
        if (ph0 < 0) cg::this_grid().sync();
        for (int ph = ph0; ph < ph1; ++ph) {
            int op, arg; decode_phase(ph, op, arg);
#ifdef REPEAT_MASK
            const int reps = 1 + (int)((REPEAT_MASK >> op) & 1ull);
#else
            const int reps = 1;
#endif
#pragma unroll 1
            for (int rep = 0; rep < reps; ++rep) {
                run_phase(p, op, arg, lds);
                if (ph + 1 < ph1 || rep + 1 < reps) { xcd_barrier(xb);
#ifdef BAR2
                    xcd_barrier(xb);
#endif
                }
            }
        }
#ifdef DBG
        xcd_barrier(xb);
#ifndef DBG_WORD
#define DBG_WORD 200
#endif
        { const int code = __hip_atomic_load(WS_(p, TAB) + DBG_WORD, __ATOMIC_RELAXED, __HIP_MEMORY_SCOPE_AGENT);
          for (size_t i = (size_t)blockIdx.x * NTHR + threadIdx.x; i < (size_t)T * D; i += (size_t)NB_ * NTHR) p.out[i] = 0.f;
          __syncthreads();
          if (blockIdx.x == 0 && threadIdx.x == 0) p.out[0] = sqrtf((float)DBG_DECODE(code) * 1.68e7f); }
#endif
    } else {
        for (int ph = ph0; ph < ph1; ++ph) { int op, arg; decode_phase(ph, op, arg); run_phase(p, op, arg, lds); }
    }
}


extern "C" void kernel_launch(void* const* d_in, const int* in_sizes, int n_in, void* d_out, int out_size, void* d_ws, size_t ws_size, hipStream_t stream) {
    (void)in_sizes; (void)n_in; (void)out_size;
    Params p; std::memset((void*)&p, 0, sizeof(p));
    auto F = [&](int i) { return (const float*)d_in[i]; };
    p.x = F(0); p.ln_g = F(1); p.ln_b = F(2);
    p.rw_mu = F(3); p.rw_w_rkv = F(4); p.rw_w0 = F(5); p.rw_w1 = F(6); p.rw_w2 = F(7); p.rw_a0 = F(8);
    p.rw_a1 = F(9); p.rw_a2 = F(10); p.rw_g1 = F(11); p.rw_g2 = F(12);
    p.rw_k_k = F(13); p.rw_k_a = F(14); p.rw_r_k = F(15); p.rw_lnx_g = F(16); p.rw_lnx_b = F(17); p.rw_w_o = F(18);
    p.mb_w_in = F(19); p.mb_conv_w = F(20); p.mb_conv_b = F(21); p.mb_dt_bias = F(22); p.mb_a_log = F(23); p.mb_d = F(24); p.mb_norm_g = F(25); p.mb_w_out = F(26);
    p.gl_w_in = F(27); p.gl_gk_w2 = F(28); p.gl_gk_b = F(29); p.gl_norm_g = F(30); p.gl_w_out = F(31);
    p.moe_w_group = F(32); p.moe_b_group = F(33); p.moe_w_route = F(34); p.moe_b_route = F(35); p.moe_w_in = F(36); p.moe_w_down = F(37);
    p.out = (float*)d_out;
    p.ws = (char*)d_ws;
    if (WS_TOTAL > ws_size) { fprintf(stderr, "workspace too small: need %zu have %zu\n", (size_t)WS_TOTAL, ws_size); return; }
    unsigned* bar_ptr = (unsigned*)(p.ws + OFF_bar);
    const int np = NPHASES;
#define X(t, n) (void*)&p.n,
#if SINGLE_LAUNCH
    (void)hipFuncSetAttribute((const void*)mega<true>, hipFuncAttributeMaxDynamicSharedMemorySize, LDS_BYTES);
    (void)hipMemsetAsync(bar_ptr, 0, XCD_BAR_WORDS * sizeof(unsigned), stream);
    int ph0 = 0, ph1 = np; void* args[] = {PARAM_LIST(X) (void*)&ph0, (void*)&ph1};
    hipError_t e = hipLaunchCooperativeKernel((const void*)mega<true>, dim3(NBLK), dim3(NTHR), args, LDS_BYTES, stream);
    if (e != hipSuccess) fprintf(stderr, "cooperative launch failed: %s\n", hipGetErrorString(e));
#else
    (void)hipFuncSetAttribute((const void*)mega<false>, hipFuncAttributeMaxDynamicSharedMemorySize, LDS_BYTES);
    for (int ph = 0; ph < np; ++ph) { int ph0 = ph, ph1 = ph + 1; void* args[] = {PARAM_LIST(X) (void*)&ph0, (void*)&ph1};
        hipError_t e = hipLaunchKernel((const void*)mega<false>, dim3(NBLK), dim3(NTHR), args, LDS_BYTES, stream);
        if (e != hipSuccess) fprintf(stderr, "launch failed: %s\n", hipGetErrorString(e)); }
#endif
#undef X
}
```

```cpp
#include <hip/hip_runtime.h>
#include <hip/hip_cooperative_groups.h>
#include <cstdint>
#include <cstdio>
#include <cstring>
namespace cg = cooperative_groups;

typedef unsigned short bf16_t;
typedef short bf16x8 __attribute__((ext_vector_type(8)));
typedef short s16x4 __attribute__((ext_vector_type(4)));
typedef float f32x4 __attribute__((ext_vector_type(4)));
typedef float f32x2 __attribute__((ext_vector_type(2)));
typedef unsigned u32x4 __attribute__((ext_vector_type(4)));
typedef unsigned u32x2 __attribute__((ext_vector_type(2)));
#define LAS __attribute__((address_space(3)))
#define DEV __device__ __forceinline__

constexpr int T = 16384, D = 1024, DEPTH = 4;
constexpr int NTHR = 512, NBLK = 256;
constexpr int LDS_BYTES = 155648;
constexpr float ALPHA = 1.681792830507429f;
constexpr float LN_EPS = 1e-5f;
constexpr int MOE_ROWS = 40960;

DEV int tid_() { int t = threadIdx.x; asm volatile("" : "+v"(t)); return t; }
DEV int bid_() { int b = blockIdx.x; asm volatile("" : "+s"(b)); return b; }
#define NB_ 256
#define RCOL(q, lane) ((((q) >> 1) * 512) + 8 * (lane) + 4 * ((q) & 1))
DEV void lds_barrier() { asm volatile("s_waitcnt lgkmcnt(0)" ::: "memory"); __builtin_amdgcn_s_barrier(); asm volatile("" ::: "memory"); }
DEV unsigned f2bf(float f) { unsigned u = __float_as_uint(f); u += 0x7FFFu + ((u >> 16) & 1u); return u >> 16; }
DEV float bf2f(unsigned short b) { return __uint_as_float(((unsigned)b) << 16); }
typedef __bf16 bf16n2 __attribute__((ext_vector_type(2)));
DEV unsigned pk2(float lo, float hi) { f32x2 v = {lo, hi}; bf16n2 b = __builtin_convertvector(v, bf16n2); return __builtin_bit_cast(unsigned, b); }
DEV float bflo(unsigned u) { return __uint_as_float(u << 16); }
DEV float bfhi(unsigned u) { return __uint_as_float(u & 0xFFFF0000u); }
DEV float sigmoidf_(float x) { return 1.0f / (1.0f + __expf(-x)); }
DEV float siluf_(float x) { return x / (1.0f + __expf(-x)); }
DEV float softplusf_(float x) { return fmaxf(x, 0.f) + __logf(1.0f + __expf(-fabsf(x))); }
DEV float tanhf_(float x) { const float e = __expf(-2.0f * fabsf(x)); const float r = (1.0f - e) / (1.0f + e); return x < 0.f ? -r : r; }
DEV float wave_sum(float v) {
#pragma unroll
    for (int o = 32; o > 0; o >>= 1) v += __shfl_xor(v, o);
    return v;
}
DEV float sum16(float v) {
#pragma unroll
    for (int o = 8; o > 0; o >>= 1) v += __shfl_xor(v, o);
    return v;
}
template <int N> DEV float reduce_scatter(float (&v)[N], int lane) {
    int s = 1;
#pragma unroll
    for (int h = N / 2; h >= 1; h >>= 1) {
#pragma unroll
        for (int i = 0; i < h; ++i) {
            const bool up = (lane & s) != 0;
            const float send = up ? v[i] : v[i + h];
            const float keep = up ? v[i + h] : v[i];
            v[i] = keep + __shfl_xor(send, s);
        }
        s <<= 1;
    }
    float r = v[0];
    for (; s < 64; s <<= 1) r += __shfl_xor(r, s);
    return r;
}
template <int N> DEV int rs_index(int lane) {
    int o = 0, s = 1;
#pragma unroll
    for (int h = N / 2; h >= 1; h >>= 1) { if (lane & s) o += h; s <<= 1; }
    return o;
}

DEV bf16x8 frag_rm(const LAS bf16_t* base, int ld, int row0, int k0, int lane) {
    return *(const LAS bf16x8*)(base + (row0 + (lane & 15)) * ld + k0 + 8 * (lane >> 4));
}
DEV bf16x8 frag_tr(const LAS bf16_t* base, int ld, int k0, int c0, int lane) {
    const int g = lane >> 4, i = lane & 15, q = i >> 2, p = i & 3;
    const LAS bf16_t* a = base + (k0 + 8 * g + q) * ld + c0 + 4 * p;
    s16x4 lo = __builtin_amdgcn_ds_read_tr16_b64_v4i16((LAS s16x4*)a);
    s16x4 hi = __builtin_amdgcn_ds_read_tr16_b64_v4i16((LAS s16x4*)(a + 4 * ld));
    bf16x8 r; r[0] = lo[0]; r[1] = lo[1]; r[2] = lo[2]; r[3] = lo[3]; r[4] = hi[0]; r[5] = hi[1]; r[6] = hi[2]; r[7] = hi[3];
    return r;
}
#define MFMA16(a, b, c) __builtin_amdgcn_mfma_f32_16x16x32_bf16((a), (b), (c), 0, 0, 0)
DEV size_t fragmajor_off(int n, int k, int K) { return ((size_t)((n >> 4) * (K >> 5) + (k >> 5)) * 64 + (n & 15) + 16 * ((k & 31) >> 3)) * 8 + (k & 7); }

template <int N> DEV void skinny_group(const f32x4 (&z)[4], const LAS float* wt, int lane, LAS float* outw) {
    float pe[N];
#pragma unroll
    for (int o = 0; o < N; ++o) {
        float a = 0.f;
#pragma unroll
        for (int q = 0; q < 4; ++q) { const f32x4 w = *(const LAS f32x4*)(wt + o * 1028 + RCOL(q, lane)); a += z[q][0] * w[0] + z[q][1] * w[1] + z[q][2] * w[2] + z[q][3] * w[3]; }
        pe[o] = a;
    }
    const float r = reduce_scatter<N>(pe, lane);
    if (lane < N) outw[rs_index<N>(lane)] = r;
}
#ifndef SINGLE_LAUNCH
#define SINGLE_LAUNCH 1
#endif
constexpr size_t OFF_bar = 0ull;
constexpr size_t OFF_rw_rkv_t = 13824ull;
constexpr size_t OFF_rw_w1_t = 12596736ull;
constexpr size_t OFF_rw_a1_t = 13645312ull;
constexpr size_t OFF_rw_g1_t = 14693888ull;
constexpr size_t OFF_rw_w2_t = 15742464ull;
constexpr size_t OFF_rw_a2_t = 16791040ull;
constexpr size_t OFF_rw_g2_t = 17839616ull;
constexpr size_t OFF_rw_wo_t = 18888192ull;
constexpr size_t OFF_mb_win_t = 23082496ull;
constexpr size_t OFF_mb_wout_t = 33568256ull;
constexpr size_t OFF_gl_win_t = 37762560ull;
constexpr size_t OFF_gl_wout_t = 44054016ull;
constexpr size_t OFF_moe_w1_t = 46151168ull;
constexpr size_t OFF_moe_w2_t = 314586624ull;
constexpr size_t OFF_H = 448804352ull;
constexpr size_t OFF_H1 = 515913216ull;
constexpr size_t OFF_MIX = 583022080ull;
constexpr size_t OFF_BUF = 650130944ull;
constexpr size_t OFF_ACT = 734017024ull;
constexpr size_t OFF_YBUF = 775960064ull;
constexpr size_t OFF_CNT = 859846144ull;
constexpr size_t OFF_EIDX = 859878912ull;
constexpr size_t OFF_GATE = 860009984ull;
constexpr size_t OFF_DEST = 860141056ull;
constexpr size_t OFF_TAB = 860272128ull;
constexpr size_t OFF_YB = 860273152ull;
constexpr size_t OFF_X6 = 927382016ull;
constexpr size_t OFF_Rr = 1128708608ull;
constexpr size_t OFF_Kk = 1195817472ull;
constexpr size_t OFF_Vv = 1262926336ull;
constexpr size_t OFF_LW = 1330035200ull;
constexpr size_t OFF_Wd = 1355201024ull;
constexpr size_t OFF_Aa = 1422309888ull;
constexpr size_t OFF_Gg = 1489418752ull;
constexpr size_t OFF_RWf = 1556527616ull;
constexpr size_t OFF_RBf = 1590082048ull;
constexpr size_t OFF_RUt = 1623636480ull;
constexpr size_t OFF_RNa = 1657190912ull;
constexpr size_t OFF_RGc = 1690745344ull;
constexpr size_t OFF_RUa = 1691793920ull;
constexpr size_t OFF_RS0 = 1725348352ull;
constexpr size_t OFF_Z = 960936448ull;
constexpr size_t OFF_XBC = 1028045312ull;
constexpr size_t OFF_XC = 1128708608ull;
constexpr size_t OFF_DT = 1229371904ull;
constexpr size_t OFF_STATES = 1231469056ull;
constexpr size_t OFF_CD = 1365686784ull;
constexpr size_t OFF_PREV = 1365703168ull;
constexpr size_t OFF_LA = 1432812032ull;
constexpr size_t OFF_CDG = 1466366464ull;
constexpr size_t OFF_QKVG = OFF_XBC;
constexpr size_t WS_TOTAL = 1758902784ull;
typedef unsigned T_bar;
typedef bf16_t T_rw_rkv_t;
typedef bf16_t T_rw_w1_t;
typedef bf16_t T_rw_a1_t;
typedef bf16_t T_rw_g1_t;
typedef bf16_t T_rw_w2_t;
typedef bf16_t T_rw_a2_t;
typedef bf16_t T_rw_g2_t;
typedef bf16_t T_rw_wo_t;
typedef bf16_t T_mb_win_t;
typedef bf16_t T_mb_wout_t;
typedef bf16_t T_gl_win_t;
typedef bf16_t T_gl_wout_t;
typedef bf16_t T_moe_w1_t;
typedef bf16_t T_moe_w2_t;
typedef float T_H;
typedef float T_H1;
typedef float T_MIX;
typedef bf16_t T_BUF;
typedef bf16_t T_ACT;
typedef bf16_t T_YBUF;
typedef int T_CNT;
typedef int T_EIDX;
typedef float T_GATE;
typedef int T_DEST;
typedef int T_TAB;
typedef bf16_t T_YB;
typedef bf16_t T_X6;
typedef float T_Rr;
typedef float T_Kk;
typedef float T_Vv;
typedef bf16_t T_LW;
typedef float T_Wd;
typedef float T_Aa;
typedef float T_Gg;
typedef bf16_t T_RWf;
typedef bf16_t T_RBf;
typedef bf16_t T_RUt;
typedef bf16_t T_RNa;
typedef float T_RGc;
typedef bf16_t T_RUa;
typedef bf16_t T_RS0;
typedef bf16_t T_Z;
typedef bf16_t T_XBC;
typedef bf16_t T_XC;
typedef float T_DT;
typedef bf16_t T_STATES;
typedef float T_CD;
typedef bf16_t T_PREV;
typedef float T_LA;
typedef float T_CDG;
typedef bf16_t T_QKVG;
#define WS_(P, N) ((T_##N*)((P).ws + OFF_##N))
constexpr size_t OFF_Hb = OFF_H, OFF_H1b = OFF_H1, OFF_MIXb = OFF_MIX;
typedef bf16_t T_Hb; typedef bf16_t T_H1b; typedef bf16_t T_MIXb;
constexpr size_t OFF_moe_wr_t = OFF_H + 33554432ull;
typedef bf16_t T_moe_wr_t;
constexpr size_t OFF_mb_dt_t = OFF_moe_wr_t + 4ull * 48 * 1024 * 2, OFF_gl_lr_t = OFF_mb_dt_t + 32ull * 1024 * 2;
typedef bf16_t T_mb_dt_t; typedef bf16_t T_gl_lr_t;
constexpr size_t OFF_MFLAG = OFF_gl_lr_t + 16ull * 1024 * 2;
typedef unsigned T_MFLAG;
constexpr int MFLAG_STRIDE = 16, MFLAG_TICKET = 256, MFLAG_SIDE = 320;
constexpr size_t OFF_RBST = OFF_MFLAG + 65536;
typedef f32x4 T_RBST;
constexpr size_t OFF_Rb = OFF_Rr, OFF_Kb = OFF_Kk, OFF_Vb = OFF_Vv, OFF_Ab = OFF_Aa, OFF_Gb = OFF_Gg;
typedef bf16_t T_Rb; typedef bf16_t T_Kb; typedef bf16_t T_Vb; typedef bf16_t T_Ab; typedef bf16_t T_Gb;
constexpr size_t OFF_Wb = OFF_Wd; typedef bf16_t T_Wb;
struct ConvJob {
    const float* src; bf16_t* dst;
    int K, N, src_ld, Kpad, Npad, perm, batch;
    long long src_bs, dst_bs;
    DEV int ntiles() const { return (Kpad / 64) * (Npad / 64) * batch; }
};
#ifndef PERMF
#define PERMF 0xDF
#endif
#define PF(bit) (((PERMF) >> (bit)) & 1)
constexpr int NJOBS = 16;
constexpr int MOE_SPLIT = 32;

#define PARAM_LIST(X) \
    X(const float*, x) X(const float*, ln_g) X(const float*, ln_b) \
    X(const float*, rw_mu) X(const float*, rw_w_rkv) X(const float*, rw_w0) X(const float*, rw_w1) X(const float*, rw_w2) X(const float*, rw_a0) X(const float*, rw_a1) X(const float*, rw_a2) \
    X(const float*, rw_g1) X(const float*, rw_g2) X(const float*, rw_k_k) X(const float*, rw_k_a) X(const float*, rw_r_k) X(const float*, rw_lnx_g) X(const float*, rw_lnx_b) X(const float*, rw_w_o) \
    X(const float*, mb_w_in) X(const float*, mb_conv_w) X(const float*, mb_conv_b) X(const float*, mb_dt_bias) X(const float*, mb_a_log) X(const float*, mb_d) X(const float*, mb_norm_g) X(const float*, mb_w_out) \
    X(const float*, gl_w_in) X(const float*, gl_gk_w2) X(const float*, gl_gk_b) X(const float*, gl_norm_g) X(const float*, gl_w_out) \
    X(const float*, moe_w_group) X(const float*, moe_b_group) X(const float*, moe_w_route) X(const float*, moe_b_route) X(const float*, moe_w_in) X(const float*, moe_w_down) \
    X(float*, out) X(char*, ws)
struct Params {
#define X(t, n) t n;
    PARAM_LIST(X)
#undef X
};

enum Op : unsigned char { OP_CONVERT = 0, OP_PRE0, OP_RW_GEMM1, OP_RW_GEMM2, OP_RW_CHA, OP_RW_CHB, OP_RW_CHC, OP_RW_CHD, OP_RW_OUT,
    OP_LN1, OP_MOE_SCATTER, OP_MOE_GEMM1, OP_MOE_GEMM2, OP_LN2,
    OP_MB_GEMM_IN, OP_MB_CONV, OP_MB_STATES, OP_MB_SCAN, OP_MB_OUT, OP_MB_GEMM_OUT,
    OP_GL_GEMM_IN, OP_GL_KV, OP_GL_SCAN, OP_GL_OUT, OP_GL_GEMM_OUT };


DEV ConvJob make_job(const Params& p, int q) {
    const long long DD = (long long)D * D;
    switch (q) {
    case 0: return ConvJob{p.rw_w_rkv, WS_(p, rw_rkv_t), 1024, 1024, 1024, 1024, 1024, 0 | 2 * PF(0), 6, DD, DD};
    case 1: return ConvJob{p.rw_w1, WS_(p, rw_w1_t), 1024, 64, 64, 1024, 256, 0 | 2 * PF(1), 2, (long long)D * 64, (long long)256 * D};
    case 2: return ConvJob{p.rw_a1, WS_(p, rw_a1_t), 1024, 64, 64, 1024, 256, 0 | 2 * PF(1), 2, (long long)D * 64, (long long)256 * D};
    case 3: return ConvJob{p.rw_g1, WS_(p, rw_g1_t), 1024, 160, 160, 1024, 256, 0 | 2 * PF(1), 2, (long long)D * 160, (long long)256 * D};
    case 4: return ConvJob{p.rw_w2, WS_(p, rw_w2_t), 64, 1024, 1024, 256, 1024, 0 | 2 * PF(2), 2, (long long)64 * D, (long long)D * 256};
    case 5: return ConvJob{p.rw_a2, WS_(p, rw_a2_t), 64, 1024, 1024, 256, 1024, 0 | 2 * PF(2), 2, (long long)64 * D, (long long)D * 256};
    case 6: return ConvJob{p.rw_g2, WS_(p, rw_g2_t), 160, 1024, 1024, 256, 1024, 0 | 2 * PF(2), 2, (long long)160 * D, (long long)D * 256};
    case 7: return ConvJob{p.rw_w_o, WS_(p, rw_wo_t), 1024, 1024, 1024, 1024, 1024, 0 | 2 * PF(3), 2, DD, DD};
    case 8: return ConvJob{p.mb_w_in, WS_(p, mb_win_t), 1024, 5120, 5152, 1024, 5120, 0 | 2 * PF(4), 1, 0, 0};
    case 9: return ConvJob{p.mb_w_out, WS_(p, mb_wout_t), 2048, 1024, 1024, 2048, 1024, 0 | 2 * PF(3), 1, 0, 0};
    case 10: return ConvJob{p.gl_w_in, WS_(p, gl_win_t), 1024, 3072, 3088, 1024, 3072, 0 | 2 * PF(5), 1, 0, 0};
    case 11: return ConvJob{p.gl_w_out, WS_(p, gl_wout_t), 1024, 1024, 1024, 1024, 1024, 0 | 2 * PF(3), 1, 0, 0};
    case 12: return ConvJob{p.moe_w_in, WS_(p, moe_w1_t), 1024, 1024, 1024, 1024, 1024, 1 | 2 * PF(6), MOE_SPLIT, DD, DD};
    case 13: return ConvJob{p.moe_w_down, WS_(p, moe_w2_t), 512, 1024, 1024, 512, 1024, 0 | 2 * PF(7), MOE_SPLIT, (long long)512 * 1024, (long long)1024 * 512};
    case 14: return ConvJob{p.moe_w_in + (size_t)MOE_SPLIT * DD, WS_(p, moe_w1_t) + (size_t)MOE_SPLIT * DD, 1024, 1024, 1024, 1024, 1024, 1 | 2 * PF(6), 128 - MOE_SPLIT, DD, DD};
    default: return ConvJob{p.moe_w_down + (size_t)MOE_SPLIT * 512 * 1024, WS_(p, moe_w2_t) + (size_t)MOE_SPLIT * 512 * 1024, 512, 1024, 1024, 512, 1024, 0 | 2 * PF(7), 128 - MOE_SPLIT, (long long)512 * 1024, (long long)1024 * 512};
    }
}

DEV void convert_tile(const ConvJob& J, LAS bf16_t* tile, int local, int lane) {
    const int tk = J.Kpad / 64, tn = J.Npad / 64;
    const int b = local / (tk * tn); local -= b * tk * tn;
    const int nt = local / tk, kt = local - nt * tk;
    const float* src = J.src + (size_t)b * J.src_bs;
    bf16_t* dst = J.dst + (size_t)b * J.dst_bs;
    const int k0 = kt * 64, n0 = nt * 64;
    const int nn = (lane & 15) * 4; const bool nok = n0 + nn < J.N;
    f32x4 v[16];
#pragma unroll
    for (int i = 0; i < 16; ++i) { const int kk = (lane >> 4) + 4 * i; v[i] = (nok && k0 + kk < J.K) ? *(const f32x4*)(src + (size_t)(k0 + kk) * J.src_ld + n0 + nn) : (f32x4){0.f, 0.f, 0.f, 0.f}; }
#pragma unroll
    for (int i = 0; i < 16; ++i) { const int kk = (lane >> 4) + 4 * i;
#pragma unroll
        for (int e = 0; e < 4; ++e) tile[(nn + e) * 72 + kk] = (bf16_t)f2bf(v[i][e]); }
#pragma unroll
    for (int i = 0; i < 8; ++i) { const int r = (lane >> 3) + 8 * i, kc = (lane & 7) * 8;
        int nsrc = n0 + r, ndst = nsrc;
        if (J.perm & 1) { const int up = nsrc >= 512, jj = nsrc - (up ? 512 : 0); ndst = (jj >> 7) * 256 + (up ? 128 : 0) + (jj & 127); }
        if (J.perm & 2) { const int cc = ndst & 31; ndst = (ndst & ~31) | (((cc >> 2) & 1) << 4) | ((cc >> 3) << 2) | (cc & 3); }
        *(u32x4*)(dst + (size_t)ndst * J.Kpad + k0 + kc) = *(const LAS u32x4*)(tile + r * 72 + kc); }
}
DEV void convert_one(const ConvJob& J, LAS unsigned char* lds, int B0, int NBW, int tbeg, int WL = 8) {
    const int tid = tid_(), bid = bid_();
    const int lane = tid & 63, wv = tid >> 6; const int gw = (bid - B0) * WL + wv, NW = NBW * WL;
    if (wv >= WL) return;
    LAS bf16_t* tile = (LAS bf16_t*)lds + wv * (64 * 72);
    const int jend = tbeg + J.ntiles();
    const int ti0 = tbeg + ((gw - tbeg) % NW + NW) % NW;
#pragma unroll 1
    for (int ti = ti0; ti < jend; ti += NW) convert_tile(J, tile, ti - tbeg, lane);
}
DEV void convert_tickets(const ConvJob& J0, const ConvJob& J1, LAS unsigned char* lds, unsigned* ctrs, int stride, int t0 = 0, int t1 = 1 << 30) {
    constexpr int NG = 32;
    const int tid = tid_(); const int lane = tid & 63, wv = tid >> 6; const int g = bid_() & (NG - 1);
    unsigned* ctr = ctrs + g * stride;
    LAS bf16_t* tile = (LAS bf16_t*)lds + wv * (64 * 72);
    const int n0 = J0.ntiles(); const int n = t1 < n0 + J1.ntiles() ? t1 : n0 + J1.ntiles();
    int cur = 0; if (lane == 0) cur = (int)__hip_atomic_fetch_add(ctr, 1u, __ATOMIC_RELAXED, __HIP_MEMORY_SCOPE_AGENT);
    cur = t0 + __builtin_amdgcn_readfirstlane(cur) * NG + g;
#pragma unroll 1
    while (cur < n) {
        int nx = 0; if (lane == 0) nx = (int)__hip_atomic_fetch_add(ctr, 1u, __ATOMIC_RELAXED, __HIP_MEMORY_SCOPE_AGENT);
        const bool first = cur < n0; const ConvJob J = first ? J0 : J1;
        convert_tile(J, tile, first ? cur : cur - n0, lane);
        cur = t0 + __builtin_amdgcn_readfirstlane(nx) * NG + g;
    }
}
template <int J0, int J1> DEV int convert_jobs(const Params& p, LAS unsigned char* lds, int B0, int NBW, int tbeg = 0, int WL = 8) {
#pragma unroll
    for (int j = J0; j < J1; ++j) { const ConvJob J = make_job(p, j); convert_one(J, lds, B0, NBW, tbeg, WL); tbeg += J.ntiles(); }
    return tbeg;
}
DEV ConvJob moe_job(const Params& p, int which, int ml) {
    const long long DD = (long long)D * D; const size_t b0 = (size_t)ml * 32;
    if (which == 0) return ConvJob{p.moe_w_in + b0 * DD, WS_(p, moe_w1_t) + b0 * DD, 1024, 1024, 1024, 1024, 1024, 1 | 2 * PF(6), 32, DD, DD};
    return ConvJob{p.moe_w_down + b0 * 512 * 1024, WS_(p, moe_w2_t) + b0 * 512 * 1024, 512, 1024, 1024, 512, 1024, 0 | 2 * PF(7), 32, (long long)512 * 1024, (long long)1024 * 512};
}
DEV void phase_convert(const Params& p, LAS unsigned char* lds) {
    const int tid = tid_(), bid = bid_();
    if (bid == 1 && tid < 7 * 32) __hip_atomic_store(WS_(p, MFLAG) + (MFLAG_SIDE + tid) * MFLAG_STRIDE, 0u, __ATOMIC_RELAXED, __HIP_MEMORY_SCOPE_AGENT);
    convert_jobs<0, 8>(p, lds, 0, NB_);
    if (bid < 4 * 48) { const int layer = bid / 48, o = bid % 48;
        for (int k = tid; k < D; k += NTHR) { float v = 0.f;
            if (o < 32) v = p.moe_w_route[((size_t)layer * D + k) * 32 + o]; else if (o < 36) v = p.moe_w_group[((size_t)layer * D + k) * 4 + (o - 32)];
            WS_(p, moe_wr_t)[((size_t)layer * 48 + o) * D + k] = (bf16_t)f2bf(v); } }
    else if (bid < 4 * 48 + 32) { const int o = bid - 192;
        for (int k = tid; k < D; k += NTHR) WS_(p, mb_dt_t)[(size_t)o * D + k] = (bf16_t)f2bf(p.mb_w_in[(size_t)k * 5152 + 5120 + o]); }
    else if (bid < 4 * 48 + 48) { const int o = bid - 224;
        for (int k = tid; k < D; k += NTHR) WS_(p, gl_lr_t)[(size_t)o * D + k] = (bf16_t)f2bf(p.gl_w_in[(size_t)k * 3088 + 3072 + o]); }
}
namespace pg8 {
constexpr int BM = 256, BK = 64, HALF = 128, HTB = HALF * BK * 2, STAGE_BYTES = 8 * HTB;
DEV int lds_byte(int r, int c) { const int st = (r >> 4) * 2 + (c >> 5), rr = r & 15, cc = c & 31, ob = rr * 64 + cc * 2; return st * 1024 + (ob ^ (((ob >> 9) & 1) << 5)); }
DEV void stage_rc(int b, int& R, int& C) { const int st = b / 1024, sb = b % 1024, swz = sb ^ (((sb >> 9) & 1) << 5); R = (st >> 1) * 16 + swz / 64; C = (st & 1) * 32 + (swz % 64) / 2; }

struct Unit { const char* A; const char* B; int row0, col0, id, aux; };

DEV bool tile_order(int i, int G, int c, int nM, int nN, int& pm, int& pn) {
    const int nwg = nM * nN; const long L = (long)i * G + c; if (L >= nwg) return false;
    int wgid = (int)L; { const int q = nwg / 8, r = nwg % 8, xcd = wgid % 8, off = wgid / 8; wgid = (xcd < r ? xcd * (q + 1) : r * (q + 1) + (xcd - r) * q) + off; }
    const int nig = 8 * nN, gid = wgid / nig, fm = gid * 8, gsz = (nM - fm) < 8 ? (nM - fm) : 8;
    pm = fm + ((wgid % nig) % gsz); pn = (wgid % nig) / gsz; return true;
}

template <class Epi, class Sched, bool GATHER = false>
DEV void gemm_phase(LAS unsigned char* lds, const int K, const Sched& S, const Epi& E, const char* gA = nullptr, const LAS int* gtab = nullptr) {
    const int tid = tid_(), wid = __builtin_amdgcn_readfirstlane(tid >> 6), lane = tid & 63, wr = wid >> 2, wc = wid & 3, fr = lane & 15, fq = lane >> 4;
    const int nt = K / BK;
    unsigned voff[2];
#pragma unroll
    for (int i = 0; i < 2; ++i) { int R, C; stage_rc(tid * 16 + i * 8192, R, C); voff[i] = (unsigned)(R * K + C) * 2u; }
    const size_t kstep = (size_t)(BK * 2);
    const size_t hstep = (size_t)HALF * K * 2;
    const unsigned ldsw = (unsigned)wid * 1024u;
    const int aoff = lds_byte(wr * 64 + fr, fq * 8), boff = lds_byte(wc * 32 + fr, fq * 8);
#define PG8_SA(b, h) (((b) * 2 + (h)) * HTB)
#define PG8_SB(b, h) ((4 + (b) * 2 + (h)) * HTB)
#define PG8_STAGE(bufoff, gbase) do { _Pragma("unroll") for (int _i = 0; _i < 2; ++_i) \
        __builtin_amdgcn_global_load_lds((const unsigned*)((const char*)(gbase) + voff[_i]), (LAS unsigned*)(lds + (bufoff) + ldsw + _i * 8192), 16, 0, 0); } while (0)
#define PG8_GLOAD(set, o) do { _Pragma("unroll") for (int h_ = 0; h_ < 2; ++h_) _Pragma("unroll") for (int i_ = 0; i_ < 2; ++i_) o[h_][i_] = (unsigned)gtab[(set) * 256 + h_ * 128 + R0g + 64 * i_] * (unsigned)(K * 2) + C2g; } while (0)
#define PG8_STAGE_A(bufoff, gbase, kb, h) do { if constexpr (GATHER) { _Pragma("unroll") for (int _i = 0; _i < 2; ++_i) \
        __builtin_amdgcn_global_load_lds((const unsigned*)(gA + (size_t)(kb) + goff[h][_i]), (LAS unsigned*)(lds + (bufoff) + ldsw + _i * 8192), 16, 0, 0); } else PG8_STAGE(bufoff, gbase); } while (0)
#define PG8_LDA(dst, b, h) do { _Pragma("unroll") for (int m = 0; m < 4; ++m) _Pragma("unroll") for (int k = 0; k < 2; ++k) dst[m][k] = *(const LAS bf16x8*)(lds + PG8_SA(b, h) + aoff + m * 2048 + k * 1024); } while (0)
#define PG8_LDB(dst, b, h) do { _Pragma("unroll") for (int n = 0; n < 2; ++n) _Pragma("unroll") for (int k = 0; k < 2; ++k) dst[n][k] = *(const LAS bf16x8*)(lds + PG8_SB(b, h) + boff + n * 2048 + k * 1024); } while (0)
#define PG8_MMA(ai, bj, At, Bt) do { __builtin_amdgcn_s_setprio(1); _Pragma("unroll") for (int m = 0; m < 4; ++m) _Pragma("unroll") for (int n = 0; n < 2; ++n) _Pragma("unroll") for (int k = 0; k < 2; ++k) \
        acc[ai][bj][m][n] = __builtin_amdgcn_mfma_f32_16x16x32_bf16(Bt[n][k], At[m][k], acc[ai][bj][m][n], 0, 0, 0); __builtin_amdgcn_s_setprio(0); } while (0)
#define PG8_WAIT_V(n) asm volatile("s_waitcnt vmcnt(" #n ")" ::: "memory")
#define PG8_WAIT_L(n) asm volatile("s_waitcnt lgkmcnt(" #n ")" ::: "memory")
#define PG8_BAR __builtin_amdgcn_s_barrier()
#define PG8_SCHED __builtin_amdgcn_sched_barrier(0)
    Unit cur, nxt; int ui = 0;
    if (!S.next(0, cur)) return;
    f32x4 acc[2][2][4][2];
#pragma unroll
    for (int a = 0; a < 2; ++a)
#pragma unroll
        for (int b = 0; b < 2; ++b)
#pragma unroll
            for (int m = 0; m < 4; ++m)
#pragma unroll
                for (int n = 0; n < 2; ++n) acc[a][b][m][n] = (f32x4){0.f, 0.f, 0.f, 0.f};
    bf16x8 At[4][2], B0[2][2], B1[2][2];
    const char* cA = cur.A; const char* cB = cur.B;
    int R0g = 0; unsigned C2g = 0u; unsigned goff[2][2] = {{0u, 0u}, {0u, 0u}};
    if constexpr (GATHER) { int R, C; stage_rc(tid * 16, R, C); R0g = R; C2g = (unsigned)C * 2u; PG8_GLOAD(0, goff); }
    PG8_STAGE(PG8_SB(0, 0), cB); PG8_STAGE_A(PG8_SA(0, 0), cA, 0, 0); PG8_STAGE(PG8_SB(0, 1), cB + hstep); PG8_STAGE_A(PG8_SA(0, 1), cA + hstep, 0, 1);
    if (wr == 1) PG8_BAR;
    PG8_WAIT_V(4); PG8_BAR;
    PG8_STAGE(PG8_SB(1, 0), cB + kstep); PG8_STAGE_A(PG8_SA(1, 0), cA + kstep, kstep, 0); PG8_STAGE(PG8_SB(1, 1), cB + hstep + kstep);
    PG8_WAIT_V(6); PG8_BAR;
    for (;;) {
        const bool has_next = S.next(ui + 1, nxt);
        const char* nA = has_next ? nxt.A : cA; const char* nB = has_next ? nxt.B : cB;
#pragma unroll 1
        for (int t = 0; t < nt; t += 2) {
            const bool last = (t == nt - 2);
            const char* a1 = cA + (size_t)(t + 1) * kstep;
            const char* a2 = last ? nA : cA + (size_t)(t + 2) * kstep; const char* b2 = last ? nB : cB + (size_t)(t + 2) * kstep;
            const char* a3 = a2 + kstep; const char* b3 = b2 + kstep;
            const bool nx = last && has_next; const size_t kb2 = last ? (size_t)0 : (size_t)(t + 2) * kstep;
            PG8_LDB(B0, 0, 0); PG8_SCHED; PG8_LDA(At, 0, 0); PG8_STAGE_A(PG8_SA(1, 1), a1 + hstep, (size_t)(t + 1) * kstep, 1);
            if constexpr (GATHER) { if (nx) PG8_GLOAD(ui + 1, goff); }
            PG8_WAIT_L(8); PG8_BAR; PG8_WAIT_L(0); PG8_MMA(0, 0, At, B0); PG8_BAR; PG8_SCHED;
            PG8_LDB(B1, 0, 1); PG8_STAGE(PG8_SB(0, 0), b2);
            PG8_BAR; PG8_WAIT_L(0); PG8_MMA(0, 1, At, B1); PG8_BAR;
            PG8_LDA(At, 0, 1); PG8_STAGE_A(PG8_SA(0, 0), a2, kb2, 0);
            PG8_BAR; PG8_WAIT_L(0); PG8_MMA(1, 0, At, B0); PG8_BAR; PG8_SCHED;
            PG8_STAGE(PG8_SB(0, 1), b2 + hstep);
            PG8_WAIT_V(6); PG8_BAR; PG8_MMA(1, 1, At, B1); PG8_BAR;
            PG8_LDB(B0, 1, 0); PG8_SCHED; PG8_LDA(At, 1, 0); PG8_STAGE_A(PG8_SA(0, 1), a2 + hstep, kb2, 1);
            PG8_WAIT_L(8); PG8_BAR; PG8_WAIT_L(0); PG8_MMA(0, 0, At, B0); PG8_BAR; PG8_SCHED;
            PG8_LDB(B1, 1, 1); PG8_STAGE(PG8_SB(1, 0), b3);
            PG8_BAR; PG8_WAIT_L(0); PG8_MMA(0, 1, At, B1); PG8_BAR;
            PG8_LDA(At, 1, 1); PG8_STAGE_A(PG8_SA(1, 0), a3, kb2 + kstep, 0);
            PG8_BAR; PG8_WAIT_L(0); PG8_MMA(1, 0, At, B0); PG8_BAR; PG8_SCHED;
            PG8_STAGE(PG8_SB(1, 1), b3 + hstep);
            PG8_WAIT_V(6); PG8_BAR; PG8_MMA(1, 1, At, B1); PG8_BAR;
        }
        E(acc, cur, wr, wc, fr, fq);
        if (!has_next) break;
#pragma unroll
        for (int a = 0; a < 2; ++a)
#pragma unroll
            for (int b = 0; b < 2; ++b)
#pragma unroll
                for (int m = 0; m < 4; ++m)
#pragma unroll
                    for (int n = 0; n < 2; ++n) acc[a][b][m][n] = (f32x4){0.f, 0.f, 0.f, 0.f};
        cur = nxt; cA = nA; cB = nB; ++ui;
    }
    PG8_WAIT_V(0);
    if (wr == 0) PG8_BAR;
    PG8_BAR;
#undef PG8_SA
#undef PG8_SB
#undef PG8_STAGE
#undef PG8_STAGE_A
#undef PG8_GLOAD
#undef PG8_LDA
#undef PG8_LDB
#undef PG8_MMA
#undef PG8_WAIT_V
#undef PG8_WAIT_L
#undef PG8_BAR
#undef PG8_SCHED
}
}
using pg8::Unit;
typedef f32x4 AccT[2][2][4][2];
#define FOR_ACC(ai, bj, m, n) _Pragma("unroll") for (int ai = 0; ai < 2; ++ai) _Pragma("unroll") for (int m = 0; m < 4; ++m) _Pragma("unroll") for (int bj = 0; bj < 2; ++bj) _Pragma("unroll") for (int n = 0; n < 2; ++n)
#define ACC_FENCE __builtin_amdgcn_sched_barrier(0)
#define ACC_ROW(u, ai, m) ((u).row0 + 128 * (ai) + 64 * wr + 16 * (m) + fr)
#define ACC_COLP(u, bj, n, P) ((P) ? ((u).col0 + 128 * (bj) + 32 * wc + 8 * fq + 4 * (n)) : ((u).col0 + 128 * (bj) + 32 * wc + 16 * (n) + 4 * fq))
#define ACC_COL8P(u, bj, P) ACC_COLP(u, bj, 0, P)
#define FOR_ACC2(ai, bj, m) _Pragma("unroll") for (int ai = 0; ai < 2; ++ai) _Pragma("unroll") for (int m = 0; m < 4; ++m) _Pragma("unroll") for (int bj = 0; bj < 2; ++bj)
DEV void st_bf4(bf16_t* p, f32x4 v) { u32x2 w; w.x = pk2(v[0], v[1]); w.y = pk2(v[2], v[3]); *(u32x2*)p = w; }
DEV u32x4 pk8v(f32x4 a, f32x4 b) { u32x4 w; w.x = pk2(a[0], a[1]); w.y = pk2(a[2], a[3]); w.z = pk2(b[0], b[1]); w.w = pk2(b[2], b[3]); return w; }
#ifdef ST8
DEV void st_bf8p(bf16_t* p, f32x4 a, f32x4 b, bool P) { if (P) { st_bf4(p, a); st_bf4(p + 4, b); } else { st_bf4(p, a); st_bf4(p + 16, b); } }
#else
DEV void st_bf8p(bf16_t* p, f32x4 a, f32x4 b, bool P) { if (P) *(u32x4*)p = pk8v(a, b); else { st_bf4(p, a); st_bf4(p + 16, b); } }
#endif
DEV void load_row(const float* p, int lane, f32x4 (&v)[4]) {
#pragma unroll
    for (int q = 0; q < 4; ++q) v[q] = *(const f32x4*)(p + RCOL(q, lane));
}

DEV void load_row_bf(const bf16_t* p, int lane, f32x4 (&v)[4]) {
#pragma unroll
    for (int q = 0; q < 4; ++q) { const u32x2 a = *(const u32x2*)(p + RCOL(q, lane)); v[q] = (f32x4){bflo(a.x), bfhi(a.x), bflo(a.y), bfhi(a.y)}; }
}
DEV void store_row_bf(bf16_t* p, int lane, const f32x4 (&v)[4]) {
#pragma unroll
    for (int q = 0; q < 4; ++q) st_bf4(p + RCOL(q, lane), v[q]);
}
DEV void emit_mix6(const Params& p, int j, int t, int lane, const f32x4 (&x)[4], const f32x4 (&xp)[4]) {
    const float* mu = p.rw_mu + (size_t)j * 6 * D;
#pragma unroll
    for (int s = 0; s < 6; ++s) {
#pragma unroll
        for (int q = 0; q < 4; ++q) {
            const f32x4 m = *(const f32x4*)(mu + s * D + RCOL(q, lane));
            st_bf4(WS_(p, X6) + (size_t)s * T * D + (size_t)t * D + RCOL(q, lane), x[q] + (xp[q] - x[q]) * m);
        }
        __builtin_amdgcn_sched_barrier(0);
    }
}
DEV void phase_pre0(const Params& p) {
    const int tid = tid_(), bid = bid_(); const int lane = tid & 63, wid = tid >> 6;
    f32x4 x[4], xp[4];
    const int tfirst = bid * 64 + wid * 8;
    if (tfirst > 0) load_row(p.x + (size_t)(tfirst - 1) * D, lane, xp); else { for (int q = 0; q < 4; ++q) xp[q] = (f32x4){0.f, 0.f, 0.f, 0.f}; }
    f32x4 xn[4]; load_row(p.x + (size_t)tfirst * D, lane, xn);
#pragma unroll 1
    for (int r = 0; r < 8; ++r) {
        const int t = tfirst + r;
#pragma unroll
        for (int q = 0; q < 4; ++q) x[q] = xn[q];
        load_row(p.x + (size_t)(r < 7 ? t + 1 : t) * D, lane, xn);
        store_row_bf(WS_(p, Hb) + (size_t)t * D, lane, x);
        emit_mix6(p, 0, t, lane, x, xp);
#pragma unroll
        for (int q = 0; q < 4; ++q) xp[q] = x[q];
    }
}

struct SchedRW1 {
    const Params* p; int j;
    DEV bool next(int i, Unit& u) const {
        int pm, pn; if (!pg8::tile_order(i, NB_, bid_(), 64, 15, pm, pn)) return false;
        int id, lpn; if (pn < 12) { id = pn >> 2; lpn = pn & 3; } else { id = 3 + (pn - 12); lpn = 0; }
        u.A = (const char*)(WS_(*p, X6) + (size_t)id * T * D + (size_t)pm * 256 * D);
        const bf16_t* B;
        if (id < 3) B = WS_(*p, rw_rkv_t) + ((size_t)j * 3 + id) * D * D + (size_t)lpn * 256 * D;
        else B = WS_(*p, rw_w1_t) + (size_t)(id - 3) * (2 * 256 * D) + (size_t)j * 256 * D;
        u.B = (const char*)B; u.row0 = pm * 256; u.col0 = lpn * 256; u.id = id; u.aux = 0; return true;
    }
};
struct EpiRW1 {
    const Params* p;
    DEV void operator()(const AccT& acc, const Unit& u, int wr, int wc, int fr, int fq) const {
        if (u.id < 3) {
            bf16_t* O = WS_(*p, Rb) + (size_t)u.id * 2 * T * D;
            FOR_ACC2(ai, bj, m) { st_bf8p(O + (size_t)ACC_ROW(u, ai, m) * D + ACC_COL8P(u, bj, PF(0)), acc[ai][bj][m][0], acc[ai][bj][m][1], PF(0)); ACC_FENCE; }
        } else {
            bf16_t* O = WS_(*p, LW) + (size_t)(u.id - 3) * T * 256;
            FOR_ACC2(ai, bj, m) {
                f32x4 v0 = acc[ai][bj][m][0], v1 = acc[ai][bj][m][1];
                if (u.id == 3) { for (int e = 0; e < 4; ++e) { v0[e] = tanhf_(v0[e]); v1[e] = tanhf_(v1[e]); } }
                else if (u.id == 5) { for (int e = 0; e < 4; ++e) { v0[e] = sigmoidf_(v0[e]); v1[e] = sigmoidf_(v1[e]); } }
                st_bf8p(O + (size_t)ACC_ROW(u, ai, m) * 256 + ACC_COL8P(u, bj, PF(1)), v0, v1, PF(1)); ACC_FENCE;
            }
        }
    }
};
struct SchedRW2 {
    const Params* p; int j;
    DEV bool next(int i, Unit& u) const {
        int pm, pn; if (!pg8::tile_order(i, NB_, bid_(), 64, 12, pm, pn)) return false;
        const int id = pn >> 2, lpn = pn & 3;
        u.A = (const char*)(WS_(*p, LW) + (size_t)id * T * 256 + (size_t)pm * 256 * 256);
        const bf16_t* B = WS_(*p, rw_w2_t) + (size_t)id * (2 * D * 256) + (size_t)j * D * 256 + (size_t)lpn * 256 * 256;
        u.B = (const char*)B; u.row0 = pm * 256; u.col0 = lpn * 256; u.id = id; u.aux = 0; return true;
    }
};
struct EpiRW2 {
    const Params* p; int j;
    DEV void operator()(const AccT& acc, const Unit& u, int wr, int wc, int fr, int fq) const {
        if (u.id == 0) { const float* bias = p->rw_w0 + (size_t)j * D; f32x4 bv[2][2];
#pragma unroll
            for (int bj = 0; bj < 2; ++bj)
#pragma unroll
                for (int n = 0; n < 2; ++n) bv[bj][n] = *(const f32x4*)(bias + ACC_COLP(u, bj, n, PF(2)));
            FOR_ACC2(ai, bj, m) { f32x4 vv[2];
#pragma unroll
                for (int n = 0; n < 2; ++n) { f32x4 v = acc[ai][bj][m][n]; const f32x4 b = bv[bj][n];
                    for (int e = 0; e < 4; ++e) { const float x = -(b[e] + v[e]); const float wl = -(fmaxf(x, 0.f) + __logf(1.0f + __expf(-fabsf(x)))) - 0.5f; v[e] = -__expf(wl); }
                    vv[n] = v; }
                st_bf8p(WS_(*p, Wb) + (size_t)ACC_ROW(u, ai, m) * D + ACC_COL8P(u, bj, PF(2)), vv[0], vv[1], PF(2)); ACC_FENCE; } }
        else if (u.id == 1) { const float* bias = p->rw_a0 + (size_t)j * D; f32x4 bv[2][2];
#pragma unroll
            for (int bj = 0; bj < 2; ++bj)
#pragma unroll
                for (int n = 0; n < 2; ++n) bv[bj][n] = *(const f32x4*)(bias + ACC_COLP(u, bj, n, PF(2)));
            FOR_ACC2(ai, bj, m) { f32x4 vv[2];
#pragma unroll
                for (int n = 0; n < 2; ++n) { f32x4 v = acc[ai][bj][m][n]; const f32x4 b = bv[bj][n];
                    for (int e = 0; e < 4; ++e) v[e] = sigmoidf_(b[e] + v[e]);
                    vv[n] = v; }
                st_bf8p(WS_(*p, Ab) + (size_t)ACC_ROW(u, ai, m) * D + ACC_COL8P(u, bj, PF(2)), vv[0], vv[1], PF(2)); ACC_FENCE; } }
        else { FOR_ACC2(ai, bj, m) { st_bf8p(WS_(*p, Gb) + (size_t)ACC_ROW(u, ai, m) * D + ACC_COL8P(u, bj, PF(2)), acc[ai][bj][m][0], acc[ai][bj][m][1], PF(2)); ACC_FENCE; } }
    }
};

struct SchedOut {
    const bf16_t* A; const bf16_t* Bt; int K;
    DEV bool next(int i, Unit& u) const {
        int pm, pn; if (!pg8::tile_order(i, NB_, bid_(), 64, 4, pm, pn)) return false;
        u.A = (const char*)(A + (size_t)pm * 256 * K); u.B = (const char*)(Bt + (size_t)pn * 256 * K); u.row0 = pm * 256; u.col0 = pn * 256; u.id = 0; u.aux = 0; return true;
    }
};
struct EpiOut {
    bf16_t* O;
    DEV void operator()(const AccT& acc, const Unit& u, int wr, int wc, int fr, int fq) const {
        FOR_ACC2(ai, bj, m) { st_bf8p(O + (size_t)ACC_ROW(u, ai, m) * D + ACC_COL8P(u, bj, PF(3)), acc[ai][bj][m][0], acc[ai][bj][m][1], PF(3)); ACC_FENCE; }
    }
};
constexpr int RC_LD = 72;
#ifdef DBG
#define DBGF(cond, bit) do { if (cond) atomicOr(&WS_(p, TAB)[200], (bit)); } while (0)
#else
#define DBGF(cond, bit) do {} while (0)
#endif
DEV bool bad_(float x) { return !(fabsf(x) < 1e30f); }
DEV int rc_pi(int g, int j) { return j < 4 ? 4 * g + j : 16 + 4 * g + (j - 4); }

DEV void rc_load_wd(const Params& p, int t0, int cb, float (&wd)[8]) {
    const int tid = tid_(); const int k = tid & 63, sg = tid >> 6;
#pragma unroll
    for (int i = 0; i < 8; ++i) wd[i] = bf2f(WS_(p, Wb)[(size_t)(t0 + sg * 8 + i) * D + cb + k]);
}
DEV void rc_cum_regs(const float (&wd)[8], LAS float* cum, LAS float* seg) {
    const int tid = tid_(); const int k = tid & 63, sg = tid >> 6;
    float v[8]; float s = 0.f;
#pragma unroll
    for (int i = 0; i < 8; ++i) { s += wd[i]; v[i] = s; }
    seg[sg * 64 + k] = s;
    lds_barrier();
    float off = 0.f;
#pragma unroll
    for (int q = 0; q < 8; ++q) off += (q < sg) ? seg[q * 64 + k] : 0.f;
#pragma unroll
    for (int i = 0; i < 8; ++i) cum[(sg * 8 + i) * 64 + k] = v[i] + off;
    lds_barrier();
}
DEV void ld8b(const bf16_t* p, float (&f)[8]) { const u32x4 v = *(const u32x4*)p; f[0] = bflo(v.x); f[1] = bfhi(v.x); f[2] = bflo(v.y); f[3] = bfhi(v.y); f[4] = bflo(v.z); f[5] = bfhi(v.z); f[6] = bflo(v.w); f[7] = bfhi(v.w); }
DEV void ld8(const float* p, float (&f)[8]) { const f32x4 a = *(const f32x4*)p, b = *(const f32x4*)(p + 4); f[0] = a[0]; f[1] = a[1]; f[2] = a[2]; f[3] = a[3]; f[4] = b[0]; f[5] = b[1]; f[6] = b[2]; f[7] = b[3]; }
DEV void lds8(const LAS float* p, float (&f)[8]) { const f32x4 a = *(const LAS f32x4*)p, b = *(const LAS f32x4*)(p + 4); f[0] = a[0]; f[1] = a[1]; f[2] = a[2]; f[3] = a[3]; f[4] = b[0]; f[5] = b[1]; f[6] = b[2]; f[7] = b[3]; }
DEV u32x4 pk8(const float (&f)[8]) { u32x4 o; o.x = pk2(f[0], f[1]); o.y = pk2(f[2], f[3]); o.z = pk2(f[4], f[5]); o.w = pk2(f[6], f[7]); return o; }

DEV bf16x8 frag_rm_pi(const LAS bf16_t* base, int ld, int row0, int k0, int lane) {
    const LAS bf16_t* a = base + (row0 + (lane & 15)) * ld + k0 + 4 * (lane >> 4);
    const s16x4 lo = *(const LAS s16x4*)a, hi = *(const LAS s16x4*)(a + 16);
    bf16x8 r; r[0] = lo[0]; r[1] = lo[1]; r[2] = lo[2]; r[3] = lo[3]; r[4] = hi[0]; r[5] = hi[1]; r[6] = hi[2]; r[7] = hi[3]; return r;
}
DEV void rc_prep8(const float (&k)[8], const float (&al)[8], const float (&kkw)[8], const float (&kaw)[8], float (&a)[8], float (&b)[8], float (&kh)[8]) {
    float kk[8]; float ss = 0.f;
#pragma unroll
    for (int e = 0; e < 8; ++e) { kk[e] = k[e] * kkw[e]; ss += kk[e] * kk[e]; }
    ss += __shfl_xor(ss, 1); ss += __shfl_xor(ss, 2); ss += __shfl_xor(ss, 4);
    const float inv = 1.0f / fmaxf(sqrtf(ss), 1e-12f);
#pragma unroll
    for (int e = 0; e < 8; ++e) { const float kn = kk[e] * inv; a[e] = -kn; b[e] = kn * al[e]; kh[e] = k[e] * (1.0f + (al[e] - 1.0f) * kaw[e]); }
}
constexpr int RW_NB = 64, RW_NW = NBLK - RW_NB;
DEV void phase_rw_cha(const Params& p, int jl, LAS unsigned char* lds, const int u0, const int ue, const int us) {
    const int tid = tid_(), bid = bid_(); (void)bid; const int lane = tid & 63, w = tid >> 6; const int fr = lane & 15, fq = lane >> 4;
    LAS float* cum = (LAS float*)lds;
    LAS float* seg = cum + 64 * 64;
    LAS float* Aab = seg + 8 * 64;
    LAS bf16_t* As = (LAS bf16_t*)(Aab + 64 * 68);
    LAS bf16_t* Bs = As + 64 * RC_LD; LAS bf16_t* Ks = Bs + 64 * RC_LD; LAS bf16_t* Vs = Ks + 64 * RC_LD; LAS bf16_t* Ke = Vs + 64 * RC_LD;
    LAS bf16_t* Aak = Ke + 64 * RC_LD; LAS bf16_t* Ts = Aak + 64 * RC_LD; LAS bf16_t* X1 = Ts + 64 * RC_LD; LAS bf16_t* Aabh = X1 + 64 * RC_LD;
    LAS bf16_t* Fimg = Aabh + 64 * RC_LD;
    LAS bf16_t* Wimg = Fimg + 4096;
    float pwd[8], pkr[8], pal[8], pv[8];
    float kkw[8], kaw[8];
    ld8(p.rw_k_k + (size_t)jl * D + (u0 & 15) * 64 + (tid & 7) * 8, kkw); ld8(p.rw_k_a + (size_t)jl * D + (u0 & 15) * 64 + (tid & 7) * 8, kaw);
    { const int c = u0 >> 4, h = u0 & 15; rc_load_wd(p, c * 64, h * 64, pwd);
      const size_t go = (size_t)(c * 64 + (tid >> 3)) * D + h * 64 + (tid & 7) * 8; ld8b(WS_(p, Kb) + go, pkr); ld8b(WS_(p, Ab) + go, pal); ld8b(WS_(p, Vb) + go, pv); }
    for (int u = u0; u < ue; u += us) {
        const int c = u >> 4, h = u & 15; const int t0 = c * 64, cb = h * 64; const size_t ub = (size_t)c * 16 + h;
        lds_barrier();
        rc_cum_regs(pwd, cum, seg);
        {
            const int t = tid >> 3, k8 = (tid & 7) * 8;
            float a[8], b[8], kh[8], v[8], ct[8], cp[8], ce[8];
            rc_prep8(pkr, pal, kkw, kaw, a, b, kh);
#pragma unroll
            for (int e = 0; e < 8; ++e) v[e] = pv[e];
            if (u + us < ue) { const int un = u + us; const int cn = un >> 4, hn = un & 15; rc_load_wd(p, cn * 64, hn * 64, pwd);
                const size_t gn = (size_t)(cn * 64 + t) * D + hn * 64 + k8; ld8b(WS_(p, Kb) + gn, pkr); ld8b(WS_(p, Ab) + gn, pal); ld8b(WS_(p, Vb) + gn, pv); }
            lds8(cum + t * 64 + k8, ct); lds8(cum + 63 * 64 + k8, ce);
            if (t > 0) lds8(cum + (t - 1) * 64 + k8, cp); else { for (int e = 0; e < 8; ++e) cp[e] = 0.f; }
            float at[8], bt[8], kt[8], be[8], ke[8];
#pragma unroll
            for (int e = 0; e < 8; ++e) { const float ei = __expf(-ct[e]), ee = __expf(ce[e] - ct[e]); at[e] = a[e] * __expf(cp[e]); bt[e] = b[e] * ei; kt[e] = kh[e] * ei; be[e] = b[e] * ee; ke[e] = kh[e] * ee; }
            *(LAS u32x4*)(As + t * RC_LD + k8) = pk8(at); *(LAS u32x4*)(Bs + t * RC_LD + k8) = pk8(bt); *(LAS u32x4*)(Ks + t * RC_LD + k8) = pk8(kt);
            *(LAS u32x4*)(Ke + t * RC_LD + k8) = pk8(ke); *(LAS u32x4*)(Vs + t * RC_LD + k8) = pk8(v);
            const int tq = t & 31, g = (tq & 15) >> 2, j = (tq & 3) + ((tq >> 4) << 2);
#pragma unroll
            for (int e = 0; e < 8; ++e) { const int k = k8 + e; Fimg[(((k >> 4) * 2 + (t >> 5)) * 64 + g * 16 + (k & 15)) * 8 + j] = (bf16_t)f2bf(be[e]); }
            *(LAS u32x4*)(Ts + tid * 8) = (u32x4){0u, 0u, 0u, 0u}; if (tid < 64) *(LAS u32x4*)(Ts + (512 + tid) * 8) = (u32x4){0u, 0u, 0u, 0u};
            if (t == 63) { float gm[8]; for (int e = 0; e < 8; ++e) gm[e] = __expf(ce[e]); *(f32x4*)(WS_(p, RGc) + ub * 64 + k8) = (f32x4){gm[0], gm[1], gm[2], gm[3]}; *(f32x4*)(WS_(p, RGc) + ub * 64 + k8 + 4) = (f32x4){gm[4], gm[5], gm[6], gm[7]}; }
        }
        lds_barrier();
        {
            const int tb = w >> 1;
#pragma unroll
            for (int ii = 0; ii < 2; ++ii) { const int ib = 2 * (w & 1) + ii;
                f32x4 ab = {0.f, 0.f, 0.f, 0.f}, ak = {0.f, 0.f, 0.f, 0.f};
                if (ib <= tb) {
#pragma unroll
                    for (int ks = 0; ks < 2; ++ks) { const bf16x8 af = frag_rm(As, RC_LD, 16 * tb, 32 * ks, lane);
                        ab = MFMA16(af, frag_rm(Bs, RC_LD, 16 * ib, 32 * ks, lane), ab); ak = MFMA16(af, frag_rm(Ks, RC_LD, 16 * ib, 32 * ks, lane), ak); } }
#pragma unroll
                for (int r = 0; r < 4; ++r) { const int t = 16 * tb + 4 * fq + r, i = 16 * ib + fr; const bool keep = i < t;
                    Aab[t * 68 + i] = keep ? ab[r] : 0.f; Aabh[t * RC_LD + i] = (bf16_t)f2bf(keep ? ab[r] : 0.f); Aak[t * RC_LD + i] = (bf16_t)f2bf(keep ? ak[r] : 0.f); } }
            *(u32x4*)(WS_(p, RBf) + ub * 4096 + tid * 8) = *(const LAS u32x4*)(Fimg + tid * 8);
        }
        lds_barrier();
        if (w == 0) {
            const int blk = lane >> 4, jc = lane & 15;
            float Tc[16];
#pragma unroll
            for (int t = 0; t < 16; ++t) {
                float acc = jc == t ? 1.f : 0.f;
#pragma unroll
                for (int i4 = 0; i4 < (t + 3) / 4; ++i4) { const f32x4 a4 = *(const LAS f32x4*)(Aab + (16 * blk + t) * 68 + 16 * blk + i4 * 4);
#pragma unroll
                    for (int e = 0; e < 4; ++e) if (i4 * 4 + e < t) acc += a4[e] * Tc[i4 * 4 + e]; }
                Tc[t] = acc;
            }
#pragma unroll
            for (int t = 0; t < 16; ++t) Ts[(16 * blk + t) * RC_LD + 16 * blk + jc] = (bf16_t)f2bf(Tc[t]);
#pragma unroll
            for (int b = 1; b < 4; ++b) {
                const s16x4 dlo = *(const LAS s16x4*)(Ts + (16 * b + fr) * RC_LD + 16 * b + 4 * fq);
                bf16x8 dfr; dfr[0] = dlo[0]; dfr[1] = dlo[1]; dfr[2] = dlo[2]; dfr[3] = dlo[3]; dfr[4] = 0; dfr[5] = 0; dfr[6] = 0; dfr[7] = 0;
                f32x4 tt_[3];
#pragma unroll
                for (int cbk = 0; cbk < b; ++cbk) {
                    f32x4 x = {0.f, 0.f, 0.f, 0.f};
#pragma unroll
                    for (int ks = 0; ks < 2; ++ks) x = MFMA16(frag_rm(Aabh, RC_LD, 16 * b, 32 * ks, lane), frag_tr(Ts, RC_LD, 32 * ks, 16 * cbk, lane), x);
                    u32x4 xb; xb.x = pk2(x[0], x[1]); xb.y = pk2(x[2], x[3]); xb.z = 0u; xb.w = 0u;
                    tt_[cbk] = MFMA16(dfr, __builtin_bit_cast(bf16x8, xb), ((f32x4){0.f, 0.f, 0.f, 0.f}));
                }
#pragma unroll
                for (int cbk = 0; cbk < b; ++cbk)
#pragma unroll
                    for (int r = 0; r < 4; ++r) Ts[(16 * b + 4 * fq + r) * RC_LD + 16 * cbk + fr] = (bf16_t)f2bf(tt_[cbk][r]);
            }
        } else {
            for (int tl = w - 1; tl < 32; tl += 7) {
                const int rb = (tl & 15) >> 2, vbk = tl & 3; f32x4 acc = {0.f, 0.f, 0.f, 0.f};
                if (tl < 16) {
#pragma unroll
                    for (int ks = 0; ks < 2; ++ks) acc = MFMA16(frag_rm(Aak, RC_LD, 16 * rb, 32 * ks, lane), frag_tr(Vs, RC_LD, 32 * ks, 16 * vbk, lane), acc);
#pragma unroll
                    for (int r = 0; r < 4; ++r) X1[(16 * rb + 4 * fq + r) * RC_LD + 16 * vbk + fr] = (bf16_t)f2bf(acc[r]);
                } else {
#pragma unroll
                    for (int ks = 0; ks < 2; ++ks) acc = MFMA16(frag_tr(Ke, RC_LD, 32 * ks, 16 * rb, lane), frag_tr(Vs, RC_LD, 32 * ks, 16 * vbk, lane), acc);
                    { u32x2 o; o.x = pk2(acc[0], acc[1]); o.y = pk2(acc[2], acc[3]); *(u32x2*)(WS_(p, RNa) + (((ub * 4 + vbk) * 4 + rb) * 64 + lane) * 4) = o; }
                }
            }
        }
        lds_barrier();
#pragma unroll
        for (int q = 0; q < 4; ++q) { const int tl = w * 4 + q; const int tt = (tl & 15) >> 2, cbk = tl & 3; f32x4 acc = {0.f, 0.f, 0.f, 0.f};
            if (tl < 16) {
#pragma unroll
                for (int ks = 0; ks < 2; ++ks) acc = MFMA16(frag_rm(Ts, RC_LD, 16 * tt, 32 * ks, lane), frag_tr(As, RC_LD, 32 * ks, 16 * cbk, lane), acc);
                const int k = 16 * cbk + fr, kq = k & 31, g = (kq & 15) >> 2, j = (kq & 3) + ((kq >> 4) << 2);
#pragma unroll
                for (int r = 0; r < 4; ++r) Wimg[((tt * 2 + (k >> 5)) * 64 + g * 16 + 4 * fq + r) * 8 + j] = (bf16_t)f2bf(acc[r]);
            } else {
#pragma unroll
                for (int ks = 0; ks < 2; ++ks) acc = MFMA16(frag_rm(Ts, RC_LD, 16 * tt, 32 * ks, lane), frag_tr(X1, RC_LD, 32 * ks, 16 * cbk, lane), acc);
                { u32x2 o; o.x = pk2(acc[0], acc[1]); o.y = pk2(acc[2], acc[3]); *(u32x2*)(WS_(p, RUt) + (((ub * 4 + cbk) * 4 + tt) * 64 + lane) * 4) = o; }
            } }
        lds_barrier();
        *(u32x4*)(WS_(p, RWf) + ub * 4096 + tid * 8) = *(const LAS u32x4*)(Wimg + tid * 8);
    }
}

constexpr int RB_SLOT = 20992, RB_R = 6, RB_P = 5;
struct RbOpsA { bf16x8 wf[8]; u32x2 ut[4]; };
struct RbOpsB { bf16x8 bf[8]; u32x2 na[4]; f32x4 gc[4]; };
DEV void rb_read_a(const LAS unsigned char* slot, int lane, RbOpsA& O) {
#pragma unroll
    for (int f = 0; f < 8; ++f) O.wf[f] = *(const LAS bf16x8*)(slot + (f * 64 + lane) * 16);
#pragma unroll
    for (int q = 0; q < 4; ++q) O.ut[q] = *(const LAS u32x2*)(slot + 16384 + (q * 64 + lane) * 8);
}
DEV void rb_read_b(const LAS unsigned char* slot, int lane, RbOpsB& O) {
    const int fq = lane >> 4;
#pragma unroll
    for (int f = 0; f < 8; ++f) O.bf[f] = *(const LAS bf16x8*)(slot + 8192 + (f * 64 + lane) * 16);
#pragma unroll
    for (int q = 0; q < 4; ++q) { O.na[q] = *(const LAS u32x2*)(slot + 18432 + (q * 64 + lane) * 8); O.gc[q] = *(const LAS f32x4*)(slot + 20480 + (16 * q + 4 * fq) * 4); }
}
DEV void phase_rw_chb(const Params& p, LAS unsigned char* lds, int half) {
    const int tid = tid_(), bid = bid_(); const int cbeg = half * 128, cend = cbeg + 128;
    const int lane = tid & 63, w = __builtin_amdgcn_readfirstlane(tid >> 6); const int head = bid & 15, vb = bid >> 4;
    auto issue = [&](int c) {
        const size_t ub = (size_t)c * 16 + head; LAS unsigned char* slot = lds + (c % RB_R) * RB_SLOT;
#pragma unroll
        for (int i = 0; i < 3; ++i) { const int pi = (w - 1) * 3 + i;
            if (pi < 8) __builtin_amdgcn_global_load_lds((const unsigned*)(WS_(p, RWf) + ub * 4096 + pi * 512 + lane * 8), (LAS unsigned*)(slot + pi * 1024), 16, 0, 0);
            else if (pi < 16) __builtin_amdgcn_global_load_lds((const unsigned*)(WS_(p, RBf) + ub * 4096 + (pi - 8) * 512 + lane * 8), (LAS unsigned*)(slot + 8192 + (pi - 8) * 1024), 16, 0, 0);
            else if (pi < 18) __builtin_amdgcn_global_load_lds((const unsigned*)(WS_(p, RUt) + (ub * 4 + vb) * 1024 + (pi - 16) * 512 + lane * 8), (LAS unsigned*)(slot + 16384 + (pi - 16) * 1024), 16, 0, 0);
            else if (pi < 20) __builtin_amdgcn_global_load_lds((const unsigned*)(WS_(p, RNa) + (ub * 4 + vb) * 1024 + (pi - 18) * 512 + lane * 8), (LAS unsigned*)(slot + 18432 + (pi - 18) * 1024), 16, 0, 0);
            else __builtin_amdgcn_global_load_lds((const unsigned*)(WS_(p, RGc) + ub * 64 + lane), (LAS unsigned*)(slot + 20480), 4, 0, 0);
        }
    };
    if (w > 0) {
#pragma unroll 1
        for (int c = cbeg; c < cbeg + RB_P; ++c) issue(c);
        asm volatile("s_waitcnt vmcnt(9)" ::: "memory");
    }
    __builtin_amdgcn_s_barrier();
    f32x4 s[4]; for (int i = 0; i < 4; ++i) s[i] = (f32x4){0.f, 0.f, 0.f, 0.f};
    f32x4* sst = WS_(p, RBST) + ((size_t)bid * 4) * 64 + lane;
    if (w > 0) {
#pragma unroll 1
        for (int c = cbeg; c < cend; ++c) {
            if (c + RB_P < cend) { issue(c + RB_P); asm volatile("s_waitcnt vmcnt(9)" ::: "memory"); }
            else asm volatile("s_waitcnt vmcnt(0)" ::: "memory");
            __builtin_amdgcn_s_barrier();
        }
    } else {
        RbOpsA A0, A1;
        rb_read_a(lds + (cbeg % RB_R) * RB_SLOT, lane, A0); if (half) { for (int i = 0; i < 4; ++i) s[i] = sst[i * 64]; }
#define RB_CHUNK(CA, NA, cc) do { const int c_ = (cc); const size_t ub = (size_t)c_ * 16 + head; RbOpsB cb_; \
            bf16x8 sb[2]; \
            _Pragma("unroll") for (int ks = 0; ks < 2; ++ks) { u32x4 o; o.x = pk2(s[2 * ks][0], s[2 * ks][1]); o.y = pk2(s[2 * ks][2], s[2 * ks][3]); o.z = pk2(s[2 * ks + 1][0], s[2 * ks + 1][1]); o.w = pk2(s[2 * ks + 1][2], s[2 * ks + 1][3]); sb[ks] = __builtin_bit_cast(bf16x8, o); *(u32x4*)(WS_(p, RS0) + (((ub * 4 + vb) * 2 + ks) * 64 + lane) * 8) = o; }       \
            f32x4 uu[4]; \
            _Pragma("unroll") for (int tt = 0; tt < 4; ++tt) { uu[tt] = (f32x4){bflo(CA.ut[tt].x), bfhi(CA.ut[tt].x), bflo(CA.ut[tt].y), bfhi(CA.ut[tt].y)}; uu[tt] = MFMA16(CA.wf[tt * 2], sb[0], uu[tt]); uu[tt] = MFMA16(CA.wf[tt * 2 + 1], sb[1], uu[tt]); } \
            __builtin_amdgcn_sched_barrier(0); \
              \
            rb_read_b(lds + (c_ % RB_R) * RB_SLOT, lane, cb_); \
            rb_read_a(lds + ((c_ + 1 < cend ? c_ + 1 : c_) % RB_R) * RB_SLOT, lane, NA); \
            __builtin_amdgcn_sched_barrier(0); \
            bf16x8 ubf[2]; \
            _Pragma("unroll") for (int ks = 0; ks < 2; ++ks) { u32x4 o; o.x = pk2(uu[2 * ks][0], uu[2 * ks][1]); o.y = pk2(uu[2 * ks][2], uu[2 * ks][3]); o.z = pk2(uu[2 * ks + 1][0], uu[2 * ks + 1][1]); o.w = pk2(uu[2 * ks + 1][2], uu[2 * ks + 1][3]); ubf[ks] = __builtin_bit_cast(bf16x8, o); *(u32x4*)(WS_(p, RUa) + (((ub * 4 + vb) * 2 + ks) * 64 + lane) * 8) = o; }      \
            _Pragma("unroll") for (int kt = 0; kt < 4; ++kt) { s[kt] = s[kt] * cb_.gc[kt] + (f32x4){bflo(cb_.na[kt].x), bfhi(cb_.na[kt].x), bflo(cb_.na[kt].y), bfhi(cb_.na[kt].y)}; s[kt] = MFMA16(cb_.bf[kt * 2], ubf[0], s[kt]); s[kt] = MFMA16(cb_.bf[kt * 2 + 1], ubf[1], s[kt]); } \
            __builtin_amdgcn_s_barrier(); \
        } while (0)
#pragma unroll 1
        for (int c = cbeg; c < cend; c += 2) { RB_CHUNK(A0, A1, c); RB_CHUNK(A1, A0, c + 1); }
#undef RB_CHUNK
    }
    if (w == 0 && !half) { for (int i = 0; i < 4; ++i) sst[i * 64] = s[i]; }
    asm volatile("s_waitcnt vmcnt(0)" ::: "memory");
}

DEV void phase_rw_chc(const Params& p, int j, LAS unsigned char* lds, const int u0, const int ue, const int us) {
    const int tid = tid_(), bid = bid_(); (void)bid; const int lane = tid & 63, w = tid >> 6; const int fr = lane & 15, fq = lane >> 4;
    LAS float* cum = (LAS float*)lds;
    LAS float* seg = cum + 64 * 64;
    LAS float* Ys = seg + 8 * 64;
    LAS bf16_t* Rs = (LAS bf16_t*)(Ys + 64 * 68);
    LAS bf16_t* Bs = Rs + 64 * RC_LD; LAS bf16_t* Ks = Bs + 64 * RC_LD; LAS bf16_t* Vs = Ks + 64 * RC_LD; LAS bf16_t* Arb = Vs + 64 * RC_LD; LAS bf16_t* Ark = Arb + 64 * RC_LD;
    float pwd[8], pr[8], pkr[8], pal[8], pv[8], pg[8];
    float kkw[8], kaw[8], rkw[8], lgw[8], lbw[8];
    { const size_t po = (size_t)j * D + (u0 & 15) * 64 + (tid & 7) * 8; ld8(p.rw_k_k + po, kkw); ld8(p.rw_k_a + po, kaw); ld8(p.rw_r_k + po, rkw); ld8(p.rw_lnx_g + po, lgw); ld8(p.rw_lnx_b + po, lbw); }
    { const int c = u0 >> 4, h = u0 & 15; rc_load_wd(p, c * 64, h * 64, pwd);
      const size_t go = (size_t)(c * 64 + (tid >> 3)) * D + h * 64 + (tid & 7) * 8; ld8b(WS_(p, Rb) + go, pr); ld8b(WS_(p, Kb) + go, pkr); ld8b(WS_(p, Ab) + go, pal); ld8b(WS_(p, Vb) + go, pv); ld8b(WS_(p, Gb) + go, pg); }
    for (int u = u0; u < ue; u += us) {
        const int c = u >> 4, h = u & 15; const int t0 = c * 64, cb = h * 64; const size_t ub = (size_t)c * 16 + h;
        const int tt = w & 3;
        bf16x8 ufr[2][2], sfr[2][2];
#pragma unroll
        for (int q = 0; q < 2; ++q)
#pragma unroll
            for (int ks = 0; ks < 2; ++ks) { const size_t o = (((ub * 4 + 2 * (w >> 2) + q) * 2 + ks) * 64 + lane) * 8;
                ufr[q][ks] = *(const bf16x8*)(WS_(p, RUa) + o); sfr[q][ks] = *(const bf16x8*)(WS_(p, RS0) + o); }
        lds_barrier();
        rc_cum_regs(pwd, cum, seg);
#ifdef DBL_CUM
        rc_cum_regs(pwd, cum, seg);
#endif
        const int t = tid >> 3, k8 = (tid & 7) * 8; const size_t go = (size_t)(t0 + t) * D + cb + k8;
        float v[8], gg[8]; float bc;
        {   float r[8], a[8], b[8], kh[8], ct[8];
#pragma unroll
            for (int e = 0; e < 8; ++e) { r[e] = pr[e]; v[e] = pv[e]; gg[e] = pg[e]; }
            lds8(cum + t * 64 + k8, ct);
            rc_prep8(pkr, pal, kkw, kaw, a, b, kh);
            if (u + us < ue) { const int un = u + us; const int cn = un >> 4, hn = un & 15; rc_load_wd(p, cn * 64, hn * 64, pwd);
                const size_t gn = (size_t)(cn * 64 + t) * D + hn * 64 + k8; ld8b(WS_(p, Rb) + gn, pr); ld8b(WS_(p, Kb) + gn, pkr); ld8b(WS_(p, Ab) + gn, pal); ld8b(WS_(p, Vb) + gn, pv); ld8b(WS_(p, Gb) + gn, pg); }
            bc = 0.f;
#pragma unroll
            for (int e = 0; e < 8; ++e) bc += r[e] * kh[e] * rkw[e];
            bc += __shfl_xor(bc, 1); bc += __shfl_xor(bc, 2); bc += __shfl_xor(bc, 4);
#pragma unroll
            for (int e = 0; e < 8; ++e) { const float ei = __expf(-ct[e]); r[e] *= __expf(ct[e]); b[e] *= ei; kh[e] *= ei; }
            *(LAS u32x4*)(Rs + t * RC_LD + k8) = pk8(r); *(LAS u32x4*)(Bs + t * RC_LD + k8) = pk8(b); *(LAS u32x4*)(Ks + t * RC_LD + k8) = pk8(kh); *(LAS u32x4*)(Vs + t * RC_LD + k8) = pk8(v);
        }
        lds_barrier();
#ifdef DBL_S3
#pragma unroll 1
        for (int rep_ = 0; rep_ < 2; ++rep_)
#endif
        {   const int tb = w >> 1;
#pragma unroll
            for (int ii = 0; ii < 2; ++ii) { const int ib = 2 * (w & 1) + ii;
                f32x4 ab = {0.f, 0.f, 0.f, 0.f}, ak = {0.f, 0.f, 0.f, 0.f};
                if (ib <= tb) {
#pragma unroll
                    for (int ks = 0; ks < 2; ++ks) { const bf16x8 af = frag_rm(Rs, RC_LD, 16 * tb, 32 * ks, lane);
                        ab = MFMA16(af, frag_rm(Bs, RC_LD, 16 * ib, 32 * ks, lane), ab); ak = MFMA16(af, frag_rm(Ks, RC_LD, 16 * ib, 32 * ks, lane), ak); } }
#pragma unroll
                for (int r = 0; r < 4; ++r) { const int tr = 16 * tb + 4 * fq + r, i = 16 * ib + fr; const bool keep = i <= tr;
                    Arb[tr * RC_LD + i] = (bf16_t)f2bf(keep ? ab[r] : 0.f); Ark[tr * RC_LD + i] = (bf16_t)f2bf(keep ? ak[r] : 0.f); } }
        }
        lds_barrier();
#ifdef DBL_Y
#pragma unroll 1
        for (int rep_ = 0; rep_ < 2; ++rep_)
#endif
#pragma unroll
        for (int q = 0; q < 2; ++q) { const int vbk = 2 * (w >> 2) + q; f32x4 acc = {0.f, 0.f, 0.f, 0.f};
#pragma unroll
            for (int ks = 0; ks < 2; ++ks) {
                acc = MFMA16(frag_rm_pi(Rs, RC_LD, 16 * tt, 32 * ks, lane), sfr[q][ks], acc);
                acc = MFMA16(frag_rm_pi(Arb, RC_LD, 16 * tt, 32 * ks, lane), ufr[q][ks], acc);
                acc = MFMA16(frag_rm(Ark, RC_LD, 16 * tt, 32 * ks, lane), frag_tr(Vs, RC_LD, 32 * ks, 16 * vbk, lane), acc); }
#pragma unroll
            for (int r = 0; r < 4; ++r) Ys[(16 * tt + 4 * fq + r) * 68 + 16 * vbk + fr] = acc[r]; }
        lds_barrier();
        {
            float y[8]; lds8(Ys + t * 68 + k8, y);
            float s1 = 0.f, s2 = 0.f;
#pragma unroll
            for (int e = 0; e < 8; ++e) { s1 += y[e]; s2 += y[e] * y[e]; }
            s1 += __shfl_xor(s1, 1); s1 += __shfl_xor(s1, 2); s1 += __shfl_xor(s1, 4); s2 += __shfl_xor(s2, 1); s2 += __shfl_xor(s2, 2); s2 += __shfl_xor(s2, 4);
            const float mean = s1 * (1.0f / 64.0f), var = s2 * (1.0f / 64.0f) - mean * mean; const float rs = rsqrtf(fmaxf(var, 0.f) + 64e-5f);
            float o[8];
#pragma unroll
            for (int e = 0; e < 8; ++e) o[e] = ((y[e] - mean) * rs * lgw[e] + lbw[e] + bc * v[e]) * gg[e];
            *(u32x4*)(WS_(p, YB) + go) = pk8(o);
        }
    }
}
DEV void phase_ln1(const Params& p, int layer, LAS unsigned char* lds) {
    const int tid = tid_(), bid = bid_(); (void)tid; (void)bid;
    const int lane = tid & 63, wid = tid >> 6; const int fr = lane & 15, fq = lane >> 4;
    LAS float* lgt = (LAS float*)lds;
    LAS int* cnt = (LAS int*)(lgt + 2 * 64 * 48);
    if (tid < 32) cnt[tid] = 0;
    const float* g = p.ln_g + ((size_t)layer * 2 + 0) * D; const float* be = p.ln_b + ((size_t)layer * 2 + 0) * D;
    const float* br = p.moe_b_route + layer * 32; const float* bg = p.moe_b_group + layer * 4;
    f32x4 gwv[4], bwv[4];
#pragma unroll
    for (int q = 0; q < 4; ++q) { gwv[q] = *(const f32x4*)(g + RCOL(q, lane)); bwv[q] = *(const f32x4*)(be + RCOL(q, lane)); }
    u32x2 rh[4], rm[4];
#pragma unroll
    for (int q = 0; q < 4; ++q) { rh[q] = *(const u32x2*)(WS_(p, Hb) + (size_t)(bid * 64 + wid * 8) * D + RCOL(q, lane)); rm[q] = *(const u32x2*)(WS_(p, MIXb) + (size_t)(bid * 64 + wid * 8) * D + RCOL(q, lane)); }
#pragma unroll 1
    for (int rr = 0; rr < 8; ++rr) {
        const int t = bid * 64 + wid * 8 + rr; const size_t ro = (size_t)t * D;
        f32x4 z[4], m[4];
#pragma unroll
        for (int q = 0; q < 4; ++q) { z[q] = (f32x4){bflo(rh[q].x), bfhi(rh[q].x), bflo(rh[q].y), bfhi(rh[q].y)}; m[q] = (f32x4){bflo(rm[q].x), bfhi(rm[q].x), bflo(rm[q].y), bfhi(rm[q].y)}; }
        { const size_t rn = (size_t)(rr < 7 ? t + 1 : t) * D;
#pragma unroll
          for (int q = 0; q < 4; ++q) { rh[q] = *(const u32x2*)(WS_(p, Hb) + rn + RCOL(q, lane)); rm[q] = *(const u32x2*)(WS_(p, MIXb) + rn + RCOL(q, lane)); } }
        float s = 0.f;
#pragma unroll
        for (int q = 0; q < 4; ++q) { z[q] = z[q] * ALPHA + m[q]; s += z[q][0] + z[q][1] + z[q][2] + z[q][3]; }
        const float mean = wave_sum(s) * (1.0f / D);
        float vs = 0.f;
#pragma unroll
        for (int q = 0; q < 4; ++q) { z[q] = z[q] - mean; vs += z[q][0] * z[q][0] + z[q][1] * z[q][1] + z[q][2] * z[q][2] + z[q][3] * z[q][3]; }
        const float rs = rsqrtf(wave_sum(vs) * (1.0f / D) + LN_EPS);
#pragma unroll
        for (int q = 0; q < 4; ++q) {
            st_bf4(WS_(p, H1b) + ro + RCOL(q, lane), z[q] * rs * gwv[q] + bwv[q]);
        }
    }
    asm volatile("s_waitcnt vmcnt(0)" ::: "memory");
    __syncthreads();
    {   const int rt = wid & 3, kh = wid >> 2;
        const bf16_t* Ab = WS_(p, H1b) + (size_t)(bid * 64 + 16 * rt + fr) * D + 512 * kh + 8 * fq;
        const bf16_t* Wb = WS_(p, moe_wr_t) + (size_t)layer * 48 * D + (size_t)fr * D + 512 * kh + 8 * fq;
        f32x4 acc[3]; for (int i = 0; i < 3; ++i) acc[i] = (f32x4){0.f, 0.f, 0.f, 0.f};
#pragma unroll 8
        for (int ks = 0; ks < 16; ++ks) {
            const bf16x8 af = *(const bf16x8*)(Ab + 32 * ks);
#pragma unroll
            for (int ct = 0; ct < 3; ++ct) acc[ct] = MFMA16(af, *(const bf16x8*)(Wb + (size_t)16 * ct * D + 32 * ks), acc[ct]);
        }
#pragma unroll
        for (int ct = 0; ct < 3; ++ct)
#pragma unroll
            for (int r = 0; r < 4; ++r) lgt[(kh * 64 + 16 * rt + 4 * fq + r) * 48 + 16 * ct + fr] = acc[ct][r];
    }
    __syncthreads();
    if (tid < 64) {
        const int t = bid * 64 + tid; const LAS float* L0 = lgt + tid * 48; const LAS float* L1 = lgt + (64 + tid) * 48;
        const float q0 = L0[32] + L1[32] + bg[0], q1 = L0[33] + L1[33] + bg[1], q2 = L0[34] + L1[34] + bg[2], q3 = L0[35] + L1[35] + bg[3];
        int gi = 0; float gm = q0;
        if (q1 > gm) { gm = q1; gi = 1; } if (q2 > gm) { gm = q2; gi = 2; } if (q3 > gm) { gm = q3; gi = 3; }
        const float den = __expf(q0 - gm) + __expf(q1 - gm) + __expf(q2 - gm) + __expf(q3 - gm);
        const float pgrp = __builtin_amdgcn_rcpf(den);
        float l1 = -INFINITY, l2 = -INFINITY; int i1 = 0, i2 = 0;
#pragma unroll 1
        for (int o = 0; o < 8; ++o) { const float v = L0[gi * 8 + o] + L1[gi * 8 + o] + br[gi * 8 + o];
            if (v > l1) { l2 = l1; i2 = i1; l1 = v; i1 = o; } else if (v > l2) { l2 = v; i2 = o; } }
        const float e2 = __expf(l2 - l1), inv = __builtin_amdgcn_rcpf(1.0f + e2);
        const int e0 = gi * 8 + i1, e1 = gi * 8 + i2;
        WS_(p, EIDX)[2 * t] = e0; WS_(p, EIDX)[2 * t + 1] = e1; WS_(p, GATE)[2 * t] = pgrp * inv; WS_(p, GATE)[2 * t + 1] = pgrp * e2 * inv;
        atomicAdd((int*)&cnt[e0], 1); atomicAdd((int*)&cnt[e1], 1);
    }
    __syncthreads();
    if (tid < 32) WS_(p, CNT)[bid * 32 + tid] = cnt[tid];
}

DEV void phase_moe_scatter(const Params& p, LAS unsigned char* lds) {
    const int tid = tid_(), bid = bid_(); (void)tid; (void)bid;
    const int lane = tid & 63, wid = tid >> 6;
    LAS int* part = (LAS int*)lds;
    LAS int* pre = part + 512;
    LAS int* base = pre + 512;
    LAS int* pst = base + 32;
    LAS int* dst = pst + 40;
    LAS int* eid = dst + 128;
    { const int e = tid & 31, part_i = tid >> 5; int tot = 0, prf = 0;
      for (int b = part_i * 16; b < part_i * 16 + 16; ++b) { const int c = WS_(p, CNT)[b * 32 + e]; tot += c; if (b < (int)bid) prf += c; }
      part[part_i * 32 + e] = tot; pre[part_i * 32 + e] = prf; }
    if (tid < 128) eid[tid] = WS_(p, EIDX)[bid * 128 + tid];
    if (bid == 1 && tid < MFLAG_TICKET + 32) __hip_atomic_store(WS_(p, MFLAG) + tid * MFLAG_STRIDE, 0u, __ATOMIC_RELAXED, __HIP_MEMORY_SCOPE_AGENT);
    lds_barrier();
    if (tid < 32) { int tot = 0, prf = 0; for (int i = 0; i < 16; ++i) { tot += part[i * 32 + tid]; prf += pre[i * 32 + tid]; } part[tid] = tot; pre[tid] = prf; }
    lds_barrier();
    if (tid == 0) { int acc = 0; for (int e = 0; e < 32; ++e) { pst[e] = acc; acc += ((part[e] + 255) >> 8) << 8; } pst[32] = acc;
        if (bid == 0) { for (int e = 0; e <= 32; ++e) WS_(p, TAB)[e] = pst[e]; WS_(p, TAB)[33] = acc >> 8;
            for (int e = 0; e < 32; ++e) for (int mt = pst[e] >> 8; mt < (pst[e + 1] >> 8); ++mt) WS_(p, TAB)[64 + mt] = e; } }
    lds_barrier();
    if (tid < 32) { int run = pst[tid] + pre[tid];
#pragma unroll 16
        for (int a = 0; a < 128; ++a) if (eid[a] == tid) dst[a] = run++; }
    lds_barrier();
    if (tid < 128) WS_(p, DEST)[bid * 128 + tid] = dst[tid];
    if (tid < 128) ((int*)WS_(p, BUF))[dst[tid]] = bid * 64 + (tid >> 1);
}

template <int which> struct SchedMoe {
    const Params* p; int layer; const LAS int* tab;
    DEV bool next(int i, Unit& u) const {
        const int nmt = tab[33]; int pm, pn; if (!pg8::tile_order(i, NB_, which == 0 ? bid_() : ((bid_() + 128) & 255), nmt, 4, pm, pn)) return false;
        const int row0 = pm * 256; const int e = tab[64 + pm];
        if constexpr (which == 0) { u.A = (const char*)WS_(*p, H1b); u.B = (const char*)(WS_(*p, moe_w1_t) + ((size_t)layer * 32 + e) * 1024 * 1024 + (size_t)pn * 256 * 1024); }
        else {
            if (tid_() == 0) { unsigned* f = WS_(*p, MFLAG) + pm * MFLAG_STRIDE; unsigned sp = 0;
                while (__hip_atomic_load(f, __ATOMIC_RELAXED, __HIP_MEMORY_SCOPE_AGENT) < 4u) { __builtin_amdgcn_s_sleep(1); if (++sp > (1u << 24)) break; }
                __builtin_amdgcn_fence(__ATOMIC_ACQUIRE, "agent");
                asm volatile("s_waitcnt vmcnt(0)" ::: "memory"); }
            __builtin_amdgcn_s_barrier();
            u.A = (const char*)(WS_(*p, ACT) + (size_t)row0 * 512); u.B = (const char*)(WS_(*p, moe_w2_t) + ((size_t)layer * 32 + e) * 1024 * 512 + (size_t)pn * 256 * 512); }
        u.row0 = row0; u.col0 = pn * 256; u.id = e; u.aux = 0; return true;
    }
};
struct EpiMoe1 {
    bf16_t* O; unsigned* flag;
    DEV void operator()(const AccT& acc, const Unit& u, int wr, int wc, int fr, int fq) const {
        const __amdgpu_buffer_rsrc_t rs = __builtin_amdgcn_make_buffer_rsrc(O, 0, MOE_ROWS * 512 * 2, 0x00020000);
#pragma unroll
        for (int ai = 0; ai < 2; ++ai)
#pragma unroll
            for (int m = 0; m < 4; ++m) {
                f32x4 v[2];
#pragma unroll
                for (int n = 0; n < 2; ++n) { const f32x4 gt = acc[ai][0][m][n], up = acc[ai][1][m][n]; for (int e = 0; e < 4; ++e) v[n][e] = siluf_(gt[e]) * up[e]; }
                const int col = (u.col0 >> 1) + 32 * wc + (PF(6) ? 8 * fq : 4 * fq);
                if (PF(6)) __builtin_amdgcn_raw_buffer_store_b128(pk8v(v[0], v[1]), rs, (unsigned)((ACC_ROW(u, ai, m) * 512 + col) * 2), 0, 16);
                else { const u32x4 w = pk8v(v[0], v[1]); unsigned long long* q = (unsigned long long*)(O + (size_t)ACC_ROW(u, ai, m) * 512 + col);
                  __hip_atomic_store(q, (unsigned long long)w.x | ((unsigned long long)w.y << 32), __ATOMIC_RELAXED, __HIP_MEMORY_SCOPE_AGENT);
                  __hip_atomic_store(q + 4, (unsigned long long)w.z | ((unsigned long long)w.w << 32), __ATOMIC_RELAXED, __HIP_MEMORY_SCOPE_AGENT); }
                ACC_FENCE;
            }
        asm volatile("s_waitcnt vmcnt(0)" ::: "memory");
        __builtin_amdgcn_s_barrier();
        if (wr == 1 && wc == 0 && fr == 0 && fq == 0) __hip_atomic_fetch_add(flag + (u.row0 >> 8) * MFLAG_STRIDE, 1u, __ATOMIC_RELAXED, __HIP_MEMORY_SCOPE_AGENT);
    }
};
struct EpiMoe2 {
    bf16_t* O;
    DEV void operator()(const AccT& acc, const Unit& u, int wr, int wc, int fr, int fq) const {
        FOR_ACC2(ai, bj, m) { st_bf8p(O + (size_t)ACC_ROW(u, ai, m) * D + ACC_COL8P(u, bj, PF(7)), acc[ai][bj][m][0], acc[ai][bj][m][1], PF(7)); ACC_FENCE; }
    }
};

struct Ln2Raw { u32x2 h[4], a[4], b[4]; float g0, g1; };
DEV void ln2_issue(const Params& p, int t, int lane, Ln2Raw& R, int dpre, float gpre, int tbase) {
    const int i0 = 2 * (t - tbase); const int d0 = __shfl(dpre, i0), d1 = __shfl(dpre, i0 + 1); R.g0 = __shfl(gpre, i0); R.g1 = __shfl(gpre, i0 + 1);
#pragma unroll
    for (int q = 0; q < 4; ++q) { R.h[q] = *(const u32x2*)(WS_(p, H1b) + (size_t)t * D + RCOL(q, lane));
        R.a[q] = *(const u32x2*)(WS_(p, YBUF) + (size_t)d0 * D + RCOL(q, lane)); R.b[q] = *(const u32x2*)(WS_(p, YBUF) + (size_t)d1 * D + RCOL(q, lane)); }
}
DEV void ln2_finish(const Ln2Raw& R, const f32x4 (&gwv)[4], const f32x4 (&bwv)[4], f32x4 (&z)[4]) {
    float s = 0.f; const float g0 = R.g0, g1 = R.g1;
#pragma unroll
    for (int q = 0; q < 4; ++q) {
        z[q][0] = bflo(R.h[q].x) * ALPHA + g0 * bflo(R.a[q].x) + g1 * bflo(R.b[q].x); z[q][1] = bfhi(R.h[q].x) * ALPHA + g0 * bfhi(R.a[q].x) + g1 * bfhi(R.b[q].x);
        z[q][2] = bflo(R.h[q].y) * ALPHA + g0 * bflo(R.a[q].y) + g1 * bflo(R.b[q].y); z[q][3] = bfhi(R.h[q].y) * ALPHA + g0 * bfhi(R.a[q].y) + g1 * bfhi(R.b[q].y);
        s += z[q][0] + z[q][1] + z[q][2] + z[q][3];
    }
    const float mean = wave_sum(s) * (1.0f / D);
    float vs = 0.f;
#pragma unroll
    for (int q = 0; q < 4; ++q) { z[q] = z[q] - mean; vs += z[q][0] * z[q][0] + z[q][1] * z[q][1] + z[q][2] * z[q][2] + z[q][3] * z[q][3]; }
    const float rs = rsqrtf(wave_sum(vs) * (1.0f / D) + LN_EPS);
#pragma unroll
    for (int q = 0; q < 4; ++q) z[q] = z[q] * rs * gwv[q] + bwv[q];
}
DEV void phase_ln2(const Params& p, int layer, LAS unsigned char* lds) {
    const int tid = tid_(), bid = bid_(); const int lane = tid & 63, wid = tid >> 6; const int fr = lane & 15, fq = lane >> 4;
    const float* g = p.ln_g + ((size_t)layer * 2 + 1) * D; const float* be = p.ln_b + ((size_t)layer * 2 + 1) * D;
    const int nk = layer == DEPTH - 1 ? 3 : (layer + 1) % 3;
    const int nj = (layer + 1) / 3;
    LAS float* lgt = (LAS float*)lds;
    LAS float* w2 = lgt + 2 * 64 * 32;
    if (nk == 2) { for (int i = tid; i < 16 * 512; i += NTHR) w2[i] = p.gl_gk_w2[(size_t)nj * 16 * 512 + i]; }
    const int tfirst = bid * 64 + wid * 8;
    f32x4 z[4], zp[4], gwv[4], bwv[4];
#pragma unroll
    for (int q = 0; q < 4; ++q) { gwv[q] = *(const f32x4*)(g + RCOL(q, lane)); bwv[q] = *(const f32x4*)(be + RCOL(q, lane)); }
    Ln2Raw R[3];
    const int tbase = tfirst > 0 ? tfirst - 1 : 0;
    const int dpre = lane < 18 ? WS_(p, DEST)[2 * tbase + lane] : 0; const float gpre = lane < 18 ? WS_(p, GATE)[2 * tbase + lane] : 0.f;
    if (nk == 0) { if (tfirst > 0) { ln2_issue(p, tfirst - 1, lane, R[2], dpre, gpre, tbase); } }
    ln2_issue(p, tfirst, lane, R[0], dpre, gpre, tbase);
    ln2_issue(p, tfirst + 1, lane, R[1], dpre, gpre, tbase);
    if (nk == 0) { if (tfirst > 0) ln2_finish(R[2], gwv, bwv, zp); else { for (int q = 0; q < 4; ++q) zp[q] = (f32x4){0.f, 0.f, 0.f, 0.f}; } }
#pragma unroll
    for (int rr = 0; rr < 8; ++rr) {
        const int t = tfirst + rr; const size_t ro = (size_t)t * D;
        if (rr + 2 < 8) ln2_issue(p, t + 2, lane, R[(rr + 2) % 3], dpre, gpre, tbase);
        ln2_finish(R[rr % 3], gwv, bwv, z);
        if (nk == 3) {
#pragma unroll
            for (int q = 0; q < 4; ++q) *(f32x4*)(p.out + ro + RCOL(q, lane)) = z[q];
        } else store_row_bf(WS_(p, Hb) + ro, lane, z);
        if (nk == 0) {
            emit_mix6(p, nj, t, lane, z, zp);
#pragma unroll
            for (int q = 0; q < 4; ++q) zp[q] = z[q];
        }
    }
    if (nk == 1 || nk == 2) {
        asm volatile("s_waitcnt vmcnt(0)" ::: "memory");
        __syncthreads();
        const int nct = nk == 1 ? 2 : 1; const int rt = wid & 3, kh = wid >> 2;
        const bf16_t* Ab = WS_(p, Hb) + (size_t)(bid * 64 + 16 * rt + fr) * D + 512 * kh + 8 * fq;
        const bf16_t* Wb = (nk == 1 ? WS_(p, mb_dt_t) : WS_(p, gl_lr_t)) + (size_t)fr * D + 512 * kh + 8 * fq;
        f32x4 acc[2]; acc[0] = (f32x4){0.f, 0.f, 0.f, 0.f}; acc[1] = acc[0];
#pragma unroll 4
        for (int ks = 0; ks < 16; ++ks) {
            const bf16x8 af = *(const bf16x8*)(Ab + 32 * ks);
            acc[0] = MFMA16(af, *(const bf16x8*)(Wb + 32 * ks), acc[0]);
            if (nct == 2) acc[1] = MFMA16(af, *(const bf16x8*)(Wb + (size_t)16 * D + 32 * ks), acc[1]);
        }
#pragma unroll
        for (int ct = 0; ct < 2; ++ct)
#pragma unroll
            for (int r = 0; r < 4; ++r) lgt[(kh * 64 + 16 * rt + 4 * fq + r) * 32 + 16 * ct + fr] = acc[ct][r];
        __syncthreads();
        if (nk == 1) {
#pragma unroll
            for (int i = 0; i < 4; ++i) { const int idx = tid + i * NTHR; const int row = idx >> 5, o = idx & 31;
                WS_(p, DT)[(size_t)(bid * 64 + row) * 32 + o] = softplusf_(lgt[row * 32 + o] + lgt[(64 + row) * 32 + o] + p.mb_dt_bias[nj * 32 + o]); }
        } else {
            const int row = tid >> 3, c0 = (tid & 7) * 64; float lr[16];
#pragma unroll
            for (int o = 0; o < 16; ++o) lr[o] = lgt[row * 32 + o] + lgt[(64 + row) * 32 + o];
#pragma unroll 1
            for (int c4 = 0; c4 < 16; ++c4) { const int c = c0 + 4 * c4; f32x4 a = *(const f32x4*)(p.gl_gk_b + nj * 512 + c);
#pragma unroll
                for (int o = 0; o < 16; ++o) { const f32x4 wv = *(const LAS f32x4*)(w2 + o * 512 + c); a = a + wv * lr[o]; }
                f32x4 r;
#pragma unroll
                for (int e = 0; e < 4; ++e) r[e] = (fminf(a[e], 0.f) - __logf(1.0f + __expf(-fabsf(a[e])))) * (1.0f / 16.0f);
                *(f32x4*)(WS_(p, LA) + (size_t)(bid * 64 + row) * 512 + c) = r; }
        }
    }
}
constexpr int MB_PROJ = 5152;
struct SchedMbIn {
    const Params* p;
    DEV bool next(int i, Unit& u) const {
        int pm, pn; if (!pg8::tile_order(i, NB_, bid_(), 64, 20, pm, pn)) return false;
        u.A = (const char*)(WS_(*p, Hb) + (size_t)pm * 256 * D); u.B = (const char*)(WS_(*p, mb_win_t) + (size_t)pn * 256 * D); u.row0 = pm * 256; u.col0 = pn * 256; u.id = 0; u.aux = 0; return true;
    }
};
struct EpiMbIn {
    const Params* p;
    DEV void operator()(const AccT& acc, const Unit& u, int wr, int wc, int fr, int fq) const {
        const bool isz = u.col0 < 2048; bf16_t* O = WS_(*p, Z) + (isz ? (size_t)0 : (size_t)T * 2048 - 2048); const int ld = isz ? 2048 : 3072;
        FOR_ACC2(ai, bj, m) { st_bf8p(O + (size_t)ACC_ROW(u, ai, m) * ld + ACC_COL8P(u, bj, PF(4)), acc[ai][bj][m][0], acc[ai][bj][m][1], PF(4)); ACC_FENCE; }
    }
};
DEV void phase_mb_conv(const Params& p, int j) {
    const int tid = tid_(), bid = bid_(); (void)tid; (void)bid;
    if (tid >= 384) return;
    const int c0 = tid * 8; const int t0 = bid * 64;
    const float* cw = p.mb_conv_w + (size_t)j * 4 * 3072; const float* cb = p.mb_conv_b + (size_t)j * 3072;
    float w[4][8], b[8];
#pragma unroll
    for (int i = 0; i < 4; ++i) { const f32x4 a = *(const f32x4*)(cw + i * 3072 + c0), bb = *(const f32x4*)(cw + i * 3072 + c0 + 4); for (int e = 0; e < 4; ++e) { w[i][e] = a[e]; w[i][4 + e] = bb[e]; } }
    { const f32x4 a = *(const f32x4*)(cb + c0), bb = *(const f32x4*)(cb + c0 + 4); for (int e = 0; e < 4; ++e) { b[e] = a[e]; b[4 + e] = bb[e]; } }
    float x0[8], x1[8], x2[8], x3[8];
    auto ld = [&](int t, float (&x)[8]) {
        if (t < 0) { for (int e = 0; e < 8; ++e) x[e] = 0.f; return; }
        const u32x4 v = *(const u32x4*)(WS_(p, XBC) + (size_t)t * 3072 + c0);
        x[0] = bflo(v.x); x[1] = bfhi(v.x); x[2] = bflo(v.y); x[3] = bfhi(v.y); x[4] = bflo(v.z); x[5] = bfhi(v.z); x[6] = bflo(v.w); x[7] = bfhi(v.w);
    };
    ld(t0 - 3, x0); ld(t0 - 2, x1); ld(t0 - 1, x2);
#pragma unroll 4
    for (int tt = 0; tt < 64; ++tt) {
        ld(t0 + tt, x3);
        float o[8];
#pragma unroll
        for (int e = 0; e < 8; ++e) o[e] = siluf_(b[e] + w[0][e] * x0[e] + w[1][e] * x1[e] + w[2][e] * x2[e] + w[3][e] * x3[e]);
        u32x4 r; r.x = pk2(o[0], o[1]); r.y = pk2(o[2], o[3]); r.z = pk2(o[4], o[5]); r.w = pk2(o[6], o[7]);
        *(u32x4*)(WS_(p, XC) + (size_t)(t0 + tt) * 3072 + c0) = r;
#pragma unroll
        for (int e = 0; e < 8; ++e) { x0[e] = x1[e]; x1[e] = x2[e]; x2[e] = x3[e]; }
    }
}

DEV void mb_dacs(const Params& p, int j, int c, int g, LAS float* dts, LAS float* dacs) {
    const int tid = tid_(); const int lane = tid & 63, h = tid >> 6;
    const int hh = 8 * g + h; const float a = -__expf(p.mb_a_log[j * 32 + hh]);
    const float d0 = WS_(p, DT)[(size_t)(c * 128 + 2 * lane) * 32 + hh], d1 = WS_(p, DT)[(size_t)(c * 128 + 2 * lane + 1) * 32 + hh];
    const float a0 = d0 * a, a1 = d1 * a;
    float s = a0 + a1;
#pragma unroll
    for (int o = 1; o < 64; o <<= 1) { const float v = __shfl_up(s, o); if (lane >= o) s += v; }
    dts[h * 128 + 2 * lane] = d0; dts[h * 128 + 2 * lane + 1] = d1;
    dacs[h * 128 + 2 * lane] = s - a1; dacs[h * 128 + 2 * lane + 1] = s;
}
constexpr int LDB = 136;
constexpr int LDX = 72;
DEV void ld_tile128(const bf16_t* src, int gld, LAS bf16_t* dst) {
    const int tid = tid_();
    for (int i = tid; i < 128 * 16; i += NTHR) { const int r = i >> 4, c8 = (i & 15) * 8; *(LAS u32x4*)(dst + r * LDB + c8) = *(const u32x4*)(src + (size_t)r * gld + c8); }
}

DEV void phase_mb_states(const Params& p, int j, LAS unsigned char* lds) {
    const int tid = tid_(), bid = bid_(); (void)tid; (void)bid;
    const int lane = tid & 63, w = tid >> 6;
    LAS bf16_t* Bm = (LAS bf16_t*)lds;
    LAS bf16_t* Xh = Bm + 128 * LDB;
    LAS float* dts = (LAS float*)(Xh + 128 * LDX);
    LAS float* dacs = dts + 1024;
    for (int u = bid; u < 512; u += NB_) {
        const int c = u >> 2, g = u & 3; const int t0 = c * 128;
        lds_barrier();
        mb_dacs(p, j, c, g, dts, dacs);
        ld_tile128(WS_(p, XC) + (size_t)t0 * 3072 + 2048 + 128 * g, 3072, Bm);
        lds_barrier();
        if (tid < 8) WS_(p, CD)[(c * 32) + 8 * g + tid] = __expf(dacs[tid * 128 + 127]);
        bf16x8 bfr[4];
#pragma unroll
        for (int ks = 0; ks < 4; ++ks) bfr[ks] = frag_tr(Bm, LDB, 32 * ks, 16 * w, lane);
        for (int h = 0; h < 8; ++h) {
            { const int l = tid >> 2, p0 = (tid & 3) * 16; const float sc = dts[h * 128 + l] * __expf(dacs[h * 128 + 127] - dacs[h * 128 + l]);
              const bf16_t* src = WS_(p, XC) + (size_t)(t0 + l) * 3072 + 64 * (8 * g + h) + p0;
#pragma unroll
              for (int hf = 0; hf < 2; ++hf) { const u32x4 v = *(const u32x4*)(src + 8 * hf); u32x4 r;
                  r.x = pk2(bflo(v.x) * sc, bfhi(v.x) * sc); r.y = pk2(bflo(v.y) * sc, bfhi(v.y) * sc); r.z = pk2(bflo(v.z) * sc, bfhi(v.z) * sc); r.w = pk2(bflo(v.w) * sc, bfhi(v.w) * sc);
                  *(LAS u32x4*)(Xh + l * LDX + p0 + 8 * hf) = r; } }
            lds_barrier();
            f32x4 acc[4];
#pragma unroll
            for (int pb = 0; pb < 4; ++pb) { acc[pb] = (f32x4){0.f, 0.f, 0.f, 0.f};
#pragma unroll
                for (int ks = 0; ks < 4; ++ks) { const bf16x8 af = frag_tr(Xh, LDX, 32 * ks, 16 * pb, lane); acc[pb] = MFMA16(af, bfr[ks], acc[pb]); } }
            bf16_t* S = WS_(p, STATES) + (((size_t)c * 32 + 8 * g + h) * 64) * 128;
#pragma unroll
            for (int pb = 0; pb < 4; ++pb)
#pragma unroll
                for (int r = 0; r < 4; ++r) S[(size_t)(16 * pb + 4 * (lane >> 4) + r) * 128 + 16 * w + (lane & 15)] = (bf16_t)f2bf(acc[pb][r]);
            lds_barrier();
        }
    }
}
DEV void phase_mb_scan(const Params& p) {
    const int tid = tid_(), bid = bid_();
    if (tid >= 128) return;
    const int gid = bid * 128 + tid;
    const int n8 = gid & 15, pp = (gid >> 4) & 63, h = gid >> 10; const int n = 8 * n8;
    float r[8]; for (int e = 0; e < 8; ++e) r[e] = 0.f;
    const size_t eo = ((size_t)h * 64 + pp) * 128 + n;
    const size_t fo = (size_t)h * 64 * 128 + fragmajor_off(pp, n, 128);
#pragma unroll 8
    for (int c = 0; c < 128; ++c) {
        const u32x4 sr = *(const u32x4*)(WS_(p, STATES) + (size_t)c * 32 * 64 * 128 + eo);
        const float cd = WS_(p, CD)[c * 32 + h];
        u32x4 o; o.x = pk2(r[0], r[1]); o.y = pk2(r[2], r[3]); o.z = pk2(r[4], r[5]); o.w = pk2(r[6], r[7]);
        *(u32x4*)(WS_(p, PREV) + (size_t)c * 32 * 64 * 128 + fo) = o;
        r[0] = r[0] * cd + bflo(sr.x); r[1] = r[1] * cd + bfhi(sr.x); r[2] = r[2] * cd + bflo(sr.y); r[3] = r[3] * cd + bfhi(sr.y);
        r[4] = r[4] * cd + bflo(sr.z); r[5] = r[5] * cd + bfhi(sr.z); r[6] = r[6] * cd + bflo(sr.w); r[7] = r[7] * cd + bfhi(sr.w);
    }
}
DEV void phase_mb_out(const Params& p, int j, LAS unsigned char* lds) {
    const int tid = tid_(), bid = bid_(); (void)tid; (void)bid;
    const int lane = tid & 63, w = tid >> 6; const int fr = lane & 15, fq = lane >> 4;
    LAS bf16_t* Cm = (LAS bf16_t*)lds;
    LAS bf16_t* Bm = Cm + 128 * LDB;
    LAS bf16_t* Xh = Bm + 128 * LDB;
    LAS bf16_t* Mw = Xh + 128 * LDX;
    LAS float* dts = (LAS float*)(Mw + 8 * 16 * LDB);
    LAS float* dacs = dts + 1024;
    LAS bf16_t* Mme = Mw + w * 16 * LDB;
    for (int u = bid; u < 512; u += NB_) {
        const int c = u >> 2, g = u & 3; const int t0 = c * 128;
        lds_barrier();
        mb_dacs(p, j, c, g, dts, dacs);
        ld_tile128(WS_(p, XC) + (size_t)t0 * 3072 + 2048 + 512 + 128 * g, 3072, Cm);
        ld_tile128(WS_(p, XC) + (size_t)t0 * 3072 + 2048 + 128 * g, 3072, Bm);
        lds_barrier();
        f32x4 sc[8]; bf16x8 cf[4];
#pragma unroll
        for (int ks = 0; ks < 4; ++ks) cf[ks] = frag_rm(Cm, LDB, 16 * w, 32 * ks, lane);
#pragma unroll
        for (int sb = 0; sb < 8; ++sb) { sc[sb] = (f32x4){0.f, 0.f, 0.f, 0.f};
#pragma unroll
            for (int ks = 0; ks < 4; ++ks) sc[sb] = MFMA16(cf[ks], frag_rm(Bm, LDB, 16 * sb, 32 * ks, lane), sc[sb]); }
        float ssq = 0.f;
        const int rl = tid >> 2, p0 = (tid & 3) * 16;
        const LAS float* Yrow = (const LAS float*)(Mw + (rl >> 4) * 16 * LDB) + (rl & 15) * 68 + p0;
        LAS float* Yw = (LAS float*)Mme;
        u32x4 xraw[2], zraw[2], xnx[2], znx[2]; bf16x8 pfc[16];
#define MB_LOADH(HH, XR, ZR) do { const int hh_ = 8 * g + (HH); \
            XR[0] = *(const u32x4*)(WS_(p, XC) + (size_t)(t0 + rl) * 3072 + 64 * hh_ + p0); XR[1] = *(const u32x4*)(WS_(p, XC) + (size_t)(t0 + rl) * 3072 + 64 * hh_ + p0 + 8); \
            ZR[0] = *(const u32x4*)(WS_(p, Z) + (size_t)(t0 + rl) * 2048 + 64 * hh_ + p0); ZR[1] = *(const u32x4*)(WS_(p, Z) + (size_t)(t0 + rl) * 2048 + 64 * hh_ + p0 + 8); } while (0)
        MB_LOADH(0, xraw, zraw);
#pragma unroll 1
        for (int h = 0; h < 8; ++h) {
            const int hh = 8 * g + h;
            MB_LOADH(h < 7 ? h + 1 : h, xnx, znx);
            { const bf16_t* pv_ = WS_(p, PREV) + ((size_t)c * 32 + hh) * 64 * 128;
#pragma unroll
              for (int i_ = 0; i_ < 16; ++i_) pfc[i_] = *(const bf16x8*)(pv_ + ((size_t)i_ * 64 + lane) * 8); }
            { const float scl = dts[h * 128 + rl];
#pragma unroll
              for (int hf = 0; hf < 2; ++hf) { const u32x4 v = xraw[hf]; u32x4 r;
                  r.x = pk2(bflo(v.x) * scl, bfhi(v.x) * scl); r.y = pk2(bflo(v.y) * scl, bfhi(v.y) * scl); r.z = pk2(bflo(v.z) * scl, bfhi(v.z) * scl); r.w = pk2(bflo(v.w) * scl, bfhi(v.w) * scl);
                  *(LAS u32x4*)(Xh + rl * LDX + p0 + 8 * hf) = r; } }
            const u32x4 zraw0 = zraw[0], zraw1 = zraw[1];
            float dl[4];
#pragma unroll
            for (int r = 0; r < 4; ++r) dl[r] = dacs[h * 128 + 16 * w + 4 * fq + r];
#pragma unroll
            for (int sb = 0; sb < 8; ++sb) { const int s_ = 16 * sb + fr; const float ds = dacs[h * 128 + s_];
#pragma unroll
                for (int r = 0; r < 4; ++r) { const int l = 16 * w + 4 * fq + r; const float m = (s_ <= l) ? sc[sb][r] * __expf(dl[r] - ds) : 0.f; Mme[(4 * fq + r) * LDB + s_] = (bf16_t)f2bf(m); } }
            lds_barrier();
            bf16x8 mf[4];
#pragma unroll
            for (int ks = 0; ks < 4; ++ks) mf[ks] = frag_rm(Mme, LDB, 0, 32 * ks, lane);
            f32x4 yv[4];
#pragma unroll
            for (int pb = 0; pb < 4; ++pb) {
                f32x4 a = {0.f, 0.f, 0.f, 0.f}, o = {0.f, 0.f, 0.f, 0.f};
#pragma unroll
                for (int ks = 0; ks < 4; ++ks) {
                    a = MFMA16(mf[ks], frag_tr(Xh, LDX, 32 * ks, 16 * pb, lane), a);
                    o = MFMA16(cf[ks], pfc[pb * 4 + ks], o);
                }
#pragma unroll
                for (int r = 0; r < 4; ++r) a[r] += o[r] * __expf(dl[r]);
                yv[pb] = a;
            }
#pragma unroll
            for (int pb = 0; pb < 4; ++pb)
#pragma unroll
                for (int r = 0; r < 4; ++r) Yw[(4 * fq + r) * 68 + 16 * pb + fr] = yv[pb][r];
            lds_barrier();
            {
                const float dsk = p.mb_d[j * 32 + hh]; const float* ng = p.mb_norm_g + (size_t)j * 2048 + 64 * hh + p0;
                float y[16], xs[16], zz[16];
#pragma unroll
                for (int q = 0; q < 4; ++q) { const f32x4 t4 = *(const LAS f32x4*)(Yrow + 4 * q); y[4 * q] = t4[0]; y[4 * q + 1] = t4[1]; y[4 * q + 2] = t4[2]; y[4 * q + 3] = t4[3]; }
                xs[0] = bflo(xraw[0].x); xs[1] = bfhi(xraw[0].x); xs[2] = bflo(xraw[0].y); xs[3] = bfhi(xraw[0].y); xs[4] = bflo(xraw[0].z); xs[5] = bfhi(xraw[0].z); xs[6] = bflo(xraw[0].w); xs[7] = bfhi(xraw[0].w);
                xs[8] = bflo(xraw[1].x); xs[9] = bfhi(xraw[1].x); xs[10] = bflo(xraw[1].y); xs[11] = bfhi(xraw[1].y); xs[12] = bflo(xraw[1].z); xs[13] = bfhi(xraw[1].z); xs[14] = bflo(xraw[1].w); xs[15] = bfhi(xraw[1].w);
                zz[0] = bflo(zraw0.x); zz[1] = bfhi(zraw0.x); zz[2] = bflo(zraw0.y); zz[3] = bfhi(zraw0.y); zz[4] = bflo(zraw0.z); zz[5] = bfhi(zraw0.z); zz[6] = bflo(zraw0.w); zz[7] = bfhi(zraw0.w);
                zz[8] = bflo(zraw1.x); zz[9] = bfhi(zraw1.x); zz[10] = bflo(zraw1.y); zz[11] = bfhi(zraw1.y); zz[12] = bflo(zraw1.z); zz[13] = bfhi(zraw1.z); zz[14] = bflo(zraw1.w); zz[15] = bfhi(zraw1.w);
                float o[16];
#pragma unroll
                for (int q = 0; q < 4; ++q) { const f32x4 n4 = *(const f32x4*)(ng + 4 * q);
#pragma unroll
                    for (int e = 0; e < 4; ++e) { const int i = 4 * q + e; const float v = (y[i] + xs[i] * dsk) * siluf_(zz[i]); ssq += v * v; o[i] = v * n4[e]; } }
                bf16_t* dst = WS_(p, YB) + (size_t)(t0 + rl) * 2048 + 64 * hh + p0;
                u32x4 w0, w1; w0.x = pk2(o[0], o[1]); w0.y = pk2(o[2], o[3]); w0.z = pk2(o[4], o[5]); w0.w = pk2(o[6], o[7]); w1.x = pk2(o[8], o[9]); w1.y = pk2(o[10], o[11]); w1.z = pk2(o[12], o[13]); w1.w = pk2(o[14], o[15]);
                *(u32x4*)dst = w0; *(u32x4*)(dst + 8) = w1;
            }
            xraw[0] = xnx[0]; xraw[1] = xnx[1]; zraw[0] = znx[0]; zraw[1] = znx[1];
            lds_barrier();
        }
#undef MB_LOADH
        ssq += __shfl_xor(ssq, 1); ssq += __shfl_xor(ssq, 2);
        const float rstd = rsqrtf(ssq * (1.0f / 512.0f) + 1e-5f);
#pragma unroll 1
        for (int h = 0; h < 8; ++h) {
            bf16_t* dst = WS_(p, YB) + (size_t)(t0 + rl) * 2048 + 64 * (8 * g + h) + p0;
#pragma unroll
            for (int hf = 0; hf < 2; ++hf) { const u32x4 v = *(const u32x4*)(dst + 8 * hf); u32x4 r;
                r.x = pk2(bflo(v.x) * rstd, bfhi(v.x) * rstd); r.y = pk2(bflo(v.y) * rstd, bfhi(v.y) * rstd); r.z = pk2(bflo(v.z) * rstd, bfhi(v.z) * rstd); r.w = pk2(bflo(v.w) * rstd, bfhi(v.w) * rstd);
                *(u32x4*)(dst + 8 * hf) = r; }
        }
    }
}
constexpr int GL_PROJ = 3088;
constexpr int LDV = 264;
struct SchedGlIn {
    const Params* p;
    DEV bool next(int i, Unit& u) const {
        int pm, pn; if (!pg8::tile_order(i, NB_, bid_(), 64, 12, pm, pn)) return false;
        u.A = (const char*)(WS_(*p, Hb) + (size_t)pm * 256 * D); u.B = (const char*)(WS_(*p, gl_win_t) + (size_t)pn * 256 * D); u.row0 = pm * 256; u.col0 = pn * 256; u.id = 0; u.aux = 0; return true;
    }
};
struct EpiGlIn {
    const Params* p;
    DEV void operator()(const AccT& acc, const Unit& u, int wr, int wc, int fr, int fq) const {
        FOR_ACC2(ai, bj, m) { st_bf8p(WS_(*p, QKVG) + (size_t)ACC_ROW(u, ai, m) * 3072 + ACC_COL8P(u, bj, PF(5)), acc[ai][bj][m][0], acc[ai][bj][m][1], PF(5)); ACC_FENCE; }
    }
};
DEV void gl_bcs(const Params& p, int n, int h, LAS float* bcs) {
    const int tid = tid_();
    for (int i = tid; i < 64 * 32; i += NTHR) { const int r = i >> 5, c4 = (i & 31) * 4; *(LAS f32x4*)(bcs + r * 128 + c4) = *(const f32x4*)(WS_(p, LA) + (size_t)(n * 64 + r) * 512 + 128 * h + c4); }
    lds_barrier();
    if (tid < 128) { float s = 0.f; for (int r = 0; r < 64; ++r) { s += bcs[r * 128 + tid]; bcs[r * 128 + tid] = s; } }
    lds_barrier();
}
DEV void phase_gl_kv(const Params& p, LAS unsigned char* lds) {
    const int tid = tid_(), bid = bid_(); (void)tid; (void)bid;
    const int lane = tid & 63, w = tid >> 6;
    LAS float* bcs = (LAS float*)lds;
    LAS bf16_t* Ke = (LAS bf16_t*)(bcs + 64 * 128);
    LAS bf16_t* Vs = Ke + 64 * LDB;
    for (int u = bid; u < 1024; u += NB_) {
        const int n = u >> 2, h = u & 3; const int t0 = n * 64;
        lds_barrier();
        gl_bcs(p, n, h, bcs);
        for (int i = tid; i < 64 * 16; i += NTHR) { const int r = i >> 4, c8 = (i & 15) * 8;
            const u32x4 v = *(const u32x4*)(WS_(p, QKVG) + (size_t)(t0 + r) * 3072 + 512 + 128 * h + c8); float f[8];
            f[0] = bflo(v.x); f[1] = bfhi(v.x); f[2] = bflo(v.y); f[3] = bfhi(v.y); f[4] = bflo(v.z); f[5] = bfhi(v.z); f[6] = bflo(v.w); f[7] = bfhi(v.w);
#pragma unroll
            for (int e = 0; e < 8; ++e) f[e] *= __expf(bcs[63 * 128 + c8 + e] - bcs[r * 128 + c8 + e]);
            u32x4 o; o.x = pk2(f[0], f[1]); o.y = pk2(f[2], f[3]); o.z = pk2(f[4], f[5]); o.w = pk2(f[6], f[7]);
            *(LAS u32x4*)(Ke + r * LDB + c8) = o; }
        for (int i = tid; i < 64 * 32; i += NTHR) { const int r = i >> 5, c8 = (i & 31) * 8; *(LAS u32x4*)(Vs + r * LDV + c8) = *(const u32x4*)(WS_(p, QKVG) + (size_t)(t0 + r) * 3072 + 1024 + 256 * h + c8); }
        if (tid < 128) WS_(p, CDG)[((size_t)n * 4 + h) * 128 + tid] = __expf(bcs[63 * 128 + tid]);
        lds_barrier();
        bf16x8 af[2];
#pragma unroll
        for (int ks = 0; ks < 2; ++ks) af[ks] = frag_tr(Ke, LDB, 32 * ks, 16 * w, lane);
        bf16_t* O = WS_(p, STATES) + (((size_t)n * 4 + h) * 128) * 256;
#pragma unroll
        for (int vb = 0; vb < 16; ++vb) {
            f32x4 acc = {0.f, 0.f, 0.f, 0.f};
#pragma unroll
            for (int ks = 0; ks < 2; ++ks) acc = MFMA16(af[ks], frag_tr(Vs, LDV, 32 * ks, 16 * vb, lane), acc);
            { u32x2 o; o.x = pk2(acc[0], acc[1]); o.y = pk2(acc[2], acc[3]); *(u32x2*)(O + (size_t)(16 * vb + (lane & 15)) * 128 + 16 * w + 4 * (lane >> 4)) = o; }
        }
    }
}
DEV void phase_gl_scan(const Params& p) {
    const int tid = tid_(), bid = bid_();
    if (tid >= 64) return;
    const int gid = bid * 64 + tid;
    const int k8 = gid & 15, v = (gid >> 4) & 255, h = gid >> 12; const int k = 8 * k8;
    float r[8]; for (int e = 0; e < 8; ++e) r[e] = 0.f;
    const size_t fo = (size_t)h * 128 * 256 + fragmajor_off(v, k, 128);
#pragma unroll 8
    for (int n = 0; n < 256; ++n) {
        const u32x4 sr = *(const u32x4*)(WS_(p, STATES) + (((size_t)n * 4 + h) * 256 + v) * 128 + k);
        const f32x4 c0 = *(const f32x4*)(WS_(p, CDG) + ((size_t)n * 4 + h) * 128 + k), c1 = *(const f32x4*)(WS_(p, CDG) + ((size_t)n * 4 + h) * 128 + k + 4);
        u32x4 o; o.x = pk2(r[0], r[1]); o.y = pk2(r[2], r[3]); o.z = pk2(r[4], r[5]); o.w = pk2(r[6], r[7]);
        *(u32x4*)(WS_(p, PREV) + (size_t)n * 4 * 128 * 256 + fo) = o;
        r[0] = r[0] * c0[0] + bflo(sr.x); r[1] = r[1] * c0[1] + bfhi(sr.x); r[2] = r[2] * c0[2] + bflo(sr.y); r[3] = r[3] * c0[3] + bfhi(sr.y);
        r[4] = r[4] * c1[0] + bflo(sr.z); r[5] = r[5] * c1[1] + bfhi(sr.z); r[6] = r[6] * c1[2] + bflo(sr.w); r[7] = r[7] * c1[3] + bfhi(sr.w);
    }
}
DEV void phase_gl_out(const Params& p, int j, LAS unsigned char* lds) {
    const int tid = tid_(), bid = bid_(); (void)tid; (void)bid;
    const int lane = tid & 63, w = tid >> 6; const int fr = lane & 15, fq = lane >> 4;
    LAS float* bcs = (LAS float*)lds;
    LAS bf16_t* Qs = (LAS bf16_t*)(bcs + 64 * 128);
    LAS bf16_t* Ks = Qs + 64 * LDB;
    LAS bf16_t* Vs = Ks + 64 * LDB;
    LAS bf16_t* At = Vs + 64 * LDV;
    LAS float* red = (LAS float*)(At + 64 * LDX);
    for (int u = bid; u < 1024; u += NB_) {
        const int n = u >> 2, h = u & 3; const int t0 = n * 64;
        lds_barrier();
        gl_bcs(p, n, h, bcs);
        for (int i = tid; i < 64 * 16; i += NTHR) { const int r = i >> 4, c8 = (i & 15) * 8;
            const u32x4 vq = *(const u32x4*)(WS_(p, QKVG) + (size_t)(t0 + r) * 3072 + 128 * h + c8), vk = *(const u32x4*)(WS_(p, QKVG) + (size_t)(t0 + r) * 3072 + 512 + 128 * h + c8);
            float fq_[8], fk_[8];
            fq_[0] = bflo(vq.x); fq_[1] = bfhi(vq.x); fq_[2] = bflo(vq.y); fq_[3] = bfhi(vq.y); fq_[4] = bflo(vq.z); fq_[5] = bfhi(vq.z); fq_[6] = bflo(vq.w); fq_[7] = bfhi(vq.w);
            fk_[0] = bflo(vk.x); fk_[1] = bfhi(vk.x); fk_[2] = bflo(vk.y); fk_[3] = bfhi(vk.y); fk_[4] = bflo(vk.z); fk_[5] = bfhi(vk.z); fk_[6] = bflo(vk.w); fk_[7] = bfhi(vk.w);
#pragma unroll
            for (int e = 0; e < 8; ++e) { const float b = bcs[r * 128 + c8 + e]; fq_[e] *= __expf(b) * 0.08838834764831845f; fk_[e] *= __expf(-b); }
            u32x4 o; o.x = pk2(fq_[0], fq_[1]); o.y = pk2(fq_[2], fq_[3]); o.z = pk2(fq_[4], fq_[5]); o.w = pk2(fq_[6], fq_[7]);
            *(LAS u32x4*)(Qs + r * LDB + c8) = o;
            o.x = pk2(fk_[0], fk_[1]); o.y = pk2(fk_[2], fk_[3]); o.z = pk2(fk_[4], fk_[5]); o.w = pk2(fk_[6], fk_[7]);
            *(LAS u32x4*)(Ks + r * LDB + c8) = o; }
        for (int i = tid; i < 64 * 32; i += NTHR) { const int r = i >> 5, c8 = (i & 31) * 8; *(LAS u32x4*)(Vs + r * LDV + c8) = *(const u32x4*)(WS_(p, QKVG) + (size_t)(t0 + r) * 3072 + 1024 + 256 * h + c8); }
        lds_barrier();
        { const int ib = w >> 1;
#pragma unroll
          for (int jj = 0; jj < 2; ++jj) { const int jb = 2 * (w & 1) + jj; f32x4 a = {0.f, 0.f, 0.f, 0.f};
#pragma unroll
              for (int ks = 0; ks < 4; ++ks) a = MFMA16(frag_rm(Qs, LDB, 16 * ib, 32 * ks, lane), frag_rm(Ks, LDB, 16 * jb, 32 * ks, lane), a);
#pragma unroll
              for (int r = 0; r < 4; ++r) { const int i = 16 * ib + 4 * fq + r, jx = 16 * jb + fr; At[i * LDX + jx] = (bf16_t)f2bf(jx <= i ? a[r] : 0.f); } } }
        lds_barrier();
        f32x4 o[4][2];
        const bf16_t* pv = WS_(p, PREV) + ((size_t)n * 4 + h) * 128 * 256;
#pragma unroll
        for (int vv = 0; vv < 2; ++vv) { const int vb = 2 * w + vv;
            bf16x8 bi[2], bp[4];
#pragma unroll
            for (int ks = 0; ks < 2; ++ks) bi[ks] = frag_tr(Vs, LDV, 32 * ks, 16 * vb, lane);
#pragma unroll
            for (int ks = 0; ks < 4; ++ks) bp[ks] = *(const bf16x8*)(pv + ((size_t)(vb * 4 + ks) * 64 + lane) * 8);
#pragma unroll
            for (int ib = 0; ib < 4; ++ib) { f32x4 a = {0.f, 0.f, 0.f, 0.f};
#pragma unroll
                for (int ks = 0; ks < 2; ++ks) a = MFMA16(frag_rm(At, LDX, 16 * ib, 32 * ks, lane), bi[ks], a);
#pragma unroll
                for (int ks = 0; ks < 4; ++ks) a = MFMA16(frag_rm(Qs, LDB, 16 * ib, 32 * ks, lane), bp[ks], a);
                o[ib][vv] = a; } }
#pragma unroll
        for (int ib = 0; ib < 4; ++ib)
#pragma unroll
            for (int r = 0; r < 4; ++r) { float s = o[ib][0][r] * o[ib][0][r] + o[ib][1][r] * o[ib][1][r]; s = sum16(s); if (fr == 0) red[w * 64 + 16 * ib + 4 * fq + r] = s; }
        lds_barrier();
        {   LAS bf16_t* Os = (LAS bf16_t*)bcs;
#pragma unroll
            for (int ib = 0; ib < 4; ++ib)
#pragma unroll
                for (int vv = 0; vv < 2; ++vv)
#pragma unroll
                    for (int r = 0; r < 4; ++r) Os[(16 * ib + 4 * fq + r) * LDV + 32 * w + 16 * vv + fr] = (bf16_t)f2bf(o[ib][vv][r]);
            lds_barrier();
            const int row = tid >> 3, c0 = (tid & 7) * 32; const int t = t0 + row; float s = 0.f;
#pragma unroll
            for (int ww = 0; ww < 8; ++ww) s += red[ww * 64 + row];
            const float rs = rsqrtf(s * (1.0f / 256.0f) + 1e-5f);
#pragma unroll
            for (int q = 0; q < 4; ++q) {
                const u32x4 ov = *(const LAS u32x4*)(Os + row * LDV + c0 + 8 * q), gv = *(const u32x4*)(WS_(p, QKVG) + (size_t)t * 3072 + 2048 + 256 * h + c0 + 8 * q);
                const f32x4 n0 = *(const f32x4*)(p.gl_norm_g + j * 256 + c0 + 8 * q), n1 = *(const f32x4*)(p.gl_norm_g + j * 256 + c0 + 8 * q + 4);
                float r8[8];
                r8[0] = bflo(ov.x) * rs * n0[0] * siluf_(bflo(gv.x)); r8[1] = bfhi(ov.x) * rs * n0[1] * siluf_(bfhi(gv.x)); r8[2] = bflo(ov.y) * rs * n0[2] * siluf_(bflo(gv.y)); r8[3] = bfhi(ov.y) * rs * n0[3] * siluf_(bfhi(gv.y));
                r8[4] = bflo(ov.z) * rs * n1[0] * siluf_(bflo(gv.z)); r8[5] = bfhi(ov.z) * rs * n1[1] * siluf_(bfhi(gv.z)); r8[6] = bflo(ov.w) * rs * n1[2] * siluf_(bflo(gv.w)); r8[7] = bfhi(ov.w) * rs * n1[3] * siluf_(bfhi(gv.w));
                u32x4 wv; wv.x = pk2(r8[0], r8[1]); wv.y = pk2(r8[2], r8[3]); wv.z = pk2(r8[4], r8[5]); wv.w = pk2(r8[6], r8[7]);
                *(u32x4*)(WS_(p, YB) + (size_t)t * D + 256 * h + c0 + 8 * q) = wv;
            }
        }
    }
}
#define XB_TMO      128
#define XB_XCNT(j)  (256  + 64 * (j))
#define XB_XSUB(j)  (1280 + 64 * (j))
#define XB_XGEN(j)  (2304 + 64 * (j))
#define XB_TOP      3328
#define XB_TOPGEN   3392
#define XCD_BAR_WORDS 3456
#define XB_SPIN_CAP (1u << 22)
DEV unsigned xb_ld(unsigned* p)              { return __hip_atomic_load(p, __ATOMIC_RELAXED, __HIP_MEMORY_SCOPE_AGENT); }
DEV unsigned xb_add(unsigned* p, unsigned v) { return __hip_atomic_fetch_add(p, v, __ATOMIC_RELAXED, __HIP_MEMORY_SCOPE_AGENT); }
DEV unsigned xb_xcc_id() { return (unsigned)__builtin_amdgcn_s_getreg((3 << 11) | 20) & 0xFu; }
#define XB_SPIN(cond, bar) do { unsigned _sp = 0; while (cond) { __builtin_amdgcn_s_sleep(1); \
    if ((++_sp & 255u) == 0u) { if (xb_ld(&(bar)[XB_TMO])) break; if (_sp > XB_SPIN_CAP) { atomicAdd(&(bar)[XB_TMO], 1u); break; } } } } while (0)
struct XcdBarrier { unsigned* bar; unsigned x; volatile LAS unsigned* st; };
DEV XcdBarrier xcd_barrier_post(unsigned* bar, volatile LAS unsigned* st) {
    XcdBarrier b; b.bar = bar; b.x = xb_xcc_id(); b.st = st;
    if (threadIdx.x == 0) (void)xb_add(&bar[XB_XCNT(b.x)], 1u);
    return b;
}
DEV void xcd_barrier_complete(unsigned* bar, unsigned x, unsigned& nloc, unsigned& nx) {
    const unsigned G = gridDim.x * gridDim.y * gridDim.z;
    unsigned sum, cnt, mine, sp = 0u;
    for (;;) {
        sum = 0u; cnt = 0u; mine = 0u;
#pragma unroll
        for (unsigned j = 0; j < 16; ++j) { const unsigned c = xb_ld(&bar[XB_XCNT(j)]); sum += c; cnt += (c > 0u) ? 1u : 0u; mine = (j == x) ? c : mine; }
        if (sum == G) break;
        __builtin_amdgcn_s_sleep(1);
        if ((++sp & 255u) == 0u) { if (xb_ld(&bar[XB_TMO])) break; if (sp > XB_SPIN_CAP) { atomicAdd(&bar[XB_TMO], 1u); break; } }
    }
    nloc = mine > 0u ? mine : 1u; nx = cnt > 0u ? cnt : 1u;
}
DEV void xcd_barrier(const XcdBarrier& b) {
    asm volatile("s_waitcnt vmcnt(0)" ::: "memory");
    __syncthreads();
    if (threadIdx.x == 0) {
        unsigned* bar = b.bar;
        __builtin_amdgcn_s_waitcnt(0);
        unsigned nloc = b.st[0], nx = b.st[1];
        if (nloc == 0u) { xcd_barrier_complete(bar, b.x, nloc, nx); b.st[0] = nloc; b.st[1] = nx; }
        const unsigned old = xb_add(&bar[XB_XSUB(b.x)], 1u);
        const unsigned gen = old / nloc;
        if (old + 1u == (gen + 1u) * nloc) {
            __builtin_amdgcn_fence(__ATOMIC_RELEASE, "agent");
            asm volatile("s_waitcnt vmcnt(0)" ::: "memory");
            const unsigned og = xb_add(&bar[XB_TOP], 1u);
            const unsigned tg = og / nx;
            if (og + 1u == (tg + 1u) * nx) xb_add(&bar[XB_TOPGEN], 1u);
            else XB_SPIN(xb_ld(&bar[XB_TOPGEN]) == tg, bar);
            __builtin_amdgcn_fence(__ATOMIC_ACQUIRE, "agent");
            xb_add(&bar[XB_XGEN(b.x)], 1u);
            asm volatile("s_waitcnt vmcnt(0)" ::: "memory");
        } else {
            XB_SPIN(xb_ld(&bar[XB_XGEN(b.x)]) == gen, bar);
            __builtin_amdgcn_fence(__ATOMIC_ACQUIRE, "agent");
            asm volatile("s_waitcnt vmcnt(0)" ::: "memory");
        }
    }
    __syncthreads();
}

#ifndef RW1T
#define RW1T 3584
#endif
#ifndef MOE1S
#define MOE1S 5632
#endif
constexpr int RW1_TAIL_TILES = RW1T, MOE1_SPLIT_TILES = MOE1S;
DEV void moe_tail_convert(const Params& p, LAS unsigned char* lds, int layer) {
    if (layer > 1) return;
    convert_tickets(moe_job(p, 0, layer + 1), moe_job(p, 1, layer + 1), lds, WS_(p, MFLAG) + MFLAG_TICKET * MFLAG_STRIDE, MFLAG_STRIDE, layer == 0 ? MOE1_SPLIT_TILES : 0);
}
DEV LAS int* moe_tab_to_lds(const Params& p, LAS unsigned char* lds) {
    LAS int* tab = (LAS int*)(lds + pg8::STAGE_BYTES);
    const int tid = tid_();
    if (tid < 256) tab[tid] = __hip_atomic_load(WS_(p, TAB) + tid, __ATOMIC_RELAXED, __HIP_MEMORY_SCOPE_AGENT);
    __syncthreads();
    return tab;
}
DEV void rw_side_convert(const Params& p, LAS unsigned char* lds, int c0, int n) {
#pragma unroll 1
    for (int c = c0; c < c0 + n; ++c) {
        const int ml = c == 0 ? 0 : c == 3 ? 1 : 3;
        const ConvJob J0 = (c == 1 || c == 2) ? make_job(p, 6 + 2 * c) : moe_job(p, 0, ml), J1 = (c == 1 || c == 2) ? make_job(p, 7 + 2 * c) : moe_job(p, 1, ml);
        const int t0 = (c == 0 || c == 4) ? RW1_TAIL_TILES : 0, t1 = c == 3 ? MOE1_SPLIT_TILES : 1 << 30;
        convert_tickets(J0, J1, lds, WS_(p, MFLAG) + (MFLAG_SIDE + 32 * c) * MFLAG_STRIDE, MFLAG_STRIDE, t0, t1);
    }
}
DEV void run_phase(const Params& pin, int op, int arg, LAS unsigned char* lds) {
    Params p = pin; { size_t z_ = 0; asm volatile("" : "+s"(z_)); p.ws = pin.ws + z_; }
    const int layer = arg; const int jj = layer / 3;
#ifdef ONLY_OP
    if (op != ONLY_OP) return;
#endif
#ifdef OPMASK
    if (!((OPMASK >> op) & 1ull)) return;
#endif
    switch (op) {
    case OP_CONVERT: phase_pre0(p); phase_convert(p, lds);
#ifdef DBG
        if (blockIdx.x == 0 && threadIdx.x < 24) WS_(p, TAB)[200 + threadIdx.x] = 0;
#endif
        break;
    case OP_PRE0: break;
    case OP_RW_GEMM1: { SchedRW1 S{&p, jj}; EpiRW1 E{&p}; pg8::gemm_phase(lds, 1024, S, E); }
        convert_tickets(moe_job(p, 0, layer), moe_job(p, 1, layer), lds, WS_(p, MFLAG) + (MFLAG_SIDE + 32 * (layer == 0 ? 5 : 6)) * MFLAG_STRIDE, MFLAG_STRIDE, 0, RW1_TAIL_TILES); break;
    case OP_RW_GEMM2: { SchedRW2 S{&p, jj}; EpiRW2 E{&p, jj}; pg8::gemm_phase(lds, 256, S, E); } break;
#ifdef REP_RW
#define REPL_(OPX) _Pragma("unroll 1") for (int rep_ = 0; rep_ < ((OPX) == REP_RW && layer == REP_L ? 2 : 1); ++rep_)
#else
#define REPL_(OPX)
#endif
#define RW_AC(FN, half, k) do { const int hs_ = (half) * 2048, tl_ = hs_ + 2048 - 64 * (k); \
        if (bid_() >= RW_NB) FN(p, jj, lds, hs_ + bid_() - RW_NB, tl_, RW_NW); else if ((k) > 0) { __syncthreads(); FN(p, jj, lds, tl_ + bid_(), hs_ + 2048, RW_NB); } } while (0)
    case OP_RW_CHA: if (bid_() >= RW_NB) phase_rw_cha(p, jj, lds, bid_() - RW_NB, 2048, RW_NW); __syncthreads(); rw_side_convert(p, lds, layer == 0 ? 0 : 4, 1); break;
    case OP_RW_CHB: if (bid_() < RW_NB) phase_rw_chb(p, lds, 0); RW_AC(phase_rw_cha, 1, 0); __syncthreads(); if (layer == 0) rw_side_convert(p, lds, 1, 2); break;
    case OP_RW_CHC: if (bid_() < RW_NB) phase_rw_chb(p, lds, 1); RW_AC(phase_rw_chc, 0, 0); break;
    case OP_RW_CHD: RW_AC(phase_rw_chc, 1, 8); __syncthreads(); if (layer == 0) rw_side_convert(p, lds, 3, 1); break;
    case OP_RW_OUT: { SchedOut S{WS_(p, YB), WS_(p, rw_wo_t) + (size_t)jj * D * D, 1024}; EpiOut E{WS_(p, MIXb)}; pg8::gemm_phase(lds, 1024, S, E); } break;
    case OP_LN1: phase_ln1(p, layer, lds); break;
    case OP_MOE_SCATTER: phase_moe_scatter(p, lds); break;
    case OP_MOE_GEMM1: { LAS int* tab = moe_tab_to_lds(p, lds);
#ifdef REP_MOE
#pragma unroll 1
        for (int rep_ = 0; rep_ < REP_MOE; ++rep_) {
#endif
        { SchedMoe<0> S{&p, layer, tab}; EpiMoe1 E{WS_(p, ACT), WS_(p, MFLAG)};
          LAS int* gtab = (LAS int*)(lds + pg8::STAGE_BYTES + 1024);
#pragma unroll 1
          for (int i = 0; i < 3; ++i) { Unit u; if (S.next(i, u) && tid_() < 256) { const int tok = ((const int*)WS_(p, BUF))[u.row0 + tid_()]; gtab[i * 256 + tid_()] = (unsigned)tok < (unsigned)T ? tok : 0; } }
          __syncthreads();
          pg8::gemm_phase<EpiMoe1, SchedMoe<0>, true>(lds, 1024, S, E, (const char*)WS_(p, H1b), gtab); }
        { SchedMoe<1> S{&p, layer, tab}; EpiMoe2 E{WS_(p, YBUF)}; pg8::gemm_phase(lds, 512, S, E); }
#ifdef REP_MOE
        }
#endif
        moe_tail_convert(p, lds, layer); } break;
    case OP_MOE_GEMM2: break;
    case OP_LN2: phase_ln2(p, layer, lds); break;
    case OP_MB_GEMM_IN: { SchedMbIn S{&p}; EpiMbIn E{&p}; pg8::gemm_phase(lds, 1024, S, E); } break;
    case OP_MB_CONV: phase_mb_conv(p, jj); break;
    case OP_MB_STATES: phase_mb_states(p, jj, lds); break;
    case OP_MB_SCAN: phase_mb_scan(p); break;
    case OP_MB_OUT: phase_mb_out(p, jj, lds); break;
    case OP_MB_GEMM_OUT: { SchedOut S{WS_(p, YB), WS_(p, mb_wout_t) + (size_t)jj * D * 2048, 2048}; EpiOut E{WS_(p, MIXb)}; pg8::gemm_phase(lds, 2048, S, E); } break;
    case OP_GL_GEMM_IN: { SchedGlIn S{&p}; EpiGlIn E{&p}; pg8::gemm_phase(lds, 1024, S, E); } break;
    case OP_GL_KV: phase_gl_kv(p, lds); break;
    case OP_GL_SCAN: phase_gl_scan(p); break;
    case OP_GL_OUT: phase_gl_out(p, jj, lds); break;
    case OP_GL_GEMM_OUT: { SchedOut S{WS_(p, YB), WS_(p, gl_wout_t) + (size_t)jj * D * D, 1024}; EpiOut E{WS_(p, MIXb)}; pg8::gemm_phase(lds, 1024, S, E); } break;
    default: break;
    }
}

constexpr int NPHASES = 1 + 11 + 10 + 9 + 11;
DEV void decode_phase(int ph, int& op, int& layer) {
    if (ph < 1) { op = OP_CONVERT; layer = 0; return; }
    int q = ph - 1; layer = 0;
    if (q >= 11) { q -= 11; layer = 1; if (q >= 10) { q -= 10; layer = 2; if (q >= 9) { q -= 9; layer = 3; } } }
    const int kind = layer % 3; const int nmix = kind == 0 ? 7 : kind == 1 ? 6 : 5;
    if (q < nmix) op = (kind == 0 ? OP_RW_GEMM1 : kind == 1 ? OP_MB_GEMM_IN : OP_GL_GEMM_IN) + q;
    else { const int m = q - nmix; op = m < 3 ? OP_LN1 + m : OP_LN2; }
}

#define X(t, n) t n##_,
template <bool COOP>
__global__ void __launch_bounds__(NTHR, 2) mega(PARAM_LIST(X) const int ph0, const int ph1) {
#undef X
    Params p;
#define X(t, n) p.n = n##_;
    PARAM_LIST(X)
#undef X

    extern __shared__ __attribute__((aligned(16))) unsigned char smem_raw[];
    LAS unsigned char* lds = (LAS unsigned char*)smem_raw;
    if constexpr (COOP) {
        volatile LAS unsigned* st = (volatile LAS unsigned*)(lds + LDS_BYTES - 16);
        if (threadIdx.x == 0) { st[0] = 0u; st[1] = 0u; }
        __syncthreads();
        XcdBarrier xb = xcd_barrier_post(WS_(p, bar), st);
        if (ph0 < 0) cg::this_grid().sync();
        for (int ph = ph0; ph < ph1; ++ph) {
            int op, arg; decode_phase(ph, op, arg);
#ifdef REPEAT_MASK
            const int reps = 1 + (int)((REPEAT_MASK >> op) & 1ull);
#else
            const int reps = 1;
#endif
#pragma unroll 1
            for (int rep = 0; rep < reps; ++rep) {
                run_phase(p, op, arg, lds);
                if (ph + 1 < ph1 || rep + 1 < reps) { xcd_barrier(xb);
#ifdef BAR2
                    xcd_barrier(xb);
#endif
                }
            }
        }
#ifdef DBG
        xcd_barrier(xb);
#ifndef DBG_WORD
#define DBG_WORD 200
#endif
        { const int code = __hip_atomic_load(WS_(p, TAB) + DBG_WORD, __ATOMIC_RELAXED, __HIP_MEMORY_SCOPE_AGENT);
          for (size_t i = (size_t)blockIdx.x * NTHR + threadIdx.x; i < (size_t)T * D; i += (size_t)NB_ * NTHR) p.out[i] = 0.f;
          __syncthreads();
          if (blockIdx.x == 0 && threadIdx.x == 0) p.out[0] = sqrtf((float)DBG_DECODE(code) * 1.68e7f); }
#endif
    } else {
        for (int ph = ph0; ph < ph1; ++ph) { int op, arg; decode_phase(ph, op, arg); run_phase(p, op, arg, lds); }
    }
}


extern "C" void kernel_launch(void* const* d_in, const int* in_sizes, int n_in, void* d_out, int out_size, void* d_ws, size_t ws_size, hipStream_t stream) {
    (void)in_sizes; (void)n_in; (void)out_size;
    Params p; std::memset((void*)&p, 0, sizeof(p));
    auto F = [&](int i) { return (const float*)d_in[i]; };
    p.x = F(0); p.ln_g = F(1); p.ln_b = F(2);
    p.rw_mu = F(3); p.rw_w_rkv = F(4); p.rw_w0 = F(5); p.rw_w1 = F(6); p.rw_w2 = F(7); p.rw_a0 = F(8);
    p.rw_a1 = F(9); p.rw_a2 = F(10); p.rw_g1 = F(11); p.rw_g2 = F(12);
    p.rw_k_k = F(13); p.rw_k_a = F(14); p.rw_r_k = F(15); p.rw_lnx_g = F(16); p.rw_lnx_b = F(17); p.rw_w_o = F(18);
    p.mb_w_in = F(19); p.mb_conv_w = F(20); p.mb_conv_b = F(21); p.mb_dt_bias = F(22); p.mb_a_log = F(23); p.mb_d = F(24); p.mb_norm_g = F(25); p.mb_w_out = F(26);
    p.gl_w_in = F(27); p.gl_gk_w2 = F(28); p.gl_gk_b = F(29); p.gl_norm_g = F(30); p.gl_w_out = F(31);
    p.moe_w_group = F(32); p.moe_b_group = F(33); p.moe_w_route = F(34); p.moe_b_route = F(35); p.moe_w_in = F(36); p.moe_w_down = F(37);
    p.out = (float*)d_out;
    p.ws = (char*)d_ws;
    if (WS_TOTAL > ws_size) { fprintf(stderr, "workspace too small: need %zu have %zu\n", (size_t)WS_TOTAL, ws_size); return; }
    unsigned* bar_ptr = (unsigned*)(p.ws + OFF_bar);
    const int np = NPHASES;
#define X(t, n) (void*)&p.n,
#if SINGLE_LAUNCH
    (void)hipFuncSetAttribute((const void*)mega<true>, hipFuncAttributeMaxDynamicSharedMemorySize, LDS_BYTES);
    (void)hipMemsetAsync(bar_ptr, 0, XCD_BAR_WORDS * sizeof(unsigned), stream);
    int ph0 = 0, ph1 = np; void* args[] = {PARAM_LIST(X) (void*)&ph0, (void*)&ph1};
    hipError_t e = hipLaunchCooperativeKernel((const void*)mega<true>, dim3(NBLK), dim3(NTHR), args, LDS_BYTES, stream);
    if (e != hipSuccess) fprintf(stderr, "cooperative launch failed: %s\n", hipGetErrorString(e));
#else
    (void)hipFuncSetAttribute((const void*)mega<false>, hipFuncAttributeMaxDynamicSharedMemorySize, LDS_BYTES);
    for (int ph = 0; ph < np; ++ph) { int ph0 = ph, ph1 = ph + 1; void* args[] = {PARAM_LIST(X) (void*)&ph0, (void*)&ph1};
        hipError_t e = hipLaunchKernel((const void*)mega<false>, dim3(NBLK), dim3(NTHR), args, LDS_BYTES, stream);
        if (e != hipSuccess) fprintf(stderr, "launch failed: %s\n", hipGetErrorString(e)); }
#endif
#undef X
}
```
